# Optimizing an MI355X kernel written in HIP

```python
import math
import jax, jax.numpy as jnp
from jax import lax
import numpy as np

D_MODEL = 1024
BATCH = 16
SEQ = 2048
DEPTH = 2

N_META = 16
CHUNK = 64
Q_BLOCK = 128
FRONT_PAD = Q_BLOCK - N_META
EPS = 1e-6
NEG = -1e30
ROPE_THETA = 10000.0

GROUP_W = D_MODEL // 4
GLA_HEADS = 4
GLA_DK = GROUP_W // GLA_HEADS // 2
GLA_DV = GROUP_W // GLA_HEADS
GLA_GATE_RANK = 16
GLA_TAU = 16.0
RET_HEADS = 4
RET_DK = GROUP_W // RET_HEADS
RET_DV = GROUP_W // RET_HEADS
MLA_HEADS = 4
MLA_Q_RANK = 192
MLA_KV_RANK = 64
MLA_NOPE = 64
MLA_ROPE = 32
MLA_DV = GROUP_W // MLA_HEADS
DIFF_HEADS = 4
DIFF_DK = 32
DIFF_DV = GROUP_W // DIFF_HEADS
D_FF = 2816
N_EXPERTS = 8
TOP_K = 2
D_FF_EXPERT = 3584
N_DENSE = (DEPTH + 1) // 2
N_MOE = DEPTH // 2

SPLIT_SIZES = (
    GLA_HEADS * GLA_DK, GLA_HEADS * GLA_DK, GLA_HEADS * GLA_DV, GLA_GATE_RANK, GLA_HEADS * GLA_DV,
    RET_HEADS * RET_DK, RET_HEADS * RET_DK, RET_HEADS * RET_DV, RET_HEADS * RET_DV,
    MLA_Q_RANK, MLA_KV_RANK, MLA_ROPE,
    DIFF_HEADS * 2 * DIFF_DK, DIFF_HEADS * 2 * DIFF_DK, DIFF_HEADS * DIFF_DV,
)
D_IN = sum(SPLIT_SIZES)

kernel_name = "hybrid_parallel_heads_gla_ret_mla_diff_moe"


def rmsnorm(x, g):
    xf = x.astype(jnp.float32)
    y = xf * lax.rsqrt(jnp.mean(xf * xf, axis=-1, keepdims=True) + EPS)
    return (y * g.astype(jnp.float32)).astype(x.dtype)


def head_groupnorm(x, g):
    xf = x.astype(jnp.float32)
    mu = jnp.mean(xf, axis=-1, keepdims=True)
    xc = xf - mu
    y = xc * lax.rsqrt(jnp.mean(xc * xc, axis=-1, keepdims=True) + EPS)
    return (y * g.astype(jnp.float32)).astype(x.dtype)


def rope(x, pos):
    half = x.shape[-1] // 2
    inv = ROPE_THETA ** (-jnp.arange(half, dtype=jnp.float32) / half)
    ang = pos.astype(jnp.float32)[:, None] * inv[None, :]
    cos, sin = jnp.cos(ang), jnp.sin(ang)
    xf = x.astype(jnp.float32)
    x1, x2 = xf[..., :half], xf[..., half:]
    return jnp.concatenate([x1 * cos - x2 * sin, x1 * sin + x2 * cos], axis=-1).astype(x.dtype)


def to_heads(t, n_heads):
    b, t_len, _ = t.shape
    return t.reshape(b, t_len, n_heads, -1).transpose(0, 2, 1, 3)


def from_heads(t):
    b, h, t_len, d = t.shape
    return t.transpose(0, 2, 1, 3).reshape(b, t_len, h * d)


def chunk_state_scan(decay, update):
    def step(s, inp):
        d, u = inp
        return d[..., None] * s + u, s
    s0 = jnp.zeros(update.shape[1:], jnp.float32)
    _, s_prev = lax.scan(step, s0, (decay, update))
    return s_prev


def gla_chunked(q, k, v, g):
    b, h, t_len, dk = q.shape
    dv = v.shape[-1]
    n = t_len // CHUNK
    q = q.astype(jnp.float32).reshape(b, h, n, CHUNK, dk)
    k = k.astype(jnp.float32).reshape(b, h, n, CHUNK, dk)
    vf = v.astype(jnp.float32).reshape(b, h, n, CHUNK, dv)
    cum = jnp.cumsum(g.astype(jnp.float32).reshape(b, h, n, CHUNK, dk), axis=-2)
    cum_last = cum[..., -1:, :]
    q_t = q * jnp.exp(cum)
    k_t = k * jnp.exp(-cum)
    tri = jnp.tril(jnp.ones((CHUNK, CHUNK), bool))
    a = jnp.where(tri, jnp.einsum('bhncd,bhnsd->bhncs', q_t, k_t), 0.0)
    o_intra = jnp.einsum('bhncs,bhnse->bhnce', a, vf)
    upd = jnp.einsum('bhncd,bhnce->nbhde', k * jnp.exp(cum_last - cum), vf)
    dec = jnp.exp(cum_last[..., 0, :]).transpose(2, 0, 1, 3)
    s_prev = chunk_state_scan(dec, upd)
    o_inter = jnp.einsum('bhncd,nbhde->bhnce', q_t, s_prev)
    return (o_intra + o_inter).reshape(b, h, t_len, dv).astype(v.dtype)


def retention_chunked(q, k, v):
    b, h, t_len, dk = q.shape
    dv = v.shape[-1]
    n = t_len // CHUNK
    lg = jnp.log(1.0 - jnp.exp2(-5.0 - jnp.arange(h, dtype=jnp.float32)))
    idx = jnp.arange(CHUNK, dtype=jnp.float32)
    rel = idx[:, None] - idx[None, :]
    dmask = jnp.where(rel[None] >= 0, jnp.exp(rel[None] * lg[:, None, None]), 0.0)
    qfac = jnp.exp((idx[None, :] + 1.0) * lg[:, None])
    kfac = jnp.exp((CHUNK - 1.0 - idx[None, :]) * lg[:, None])
    q = q.astype(jnp.float32).reshape(b, h, n, CHUNK, dk)
    k = k.astype(jnp.float32).reshape(b, h, n, CHUNK, dk)
    vf = v.astype(jnp.float32).reshape(b, h, n, CHUNK, dv)
    a = jnp.einsum('bhncd,bhnsd->bhncs', q, k) * dmask[None, :, None]
    o_intra = jnp.einsum('bhncs,bhnse->bhnce', a, vf)
    upd = jnp.einsum('bhncd,hc,bhnce->nbhde', k, kfac, vf)
    dec = jnp.broadcast_to(jnp.exp(CHUNK * lg)[None, None, :, None], (n, b, h, dk))
    s_prev = chunk_state_scan(dec, upd)
    o_inter = jnp.einsum('bhncd,hc,nbhde->bhnce', q, qfac, s_prev)
    return (o_intra + o_inter).reshape(b, h, t_len, dv).astype(v.dtype)


def signed_softmax_attention(q, k, v, valid, scale, coef):
    b, h, m, t_len, dk = q.shape
    dv = v.shape[-1]
    nb = t_len // Q_BLOCK
    qb = q.reshape(b, h, m, nb, Q_BLOCK, dk).transpose(3, 0, 1, 2, 4, 5)
    kpos = jnp.arange(t_len)
    coef = coef.astype(jnp.float32)

    def block(args):
        qi, i = args
        qpos = i * Q_BLOCK + jnp.arange(Q_BLOCK)
        mask = (kpos[None, :] <= qpos[:, None]) & valid[None, :]
        s = jnp.einsum('bhmqd,bhmkd->bhmqk', qi, k).astype(jnp.float32) * scale
        p = jax.nn.softmax(jnp.where(mask, s, NEG), axis=-1)
        w = jnp.einsum('bhmqk,m->bhqk', p, coef)
        return jnp.einsum('bhqk,bhkd->bhqd', w.astype(v.dtype), v)

    out = lax.map(block, (qb, jnp.arange(nb)))
    return out.transpose(1, 2, 0, 3, 4).reshape(b, h, t_len, dv)


def hybrid_mixer(hn, li, w_in, gla_w_gate, gla_b_gate, gla_norm, ret_norm,
                 mla_q_norm, mla_w_uq, mla_kv_norm, mla_w_ukv, diff_lambda, diff_norm, w_out):
    b, t_len, _ = hn.shape
    tp = t_len + FRONT_PAD
    proj = jnp.pad(hn @ w_in, ((0, 0), (FRONT_PAD, 0), (0, 0)))
    offs = [int(o) for o in np.cumsum(SPLIT_SIZES)[:-1]]
    (a_q, a_k, a_v, a_lr, a_og, r_q, r_k, r_v, r_og,
     c_cq, c_ckv, c_kpe, d_q, d_k, d_v) = jnp.split(proj, offs, axis=-1)
    tpos = jnp.arange(tp)
    valid = tpos >= FRONT_PAD
    pos = tpos - FRONT_PAD
    kmask = valid[None, None, :, None].astype(proj.dtype)

    g = jax.nn.log_sigmoid((a_lr @ gla_w_gate + gla_b_gate).astype(jnp.float32)) / GLA_TAU
    g = jnp.where(valid[None, :, None], g, 0.0)
    o_a = gla_chunked(to_heads(a_q, GLA_HEADS) * (GLA_DK ** -0.5), to_heads(a_k, GLA_HEADS) * kmask,
                      to_heads(a_v, GLA_HEADS), to_heads(g, GLA_HEADS))
    o_a = from_heads(rmsnorm(o_a, gla_norm)) * jax.nn.silu(a_og)

    rq = rope(to_heads(r_q, RET_HEADS), pos)
    rk = rope(to_heads(r_k, RET_HEADS), pos) * (RET_DK ** -0.5) * kmask
    o_b = retention_chunked(rq, rk, to_heads(r_v, RET_HEADS))
    o_b = from_heads(head_groupnorm(o_b, ret_norm)) * jax.nn.silu(r_og)

    cq = (rmsnorm(c_cq, mla_q_norm) @ mla_w_uq).reshape(b, tp, MLA_HEADS, MLA_NOPE + MLA_ROPE).transpose(0, 2, 1, 3)
    q_c = jnp.concatenate([cq[..., :MLA_NOPE], rope(cq[..., MLA_NOPE:], pos)], axis=-1)
    kv = (rmsnorm(c_ckv, mla_kv_norm) @ mla_w_ukv).reshape(b, tp, MLA_HEADS, MLA_NOPE + MLA_DV).transpose(0, 2, 1, 3)
    k_pe = jnp.broadcast_to(rope(c_kpe[:, None], pos), (b, MLA_HEADS, tp, MLA_ROPE))
    k_c = jnp.concatenate([kv[..., :MLA_NOPE], k_pe], axis=-1)
    o_c = signed_softmax_attention(q_c[:, :, None], k_c[:, :, None], kv[..., MLA_NOPE:], valid,
                                   (MLA_NOPE + MLA_ROPE) ** -0.5, jnp.ones((1,), jnp.float32))
    o_c = from_heads(o_c)

    lam_init = 0.8 - 0.6 * math.exp(-0.3 * li)
    lv = diff_lambda.astype(jnp.float32)
    lam = jnp.exp(jnp.sum(lv[0] * lv[1])) - jnp.exp(jnp.sum(lv[2] * lv[3])) + lam_init
    qd = d_q.reshape(b, tp, DIFF_HEADS, 2, DIFF_DK).transpose(0, 2, 3, 1, 4)
    kd = d_k.reshape(b, tp, DIFF_HEADS, 2, DIFF_DK).transpose(0, 2, 3, 1, 4)
    o_d = signed_softmax_attention(qd, kd, to_heads(d_v, DIFF_HEADS), valid, DIFF_DK ** -0.5,
                                   jnp.stack([jnp.ones((), jnp.float32), -lam]))
    o_d = from_heads(rmsnorm(o_d, diff_norm)) * (1.0 - lam_init)

    o = jnp.concatenate([o_a, o_b, o_c, o_d], axis=-1)[:, FRONT_PAD:]
    return o @ w_out


def swiglu(h, wg, wu, wd):
    return (jax.nn.silu(h @ wg) * (h @ wu)) @ wd


def moe_swiglu(h, router, wg, wu, wd):
    logits = (h @ router).astype(jnp.float32)
    top_v, top_i = lax.top_k(logits, TOP_K)
    top_w = jax.nn.softmax(top_v, axis=-1)
    gates = jnp.sum(jax.nn.one_hot(top_i, N_EXPERTS, dtype=jnp.float32) * top_w[..., None], axis=-2)
    out = jnp.zeros_like(h)
    for e in range(N_EXPERTS):
        out = out + gates[..., e:e + 1].astype(h.dtype) * swiglu(h, wg[e], wu[e], wd[e])
    return out


def setup_inputs(seed: int = 0) -> dict:
    key = jax.random.key(seed)
    ks = jax.random.split(key, 32)
    f32 = jnp.float32

    def nrm(k, shape, fan_in):
        return jax.random.normal(k, shape, f32) * (fan_in ** -0.5)

    def gain(k, shape):
        return 1.0 + 0.01 * jax.random.normal(k, shape, f32)

    return {
        "x": jax.random.normal(ks[0], (BATCH, SEQ, D_MODEL), f32),
        "meta_tokens": jax.random.normal(ks[1], (N_META, D_MODEL), f32),
        "attn_norm": gain(ks[2], (DEPTH, D_MODEL)),
        "w_in": nrm(ks[3], (DEPTH, D_MODEL, D_IN), D_MODEL),
        "gla_w_gate": nrm(ks[4], (DEPTH, GLA_GATE_RANK, GLA_HEADS * GLA_DK), GLA_GATE_RANK),
        "gla_b_gate": 0.01 * jax.random.normal(ks[5], (DEPTH, GLA_HEADS * GLA_DK), f32),
        "gla_norm": gain(ks[6], (DEPTH, GLA_DV)),
        "ret_norm": gain(ks[7], (DEPTH, RET_DV)),
        "mla_q_norm": gain(ks[8], (DEPTH, MLA_Q_RANK)),
        "mla_w_uq": nrm(ks[9], (DEPTH, MLA_Q_RANK, MLA_HEADS * (MLA_NOPE + MLA_ROPE)), MLA_Q_RANK),
        "mla_kv_norm": gain(ks[10], (DEPTH, MLA_KV_RANK)),
        "mla_w_ukv": nrm(ks[11], (DEPTH, MLA_KV_RANK, MLA_HEADS * (MLA_NOPE + MLA_DV)), MLA_KV_RANK),
        "diff_lambda": 0.1 * jax.random.normal(ks[12], (DEPTH, 4, DIFF_DK), f32),
        "diff_norm": gain(ks[13], (DEPTH, DIFF_DV)),
        "w_out": nrm(ks[14], (DEPTH, D_MODEL, D_MODEL), D_MODEL),
        "ffn_norm": gain(ks[15], (DEPTH, D_MODEL)),
        "ffn_w_gate": nrm(ks[16], (N_DENSE, D_MODEL, D_FF), D_MODEL),
        "ffn_w_up": nrm(ks[17], (N_DENSE, D_MODEL, D_FF), D_MODEL),
        "ffn_w_down": nrm(ks[18], (N_DENSE, D_FF, D_MODEL), D_FF),
        "moe_router": nrm(ks[19], (N_MOE, D_MODEL, N_EXPERTS), D_MODEL),
        "moe_w_gate": nrm(ks[20], (N_MOE, N_EXPERTS, D_MODEL, D_FF_EXPERT), D_MODEL),
        "moe_w_up": nrm(ks[21], (N_MOE, N_EXPERTS, D_MODEL, D_FF_EXPERT), D_MODEL),
        "moe_w_down": nrm(ks[22], (N_MOE, N_EXPERTS, D_FF_EXPERT, D_MODEL), D_FF_EXPERT),
        "final_norm": gain(ks[23], (D_MODEL,)),
    }


def reference(x, meta_tokens, attn_norm, w_in, gla_w_gate, gla_b_gate, gla_norm, ret_norm,
              mla_q_norm, mla_w_uq, mla_kv_norm, mla_w_ukv, diff_lambda, diff_norm, w_out,
              ffn_norm, ffn_w_gate, ffn_w_up, ffn_w_down, moe_router, moe_w_gate, moe_w_up,
              moe_w_down, final_norm):
    b = x.shape[0]
    meta = jnp.broadcast_to(meta_tokens[None].astype(x.dtype), (b, N_META, x.shape[-1]))
    h = jnp.concatenate([meta, x], axis=1)
    for li in range(DEPTH):
        h = h + hybrid_mixer(rmsnorm(h, attn_norm[li]), li, w_in[li], gla_w_gate[li], gla_b_gate[li],
                             gla_norm[li], ret_norm[li], mla_q_norm[li], mla_w_uq[li], mla_kv_norm[li],
                             mla_w_ukv[li], diff_lambda[li], diff_norm[li], w_out[li])
        hn = rmsnorm(h, ffn_norm[li])
        j = li // 2
        if li % 2 == 0:
            h = h + swiglu(hn, ffn_w_gate[j], ffn_w_up[j], ffn_w_down[j])
        else:
            h = h + moe_swiglu(hn, moe_router[j], moe_w_gate[j], moe_w_up[j], moe_w_down[j])
    h = rmsnorm(h, final_norm)
    return h[:, N_META:]
```

```cpp
#define MK_ONE_LAUNCH 0
#include <hip/hip_runtime.h>
#include <cstdio>
#include <cstdint>

namespace pg8 {
#define PG8_LAS __attribute__((address_space(3)))
typedef unsigned short bf16_t;
typedef short bf16x8 __attribute__((ext_vector_type(8)));
typedef float f32x4 __attribute__((ext_vector_type(4)));
typedef unsigned u32x4 __attribute__((ext_vector_type(4)));
constexpr int BM = 256, BK = 64, HALF = 128, HTB = HALF * BK * 2  , STAGE_BYTES = 8 * HTB, NXCD = 8, WGM = 8;

__host__ __device__ __forceinline__ int lds_byte(int r, int c) { const int st = (r >> 4) * 2 + (c >> 5), rr = r & 15, cc = c & 31, ob = rr * 64 + cc * 2; return st * 1024 + (ob ^ (((ob >> 9) & 1) << 5)); }
__host__ __device__ __forceinline__ void stage_rc(int b, int& R, int& C) { const int st = b / 1024, sb = b % 1024, swz = sb ^ (((sb >> 9) & 1) << 5); R = (st >> 1) * 16 + swz / 64; C = (st & 1) * 32 + (swz % 64) / 2; }
__host__ __device__ __forceinline__ int perm32(int rho) { const int n = rho >> 4, i = rho & 15; return 8 * (i >> 2) + 4 * n + (i & 3); }

struct Unit { int pm, pn, e, gp; };
struct Gemm { const bf16_t* A; const bf16_t* Bt; int K; size_t estride  ; const int* rowidx  ; };

struct StaticOrder {
    int nM, nN, nwg, G, c;
    __device__ void init(int nM_, int nN_, int G_, int c_) { nM = nM_; nN = nN_; nwg = nM * nN; G = G_; c = c_; }
    __device__ __forceinline__ bool map(int i, int& pm, int& pn) const {
        const long L = (long)i * G + c; if (L >= nwg) return false;
        int wgid = (int)L; { const int q = nwg / NXCD, r = nwg % NXCD, xcd = wgid % NXCD, off = wgid / NXCD; wgid = (xcd < r ? xcd * (q + 1) : r * (q + 1) + (xcd - r) * q) + off; }
        const int nig = WGM * nN, gid = wgid / nig, fm = gid * WGM, gsz = (nM - fm) < WGM ? (nM - fm) : WGM;
        pm = fm + ((wgid % nig) % gsz); pn = (wgid % nig) / gsz; return true;
    }
    __device__ __forceinline__ bool next(int i, Unit& u) const { int pm, pn; if (!map(i, pm, pn)) return false; u.pm = pm; u.pn = pn; u.e = 0; u.gp = pm; return true; }
};
struct MoeOrder {
    StaticOrder so; int p0; const int* pexp;
    __device__ void init(int nP, int nN, int G, int c, int p0_, const int* pexp_) { so.init(nP, nN, G, c); p0 = p0_; pexp = pexp_; }
    __device__ __forceinline__ bool next(int i, Unit& u) const { int pm, pn; if (!so.map(i, pm, pn)) return false; u.pm = pm; u.pn = pn; u.gp = p0 + pm; u.e = __builtin_amdgcn_readfirstlane(pexp[u.gp]); return true; }
};

__device__ __forceinline__ unsigned cvt_pk_bf16(float lo, float hi) { unsigned r; asm volatile("v_cvt_pk_bf16_f32 %0, %1, %2" : "=v"(r) : "v"(lo), "v"(hi)); return r; }
__device__ __forceinline__ float bf_lo(unsigned w) { return __uint_as_float(w << 16); }
__device__ __forceinline__ float bf_hi(unsigned w) { return __uint_as_float(w & 0xffff0000u); }

template <class Epi, class Sched, bool GATHER>
__device__ __forceinline__ void gemm_phase(PG8_LAS unsigned char* lds, const Gemm g, const Sched& S, const Epi& E) {
    int tid_ = threadIdx.x; asm volatile("" : "+v"(tid_));
    const int tid = tid_, wid = __builtin_amdgcn_readfirstlane(tid >> 6), lane = tid & 63, wr = wid >> 2, wc = wid & 3, fr = lane & 15, fq = lane >> 4;
    const int K = g.K, nt = K / BK;
    int Ra[2], Ca[2]; unsigned voffB[2];
#pragma unroll
    for (int i = 0; i < 2; ++i) { int R, C; stage_rc(tid * 16 + i * 8192, R, C); const int Rb = (R & ~31) + perm32(R & 31);
        Ra[i] = R; Ca[i] = C; voffB[i] = (unsigned)(Rb * K + C) * 2u; }
    const size_t kstep = (size_t)(BK * 2);
    const size_t hstep = (size_t)HALF * K * 2;
    const size_t tstep = 2 * hstep;
    const unsigned ldsw = (unsigned)wid * 1024u;
    const int aoff = lds_byte(wr * 64 + fr, fq * 8), boff = lds_byte(wc * 32 + fr, fq * 8);
    const char* const A0 = (const char*)g.A;
#define PG8_SA(b, h) (((b) * 2 + (h)) * HTB)
#define PG8_SB(b, h) ((4 + (b) * 2 + (h)) * HTB)
#define PG8_STAGE(bufoff, gbase, voff) do { _Pragma("unroll") for (int _i = 0; _i < 2; ++_i) \
        __builtin_amdgcn_global_load_lds((const unsigned*)((const char*)(gbase) + (voff)[_i]), (PG8_LAS unsigned*)(lds + (bufoff) + ldsw + _i * 8192), 16, 0, 0); } while (0)
#define PG8_LDA(dst, b, h) do { _Pragma("unroll") for (int m = 0; m < 4; ++m) _Pragma("unroll") for (int k = 0; k < 2; ++k) dst[m][k] = *(const PG8_LAS bf16x8*)(lds + PG8_SA(b, h) + aoff + m * 2048 + k * 1024); } while (0)
#define PG8_LDB(dst, b, h) do { _Pragma("unroll") for (int n = 0; n < 2; ++n) _Pragma("unroll") for (int k = 0; k < 2; ++k) dst[n][k] = *(const PG8_LAS bf16x8*)(lds + PG8_SB(b, h) + boff + n * 2048 + k * 1024); } while (0)
#define PG8_MMA(ai, bj, At, Bt) do { __builtin_amdgcn_s_setprio(1); _Pragma("unroll") for (int m = 0; m < 4; ++m) _Pragma("unroll") for (int n = 0; n < 2; ++n) _Pragma("unroll") for (int k = 0; k < 2; ++k) \
        acc[ai][bj][m][n] = __builtin_amdgcn_mfma_f32_16x16x32_bf16(Bt[n][k], At[m][k], acc[ai][bj][m][n], 0, 0, 0); __builtin_amdgcn_s_setprio(0); } while (0)
#define PG8_WAIT_V(n) asm volatile("s_waitcnt vmcnt(" #n ")" ::: "memory")
#define PG8_WAIT_L(n) asm volatile("s_waitcnt lgkmcnt(" #n ")" ::: "memory")
#define PG8_BAR __builtin_amdgcn_s_barrier()
#define PG8_SCHED __builtin_amdgcn_sched_barrier(0)
#define PG8_AOFFS(dst, u) do { _Pragma("unroll") for (int _h = 0; _h < 2; ++_h) _Pragma("unroll") for (int _i = 0; _i < 2; ++_i) { \
        int _row = (u).pm * BM + _h * HALF + Ra[_i]; \
        if (GATHER) { const int _gi = g.rowidx[(u).gp * BM + _h * HALF + Ra[_i]]; _row = _gi < 0 ? 0 : _gi; } \
        dst[_h][_i] = ((unsigned)_row * (unsigned)K + (unsigned)Ca[_i]) * 2u; } } while (0)
    Unit cur, nxt; int ui = 0;
    if (!S.next(0, cur)) return;
    f32x4 acc[2][2][4][2];
#pragma unroll
    for (int a = 0; a < 2; ++a)
#pragma unroll
        for (int b = 0; b < 2; ++b)
#pragma unroll
            for (int m = 0; m < 4; ++m)
#pragma unroll
                for (int n = 0; n < 2; ++n) acc[a][b][m][n] = (f32x4){0.f, 0.f, 0.f, 0.f};
    bf16x8 At[4][2], B0[2][2], B1[2][2];
    unsigned oaC[2][2], oaN[2][2];
    PG8_AOFFS(oaC, cur);
    const char* cB = (const char*)g.Bt + (size_t)cur.e * g.estride + (size_t)cur.pn * tstep;
    PG8_STAGE(PG8_SB(0, 0), cB, voffB); PG8_STAGE(PG8_SB(0, 1), cB + hstep, voffB); PG8_STAGE(PG8_SA(0, 0), A0, oaC[0]); PG8_STAGE(PG8_SA(0, 1), A0, oaC[1]);
    if (wr == 1) PG8_BAR;
    PG8_WAIT_V(2); PG8_BAR;
    PG8_STAGE(PG8_SB(1, 0), cB + kstep, voffB); PG8_STAGE(PG8_SA(1, 0), A0 + kstep, oaC[0]); PG8_STAGE(PG8_SB(1, 1), cB + hstep + kstep, voffB);
    PG8_WAIT_V(6); PG8_BAR;
    for (;;) {
        const bool has_next = S.next(ui + 1, nxt);
        if (has_next) { PG8_AOFFS(oaN, nxt); }
        else {
#pragma unroll
            for (int _h = 0; _h < 2; ++_h)
#pragma unroll
                for (int _i = 0; _i < 2; ++_i) oaN[_h][_i] = oaC[_h][_i]; }
        const char* nB = has_next ? (const char*)g.Bt + (size_t)nxt.e * g.estride + (size_t)nxt.pn * tstep : cB;
        for (int t = 0; t < nt; t += 2) {
            const bool last = (t == nt - 2);
            const char* ka1 = A0 + (size_t)(t + 1) * kstep;
            const char* ka2 = last ? A0 : A0 + (size_t)(t + 2) * kstep; const char* b2 = last ? nB : cB + (size_t)(t + 2) * kstep;
            const char* ka3 = ka2 + kstep; const char* b3 = b2 + kstep;
            unsigned o2[2][2];
#pragma unroll
            for (int _h = 0; _h < 2; ++_h)
#pragma unroll
                for (int _i = 0; _i < 2; ++_i) o2[_h][_i] = last ? oaN[_h][_i] : oaC[_h][_i];
            PG8_LDB(B0, 0, 0); PG8_LDB(B1, 0, 1); PG8_SCHED; PG8_LDA(At, 0, 0); PG8_STAGE(PG8_SA(1, 1), ka1, oaC[1]);
            PG8_WAIT_V(8); PG8_WAIT_L(0); PG8_BAR; PG8_MMA(0, 0, At, B0); PG8_MMA(0, 1, At, B1); PG8_BAR; PG8_SCHED;
            PG8_LDA(At, 0, 1); PG8_STAGE(PG8_SB(0, 0), b2, voffB); PG8_STAGE(PG8_SB(0, 1), b2 + hstep, voffB); PG8_STAGE(PG8_SA(0, 0), ka2, o2[0]);
            PG8_WAIT_V(8); PG8_WAIT_L(0); PG8_BAR; PG8_MMA(1, 0, At, B0); PG8_MMA(1, 1, At, B1); PG8_BAR; PG8_SCHED;
            PG8_LDB(B0, 1, 0); PG8_LDB(B1, 1, 1); PG8_SCHED; PG8_LDA(At, 1, 0); PG8_STAGE(PG8_SA(0, 1), ka2, o2[1]);
            PG8_WAIT_V(8); PG8_WAIT_L(0); PG8_BAR; PG8_MMA(0, 0, At, B0); PG8_MMA(0, 1, At, B1); PG8_BAR; PG8_SCHED;
            PG8_LDA(At, 1, 1); PG8_STAGE(PG8_SB(1, 0), b3, voffB); PG8_STAGE(PG8_SB(1, 1), b3 + hstep, voffB); PG8_STAGE(PG8_SA(1, 0), ka3, o2[0]);
            PG8_WAIT_V(8); PG8_WAIT_L(0); PG8_BAR; PG8_MMA(1, 0, At, B0); PG8_MMA(1, 1, At, B1); PG8_BAR; PG8_SCHED;
        }
        if (wr == 0) PG8_BAR;
        E(acc, cur, wr, wc, fr, fq);
        if (!has_next) break;
#pragma unroll
        for (int a = 0; a < 2; ++a)
#pragma unroll
            for (int b = 0; b < 2; ++b)
#pragma unroll
                for (int m = 0; m < 4; ++m)
#pragma unroll
                    for (int n = 0; n < 2; ++n) acc[a][b][m][n] = (f32x4){0.f, 0.f, 0.f, 0.f};
        cur = nxt; cB = nB; ++ui;
#pragma unroll
        for (int _h = 0; _h < 2; ++_h)
#pragma unroll
            for (int _i = 0; _i < 2; ++_i) oaC[_h][_i] = oaN[_h][_i];
        if (wr == 1) PG8_BAR;
    }
    PG8_WAIT_V(0);
    PG8_BAR;
#undef PG8_SA
#undef PG8_SB
#undef PG8_STAGE
#undef PG8_LDA
#undef PG8_LDB
#undef PG8_MMA
#undef PG8_WAIT_V
#undef PG8_WAIT_L
#undef PG8_BAR
#undef PG8_SCHED
#undef PG8_AOFFS
}
}
#define GAS __attribute__((address_space(1)))
#define LAS __attribute__((address_space(3)))
typedef unsigned short bf16;
typedef unsigned v4u __attribute__((ext_vector_type(4)));
typedef unsigned v2u __attribute__((ext_vector_type(2)));
typedef float f32x4 __attribute__((ext_vector_type(4)));
typedef float f32x2 __attribute__((ext_vector_type(2)));
typedef GAS unsigned gu32;
#define RLX_AGENT __ATOMIC_RELAXED, __HIP_MEMORY_SCOPE_AGENT
#define LDS_WAIT() asm volatile("s_waitcnt lgkmcnt(0)" ::: "memory")
#define VM_WAIT() asm volatile("s_waitcnt vmcnt(0)" ::: "memory")
__device__ __forceinline__ unsigned f2bf(float f) { unsigned u = __builtin_bit_cast(unsigned, f); return (u + 0x7fffu + ((u >> 16) & 1u)) >> 16; }
__device__ __forceinline__ unsigned pk2(float lo, float hi) { return f2bf(lo) | (f2bf(hi) << 16); }
__device__ __forceinline__ float bf2f(bf16 h) { return __uint_as_float(((unsigned)h) << 16); }
__device__ __forceinline__ float bflo(unsigned w) { return __uint_as_float(w << 16); }
__device__ __forceinline__ float bfhi(unsigned w) { return __uint_as_float(w & 0xffff0000u); }

#define XB_TMO      128
#define XB_XCNT(j)  (256  + 64 * (j))
#define XB_XSUB(j)  (1280 + 64 * (j))
#define XB_XGEN(j)  (2304 + 64 * (j))
#define XB_TOP      3328
#define XB_TOPGEN   3392
#define XCD_BAR_WORDS 3456
#define XB_SPIN_CAP (1u << 18)

__device__ __forceinline__ unsigned xb_ld(unsigned* p)              { return __hip_atomic_load(p, __ATOMIC_RELAXED, __HIP_MEMORY_SCOPE_AGENT); }
__device__ __forceinline__ unsigned xb_add(unsigned* p, unsigned v) { return __hip_atomic_fetch_add(p, v, __ATOMIC_RELAXED, __HIP_MEMORY_SCOPE_AGENT); }
__device__ __forceinline__ unsigned xb_xcc_id() { return (unsigned)__builtin_amdgcn_s_getreg((3 << 11) | 20) & 0xFu; }
#define XB_SPIN(cond, bar) do { unsigned _sp = 0; while (cond) { __builtin_amdgcn_s_sleep(1); \
    if ((++_sp & 255u) == 0u) { if (xb_ld(&(bar)[XB_TMO])) break; if (_sp > XB_SPIN_CAP) { atomicAdd(&(bar)[XB_TMO], 1u); break; } } } } while (0)

struct XcdBarrier {
    unsigned* bar; unsigned x;
    volatile LAS unsigned* st;
};

__device__ __forceinline__ XcdBarrier xcd_barrier_post(unsigned* bar, volatile LAS unsigned* st) {
    XcdBarrier b; b.bar = bar; b.x = xb_xcc_id(); b.st = st;
    if (threadIdx.x == 0) (void)xb_add(&bar[XB_XCNT(b.x)], 1u);
    return b;
}
__device__ __forceinline__ void xcd_barrier_complete(unsigned* bar, unsigned x, unsigned& nloc, unsigned& nx) {
    const unsigned G = gridDim.x * gridDim.y * gridDim.z;
    unsigned sum, cnt, mine, sp = 0u;
    for (;;) {
        sum = 0u; cnt = 0u; mine = 0u;
#pragma unroll
        for (unsigned j = 0; j < 16; ++j) { const unsigned c = xb_ld(&bar[XB_XCNT(j)]); sum += c; cnt += (c > 0u) ? 1u : 0u; mine = (j == x) ? c : mine; }
        if (sum == G) break;
        __builtin_amdgcn_s_sleep(1);
        if ((++sp & 255u) == 0u) { if (xb_ld(&bar[XB_TMO])) break; if (sp > XB_SPIN_CAP) { atomicAdd(&bar[XB_TMO], 1u); break; } }
    }
    nloc = mine > 0u ? mine : 1u; nx = cnt > 0u ? cnt : 1u;
}

__device__ __forceinline__ void xcd_barrier(const XcdBarrier& b) {
    asm volatile("s_waitcnt vmcnt(0)" ::: "memory");
    __syncthreads();
    if (threadIdx.x == 0) {
        unsigned* bar = b.bar;
        __builtin_amdgcn_s_waitcnt(0);
        unsigned nloc = b.st[0], nx = b.st[1];
        if (nloc == 0u) { xcd_barrier_complete(bar, b.x, nloc, nx); b.st[0] = nloc; b.st[1] = nx; }
        const unsigned old = xb_add(&bar[XB_XSUB(b.x)], 1u);
        const unsigned gen = old / nloc;
        if (old + 1u == (gen + 1u) * nloc) {
            __builtin_amdgcn_fence(__ATOMIC_RELEASE, "agent");
            asm volatile("s_waitcnt vmcnt(0)" ::: "memory");
            const unsigned og = xb_add(&bar[XB_TOP], 1u);
            const unsigned tg = og / nx;
            if (og + 1u == (tg + 1u) * nx) xb_add(&bar[XB_TOPGEN], 1u);
            else XB_SPIN(xb_ld(&bar[XB_TOPGEN]) == tg, bar);
            __builtin_amdgcn_fence(__ATOMIC_ACQUIRE, "agent");
            xb_add(&bar[XB_XGEN(b.x)], 1u);
            asm volatile("s_waitcnt vmcnt(0)" ::: "memory");
        } else {
            XB_SPIN(xb_ld(&bar[XB_XGEN(b.x)]) == gen, bar);
            __builtin_amdgcn_fence(__ATOMIC_ACQUIRE, "agent");
            asm volatile("s_waitcnt vmcnt(0)" ::: "memory");
        }
    }
    __syncthreads();
}

constexpr int NB = 16, TT = 2048, DM = 1024, MR = NB * TT, NMETA = 16, MROWS = MR + 256, NPAN = MROWS / 256;
constexpr int PSEQ = 2112, NCH = 33;
constexpr int DIN = 2864, N1 = 3328;
constexpr int DFF = 2816, DFE = 3584, NEXP = 8;
constexpr float EPS = 1e-6f;
constexpr int C_AQ = 0, C_AK = 128, C_AV = 256, C_ALR = 512, C_AOG = 528, C_RQ = 784, C_RK = 1040, C_RV = 1296, C_ROG = 1552, C_CQ = 1808, C_CKV = 2000, C_KPE = 2064, C_DQ = 2096, C_DK = 2352, C_DV = 2608, C_QEFF = 2864;
constexpr int MAXPAN = 264;
constexpr float LOG2E = 1.4426950408889634f;

constexpr size_t MiB = 1u << 20;
constexpr size_t WS_CTL = 0, CTL_BYTES = 1 * MiB;
constexpr size_t WS_TABR = 1 * MiB, WS_TABM = 1 * MiB + 576 * 1024;
constexpr size_t WS_RT = 2 * MiB;
constexpr size_t WS_STA = 3 * MiB, WS_STB = 6 * MiB;
constexpr size_t WS_MOE = 9 * MiB;
constexpr size_t MO_ROWIDX = WS_MOE, MO_PDST = WS_MOE + 512 * 1024, MO_PINFO = WS_MOE + 1 * MiB, MO_TOKE = WS_MOE + 2 * MiB, MO_TOKP = MO_TOKE + 256 * 1024, MO_TOKW = MO_TOKE + 512 * 1024, MO_PEXP = WS_MOE + 3 * MiB;
constexpr size_t WS_GD = 13 * MiB;
constexpr size_t WS_W1T = 16 * MiB, W1T_BYTES = (size_t)N1 * DM * 2;
constexpr size_t WS_WOT = 29 * MiB, WOT_BYTES = (size_t)DM * DM * 2;
constexpr size_t WS_WGU = 33 * MiB;
constexpr size_t WS_WD = 44 * MiB;
constexpr size_t WS_HB = 50 * MiB;
constexpr size_t WS_BIG = 115 * MiB;
constexpr size_t B_PROJ = WS_BIG;
constexpr size_t B_GQ = WS_BIG + 210 * MiB, B_GK = WS_BIG + 219 * MiB, B_GV = WS_BIG + 228 * MiB;
constexpr size_t B_RQ = WS_BIG + 245 * MiB, B_RK = WS_BIG + 262 * MiB, B_RV = WS_BIG + 279 * MiB;
constexpr size_t B_MQ = WS_BIG + 296 * MiB, B_MK = WS_BIG + 321 * MiB;
constexpr size_t B_DQ = WS_BIG + 328 * MiB, B_DK = WS_BIG + 345 * MiB, B_DV = WS_BIG + 362 * MiB;
constexpr size_t B_ACT = WS_BIG;
constexpr size_t B_EGU = WS_BIG, EGU_BYTES = (size_t)2 * DFE * DM * 2;
constexpr size_t B_ED = WS_BIG + 112 * MiB, ED_BYTES = (size_t)DM * DFE * 2;
constexpr size_t B_EACT = WS_BIG + 168 * MiB;
constexpr size_t WS_NEED = WS_BIG + 392 * MiB;
constexpr int CW_BAR = 4096, CW_CNT = 8192;

constexpr int RING_BYTES = 131072, MISC_OFF = RING_BYTES + 320, LDS_BYTES = 147456;

__device__ __forceinline__ float row_rstd16(const float* stats, int row, int fq) {
    const f32x4 v = *(const f32x4*)(stats + (size_t)row * 16 + 4 * fq);
    float s = (v[0] + v[1]) + (v[2] + v[3]);
    s += __shfl_xor(s, 16); s += __shfl_xor(s, 32);
    return __builtin_amdgcn_rsqf(s * (1.0f / 1024.0f) + EPS);
}
__device__ __forceinline__ float silu_f(float x) { return x * __builtin_amdgcn_rcpf(1.0f + __builtin_amdgcn_exp2f(-x * LOG2E)); }
__device__ __forceinline__ v4u pack8(const f32x4 a, const f32x4 b) { v4u w; w.x = pg8::cvt_pk_bf16(a[0], a[1]); w.y = pg8::cvt_pk_bf16(a[2], a[3]); w.z = pg8::cvt_pk_bf16(b[0], b[1]); w.w = pg8::cvt_pk_bf16(b[2], b[3]); return w; }

struct EpiProj {
    bf16* O; const float* stats;
    __device__ __forceinline__ void operator()(const f32x4 (&acc)[2][2][4][2], const pg8::Unit& u, int wr, int wc, int fr, int fq) const {
        const int col0 = u.pn * 256 + wc * 32 + 8 * fq;
#pragma unroll
        for (int ai = 0; ai < 2; ++ai)
#pragma unroll
            for (int m = 0; m < 4; ++m) { const int r = u.pm * 256 + ai * 128 + wr * 64 + m * 16 + fr; const float rs = row_rstd16(stats, r, fq); bf16* rowp = O + (size_t)r * N1 + col0;
#pragma unroll
                for (int bj = 0; bj < 2; ++bj) *(v4u*)(rowp + bj * 128) = pack8(acc[ai][bj][m][0] * rs, acc[ai][bj][m][1] * rs); }
    }
};
struct EpiSwiglu {
    bf16* O; int ldo; const float* stats;
    __device__ __forceinline__ void operator()(const f32x4 (&acc)[2][2][4][2], const pg8::Unit& u, int wr, int wc, int fr, int fq) const {
        const int col0 = u.pn * 128 + wc * 32 + 8 * fq;
#pragma unroll
        for (int ai = 0; ai < 2; ++ai)
#pragma unroll
            for (int m = 0; m < 4; ++m) { const int r = u.pm * 256 + ai * 128 + wr * 64 + m * 16 + fr; const float rs = row_rstd16(stats, r, fq);
                f32x4 o[2];
#pragma unroll
                for (int n = 0; n < 2; ++n)
#pragma unroll
                    for (int i = 0; i < 4; ++i) o[n][i] = silu_f(acc[ai][0][m][n][i] * rs) * (acc[ai][1][m][n][i] * rs);
                *(v4u*)(O + (size_t)r * ldo + col0) = pack8(o[0], o[1]); }
    }
};
struct EpiResid {
    bf16* H; float* stats;
    __device__ __forceinline__ void operator()(const f32x4 (&acc)[2][2][4][2], const pg8::Unit& u, int wr, int wc, int fr, int fq) const {
        const int col0 = u.pn * 256 + wc * 32 + 8 * fq;
#pragma unroll
        for (int ai = 0; ai < 2; ++ai)
#pragma unroll
            for (int m = 0; m < 4; ++m) { const int r = u.pm * 256 + ai * 128 + wr * 64 + m * 16 + fr; bf16* rowp = H + (size_t)r * DM + col0; float ss = 0.f;
#pragma unroll
                for (int bj = 0; bj < 2; ++bj) { const v4u w = *(const v4u*)(rowp + bj * 128);
                    f32x4 a = acc[ai][bj][m][0], b = acc[ai][bj][m][1];
                    a[0] += bflo(w.x); a[1] += bfhi(w.x); a[2] += bflo(w.y); a[3] += bfhi(w.y); b[0] += bflo(w.z); b[1] += bfhi(w.z); b[2] += bflo(w.w); b[3] += bfhi(w.w);
                    ss += (a[0] * a[0] + a[1] * a[1]) + (a[2] * a[2] + a[3] * a[3]) + (b[0] * b[0] + b[1] * b[1]) + (b[2] * b[2] + b[3] * b[3]);
                    *(v4u*)(rowp + bj * 128) = pack8(a, b); }
                ss += __shfl_xor(ss, 16); ss += __shfl_xor(ss, 32);
                if (fq == 0) stats[(size_t)r * 16 + u.pn * 4 + wc] = ss; }
    }
};
struct EpiSwigluMoe {
    bf16* O; const f32x2* pinfo;
    __device__ __forceinline__ void operator()(const f32x4 (&acc)[2][2][4][2], const pg8::Unit& u, int wr, int wc, int fr, int fq) const {
        const int col0 = u.pn * 128 + wc * 32 + 8 * fq;
#pragma unroll
        for (int ai = 0; ai < 2; ++ai)
#pragma unroll
            for (int m = 0; m < 4; ++m) { const int rl = ai * 128 + wr * 64 + m * 16 + fr; const float rs = pinfo[u.gp * 256 + rl][0];
                f32x4 o[2];
#pragma unroll
                for (int n = 0; n < 2; ++n)
#pragma unroll
                    for (int i = 0; i < 4; ++i) o[n][i] = silu_f(acc[ai][0][m][n][i] * rs) * (acc[ai][1][m][n][i] * rs);
                *(v4u*)(O + (size_t)(u.pm * 256 + rl) * DFE + col0) = pack8(o[0], o[1]); }
    }
};
struct EpiMoeDown {
    unsigned char* Y; const int* pdst; const f32x2* pinfo;
    __device__ __forceinline__ void operator()(const f32x4 (&acc)[2][2][4][2], const pg8::Unit& u, int wr, int wc, int fr, int fq) const {
        const int col0 = u.pn * 256 + wc * 32 + 8 * fq;
#pragma unroll
        for (int ai = 0; ai < 2; ++ai)
#pragma unroll
            for (int m = 0; m < 4; ++m) { const int rl = ai * 128 + wr * 64 + m * 16 + fr; const int dst = pdst[u.gp * 256 + rl]; const float w = pinfo[u.gp * 256 + rl][1];
                if (dst >= 0) { bf16* rowp = (bf16*)(Y + (size_t)(dst >> 1) * 4096 + (size_t)(dst & 1) * 2048) + col0;
#pragma unroll
                    for (int bj = 0; bj < 2; ++bj) *(v4u*)(rowp + bj * 128) = pack8(acc[ai][bj][m][0] * w, acc[ai][bj][m][1] * w); } }
    }
};

__device__ __forceinline__ float wave_sum(float v) {
#pragma unroll
    for (int o = 1; o < 64; o <<= 1) v += __shfl_xor(v, o);
    return v;
}
__device__ __forceinline__ void transpose_item(const float* W, int K, int N, const float* gain, bf16* WT, int kb, int nb, int dmode, LAS float* scr, int lane) {
    const int k0 = 64 * kb, n0 = 32 * nb;
#pragma unroll 8
    for (int i = 0; i < 32; ++i) { const int kk = 2 * i + (lane >> 5), n = n0 + (lane & 31);
        float v = (n < N) ? W[(size_t)(k0 + kk) * N + n] : 0.f; if (gain) v *= gain[k0 + kk];
        scr[kk * 33 + (lane & 31)] = v; }
    LDS_WAIT(); asm volatile("" ::: "memory");
    const int c = lane & 7;
    const int d0 = dmode == 0 ? n0 : 256 * (n0 >> 7) + (n0 & 127) + (dmode == 2 ? 128 : 0);
#pragma unroll
    for (int j = 0; j < 4; ++j) { const int nl = (lane >> 3) + 8 * j; const LAS float* s = scr + (8 * c) * 33 + nl;
        v4u o; o.x = pk2(s[0 * 33], s[1 * 33]); o.y = pk2(s[2 * 33], s[3 * 33]); o.z = pk2(s[4 * 33], s[5 * 33]); o.w = pk2(s[6 * 33], s[7 * 33]);
        if (n0 + nl < N) *(v4u*)(WT + (size_t)(d0 + nl) * K + k0 + 8 * c) = o; }
    LDS_WAIT(); asm volatile("" ::: "memory");
}

struct Args { const float* in[24]; float* out; unsigned char* ws; int ph_lo, ph_hi; };
enum { I_X = 0, I_META, I_ANORM, I_WIN, I_GWG, I_GBG, I_GNORM, I_RNORM, I_MQN, I_WUQ, I_MKVN, I_WUKV, I_DLAM, I_DNORM, I_WOUT, I_FNORM, I_FG, I_FU, I_FD, I_ROUTER, I_EG, I_EU, I_ED, I_FINAL };

__device__ __forceinline__ void qeff_unit(const Args& a, int li, int hh, int kb, LAS float* L, int tid) {
    const float* Wuq = a.in[I_WUQ] + (size_t)li * 192 * 384; const float* Wukv = a.in[I_WUKV] + (size_t)li * 64 * 512;
    const float* gq = a.in[I_MQN] + li * 192; const float* gkv = a.in[I_MKVN] + li * 64;
    const float* Win = a.in[I_WIN] + (size_t)li * DM * DIN; const float* gan = a.in[I_ANORM] + li * DM;
    bf16* W1t = (bf16*)(a.ws + WS_W1T + li * W1T_BYTES);
    for (int idx = tid; idx < 192 * 96; idx += 512) { const int i = idx / 96, n = idx % 96; float v;
        if (n < 64) { float s = 0.f; for (int m = 0; m < 64; ++m) s += Wuq[i * 384 + hh * 96 + m] * Wukv[n * 512 + hh * 128 + m]; v = gq[i] * gkv[n] * s; }
        else v = gq[i] * Wuq[i * 384 + hh * 96 + n];
        L[idx] = v; }
    __syncthreads();
    const int k0 = kb * 64;
    for (int idx = tid; idx < 64 * 96; idx += 512) { const int kk = idx & 63, n = idx >> 6; const float* wr = Win + (size_t)(k0 + kk) * DIN + C_CQ; float s = 0.f;
        for (int i = 0; i < 192; ++i) s += wr[i] * L[i * 96 + n];
        W1t[(size_t)(C_QEFF + hh * 96 + n) * DM + k0 + kk] = (bf16)f2bf(gan[k0 + kk] * s); }
    __syncthreads();
}
__device__ __forceinline__ void wofold_unit(const Args& a, int li, int hh, int nb, int tid) {
    const float* Wukv = a.in[I_WUKV] + (size_t)li * 64 * 512; const float* gkv = a.in[I_MKVN] + li * 64; const float* Wo = a.in[I_WOUT] + (size_t)li * DM * DM;
    bf16* Wot = (bf16*)(a.ws + WS_WOT + li * WOT_BYTES);
    for (int idx = tid; idx < 64 * 64; idx += 512) { const int j = idx & 63, n = nb * 64 + (idx >> 6); float s = 0.f;
        for (int e = 0; e < 64; ++e) s += Wukv[j * 512 + hh * 128 + 64 + e] * Wo[(size_t)(512 + 64 * hh + e) * DM + n];
        Wot[(size_t)n * DM + 512 + 64 * hh + j] = (bf16)f2bf(gkv[j] * s); }
}
__device__ __forceinline__ void p0_prologue(const Args& a, LAS unsigned char* lds, int tid, int lane, int wave) {
    const int G = gridDim.x;
    for (int un = blockIdx.x; un < 256; un += G) {
        if (un < 128) qeff_unit(a, un >> 6, (un >> 4) & 3, un & 15, (LAS float*)lds, tid);
        else { const int v = un - 128; wofold_unit(a, v >> 6, (v >> 4) & 3, v & 15, tid); }
    }
    __syncthreads();
    LAS float* scr = (LAS float*)(lds + wave * 16384);
    const int gw = blockIdx.x * 8 + wave, NGW = G * 8;
    constexpr int I_IN = 16 * 90, I_WO = 12 * 32, I_G = 16 * 88, I_D = 44 * 32;
    constexpr int NIT = 2 * I_IN + 2 * I_WO + 2 * I_G + I_D;
    for (int it = gw; it < NIT; it += NGW) {
        int r = it;
        if (r < 2 * I_IN) { const int li = r / I_IN; r %= I_IN; transpose_item(a.in[I_WIN] + (size_t)li * DM * DIN, DM, DIN, a.in[I_ANORM] + li * DM, (bf16*)(a.ws + WS_W1T + li * W1T_BYTES), r / 90, r % 90, 0, scr, lane); continue; } r -= 2 * I_IN;
        if (r < 2 * I_WO) { const int li = r / I_WO; r %= I_WO; int kb = r / 32; if (kb >= 8) kb += 4; transpose_item(a.in[I_WOUT] + (size_t)li * DM * DM, DM, DM, nullptr, (bf16*)(a.ws + WS_WOT + li * WOT_BYTES), kb, r % 32, 0, scr, lane); continue; } r -= 2 * I_WO;
        if (r < I_G) { transpose_item(a.in[I_FG], DM, DFF, a.in[I_FNORM], (bf16*)(a.ws + WS_WGU), r / 88, r % 88, 1, scr, lane); continue; } r -= I_G;
        if (r < I_G) { transpose_item(a.in[I_FU], DM, DFF, a.in[I_FNORM], (bf16*)(a.ws + WS_WGU), r / 88, r % 88, 2, scr, lane); continue; } r -= I_G;
        transpose_item(a.in[I_FD], DFF, DM, nullptr, (bf16*)(a.ws + WS_WD), r / 32, r % 32, 0, scr, lane);
    }
    const int gt = blockIdx.x * 512 + tid, NGT = G * 512;
    for (int i = gt; i < 2 * 80 * 128; i += NGT) { const int li = i / (80 * 128), r = i % (80 * 128);
        *(v4u*)(a.ws + WS_W1T + li * W1T_BYTES + (size_t)(C_QEFF + 384) * DM * 2 + (size_t)r * 16) = (v4u){0u, 0u, 0u, 0u}; }
    for (int i = gt; i < 8 * DM; i += NGT) { const int e = i >> 10, k = i & 1023; ((float*)(a.ws + WS_RT))[i] = a.in[I_FNORM][DM + k] * a.in[I_ROUTER][k * 8 + e]; }
    for (int i = gt; i < PSEQ * 48; i += NGT) { const int p = i / 48, j = i % 48; const bool isR = j < 32; const int f = isR ? j : j - 32;
        const float inv = __builtin_amdgcn_exp2f(-(float)f * (isR ? 13.287712379549449f / 32.f : 13.287712379549449f / 16.f));
        const double rev = (double)(p - 48) * (double)inv * 0.15915494309189535; const float fr = (float)(rev - __builtin_rint(rev));
        const f32x2 cs = {__builtin_amdgcn_cosf(fr), __builtin_amdgcn_sinf(fr)};
        if (isR) ((f32x2*)(a.ws + WS_TABR))[p * 32 + f] = cs; else ((f32x2*)(a.ws + WS_TABM))[p * 16 + f] = cs; }
    for (int i = gt; i < 240 * 128; i += NGT) *(v4u*)((unsigned char*)a.out + (size_t)(MR + 16) * 2048 + (size_t)i * 16) = (v4u){0u, 0u, 0u, 0u};
    bf16* hb = (bf16*)(a.ws + WS_HB); float* stA = (float*)(a.ws + WS_STA);
    for (int r = gw; r < MROWS; r += NGW) {
        f32x4 v[4]; float s = 0.f;
#pragma unroll
        for (int j = 0; j < 4; ++j) { if (r < MR) v[j] = ((const f32x4*)(a.in[I_X] + (size_t)r * DM))[lane + 64 * j]; else if (r < MR + NMETA) v[j] = ((const f32x4*)(a.in[I_META] + (size_t)(r - MR) * DM))[lane + 64 * j]; else v[j] = (f32x4){0.f, 0.f, 0.f, 0.f};
            s += (v[j][0] * v[j][0] + v[j][1] * v[j][1]) + (v[j][2] * v[j][2] + v[j][3] * v[j][3]); }
        s = wave_sum(s);
#pragma unroll
        for (int j = 0; j < 4; ++j) { v2u w; w.x = pk2(v[j][0], v[j][1]); w.y = pk2(v[j][2], v[j][3]); ((v2u*)(hb + (size_t)r * DM))[lane + 64 * j] = w; }
        if (lane < 16) stA[(size_t)r * 16 + lane] = lane == 0 ? s : 0.f;
    }
}

__device__ __forceinline__ int src_row(int b, int c, int i) { return c == 0 ? (i < 48 ? -1 : MR + i - 48) : b * TT + 64 * (c - 1) + i; }
__device__ __forceinline__ float lg2gamma(int h) { return h == 0 ? -0.045803689613124789f : h == 1 ? -0.022720076500083529f : h == 2 ? -0.011315313227834146f : -0.0056465631411420627f; }
__device__ __forceinline__ void prep_unit(const Args& a, int li, int b, int c, LAS unsigned char* lds, int tid, int lane, int wave) {
    const bf16* proj = (const bf16*)(a.ws + B_PROJ);
    LAS float* lr = (LAS float*)lds;
    LAS float* rsd = (LAS float*)(lds + 4096);
    const int blk0 = (b * NCH + c) * 4;
    const size_t prow0 = (size_t)b * PSEQ + 64 * c;
    for (int idx = tid; idx < 64 * 16; idx += 512) { const int i = idx >> 4, r = idx & 15, sr = src_row(b, c, i); lr[idx] = sr < 0 ? 0.f : bf2f(proj[(size_t)sr * N1 + C_ALR + r]); }
    for (int rr = 0; rr < 8; ++rr) { const int i = wave * 8 + rr, sr = src_row(b, c, i); float sq = 0.f, sk = 0.f;
        if (sr >= 0) { const bf16* pr = proj + (size_t)sr * N1;
#pragma unroll
            for (int j = 0; j < 3; ++j) { const float v = bf2f(pr[C_CQ + lane + 64 * j]); sq += v * v; }
            const float v = bf2f(pr[C_CKV + lane]); sk = v * v; }
        sq = wave_sum(sq); sk = wave_sum(sk);
        if (lane == 0) { rsd[i * 2] = __builtin_amdgcn_rsqf(sq * (1.f / 192.f) + EPS); rsd[i * 2 + 1] = __builtin_amdgcn_rsqf(sk * (1.f / 64.f) + EPS); } }
    __syncthreads();
    if (tid < 128) { const int ch = tid, h = ch >> 5, d = ch & 31;
        const float* Wg = a.in[I_GWG] + (size_t)li * 16 * 128; const float bg = a.in[I_GBG][li * 128 + ch];
        float wg[16];
#pragma unroll
        for (int r = 0; r < 16; ++r) wg[r] = Wg[r * 128 + ch];
        bf16* gq = (bf16*)(a.ws + B_GQ) + (size_t)(blk0 + h) * 64 * 32 + d; bf16* gk = (bf16*)(a.ws + B_GK) + (size_t)(blk0 + h) * 64 * 32 + d;
        float cum = 0.f;
        for (int i = 0; i < 64; ++i) { const int sr = src_row(b, c, i); float qv = 0.f, kv = 0.f;
            if (sr >= 0) { float x = bg;
#pragma unroll
                for (int r = 0; r < 16; ++r) x += lr[i * 16 + r] * wg[r];
                const float ls = fminf(x, 0.f) - __logf(1.f + __expf(-fabsf(x)));
                cum += ls * (1.f / 16.f);
                qv = bf2f(proj[(size_t)sr * N1 + C_AQ + ch]) * 0.17677669529663687f * __expf(cum); kv = bf2f(proj[(size_t)sr * N1 + C_AK + ch]) * __expf(-cum); }
            gq[i * 32] = (bf16)f2bf(qv); gk[i * 32] = (bf16)f2bf(kv); }
        ((float*)(a.ws + WS_GD))[(size_t)(blk0 + h) * 32 + d] = __expf(cum);
    }
    for (int idx = tid; idx < 64 * 32; idx += 512) { const int i = idx >> 5, ch8 = idx & 31, h = ch8 >> 3, e8 = (ch8 & 7) * 8, sr = src_row(b, c, i);
        v4u va = {0u, 0u, 0u, 0u}, vr = va, dq = va, dk = va, dv = va;
        if (sr >= 0) { const bf16* pr = proj + (size_t)sr * N1; va = *(const v4u*)(pr + C_AV + ch8 * 8); vr = *(const v4u*)(pr + C_RV + ch8 * 8);
            dq = *(const v4u*)(pr + C_DQ + ch8 * 8); dk = *(const v4u*)(pr + C_DK + ch8 * 8); dv = *(const v4u*)(pr + C_DV + ch8 * 8);
            const float qs = 0.17677669529663687f * LOG2E;
            dq.x = pk2(bflo(dq.x) * qs, bfhi(dq.x) * qs); dq.y = pk2(bflo(dq.y) * qs, bfhi(dq.y) * qs); dq.z = pk2(bflo(dq.z) * qs, bfhi(dq.z) * qs); dq.w = pk2(bflo(dq.w) * qs, bfhi(dq.w) * qs); }
        *(v4u*)((bf16*)(a.ws + B_GV) + ((size_t)(blk0 + h) * 64 + i) * 64 + e8) = va;
        *(v4u*)((bf16*)(a.ws + B_RV) + ((size_t)(blk0 + h) * 64 + i) * 64 + e8) = vr;
        *(v4u*)((bf16*)(a.ws + B_DQ) + (prow0 + i) * 256 + ch8 * 8) = dq;
        *(v4u*)((bf16*)(a.ws + B_DK) + (prow0 + i) * 256 + ch8 * 8) = dk;
        *(v4u*)((bf16*)(a.ws + B_DV) + (prow0 + i) * 256 + ch8 * 8) = dv; }
    const f32x2* tabR = (const f32x2*)(a.ws + WS_TABR); const f32x2* tabM = (const f32x2*)(a.ws + WS_TABM);
    for (int idx = tid; idx < 64 * 4 * 32; idx += 512) { const int j = idx & 31, h = (idx >> 5) & 3, i = idx >> 7, sr = src_row(b, c, i);
        float q1 = 0.f, q2 = 0.f, k1 = 0.f, k2 = 0.f;
        if (sr >= 0) { const bf16* pr = proj + (size_t)sr * N1; const f32x2 cs = tabR[(64 * c + i) * 32 + j];
            const float a1 = bf2f(pr[C_RQ + h * 64 + j]), a2 = bf2f(pr[C_RQ + h * 64 + 32 + j]), b1 = bf2f(pr[C_RK + h * 64 + j]), b2 = bf2f(pr[C_RK + h * 64 + 32 + j]);
            const float e = (float)(i + 1) * lg2gamma(h); const float fq = __builtin_amdgcn_exp2f(e), fk = 0.125f * __builtin_amdgcn_exp2f(-e);
            q1 = (a1 * cs[0] - a2 * cs[1]) * fq; q2 = (a1 * cs[1] + a2 * cs[0]) * fq; k1 = (b1 * cs[0] - b2 * cs[1]) * fk; k2 = (b1 * cs[1] + b2 * cs[0]) * fk; }
        bf16* rq = (bf16*)(a.ws + B_RQ) + ((size_t)(blk0 + h) * 64 + i) * 64; bf16* rk = (bf16*)(a.ws + B_RK) + ((size_t)(blk0 + h) * 64 + i) * 64;
        rq[j] = (bf16)f2bf(q1); rq[32 + j] = (bf16)f2bf(q2); rk[j] = (bf16)f2bf(k1); rk[32 + j] = (bf16)f2bf(k2); }
    const float QS = 0.10206207261596577f * LOG2E;
    for (int idx = tid; idx < 64 * 4 * 80; idx += 512) { const int n = idx % 80, hh = (idx / 80) & 3, i = idx / 320, sr = src_row(b, c, i);
        bf16* mq = (bf16*)(a.ws + B_MQ) + (prow0 + i) * 384 + hh * 96;
        if (n < 64) { mq[n] = sr < 0 ? (bf16)0 : (bf16)f2bf(bf2f(proj[(size_t)sr * N1 + C_QEFF + hh * 96 + n]) * rsd[i * 2] * QS); }
        else { const int j = n - 64; float y1 = 0.f, y2 = 0.f;
            if (sr >= 0) { const f32x2 cs = tabM[(64 * c + i) * 16 + j]; const float s = rsd[i * 2] * QS;
                const float x1 = bf2f(proj[(size_t)sr * N1 + C_QEFF + hh * 96 + 64 + j]) * s, x2 = bf2f(proj[(size_t)sr * N1 + C_QEFF + hh * 96 + 80 + j]) * s;
                y1 = x1 * cs[0] - x2 * cs[1]; y2 = x1 * cs[1] + x2 * cs[0]; }
            mq[64 + j] = (bf16)f2bf(y1); mq[80 + j] = (bf16)f2bf(y2); } }
    for (int idx = tid; idx < 64 * 80; idx += 512) { const int n = idx % 80, i = idx / 80, sr = src_row(b, c, i);
        bf16* mk = (bf16*)(a.ws + B_MK) + (prow0 + i) * 96;
        if (n < 64) { mk[n] = sr < 0 ? (bf16)0 : (bf16)f2bf(bf2f(proj[(size_t)sr * N1 + C_CKV + n]) * rsd[i * 2 + 1]); }
        else { const int j = n - 64; float y1 = 0.f, y2 = 0.f;
            if (sr >= 0) { const f32x2 cs = tabM[(64 * c + i) * 16 + j]; const float x1 = bf2f(proj[(size_t)sr * N1 + C_KPE + j]), x2 = bf2f(proj[(size_t)sr * N1 + C_KPE + 16 + j]);
                y1 = x1 * cs[0] - x2 * cs[1]; y2 = x1 * cs[1] + x2 * cs[0]; }
            mk[64 + j] = (bf16)f2bf(y1); mk[80 + j] = (bf16)f2bf(y2); } }
    __syncthreads();
}

template <int DK, int KIND>
__device__ __forceinline__ void lin_unit(const Args& a, int li, int b, int h, LAS unsigned char* lds, int tid) {
    LAS float* Qs = (LAS float*)lds; LAS float* Ks = Qs + 4096; LAS float* Vs = Qs + 8192; LAS float* As = Qs + 12288; LAS float* Ss = Qs + 16448; LAS float* Os = Qs + 20544; LAS float* Ds = Qs + 24704;
    const bf16* Qb = (const bf16*)(a.ws + (KIND ? B_RQ : B_GQ)); const bf16* Kb = (const bf16*)(a.ws + (KIND ? B_RK : B_GK)); const bf16* Vb = (const bf16*)(a.ws + (KIND ? B_RV : B_GV));
    const float* gain = a.in[KIND ? I_RNORM : I_GNORM] + li * 64;
    const bf16* proj = (const bf16*)(a.ws + B_PROJ); bf16* ob = (bf16*)a.out;
    for (int idx = tid; idx < DK * 64; idx += 512) Ss[idx] = 0.f;
    __syncthreads();
    for (int c = 0; c < NCH; ++c) {
        const size_t blk = (size_t)(b * NCH + c) * 4 + h;
        for (int idx = tid; idx < 64 * DK; idx += 512) { Qs[idx] = bf2f(Qb[blk * 64 * DK + idx]); Ks[idx] = bf2f(Kb[blk * 64 * DK + idx]); }
        for (int idx = tid; idx < 4096; idx += 512) Vs[idx] = bf2f(Vb[blk * 4096 + idx]);
        if (tid < DK) Ds[tid] = KIND ? __builtin_amdgcn_exp2f(64.f * lg2gamma(h)) : ((const float*)(a.ws + WS_GD))[blk * 32 + tid];
        __syncthreads();
        for (int idx = tid; idx < 4096; idx += 512) { const int i = idx >> 6, s = idx & 63; float v = 0.f;
            if (s <= i) { for (int d = 0; d < DK; ++d) v += Qs[i * DK + d] * Ks[s * DK + d]; }
            As[i * 65 + s] = v; }
        __syncthreads();
        for (int idx = tid; idx < 4096; idx += 512) { const int i = idx >> 6, e = idx & 63; float v = 0.f;
            for (int s = 0; s < 64; ++s) v += As[i * 65 + s] * Vs[s * 64 + e];
            for (int d = 0; d < DK; ++d) v += Qs[i * DK + d] * Ss[d * 64 + e];
            Os[i * 65 + e] = v; }
        float sn[DK * 64 / 512];
#pragma unroll
        for (int j = 0; j < DK * 64 / 512; ++j) { const int idx = tid + 512 * j, d = idx >> 6, e = idx & 63; float v = Ss[idx];
            for (int s = 0; s < 64; ++s) v += Ks[s * DK + d] * Vs[s * 64 + e];
            sn[j] = Ds[d] * v; }
        __syncthreads();
#pragma unroll
        for (int j = 0; j < DK * 64 / 512; ++j) Ss[tid + 512 * j] = sn[j];
        { const int i = tid >> 3, e0 = (tid & 7) * 8, sr = src_row(b, c, i); float v[8]; float s1 = 0.f;
#pragma unroll
            for (int j = 0; j < 8; ++j) { v[j] = Os[i * 65 + e0 + j]; s1 += v[j]; }
            float mean = 0.f;
            if (KIND) { s1 += __shfl_xor(s1, 1); s1 += __shfl_xor(s1, 2); s1 += __shfl_xor(s1, 4); mean = s1 * (1.f / 64.f); }
            float s2 = 0.f;
#pragma unroll
            for (int j = 0; j < 8; ++j) { v[j] -= mean; s2 += v[j] * v[j]; }
            s2 += __shfl_xor(s2, 1); s2 += __shfl_xor(s2, 2); s2 += __shfl_xor(s2, 4);
            const float rs = __builtin_amdgcn_rsqf(s2 * (1.f / 64.f) + EPS);
            if (sr >= 0 && (c > 0 || b == 0)) { const v4u og = *(const v4u*)(proj + (size_t)sr * N1 + (KIND ? C_ROG : C_AOG) + h * 64 + e0);
                const float g[8] = {bflo(og.x), bfhi(og.x), bflo(og.y), bfhi(og.y), bflo(og.z), bfhi(og.z), bflo(og.w), bfhi(og.w)};
                float y[8];
#pragma unroll
                for (int j = 0; j < 8; ++j) y[j] = v[j] * rs * gain[e0 + j] * silu_f(g[j]);
                v4u w; w.x = pk2(y[0], y[1]); w.y = pk2(y[2], y[3]); w.z = pk2(y[4], y[5]); w.w = pk2(y[6], y[7]);
                *(v4u*)(ob + (size_t)sr * DM + KIND * 256 + h * 64 + e0) = w; } }
        __syncthreads();
    }
}

template <int DK, bool VSEP>
__device__ __forceinline__ void attn_scalar(const bf16* Qb, int qld, const bf16* Kb, int kld, const bf16* Vb, int vld, int qpos, int ntiles, LAS float* Ks, LAS float* Vs, LAS float* Qs, float (&O)[64], float& lsum, int tid) {
    constexpr int KS = DK + 4, VS = 68;
    __syncthreads();
    for (int idx = tid; idx < 64 * (DK / 8); idx += 512) { const int r = idx / (DK / 8), ch = idx % (DK / 8); const v4u w = *(const v4u*)(Qb + (size_t)r * qld + ch * 8);
        LAS float* d = Qs + r * KS + ch * 8; *(LAS f32x4*)d = (f32x4){bflo(w.x), bfhi(w.x), bflo(w.y), bfhi(w.y)}; *(LAS f32x4*)(d + 4) = (f32x4){bflo(w.z), bfhi(w.z), bflo(w.w), bfhi(w.w)}; }
    float m = -1e30f, l = 0.f;
#pragma unroll
    for (int e = 0; e < 64; ++e) O[e] = 0.f;
    const int ks = tid & 7; const LAS float* qr = Qs + (tid >> 3) * KS;
    for (int kt = 0; kt < ntiles; ++kt) {
        __syncthreads();
        for (int idx = tid; idx < 64 * (DK / 8); idx += 512) { const int key = idx / (DK / 8), ch = idx % (DK / 8); const v4u w = *(const v4u*)(Kb + (size_t)(64 * kt + key) * kld + ch * 8);
            LAS float* d = Ks + key * KS + ch * 8; *(LAS f32x4*)d = (f32x4){bflo(w.x), bfhi(w.x), bflo(w.y), bfhi(w.y)}; *(LAS f32x4*)(d + 4) = (f32x4){bflo(w.z), bfhi(w.z), bflo(w.w), bfhi(w.w)}; }
        if (VSEP) { const int key = tid >> 3, ch = tid & 7; const v4u w = *(const v4u*)(Vb + (size_t)(64 * kt + key) * vld + ch * 8);
            LAS float* d = Vs + key * VS + ch * 8; *(LAS f32x4*)d = (f32x4){bflo(w.x), bfhi(w.x), bflo(w.y), bfhi(w.y)}; *(LAS f32x4*)(d + 4) = (f32x4){bflo(w.z), bfhi(w.z), bflo(w.w), bfhi(w.w)}; }
        __syncthreads();
        float s[8];
#pragma unroll
        for (int n = 0; n < 8; ++n) s[n] = 0.f;
#pragma unroll 2
        for (int d4 = 0; d4 < DK / 4; ++d4) { const f32x4 qv = *(const LAS f32x4*)(qr + 4 * d4);
#pragma unroll
            for (int n = 0; n < 8; ++n) { const f32x4 kv = *(const LAS f32x4*)(Ks + (ks + 8 * n) * KS + 4 * d4); s[n] += (qv[0] * kv[0] + qv[1] * kv[1]) + (qv[2] * kv[2] + qv[3] * kv[3]); } }
        float mx = -1e30f;
#pragma unroll
        for (int n = 0; n < 8; ++n) { const int kpos = 64 * kt + ks + 8 * n; if (kpos > qpos || kpos < 48) s[n] = -1e30f; mx = fmaxf(mx, s[n]); }
        mx = fmaxf(mx, __shfl_xor(mx, 1)); mx = fmaxf(mx, __shfl_xor(mx, 2)); mx = fmaxf(mx, __shfl_xor(mx, 4));
        const float mn = fmaxf(m, mx), sc = __builtin_amdgcn_exp2f(m - mn); m = mn; l *= sc;
#pragma unroll
        for (int e = 0; e < 64; ++e) O[e] *= sc;
#pragma unroll
        for (int n = 0; n < 8; ++n) { s[n] = s[n] <= -1e29f ? 0.f : __builtin_amdgcn_exp2f(s[n] - mn); l += s[n]; }
#pragma unroll 1
        for (int n = 0; n < 8; ++n) { float p = 0.f;
#pragma unroll
            for (int t = 0; t < 8; ++t) p = (t == n) ? s[t] : p;
            const int key = ks + 8 * n; const LAS float* vr = VSEP ? Vs + key * VS : Ks + key * KS;
#pragma unroll
            for (int e4 = 0; e4 < 16; ++e4) { const f32x4 vv = *(const LAS f32x4*)(vr + 4 * e4); O[4 * e4] += p * vv[0]; O[4 * e4 + 1] += p * vv[1]; O[4 * e4 + 2] += p * vv[2]; O[4 * e4 + 3] += p * vv[3]; } }
    }
    l += __shfl_xor(l, 1); l += __shfl_xor(l, 2); l += __shfl_xor(l, 4);
#pragma unroll
    for (int e = 0; e < 64; ++e) { float v = O[e]; v += __shfl_xor(v, 1); v += __shfl_xor(v, 2); v += __shfl_xor(v, 4); O[e] = v; }
    lsum = l;
}
__device__ __forceinline__ void attn_unit(const Args& a, int li, int kind, int b, int hh, int j, LAS unsigned char* lds, int tid) {
    LAS float* Ks = (LAS float*)lds; LAS float* Vs = Ks + 64 * 100; LAS float* Qs = Vs + 64 * 68; LAS float* O1s = Qs + 64 * 100;
    const int i = tid >> 3, ks = tid & 7, qpos = 64 * j + i; const size_t prow0 = (size_t)b * PSEQ + 64 * j;
    const int sr = src_row(b, j, i); const bool wr = sr >= 0 && (j > 0 || b == 0);
    bf16* ob = (bf16*)a.out;
    float O[64]; float l;
    if (kind == 0) {
        const bf16* K = (const bf16*)(a.ws + B_MK) + (size_t)b * PSEQ * 96;
        attn_scalar<96, false>((const bf16*)(a.ws + B_MQ) + prow0 * 384 + hh * 96, 384, K, 96, K, 96, qpos, j + 1, Ks, Vs, Qs, O, l, tid);
        const float il = l > 0.f ? 1.f / l : 0.f;
        if (wr) {
#pragma unroll
            for (int e8 = 0; e8 < 8; ++e8) if (e8 == ks) { v4u w; w.x = pk2(O[8 * e8] * il, O[8 * e8 + 1] * il); w.y = pk2(O[8 * e8 + 2] * il, O[8 * e8 + 3] * il); w.z = pk2(O[8 * e8 + 4] * il, O[8 * e8 + 5] * il); w.w = pk2(O[8 * e8 + 6] * il, O[8 * e8 + 7] * il);
                *(v4u*)(ob + (size_t)sr * DM + 512 + hh * 64 + 8 * e8) = w; } }
    } else {
        const float* lv = a.in[I_DLAM] + li * 128; float s01 = 0.f, s23 = 0.f;
        for (int d = 0; d < 32; ++d) { s01 += lv[d] * lv[32 + d]; s23 += lv[64 + d] * lv[96 + d]; }
        const float lam_init = 0.8f - 0.6f * __expf(-0.3f * (float)li), lam = __expf(s01) - __expf(s23) + lam_init;
        const bf16* Q = (const bf16*)(a.ws + B_DQ) + prow0 * 256 + hh * 64; const bf16* K = (const bf16*)(a.ws + B_DK) + (size_t)b * PSEQ * 256 + hh * 64; const bf16* V = (const bf16*)(a.ws + B_DV) + (size_t)b * PSEQ * 256 + hh * 64;
        attn_scalar<32, true>(Q, 256, K, 256, V, 256, qpos, j + 1, Ks, Vs, Qs, O, l, tid);
        { const float il = l > 0.f ? 1.f / l : 0.f;
#pragma unroll
            for (int e8 = 0; e8 < 8; ++e8) if (e8 == ks) {
#pragma unroll
                for (int t = 0; t < 8; ++t) O1s[i * 64 + 8 * e8 + t] = O[8 * e8 + t] * il; } }
        attn_scalar<32, true>(Q + 32, 256, K + 32, 256, V, 256, qpos, j + 1, Ks, Vs, Qs, O, l, tid);
        const float il = l > 0.f ? lam / l : 0.f; float y[8]; float ss = 0.f;
#pragma unroll
        for (int e8 = 0; e8 < 8; ++e8) if (e8 == ks) {
#pragma unroll
            for (int t = 0; t < 8; ++t) { y[t] = O1s[i * 64 + 8 * e8 + t] - O[8 * e8 + t] * il; ss += y[t] * y[t]; } }
        ss += __shfl_xor(ss, 1); ss += __shfl_xor(ss, 2); ss += __shfl_xor(ss, 4);
        const float rs = __builtin_amdgcn_rsqf(ss * (1.f / 64.f) + EPS) * (1.f - lam_init); const float* gn = a.in[I_DNORM] + li * 64 + 8 * ks;
        if (wr) { v4u w; w.x = pk2(y[0] * rs * gn[0], y[1] * rs * gn[1]); w.y = pk2(y[2] * rs * gn[2], y[3] * rs * gn[3]); w.z = pk2(y[4] * rs * gn[4], y[5] * rs * gn[5]); w.w = pk2(y[6] * rs * gn[6], y[7] * rs * gn[7]);
            *(v4u*)(ob + (size_t)sr * DM + 768 + hh * 64 + 8 * ks) = w; }
    }
}

__device__ __forceinline__ void route_block(const Args& a, int blk, LAS unsigned char* lds, int tid, int lane, int wave) {
    LAS float* Rs = (LAS float*)lds; LAS int* lcnt = (LAS int*)(lds + 32768); LAS int* gbase = lcnt + 8; LAS int* rec = lcnt + 16;
    gu32* ctl = (gu32*)(a.ws + WS_CTL);
    const float* Rt = (const float*)(a.ws + WS_RT); const bf16* hb = (const bf16*)(a.ws + WS_HB); const float* stB = (const float*)(a.ws + WS_STB);
    __syncthreads();
    for (int idx = tid; idx < 8 * DM; idx += 512) Rs[idx] = Rt[idx];
    if (tid < 8) lcnt[tid] = 0;
    __syncthreads();
    for (int rr = 0; rr < 16; ++rr) { const int rl = wave * 16 + rr, row = blk * 128 + rl;
        const v4u w0 = *(const v4u*)(hb + (size_t)row * DM + 8 * lane), w1 = *(const v4u*)(hb + (size_t)row * DM + 512 + 8 * lane);
        const float x[16] = {bflo(w0.x), bfhi(w0.x), bflo(w0.y), bfhi(w0.y), bflo(w0.z), bfhi(w0.z), bflo(w0.w), bfhi(w0.w), bflo(w1.x), bfhi(w1.x), bflo(w1.y), bfhi(w1.y), bflo(w1.z), bfhi(w1.z), bflo(w1.w), bfhi(w1.w)};
        float st = lane < 16 ? stB[(size_t)row * 16 + lane] : 0.f; st = wave_sum(st); const float rs = __builtin_amdgcn_rsqf(st * (1.f / 1024.f) + EPS);
        float lg[8];
#pragma unroll
        for (int e = 0; e < 8; ++e) { float s = 0.f;
#pragma unroll
            for (int t = 0; t < 8; ++t) s += x[t] * Rs[e * DM + 8 * lane + t] + x[8 + t] * Rs[e * DM + 512 + 8 * lane + t];
            lg[e] = wave_sum(s) * rs; }
        int e0 = 0; float v0 = lg[0];
#pragma unroll
        for (int e = 1; e < 8; ++e) if (lg[e] > v0) { v0 = lg[e]; e0 = e; }
        int e1 = -1; float v1 = -3.0e38f;
#pragma unroll
        for (int e = 0; e < 8; ++e) if (e != e0 && lg[e] > v1) { v1 = lg[e]; e1 = e; }
        const float g0 = 1.f / (1.f + __expf(v1 - v0)), g1 = 1.f - g0;
        if (lane == 0) { const int lp0 = atomicAdd((int*)(lcnt + e0), 1), lp1 = atomicAdd((int*)(lcnt + e1), 1);
            rec[rl * 6] = e0; rec[rl * 6 + 1] = e1; rec[rl * 6 + 2] = lp0; rec[rl * 6 + 3] = lp1; rec[rl * 6 + 4] = __float_as_int(g0); rec[rl * 6 + 5] = __float_as_int(g1); } }
    __syncthreads();
    if (tid < 8) gbase[tid] = (int)__hip_atomic_fetch_add(ctl + CW_CNT + 64 * tid, (unsigned)lcnt[tid], RLX_AGENT);
    __syncthreads();
    if (tid < 256) { const int rl = tid >> 1, s = tid & 1, tok = blk * 128 + rl, e = rec[rl * 6 + s];
        ((int*)(a.ws + MO_TOKE))[tok * 2 + s] = e; ((int*)(a.ws + MO_TOKP))[tok * 2 + s] = gbase[e] + rec[rl * 6 + 2 + s]; ((int*)(a.ws + MO_TOKW))[tok * 2 + s] = rec[rl * 6 + 4 + s]; }
    __syncthreads();
}
__device__ __forceinline__ void moe_offsets(const Args& a, LAS int* offs, int tid) {
    gu32* ctl = (gu32*)(a.ws + WS_CTL);
    __syncthreads();
    if (tid == 0) { int o = 0;
        for (int e = 0; e < 8; ++e) { const int cnt = (int)__hip_atomic_load(ctl + CW_CNT + 64 * e, RLX_AGENT); offs[e] = o * 256; o += (cnt + 255) >> 8; }
        offs[8] = o; }
    __syncthreads();
}

#ifndef MK_ONE_LAUNCH
#define MK_ONE_LAUNCH 1
#endif
constexpr int NPHASE = 20;
constexpr int CW_Q = 12288;
__global__ void __launch_bounds__(512, 2) mega_fwd(Args a) {
    extern __shared__ __attribute__((aligned(16))) unsigned char lds_raw[];
    LAS unsigned char* lds = (LAS unsigned char*)lds_raw;
    volatile LAS unsigned* MISC = (volatile LAS unsigned*)(lds + MISC_OFF);
    const int tid = threadIdx.x, lane = tid & 63, wave = __builtin_amdgcn_readfirstlane(tid >> 6), G = gridDim.x;
    for (int u = tid; u < (LDS_BYTES - RING_BYTES) / 4; u += 512) ((LAS unsigned*)(lds + RING_BYTES))[u] = 0u;
    __syncthreads();
    gu32* ctl = (gu32*)(a.ws + WS_CTL);
    const int lo = a.ph_lo, hi = a.ph_hi;
    XcdBarrier bar; bar.bar = (unsigned*)(ctl + CW_BAR); bar.x = 0; bar.st = nullptr;
    if (hi - lo > 1) bar = xcd_barrier_post((unsigned*)(ctl + CW_BAR), MISC + 8);
#define IN(k) (lo <= (k) && (k) < hi)
#define OPQ() int ptid = threadIdx.x; asm volatile("" : "+v"(ptid)); const int plane = ptid & 63; (void)plane
#define SEAM(k) do { if (IN(k) && IN((k) + 1)) xcd_barrier(bar); } while (0)
    bf16* hb = (bf16*)(a.ws + WS_HB); float* stA = (float*)(a.ws + WS_STA); float* stB = (float*)(a.ws + WS_STB);

    if (IN(0)) { OPQ(); p0_prologue(a, lds, ptid, plane, wave); }
    SEAM(0);

    for (int li = 0; li < 2; ++li) {
        const int pb = 1 + 6 * li;
        if (IN(pb)) {
            pg8::Gemm g{hb, (const bf16*)(a.ws + WS_W1T + li * W1T_BYTES), DM, 0, nullptr}; pg8::StaticOrder S; S.init(NPAN, N1 / 256, G, (int)blockIdx.x);
            EpiProj E{(bf16*)(a.ws + B_PROJ), stA};
            pg8::gemm_phase<EpiProj, pg8::StaticOrder, false>(lds, g, S, E);
        }
        SEAM(pb);
        if (IN(pb + 1)) { OPQ(); for (int u = blockIdx.x; u < NB * NCH; u += G) prep_unit(a, li, u / NCH, u % NCH, lds, ptid, plane, wave); }
        SEAM(pb + 1);
        if (IN(pb + 2)) {
            OPQ(); const int tid = ptid;
            LAS int* qid = (LAS int*)(lds + RING_BYTES + 64);
            for (;;) {
                __syncthreads();
                if (tid == 0) *qid = (int)__hip_atomic_fetch_add(ctl + CW_Q + 64 * li, 1u, RLX_AGENT);
                __syncthreads();
                const int id = *qid;
                if (id >= 128 + 33 * 128) break;
                if (id < 128) { const int b = id >> 3, k = (id >> 2) & 1, h = id & 3; if (k == 0) lin_unit<32, 0>(a, li, b, h, lds, tid); else lin_unit<64, 1>(a, li, b, h, lds, tid); }
                else { const int v = id - 128, j = 32 - v / 128, rem = v % 128, kind = rem >> 6, b = (rem >> 2) & 15, hh = rem & 3;
                    if (j > 0 || b == 0) attn_unit(a, li, kind, b, hh, j, lds, tid); }
            }
        }
        SEAM(pb + 2);
        if (IN(pb + 3)) {
            pg8::Gemm g{(const bf16*)a.out, (const bf16*)(a.ws + WS_WOT + li * WOT_BYTES), DM, 0, nullptr}; pg8::StaticOrder S; S.init(NPAN, 4, G, (int)blockIdx.x);
            EpiResid E{hb, stB};
            pg8::gemm_phase<EpiResid, pg8::StaticOrder, false>(lds, g, S, E);
        }
        SEAM(pb + 3);
        if (li == 0) {
            if (IN(5)) {
                pg8::Gemm g{hb, (const bf16*)(a.ws + WS_WGU), DM, 0, nullptr}; pg8::StaticOrder S; S.init(NPAN, 2 * DFF / 256, G, (int)blockIdx.x);
                EpiSwiglu E{(bf16*)(a.ws + B_ACT), DFF, stB};
                pg8::gemm_phase<EpiSwiglu, pg8::StaticOrder, false>(lds, g, S, E);
            }
            SEAM(5);
            if (IN(6)) {
                pg8::Gemm g{(const bf16*)(a.ws + B_ACT), (const bf16*)(a.ws + WS_WD), DFF, 0, nullptr}; pg8::StaticOrder S; S.init(NPAN, 4, G, (int)blockIdx.x);
                EpiResid E{hb, stA};
                pg8::gemm_phase<EpiResid, pg8::StaticOrder, false>(lds, g, S, E);
            }
            SEAM(6);
        }
    }
    if (IN(11)) { OPQ(); const int tid = ptid, lane = plane;
        LAS float* scr = (LAS float*)(lds + wave * 16384);
        const int gw = blockIdx.x * 8 + wave, NGW = G * 8;
        constexpr int IG = 16 * 112, ID = 56 * 32;
        for (int it = gw; it < 8 * (2 * IG + ID); it += NGW) { const int e = it / (2 * IG + ID); int r = it % (2 * IG + ID);
            if (r < IG) { transpose_item(a.in[I_EG] + (size_t)e * DM * DFE, DM, DFE, a.in[I_FNORM] + DM, (bf16*)(a.ws + B_EGU + e * EGU_BYTES), r / 112, r % 112, 1, scr, lane); continue; } r -= IG;
            if (r < IG) { transpose_item(a.in[I_EU] + (size_t)e * DM * DFE, DM, DFE, a.in[I_FNORM] + DM, (bf16*)(a.ws + B_EGU + e * EGU_BYTES), r / 112, r % 112, 2, scr, lane); continue; } r -= IG;
            transpose_item(a.in[I_ED] + (size_t)e * DFE * DM, DFE, DM, nullptr, (bf16*)(a.ws + B_ED + e * ED_BYTES), r / 32, r % 32, 0, scr, lane); }
        for (int i = blockIdx.x * 512 + tid; i < MAXPAN * 256; i += G * 512) { ((int*)(a.ws + MO_ROWIDX))[i] = -1; ((int*)(a.ws + MO_PDST))[i] = -1; ((f32x2*)(a.ws + MO_PINFO))[i] = (f32x2){0.f, 0.f}; }
        for (int blk = blockIdx.x; blk < MR / 128; blk += G) route_block(a, blk, lds, tid, lane, wave);
    }
    SEAM(11);
    LAS int* offs = (LAS int*)(lds + RING_BYTES + 128);
    if (IN(12)) { OPQ(); const int tid = ptid;
        moe_offsets(a, offs, tid);
        for (int idx = blockIdx.x * 512 + tid; idx < 2 * MR; idx += G * 512) { const int tok = idx >> 1, e = ((const int*)(a.ws + MO_TOKE))[idx], gpos = offs[e] + ((const int*)(a.ws + MO_TOKP))[idx];
            const f32x4* sp = (const f32x4*)(stB + (size_t)tok * 16); const f32x4 s0 = sp[0], s1 = sp[1], s2 = sp[2], s3 = sp[3];
            const float ss = ((s0[0] + s0[1]) + (s0[2] + s0[3])) + ((s1[0] + s1[1]) + (s1[2] + s1[3])) + ((s2[0] + s2[1]) + (s2[2] + s2[3])) + ((s3[0] + s3[1]) + (s3[2] + s3[3]));
            ((int*)(a.ws + MO_ROWIDX))[gpos] = tok; ((int*)(a.ws + MO_PDST))[gpos] = idx;
            ((f32x2*)(a.ws + MO_PINFO))[gpos] = (f32x2){__builtin_amdgcn_rsqf(ss * (1.f / 1024.f) + EPS), __int_as_float(((const int*)(a.ws + MO_TOKW))[idx])}; }
        if (blockIdx.x == 0 && tid < MAXPAN + 8) { int e = 0;
            for (int k = 1; k < 8; ++k) if (tid * 256 >= offs[k]) e = k;
            ((int*)(a.ws + MO_PEXP))[tid] = e; }
    }
    SEAM(12);
    for (int ci = 0; ci < 3; ++ci) {
        if (IN(13 + 2 * ci) || IN(14 + 2 * ci)) moe_offsets(a, offs, tid);
        int nP = 0; if (IN(13 + 2 * ci) || IN(14 + 2 * ci)) { nP = __builtin_amdgcn_readfirstlane(offs[8]) - 128 * ci; nP = nP > 128 ? 128 : nP; }
        if (IN(13 + 2 * ci) && nP > 0) {
            pg8::Gemm g{hb, (const bf16*)(a.ws + B_EGU), DM, EGU_BYTES, (const int*)(a.ws + MO_ROWIDX)}; pg8::MoeOrder S; S.init(nP, 2 * DFE / 256, G, (int)blockIdx.x, 128 * ci, (const int*)(a.ws + MO_PEXP));
            EpiSwigluMoe E{(bf16*)(a.ws + B_EACT), (const f32x2*)(a.ws + MO_PINFO)};
            pg8::gemm_phase<EpiSwigluMoe, pg8::MoeOrder, true>(lds, g, S, E);
        }
        SEAM(13 + 2 * ci);
        if (IN(14 + 2 * ci) && nP > 0) {
            pg8::Gemm g{(const bf16*)(a.ws + B_EACT), (const bf16*)(a.ws + B_ED), DFE, ED_BYTES, nullptr}; pg8::MoeOrder S; S.init(nP, 4, G, (int)blockIdx.x, 128 * ci, (const int*)(a.ws + MO_PEXP));
            EpiMoeDown E{(unsigned char*)a.out, (const int*)(a.ws + MO_PDST), (const f32x2*)(a.ws + MO_PINFO)};
            pg8::gemm_phase<EpiMoeDown, pg8::MoeOrder, false>(lds, g, S, E);
        }
        SEAM(14 + 2 * ci);
    }
    if (IN(19)) { OPQ(); const int lane = plane;
        const float* fn = a.in[I_FINAL];
        for (int r = blockIdx.x * 8 + wave; r < MR; r += G * 8) {
            unsigned char* orow = (unsigned char*)a.out + (size_t)r * 4096; float v[16]; float ss = 0.f;
#pragma unroll
            for (int hf = 0; hf < 2; ++hf) { const int k = 512 * hf + 8 * lane; const v4u h4 = *(const v4u*)(hb + (size_t)r * DM + k), y0 = *(const v4u*)(orow + 2 * k), y1 = *(const v4u*)(orow + 2048 + 2 * k);
                const unsigned hw[4] = {h4.x, h4.y, h4.z, h4.w}, aw[4] = {y0.x, y0.y, y0.z, y0.w}, bw[4] = {y1.x, y1.y, y1.z, y1.w};
#pragma unroll
                for (int t = 0; t < 4; ++t) { const float x0 = bflo(hw[t]) + bflo(aw[t]) + bflo(bw[t]), x1 = bfhi(hw[t]) + bfhi(aw[t]) + bfhi(bw[t]); v[8 * hf + 2 * t] = x0; v[8 * hf + 2 * t + 1] = x1; ss += x0 * x0 + x1 * x1; } }
            ss = wave_sum(ss); const float rs = __builtin_amdgcn_rsqf(ss * (1.f / 1024.f) + EPS);
#pragma unroll
            for (int hf = 0; hf < 2; ++hf) { const int k = 512 * hf + 8 * lane; const f32x4 g0 = *(const f32x4*)(fn + k), g1 = *(const f32x4*)(fn + k + 4);
                *(f32x4*)(orow + 4 * k) = (f32x4){v[8 * hf] * rs * g0[0], v[8 * hf + 1] * rs * g0[1], v[8 * hf + 2] * rs * g0[2], v[8 * hf + 3] * rs * g0[3]};
                *(f32x4*)(orow + 4 * k + 16) = (f32x4){v[8 * hf + 4] * rs * g1[0], v[8 * hf + 5] * rs * g1[1], v[8 * hf + 6] * rs * g1[2], v[8 * hf + 7] * rs * g1[3]}; }
        }
    }
#undef IN
#undef SEAM
}

extern "C" void kernel_launch(void* const* d_in, const int* in_sizes, int n_in, void* d_out, int out_size, void* d_ws, size_t ws_size, hipStream_t stream) {
    static int grid = 0;
    if (grid == 0) {
        if (n_in != 24 || in_sizes[0] != MR * DM || out_size != MR * DM || ws_size < WS_NEED) { fprintf(stderr, "kernel_launch: unexpected problem (n_in %d, in0 %d, out %d, ws %zu < %zu)\n", n_in, n_in > 0 ? in_sizes[0] : -1, out_size, ws_size, (size_t)WS_NEED); grid = -1; return; }
        int dev = 0, cus = 0, per_cu = 0;
        if (hipGetDevice(&dev) != hipSuccess || hipDeviceGetAttribute(&cus, hipDeviceAttributeMultiprocessorCount, dev) != hipSuccess) { grid = -1; return; }
        if (hipFuncSetAttribute((const void*)mega_fwd, hipFuncAttributeMaxDynamicSharedMemorySize, LDS_BYTES) != hipSuccess) { fprintf(stderr, "kernel_launch: hipFuncSetAttribute failed\n"); grid = -1; return; }
        if (hipOccupancyMaxActiveBlocksPerMultiprocessor(&per_cu, (const void*)mega_fwd, 512, LDS_BYTES) != hipSuccess || per_cu < 1) fprintf(stderr, "kernel_launch: occupancy query reports %d\n", per_cu);
        (void)hipGetLastError();
        grid = cus;
    }
    if (grid < 0) return;
    if (hipMemsetAsync((char*)d_ws + WS_CTL, 0, CTL_BYTES, stream) != hipSuccess) return;
    Args a{};
    for (int i = 0; i < 24; ++i) a.in[i] = (const float*)d_in[i];
    a.out = (float*)d_out; a.ws = (unsigned char*)d_ws;
#if MK_ONE_LAUNCH
    a.ph_lo = 0; a.ph_hi = NPHASE;
    hipLaunchKernelGGL(mega_fwd, dim3(grid), dim3(512), LDS_BYTES, stream, a);
#else
    for (int p = 0; p < NPHASE; ++p) { a.ph_lo = p; a.ph_hi = p + 1; hipLaunchKernelGGL(mega_fwd, dim3(grid), dim3(512), LDS_BYTES, stream, a); }
#endif
}
```

```cpp
#include <hip/hip_runtime.h>
#include <cstdio>
#include <cstdint>

namespace pg8 {
#define PG8_LAS __attribute__((address_space(3)))
typedef unsigned short bf16_t;
typedef short bf16x8 __attribute__((ext_vector_type(8)));
typedef float f32x4 __attribute__((ext_vector_type(4)));
typedef unsigned u32x4 __attribute__((ext_vector_type(4)));
constexpr int BM = 256, BK = 64, HALF = 128, HTB = HALF * BK * 2  , STAGE_BYTES = 8 * HTB, NXCD = 8, WGM = 8;

__host__ __device__ __forceinline__ int lds_byte(int r, int c) { const int st = (r >> 4) * 2 + (c >> 5), rr = r & 15, cc = c & 31, ob = rr * 64 + cc * 2; return st * 1024 + (ob ^ (((ob >> 9) & 1) << 5)); }
__host__ __device__ __forceinline__ void stage_rc(int b, int& R, int& C) { const int st = b / 1024, sb = b % 1024, swz = sb ^ (((sb >> 9) & 1) << 5); R = (st >> 1) * 16 + swz / 64; C = (st & 1) * 32 + (swz % 64) / 2; }
__host__ __device__ __forceinline__ int perm32(int rho) { const int n = rho >> 4, i = rho & 15; return 8 * (i >> 2) + 4 * n + (i & 3); }

struct Unit { int pm, pn, e, gp; };
struct Gemm { const bf16_t* A; const bf16_t* Bt; int K; size_t estride  ; const int* rowidx  ; };

struct StaticOrder {
    int nM, nN, nwg, G, c;
    __device__ void init(int nM_, int nN_, int G_, int c_) { nM = nM_; nN = nN_; nwg = nM * nN; G = G_; c = c_; }
    __device__ __forceinline__ bool map(int i, int& pm, int& pn) const {
        const long L = (long)i * G + c; if (L >= nwg) return false;
        int wgid = (int)L; { const int q = nwg / NXCD, r = nwg % NXCD, xcd = wgid % NXCD, off = wgid / NXCD; wgid = (xcd < r ? xcd * (q + 1) : r * (q + 1) + (xcd - r) * q) + off; }
        const int nig = WGM * nN, gid = wgid / nig, fm = gid * WGM, gsz = (nM - fm) < WGM ? (nM - fm) : WGM;
        pm = fm + ((wgid % nig) % gsz); pn = (wgid % nig) / gsz; return true;
    }
    __device__ __forceinline__ bool next(int i, Unit& u) const { int pm, pn; if (!map(i, pm, pn)) return false; u.pm = pm; u.pn = pn; u.e = 0; u.gp = pm; return true; }
};
struct MoeOrder {
    StaticOrder so; int p0; const int* pexp;
    __device__ void init(int nP, int nN, int G, int c, int p0_, const int* pexp_) { so.init(nP, nN, G, c); p0 = p0_; pexp = pexp_; }
    __device__ __forceinline__ bool next(int i, Unit& u) const { int pm, pn; if (!so.map(i, pm, pn)) return false; u.pm = pm; u.pn = pn; u.gp = p0 + pm; u.e = __builtin_amdgcn_readfirstlane(pexp[u.gp]); return true; }
};

__device__ __forceinline__ unsigned cvt_pk_bf16(float lo, float hi) { unsigned r; asm volatile("v_cvt_pk_bf16_f32 %0, %1, %2" : "=v"(r) : "v"(lo), "v"(hi)); return r; }
__device__ __forceinline__ float bf_lo(unsigned w) { return __uint_as_float(w << 16); }
__device__ __forceinline__ float bf_hi(unsigned w) { return __uint_as_float(w & 0xffff0000u); }

template <class Epi, class Sched, bool GATHER>
__device__ __forceinline__ void gemm_phase(PG8_LAS unsigned char* lds, const Gemm g, const Sched& S, const Epi& E) {
    int tid_ = threadIdx.x; asm volatile("" : "+v"(tid_));
    const int tid = tid_, wid = __builtin_amdgcn_readfirstlane(tid >> 6), lane = tid & 63, wr = wid >> 2, wc = wid & 3, fr = lane & 15, fq = lane >> 4;
    const int K = g.K, nt = K / BK;
    int Ra[2], Ca[2]; unsigned voffB[2];
#pragma unroll
    for (int i = 0; i < 2; ++i) { int R, C; stage_rc(tid * 16 + i * 8192, R, C); const int Rb = (R & ~31) + perm32(R & 31);
        Ra[i] = R; Ca[i] = C; voffB[i] = (unsigned)(Rb * K + C) * 2u; }
    const size_t kstep = (size_t)(BK * 2);
    const size_t hstep = (size_t)HALF * K * 2;
    const size_t tstep = 2 * hstep;
    const unsigned ldsw = (unsigned)wid * 1024u;
    const int aoff = lds_byte(wr * 64 + fr, fq * 8), boff = lds_byte(wc * 32 + fr, fq * 8);
    const char* const A0 = (const char*)g.A;
#define PG8_SA(b, h) (((b) * 2 + (h)) * HTB)
#define PG8_SB(b, h) ((4 + (b) * 2 + (h)) * HTB)
#define PG8_STAGE(bufoff, gbase, voff) do { _Pragma("unroll") for (int _i = 0; _i < 2; ++_i) \
        __builtin_amdgcn_global_load_lds((const unsigned*)((const char*)(gbase) + (voff)[_i]), (PG8_LAS unsigned*)(lds + (bufoff) + ldsw + _i * 8192), 16, 0, 0); } while (0)
#define PG8_LDA(dst, b, h) do { _Pragma("unroll") for (int m = 0; m < 4; ++m) _Pragma("unroll") for (int k = 0; k < 2; ++k) dst[m][k] = *(const PG8_LAS bf16x8*)(lds + PG8_SA(b, h) + aoff + m * 2048 + k * 1024); } while (0)
#define PG8_LDB(dst, b, h) do { _Pragma("unroll") for (int n = 0; n < 2; ++n) _Pragma("unroll") for (int k = 0; k < 2; ++k) dst[n][k] = *(const PG8_LAS bf16x8*)(lds + PG8_SB(b, h) + boff + n * 2048 + k * 1024); } while (0)
#define PG8_MMA(ai, bj, At, Bt) do { __builtin_amdgcn_s_setprio(1); _Pragma("unroll") for (int m = 0; m < 4; ++m) _Pragma("unroll") for (int n = 0; n < 2; ++n) _Pragma("unroll") for (int k = 0; k < 2; ++k) \
        acc[ai][bj][m][n] = __builtin_amdgcn_mfma_f32_16x16x32_bf16(Bt[n][k], At[m][k], acc[ai][bj][m][n], 0, 0, 0); __builtin_amdgcn_s_setprio(0); } while (0)
#define PG8_WAIT_V(n) asm volatile("s_waitcnt vmcnt(" #n ")" ::: "memory")
#define PG8_WAIT_L(n) asm volatile("s_waitcnt lgkmcnt(" #n ")" ::: "memory")
#define PG8_BAR __builtin_amdgcn_s_barrier()
#define PG8_SCHED __builtin_amdgcn_sched_barrier(0)
#define PG8_AOFFS(dst, u) do { _Pragma("unroll") for (int _h = 0; _h < 2; ++_h) _Pragma("unroll") for (int _i = 0; _i < 2; ++_i) { \
        int _row = (u).pm * BM + _h * HALF + Ra[_i]; \
        if (GATHER) { const int _gi = g.rowidx[(u).gp * BM + _h * HALF + Ra[_i]]; _row = _gi < 0 ? 0 : _gi; } \
        dst[_h][_i] = ((unsigned)_row * (unsigned)K + (unsigned)Ca[_i]) * 2u; } } while (0)
    Unit cur, nxt; int ui = 0;
    if (!S.next(0, cur)) return;
    f32x4 acc[2][2][4][2];
#pragma unroll
    for (int a = 0; a < 2; ++a)
#pragma unroll
        for (int b = 0; b < 2; ++b)
#pragma unroll
            for (int m = 0; m < 4; ++m)
#pragma unroll
                for (int n = 0; n < 2; ++n) acc[a][b][m][n] = (f32x4){0.f, 0.f, 0.f, 0.f};
    bf16x8 At[4][2], B0[2][2], B1[2][2];
    unsigned oaC[2][2], oaN[2][2];
    PG8_AOFFS(oaC, cur);
    const char* cB = (const char*)g.Bt + (size_t)cur.e * g.estride + (size_t)cur.pn * tstep;
    PG8_STAGE(PG8_SB(0, 0), cB, voffB); PG8_STAGE(PG8_SB(0, 1), cB + hstep, voffB); PG8_STAGE(PG8_SA(0, 0), A0, oaC[0]); PG8_STAGE(PG8_SA(0, 1), A0, oaC[1]);
    if (wr == 1) PG8_BAR;
    PG8_WAIT_V(2); PG8_BAR;
    PG8_STAGE(PG8_SB(1, 0), cB + kstep, voffB); PG8_STAGE(PG8_SA(1, 0), A0 + kstep, oaC[0]); PG8_STAGE(PG8_SB(1, 1), cB + hstep + kstep, voffB);
    PG8_WAIT_V(6); PG8_BAR;
    for (;;) {
        const bool has_next = S.next(ui + 1, nxt);
        if (has_next) { PG8_AOFFS(oaN, nxt); }
        else {
#pragma unroll
            for (int _h = 0; _h < 2; ++_h)
#pragma unroll
                for (int _i = 0; _i < 2; ++_i) oaN[_h][_i] = oaC[_h][_i]; }
        const char* nB = has_next ? (const char*)g.Bt + (size_t)nxt.e * g.estride + (size_t)nxt.pn * tstep : cB;
        for (int t = 0; t < nt; t += 2) {
            const bool last = (t == nt - 2);
            const char* ka1 = A0 + (size_t)(t + 1) * kstep;
            const char* ka2 = last ? A0 : A0 + (size_t)(t + 2) * kstep; const char* b2 = last ? nB : cB + (size_t)(t + 2) * kstep;
            const char* ka3 = ka2 + kstep; const char* b3 = b2 + kstep;
            unsigned o2[2][2];
#pragma unroll
            for (int _h = 0; _h < 2; ++_h)
#pragma unroll
                for (int _i = 0; _i < 2; ++_i) o2[_h][_i] = last ? oaN[_h][_i] : oaC[_h][_i];
            PG8_LDB(B0, 0, 0); PG8_LDB(B1, 0, 1); PG8_SCHED; PG8_LDA(At, 0, 0); PG8_STAGE(PG8_SA(1, 1), ka1, oaC[1]);
            PG8_WAIT_V(8); PG8_WAIT_L(0); PG8_BAR; PG8_MMA(0, 0, At, B0); PG8_MMA(0, 1, At, B1); PG8_BAR; PG8_SCHED;
            PG8_LDA(At, 0, 1); PG8_STAGE(PG8_SB(0, 0), b2, voffB); PG8_STAGE(PG8_SB(0, 1), b2 + hstep, voffB); PG8_STAGE(PG8_SA(0, 0), ka2, o2[0]);
            PG8_WAIT_V(8); PG8_WAIT_L(0); PG8_BAR; PG8_MMA(1, 0, At, B0); PG8_MMA(1, 1, At, B1); PG8_BAR; PG8_SCHED;
            PG8_LDB(B0, 1, 0); PG8_LDB(B1, 1, 1); PG8_SCHED; PG8_LDA(At, 1, 0); PG8_STAGE(PG8_SA(0, 1), ka2, o2[1]);
            PG8_WAIT_V(8); PG8_WAIT_L(0); PG8_BAR; PG8_MMA(0, 0, At, B0); PG8_MMA(0, 1, At, B1); PG8_BAR; PG8_SCHED;
            PG8_LDA(At, 1, 1); PG8_STAGE(PG8_SB(1, 0), b3, voffB); PG8_STAGE(PG8_SB(1, 1), b3 + hstep, voffB); PG8_STAGE(PG8_SA(1, 0), ka3, o2[0]);
            PG8_WAIT_V(8); PG8_WAIT_L(0); PG8_BAR; PG8_MMA(1, 0, At, B0); PG8_MMA(1, 1, At, B1); PG8_BAR; PG8_SCHED;
        }
        if (wr == 0) PG8_BAR;
        E(acc, cur, wr, wc, fr, fq);
        if (!has_next) break;
#pragma unroll
        for (int a = 0; a < 2; ++a)
#pragma unroll
            for (int b = 0; b < 2; ++b)
#pragma unroll
                for (int m = 0; m < 4; ++m)
#pragma unroll
                    for (int n = 0; n < 2; ++n) acc[a][b][m][n] = (f32x4){0.f, 0.f, 0.f, 0.f};
        cur = nxt; cB = nB; ++ui;
#pragma unroll
        for (int _h = 0; _h < 2; ++_h)
#pragma unroll
            for (int _i = 0; _i < 2; ++_i) oaC[_h][_i] = oaN[_h][_i];
        if (wr == 1) PG8_BAR;
    }
    PG8_WAIT_V(0);
    PG8_BAR;
#undef PG8_SA
#undef PG8_SB
#undef PG8_STAGE
#undef PG8_LDA
#undef PG8_LDB
#undef PG8_MMA
#undef PG8_WAIT_V
#undef PG8_WAIT_L
#undef PG8_BAR
#undef PG8_SCHED
#undef PG8_AOFFS
}
}
#define GAS __attribute__((address_space(1)))
#define LAS __attribute__((address_space(3)))
typedef unsigned short bf16;
typedef unsigned v4u __attribute__((ext_vector_type(4)));
typedef unsigned v2u __attribute__((ext_vector_type(2)));
typedef float f32x4 __attribute__((ext_vector_type(4)));
typedef float f32x2 __attribute__((ext_vector_type(2)));
typedef GAS unsigned gu32;
#define RLX_AGENT __ATOMIC_RELAXED, __HIP_MEMORY_SCOPE_AGENT
#define LDS_WAIT() asm volatile("s_waitcnt lgkmcnt(0)" ::: "memory")
#define VM_WAIT() asm volatile("s_waitcnt vmcnt(0)" ::: "memory")
__device__ __forceinline__ unsigned f2bf(float f) { unsigned u = __builtin_bit_cast(unsigned, f); return (u + 0x7fffu + ((u >> 16) & 1u)) >> 16; }
__device__ __forceinline__ unsigned pk2(float lo, float hi) { return f2bf(lo) | (f2bf(hi) << 16); }
__device__ __forceinline__ float bf2f(bf16 h) { return __uint_as_float(((unsigned)h) << 16); }
__device__ __forceinline__ float bflo(unsigned w) { return __uint_as_float(w << 16); }
__device__ __forceinline__ float bfhi(unsigned w) { return __uint_as_float(w & 0xffff0000u); }

#define XB_TMO      128
#define XB_XCNT(j)  (256  + 64 * (j))
#define XB_XSUB(j)  (1280 + 64 * (j))
#define XB_XGEN(j)  (2304 + 64 * (j))
#define XB_TOP      3328
#define XB_TOPGEN   3392
#define XCD_BAR_WORDS 3456
#define XB_SPIN_CAP (1u << 18)

__device__ __forceinline__ unsigned xb_ld(unsigned* p)              { return __hip_atomic_load(p, __ATOMIC_RELAXED, __HIP_MEMORY_SCOPE_AGENT); }
__device__ __forceinline__ unsigned xb_add(unsigned* p, unsigned v) { return __hip_atomic_fetch_add(p, v, __ATOMIC_RELAXED, __HIP_MEMORY_SCOPE_AGENT); }
__device__ __forceinline__ unsigned xb_xcc_id() { return (unsigned)__builtin_amdgcn_s_getreg((3 << 11) | 20) & 0xFu; }
#define XB_SPIN(cond, bar) do { unsigned _sp = 0; while (cond) { __builtin_amdgcn_s_sleep(1); \
    if ((++_sp & 255u) == 0u) { if (xb_ld(&(bar)[XB_TMO])) break; if (_sp > XB_SPIN_CAP) { atomicAdd(&(bar)[XB_TMO], 1u); break; } } } } while (0)

struct XcdBarrier {
    unsigned* bar; unsigned x;
    volatile LAS unsigned* st;
};

__device__ __forceinline__ XcdBarrier xcd_barrier_post(unsigned* bar, volatile LAS unsigned* st) {
    XcdBarrier b; b.bar = bar; b.x = xb_xcc_id(); b.st = st;
    if (threadIdx.x == 0) (void)xb_add(&bar[XB_XCNT(b.x)], 1u);
    return b;
}
__device__ __forceinline__ void xcd_barrier_complete(unsigned* bar, unsigned x, unsigned& nloc, unsigned& nx) {
    const unsigned G = gridDim.x * gridDim.y * gridDim.z;
    unsigned sum, cnt, mine, sp = 0u;
    for (;;) {
        sum = 0u; cnt = 0u; mine = 0u;
#pragma unroll
        for (unsigned j = 0; j < 16; ++j) { const unsigned c = xb_ld(&bar[XB_XCNT(j)]); sum += c; cnt += (c > 0u) ? 1u : 0u; mine = (j == x) ? c : mine; }
        if (sum == G) break;
        __builtin_amdgcn_s_sleep(1);
        if ((++sp & 255u) == 0u) { if (xb_ld(&bar[XB_TMO])) break; if (sp > XB_SPIN_CAP) { atomicAdd(&bar[XB_TMO], 1u); break; } }
    }
    nloc = mine > 0u ? mine : 1u; nx = cnt > 0u ? cnt : 1u;
}

__device__ __forceinline__ void xcd_barrier(const XcdBarrier& b) {
    asm volatile("s_waitcnt vmcnt(0)" ::: "memory");
    __syncthreads();
    if (threadIdx.x == 0) {
        unsigned* bar = b.bar;
        __builtin_amdgcn_s_waitcnt(0);
        unsigned nloc = b.st[0], nx = b.st[1];
        if (nloc == 0u) { xcd_barrier_complete(bar, b.x, nloc, nx); b.st[0] = nloc; b.st[1] = nx; }
        const unsigned old = xb_add(&bar[XB_XSUB(b.x)], 1u);
        const unsigned gen = old / nloc;
        if (old + 1u == (gen + 1u) * nloc) {
            __builtin_amdgcn_fence(__ATOMIC_RELEASE, "agent");
            asm volatile("s_waitcnt vmcnt(0)" ::: "memory");
            const unsigned og = xb_add(&bar[XB_TOP], 1u);
            const unsigned tg = og / nx;
            if (og + 1u == (tg + 1u) * nx) xb_add(&bar[XB_TOPGEN], 1u);
            else XB_SPIN(xb_ld(&bar[XB_TOPGEN]) == tg, bar);
            __builtin_amdgcn_fence(__ATOMIC_ACQUIRE, "agent");
            xb_add(&bar[XB_XGEN(b.x)], 1u);
            asm volatile("s_waitcnt vmcnt(0)" ::: "memory");
        } else {
            XB_SPIN(xb_ld(&bar[XB_XGEN(b.x)]) == gen, bar);
            __builtin_amdgcn_fence(__ATOMIC_ACQUIRE, "agent");
            asm volatile("s_waitcnt vmcnt(0)" ::: "memory");
        }
    }
    __syncthreads();
}

constexpr int NB = 16, TT = 2048, DM = 1024, MR = NB * TT, NMETA = 16, MROWS = MR + 256, NPAN = MROWS / 256;
constexpr int PSEQ = 2112, NCH = 33;
constexpr int DIN = 2864, N1 = 3328;
constexpr int DFF = 2816, DFE = 3584, NEXP = 8;
constexpr float EPS = 1e-6f;
constexpr int C_AQ = 0, C_AK = 128, C_AV = 256, C_ALR = 512, C_AOG = 528, C_RQ = 784, C_RK = 1040, C_RV = 1296, C_ROG = 1552, C_CQ = 1808, C_CKV = 2000, C_KPE = 2064, C_DQ = 2096, C_DK = 2352, C_DV = 2608, C_QEFF = 2864;
constexpr int MAXPAN = 264;
constexpr float LOG2E = 1.4426950408889634f;

constexpr size_t MiB = 1u << 20;
constexpr size_t WS_CTL = 0, CTL_BYTES = 1 * MiB;
constexpr size_t WS_TABR = 1 * MiB, WS_TABM = 1 * MiB + 576 * 1024;
constexpr size_t WS_RT = 2 * MiB;
constexpr size_t WS_STA = 3 * MiB, WS_STB = 6 * MiB;
constexpr size_t WS_MOE = 9 * MiB;
constexpr size_t MO_ROWIDX = WS_MOE, MO_PDST = WS_MOE + 512 * 1024, MO_PINFO = WS_MOE + 1 * MiB, MO_TOKE = WS_MOE + 2 * MiB, MO_TOKP = MO_TOKE + 256 * 1024, MO_TOKW = MO_TOKE + 512 * 1024, MO_PEXP = WS_MOE + 3 * MiB;
constexpr size_t WS_GD = 13 * MiB;
constexpr size_t WS_W1T = 16 * MiB, W1T_BYTES = (size_t)N1 * DM * 2;
constexpr size_t WS_WOT = 29 * MiB, WOT_BYTES = (size_t)DM * DM * 2;
constexpr size_t WS_WGU = 33 * MiB;
constexpr size_t WS_WD = 44 * MiB;
constexpr size_t WS_HB = 50 * MiB;
constexpr size_t WS_BIG = 115 * MiB;
constexpr size_t B_PROJ = WS_BIG;
constexpr size_t B_GQ = WS_BIG + 210 * MiB, B_GK = WS_BIG + 219 * MiB, B_GV = WS_BIG + 228 * MiB;
constexpr size_t B_RQ = WS_BIG + 245 * MiB, B_RK = WS_BIG + 262 * MiB, B_RV = WS_BIG + 279 * MiB;
constexpr size_t B_MQ = WS_BIG + 296 * MiB, B_MK = WS_BIG + 321 * MiB;
constexpr size_t B_DQ = WS_BIG + 328 * MiB, B_DK = WS_BIG + 345 * MiB, B_DV = WS_BIG + 362 * MiB;
constexpr size_t B_ACT = WS_BIG;
constexpr size_t B_EGU = WS_BIG, EGU_BYTES = (size_t)2 * DFE * DM * 2;
constexpr size_t B_ED = WS_BIG + 112 * MiB, ED_BYTES = (size_t)DM * DFE * 2;
constexpr size_t B_EACT = WS_BIG + 168 * MiB;
constexpr size_t WS_NEED = WS_BIG + 392 * MiB;
constexpr int CW_BAR = 4096, CW_CNT = 8192;

constexpr int RING_BYTES = 131072, MISC_OFF = RING_BYTES + 320, LDS_BYTES = 147456;

__device__ __forceinline__ float row_rstd16(const float* stats, int row, int fq) {
    const f32x4 v = *(const f32x4*)(stats + (size_t)row * 16 + 4 * fq);
    float s = (v[0] + v[1]) + (v[2] + v[3]);
    s += __shfl_xor(s, 16); s += __shfl_xor(s, 32);
    return __builtin_amdgcn_rsqf(s * (1.0f / 1024.0f) + EPS);
}
__device__ __forceinline__ float silu_f(float x) { return x * __builtin_amdgcn_rcpf(1.0f + __builtin_amdgcn_exp2f(-x * LOG2E)); }
__device__ __forceinline__ v4u pack8(const f32x4 a, const f32x4 b) { v4u w; w.x = pg8::cvt_pk_bf16(a[0], a[1]); w.y = pg8::cvt_pk_bf16(a[2], a[3]); w.z = pg8::cvt_pk_bf16(b[0], b[1]); w.w = pg8::cvt_pk_bf16(b[2], b[3]); return w; }

struct EpiProj {
    bf16* O; const float* stats;
    __device__ __forceinline__ void operator()(const f32x4 (&acc)[2][2][4][2], const pg8::Unit& u, int wr, int wc, int fr, int fq) const {
        const int col0 = u.pn * 256 + wc * 32 + 8 * fq;
#pragma unroll
        for (int ai = 0; ai < 2; ++ai)
#pragma unroll
            for (int m = 0; m < 4; ++m) { const int r = u.pm * 256 + ai * 128 + wr * 64 + m * 16 + fr; const float rs = row_rstd16(stats, r, fq); bf16* rowp = O + (size_t)r * N1 + col0;
#pragma unroll
                for (int bj = 0; bj < 2; ++bj) *(v4u*)(rowp + bj * 128) = pack8(acc[ai][bj][m][0] * rs, acc[ai][bj][m][1] * rs); }
    }
};
struct EpiSwiglu {
    bf16* O; int ldo; const float* stats;
    __device__ __forceinline__ void operator()(const f32x4 (&acc)[2][2][4][2], const pg8::Unit& u, int wr, int wc, int fr, int fq) const {
        const int col0 = u.pn * 128 + wc * 32 + 8 * fq;
#pragma unroll
        for (int ai = 0; ai < 2; ++ai)
#pragma unroll
            for (int m = 0; m < 4; ++m) { const int r = u.pm * 256 + ai * 128 + wr * 64 + m * 16 + fr; const float rs = row_rstd16(stats, r, fq);
                f32x4 o[2];
#pragma unroll
                for (int n = 0; n < 2; ++n)
#pragma unroll
                    for (int i = 0; i < 4; ++i) o[n][i] = silu_f(acc[ai][0][m][n][i] * rs) * (acc[ai][1][m][n][i] * rs);
                *(v4u*)(O + (size_t)r * ldo + col0) = pack8(o[0], o[1]); }
    }
};
struct EpiResid {
    bf16* H; float* stats;
    __device__ __forceinline__ void operator()(const f32x4 (&acc)[2][2][4][2], const pg8::Unit& u, int wr, int wc, int fr, int fq) const {
        const int col0 = u.pn * 256 + wc * 32 + 8 * fq;
#pragma unroll
        for (int ai = 0; ai < 2; ++ai)
#pragma unroll
            for (int m = 0; m < 4; ++m) { const int r = u.pm * 256 + ai * 128 + wr * 64 + m * 16 + fr; bf16* rowp = H + (size_t)r * DM + col0; float ss = 0.f;
#pragma unroll
                for (int bj = 0; bj < 2; ++bj) { const v4u w = *(const v4u*)(rowp + bj * 128);
                    f32x4 a = acc[ai][bj][m][0], b = acc[ai][bj][m][1];
                    a[0] += bflo(w.x); a[1] += bfhi(w.x); a[2] += bflo(w.y); a[3] += bfhi(w.y); b[0] += bflo(w.z); b[1] += bfhi(w.z); b[2] += bflo(w.w); b[3] += bfhi(w.w);
                    ss += (a[0] * a[0] + a[1] * a[1]) + (a[2] * a[2] + a[3] * a[3]) + (b[0] * b[0] + b[1] * b[1]) + (b[2] * b[2] + b[3] * b[3]);
                    *(v4u*)(rowp + bj * 128) = pack8(a, b); }
                ss += __shfl_xor(ss, 16); ss += __shfl_xor(ss, 32);
                if (fq == 0) stats[(size_t)r * 16 + u.pn * 4 + wc] = ss; }
    }
};
struct EpiSwigluMoe {
    bf16* O; const f32x2* pinfo;
    __device__ __forceinline__ void operator()(const f32x4 (&acc)[2][2][4][2], const pg8::Unit& u, int wr, int wc, int fr, int fq) const {
        const int col0 = u.pn * 128 + wc * 32 + 8 * fq;
#pragma unroll
        for (int ai = 0; ai < 2; ++ai)
#pragma unroll
            for (int m = 0; m < 4; ++m) { const int rl = ai * 128 + wr * 64 + m * 16 + fr; const float rs = pinfo[u.gp * 256 + rl][0];
                f32x4 o[2];
#pragma unroll
                for (int n = 0; n < 2; ++n)
#pragma unroll
                    for (int i = 0; i < 4; ++i) o[n][i] = silu_f(acc[ai][0][m][n][i] * rs) * (acc[ai][1][m][n][i] * rs);
                *(v4u*)(O + (size_t)(u.pm * 256 + rl) * DFE + col0) = pack8(o[0], o[1]); }
    }
};
struct EpiMoeDown {
    unsigned char* Y; const int* pdst; const f32x2* pinfo;
    __device__ __forceinline__ void operator()(const f32x4 (&acc)[2][2][4][2], const pg8::Unit& u, int wr, int wc, int fr, int fq) const {
        const int col0 = u.pn * 256 + wc * 32 + 8 * fq;
#pragma unroll
        for (int ai = 0; ai < 2; ++ai)
#pragma unroll
            for (int m = 0; m < 4; ++m) { const int rl = ai * 128 + wr * 64 + m * 16 + fr; const int dst = pdst[u.gp * 256 + rl]; const float w = pinfo[u.gp * 256 + rl][1];
                if (dst >= 0) { bf16* rowp = (bf16*)(Y + (size_t)(dst >> 1) * 4096 + (size_t)(dst & 1) * 2048) + col0;
#pragma unroll
                    for (int bj = 0; bj < 2; ++bj) *(v4u*)(rowp + bj * 128) = pack8(acc[ai][bj][m][0] * w, acc[ai][bj][m][1] * w); } }
    }
};

__device__ __forceinline__ float wave_sum(float v) {
#pragma unroll
    for (int o = 1; o < 64; o <<= 1) v += __shfl_xor(v, o);
    return v;
}
__device__ __forceinline__ void transpose_item(const float* W, int K, int N, const float* gain, bf16* WT, int kb, int nb, int dmode, LAS float* scr, int lane) {
    const int k0 = 64 * kb, n0 = 32 * nb;
#pragma unroll 8
    for (int i = 0; i < 32; ++i) { const int kk = 2 * i + (lane >> 5), n = n0 + (lane & 31);
        float v = (n < N) ? W[(size_t)(k0 + kk) * N + n] : 0.f; if (gain) v *= gain[k0 + kk];
        scr[kk * 33 + (lane & 31)] = v; }
    LDS_WAIT(); asm volatile("" ::: "memory");
    const int c = lane & 7;
    const int d0 = dmode == 0 ? n0 : 256 * (n0 >> 7) + (n0 & 127) + (dmode == 2 ? 128 : 0);
#pragma unroll
    for (int j = 0; j < 4; ++j) { const int nl = (lane >> 3) + 8 * j; const LAS float* s = scr + (8 * c) * 33 + nl;
        v4u o; o.x = pk2(s[0 * 33], s[1 * 33]); o.y = pk2(s[2 * 33], s[3 * 33]); o.z = pk2(s[4 * 33], s[5 * 33]); o.w = pk2(s[6 * 33], s[7 * 33]);
        if (n0 + nl < N) *(v4u*)(WT + (size_t)(d0 + nl) * K + k0 + 8 * c) = o; }
    LDS_WAIT(); asm volatile("" ::: "memory");
}

struct Args { const float* in[24]; float* out; unsigned char* ws; int ph_lo, ph_hi; };
enum { I_X = 0, I_META, I_ANORM, I_WIN, I_GWG, I_GBG, I_GNORM, I_RNORM, I_MQN, I_WUQ, I_MKVN, I_WUKV, I_DLAM, I_DNORM, I_WOUT, I_FNORM, I_FG, I_FU, I_FD, I_ROUTER, I_EG, I_EU, I_ED, I_FINAL };

__device__ __forceinline__ void qeff_unit(const Args& a, int li, int hh, int kb, LAS float* L, int tid) {
    const float* Wuq = a.in[I_WUQ] + (size_t)li * 192 * 384; const float* Wukv = a.in[I_WUKV] + (size_t)li * 64 * 512;
    const float* gq = a.in[I_MQN] + li * 192; const float* gkv = a.in[I_MKVN] + li * 64;
    const float* Win = a.in[I_WIN] + (size_t)li * DM * DIN; const float* gan = a.in[I_ANORM] + li * DM;
    bf16* W1t = (bf16*)(a.ws + WS_W1T + li * W1T_BYTES);
    for (int idx = tid; idx < 192 * 96; idx += 512) { const int i = idx / 96, n = idx % 96; float v;
        if (n < 64) { float s = 0.f; for (int m = 0; m < 64; ++m) s += Wuq[i * 384 + hh * 96 + m] * Wukv[n * 512 + hh * 128 + m]; v = gq[i] * gkv[n] * s; }
        else v = gq[i] * Wuq[i * 384 + hh * 96 + n];
        L[idx] = v; }
    __syncthreads();
    const int k0 = kb * 64;
    for (int idx = tid; idx < 64 * 96; idx += 512) { const int kk = idx & 63, n = idx >> 6; const float* wr = Win + (size_t)(k0 + kk) * DIN + C_CQ; float s = 0.f;
        for (int i = 0; i < 192; ++i) s += wr[i] * L[i * 96 + n];
        W1t[(size_t)(C_QEFF + hh * 96 + n) * DM + k0 + kk] = (bf16)f2bf(gan[k0 + kk] * s); }
    __syncthreads();
}
__device__ __forceinline__ void wofold_unit(const Args& a, int li, int hh, int nb, int tid) {
    const float* Wukv = a.in[I_WUKV] + (size_t)li * 64 * 512; const float* gkv = a.in[I_MKVN] + li * 64; const float* Wo = a.in[I_WOUT] + (size_t)li * DM * DM;
    bf16* Wot = (bf16*)(a.ws + WS_WOT + li * WOT_BYTES);
    for (int idx = tid; idx < 64 * 64; idx += 512) { const int j = idx & 63, n = nb * 64 + (idx >> 6); float s = 0.f;
        for (int e = 0; e < 64; ++e) s += Wukv[j * 512 + hh * 128 + 64 + e] * Wo[(size_t)(512 + 64 * hh + e) * DM + n];
        Wot[(size_t)n * DM + 512 + 64 * hh + j] = (bf16)f2bf(gkv[j] * s); }
}
__device__ __forceinline__ void p0_prologue(const Args& a, LAS unsigned char* lds, int tid, int lane, int wave) {
    const int G = gridDim.x;
    for (int un = blockIdx.x; un < 256; un += G) {
        if (un < 128) qeff_unit(a, un >> 6, (un >> 4) & 3, un & 15, (LAS float*)lds, tid);
        else { const int v = un - 128; wofold_unit(a, v >> 6, (v >> 4) & 3, v & 15, tid); }
    }
    __syncthreads();
    LAS float* scr = (LAS float*)(lds + wave * 16384);
    const int gw = blockIdx.x * 8 + wave, NGW = G * 8;
    constexpr int I_IN = 16 * 90, I_WO = 12 * 32, I_G = 16 * 88, I_D = 44 * 32;
    constexpr int NIT = 2 * I_IN + 2 * I_WO + 2 * I_G + I_D;
    for (int it = gw; it < NIT; it += NGW) {
        int r = it;
        if (r < 2 * I_IN) { const int li = r / I_IN; r %= I_IN; transpose_item(a.in[I_WIN] + (size_t)li * DM * DIN, DM, DIN, a.in[I_ANORM] + li * DM, (bf16*)(a.ws + WS_W1T + li * W1T_BYTES), r / 90, r % 90, 0, scr, lane); continue; } r -= 2 * I_IN;
        if (r < 2 * I_WO) { const int li = r / I_WO; r %= I_WO; int kb = r / 32; if (kb >= 8) kb += 4; transpose_item(a.in[I_WOUT] + (size_t)li * DM * DM, DM, DM, nullptr, (bf16*)(a.ws + WS_WOT + li * WOT_BYTES), kb, r % 32, 0, scr, lane); continue; } r -= 2 * I_WO;
        if (r < I_G) { transpose_item(a.in[I_FG], DM, DFF, a.in[I_FNORM], (bf16*)(a.ws + WS_WGU), r / 88, r % 88, 1, scr, lane); continue; } r -= I_G;
        if (r < I_G) { transpose_item(a.in[I_FU], DM, DFF, a.in[I_FNORM], (bf16*)(a.ws + WS_WGU), r / 88, r % 88, 2, scr, lane); continue; } r -= I_G;
        transpose_item(a.in[I_FD], DFF, DM, nullptr, (bf16*)(a.ws + WS_WD), r / 32, r % 32, 0, scr, lane);
    }
    const int gt = blockIdx.x * 512 + tid, NGT = G * 512;
    for (int i = gt; i < 2 * 80 * 128; i += NGT) { const int li = i / (80 * 128), r = i % (80 * 128);
        *(v4u*)(a.ws + WS_W1T + li * W1T_BYTES + (size_t)(C_QEFF + 384) * DM * 2 + (size_t)r * 16) = (v4u){0u, 0u, 0u, 0u}; }
    for (int i = gt; i < 8 * DM; i += NGT) { const int e = i >> 10, k = i & 1023; ((float*)(a.ws + WS_RT))[i] = a.in[I_FNORM][DM + k] * a.in[I_ROUTER][k * 8 + e]; }
    for (int i = gt; i < PSEQ * 48; i += NGT) { const int p = i / 48, j = i % 48; const bool isR = j < 32; const int f = isR ? j : j - 32;
        const float inv = __builtin_amdgcn_exp2f(-(float)f * (isR ? 13.287712379549449f / 32.f : 13.287712379549449f / 16.f));
        const double rev = (double)(p - 48) * (double)inv * 0.15915494309189535; const float fr = (float)(rev - __builtin_rint(rev));
        const f32x2 cs = {__builtin_amdgcn_cosf(fr), __builtin_amdgcn_sinf(fr)};
        if (isR) ((f32x2*)(a.ws + WS_TABR))[p * 32 + f] = cs; else ((f32x2*)(a.ws + WS_TABM))[p * 16 + f] = cs; }
    for (int i = gt; i < 240 * 128; i += NGT) *(v4u*)((unsigned char*)a.out + (size_t)(MR + 16) * 2048 + (size_t)i * 16) = (v4u){0u, 0u, 0u, 0u};
    bf16* hb = (bf16*)(a.ws + WS_HB); float* stA = (float*)(a.ws + WS_STA);
    for (int r = gw; r < MROWS; r += NGW) {
        f32x4 v[4]; float s = 0.f;
#pragma unroll
        for (int j = 0; j < 4; ++j) { if (r < MR) v[j] = ((const f32x4*)(a.in[I_X] + (size_t)r * DM))[lane + 64 * j]; else if (r < MR + NMETA) v[j] = ((const f32x4*)(a.in[I_META] + (size_t)(r - MR) * DM))[lane + 64 * j]; else v[j] = (f32x4){0.f, 0.f, 0.f, 0.f};
            s += (v[j][0] * v[j][0] + v[j][1] * v[j][1]) + (v[j][2] * v[j][2] + v[j][3] * v[j][3]); }
        s = wave_sum(s);
#pragma unroll
        for (int j = 0; j < 4; ++j) { v2u w; w.x = pk2(v[j][0], v[j][1]); w.y = pk2(v[j][2], v[j][3]); ((v2u*)(hb + (size_t)r * DM))[lane + 64 * j] = w; }
        if (lane < 16) stA[(size_t)r * 16 + lane] = lane == 0 ? s : 0.f;
    }
}

__device__ __forceinline__ int src_row(int b, int c, int i) { return c == 0 ? (i < 48 ? -1 : MR + i - 48) : b * TT + 64 * (c - 1) + i; }
__device__ __forceinline__ float lg2gamma(int h) { return h == 0 ? -0.045803689613124789f : h == 1 ? -0.022720076500083529f : h == 2 ? -0.011315313227834146f : -0.0056465631411420627f; }
__device__ __forceinline__ void prep_unit(const Args& a, int li, int b, int c, LAS unsigned char* lds, int tid, int lane, int wave) {
    const bf16* proj = (const bf16*)(a.ws + B_PROJ);
    LAS float* lr = (LAS float*)lds;
    LAS float* rsd = (LAS float*)(lds + 4096);
    const int blk0 = (b * NCH + c) * 4;
    const size_t prow0 = (size_t)b * PSEQ + 64 * c;
    for (int idx = tid; idx < 64 * 16; idx += 512) { const int i = idx >> 4, r = idx & 15, sr = src_row(b, c, i); lr[idx] = sr < 0 ? 0.f : bf2f(proj[(size_t)sr * N1 + C_ALR + r]); }
    for (int rr = 0; rr < 8; ++rr) { const int i = wave * 8 + rr, sr = src_row(b, c, i); float sq = 0.f, sk = 0.f;
        if (sr >= 0) { const bf16* pr = proj + (size_t)sr * N1;
#pragma unroll
            for (int j = 0; j < 3; ++j) { const float v = bf2f(pr[C_CQ + lane + 64 * j]); sq += v * v; }
            const float v = bf2f(pr[C_CKV + lane]); sk = v * v; }
        sq = wave_sum(sq); sk = wave_sum(sk);
        if (lane == 0) { rsd[i * 2] = __builtin_amdgcn_rsqf(sq * (1.f / 192.f) + EPS); rsd[i * 2 + 1] = __builtin_amdgcn_rsqf(sk * (1.f / 64.f) + EPS); } }
    __syncthreads();
    if (tid < 128) { const int ch = tid, h = ch >> 5, d = ch & 31;
        const float* Wg = a.in[I_GWG] + (size_t)li * 16 * 128; const float bg = a.in[I_GBG][li * 128 + ch];
        float wg[16];
#pragma unroll
        for (int r = 0; r < 16; ++r) wg[r] = Wg[r * 128 + ch];
        bf16* gq = (bf16*)(a.ws + B_GQ) + (size_t)(blk0 + h) * 64 * 32 + d; bf16* gk = (bf16*)(a.ws + B_GK) + (size_t)(blk0 + h) * 64 * 32 + d;
        float cum = 0.f;
        for (int i = 0; i < 64; ++i) { const int sr = src_row(b, c, i); float qv = 0.f, kv = 0.f;
            if (sr >= 0) { float x = bg;
#pragma unroll
                for (int r = 0; r < 16; ++r) x += lr[i * 16 + r] * wg[r];
                const float ls = fminf(x, 0.f) - __logf(1.f + __expf(-fabsf(x)));
                cum += ls * (1.f / 16.f);
                qv = bf2f(proj[(size_t)sr * N1 + C_AQ + ch]) * 0.17677669529663687f * __expf(cum); kv = bf2f(proj[(size_t)sr * N1 + C_AK + ch]) * __expf(-cum); }
            gq[i * 32] = (bf16)f2bf(qv); gk[i * 32] = (bf16)f2bf(kv); }
        ((float*)(a.ws + WS_GD))[(size_t)(blk0 + h) * 32 + d] = __expf(cum);
    }
    for (int idx = tid; idx < 64 * 32; idx += 512) { const int i = idx >> 5, ch8 = idx & 31, h = ch8 >> 3, e8 = (ch8 & 7) * 8, sr = src_row(b, c, i);
        v4u va = {0u, 0u, 0u, 0u}, vr = va, dq = va, dk = va, dv = va;
        if (sr >= 0) { const bf16* pr = proj + (size_t)sr * N1; va = *(const v4u*)(pr + C_AV + ch8 * 8); vr = *(const v4u*)(pr + C_RV + ch8 * 8);
            dq = *(const v4u*)(pr + C_DQ + ch8 * 8); dk = *(const v4u*)(pr + C_DK + ch8 * 8); dv = *(const v4u*)(pr + C_DV + ch8 * 8);
            const float qs = 0.17677669529663687f * LOG2E;
            dq.x = pk2(bflo(dq.x) * qs, bfhi(dq.x) * qs); dq.y = pk2(bflo(dq.y) * qs, bfhi(dq.y) * qs); dq.z = pk2(bflo(dq.z) * qs, bfhi(dq.z) * qs); dq.w = pk2(bflo(dq.w) * qs, bfhi(dq.w) * qs); }
        *(v4u*)((bf16*)(a.ws + B_GV) + ((size_t)(blk0 + h) * 64 + i) * 64 + e8) = va;
        *(v4u*)((bf16*)(a.ws + B_RV) + ((size_t)(blk0 + h) * 64 + i) * 64 + e8) = vr;
        *(v4u*)((bf16*)(a.ws + B_DQ) + (prow0 + i) * 256 + ch8 * 8) = dq;
        *(v4u*)((bf16*)(a.ws + B_DK) + (prow0 + i) * 256 + ch8 * 8) = dk;
        *(v4u*)((bf16*)(a.ws + B_DV) + (prow0 + i) * 256 + ch8 * 8) = dv; }
    const f32x2* tabR = (const f32x2*)(a.ws + WS_TABR); const f32x2* tabM = (const f32x2*)(a.ws + WS_TABM);
    for (int idx = tid; idx < 64 * 4 * 32; idx += 512) { const int j = idx & 31, h = (idx >> 5) & 3, i = idx >> 7, sr = src_row(b, c, i);
        float q1 = 0.f, q2 = 0.f, k1 = 0.f, k2 = 0.f;
        if (sr >= 0) { const bf16* pr = proj + (size_t)sr * N1; const f32x2 cs = tabR[(64 * c + i) * 32 + j];
            const float a1 = bf2f(pr[C_RQ + h * 64 + j]), a2 = bf2f(pr[C_RQ + h * 64 + 32 + j]), b1 = bf2f(pr[C_RK + h * 64 + j]), b2 = bf2f(pr[C_RK + h * 64 + 32 + j]);
            const float e = (float)(i + 1) * lg2gamma(h); const float fq = __builtin_amdgcn_exp2f(e), fk = 0.125f * __builtin_amdgcn_exp2f(-e);
            q1 = (a1 * cs[0] - a2 * cs[1]) * fq; q2 = (a1 * cs[1] + a2 * cs[0]) * fq; k1 = (b1 * cs[0] - b2 * cs[1]) * fk; k2 = (b1 * cs[1] + b2 * cs[0]) * fk; }
        bf16* rq = (bf16*)(a.ws + B_RQ) + ((size_t)(blk0 + h) * 64 + i) * 64; bf16* rk = (bf16*)(a.ws + B_RK) + ((size_t)(blk0 + h) * 64 + i) * 64;
        rq[j] = (bf16)f2bf(q1); rq[32 + j] = (bf16)f2bf(q2); rk[j] = (bf16)f2bf(k1); rk[32 + j] = (bf16)f2bf(k2); }
    const float QS = 0.10206207261596577f * LOG2E;
    for (int idx = tid; idx < 64 * 4 * 80; idx += 512) { const int n = idx % 80, hh = (idx / 80) & 3, i = idx / 320, sr = src_row(b, c, i);
        bf16* mq = (bf16*)(a.ws + B_MQ) + (prow0 + i) * 384 + hh * 96;
        if (n < 64) { mq[n] = sr < 0 ? (bf16)0 : (bf16)f2bf(bf2f(proj[(size_t)sr * N1 + C_QEFF + hh * 96 + n]) * rsd[i * 2] * QS); }
        else { const int j = n - 64; float y1 = 0.f, y2 = 0.f;
            if (sr >= 0) { const f32x2 cs = tabM[(64 * c + i) * 16 + j]; const float s = rsd[i * 2] * QS;
                const float x1 = bf2f(proj[(size_t)sr * N1 + C_QEFF + hh * 96 + 64 + j]) * s, x2 = bf2f(proj[(size_t)sr * N1 + C_QEFF + hh * 96 + 80 + j]) * s;
                y1 = x1 * cs[0] - x2 * cs[1]; y2 = x1 * cs[1] + x2 * cs[0]; }
            mq[64 + j] = (bf16)f2bf(y1); mq[80 + j] = (bf16)f2bf(y2); } }
    for (int idx = tid; idx < 64 * 80; idx += 512) { const int n = idx % 80, i = idx / 80, sr = src_row(b, c, i);
        bf16* mk = (bf16*)(a.ws + B_MK) + (prow0 + i) * 96;
        if (n < 64) { mk[n] = sr < 0 ? (bf16)0 : (bf16)f2bf(bf2f(proj[(size_t)sr * N1 + C_CKV + n]) * rsd[i * 2 + 1]); }
        else { const int j = n - 64; float y1 = 0.f, y2 = 0.f;
            if (sr >= 0) { const f32x2 cs = tabM[(64 * c + i) * 16 + j]; const float x1 = bf2f(proj[(size_t)sr * N1 + C_KPE + j]), x2 = bf2f(proj[(size_t)sr * N1 + C_KPE + 16 + j]);
                y1 = x1 * cs[0] - x2 * cs[1]; y2 = x1 * cs[1] + x2 * cs[0]; }
            mk[64 + j] = (bf16)f2bf(y1); mk[80 + j] = (bf16)f2bf(y2); } }
    __syncthreads();
}

template <int DK, int KIND>
__device__ __forceinline__ void lin_unit(const Args& a, int li, int b, int h, LAS unsigned char* lds, int tid) {
    LAS float* Qs = (LAS float*)lds; LAS float* Ks = Qs + 4096; LAS float* Vs = Qs + 8192; LAS float* As = Qs + 12288; LAS float* Ss = Qs + 16448; LAS float* Os = Qs + 20544; LAS float* Ds = Qs + 24704;
    const bf16* Qb = (const bf16*)(a.ws + (KIND ? B_RQ : B_GQ)); const bf16* Kb = (const bf16*)(a.ws + (KIND ? B_RK : B_GK)); const bf16* Vb = (const bf16*)(a.ws + (KIND ? B_RV : B_GV));
    const float* gain = a.in[KIND ? I_RNORM : I_GNORM] + li * 64;
    const bf16* proj = (const bf16*)(a.ws + B_PROJ); bf16* ob = (bf16*)a.out;
    for (int idx = tid; idx < DK * 64; idx += 512) Ss[idx] = 0.f;
    __syncthreads();
    for (int c = 0; c < NCH; ++c) {
        const size_t blk = (size_t)(b * NCH + c) * 4 + h;
        for (int idx = tid; idx < 64 * DK; idx += 512) { Qs[idx] = bf2f(Qb[blk * 64 * DK + idx]); Ks[idx] = bf2f(Kb[blk * 64 * DK + idx]); }
        for (int idx = tid; idx < 4096; idx += 512) Vs[idx] = bf2f(Vb[blk * 4096 + idx]);
        if (tid < DK) Ds[tid] = KIND ? __builtin_amdgcn_exp2f(64.f * lg2gamma(h)) : ((const float*)(a.ws + WS_GD))[blk * 32 + tid];
        __syncthreads();
        for (int idx = tid; idx < 4096; idx += 512) { const int i = idx >> 6, s = idx & 63; float v = 0.f;
            if (s <= i) { for (int d = 0; d < DK; ++d) v += Qs[i * DK + d] * Ks[s * DK + d]; }
            As[i * 65 + s] = v; }
        __syncthreads();
        for (int idx = tid; idx < 4096; idx += 512) { const int i = idx >> 6, e = idx & 63; float v = 0.f;
            for (int s = 0; s < 64; ++s) v += As[i * 65 + s] * Vs[s * 64 + e];
            for (int d = 0; d < DK; ++d) v += Qs[i * DK + d] * Ss[d * 64 + e];
            Os[i * 65 + e] = v; }
        float sn[DK * 64 / 512];
#pragma unroll
        for (int j = 0; j < DK * 64 / 512; ++j) { const int idx = tid + 512 * j, d = idx >> 6, e = idx & 63; float v = Ss[idx];
            for (int s = 0; s < 64; ++s) v += Ks[s * DK + d] * Vs[s * 64 + e];
            sn[j] = Ds[d] * v; }
        __syncthreads();
#pragma unroll
        for (int j = 0; j < DK * 64 / 512; ++j) Ss[tid + 512 * j] = sn[j];
        { const int i = tid >> 3, e0 = (tid & 7) * 8, sr = src_row(b, c, i); float v[8]; float s1 = 0.f;
#pragma unroll
            for (int j = 0; j < 8; ++j) { v[j] = Os[i * 65 + e0 + j]; s1 += v[j]; }
            float mean = 0.f;
            if (KIND) { s1 += __shfl_xor(s1, 1); s1 += __shfl_xor(s1, 2); s1 += __shfl_xor(s1, 4); mean = s1 * (1.f / 64.f); }
            float s2 = 0.f;
#pragma unroll
            for (int j = 0; j < 8; ++j) { v[j] -= mean; s2 += v[j] * v[j]; }
            s2 += __shfl_xor(s2, 1); s2 += __shfl_xor(s2, 2); s2 += __shfl_xor(s2, 4);
            const float rs = __builtin_amdgcn_rsqf(s2 * (1.f / 64.f) + EPS);
            if (sr >= 0 && (c > 0 || b == 0)) { const v4u og = *(const v4u*)(proj + (size_t)sr * N1 + (KIND ? C_ROG : C_AOG) + h * 64 + e0);
                const float g[8] = {bflo(og.x), bfhi(og.x), bflo(og.y), bfhi(og.y), bflo(og.z), bfhi(og.z), bflo(og.w), bfhi(og.w)};
                float y[8];
#pragma unroll
                for (int j = 0; j < 8; ++j) y[j] = v[j] * rs * gain[e0 + j] * silu_f(g[j]);
                v4u w; w.x = pk2(y[0], y[1]); w.y = pk2(y[2], y[3]); w.z = pk2(y[4], y[5]); w.w = pk2(y[6], y[7]);
                *(v4u*)(ob + (size_t)sr * DM + KIND * 256 + h * 64 + e0) = w; } }
        __syncthreads();
    }
}

template <int DK, bool VSEP>
__device__ __forceinline__ void attn_scalar(const bf16* Qb, int qld, const bf16* Kb, int kld, const bf16* Vb, int vld, int qpos, int ntiles, LAS float* Ks, LAS float* Vs, LAS float* Qs, float (&O)[64], float& lsum, int tid) {
    constexpr int KS = DK + 4, VS = 68;
    __syncthreads();
    for (int idx = tid; idx < 64 * (DK / 8); idx += 512) { const int r = idx / (DK / 8), ch = idx % (DK / 8); const v4u w = *(const v4u*)(Qb + (size_t)r * qld + ch * 8);
        LAS float* d = Qs + r * KS + ch * 8; *(LAS f32x4*)d = (f32x4){bflo(w.x), bfhi(w.x), bflo(w.y), bfhi(w.y)}; *(LAS f32x4*)(d + 4) = (f32x4){bflo(w.z), bfhi(w.z), bflo(w.w), bfhi(w.w)}; }
    float m = -1e30f, l = 0.f;
#pragma unroll
    for (int e = 0; e < 64; ++e) O[e] = 0.f;
    const int ks = tid & 7; const LAS float* qr = Qs + (tid >> 3) * KS;
    for (int kt = 0; kt < ntiles; ++kt) {
        __syncthreads();
        for (int idx = tid; idx < 64 * (DK / 8); idx += 512) { const int key = idx / (DK / 8), ch = idx % (DK / 8); const v4u w = *(const v4u*)(Kb + (size_t)(64 * kt + key) * kld + ch * 8);
            LAS float* d = Ks + key * KS + ch * 8; *(LAS f32x4*)d = (f32x4){bflo(w.x), bfhi(w.x), bflo(w.y), bfhi(w.y)}; *(LAS f32x4*)(d + 4) = (f32x4){bflo(w.z), bfhi(w.z), bflo(w.w), bfhi(w.w)}; }
        if (VSEP) { const int key = tid >> 3, ch = tid & 7; const v4u w = *(const v4u*)(Vb + (size_t)(64 * kt + key) * vld + ch * 8);
            LAS float* d = Vs + key * VS + ch * 8; *(LAS f32x4*)d = (f32x4){bflo(w.x), bfhi(w.x), bflo(w.y), bfhi(w.y)}; *(LAS f32x4*)(d + 4) = (f32x4){bflo(w.z), bfhi(w.z), bflo(w.w), bfhi(w.w)}; }
        __syncthreads();
        float s[8];
#pragma unroll
        for (int n = 0; n < 8; ++n) s[n] = 0.f;
#pragma unroll 2
        for (int d4 = 0; d4 < DK / 4; ++d4) { const f32x4 qv = *(const LAS f32x4*)(qr + 4 * d4);
#pragma unroll
            for (int n = 0; n < 8; ++n) { const f32x4 kv = *(const LAS f32x4*)(Ks + (ks + 8 * n) * KS + 4 * d4); s[n] += (qv[0] * kv[0] + qv[1] * kv[1]) + (qv[2] * kv[2] + qv[3] * kv[3]); } }
        float mx = -1e30f;
#pragma unroll
        for (int n = 0; n < 8; ++n) { const int kpos = 64 * kt + ks + 8 * n; if (kpos > qpos || kpos < 48) s[n] = -1e30f; mx = fmaxf(mx, s[n]); }
        mx = fmaxf(mx, __shfl_xor(mx, 1)); mx = fmaxf(mx, __shfl_xor(mx, 2)); mx = fmaxf(mx, __shfl_xor(mx, 4));
        const float mn = fmaxf(m, mx), sc = __builtin_amdgcn_exp2f(m - mn); m = mn; l *= sc;
#pragma unroll
        for (int e = 0; e < 64; ++e) O[e] *= sc;
#pragma unroll
        for (int n = 0; n < 8; ++n) { s[n] = s[n] <= -1e29f ? 0.f : __builtin_amdgcn_exp2f(s[n] - mn); l += s[n]; }
#pragma unroll 1
        for (int n = 0; n < 8; ++n) { float p = 0.f;
#pragma unroll
            for (int t = 0; t < 8; ++t) p = (t == n) ? s[t] : p;
            const int key = ks + 8 * n; const LAS float* vr = VSEP ? Vs + key * VS : Ks + key * KS;
#pragma unroll
            for (int e4 = 0; e4 < 16; ++e4) { const f32x4 vv = *(const LAS f32x4*)(vr + 4 * e4); O[4 * e4] += p * vv[0]; O[4 * e4 + 1] += p * vv[1]; O[4 * e4 + 2] += p * vv[2]; O[4 * e4 + 3] += p * vv[3]; } }
    }
    l += __shfl_xor(l, 1); l += __shfl_xor(l, 2); l += __shfl_xor(l, 4);
#pragma unroll
    for (int e = 0; e < 64; ++e) { float v = O[e]; v += __shfl_xor(v, 1); v += __shfl_xor(v, 2); v += __shfl_xor(v, 4); O[e] = v; }
    lsum = l;
}
__device__ __forceinline__ void attn_unit(const Args& a, int li, int kind, int b, int hh, int j, LAS unsigned char* lds, int tid) {
    LAS float* Ks = (LAS float*)lds; LAS float* Vs = Ks + 64 * 100; LAS float* Qs = Vs + 64 * 68; LAS float* O1s = Qs + 64 * 100;
    const int i = tid >> 3, ks = tid & 7, qpos = 64 * j + i; const size_t prow0 = (size_t)b * PSEQ + 64 * j;
    const int sr = src_row(b, j, i); const bool wr = sr >= 0 && (j > 0 || b == 0);
    bf16* ob = (bf16*)a.out;
    float O[64]; float l;
    if (kind == 0) {
        const bf16* K = (const bf16*)(a.ws + B_MK) + (size_t)b * PSEQ * 96;
        attn_scalar<96, false>((const bf16*)(a.ws + B_MQ) + prow0 * 384 + hh * 96, 384, K, 96, K, 96, qpos, j + 1, Ks, Vs, Qs, O, l, tid);
        const float il = l > 0.f ? 1.f / l : 0.f;
        if (wr) {
#pragma unroll
            for (int e8 = 0; e8 < 8; ++e8) if (e8 == ks) { v4u w; w.x = pk2(O[8 * e8] * il, O[8 * e8 + 1] * il); w.y = pk2(O[8 * e8 + 2] * il, O[8 * e8 + 3] * il); w.z = pk2(O[8 * e8 + 4] * il, O[8 * e8 + 5] * il); w.w = pk2(O[8 * e8 + 6] * il, O[8 * e8 + 7] * il);
                *(v4u*)(ob + (size_t)sr * DM + 512 + hh * 64 + 8 * e8) = w; } }
    } else {
        const float* lv = a.in[I_DLAM] + li * 128; float s01 = 0.f, s23 = 0.f;
        for (int d = 0; d < 32; ++d) { s01 += lv[d] * lv[32 + d]; s23 += lv[64 + d] * lv[96 + d]; }
        const float lam_init = 0.8f - 0.6f * __expf(-0.3f * (float)li), lam = __expf(s01) - __expf(s23) + lam_init;
        const bf16* Q = (const bf16*)(a.ws + B_DQ) + prow0 * 256 + hh * 64; const bf16* K = (const bf16*)(a.ws + B_DK) + (size_t)b * PSEQ * 256 + hh * 64; const bf16* V = (const bf16*)(a.ws + B_DV) + (size_t)b * PSEQ * 256 + hh * 64;
        attn_scalar<32, true>(Q, 256, K, 256, V, 256, qpos, j + 1, Ks, Vs, Qs, O, l, tid);
        { const float il = l > 0.f ? 1.f / l : 0.f;
#pragma unroll
            for (int e8 = 0; e8 < 8; ++e8) if (e8 == ks) {
#pragma unroll
                for (int t = 0; t < 8; ++t) O1s[i * 64 + 8 * e8 + t] = O[8 * e8 + t] * il; } }
        attn_scalar<32, true>(Q + 32, 256, K + 32, 256, V, 256, qpos, j + 1, Ks, Vs, Qs, O, l, tid);
        const float il = l > 0.f ? lam / l : 0.f; float y[8]; float ss = 0.f;
#pragma unroll
        for (int e8 = 0; e8 < 8; ++e8) if (e8 == ks) {
#pragma unroll
            for (int t = 0; t < 8; ++t) { y[t] = O1s[i * 64 + 8 * e8 + t] - O[8 * e8 + t] * il; ss += y[t] * y[t]; } }
        ss += __shfl_xor(ss, 1); ss += __shfl_xor(ss, 2); ss += __shfl_xor(ss, 4);
        const float rs = __builtin_amdgcn_rsqf(ss * (1.f / 64.f) + EPS) * (1.f - lam_init); const float* gn = a.in[I_DNORM] + li * 64 + 8 * ks;
        if (wr) { v4u w; w.x = pk2(y[0] * rs * gn[0], y[1] * rs * gn[1]); w.y = pk2(y[2] * rs * gn[2], y[3] * rs * gn[3]); w.z = pk2(y[4] * rs * gn[4], y[5] * rs * gn[5]); w.w = pk2(y[6] * rs * gn[6], y[7] * rs * gn[7]);
            *(v4u*)(ob + (size_t)sr * DM + 768 + hh * 64 + 8 * ks) = w; }
    }
}

__device__ __forceinline__ void route_block(const Args& a, int blk, LAS unsigned char* lds, int tid, int lane, int wave) {
    LAS float* Rs = (LAS float*)lds; LAS int* lcnt = (LAS int*)(lds + 32768); LAS int* gbase = lcnt + 8; LAS int* rec = lcnt + 16;
    gu32* ctl = (gu32*)(a.ws + WS_CTL);
    const float* Rt = (const float*)(a.ws + WS_RT); const bf16* hb = (const bf16*)(a.ws + WS_HB); const float* stB = (const float*)(a.ws + WS_STB);
    __syncthreads();
    for (int idx = tid; idx < 8 * DM; idx += 512) Rs[idx] = Rt[idx];
    if (tid < 8) lcnt[tid] = 0;
    __syncthreads();
    for (int rr = 0; rr < 16; ++rr) { const int rl = wave * 16 + rr, row = blk * 128 + rl;
        const v4u w0 = *(const v4u*)(hb + (size_t)row * DM + 8 * lane), w1 = *(const v4u*)(hb + (size_t)row * DM + 512 + 8 * lane);
        const float x[16] = {bflo(w0.x), bfhi(w0.x), bflo(w0.y), bfhi(w0.y), bflo(w0.z), bfhi(w0.z), bflo(w0.w), bfhi(w0.w), bflo(w1.x), bfhi(w1.x), bflo(w1.y), bfhi(w1.y), bflo(w1.z), bfhi(w1.z), bflo(w1.w), bfhi(w1.w)};
        float st = lane < 16 ? stB[(size_t)row * 16 + lane] : 0.f; st = wave_sum(st); const float rs = __builtin_amdgcn_rsqf(st * (1.f / 1024.f) + EPS);
        float lg[8];
#pragma unroll
        for (int e = 0; e < 8; ++e) { float s = 0.f;
#pragma unroll
            for (int t = 0; t < 8; ++t) s += x[t] * Rs[e * DM + 8 * lane + t] + x[8 + t] * Rs[e * DM + 512 + 8 * lane + t];
            lg[e] = wave_sum(s) * rs; }
        int e0 = 0; float v0 = lg[0];
#pragma unroll
        for (int e = 1; e < 8; ++e) if (lg[e] > v0) { v0 = lg[e]; e0 = e; }
        int e1 = -1; float v1 = -3.0e38f;
#pragma unroll
        for (int e = 0; e < 8; ++e) if (e != e0 && lg[e] > v1) { v1 = lg[e]; e1 = e; }
        const float g0 = 1.f / (1.f + __expf(v1 - v0)), g1 = 1.f - g0;
        if (lane == 0) { const int lp0 = atomicAdd((int*)(lcnt + e0), 1), lp1 = atomicAdd((int*)(lcnt + e1), 1);
            rec[rl * 6] = e0; rec[rl * 6 + 1] = e1; rec[rl * 6 + 2] = lp0; rec[rl * 6 + 3] = lp1; rec[rl * 6 + 4] = __float_as_int(g0); rec[rl * 6 + 5] = __float_as_int(g1); } }
    __syncthreads();
    if (tid < 8) gbase[tid] = (int)__hip_atomic_fetch_add(ctl + CW_CNT + 64 * tid, (unsigned)lcnt[tid], RLX_AGENT);
    __syncthreads();
    if (tid < 256) { const int rl = tid >> 1, s = tid & 1, tok = blk * 128 + rl, e = rec[rl * 6 + s];
        ((int*)(a.ws + MO_TOKE))[tok * 2 + s] = e; ((int*)(a.ws + MO_TOKP))[tok * 2 + s] = gbase[e] + rec[rl * 6 + 2 + s]; ((int*)(a.ws + MO_TOKW))[tok * 2 + s] = rec[rl * 6 + 4 + s]; }
    __syncthreads();
}
__device__ __forceinline__ void moe_offsets(const Args& a, LAS int* offs, int tid) {
    gu32* ctl = (gu32*)(a.ws + WS_CTL);
    __syncthreads();
    if (tid == 0) { int o = 0;
        for (int e = 0; e < 8; ++e) { const int cnt = (int)__hip_atomic_load(ctl + CW_CNT + 64 * e, RLX_AGENT); offs[e] = o * 256; o += (cnt + 255) >> 8; }
        offs[8] = o; }
    __syncthreads();
}

#ifndef MK_ONE_LAUNCH
#define MK_ONE_LAUNCH 1
#endif
constexpr int NPHASE = 20;
constexpr int CW_Q = 12288;
__global__ void __launch_bounds__(512, 2) mega_fwd(Args a) {
    extern __shared__ __attribute__((aligned(16))) unsigned char lds_raw[];
    LAS unsigned char* lds = (LAS unsigned char*)lds_raw;
    volatile LAS unsigned* MISC = (volatile LAS unsigned*)(lds + MISC_OFF);
    const int tid = threadIdx.x, lane = tid & 63, wave = __builtin_amdgcn_readfirstlane(tid >> 6), G = gridDim.x;
    for (int u = tid; u < (LDS_BYTES - RING_BYTES) / 4; u += 512) ((LAS unsigned*)(lds + RING_BYTES))[u] = 0u;
    __syncthreads();
    gu32* ctl = (gu32*)(a.ws + WS_CTL);
    const int lo = a.ph_lo, hi = a.ph_hi;
    XcdBarrier bar; bar.bar = (unsigned*)(ctl + CW_BAR); bar.x = 0; bar.st = nullptr;
    if (hi - lo > 1) bar = xcd_barrier_post((unsigned*)(ctl + CW_BAR), MISC + 8);
#define IN(k) (lo <= (k) && (k) < hi)
#define OPQ() int ptid = threadIdx.x; asm volatile("" : "+v"(ptid)); const int plane = ptid & 63; (void)plane
#define SEAM(k) do { if (IN(k) && IN((k) + 1)) xcd_barrier(bar); } while (0)
    bf16* hb = (bf16*)(a.ws + WS_HB); float* stA = (float*)(a.ws + WS_STA); float* stB = (float*)(a.ws + WS_STB);

    if (IN(0)) { OPQ(); p0_prologue(a, lds, ptid, plane, wave); }
    SEAM(0);

    for (int li = 0; li < 2; ++li) {
        const int pb = 1 + 6 * li;
        if (IN(pb)) {
            pg8::Gemm g{hb, (const bf16*)(a.ws + WS_W1T + li * W1T_BYTES), DM, 0, nullptr}; pg8::StaticOrder S; S.init(NPAN, N1 / 256, G, (int)blockIdx.x);
            EpiProj E{(bf16*)(a.ws + B_PROJ), stA};
            pg8::gemm_phase<EpiProj, pg8::StaticOrder, false>(lds, g, S, E);
        }
        SEAM(pb);
        if (IN(pb + 1)) { OPQ(); for (int u = blockIdx.x; u < NB * NCH; u += G) prep_unit(a, li, u / NCH, u % NCH, lds, ptid, plane, wave); }
        SEAM(pb + 1);
        if (IN(pb + 2)) {
            OPQ(); const int tid = ptid;
            LAS int* qid = (LAS int*)(lds + RING_BYTES + 64);
            for (;;) {
                __syncthreads();
                if (tid == 0) *qid = (int)__hip_atomic_fetch_add(ctl + CW_Q + 64 * li, 1u, RLX_AGENT);
                __syncthreads();
                const int id = *qid;
                if (id >= 128 + 33 * 128) break;
                if (id < 128) { const int b = id >> 3, k = (id >> 2) & 1, h = id & 3; if (k == 0) lin_unit<32, 0>(a, li, b, h, lds, tid); else lin_unit<64, 1>(a, li, b, h, lds, tid); }
                else { const int v = id - 128, j = 32 - v / 128, rem = v % 128, kind = rem >> 6, b = (rem >> 2) & 15, hh = rem & 3;
                    if (j > 0 || b == 0) attn_unit(a, li, kind, b, hh, j, lds, tid); }
            }
        }
        SEAM(pb + 2);
        if (IN(pb + 3)) {
            pg8::Gemm g{(const bf16*)a.out, (const bf16*)(a.ws + WS_WOT + li * WOT_BYTES), DM, 0, nullptr}; pg8::StaticOrder S; S.init(NPAN, 4, G, (int)blockIdx.x);
            EpiResid E{hb, stB};
            pg8::gemm_phase<EpiResid, pg8::StaticOrder, false>(lds, g, S, E);
        }
        SEAM(pb + 3);
        if (li == 0) {
            if (IN(5)) {
                pg8::Gemm g{hb, (const bf16*)(a.ws + WS_WGU), DM, 0, nullptr}; pg8::StaticOrder S; S.init(NPAN, 2 * DFF / 256, G, (int)blockIdx.x);
                EpiSwiglu E{(bf16*)(a.ws + B_ACT), DFF, stB};
                pg8::gemm_phase<EpiSwiglu, pg8::StaticOrder, false>(lds, g, S, E);
            }
            SEAM(5);
            if (IN(6)) {
                pg8::Gemm g{(const bf16*)(a.ws + B_ACT), (const bf16*)(a.ws + WS_WD), DFF, 0, nullptr}; pg8::StaticOrder S; S.init(NPAN, 4, G, (int)blockIdx.x);
                EpiResid E{hb, stA};
                pg8::gemm_phase<EpiResid, pg8::StaticOrder, false>(lds, g, S, E);
            }
            SEAM(6);
        }
    }
    if (IN(11)) { OPQ(); const int tid = ptid, lane = plane;
        LAS float* scr = (LAS float*)(lds + wave * 16384);
        const int gw = blockIdx.x * 8 + wave, NGW = G * 8;
        constexpr int IG = 16 * 112, ID = 56 * 32;
        for (int it = gw; it < 8 * (2 * IG + ID); it += NGW) { const int e = it / (2 * IG + ID); int r = it % (2 * IG + ID);
            if (r < IG) { transpose_item(a.in[I_EG] + (size_t)e * DM * DFE, DM, DFE, a.in[I_FNORM] + DM, (bf16*)(a.ws + B_EGU + e * EGU_BYTES), r / 112, r % 112, 1, scr, lane); continue; } r -= IG;
            if (r < IG) { transpose_item(a.in[I_EU] + (size_t)e * DM * DFE, DM, DFE, a.in[I_FNORM] + DM, (bf16*)(a.ws + B_EGU + e * EGU_BYTES), r / 112, r % 112, 2, scr, lane); continue; } r -= IG;
            transpose_item(a.in[I_ED] + (size_t)e * DFE * DM, DFE, DM, nullptr, (bf16*)(a.ws + B_ED + e * ED_BYTES), r / 32, r % 32, 0, scr, lane); }
        for (int i = blockIdx.x * 512 + tid; i < MAXPAN * 256; i += G * 512) { ((int*)(a.ws + MO_ROWIDX))[i] = -1; ((int*)(a.ws + MO_PDST))[i] = -1; ((f32x2*)(a.ws + MO_PINFO))[i] = (f32x2){0.f, 0.f}; }
        for (int blk = blockIdx.x; blk < MR / 128; blk += G) route_block(a, blk, lds, tid, lane, wave);
    }
    SEAM(11);
    LAS int* offs = (LAS int*)(lds + RING_BYTES + 128);
    if (IN(12)) { OPQ(); const int tid = ptid;
        moe_offsets(a, offs, tid);
        for (int idx = blockIdx.x * 512 + tid; idx < 2 * MR; idx += G * 512) { const int tok = idx >> 1, e = ((const int*)(a.ws + MO_TOKE))[idx], gpos = offs[e] + ((const int*)(a.ws + MO_TOKP))[idx];
            const f32x4* sp = (const f32x4*)(stB + (size_t)tok * 16); const f32x4 s0 = sp[0], s1 = sp[1], s2 = sp[2], s3 = sp[3];
            const float ss = ((s0[0] + s0[1]) + (s0[2] + s0[3])) + ((s1[0] + s1[1]) + (s1[2] + s1[3])) + ((s2[0] + s2[1]) + (s2[2] + s2[3])) + ((s3[0] + s3[1]) + (s3[2] + s3[3]));
            ((int*)(a.ws + MO_ROWIDX))[gpos] = tok; ((int*)(a.ws + MO_PDST))[gpos] = idx;
            ((f32x2*)(a.ws + MO_PINFO))[gpos] = (f32x2){__builtin_amdgcn_rsqf(ss * (1.f / 1024.f) + EPS), __int_as_float(((const int*)(a.ws + MO_TOKW))[idx])}; }
        if (blockIdx.x == 0 && tid < MAXPAN + 8) { int e = 0;
            for (int k = 1; k < 8; ++k) if (tid * 256 >= offs[k]) e = k;
            ((int*)(a.ws + MO_PEXP))[tid] = e; }
    }
    SEAM(12);
    for (int ci = 0; ci < 3; ++ci) {
        if (IN(13 + 2 * ci) || IN(14 + 2 * ci)) moe_offsets(a, offs, tid);
        int nP = 0; if (IN(13 + 2 * ci) || IN(14 + 2 * ci)) { nP = __builtin_amdgcn_readfirstlane(offs[8]) - 128 * ci; nP = nP > 128 ? 128 : nP; }
        if (IN(13 + 2 * ci) && nP > 0) {
            pg8::Gemm g{hb, (const bf16*)(a.ws + B_EGU), DM, EGU_BYTES, (const int*)(a.ws + MO_ROWIDX)}; pg8::MoeOrder S; S.init(nP, 2 * DFE / 256, G, (int)blockIdx.x, 128 * ci, (const int*)(a.ws + MO_PEXP));
            EpiSwigluMoe E{(bf16*)(a.ws + B_EACT), (const f32x2*)(a.ws + MO_PINFO)};
            pg8::gemm_phase<EpiSwigluMoe, pg8::MoeOrder, true>(lds, g, S, E);
        }
        SEAM(13 + 2 * ci);
        if (IN(14 + 2 * ci) && nP > 0) {
            pg8::Gemm g{(const bf16*)(a.ws + B_EACT), (const bf16*)(a.ws + B_ED), DFE, ED_BYTES, nullptr}; pg8::MoeOrder S; S.init(nP, 4, G, (int)blockIdx.x, 128 * ci, (const int*)(a.ws + MO_PEXP));
            EpiMoeDown E{(unsigned char*)a.out, (const int*)(a.ws + MO_PDST), (const f32x2*)(a.ws + MO_PINFO)};
            pg8::gemm_phase<EpiMoeDown, pg8::MoeOrder, false>(lds, g, S, E);
        }
        SEAM(14 + 2 * ci);
    }
    if (IN(19)) { OPQ(); const int lane = plane;
        const float* fn = a.in[I_FINAL];
        for (int r = blockIdx.x * 8 + wave; r < MR; r += G * 8) {
            unsigned char* orow = (unsigned char*)a.out + (size_t)r * 4096; float v[16]; float ss = 0.f;
#pragma unroll
            for (int hf = 0; hf < 2; ++hf) { const int k = 512 * hf + 8 * lane; const v4u h4 = *(const v4u*)(hb + (size_t)r * DM + k), y0 = *(const v4u*)(orow + 2 * k), y1 = *(const v4u*)(orow + 2048 + 2 * k);
                const unsigned hw[4] = {h4.x, h4.y, h4.z, h4.w}, aw[4] = {y0.x, y0.y, y0.z, y0.w}, bw[4] = {y1.x, y1.y, y1.z, y1.w};
#pragma unroll
                for (int t = 0; t < 4; ++t) { const float x0 = bflo(hw[t]) + bflo(aw[t]) + bflo(bw[t]), x1 = bfhi(hw[t]) + bfhi(aw[t]) + bfhi(bw[t]); v[8 * hf + 2 * t] = x0; v[8 * hf + 2 * t + 1] = x1; ss += x0 * x0 + x1 * x1; } }
            ss = wave_sum(ss); const float rs = __builtin_amdgcn_rsqf(ss * (1.f / 1024.f) + EPS);
#pragma unroll
            for (int hf = 0; hf < 2; ++hf) { const int k = 512 * hf + 8 * lane; const f32x4 g0 = *(const f32x4*)(fn + k), g1 = *(const f32x4*)(fn + k + 4);
                *(f32x4*)(orow + 4 * k) = (f32x4){v[8 * hf] * rs * g0[0], v[8 * hf + 1] * rs * g0[1], v[8 * hf + 2] * rs * g0[2], v[8 * hf + 3] * rs * g0[3]};
                *(f32x4*)(orow + 4 * k + 16) = (f32x4){v[8 * hf + 4] * rs * g1[0], v[8 * hf + 5] * rs * g1[1], v[8 * hf + 6] * rs * g1[2], v[8 * hf + 7] * rs * g1[3]}; }
        }
    }
#undef IN
#undef SEAM
}

extern "C" void kernel_launch(void* const* d_in, const int* in_sizes, int n_in, void* d_out, int out_size, void* d_ws, size_t ws_size, hipStream_t stream) {
    static int grid = 0;
    if (grid == 0) {
        if (n_in != 24 || in_sizes[0] != MR * DM || out_size != MR * DM || ws_size < WS_NEED) { fprintf(stderr, "kernel_launch: unexpected problem (n_in %d, in0 %d, out %d, ws %zu < %zu)\n", n_in, n_in > 0 ? in_sizes[0] : -1, out_size, ws_size, (size_t)WS_NEED); grid = -1; return; }
        int dev = 0, cus = 0, per_cu = 0;
        if (hipGetDevice(&dev) != hipSuccess || hipDeviceGetAttribute(&cus, hipDeviceAttributeMultiprocessorCount, dev) != hipSuccess) { grid = -1; return; }
        if (hipFuncSetAttribute((const void*)mega_fwd, hipFuncAttributeMaxDynamicSharedMemorySize, LDS_BYTES) != hipSuccess) { fprintf(stderr, "kernel_launch: hipFuncSetAttribute failed\n"); grid = -1; return; }
        if (hipOccupancyMaxActiveBlocksPerMultiprocessor(&per_cu, (const void*)mega_fwd, 512, LDS_BYTES) != hipSuccess || per_cu < 1) fprintf(stderr, "kernel_launch: occupancy query reports %d\n", per_cu);
        (void)hipGetLastError();
        grid = cus;
    }
    if (grid < 0) return;
    if (hipMemsetAsync((char*)d_ws + WS_CTL, 0, CTL_BYTES, stream) != hipSuccess) return;
    Args a{};
    for (int i = 0; i < 24; ++i) a.in[i] = (const float*)d_in[i];
    a.out = (float*)d_out; a.ws = (unsigned char*)d_ws;
#if MK_ONE_LAUNCH
    a.ph_lo = 0; a.ph_hi = NPHASE;
    hipLaunchKernelGGL(mega_fwd, dim3(grid), dim3(512), LDS_BYTES, stream, a);
#else
    for (int p = 0; p < NPHASE; ++p) { a.ph_lo = p; a.ph_hi = p + 1; hipLaunchKernelGGL(mega_fwd, dim3(grid), dim3(512), LDS_BYTES, stream, a); }
#endif
}
```

```cpp
#include <hip/hip_runtime.h>
#include <cstdio>
#include <cstdint>

namespace pg8 {
#define PG8_LAS __attribute__((address_space(3)))
typedef unsigned short bf16_t;
typedef short bf16x8 __attribute__((ext_vector_type(8)));
typedef float f32x4 __attribute__((ext_vector_type(4)));
typedef unsigned u32x4 __attribute__((ext_vector_type(4)));
constexpr int BM = 256, BK = 64, HALF = 128, HTB = HALF * BK * 2  , STAGE_BYTES = 8 * HTB, NXCD = 8, WGM = 8;

__host__ __device__ __forceinline__ int lds_byte(int r, int c) { const int st = (r >> 4) * 2 + (c >> 5), rr = r & 15, cc = c & 31, ob = rr * 64 + cc * 2; return st * 1024 + (ob ^ (((ob >> 9) & 1) << 5)); }
__host__ __device__ __forceinline__ void stage_rc(int b, int& R, int& C) { const int st = b / 1024, sb = b % 1024, swz = sb ^ (((sb >> 9) & 1) << 5); R = (st >> 1) * 16 + swz / 64; C = (st & 1) * 32 + (swz % 64) / 2; }
__host__ __device__ __forceinline__ int perm32(int rho) { const int n = rho >> 4, i = rho & 15; return 8 * (i >> 2) + 4 * n + (i & 3); }

struct Unit { int pm, pn, e, gp; };
struct Gemm { const bf16_t* A; const bf16_t* Bt; int K; size_t estride  ; const int* rowidx  ; };

struct StaticOrder {
    int nM, nN, nwg, G, c;
    __device__ void init(int nM_, int nN_, int G_, int c_) { nM = nM_; nN = nN_; nwg = nM * nN; G = G_; c = c_; }
    __device__ __forceinline__ bool map(int i, int& pm, int& pn) const {
        const long L = (long)i * G + c; if (L >= nwg) return false;
        int wgid = (int)L; { const int q = nwg / NXCD, r = nwg % NXCD, xcd = wgid % NXCD, off = wgid / NXCD; wgid = (xcd < r ? xcd * (q + 1) : r * (q + 1) + (xcd - r) * q) + off; }
        const int nig = WGM * nN, gid = wgid / nig, fm = gid * WGM, gsz = (nM - fm) < WGM ? (nM - fm) : WGM;
        pm = fm + ((wgid % nig) % gsz); pn = (wgid % nig) / gsz; return true;
    }
    __device__ __forceinline__ bool next(int i, Unit& u) const { int pm, pn; if (!map(i, pm, pn)) return false; u.pm = pm; u.pn = pn; u.e = 0; u.gp = pm; return true; }
};
struct MoeOrder {
    StaticOrder so; int p0; const int* pexp;
    __device__ void init(int nP, int nN, int G, int c, int p0_, const int* pexp_) { so.init(nP, nN, G, c); p0 = p0_; pexp = pexp_; }
    __device__ __forceinline__ bool next(int i, Unit& u) const { int pm, pn; if (!so.map(i, pm, pn)) return false; u.pm = pm; u.pn = pn; u.gp = p0 + pm; u.e = __builtin_amdgcn_readfirstlane(pexp[u.gp]); return true; }
};

__device__ __forceinline__ unsigned cvt_pk_bf16(float lo, float hi) { unsigned r; asm volatile("v_cvt_pk_bf16_f32 %0, %1, %2" : "=v"(r) : "v"(lo), "v"(hi)); return r; }
__device__ __forceinline__ float bf_lo(unsigned w) { return __uint_as_float(w << 16); }
__device__ __forceinline__ float bf_hi(unsigned w) { return __uint_as_float(w & 0xffff0000u); }

template <class Epi, class Sched, bool GATHER>
__device__ __forceinline__ void gemm_phase(PG8_LAS unsigned char* lds, const Gemm g, const Sched& S, const Epi& E) {
    int tid_ = threadIdx.x; asm volatile("" : "+v"(tid_));
    const int tid = tid_, wid = __builtin_amdgcn_readfirstlane(tid >> 6), lane = tid & 63, wr = wid >> 2, wc = wid & 3, fr = lane & 15, fq = lane >> 4;
    const int K = g.K, nt = K / BK;
    int Ra[2], Ca[2]; unsigned voffB[2];
#pragma unroll
    for (int i = 0; i < 2; ++i) { int R, C; stage_rc(tid * 16 + i * 8192, R, C); const int Rb = (R & ~31) + perm32(R & 31);
        Ra[i] = R; Ca[i] = C; voffB[i] = (unsigned)(Rb * K + C) * 2u; }
    const size_t kstep = (size_t)(BK * 2);
    const size_t hstep = (size_t)HALF * K * 2;
    const size_t tstep = 2 * hstep;
    const unsigned ldsw = (unsigned)wid * 1024u;
    const int aoff = lds_byte(wr * 64 + fr, fq * 8), boff = lds_byte(wc * 32 + fr, fq * 8);
    const char* const A0 = (const char*)g.A;
#define PG8_SA(b, h) (((b) * 2 + (h)) * HTB)
#define PG8_SB(b, h) ((4 + (b) * 2 + (h)) * HTB)
#define PG8_STAGE(bufoff, gbase, voff) do { _Pragma("unroll") for (int _i = 0; _i < 2; ++_i) \
        __builtin_amdgcn_global_load_lds((const unsigned*)((const char*)(gbase) + (voff)[_i]), (PG8_LAS unsigned*)(lds + (bufoff) + ldsw + _i * 8192), 16, 0, 0); } while (0)
#define PG8_LDA(dst, b, h) do { _Pragma("unroll") for (int m = 0; m < 4; ++m) _Pragma("unroll") for (int k = 0; k < 2; ++k) dst[m][k] = *(const PG8_LAS bf16x8*)(lds + PG8_SA(b, h) + aoff + m * 2048 + k * 1024); } while (0)
#define PG8_LDB(dst, b, h) do { _Pragma("unroll") for (int n = 0; n < 2; ++n) _Pragma("unroll") for (int k = 0; k < 2; ++k) dst[n][k] = *(const PG8_LAS bf16x8*)(lds + PG8_SB(b, h) + boff + n * 2048 + k * 1024); } while (0)
#define PG8_MMA(ai, bj, At, Bt) do { __builtin_amdgcn_s_setprio(1); _Pragma("unroll") for (int m = 0; m < 4; ++m) _Pragma("unroll") for (int n = 0; n < 2; ++n) _Pragma("unroll") for (int k = 0; k < 2; ++k) \
        acc[ai][bj][m][n] = __builtin_amdgcn_mfma_f32_16x16x32_bf16(Bt[n][k], At[m][k], acc[ai][bj][m][n], 0, 0, 0); __builtin_amdgcn_s_setprio(0); } while (0)
#define PG8_WAIT_V(n) asm volatile("s_waitcnt vmcnt(" #n ")" ::: "memory")
#define PG8_WAIT_L(n) asm volatile("s_waitcnt lgkmcnt(" #n ")" ::: "memory")
#define PG8_BAR __builtin_amdgcn_s_barrier()
#define PG8_SCHED __builtin_amdgcn_sched_barrier(0)
#define PG8_AOFFS(dst, u) do { _Pragma("unroll") for (int _h = 0; _h < 2; ++_h) _Pragma("unroll") for (int _i = 0; _i < 2; ++_i) { \
        int _row = (u).pm * BM + _h * HALF + Ra[_i]; \
        if (GATHER) { const int _gi = g.rowidx[(u).gp * BM + _h * HALF + Ra[_i]]; _row = _gi < 0 ? 0 : _gi; } \
        dst[_h][_i] = ((unsigned)_row * (unsigned)K + (unsigned)Ca[_i]) * 2u; } } while (0)
    Unit cur, nxt; int ui = 0;
    if (!S.next(0, cur)) return;
    f32x4 acc[2][2][4][2];
#pragma unroll
    for (int a = 0; a < 2; ++a)
#pragma unroll
        for (int b = 0; b < 2; ++b)
#pragma unroll
            for (int m = 0; m < 4; ++m)
#pragma unroll
                for (int n = 0; n < 2; ++n) acc[a][b][m][n] = (f32x4){0.f, 0.f, 0.f, 0.f};
    bf16x8 At[4][2], B0[2][2], B1[2][2];
    unsigned oaC[2][2], oaN[2][2];
    PG8_AOFFS(oaC, cur);
    const char* cB = (const char*)g.Bt + (size_t)cur.e * g.estride + (size_t)cur.pn * tstep;
    PG8_STAGE(PG8_SB(0, 0), cB, voffB); PG8_STAGE(PG8_SB(0, 1), cB + hstep, voffB); PG8_STAGE(PG8_SA(0, 0), A0, oaC[0]); PG8_STAGE(PG8_SA(0, 1), A0, oaC[1]);
    if (wr == 1) PG8_BAR;
    PG8_WAIT_V(2); PG8_BAR;
    PG8_STAGE(PG8_SB(1, 0), cB + kstep, voffB); PG8_STAGE(PG8_SA(1, 0), A0 + kstep, oaC[0]); PG8_STAGE(PG8_SB(1, 1), cB + hstep + kstep, voffB);
    PG8_WAIT_V(6); PG8_BAR;
    for (;;) {
        const bool has_next = S.next(ui + 1, nxt);
        if (has_next) { PG8_AOFFS(oaN, nxt); }
        else {
#pragma unroll
            for (int _h = 0; _h < 2; ++_h)
#pragma unroll
                for (int _i = 0; _i < 2; ++_i) oaN[_h][_i] = oaC[_h][_i]; }
        const char* nB = has_next ? (const char*)g.Bt + (size_t)nxt.e * g.estride + (size_t)nxt.pn * tstep : cB;
        for (int t = 0; t < nt; t += 2) {
            const bool last = (t == nt - 2);
            const char* ka1 = A0 + (size_t)(t + 1) * kstep;
            const char* ka2 = last ? A0 : A0 + (size_t)(t + 2) * kstep; const char* b2 = last ? nB : cB + (size_t)(t + 2) * kstep;
            const char* ka3 = ka2 + kstep; const char* b3 = b2 + kstep;
            unsigned o2[2][2];
#pragma unroll
            for (int _h = 0; _h < 2; ++_h)
#pragma unroll
                for (int _i = 0; _i < 2; ++_i) o2[_h][_i] = last ? oaN[_h][_i] : oaC[_h][_i];
            PG8_LDB(B0, 0, 0); PG8_LDB(B1, 0, 1); PG8_SCHED; PG8_LDA(At, 0, 0); PG8_STAGE(PG8_SA(1, 1), ka1, oaC[1]);
            PG8_WAIT_V(8); PG8_WAIT_L(0); PG8_BAR; PG8_MMA(0, 0, At, B0); PG8_MMA(0, 1, At, B1); PG8_BAR; PG8_SCHED;
            PG8_LDA(At, 0, 1); PG8_STAGE(PG8_SB(0, 0), b2, voffB); PG8_STAGE(PG8_SB(0, 1), b2 + hstep, voffB); PG8_STAGE(PG8_SA(0, 0), ka2, o2[0]);
            PG8_WAIT_V(8); PG8_WAIT_L(0); PG8_BAR; PG8_MMA(1, 0, At, B0); PG8_MMA(1, 1, At, B1); PG8_BAR; PG8_SCHED;
            PG8_LDB(B0, 1, 0); PG8_LDB(B1, 1, 1); PG8_SCHED; PG8_LDA(At, 1, 0); PG8_STAGE(PG8_SA(0, 1), ka2, o2[1]);
            PG8_WAIT_V(8); PG8_WAIT_L(0); PG8_BAR; PG8_MMA(0, 0, At, B0); PG8_MMA(0, 1, At, B1); PG8_BAR; PG8_SCHED;
            PG8_LDA(At, 1, 1); PG8_STAGE(PG8_SB(1, 0), b3, voffB); PG8_STAGE(PG8_SB(1, 1), b3 + hstep, voffB); PG8_STAGE(PG8_SA(1, 0), ka3, o2[0]);
            PG8_WAIT_V(8); PG8_WAIT_L(0); PG8_BAR; PG8_MMA(1, 0, At, B0); PG8_MMA(1, 1, At, B1); PG8_BAR; PG8_SCHED;
        }
        if (wr == 0) PG8_BAR;
        E(acc, cur, wr, wc, fr, fq);
        if (!has_next) break;
#pragma unroll
        for (int a = 0; a < 2; ++a)
#pragma unroll
            for (int b = 0; b < 2; ++b)
#pragma unroll
                for (int m = 0; m < 4; ++m)
#pragma unroll
                    for (int n = 0; n < 2; ++n) acc[a][b][m][n] = (f32x4){0.f, 0.f, 0.f, 0.f};
        cur = nxt; cB = nB; ++ui;
#pragma unroll
        for (int _h = 0; _h < 2; ++_h)
#pragma unroll
            for (int _i = 0; _i < 2; ++_i) oaC[_h][_i] = oaN[_h][_i];
        if (wr == 1) PG8_BAR;
    }
    PG8_WAIT_V(0);
    PG8_BAR;
#undef PG8_SA
#undef PG8_SB
#undef PG8_STAGE
#undef PG8_LDA
#undef PG8_LDB
#undef PG8_MMA
#undef PG8_WAIT_V
#undef PG8_WAIT_L
#undef PG8_BAR
#undef PG8_SCHED
#undef PG8_AOFFS
}
}
#define GAS __attribute__((address_space(1)))
#define LAS __attribute__((address_space(3)))
typedef unsigned short bf16;
typedef unsigned v4u __attribute__((ext_vector_type(4)));
typedef unsigned v2u __attribute__((ext_vector_type(2)));
typedef float f32x4 __attribute__((ext_vector_type(4)));
typedef float f32x2 __attribute__((ext_vector_type(2)));
typedef GAS unsigned gu32;
#define RLX_AGENT __ATOMIC_RELAXED, __HIP_MEMORY_SCOPE_AGENT
#define LDS_WAIT() asm volatile("s_waitcnt lgkmcnt(0)" ::: "memory")
#define VM_WAIT() asm volatile("s_waitcnt vmcnt(0)" ::: "memory")
__device__ __forceinline__ unsigned f2bf(float f) { unsigned u = __builtin_bit_cast(unsigned, f); return (u + 0x7fffu + ((u >> 16) & 1u)) >> 16; }
__device__ __forceinline__ unsigned pk2(float lo, float hi) { return f2bf(lo) | (f2bf(hi) << 16); }
__device__ __forceinline__ float bf2f(bf16 h) { return __uint_as_float(((unsigned)h) << 16); }
__device__ __forceinline__ float bflo(unsigned w) { return __uint_as_float(w << 16); }
__device__ __forceinline__ float bfhi(unsigned w) { return __uint_as_float(w & 0xffff0000u); }

#define XB_TMO      128
#define XB_XCNT(j)  (256  + 64 * (j))
#define XB_XSUB(j)  (1280 + 64 * (j))
#define XB_XGEN(j)  (2304 + 64 * (j))
#define XB_TOP      3328
#define XB_TOPGEN   3392
#define XCD_BAR_WORDS 3456
#define XB_SPIN_CAP (1u << 18)

__device__ __forceinline__ unsigned xb_ld(unsigned* p)              { return __hip_atomic_load(p, __ATOMIC_RELAXED, __HIP_MEMORY_SCOPE_AGENT); }
__device__ __forceinline__ unsigned xb_add(unsigned* p, unsigned v) { return __hip_atomic_fetch_add(p, v, __ATOMIC_RELAXED, __HIP_MEMORY_SCOPE_AGENT); }
__device__ __forceinline__ unsigned xb_xcc_id() { return (unsigned)__builtin_amdgcn_s_getreg((3 << 11) | 20) & 0xFu; }
#define XB_SPIN(cond, bar) do { unsigned _sp = 0; while (cond) { __builtin_amdgcn_s_sleep(1); \
    if ((++_sp & 255u) == 0u) { if (xb_ld(&(bar)[XB_TMO])) break; if (_sp > XB_SPIN_CAP) { atomicAdd(&(bar)[XB_TMO], 1u); break; } } } } while (0)

struct XcdBarrier {
    unsigned* bar; unsigned x;
    volatile LAS unsigned* st;
};

__device__ __forceinline__ XcdBarrier xcd_barrier_post(unsigned* bar, volatile LAS unsigned* st) {
    XcdBarrier b; b.bar = bar; b.x = xb_xcc_id(); b.st = st;
    if (threadIdx.x == 0) (void)xb_add(&bar[XB_XCNT(b.x)], 1u);
    return b;
}
__device__ __forceinline__ void xcd_barrier_complete(unsigned* bar, unsigned x, unsigned& nloc, unsigned& nx) {
    const unsigned G = gridDim.x * gridDim.y * gridDim.z;
    unsigned sum, cnt, mine, sp = 0u;
    for (;;) {
        sum = 0u; cnt = 0u; mine = 0u;
#pragma unroll
        for (unsigned j = 0; j < 16; ++j) { const unsigned c = xb_ld(&bar[XB_XCNT(j)]); sum += c; cnt += (c > 0u) ? 1u : 0u; mine = (j == x) ? c : mine; }
        if (sum == G) break;
        __builtin_amdgcn_s_sleep(1);
        if ((++sp & 255u) == 0u) { if (xb_ld(&bar[XB_TMO])) break; if (sp > XB_SPIN_CAP) { atomicAdd(&bar[XB_TMO], 1u); break; } }
    }
    nloc = mine > 0u ? mine : 1u; nx = cnt > 0u ? cnt : 1u;
}

__device__ __forceinline__ void xcd_barrier(const XcdBarrier& b) {
    asm volatile("s_waitcnt vmcnt(0)" ::: "memory");
    __syncthreads();
    if (threadIdx.x == 0) {
        unsigned* bar = b.bar;
        __builtin_amdgcn_s_waitcnt(0);
        unsigned nloc = b.st[0], nx = b.st[1];
        if (nloc == 0u) { xcd_barrier_complete(bar, b.x, nloc, nx); b.st[0] = nloc; b.st[1] = nx; }
        const unsigned old = xb_add(&bar[XB_XSUB(b.x)], 1u);
        const unsigned gen = old / nloc;
        if (old + 1u == (gen + 1u) * nloc) {
            __builtin_amdgcn_fence(__ATOMIC_RELEASE, "agent");
            asm volatile("s_waitcnt vmcnt(0)" ::: "memory");
            const unsigned og = xb_add(&bar[XB_TOP], 1u);
            const unsigned tg = og / nx;
            if (og + 1u == (tg + 1u) * nx) xb_add(&bar[XB_TOPGEN], 1u);
            else XB_SPIN(xb_ld(&bar[XB_TOPGEN]) == tg, bar);
            __builtin_amdgcn_fence(__ATOMIC_ACQUIRE, "agent");
            xb_add(&bar[XB_XGEN(b.x)], 1u);
            asm volatile("s_waitcnt vmcnt(0)" ::: "memory");
        } else {
            XB_SPIN(xb_ld(&bar[XB_XGEN(b.x)]) == gen, bar);
            __builtin_amdgcn_fence(__ATOMIC_ACQUIRE, "agent");
            asm volatile("s_waitcnt vmcnt(0)" ::: "memory");
        }
    }
    __syncthreads();
}

constexpr int NB = 16, TT = 2048, DM = 1024, MR = NB * TT, NMETA = 16, MROWS = MR + 256, NPAN = MROWS / 256;
constexpr int PSEQ = 2112, NCH = 33;
constexpr int DIN = 2864, N1 = 3328;
constexpr int DFF = 2816, DFE = 3584, NEXP = 8;
constexpr float EPS = 1e-6f;
constexpr int C_AQ = 0, C_AK = 128, C_AV = 256, C_ALR = 512, C_AOG = 528, C_RQ = 784, C_RK = 1040, C_RV = 1296, C_ROG = 1552, C_CQ = 1808, C_CKV = 2000, C_KPE = 2064, C_DQ = 2096, C_DK = 2352, C_DV = 2608, C_QEFF = 2864;
constexpr int MAXPAN = 264;
constexpr float LOG2E = 1.4426950408889634f;

constexpr size_t MiB = 1u << 20;
constexpr size_t WS_CTL = 0, CTL_BYTES = 1 * MiB;
constexpr size_t WS_TABR = 1 * MiB, WS_TABM = 1 * MiB + 576 * 1024;
constexpr size_t WS_RT = 2 * MiB;
constexpr size_t WS_STA = 3 * MiB, WS_STB = 6 * MiB;
constexpr size_t WS_MOE = 9 * MiB;
constexpr size_t MO_ROWIDX = WS_MOE, MO_PDST = WS_MOE + 512 * 1024, MO_PINFO = WS_MOE + 1 * MiB, MO_TOKE = WS_MOE + 2 * MiB, MO_TOKP = MO_TOKE + 256 * 1024, MO_TOKW = MO_TOKE + 512 * 1024, MO_PEXP = WS_MOE + 3 * MiB;
constexpr size_t WS_GD = 13 * MiB;
constexpr size_t WS_W1T = 16 * MiB, W1T_BYTES = (size_t)N1 * DM * 2;
constexpr size_t WS_WOT = 29 * MiB, WOT_BYTES = (size_t)DM * DM * 2;
constexpr size_t WS_WGU = 33 * MiB;
constexpr size_t WS_WD = 44 * MiB;
constexpr size_t WS_HB = 50 * MiB;
constexpr size_t WS_BIG = 115 * MiB;
constexpr size_t B_PROJ = WS_BIG;
constexpr size_t B_GQ = WS_BIG + 210 * MiB, B_GK = B_GQ + 8704 * 1024, B_GV = WS_BIG + 227 * MiB;
constexpr size_t B_RQ = WS_BIG + 244 * MiB, B_RK = B_RQ + 16896 * 1024, B_RV = WS_BIG + 277 * MiB;
constexpr size_t B_MQ = WS_BIG + 294 * MiB, B_MK = WS_BIG + 319 * MiB;
constexpr size_t B_DQ = WS_BIG + 326 * MiB, B_DK = B_DQ + 16896 * 1024;
constexpr size_t O_DVT = 65 * MiB, O_MVT = 82 * MiB, O_GKT = 87 * MiB, O_RKT = 96 * MiB;
constexpr size_t B_ACT = WS_BIG;
constexpr size_t B_EGU = WS_BIG, EGU_BYTES = (size_t)2 * DFE * DM * 2;
constexpr size_t B_ED = WS_BIG + 112 * MiB, ED_BYTES = (size_t)DM * DFE * 2;
constexpr size_t B_EACT = WS_BIG + 168 * MiB;
constexpr size_t WS_NEED = WS_BIG + 392 * MiB;
constexpr int CW_BAR = 4096, CW_CNT = 8192;

constexpr int RING_BYTES = 131072, MISC_OFF = RING_BYTES + 320, LDS_BYTES = 147456;

__device__ __forceinline__ float row_rstd16(const float* stats, int row, int fq) {
    const f32x4 v = *(const f32x4*)(stats + (size_t)row * 16 + 4 * fq);
    float s = (v[0] + v[1]) + (v[2] + v[3]);
    s += __shfl_xor(s, 16); s += __shfl_xor(s, 32);
    return __builtin_amdgcn_rsqf(s * (1.0f / 1024.0f) + EPS);
}
__device__ __forceinline__ float silu_f(float x) { return x * __builtin_amdgcn_rcpf(1.0f + __builtin_amdgcn_exp2f(-x * LOG2E)); }
__device__ __forceinline__ v4u pack8(const f32x4 a, const f32x4 b) { v4u w; w.x = pg8::cvt_pk_bf16(a[0], a[1]); w.y = pg8::cvt_pk_bf16(a[2], a[3]); w.z = pg8::cvt_pk_bf16(b[0], b[1]); w.w = pg8::cvt_pk_bf16(b[2], b[3]); return w; }

struct EpiProj {
    bf16* O; const float* stats;
    __device__ __forceinline__ void operator()(const f32x4 (&acc)[2][2][4][2], const pg8::Unit& u, int wr, int wc, int fr, int fq) const {
        const int col0 = u.pn * 256 + wc * 32 + 8 * fq;
#pragma unroll
        for (int ai = 0; ai < 2; ++ai)
#pragma unroll
            for (int m = 0; m < 4; ++m) { const int r = u.pm * 256 + ai * 128 + wr * 64 + m * 16 + fr; const float rs = row_rstd16(stats, r, fq); bf16* rowp = O + (size_t)r * N1 + col0;
#pragma unroll
                for (int bj = 0; bj < 2; ++bj) *(v4u*)(rowp + bj * 128) = pack8(acc[ai][bj][m][0] * rs, acc[ai][bj][m][1] * rs); }
    }
};
struct EpiSwiglu {
    bf16* O; int ldo; const float* stats;
    __device__ __forceinline__ void operator()(const f32x4 (&acc)[2][2][4][2], const pg8::Unit& u, int wr, int wc, int fr, int fq) const {
        const int col0 = u.pn * 128 + wc * 32 + 8 * fq;
#pragma unroll
        for (int ai = 0; ai < 2; ++ai)
#pragma unroll
            for (int m = 0; m < 4; ++m) { const int r = u.pm * 256 + ai * 128 + wr * 64 + m * 16 + fr; const float rs = row_rstd16(stats, r, fq);
                f32x4 o[2];
#pragma unroll
                for (int n = 0; n < 2; ++n)
#pragma unroll
                    for (int i = 0; i < 4; ++i) o[n][i] = silu_f(acc[ai][0][m][n][i] * rs) * (acc[ai][1][m][n][i] * rs);
                *(v4u*)(O + (size_t)r * ldo + col0) = pack8(o[0], o[1]); }
    }
};
struct EpiResid {
    bf16* H; float* stats;
    __device__ __forceinline__ void operator()(const f32x4 (&acc)[2][2][4][2], const pg8::Unit& u, int wr, int wc, int fr, int fq) const {
        const int col0 = u.pn * 256 + wc * 32 + 8 * fq;
#pragma unroll
        for (int ai = 0; ai < 2; ++ai)
#pragma unroll
            for (int m = 0; m < 4; ++m) { const int r = u.pm * 256 + ai * 128 + wr * 64 + m * 16 + fr; bf16* rowp = H + (size_t)r * DM + col0; float ss = 0.f;
#pragma unroll
                for (int bj = 0; bj < 2; ++bj) { const v4u w = *(const v4u*)(rowp + bj * 128);
                    f32x4 a = acc[ai][bj][m][0], b = acc[ai][bj][m][1];
                    a[0] += bflo(w.x); a[1] += bfhi(w.x); a[2] += bflo(w.y); a[3] += bfhi(w.y); b[0] += bflo(w.z); b[1] += bfhi(w.z); b[2] += bflo(w.w); b[3] += bfhi(w.w);
                    ss += (a[0] * a[0] + a[1] * a[1]) + (a[2] * a[2] + a[3] * a[3]) + (b[0] * b[0] + b[1] * b[1]) + (b[2] * b[2] + b[3] * b[3]);
                    *(v4u*)(rowp + bj * 128) = pack8(a, b); }
                ss += __shfl_xor(ss, 16); ss += __shfl_xor(ss, 32);
                if (fq == 0) stats[(size_t)r * 16 + u.pn * 4 + wc] = ss; }
    }
};
struct EpiSwigluMoe {
    bf16* O; const f32x2* pinfo;
    __device__ __forceinline__ void operator()(const f32x4 (&acc)[2][2][4][2], const pg8::Unit& u, int wr, int wc, int fr, int fq) const {
        const int col0 = u.pn * 128 + wc * 32 + 8 * fq;
#pragma unroll
        for (int ai = 0; ai < 2; ++ai)
#pragma unroll
            for (int m = 0; m < 4; ++m) { const int rl = ai * 128 + wr * 64 + m * 16 + fr; const float rs = pinfo[u.gp * 256 + rl][0];
                f32x4 o[2];
#pragma unroll
                for (int n = 0; n < 2; ++n)
#pragma unroll
                    for (int i = 0; i < 4; ++i) o[n][i] = silu_f(acc[ai][0][m][n][i] * rs) * (acc[ai][1][m][n][i] * rs);
                *(v4u*)(O + (size_t)(u.pm * 256 + rl) * DFE + col0) = pack8(o[0], o[1]); }
    }
};
struct EpiMoeDown {
    unsigned char* Y; const int* pdst; const f32x2* pinfo;
    __device__ __forceinline__ void operator()(const f32x4 (&acc)[2][2][4][2], const pg8::Unit& u, int wr, int wc, int fr, int fq) const {
        const int col0 = u.pn * 256 + wc * 32 + 8 * fq;
#pragma unroll
        for (int ai = 0; ai < 2; ++ai)
#pragma unroll
            for (int m = 0; m < 4; ++m) { const int rl = ai * 128 + wr * 64 + m * 16 + fr; const int dst = pdst[u.gp * 256 + rl]; const float w = pinfo[u.gp * 256 + rl][1];
                if (dst >= 0) { bf16* rowp = (bf16*)(Y + (size_t)(dst >> 1) * 4096 + (size_t)(dst & 1) * 2048) + col0;
#pragma unroll
                    for (int bj = 0; bj < 2; ++bj) *(v4u*)(rowp + bj * 128) = pack8(acc[ai][bj][m][0] * w, acc[ai][bj][m][1] * w); } }
    }
};

__device__ __forceinline__ float wave_sum(float v) {
#pragma unroll
    for (int o = 1; o < 64; o <<= 1) v += __shfl_xor(v, o);
    return v;
}
__device__ __forceinline__ void transpose_item(const float* W, int K, int N, const float* gain, bf16* WT, int kb, int nb, int dmode, LAS float* scr, int lane) {
    const int k0 = 64 * kb, n0 = 32 * nb;
#pragma unroll 8
    for (int i = 0; i < 32; ++i) { const int kk = 2 * i + (lane >> 5), n = n0 + (lane & 31);
        float v = (n < N) ? W[(size_t)(k0 + kk) * N + n] : 0.f; if (gain) v *= gain[k0 + kk];
        scr[kk * 33 + (lane & 31)] = v; }
    LDS_WAIT(); asm volatile("" ::: "memory");
    const int c = lane & 7;
    const int d0 = dmode == 0 ? n0 : 256 * (n0 >> 7) + (n0 & 127) + (dmode == 2 ? 128 : 0);
#pragma unroll
    for (int j = 0; j < 4; ++j) { const int nl = (lane >> 3) + 8 * j; const LAS float* s = scr + (8 * c) * 33 + nl;
        v4u o; o.x = pk2(s[0 * 33], s[1 * 33]); o.y = pk2(s[2 * 33], s[3 * 33]); o.z = pk2(s[4 * 33], s[5 * 33]); o.w = pk2(s[6 * 33], s[7 * 33]);
        if (n0 + nl < N) *(v4u*)(WT + (size_t)(d0 + nl) * K + k0 + 8 * c) = o; }
    LDS_WAIT(); asm volatile("" ::: "memory");
}

struct Args { const float* in[24]; float* out; unsigned char* ws; int ph_lo, ph_hi; };
enum { I_X = 0, I_META, I_ANORM, I_WIN, I_GWG, I_GBG, I_GNORM, I_RNORM, I_MQN, I_WUQ, I_MKVN, I_WUKV, I_DLAM, I_DNORM, I_WOUT, I_FNORM, I_FG, I_FU, I_FD, I_ROUTER, I_EG, I_EU, I_ED, I_FINAL };

__device__ __forceinline__ void qeff_unit(const Args& a, int li, int hh, int kb, LAS float* L, int tid) {
    const float* Wuq = a.in[I_WUQ] + (size_t)li * 192 * 384; const float* Wukv = a.in[I_WUKV] + (size_t)li * 64 * 512;
    const float* gq = a.in[I_MQN] + li * 192; const float* gkv = a.in[I_MKVN] + li * 64;
    const float* Win = a.in[I_WIN] + (size_t)li * DM * DIN; const float* gan = a.in[I_ANORM] + li * DM;
    bf16* W1t = (bf16*)(a.ws + WS_W1T + li * W1T_BYTES);
    for (int idx = tid; idx < 192 * 96; idx += 512) { const int i = idx / 96, n = idx % 96; float v;
        if (n < 64) { float s = 0.f; for (int m = 0; m < 64; ++m) s += Wuq[i * 384 + hh * 96 + m] * Wukv[n * 512 + hh * 128 + m]; v = gq[i] * gkv[n] * s; }
        else v = gq[i] * Wuq[i * 384 + hh * 96 + n];
        L[idx] = v; }
    __syncthreads();
    const int k0 = kb * 64;
    for (int idx = tid; idx < 64 * 96; idx += 512) { const int kk = idx & 63, n = idx >> 6; const float* wr = Win + (size_t)(k0 + kk) * DIN + C_CQ; float s = 0.f;
        for (int i = 0; i < 192; ++i) s += wr[i] * L[i * 96 + n];
        W1t[(size_t)(C_QEFF + hh * 96 + n) * DM + k0 + kk] = (bf16)f2bf(gan[k0 + kk] * s); }
    __syncthreads();
}
__device__ __forceinline__ void wofold_unit(const Args& a, int li, int hh, int nb, int tid) {
    const float* Wukv = a.in[I_WUKV] + (size_t)li * 64 * 512; const float* gkv = a.in[I_MKVN] + li * 64; const float* Wo = a.in[I_WOUT] + (size_t)li * DM * DM;
    bf16* Wot = (bf16*)(a.ws + WS_WOT + li * WOT_BYTES);
    for (int idx = tid; idx < 64 * 64; idx += 512) { const int j = idx & 63, n = nb * 64 + (idx >> 6); float s = 0.f;
        for (int e = 0; e < 64; ++e) s += Wukv[j * 512 + hh * 128 + 64 + e] * Wo[(size_t)(512 + 64 * hh + e) * DM + n];
        Wot[(size_t)n * DM + 512 + 64 * hh + j] = (bf16)f2bf(gkv[j] * s); }
}
__device__ __forceinline__ void p0_prologue(const Args& a, LAS unsigned char* lds, int tid, int lane, int wave) {
    const int G = gridDim.x;
    for (int un = blockIdx.x; un < 256; un += G) {
        if (un < 128) qeff_unit(a, un >> 6, (un >> 4) & 3, un & 15, (LAS float*)lds, tid);
        else { const int v = un - 128; wofold_unit(a, v >> 6, (v >> 4) & 3, v & 15, tid); }
    }
    __syncthreads();
    LAS float* scr = (LAS float*)(lds + wave * 16384);
    const int gw = blockIdx.x * 8 + wave, NGW = G * 8;
    constexpr int I_IN = 16 * 90, I_WO = 12 * 32, I_G = 16 * 88, I_D = 44 * 32;
    constexpr int NIT = 2 * I_IN + 2 * I_WO + 2 * I_G + I_D;
    for (int it = gw; it < NIT; it += NGW) {
        int r = it;
        if (r < 2 * I_IN) { const int li = r / I_IN; r %= I_IN; transpose_item(a.in[I_WIN] + (size_t)li * DM * DIN, DM, DIN, a.in[I_ANORM] + li * DM, (bf16*)(a.ws + WS_W1T + li * W1T_BYTES), r / 90, r % 90, 0, scr, lane); continue; } r -= 2 * I_IN;
        if (r < 2 * I_WO) { const int li = r / I_WO; r %= I_WO; int kb = r / 32; if (kb >= 8) kb += 4; transpose_item(a.in[I_WOUT] + (size_t)li * DM * DM, DM, DM, nullptr, (bf16*)(a.ws + WS_WOT + li * WOT_BYTES), kb, r % 32, 0, scr, lane); continue; } r -= 2 * I_WO;
        if (r < I_G) { transpose_item(a.in[I_FG], DM, DFF, a.in[I_FNORM], (bf16*)(a.ws + WS_WGU), r / 88, r % 88, 1, scr, lane); continue; } r -= I_G;
        if (r < I_G) { transpose_item(a.in[I_FU], DM, DFF, a.in[I_FNORM], (bf16*)(a.ws + WS_WGU), r / 88, r % 88, 2, scr, lane); continue; } r -= I_G;
        transpose_item(a.in[I_FD], DFF, DM, nullptr, (bf16*)(a.ws + WS_WD), r / 32, r % 32, 0, scr, lane);
    }
    const int gt = blockIdx.x * 512 + tid, NGT = G * 512;
    for (int i = gt; i < 2 * 80 * 128; i += NGT) { const int li = i / (80 * 128), r = i % (80 * 128);
        *(v4u*)(a.ws + WS_W1T + li * W1T_BYTES + (size_t)(C_QEFF + 384) * DM * 2 + (size_t)r * 16) = (v4u){0u, 0u, 0u, 0u}; }
    for (int i = gt; i < 8 * DM; i += NGT) { const int e = i >> 10, k = i & 1023; ((float*)(a.ws + WS_RT))[i] = a.in[I_FNORM][DM + k] * a.in[I_ROUTER][k * 8 + e]; }
    for (int i = gt; i < PSEQ * 48; i += NGT) { const int p = i / 48, j = i % 48; const bool isR = j < 32; const int f = isR ? j : j - 32;
        const float inv = __builtin_amdgcn_exp2f(-(float)f * (isR ? 13.287712379549449f / 32.f : 13.287712379549449f / 16.f));
        const double rev = (double)(p - 48) * (double)inv * 0.15915494309189535; const float fr = (float)(rev - __builtin_rint(rev));
        const f32x2 cs = {__builtin_amdgcn_cosf(fr), __builtin_amdgcn_sinf(fr)};
        if (isR) ((f32x2*)(a.ws + WS_TABR))[p * 32 + f] = cs; else ((f32x2*)(a.ws + WS_TABM))[p * 16 + f] = cs; }
    for (int i = gt; i < 240 * 128; i += NGT) *(v4u*)((unsigned char*)a.out + (size_t)(MR + 16) * 2048 + (size_t)i * 16) = (v4u){0u, 0u, 0u, 0u};
    bf16* hb = (bf16*)(a.ws + WS_HB); float* stA = (float*)(a.ws + WS_STA);
    for (int r = gw; r < MROWS; r += NGW) {
        f32x4 v[4]; float s = 0.f;
#pragma unroll
        for (int j = 0; j < 4; ++j) { if (r < MR) v[j] = ((const f32x4*)(a.in[I_X] + (size_t)r * DM))[lane + 64 * j]; else if (r < MR + NMETA) v[j] = ((const f32x4*)(a.in[I_META] + (size_t)(r - MR) * DM))[lane + 64 * j]; else v[j] = (f32x4){0.f, 0.f, 0.f, 0.f};
            s += (v[j][0] * v[j][0] + v[j][1] * v[j][1]) + (v[j][2] * v[j][2] + v[j][3] * v[j][3]); }
        s = wave_sum(s);
#pragma unroll
        for (int j = 0; j < 4; ++j) { v2u w; w.x = pk2(v[j][0], v[j][1]); w.y = pk2(v[j][2], v[j][3]); ((v2u*)(hb + (size_t)r * DM))[lane + 64 * j] = w; }
        if (lane < 16) stA[(size_t)r * 16 + lane] = lane == 0 ? s : 0.f;
    }
}

__device__ __forceinline__ int src_row(int b, int c, int i) { return c == 0 ? (i < 48 ? -1 : MR + i - 48) : b * TT + 64 * (c - 1) + i; }
__device__ __forceinline__ float lg2gamma(int h) { return h == 0 ? -0.045803689613124789f : h == 1 ? -0.022720076500083529f : h == 2 ? -0.011315313227834146f : -0.0056465631411420627f; }
__device__ __forceinline__ void prep_unit(const Args& a, int li, int b, int c, LAS unsigned char* lds, int tid, int lane, int wave) {
    const bf16* proj = (const bf16*)(a.ws + B_PROJ);
    LAS float* lr = (LAS float*)lds;
    LAS float* rsd = (LAS float*)(lds + 4096);
    const int blk0 = (b * NCH + c) * 4;
    const size_t prow0 = (size_t)b * PSEQ + 64 * c;
    for (int idx = tid; idx < 64 * 16; idx += 512) { const int i = idx >> 4, r = idx & 15, sr = src_row(b, c, i); lr[idx] = sr < 0 ? 0.f : bf2f(proj[(size_t)sr * N1 + C_ALR + r]); }
    for (int rr = 0; rr < 8; ++rr) { const int i = wave * 8 + rr, sr = src_row(b, c, i); float sq = 0.f, sk = 0.f;
        if (sr >= 0) { const bf16* pr = proj + (size_t)sr * N1;
#pragma unroll
            for (int j = 0; j < 3; ++j) { const float v = bf2f(pr[C_CQ + lane + 64 * j]); sq += v * v; }
            const float v = bf2f(pr[C_CKV + lane]); sk = v * v; }
        sq = wave_sum(sq); sk = wave_sum(sk);
        if (lane == 0) { rsd[i * 2] = __builtin_amdgcn_rsqf(sq * (1.f / 192.f) + EPS); rsd[i * 2 + 1] = __builtin_amdgcn_rsqf(sk * (1.f / 64.f) + EPS); } }
    __syncthreads();
    if (tid < 128) { const int ch = tid, h = ch >> 5, d = ch & 31;
        const float* Wg = a.in[I_GWG] + (size_t)li * 16 * 128; const float bg = a.in[I_GBG][li * 128 + ch];
        float wg[16];
#pragma unroll
        for (int r = 0; r < 16; ++r) wg[r] = Wg[r * 128 + ch];
        bf16* gq = (bf16*)(a.ws + B_GQ) + (size_t)(blk0 + h) * 64 * 32 + d; bf16* gk = (bf16*)(a.ws + B_GK) + (size_t)(blk0 + h) * 64 * 32 + d;
        bf16* gkt = (bf16*)((unsigned char*)a.out + O_GKT) + ((size_t)(blk0 + h) * 32 + d) * 64;
        float cum = 0.f; unsigned kprev = 0u;
        for (int i = 0; i < 64; ++i) { const int sr = src_row(b, c, i); float qv = 0.f, kv = 0.f;
            if (sr >= 0) { float x = bg;
#pragma unroll
                for (int r = 0; r < 16; ++r) x += lr[i * 16 + r] * wg[r];
                const float ls = fminf(x, 0.f) - __logf(1.f + __expf(-fabsf(x)));
                cum += ls * (1.f / 16.f);
                qv = bf2f(proj[(size_t)sr * N1 + C_AQ + ch]) * 0.17677669529663687f * __expf(cum); kv = bf2f(proj[(size_t)sr * N1 + C_AK + ch]) * __expf(-cum); }
            gq[i * 32] = (bf16)f2bf(qv); gk[i * 32] = (bf16)f2bf(kv);
            if (i & 1) ((unsigned*)gkt)[i >> 1] = kprev | (f2bf(kv) << 16); else kprev = f2bf(kv); }
        ((float*)(a.ws + WS_GD))[(size_t)(blk0 + h) * 32 + d] = __expf(cum);
    }
    for (int idx = tid; idx < 64 * 32; idx += 512) { const int i = idx >> 5, ch8 = idx & 31, sr = src_row(b, c, i);
        v4u dq = {0u, 0u, 0u, 0u}, dk = dq;
        if (sr >= 0) { const bf16* pr = proj + (size_t)sr * N1; dq = *(const v4u*)(pr + C_DQ + ch8 * 8); dk = *(const v4u*)(pr + C_DK + ch8 * 8);
            const float qs = 0.17677669529663687f * LOG2E;
            dq.x = pk2(bflo(dq.x) * qs, bfhi(dq.x) * qs); dq.y = pk2(bflo(dq.y) * qs, bfhi(dq.y) * qs); dq.z = pk2(bflo(dq.z) * qs, bfhi(dq.z) * qs); dq.w = pk2(bflo(dq.w) * qs, bfhi(dq.w) * qs); }
        *(v4u*)((bf16*)(a.ws + B_DQ) + (prow0 + i) * 256 + ch8 * 8) = dq;
        *(v4u*)((bf16*)(a.ws + B_DK) + (prow0 + i) * 256 + ch8 * 8) = dk; }
    const f32x2* tabR = (const f32x2*)(a.ws + WS_TABR); const f32x2* tabM = (const f32x2*)(a.ws + WS_TABM);
    for (int idx = tid; idx < 32 * 4 * 32; idx += 512) { const int j = idx & 31, h = (idx >> 5) & 3, ip = idx >> 7; unsigned kk1[2], kk2[2];
#pragma unroll
        for (int u = 0; u < 2; ++u) { const int i = 2 * ip + u, sr = src_row(b, c, i);
            float q1 = 0.f, q2 = 0.f, k1 = 0.f, k2 = 0.f;
            if (sr >= 0) { const bf16* pr = proj + (size_t)sr * N1; const f32x2 cs = tabR[(64 * c + i) * 32 + j];
                const float a1 = bf2f(pr[C_RQ + h * 64 + j]), a2 = bf2f(pr[C_RQ + h * 64 + 32 + j]), b1 = bf2f(pr[C_RK + h * 64 + j]), b2 = bf2f(pr[C_RK + h * 64 + 32 + j]);
                const float e = (float)(i + 1) * lg2gamma(h); const float fq = __builtin_amdgcn_exp2f(e), fk = 0.125f * __builtin_amdgcn_exp2f(-e);
                q1 = (a1 * cs[0] - a2 * cs[1]) * fq; q2 = (a1 * cs[1] + a2 * cs[0]) * fq; k1 = (b1 * cs[0] - b2 * cs[1]) * fk; k2 = (b1 * cs[1] + b2 * cs[0]) * fk; }
            bf16* rq = (bf16*)(a.ws + B_RQ) + ((size_t)(blk0 + h) * 64 + i) * 64; bf16* rk = (bf16*)(a.ws + B_RK) + ((size_t)(blk0 + h) * 64 + i) * 64;
            kk1[u] = f2bf(k1); kk2[u] = f2bf(k2);
            rq[j] = (bf16)f2bf(q1); rq[32 + j] = (bf16)f2bf(q2); rk[j] = (bf16)kk1[u]; rk[32 + j] = (bf16)kk2[u]; }
        unsigned* rkt = (unsigned*)((unsigned char*)a.out + O_RKT) + ((size_t)(blk0 + h) * 4096 + 2 * ip) / 2;
        rkt[j * 32] = kk1[0] | (kk1[1] << 16); rkt[(32 + j) * 32] = kk2[0] | (kk2[1] << 16); }
    const float QS = 0.10206207261596577f * LOG2E;
    for (int idx = tid; idx < 64 * 4 * 80; idx += 512) { const int n = idx % 80, hh = (idx / 80) & 3, i = idx / 320, sr = src_row(b, c, i);
        bf16* mq = (bf16*)(a.ws + B_MQ) + (prow0 + i) * 384 + hh * 96;
        if (n < 64) { mq[n] = sr < 0 ? (bf16)0 : (bf16)f2bf(bf2f(proj[(size_t)sr * N1 + C_QEFF + hh * 96 + n]) * rsd[i * 2] * QS); }
        else { const int j = n - 64; float y1 = 0.f, y2 = 0.f;
            if (sr >= 0) { const f32x2 cs = tabM[(64 * c + i) * 16 + j]; const float s = rsd[i * 2] * QS;
                const float x1 = bf2f(proj[(size_t)sr * N1 + C_QEFF + hh * 96 + 64 + j]) * s, x2 = bf2f(proj[(size_t)sr * N1 + C_QEFF + hh * 96 + 80 + j]) * s;
                y1 = x1 * cs[0] - x2 * cs[1]; y2 = x1 * cs[1] + x2 * cs[0]; }
            mq[64 + j] = (bf16)f2bf(y1); mq[80 + j] = (bf16)f2bf(y2); } }
    for (int idx = tid; idx < 64 * 80; idx += 512) { const int n = idx % 80, i = idx / 80, sr = src_row(b, c, i);
        bf16* mk = (bf16*)(a.ws + B_MK) + (prow0 + i) * 96;
        if (n < 64) { mk[n] = sr < 0 ? (bf16)0 : (bf16)f2bf(bf2f(proj[(size_t)sr * N1 + C_CKV + n]) * rsd[i * 2 + 1]); }
        else { const int j = n - 64; float y1 = 0.f, y2 = 0.f;
            if (sr >= 0) { const f32x2 cs = tabM[(64 * c + i) * 16 + j]; const float x1 = bf2f(proj[(size_t)sr * N1 + C_KPE + j]), x2 = bf2f(proj[(size_t)sr * N1 + C_KPE + 16 + j]);
                y1 = x1 * cs[0] - x2 * cs[1]; y2 = x1 * cs[1] + x2 * cs[0]; }
            mk[64 + j] = (bf16)f2bf(y1); mk[80 + j] = (bf16)f2bf(y2); } }
    { LAS bf16* TT = (LAS bf16*)(lds + 8192);
      for (int idx = tid; idx < 64 * 832; idx += 512) { const int i = idx / 832, col = idx % 832, sr = src_row(b, c, i); float v = 0.f;
          if (sr >= 0) { const bf16* pr = proj + (size_t)sr * N1; v = col < 64 ? bf2f(pr[C_CKV + col]) * rsd[i * 2 + 1] : col < 320 ? bf2f(pr[C_DV + col - 64]) : col < 576 ? bf2f(pr[C_AV + col - 320]) : bf2f(pr[C_RV + col - 576]); }
          TT[i * 834 + col] = (bf16)f2bf(v); }
      __syncthreads();
      for (int idx = tid; idx < 832 * 8; idx += 512) { const int col = idx >> 3, k8 = idx & 7; unsigned x[8];
#pragma unroll
          for (int t = 0; t < 8; ++t) x[t] = TT[(8 * k8 + t) * 834 + col];
          v4u w; w.x = x[0] | (x[1] << 16); w.y = x[2] | (x[3] << 16); w.z = x[4] | (x[5] << 16); w.w = x[6] | (x[7] << 16);
          bf16* dst;
          if (col < 64) dst = (bf16*)((unsigned char*)a.out + O_MVT) + ((size_t)(b * NCH + c) * 64 + col) * 64;
          else { const int cc = (col - 64) & 255, grp = (col - 64) >> 8; unsigned char* base = grp == 0 ? (unsigned char*)a.out + O_DVT : grp == 1 ? a.ws + B_GV : a.ws + B_RV;
              dst = (bf16*)base + ((size_t)(blk0 + (cc >> 6)) * 64 + (cc & 63)) * 64; }
          *(v4u*)(dst + 8 * k8) = w; } }
    __syncthreads();
}

__device__ __forceinline__ void route_block(const Args& a, int blk, LAS unsigned char* lds, int tid, int lane, int wave) {
    LAS float* Rs = (LAS float*)lds; LAS int* lcnt = (LAS int*)(lds + 32768); LAS int* gbase = lcnt + 8; LAS int* rec = lcnt + 16;
    gu32* ctl = (gu32*)(a.ws + WS_CTL);
    const float* Rt = (const float*)(a.ws + WS_RT); const bf16* hb = (const bf16*)(a.ws + WS_HB); const float* stB = (const float*)(a.ws + WS_STB);
    __syncthreads();
    for (int idx = tid; idx < 8 * DM; idx += 512) Rs[idx] = Rt[idx];
    if (tid < 8) lcnt[tid] = 0;
    __syncthreads();
    for (int rr = 0; rr < 16; ++rr) { const int rl = wave * 16 + rr, row = blk * 128 + rl;
        const v4u w0 = *(const v4u*)(hb + (size_t)row * DM + 8 * lane), w1 = *(const v4u*)(hb + (size_t)row * DM + 512 + 8 * lane);
        const float x[16] = {bflo(w0.x), bfhi(w0.x), bflo(w0.y), bfhi(w0.y), bflo(w0.z), bfhi(w0.z), bflo(w0.w), bfhi(w0.w), bflo(w1.x), bfhi(w1.x), bflo(w1.y), bfhi(w1.y), bflo(w1.z), bfhi(w1.z), bflo(w1.w), bfhi(w1.w)};
        float st = lane < 16 ? stB[(size_t)row * 16 + lane] : 0.f; st = wave_sum(st); const float rs = __builtin_amdgcn_rsqf(st * (1.f / 1024.f) + EPS);
        float lg[8];
#pragma unroll
        for (int e = 0; e < 8; ++e) { float s = 0.f;
#pragma unroll
            for (int t = 0; t < 8; ++t) s += x[t] * Rs[e * DM + 8 * lane + t] + x[8 + t] * Rs[e * DM + 512 + 8 * lane + t];
            lg[e] = wave_sum(s) * rs; }
        int e0 = 0; float v0 = lg[0];
#pragma unroll
        for (int e = 1; e < 8; ++e) if (lg[e] > v0) { v0 = lg[e]; e0 = e; }
        int e1 = -1; float v1 = -3.0e38f;
#pragma unroll
        for (int e = 0; e < 8; ++e) if (e != e0 && lg[e] > v1) { v1 = lg[e]; e1 = e; }
        const float g0 = 1.f / (1.f + __expf(v1 - v0)), g1 = 1.f - g0;
        if (lane == 0) { const int lp0 = atomicAdd((int*)(lcnt + e0), 1), lp1 = atomicAdd((int*)(lcnt + e1), 1);
            rec[rl * 6] = e0; rec[rl * 6 + 1] = e1; rec[rl * 6 + 2] = lp0; rec[rl * 6 + 3] = lp1; rec[rl * 6 + 4] = __float_as_int(g0); rec[rl * 6 + 5] = __float_as_int(g1); } }
    __syncthreads();
    if (tid < 8) gbase[tid] = (int)__hip_atomic_fetch_add(ctl + CW_CNT + 64 * tid, (unsigned)lcnt[tid], RLX_AGENT);
    __syncthreads();
    if (tid < 256) { const int rl = tid >> 1, s = tid & 1, tok = blk * 128 + rl, e = rec[rl * 6 + s];
        ((int*)(a.ws + MO_TOKE))[tok * 2 + s] = e; ((int*)(a.ws + MO_TOKP))[tok * 2 + s] = gbase[e] + rec[rl * 6 + 2 + s]; ((int*)(a.ws + MO_TOKW))[tok * 2 + s] = rec[rl * 6 + 4 + s]; }
    __syncthreads();
}
__device__ __forceinline__ void moe_offsets(const Args& a, LAS int* offs, int tid) {
    gu32* ctl = (gu32*)(a.ws + WS_CTL);
    __syncthreads();
    if (tid == 0) { int o = 0;
        for (int e = 0; e < 8; ++e) { const int cnt = (int)__hip_atomic_load(ctl + CW_CNT + 64 * e, RLX_AGENT); offs[e] = o * 256; o += (cnt + 255) >> 8; }
        offs[8] = o; }
    __syncthreads();
}

typedef float f32x16 __attribute__((ext_vector_type(16)));
typedef short s16x8 __attribute__((ext_vector_type(8)));
typedef short s16x4 __attribute__((ext_vector_type(4)));
__device__ __forceinline__ int crow(int r, int hi) { return (r & 3) + 8 * (r >> 2) + 4 * hi; }

template <int KIND>
__device__ __forceinline__ void attn_mfma_unit(const Args& a, int li, int b, int hh, int qb  , LAS unsigned char* lds, int tid, float lam, float oscale) {
    constexpr int KW = KIND ? 64 : 96, KST = KW + 8, VST = 72, NMAP = KIND ? 2 : 1, DSTEPS = KIND ? 2 : 6, CPR = KW / 8;
    constexpr int KBUF = 64 * KST * 2, VBUF = 64 * VST * 2, OFF_V = 2 * KBUF, OFF_WS = OFF_V + 2 * VBUF, OFF_OST = OFF_WS + 8 * 256, OSTW = 68;
    const int lane = tid & 63, w = __builtin_amdgcn_readfirstlane(tid >> 6), r32 = lane & 31, hi = lane >> 5;
    const int q0 = qb < 0 ? 0 : 64 + 256 * qb, NT = qb < 0 ? 1 : 5 + 4 * qb;
    const bool wact = qb >= 0 || w < 2;
    const int qpos = q0 + 32 * w + r32, wlast = (q0 + 32 * w + 31) >> 6;
    const size_t prow = (size_t)b * PSEQ + qpos;
    const bf16* Kg = KIND ? (const bf16*)(a.ws + B_DK) + (size_t)b * PSEQ * 256 + hh * 64 : (const bf16*)(a.ws + B_MK) + (size_t)b * PSEQ * 96;
    constexpr int KLD = KIND ? 256 : 96;
    const bf16* VTg = KIND ? (const bf16*)((const unsigned char*)a.out + O_DVT) + ((size_t)b * NCH * 4 + hh) * 4096 : (const bf16*)((const unsigned char*)a.out + O_MVT) + (size_t)b * NCH * 4096;
    constexpr int VTT = KIND ? 4 * 4096 : 4096;
    LAS float* wsf = (LAS float*)(lds + OFF_WS) + w * 64;
    LAS float* ost = (LAS float*)(lds + OFF_OST) + w * (32 * OSTW);
    s16x8 qf[NMAP][DSTEPS];
#pragma unroll
    for (int m = 0; m < NMAP; ++m)
#pragma unroll
        for (int ds = 0; ds < DSTEPS; ++ds) {
            const bf16* qp = KIND ? (const bf16*)(a.ws + B_DQ) + prow * 256 + hh * 64 + 32 * m + 16 * ds + 8 * hi : (const bf16*)(a.ws + B_MQ) + prow * 384 + hh * 96 + 16 * ds + 8 * hi;
            qf[m][ds] = wact ? *(const s16x8*)qp : (s16x8){0, 0, 0, 0, 0, 0, 0, 0}; }
    float mrun[NMAP], lrun[NMAP]; f32x16 o[NMAP][2];
#pragma unroll
    for (int m = 0; m < NMAP; ++m) { mrun[m] = -1e30f; lrun[m] = 0.f; o[m][0] = (f32x16){}; o[m][1] = (f32x16){}; }
    const int kc0 = tid, kc1 = tid + 512; const bool has1 = (CPR == 12) && kc1 < 64 * CPR;
    const int kr0 = kc0 / CPR, kh0 = kc0 % CPR, kr1 = kc1 / CPR, kh1 = kc1 % CPR, ve = tid >> 3, vh = tid & 7;
    v4u rk0, rk1 = {0u, 0u, 0u, 0u}, rv;
#define ATT_LOAD(t) do { rk0 = *(const v4u*)(Kg + (size_t)(64 * (t) + kr0) * KLD + kh0 * 8); if (has1) rk1 = *(const v4u*)(Kg + (size_t)(64 * (t) + kr1) * KLD + kh1 * 8); \
        rv = *(const v4u*)(VTg + (size_t)(t) * VTT + ve * 64 + vh * 8); } while (0)
#define ATT_STORE(bufi) do { *(LAS v4u*)(lds + (bufi) * KBUF + (kr0 * KST + kh0 * 8) * 2) = rk0; if (has1) *(LAS v4u*)(lds + (bufi) * KBUF + (kr1 * KST + kh1 * 8) * 2) = rk1; \
        *(LAS v4u*)(lds + OFF_V + (bufi) * VBUF + (ve * VST + vh * 8) * 2) = rv; } while (0)
    __syncthreads();
    ATT_LOAD(0); ATT_STORE(0);
    __syncthreads();
    for (int t = 0; t < NT; ++t) {
        const int bi = t & 1;
        if (t + 1 < NT) ATT_LOAD(t + 1);
        if (wact && t <= wlast) {
            const LAS unsigned char* Kb = lds + bi * KBUF; const LAS unsigned char* Vb = lds + OFF_V + bi * VBUF;
            const bool need_mask = (t == 0) || (64 * t + 63 > q0 + 32 * w);
#pragma unroll
            for (int m = 0; m < NMAP; ++m) {
                f32x16 p0 = (f32x16){}, p1 = (f32x16){};
#pragma unroll
                for (int ds = 0; ds < DSTEPS; ++ds) {
                    const s16x8 k0 = *(const LAS s16x8*)(Kb + (r32 * KST + 32 * m * KIND + 16 * ds + 8 * hi) * 2);
                    const s16x8 k1 = *(const LAS s16x8*)(Kb + ((32 + r32) * KST + 32 * m * KIND + 16 * ds + 8 * hi) * 2);
                    p0 = __builtin_amdgcn_mfma_f32_32x32x16_bf16(k0, qf[m][ds], p0, 0, 0, 0);
                    p1 = __builtin_amdgcn_mfma_f32_32x32x16_bf16(k1, qf[m][ds], p1, 0, 0, 0); }
                asm volatile("s_nop 15\n\ts_nop 7" : "+v"(p0), "+v"(p1));
                if (need_mask) {
#pragma unroll
                    for (int r = 0; r < 16; ++r) { const int kv = 64 * t + crow(r, hi);
                        if (kv > qpos || kv < 48) p0[r] = -1e30f;
                        if (kv + 32 > qpos || kv + 32 < 48) p1[r] = -1e30f; } }
                float mx = fmaxf(p0[0], p1[0]);
#pragma unroll
                for (int r = 1; r < 16; ++r) mx = fmaxf(mx, fmaxf(p0[r], p1[r]));
                mx = fmaxf(mx, __shfl_xor(mx, 32));
                const float mn = fmaxf(mrun[m], mx), alpha = __builtin_amdgcn_exp2f(mrun[m] - mn); mrun[m] = mn;
                float ls = 0.f;
#pragma unroll
                for (int r = 0; r < 16; ++r) { p0[r] = __builtin_amdgcn_exp2f(p0[r] - mn); p1[r] = __builtin_amdgcn_exp2f(p1[r] - mn); ls += p0[r] + p1[r]; }
                lrun[m] = lrun[m] * alpha + ls;
                if (hi == 0) wsf[r32] = alpha;
                f32x4 al[4];
#pragma unroll
                for (int g = 0; g < 4; ++g) al[g] = *(const LAS f32x4*)(wsf + 8 * g + 4 * hi);
#pragma unroll
                for (int r = 0; r < 16; ++r) { o[m][0][r] *= al[r >> 2][r & 3]; o[m][1][r] *= al[r >> 2][r & 3]; }
                s16x8 pw[4];
#pragma unroll
                for (int ks = 0; ks < 4; ++ks) { v4u u;
                    if (ks < 2) { u.x = pg8::cvt_pk_bf16(p0[8 * ks], p0[8 * ks + 1]); u.y = pg8::cvt_pk_bf16(p0[8 * ks + 2], p0[8 * ks + 3]); u.z = pg8::cvt_pk_bf16(p0[8 * ks + 4], p0[8 * ks + 5]); u.w = pg8::cvt_pk_bf16(p0[8 * ks + 6], p0[8 * ks + 7]); }
                    else { const int k2 = ks - 2; u.x = pg8::cvt_pk_bf16(p1[8 * k2], p1[8 * k2 + 1]); u.y = pg8::cvt_pk_bf16(p1[8 * k2 + 2], p1[8 * k2 + 3]); u.z = pg8::cvt_pk_bf16(p1[8 * k2 + 4], p1[8 * k2 + 5]); u.w = pg8::cvt_pk_bf16(p1[8 * k2 + 6], p1[8 * k2 + 7]); }
                    pw[ks] = __builtin_bit_cast(s16x8, u); }
#pragma unroll
                for (int d0 = 0; d0 < 2; ++d0)
#pragma unroll
                    for (int ks = 0; ks < 4; ++ks) { const LAS unsigned char* vp = Vb + ((32 * d0 + r32) * VST + 16 * ks + 4 * hi) * 2;
                        const s16x4 va = *(const LAS s16x4*)vp, vb = *(const LAS s16x4*)(vp + 16);
                        const s16x8 vf = {va[0], va[1], va[2], va[3], vb[0], vb[1], vb[2], vb[3]};
                        o[m][d0] = __builtin_amdgcn_mfma_f32_32x32x16_bf16(pw[ks], vf, o[m][d0], 0, 0, 0); }
            }
        }
        if (t + 1 < NT) ATT_STORE(bi ^ 1);
        __syncthreads();
    }
#undef ATT_LOAD
#undef ATT_STORE
    if (wact) {
#pragma unroll
        for (int m = 0; m < NMAP; ++m) asm volatile("s_nop 15\n\ts_nop 7" : "+v"(o[m][0]), "+v"(o[m][1]));
        float il0, il1 = 0.f;
        { float l = lrun[0]; l += __shfl_xor(l, 32); il0 = l > 0.f ? 1.f / l : 0.f; }
        if (KIND) { float l = lrun[NMAP - 1]; l += __shfl_xor(l, 32); il1 = l > 0.f ? lam / l : 0.f; }
        if (hi == 0) { wsf[r32] = il0; wsf[32 + r32] = il1; }
        f32x4 a0[4], a1[4];
#pragma unroll
        for (int g = 0; g < 4; ++g) { a0[g] = *(const LAS f32x4*)(wsf + 8 * g + 4 * hi); a1[g] = *(const LAS f32x4*)(wsf + 32 + 8 * g + 4 * hi); }
#pragma unroll
        for (int d0 = 0; d0 < 2; ++d0)
#pragma unroll
            for (int r = 0; r < 16; ++r) { float v = o[0][d0][r] * a0[r >> 2][r & 3]; if (KIND) v -= o[NMAP - 1][d0][r] * a1[r >> 2][r & 3];
                ost[crow(r, hi) * OSTW + 32 * d0 + r32] = v; }
        const int row = lane >> 1, half = lane & 1, p = q0 + 32 * w + row;
        f32x4 v[8]; float ss = 0.f;
#pragma unroll
        for (int i = 0; i < 8; ++i) { v[i] = *(const LAS f32x4*)(ost + row * OSTW + 32 * half + 4 * i); ss += (v[i][0] * v[i][0] + v[i][1] * v[i][1]) + (v[i][2] * v[i][2] + v[i][3] * v[i][3]); }
        ss += __shfl_xor(ss, 1);
        const float rs = KIND ? __builtin_amdgcn_rsqf(ss * (1.f / 64.f) + EPS) * oscale : 1.f;
        const int sr = qb >= 0 ? b * TT + p - 64 : ((p >= 48 && b == 0) ? MR + p - 48 : -1);
        if (sr >= 0) { bf16* dst = (bf16*)a.out + (size_t)sr * DM + (KIND ? 768 : 512) + hh * 64 + 32 * half; const float* gn = a.in[I_DNORM] + li * 64 + 32 * half;
#pragma unroll
            for (int i = 0; i < 4; ++i) { f32x4 x0 = v[2 * i] * rs, x1 = v[2 * i + 1] * rs;
                if (KIND) { const f32x4 g0 = *(const f32x4*)(gn + 8 * i), g1 = *(const f32x4*)(gn + 8 * i + 4); x0 = x0 * g0; x1 = x1 * g1; }
                *(v4u*)(dst + 8 * i) = pack8(x0, x1); } }
    }
    __syncthreads();
}

__device__ __forceinline__ s16x8 ldperm(const bf16* p, int hi) { const s16x4 x = *(const s16x4*)(p + 4 * hi), y = *(const s16x4*)(p + 8 + 4 * hi); return (s16x8){x[0], x[1], x[2], x[3], y[0], y[1], y[2], y[3]}; }
__device__ __forceinline__ s16x8 packacc(const f32x16& v, int k) { v4u u; u.x = pg8::cvt_pk_bf16(v[8 * k], v[8 * k + 1]); u.y = pg8::cvt_pk_bf16(v[8 * k + 2], v[8 * k + 3]); u.z = pg8::cvt_pk_bf16(v[8 * k + 4], v[8 * k + 5]); u.w = pg8::cvt_pk_bf16(v[8 * k + 6], v[8 * k + 7]); return __builtin_bit_cast(s16x8, u); }
template <int KIND>
__device__ __forceinline__ void lin_mfma_unit(const Args& a, int li, int b, LAS unsigned char* lds, int tid) {
    constexpr int DK = KIND ? 64 : 32, NDS = DK / 16, NDB = DK / 32, OTW = 68;
    const int lane = tid & 63, w = __builtin_amdgcn_readfirstlane(tid >> 6), r32 = lane & 31, hi = lane >> 5, h = w >> 1, e0 = 32 * (w & 1);
    const bf16* Qb = (const bf16*)(a.ws + (KIND ? B_RQ : B_GQ)); const bf16* Kb = (const bf16*)(a.ws + (KIND ? B_RK : B_GK));
    const bf16* KTb = (const bf16*)((const unsigned char*)a.out + (KIND ? O_RKT : O_GKT)); const bf16* VTb = (const bf16*)(a.ws + (KIND ? B_RV : B_GV));
    const float* gain = a.in[KIND ? I_RNORM : I_GNORM] + li * 64; const bf16* proj = (const bf16*)(a.ws + B_PROJ); bf16* ob = (bf16*)a.out;
    LAS float* Ot = (LAS float*)lds;
    const float dret = __builtin_amdgcn_exp2f(64.f * lg2gamma(h));
    f32x16 S[NDB];
#pragma unroll
    for (int db = 0; db < NDB; ++db) S[db] = (f32x16){};
    __syncthreads();
    for (int c = 0; c < NCH; ++c) {
        const size_t blk = (size_t)(b * NCH + c) * 4 + h;
        const bf16* q = Qb + blk * 64 * DK; const bf16* k = Kb + blk * 64 * DK; const bf16* kT = KTb + blk * DK * 64; const bf16* vT = VTb + blk * 4096;
        s16x8 qf[2][NDS], kf[2][NDS], vf[4];
#pragma unroll
        for (int ib = 0; ib < 2; ++ib)
#pragma unroll
            for (int ds = 0; ds < NDS; ++ds) { qf[ib][ds] = ldperm(q + (32 * ib + r32) * DK + 16 * ds, hi); kf[ib][ds] = ldperm(k + (32 * ib + r32) * DK + 16 * ds, hi); }
#pragma unroll
        for (int ks = 0; ks < 4; ++ks) vf[ks] = ldperm(vT + (e0 + r32) * 64 + 16 * ks, hi);
        f32x16 a00 = (f32x16){}, a01 = (f32x16){}, a11 = (f32x16){};
#pragma unroll
        for (int ds = 0; ds < NDS; ++ds) { a00 = __builtin_amdgcn_mfma_f32_32x32x16_bf16(kf[0][ds], qf[0][ds], a00, 0, 0, 0); a01 = __builtin_amdgcn_mfma_f32_32x32x16_bf16(kf[0][ds], qf[1][ds], a01, 0, 0, 0);
            a11 = __builtin_amdgcn_mfma_f32_32x32x16_bf16(kf[1][ds], qf[1][ds], a11, 0, 0, 0); }
        asm volatile("s_nop 15\n\ts_nop 15" : "+v"(a00), "+v"(a01), "+v"(a11));
#pragma unroll
        for (int r = 0; r < 16; ++r) if (crow(r, hi) > r32) { a00[r] = 0.f; a11[r] = 0.f; }
        f32x16 O[2]; O[0] = (f32x16){}; O[1] = (f32x16){};
#pragma unroll
        for (int db = 0; db < NDB; ++db)
#pragma unroll
            for (int ksub = 0; ksub < 2; ++ksub) { const s16x8 sb = packacc(S[db], ksub);
                O[0] = __builtin_amdgcn_mfma_f32_32x32x16_bf16(qf[0][2 * db + ksub], sb, O[0], 0, 0, 0); O[1] = __builtin_amdgcn_mfma_f32_32x32x16_bf16(qf[1][2 * db + ksub], sb, O[1], 0, 0, 0); }
#pragma unroll
        for (int ksub = 0; ksub < 2; ++ksub) { O[0] = __builtin_amdgcn_mfma_f32_32x32x16_bf16(packacc(a00, ksub), vf[ksub], O[0], 0, 0, 0);
            O[1] = __builtin_amdgcn_mfma_f32_32x32x16_bf16(packacc(a01, ksub), vf[ksub], O[1], 0, 0, 0); O[1] = __builtin_amdgcn_mfma_f32_32x32x16_bf16(packacc(a11, ksub), vf[2 + ksub], O[1], 0, 0, 0); }
#pragma unroll
        for (int db = 0; db < NDB; ++db) {
#pragma unroll
            for (int ks = 0; ks < 4; ++ks) S[db] = __builtin_amdgcn_mfma_f32_32x32x16_bf16(ldperm(kT + (32 * db + r32) * 64 + 16 * ks, hi), vf[ks], S[db], 0, 0, 0);
            if (KIND) { S[db] = S[db] * dret; }
            else { const float* dp = (const float*)(a.ws + WS_GD) + blk * 32;
#pragma unroll
                for (int g = 0; g < 4; ++g) { const f32x4 dv = *(const f32x4*)(dp + 8 * g + 4 * hi); S[db][4 * g] *= dv[0]; S[db][4 * g + 1] *= dv[1]; S[db][4 * g + 2] *= dv[2]; S[db][4 * g + 3] *= dv[3]; } } }
        asm volatile("s_nop 15\n\ts_nop 15" : "+v"(O[0]), "+v"(O[1]));
#pragma unroll
        for (int db = 0; db < NDB; ++db) asm volatile("s_nop 15\n\ts_nop 15" : "+v"(S[db]));
#pragma unroll
        for (int ib = 0; ib < 2; ++ib)
#pragma unroll
            for (int r = 0; r < 16; ++r) Ot[(h * 64 + 32 * ib + crow(r, hi)) * OTW + e0 + r32] = O[ib][r];
        __syncthreads();
        { const int row = 32 * (w & 1) + (lane >> 1), half = lane & 1, sr = src_row(b, c, row);
            f32x4 v[8]; float s1 = 0.f;
#pragma unroll
            for (int i = 0; i < 8; ++i) { v[i] = *(const LAS f32x4*)(Ot + (h * 64 + row) * OTW + 32 * half + 4 * i); s1 += (v[i][0] + v[i][1]) + (v[i][2] + v[i][3]); }
            float mean = 0.f; if (KIND) { s1 += __shfl_xor(s1, 1); mean = s1 * (1.f / 64.f); }
            float s2 = 0.f;
#pragma unroll
            for (int i = 0; i < 8; ++i) { v[i] = v[i] - mean; s2 += (v[i][0] * v[i][0] + v[i][1] * v[i][1]) + (v[i][2] * v[i][2] + v[i][3] * v[i][3]); }
            s2 += __shfl_xor(s2, 1);
            const float rs = __builtin_amdgcn_rsqf(s2 * (1.f / 64.f) + EPS);
            if (sr >= 0 && (c > 0 || b == 0)) { const bf16* ogp = proj + (size_t)sr * N1 + (KIND ? C_ROG : C_AOG) + h * 64 + 32 * half; bf16* dst = ob + (size_t)sr * DM + KIND * 256 + h * 64 + 32 * half; const float* gp = gain + 32 * half;
#pragma unroll
                for (int i = 0; i < 4; ++i) { const v4u og = *(const v4u*)(ogp + 8 * i); const f32x4 g0 = *(const f32x4*)(gp + 8 * i), g1 = *(const f32x4*)(gp + 8 * i + 4);
                    f32x4 x0 = v[2 * i] * rs * g0, x1 = v[2 * i + 1] * rs * g1;
                    x0[0] *= silu_f(bflo(og.x)); x0[1] *= silu_f(bfhi(og.x)); x0[2] *= silu_f(bflo(og.y)); x0[3] *= silu_f(bfhi(og.y)); x1[0] *= silu_f(bflo(og.z)); x1[1] *= silu_f(bfhi(og.z)); x1[2] *= silu_f(bflo(og.w)); x1[3] *= silu_f(bfhi(og.w));
                    *(v4u*)(dst + 8 * i) = pack8(x0, x1); } } }
        __syncthreads();
    }
}

#ifndef REP_PREP
#define REP_PREP 1
#endif
#ifndef REP_MIX
#define REP_MIX 1
#endif
#ifndef MK_ONE_LAUNCH
#define MK_ONE_LAUNCH 1
#endif
constexpr int NPHASE = 20;
constexpr int CW_Q = 12288;
__global__ void __launch_bounds__(512, 2) mega_fwd(Args a) {
    extern __shared__ __attribute__((aligned(16))) unsigned char lds_raw[];
    LAS unsigned char* lds = (LAS unsigned char*)lds_raw;
    volatile LAS unsigned* MISC = (volatile LAS unsigned*)(lds + MISC_OFF);
    const int tid = threadIdx.x, lane = tid & 63, wave = __builtin_amdgcn_readfirstlane(tid >> 6), G = gridDim.x;
    for (int u = tid; u < (LDS_BYTES - RING_BYTES) / 4; u += 512) ((LAS unsigned*)(lds + RING_BYTES))[u] = 0u;
    __syncthreads();
    gu32* ctl = (gu32*)(a.ws + WS_CTL);
    const int lo = a.ph_lo, hi = a.ph_hi;
    XcdBarrier bar; bar.bar = (unsigned*)(ctl + CW_BAR); bar.x = 0; bar.st = nullptr;
    if (hi - lo > 1) bar = xcd_barrier_post((unsigned*)(ctl + CW_BAR), MISC + 8);
#define IN(k) (lo <= (k) && (k) < hi)
#define OPQ() int ptid = threadIdx.x; asm volatile("" : "+v"(ptid)); const int plane = ptid & 63; (void)plane
#define SEAM(k) do { if (IN(k) && IN((k) + 1)) xcd_barrier(bar); } while (0)
    bf16* hb = (bf16*)(a.ws + WS_HB); float* stA = (float*)(a.ws + WS_STA); float* stB = (float*)(a.ws + WS_STB);

    if (IN(0)) { OPQ(); p0_prologue(a, lds, ptid, plane, wave); }
    SEAM(0);

    for (int li = 0; li < 2; ++li) {
        const int pb = 1 + 6 * li;
        if (IN(pb)) {
            pg8::Gemm g{hb, (const bf16*)(a.ws + WS_W1T + li * W1T_BYTES), DM, 0, nullptr}; pg8::StaticOrder S; S.init(NPAN, N1 / 256, G, (int)blockIdx.x);
            EpiProj E{(bf16*)(a.ws + B_PROJ), stA};
            pg8::gemm_phase<EpiProj, pg8::StaticOrder, false>(lds, g, S, E);
        }
        SEAM(pb);
        if (IN(pb + 1)) { OPQ(); for (int rep = 0; rep < REP_PREP; ++rep) for (int u = blockIdx.x; u < NB * NCH; u += G) prep_unit(a, li, u / NCH, u % NCH, lds, ptid, plane, wave); }
        SEAM(pb + 1);
        if (IN(pb + 2)) {
            OPQ(); const int tid = ptid;
            LAS int* qid = (LAS int*)(lds + RING_BYTES + 64);
            float lam, lam_init; { const float* lv = a.in[I_DLAM] + li * 128; float s01 = 0.f, s23 = 0.f;
                for (int d = 0; d < 32; ++d) { s01 += lv[d] * lv[32 + d]; s23 += lv[64 + d] * lv[96 + d]; }
                lam_init = 0.8f - 0.6f * __expf(-0.3f * (float)li); lam = __expf(s01) - __expf(s23) + lam_init; }
            for (int rep = 0; rep < REP_MIX; ++rep)
            for (;;) {
                __syncthreads();
                if (tid == 0) *qid = (int)__hip_atomic_fetch_add(ctl + CW_Q + 64 * (li + 2 * rep), 1u, RLX_AGENT);
                __syncthreads();
                const int id = *qid;
                int utid = ptid; asm volatile("" : "+v"(utid));
                if (id >= 32 + 1024 + 8) break;
                if (id < 32) { if ((id & 1) == 0) lin_mfma_unit<0>(a, li, id >> 1, lds, utid); else lin_mfma_unit<1>(a, li, id >> 1, lds, utid); }
                else { const int v = id - 32; int qb, kind, b, hh;
                    if (v < 1024) { qb = 7 - (v >> 7); const int rem = v & 127; kind = rem >> 6; b = (rem >> 2) & 15; hh = rem & 3; } else { qb = -1; kind = (v - 1024) >> 2; b = 0; hh = v & 3; }
                    if (kind == 0) attn_mfma_unit<0>(a, li, b, hh, qb, lds, utid, 0.f, 1.f); else attn_mfma_unit<1>(a, li, b, hh, qb, lds, utid, lam, 1.f - lam_init); }
            }
        }
        SEAM(pb + 2);
        if (IN(pb + 3)) {
            pg8::Gemm g{(const bf16*)a.out, (const bf16*)(a.ws + WS_WOT + li * WOT_BYTES), DM, 0, nullptr}; pg8::StaticOrder S; S.init(NPAN, 4, G, (int)blockIdx.x);
            EpiResid E{hb, stB};
            pg8::gemm_phase<EpiResid, pg8::StaticOrder, false>(lds, g, S, E);
        }
        SEAM(pb + 3);
        if (li == 0) {
            if (IN(5)) {
                pg8::Gemm g{hb, (const bf16*)(a.ws + WS_WGU), DM, 0, nullptr}; pg8::StaticOrder S; S.init(NPAN, 2 * DFF / 256, G, (int)blockIdx.x);
                EpiSwiglu E{(bf16*)(a.ws + B_ACT), DFF, stB};
                pg8::gemm_phase<EpiSwiglu, pg8::StaticOrder, false>(lds, g, S, E);
            }
            SEAM(5);
            if (IN(6)) {
                pg8::Gemm g{(const bf16*)(a.ws + B_ACT), (const bf16*)(a.ws + WS_WD), DFF, 0, nullptr}; pg8::StaticOrder S; S.init(NPAN, 4, G, (int)blockIdx.x);
                EpiResid E{hb, stA};
                pg8::gemm_phase<EpiResid, pg8::StaticOrder, false>(lds, g, S, E);
            }
            SEAM(6);
        }
    }
    if (IN(11)) { OPQ(); const int tid = ptid, lane = plane;
        LAS float* scr = (LAS float*)(lds + wave * 16384);
        const int gw = blockIdx.x * 8 + wave, NGW = G * 8;
        constexpr int IG = 16 * 112, ID = 56 * 32;
        for (int it = gw; it < 8 * (2 * IG + ID); it += NGW) { const int e = it / (2 * IG + ID); int r = it % (2 * IG + ID);
            if (r < IG) { transpose_item(a.in[I_EG] + (size_t)e * DM * DFE, DM, DFE, a.in[I_FNORM] + DM, (bf16*)(a.ws + B_EGU + e * EGU_BYTES), r / 112, r % 112, 1, scr, lane); continue; } r -= IG;
            if (r < IG) { transpose_item(a.in[I_EU] + (size_t)e * DM * DFE, DM, DFE, a.in[I_FNORM] + DM, (bf16*)(a.ws + B_EGU + e * EGU_BYTES), r / 112, r % 112, 2, scr, lane); continue; } r -= IG;
            transpose_item(a.in[I_ED] + (size_t)e * DFE * DM, DFE, DM, nullptr, (bf16*)(a.ws + B_ED + e * ED_BYTES), r / 32, r % 32, 0, scr, lane); }
        for (int i = blockIdx.x * 512 + tid; i < MAXPAN * 256; i += G * 512) { ((int*)(a.ws + MO_ROWIDX))[i] = -1; ((int*)(a.ws + MO_PDST))[i] = -1; ((f32x2*)(a.ws + MO_PINFO))[i] = (f32x2){0.f, 0.f}; }
        for (int blk = blockIdx.x; blk < MR / 128; blk += G) route_block(a, blk, lds, tid, lane, wave);
    }
    SEAM(11);
    LAS int* offs = (LAS int*)(lds + RING_BYTES + 128);
    if (IN(12)) { OPQ(); const int tid = ptid;
        moe_offsets(a, offs, tid);
        for (int idx = blockIdx.x * 512 + tid; idx < 2 * MR; idx += G * 512) { const int tok = idx >> 1, e = ((const int*)(a.ws + MO_TOKE))[idx], gpos = offs[e] + ((const int*)(a.ws + MO_TOKP))[idx];
            const f32x4* sp = (const f32x4*)(stB + (size_t)tok * 16); const f32x4 s0 = sp[0], s1 = sp[1], s2 = sp[2], s3 = sp[3];
            const float ss = ((s0[0] + s0[1]) + (s0[2] + s0[3])) + ((s1[0] + s1[1]) + (s1[2] + s1[3])) + ((s2[0] + s2[1]) + (s2[2] + s2[3])) + ((s3[0] + s3[1]) + (s3[2] + s3[3]));
            ((int*)(a.ws + MO_ROWIDX))[gpos] = tok; ((int*)(a.ws + MO_PDST))[gpos] = idx;
            ((f32x2*)(a.ws + MO_PINFO))[gpos] = (f32x2){__builtin_amdgcn_rsqf(ss * (1.f / 1024.f) + EPS), __int_as_float(((const int*)(a.ws + MO_TOKW))[idx])}; }
        if (blockIdx.x == 0 && tid < MAXPAN + 8) { int e = 0;
            for (int k = 1; k < 8; ++k) if (tid * 256 >= offs[k]) e = k;
            ((int*)(a.ws + MO_PEXP))[tid] = e; }
    }
    SEAM(12);
    for (int ci = 0; ci < 3; ++ci) {
        if (IN(13 + 2 * ci) || IN(14 + 2 * ci)) moe_offsets(a, offs, tid);
        int nP = 0; if (IN(13 + 2 * ci) || IN(14 + 2 * ci)) { nP = __builtin_amdgcn_readfirstlane(offs[8]) - 128 * ci; nP = nP > 128 ? 128 : nP; }
        if (IN(13 + 2 * ci) && nP > 0) {
            pg8::Gemm g{hb, (const bf16*)(a.ws + B_EGU), DM, EGU_BYTES, (const int*)(a.ws + MO_ROWIDX)}; pg8::MoeOrder S; S.init(nP, 2 * DFE / 256, G, (int)blockIdx.x, 128 * ci, (const int*)(a.ws + MO_PEXP));
            EpiSwigluMoe E{(bf16*)(a.ws + B_EACT), (const f32x2*)(a.ws + MO_PINFO)};
            pg8::gemm_phase<EpiSwigluMoe, pg8::MoeOrder, true>(lds, g, S, E);
        }
        SEAM(13 + 2 * ci);
        if (IN(14 + 2 * ci) && nP > 0) {
            pg8::Gemm g{(const bf16*)(a.ws + B_EACT), (const bf16*)(a.ws + B_ED), DFE, ED_BYTES, nullptr}; pg8::MoeOrder S; S.init(nP, 4, G, (int)blockIdx.x, 128 * ci, (const int*)(a.ws + MO_PEXP));
            EpiMoeDown E{(unsigned char*)a.out, (const int*)(a.ws + MO_PDST), (const f32x2*)(a.ws + MO_PINFO)};
            pg8::gemm_phase<EpiMoeDown, pg8::MoeOrder, false>(lds, g, S, E);
        }
        SEAM(14 + 2 * ci);
    }
    if (IN(19)) { OPQ(); const int lane = plane;
        const float* fn = a.in[I_FINAL];
        for (int r = blockIdx.x * 8 + wave; r < MR; r += G * 8) {
            unsigned char* orow = (unsigned char*)a.out + (size_t)r * 4096; float v[16]; float ss = 0.f;
#pragma unroll
            for (int hf = 0; hf < 2; ++hf) { const int k = 512 * hf + 8 * lane; const v4u h4 = *(const v4u*)(hb + (size_t)r * DM + k), y0 = *(const v4u*)(orow + 2 * k), y1 = *(const v4u*)(orow + 2048 + 2 * k);
                const unsigned hw[4] = {h4.x, h4.y, h4.z, h4.w}, aw[4] = {y0.x, y0.y, y0.z, y0.w}, bw[4] = {y1.x, y1.y, y1.z, y1.w};
#pragma unroll
                for (int t = 0; t < 4; ++t) { const float x0 = bflo(hw[t]) + bflo(aw[t]) + bflo(bw[t]), x1 = bfhi(hw[t]) + bfhi(aw[t]) + bfhi(bw[t]); v[8 * hf + 2 * t] = x0; v[8 * hf + 2 * t + 1] = x1; ss += x0 * x0 + x1 * x1; } }
            ss = wave_sum(ss); const float rs = __builtin_amdgcn_rsqf(ss * (1.f / 1024.f) + EPS);
#pragma unroll
            for (int hf = 0; hf < 2; ++hf) { const int k = 512 * hf + 8 * lane; const f32x4 g0 = *(const f32x4*)(fn + k), g1 = *(const f32x4*)(fn + k + 4);
                *(f32x4*)(orow + 4 * k) = (f32x4){v[8 * hf] * rs * g0[0], v[8 * hf + 1] * rs * g0[1], v[8 * hf + 2] * rs * g0[2], v[8 * hf + 3] * rs * g0[3]};
                *(f32x4*)(orow + 4 * k + 16) = (f32x4){v[8 * hf + 4] * rs * g1[0], v[8 * hf + 5] * rs * g1[1], v[8 * hf + 6] * rs * g1[2], v[8 * hf + 7] * rs * g1[3]}; }
        }
    }
#undef IN
#undef SEAM
}

extern "C" void kernel_launch(void* const* d_in, const int* in_sizes, int n_in, void* d_out, int out_size, void* d_ws, size_t ws_size, hipStream_t stream) {
    static int grid = 0;
    if (grid == 0) {
        if (n_in != 24 || in_sizes[0] != MR * DM || out_size != MR * DM || ws_size < WS_NEED) { fprintf(stderr, "kernel_launch: unexpected problem (n_in %d, in0 %d, out %d, ws %zu < %zu)\n", n_in, n_in > 0 ? in_sizes[0] : -1, out_size, ws_size, (size_t)WS_NEED); grid = -1; return; }
        int dev = 0, cus = 0, per_cu = 0;
        if (hipGetDevice(&dev) != hipSuccess || hipDeviceGetAttribute(&cus, hipDeviceAttributeMultiprocessorCount, dev) != hipSuccess) { grid = -1; return; }
        if (hipFuncSetAttribute((const void*)mega_fwd, hipFuncAttributeMaxDynamicSharedMemorySize, LDS_BYTES) != hipSuccess) { fprintf(stderr, "kernel_launch: hipFuncSetAttribute failed\n"); grid = -1; return; }
        if (hipOccupancyMaxActiveBlocksPerMultiprocessor(&per_cu, (const void*)mega_fwd, 512, LDS_BYTES) != hipSuccess || per_cu < 1) fprintf(stderr, "kernel_launch: occupancy query reports %d\n", per_cu);
        (void)hipGetLastError();
        grid = cus;
    }
    if (grid < 0) return;
    if (hipMemsetAsync((char*)d_ws + WS_CTL, 0, CTL_BYTES, stream) != hipSuccess) return;
    Args a{};
    for (int i = 0; i < 24; ++i) a.in[i] = (const float*)d_in[i];
    a.out = (float*)d_out; a.ws = (unsigned char*)d_ws;
#if MK_ONE_LAUNCH
    a.ph_lo = 0; a.ph_hi = NPHASE;
    hipLaunchKernelGGL(mega_fwd, dim3(grid), dim3(512), LDS_BYTES, stream, a);
#else
    for (int p = 0; p < NPHASE; ++p) { a.ph_lo = p; a.ph_hi = p + 1; hipLaunchKernelGGL(mega_fwd, dim3(grid), dim3(512), LDS_BYTES, stream, a); }
#endif
}
```

```cpp
#include <hip/hip_runtime.h>
#include <cstdio>
#include <cstdint>

namespace pg8 {
#define PG8_LAS __attribute__((address_space(3)))
typedef unsigned short bf16_t;
typedef short bf16x8 __attribute__((ext_vector_type(8)));
typedef float f32x4 __attribute__((ext_vector_type(4)));
typedef unsigned u32x4 __attribute__((ext_vector_type(4)));
constexpr int BM = 256, BK = 64, HALF = 128, HTB = HALF * BK * 2  , STAGE_BYTES = 8 * HTB, NXCD = 8, WGM = 8;

__host__ __device__ __forceinline__ int lds_byte(int r, int c) { const int st = (r >> 4) * 2 + (c >> 5), rr = r & 15, cc = c & 31, ob = rr * 64 + cc * 2; return st * 1024 + (ob ^ (((ob >> 9) & 1) << 5)); }
__host__ __device__ __forceinline__ void stage_rc(int b, int& R, int& C) { const int st = b / 1024, sb = b % 1024, swz = sb ^ (((sb >> 9) & 1) << 5); R = (st >> 1) * 16 + swz / 64; C = (st & 1) * 32 + (swz % 64) / 2; }
__host__ __device__ __forceinline__ int perm32(int rho) { const int n = rho >> 4, i = rho & 15; return 8 * (i >> 2) + 4 * n + (i & 3); }

struct Unit { int pm, pn, e, gp; };
struct Gemm { const bf16_t* A; const bf16_t* Bt; int K; size_t estride  ; const int* rowidx  ; };

struct StaticOrder {
    int nM, nN, nwg, G, c;
    __device__ void init(int nM_, int nN_, int G_, int c_) { nM = nM_; nN = nN_; nwg = nM * nN; G = G_; c = c_; }
    __device__ __forceinline__ bool map(int i, int& pm, int& pn) const {
        const long L = (long)i * G + c; if (L >= nwg) return false;
        int wgid = (int)L; { const int q = nwg / NXCD, r = nwg % NXCD, xcd = wgid % NXCD, off = wgid / NXCD; wgid = (xcd < r ? xcd * (q + 1) : r * (q + 1) + (xcd - r) * q) + off; }
        const int nig = WGM * nN, gid = wgid / nig, fm = gid * WGM, gsz = (nM - fm) < WGM ? (nM - fm) : WGM;
        pm = fm + ((wgid % nig) % gsz); pn = (wgid % nig) / gsz; return true;
    }
    __device__ __forceinline__ bool next(int i, Unit& u) const { int pm, pn; if (!map(i, pm, pn)) return false; u.pm = pm; u.pn = pn; u.e = 0; u.gp = pm; return true; }
};
struct MoeOrder {
    StaticOrder so; int p0; const int* pexp;
    __device__ void init(int nP, int nN, int G, int c, int p0_, const int* pexp_) { so.init(nP, nN, G, c); p0 = p0_; pexp = pexp_; }
    __device__ __forceinline__ bool next(int i, Unit& u) const { int pm, pn; if (!so.map(i, pm, pn)) return false; u.pm = pm; u.pn = pn; u.gp = p0 + pm; u.e = __builtin_amdgcn_readfirstlane(pexp[u.gp]); return true; }
};

__device__ __forceinline__ unsigned cvt_pk_bf16(float lo, float hi) { unsigned r; asm volatile("v_cvt_pk_bf16_f32 %0, %1, %2" : "=v"(r) : "v"(lo), "v"(hi)); return r; }
__device__ __forceinline__ float bf_lo(unsigned w) { return __uint_as_float(w << 16); }
__device__ __forceinline__ float bf_hi(unsigned w) { return __uint_as_float(w & 0xffff0000u); }

template <class Epi, class Sched, bool GATHER>
__device__ __forceinline__ void gemm_phase(PG8_LAS unsigned char* lds, const Gemm g, const Sched& S, const Epi& E) {
    int tid_ = threadIdx.x; asm volatile("" : "+v"(tid_));
    const int tid = tid_, wid = __builtin_amdgcn_readfirstlane(tid >> 6), lane = tid & 63, wr = wid >> 2, wc = wid & 3, fr = lane & 15, fq = lane >> 4;
    const int K = g.K, nt = K / BK;
    int Ra[2], Ca[2]; unsigned voffB[2];
#pragma unroll
    for (int i = 0; i < 2; ++i) { int R, C; stage_rc(tid * 16 + i * 8192, R, C); const int Rb = (R & ~31) + perm32(R & 31);
        Ra[i] = R; Ca[i] = C; voffB[i] = (unsigned)(Rb * K + C) * 2u; }
    const size_t kstep = (size_t)(BK * 2);
    const size_t hstep = (size_t)HALF * K * 2;
    const size_t tstep = 2 * hstep;
    const unsigned ldsw = (unsigned)wid * 1024u;
    const int aoff = lds_byte(wr * 64 + fr, fq * 8), boff = lds_byte(wc * 32 + fr, fq * 8);
    const char* const A0 = (const char*)g.A;
#define PG8_SA(b, h) (((b) * 2 + (h)) * HTB)
#define PG8_SB(b, h) ((4 + (b) * 2 + (h)) * HTB)
#define PG8_STAGE(bufoff, gbase, voff) do { _Pragma("unroll") for (int _i = 0; _i < 2; ++_i) \
        __builtin_amdgcn_global_load_lds((const unsigned*)((const char*)(gbase) + (voff)[_i]), (PG8_LAS unsigned*)(lds + (bufoff) + ldsw + _i * 8192), 16, 0, 0); } while (0)
#define PG8_LDA(dst, b, h) do { _Pragma("unroll") for (int m = 0; m < 4; ++m) _Pragma("unroll") for (int k = 0; k < 2; ++k) dst[m][k] = *(const PG8_LAS bf16x8*)(lds + PG8_SA(b, h) + aoff + m * 2048 + k * 1024); } while (0)
#define PG8_LDB(dst, b, h) do { _Pragma("unroll") for (int n = 0; n < 2; ++n) _Pragma("unroll") for (int k = 0; k < 2; ++k) dst[n][k] = *(const PG8_LAS bf16x8*)(lds + PG8_SB(b, h) + boff + n * 2048 + k * 1024); } while (0)
#define PG8_MMA(ai, bj, At, Bt) do { __builtin_amdgcn_s_setprio(1); _Pragma("unroll") for (int m = 0; m < 4; ++m) _Pragma("unroll") for (int n = 0; n < 2; ++n) _Pragma("unroll") for (int k = 0; k < 2; ++k) \
        acc[ai][bj][m][n] = __builtin_amdgcn_mfma_f32_16x16x32_bf16(Bt[n][k], At[m][k], acc[ai][bj][m][n], 0, 0, 0); __builtin_amdgcn_s_setprio(0); } while (0)
#define PG8_WAIT_V(n) asm volatile("s_waitcnt vmcnt(" #n ")" ::: "memory")
#define PG8_WAIT_L(n) asm volatile("s_waitcnt lgkmcnt(" #n ")" ::: "memory")
#define PG8_BAR __builtin_amdgcn_s_barrier()
#define PG8_SCHED __builtin_amdgcn_sched_barrier(0)
#define PG8_AOFFS(dst, u) do { _Pragma("unroll") for (int _h = 0; _h < 2; ++_h) _Pragma("unroll") for (int _i = 0; _i < 2; ++_i) { \
        int _row = (u).pm * BM + _h * HALF + Ra[_i]; \
        if (GATHER) { const int _gi = g.rowidx[(u).gp * BM + _h * HALF + Ra[_i]]; _row = _gi < 0 ? 0 : _gi; } \
        dst[_h][_i] = ((unsigned)_row * (unsigned)K + (unsigned)Ca[_i]) * 2u; } } while (0)
    Unit cur, nxt; int ui = 0;
    if (!S.next(0, cur)) return;
    f32x4 acc[2][2][4][2];
#pragma unroll
    for (int a = 0; a < 2; ++a)
#pragma unroll
        for (int b = 0; b < 2; ++b)
#pragma unroll
            for (int m = 0; m < 4; ++m)
#pragma unroll
                for (int n = 0; n < 2; ++n) acc[a][b][m][n] = (f32x4){0.f, 0.f, 0.f, 0.f};
    bf16x8 At[4][2], B0[2][2], B1[2][2];
    unsigned oaC[2][2], oaN[2][2];
    PG8_AOFFS(oaC, cur);
    const char* cB = (const char*)g.Bt + (size_t)cur.e * g.estride + (size_t)cur.pn * tstep;
    PG8_STAGE(PG8_SB(0, 0), cB, voffB); PG8_STAGE(PG8_SB(0, 1), cB + hstep, voffB); PG8_STAGE(PG8_SA(0, 0), A0, oaC[0]); PG8_STAGE(PG8_SA(0, 1), A0, oaC[1]);
    if (wr == 1) PG8_BAR;
    PG8_WAIT_V(2); PG8_BAR;
    PG8_STAGE(PG8_SB(1, 0), cB + kstep, voffB); PG8_STAGE(PG8_SA(1, 0), A0 + kstep, oaC[0]); PG8_STAGE(PG8_SB(1, 1), cB + hstep + kstep, voffB);
    PG8_WAIT_V(6); PG8_BAR;
    for (;;) {
        const bool has_next = S.next(ui + 1, nxt);
        if (has_next) { PG8_AOFFS(oaN, nxt); }
        else {
#pragma unroll
            for (int _h = 0; _h < 2; ++_h)
#pragma unroll
                for (int _i = 0; _i < 2; ++_i) oaN[_h][_i] = oaC[_h][_i]; }
        const char* nB = has_next ? (const char*)g.Bt + (size_t)nxt.e * g.estride + (size_t)nxt.pn * tstep : cB;
        for (int t = 0; t < nt; t += 2) {
            const bool last = (t == nt - 2);
            const char* ka1 = A0 + (size_t)(t + 1) * kstep;
            const char* ka2 = last ? A0 : A0 + (size_t)(t + 2) * kstep; const char* b2 = last ? nB : cB + (size_t)(t + 2) * kstep;
            const char* ka3 = ka2 + kstep; const char* b3 = b2 + kstep;
            unsigned o2[2][2];
#pragma unroll
            for (int _h = 0; _h < 2; ++_h)
#pragma unroll
                for (int _i = 0; _i < 2; ++_i) o2[_h][_i] = oaC[_h][_i];
            if (last) {
#pragma unroll
                for (int _h = 0; _h < 2; ++_h)
#pragma unroll
                    for (int _i = 0; _i < 2; ++_i) o2[_h][_i] = oaN[_h][_i];
                asm volatile("" : "+v"(o2[0][0]), "+v"(o2[0][1]), "+v"(o2[1][0]), "+v"(o2[1][1])); }
            PG8_LDB(B0, 0, 0); PG8_LDB(B1, 0, 1); PG8_SCHED; PG8_LDA(At, 0, 0); PG8_STAGE(PG8_SA(1, 1), ka1, oaC[1]);
            PG8_WAIT_V(8); PG8_WAIT_L(0); PG8_BAR; PG8_MMA(0, 0, At, B0); PG8_MMA(0, 1, At, B1); PG8_BAR; PG8_SCHED;
            PG8_LDA(At, 0, 1); PG8_STAGE(PG8_SB(0, 0), b2, voffB); PG8_STAGE(PG8_SB(0, 1), b2 + hstep, voffB); PG8_STAGE(PG8_SA(0, 0), ka2, o2[0]);
            PG8_WAIT_V(8); PG8_WAIT_L(0); PG8_BAR; PG8_MMA(1, 0, At, B0); PG8_MMA(1, 1, At, B1); PG8_BAR; PG8_SCHED;
            PG8_LDB(B0, 1, 0); PG8_LDB(B1, 1, 1); PG8_SCHED; PG8_LDA(At, 1, 0); PG8_STAGE(PG8_SA(0, 1), ka2, o2[1]);
            PG8_WAIT_V(8); PG8_WAIT_L(0); PG8_BAR; PG8_MMA(0, 0, At, B0); PG8_MMA(0, 1, At, B1); PG8_BAR; PG8_SCHED;
            PG8_LDA(At, 1, 1); PG8_STAGE(PG8_SB(1, 0), b3, voffB); PG8_STAGE(PG8_SB(1, 1), b3 + hstep, voffB); PG8_STAGE(PG8_SA(1, 0), ka3, o2[0]);
            PG8_WAIT_V(8); PG8_WAIT_L(0); PG8_BAR; PG8_MMA(1, 0, At, B0); PG8_MMA(1, 1, At, B1); PG8_BAR; PG8_SCHED;
        }
        if (wr == 0) PG8_BAR;
        E(acc, cur, wr, wc, fr, fq);
        if (!has_next) break;
#pragma unroll
        for (int a = 0; a < 2; ++a)
#pragma unroll
            for (int b = 0; b < 2; ++b)
#pragma unroll
                for (int m = 0; m < 4; ++m)
#pragma unroll
                    for (int n = 0; n < 2; ++n) acc[a][b][m][n] = (f32x4){0.f, 0.f, 0.f, 0.f};
        cur = nxt; cB = nB; ++ui;
#pragma unroll
        for (int _h = 0; _h < 2; ++_h)
#pragma unroll
            for (int _i = 0; _i < 2; ++_i) oaC[_h][_i] = oaN[_h][_i];
        if (wr == 1) PG8_BAR;
    }
    PG8_WAIT_V(0);
    PG8_BAR;
#undef PG8_SA
#undef PG8_SB
#undef PG8_STAGE
#undef PG8_LDA
#undef PG8_LDB
#undef PG8_MMA
#undef PG8_WAIT_V
#undef PG8_WAIT_L
#undef PG8_BAR
#undef PG8_SCHED
#undef PG8_AOFFS
}
}
#define GAS __attribute__((address_space(1)))
#define LAS __attribute__((address_space(3)))
typedef unsigned short bf16;
typedef unsigned v4u __attribute__((ext_vector_type(4)));
typedef unsigned v2u __attribute__((ext_vector_type(2)));
typedef float f32x4 __attribute__((ext_vector_type(4)));
typedef float f32x2 __attribute__((ext_vector_type(2)));
typedef GAS unsigned gu32;
#define RLX_AGENT __ATOMIC_RELAXED, __HIP_MEMORY_SCOPE_AGENT
#define LDS_WAIT() asm volatile("s_waitcnt lgkmcnt(0)" ::: "memory")
#define VM_WAIT() asm volatile("s_waitcnt vmcnt(0)" ::: "memory")
__device__ __forceinline__ unsigned f2bf(float f) { unsigned u = __builtin_bit_cast(unsigned, f); return (u + 0x7fffu + ((u >> 16) & 1u)) >> 16; }
__device__ __forceinline__ unsigned pk2(float lo, float hi) { return f2bf(lo) | (f2bf(hi) << 16); }
__device__ __forceinline__ float bf2f(bf16 h) { return __uint_as_float(((unsigned)h) << 16); }
__device__ __forceinline__ float bflo(unsigned w) { return __uint_as_float(w << 16); }
__device__ __forceinline__ float bfhi(unsigned w) { return __uint_as_float(w & 0xffff0000u); }

#define XB_TMO      128
#define XB_XCNT(j)  (256  + 64 * (j))
#define XB_XSUB(j)  (1280 + 64 * (j))
#define XB_XGEN(j)  (2304 + 64 * (j))
#define XB_TOP      3328
#define XB_TOPGEN   3392
#define XCD_BAR_WORDS 3456
#define XB_SPIN_CAP (1u << 18)

__device__ __forceinline__ unsigned xb_ld(unsigned* p)              { return __hip_atomic_load(p, __ATOMIC_RELAXED, __HIP_MEMORY_SCOPE_AGENT); }
__device__ __forceinline__ unsigned xb_add(unsigned* p, unsigned v) { return __hip_atomic_fetch_add(p, v, __ATOMIC_RELAXED, __HIP_MEMORY_SCOPE_AGENT); }
__device__ __forceinline__ unsigned xb_xcc_id() { return (unsigned)__builtin_amdgcn_s_getreg((3 << 11) | 20) & 0xFu; }
#define XB_SPIN(cond, bar) do { unsigned _sp = 0; while (cond) { __builtin_amdgcn_s_sleep(1); \
    if ((++_sp & 255u) == 0u) { if (xb_ld(&(bar)[XB_TMO])) break; if (_sp > XB_SPIN_CAP) { atomicAdd(&(bar)[XB_TMO], 1u); break; } } } } while (0)

struct XcdBarrier {
    unsigned* bar; unsigned x;
    volatile LAS unsigned* st;
};

__device__ __forceinline__ XcdBarrier xcd_barrier_post(unsigned* bar, volatile LAS unsigned* st) {
    XcdBarrier b; b.bar = bar; b.x = xb_xcc_id(); b.st = st;
    if (threadIdx.x == 0) (void)xb_add(&bar[XB_XCNT(b.x)], 1u);
    return b;
}
__device__ __forceinline__ void xcd_barrier_complete(unsigned* bar, unsigned x, unsigned& nloc, unsigned& nx) {
    const unsigned G = gridDim.x * gridDim.y * gridDim.z;
    unsigned sum, cnt, mine, sp = 0u;
    for (;;) {
        sum = 0u; cnt = 0u; mine = 0u;
#pragma unroll
        for (unsigned j = 0; j < 16; ++j) { const unsigned c = xb_ld(&bar[XB_XCNT(j)]); sum += c; cnt += (c > 0u) ? 1u : 0u; mine = (j == x) ? c : mine; }
        if (sum == G) break;
        __builtin_amdgcn_s_sleep(1);
        if ((++sp & 255u) == 0u) { if (xb_ld(&bar[XB_TMO])) break; if (sp > XB_SPIN_CAP) { atomicAdd(&bar[XB_TMO], 1u); break; } }
    }
    nloc = mine > 0u ? mine : 1u; nx = cnt > 0u ? cnt : 1u;
}

__device__ __forceinline__ void xcd_barrier(const XcdBarrier& b) {
    asm volatile("s_waitcnt vmcnt(0)" ::: "memory");
    __syncthreads();
    if (threadIdx.x == 0) {
        unsigned* bar = b.bar;
        __builtin_amdgcn_s_waitcnt(0);
        unsigned nloc = b.st[0], nx = b.st[1];
        if (nloc == 0u) { xcd_barrier_complete(bar, b.x, nloc, nx); b.st[0] = nloc; b.st[1] = nx; }
        const unsigned old = xb_add(&bar[XB_XSUB(b.x)], 1u);
        const unsigned gen = old / nloc;
        if (old + 1u == (gen + 1u) * nloc) {
            __builtin_amdgcn_fence(__ATOMIC_RELEASE, "agent");
            asm volatile("s_waitcnt vmcnt(0)" ::: "memory");
            const unsigned og = xb_add(&bar[XB_TOP], 1u);
            const unsigned tg = og / nx;
            if (og + 1u == (tg + 1u) * nx) xb_add(&bar[XB_TOPGEN], 1u);
            else XB_SPIN(xb_ld(&bar[XB_TOPGEN]) == tg, bar);
            __builtin_amdgcn_fence(__ATOMIC_ACQUIRE, "agent");
            xb_add(&bar[XB_XGEN(b.x)], 1u);
            asm volatile("s_waitcnt vmcnt(0)" ::: "memory");
        } else {
            XB_SPIN(xb_ld(&bar[XB_XGEN(b.x)]) == gen, bar);
            __builtin_amdgcn_fence(__ATOMIC_ACQUIRE, "agent");
            asm volatile("s_waitcnt vmcnt(0)" ::: "memory");
        }
    }
    __syncthreads();
}

constexpr int NB = 16, TT = 2048, DM = 1024, MR = NB * TT, NMETA = 16, MROWS = MR + 256, NPAN = MROWS / 256;
constexpr int PSEQ = 2112, NCH = 33;
constexpr int DIN = 2864, N1 = 3328;
constexpr int DFF = 2816, DFE = 3584, NEXP = 8;
constexpr float EPS = 1e-6f;
constexpr int C_AQ = 0, C_AK = 128, C_AV = 256, C_ALR = 512, C_AOG = 528, C_RQ = 784, C_RK = 1040, C_RV = 1296, C_ROG = 1552, C_CQ = 1808, C_CKV = 2000, C_KPE = 2064, C_DQ = 2096, C_DK = 2352, C_DV = 2608, C_QEFF = 2864;
constexpr int MAXPAN = 264;
constexpr float LOG2E = 1.4426950408889634f;

constexpr size_t MiB = 1u << 20;
constexpr size_t WS_CTL = 0, CTL_BYTES = 1 * MiB;
constexpr size_t WS_TABR = 1 * MiB, WS_TABM = 1 * MiB + 576 * 1024;
constexpr size_t WS_RT = 2 * MiB;
constexpr size_t WS_STA = 3 * MiB, WS_STB = 6 * MiB;
constexpr size_t WS_MOE = 9 * MiB;
constexpr size_t MO_ROWIDX = WS_MOE, MO_PDST = WS_MOE + 512 * 1024, MO_PINFO = WS_MOE + 1 * MiB, MO_TOKE = WS_MOE + 2 * MiB, MO_TOKP = MO_TOKE + 256 * 1024, MO_TOKW = MO_TOKE + 512 * 1024, MO_PEXP = WS_MOE + 3 * MiB;
constexpr size_t WS_GD = 13 * MiB;
constexpr size_t WS_W1T = 16 * MiB, W1T_BYTES = (size_t)N1 * DM * 2;
constexpr size_t WS_WOT = 29 * MiB, WOT_BYTES = (size_t)DM * DM * 2;
constexpr size_t WS_WGU = 33 * MiB;
constexpr size_t WS_WD = 44 * MiB;
constexpr size_t WS_HB = 50 * MiB;
constexpr size_t WS_BIG = 115 * MiB;
constexpr size_t B_PROJ = WS_BIG;
constexpr size_t B_GQ = WS_BIG + 210 * MiB, B_GK = B_GQ + 8704 * 1024, B_GV = WS_BIG + 227 * MiB;
constexpr size_t B_RQ = WS_BIG + 244 * MiB, B_RK = B_RQ + 16896 * 1024, B_RV = WS_BIG + 277 * MiB;
constexpr size_t B_MQ = WS_BIG + 294 * MiB, B_MK = WS_BIG + 319 * MiB;
constexpr size_t B_DQ = WS_BIG + 326 * MiB, B_DK = B_DQ + 16896 * 1024;
constexpr size_t O_DVT = 65 * MiB, O_MVT = 82 * MiB, O_GKT = 87 * MiB, O_RKT = 96 * MiB;
constexpr size_t B_ACT = WS_BIG;
constexpr size_t B_EGU = WS_BIG, EGU_BYTES = (size_t)2 * DFE * DM * 2;
constexpr size_t B_ED = WS_BIG + 112 * MiB, ED_BYTES = (size_t)DM * DFE * 2;
constexpr size_t B_EACT = WS_BIG + 168 * MiB;
constexpr size_t WS_NEED = WS_BIG + 392 * MiB;
constexpr int CW_BAR = 4096, CW_CNT = 8192;

constexpr int RING_BYTES = 131072, MISC_OFF = RING_BYTES + 320, LDS_BYTES = 147456;

__device__ __forceinline__ float row_rstd16(const float* stats, int row, int fq) {
    const f32x4 v = *(const f32x4*)(stats + (size_t)row * 16 + 4 * fq);
    float s = (v[0] + v[1]) + (v[2] + v[3]);
    s += __shfl_xor(s, 16); s += __shfl_xor(s, 32);
    return __builtin_amdgcn_rsqf(s * (1.0f / 1024.0f) + EPS);
}
__device__ __forceinline__ float silu_f(float x) { return x * __builtin_amdgcn_rcpf(1.0f + __builtin_amdgcn_exp2f(-x * LOG2E)); }
__device__ __forceinline__ v4u pack8(const f32x4 a, const f32x4 b) { v4u w; w.x = pg8::cvt_pk_bf16(a[0], a[1]); w.y = pg8::cvt_pk_bf16(a[2], a[3]); w.z = pg8::cvt_pk_bf16(b[0], b[1]); w.w = pg8::cvt_pk_bf16(b[2], b[3]); return w; }

struct EpiProj {
    bf16* O; const float* stats;
    __device__ __forceinline__ void operator()(const f32x4 (&acc)[2][2][4][2], const pg8::Unit& u, int wr, int wc, int fr, int fq) const {
        const int col0 = u.pn * 256 + wc * 32 + 8 * fq;
#pragma unroll
        for (int ai = 0; ai < 2; ++ai)
#pragma unroll
            for (int m = 0; m < 4; ++m) { const int r = u.pm * 256 + ai * 128 + wr * 64 + m * 16 + fr; const float rs = row_rstd16(stats, r, fq); bf16* rowp = O + (size_t)r * N1 + col0;
#pragma unroll
                for (int bj = 0; bj < 2; ++bj) *(v4u*)(rowp + bj * 128) = pack8(acc[ai][bj][m][0] * rs, acc[ai][bj][m][1] * rs); }
    }
};
struct EpiSwiglu {
    bf16* O; int ldo; const float* stats;
    __device__ __forceinline__ void operator()(const f32x4 (&acc)[2][2][4][2], const pg8::Unit& u, int wr, int wc, int fr, int fq) const {
        const int col0 = u.pn * 128 + wc * 32 + 8 * fq;
#pragma unroll
        for (int ai = 0; ai < 2; ++ai)
#pragma unroll
            for (int m = 0; m < 4; ++m) { const int r = u.pm * 256 + ai * 128 + wr * 64 + m * 16 + fr; const float rs = row_rstd16(stats, r, fq);
                f32x4 o[2];
#pragma unroll
                for (int n = 0; n < 2; ++n)
#pragma unroll
                    for (int i = 0; i < 4; ++i) o[n][i] = silu_f(acc[ai][0][m][n][i] * rs) * (acc[ai][1][m][n][i] * rs);
                *(v4u*)(O + (size_t)r * ldo + col0) = pack8(o[0], o[1]); }
    }
};
struct EpiResid {
    bf16* H; float* stats;
    __device__ __forceinline__ void operator()(const f32x4 (&acc)[2][2][4][2], const pg8::Unit& u, int wr, int wc, int fr, int fq) const {
        const int col0 = u.pn * 256 + wc * 32 + 8 * fq;
#pragma unroll
        for (int ai = 0; ai < 2; ++ai)
#pragma unroll
            for (int m = 0; m < 4; ++m) { const int r = u.pm * 256 + ai * 128 + wr * 64 + m * 16 + fr; bf16* rowp = H + (size_t)r * DM + col0; float ss = 0.f;
#pragma unroll
                for (int bj = 0; bj < 2; ++bj) { const v4u w = *(const v4u*)(rowp + bj * 128);
                    f32x4 a = acc[ai][bj][m][0], b = acc[ai][bj][m][1];
                    a[0] += bflo(w.x); a[1] += bfhi(w.x); a[2] += bflo(w.y); a[3] += bfhi(w.y); b[0] += bflo(w.z); b[1] += bfhi(w.z); b[2] += bflo(w.w); b[3] += bfhi(w.w);
                    ss += (a[0] * a[0] + a[1] * a[1]) + (a[2] * a[2] + a[3] * a[3]) + (b[0] * b[0] + b[1] * b[1]) + (b[2] * b[2] + b[3] * b[3]);
                    *(v4u*)(rowp + bj * 128) = pack8(a, b); }
                ss += __shfl_xor(ss, 16); ss += __shfl_xor(ss, 32);
                if (fq == 0) stats[(size_t)r * 16 + u.pn * 4 + wc] = ss; }
    }
};
struct EpiSwigluMoe {
    bf16* O; const f32x2* pinfo;
    __device__ __forceinline__ void operator()(const f32x4 (&acc)[2][2][4][2], const pg8::Unit& u, int wr, int wc, int fr, int fq) const {
        const int col0 = u.pn * 128 + wc * 32 + 8 * fq;
#pragma unroll
        for (int ai = 0; ai < 2; ++ai)
#pragma unroll
            for (int m = 0; m < 4; ++m) { const int rl = ai * 128 + wr * 64 + m * 16 + fr; const float rs = pinfo[u.gp * 256 + rl][0];
                f32x4 o[2];
#pragma unroll
                for (int n = 0; n < 2; ++n)
#pragma unroll
                    for (int i = 0; i < 4; ++i) o[n][i] = silu_f(acc[ai][0][m][n][i] * rs) * (acc[ai][1][m][n][i] * rs);
                *(v4u*)(O + (size_t)(u.pm * 256 + rl) * DFE + col0) = pack8(o[0], o[1]); }
    }
};
struct EpiMoeDown {
    unsigned char* Y; const int* pdst; const f32x2* pinfo;
    __device__ __forceinline__ void operator()(const f32x4 (&acc)[2][2][4][2], const pg8::Unit& u, int wr, int wc, int fr, int fq) const {
        const int col0 = u.pn * 256 + wc * 32 + 8 * fq;
#pragma unroll
        for (int ai = 0; ai < 2; ++ai)
#pragma unroll
            for (int m = 0; m < 4; ++m) { const int rl = ai * 128 + wr * 64 + m * 16 + fr; const int dst = pdst[u.gp * 256 + rl]; const float w = pinfo[u.gp * 256 + rl][1];
                if (dst >= 0) { bf16* rowp = (bf16*)(Y + (size_t)(dst >> 1) * 4096 + (size_t)(dst & 1) * 2048) + col0;
#pragma unroll
                    for (int bj = 0; bj < 2; ++bj) *(v4u*)(rowp + bj * 128) = pack8(acc[ai][bj][m][0] * w, acc[ai][bj][m][1] * w); } }
    }
};

__device__ __forceinline__ float wave_sum(float v) {
#pragma unroll
    for (int o = 1; o < 64; o <<= 1) v += __shfl_xor(v, o);
    return v;
}
__device__ __forceinline__ void transpose_item(const float* W, int K, int N, const float* gain, bf16* WT, int kb, int nb, int dmode, LAS float* scr, int lane) {
    const int k0 = 64 * kb, n0 = 32 * nb, n = n0 + (lane & 31), kh = lane >> 5;
    float v[32];
#pragma unroll
    for (int i = 0; i < 32; ++i) v[i] = (n < N) ? W[(size_t)(k0 + 2 * i + kh) * N + n] : 0.f;
    if (gain) {
#pragma unroll
        for (int i = 0; i < 32; ++i) v[i] *= gain[k0 + 2 * i + kh]; }
#pragma unroll
    for (int i = 0; i < 32; ++i) scr[(2 * i + kh) * 33 + (lane & 31)] = v[i];
    LDS_WAIT(); asm volatile("" ::: "memory");
    const int c = lane & 7;
    const int d0 = dmode == 0 ? n0 : 256 * (n0 >> 7) + (n0 & 127) + (dmode == 2 ? 128 : 0);
#pragma unroll
    for (int j = 0; j < 4; ++j) { const int nl = (lane >> 3) + 8 * j; const LAS float* s = scr + (8 * c) * 33 + nl;
        v4u o; o.x = pk2(s[0 * 33], s[1 * 33]); o.y = pk2(s[2 * 33], s[3 * 33]); o.z = pk2(s[4 * 33], s[5 * 33]); o.w = pk2(s[6 * 33], s[7 * 33]);
        if (n0 + nl < N) *(v4u*)(WT + (size_t)(d0 + nl) * K + k0 + 8 * c) = o; }
    LDS_WAIT(); asm volatile("" ::: "memory");
}

struct Args { const float* in[24]; float* out; unsigned char* ws; int ph_lo, ph_hi; };
enum { I_X = 0, I_META, I_ANORM, I_WIN, I_GWG, I_GBG, I_GNORM, I_RNORM, I_MQN, I_WUQ, I_MKVN, I_WUKV, I_DLAM, I_DNORM, I_WOUT, I_FNORM, I_FG, I_FU, I_FD, I_ROUTER, I_EG, I_EU, I_ED, I_FINAL };

__device__ __forceinline__ void qeff_unit(const Args& a, int li, int hh, int kb, LAS float* L, int tid) {
    const float* Wuq = a.in[I_WUQ] + (size_t)li * 192 * 384; const float* Wukv = a.in[I_WUKV] + (size_t)li * 64 * 512;
    const float* gq = a.in[I_MQN] + li * 192; const float* gkv = a.in[I_MKVN] + li * 64;
    const float* Win = a.in[I_WIN] + (size_t)li * DM * DIN; const float* gan = a.in[I_ANORM] + li * DM;
    bf16* W1t = (bf16*)(a.ws + WS_W1T + li * W1T_BYTES);
    for (int idx = tid; idx < 192 * 96; idx += 512) { const int i = idx / 96, n = idx % 96; float v;
        if (n < 64) { float s = 0.f; for (int m = 0; m < 64; ++m) s += Wuq[i * 384 + hh * 96 + m] * Wukv[n * 512 + hh * 128 + m]; v = gq[i] * gkv[n] * s; }
        else v = gq[i] * Wuq[i * 384 + hh * 96 + n];
        L[idx] = v; }
    __syncthreads();
    const int k0 = kb * 64;
    for (int idx = tid; idx < 64 * 96; idx += 512) { const int kk = idx & 63, n = idx >> 6; const float* wr = Win + (size_t)(k0 + kk) * DIN + C_CQ; float s = 0.f;
        for (int i = 0; i < 192; ++i) s += wr[i] * L[i * 96 + n];
        W1t[(size_t)(C_QEFF + hh * 96 + n) * DM + k0 + kk] = (bf16)f2bf(gan[k0 + kk] * s); }
    __syncthreads();
}
__device__ __forceinline__ void wofold_unit(const Args& a, int li, int hh, int nb, int tid) {
    const float* Wukv = a.in[I_WUKV] + (size_t)li * 64 * 512; const float* gkv = a.in[I_MKVN] + li * 64; const float* Wo = a.in[I_WOUT] + (size_t)li * DM * DM;
    bf16* Wot = (bf16*)(a.ws + WS_WOT + li * WOT_BYTES);
    for (int idx = tid; idx < 64 * 64; idx += 512) { const int j = idx & 63, n = nb * 64 + (idx >> 6); float s = 0.f;
        for (int e = 0; e < 64; ++e) s += Wukv[j * 512 + hh * 128 + 64 + e] * Wo[(size_t)(512 + 64 * hh + e) * DM + n];
        Wot[(size_t)n * DM + 512 + 64 * hh + j] = (bf16)f2bf(gkv[j] * s); }
}
__device__ __forceinline__ void p0_prologue(const Args& a, LAS unsigned char* lds, int tid, int lane, int wave) {
    const int G = gridDim.x;
    for (int un = blockIdx.x; un < 256; un += G) {
        if (un < 128) qeff_unit(a, un >> 6, (un >> 4) & 3, un & 15, (LAS float*)lds, tid);
        else { const int v = un - 128; wofold_unit(a, v >> 6, (v >> 4) & 3, v & 15, tid); }
    }
    __syncthreads();
    LAS float* scr = (LAS float*)(lds + wave * 16384);
    const int gw = blockIdx.x * 8 + wave, NGW = G * 8;
    constexpr int I_IN = 16 * 90, I_WO = 12 * 32, I_G = 16 * 88, I_D = 44 * 32;
    constexpr int NIT = 2 * I_IN + 2 * I_WO + 2 * I_G + I_D;
    for (int it = gw; it < NIT; it += NGW) {
        int r = it;
        if (r < 2 * I_IN) { const int li = r / I_IN; r %= I_IN; transpose_item(a.in[I_WIN] + (size_t)li * DM * DIN, DM, DIN, a.in[I_ANORM] + li * DM, (bf16*)(a.ws + WS_W1T + li * W1T_BYTES), r / 90, r % 90, 0, scr, lane); continue; } r -= 2 * I_IN;
        if (r < 2 * I_WO) { const int li = r / I_WO; r %= I_WO; int kb = r / 32; if (kb >= 8) kb += 4; transpose_item(a.in[I_WOUT] + (size_t)li * DM * DM, DM, DM, nullptr, (bf16*)(a.ws + WS_WOT + li * WOT_BYTES), kb, r % 32, 0, scr, lane); continue; } r -= 2 * I_WO;
        if (r < I_G) { transpose_item(a.in[I_FG], DM, DFF, a.in[I_FNORM], (bf16*)(a.ws + WS_WGU), r / 88, r % 88, 1, scr, lane); continue; } r -= I_G;
        if (r < I_G) { transpose_item(a.in[I_FU], DM, DFF, a.in[I_FNORM], (bf16*)(a.ws + WS_WGU), r / 88, r % 88, 2, scr, lane); continue; } r -= I_G;
        transpose_item(a.in[I_FD], DFF, DM, nullptr, (bf16*)(a.ws + WS_WD), r / 32, r % 32, 0, scr, lane);
    }
    const int gt = blockIdx.x * 512 + tid, NGT = G * 512;
    for (int i = gt; i < 2 * 80 * 128; i += NGT) { const int li = i / (80 * 128), r = i % (80 * 128);
        *(v4u*)(a.ws + WS_W1T + li * W1T_BYTES + (size_t)(C_QEFF + 384) * DM * 2 + (size_t)r * 16) = (v4u){0u, 0u, 0u, 0u}; }
    for (int i = gt; i < 8 * DM; i += NGT) { const int e = i >> 10, k = i & 1023; ((float*)(a.ws + WS_RT))[i] = a.in[I_FNORM][DM + k] * a.in[I_ROUTER][k * 8 + e]; }
    for (int i = gt; i < PSEQ * 48; i += NGT) { const int p = i / 48, j = i % 48; const bool isR = j < 32; const int f = isR ? j : j - 32;
        const float inv = __builtin_amdgcn_exp2f(-(float)f * (isR ? 13.287712379549449f / 32.f : 13.287712379549449f / 16.f));
        const double rev = (double)(p - 48) * (double)inv * 0.15915494309189535; const float fr = (float)(rev - __builtin_rint(rev));
        const f32x2 cs = {__builtin_amdgcn_cosf(fr), __builtin_amdgcn_sinf(fr)};
        if (isR) ((f32x2*)(a.ws + WS_TABR))[p * 32 + f] = cs; else ((f32x2*)(a.ws + WS_TABM))[p * 16 + f] = cs; }
    for (int i = gt; i < 240 * 128; i += NGT) *(v4u*)((unsigned char*)a.out + (size_t)(MR + 16) * 2048 + (size_t)i * 16) = (v4u){0u, 0u, 0u, 0u};
    bf16* hb = (bf16*)(a.ws + WS_HB); float* stA = (float*)(a.ws + WS_STA);
    for (int r = gw; r < MROWS; r += NGW) {
        f32x4 v[4]; float s = 0.f;
#pragma unroll
        for (int j = 0; j < 4; ++j) { if (r < MR) v[j] = ((const f32x4*)(a.in[I_X] + (size_t)r * DM))[lane + 64 * j]; else if (r < MR + NMETA) v[j] = ((const f32x4*)(a.in[I_META] + (size_t)(r - MR) * DM))[lane + 64 * j]; else v[j] = (f32x4){0.f, 0.f, 0.f, 0.f};
            s += (v[j][0] * v[j][0] + v[j][1] * v[j][1]) + (v[j][2] * v[j][2] + v[j][3] * v[j][3]); }
        s = wave_sum(s);
#pragma unroll
        for (int j = 0; j < 4; ++j) { v2u w; w.x = pk2(v[j][0], v[j][1]); w.y = pk2(v[j][2], v[j][3]); ((v2u*)(hb + (size_t)r * DM))[lane + 64 * j] = w; }
        if (lane < 16) stA[(size_t)r * 16 + lane] = lane == 0 ? s : 0.f;
    }
}

__device__ __forceinline__ int src_row(int b, int c, int i) { return c == 0 ? (i < 48 ? -1 : MR + i - 48) : b * TT + 64 * (c - 1) + i; }
__device__ __forceinline__ float lg2gamma(int h) { return h == 0 ? -0.045803689613124789f : h == 1 ? -0.022720076500083529f : h == 2 ? -0.011315313227834146f : -0.0056465631411420627f; }

__device__ __forceinline__ void route_block(const Args& a, int blk, LAS unsigned char* lds, int tid, int lane, int wave) {
    LAS float* Rs = (LAS float*)lds; LAS int* lcnt = (LAS int*)(lds + 32768); LAS int* gbase = lcnt + 8; LAS int* rec = lcnt + 16;
    gu32* ctl = (gu32*)(a.ws + WS_CTL);
    const float* Rt = (const float*)(a.ws + WS_RT); const bf16* hb = (const bf16*)(a.ws + WS_HB); const float* stB = (const float*)(a.ws + WS_STB);
    __syncthreads();
    for (int idx = tid; idx < 8 * DM; idx += 512) Rs[idx] = Rt[idx];
    if (tid < 8) lcnt[tid] = 0;
    __syncthreads();
    for (int rr = 0; rr < 16; ++rr) { const int rl = wave * 16 + rr, row = blk * 128 + rl;
        const v4u w0 = *(const v4u*)(hb + (size_t)row * DM + 8 * lane), w1 = *(const v4u*)(hb + (size_t)row * DM + 512 + 8 * lane);
        const float x[16] = {bflo(w0.x), bfhi(w0.x), bflo(w0.y), bfhi(w0.y), bflo(w0.z), bfhi(w0.z), bflo(w0.w), bfhi(w0.w), bflo(w1.x), bfhi(w1.x), bflo(w1.y), bfhi(w1.y), bflo(w1.z), bfhi(w1.z), bflo(w1.w), bfhi(w1.w)};
        float st = lane < 16 ? stB[(size_t)row * 16 + lane] : 0.f; st = wave_sum(st); const float rs = __builtin_amdgcn_rsqf(st * (1.f / 1024.f) + EPS);
        float lg[8];
#pragma unroll
        for (int e = 0; e < 8; ++e) { float s = 0.f;
#pragma unroll
            for (int t = 0; t < 8; ++t) s += x[t] * Rs[e * DM + 8 * lane + t] + x[8 + t] * Rs[e * DM + 512 + 8 * lane + t];
            lg[e] = wave_sum(s) * rs; }
        int e0 = 0; float v0 = lg[0];
#pragma unroll
        for (int e = 1; e < 8; ++e) if (lg[e] > v0) { v0 = lg[e]; e0 = e; }
        int e1 = -1; float v1 = -3.0e38f;
#pragma unroll
        for (int e = 0; e < 8; ++e) if (e != e0 && lg[e] > v1) { v1 = lg[e]; e1 = e; }
        const float g0 = 1.f / (1.f + __expf(v1 - v0)), g1 = 1.f - g0;
        if (lane == 0) { const int lp0 = atomicAdd((int*)(lcnt + e0), 1), lp1 = atomicAdd((int*)(lcnt + e1), 1);
            rec[rl * 6] = e0; rec[rl * 6 + 1] = e1; rec[rl * 6 + 2] = lp0; rec[rl * 6 + 3] = lp1; rec[rl * 6 + 4] = __float_as_int(g0); rec[rl * 6 + 5] = __float_as_int(g1); } }
    __syncthreads();
    if (tid < 8) gbase[tid] = (int)__hip_atomic_fetch_add(ctl + CW_CNT + 64 * tid, (unsigned)lcnt[tid], RLX_AGENT);
    __syncthreads();
    if (tid < 256) { const int rl = tid >> 1, s = tid & 1, tok = blk * 128 + rl, e = rec[rl * 6 + s];
        ((int*)(a.ws + MO_TOKE))[tok * 2 + s] = e; ((int*)(a.ws + MO_TOKP))[tok * 2 + s] = gbase[e] + rec[rl * 6 + 2 + s]; ((int*)(a.ws + MO_TOKW))[tok * 2 + s] = rec[rl * 6 + 4 + s]; }
    __syncthreads();
}
__device__ __forceinline__ void moe_offsets(const Args& a, LAS int* offs, int tid) {
    gu32* ctl = (gu32*)(a.ws + WS_CTL);
    __syncthreads();
    if (tid == 0) { int o = 0;
        for (int e = 0; e < 8; ++e) { const int cnt = (int)__hip_atomic_load(ctl + CW_CNT + 64 * e, RLX_AGENT); offs[e] = o * 256; o += (cnt + 255) >> 8; }
        offs[8] = o; }
    __syncthreads();
}

__device__ __forceinline__ void stage_cols(const bf16* proj, int b, int c, int col0, int ncols, LAS bf16* S, int sst, int lcol0, int tid) {
    const int cpr = ncols >> 3;
    for (int idx = tid; idx < 64 * cpr; idx += 512) { const int i = idx / cpr, ch = idx - i * cpr, sr = src_row(b, c, i);
        v4u v = {0u, 0u, 0u, 0u}; if (sr >= 0) v = *(const v4u*)(proj + (size_t)sr * N1 + col0 + ch * 8);
        *(LAS v4u*)(S + i * sst + lcol0 + ch * 8) = v; }
}
__device__ __forceinline__ v4u gather8(const LAS bf16* S, int sst, int row0, int col) {
    unsigned x[8];
#pragma unroll
    for (int t = 0; t < 8; ++t) x[t] = S[(row0 + t) * sst + col];
    v4u w; w.x = x[0] | (x[1] << 16); w.y = x[2] | (x[3] << 16); w.z = x[4] | (x[5] << 16); w.w = x[6] | (x[7] << 16); return w;
}
__device__ __forceinline__ void prep2_unit(const Args& a, int li, int b, int c, int part, LAS unsigned char* lds, int tid) {
    const bf16* proj = (const bf16*)(a.ws + B_PROJ);
    LAS bf16* S = (LAS bf16*)lds;
    const int blk0 = (b * NCH + c) * 4; const size_t prow0 = (size_t)b * PSEQ + 64 * c;
    unsigned char* dout = (unsigned char*)a.out;
    __syncthreads();
    if (part == 0) {
        constexpr int SST = 536; LAS float* seg = (LAS float*)(lds + 64 * SST * 2);
        stage_cols(proj, b, c, C_AQ, 128, S, SST, 0, tid); stage_cols(proj, b, c, C_AK, 128, S, SST, 128, tid); stage_cols(proj, b, c, C_AV, 256, S, SST, 256, tid); stage_cols(proj, b, c, C_ALR, 16, S, SST, 512, tid);
        __syncthreads();
        { const int ch = tid & 127, sg = tid >> 7; const float* Wg = a.in[I_GWG] + (size_t)li * 16 * 128; const float bg = a.in[I_GBG][li * 128 + ch];
            float wg[16];
#pragma unroll
            for (int r = 0; r < 16; ++r) wg[r] = Wg[r * 128 + ch];
            float cl[16]; float run = 0.f;
#pragma unroll
            for (int t = 0; t < 16; ++t) { const int i = 16 * sg + t; const v4u l0 = *(const LAS v4u*)(S + i * SST + 512), l1 = *(const LAS v4u*)(S + i * SST + 520);
                float x = bg + bflo(l0.x) * wg[0] + bfhi(l0.x) * wg[1] + bflo(l0.y) * wg[2] + bfhi(l0.y) * wg[3] + bflo(l0.z) * wg[4] + bfhi(l0.z) * wg[5] + bflo(l0.w) * wg[6] + bfhi(l0.w) * wg[7]
                               + bflo(l1.x) * wg[8] + bfhi(l1.x) * wg[9] + bflo(l1.y) * wg[10] + bfhi(l1.y) * wg[11] + bflo(l1.z) * wg[12] + bfhi(l1.z) * wg[13] + bflo(l1.w) * wg[14] + bfhi(l1.w) * wg[15];
                const float ls = fminf(x, 0.f) - __logf(1.f + __expf(-fabsf(x)));
                run += (c > 0 || i >= 48) ? ls * (1.f / 16.f) : 0.f; cl[t] = run; }
            seg[sg * 128 + ch] = run;
            __syncthreads();
            float off = 0.f;
#pragma unroll
            for (int s2 = 0; s2 < 3; ++s2) off += s2 < sg ? seg[s2 * 128 + ch] : 0.f;
            if (sg == 3) ((float*)(a.ws + WS_GD))[(size_t)(blk0 + (ch >> 5)) * 32 + (ch & 31)] = __expf(off + run);
#pragma unroll
            for (int t = 0; t < 16; ++t) { const int i = 16 * sg + t; const float cum = cl[t] + off;
                S[i * SST + ch] = (bf16)f2bf(bf2f(S[i * SST + ch]) * 0.17677669529663687f * __expf(cum)); S[i * SST + 128 + ch] = (bf16)f2bf(bf2f(S[i * SST + 128 + ch]) * __expf(-cum)); } }
        __syncthreads();
        for (int idx = tid; idx < 1024; idx += 512) { const int d8 = idx & 3, i = (idx >> 2) & 63, h = idx >> 8;
            *(v4u*)((bf16*)(a.ws + B_GQ) + ((size_t)(blk0 + h) * 64 + i) * 32 + 8 * d8) = *(const LAS v4u*)(S + i * SST + h * 32 + 8 * d8);
            *(v4u*)((bf16*)(a.ws + B_GK) + ((size_t)(blk0 + h) * 64 + i) * 32 + 8 * d8) = *(const LAS v4u*)(S + i * SST + 128 + h * 32 + 8 * d8); }
        for (int idx = tid; idx < 1024; idx += 512) { const int d = idx & 31, h = (idx >> 5) & 3, s8 = idx >> 7;
            *(v4u*)((bf16*)(dout + O_GKT) + ((size_t)(blk0 + h) * 32 + d) * 64 + 8 * s8) = gather8(S, SST, 8 * s8, 128 + h * 32 + d); }
        for (int idx = tid; idx < 2048; idx += 512) { const int e = idx & 63, h = (idx >> 6) & 3, s8 = idx >> 8;
            *(v4u*)((bf16*)(a.ws + B_GV) + ((size_t)(blk0 + h) * 64 + e) * 64 + 8 * s8) = gather8(S, SST, 8 * s8, 256 + h * 64 + e); }
    } else if (part == 1) {
        constexpr int SST = 776;
        stage_cols(proj, b, c, C_RQ, 256, S, SST, 0, tid); stage_cols(proj, b, c, C_RK, 256, S, SST, 256, tid); stage_cols(proj, b, c, C_RV, 256, S, SST, 512, tid);
        __syncthreads();
        const f32x2* tabR = (const f32x2*)(a.ws + WS_TABR);
        for (int idx = tid; idx < 64 * 4 * 32; idx += 512) { const int j = idx & 31, h = (idx >> 5) & 3, i = idx >> 7; const f32x2 cs = tabR[(64 * c + i) * 32 + j];
            LAS bf16* qp = S + i * SST + h * 64 + j; LAS bf16* kp = qp + 256;
            const float a1 = bf2f(qp[0]), a2 = bf2f(qp[32]), b1 = bf2f(kp[0]), b2 = bf2f(kp[32]);
            const float e = (float)(i + 1) * lg2gamma(h); const float fq = __builtin_amdgcn_exp2f(e), fk = 0.125f * __builtin_amdgcn_exp2f(-e);
            qp[0] = (bf16)f2bf((a1 * cs[0] - a2 * cs[1]) * fq); qp[32] = (bf16)f2bf((a1 * cs[1] + a2 * cs[0]) * fq); kp[0] = (bf16)f2bf((b1 * cs[0] - b2 * cs[1]) * fk); kp[32] = (bf16)f2bf((b1 * cs[1] + b2 * cs[0]) * fk); }
        __syncthreads();
        for (int idx = tid; idx < 2048; idx += 512) { const int d8 = idx & 7, i = (idx >> 3) & 63, h = idx >> 9;
            *(v4u*)((bf16*)(a.ws + B_RQ) + ((size_t)(blk0 + h) * 64 + i) * 64 + 8 * d8) = *(const LAS v4u*)(S + i * SST + h * 64 + 8 * d8);
            *(v4u*)((bf16*)(a.ws + B_RK) + ((size_t)(blk0 + h) * 64 + i) * 64 + 8 * d8) = *(const LAS v4u*)(S + i * SST + 256 + h * 64 + 8 * d8); }
        for (int idx = tid; idx < 2048; idx += 512) { const int d = idx & 63, h = (idx >> 6) & 3, s8 = idx >> 8;
            *(v4u*)((bf16*)(dout + O_RKT) + ((size_t)(blk0 + h) * 64 + d) * 64 + 8 * s8) = gather8(S, SST, 8 * s8, 256 + h * 64 + d);
            *(v4u*)((bf16*)(a.ws + B_RV) + ((size_t)(blk0 + h) * 64 + d) * 64 + 8 * s8) = gather8(S, SST, 8 * s8, 512 + h * 64 + d); }
    } else if (part == 2) {
        constexpr int SST = 680; LAS float* rsd = (LAS float*)(lds + 64 * SST * 2);
        stage_cols(proj, b, c, C_CQ, 192, S, SST, 0, tid); stage_cols(proj, b, c, C_CKV, 64, S, SST, 192, tid); stage_cols(proj, b, c, C_KPE, 32, S, SST, 256, tid); stage_cols(proj, b, c, C_QEFF, 384, S, SST, 288, tid);
        __syncthreads();
        { const int i = tid >> 3, g = tid & 7; float sq = 0.f, sk = 0.f;
#pragma unroll
            for (int t = 0; t < 24; ++t) { const float v = bf2f(S[i * SST + g * 24 + t]); sq += v * v; }
#pragma unroll
            for (int t = 0; t < 8; ++t) { const float v = bf2f(S[i * SST + 192 + g * 8 + t]); sk += v * v; }
            sq += __shfl_xor(sq, 1); sq += __shfl_xor(sq, 2); sq += __shfl_xor(sq, 4); sk += __shfl_xor(sk, 1); sk += __shfl_xor(sk, 2); sk += __shfl_xor(sk, 4);
            if (g == 0) { rsd[i * 2] = __builtin_amdgcn_rsqf(sq * (1.f / 192.f) + EPS); rsd[i * 2 + 1] = __builtin_amdgcn_rsqf(sk * (1.f / 64.f) + EPS); } }
        __syncthreads();
        const f32x2* tabM = (const f32x2*)(a.ws + WS_TABM); const float QS = 0.10206207261596577f * LOG2E;
        for (int idx = tid; idx < 64 * 48; idx += 512) { const int c8 = idx % 48, i = idx / 48, hh = c8 / 12, k8 = c8 % 12; const float s = rsd[i * 2] * QS; const LAS bf16* qe = S + i * SST + 288 + hh * 96; float y[8];
            if (k8 < 8) {
#pragma unroll
                for (int t = 0; t < 8; ++t) y[t] = bf2f(qe[8 * k8 + t]) * s; }
            else { const int kk = (k8 - 8) & 1, second = (k8 - 8) >> 1;
#pragma unroll
                for (int t = 0; t < 8; ++t) { const int j = 8 * kk + t; const f32x2 cs = tabM[(64 * c + i) * 16 + j]; const float x1 = bf2f(qe[64 + j]) * s, x2 = bf2f(qe[80 + j]) * s; y[t] = second ? x1 * cs[1] + x2 * cs[0] : x1 * cs[0] - x2 * cs[1]; } }
            v4u w; w.x = pk2(y[0], y[1]); w.y = pk2(y[2], y[3]); w.z = pk2(y[4], y[5]); w.w = pk2(y[6], y[7]);
            *(v4u*)((bf16*)(a.ws + B_MQ) + (prow0 + i) * 384 + hh * 96 + 8 * k8) = w; }
        for (int idx = tid; idx < 64 * 12; idx += 512) { const int k8 = idx % 12, i = idx / 12; float y[8];
            if (k8 < 8) { const float s = rsd[i * 2 + 1];
#pragma unroll
                for (int t = 0; t < 8; ++t) y[t] = bf2f(S[i * SST + 192 + 8 * k8 + t]) * s; }
            else { const int kk = (k8 - 8) & 1, second = (k8 - 8) >> 1;
#pragma unroll
                for (int t = 0; t < 8; ++t) { const int j = 8 * kk + t; const f32x2 cs = tabM[(64 * c + i) * 16 + j]; const float x1 = bf2f(S[i * SST + 256 + j]), x2 = bf2f(S[i * SST + 272 + j]); y[t] = second ? x1 * cs[1] + x2 * cs[0] : x1 * cs[0] - x2 * cs[1]; } }
            v4u w; w.x = pk2(y[0], y[1]); w.y = pk2(y[2], y[3]); w.z = pk2(y[4], y[5]); w.w = pk2(y[6], y[7]);
            *(v4u*)((bf16*)(a.ws + B_MK) + (prow0 + i) * 96 + 8 * k8) = w; }
        __syncthreads();
        for (int idx = tid; idx < 512; idx += 512) { const int e = idx & 63, s8 = idx >> 6; unsigned x[8];
#pragma unroll
            for (int t = 0; t < 8; ++t) x[t] = f2bf(bf2f(S[(8 * s8 + t) * SST + 192 + e]) * rsd[(8 * s8 + t) * 2 + 1]);
            v4u w; w.x = x[0] | (x[1] << 16); w.y = x[2] | (x[3] << 16); w.z = x[4] | (x[5] << 16); w.w = x[6] | (x[7] << 16);
            *(v4u*)((bf16*)(dout + O_MVT) + ((size_t)(b * NCH + c) * 64 + e) * 64 + 8 * s8) = w; }
    } else {
        constexpr int SST = 264;
        stage_cols(proj, b, c, C_DV, 256, S, SST, 0, tid);
        for (int idx = tid; idx < 64 * 32; idx += 512) { const int i = idx >> 5, ch8 = idx & 31, sr = src_row(b, c, i);
            v4u dq = {0u, 0u, 0u, 0u}, dk = dq;
            if (sr >= 0) { const bf16* pr = proj + (size_t)sr * N1; dq = *(const v4u*)(pr + C_DQ + ch8 * 8); dk = *(const v4u*)(pr + C_DK + ch8 * 8);
                const float qs = 0.17677669529663687f * LOG2E;
                dq.x = pk2(bflo(dq.x) * qs, bfhi(dq.x) * qs); dq.y = pk2(bflo(dq.y) * qs, bfhi(dq.y) * qs); dq.z = pk2(bflo(dq.z) * qs, bfhi(dq.z) * qs); dq.w = pk2(bflo(dq.w) * qs, bfhi(dq.w) * qs); }
            *(v4u*)((bf16*)(a.ws + B_DQ) + (prow0 + i) * 256 + ch8 * 8) = dq;
            *(v4u*)((bf16*)(a.ws + B_DK) + (prow0 + i) * 256 + ch8 * 8) = dk; }
        __syncthreads();
        for (int idx = tid; idx < 2048; idx += 512) { const int e = idx & 63, h = (idx >> 6) & 3, s8 = idx >> 8;
            *(v4u*)((bf16*)(dout + O_DVT) + ((size_t)(blk0 + h) * 64 + e) * 64 + 8 * s8) = gather8(S, SST, 8 * s8, h * 64 + e); }
    }
}

typedef float f32x16 __attribute__((ext_vector_type(16)));
typedef short s16x8 __attribute__((ext_vector_type(8)));
typedef short s16x4 __attribute__((ext_vector_type(4)));
__device__ __forceinline__ int crow(int r, int hi) { return (r & 3) + 8 * (r >> 2) + 4 * hi; }

template <int KIND>
__device__ __forceinline__ void attn_mfma_unit(const Args& a, int li, int b, int hh, int qb  , LAS unsigned char* lds, int tid, float lam, float oscale) {
    constexpr int KW = KIND ? 64 : 96, KST = KW + 8, VST = 72, NMAP = KIND ? 2 : 1, DSTEPS = KIND ? 2 : 6, CPR = KW / 8;
    constexpr int KBUF = 64 * KST * 2, VBUF = 64 * VST * 2, OFF_V = 2 * KBUF, OFF_WS = OFF_V + 2 * VBUF, OFF_OST = OFF_WS + 8 * 256, OSTW = 68;
    const int lane = tid & 63, w = __builtin_amdgcn_readfirstlane(tid >> 6), r32 = lane & 31, hi = lane >> 5;
    const int q0 = qb < 0 ? 0 : 64 + 256 * qb, NT = qb < 0 ? 1 : 5 + 4 * qb;
    const bool wact = qb >= 0 || w < 2;
    const int qpos = q0 + 32 * w + r32, wlast = (q0 + 32 * w + 31) >> 6;
    const size_t prow = (size_t)b * PSEQ + qpos;
    const bf16* Kg = KIND ? (const bf16*)(a.ws + B_DK) + (size_t)b * PSEQ * 256 + hh * 64 : (const bf16*)(a.ws + B_MK) + (size_t)b * PSEQ * 96;
    constexpr int KLD = KIND ? 256 : 96;
    const bf16* VTg = KIND ? (const bf16*)((const unsigned char*)a.out + O_DVT) + ((size_t)b * NCH * 4 + hh) * 4096 : (const bf16*)((const unsigned char*)a.out + O_MVT) + (size_t)b * NCH * 4096;
    constexpr int VTT = KIND ? 4 * 4096 : 4096;
    LAS float* wsf = (LAS float*)(lds + OFF_WS) + w * 64;
    LAS float* ost = (LAS float*)(lds + OFF_OST) + w * (32 * OSTW);
    s16x8 qf[NMAP][DSTEPS];
#pragma unroll
    for (int m = 0; m < NMAP; ++m)
#pragma unroll
        for (int ds = 0; ds < DSTEPS; ++ds) {
            const bf16* qp = KIND ? (const bf16*)(a.ws + B_DQ) + prow * 256 + hh * 64 + 32 * m + 16 * ds + 8 * hi : (const bf16*)(a.ws + B_MQ) + prow * 384 + hh * 96 + 16 * ds + 8 * hi;
            qf[m][ds] = wact ? *(const s16x8*)qp : (s16x8){0, 0, 0, 0, 0, 0, 0, 0}; }
    float mrun[NMAP], lrun[NMAP]; f32x16 o[NMAP][2];
#pragma unroll
    for (int m = 0; m < NMAP; ++m) { mrun[m] = -1e30f; lrun[m] = 0.f; o[m][0] = (f32x16){}; o[m][1] = (f32x16){}; }
    const int kc0 = tid, kc1 = tid + 512; const bool has1 = (CPR == 12) && kc1 < 64 * CPR;
    const int kr0 = kc0 / CPR, kh0 = kc0 % CPR, kr1 = kc1 / CPR, kh1 = kc1 % CPR, ve = tid >> 3, vh = tid & 7;
    v4u rk0, rk1 = {0u, 0u, 0u, 0u}, rv;
#define ATT_LOAD(t) do { rk0 = *(const v4u*)(Kg + (size_t)(64 * (t) + kr0) * KLD + kh0 * 8); if (has1) rk1 = *(const v4u*)(Kg + (size_t)(64 * (t) + kr1) * KLD + kh1 * 8); \
        rv = *(const v4u*)(VTg + (size_t)(t) * VTT + ve * 64 + vh * 8); } while (0)
#define ATT_STORE(bufi) do { *(LAS v4u*)(lds + (bufi) * KBUF + (kr0 * KST + kh0 * 8) * 2) = rk0; if (has1) *(LAS v4u*)(lds + (bufi) * KBUF + (kr1 * KST + kh1 * 8) * 2) = rk1; \
        *(LAS v4u*)(lds + OFF_V + (bufi) * VBUF + (ve * VST + vh * 8) * 2) = rv; } while (0)
    __syncthreads();
    ATT_LOAD(0); ATT_STORE(0);
    __syncthreads();
    for (int t = 0; t < NT; ++t) {
        const int bi = t & 1;
        if (t + 1 < NT) ATT_LOAD(t + 1);
        if (wact && t <= wlast) {
            const LAS unsigned char* Kb = lds + bi * KBUF; const LAS unsigned char* Vb = lds + OFF_V + bi * VBUF;
            const bool need_mask = (t == 0) || (64 * t + 63 > q0 + 32 * w);
#pragma unroll
            for (int m = 0; m < NMAP; ++m) {
                f32x16 p0 = (f32x16){}, p1 = (f32x16){};
#pragma unroll
                for (int ds = 0; ds < DSTEPS; ++ds) {
                    const s16x8 k0 = *(const LAS s16x8*)(Kb + (r32 * KST + 32 * m * KIND + 16 * ds + 8 * hi) * 2);
                    const s16x8 k1 = *(const LAS s16x8*)(Kb + ((32 + r32) * KST + 32 * m * KIND + 16 * ds + 8 * hi) * 2);
                    p0 = __builtin_amdgcn_mfma_f32_32x32x16_bf16(k0, qf[m][ds], p0, 0, 0, 0);
                    p1 = __builtin_amdgcn_mfma_f32_32x32x16_bf16(k1, qf[m][ds], p1, 0, 0, 0); }
                asm volatile("s_nop 15\n\ts_nop 7" : "+v"(p0), "+v"(p1));
                if (need_mask) {
#pragma unroll
                    for (int r = 0; r < 16; ++r) { const int kv = 64 * t + crow(r, hi);
                        if (kv > qpos || kv < 48) p0[r] = -1e30f;
                        if (kv + 32 > qpos || kv + 32 < 48) p1[r] = -1e30f; } }
                float mx = fmaxf(p0[0], p1[0]);
#pragma unroll
                for (int r = 1; r < 16; ++r) mx = fmaxf(mx, fmaxf(p0[r], p1[r]));
                mx = fmaxf(mx, __shfl_xor(mx, 32));
                const float mn = fmaxf(mrun[m], mx), alpha = __builtin_amdgcn_exp2f(mrun[m] - mn); mrun[m] = mn;
                float ls = 0.f;
#pragma unroll
                for (int r = 0; r < 16; ++r) { p0[r] = __builtin_amdgcn_exp2f(p0[r] - mn); p1[r] = __builtin_amdgcn_exp2f(p1[r] - mn); ls += p0[r] + p1[r]; }
                lrun[m] = lrun[m] * alpha + ls;
                if (hi == 0) wsf[r32] = alpha;
                f32x4 al[4];
#pragma unroll
                for (int g = 0; g < 4; ++g) al[g] = *(const LAS f32x4*)(wsf + 8 * g + 4 * hi);
#pragma unroll
                for (int r = 0; r < 16; ++r) { o[m][0][r] *= al[r >> 2][r & 3]; o[m][1][r] *= al[r >> 2][r & 3]; }
                s16x8 pw[4];
#pragma unroll
                for (int ks = 0; ks < 4; ++ks) { v4u u;
                    if (ks < 2) { u.x = pg8::cvt_pk_bf16(p0[8 * ks], p0[8 * ks + 1]); u.y = pg8::cvt_pk_bf16(p0[8 * ks + 2], p0[8 * ks + 3]); u.z = pg8::cvt_pk_bf16(p0[8 * ks + 4], p0[8 * ks + 5]); u.w = pg8::cvt_pk_bf16(p0[8 * ks + 6], p0[8 * ks + 7]); }
                    else { const int k2 = ks - 2; u.x = pg8::cvt_pk_bf16(p1[8 * k2], p1[8 * k2 + 1]); u.y = pg8::cvt_pk_bf16(p1[8 * k2 + 2], p1[8 * k2 + 3]); u.z = pg8::cvt_pk_bf16(p1[8 * k2 + 4], p1[8 * k2 + 5]); u.w = pg8::cvt_pk_bf16(p1[8 * k2 + 6], p1[8 * k2 + 7]); }
                    pw[ks] = __builtin_bit_cast(s16x8, u); }
#pragma unroll
                for (int d0 = 0; d0 < 2; ++d0)
#pragma unroll
                    for (int ks = 0; ks < 4; ++ks) { const LAS unsigned char* vp = Vb + ((32 * d0 + r32) * VST + 16 * ks + 4 * hi) * 2;
                        const s16x4 va = *(const LAS s16x4*)vp, vb = *(const LAS s16x4*)(vp + 16);
                        const s16x8 vf = {va[0], va[1], va[2], va[3], vb[0], vb[1], vb[2], vb[3]};
                        o[m][d0] = __builtin_amdgcn_mfma_f32_32x32x16_bf16(pw[ks], vf, o[m][d0], 0, 0, 0); }
            }
        }
        if (t + 1 < NT) ATT_STORE(bi ^ 1);
        __syncthreads();
    }
#undef ATT_LOAD
#undef ATT_STORE
    if (wact) {
#pragma unroll
        for (int m = 0; m < NMAP; ++m) asm volatile("s_nop 15\n\ts_nop 7" : "+v"(o[m][0]), "+v"(o[m][1]));
        float il0, il1 = 0.f;
        { float l = lrun[0]; l += __shfl_xor(l, 32); il0 = l > 0.f ? 1.f / l : 0.f; }
        if (KIND) { float l = lrun[NMAP - 1]; l += __shfl_xor(l, 32); il1 = l > 0.f ? lam / l : 0.f; }
        if (hi == 0) { wsf[r32] = il0; wsf[32 + r32] = il1; }
        f32x4 a0[4], a1[4];
#pragma unroll
        for (int g = 0; g < 4; ++g) { a0[g] = *(const LAS f32x4*)(wsf + 8 * g + 4 * hi); a1[g] = *(const LAS f32x4*)(wsf + 32 + 8 * g + 4 * hi); }
#pragma unroll
        for (int d0 = 0; d0 < 2; ++d0)
#pragma unroll
            for (int r = 0; r < 16; ++r) { float v = o[0][d0][r] * a0[r >> 2][r & 3]; if (KIND) v -= o[NMAP - 1][d0][r] * a1[r >> 2][r & 3];
                ost[crow(r, hi) * OSTW + 32 * d0 + r32] = v; }
        const int row = lane >> 1, half = lane & 1, p = q0 + 32 * w + row;
        f32x4 v[8]; float ss = 0.f;
#pragma unroll
        for (int i = 0; i < 8; ++i) { v[i] = *(const LAS f32x4*)(ost + row * OSTW + 32 * half + 4 * i); ss += (v[i][0] * v[i][0] + v[i][1] * v[i][1]) + (v[i][2] * v[i][2] + v[i][3] * v[i][3]); }
        ss += __shfl_xor(ss, 1);
        const float rs = KIND ? __builtin_amdgcn_rsqf(ss * (1.f / 64.f) + EPS) * oscale : 1.f;
        const int sr = qb >= 0 ? b * TT + p - 64 : ((p >= 48 && b == 0) ? MR + p - 48 : -1);
        if (sr >= 0) { bf16* dst = (bf16*)a.out + (size_t)sr * DM + (KIND ? 768 : 512) + hh * 64 + 32 * half; const float* gn = a.in[I_DNORM] + li * 64 + 32 * half;
#pragma unroll
            for (int i = 0; i < 4; ++i) { f32x4 x0 = v[2 * i] * rs, x1 = v[2 * i + 1] * rs;
                if (KIND) { const f32x4 g0 = *(const f32x4*)(gn + 8 * i), g1 = *(const f32x4*)(gn + 8 * i + 4); x0 = x0 * g0; x1 = x1 * g1; }
                *(v4u*)(dst + 8 * i) = pack8(x0, x1); } }
    }
    __syncthreads();
}

__device__ __forceinline__ s16x8 ldperm(const bf16* p, int hi) { const s16x4 x = *(const s16x4*)(p + 4 * hi), y = *(const s16x4*)(p + 8 + 4 * hi); return (s16x8){x[0], x[1], x[2], x[3], y[0], y[1], y[2], y[3]}; }
__device__ __forceinline__ s16x8 packacc(const f32x16& v, int k) { v4u u; u.x = pg8::cvt_pk_bf16(v[8 * k], v[8 * k + 1]); u.y = pg8::cvt_pk_bf16(v[8 * k + 2], v[8 * k + 3]); u.z = pg8::cvt_pk_bf16(v[8 * k + 4], v[8 * k + 5]); u.w = pg8::cvt_pk_bf16(v[8 * k + 6], v[8 * k + 7]); return __builtin_bit_cast(s16x8, u); }
template <int KIND>
__device__ __forceinline__ void lin_mfma_unit(const Args& a, int li, int b, LAS unsigned char* lds, int tid) {
    constexpr int DK = KIND ? 64 : 32, NDS = DK / 16, NDB = DK / 32, OTW = 68;
    const int lane = tid & 63, w = __builtin_amdgcn_readfirstlane(tid >> 6), r32 = lane & 31, hi = lane >> 5, h = w >> 1, e0 = 32 * (w & 1);
    const bf16* Qb = (const bf16*)(a.ws + (KIND ? B_RQ : B_GQ)); const bf16* Kb = (const bf16*)(a.ws + (KIND ? B_RK : B_GK));
    const bf16* KTb = (const bf16*)((const unsigned char*)a.out + (KIND ? O_RKT : O_GKT)); const bf16* VTb = (const bf16*)(a.ws + (KIND ? B_RV : B_GV));
    const float* gain = a.in[KIND ? I_RNORM : I_GNORM] + li * 64; const bf16* proj = (const bf16*)(a.ws + B_PROJ); bf16* ob = (bf16*)a.out;
    LAS float* Ot = (LAS float*)lds;
    const float dret = __builtin_amdgcn_exp2f(64.f * lg2gamma(h));
    f32x16 S[NDB];
#pragma unroll
    for (int db = 0; db < NDB; ++db) S[db] = (f32x16){};
    __syncthreads();
    for (int c = 0; c < NCH; ++c) {
        const size_t blk = (size_t)(b * NCH + c) * 4 + h;
        const bf16* q = Qb + blk * 64 * DK; const bf16* k = Kb + blk * 64 * DK; const bf16* kT = KTb + blk * DK * 64; const bf16* vT = VTb + blk * 4096;
        s16x8 qf[2][NDS], kf[2][NDS], vf[4];
#pragma unroll
        for (int ib = 0; ib < 2; ++ib)
#pragma unroll
            for (int ds = 0; ds < NDS; ++ds) { qf[ib][ds] = ldperm(q + (32 * ib + r32) * DK + 16 * ds, hi); kf[ib][ds] = ldperm(k + (32 * ib + r32) * DK + 16 * ds, hi); }
#pragma unroll
        for (int ks = 0; ks < 4; ++ks) vf[ks] = ldperm(vT + (e0 + r32) * 64 + 16 * ks, hi);
        f32x16 a00 = (f32x16){}, a01 = (f32x16){}, a11 = (f32x16){};
#pragma unroll
        for (int ds = 0; ds < NDS; ++ds) { a00 = __builtin_amdgcn_mfma_f32_32x32x16_bf16(kf[0][ds], qf[0][ds], a00, 0, 0, 0); a01 = __builtin_amdgcn_mfma_f32_32x32x16_bf16(kf[0][ds], qf[1][ds], a01, 0, 0, 0);
            a11 = __builtin_amdgcn_mfma_f32_32x32x16_bf16(kf[1][ds], qf[1][ds], a11, 0, 0, 0); }
        asm volatile("s_nop 15\n\ts_nop 15" : "+v"(a00), "+v"(a01), "+v"(a11));
#pragma unroll
        for (int r = 0; r < 16; ++r) if (crow(r, hi) > r32) { a00[r] = 0.f; a11[r] = 0.f; }
        f32x16 O[2]; O[0] = (f32x16){}; O[1] = (f32x16){};
#pragma unroll
        for (int db = 0; db < NDB; ++db)
#pragma unroll
            for (int ksub = 0; ksub < 2; ++ksub) { const s16x8 sb = packacc(S[db], ksub);
                O[0] = __builtin_amdgcn_mfma_f32_32x32x16_bf16(qf[0][2 * db + ksub], sb, O[0], 0, 0, 0); O[1] = __builtin_amdgcn_mfma_f32_32x32x16_bf16(qf[1][2 * db + ksub], sb, O[1], 0, 0, 0); }
#pragma unroll
        for (int ksub = 0; ksub < 2; ++ksub) { O[0] = __builtin_amdgcn_mfma_f32_32x32x16_bf16(packacc(a00, ksub), vf[ksub], O[0], 0, 0, 0);
            O[1] = __builtin_amdgcn_mfma_f32_32x32x16_bf16(packacc(a01, ksub), vf[ksub], O[1], 0, 0, 0); O[1] = __builtin_amdgcn_mfma_f32_32x32x16_bf16(packacc(a11, ksub), vf[2 + ksub], O[1], 0, 0, 0); }
#pragma unroll
        for (int db = 0; db < NDB; ++db) {
#pragma unroll
            for (int ks = 0; ks < 4; ++ks) S[db] = __builtin_amdgcn_mfma_f32_32x32x16_bf16(ldperm(kT + (32 * db + r32) * 64 + 16 * ks, hi), vf[ks], S[db], 0, 0, 0);
            if (KIND) { S[db] = S[db] * dret; }
            else { const float* dp = (const float*)(a.ws + WS_GD) + blk * 32;
#pragma unroll
                for (int g = 0; g < 4; ++g) { const f32x4 dv = *(const f32x4*)(dp + 8 * g + 4 * hi); S[db][4 * g] *= dv[0]; S[db][4 * g + 1] *= dv[1]; S[db][4 * g + 2] *= dv[2]; S[db][4 * g + 3] *= dv[3]; } } }
        asm volatile("s_nop 15\n\ts_nop 15" : "+v"(O[0]), "+v"(O[1]));
#pragma unroll
        for (int db = 0; db < NDB; ++db) asm volatile("s_nop 15\n\ts_nop 15" : "+v"(S[db]));
#pragma unroll
        for (int ib = 0; ib < 2; ++ib)
#pragma unroll
            for (int r = 0; r < 16; ++r) Ot[(h * 64 + 32 * ib + crow(r, hi)) * OTW + e0 + r32] = O[ib][r];
        __syncthreads();
        { const int row = 32 * (w & 1) + (lane >> 1), half = lane & 1, sr = src_row(b, c, row);
            f32x4 v[8]; float s1 = 0.f;
#pragma unroll
            for (int i = 0; i < 8; ++i) { v[i] = *(const LAS f32x4*)(Ot + (h * 64 + row) * OTW + 32 * half + 4 * i); s1 += (v[i][0] + v[i][1]) + (v[i][2] + v[i][3]); }
            float mean = 0.f; if (KIND) { s1 += __shfl_xor(s1, 1); mean = s1 * (1.f / 64.f); }
            float s2 = 0.f;
#pragma unroll
            for (int i = 0; i < 8; ++i) { v[i] = v[i] - mean; s2 += (v[i][0] * v[i][0] + v[i][1] * v[i][1]) + (v[i][2] * v[i][2] + v[i][3] * v[i][3]); }
            s2 += __shfl_xor(s2, 1);
            const float rs = __builtin_amdgcn_rsqf(s2 * (1.f / 64.f) + EPS);
            if (sr >= 0 && (c > 0 || b == 0)) { const bf16* ogp = proj + (size_t)sr * N1 + (KIND ? C_ROG : C_AOG) + h * 64 + 32 * half; bf16* dst = ob + (size_t)sr * DM + KIND * 256 + h * 64 + 32 * half; const float* gp = gain + 32 * half;
#pragma unroll
                for (int i = 0; i < 4; ++i) { const v4u og = *(const v4u*)(ogp + 8 * i); const f32x4 g0 = *(const f32x4*)(gp + 8 * i), g1 = *(const f32x4*)(gp + 8 * i + 4);
                    f32x4 x0 = v[2 * i] * rs * g0, x1 = v[2 * i + 1] * rs * g1;
                    x0[0] *= silu_f(bflo(og.x)); x0[1] *= silu_f(bfhi(og.x)); x0[2] *= silu_f(bflo(og.y)); x0[3] *= silu_f(bfhi(og.y)); x1[0] *= silu_f(bflo(og.z)); x1[1] *= silu_f(bfhi(og.z)); x1[2] *= silu_f(bflo(og.w)); x1[3] *= silu_f(bfhi(og.w));
                    *(v4u*)(dst + 8 * i) = pack8(x0, x1); } } }
        __syncthreads();
    }
}

template <int MODE, int KSTEPS  >
__device__ __forceinline__ void thin_unit(const bf16* A, int lda, const bf16* Bt, int u, bf16* H, float* stats_out, const float* stats_in, bf16* ACT, LAS unsigned char* lds, int tid) {
    constexpr int K = KSTEPS * 256;
    const int lane = tid & 63, w = __builtin_amdgcn_readfirstlane(tid >> 6), fr = lane & 15, fq = lane >> 4;
    int brow[4];
#pragma unroll
    for (int nb = 0; nb < 4; ++nb) brow[nb] = MODE == 0 ? 64 * u + 16 * nb + fr : 256 * (u >> 2) + 32 * (u & 3) + (nb >> 1) * 128 + 16 * (nb & 1) + fr;
    f32x4 acc[4];
#pragma unroll
    for (int nb = 0; nb < 4; ++nb) acc[nb] = (f32x4){0.f, 0.f, 0.f, 0.f};
    const bf16* ap = A + (size_t)fr * lda + w * (KSTEPS * 32) + 8 * fq;
    constexpr int B1 = KSTEPS > 6 ? 6 : KSTEPS;
    { s16x8 af[B1], bf[B1][4];
#pragma unroll
        for (int s = 0; s < B1; ++s) { af[s] = *(const s16x8*)(ap + 32 * s);
#pragma unroll
            for (int nb = 0; nb < 4; ++nb) bf[s][nb] = *(const s16x8*)(Bt + (size_t)brow[nb] * K + w * (KSTEPS * 32) + 32 * s + 8 * fq); }
#pragma unroll
        for (int s = 0; s < B1; ++s)
#pragma unroll
            for (int nb = 0; nb < 4; ++nb) acc[nb] = __builtin_amdgcn_mfma_f32_16x16x32_bf16(bf[s][nb], af[s], acc[nb], 0, 0, 0); }
    if (KSTEPS > B1) { constexpr int B2 = KSTEPS > B1 ? KSTEPS - B1 : 1; s16x8 af[B2], bf[B2][4];
#pragma unroll
        for (int s = 0; s < B2; ++s) { af[s] = *(const s16x8*)(ap + 32 * (B1 + s));
#pragma unroll
            for (int nb = 0; nb < 4; ++nb) bf[s][nb] = *(const s16x8*)(Bt + (size_t)brow[nb] * K + w * (KSTEPS * 32) + 32 * (B1 + s) + 8 * fq); }
#pragma unroll
        for (int s = 0; s < B2; ++s)
#pragma unroll
            for (int nb = 0; nb < 4; ++nb) acc[nb] = __builtin_amdgcn_mfma_f32_16x16x32_bf16(bf[s][nb], af[s], acc[nb], 0, 0, 0); }
    asm volatile("s_nop 15" : "+v"(acc[0]), "+v"(acc[1]), "+v"(acc[2]), "+v"(acc[3]));
    LAS f32x4* part = (LAS f32x4*)lds;
    __syncthreads();
#pragma unroll
    for (int nb = 0; nb < 4; ++nb) part[(w * 4 + nb) * 64 + lane] = acc[nb];
    __syncthreads();
    if (w == 0) {
#pragma unroll
        for (int nb = 0; nb < 4; ++nb) {
#pragma unroll
            for (int w2 = 1; w2 < 8; ++w2) acc[nb] = acc[nb] + part[(w2 * 4 + nb) * 64 + lane]; }
        const int row = MR + fr;
        if (MODE == 0) { float ss = 0.f;
#pragma unroll
            for (int nb = 0; nb < 4; ++nb) { bf16* p = H + (size_t)row * DM + 64 * u + 16 * nb + 4 * fq; const v2u wv = *(const v2u*)p;
                const float x0 = acc[nb][0] + bflo(wv.x), x1 = acc[nb][1] + bfhi(wv.x), x2 = acc[nb][2] + bflo(wv.y), x3 = acc[nb][3] + bfhi(wv.y);
                ss += (x0 * x0 + x1 * x1) + (x2 * x2 + x3 * x3);
                v2u o; o.x = pg8::cvt_pk_bf16(x0, x1); o.y = pg8::cvt_pk_bf16(x2, x3); *(v2u*)p = o; }
            ss += __shfl_xor(ss, 16); ss += __shfl_xor(ss, 32);
            if (fq == 0) stats_out[(size_t)row * 16 + u] = ss;
        } else { const f32x4* sp = (const f32x4*)(stats_in + (size_t)row * 16); const f32x4 s0 = sp[0], s1 = sp[1], s2 = sp[2], s3 = sp[3];
            const float st = ((s0[0] + s0[1]) + (s0[2] + s0[3])) + ((s1[0] + s1[1]) + (s1[2] + s1[3])) + ((s2[0] + s2[1]) + (s2[2] + s2[3])) + ((s3[0] + s3[1]) + (s3[2] + s3[3]));
            const float rs = __builtin_amdgcn_rsqf(st * (1.f / 1024.f) + EPS);
#pragma unroll
            for (int nb = 0; nb < 2; ++nb) { float y[4];
#pragma unroll
                for (int t = 0; t < 4; ++t) y[t] = silu_f(acc[nb][t] * rs) * (acc[2 + nb][t] * rs);
                v2u o; o.x = pg8::cvt_pk_bf16(y[0], y[1]); o.y = pg8::cvt_pk_bf16(y[2], y[3]);
                *(v2u*)(ACT + (size_t)row * DFF + 128 * (u >> 2) + 32 * (u & 3) + 16 * nb + 4 * fq) = o; } }
    }
    __syncthreads();
}

#ifndef REP_PREP
#define REP_PREP 1
#endif
#ifndef REP_MIX
#define REP_MIX 1
#endif
#ifndef REP_P0
#define REP_P0 1
#endif
#ifndef REP_CONV
#define REP_CONV 1
#endif
#ifndef REP_G1
#define REP_G1 1
#endif
#ifndef MK_ONE_LAUNCH
#define MK_ONE_LAUNCH 1
#endif
constexpr int NPHASE = 20;
constexpr int CW_Q = 12288;
__global__ void __launch_bounds__(512, 2) mega_fwd(Args a) {
    extern __shared__ __attribute__((aligned(16))) unsigned char lds_raw[];
    LAS unsigned char* lds = (LAS unsigned char*)lds_raw;
    volatile LAS unsigned* MISC = (volatile LAS unsigned*)(lds + MISC_OFF);
    const int tid = threadIdx.x, lane = tid & 63, wave = __builtin_amdgcn_readfirstlane(tid >> 6), G = gridDim.x;
    for (int u = tid; u < (LDS_BYTES - RING_BYTES) / 4; u += 512) ((LAS unsigned*)(lds + RING_BYTES))[u] = 0u;
    __syncthreads();
    gu32* ctl = (gu32*)(a.ws + WS_CTL);
    const int lo = a.ph_lo, hi = a.ph_hi;
    XcdBarrier bar; bar.bar = (unsigned*)(ctl + CW_BAR); bar.x = 0; bar.st = nullptr;
    if (hi - lo > 1) bar = xcd_barrier_post((unsigned*)(ctl + CW_BAR), MISC + 8);
#define IN(k) (lo <= (k) && (k) < hi)
#define OPQ() int ptid = threadIdx.x; asm volatile("" : "+v"(ptid)); const int plane = ptid & 63; (void)plane
#define SEAM(k) do { if (IN(k) && IN((k) + 1)) xcd_barrier(bar); } while (0)
    bf16* hb = (bf16*)(a.ws + WS_HB); float* stA = (float*)(a.ws + WS_STA); float* stB = (float*)(a.ws + WS_STB);

    if (IN(0)) { OPQ(); for (int rep = 0; rep < REP_P0; ++rep) { p0_prologue(a, lds, ptid, plane, wave); __syncthreads(); } }
    SEAM(0);

    for (int li = 0; li < 2; ++li) {
        const int pb = 1 + 6 * li;
        if (IN(pb)) {
            pg8::Gemm g{hb, (const bf16*)(a.ws + WS_W1T + li * W1T_BYTES), DM, 0, nullptr}; pg8::StaticOrder S; S.init(NPAN, N1 / 256, G, (int)blockIdx.x);
            EpiProj E{(bf16*)(a.ws + B_PROJ), stA};
            for (int rep = 0; rep < REP_G1; ++rep) pg8::gemm_phase<EpiProj, pg8::StaticOrder, false>(lds, g, S, E);
        }
        SEAM(pb);
        if (IN(pb + 1)) { OPQ(); for (int rep = 0; rep < REP_PREP; ++rep) for (int u = blockIdx.x; u < NB * NCH * 4; u += G) { int ut = ptid; asm volatile("" : "+v"(ut)); prep2_unit(a, li, (u >> 2) / NCH, (u >> 2) % NCH, u & 3, lds, ut); } __syncthreads(); }
        SEAM(pb + 1);
        if (IN(pb + 2)) {
            OPQ(); const int tid = ptid;
            LAS int* qid = (LAS int*)(lds + RING_BYTES + 64);
            float lam, lam_init; { const float* lv = a.in[I_DLAM] + li * 128; float s01 = 0.f, s23 = 0.f;
                for (int d = 0; d < 32; ++d) { s01 += lv[d] * lv[32 + d]; s23 += lv[64 + d] * lv[96 + d]; }
                lam_init = 0.8f - 0.6f * __expf(-0.3f * (float)li); lam = __expf(s01) - __expf(s23) + lam_init; }
            for (int rep = 0; rep < REP_MIX; ++rep)
            for (;;) {
                __syncthreads();
                if (tid == 0) *qid = (int)__hip_atomic_fetch_add(ctl + CW_Q + 64 * (li + 2 * rep), 1u, RLX_AGENT);
                __syncthreads();
                const int id = *qid;
                int utid = ptid; asm volatile("" : "+v"(utid));
                if (id >= 32 + 1024 + 8) break;
                if (id < 32) { if ((id & 1) == 0) lin_mfma_unit<0>(a, li, id >> 1, lds, utid); else lin_mfma_unit<1>(a, li, id >> 1, lds, utid); }
                else { const int v = id - 32; int qb, kind, b, hh;
                    if (v < 1024) { qb = 7 - (v >> 7); const int rem = v & 127; kind = rem >> 6; b = (rem >> 2) & 15; hh = rem & 3; } else { qb = -1; kind = (v - 1024) >> 2; b = 0; hh = v & 3; }
                    if (kind == 0) attn_mfma_unit<0>(a, li, b, hh, qb, lds, utid, 0.f, 1.f); else attn_mfma_unit<1>(a, li, b, hh, qb, lds, utid, lam, 1.f - lam_init); }
            }
        }
        SEAM(pb + 2);
        if (IN(pb + 3)) {
            if (li == 0) { OPQ(); for (int u = blockIdx.x; u < 16; u += G) thin_unit<0, 4>((const bf16*)a.out + (size_t)MR * DM, DM, (const bf16*)(a.ws + WS_WOT), u, hb, stB, nullptr, nullptr, lds, ptid); }
            pg8::Gemm g{(const bf16*)a.out, (const bf16*)(a.ws + WS_WOT + li * WOT_BYTES), DM, 0, nullptr}; pg8::StaticOrder S; S.init(NPAN - 1, 4, G, (int)blockIdx.x);
            EpiResid E{hb, stB};
            pg8::gemm_phase<EpiResid, pg8::StaticOrder, false>(lds, g, S, E);
        }
        SEAM(pb + 3);
        if (li == 0) {
            if (IN(5)) {
                { OPQ(); for (int u = blockIdx.x; u < 88; u += G) thin_unit<1, 4>(hb + (size_t)MR * DM, DM, (const bf16*)(a.ws + WS_WGU), u, nullptr, nullptr, stB, (bf16*)(a.ws + B_ACT), lds, ptid); }
                pg8::Gemm g{hb, (const bf16*)(a.ws + WS_WGU), DM, 0, nullptr}; pg8::StaticOrder S; S.init(NPAN - 1, 2 * DFF / 256, G, (int)blockIdx.x);
                EpiSwiglu E{(bf16*)(a.ws + B_ACT), DFF, stB};
                pg8::gemm_phase<EpiSwiglu, pg8::StaticOrder, false>(lds, g, S, E);
            }
            SEAM(5);
            if (IN(6)) {
                { OPQ(); for (int u = blockIdx.x; u < 16; u += G) thin_unit<0, 11>((const bf16*)(a.ws + B_ACT) + (size_t)MR * DFF, DFF, (const bf16*)(a.ws + WS_WD), u, hb, stA, nullptr, nullptr, lds, ptid); }
                pg8::Gemm g{(const bf16*)(a.ws + B_ACT), (const bf16*)(a.ws + WS_WD), DFF, 0, nullptr}; pg8::StaticOrder S; S.init(NPAN - 1, 4, G, (int)blockIdx.x);
                EpiResid E{hb, stA};
                pg8::gemm_phase<EpiResid, pg8::StaticOrder, false>(lds, g, S, E);
            }
            SEAM(6);
        }
    }
    if (IN(11)) { OPQ(); const int tid = ptid, lane = plane;
        LAS float* scr = (LAS float*)(lds + wave * 16384);
        const int gw = blockIdx.x * 8 + wave, NGW = G * 8;
        constexpr int IG = 16 * 112, ID = 56 * 32;
        for (int rep = 0; rep < REP_CONV; ++rep)
        for (int it = gw; it < 8 * (2 * IG + ID); it += NGW) { const int e = it / (2 * IG + ID); int r = it % (2 * IG + ID);
            if (r < IG) { transpose_item(a.in[I_EG] + (size_t)e * DM * DFE, DM, DFE, a.in[I_FNORM] + DM, (bf16*)(a.ws + B_EGU + e * EGU_BYTES), r / 112, r % 112, 1, scr, lane); continue; } r -= IG;
            if (r < IG) { transpose_item(a.in[I_EU] + (size_t)e * DM * DFE, DM, DFE, a.in[I_FNORM] + DM, (bf16*)(a.ws + B_EGU + e * EGU_BYTES), r / 112, r % 112, 2, scr, lane); continue; } r -= IG;
            transpose_item(a.in[I_ED] + (size_t)e * DFE * DM, DFE, DM, nullptr, (bf16*)(a.ws + B_ED + e * ED_BYTES), r / 32, r % 32, 0, scr, lane); }
        for (int i = blockIdx.x * 512 + tid; i < MAXPAN * 256; i += G * 512) { ((int*)(a.ws + MO_ROWIDX))[i] = -1; ((int*)(a.ws + MO_PDST))[i] = -1; ((f32x2*)(a.ws + MO_PINFO))[i] = (f32x2){0.f, 0.f}; }
        for (int blk = blockIdx.x; blk < MR / 128; blk += G) route_block(a, blk, lds, tid, lane, wave);
    }
    SEAM(11);
    LAS int* offs = (LAS int*)(lds + RING_BYTES + 128);
    if (IN(12)) { OPQ(); const int tid = ptid;
        moe_offsets(a, offs, tid);
        for (int idx = blockIdx.x * 512 + tid; idx < 2 * MR; idx += G * 512) { const int tok = idx >> 1, e = ((const int*)(a.ws + MO_TOKE))[idx], gpos = offs[e] + ((const int*)(a.ws + MO_TOKP))[idx];
            const f32x4* sp = (const f32x4*)(stB + (size_t)tok * 16); const f32x4 s0 = sp[0], s1 = sp[1], s2 = sp[2], s3 = sp[3];
            const float ss = ((s0[0] + s0[1]) + (s0[2] + s0[3])) + ((s1[0] + s1[1]) + (s1[2] + s1[3])) + ((s2[0] + s2[1]) + (s2[2] + s2[3])) + ((s3[0] + s3[1]) + (s3[2] + s3[3]));
            ((int*)(a.ws + MO_ROWIDX))[gpos] = tok; ((int*)(a.ws + MO_PDST))[gpos] = idx;
            ((f32x2*)(a.ws + MO_PINFO))[gpos] = (f32x2){__builtin_amdgcn_rsqf(ss * (1.f / 1024.f) + EPS), __int_as_float(((const int*)(a.ws + MO_TOKW))[idx])}; }
        if (blockIdx.x == 0 && tid < MAXPAN + 8) { int e = 0;
            for (int k = 1; k < 8; ++k) if (tid * 256 >= offs[k]) e = k;
            ((int*)(a.ws + MO_PEXP))[tid] = e; }
    }
    SEAM(12);
    for (int ci = 0; ci < 3; ++ci) {
        if (IN(13 + 2 * ci) || IN(14 + 2 * ci)) moe_offsets(a, offs, tid);
        int nP = 0; if (IN(13 + 2 * ci) || IN(14 + 2 * ci)) { nP = __builtin_amdgcn_readfirstlane(offs[8]) - 128 * ci; nP = nP > 128 ? 128 : nP; }
        if (IN(13 + 2 * ci) && nP > 0) {
            pg8::Gemm g{hb, (const bf16*)(a.ws + B_EGU), DM, EGU_BYTES, (const int*)(a.ws + MO_ROWIDX)}; pg8::MoeOrder S; S.init(nP, 2 * DFE / 256, G, (int)blockIdx.x, 128 * ci, (const int*)(a.ws + MO_PEXP));
            EpiSwigluMoe E{(bf16*)(a.ws + B_EACT), (const f32x2*)(a.ws + MO_PINFO)};
            pg8::gemm_phase<EpiSwigluMoe, pg8::MoeOrder, true>(lds, g, S, E);
        }
        SEAM(13 + 2 * ci);
        if (IN(14 + 2 * ci) && nP > 0) {
            pg8::Gemm g{(const bf16*)(a.ws + B_EACT), (const bf16*)(a.ws + B_ED), DFE, ED_BYTES, nullptr}; pg8::MoeOrder S; S.init(nP, 4, G, (int)blockIdx.x, 128 * ci, (const int*)(a.ws + MO_PEXP));
            EpiMoeDown E{(unsigned char*)a.out, (const int*)(a.ws + MO_PDST), (const f32x2*)(a.ws + MO_PINFO)};
            pg8::gemm_phase<EpiMoeDown, pg8::MoeOrder, false>(lds, g, S, E);
        }
        SEAM(14 + 2 * ci);
    }
    if (IN(19)) { OPQ(); const int lane = plane;
        const float* fn = a.in[I_FINAL];
        for (int r = blockIdx.x * 8 + wave; r < MR; r += G * 8) {
            unsigned char* orow = (unsigned char*)a.out + (size_t)r * 4096; float v[16]; float ss = 0.f;
#pragma unroll
            for (int hf = 0; hf < 2; ++hf) { const int k = 512 * hf + 8 * lane; const v4u h4 = *(const v4u*)(hb + (size_t)r * DM + k), y0 = *(const v4u*)(orow + 2 * k), y1 = *(const v4u*)(orow + 2048 + 2 * k);
                const unsigned hw[4] = {h4.x, h4.y, h4.z, h4.w}, aw[4] = {y0.x, y0.y, y0.z, y0.w}, bw[4] = {y1.x, y1.y, y1.z, y1.w};
#pragma unroll
                for (int t = 0; t < 4; ++t) { const float x0 = bflo(hw[t]) + bflo(aw[t]) + bflo(bw[t]), x1 = bfhi(hw[t]) + bfhi(aw[t]) + bfhi(bw[t]); v[8 * hf + 2 * t] = x0; v[8 * hf + 2 * t + 1] = x1; ss += x0 * x0 + x1 * x1; } }
            ss = wave_sum(ss); const float rs = __builtin_amdgcn_rsqf(ss * (1.f / 1024.f) + EPS);
#pragma unroll
            for (int hf = 0; hf < 2; ++hf) { const int k = 512 * hf + 8 * lane; const f32x4 g0 = *(const f32x4*)(fn + k), g1 = *(const f32x4*)(fn + k + 4);
                *(f32x4*)(orow + 4 * k) = (f32x4){v[8 * hf] * rs * g0[0], v[8 * hf + 1] * rs * g0[1], v[8 * hf + 2] * rs * g0[2], v[8 * hf + 3] * rs * g0[3]};
                *(f32x4*)(orow + 4 * k + 16) = (f32x4){v[8 * hf + 4] * rs * g1[0], v[8 * hf + 5] * rs * g1[1], v[8 * hf + 6] * rs * g1[2], v[8 * hf + 7] * rs * g1[3]}; }
        }
    }
#undef IN
#undef SEAM
}

extern "C" void kernel_launch(void* const* d_in, const int* in_sizes, int n_in, void* d_out, int out_size, void* d_ws, size_t ws_size, hipStream_t stream) {
    static int grid = 0;
    if (grid == 0) {
        if (n_in != 24 || in_sizes[0] != MR * DM || out_size != MR * DM || ws_size < WS_NEED) { fprintf(stderr, "kernel_launch: unexpected problem (n_in %d, in0 %d, out %d, ws %zu < %zu)\n", n_in, n_in > 0 ? in_sizes[0] : -1, out_size, ws_size, (size_t)WS_NEED); grid = -1; return; }
        int dev = 0, cus = 0, per_cu = 0;
        if (hipGetDevice(&dev) != hipSuccess || hipDeviceGetAttribute(&cus, hipDeviceAttributeMultiprocessorCount, dev) != hipSuccess) { grid = -1; return; }
        if (hipFuncSetAttribute((const void*)mega_fwd, hipFuncAttributeMaxDynamicSharedMemorySize, LDS_BYTES) != hipSuccess) { fprintf(stderr, "kernel_launch: hipFuncSetAttribute failed\n"); grid = -1; return; }
        if (hipOccupancyMaxActiveBlocksPerMultiprocessor(&per_cu, (const void*)mega_fwd, 512, LDS_BYTES) != hipSuccess || per_cu < 1) fprintf(stderr, "kernel_launch: occupancy query reports %d\n", per_cu);
        (void)hipGetLastError();
        grid = cus;
    }
    if (grid < 0) return;
    if (hipMemsetAsync((char*)d_ws + WS_CTL, 0, CTL_BYTES, stream) != hipSuccess) return;
    Args a{};
    for (int i = 0; i < 24; ++i) a.in[i] = (const float*)d_in[i];
    a.out = (float*)d_out; a.ws = (unsigned char*)d_ws;
#if MK_ONE_LAUNCH
    a.ph_lo = 0; a.ph_hi = NPHASE;
    hipLaunchKernelGGL(mega_fwd, dim3(grid), dim3(512), LDS_BYTES, stream, a);
#else
    for (int p = 0; p < NPHASE; ++p) { a.ph_lo = p; a.ph_hi = p + 1; hipLaunchKernelGGL(mega_fwd, dim3(grid), dim3(512), LDS_BYTES, stream, a); }
#endif
}
```

```cpp
#include <hip/hip_runtime.h>
#include <cstdio>
#include <cstdint>

namespace pg8 {
#define PG8_LAS __attribute__((address_space(3)))
typedef unsigned short bf16_t;
typedef short bf16x8 __attribute__((ext_vector_type(8)));
typedef float f32x4 __attribute__((ext_vector_type(4)));
typedef unsigned u32x4 __attribute__((ext_vector_type(4)));
constexpr int BM = 256, BK = 64, HALF = 128, HTB = HALF * BK * 2  , STAGE_BYTES = 8 * HTB, NXCD = 8, WGM = 8;

__host__ __device__ __forceinline__ int lds_byte(int r, int c) { const int st = (r >> 4) * 2 + (c >> 5), rr = r & 15, cc = c & 31, ob = rr * 64 + cc * 2; return st * 1024 + (ob ^ (((ob >> 9) & 1) << 5)); }
__host__ __device__ __forceinline__ void stage_rc(int b, int& R, int& C) { const int st = b / 1024, sb = b % 1024, swz = sb ^ (((sb >> 9) & 1) << 5); R = (st >> 1) * 16 + swz / 64; C = (st & 1) * 32 + (swz % 64) / 2; }
__host__ __device__ __forceinline__ int perm32(int rho) { const int n = rho >> 4, i = rho & 15; return 8 * (i >> 2) + 4 * n + (i & 3); }

struct Unit { int pm, pn, e, gp; };
struct Gemm { const bf16_t* A; const bf16_t* Bt; int K; size_t estride  ; const int* rowidx  ; };

struct StaticOrder {
    int nM, nN, nwg, G, c;
    __device__ void init(int nM_, int nN_, int G_, int c_) { nM = nM_; nN = nN_; nwg = nM * nN; G = G_; c = c_; }
    __device__ __forceinline__ bool map(int i, int& pm, int& pn) const {
        const long L = (long)i * G + c; if (L >= nwg) return false;
        int wgid = (int)L; { const int q = nwg / NXCD, r = nwg % NXCD, xcd = wgid % NXCD, off = wgid / NXCD; wgid = (xcd < r ? xcd * (q + 1) : r * (q + 1) + (xcd - r) * q) + off; }
        const int nig = WGM * nN, gid = wgid / nig, fm = gid * WGM, gsz = (nM - fm) < WGM ? (nM - fm) : WGM;
        pm = fm + ((wgid % nig) % gsz); pn = (wgid % nig) / gsz; return true;
    }
    __device__ __forceinline__ bool next(int i, Unit& u) const { int pm, pn; if (!map(i, pm, pn)) return false; u.pm = pm; u.pn = pn; u.e = 0; u.gp = pm; return true; }
};
struct MoeOrder {
    StaticOrder so; int p0; const int* pexp;
    __device__ void init(int nP, int nN, int G, int c, int p0_, const int* pexp_) { so.init(nP, nN, G, c); p0 = p0_; pexp = pexp_; }
    __device__ __forceinline__ bool next(int i, Unit& u) const { int pm, pn; if (!so.map(i, pm, pn)) return false; u.pm = pm; u.pn = pn; u.gp = p0 + pm; u.e = __builtin_amdgcn_readfirstlane(pexp[u.gp]); return true; }
};

__device__ __forceinline__ unsigned cvt_pk_bf16(float lo, float hi) { unsigned r; asm volatile("v_cvt_pk_bf16_f32 %0, %1, %2" : "=v"(r) : "v"(lo), "v"(hi)); return r; }
__device__ __forceinline__ float bf_lo(unsigned w) { return __uint_as_float(w << 16); }
__device__ __forceinline__ float bf_hi(unsigned w) { return __uint_as_float(w & 0xffff0000u); }

template <class Epi, class Sched, bool GATHER>
__device__ __forceinline__ void gemm_phase(PG8_LAS unsigned char* lds, const Gemm g, const Sched& S, const Epi& E) {
    int tid_ = threadIdx.x; asm volatile("" : "+v"(tid_));
    const int tid = tid_, wid = __builtin_amdgcn_readfirstlane(tid >> 6), lane = tid & 63, wr = wid >> 2, wc = wid & 3, fr = lane & 15, fq = lane >> 4;
    const int K = g.K, nt = K / BK;
    int Ra[2], Ca[2]; unsigned voffB[2];
#pragma unroll
    for (int i = 0; i < 2; ++i) { int R, C; stage_rc(tid * 16 + i * 8192, R, C); const int Rb = (R & ~31) + perm32(R & 31);
        Ra[i] = R; Ca[i] = C; voffB[i] = (unsigned)(Rb * K + C) * 2u; }
    const size_t kstep = (size_t)(BK * 2);
    const size_t hstep = (size_t)HALF * K * 2;
    const size_t tstep = 2 * hstep;
    const unsigned ldsw = (unsigned)wid * 1024u;
    const int aoff = lds_byte(wr * 64 + fr, fq * 8), boff = lds_byte(wc * 32 + fr, fq * 8);
    const char* const A0 = (const char*)g.A;
#define PG8_SA(b, h) (((b) * 2 + (h)) * HTB)
#define PG8_SB(b, h) ((4 + (b) * 2 + (h)) * HTB)
#define PG8_STAGE(bufoff, gbase, voff) do { _Pragma("unroll") for (int _i = 0; _i < 2; ++_i) \
        __builtin_amdgcn_global_load_lds((const unsigned*)((const char*)(gbase) + (voff)[_i]), (PG8_LAS unsigned*)(lds + (bufoff) + ldsw + _i * 8192), 16, 0, 0); } while (0)
#define PG8_LDA(dst, b, h) do { _Pragma("unroll") for (int m = 0; m < 4; ++m) _Pragma("unroll") for (int k = 0; k < 2; ++k) dst[m][k] = *(const PG8_LAS bf16x8*)(lds + PG8_SA(b, h) + aoff + m * 2048 + k * 1024); } while (0)
#define PG8_LDB(dst, b, h) do { _Pragma("unroll") for (int n = 0; n < 2; ++n) _Pragma("unroll") for (int k = 0; k < 2; ++k) dst[n][k] = *(const PG8_LAS bf16x8*)(lds + PG8_SB(b, h) + boff + n * 2048 + k * 1024); } while (0)
#define PG8_MMA(ai, bj, At, Bt) do { __builtin_amdgcn_s_setprio(1); _Pragma("unroll") for (int m = 0; m < 4; ++m) _Pragma("unroll") for (int n = 0; n < 2; ++n) _Pragma("unroll") for (int k = 0; k < 2; ++k) \
        acc[ai][bj][m][n] = __builtin_amdgcn_mfma_f32_16x16x32_bf16(Bt[n][k], At[m][k], acc[ai][bj][m][n], 0, 0, 0); __builtin_amdgcn_s_setprio(0); } while (0)
#define PG8_WAIT_V(n) asm volatile("s_waitcnt vmcnt(" #n ")" ::: "memory")
#define PG8_WAIT_L(n) asm volatile("s_waitcnt lgkmcnt(" #n ")" ::: "memory")
#define PG8_BAR __builtin_amdgcn_s_barrier()
#define PG8_SCHED __builtin_amdgcn_sched_barrier(0)
#define PG8_AOFFS(dst, u) do { _Pragma("unroll") for (int _h = 0; _h < 2; ++_h) _Pragma("unroll") for (int _i = 0; _i < 2; ++_i) { \
        int _row = (u).pm * BM + _h * HALF + Ra[_i]; \
        if (GATHER) { const int _gi = g.rowidx[(u).gp * BM + _h * HALF + Ra[_i]]; _row = _gi < 0 ? 0 : _gi; } \
        dst[_h][_i] = ((unsigned)_row * (unsigned)K + (unsigned)Ca[_i]) * 2u; } } while (0)
    Unit cur, nxt; int ui = 0;
    if (!S.next(0, cur)) return;
    f32x4 acc[2][2][4][2];
#pragma unroll
    for (int a = 0; a < 2; ++a)
#pragma unroll
        for (int b = 0; b < 2; ++b)
#pragma unroll
            for (int m = 0; m < 4; ++m)
#pragma unroll
                for (int n = 0; n < 2; ++n) acc[a][b][m][n] = (f32x4){0.f, 0.f, 0.f, 0.f};
    bf16x8 At[4][2], B0[2][2], B1[2][2];
    unsigned oaC[2][2], oaN[2][2];
    PG8_AOFFS(oaC, cur);
    const char* cB = (const char*)g.Bt + (size_t)cur.e * g.estride + (size_t)cur.pn * tstep;
    PG8_STAGE(PG8_SB(0, 0), cB, voffB); PG8_STAGE(PG8_SB(0, 1), cB + hstep, voffB); PG8_STAGE(PG8_SA(0, 0), A0, oaC[0]); PG8_STAGE(PG8_SA(0, 1), A0, oaC[1]);
    if (wr == 1) PG8_BAR;
    PG8_WAIT_V(2); PG8_BAR;
    PG8_STAGE(PG8_SB(1, 0), cB + kstep, voffB); PG8_STAGE(PG8_SA(1, 0), A0 + kstep, oaC[0]); PG8_STAGE(PG8_SB(1, 1), cB + hstep + kstep, voffB);
    PG8_WAIT_V(6); PG8_BAR;
    for (;;) {
        const bool has_next = S.next(ui + 1, nxt);
        if (has_next) { PG8_AOFFS(oaN, nxt); }
        else {
#pragma unroll
            for (int _h = 0; _h < 2; ++_h)
#pragma unroll
                for (int _i = 0; _i < 2; ++_i) oaN[_h][_i] = oaC[_h][_i]; }
        const char* nB = has_next ? (const char*)g.Bt + (size_t)nxt.e * g.estride + (size_t)nxt.pn * tstep : cB;
        for (int t = 0; t < nt; t += 2) {
            const bool last = (t == nt - 2);
            const char* ka1 = A0 + (size_t)(t + 1) * kstep;
            const char* ka2 = last ? A0 : A0 + (size_t)(t + 2) * kstep; const char* b2 = last ? nB : cB + (size_t)(t + 2) * kstep;
            const char* ka3 = ka2 + kstep; const char* b3 = b2 + kstep;
            unsigned o2[2][2];
#pragma unroll
            for (int _h = 0; _h < 2; ++_h)
#pragma unroll
                for (int _i = 0; _i < 2; ++_i) o2[_h][_i] = oaC[_h][_i];
            if (last) {
#pragma unroll
                for (int _h = 0; _h < 2; ++_h)
#pragma unroll
                    for (int _i = 0; _i < 2; ++_i) o2[_h][_i] = oaN[_h][_i];
                asm volatile("" : "+v"(o2[0][0]), "+v"(o2[0][1]), "+v"(o2[1][0]), "+v"(o2[1][1])); }
            PG8_LDB(B0, 0, 0); PG8_LDB(B1, 0, 1); PG8_SCHED; PG8_LDA(At, 0, 0); PG8_STAGE(PG8_SA(1, 1), ka1, oaC[1]);
            PG8_WAIT_V(8); PG8_WAIT_L(0); PG8_BAR; PG8_MMA(0, 0, At, B0); PG8_MMA(0, 1, At, B1); PG8_BAR; PG8_SCHED;
            PG8_LDA(At, 0, 1); PG8_STAGE(PG8_SB(0, 0), b2, voffB); PG8_STAGE(PG8_SB(0, 1), b2 + hstep, voffB); PG8_STAGE(PG8_SA(0, 0), ka2, o2[0]);
            PG8_WAIT_V(8); PG8_WAIT_L(0); PG8_BAR; PG8_MMA(1, 0, At, B0); PG8_MMA(1, 1, At, B1); PG8_BAR; PG8_SCHED;
            PG8_LDB(B0, 1, 0); PG8_LDB(B1, 1, 1); PG8_SCHED; PG8_LDA(At, 1, 0); PG8_STAGE(PG8_SA(0, 1), ka2, o2[1]);
            PG8_WAIT_V(8); PG8_WAIT_L(0); PG8_BAR; PG8_MMA(0, 0, At, B0); PG8_MMA(0, 1, At, B1); PG8_BAR; PG8_SCHED;
            PG8_LDA(At, 1, 1); PG8_STAGE(PG8_SB(1, 0), b3, voffB); PG8_STAGE(PG8_SB(1, 1), b3 + hstep, voffB); PG8_STAGE(PG8_SA(1, 0), ka3, o2[0]);
            PG8_WAIT_V(8); PG8_WAIT_L(0); PG8_BAR; PG8_MMA(1, 0, At, B0); PG8_MMA(1, 1, At, B1); PG8_BAR; PG8_SCHED;
        }
        if (wr == 0) PG8_BAR;
        E(acc, cur, wr, wc, fr, fq);
        if (!has_next) break;
#pragma unroll
        for (int a = 0; a < 2; ++a)
#pragma unroll
            for (int b = 0; b < 2; ++b)
#pragma unroll
                for (int m = 0; m < 4; ++m)
#pragma unroll
                    for (int n = 0; n < 2; ++n) acc[a][b][m][n] = (f32x4){0.f, 0.f, 0.f, 0.f};
        cur = nxt; cB = nB; ++ui;
#pragma unroll
        for (int _h = 0; _h < 2; ++_h)
#pragma unroll
            for (int _i = 0; _i < 2; ++_i) oaC[_h][_i] = oaN[_h][_i];
        if (wr == 1) PG8_BAR;
    }
    PG8_WAIT_V(0);
    PG8_BAR;
#undef PG8_SA
#undef PG8_SB
#undef PG8_STAGE
#undef PG8_LDA
#undef PG8_LDB
#undef PG8_MMA
#undef PG8_WAIT_V
#undef PG8_WAIT_L
#undef PG8_BAR
#undef PG8_SCHED
#undef PG8_AOFFS
}
}
#define GAS __attribute__((address_space(1)))
#define LAS __attribute__((address_space(3)))
typedef unsigned short bf16;
typedef unsigned v4u __attribute__((ext_vector_type(4)));
typedef unsigned v2u __attribute__((ext_vector_type(2)));
typedef float f32x4 __attribute__((ext_vector_type(4)));
typedef float f32x2 __attribute__((ext_vector_type(2)));
typedef GAS unsigned gu32;
#define RLX_AGENT __ATOMIC_RELAXED, __HIP_MEMORY_SCOPE_AGENT
#define LDS_WAIT() asm volatile("s_waitcnt lgkmcnt(0)" ::: "memory")
#define VM_WAIT() asm volatile("s_waitcnt vmcnt(0)" ::: "memory")
__device__ __forceinline__ unsigned f2bf(float f) { unsigned u = __builtin_bit_cast(unsigned, f); return (u + 0x7fffu + ((u >> 16) & 1u)) >> 16; }
__device__ __forceinline__ unsigned pk2(float lo, float hi) { return f2bf(lo) | (f2bf(hi) << 16); }
__device__ __forceinline__ float bf2f(bf16 h) { return __uint_as_float(((unsigned)h) << 16); }
__device__ __forceinline__ float bflo(unsigned w) { return __uint_as_float(w << 16); }
__device__ __forceinline__ float bfhi(unsigned w) { return __uint_as_float(w & 0xffff0000u); }

#define XB_TMO      128
#define XB_XCNT(j)  (256  + 64 * (j))
#define XB_XSUB(j)  (1280 + 64 * (j))
#define XB_XGEN(j)  (2304 + 64 * (j))
#define XB_TOP      3328
#define XB_TOPGEN   3392
#define XCD_BAR_WORDS 3456
#define XB_SPIN_CAP (1u << 18)

__device__ __forceinline__ unsigned xb_ld(unsigned* p)              { return __hip_atomic_load(p, __ATOMIC_RELAXED, __HIP_MEMORY_SCOPE_AGENT); }
__device__ __forceinline__ unsigned xb_add(unsigned* p, unsigned v) { return __hip_atomic_fetch_add(p, v, __ATOMIC_RELAXED, __HIP_MEMORY_SCOPE_AGENT); }
__device__ __forceinline__ unsigned xb_xcc_id() { return (unsigned)__builtin_amdgcn_s_getreg((3 << 11) | 20) & 0xFu; }
#define XB_SPIN(cond, bar) do { unsigned _sp = 0; while (cond) { __builtin_amdgcn_s_sleep(1); \
    if ((++_sp & 255u) == 0u) { if (xb_ld(&(bar)[XB_TMO])) break; if (_sp > XB_SPIN_CAP) { atomicAdd(&(bar)[XB_TMO], 1u); break; } } } } while (0)

struct XcdBarrier {
    unsigned* bar; unsigned x;
    volatile LAS unsigned* st;
};

__device__ __forceinline__ XcdBarrier xcd_barrier_post(unsigned* bar, volatile LAS unsigned* st) {
    XcdBarrier b; b.bar = bar; b.x = xb_xcc_id(); b.st = st;
    if (threadIdx.x == 0) (void)xb_add(&bar[XB_XCNT(b.x)], 1u);
    return b;
}
__device__ __forceinline__ void xcd_barrier_complete(unsigned* bar, unsigned x, unsigned& nloc, unsigned& nx) {
    const unsigned G = gridDim.x * gridDim.y * gridDim.z;
    unsigned sum, cnt, mine, sp = 0u;
    for (;;) {
        sum = 0u; cnt = 0u; mine = 0u;
#pragma unroll
        for (unsigned j = 0; j < 16; ++j) { const unsigned c = xb_ld(&bar[XB_XCNT(j)]); sum += c; cnt += (c > 0u) ? 1u : 0u; mine = (j == x) ? c : mine; }
        if (sum == G) break;
        __builtin_amdgcn_s_sleep(1);
        if ((++sp & 255u) == 0u) { if (xb_ld(&bar[XB_TMO])) break; if (sp > XB_SPIN_CAP) { atomicAdd(&bar[XB_TMO], 1u); break; } }
    }
    nloc = mine > 0u ? mine : 1u; nx = cnt > 0u ? cnt : 1u;
}

__device__ __forceinline__ void xcd_barrier(const XcdBarrier& b) {
    asm volatile("s_waitcnt vmcnt(0)" ::: "memory");
    __syncthreads();
    if (threadIdx.x == 0) {
        unsigned* bar = b.bar;
        __builtin_amdgcn_s_waitcnt(0);
        unsigned nloc = b.st[0], nx = b.st[1];
        if (nloc == 0u) { xcd_barrier_complete(bar, b.x, nloc, nx); b.st[0] = nloc; b.st[1] = nx; }
        const unsigned old = xb_add(&bar[XB_XSUB(b.x)], 1u);
        const unsigned gen = old / nloc;
        if (old + 1u == (gen + 1u) * nloc) {
            __builtin_amdgcn_fence(__ATOMIC_RELEASE, "agent");
            asm volatile("s_waitcnt vmcnt(0)" ::: "memory");
            const unsigned og = xb_add(&bar[XB_TOP], 1u);
            const unsigned tg = og / nx;
            if (og + 1u == (tg + 1u) * nx) xb_add(&bar[XB_TOPGEN], 1u);
            else XB_SPIN(xb_ld(&bar[XB_TOPGEN]) == tg, bar);
            __builtin_amdgcn_fence(__ATOMIC_ACQUIRE, "agent");
            xb_add(&bar[XB_XGEN(b.x)], 1u);
            asm volatile("s_waitcnt vmcnt(0)" ::: "memory");
        } else {
            XB_SPIN(xb_ld(&bar[XB_XGEN(b.x)]) == gen, bar);
            __builtin_amdgcn_fence(__ATOMIC_ACQUIRE, "agent");
            asm volatile("s_waitcnt vmcnt(0)" ::: "memory");
        }
    }
    __syncthreads();
}

constexpr int NB = 16, TT = 2048, DM = 1024, MR = NB * TT, NMETA = 16, MROWS = MR + 256, NPAN = MROWS / 256;
constexpr int PSEQ = 2112, NCH = 33;
constexpr int DIN = 2864, N1 = 3328;
constexpr int DFF = 2816, DFE = 3584, NEXP = 8;
constexpr float EPS = 1e-6f;
constexpr int C_AQ = 0, C_AK = 128, C_AV = 256, C_ALR = 512, C_AOG = 528, C_RQ = 784, C_RK = 1040, C_RV = 1296, C_ROG = 1552, C_CQ = 1808, C_CKV = 2000, C_KPE = 2064, C_DQ = 2096, C_DK = 2352, C_DV = 2608, C_QEFF = 2864;
constexpr int MAXPAN = 264;
constexpr float LOG2E = 1.4426950408889634f;

constexpr size_t MiB = 1u << 20;
constexpr size_t WS_CTL = 0, CTL_BYTES = 1 * MiB;
constexpr size_t WS_TABR = 1 * MiB, WS_TABM = 1 * MiB + 576 * 1024;
constexpr size_t WS_RT = 2 * MiB;
constexpr size_t WS_STA = 3 * MiB, WS_STB = 6 * MiB;
constexpr size_t WS_MOE = 9 * MiB;
constexpr size_t MO_ROWIDX = WS_MOE, MO_PDST = WS_MOE + 512 * 1024, MO_PINFO = WS_MOE + 1 * MiB, MO_TOKE = WS_MOE + 2 * MiB, MO_TOKP = MO_TOKE + 256 * 1024, MO_TOKW = MO_TOKE + 512 * 1024, MO_PEXP = WS_MOE + 3 * MiB;
constexpr size_t WS_GD = 13 * MiB;
constexpr size_t WS_W1T = 16 * MiB, W1T_BYTES = (size_t)N1 * DM * 2;
constexpr size_t WS_WOT = 29 * MiB, WOT_BYTES = (size_t)DM * DM * 2;
constexpr size_t WS_WGU = 33 * MiB;
constexpr size_t WS_WD = 44 * MiB;
constexpr size_t WS_HB = 50 * MiB;
constexpr size_t WS_BIG = 115 * MiB;
constexpr size_t B_PROJ = WS_BIG;
constexpr size_t B_GQ = WS_BIG + 210 * MiB, B_GK = B_GQ + 8704 * 1024, B_GV = WS_BIG + 227 * MiB;
constexpr size_t B_RQ = WS_BIG + 244 * MiB, B_RK = B_RQ + 16896 * 1024, B_RV = WS_BIG + 277 * MiB;
constexpr size_t B_MQ = WS_BIG + 294 * MiB, B_MK = WS_BIG + 319 * MiB;
constexpr size_t B_DQ = WS_BIG + 326 * MiB, B_DK = B_DQ + 16896 * 1024;
constexpr size_t O_DVT = 65 * MiB, O_MVT = 82 * MiB, O_GKT = 87 * MiB, O_RKT = 96 * MiB;
constexpr size_t B_ACT = WS_BIG;
constexpr size_t B_EGU = WS_BIG, EGU_BYTES = (size_t)2 * DFE * DM * 2;
constexpr size_t B_ED = WS_BIG + 112 * MiB, ED_BYTES = (size_t)DM * DFE * 2;
constexpr size_t B_EACT = WS_BIG + 168 * MiB;
constexpr size_t WS_NEED = WS_BIG + 392 * MiB;
constexpr int CW_BAR = 4096, CW_CNT = 8192;

constexpr int RING_BYTES = 131072, MISC_OFF = RING_BYTES + 320, LDS_BYTES = 147456;

__device__ __forceinline__ float silu_f(float x) { return x * __builtin_amdgcn_rcpf(1.0f + __builtin_amdgcn_exp2f(-x * LOG2E)); }
__device__ __forceinline__ v4u pack8(const f32x4 a, const f32x4 b) { v4u w; w.x = pg8::cvt_pk_bf16(a[0], a[1]); w.y = pg8::cvt_pk_bf16(a[2], a[3]); w.z = pg8::cvt_pk_bf16(b[0], b[1]); w.w = pg8::cvt_pk_bf16(b[2], b[3]); return w; }

__device__ __forceinline__ void rows_rstd16(const float* stats, int row0, int fq, float (&rs)[8]) {
    f32x4 v[8];
#pragma unroll
    for (int j = 0; j < 8; ++j) v[j] = *(const f32x4*)(stats + (size_t)(row0 + (j >> 2) * 128 + (j & 3) * 16) * 16 + 4 * fq);
#pragma unroll
    for (int j = 0; j < 8; ++j) { float s = (v[j][0] + v[j][1]) + (v[j][2] + v[j][3]); s += __shfl_xor(s, 16); s += __shfl_xor(s, 32); rs[j] = __builtin_amdgcn_rsqf(s * (1.0f / 1024.0f) + EPS); }
}
struct EpiProj {
    bf16* O; const float* stats;
    __device__ __forceinline__ void operator()(const f32x4 (&acc)[2][2][4][2], const pg8::Unit& u, int wr, int wc, int fr, int fq) const {
        const int col0 = u.pn * 256 + wc * 32 + 8 * fq, row0 = u.pm * 256 + wr * 64 + fr;
        float rs[8]; rows_rstd16(stats, row0, fq, rs);
#pragma unroll
        for (int ai = 0; ai < 2; ++ai)
#pragma unroll
            for (int m = 0; m < 4; ++m) { const int r = row0 + ai * 128 + m * 16; const float sc = rs[ai * 4 + m]; bf16* rowp = O + (size_t)r * N1 + col0;
#pragma unroll
                for (int bj = 0; bj < 2; ++bj) *(v4u*)(rowp + bj * 128) = pack8(acc[ai][bj][m][0] * sc, acc[ai][bj][m][1] * sc); }
    }
};
struct EpiSwiglu {
    bf16* O; int ldo; const float* stats;
    __device__ __forceinline__ void operator()(const f32x4 (&acc)[2][2][4][2], const pg8::Unit& u, int wr, int wc, int fr, int fq) const {
        const int col0 = u.pn * 128 + wc * 32 + 8 * fq, row0 = u.pm * 256 + wr * 64 + fr;
        float rs[8]; rows_rstd16(stats, row0, fq, rs);
#pragma unroll
        for (int ai = 0; ai < 2; ++ai)
#pragma unroll
            for (int m = 0; m < 4; ++m) { const int r = row0 + ai * 128 + m * 16; const float sc = rs[ai * 4 + m];
                f32x4 o[2];
#pragma unroll
                for (int n = 0; n < 2; ++n)
#pragma unroll
                    for (int i = 0; i < 4; ++i) o[n][i] = silu_f(acc[ai][0][m][n][i] * sc) * (acc[ai][1][m][n][i] * sc);
                *(v4u*)(O + (size_t)r * ldo + col0) = pack8(o[0], o[1]); }
    }
};
struct EpiResid {
    bf16* H; float* stats;
    __device__ __forceinline__ void operator()(const f32x4 (&acc)[2][2][4][2], const pg8::Unit& u, int wr, int wc, int fr, int fq) const {
        const int col0 = u.pn * 256 + wc * 32 + 8 * fq, row0 = u.pm * 256 + wr * 64 + fr;
#pragma unroll
        for (int ai = 0; ai < 2; ++ai) {
            v4u w[4][2];
#pragma unroll
            for (int m = 0; m < 4; ++m)
#pragma unroll
                for (int bj = 0; bj < 2; ++bj) w[m][bj] = *(const v4u*)(H + (size_t)(row0 + ai * 128 + m * 16) * DM + col0 + bj * 128);
            float ssm[4];
#pragma unroll
            for (int m = 0; m < 4; ++m) { bf16* rowp = H + (size_t)(row0 + ai * 128 + m * 16) * DM + col0; float ss = 0.f;
#pragma unroll
                for (int bj = 0; bj < 2; ++bj) { const v4u x = w[m][bj];
                    f32x4 a = acc[ai][bj][m][0], b = acc[ai][bj][m][1];
                    a[0] += bflo(x.x); a[1] += bfhi(x.x); a[2] += bflo(x.y); a[3] += bfhi(x.y); b[0] += bflo(x.z); b[1] += bfhi(x.z); b[2] += bflo(x.w); b[3] += bfhi(x.w);
                    ss += (a[0] * a[0] + a[1] * a[1]) + (a[2] * a[2] + a[3] * a[3]) + (b[0] * b[0] + b[1] * b[1]) + (b[2] * b[2] + b[3] * b[3]);
                    *(v4u*)(rowp + bj * 128) = pack8(a, b); }
                ss += __shfl_xor(ss, 16); ss += __shfl_xor(ss, 32); ssm[m] = ss; }
            if (fq == 0) {
#pragma unroll
                for (int m = 0; m < 4; ++m) stats[(size_t)(row0 + ai * 128 + m * 16) * 16 + u.pn * 4 + wc] = ssm[m]; } }
    }
};
struct EpiSwigluMoe {
    bf16* O; const f32x2* pinfo;
    __device__ __forceinline__ void operator()(const f32x4 (&acc)[2][2][4][2], const pg8::Unit& u, int wr, int wc, int fr, int fq) const {
        const int col0 = u.pn * 128 + wc * 32 + 8 * fq, rl0 = wr * 64 + fr;
        float rs[8];
#pragma unroll
        for (int j = 0; j < 8; ++j) rs[j] = pinfo[u.gp * 256 + rl0 + (j >> 2) * 128 + (j & 3) * 16][0];
#pragma unroll
        for (int ai = 0; ai < 2; ++ai)
#pragma unroll
            for (int m = 0; m < 4; ++m) { const int rl = rl0 + ai * 128 + m * 16; const float sc = rs[ai * 4 + m];
                f32x4 o[2];
#pragma unroll
                for (int n = 0; n < 2; ++n)
#pragma unroll
                    for (int i = 0; i < 4; ++i) o[n][i] = silu_f(acc[ai][0][m][n][i] * sc) * (acc[ai][1][m][n][i] * sc);
                *(v4u*)(O + (size_t)(u.pm * 256 + rl) * DFE + col0) = pack8(o[0], o[1]); }
    }
};
struct EpiMoeDown {
    unsigned char* Y; const int* pdst; const f32x2* pinfo;
    __device__ __forceinline__ void operator()(const f32x4 (&acc)[2][2][4][2], const pg8::Unit& u, int wr, int wc, int fr, int fq) const {
        const int col0 = u.pn * 256 + wc * 32 + 8 * fq, rl0 = wr * 64 + fr;
        int dst[8]; float wt[8];
#pragma unroll
        for (int j = 0; j < 8; ++j) { const int gi = u.gp * 256 + rl0 + (j >> 2) * 128 + (j & 3) * 16; dst[j] = pdst[gi]; wt[j] = pinfo[gi][1]; }
#pragma unroll
        for (int ai = 0; ai < 2; ++ai)
#pragma unroll
            for (int m = 0; m < 4; ++m) { const int d = dst[ai * 4 + m]; const float w = wt[ai * 4 + m];
                if (d >= 0) { bf16* rowp = (bf16*)(Y + (size_t)(d >> 1) * 4096 + (size_t)(d & 1) * 2048) + col0;
#pragma unroll
                    for (int bj = 0; bj < 2; ++bj) *(v4u*)(rowp + bj * 128) = pack8(acc[ai][bj][m][0] * w, acc[ai][bj][m][1] * w); } }
    }
};

__device__ __forceinline__ float wave_sum(float v) {
#pragma unroll
    for (int o = 1; o < 64; o <<= 1) v += __shfl_xor(v, o);
    return v;
}
__device__ __forceinline__ void transpose_item(const float* W, int K, int N, const float* gain, bf16* WT, int kb, int nb, int dmode, LAS float* scr_, int lane) {
    LAS unsigned* scr = (LAS unsigned*)scr_;
    const int k0 = 64 * kb, n0 = 64 * nb, n = n0 + 2 * (lane & 31), kh = lane >> 5;
    f32x2 v[32];
#pragma unroll
    for (int i = 0; i < 32; ++i) v[i] = (n < N) ? *(const f32x2*)(W + (size_t)(k0 + 2 * i + kh) * N + n) : (f32x2){0.f, 0.f};
    if (gain) {
#pragma unroll
        for (int i = 0; i < 32; ++i) v[i] = v[i] * gain[k0 + 2 * i + kh]; }
#pragma unroll
    for (int i = 0; i < 32; ++i) scr[(2 * i + kh) * 33 + (lane & 31)] = pk2(v[i][0], v[i][1]);
    LDS_WAIT(); asm volatile("" ::: "memory");
    const LAS bf16* T = (const LAS bf16*)scr;
    const int c = lane & 7;
    const int d0 = dmode == 0 ? n0 : 256 * (n0 >> 7) + (n0 & 127) + (dmode == 2 ? 128 : 0);
#pragma unroll
    for (int j = 0; j < 8; ++j) { const int nl = (lane >> 3) + 8 * j; unsigned x[8];
#pragma unroll
        for (int t = 0; t < 8; ++t) x[t] = T[(8 * c + t) * 66 + nl];
        v4u o; o.x = x[0] | (x[1] << 16); o.y = x[2] | (x[3] << 16); o.z = x[4] | (x[5] << 16); o.w = x[6] | (x[7] << 16);
        if (n0 + nl < N) *(v4u*)(WT + (size_t)(d0 + nl) * K + k0 + 8 * c) = o; }
    LDS_WAIT(); asm volatile("" ::: "memory");
}

struct Args { const float* in[24]; float* out; unsigned char* ws; int ph_lo, ph_hi; };
enum { I_X = 0, I_META, I_ANORM, I_WIN, I_GWG, I_GBG, I_GNORM, I_RNORM, I_MQN, I_WUQ, I_MKVN, I_WUKV, I_DLAM, I_DNORM, I_WOUT, I_FNORM, I_FG, I_FU, I_FD, I_ROUTER, I_EG, I_EU, I_ED, I_FINAL };

#ifndef REP_FOLD
#define REP_FOLD 1
#endif
#ifndef REP_HINIT
#define REP_HINIT 1
#endif
__device__ __forceinline__ void qeff_unit(const Args& a, int li, int hh, int k16, LAS float* L, int tid) {
    const float* Wuq = a.in[I_WUQ] + (size_t)li * 192 * 384; const float* Wukv = a.in[I_WUKV] + (size_t)li * 64 * 512;
    const float* gq = a.in[I_MQN] + li * 192; const float* gkv = a.in[I_MKVN] + li * 64;
    const float* Win = a.in[I_WIN] + (size_t)li * DM * DIN; const float* gan = a.in[I_ANORM] + li * DM;
    bf16* W1t = (bf16*)(a.ws + WS_W1T + li * W1T_BYTES);
    LAS float* Wqa = L; LAS float* Wuk = L + 192 * 96; LAS float* Wis = Wuk;
    __syncthreads();
    for (int idx = tid; idx < 64 * 64; idx += 512) { const int n = idx >> 6, m = idx & 63; Wuk[n * 65 + m] = Wukv[n * 512 + hh * 128 + m]; }
    __syncthreads();
    for (int pass = 0; pass < 3; ++pass) { const int i = pass * 64 + (tid >> 3), ng = tid & 7; f32x4 wq[16];
#pragma unroll
        for (int j = 0; j < 16; ++j) wq[j] = *(const f32x4*)(Wuq + i * 384 + hh * 96 + 4 * j);
        const float gi = gq[i];
#pragma unroll
        for (int t = 0; t < 8; ++t) { const int n = ng * 8 + t; float s = 0.f;
#pragma unroll
            for (int j = 0; j < 16; ++j) s += (wq[j][0] * Wuk[n * 65 + 4 * j] + wq[j][1] * Wuk[n * 65 + 4 * j + 1]) + (wq[j][2] * Wuk[n * 65 + 4 * j + 2] + wq[j][3] * Wuk[n * 65 + 4 * j + 3]);
            Wqa[i * 96 + n] = gi * gkv[n] * s; }
        if (ng < 4) {
#pragma unroll
            for (int j = 0; j < 2; ++j) { const f32x4 r = *(const f32x4*)(Wuq + i * 384 + hh * 96 + 64 + ng * 8 + 4 * j); LAS float* d = Wqa + i * 96 + 64 + ng * 8 + 4 * j; d[0] = gi * r[0]; d[1] = gi * r[1]; d[2] = gi * r[2]; d[3] = gi * r[3]; } } }
    __syncthreads();
    for (int sb = 0; sb < 2; ++sb) { const int k0 = k16 * 64 + sb * 32;
        for (int idx = tid; idx < 32 * 48; idx += 512) { const int kk = idx / 48, i4 = idx % 48; const float* src = Win + (size_t)(k0 + kk) * DIN + C_CQ + 4 * i4;
            Wis[kk * 193 + 4 * i4] = src[0]; Wis[kk * 193 + 4 * i4 + 1] = src[1]; Wis[kk * 193 + 4 * i4 + 2] = src[2]; Wis[kk * 193 + 4 * i4 + 3] = src[3]; }
        __syncthreads();
        { const int kk = tid & 31, ng = tid >> 5; float acc[6] = {0.f, 0.f, 0.f, 0.f, 0.f, 0.f};
#pragma unroll 8
            for (int i = 0; i < 192; ++i) { const float w = Wis[kk * 193 + i]; const LAS f32x2* q2 = (const LAS f32x2*)(Wqa + i * 96 + ng * 6); const f32x2 q0 = q2[0], q1 = q2[1], q3 = q2[2];
                acc[0] += w * q0[0]; acc[1] += w * q0[1]; acc[2] += w * q1[0]; acc[3] += w * q1[1]; acc[4] += w * q3[0]; acc[5] += w * q3[1]; }
            const float g = gan[k0 + kk];
#pragma unroll
            for (int t = 0; t < 6; ++t) W1t[(size_t)(C_QEFF + hh * 96 + ng * 6 + t) * DM + k0 + kk] = (bf16)f2bf(g * acc[t]); }
        __syncthreads(); }
}
__device__ __forceinline__ void wofold_unit(const Args& a, int li, int hh, int nq, LAS float* L, int tid) {
    const float* Wukv = a.in[I_WUKV] + (size_t)li * 64 * 512; const float* gkv = a.in[I_MKVN] + li * 64; const float* Wo = a.in[I_WOUT] + (size_t)li * DM * DM;
    bf16* Wot = (bf16*)(a.ws + WS_WOT + li * WOT_BYTES);
    LAS float* WuvT = L; LAS float* Wos = L + 64 * 64;
    __syncthreads();
    for (int idx = tid; idx < 64 * 64; idx += 512) { const int j = idx >> 6, e = idx & 63; WuvT[e * 64 + j] = Wukv[j * 512 + hh * 128 + 64 + e] * gkv[j]; }
    for (int idx = tid; idx < 64 * 64; idx += 512) { const int e = idx >> 6, n4 = idx & 63; *(LAS f32x4*)(Wos + e * 256 + 4 * n4) = *(const f32x4*)(Wo + (size_t)(512 + 64 * hh + e) * DM + nq * 256 + 4 * n4); }
    __syncthreads();
    { const int n4 = tid & 63, j8 = tid >> 6; f32x4 acc[8];
#pragma unroll
        for (int j = 0; j < 8; ++j) acc[j] = (f32x4){0.f, 0.f, 0.f, 0.f};
#pragma unroll 4
        for (int e = 0; e < 64; ++e) { const f32x4 wv = *(const LAS f32x4*)(Wos + e * 256 + 4 * n4); const f32x4 u0 = *(const LAS f32x4*)(WuvT + e * 64 + 8 * j8), u1 = *(const LAS f32x4*)(WuvT + e * 64 + 8 * j8 + 4);
#pragma unroll
            for (int j = 0; j < 4; ++j) { acc[j] += wv * u0[j]; acc[4 + j] += wv * u1[j]; } }
#pragma unroll
        for (int t = 0; t < 4; ++t) { v4u w; w.x = pk2(acc[0][t], acc[1][t]); w.y = pk2(acc[2][t], acc[3][t]); w.z = pk2(acc[4][t], acc[5][t]); w.w = pk2(acc[6][t], acc[7][t]);
            *(v4u*)(Wot + (size_t)(nq * 256 + 4 * n4 + t) * DM + 512 + 64 * hh + 8 * j8) = w; } }
    __syncthreads();
}
__device__ __forceinline__ void p0_prologue(const Args& a, LAS unsigned char* lds, int tid, int lane, int wave) {
    const int G = gridDim.x;
    for (int rep = 0; rep < REP_FOLD; ++rep)
    for (int un = blockIdx.x; un < 160; un += G) {
        if (un < 128) qeff_unit(a, un >> 6, (un >> 4) & 3, un & 15, (LAS float*)lds, tid);
        else { const int v = un - 128; wofold_unit(a, v >> 4, (v >> 2) & 3, v & 3, (LAS float*)lds, tid); }
    }
    __syncthreads();
    LAS float* scr = (LAS float*)(lds + wave * 16384);
    const int gw = blockIdx.x * 8 + wave, NGW = G * 8;
    constexpr int I_IN = 16 * 45, I_WO = 12 * 16, I_G = 16 * 44, I_D = 44 * 16;
    constexpr int NIT = 2 * I_IN + 2 * I_WO + 2 * I_G + I_D;
    for (int it = gw; it < NIT; it += NGW) {
        int r = it;
        if (r < 2 * I_IN) { const int li = r / I_IN; r %= I_IN; transpose_item(a.in[I_WIN] + (size_t)li * DM * DIN, DM, DIN, a.in[I_ANORM] + li * DM, (bf16*)(a.ws + WS_W1T + li * W1T_BYTES), r / 45, r % 45, 0, scr, lane); continue; } r -= 2 * I_IN;
        if (r < 2 * I_WO) { const int li = r / I_WO; r %= I_WO; int kb = r / 16; if (kb >= 8) kb += 4; transpose_item(a.in[I_WOUT] + (size_t)li * DM * DM, DM, DM, nullptr, (bf16*)(a.ws + WS_WOT + li * WOT_BYTES), kb, r % 16, 0, scr, lane); continue; } r -= 2 * I_WO;
        if (r < I_G) { transpose_item(a.in[I_FG], DM, DFF, a.in[I_FNORM], (bf16*)(a.ws + WS_WGU), r / 44, r % 44, 1, scr, lane); continue; } r -= I_G;
        if (r < I_G) { transpose_item(a.in[I_FU], DM, DFF, a.in[I_FNORM], (bf16*)(a.ws + WS_WGU), r / 44, r % 44, 2, scr, lane); continue; } r -= I_G;
        transpose_item(a.in[I_FD], DFF, DM, nullptr, (bf16*)(a.ws + WS_WD), r / 16, r % 16, 0, scr, lane);
    }
    const int gt = blockIdx.x * 512 + tid, NGT = G * 512;
    for (int i = gt; i < 2 * 80 * 128; i += NGT) { const int li = i / (80 * 128), r = i % (80 * 128);
        *(v4u*)(a.ws + WS_W1T + li * W1T_BYTES + (size_t)(C_QEFF + 384) * DM * 2 + (size_t)r * 16) = (v4u){0u, 0u, 0u, 0u}; }
    for (int i = gt; i < 8 * DM; i += NGT) { const int e = i >> 10, k = i & 1023; ((float*)(a.ws + WS_RT))[i] = a.in[I_FNORM][DM + k] * a.in[I_ROUTER][k * 8 + e]; }
    for (int i = gt; i < PSEQ * 48; i += NGT) { const int p = i / 48, j = i % 48; const bool isR = j < 32; const int f = isR ? j : j - 32;
        const float inv = __builtin_amdgcn_exp2f(-(float)f * (isR ? 13.287712379549449f / 32.f : 13.287712379549449f / 16.f));
        const double rev = (double)(p - 48) * (double)inv * 0.15915494309189535; const float fr = (float)(rev - __builtin_rint(rev));
        const f32x2 cs = {__builtin_amdgcn_cosf(fr), __builtin_amdgcn_sinf(fr)};
        if (isR) ((f32x2*)(a.ws + WS_TABR))[p * 32 + f] = cs; else ((f32x2*)(a.ws + WS_TABM))[p * 16 + f] = cs; }
    for (int i = gt; i < 240 * 128; i += NGT) *(v4u*)((unsigned char*)a.out + (size_t)(MR + 16) * 2048 + (size_t)i * 16) = (v4u){0u, 0u, 0u, 0u};
    bf16* hb = (bf16*)(a.ws + WS_HB); float* stA = (float*)(a.ws + WS_STA);
    for (int rep = 0; rep < REP_HINIT; ++rep)
    for (int r = gw; r < MROWS; r += NGW) {
        f32x4 v[4]; float s = 0.f;
#pragma unroll
        for (int j = 0; j < 4; ++j) { if (r < MR) v[j] = ((const f32x4*)(a.in[I_X] + (size_t)r * DM))[lane + 64 * j]; else if (r < MR + NMETA) v[j] = ((const f32x4*)(a.in[I_META] + (size_t)(r - MR) * DM))[lane + 64 * j]; else v[j] = (f32x4){0.f, 0.f, 0.f, 0.f};
            s += (v[j][0] * v[j][0] + v[j][1] * v[j][1]) + (v[j][2] * v[j][2] + v[j][3] * v[j][3]); }
        s = wave_sum(s);
#pragma unroll
        for (int j = 0; j < 4; ++j) { v2u w; w.x = pk2(v[j][0], v[j][1]); w.y = pk2(v[j][2], v[j][3]); ((v2u*)(hb + (size_t)r * DM))[lane + 64 * j] = w; }
        if (lane < 16) stA[(size_t)r * 16 + lane] = lane == 0 ? s : 0.f;
    }
}

__device__ __forceinline__ int src_row(int b, int c, int i) { return c == 0 ? (i < 48 ? -1 : MR + i - 48) : b * TT + 64 * (c - 1) + i; }
__device__ __forceinline__ float lg2gamma(int h) { return h == 0 ? -0.045803689613124789f : h == 1 ? -0.022720076500083529f : h == 2 ? -0.011315313227834146f : -0.0056465631411420627f; }

__device__ __forceinline__ void route_block(const Args& a, int blk, LAS unsigned char* lds, int tid, int lane, int wave) {
    LAS float* Rs = (LAS float*)lds; LAS int* lcnt = (LAS int*)(lds + 32768); LAS int* gbase = lcnt + 8; LAS int* rec = lcnt + 16;
    gu32* ctl = (gu32*)(a.ws + WS_CTL);
    const float* Rt = (const float*)(a.ws + WS_RT); const bf16* hb = (const bf16*)(a.ws + WS_HB); const float* stB = (const float*)(a.ws + WS_STB);
    __syncthreads();
    for (int idx = tid; idx < 8 * DM; idx += 512) Rs[idx] = Rt[idx];
    if (tid < 8) lcnt[tid] = 0;
    __syncthreads();
    for (int rr = 0; rr < 16; ++rr) { const int rl = wave * 16 + rr, row = blk * 128 + rl;
        const v4u w0 = *(const v4u*)(hb + (size_t)row * DM + 8 * lane), w1 = *(const v4u*)(hb + (size_t)row * DM + 512 + 8 * lane);
        const float x[16] = {bflo(w0.x), bfhi(w0.x), bflo(w0.y), bfhi(w0.y), bflo(w0.z), bfhi(w0.z), bflo(w0.w), bfhi(w0.w), bflo(w1.x), bfhi(w1.x), bflo(w1.y), bfhi(w1.y), bflo(w1.z), bfhi(w1.z), bflo(w1.w), bfhi(w1.w)};
        float st = lane < 16 ? stB[(size_t)row * 16 + lane] : 0.f; st = wave_sum(st); const float rs = __builtin_amdgcn_rsqf(st * (1.f / 1024.f) + EPS);
        float lg[8];
#pragma unroll
        for (int e = 0; e < 8; ++e) { float s = 0.f;
#pragma unroll
            for (int t = 0; t < 8; ++t) s += x[t] * Rs[e * DM + 8 * lane + t] + x[8 + t] * Rs[e * DM + 512 + 8 * lane + t];
            lg[e] = wave_sum(s) * rs; }
        int e0 = 0; float v0 = lg[0];
#pragma unroll
        for (int e = 1; e < 8; ++e) if (lg[e] > v0) { v0 = lg[e]; e0 = e; }
        int e1 = -1; float v1 = -3.0e38f;
#pragma unroll
        for (int e = 0; e < 8; ++e) if (e != e0 && lg[e] > v1) { v1 = lg[e]; e1 = e; }
        const float g0 = 1.f / (1.f + __expf(v1 - v0)), g1 = 1.f - g0;
        if (lane == 0) { const int lp0 = atomicAdd((int*)(lcnt + e0), 1), lp1 = atomicAdd((int*)(lcnt + e1), 1);
            rec[rl * 6] = e0; rec[rl * 6 + 1] = e1; rec[rl * 6 + 2] = lp0; rec[rl * 6 + 3] = lp1; rec[rl * 6 + 4] = __float_as_int(g0); rec[rl * 6 + 5] = __float_as_int(g1); } }
    __syncthreads();
    if (tid < 8) gbase[tid] = (int)__hip_atomic_fetch_add(ctl + CW_CNT + 64 * tid, (unsigned)lcnt[tid], RLX_AGENT);
    __syncthreads();
    if (tid < 256) { const int rl = tid >> 1, s = tid & 1, tok = blk * 128 + rl, e = rec[rl * 6 + s];
        ((int*)(a.ws + MO_TOKE))[tok * 2 + s] = e; ((int*)(a.ws + MO_TOKP))[tok * 2 + s] = gbase[e] + rec[rl * 6 + 2 + s]; ((int*)(a.ws + MO_TOKW))[tok * 2 + s] = rec[rl * 6 + 4 + s]; }
    __syncthreads();
}
__device__ __forceinline__ void moe_offsets(const Args& a, LAS int* offs, int tid) {
    gu32* ctl = (gu32*)(a.ws + WS_CTL);
    __syncthreads();
    if (tid == 0) { int o = 0;
        for (int e = 0; e < 8; ++e) { const int cnt = (int)__hip_atomic_load(ctl + CW_CNT + 64 * e, RLX_AGENT); offs[e] = o * 256; o += (cnt + 255) >> 8; }
        offs[8] = o; }
    __syncthreads();
}

__device__ __forceinline__ void stage_cols(const bf16* proj, int b, int c, int col0, int ncols, LAS bf16* S, int sst, int lcol0, int tid) {
    const int cpr = ncols >> 3;
    for (int idx = tid; idx < 64 * cpr; idx += 512) { const int i = idx / cpr, ch = idx - i * cpr, sr = src_row(b, c, i);
        v4u v = {0u, 0u, 0u, 0u}; if (sr >= 0) v = *(const v4u*)(proj + (size_t)sr * N1 + col0 + ch * 8);
        *(LAS v4u*)(S + i * sst + lcol0 + ch * 8) = v; }
}
__device__ __forceinline__ v4u gather8(const LAS bf16* S, int sst, int row0, int col) {
    unsigned x[8];
#pragma unroll
    for (int t = 0; t < 8; ++t) x[t] = S[(row0 + t) * sst + col];
    v4u w; w.x = x[0] | (x[1] << 16); w.y = x[2] | (x[3] << 16); w.z = x[4] | (x[5] << 16); w.w = x[6] | (x[7] << 16); return w;
}
__device__ __forceinline__ void prep2_unit(const Args& a, int li, int b, int c, int part, LAS unsigned char* lds, int tid) {
    const bf16* proj = (const bf16*)(a.ws + B_PROJ);
    LAS bf16* S = (LAS bf16*)lds;
    const int blk0 = (b * NCH + c) * 4; const size_t prow0 = (size_t)b * PSEQ + 64 * c;
    unsigned char* dout = (unsigned char*)a.out;
    __syncthreads();
    if (part == 0) {
        constexpr int SST = 536; LAS float* seg = (LAS float*)(lds + 64 * SST * 2);
        stage_cols(proj, b, c, C_AQ, 128, S, SST, 0, tid); stage_cols(proj, b, c, C_AK, 128, S, SST, 128, tid); stage_cols(proj, b, c, C_AV, 256, S, SST, 256, tid); stage_cols(proj, b, c, C_ALR, 16, S, SST, 512, tid);
        __syncthreads();
        { const int ch = tid & 127, sg = tid >> 7; const float* Wg = a.in[I_GWG] + (size_t)li * 16 * 128; const float bg = a.in[I_GBG][li * 128 + ch];
            float wg[16];
#pragma unroll
            for (int r = 0; r < 16; ++r) wg[r] = Wg[r * 128 + ch];
            float cl[16]; float run = 0.f;
#pragma unroll
            for (int t = 0; t < 16; ++t) { const int i = 16 * sg + t; const v4u l0 = *(const LAS v4u*)(S + i * SST + 512), l1 = *(const LAS v4u*)(S + i * SST + 520);
                float x = bg + bflo(l0.x) * wg[0] + bfhi(l0.x) * wg[1] + bflo(l0.y) * wg[2] + bfhi(l0.y) * wg[3] + bflo(l0.z) * wg[4] + bfhi(l0.z) * wg[5] + bflo(l0.w) * wg[6] + bfhi(l0.w) * wg[7]
                               + bflo(l1.x) * wg[8] + bfhi(l1.x) * wg[9] + bflo(l1.y) * wg[10] + bfhi(l1.y) * wg[11] + bflo(l1.z) * wg[12] + bfhi(l1.z) * wg[13] + bflo(l1.w) * wg[14] + bfhi(l1.w) * wg[15];
                const float ls = fminf(x, 0.f) - __logf(1.f + __expf(-fabsf(x)));
                run += (c > 0 || i >= 48) ? ls * (1.f / 16.f) : 0.f; cl[t] = run; }
            seg[sg * 128 + ch] = run;
            __syncthreads();
            float off = 0.f;
#pragma unroll
            for (int s2 = 0; s2 < 3; ++s2) off += s2 < sg ? seg[s2 * 128 + ch] : 0.f;
            if (sg == 3) ((float*)(a.ws + WS_GD))[(size_t)(blk0 + (ch >> 5)) * 32 + (ch & 31)] = __expf(off + run);
#pragma unroll
            for (int t = 0; t < 16; ++t) { const int i = 16 * sg + t; const float cum = cl[t] + off;
                S[i * SST + ch] = (bf16)f2bf(bf2f(S[i * SST + ch]) * 0.17677669529663687f * __expf(cum)); S[i * SST + 128 + ch] = (bf16)f2bf(bf2f(S[i * SST + 128 + ch]) * __expf(-cum)); } }
        __syncthreads();
        for (int idx = tid; idx < 1024; idx += 512) { const int d8 = idx & 3, i = (idx >> 2) & 63, h = idx >> 8;
            *(v4u*)((bf16*)(a.ws + B_GQ) + ((size_t)(blk0 + h) * 64 + i) * 32 + 8 * d8) = *(const LAS v4u*)(S + i * SST + h * 32 + 8 * d8);
            *(v4u*)((bf16*)(a.ws + B_GK) + ((size_t)(blk0 + h) * 64 + i) * 32 + 8 * d8) = *(const LAS v4u*)(S + i * SST + 128 + h * 32 + 8 * d8); }
        for (int idx = tid; idx < 1024; idx += 512) { const int d = idx & 31, h = (idx >> 5) & 3, s8 = idx >> 7;
            *(v4u*)((bf16*)(dout + O_GKT) + ((size_t)(blk0 + h) * 32 + d) * 64 + 8 * s8) = gather8(S, SST, 8 * s8, 128 + h * 32 + d); }
        for (int idx = tid; idx < 2048; idx += 512) { const int e = idx & 63, h = (idx >> 6) & 3, s8 = idx >> 8;
            *(v4u*)((bf16*)(a.ws + B_GV) + ((size_t)(blk0 + h) * 64 + e) * 64 + 8 * s8) = gather8(S, SST, 8 * s8, 256 + h * 64 + e); }
    } else if (part == 1) {
        constexpr int SST = 776;
        stage_cols(proj, b, c, C_RQ, 256, S, SST, 0, tid); stage_cols(proj, b, c, C_RK, 256, S, SST, 256, tid); stage_cols(proj, b, c, C_RV, 256, S, SST, 512, tid);
        LAS f32x4* tabL = (LAS f32x4*)(lds + 64 * SST * 2);
        for (int idx = tid; idx < 64 * 16; idx += 512) tabL[idx] = ((const f32x4*)(a.ws + WS_TABR))[(size_t)(64 * c) * 16 + idx];
        __syncthreads();
        const LAS f32x2* tabR = (const LAS f32x2*)tabL;
        for (int idx = tid; idx < 64 * 4 * 32; idx += 512) { const int j = idx & 31, h = (idx >> 5) & 3, i = idx >> 7; const f32x2 cs = tabR[i * 32 + j];
            LAS bf16* qp = S + i * SST + h * 64 + j; LAS bf16* kp = qp + 256;
            const float a1 = bf2f(qp[0]), a2 = bf2f(qp[32]), b1 = bf2f(kp[0]), b2 = bf2f(kp[32]);
            const float e = (float)(i + 1) * lg2gamma(h); const float fq = __builtin_amdgcn_exp2f(e), fk = 0.125f * __builtin_amdgcn_exp2f(-e);
            qp[0] = (bf16)f2bf((a1 * cs[0] - a2 * cs[1]) * fq); qp[32] = (bf16)f2bf((a1 * cs[1] + a2 * cs[0]) * fq); kp[0] = (bf16)f2bf((b1 * cs[0] - b2 * cs[1]) * fk); kp[32] = (bf16)f2bf((b1 * cs[1] + b2 * cs[0]) * fk); }
        __syncthreads();
        for (int idx = tid; idx < 2048; idx += 512) { const int d8 = idx & 7, i = (idx >> 3) & 63, h = idx >> 9;
            *(v4u*)((bf16*)(a.ws + B_RQ) + ((size_t)(blk0 + h) * 64 + i) * 64 + 8 * d8) = *(const LAS v4u*)(S + i * SST + h * 64 + 8 * d8);
            *(v4u*)((bf16*)(a.ws + B_RK) + ((size_t)(blk0 + h) * 64 + i) * 64 + 8 * d8) = *(const LAS v4u*)(S + i * SST + 256 + h * 64 + 8 * d8); }
        for (int idx = tid; idx < 2048; idx += 512) { const int d = idx & 63, h = (idx >> 6) & 3, s8 = idx >> 8;
            *(v4u*)((bf16*)(dout + O_RKT) + ((size_t)(blk0 + h) * 64 + d) * 64 + 8 * s8) = gather8(S, SST, 8 * s8, 256 + h * 64 + d);
            *(v4u*)((bf16*)(a.ws + B_RV) + ((size_t)(blk0 + h) * 64 + d) * 64 + 8 * s8) = gather8(S, SST, 8 * s8, 512 + h * 64 + d); }
    } else if (part == 2) {
        constexpr int SST = 680; LAS float* rsd = (LAS float*)(lds + 64 * SST * 2); LAS f32x4* tabL = (LAS f32x4*)(lds + 64 * SST * 2 + 512);
        stage_cols(proj, b, c, C_CQ, 192, S, SST, 0, tid); stage_cols(proj, b, c, C_CKV, 64, S, SST, 192, tid); stage_cols(proj, b, c, C_KPE, 32, S, SST, 256, tid); stage_cols(proj, b, c, C_QEFF, 384, S, SST, 288, tid);
        for (int idx = tid; idx < 64 * 8; idx += 512) tabL[idx] = ((const f32x4*)(a.ws + WS_TABM))[(size_t)(64 * c) * 8 + idx];
        __syncthreads();
        { const int i = tid >> 3, g = tid & 7; float sq = 0.f, sk = 0.f;
#pragma unroll
            for (int t = 0; t < 24; ++t) { const float v = bf2f(S[i * SST + g * 24 + t]); sq += v * v; }
#pragma unroll
            for (int t = 0; t < 8; ++t) { const float v = bf2f(S[i * SST + 192 + g * 8 + t]); sk += v * v; }
            sq += __shfl_xor(sq, 1); sq += __shfl_xor(sq, 2); sq += __shfl_xor(sq, 4); sk += __shfl_xor(sk, 1); sk += __shfl_xor(sk, 2); sk += __shfl_xor(sk, 4);
            if (g == 0) { rsd[i * 2] = __builtin_amdgcn_rsqf(sq * (1.f / 192.f) + EPS); rsd[i * 2 + 1] = __builtin_amdgcn_rsqf(sk * (1.f / 64.f) + EPS); } }
        __syncthreads();
        const LAS f32x2* tabM = (const LAS f32x2*)tabL; const float QS = 0.10206207261596577f * LOG2E;
        for (int idx = tid; idx < 64 * 48; idx += 512) { const int c8 = idx % 48, i = idx / 48, hh = c8 / 12, k8 = c8 % 12; const float s = rsd[i * 2] * QS; const LAS bf16* qe = S + i * SST + 288 + hh * 96; float y[8];
            if (k8 < 8) {
#pragma unroll
                for (int t = 0; t < 8; ++t) y[t] = bf2f(qe[8 * k8 + t]) * s; }
            else { const int kk = (k8 - 8) & 1, second = (k8 - 8) >> 1;
#pragma unroll
                for (int t = 0; t < 8; ++t) { const int j = 8 * kk + t; const f32x2 cs = tabM[i * 16 + j]; const float x1 = bf2f(qe[64 + j]) * s, x2 = bf2f(qe[80 + j]) * s; y[t] = second ? x1 * cs[1] + x2 * cs[0] : x1 * cs[0] - x2 * cs[1]; } }
            v4u w; w.x = pk2(y[0], y[1]); w.y = pk2(y[2], y[3]); w.z = pk2(y[4], y[5]); w.w = pk2(y[6], y[7]);
            *(v4u*)((bf16*)(a.ws + B_MQ) + (prow0 + i) * 384 + hh * 96 + 8 * k8) = w; }
        for (int idx = tid; idx < 64 * 12; idx += 512) { const int k8 = idx % 12, i = idx / 12; float y[8];
            if (k8 < 8) { const float s = rsd[i * 2 + 1];
#pragma unroll
                for (int t = 0; t < 8; ++t) y[t] = bf2f(S[i * SST + 192 + 8 * k8 + t]) * s; }
            else { const int kk = (k8 - 8) & 1, second = (k8 - 8) >> 1;
#pragma unroll
                for (int t = 0; t < 8; ++t) { const int j = 8 * kk + t; const f32x2 cs = tabM[i * 16 + j]; const float x1 = bf2f(S[i * SST + 256 + j]), x2 = bf2f(S[i * SST + 272 + j]); y[t] = second ? x1 * cs[1] + x2 * cs[0] : x1 * cs[0] - x2 * cs[1]; } }
            v4u w; w.x = pk2(y[0], y[1]); w.y = pk2(y[2], y[3]); w.z = pk2(y[4], y[5]); w.w = pk2(y[6], y[7]);
            *(v4u*)((bf16*)(a.ws + B_MK) + (prow0 + i) * 96 + 8 * k8) = w; }
        __syncthreads();
        for (int idx = tid; idx < 512; idx += 512) { const int e = idx & 63, s8 = idx >> 6; unsigned x[8];
#pragma unroll
            for (int t = 0; t < 8; ++t) x[t] = f2bf(bf2f(S[(8 * s8 + t) * SST + 192 + e]) * rsd[(8 * s8 + t) * 2 + 1]);
            v4u w; w.x = x[0] | (x[1] << 16); w.y = x[2] | (x[3] << 16); w.z = x[4] | (x[5] << 16); w.w = x[6] | (x[7] << 16);
            *(v4u*)((bf16*)(dout + O_MVT) + ((size_t)(b * NCH + c) * 64 + e) * 64 + 8 * s8) = w; }
    } else {
        constexpr int SST = 264;
        stage_cols(proj, b, c, C_DV, 256, S, SST, 0, tid);
        for (int idx = tid; idx < 64 * 32; idx += 512) { const int i = idx >> 5, ch8 = idx & 31, sr = src_row(b, c, i);
            v4u dq = {0u, 0u, 0u, 0u}, dk = dq;
            if (sr >= 0) { const bf16* pr = proj + (size_t)sr * N1; dq = *(const v4u*)(pr + C_DQ + ch8 * 8); dk = *(const v4u*)(pr + C_DK + ch8 * 8);
                const float qs = 0.17677669529663687f * LOG2E;
                dq.x = pk2(bflo(dq.x) * qs, bfhi(dq.x) * qs); dq.y = pk2(bflo(dq.y) * qs, bfhi(dq.y) * qs); dq.z = pk2(bflo(dq.z) * qs, bfhi(dq.z) * qs); dq.w = pk2(bflo(dq.w) * qs, bfhi(dq.w) * qs); }
            *(v4u*)((bf16*)(a.ws + B_DQ) + (prow0 + i) * 256 + ch8 * 8) = dq;
            *(v4u*)((bf16*)(a.ws + B_DK) + (prow0 + i) * 256 + ch8 * 8) = dk; }
        __syncthreads();
        for (int idx = tid; idx < 2048; idx += 512) { const int e = idx & 63, h = (idx >> 6) & 3, s8 = idx >> 8;
            *(v4u*)((bf16*)(dout + O_DVT) + ((size_t)(blk0 + h) * 64 + e) * 64 + 8 * s8) = gather8(S, SST, 8 * s8, h * 64 + e); }
    }
}

typedef float f32x16 __attribute__((ext_vector_type(16)));
typedef short s16x8 __attribute__((ext_vector_type(8)));
typedef short s16x4 __attribute__((ext_vector_type(4)));
__device__ __forceinline__ int crow(int r, int hi) { return (r & 3) + 8 * (r >> 2) + 4 * hi; }

template <int KIND>
__device__ __forceinline__ void attn_mfma_unit(const Args& a, int li, int b, int hh, int qb  , LAS unsigned char* lds, int tid, float lam, float oscale) {
    constexpr int KW = KIND ? 64 : 96, KST = KW + 8, VST = 72, NMAP = KIND ? 2 : 1, DSTEPS = KIND ? 2 : 6, CPR = KW / 8;
    constexpr int KBUF = 64 * KST * 2, VBUF = 64 * VST * 2, OFF_V = 2 * KBUF, OFF_WS = OFF_V + 2 * VBUF, OFF_OST = OFF_WS + 8 * 256, OSTW = 68;
    const int lane = tid & 63, w = __builtin_amdgcn_readfirstlane(tid >> 6), r32 = lane & 31, hi = lane >> 5;
    const int q0 = qb < 0 ? 0 : 64 + 256 * qb, NT = qb < 0 ? 1 : 5 + 4 * qb;
    const bool wact = qb >= 0 || w < 2;
    const int qpos = q0 + 32 * w + r32, wlast = (q0 + 32 * w + 31) >> 6;
    const size_t prow = (size_t)b * PSEQ + qpos;
    const bf16* Kg = KIND ? (const bf16*)(a.ws + B_DK) + (size_t)b * PSEQ * 256 + hh * 64 : (const bf16*)(a.ws + B_MK) + (size_t)b * PSEQ * 96;
    constexpr int KLD = KIND ? 256 : 96;
    const bf16* VTg = KIND ? (const bf16*)((const unsigned char*)a.out + O_DVT) + ((size_t)b * NCH * 4 + hh) * 4096 : (const bf16*)((const unsigned char*)a.out + O_MVT) + (size_t)b * NCH * 4096;
    constexpr int VTT = KIND ? 4 * 4096 : 4096;
    LAS float* wsf = (LAS float*)(lds + OFF_WS) + w * 64;
    LAS float* ost = (LAS float*)(lds + OFF_OST) + w * (32 * OSTW);
    s16x8 qf[NMAP][DSTEPS];
#pragma unroll
    for (int m = 0; m < NMAP; ++m)
#pragma unroll
        for (int ds = 0; ds < DSTEPS; ++ds) {
            const bf16* qp = KIND ? (const bf16*)(a.ws + B_DQ) + prow * 256 + hh * 64 + 32 * m + 16 * ds + 8 * hi : (const bf16*)(a.ws + B_MQ) + prow * 384 + hh * 96 + 16 * ds + 8 * hi;
            qf[m][ds] = wact ? *(const s16x8*)qp : (s16x8){0, 0, 0, 0, 0, 0, 0, 0}; }
    float mref[NMAP], lrun[NMAP]; f32x16 negm = (f32x16){}, o[NMAP][2];
#pragma unroll
    for (int m = 0; m < NMAP; ++m) { mref[m] = 0.f; lrun[m] = 0.f; o[m][0] = (f32x16){}; o[m][1] = (f32x16){}; }
    const int kc0 = tid, kc1 = tid + 512; const bool has1 = (CPR == 12) && kc1 < 64 * CPR;
    const int kr0 = kc0 / CPR, kh0 = kc0 % CPR, kr1 = kc1 / CPR, kh1 = kc1 % CPR, ve = tid >> 3, vh = tid & 7;
    v4u rk0, rk1 = {0u, 0u, 0u, 0u}, rv;
#define ATT_LOAD(t) do { rk0 = *(const v4u*)(Kg + (size_t)(64 * (t) + kr0) * KLD + kh0 * 8); if (has1) rk1 = *(const v4u*)(Kg + (size_t)(64 * (t) + kr1) * KLD + kh1 * 8); \
        rv = *(const v4u*)(VTg + (size_t)(t) * VTT + ve * 64 + vh * 8); } while (0)
#define ATT_STORE(bufi) do { *(LAS v4u*)(lds + (bufi) * KBUF + (kr0 * KST + kh0 * 8) * 2) = rk0; if (has1) *(LAS v4u*)(lds + (bufi) * KBUF + (kr1 * KST + kh1 * 8) * 2) = rk1; \
        *(LAS v4u*)(lds + OFF_V + (bufi) * VBUF + (ve * VST + vh * 8) * 2) = rv; } while (0)
    __syncthreads();
    ATT_LOAD(0); ATT_STORE(0);
    __syncthreads();
    for (int t = 0; t < NT; ++t) {
        const int bi = t & 1;
        if (t + 1 < NT) ATT_LOAD(t + 1);
        if (wact && t <= wlast) {
            const LAS unsigned char* Kb = lds + bi * KBUF; const LAS unsigned char* Vb = lds + OFF_V + bi * VBUF;
            const bool need_mask = (t == 0) || (64 * t + 63 > q0 + 32 * w);
#pragma unroll
            for (int m = 0; m < NMAP; ++m) {
                f32x16 p0, p1;
                if (KIND) { const float nm = -mref[m];
#pragma unroll
                    for (int r = 0; r < 16; ++r) { p0[r] = nm; p1[r] = nm; } }
                else { p0 = negm; p1 = negm; }
#pragma unroll
                for (int ds = 0; ds < DSTEPS; ++ds) {
                    const s16x8 k0 = *(const LAS s16x8*)(Kb + (r32 * KST + 32 * m * KIND + 16 * ds + 8 * hi) * 2);
                    const s16x8 k1 = *(const LAS s16x8*)(Kb + ((32 + r32) * KST + 32 * m * KIND + 16 * ds + 8 * hi) * 2);
                    p0 = __builtin_amdgcn_mfma_f32_32x32x16_bf16(k0, qf[m][ds], p0, 0, 0, 0);
                    p1 = __builtin_amdgcn_mfma_f32_32x32x16_bf16(k1, qf[m][ds], p1, 0, 0, 0); }
                asm volatile("s_nop 15\n\ts_nop 7" : "+v"(p0), "+v"(p1));
                if (need_mask) {
#pragma unroll
                    for (int r = 0; r < 16; ++r) { const int kv = 64 * t + crow(r, hi);
                        if (kv > qpos || kv < 48) p0[r] = -1e30f;
                        if (kv + 32 > qpos || kv + 32 < 48) p1[r] = -1e30f; } }
                float mx = fmaxf(fmaxf(p0[0], p1[0]), fmaxf(p0[1], p1[1]));
#pragma unroll
                for (int r = 2; r < 16; r += 2) mx = fmaxf(mx, fmaxf(fmaxf(p0[r], p1[r]), fmaxf(p0[r + 1], p1[r + 1])));
                { auto rr = __builtin_amdgcn_permlane32_swap(__float_as_uint(mx), __float_as_uint(mx), false, false); mx = fmaxf(__uint_as_float(rr[0]), __uint_as_float(rr[1])); }
                if (t == 0 || __any(mx > 6.0f)) {
                    const float delta = t == 0 ? mx : fmaxf(mx, 0.f); mref[m] += delta;
#pragma unroll
                    for (int r = 0; r < 16; ++r) { p0[r] -= delta; p1[r] -= delta; if (!KIND) negm[r] = -mref[m]; }
                    if (t != 0) { const float alpha = __builtin_amdgcn_exp2f(-delta); lrun[m] *= alpha;
                        if (hi == 0) wsf[r32] = alpha;
                        f32x4 al[4];
#pragma unroll
                        for (int g = 0; g < 4; ++g) al[g] = *(const LAS f32x4*)(wsf + 8 * g + 4 * hi);
#pragma unroll
                        for (int r = 0; r < 16; ++r) { o[m][0][r] *= al[r >> 2][r & 3]; o[m][1][r] *= al[r >> 2][r & 3]; } } }
                float ls = 0.f;
#pragma unroll
                for (int r = 0; r < 16; ++r) { p0[r] = __builtin_amdgcn_exp2f(p0[r]); p1[r] = __builtin_amdgcn_exp2f(p1[r]); ls += p0[r] + p1[r]; }
                lrun[m] += ls;
                s16x8 pw[4];
#pragma unroll
                for (int ks = 0; ks < 4; ++ks) { v4u u;
                    if (ks < 2) { u.x = pg8::cvt_pk_bf16(p0[8 * ks], p0[8 * ks + 1]); u.y = pg8::cvt_pk_bf16(p0[8 * ks + 2], p0[8 * ks + 3]); u.z = pg8::cvt_pk_bf16(p0[8 * ks + 4], p0[8 * ks + 5]); u.w = pg8::cvt_pk_bf16(p0[8 * ks + 6], p0[8 * ks + 7]); }
                    else { const int k2 = ks - 2; u.x = pg8::cvt_pk_bf16(p1[8 * k2], p1[8 * k2 + 1]); u.y = pg8::cvt_pk_bf16(p1[8 * k2 + 2], p1[8 * k2 + 3]); u.z = pg8::cvt_pk_bf16(p1[8 * k2 + 4], p1[8 * k2 + 5]); u.w = pg8::cvt_pk_bf16(p1[8 * k2 + 6], p1[8 * k2 + 7]); }
                    pw[ks] = __builtin_bit_cast(s16x8, u); }
#pragma unroll
                for (int d0 = 0; d0 < 2; ++d0)
#pragma unroll
                    for (int ks = 0; ks < 4; ++ks) { const LAS unsigned char* vp = Vb + ((32 * d0 + r32) * VST + 16 * ks + 4 * hi) * 2;
                        const s16x4 va = *(const LAS s16x4*)vp, vb = *(const LAS s16x4*)(vp + 16);
                        const s16x8 vf = {va[0], va[1], va[2], va[3], vb[0], vb[1], vb[2], vb[3]};
                        o[m][d0] = __builtin_amdgcn_mfma_f32_32x32x16_bf16(pw[ks], vf, o[m][d0], 0, 0, 0); }
            }
        }
        if (t + 1 < NT) ATT_STORE(bi ^ 1);
        __syncthreads();
    }
#undef ATT_LOAD
#undef ATT_STORE
    if (wact) {
#pragma unroll
        for (int m = 0; m < NMAP; ++m) asm volatile("s_nop 15\n\ts_nop 7" : "+v"(o[m][0]), "+v"(o[m][1]));
        float il0, il1 = 0.f;
        { float l = lrun[0]; l += __shfl_xor(l, 32); il0 = l > 0.f ? 1.f / l : 0.f; }
        if (KIND) { float l = lrun[NMAP - 1]; l += __shfl_xor(l, 32); il1 = l > 0.f ? lam / l : 0.f; }
        if (hi == 0) { wsf[r32] = il0; wsf[32 + r32] = il1; }
        f32x4 a0[4], a1[4];
#pragma unroll
        for (int g = 0; g < 4; ++g) { a0[g] = *(const LAS f32x4*)(wsf + 8 * g + 4 * hi); a1[g] = *(const LAS f32x4*)(wsf + 32 + 8 * g + 4 * hi); }
#pragma unroll
        for (int d0 = 0; d0 < 2; ++d0)
#pragma unroll
            for (int r = 0; r < 16; ++r) { float v = o[0][d0][r] * a0[r >> 2][r & 3]; if (KIND) v -= o[NMAP - 1][d0][r] * a1[r >> 2][r & 3];
                ost[crow(r, hi) * OSTW + 32 * d0 + r32] = v; }
        const int row = lane >> 1, half = lane & 1, p = q0 + 32 * w + row;
        f32x4 v[8]; float ss = 0.f;
#pragma unroll
        for (int i = 0; i < 8; ++i) { v[i] = *(const LAS f32x4*)(ost + row * OSTW + 32 * half + 4 * i); ss += (v[i][0] * v[i][0] + v[i][1] * v[i][1]) + (v[i][2] * v[i][2] + v[i][3] * v[i][3]); }
        ss += __shfl_xor(ss, 1);
        const float rs = KIND ? __builtin_amdgcn_rsqf(ss * (1.f / 64.f) + EPS) * oscale : 1.f;
        const int sr = qb >= 0 ? b * TT + p - 64 : ((p >= 48 && b == 0) ? MR + p - 48 : -1);
        if (sr >= 0) { bf16* dst = (bf16*)a.out + (size_t)sr * DM + (KIND ? 768 : 512) + hh * 64 + 32 * half; const float* gn = a.in[I_DNORM] + li * 64 + 32 * half;
#pragma unroll
            for (int i = 0; i < 4; ++i) { f32x4 x0 = v[2 * i] * rs, x1 = v[2 * i + 1] * rs;
                if (KIND) { const f32x4 g0 = *(const f32x4*)(gn + 8 * i), g1 = *(const f32x4*)(gn + 8 * i + 4); x0 = x0 * g0; x1 = x1 * g1; }
                *(v4u*)(dst + 8 * i) = pack8(x0, x1); } }
    }
    __syncthreads();
}

__device__ __forceinline__ s16x8 ldperm(const bf16* p, int hi) { const s16x4 x = *(const s16x4*)(p + 4 * hi), y = *(const s16x4*)(p + 8 + 4 * hi); return (s16x8){x[0], x[1], x[2], x[3], y[0], y[1], y[2], y[3]}; }
__device__ __forceinline__ s16x8 packacc(const f32x16& v, int k) { v4u u; u.x = pg8::cvt_pk_bf16(v[8 * k], v[8 * k + 1]); u.y = pg8::cvt_pk_bf16(v[8 * k + 2], v[8 * k + 3]); u.z = pg8::cvt_pk_bf16(v[8 * k + 4], v[8 * k + 5]); u.w = pg8::cvt_pk_bf16(v[8 * k + 6], v[8 * k + 7]); return __builtin_bit_cast(s16x8, u); }
template <int KIND>
__device__ __forceinline__ void lin_mfma_unit(const Args& a, int li, int b, LAS unsigned char* lds, int tid) {
    constexpr int DK = KIND ? 64 : 32, NDS = DK / 16, NDB = DK / 32, OTW = 68;
    const int lane = tid & 63, w = __builtin_amdgcn_readfirstlane(tid >> 6), r32 = lane & 31, hi = lane >> 5, h = w >> 1, e0 = 32 * (w & 1);
    const bf16* Qb = (const bf16*)(a.ws + (KIND ? B_RQ : B_GQ)); const bf16* Kb = (const bf16*)(a.ws + (KIND ? B_RK : B_GK));
    const bf16* KTb = (const bf16*)((const unsigned char*)a.out + (KIND ? O_RKT : O_GKT)); const bf16* VTb = (const bf16*)(a.ws + (KIND ? B_RV : B_GV));
    const float* gain = a.in[KIND ? I_RNORM : I_GNORM] + li * 64; const bf16* proj = (const bf16*)(a.ws + B_PROJ); bf16* ob = (bf16*)a.out;
    LAS float* Ot = (LAS float*)lds;
    const float dret = __builtin_amdgcn_exp2f(64.f * lg2gamma(h));
    f32x16 S[NDB];
#pragma unroll
    for (int db = 0; db < NDB; ++db) S[db] = (f32x16){};
    __syncthreads();
    for (int c = 0; c < NCH; ++c) {
        const size_t blk = (size_t)(b * NCH + c) * 4 + h;
        const bf16* q = Qb + blk * 64 * DK; const bf16* k = Kb + blk * 64 * DK; const bf16* kT = KTb + blk * DK * 64; const bf16* vT = VTb + blk * 4096;
        s16x8 qf[2][NDS], kf[2][NDS], vf[4];
#pragma unroll
        for (int ib = 0; ib < 2; ++ib)
#pragma unroll
            for (int ds = 0; ds < NDS; ++ds) { qf[ib][ds] = ldperm(q + (32 * ib + r32) * DK + 16 * ds, hi); kf[ib][ds] = ldperm(k + (32 * ib + r32) * DK + 16 * ds, hi); }
#pragma unroll
        for (int ks = 0; ks < 4; ++ks) vf[ks] = ldperm(vT + (e0 + r32) * 64 + 16 * ks, hi);
        f32x16 a00 = (f32x16){}, a01 = (f32x16){}, a11 = (f32x16){};
#pragma unroll
        for (int ds = 0; ds < NDS; ++ds) { a00 = __builtin_amdgcn_mfma_f32_32x32x16_bf16(kf[0][ds], qf[0][ds], a00, 0, 0, 0); a01 = __builtin_amdgcn_mfma_f32_32x32x16_bf16(kf[0][ds], qf[1][ds], a01, 0, 0, 0);
            a11 = __builtin_amdgcn_mfma_f32_32x32x16_bf16(kf[1][ds], qf[1][ds], a11, 0, 0, 0); }
        asm volatile("s_nop 15\n\ts_nop 15" : "+v"(a00), "+v"(a01), "+v"(a11));
#pragma unroll
        for (int r = 0; r < 16; ++r) if (crow(r, hi) > r32) { a00[r] = 0.f; a11[r] = 0.f; }
        f32x16 O[2]; O[0] = (f32x16){}; O[1] = (f32x16){};
#pragma unroll
        for (int db = 0; db < NDB; ++db)
#pragma unroll
            for (int ksub = 0; ksub < 2; ++ksub) { const s16x8 sb = packacc(S[db], ksub);
                O[0] = __builtin_amdgcn_mfma_f32_32x32x16_bf16(qf[0][2 * db + ksub], sb, O[0], 0, 0, 0); O[1] = __builtin_amdgcn_mfma_f32_32x32x16_bf16(qf[1][2 * db + ksub], sb, O[1], 0, 0, 0); }
#pragma unroll
        for (int ksub = 0; ksub < 2; ++ksub) { O[0] = __builtin_amdgcn_mfma_f32_32x32x16_bf16(packacc(a00, ksub), vf[ksub], O[0], 0, 0, 0);
            O[1] = __builtin_amdgcn_mfma_f32_32x32x16_bf16(packacc(a01, ksub), vf[ksub], O[1], 0, 0, 0); O[1] = __builtin_amdgcn_mfma_f32_32x32x16_bf16(packacc(a11, ksub), vf[2 + ksub], O[1], 0, 0, 0); }
#pragma unroll
        for (int db = 0; db < NDB; ++db) {
#pragma unroll
            for (int ks = 0; ks < 4; ++ks) S[db] = __builtin_amdgcn_mfma_f32_32x32x16_bf16(ldperm(kT + (32 * db + r32) * 64 + 16 * ks, hi), vf[ks], S[db], 0, 0, 0);
            if (KIND) { S[db] = S[db] * dret; }
            else { const float* dp = (const float*)(a.ws + WS_GD) + blk * 32;
#pragma unroll
                for (int g = 0; g < 4; ++g) { const f32x4 dv = *(const f32x4*)(dp + 8 * g + 4 * hi); S[db][4 * g] *= dv[0]; S[db][4 * g + 1] *= dv[1]; S[db][4 * g + 2] *= dv[2]; S[db][4 * g + 3] *= dv[3]; } } }
        asm volatile("s_nop 15\n\ts_nop 15" : "+v"(O[0]), "+v"(O[1]));
#pragma unroll
        for (int db = 0; db < NDB; ++db) asm volatile("s_nop 15\n\ts_nop 15" : "+v"(S[db]));
#pragma unroll
        for (int ib = 0; ib < 2; ++ib)
#pragma unroll
            for (int r = 0; r < 16; ++r) Ot[(h * 64 + 32 * ib + crow(r, hi)) * OTW + e0 + r32] = O[ib][r];
        __syncthreads();
        { const int row = 32 * (w & 1) + (lane >> 1), half = lane & 1, sr = src_row(b, c, row);
            f32x4 v[8]; float s1 = 0.f;
#pragma unroll
            for (int i = 0; i < 8; ++i) { v[i] = *(const LAS f32x4*)(Ot + (h * 64 + row) * OTW + 32 * half + 4 * i); s1 += (v[i][0] + v[i][1]) + (v[i][2] + v[i][3]); }
            float mean = 0.f; if (KIND) { s1 += __shfl_xor(s1, 1); mean = s1 * (1.f / 64.f); }
            float s2 = 0.f;
#pragma unroll
            for (int i = 0; i < 8; ++i) { v[i] = v[i] - mean; s2 += (v[i][0] * v[i][0] + v[i][1] * v[i][1]) + (v[i][2] * v[i][2] + v[i][3] * v[i][3]); }
            s2 += __shfl_xor(s2, 1);
            const float rs = __builtin_amdgcn_rsqf(s2 * (1.f / 64.f) + EPS);
            if (sr >= 0 && (c > 0 || b == 0)) { const bf16* ogp = proj + (size_t)sr * N1 + (KIND ? C_ROG : C_AOG) + h * 64 + 32 * half; bf16* dst = ob + (size_t)sr * DM + KIND * 256 + h * 64 + 32 * half; const float* gp = gain + 32 * half;
#pragma unroll
                for (int i = 0; i < 4; ++i) { const v4u og = *(const v4u*)(ogp + 8 * i); const f32x4 g0 = *(const f32x4*)(gp + 8 * i), g1 = *(const f32x4*)(gp + 8 * i + 4);
                    f32x4 x0 = v[2 * i] * rs * g0, x1 = v[2 * i + 1] * rs * g1;
                    x0[0] *= silu_f(bflo(og.x)); x0[1] *= silu_f(bfhi(og.x)); x0[2] *= silu_f(bflo(og.y)); x0[3] *= silu_f(bfhi(og.y)); x1[0] *= silu_f(bflo(og.z)); x1[1] *= silu_f(bfhi(og.z)); x1[2] *= silu_f(bflo(og.w)); x1[3] *= silu_f(bfhi(og.w));
                    *(v4u*)(dst + 8 * i) = pack8(x0, x1); } } }
        __syncthreads();
    }
}

template <int MODE, int KSTEPS  >
__device__ __forceinline__ void thin_unit(const bf16* A, int lda, const bf16* Bt, int u, bf16* H, float* stats_out, const float* stats_in, bf16* ACT, LAS unsigned char* lds, int tid) {
    constexpr int K = KSTEPS * 256;
    const int lane = tid & 63, w = __builtin_amdgcn_readfirstlane(tid >> 6), fr = lane & 15, fq = lane >> 4;
    int brow[4];
#pragma unroll
    for (int nb = 0; nb < 4; ++nb) brow[nb] = MODE == 0 ? 64 * u + 16 * nb + fr : 256 * (u >> 2) + 32 * (u & 3) + (nb >> 1) * 128 + 16 * (nb & 1) + fr;
    f32x4 acc[4];
#pragma unroll
    for (int nb = 0; nb < 4; ++nb) acc[nb] = (f32x4){0.f, 0.f, 0.f, 0.f};
    const bf16* ap = A + (size_t)fr * lda + w * (KSTEPS * 32) + 8 * fq;
    constexpr int B1 = KSTEPS > 6 ? 6 : KSTEPS;
    { s16x8 af[B1], bf[B1][4];
#pragma unroll
        for (int s = 0; s < B1; ++s) { af[s] = *(const s16x8*)(ap + 32 * s);
#pragma unroll
            for (int nb = 0; nb < 4; ++nb) bf[s][nb] = *(const s16x8*)(Bt + (size_t)brow[nb] * K + w * (KSTEPS * 32) + 32 * s + 8 * fq); }
#pragma unroll
        for (int s = 0; s < B1; ++s)
#pragma unroll
            for (int nb = 0; nb < 4; ++nb) acc[nb] = __builtin_amdgcn_mfma_f32_16x16x32_bf16(bf[s][nb], af[s], acc[nb], 0, 0, 0); }
    if (KSTEPS > B1) { constexpr int B2 = KSTEPS > B1 ? KSTEPS - B1 : 1; s16x8 af[B2], bf[B2][4];
#pragma unroll
        for (int s = 0; s < B2; ++s) { af[s] = *(const s16x8*)(ap + 32 * (B1 + s));
#pragma unroll
            for (int nb = 0; nb < 4; ++nb) bf[s][nb] = *(const s16x8*)(Bt + (size_t)brow[nb] * K + w * (KSTEPS * 32) + 32 * (B1 + s) + 8 * fq); }
#pragma unroll
        for (int s = 0; s < B2; ++s)
#pragma unroll
            for (int nb = 0; nb < 4; ++nb) acc[nb] = __builtin_amdgcn_mfma_f32_16x16x32_bf16(bf[s][nb], af[s], acc[nb], 0, 0, 0); }
    asm volatile("s_nop 15" : "+v"(acc[0]), "+v"(acc[1]), "+v"(acc[2]), "+v"(acc[3]));
    LAS f32x4* part = (LAS f32x4*)lds;
    __syncthreads();
#pragma unroll
    for (int nb = 0; nb < 4; ++nb) part[(w * 4 + nb) * 64 + lane] = acc[nb];
    __syncthreads();
    if (w == 0) {
#pragma unroll
        for (int nb = 0; nb < 4; ++nb) {
#pragma unroll
            for (int w2 = 1; w2 < 8; ++w2) acc[nb] = acc[nb] + part[(w2 * 4 + nb) * 64 + lane]; }
        const int row = MR + fr;
        if (MODE == 0) { float ss = 0.f;
#pragma unroll
            for (int nb = 0; nb < 4; ++nb) { bf16* p = H + (size_t)row * DM + 64 * u + 16 * nb + 4 * fq; const v2u wv = *(const v2u*)p;
                const float x0 = acc[nb][0] + bflo(wv.x), x1 = acc[nb][1] + bfhi(wv.x), x2 = acc[nb][2] + bflo(wv.y), x3 = acc[nb][3] + bfhi(wv.y);
                ss += (x0 * x0 + x1 * x1) + (x2 * x2 + x3 * x3);
                v2u o; o.x = pg8::cvt_pk_bf16(x0, x1); o.y = pg8::cvt_pk_bf16(x2, x3); *(v2u*)p = o; }
            ss += __shfl_xor(ss, 16); ss += __shfl_xor(ss, 32);
            if (fq == 0) stats_out[(size_t)row * 16 + u] = ss;
        } else { const f32x4* sp = (const f32x4*)(stats_in + (size_t)row * 16); const f32x4 s0 = sp[0], s1 = sp[1], s2 = sp[2], s3 = sp[3];
            const float st = ((s0[0] + s0[1]) + (s0[2] + s0[3])) + ((s1[0] + s1[1]) + (s1[2] + s1[3])) + ((s2[0] + s2[1]) + (s2[2] + s2[3])) + ((s3[0] + s3[1]) + (s3[2] + s3[3]));
            const float rs = __builtin_amdgcn_rsqf(st * (1.f / 1024.f) + EPS);
#pragma unroll
            for (int nb = 0; nb < 2; ++nb) { float y[4];
#pragma unroll
                for (int t = 0; t < 4; ++t) y[t] = silu_f(acc[nb][t] * rs) * (acc[2 + nb][t] * rs);
                v2u o; o.x = pg8::cvt_pk_bf16(y[0], y[1]); o.y = pg8::cvt_pk_bf16(y[2], y[3]);
                *(v2u*)(ACT + (size_t)row * DFF + 128 * (u >> 2) + 32 * (u & 3) + 16 * nb + 4 * fq) = o; } }
    }
    __syncthreads();
}

#ifndef REP_PREP
#define REP_PREP 1
#endif
#ifndef REP_MIX
#define REP_MIX 1
#endif
#ifndef REP_P0
#define REP_P0 1
#endif
#ifndef REP_CONV
#define REP_CONV 1
#endif
#ifndef REP_G1
#define REP_G1 1
#endif
#ifndef REP_MGU
#define REP_MGU 1
#endif
#ifndef REP_MDN
#define REP_MDN 1
#endif
#ifndef REP_BAR
#define REP_BAR 0
#endif
#ifndef REP_PART
#define REP_PART -1
#endif
#ifndef MK_ONE_LAUNCH
#define MK_ONE_LAUNCH 1
#endif
constexpr int NPHASE = 20;
constexpr int CW_Q = 12288;
__global__ void __launch_bounds__(512, 2) mega_fwd(Args a) {
    extern __shared__ __attribute__((aligned(16))) unsigned char lds_raw[];
    LAS unsigned char* lds = (LAS unsigned char*)lds_raw;
    volatile LAS unsigned* MISC = (volatile LAS unsigned*)(lds + MISC_OFF);
    const int tid = threadIdx.x, lane = tid & 63, wave = __builtin_amdgcn_readfirstlane(tid >> 6), G = gridDim.x;
    for (int u = tid; u < (LDS_BYTES - RING_BYTES) / 4; u += 512) ((LAS unsigned*)(lds + RING_BYTES))[u] = 0u;
    __syncthreads();
    gu32* ctl = (gu32*)(a.ws + WS_CTL);
    const int lo = a.ph_lo, hi = a.ph_hi;
    XcdBarrier bar; bar.bar = (unsigned*)(ctl + CW_BAR); bar.x = 0; bar.st = nullptr;
    if (hi - lo > 1) bar = xcd_barrier_post((unsigned*)(ctl + CW_BAR), MISC + 8);
#define IN(k) (lo <= (k) && (k) < hi)
#define OPQ() int ptid = threadIdx.x; asm volatile("" : "+v"(ptid)); const int plane = ptid & 63; (void)plane
#define SEAM(k) do { if (IN(k) && IN((k) + 1)) xcd_barrier(bar); } while (0)
    bf16* hb = (bf16*)(a.ws + WS_HB); float* stA = (float*)(a.ws + WS_STA); float* stB = (float*)(a.ws + WS_STB);

    for (int rep = 0; rep < REP_BAR; ++rep) xcd_barrier(bar);
    if (IN(0)) { OPQ(); for (int rep = 0; rep < REP_P0; ++rep) { p0_prologue(a, lds, ptid, plane, wave); __syncthreads(); } }
    SEAM(0);

    for (int li = 0; li < 2; ++li) {
        const int pb = 1 + 6 * li;
        if (IN(pb)) {
            pg8::Gemm g{hb, (const bf16*)(a.ws + WS_W1T + li * W1T_BYTES), DM, 0, nullptr}; pg8::StaticOrder S; S.init(NPAN, N1 / 256, G, (int)blockIdx.x);
            EpiProj E{(bf16*)(a.ws + B_PROJ), stA};
            for (int rep = 0; rep < REP_G1; ++rep) pg8::gemm_phase<EpiProj, pg8::StaticOrder, false>(lds, g, S, E);
        }
        SEAM(pb);
        if (IN(pb + 1)) { OPQ(); for (int rep = 0; rep < REP_PREP; ++rep) for (int u = blockIdx.x; u < NB * NCH * 4; u += G) { const int part = ((u & 3) + (u >> 8)) & 3;     if (rep > 0 && REP_PART >= 0 && part != REP_PART) continue; int ut = ptid; asm volatile("" : "+v"(ut)); prep2_unit(a, li, (u >> 2) / NCH, (u >> 2) % NCH, part, lds, ut); } __syncthreads(); }
        SEAM(pb + 1);
        if (IN(pb + 2)) {
            OPQ(); const int tid = ptid;
            LAS int* qid = (LAS int*)(lds + RING_BYTES + 64);
            float lam, lam_init; { const float* lv = a.in[I_DLAM] + li * 128; float s01 = 0.f, s23 = 0.f;
                for (int d = 0; d < 32; ++d) { s01 += lv[d] * lv[32 + d]; s23 += lv[64 + d] * lv[96 + d]; }
                lam_init = 0.8f - 0.6f * __expf(-0.3f * (float)li); lam = __expf(s01) - __expf(s23) + lam_init;
                lam = __uint_as_float(__builtin_amdgcn_readfirstlane(__float_as_uint(lam))); lam_init = __uint_as_float(__builtin_amdgcn_readfirstlane(__float_as_uint(lam_init))); }
            for (int rep = 0; rep < REP_MIX; ++rep)
            for (;;) {
                __syncthreads();
                if (tid == 0) *qid = (int)__hip_atomic_fetch_add(ctl + CW_Q + 64 * (li + 2 * rep), 1u, RLX_AGENT);
                __syncthreads();
                const int id = *qid;
                int utid = ptid; asm volatile("" : "+v"(utid));
                if (id >= 32 + 1024 + 8) break;
                if (id < 32) { if ((id & 1) == 0) lin_mfma_unit<0>(a, li, id >> 1, lds, utid); else lin_mfma_unit<1>(a, li, id >> 1, lds, utid); }
                else { const int v = id - 32; int qb, kind, b, hh;
                    if (v < 1024) { qb = 7 - (v >> 7); const int rem = v & 127; kind = rem >> 6; b = (rem >> 2) & 15; hh = rem & 3; } else { qb = -1; kind = (v - 1024) >> 2; b = 0; hh = v & 3; }
                    if (kind == 0) attn_mfma_unit<0>(a, li, b, hh, qb, lds, utid, 0.f, 1.f); else attn_mfma_unit<1>(a, li, b, hh, qb, lds, utid, lam, 1.f - lam_init); }
            }
        }
        SEAM(pb + 2);
        if (IN(pb + 3)) {
            if (li == 0) { OPQ(); for (int u = blockIdx.x; u < 16; u += G) thin_unit<0, 4>((const bf16*)a.out + (size_t)MR * DM, DM, (const bf16*)(a.ws + WS_WOT), u, hb, stB, nullptr, nullptr, lds, ptid); }
            pg8::Gemm g{(const bf16*)a.out, (const bf16*)(a.ws + WS_WOT + li * WOT_BYTES), DM, 0, nullptr}; pg8::StaticOrder S; S.init(NPAN - 1, 4, G, (int)blockIdx.x);
            EpiResid E{hb, stB};
            pg8::gemm_phase<EpiResid, pg8::StaticOrder, false>(lds, g, S, E);
        }
        SEAM(pb + 3);
        if (li == 0) {
            if (IN(5)) {
                { OPQ(); for (int u = blockIdx.x; u < 88; u += G) thin_unit<1, 4>(hb + (size_t)MR * DM, DM, (const bf16*)(a.ws + WS_WGU), u, nullptr, nullptr, stB, (bf16*)(a.ws + B_ACT), lds, ptid); }
                pg8::Gemm g{hb, (const bf16*)(a.ws + WS_WGU), DM, 0, nullptr}; pg8::StaticOrder S; S.init(NPAN - 1, 2 * DFF / 256, G, (int)blockIdx.x);
                EpiSwiglu E{(bf16*)(a.ws + B_ACT), DFF, stB};
                pg8::gemm_phase<EpiSwiglu, pg8::StaticOrder, false>(lds, g, S, E);
            }
            SEAM(5);
            if (IN(6)) {
                { OPQ(); for (int u = blockIdx.x; u < 16; u += G) thin_unit<0, 11>((const bf16*)(a.ws + B_ACT) + (size_t)MR * DFF, DFF, (const bf16*)(a.ws + WS_WD), u, hb, stA, nullptr, nullptr, lds, ptid); }
                pg8::Gemm g{(const bf16*)(a.ws + B_ACT), (const bf16*)(a.ws + WS_WD), DFF, 0, nullptr}; pg8::StaticOrder S; S.init(NPAN - 1, 4, G, (int)blockIdx.x);
                EpiResid E{hb, stA};
                pg8::gemm_phase<EpiResid, pg8::StaticOrder, false>(lds, g, S, E);
            }
            SEAM(6);
        }
    }
    if (IN(11)) { OPQ(); const int tid = ptid, lane = plane;
        LAS float* scr = (LAS float*)(lds + wave * 16384);
        const int gw = blockIdx.x * 8 + wave, NGW = G * 8;
        constexpr int IG = 16 * 56, ID = 56 * 16;
        for (int rep = 0; rep < REP_CONV; ++rep)
        for (int it = gw; it < 8 * (2 * IG + ID); it += NGW) { const int e = it / (2 * IG + ID); int r = it % (2 * IG + ID);
            if (r < IG) { transpose_item(a.in[I_EG] + (size_t)e * DM * DFE, DM, DFE, a.in[I_FNORM] + DM, (bf16*)(a.ws + B_EGU + e * EGU_BYTES), r / 56, r % 56, 1, scr, lane); continue; } r -= IG;
            if (r < IG) { transpose_item(a.in[I_EU] + (size_t)e * DM * DFE, DM, DFE, a.in[I_FNORM] + DM, (bf16*)(a.ws + B_EGU + e * EGU_BYTES), r / 56, r % 56, 2, scr, lane); continue; } r -= IG;
            transpose_item(a.in[I_ED] + (size_t)e * DFE * DM, DFE, DM, nullptr, (bf16*)(a.ws + B_ED + e * ED_BYTES), r / 16, r % 16, 0, scr, lane); }
        for (int i = blockIdx.x * 512 + tid; i < MAXPAN * 256; i += G * 512) { ((int*)(a.ws + MO_ROWIDX))[i] = -1; ((int*)(a.ws + MO_PDST))[i] = -1; ((f32x2*)(a.ws + MO_PINFO))[i] = (f32x2){0.f, 0.f}; }
        for (int blk = blockIdx.x; blk < MR / 128; blk += G) route_block(a, blk, lds, tid, lane, wave);
    }
    SEAM(11);
    LAS int* offs = (LAS int*)(lds + RING_BYTES + 128);
    if (IN(12)) { OPQ(); const int tid = ptid;
        moe_offsets(a, offs, tid);
        for (int idx = blockIdx.x * 512 + tid; idx < 2 * MR; idx += G * 512) { const int tok = idx >> 1, e = ((const int*)(a.ws + MO_TOKE))[idx], gpos = offs[e] + ((const int*)(a.ws + MO_TOKP))[idx];
            const f32x4* sp = (const f32x4*)(stB + (size_t)tok * 16); const f32x4 s0 = sp[0], s1 = sp[1], s2 = sp[2], s3 = sp[3];
            const float ss = ((s0[0] + s0[1]) + (s0[2] + s0[3])) + ((s1[0] + s1[1]) + (s1[2] + s1[3])) + ((s2[0] + s2[1]) + (s2[2] + s2[3])) + ((s3[0] + s3[1]) + (s3[2] + s3[3]));
            ((int*)(a.ws + MO_ROWIDX))[gpos] = tok; ((int*)(a.ws + MO_PDST))[gpos] = idx;
            ((f32x2*)(a.ws + MO_PINFO))[gpos] = (f32x2){__builtin_amdgcn_rsqf(ss * (1.f / 1024.f) + EPS), __int_as_float(((const int*)(a.ws + MO_TOKW))[idx])}; }
        if (blockIdx.x == 0 && tid < MAXPAN + 8) { int e = 0;
            for (int k = 1; k < 8; ++k) if (tid * 256 >= offs[k]) e = k;
            ((int*)(a.ws + MO_PEXP))[tid] = e; }
    }
    SEAM(12);
    for (int ci = 0; ci < 3; ++ci) {
        if (IN(13 + 2 * ci) || IN(14 + 2 * ci)) moe_offsets(a, offs, tid);
        int nP = 0; if (IN(13 + 2 * ci) || IN(14 + 2 * ci)) { nP = __builtin_amdgcn_readfirstlane(offs[8]) - 128 * ci; nP = nP > 128 ? 128 : nP; }
        if (IN(13 + 2 * ci) && nP > 0) {
            pg8::Gemm g{hb, (const bf16*)(a.ws + B_EGU), DM, EGU_BYTES, (const int*)(a.ws + MO_ROWIDX)}; pg8::MoeOrder S; S.init(nP, 2 * DFE / 256, G, (int)blockIdx.x, 128 * ci, (const int*)(a.ws + MO_PEXP));
            EpiSwigluMoe E{(bf16*)(a.ws + B_EACT), (const f32x2*)(a.ws + MO_PINFO)};
            for (int rep = 0; rep < REP_MGU; ++rep) pg8::gemm_phase<EpiSwigluMoe, pg8::MoeOrder, true>(lds, g, S, E);
        }
        SEAM(13 + 2 * ci);
        if (IN(14 + 2 * ci) && nP > 0) {
            pg8::Gemm g{(const bf16*)(a.ws + B_EACT), (const bf16*)(a.ws + B_ED), DFE, ED_BYTES, nullptr}; pg8::MoeOrder S; S.init(nP, 4, G, (int)blockIdx.x, 128 * ci, (const int*)(a.ws + MO_PEXP));
            EpiMoeDown E{(unsigned char*)a.out, (const int*)(a.ws + MO_PDST), (const f32x2*)(a.ws + MO_PINFO)};
            for (int rep = 0; rep < REP_MDN; ++rep) pg8::gemm_phase<EpiMoeDown, pg8::MoeOrder, false>(lds, g, S, E);
        }
        SEAM(14 + 2 * ci);
    }
    if (IN(19)) { OPQ(); const int lane = plane;
        const float* fn = a.in[I_FINAL];
        for (int r = blockIdx.x * 8 + wave; r < MR; r += G * 8) {
            unsigned char* orow = (unsigned char*)a.out + (size_t)r * 4096; float v[16]; float ss = 0.f;
#pragma unroll
            for (int hf = 0; hf < 2; ++hf) { const int k = 512 * hf + 8 * lane; const v4u h4 = *(const v4u*)(hb + (size_t)r * DM + k), y0 = *(const v4u*)(orow + 2 * k), y1 = *(const v4u*)(orow + 2048 + 2 * k);
                const unsigned hw[4] = {h4.x, h4.y, h4.z, h4.w}, aw[4] = {y0.x, y0.y, y0.z, y0.w}, bw[4] = {y1.x, y1.y, y1.z, y1.w};
#pragma unroll
                for (int t = 0; t < 4; ++t) { const float x0 = bflo(hw[t]) + bflo(aw[t]) + bflo(bw[t]), x1 = bfhi(hw[t]) + bfhi(aw[t]) + bfhi(bw[t]); v[8 * hf + 2 * t] = x0; v[8 * hf + 2 * t + 1] = x1; ss += x0 * x0 + x1 * x1; } }
            ss = wave_sum(ss); const float rs = __builtin_amdgcn_rsqf(ss * (1.f / 1024.f) + EPS);
#pragma unroll
            for (int hf = 0; hf < 2; ++hf) { const int k = 512 * hf + 8 * lane; const f32x4 g0 = *(const f32x4*)(fn + k), g1 = *(const f32x4*)(fn + k + 4);
                *(f32x4*)(orow + 4 * k) = (f32x4){v[8 * hf] * rs * g0[0], v[8 * hf + 1] * rs * g0[1], v[8 * hf + 2] * rs * g0[2], v[8 * hf + 3] * rs * g0[3]};
                *(f32x4*)(orow + 4 * k + 16) = (f32x4){v[8 * hf + 4] * rs * g1[0], v[8 * hf + 5] * rs * g1[1], v[8 * hf + 6] * rs * g1[2], v[8 * hf + 7] * rs * g1[3]}; }
        }
    }
#undef IN
#undef SEAM
}

extern "C" void kernel_launch(void* const* d_in, const int* in_sizes, int n_in, void* d_out, int out_size, void* d_ws, size_t ws_size, hipStream_t stream) {
    static int grid = 0;
    if (grid == 0) {
        if (n_in != 24 || in_sizes[0] != MR * DM || out_size != MR * DM || ws_size < WS_NEED) { fprintf(stderr, "kernel_launch: unexpected problem (n_in %d, in0 %d, out %d, ws %zu < %zu)\n", n_in, n_in > 0 ? in_sizes[0] : -1, out_size, ws_size, (size_t)WS_NEED); grid = -1; return; }
        int dev = 0, cus = 0, per_cu = 0;
        if (hipGetDevice(&dev) != hipSuccess || hipDeviceGetAttribute(&cus, hipDeviceAttributeMultiprocessorCount, dev) != hipSuccess) { grid = -1; return; }
        if (hipFuncSetAttribute((const void*)mega_fwd, hipFuncAttributeMaxDynamicSharedMemorySize, LDS_BYTES) != hipSuccess) { fprintf(stderr, "kernel_launch: hipFuncSetAttribute failed\n"); grid = -1; return; }
        if (hipOccupancyMaxActiveBlocksPerMultiprocessor(&per_cu, (const void*)mega_fwd, 512, LDS_BYTES) != hipSuccess || per_cu < 1) fprintf(stderr, "kernel_launch: occupancy query reports %d\n", per_cu);
        (void)hipGetLastError();
        grid = cus;
    }
    if (grid < 0) return;
    if (hipMemsetAsync((char*)d_ws + WS_CTL, 0, CTL_BYTES, stream) != hipSuccess) return;
    Args a{};
    for (int i = 0; i < 24; ++i) a.in[i] = (const float*)d_in[i];
    a.out = (float*)d_out; a.ws = (unsigned char*)d_ws;
#if MK_ONE_LAUNCH
    a.ph_lo = 0; a.ph_hi = NPHASE;
    hipLaunchKernelGGL(mega_fwd, dim3(grid), dim3(512), LDS_BYTES, stream, a);
#else
    for (int p = 0; p < NPHASE; ++p) { a.ph_lo = p; a.ph_hi = p + 1; hipLaunchKernelGGL(mega_fwd, dim3(grid), dim3(512), LDS_BYTES, stream, a); }
#endif
}
```

```cpp
#include <hip/hip_runtime.h>
#include <cstdio>
#include <cstdint>

namespace pg8 {
#define PG8_LAS __attribute__((address_space(3)))
typedef unsigned short bf16_t;
typedef short bf16x8 __attribute__((ext_vector_type(8)));
typedef float f32x4 __attribute__((ext_vector_type(4)));
typedef unsigned u32x4 __attribute__((ext_vector_type(4)));
constexpr int BM = 256, BK = 64, HALF = 128, HTB = HALF * BK * 2  , STAGE_BYTES = 8 * HTB, NXCD = 8, WGM = 8;

__host__ __device__ __forceinline__ int lds_byte(int r, int c) { const int st = (r >> 4) * 2 + (c >> 5), rr = r & 15, cc = c & 31, ob = rr * 64 + cc * 2; return st * 1024 + (ob ^ (((ob >> 9) & 1) << 5)); }
__host__ __device__ __forceinline__ void stage_rc(int b, int& R, int& C) { const int st = b / 1024, sb = b % 1024, swz = sb ^ (((sb >> 9) & 1) << 5); R = (st >> 1) * 16 + swz / 64; C = (st & 1) * 32 + (swz % 64) / 2; }
__host__ __device__ __forceinline__ int perm32(int rho) { const int n = rho >> 4, i = rho & 15; return 8 * (i >> 2) + 4 * n + (i & 3); }

struct Unit { int pm, pn, e, gp; };
struct Gemm { const bf16_t* A; const bf16_t* Bt; int K; size_t estride  ; const int* rowidx  ; };

struct StaticOrder {
    int nM, nN, nwg, G, c;
    __device__ void init(int nM_, int nN_, int G_, int c_) { nM = nM_; nN = nN_; nwg = nM * nN; G = G_; c = c_; }
    __device__ __forceinline__ bool map(int i, int& pm, int& pn) const {
        const long L = (long)i * G + c; if (L >= nwg) return false;
        int wgid = (int)L; { const int q = nwg / NXCD, r = nwg % NXCD, xcd = wgid % NXCD, off = wgid / NXCD; wgid = (xcd < r ? xcd * (q + 1) : r * (q + 1) + (xcd - r) * q) + off; }
        const int nig = WGM * nN, gid = wgid / nig, fm = gid * WGM, gsz = (nM - fm) < WGM ? (nM - fm) : WGM;
        pm = fm + ((wgid % nig) % gsz); pn = (wgid % nig) / gsz; return true;
    }
    __device__ __forceinline__ bool next(int i, Unit& u) const { int pm, pn; if (!map(i, pm, pn)) return false; u.pm = pm; u.pn = pn; u.e = 0; u.gp = pm; return true; }
};
struct MoeOrder {
    StaticOrder so; int p0; const int* pexp;
    __device__ void init(int nP, int nN, int G, int c, int p0_, const int* pexp_) { so.init(nP, nN, G, c); p0 = p0_; pexp = pexp_; }
    __device__ __forceinline__ bool next(int i, Unit& u) const { int pm, pn; if (!so.map(i, pm, pn)) return false; u.pm = pm; u.pn = pn; u.gp = p0 + pm; u.e = __builtin_amdgcn_readfirstlane(pexp[u.gp]); return true; }
};

__device__ __forceinline__ unsigned cvt_pk_bf16(float lo, float hi) { unsigned r; asm volatile("v_cvt_pk_bf16_f32 %0, %1, %2" : "=v"(r) : "v"(lo), "v"(hi)); return r; }
__device__ __forceinline__ float bf_lo(unsigned w) { return __uint_as_float(w << 16); }
__device__ __forceinline__ float bf_hi(unsigned w) { return __uint_as_float(w & 0xffff0000u); }

template <class Epi, class Sched, bool GATHER>
__device__ __forceinline__ void gemm_phase(PG8_LAS unsigned char* lds, const Gemm g, const Sched& S, const Epi& E, int wave_id  ) {
    int tid_; asm volatile("v_mbcnt_lo_u32_b32 %0, -1, 0\n\tv_mbcnt_hi_u32_b32 %0, -1, %0" : "=v"(tid_)); tid_ += wave_id << 6;
    const int tid = tid_, wid = __builtin_amdgcn_readfirstlane(tid >> 6), lane = tid & 63, wr = wid >> 2, wc = wid & 3, fr = lane & 15, fq = lane >> 4;
    const int K = g.K, nt = K / BK;
    int Ra[2], Ca[2]; unsigned voffB[2];
#pragma unroll
    for (int i = 0; i < 2; ++i) { int R, C; stage_rc(tid * 16 + i * 8192, R, C); const int Rb = (R & ~31) + perm32(R & 31);
        Ra[i] = R; Ca[i] = C; voffB[i] = (unsigned)(Rb * K + C) * 2u; }
    const size_t kstep = (size_t)(BK * 2);
    const size_t hstep = (size_t)HALF * K * 2;
    const size_t tstep = 2 * hstep;
    const unsigned ldsw = (unsigned)wid * 1024u;
    const int aoff = lds_byte(wr * 64 + fr, fq * 8), boff = lds_byte(wc * 32 + fr, fq * 8);
    const char* const A0 = (const char*)g.A;
#define PG8_SA(b, h) (((b) * 2 + (h)) * HTB)
#define PG8_SB(b, h) ((4 + (b) * 2 + (h)) * HTB)
#define PG8_STAGE(bufoff, gbase, voff) do { _Pragma("unroll") for (int _i = 0; _i < 2; ++_i) \
        __builtin_amdgcn_global_load_lds((const unsigned*)((const char*)(gbase) + (voff)[_i]), (PG8_LAS unsigned*)(lds + (bufoff) + ldsw + _i * 8192), 16, 0, 0); } while (0)
#define PG8_LDA(dst, b, h) do { _Pragma("unroll") for (int m = 0; m < 4; ++m) _Pragma("unroll") for (int k = 0; k < 2; ++k) dst[m][k] = *(const PG8_LAS bf16x8*)(lds + PG8_SA(b, h) + aoff + m * 2048 + k * 1024); } while (0)
#define PG8_LDB(dst, b, h) do { _Pragma("unroll") for (int n = 0; n < 2; ++n) _Pragma("unroll") for (int k = 0; k < 2; ++k) dst[n][k] = *(const PG8_LAS bf16x8*)(lds + PG8_SB(b, h) + boff + n * 2048 + k * 1024); } while (0)
#define PG8_MMA(ai, bj, At, Bt) do { __builtin_amdgcn_s_setprio(1); _Pragma("unroll") for (int m = 0; m < 4; ++m) _Pragma("unroll") for (int n = 0; n < 2; ++n) _Pragma("unroll") for (int k = 0; k < 2; ++k) \
        acc[ai][bj][m][n] = __builtin_amdgcn_mfma_f32_16x16x32_bf16(Bt[n][k], At[m][k], acc[ai][bj][m][n], 0, 0, 0); __builtin_amdgcn_s_setprio(0); } while (0)
#define PG8_WAIT_V(n) asm volatile("s_waitcnt vmcnt(" #n ")" ::: "memory")
#define PG8_WAIT_L(n) asm volatile("s_waitcnt lgkmcnt(" #n ")" ::: "memory")
#define PG8_BAR __builtin_amdgcn_s_barrier()
#define PG8_SCHED __builtin_amdgcn_sched_barrier(0)
#define PG8_AOFFS(dst, u) do { _Pragma("unroll") for (int _h = 0; _h < 2; ++_h) _Pragma("unroll") for (int _i = 0; _i < 2; ++_i) { \
        int _row = (u).pm * BM + _h * HALF + Ra[_i]; \
        if (GATHER) { const int _gi = g.rowidx[(u).gp * BM + _h * HALF + Ra[_i]]; _row = _gi < 0 ? 0 : _gi; } \
        dst[_h][_i] = ((unsigned)_row * (unsigned)K + (unsigned)Ca[_i]) * 2u; } } while (0)
    Unit cur, nxt; int ui = 0;
    if (!S.next(0, cur)) return;
    f32x4 acc[2][2][4][2];
#pragma unroll
    for (int a = 0; a < 2; ++a)
#pragma unroll
        for (int b = 0; b < 2; ++b)
#pragma unroll
            for (int m = 0; m < 4; ++m)
#pragma unroll
                for (int n = 0; n < 2; ++n) acc[a][b][m][n] = (f32x4){0.f, 0.f, 0.f, 0.f};
    bf16x8 At[4][2], B0[2][2], B1[2][2];
    unsigned oaC[2][2], oaN[2][2];
    PG8_AOFFS(oaC, cur);
    const char* cB = (const char*)g.Bt + (size_t)cur.e * g.estride + (size_t)cur.pn * tstep;
    PG8_STAGE(PG8_SB(0, 0), cB, voffB); PG8_STAGE(PG8_SB(0, 1), cB + hstep, voffB); PG8_STAGE(PG8_SA(0, 0), A0, oaC[0]); PG8_STAGE(PG8_SA(0, 1), A0, oaC[1]);
    if (wr == 1) PG8_BAR;
    PG8_WAIT_V(2); PG8_BAR;
    PG8_STAGE(PG8_SB(1, 0), cB + kstep, voffB); PG8_STAGE(PG8_SA(1, 0), A0 + kstep, oaC[0]); PG8_STAGE(PG8_SB(1, 1), cB + hstep + kstep, voffB);
    PG8_WAIT_V(6); PG8_BAR;
    for (;;) {
        const bool has_next = S.next(ui + 1, nxt);
        if (has_next) { PG8_AOFFS(oaN, nxt); }
        else {
#pragma unroll
            for (int _h = 0; _h < 2; ++_h)
#pragma unroll
                for (int _i = 0; _i < 2; ++_i) oaN[_h][_i] = oaC[_h][_i]; }
        const char* nB = has_next ? (const char*)g.Bt + (size_t)nxt.e * g.estride + (size_t)nxt.pn * tstep : cB;
        for (int t = 0; t < nt; t += 2) {
            const bool last = (t == nt - 2);
            const char* ka1 = A0 + (size_t)(t + 1) * kstep;
            const char* ka2 = last ? A0 : A0 + (size_t)(t + 2) * kstep; const char* b2 = last ? nB : cB + (size_t)(t + 2) * kstep;
            const char* ka3 = ka2 + kstep; const char* b3 = b2 + kstep;
            unsigned o2[2][2];
#pragma unroll
            for (int _h = 0; _h < 2; ++_h)
#pragma unroll
                for (int _i = 0; _i < 2; ++_i) o2[_h][_i] = oaC[_h][_i];
            if (last) {
#pragma unroll
                for (int _h = 0; _h < 2; ++_h)
#pragma unroll
                    for (int _i = 0; _i < 2; ++_i) o2[_h][_i] = oaN[_h][_i];
                asm volatile("" : "+v"(o2[0][0]), "+v"(o2[0][1]), "+v"(o2[1][0]), "+v"(o2[1][1])); }
            PG8_LDB(B0, 0, 0); PG8_LDB(B1, 0, 1); PG8_SCHED; PG8_LDA(At, 0, 0); PG8_STAGE(PG8_SA(1, 1), ka1, oaC[1]);
            PG8_WAIT_V(8); PG8_WAIT_L(0); PG8_BAR; PG8_MMA(0, 0, At, B0); PG8_MMA(0, 1, At, B1); PG8_BAR; PG8_SCHED;
            PG8_LDA(At, 0, 1); PG8_STAGE(PG8_SB(0, 0), b2, voffB); PG8_STAGE(PG8_SB(0, 1), b2 + hstep, voffB); PG8_STAGE(PG8_SA(0, 0), ka2, o2[0]);
            PG8_WAIT_V(8); PG8_WAIT_L(0); PG8_BAR; PG8_MMA(1, 0, At, B0); PG8_MMA(1, 1, At, B1); PG8_BAR; PG8_SCHED;
            PG8_LDB(B0, 1, 0); PG8_LDB(B1, 1, 1); PG8_SCHED; PG8_LDA(At, 1, 0); PG8_STAGE(PG8_SA(0, 1), ka2, o2[1]);
            PG8_WAIT_V(8); PG8_WAIT_L(0); PG8_BAR; PG8_MMA(0, 0, At, B0); PG8_MMA(0, 1, At, B1); PG8_BAR; PG8_SCHED;
            PG8_LDA(At, 1, 1); PG8_STAGE(PG8_SB(1, 0), b3, voffB); PG8_STAGE(PG8_SB(1, 1), b3 + hstep, voffB); PG8_STAGE(PG8_SA(1, 0), ka3, o2[0]);
            PG8_WAIT_V(8); PG8_WAIT_L(0); PG8_BAR; PG8_MMA(1, 0, At, B0); PG8_MMA(1, 1, At, B1); PG8_BAR; PG8_SCHED;
        }
        if (wr == 0) PG8_BAR;
        E(acc, cur, wr, wc, fr, fq);
        if (!has_next) break;
#pragma unroll
        for (int a = 0; a < 2; ++a)
#pragma unroll
            for (int b = 0; b < 2; ++b)
#pragma unroll
                for (int m = 0; m < 4; ++m)
#pragma unroll
                    for (int n = 0; n < 2; ++n) acc[a][b][m][n] = (f32x4){0.f, 0.f, 0.f, 0.f};
        cur = nxt; cB = nB; ++ui;
#pragma unroll
        for (int _h = 0; _h < 2; ++_h)
#pragma unroll
            for (int _i = 0; _i < 2; ++_i) oaC[_h][_i] = oaN[_h][_i];
        if (wr == 1) PG8_BAR;
    }
    PG8_WAIT_V(0);
    PG8_BAR;
#undef PG8_SA
#undef PG8_SB
#undef PG8_STAGE
#undef PG8_LDA
#undef PG8_LDB
#undef PG8_MMA
#undef PG8_WAIT_V
#undef PG8_WAIT_L
#undef PG8_BAR
#undef PG8_SCHED
#undef PG8_AOFFS
}
}
#define GAS __attribute__((address_space(1)))
#define LAS __attribute__((address_space(3)))
typedef unsigned short bf16;
typedef unsigned v4u __attribute__((ext_vector_type(4)));
typedef unsigned v2u __attribute__((ext_vector_type(2)));
typedef float f32x4 __attribute__((ext_vector_type(4)));
typedef float f32x2 __attribute__((ext_vector_type(2)));
typedef GAS unsigned gu32;
#define RLX_AGENT __ATOMIC_RELAXED, __HIP_MEMORY_SCOPE_AGENT
#define LDS_WAIT() asm volatile("s_waitcnt lgkmcnt(0)" ::: "memory")
#define VM_WAIT() asm volatile("s_waitcnt vmcnt(0)" ::: "memory")
__device__ __forceinline__ unsigned f2bf(float f) { unsigned u = __builtin_bit_cast(unsigned, f); return (u + 0x7fffu + ((u >> 16) & 1u)) >> 16; }
__device__ __forceinline__ unsigned pk2(float lo, float hi) { return f2bf(lo) | (f2bf(hi) << 16); }
__device__ __forceinline__ float bf2f(bf16 h) { return __uint_as_float(((unsigned)h) << 16); }
__device__ __forceinline__ float bflo(unsigned w) { return __uint_as_float(w << 16); }
__device__ __forceinline__ float bfhi(unsigned w) { return __uint_as_float(w & 0xffff0000u); }

#define XB_TMO      128
#define XB_XCNT(j)  (256  + 64 * (j))
#define XB_XSUB(j)  (1280 + 64 * (j))
#define XB_XGEN(j)  (2304 + 64 * (j))
#define XB_TOP      3328
#define XB_TOPGEN   3392
#define XCD_BAR_WORDS 3456
#define XB_SPIN_CAP (1u << 18)

__device__ __forceinline__ unsigned xb_ld(unsigned* p)              { return __hip_atomic_load(p, __ATOMIC_RELAXED, __HIP_MEMORY_SCOPE_AGENT); }
__device__ __forceinline__ unsigned xb_add(unsigned* p, unsigned v) { return __hip_atomic_fetch_add(p, v, __ATOMIC_RELAXED, __HIP_MEMORY_SCOPE_AGENT); }
__device__ __forceinline__ unsigned xb_xcc_id() { return (unsigned)__builtin_amdgcn_s_getreg((3 << 11) | 20) & 0xFu; }
#define XB_SPIN(cond, bar) do { unsigned _sp = 0; while (cond) { __builtin_amdgcn_s_sleep(1); \
    if ((++_sp & 255u) == 0u) { if (xb_ld(&(bar)[XB_TMO])) break; if (_sp > XB_SPIN_CAP) { atomicAdd(&(bar)[XB_TMO], 1u); break; } } } } while (0)

struct XcdBarrier {
    unsigned* bar; unsigned x;
    volatile LAS unsigned* st;
};

__device__ __forceinline__ XcdBarrier xcd_barrier_post(unsigned* bar, volatile LAS unsigned* st, bool leader  ) {
    XcdBarrier b; b.bar = bar; b.x = xb_xcc_id(); b.st = st;
    if (leader) (void)xb_add(&bar[XB_XCNT(b.x)], 1u);
    return b;
}
__device__ __forceinline__ void xcd_barrier_complete(unsigned* bar, unsigned x, unsigned& nloc, unsigned& nx) {
    const unsigned G = gridDim.x * gridDim.y * gridDim.z;
    unsigned sum, cnt, mine, sp = 0u;
    for (;;) {
        sum = 0u; cnt = 0u; mine = 0u;
#pragma unroll
        for (unsigned j = 0; j < 16; ++j) { const unsigned c = xb_ld(&bar[XB_XCNT(j)]); sum += c; cnt += (c > 0u) ? 1u : 0u; mine = (j == x) ? c : mine; }
        if (sum == G) break;
        __builtin_amdgcn_s_sleep(1);
        if ((++sp & 255u) == 0u) { if (xb_ld(&bar[XB_TMO])) break; if (sp > XB_SPIN_CAP) { atomicAdd(&bar[XB_TMO], 1u); break; } }
    }
    nloc = mine > 0u ? mine : 1u; nx = cnt > 0u ? cnt : 1u;
}

__device__ __forceinline__ void xcd_barrier(const XcdBarrier& b, bool leader) {
    asm volatile("s_waitcnt vmcnt(0)" ::: "memory");
    __syncthreads();
    if (leader) {
        unsigned* bar = b.bar;
        __builtin_amdgcn_s_waitcnt(0);
        unsigned nloc = b.st[0], nx = b.st[1];
        if (nloc == 0u) { xcd_barrier_complete(bar, b.x, nloc, nx); b.st[0] = nloc; b.st[1] = nx; }
        const unsigned old = xb_add(&bar[XB_XSUB(b.x)], 1u);
        const unsigned gen = old / nloc;
        if (old + 1u == (gen + 1u) * nloc) {
            __builtin_amdgcn_fence(__ATOMIC_RELEASE, "agent");
            asm volatile("s_waitcnt vmcnt(0)" ::: "memory");
            const unsigned og = xb_add(&bar[XB_TOP], 1u);
            const unsigned tg = og / nx;
            if (og + 1u == (tg + 1u) * nx) xb_add(&bar[XB_TOPGEN], 1u);
            else XB_SPIN(xb_ld(&bar[XB_TOPGEN]) == tg, bar);
            __builtin_amdgcn_fence(__ATOMIC_ACQUIRE, "agent");
            xb_add(&bar[XB_XGEN(b.x)], 1u);
            asm volatile("s_waitcnt vmcnt(0)" ::: "memory");
        } else {
            XB_SPIN(xb_ld(&bar[XB_XGEN(b.x)]) == gen, bar);
            __builtin_amdgcn_fence(__ATOMIC_ACQUIRE, "agent");
            asm volatile("s_waitcnt vmcnt(0)" ::: "memory");
        }
    }
    __syncthreads();
}

__device__ __forceinline__ int lane_id() { int l; asm volatile("v_mbcnt_lo_u32_b32 %0, -1, 0\n\tv_mbcnt_hi_u32_b32 %0, -1, %0" : "=v"(l)); return l; }

constexpr int NB = 16, TT = 2048, DM = 1024, MR = NB * TT, NMETA = 16, MROWS = MR + 256, NPAN = MROWS / 256;
constexpr int PSEQ = 2112, NCH = 33;
constexpr int DIN = 2864, N1 = 3328;
constexpr int DFF = 2816, DFE = 3584, NEXP = 8;
constexpr float EPS = 1e-6f;
constexpr int C_AQ = 0, C_AK = 128, C_AV = 256, C_ALR = 512, C_AOG = 528, C_RQ = 784, C_RK = 1040, C_RV = 1296, C_ROG = 1552, C_CQ = 1808, C_CKV = 2000, C_KPE = 2064, C_DQ = 2096, C_DK = 2352, C_DV = 2608, C_QEFF = 2864;
constexpr int MAXPAN = 264;
constexpr float LOG2E = 1.4426950408889634f;

constexpr size_t MiB = 1u << 20;
constexpr size_t WS_CTL = 0, CTL_BYTES = 1 * MiB;
constexpr size_t WS_TABR = 1 * MiB, WS_TABM = 1 * MiB + 576 * 1024;
constexpr size_t WS_RT = 2 * MiB;
constexpr size_t WS_STA = 3 * MiB, WS_STB = 6 * MiB;
constexpr size_t WS_MOE = 9 * MiB;
constexpr size_t MO_ROWIDX = WS_MOE, MO_PDST = WS_MOE + 512 * 1024, MO_PINFO = WS_MOE + 1 * MiB, MO_TOKE = WS_MOE + 2 * MiB, MO_TOKP = MO_TOKE + 256 * 1024, MO_TOKW = MO_TOKE + 512 * 1024, MO_PEXP = WS_MOE + 3 * MiB;
constexpr size_t WS_GD = 13 * MiB;
constexpr size_t WS_W1T = 16 * MiB, W1T_BYTES = (size_t)N1 * DM * 2;
constexpr size_t WS_WOT = 29 * MiB, WOT_BYTES = (size_t)DM * DM * 2;
constexpr size_t WS_WGU = 33 * MiB;
constexpr size_t WS_WD = 44 * MiB;
constexpr size_t WS_HB = 50 * MiB;
constexpr size_t WS_BIG = 115 * MiB;
constexpr size_t B_PROJ = WS_BIG;
constexpr int GQ_T = 5120, GKT_T = 5120, RT_T = 9216, VT_T = 9216;
constexpr size_t B_GQ = WS_BIG + 210 * MiB, B_GK = WS_BIG + 221 * MiB, B_GV = WS_BIG + 232 * MiB;
constexpr size_t B_RQ = WS_BIG + 251 * MiB, B_RK = WS_BIG + 270 * MiB, B_RV = WS_BIG + 289 * MiB;
constexpr size_t B_MQ = WS_BIG + 308 * MiB, B_MK = WS_BIG + 333 * MiB;
constexpr size_t B_DQ = WS_BIG + 340 * MiB, B_DK = B_DQ + 16896 * 1024;
constexpr size_t O_DVT = 65 * MiB, O_MVT = 82 * MiB, O_GKT = 87 * MiB, O_RKT = 98 * MiB;
constexpr size_t B_ACT = WS_BIG;
constexpr size_t B_EGU = WS_BIG, EGU_BYTES = (size_t)2 * DFE * DM * 2;
constexpr size_t B_ED = WS_BIG + 112 * MiB, ED_BYTES = (size_t)DM * DFE * 2;
constexpr size_t B_EACT = WS_BIG + 168 * MiB;
constexpr size_t WS_NEED = WS_BIG + 392 * MiB;
constexpr int CW_BAR = 4096, CW_CNT = 8192;

constexpr int RING_BYTES = 131072, MISC_OFF = RING_BYTES + 320, LDS_BYTES = 147456;

__device__ __forceinline__ float silu_f(float x) { return x * __builtin_amdgcn_rcpf(1.0f + __builtin_amdgcn_exp2f(-x * LOG2E)); }
__device__ __forceinline__ v4u pack8(const f32x4 a, const f32x4 b) { v4u w; w.x = pg8::cvt_pk_bf16(a[0], a[1]); w.y = pg8::cvt_pk_bf16(a[2], a[3]); w.z = pg8::cvt_pk_bf16(b[0], b[1]); w.w = pg8::cvt_pk_bf16(b[2], b[3]); return w; }

__device__ __forceinline__ void rows_rstd16(const float* stats, int row0, int fq, float (&rs)[8]) {
    f32x4 v[8];
#pragma unroll
    for (int j = 0; j < 8; ++j) v[j] = *(const f32x4*)(stats + (size_t)(row0 + (j >> 2) * 128 + (j & 3) * 16) * 16 + 4 * fq);
#pragma unroll
    for (int j = 0; j < 8; ++j) { float s = (v[j][0] + v[j][1]) + (v[j][2] + v[j][3]); s += __shfl_xor(s, 16); s += __shfl_xor(s, 32); rs[j] = __builtin_amdgcn_rsqf(s * (1.0f / 1024.0f) + EPS); }
}
struct EpiProj {
    bf16* O; const float* stats;
    __device__ __forceinline__ void operator()(const f32x4 (&acc)[2][2][4][2], const pg8::Unit& u, int wr, int wc, int fr, int fq) const {
        const int col0 = u.pn * 256 + wc * 32 + 8 * fq, row0 = u.pm * 256 + wr * 64 + fr;
        float rs[8]; rows_rstd16(stats, row0, fq, rs);
#pragma unroll
        for (int ai = 0; ai < 2; ++ai)
#pragma unroll
            for (int m = 0; m < 4; ++m) { const int r = row0 + ai * 128 + m * 16; const float sc = rs[ai * 4 + m]; bf16* rowp = O + (size_t)r * N1 + col0;
#pragma unroll
                for (int bj = 0; bj < 2; ++bj) *(v4u*)(rowp + bj * 128) = pack8(acc[ai][bj][m][0] * sc, acc[ai][bj][m][1] * sc); }
    }
};
struct EpiSwiglu {
    bf16* O; int ldo; const float* stats;
    __device__ __forceinline__ void operator()(const f32x4 (&acc)[2][2][4][2], const pg8::Unit& u, int wr, int wc, int fr, int fq) const {
        const int col0 = u.pn * 128 + wc * 32 + 8 * fq, row0 = u.pm * 256 + wr * 64 + fr;
        float rs[8]; rows_rstd16(stats, row0, fq, rs);
#pragma unroll
        for (int ai = 0; ai < 2; ++ai)
#pragma unroll
            for (int m = 0; m < 4; ++m) { const int r = row0 + ai * 128 + m * 16; const float sc = rs[ai * 4 + m];
                f32x4 o[2];
#pragma unroll
                for (int n = 0; n < 2; ++n)
#pragma unroll
                    for (int i = 0; i < 4; ++i) o[n][i] = silu_f(acc[ai][0][m][n][i] * sc) * (acc[ai][1][m][n][i] * sc);
                *(v4u*)(O + (size_t)r * ldo + col0) = pack8(o[0], o[1]); }
    }
};
struct EpiResid {
    bf16* H; float* stats;
    __device__ __forceinline__ void operator()(const f32x4 (&acc)[2][2][4][2], const pg8::Unit& u, int wr, int wc, int fr, int fq) const {
        const int col0 = u.pn * 256 + wc * 32 + 8 * fq, row0 = u.pm * 256 + wr * 64 + fr;
#pragma unroll
        for (int ai = 0; ai < 2; ++ai) {
            v4u w[4][2];
#pragma unroll
            for (int m = 0; m < 4; ++m)
#pragma unroll
                for (int bj = 0; bj < 2; ++bj) w[m][bj] = *(const v4u*)(H + (size_t)(row0 + ai * 128 + m * 16) * DM + col0 + bj * 128);
            float ssm[4];
#pragma unroll
            for (int m = 0; m < 4; ++m) { bf16* rowp = H + (size_t)(row0 + ai * 128 + m * 16) * DM + col0; float ss = 0.f;
#pragma unroll
                for (int bj = 0; bj < 2; ++bj) { const v4u x = w[m][bj];
                    f32x4 a = acc[ai][bj][m][0], b = acc[ai][bj][m][1];
                    a[0] += bflo(x.x); a[1] += bfhi(x.x); a[2] += bflo(x.y); a[3] += bfhi(x.y); b[0] += bflo(x.z); b[1] += bfhi(x.z); b[2] += bflo(x.w); b[3] += bfhi(x.w);
                    ss += (a[0] * a[0] + a[1] * a[1]) + (a[2] * a[2] + a[3] * a[3]) + (b[0] * b[0] + b[1] * b[1]) + (b[2] * b[2] + b[3] * b[3]);
                    *(v4u*)(rowp + bj * 128) = pack8(a, b); }
                ss += __shfl_xor(ss, 16); ss += __shfl_xor(ss, 32); ssm[m] = ss; }
            if (fq == 0) {
#pragma unroll
                for (int m = 0; m < 4; ++m) stats[(size_t)(row0 + ai * 128 + m * 16) * 16 + u.pn * 4 + wc] = ssm[m]; } }
    }
};
struct EpiSwigluMoe {
    bf16* O; const f32x2* pinfo;
    __device__ __forceinline__ void operator()(const f32x4 (&acc)[2][2][4][2], const pg8::Unit& u, int wr, int wc, int fr, int fq) const {
        const int col0 = u.pn * 128 + wc * 32 + 8 * fq, rl0 = wr * 64 + fr;
        float rs[8];
#pragma unroll
        for (int j = 0; j < 8; ++j) rs[j] = pinfo[u.gp * 256 + rl0 + (j >> 2) * 128 + (j & 3) * 16][0];
#pragma unroll
        for (int ai = 0; ai < 2; ++ai)
#pragma unroll
            for (int m = 0; m < 4; ++m) { const int rl = rl0 + ai * 128 + m * 16; const float sc = rs[ai * 4 + m];
                f32x4 o[2];
#pragma unroll
                for (int n = 0; n < 2; ++n)
#pragma unroll
                    for (int i = 0; i < 4; ++i) o[n][i] = silu_f(acc[ai][0][m][n][i] * sc) * (acc[ai][1][m][n][i] * sc);
                *(v4u*)(O + (size_t)(u.pm * 256 + rl) * DFE + col0) = pack8(o[0], o[1]); }
    }
};
struct EpiMoeDown {
    unsigned char* Y; const int* pdst; const f32x2* pinfo;
    __device__ __forceinline__ void operator()(const f32x4 (&acc)[2][2][4][2], const pg8::Unit& u, int wr, int wc, int fr, int fq) const {
        const int col0 = u.pn * 256 + wc * 32 + 8 * fq, rl0 = wr * 64 + fr;
        int dst[8]; float wt[8];
#pragma unroll
        for (int j = 0; j < 8; ++j) { const int gi = u.gp * 256 + rl0 + (j >> 2) * 128 + (j & 3) * 16; dst[j] = pdst[gi]; wt[j] = pinfo[gi][1]; }
#pragma unroll
        for (int ai = 0; ai < 2; ++ai)
#pragma unroll
            for (int m = 0; m < 4; ++m) { const int d = dst[ai * 4 + m]; const float w = wt[ai * 4 + m];
                if (d >= 0) { bf16* rowp = (bf16*)(Y + (size_t)(d >> 1) * 4096 + (size_t)(d & 1) * 2048) + col0;
#pragma unroll
                    for (int bj = 0; bj < 2; ++bj) *(v4u*)(rowp + bj * 128) = pack8(acc[ai][bj][m][0] * w, acc[ai][bj][m][1] * w); } }
    }
};

__device__ __forceinline__ float wave_sum(float v) {
#pragma unroll
    for (int o = 1; o < 64; o <<= 1) v += __shfl_xor(v, o);
    return v;
}
__device__ __forceinline__ void transpose_item(const float* W, int K, int N, const float* gain, bf16* WT, int kb, int nb, int dmode, LAS float* scr_, int lane) {
    LAS unsigned* scr = (LAS unsigned*)scr_;
    const int k0 = 64 * kb, n0 = 64 * nb, n = n0 + 2 * (lane & 31), kh = lane >> 5;
    f32x2 v[32];
#pragma unroll
    for (int i = 0; i < 32; ++i) v[i] = (n < N) ? *(const f32x2*)(W + (size_t)(k0 + 2 * i + kh) * N + n) : (f32x2){0.f, 0.f};
    if (gain) {
#pragma unroll
        for (int i = 0; i < 32; ++i) v[i] = v[i] * gain[k0 + 2 * i + kh]; }
#pragma unroll
    for (int i = 0; i < 32; ++i) scr[(2 * i + kh) * 33 + (lane & 31)] = pk2(v[i][0], v[i][1]);
    LDS_WAIT(); asm volatile("" ::: "memory");
    const LAS bf16* T = (const LAS bf16*)scr;
    const int c = lane & 7;
    const int d0 = dmode == 0 ? n0 : 256 * (n0 >> 7) + (n0 & 127) + (dmode == 2 ? 128 : 0);
#pragma unroll
    for (int j = 0; j < 8; ++j) { const int nl = (lane >> 3) + 8 * j; unsigned x[8];
#pragma unroll
        for (int t = 0; t < 8; ++t) x[t] = T[(8 * c + t) * 66 + nl];
        v4u o; o.x = x[0] | (x[1] << 16); o.y = x[2] | (x[3] << 16); o.z = x[4] | (x[5] << 16); o.w = x[6] | (x[7] << 16);
        if (n0 + nl < N) *(v4u*)(WT + (size_t)(d0 + nl) * K + k0 + 8 * c) = o; }
    LDS_WAIT(); asm volatile("" ::: "memory");
}

struct Args { const float* in[24]; float* out; unsigned char* ws; int ph_lo, ph_hi; };
enum { I_X = 0, I_META, I_ANORM, I_WIN, I_GWG, I_GBG, I_GNORM, I_RNORM, I_MQN, I_WUQ, I_MKVN, I_WUKV, I_DLAM, I_DNORM, I_WOUT, I_FNORM, I_FG, I_FU, I_FD, I_ROUTER, I_EG, I_EU, I_ED, I_FINAL };

#ifndef REP_FOLD
#define REP_FOLD 1
#endif
#ifndef REP_HINIT
#define REP_HINIT 1
#endif
__device__ __forceinline__ void qeff_unit(const Args& a, int li, int hh, int k16, LAS float* L, int tid) {
    const float* Wuq = a.in[I_WUQ] + (size_t)li * 192 * 384; const float* Wukv = a.in[I_WUKV] + (size_t)li * 64 * 512;
    const float* gq = a.in[I_MQN] + li * 192; const float* gkv = a.in[I_MKVN] + li * 64;
    const float* Win = a.in[I_WIN] + (size_t)li * DM * DIN; const float* gan = a.in[I_ANORM] + li * DM;
    bf16* W1t = (bf16*)(a.ws + WS_W1T + li * W1T_BYTES);
    LAS float* Wqa = L; LAS float* Wuk = L + 192 * 96; LAS float* Wis = Wuk;
    __syncthreads();
    for (int idx = tid; idx < 64 * 64; idx += 512) { const int n = idx >> 6, m = idx & 63; Wuk[n * 65 + m] = Wukv[n * 512 + hh * 128 + m]; }
    __syncthreads();
    for (int pass = 0; pass < 3; ++pass) { const int i = pass * 64 + (tid >> 3), ng = tid & 7; f32x4 wq[16];
#pragma unroll
        for (int j = 0; j < 16; ++j) wq[j] = *(const f32x4*)(Wuq + i * 384 + hh * 96 + 4 * j);
        const float gi = gq[i];
#pragma unroll
        for (int t = 0; t < 8; ++t) { const int n = ng * 8 + t; float s = 0.f;
#pragma unroll
            for (int j = 0; j < 16; ++j) s += (wq[j][0] * Wuk[n * 65 + 4 * j] + wq[j][1] * Wuk[n * 65 + 4 * j + 1]) + (wq[j][2] * Wuk[n * 65 + 4 * j + 2] + wq[j][3] * Wuk[n * 65 + 4 * j + 3]);
            Wqa[i * 96 + n] = gi * gkv[n] * s; }
        if (ng < 4) {
#pragma unroll
            for (int j = 0; j < 2; ++j) { const f32x4 r = *(const f32x4*)(Wuq + i * 384 + hh * 96 + 64 + ng * 8 + 4 * j); LAS float* d = Wqa + i * 96 + 64 + ng * 8 + 4 * j; d[0] = gi * r[0]; d[1] = gi * r[1]; d[2] = gi * r[2]; d[3] = gi * r[3]; } } }
    __syncthreads();
    for (int sb = 0; sb < 2; ++sb) { const int k0 = k16 * 64 + sb * 32;
        for (int idx = tid; idx < 32 * 48; idx += 512) { const int kk = idx / 48, i4 = idx % 48; const float* src = Win + (size_t)(k0 + kk) * DIN + C_CQ + 4 * i4;
            Wis[kk * 193 + 4 * i4] = src[0]; Wis[kk * 193 + 4 * i4 + 1] = src[1]; Wis[kk * 193 + 4 * i4 + 2] = src[2]; Wis[kk * 193 + 4 * i4 + 3] = src[3]; }
        __syncthreads();
        { const int kk = tid & 31, ng = tid >> 5; float acc[6] = {0.f, 0.f, 0.f, 0.f, 0.f, 0.f};
#pragma unroll 8
            for (int i = 0; i < 192; ++i) { const float w = Wis[kk * 193 + i]; const LAS f32x2* q2 = (const LAS f32x2*)(Wqa + i * 96 + ng * 6); const f32x2 q0 = q2[0], q1 = q2[1], q3 = q2[2];
                acc[0] += w * q0[0]; acc[1] += w * q0[1]; acc[2] += w * q1[0]; acc[3] += w * q1[1]; acc[4] += w * q3[0]; acc[5] += w * q3[1]; }
            const float g = gan[k0 + kk];
#pragma unroll
            for (int t = 0; t < 6; ++t) W1t[(size_t)(C_QEFF + hh * 96 + ng * 6 + t) * DM + k0 + kk] = (bf16)f2bf(g * acc[t]); }
        __syncthreads(); }
}
__device__ __forceinline__ void wofold_unit(const Args& a, int li, int hh, int nq, LAS float* L, int tid) {
    const float* Wukv = a.in[I_WUKV] + (size_t)li * 64 * 512; const float* gkv = a.in[I_MKVN] + li * 64; const float* Wo = a.in[I_WOUT] + (size_t)li * DM * DM;
    bf16* Wot = (bf16*)(a.ws + WS_WOT + li * WOT_BYTES);
    LAS float* WuvT = L; LAS float* Wos = L + 64 * 64;
    __syncthreads();
    for (int idx = tid; idx < 64 * 64; idx += 512) { const int j = idx >> 6, e = idx & 63; WuvT[e * 64 + j] = Wukv[j * 512 + hh * 128 + 64 + e] * gkv[j]; }
    for (int idx = tid; idx < 64 * 64; idx += 512) { const int e = idx >> 6, n4 = idx & 63; *(LAS f32x4*)(Wos + e * 256 + 4 * n4) = *(const f32x4*)(Wo + (size_t)(512 + 64 * hh + e) * DM + nq * 256 + 4 * n4); }
    __syncthreads();
    { const int n4 = tid & 63, j8 = tid >> 6; f32x4 acc[8];
#pragma unroll
        for (int j = 0; j < 8; ++j) acc[j] = (f32x4){0.f, 0.f, 0.f, 0.f};
#pragma unroll 4
        for (int e = 0; e < 64; ++e) { const f32x4 wv = *(const LAS f32x4*)(Wos + e * 256 + 4 * n4); const f32x4 u0 = *(const LAS f32x4*)(WuvT + e * 64 + 8 * j8), u1 = *(const LAS f32x4*)(WuvT + e * 64 + 8 * j8 + 4);
#pragma unroll
            for (int j = 0; j < 4; ++j) { acc[j] += wv * u0[j]; acc[4 + j] += wv * u1[j]; } }
#pragma unroll
        for (int t = 0; t < 4; ++t) { v4u w; w.x = pk2(acc[0][t], acc[1][t]); w.y = pk2(acc[2][t], acc[3][t]); w.z = pk2(acc[4][t], acc[5][t]); w.w = pk2(acc[6][t], acc[7][t]);
            *(v4u*)(Wot + (size_t)(nq * 256 + 4 * n4 + t) * DM + 512 + 64 * hh + 8 * j8) = w; } }
    __syncthreads();
}
__device__ __forceinline__ void p0_prologue(const Args& a, LAS unsigned char* lds, int tid, int lane, int wave) {
    const int G = gridDim.x;
    for (int rep = 0; rep < REP_FOLD; ++rep)
    for (int un = blockIdx.x; un < 160; un += G) {
        if (un < 128) qeff_unit(a, un >> 6, (un >> 4) & 3, un & 15, (LAS float*)lds, tid);
        else { const int v = un - 128; wofold_unit(a, v >> 4, (v >> 2) & 3, v & 3, (LAS float*)lds, tid); }
    }
    __syncthreads();
    LAS float* scr = (LAS float*)(lds + wave * 16384);
    const int gw = blockIdx.x * 8 + wave, NGW = G * 8;
    constexpr int I_IN = 16 * 45, I_WO = 12 * 16, I_G = 16 * 44, I_D = 44 * 16;
    constexpr int NIT = 2 * I_IN + 2 * I_WO + 2 * I_G + I_D;
    for (int it = gw; it < NIT; it += NGW) {
        int r = it;
        if (r < 2 * I_IN) { const int li = r / I_IN; r %= I_IN; transpose_item(a.in[I_WIN] + (size_t)li * DM * DIN, DM, DIN, a.in[I_ANORM] + li * DM, (bf16*)(a.ws + WS_W1T + li * W1T_BYTES), r / 45, r % 45, 0, scr, lane); continue; } r -= 2 * I_IN;
        if (r < 2 * I_WO) { const int li = r / I_WO; r %= I_WO; int kb = r / 16; if (kb >= 8) kb += 4; transpose_item(a.in[I_WOUT] + (size_t)li * DM * DM, DM, DM, nullptr, (bf16*)(a.ws + WS_WOT + li * WOT_BYTES), kb, r % 16, 0, scr, lane); continue; } r -= 2 * I_WO;
        if (r < I_G) { transpose_item(a.in[I_FG], DM, DFF, a.in[I_FNORM], (bf16*)(a.ws + WS_WGU), r / 44, r % 44, 1, scr, lane); continue; } r -= I_G;
        if (r < I_G) { transpose_item(a.in[I_FU], DM, DFF, a.in[I_FNORM], (bf16*)(a.ws + WS_WGU), r / 44, r % 44, 2, scr, lane); continue; } r -= I_G;
        transpose_item(a.in[I_FD], DFF, DM, nullptr, (bf16*)(a.ws + WS_WD), r / 16, r % 16, 0, scr, lane);
    }
    const int gt = blockIdx.x * 512 + tid, NGT = G * 512;
    for (int i = gt; i < 2 * 80 * 128; i += NGT) { const int li = i / (80 * 128), r = i % (80 * 128);
        *(v4u*)(a.ws + WS_W1T + li * W1T_BYTES + (size_t)(C_QEFF + 384) * DM * 2 + (size_t)r * 16) = (v4u){0u, 0u, 0u, 0u}; }
    for (int i = gt; i < 8 * DM; i += NGT) { const int e = i >> 10, k = i & 1023; ((float*)(a.ws + WS_RT))[i] = a.in[I_FNORM][DM + k] * a.in[I_ROUTER][k * 8 + e]; }
    for (int i = gt; i < PSEQ * 48; i += NGT) { const int p = i / 48, j = i % 48; const bool isR = j < 32; const int f = isR ? j : j - 32;
        const float inv = __builtin_amdgcn_exp2f(-(float)f * (isR ? 13.287712379549449f / 32.f : 13.287712379549449f / 16.f));
        const double rev = (double)(p - 48) * (double)inv * 0.15915494309189535; const float fr = (float)(rev - __builtin_rint(rev));
        const f32x2 cs = {__builtin_amdgcn_cosf(fr), __builtin_amdgcn_sinf(fr)};
        if (isR) ((f32x2*)(a.ws + WS_TABR))[p * 32 + f] = cs; else ((f32x2*)(a.ws + WS_TABM))[p * 16 + f] = cs; }
    for (int i = gt; i < 240 * 128; i += NGT) *(v4u*)((unsigned char*)a.out + (size_t)(MR + 16) * 2048 + (size_t)i * 16) = (v4u){0u, 0u, 0u, 0u};
    bf16* hb = (bf16*)(a.ws + WS_HB); float* stA = (float*)(a.ws + WS_STA);
    for (int rep = 0; rep < REP_HINIT; ++rep)
    for (int r = gw; r < MROWS; r += NGW) {
        f32x4 v[4]; float s = 0.f;
#pragma unroll
        for (int j = 0; j < 4; ++j) { if (r < MR) v[j] = ((const f32x4*)(a.in[I_X] + (size_t)r * DM))[lane + 64 * j]; else if (r < MR + NMETA) v[j] = ((const f32x4*)(a.in[I_META] + (size_t)(r - MR) * DM))[lane + 64 * j]; else v[j] = (f32x4){0.f, 0.f, 0.f, 0.f};
            s += (v[j][0] * v[j][0] + v[j][1] * v[j][1]) + (v[j][2] * v[j][2] + v[j][3] * v[j][3]); }
        s = wave_sum(s);
#pragma unroll
        for (int j = 0; j < 4; ++j) { v2u w; w.x = pk2(v[j][0], v[j][1]); w.y = pk2(v[j][2], v[j][3]); ((v2u*)(hb + (size_t)r * DM))[lane + 64 * j] = w; }
        if (lane < 16) stA[(size_t)r * 16 + lane] = lane == 0 ? s : 0.f;
    }
}

__device__ __forceinline__ int src_row(int b, int c, int i) { return c == 0 ? (i < 48 ? -1 : MR + i - 48) : b * TT + 64 * (c - 1) + i; }
__device__ __forceinline__ float lg2gamma(int h) { return h == 0 ? -0.045803689613124789f : h == 1 ? -0.022720076500083529f : h == 2 ? -0.011315313227834146f : -0.0056465631411420627f; }

__device__ __forceinline__ void route_block(const Args& a, int blk, LAS unsigned char* lds, int tid, int lane, int wave) {
    LAS float* Rs = (LAS float*)lds; LAS int* lcnt = (LAS int*)(lds + 32768); LAS int* gbase = lcnt + 8; LAS int* rec = lcnt + 16;
    gu32* ctl = (gu32*)(a.ws + WS_CTL);
    const float* Rt = (const float*)(a.ws + WS_RT); const bf16* hb = (const bf16*)(a.ws + WS_HB); const float* stB = (const float*)(a.ws + WS_STB);
    __syncthreads();
    for (int idx = tid; idx < 8 * DM; idx += 512) Rs[idx] = Rt[idx];
    if (tid < 8) lcnt[tid] = 0;
    __syncthreads();
    for (int rr = 0; rr < 16; ++rr) { const int rl = wave * 16 + rr, row = blk * 128 + rl;
        const v4u w0 = *(const v4u*)(hb + (size_t)row * DM + 8 * lane), w1 = *(const v4u*)(hb + (size_t)row * DM + 512 + 8 * lane);
        const float x[16] = {bflo(w0.x), bfhi(w0.x), bflo(w0.y), bfhi(w0.y), bflo(w0.z), bfhi(w0.z), bflo(w0.w), bfhi(w0.w), bflo(w1.x), bfhi(w1.x), bflo(w1.y), bfhi(w1.y), bflo(w1.z), bfhi(w1.z), bflo(w1.w), bfhi(w1.w)};
        float st = lane < 16 ? stB[(size_t)row * 16 + lane] : 0.f; st = wave_sum(st); const float rs = __builtin_amdgcn_rsqf(st * (1.f / 1024.f) + EPS);
        float lg[8];
#pragma unroll
        for (int e = 0; e < 8; ++e) { float s = 0.f;
#pragma unroll
            for (int t = 0; t < 8; ++t) s += x[t] * Rs[e * DM + 8 * lane + t] + x[8 + t] * Rs[e * DM + 512 + 8 * lane + t];
            lg[e] = wave_sum(s) * rs; }
        int e0 = 0; float v0 = lg[0];
#pragma unroll
        for (int e = 1; e < 8; ++e) if (lg[e] > v0) { v0 = lg[e]; e0 = e; }
        int e1 = -1; float v1 = -3.0e38f;
#pragma unroll
        for (int e = 0; e < 8; ++e) if (e != e0 && lg[e] > v1) { v1 = lg[e]; e1 = e; }
        const float g0 = 1.f / (1.f + __expf(v1 - v0)), g1 = 1.f - g0;
        if (lane == 0) { const int lp0 = atomicAdd((int*)(lcnt + e0), 1), lp1 = atomicAdd((int*)(lcnt + e1), 1);
            rec[rl * 6] = e0; rec[rl * 6 + 1] = e1; rec[rl * 6 + 2] = lp0; rec[rl * 6 + 3] = lp1; rec[rl * 6 + 4] = __float_as_int(g0); rec[rl * 6 + 5] = __float_as_int(g1); } }
    __syncthreads();
    if (tid < 8) gbase[tid] = (int)__hip_atomic_fetch_add(ctl + CW_CNT + 64 * tid, (unsigned)lcnt[tid], RLX_AGENT);
    __syncthreads();
    if (tid < 256) { const int rl = tid >> 1, s = tid & 1, tok = blk * 128 + rl, e = rec[rl * 6 + s];
        ((int*)(a.ws + MO_TOKE))[tok * 2 + s] = e; ((int*)(a.ws + MO_TOKP))[tok * 2 + s] = gbase[e] + rec[rl * 6 + 2 + s]; ((int*)(a.ws + MO_TOKW))[tok * 2 + s] = rec[rl * 6 + 4 + s]; }
    __syncthreads();
}
__device__ __forceinline__ void moe_offsets(const Args& a, LAS int* offs, int tid) {
    gu32* ctl = (gu32*)(a.ws + WS_CTL);
    __syncthreads();
    if (tid == 0) { int o = 0;
        for (int e = 0; e < 8; ++e) { const int cnt = (int)__hip_atomic_load(ctl + CW_CNT + 64 * e, RLX_AGENT); offs[e] = o * 256; o += (cnt + 255) >> 8; }
        offs[8] = o; }
    __syncthreads();
}

__device__ __forceinline__ void stage_cols(const bf16* proj, int b, int c, int col0, int ncols, LAS bf16* S, int sst, int lcol0, int tid) {
    const int cpr = ncols >> 3;
    for (int idx = tid; idx < 64 * cpr; idx += 512) { const int i = idx / cpr, ch = idx - i * cpr, sr = src_row(b, c, i);
        v4u v = {0u, 0u, 0u, 0u}; if (sr >= 0) v = *(const v4u*)(proj + (size_t)sr * N1 + col0 + ch * 8);
        *(LAS v4u*)(S + i * sst + lcol0 + ch * 8) = v; }
}
__device__ __forceinline__ v4u gather8(const LAS bf16* S, int sst, int row0, int col) {
    unsigned x[8];
#pragma unroll
    for (int t = 0; t < 8; ++t) x[t] = S[(row0 + t) * sst + col];
    v4u w; w.x = x[0] | (x[1] << 16); w.y = x[2] | (x[3] << 16); w.z = x[4] | (x[5] << 16); w.w = x[6] | (x[7] << 16); return w;
}
__device__ __forceinline__ void prep2_unit(const Args& a, int li, int b, int c, int part, LAS unsigned char* lds, int tid) {
    const bf16* proj = (const bf16*)(a.ws + B_PROJ);
    LAS bf16* S = (LAS bf16*)lds;
    const int blk0 = (b * NCH + c) * 4; const size_t prow0 = (size_t)b * PSEQ + 64 * c;
    unsigned char* dout = (unsigned char*)a.out;
    __syncthreads();
    if (part == 0) {
        constexpr int SST = 536; LAS float* seg = (LAS float*)(lds + 64 * SST * 2);
        stage_cols(proj, b, c, C_AQ, 128, S, SST, 0, tid); stage_cols(proj, b, c, C_AK, 128, S, SST, 128, tid); stage_cols(proj, b, c, C_AV, 256, S, SST, 256, tid); stage_cols(proj, b, c, C_ALR, 16, S, SST, 512, tid);
        __syncthreads();
        { const int ch = tid & 127, sg = tid >> 7; const float* Wg = a.in[I_GWG] + (size_t)li * 16 * 128; const float bg = a.in[I_GBG][li * 128 + ch];
            float wg[16];
#pragma unroll
            for (int r = 0; r < 16; ++r) wg[r] = Wg[r * 128 + ch];
            float cl[16]; float run = 0.f;
#pragma unroll
            for (int t = 0; t < 16; ++t) { const int i = 16 * sg + t; const v4u l0 = *(const LAS v4u*)(S + i * SST + 512), l1 = *(const LAS v4u*)(S + i * SST + 520);
                float x = bg + bflo(l0.x) * wg[0] + bfhi(l0.x) * wg[1] + bflo(l0.y) * wg[2] + bfhi(l0.y) * wg[3] + bflo(l0.z) * wg[4] + bfhi(l0.z) * wg[5] + bflo(l0.w) * wg[6] + bfhi(l0.w) * wg[7]
                               + bflo(l1.x) * wg[8] + bfhi(l1.x) * wg[9] + bflo(l1.y) * wg[10] + bfhi(l1.y) * wg[11] + bflo(l1.z) * wg[12] + bfhi(l1.z) * wg[13] + bflo(l1.w) * wg[14] + bfhi(l1.w) * wg[15];
                const float ls = fminf(x, 0.f) - __logf(1.f + __expf(-fabsf(x)));
                run += (c > 0 || i >= 48) ? ls * (1.f / 16.f) : 0.f; cl[t] = run; }
            seg[sg * 128 + ch] = run;
            __syncthreads();
            float off = 0.f;
#pragma unroll
            for (int s2 = 0; s2 < 3; ++s2) off += s2 < sg ? seg[s2 * 128 + ch] : 0.f;
            if (sg == 3) ((float*)(a.ws + WS_GD))[(size_t)(blk0 + (ch >> 5)) * 32 + (ch & 31)] = __expf(off + run);
#pragma unroll
            for (int t = 0; t < 16; ++t) { const int i = 16 * sg + t; const float cum = cl[t] + off;
                S[i * SST + ch] = (bf16)f2bf(bf2f(S[i * SST + ch]) * 0.17677669529663687f * __expf(cum)); S[i * SST + 128 + ch] = (bf16)f2bf(bf2f(S[i * SST + 128 + ch]) * __expf(-cum)); } }
        __syncthreads();
        for (int idx = tid; idx < 1024; idx += 512) { const int d8 = idx & 3, i = (idx >> 2) & 63, h = idx >> 8;
            *(v4u*)(a.ws + B_GQ + (size_t)(blk0 + h) * GQ_T + i * 80 + 16 * d8) = *(const LAS v4u*)(S + i * SST + h * 32 + 8 * d8);
            *(v4u*)(a.ws + B_GK + (size_t)(blk0 + h) * GQ_T + i * 80 + 16 * d8) = *(const LAS v4u*)(S + i * SST + 128 + h * 32 + 8 * d8); }
        for (int idx = tid; idx < 1024; idx += 512) { const int d = idx & 31, h = (idx >> 5) & 3, s8 = idx >> 7;
            *(v4u*)(dout + O_GKT + (size_t)(blk0 + h) * GKT_T + d * 144 + 16 * s8) = gather8(S, SST, 8 * s8, 128 + h * 32 + d); }
        for (int idx = tid; idx < 2048; idx += 512) { const int e = idx & 63, h = (idx >> 6) & 3, s8 = idx >> 8;
            *(v4u*)(a.ws + B_GV + (size_t)(blk0 + h) * VT_T + e * 144 + 16 * s8) = gather8(S, SST, 8 * s8, 256 + h * 64 + e); }
    } else if (part == 1) {
        constexpr int SST = 776;
        stage_cols(proj, b, c, C_RQ, 256, S, SST, 0, tid); stage_cols(proj, b, c, C_RK, 256, S, SST, 256, tid); stage_cols(proj, b, c, C_RV, 256, S, SST, 512, tid);
        LAS f32x4* tabL = (LAS f32x4*)(lds + 64 * SST * 2);
        for (int idx = tid; idx < 64 * 16; idx += 512) tabL[idx] = ((const f32x4*)(a.ws + WS_TABR))[(size_t)(64 * c) * 16 + idx];
        __syncthreads();
        const LAS f32x2* tabR = (const LAS f32x2*)tabL;
        for (int idx = tid; idx < 64 * 4 * 32; idx += 512) { const int j = idx & 31, h = (idx >> 5) & 3, i = idx >> 7; const f32x2 cs = tabR[i * 32 + j];
            LAS bf16* qp = S + i * SST + h * 64 + j; LAS bf16* kp = qp + 256;
            const float a1 = bf2f(qp[0]), a2 = bf2f(qp[32]), b1 = bf2f(kp[0]), b2 = bf2f(kp[32]);
            const float e = (float)(i + 1) * lg2gamma(h); const float fq = __builtin_amdgcn_exp2f(e), fk = 0.125f * __builtin_amdgcn_exp2f(-e);
            qp[0] = (bf16)f2bf((a1 * cs[0] - a2 * cs[1]) * fq); qp[32] = (bf16)f2bf((a1 * cs[1] + a2 * cs[0]) * fq); kp[0] = (bf16)f2bf((b1 * cs[0] - b2 * cs[1]) * fk); kp[32] = (bf16)f2bf((b1 * cs[1] + b2 * cs[0]) * fk); }
        __syncthreads();
        for (int idx = tid; idx < 2048; idx += 512) { const int d8 = idx & 7, i = (idx >> 3) & 63, h = idx >> 9;
            *(v4u*)(a.ws + B_RQ + (size_t)(blk0 + h) * RT_T + i * 144 + 16 * d8) = *(const LAS v4u*)(S + i * SST + h * 64 + 8 * d8);
            *(v4u*)(a.ws + B_RK + (size_t)(blk0 + h) * RT_T + i * 144 + 16 * d8) = *(const LAS v4u*)(S + i * SST + 256 + h * 64 + 8 * d8); }
        for (int idx = tid; idx < 2048; idx += 512) { const int d = idx & 63, h = (idx >> 6) & 3, s8 = idx >> 8;
            *(v4u*)(dout + O_RKT + (size_t)(blk0 + h) * RT_T + d * 144 + 16 * s8) = gather8(S, SST, 8 * s8, 256 + h * 64 + d);
            *(v4u*)(a.ws + B_RV + (size_t)(blk0 + h) * VT_T + d * 144 + 16 * s8) = gather8(S, SST, 8 * s8, 512 + h * 64 + d); }
    } else if (part == 2) {
        constexpr int SST = 680; LAS float* rsd = (LAS float*)(lds + 64 * SST * 2); LAS f32x4* tabL = (LAS f32x4*)(lds + 64 * SST * 2 + 512);
        stage_cols(proj, b, c, C_CQ, 192, S, SST, 0, tid); stage_cols(proj, b, c, C_CKV, 64, S, SST, 192, tid); stage_cols(proj, b, c, C_KPE, 32, S, SST, 256, tid); stage_cols(proj, b, c, C_QEFF, 384, S, SST, 288, tid);
        for (int idx = tid; idx < 64 * 8; idx += 512) tabL[idx] = ((const f32x4*)(a.ws + WS_TABM))[(size_t)(64 * c) * 8 + idx];
        __syncthreads();
        { const int i = tid >> 3, g = tid & 7; float sq = 0.f, sk = 0.f;
#pragma unroll
            for (int t = 0; t < 24; ++t) { const float v = bf2f(S[i * SST + g * 24 + t]); sq += v * v; }
#pragma unroll
            for (int t = 0; t < 8; ++t) { const float v = bf2f(S[i * SST + 192 + g * 8 + t]); sk += v * v; }
            sq += __shfl_xor(sq, 1); sq += __shfl_xor(sq, 2); sq += __shfl_xor(sq, 4); sk += __shfl_xor(sk, 1); sk += __shfl_xor(sk, 2); sk += __shfl_xor(sk, 4);
            if (g == 0) { rsd[i * 2] = __builtin_amdgcn_rsqf(sq * (1.f / 192.f) + EPS); rsd[i * 2 + 1] = __builtin_amdgcn_rsqf(sk * (1.f / 64.f) + EPS); } }
        __syncthreads();
        const LAS f32x2* tabM = (const LAS f32x2*)tabL; const float QS = 0.10206207261596577f * LOG2E;
        for (int idx = tid; idx < 64 * 48; idx += 512) { const int c8 = idx % 48, i = idx / 48, hh = c8 / 12, k8 = c8 % 12; const float s = rsd[i * 2] * QS; const LAS bf16* qe = S + i * SST + 288 + hh * 96; float y[8];
            if (k8 < 8) {
#pragma unroll
                for (int t = 0; t < 8; ++t) y[t] = bf2f(qe[8 * k8 + t]) * s; }
            else { const int kk = (k8 - 8) & 1, second = (k8 - 8) >> 1;
#pragma unroll
                for (int t = 0; t < 8; ++t) { const int j = 8 * kk + t; const f32x2 cs = tabM[i * 16 + j]; const float x1 = bf2f(qe[64 + j]) * s, x2 = bf2f(qe[80 + j]) * s; y[t] = second ? x1 * cs[1] + x2 * cs[0] : x1 * cs[0] - x2 * cs[1]; } }
            v4u w; w.x = pk2(y[0], y[1]); w.y = pk2(y[2], y[3]); w.z = pk2(y[4], y[5]); w.w = pk2(y[6], y[7]);
            *(v4u*)((bf16*)(a.ws + B_MQ) + (prow0 + i) * 384 + hh * 96 + 8 * k8) = w; }
        for (int idx = tid; idx < 64 * 12; idx += 512) { const int k8 = idx % 12, i = idx / 12; float y[8];
            if (k8 < 8) { const float s = rsd[i * 2 + 1];
#pragma unroll
                for (int t = 0; t < 8; ++t) y[t] = bf2f(S[i * SST + 192 + 8 * k8 + t]) * s; }
            else { const int kk = (k8 - 8) & 1, second = (k8 - 8) >> 1;
#pragma unroll
                for (int t = 0; t < 8; ++t) { const int j = 8 * kk + t; const f32x2 cs = tabM[i * 16 + j]; const float x1 = bf2f(S[i * SST + 256 + j]), x2 = bf2f(S[i * SST + 272 + j]); y[t] = second ? x1 * cs[1] + x2 * cs[0] : x1 * cs[0] - x2 * cs[1]; } }
            v4u w; w.x = pk2(y[0], y[1]); w.y = pk2(y[2], y[3]); w.z = pk2(y[4], y[5]); w.w = pk2(y[6], y[7]);
            *(v4u*)((bf16*)(a.ws + B_MK) + (prow0 + i) * 96 + 8 * k8) = w; }
        __syncthreads();
        for (int idx = tid; idx < 512; idx += 512) { const int e = idx & 63, s8 = idx >> 6; unsigned x[8];
#pragma unroll
            for (int t = 0; t < 8; ++t) x[t] = f2bf(bf2f(S[(8 * s8 + t) * SST + 192 + e]) * rsd[(8 * s8 + t) * 2 + 1]);
            v4u w; w.x = x[0] | (x[1] << 16); w.y = x[2] | (x[3] << 16); w.z = x[4] | (x[5] << 16); w.w = x[6] | (x[7] << 16);
            *(v4u*)((bf16*)(dout + O_MVT) + ((size_t)(b * NCH + c) * 64 + e) * 64 + 8 * s8) = w; }
    } else {
        constexpr int SST = 264;
        stage_cols(proj, b, c, C_DV, 256, S, SST, 0, tid);
        for (int idx = tid; idx < 64 * 32; idx += 512) { const int i = idx >> 5, ch8 = idx & 31, sr = src_row(b, c, i);
            v4u dq = {0u, 0u, 0u, 0u}, dk = dq;
            if (sr >= 0) { const bf16* pr = proj + (size_t)sr * N1; dq = *(const v4u*)(pr + C_DQ + ch8 * 8); dk = *(const v4u*)(pr + C_DK + ch8 * 8);
                const float qs = 0.17677669529663687f * LOG2E;
                dq.x = pk2(bflo(dq.x) * qs, bfhi(dq.x) * qs); dq.y = pk2(bflo(dq.y) * qs, bfhi(dq.y) * qs); dq.z = pk2(bflo(dq.z) * qs, bfhi(dq.z) * qs); dq.w = pk2(bflo(dq.w) * qs, bfhi(dq.w) * qs); }
            *(v4u*)((bf16*)(a.ws + B_DQ) + (prow0 + i) * 256 + ch8 * 8) = dq;
            *(v4u*)((bf16*)(a.ws + B_DK) + (prow0 + i) * 256 + ch8 * 8) = dk; }
        __syncthreads();
        for (int idx = tid; idx < 2048; idx += 512) { const int e = idx & 63, h = (idx >> 6) & 3, s8 = idx >> 8;
            *(v4u*)((bf16*)(dout + O_DVT) + ((size_t)(blk0 + h) * 64 + e) * 64 + 8 * s8) = gather8(S, SST, 8 * s8, h * 64 + e); }
    }
}

typedef float f32x16 __attribute__((ext_vector_type(16)));
typedef short s16x8 __attribute__((ext_vector_type(8)));
typedef short s16x4 __attribute__((ext_vector_type(4)));
__device__ __forceinline__ int crow(int r, int hi) { return (r & 3) + 8 * (r >> 2) + 4 * hi; }

template <int KIND>
__device__ __forceinline__ void attn_mfma_unit(const Args& a, int li, int b, int hh, int qb  , LAS unsigned char* lds, int tid, float lam, float oscale) {
    constexpr int KW = KIND ? 64 : 96, KST = KW + 8, VST = 72, NMAP = KIND ? 2 : 1, DSTEPS = KIND ? 2 : 6, CPR = KW / 8;
    constexpr int KBUF = 64 * KST * 2, VBUF = 64 * VST * 2, OFF_V = 2 * KBUF, OFF_WS = OFF_V + 2 * VBUF, OFF_OST = OFF_WS + 8 * 256, OSTW = 68;
    const int lane = tid & 63, w = __builtin_amdgcn_readfirstlane(tid >> 6), r32 = lane & 31, hi = lane >> 5;
    const int q0 = qb < 0 ? 0 : 64 + 256 * qb, NT = qb < 0 ? 1 : 5 + 4 * qb;
    const bool wact = qb >= 0 || w < 2;
    const int qpos = q0 + 32 * w + r32, wlast = (q0 + 32 * w + 31) >> 6;
    const size_t prow = (size_t)b * PSEQ + qpos;
    const bf16* Kg = KIND ? (const bf16*)(a.ws + B_DK) + (size_t)b * PSEQ * 256 + hh * 64 : (const bf16*)(a.ws + B_MK) + (size_t)b * PSEQ * 96;
    constexpr int KLD = KIND ? 256 : 96;
    const bf16* VTg = KIND ? (const bf16*)((const unsigned char*)a.out + O_DVT) + ((size_t)b * NCH * 4 + hh) * 4096 : (const bf16*)((const unsigned char*)a.out + O_MVT) + (size_t)b * NCH * 4096;
    constexpr int VTT = KIND ? 4 * 4096 : 4096;
    LAS float* wsf = (LAS float*)(lds + OFF_WS) + w * 64;
    LAS float* ost = (LAS float*)(lds + OFF_OST) + w * (32 * OSTW);
    s16x8 qf[NMAP][DSTEPS];
#pragma unroll
    for (int m = 0; m < NMAP; ++m)
#pragma unroll
        for (int ds = 0; ds < DSTEPS; ++ds) {
            const bf16* qp = KIND ? (const bf16*)(a.ws + B_DQ) + prow * 256 + hh * 64 + 32 * m + 16 * ds + 8 * hi : (const bf16*)(a.ws + B_MQ) + prow * 384 + hh * 96 + 16 * ds + 8 * hi;
            qf[m][ds] = wact ? *(const s16x8*)qp : (s16x8){0, 0, 0, 0, 0, 0, 0, 0}; }
    float mref[NMAP], lrun[NMAP]; f32x16 negm = (f32x16){}, o[NMAP][2];
#pragma unroll
    for (int m = 0; m < NMAP; ++m) { mref[m] = 0.f; lrun[m] = 0.f; o[m][0] = (f32x16){}; o[m][1] = (f32x16){}; }
    const int kc0 = tid, kc1 = tid + 512; const bool has1 = (CPR == 12) && kc1 < 64 * CPR;
    const int kr0 = kc0 / CPR, kh0 = kc0 % CPR, kr1 = kc1 / CPR, kh1 = kc1 % CPR, ve = tid >> 3, vh = tid & 7;
    v4u rk0, rk1 = {0u, 0u, 0u, 0u}, rv;
#define ATT_LOAD(t) do { rk0 = *(const v4u*)(Kg + (size_t)(64 * (t) + kr0) * KLD + kh0 * 8); if (has1) rk1 = *(const v4u*)(Kg + (size_t)(64 * (t) + kr1) * KLD + kh1 * 8); \
        rv = *(const v4u*)(VTg + (size_t)(t) * VTT + ve * 64 + vh * 8); } while (0)
#define ATT_STORE(bufi) do { *(LAS v4u*)(lds + (bufi) * KBUF + (kr0 * KST + kh0 * 8) * 2) = rk0; if (has1) *(LAS v4u*)(lds + (bufi) * KBUF + (kr1 * KST + kh1 * 8) * 2) = rk1; \
        *(LAS v4u*)(lds + OFF_V + (bufi) * VBUF + (ve * VST + vh * 8) * 2) = rv; } while (0)
    __syncthreads();
    ATT_LOAD(0); ATT_STORE(0);
    __syncthreads();
    for (int t = 0; t < NT; ++t) {
        const int bi = t & 1;
        if (t + 1 < NT) ATT_LOAD(t + 1);
        if (wact && t <= wlast) {
            const LAS unsigned char* Kb = lds + bi * KBUF; const LAS unsigned char* Vb = lds + OFF_V + bi * VBUF;
            const bool need_mask = (t == 0) || (64 * t + 63 > q0 + 32 * w);
#pragma unroll
            for (int m = 0; m < NMAP; ++m) {
                f32x16 p0, p1;
                if (KIND) { const float nm = -mref[m];
#pragma unroll
                    for (int r = 0; r < 16; ++r) { p0[r] = nm; p1[r] = nm; } }
                else { p0 = negm; p1 = negm; }
#pragma unroll
                for (int ds = 0; ds < DSTEPS; ++ds) {
                    const s16x8 k0 = *(const LAS s16x8*)(Kb + (r32 * KST + 32 * m * KIND + 16 * ds + 8 * hi) * 2);
                    const s16x8 k1 = *(const LAS s16x8*)(Kb + ((32 + r32) * KST + 32 * m * KIND + 16 * ds + 8 * hi) * 2);
                    p0 = __builtin_amdgcn_mfma_f32_32x32x16_bf16(k0, qf[m][ds], p0, 0, 0, 0);
                    p1 = __builtin_amdgcn_mfma_f32_32x32x16_bf16(k1, qf[m][ds], p1, 0, 0, 0); }
                asm volatile("s_nop 15\n\ts_nop 7" : "+v"(p0), "+v"(p1));
                if (need_mask) {
#pragma unroll
                    for (int r = 0; r < 16; ++r) { const int kv = 64 * t + crow(r, hi);
                        if (kv > qpos || kv < 48) p0[r] = -1e30f;
                        if (kv + 32 > qpos || kv + 32 < 48) p1[r] = -1e30f; } }
                float mx = fmaxf(fmaxf(p0[0], p1[0]), fmaxf(p0[1], p1[1]));
#pragma unroll
                for (int r = 2; r < 16; r += 2) mx = fmaxf(mx, fmaxf(fmaxf(p0[r], p1[r]), fmaxf(p0[r + 1], p1[r + 1])));
                { auto rr = __builtin_amdgcn_permlane32_swap(__float_as_uint(mx), __float_as_uint(mx), false, false); mx = fmaxf(__uint_as_float(rr[0]), __uint_as_float(rr[1])); }
                if (t == 0 || __any(mx > 6.0f)) {
                    const float delta = t == 0 ? mx : fmaxf(mx, 0.f); mref[m] += delta;
#pragma unroll
                    for (int r = 0; r < 16; ++r) { p0[r] -= delta; p1[r] -= delta; if (!KIND) negm[r] = -mref[m]; }
                    if (t != 0) { const float alpha = __builtin_amdgcn_exp2f(-delta); lrun[m] *= alpha;
                        if (hi == 0) wsf[r32] = alpha;
                        f32x4 al[4];
#pragma unroll
                        for (int g = 0; g < 4; ++g) al[g] = *(const LAS f32x4*)(wsf + 8 * g + 4 * hi);
#pragma unroll
                        for (int r = 0; r < 16; ++r) { o[m][0][r] *= al[r >> 2][r & 3]; o[m][1][r] *= al[r >> 2][r & 3]; } } }
                float ls = 0.f;
#pragma unroll
                for (int r = 0; r < 16; ++r) { p0[r] = __builtin_amdgcn_exp2f(p0[r]); p1[r] = __builtin_amdgcn_exp2f(p1[r]); ls += p0[r] + p1[r]; }
                lrun[m] += ls;
                s16x8 pw[4];
#pragma unroll
                for (int ks = 0; ks < 4; ++ks) { v4u u;
                    if (ks < 2) { u.x = pg8::cvt_pk_bf16(p0[8 * ks], p0[8 * ks + 1]); u.y = pg8::cvt_pk_bf16(p0[8 * ks + 2], p0[8 * ks + 3]); u.z = pg8::cvt_pk_bf16(p0[8 * ks + 4], p0[8 * ks + 5]); u.w = pg8::cvt_pk_bf16(p0[8 * ks + 6], p0[8 * ks + 7]); }
                    else { const int k2 = ks - 2; u.x = pg8::cvt_pk_bf16(p1[8 * k2], p1[8 * k2 + 1]); u.y = pg8::cvt_pk_bf16(p1[8 * k2 + 2], p1[8 * k2 + 3]); u.z = pg8::cvt_pk_bf16(p1[8 * k2 + 4], p1[8 * k2 + 5]); u.w = pg8::cvt_pk_bf16(p1[8 * k2 + 6], p1[8 * k2 + 7]); }
                    pw[ks] = __builtin_bit_cast(s16x8, u); }
#pragma unroll
                for (int d0 = 0; d0 < 2; ++d0)
#pragma unroll
                    for (int ks = 0; ks < 4; ++ks) { const LAS unsigned char* vp = Vb + ((32 * d0 + r32) * VST + 16 * ks + 4 * hi) * 2;
                        const s16x4 va = *(const LAS s16x4*)vp, vb = *(const LAS s16x4*)(vp + 16);
                        const s16x8 vf = {va[0], va[1], va[2], va[3], vb[0], vb[1], vb[2], vb[3]};
                        o[m][d0] = __builtin_amdgcn_mfma_f32_32x32x16_bf16(pw[ks], vf, o[m][d0], 0, 0, 0); }
            }
        }
        if (t + 1 < NT) ATT_STORE(bi ^ 1);
        __syncthreads();
    }
#undef ATT_LOAD
#undef ATT_STORE
    if (wact) {
#pragma unroll
        for (int m = 0; m < NMAP; ++m) asm volatile("s_nop 15\n\ts_nop 7" : "+v"(o[m][0]), "+v"(o[m][1]));
        float il0, il1 = 0.f;
        { float l = lrun[0]; l += __shfl_xor(l, 32); il0 = l > 0.f ? 1.f / l : 0.f; }
        if (KIND) { float l = lrun[NMAP - 1]; l += __shfl_xor(l, 32); il1 = l > 0.f ? lam / l : 0.f; }
        if (hi == 0) { wsf[r32] = il0; wsf[32 + r32] = il1; }
        f32x4 a0[4], a1[4];
#pragma unroll
        for (int g = 0; g < 4; ++g) { a0[g] = *(const LAS f32x4*)(wsf + 8 * g + 4 * hi); a1[g] = *(const LAS f32x4*)(wsf + 32 + 8 * g + 4 * hi); }
#pragma unroll
        for (int d0 = 0; d0 < 2; ++d0)
#pragma unroll
            for (int r = 0; r < 16; ++r) { float v = o[0][d0][r] * a0[r >> 2][r & 3]; if (KIND) v -= o[NMAP - 1][d0][r] * a1[r >> 2][r & 3];
                ost[crow(r, hi) * OSTW + 32 * d0 + r32] = v; }
        const int row = lane >> 1, half = lane & 1, p = q0 + 32 * w + row;
        f32x4 v[8]; float ss = 0.f;
#pragma unroll
        for (int i = 0; i < 8; ++i) { v[i] = *(const LAS f32x4*)(ost + row * OSTW + 32 * half + 4 * i); ss += (v[i][0] * v[i][0] + v[i][1] * v[i][1]) + (v[i][2] * v[i][2] + v[i][3] * v[i][3]); }
        ss += __shfl_xor(ss, 1);
        const float rs = KIND ? __builtin_amdgcn_rsqf(ss * (1.f / 64.f) + EPS) * oscale : 1.f;
        const int sr = qb >= 0 ? b * TT + p - 64 : ((p >= 48 && b == 0) ? MR + p - 48 : -1);
        if (sr >= 0) { bf16* dst = (bf16*)a.out + (size_t)sr * DM + (KIND ? 768 : 512) + hh * 64 + 32 * half; const float* gn = a.in[I_DNORM] + li * 64 + 32 * half;
#pragma unroll
            for (int i = 0; i < 4; ++i) { f32x4 x0 = v[2 * i] * rs, x1 = v[2 * i + 1] * rs;
                if (KIND) { const f32x4 g0 = *(const f32x4*)(gn + 8 * i), g1 = *(const f32x4*)(gn + 8 * i + 4); x0 = x0 * g0; x1 = x1 * g1; }
                *(v4u*)(dst + 8 * i) = pack8(x0, x1); } }
    }
    __syncthreads();
}

__device__ __forceinline__ s16x8 ldperm(const bf16* p, int hi) { const s16x4 x = *(const s16x4*)(p + 4 * hi), y = *(const s16x4*)(p + 8 + 4 * hi); return (s16x8){x[0], x[1], x[2], x[3], y[0], y[1], y[2], y[3]}; }
__device__ __forceinline__ s16x8 packacc(const f32x16& v, int k) { v4u u; u.x = pg8::cvt_pk_bf16(v[8 * k], v[8 * k + 1]); u.y = pg8::cvt_pk_bf16(v[8 * k + 2], v[8 * k + 3]); u.z = pg8::cvt_pk_bf16(v[8 * k + 4], v[8 * k + 5]); u.w = pg8::cvt_pk_bf16(v[8 * k + 6], v[8 * k + 7]); return __builtin_bit_cast(s16x8, u); }
__device__ __forceinline__ s16x8 ldperm_lds(const LAS unsigned char* p, int hi) { const s16x4 x = *(const LAS s16x4*)(p + 8 * hi), y = *(const LAS s16x4*)(p + 16 + 8 * hi); return (s16x8){x[0], x[1], x[2], x[3], y[0], y[1], y[2], y[3]}; }
template <int KIND>
__device__ __forceinline__ void lin_mfma_unit(const Args& a, int li, int b, int hp, LAS unsigned char* lds, int tid) {
    constexpr int DK = KIND ? 64 : 32, NDS = DK / 16, NDB = DK / 32, OTW = 68;
    constexpr int QROW = KIND ? 144 : 80, QT = KIND ? RT_T : GQ_T, KTT = KIND ? RT_T : GKT_T, HB = 2 * QT + KTT + VT_T, PPH = HB / 1024, NP = 2 * PPH;
    constexpr int OFF_OT = 2 * HB, OFF_G = OFF_OT + 2 * 64 * OTW * 4;
    static_assert(HB % 1024 == 0 && OFF_G + 256 <= RING_BYTES, "lin unit LDS map");
    const int lane = tid & 63, w = __builtin_amdgcn_readfirstlane(tid >> 6), r32 = lane & 31, hi = lane >> 5, hl = w >> 2, e0 = 32 * ((w >> 1) & 1), ib = w & 1, h = 2 * hp + hl;
    const unsigned char* Qg = a.ws + (KIND ? B_RQ : B_GQ); const unsigned char* Kg = a.ws + (KIND ? B_RK : B_GK);
    const unsigned char* KTg = (const unsigned char*)a.out + (KIND ? O_RKT : O_GKT); const unsigned char* VTg = a.ws + (KIND ? B_RV : B_GV);
    const bf16* proj = (const bf16*)(a.ws + B_PROJ); bf16* ob = (bf16*)a.out;
    LAS float* Ot = (LAS float*)(lds + OFF_OT);
    LAS float* Gs = (LAS float*)(lds + OFF_G);
    const LAS unsigned char* Lh = lds + hl * HB;
    const float dret = __builtin_amdgcn_exp2f(64.f * lg2gamma(h));
    f32x16 S[NDB];
#pragma unroll
    for (int db = 0; db < NDB; ++db) S[db] = (f32x16){};
#define LIN_DMA(c_) do { _Pragma("unroll") for (int j_ = 0; j_ < (NP + 7) / 8; ++j_) { const int p_ = w + 8 * j_; if (p_ < NP) { const int hl_ = p_ / PPH, pp_ = p_ % PPH; const size_t blk_ = (size_t)(b * NCH + (c_)) * 4 + 2 * hp + hl_; \
        const unsigned char* src_ = pp_ < QT / 1024 ? Qg + blk_ * QT + pp_ * 1024 : pp_ < 2 * QT / 1024 ? Kg + blk_ * QT + (pp_ - QT / 1024) * 1024 : pp_ < (2 * QT + KTT) / 1024 ? KTg + blk_ * KTT + (pp_ - 2 * QT / 1024) * 1024 : VTg + blk_ * VT_T + (pp_ - (2 * QT + KTT) / 1024) * 1024; \
        __builtin_amdgcn_global_load_lds((const unsigned*)(src_ + lane * 16), (LAS unsigned*)(lds + hl_ * HB + pp_ * 1024), 16, 0, 0); } } } while (0)
#define LIN_BAR() do { asm volatile("s_waitcnt lgkmcnt(0)" ::: "memory"); __builtin_amdgcn_s_barrier(); asm volatile("" ::: "memory"); } while (0)
    LIN_BAR();
    if (tid < 64) Gs[tid] = a.in[KIND ? I_RNORM : I_GNORM][li * 64 + tid];
    LIN_DMA(0);
    const int nh = tid >> 8, nrow = (tid >> 2) & 63, nq = tid & 3, hn = 2 * hp + nh;
    for (int c = 0; c < NCH; ++c) {
        asm volatile("s_waitcnt vmcnt(0)" ::: "memory"); LIN_BAR();
        s16x8 qf[NDS], kf0[NDS], kf1[NDS], vf[4], ktf[NDB][4];
#pragma unroll
        for (int ds = 0; ds < NDS; ++ds) { qf[ds] = ldperm_lds(Lh + (32 * ib + r32) * QROW + 32 * ds, hi); kf0[ds] = ldperm_lds(Lh + QT + r32 * QROW + 32 * ds, hi); kf1[ds] = ldperm_lds(Lh + QT + (32 + r32) * QROW + 32 * ds, hi); }
#pragma unroll
        for (int ks = 0; ks < 4; ++ks) vf[ks] = ldperm_lds(Lh + 2 * QT + KTT + (e0 + r32) * 144 + 32 * ks, hi);
#pragma unroll
        for (int db = 0; db < NDB; ++db)
#pragma unroll
            for (int ks = 0; ks < 4; ++ks) ktf[db][ks] = ldperm_lds(Lh + 2 * QT + (32 * db + r32) * 144 + 32 * ks, hi);
        LIN_BAR();
        const int sr = src_row(b, c, nrow); const bool wr = sr >= 0 && (c > 0 || b == 0);
        v4u og[2];
#pragma unroll
        for (int i = 0; i < 2; ++i) og[i] = wr ? *(const v4u*)(proj + (size_t)sr * N1 + (KIND ? C_ROG : C_AOG) + hn * 64 + 16 * nq + 8 * i) : (v4u){0u, 0u, 0u, 0u};
        f32x4 dvv[4];
        if (!KIND) { const float* dp = (const float*)(a.ws + WS_GD) + ((size_t)(b * NCH + c) * 4 + h) * 32;
#pragma unroll
            for (int g = 0; g < 4; ++g) dvv[g] = *(const f32x4*)(dp + 8 * g + 4 * hi); }
        if (c + 1 < NCH) LIN_DMA(c + 1);
        f32x16 aA = (f32x16){}, aB = (f32x16){};
#pragma unroll
        for (int ds = 0; ds < NDS; ++ds) { aA = __builtin_amdgcn_mfma_f32_32x32x16_bf16(kf0[ds], qf[ds], aA, 0, 0, 0); if (ib) aB = __builtin_amdgcn_mfma_f32_32x32x16_bf16(kf1[ds], qf[ds], aB, 0, 0, 0); }
        asm volatile("s_nop 15\n\ts_nop 15" : "+v"(aA), "+v"(aB));
#pragma unroll
        for (int r = 0; r < 16; ++r) if (crow(r, hi) > r32) { if (ib) aB[r] = 0.f; else aA[r] = 0.f; }
        f32x16 O = (f32x16){};
#pragma unroll
        for (int db = 0; db < NDB; ++db)
#pragma unroll
            for (int ksub = 0; ksub < 2; ++ksub) O = __builtin_amdgcn_mfma_f32_32x32x16_bf16(qf[2 * db + ksub], packacc(S[db], ksub), O, 0, 0, 0);
#pragma unroll
        for (int ksub = 0; ksub < 2; ++ksub) { O = __builtin_amdgcn_mfma_f32_32x32x16_bf16(packacc(aA, ksub), vf[ksub], O, 0, 0, 0); if (ib) O = __builtin_amdgcn_mfma_f32_32x32x16_bf16(packacc(aB, ksub), vf[2 + ksub], O, 0, 0, 0); }
#pragma unroll
        for (int db = 0; db < NDB; ++db) {
#pragma unroll
            for (int ks = 0; ks < 4; ++ks) S[db] = __builtin_amdgcn_mfma_f32_32x32x16_bf16(ktf[db][ks], vf[ks], S[db], 0, 0, 0); }
        asm volatile("s_nop 15\n\ts_nop 15" : "+v"(O));
#pragma unroll
        for (int db = 0; db < NDB; ++db) asm volatile("s_nop 15\n\ts_nop 15" : "+v"(S[db]));
#pragma unroll
        for (int db = 0; db < NDB; ++db) {
            if (KIND) { S[db] = S[db] * dret; }
            else {
#pragma unroll
                for (int g = 0; g < 4; ++g) { S[db][4 * g] *= dvv[g][0]; S[db][4 * g + 1] *= dvv[g][1]; S[db][4 * g + 2] *= dvv[g][2]; S[db][4 * g + 3] *= dvv[g][3]; } } }
#pragma unroll
        for (int r = 0; r < 16; ++r) Ot[(hl * 64 + 32 * ib + crow(r, hi)) * OTW + e0 + r32] = O[r];
        LIN_BAR();
        { f32x4 v[4]; float s1 = 0.f;
#pragma unroll
            for (int i = 0; i < 4; ++i) { v[i] = *(const LAS f32x4*)(Ot + (nh * 64 + nrow) * OTW + 16 * nq + 4 * i); s1 += (v[i][0] + v[i][1]) + (v[i][2] + v[i][3]); }
            float mean = 0.f; if (KIND) { s1 += __shfl_xor(s1, 1); s1 += __shfl_xor(s1, 2); mean = s1 * (1.f / 64.f); }
            float s2 = 0.f;
#pragma unroll
            for (int i = 0; i < 4; ++i) { v[i] = v[i] - mean; s2 += (v[i][0] * v[i][0] + v[i][1] * v[i][1]) + (v[i][2] * v[i][2] + v[i][3] * v[i][3]); }
            s2 += __shfl_xor(s2, 1); s2 += __shfl_xor(s2, 2);
            const float rs = __builtin_amdgcn_rsqf(s2 * (1.f / 64.f) + EPS);
            if (wr) { bf16* dst = ob + (size_t)sr * DM + KIND * 256 + hn * 64 + 16 * nq; const LAS float* gp = Gs + 16 * nq;
#pragma unroll
                for (int i = 0; i < 2; ++i) { const v4u g4 = og[i]; const f32x4 g0 = *(const LAS f32x4*)(gp + 8 * i), g1 = *(const LAS f32x4*)(gp + 8 * i + 4);
                    f32x4 x0 = v[2 * i] * rs * g0, x1 = v[2 * i + 1] * rs * g1;
                    x0[0] *= silu_f(bflo(g4.x)); x0[1] *= silu_f(bfhi(g4.x)); x0[2] *= silu_f(bflo(g4.y)); x0[3] *= silu_f(bfhi(g4.y)); x1[0] *= silu_f(bflo(g4.z)); x1[1] *= silu_f(bfhi(g4.z)); x1[2] *= silu_f(bflo(g4.w)); x1[3] *= silu_f(bfhi(g4.w));
                    *(v4u*)(dst + 8 * i) = pack8(x0, x1); } } }
        LIN_BAR();
    }
    asm volatile("s_waitcnt vmcnt(0)" ::: "memory");
#undef LIN_DMA
#undef LIN_BAR
}

template <int MODE, int KSTEPS  >
__device__ __forceinline__ void thin_unit(const bf16* A, int lda, const bf16* Bt, int u, bf16* H, float* stats_out, const float* stats_in, bf16* ACT, LAS unsigned char* lds, int tid) {
    constexpr int K = KSTEPS * 256;
    const int lane = tid & 63, w = __builtin_amdgcn_readfirstlane(tid >> 6), fr = lane & 15, fq = lane >> 4;
    int brow[4];
#pragma unroll
    for (int nb = 0; nb < 4; ++nb) brow[nb] = MODE == 0 ? 64 * u + 16 * nb + fr : 256 * (u >> 2) + 32 * (u & 3) + (nb >> 1) * 128 + 16 * (nb & 1) + fr;
    f32x4 acc[4];
#pragma unroll
    for (int nb = 0; nb < 4; ++nb) acc[nb] = (f32x4){0.f, 0.f, 0.f, 0.f};
    const bf16* ap = A + (size_t)fr * lda + w * (KSTEPS * 32) + 8 * fq;
    constexpr int B1 = KSTEPS > 6 ? 6 : KSTEPS;
    { s16x8 af[B1], bf[B1][4];
#pragma unroll
        for (int s = 0; s < B1; ++s) { af[s] = *(const s16x8*)(ap + 32 * s);
#pragma unroll
            for (int nb = 0; nb < 4; ++nb) bf[s][nb] = *(const s16x8*)(Bt + (size_t)brow[nb] * K + w * (KSTEPS * 32) + 32 * s + 8 * fq); }
#pragma unroll
        for (int s = 0; s < B1; ++s)
#pragma unroll
            for (int nb = 0; nb < 4; ++nb) acc[nb] = __builtin_amdgcn_mfma_f32_16x16x32_bf16(bf[s][nb], af[s], acc[nb], 0, 0, 0); }
    if (KSTEPS > B1) { constexpr int B2 = KSTEPS > B1 ? KSTEPS - B1 : 1; s16x8 af[B2], bf[B2][4];
#pragma unroll
        for (int s = 0; s < B2; ++s) { af[s] = *(const s16x8*)(ap + 32 * (B1 + s));
#pragma unroll
            for (int nb = 0; nb < 4; ++nb) bf[s][nb] = *(const s16x8*)(Bt + (size_t)brow[nb] * K + w * (KSTEPS * 32) + 32 * (B1 + s) + 8 * fq); }
#pragma unroll
        for (int s = 0; s < B2; ++s)
#pragma unroll
            for (int nb = 0; nb < 4; ++nb) acc[nb] = __builtin_amdgcn_mfma_f32_16x16x32_bf16(bf[s][nb], af[s], acc[nb], 0, 0, 0); }
    asm volatile("s_nop 15" : "+v"(acc[0]), "+v"(acc[1]), "+v"(acc[2]), "+v"(acc[3]));
    LAS f32x4* part = (LAS f32x4*)lds;
    __syncthreads();
#pragma unroll
    for (int nb = 0; nb < 4; ++nb) part[(w * 4 + nb) * 64 + lane] = acc[nb];
    __syncthreads();
    if (w == 0) {
#pragma unroll
        for (int nb = 0; nb < 4; ++nb) {
#pragma unroll
            for (int w2 = 1; w2 < 8; ++w2) acc[nb] = acc[nb] + part[(w2 * 4 + nb) * 64 + lane]; }
        const int row = MR + fr;
        if (MODE == 0) { float ss = 0.f;
#pragma unroll
            for (int nb = 0; nb < 4; ++nb) { bf16* p = H + (size_t)row * DM + 64 * u + 16 * nb + 4 * fq; const v2u wv = *(const v2u*)p;
                const float x0 = acc[nb][0] + bflo(wv.x), x1 = acc[nb][1] + bfhi(wv.x), x2 = acc[nb][2] + bflo(wv.y), x3 = acc[nb][3] + bfhi(wv.y);
                ss += (x0 * x0 + x1 * x1) + (x2 * x2 + x3 * x3);
                v2u o; o.x = pg8::cvt_pk_bf16(x0, x1); o.y = pg8::cvt_pk_bf16(x2, x3); *(v2u*)p = o; }
            ss += __shfl_xor(ss, 16); ss += __shfl_xor(ss, 32);
            if (fq == 0) stats_out[(size_t)row * 16 + u] = ss;
        } else { const f32x4* sp = (const f32x4*)(stats_in + (size_t)row * 16); const f32x4 s0 = sp[0], s1 = sp[1], s2 = sp[2], s3 = sp[3];
            const float st = ((s0[0] + s0[1]) + (s0[2] + s0[3])) + ((s1[0] + s1[1]) + (s1[2] + s1[3])) + ((s2[0] + s2[1]) + (s2[2] + s2[3])) + ((s3[0] + s3[1]) + (s3[2] + s3[3]));
            const float rs = __builtin_amdgcn_rsqf(st * (1.f / 1024.f) + EPS);
#pragma unroll
            for (int nb = 0; nb < 2; ++nb) { float y[4];
#pragma unroll
                for (int t = 0; t < 4; ++t) y[t] = silu_f(acc[nb][t] * rs) * (acc[2 + nb][t] * rs);
                v2u o; o.x = pg8::cvt_pk_bf16(y[0], y[1]); o.y = pg8::cvt_pk_bf16(y[2], y[3]);
                *(v2u*)(ACT + (size_t)row * DFF + 128 * (u >> 2) + 32 * (u & 3) + 16 * nb + 4 * fq) = o; } }
    }
    __syncthreads();
}

#ifndef REP_PREP
#define REP_PREP 1
#endif
#ifndef REP_MIX
#define REP_MIX 1
#endif
#ifndef REP_P0
#define REP_P0 1
#endif
#ifndef REP_CONV
#define REP_CONV 1
#endif
#ifndef REP_G1
#define REP_G1 1
#endif
#ifndef REP_MGU
#define REP_MGU 1
#endif
#ifndef REP_MDN
#define REP_MDN 1
#endif
#ifndef REP_BAR
#define REP_BAR 0
#endif
#ifndef REP_PART
#define REP_PART -1
#endif
#ifndef MK_ONE_LAUNCH
#define MK_ONE_LAUNCH 1
#endif
constexpr int NPHASE = 20;
constexpr int CW_Q = 12288;
__global__ void __launch_bounds__(512, 2) mega_fwd(Args a) {
    extern __shared__ __attribute__((aligned(16))) unsigned char lds_raw[];
    LAS unsigned char* lds = (LAS unsigned char*)lds_raw;
    volatile LAS unsigned* MISC = (volatile LAS unsigned*)(lds + MISC_OFF);
    int wave = __builtin_amdgcn_readfirstlane((int)threadIdx.x >> 6); asm volatile("" : "+s"(wave));
    const int G = gridDim.x;
#define TID() ((wave << 6) + lane_id())
    for (int u = TID(); u < (LDS_BYTES - RING_BYTES) / 4; u += 512) ((LAS unsigned*)(lds + RING_BYTES))[u] = 0u;
    __syncthreads();
    gu32* ctl = (gu32*)(a.ws + WS_CTL);
    const int lo = a.ph_lo, hi = a.ph_hi;
    XcdBarrier bar; bar.bar = (unsigned*)(ctl + CW_BAR); bar.x = 0; bar.st = nullptr;
    if (hi - lo > 1) bar = xcd_barrier_post((unsigned*)(ctl + CW_BAR), MISC + 8, TID() == 0);
#define IN(k) (lo <= (k) && (k) < hi)
#define OPQ() int ptid = TID(); asm volatile("" : "+v"(ptid)); const int plane = ptid & 63; (void)plane
#define SEAM(k) do { if (IN(k) && IN((k) + 1)) xcd_barrier(bar, TID() == 0); } while (0)
#define hb ((bf16*)(a.ws + WS_HB))
#define stA ((float*)(a.ws + WS_STA))
#define stB ((float*)(a.ws + WS_STB))

    for (int rep = 0; rep < REP_BAR; ++rep) xcd_barrier(bar, TID() == 0);
    if (IN(0)) { OPQ(); for (int rep = 0; rep < REP_P0; ++rep) { p0_prologue(a, lds, ptid, plane, wave); __syncthreads(); } }
    SEAM(0);

    for (int li = 0; li < 2; ++li) {
        const int pb = 1 + 6 * li;
        if (IN(pb)) {
            pg8::Gemm g{hb, (const bf16*)(a.ws + WS_W1T + li * W1T_BYTES), DM, 0, nullptr}; pg8::StaticOrder S; S.init(NPAN, N1 / 256, G, (int)blockIdx.x);
            EpiProj E{(bf16*)(a.ws + B_PROJ), stA};
            for (int rep = 0; rep < REP_G1; ++rep) pg8::gemm_phase<EpiProj, pg8::StaticOrder, false>(lds, g, S, E, wave);
        }
        SEAM(pb);
        if (IN(pb + 1)) { OPQ(); for (int rep = 0; rep < REP_PREP; ++rep) for (int u = blockIdx.x; u < NB * NCH * 4; u += G) { const int part = ((u & 3) + (u >> 8)) & 3;     if (rep > 0 && REP_PART >= 0 && part != REP_PART) continue; int ut = ptid; asm volatile("" : "+v"(ut)); prep2_unit(a, li, (u >> 2) / NCH, (u >> 2) % NCH, part, lds, ut); } __syncthreads(); }
        SEAM(pb + 1);
        if (IN(pb + 2)) {
            OPQ(); const int tid = ptid;
            LAS int* qid = (LAS int*)(lds + RING_BYTES + 64);
            float lam, lam_init; { const float* lv = a.in[I_DLAM] + li * 128; float s01 = 0.f, s23 = 0.f;
                for (int d = 0; d < 32; ++d) { s01 += lv[d] * lv[32 + d]; s23 += lv[64 + d] * lv[96 + d]; }
                lam_init = 0.8f - 0.6f * __expf(-0.3f * (float)li); lam = __expf(s01) - __expf(s23) + lam_init;
                lam = __uint_as_float(__builtin_amdgcn_readfirstlane(__float_as_uint(lam))); lam_init = __uint_as_float(__builtin_amdgcn_readfirstlane(__float_as_uint(lam_init))); }
            for (int rep = 0; rep < REP_MIX; ++rep)
            for (;;) {
                __syncthreads();
                if (tid == 0) *qid = (int)__hip_atomic_fetch_add(ctl + CW_Q + 64 * (li + 2 * rep), 1u, RLX_AGENT);
                __syncthreads();
                const int id = *qid;
                int utid = ptid; asm volatile("" : "+v"(utid));
                if (id >= 64 + 1024 + 8) break;
                if (id < 64) { if ((id & 1) == 0) lin_mfma_unit<0>(a, li, (id >> 1) & 15, id >> 5, lds, utid); else lin_mfma_unit<1>(a, li, (id >> 1) & 15, id >> 5, lds, utid); }
                else { const int v = id - 64; int qb, kind, b, hh;
                    if (v < 1024) { qb = 7 - (v >> 7); const int rem = v & 127; kind = rem >> 6; b = (rem >> 2) & 15; hh = rem & 3; } else { qb = -1; kind = (v - 1024) >> 2; b = 0; hh = v & 3; }
                    if (kind == 0) attn_mfma_unit<0>(a, li, b, hh, qb, lds, utid, 0.f, 1.f); else attn_mfma_unit<1>(a, li, b, hh, qb, lds, utid, lam, 1.f - lam_init); }
            }
        }
        SEAM(pb + 2);
        if (IN(pb + 3)) {
            if (li == 0) { OPQ(); for (int u = blockIdx.x; u < 16; u += G) thin_unit<0, 4>((const bf16*)a.out + (size_t)MR * DM, DM, (const bf16*)(a.ws + WS_WOT), u, hb, stB, nullptr, nullptr, lds, ptid); }
            pg8::Gemm g{(const bf16*)a.out, (const bf16*)(a.ws + WS_WOT + li * WOT_BYTES), DM, 0, nullptr}; pg8::StaticOrder S; S.init(NPAN - 1, 4, G, (int)blockIdx.x);
            EpiResid E{hb, stB};
            pg8::gemm_phase<EpiResid, pg8::StaticOrder, false>(lds, g, S, E, wave);
        }
        SEAM(pb + 3);
        if (li == 0) {
            if (IN(5)) {
                { OPQ(); for (int u = blockIdx.x; u < 88; u += G) thin_unit<1, 4>(hb + (size_t)MR * DM, DM, (const bf16*)(a.ws + WS_WGU), u, nullptr, nullptr, stB, (bf16*)(a.ws + B_ACT), lds, ptid); }
                pg8::Gemm g{hb, (const bf16*)(a.ws + WS_WGU), DM, 0, nullptr}; pg8::StaticOrder S; S.init(NPAN - 1, 2 * DFF / 256, G, (int)blockIdx.x);
                EpiSwiglu E{(bf16*)(a.ws + B_ACT), DFF, stB};
                pg8::gemm_phase<EpiSwiglu, pg8::StaticOrder, false>(lds, g, S, E, wave);
            }
            SEAM(5);
            if (IN(6)) {
                { OPQ(); for (int u = blockIdx.x; u < 16; u += G) thin_unit<0, 11>((const bf16*)(a.ws + B_ACT) + (size_t)MR * DFF, DFF, (const bf16*)(a.ws + WS_WD), u, hb, stA, nullptr, nullptr, lds, ptid); }
                pg8::Gemm g{(const bf16*)(a.ws + B_ACT), (const bf16*)(a.ws + WS_WD), DFF, 0, nullptr}; pg8::StaticOrder S; S.init(NPAN - 1, 4, G, (int)blockIdx.x);
                EpiResid E{hb, stA};
                pg8::gemm_phase<EpiResid, pg8::StaticOrder, false>(lds, g, S, E, wave);
            }
            SEAM(6);
        }
    }
    if (IN(11)) { OPQ(); const int tid = ptid, lane = plane;
        LAS float* scr = (LAS float*)(lds + wave * 16384);
        const int gw = blockIdx.x * 8 + wave, NGW = G * 8;
        constexpr int IG = 16 * 56, ID = 56 * 16;
        for (int rep = 0; rep < REP_CONV; ++rep)
        for (int it = gw; it < 8 * (2 * IG + ID); it += NGW) { const int e = it / (2 * IG + ID); int r = it % (2 * IG + ID);
            if (r < IG) { transpose_item(a.in[I_EG] + (size_t)e * DM * DFE, DM, DFE, a.in[I_FNORM] + DM, (bf16*)(a.ws + B_EGU + e * EGU_BYTES), r / 56, r % 56, 1, scr, lane); continue; } r -= IG;
            if (r < IG) { transpose_item(a.in[I_EU] + (size_t)e * DM * DFE, DM, DFE, a.in[I_FNORM] + DM, (bf16*)(a.ws + B_EGU + e * EGU_BYTES), r / 56, r % 56, 2, scr, lane); continue; } r -= IG;
            transpose_item(a.in[I_ED] + (size_t)e * DFE * DM, DFE, DM, nullptr, (bf16*)(a.ws + B_ED + e * ED_BYTES), r / 16, r % 16, 0, scr, lane); }
        for (int i = blockIdx.x * 512 + tid; i < MAXPAN * 256; i += G * 512) { ((int*)(a.ws + MO_ROWIDX))[i] = -1; ((int*)(a.ws + MO_PDST))[i] = -1; ((f32x2*)(a.ws + MO_PINFO))[i] = (f32x2){0.f, 0.f}; }
        for (int blk = blockIdx.x; blk < MR / 128; blk += G) route_block(a, blk, lds, tid, lane, wave);
    }
    SEAM(11);
    LAS int* offs = (LAS int*)(lds + RING_BYTES + 128);
    if (IN(12)) { OPQ(); const int tid = ptid;
        moe_offsets(a, offs, tid);
        for (int idx = blockIdx.x * 512 + tid; idx < 2 * MR; idx += G * 512) { const int tok = idx >> 1, e = ((const int*)(a.ws + MO_TOKE))[idx], gpos = offs[e] + ((const int*)(a.ws + MO_TOKP))[idx];
            const f32x4* sp = (const f32x4*)(stB + (size_t)tok * 16); const f32x4 s0 = sp[0], s1 = sp[1], s2 = sp[2], s3 = sp[3];
            const float ss = ((s0[0] + s0[1]) + (s0[2] + s0[3])) + ((s1[0] + s1[1]) + (s1[2] + s1[3])) + ((s2[0] + s2[1]) + (s2[2] + s2[3])) + ((s3[0] + s3[1]) + (s3[2] + s3[3]));
            ((int*)(a.ws + MO_ROWIDX))[gpos] = tok; ((int*)(a.ws + MO_PDST))[gpos] = idx;
            ((f32x2*)(a.ws + MO_PINFO))[gpos] = (f32x2){__builtin_amdgcn_rsqf(ss * (1.f / 1024.f) + EPS), __int_as_float(((const int*)(a.ws + MO_TOKW))[idx])}; }
        if (blockIdx.x == 0 && tid < MAXPAN + 8) { int e = 0;
            for (int k = 1; k < 8; ++k) if (tid * 256 >= offs[k]) e = k;
            ((int*)(a.ws + MO_PEXP))[tid] = e; }
    }
    SEAM(12);
    for (int ci = 0; ci < 3; ++ci) {
        if (IN(13 + 2 * ci) || IN(14 + 2 * ci)) moe_offsets(a, offs, TID());
        int nP = 0; if (IN(13 + 2 * ci) || IN(14 + 2 * ci)) { nP = __builtin_amdgcn_readfirstlane(offs[8]) - 128 * ci; nP = nP > 128 ? 128 : nP; }
        if (IN(13 + 2 * ci) && nP > 0) {
            pg8::Gemm g{hb, (const bf16*)(a.ws + B_EGU), DM, EGU_BYTES, (const int*)(a.ws + MO_ROWIDX)}; pg8::MoeOrder S; S.init(nP, 2 * DFE / 256, G, (int)blockIdx.x, 128 * ci, (const int*)(a.ws + MO_PEXP));
            EpiSwigluMoe E{(bf16*)(a.ws + B_EACT), (const f32x2*)(a.ws + MO_PINFO)};
            for (int rep = 0; rep < REP_MGU; ++rep) pg8::gemm_phase<EpiSwigluMoe, pg8::MoeOrder, true>(lds, g, S, E, wave);
        }
        SEAM(13 + 2 * ci);
        if (IN(14 + 2 * ci) && nP > 0) {
            pg8::Gemm g{(const bf16*)(a.ws + B_EACT), (const bf16*)(a.ws + B_ED), DFE, ED_BYTES, nullptr}; pg8::MoeOrder S; S.init(nP, 4, G, (int)blockIdx.x, 128 * ci, (const int*)(a.ws + MO_PEXP));
            EpiMoeDown E{(unsigned char*)a.out, (const int*)(a.ws + MO_PDST), (const f32x2*)(a.ws + MO_PINFO)};
            for (int rep = 0; rep < REP_MDN; ++rep) pg8::gemm_phase<EpiMoeDown, pg8::MoeOrder, false>(lds, g, S, E, wave);
        }
        SEAM(14 + 2 * ci);
    }
    if (IN(19)) { OPQ(); const int lane = plane;
        const float* fn = a.in[I_FINAL];
        for (int r = blockIdx.x * 8 + wave; r < MR; r += G * 8) {
            unsigned char* orow = (unsigned char*)a.out + (size_t)r * 4096; float v[16]; float ss = 0.f;
#pragma unroll
            for (int hf = 0; hf < 2; ++hf) { const int k = 512 * hf + 8 * lane; const v4u h4 = *(const v4u*)(hb + (size_t)r * DM + k), y0 = *(const v4u*)(orow + 2 * k), y1 = *(const v4u*)(orow + 2048 + 2 * k);
                const unsigned hw[4] = {h4.x, h4.y, h4.z, h4.w}, aw[4] = {y0.x, y0.y, y0.z, y0.w}, bw[4] = {y1.x, y1.y, y1.z, y1.w};
#pragma unroll
                for (int t = 0; t < 4; ++t) { const float x0 = bflo(hw[t]) + bflo(aw[t]) + bflo(bw[t]), x1 = bfhi(hw[t]) + bfhi(aw[t]) + bfhi(bw[t]); v[8 * hf + 2 * t] = x0; v[8 * hf + 2 * t + 1] = x1; ss += x0 * x0 + x1 * x1; } }
            ss = wave_sum(ss); const float rs = __builtin_amdgcn_rsqf(ss * (1.f / 1024.f) + EPS);
#pragma unroll
            for (int hf = 0; hf < 2; ++hf) { const int k = 512 * hf + 8 * lane; const f32x4 g0 = *(const f32x4*)(fn + k), g1 = *(const f32x4*)(fn + k + 4);
                *(f32x4*)(orow + 4 * k) = (f32x4){v[8 * hf] * rs * g0[0], v[8 * hf + 1] * rs * g0[1], v[8 * hf + 2] * rs * g0[2], v[8 * hf + 3] * rs * g0[3]};
                *(f32x4*)(orow + 4 * k + 16) = (f32x4){v[8 * hf + 4] * rs * g1[0], v[8 * hf + 5] * rs * g1[1], v[8 * hf + 6] * rs * g1[2], v[8 * hf + 7] * rs * g1[3]}; }
        }
    }
#undef IN
#undef SEAM
#undef hb
#undef stA
#undef stB
}

extern "C" void kernel_launch(void* const* d_in, const int* in_sizes, int n_in, void* d_out, int out_size, void* d_ws, size_t ws_size, hipStream_t stream) {
    static int grid = 0;
    if (grid == 0) {
        if (n_in != 24 || in_sizes[0] != MR * DM || out_size != MR * DM || ws_size < WS_NEED) { fprintf(stderr, "kernel_launch: unexpected problem (n_in %d, in0 %d, out %d, ws %zu < %zu)\n", n_in, n_in > 0 ? in_sizes[0] : -1, out_size, ws_size, (size_t)WS_NEED); grid = -1; return; }
        int dev = 0, cus = 0, per_cu = 0;
        if (hipGetDevice(&dev) != hipSuccess || hipDeviceGetAttribute(&cus, hipDeviceAttributeMultiprocessorCount, dev) != hipSuccess) { grid = -1; return; }
        if (hipFuncSetAttribute((const void*)mega_fwd, hipFuncAttributeMaxDynamicSharedMemorySize, LDS_BYTES) != hipSuccess) { fprintf(stderr, "kernel_launch: hipFuncSetAttribute failed\n"); grid = -1; return; }
        if (hipOccupancyMaxActiveBlocksPerMultiprocessor(&per_cu, (const void*)mega_fwd, 512, LDS_BYTES) != hipSuccess || per_cu < 1) fprintf(stderr, "kernel_launch: occupancy query reports %d\n", per_cu);
        (void)hipGetLastError();
        grid = cus;
    }
    if (grid < 0) return;
    if (hipMemsetAsync((char*)d_ws + WS_CTL, 0, CTL_BYTES, stream) != hipSuccess) return;
    Args a{};
    for (int i = 0; i < 24; ++i) a.in[i] = (const float*)d_in[i];
    a.out = (float*)d_out; a.ws = (unsigned char*)d_ws;
#if MK_ONE_LAUNCH
    a.ph_lo = 0; a.ph_hi = NPHASE;
    hipLaunchKernelGGL(mega_fwd, dim3(grid), dim3(512), LDS_BYTES, stream, a);
#else
    for (int p = 0; p < NPHASE; ++p) { a.ph_lo = p; a.ph_hi = p + 1; hipLaunchKernelGGL(mega_fwd, dim3(grid), dim3(512), LDS_BYTES, stream, a); }
#endif
}
```

```cpp
#include <hip/hip_runtime.h>
#include <cstdio>
#include <cstdint>

namespace pg8 {
#define PG8_LAS __attribute__((address_space(3)))
typedef unsigned short bf16_t;
typedef short bf16x8 __attribute__((ext_vector_type(8)));
typedef float f32x4 __attribute__((ext_vector_type(4)));
typedef unsigned u32x4 __attribute__((ext_vector_type(4)));
constexpr int BM = 256, BK = 64, HALF = 128, HTB = HALF * BK * 2  , STAGE_BYTES = 8 * HTB, NXCD = 8, WGM = 8;

__host__ __device__ __forceinline__ int lds_byte(int r, int c) { const int st = (r >> 4) * 2 + (c >> 5), rr = r & 15, cc = c & 31, ob = rr * 64 + cc * 2; return st * 1024 + (ob ^ (((ob >> 9) & 1) << 5)); }
__host__ __device__ __forceinline__ void stage_rc(int b, int& R, int& C) { const int st = b / 1024, sb = b % 1024, swz = sb ^ (((sb >> 9) & 1) << 5); R = (st >> 1) * 16 + swz / 64; C = (st & 1) * 32 + (swz % 64) / 2; }
__host__ __device__ __forceinline__ int perm32(int rho) { const int n = rho >> 4, i = rho & 15; return 8 * (i >> 2) + 4 * n + (i & 3); }

struct Unit { int pm, pn, e, gp; };
struct Gemm { const bf16_t* A; const bf16_t* Bt; int K; size_t estride  ; const int* rowidx  ; };

struct StaticOrder {
    int nM, nN, nwg, G, c;
    __device__ void init(int nM_, int nN_, int G_, int c_) { nM = nM_; nN = nN_; nwg = nM * nN; G = G_; c = c_; }
    __device__ __forceinline__ bool map(int i, int& pm, int& pn) const {
        const long L = (long)i * G + c; if (L >= nwg) return false;
        int wgid = (int)L; { const int q = nwg / NXCD, r = nwg % NXCD, xcd = wgid % NXCD, off = wgid / NXCD; wgid = (xcd < r ? xcd * (q + 1) : r * (q + 1) + (xcd - r) * q) + off; }
        const int nig = WGM * nN, gid = wgid / nig, fm = gid * WGM, gsz = (nM - fm) < WGM ? (nM - fm) : WGM;
        pm = fm + ((wgid % nig) % gsz); pn = (wgid % nig) / gsz; return true;
    }
    __device__ __forceinline__ bool next(int i, Unit& u) const { int pm, pn; if (!map(i, pm, pn)) return false; u.pm = pm; u.pn = pn; u.e = 0; u.gp = pm; return true; }
};
struct MoeOrder {
    StaticOrder so; int p0; const int* pexp;
    __device__ void init(int nP, int nN, int G, int c, int p0_, const int* pexp_) { so.init(nP, nN, G, c); p0 = p0_; pexp = pexp_; }
    __device__ __forceinline__ bool next(int i, Unit& u) const { int pm, pn; if (!so.map(i, pm, pn)) return false; u.pm = pm; u.pn = pn; u.gp = p0 + pm; u.e = __builtin_amdgcn_readfirstlane(pexp[u.gp]); return true; }
};

__device__ __forceinline__ unsigned cvt_pk_bf16(float lo, float hi) { unsigned r; asm volatile("v_cvt_pk_bf16_f32 %0, %1, %2" : "=v"(r) : "v"(lo), "v"(hi)); return r; }
__device__ __forceinline__ float bf_lo(unsigned w) { return __uint_as_float(w << 16); }
__device__ __forceinline__ float bf_hi(unsigned w) { return __uint_as_float(w & 0xffff0000u); }

template <class Epi, class Sched, bool GATHER>
__device__ __forceinline__ void gemm_phase(PG8_LAS unsigned char* lds, const Gemm g, const Sched& S, const Epi& E, int wave_id  ) {
    int tid_; asm volatile("v_mbcnt_lo_u32_b32 %0, -1, 0\n\tv_mbcnt_hi_u32_b32 %0, -1, %0" : "=v"(tid_)); tid_ += wave_id << 6;
    const int tid = tid_, wid = __builtin_amdgcn_readfirstlane(tid >> 6), lane = tid & 63, wr = wid >> 2, wc = wid & 3, fr = lane & 15, fq = lane >> 4;
    const int K = g.K, nt = K / BK;
    int Ra[2], Ca[2]; unsigned voffB[2];
#pragma unroll
    for (int i = 0; i < 2; ++i) { int R, C; stage_rc(tid * 16 + i * 8192, R, C); const int Rb = (R & ~31) + perm32(R & 31);
        Ra[i] = R; Ca[i] = C; voffB[i] = (unsigned)(Rb * K + C) * 2u; }
    const size_t kstep = (size_t)(BK * 2);
    const size_t hstep = (size_t)HALF * K * 2;
    const size_t tstep = 2 * hstep;
    const unsigned ldsw = (unsigned)wid * 1024u;
    const int aoff = lds_byte(wr * 64 + fr, fq * 8), boff = lds_byte(wc * 32 + fr, fq * 8);
    const char* const A0 = (const char*)g.A;
#define PG8_SA(b, h) (((b) * 2 + (h)) * HTB)
#define PG8_SB(b, h) ((4 + (b) * 2 + (h)) * HTB)
#define PG8_STAGE(bufoff, gbase, voff) do { _Pragma("unroll") for (int _i = 0; _i < 2; ++_i) \
        __builtin_amdgcn_global_load_lds((const unsigned*)((const char*)(gbase) + (voff)[_i]), (PG8_LAS unsigned*)(lds + (bufoff) + ldsw + _i * 8192), 16, 0, 0); } while (0)
#define PG8_LDA(dst, b, h) do { _Pragma("unroll") for (int m = 0; m < 4; ++m) _Pragma("unroll") for (int k = 0; k < 2; ++k) dst[m][k] = *(const PG8_LAS bf16x8*)(lds + PG8_SA(b, h) + aoff + m * 2048 + k * 1024); } while (0)
#define PG8_LDB(dst, b, h) do { _Pragma("unroll") for (int n = 0; n < 2; ++n) _Pragma("unroll") for (int k = 0; k < 2; ++k) dst[n][k] = *(const PG8_LAS bf16x8*)(lds + PG8_SB(b, h) + boff + n * 2048 + k * 1024); } while (0)
#define PG8_MMA(ai, bj, At, Bt) do { __builtin_amdgcn_s_setprio(1); _Pragma("unroll") for (int m = 0; m < 4; ++m) _Pragma("unroll") for (int n = 0; n < 2; ++n) _Pragma("unroll") for (int k = 0; k < 2; ++k) \
        acc[ai][bj][m][n] = __builtin_amdgcn_mfma_f32_16x16x32_bf16(Bt[n][k], At[m][k], acc[ai][bj][m][n], 0, 0, 0); __builtin_amdgcn_s_setprio(0); } while (0)
#define PG8_WAIT_V(n) asm volatile("s_waitcnt vmcnt(" #n ")" ::: "memory")
#define PG8_WAIT_L(n) asm volatile("s_waitcnt lgkmcnt(" #n ")" ::: "memory")
#define PG8_BAR __builtin_amdgcn_s_barrier()
#define PG8_SCHED __builtin_amdgcn_sched_barrier(0)
#define PG8_AOFFS(dst, u) do { _Pragma("unroll") for (int _h = 0; _h < 2; ++_h) _Pragma("unroll") for (int _i = 0; _i < 2; ++_i) { \
        int _row = (u).pm * BM + _h * HALF + Ra[_i]; \
        if (GATHER) { const int _gi = g.rowidx[(u).gp * BM + _h * HALF + Ra[_i]]; _row = _gi < 0 ? 0 : _gi; } \
        dst[_h][_i] = ((unsigned)_row * (unsigned)K + (unsigned)Ca[_i]) * 2u; } } while (0)
    Unit cur, nxt; int ui = 0;
    if (!S.next(0, cur)) return;
    f32x4 acc[2][2][4][2];
#pragma unroll
    for (int a = 0; a < 2; ++a)
#pragma unroll
        for (int b = 0; b < 2; ++b)
#pragma unroll
            for (int m = 0; m < 4; ++m)
#pragma unroll
                for (int n = 0; n < 2; ++n) acc[a][b][m][n] = (f32x4){0.f, 0.f, 0.f, 0.f};
    bf16x8 At[4][2], B0[2][2], B1[2][2];
    unsigned oaC[2][2], oaN[2][2];
    PG8_AOFFS(oaC, cur);
    const char* cB = (const char*)g.Bt + (size_t)cur.e * g.estride + (size_t)cur.pn * tstep;
    PG8_STAGE(PG8_SB(0, 0), cB, voffB); PG8_STAGE(PG8_SB(0, 1), cB + hstep, voffB); PG8_STAGE(PG8_SA(0, 0), A0, oaC[0]); PG8_STAGE(PG8_SA(0, 1), A0, oaC[1]);
    if (wr == 1) PG8_BAR;
    PG8_WAIT_V(2); PG8_BAR;
    PG8_STAGE(PG8_SB(1, 0), cB + kstep, voffB); PG8_STAGE(PG8_SA(1, 0), A0 + kstep, oaC[0]); PG8_STAGE(PG8_SB(1, 1), cB + hstep + kstep, voffB);
    PG8_WAIT_V(6); PG8_BAR;
    for (;;) {
        const bool has_next = S.next(ui + 1, nxt);
        if (has_next) { PG8_AOFFS(oaN, nxt); }
        else {
#pragma unroll
            for (int _h = 0; _h < 2; ++_h)
#pragma unroll
                for (int _i = 0; _i < 2; ++_i) oaN[_h][_i] = oaC[_h][_i]; }
        const char* nB = has_next ? (const char*)g.Bt + (size_t)nxt.e * g.estride + (size_t)nxt.pn * tstep : cB;
        for (int t = 0; t < nt; t += 2) {
            const bool last = (t == nt - 2);
            const char* ka1 = A0 + (size_t)(t + 1) * kstep;
            const char* ka2 = last ? A0 : A0 + (size_t)(t + 2) * kstep; const char* b2 = last ? nB : cB + (size_t)(t + 2) * kstep;
            const char* ka3 = ka2 + kstep; const char* b3 = b2 + kstep;
            unsigned o2[2][2];
#pragma unroll
            for (int _h = 0; _h < 2; ++_h)
#pragma unroll
                for (int _i = 0; _i < 2; ++_i) o2[_h][_i] = oaC[_h][_i];
            if (last) {
#pragma unroll
                for (int _h = 0; _h < 2; ++_h)
#pragma unroll
                    for (int _i = 0; _i < 2; ++_i) o2[_h][_i] = oaN[_h][_i];
                asm volatile("" : "+v"(o2[0][0]), "+v"(o2[0][1]), "+v"(o2[1][0]), "+v"(o2[1][1])); }
            PG8_LDB(B0, 0, 0); PG8_LDB(B1, 0, 1); PG8_SCHED; PG8_LDA(At, 0, 0); PG8_STAGE(PG8_SA(1, 1), ka1, oaC[1]);
            PG8_WAIT_V(8); PG8_WAIT_L(0); PG8_BAR; PG8_MMA(0, 0, At, B0); PG8_MMA(0, 1, At, B1); PG8_BAR; PG8_SCHED;
            PG8_LDA(At, 0, 1); PG8_STAGE(PG8_SB(0, 0), b2, voffB); PG8_STAGE(PG8_SB(0, 1), b2 + hstep, voffB); PG8_STAGE(PG8_SA(0, 0), ka2, o2[0]);
            PG8_WAIT_V(8); PG8_WAIT_L(0); PG8_BAR; PG8_MMA(1, 0, At, B0); PG8_MMA(1, 1, At, B1); PG8_BAR; PG8_SCHED;
            PG8_LDB(B0, 1, 0); PG8_LDB(B1, 1, 1); PG8_SCHED; PG8_LDA(At, 1, 0); PG8_STAGE(PG8_SA(0, 1), ka2, o2[1]);
            PG8_WAIT_V(8); PG8_WAIT_L(0); PG8_BAR; PG8_MMA(0, 0, At, B0); PG8_MMA(0, 1, At, B1); PG8_BAR; PG8_SCHED;
            PG8_LDA(At, 1, 1); PG8_STAGE(PG8_SB(1, 0), b3, voffB); PG8_STAGE(PG8_SB(1, 1), b3 + hstep, voffB); PG8_STAGE(PG8_SA(1, 0), ka3, o2[0]);
            PG8_WAIT_V(8); PG8_WAIT_L(0); PG8_BAR; PG8_MMA(1, 0, At, B0); PG8_MMA(1, 1, At, B1); PG8_BAR; PG8_SCHED;
        }
        if (wr == 0) PG8_BAR;
        E(acc, cur, wr, wc, fr, fq);
        if (!has_next) break;
#pragma unroll
        for (int a = 0; a < 2; ++a)
#pragma unroll
            for (int b = 0; b < 2; ++b)
#pragma unroll
                for (int m = 0; m < 4; ++m)
#pragma unroll
                    for (int n = 0; n < 2; ++n) acc[a][b][m][n] = (f32x4){0.f, 0.f, 0.f, 0.f};
        cur = nxt; cB = nB; ++ui;
#pragma unroll
        for (int _h = 0; _h < 2; ++_h)
#pragma unroll
            for (int _i = 0; _i < 2; ++_i) oaC[_h][_i] = oaN[_h][_i];
        if (wr == 1) PG8_BAR;
    }
    PG8_WAIT_V(0);
    PG8_BAR;
#undef PG8_SA
#undef PG8_SB
#undef PG8_STAGE
#undef PG8_LDA
#undef PG8_LDB
#undef PG8_MMA
#undef PG8_WAIT_V
#undef PG8_WAIT_L
#undef PG8_BAR
#undef PG8_SCHED
#undef PG8_AOFFS
}
}
#define GAS __attribute__((address_space(1)))
#define LAS __attribute__((address_space(3)))
typedef unsigned short bf16;
typedef unsigned v4u __attribute__((ext_vector_type(4)));
typedef unsigned v2u __attribute__((ext_vector_type(2)));
typedef float f32x4 __attribute__((ext_vector_type(4)));
typedef float f32x2 __attribute__((ext_vector_type(2)));
typedef GAS unsigned gu32;
#define RLX_AGENT __ATOMIC_RELAXED, __HIP_MEMORY_SCOPE_AGENT
#define LDS_WAIT() asm volatile("s_waitcnt lgkmcnt(0)" ::: "memory")
#define VM_WAIT() asm volatile("s_waitcnt vmcnt(0)" ::: "memory")
__device__ __forceinline__ unsigned f2bf(float f) { unsigned u = __builtin_bit_cast(unsigned, f); return (u + 0x7fffu + ((u >> 16) & 1u)) >> 16; }
__device__ __forceinline__ unsigned pk2(float lo, float hi) { return f2bf(lo) | (f2bf(hi) << 16); }
__device__ __forceinline__ float bf2f(bf16 h) { return __uint_as_float(((unsigned)h) << 16); }
__device__ __forceinline__ float bflo(unsigned w) { return __uint_as_float(w << 16); }
__device__ __forceinline__ float bfhi(unsigned w) { return __uint_as_float(w & 0xffff0000u); }

#define XB_TMO      128
#define XB_XCNT(j)  (256  + 64 * (j))
#define XB_XSUB(j)  (1280 + 64 * (j))
#define XB_XGEN(j)  (2304 + 64 * (j))
#define XB_TOP      3328
#define XB_TOPGEN   3392
#define XCD_BAR_WORDS 3456
#define XB_SPIN_CAP (1u << 18)

__device__ __forceinline__ unsigned xb_ld(unsigned* p)              { return __hip_atomic_load(p, __ATOMIC_RELAXED, __HIP_MEMORY_SCOPE_AGENT); }
__device__ __forceinline__ unsigned xb_add(unsigned* p, unsigned v) { return __hip_atomic_fetch_add(p, v, __ATOMIC_RELAXED, __HIP_MEMORY_SCOPE_AGENT); }
__device__ __forceinline__ unsigned xb_xcc_id() { return (unsigned)__builtin_amdgcn_s_getreg((3 << 11) | 20) & 0xFu; }
#define XB_SPIN(cond, bar) do { unsigned _sp = 0; while (cond) { __builtin_amdgcn_s_sleep(1); \
    if ((++_sp & 255u) == 0u) { if (xb_ld(&(bar)[XB_TMO])) break; if (_sp > XB_SPIN_CAP) { atomicAdd(&(bar)[XB_TMO], 1u); break; } } } } while (0)

struct XcdBarrier {
    unsigned* bar; unsigned x;
    volatile LAS unsigned* st;
};

__device__ __forceinline__ XcdBarrier xcd_barrier_post(unsigned* bar, volatile LAS unsigned* st, bool leader  ) {
    XcdBarrier b; b.bar = bar; b.x = xb_xcc_id(); b.st = st;
    if (leader) (void)xb_add(&bar[XB_XCNT(b.x)], 1u);
    return b;
}
__device__ __forceinline__ void xcd_barrier_complete(unsigned* bar, unsigned x, unsigned& nloc, unsigned& nx) {
    const unsigned G = gridDim.x * gridDim.y * gridDim.z;
    unsigned sum, cnt, mine, sp = 0u;
    for (;;) {
        sum = 0u; cnt = 0u; mine = 0u;
#pragma unroll
        for (unsigned j = 0; j < 16; ++j) { const unsigned c = xb_ld(&bar[XB_XCNT(j)]); sum += c; cnt += (c > 0u) ? 1u : 0u; mine = (j == x) ? c : mine; }
        if (sum == G) break;
        __builtin_amdgcn_s_sleep(1);
        if ((++sp & 255u) == 0u) { if (xb_ld(&bar[XB_TMO])) break; if (sp > XB_SPIN_CAP) { atomicAdd(&bar[XB_TMO], 1u); break; } }
    }
    nloc = mine > 0u ? mine : 1u; nx = cnt > 0u ? cnt : 1u;
}

__device__ __forceinline__ void xcd_barrier(const XcdBarrier& b, bool leader) {
    asm volatile("s_waitcnt vmcnt(0)" ::: "memory");
    __syncthreads();
    if (leader) {
        unsigned* bar = b.bar;
        __builtin_amdgcn_s_waitcnt(0);
        unsigned nloc = b.st[0], nx = b.st[1];
        if (nloc == 0u) { xcd_barrier_complete(bar, b.x, nloc, nx); b.st[0] = nloc; b.st[1] = nx; }
        const unsigned old = xb_add(&bar[XB_XSUB(b.x)], 1u);
        const unsigned gen = old / nloc;
        if (old + 1u == (gen + 1u) * nloc) {
            __builtin_amdgcn_fence(__ATOMIC_RELEASE, "agent");
            asm volatile("s_waitcnt vmcnt(0)" ::: "memory");
            const unsigned og = xb_add(&bar[XB_TOP], 1u);
            const unsigned tg = og / nx;
            if (og + 1u == (tg + 1u) * nx) xb_add(&bar[XB_TOPGEN], 1u);
            else XB_SPIN(xb_ld(&bar[XB_TOPGEN]) == tg, bar);
            __builtin_amdgcn_fence(__ATOMIC_ACQUIRE, "agent");
            xb_add(&bar[XB_XGEN(b.x)], 1u);
            asm volatile("s_waitcnt vmcnt(0)" ::: "memory");
        } else {
            XB_SPIN(xb_ld(&bar[XB_XGEN(b.x)]) == gen, bar);
            __builtin_amdgcn_fence(__ATOMIC_ACQUIRE, "agent");
            asm volatile("s_waitcnt vmcnt(0)" ::: "memory");
        }
    }
    __syncthreads();
}

__device__ __forceinline__ int lane_id() { int l; asm volatile("v_mbcnt_lo_u32_b32 %0, -1, 0\n\tv_mbcnt_hi_u32_b32 %0, -1, %0" : "=v"(l)); return l; }

constexpr int NB = 16, TT = 2048, DM = 1024, MR = NB * TT, NMETA = 16, MROWS = MR + 256, NPAN = MROWS / 256;
constexpr int PSEQ = 2112, NCH = 33;
constexpr int DIN = 2864, N1 = 3328;
constexpr int DFF = 2816, DFE = 3584, NEXP = 8;
constexpr float EPS = 1e-6f;
constexpr int C_AQ = 0, C_AK = 128, C_AV = 256, C_ALR = 512, C_AOG = 528, C_RQ = 784, C_RK = 1040, C_RV = 1296, C_ROG = 1552, C_CQ = 1808, C_CKV = 2000, C_KPE = 2064, C_DQ = 2096, C_DK = 2352, C_DV = 2608, C_QEFF = 2864;
constexpr int MAXPAN = 264;
constexpr float LOG2E = 1.4426950408889634f;

constexpr size_t MiB = 1u << 20;
constexpr size_t WS_CTL = 0, CTL_BYTES = 1 * MiB;
constexpr size_t WS_TABR = 1 * MiB, WS_TABM = 1 * MiB + 576 * 1024;
constexpr size_t WS_RT = 2 * MiB;
constexpr size_t WS_STA = 3 * MiB, WS_STB = 6 * MiB;
constexpr size_t WS_MOE = 9 * MiB;
constexpr size_t MO_ROWIDX = WS_MOE, MO_PDST = WS_MOE + 512 * 1024, MO_PINFO = WS_MOE + 1 * MiB, MO_TOKE = WS_MOE + 2 * MiB, MO_TOKP = MO_TOKE + 256 * 1024, MO_TOKW = MO_TOKE + 512 * 1024, MO_PEXP = WS_MOE + 3 * MiB;
constexpr size_t WS_GD = 13 * MiB;
constexpr size_t WS_W1T = 16 * MiB, W1T_BYTES = (size_t)N1 * DM * 2;
constexpr size_t WS_WOT = 29 * MiB, WOT_BYTES = (size_t)DM * DM * 2;
constexpr size_t WS_WGU = 33 * MiB;
constexpr size_t WS_WD = 44 * MiB;
constexpr size_t WS_HB = 50 * MiB;
constexpr size_t WS_BIG = 115 * MiB;
constexpr size_t B_PROJ = WS_BIG;
constexpr int GQ_T = 5120, GKT_T = 5120, RT_T = 9216, VT_T = 9216;
constexpr size_t B_GQ = WS_BIG + 210 * MiB, B_GK = WS_BIG + 221 * MiB, B_GV = WS_BIG + 232 * MiB;
constexpr size_t B_RQ = WS_BIG + 251 * MiB, B_RK = WS_BIG + 270 * MiB, B_RV = WS_BIG + 289 * MiB;
constexpr size_t B_MQ = WS_BIG + 308 * MiB, B_MK = WS_BIG + 333 * MiB;
constexpr size_t B_DQ = WS_BIG + 340 * MiB, B_DK = B_DQ + 16896 * 1024;
constexpr size_t O_DVT = 65 * MiB, O_MVT = 82 * MiB, O_GKT = 87 * MiB, O_RKT = 98 * MiB;
constexpr size_t B_ACT = WS_BIG;
constexpr size_t B_EGU = WS_BIG, EGU_BYTES = (size_t)2 * DFE * DM * 2;
constexpr size_t B_ED = WS_BIG + 112 * MiB, ED_BYTES = (size_t)DM * DFE * 2;
constexpr size_t B_EACT = WS_BIG + 168 * MiB;
constexpr size_t WS_NEED = WS_BIG + 392 * MiB;
constexpr int CW_BAR = 4096, CW_CNT = 8192;

constexpr int RING_BYTES = 131072, MISC_OFF = RING_BYTES + 320, LDS_BYTES = 147456;

__device__ __forceinline__ float silu_f(float x) { return x * __builtin_amdgcn_rcpf(1.0f + __builtin_amdgcn_exp2f(-x * LOG2E)); }
__device__ __forceinline__ v4u pack8(const f32x4 a, const f32x4 b) { v4u w; w.x = pg8::cvt_pk_bf16(a[0], a[1]); w.y = pg8::cvt_pk_bf16(a[2], a[3]); w.z = pg8::cvt_pk_bf16(b[0], b[1]); w.w = pg8::cvt_pk_bf16(b[2], b[3]); return w; }

__device__ __forceinline__ void rows_rstd16(const float* stats, int row0, int fq, float (&rs)[8]) {
    f32x4 v[8];
#pragma unroll
    for (int j = 0; j < 8; ++j) v[j] = *(const f32x4*)(stats + (size_t)(row0 + (j >> 2) * 128 + (j & 3) * 16) * 16 + 4 * fq);
#pragma unroll
    for (int j = 0; j < 8; ++j) { float s = (v[j][0] + v[j][1]) + (v[j][2] + v[j][3]); s += __shfl_xor(s, 16); s += __shfl_xor(s, 32); rs[j] = __builtin_amdgcn_rsqf(s * (1.0f / 1024.0f) + EPS); }
}
struct EpiProj {
    bf16* O; const float* stats;
    __device__ __forceinline__ void operator()(const f32x4 (&acc)[2][2][4][2], const pg8::Unit& u, int wr, int wc, int fr, int fq) const {
        const int col0 = u.pn * 256 + wc * 32 + 8 * fq, row0 = u.pm * 256 + wr * 64 + fr;
        float rs[8]; rows_rstd16(stats, row0, fq, rs);
#pragma unroll
        for (int ai = 0; ai < 2; ++ai)
#pragma unroll
            for (int m = 0; m < 4; ++m) { const int r = row0 + ai * 128 + m * 16; const float sc = rs[ai * 4 + m]; bf16* rowp = O + (size_t)r * N1 + col0;
#pragma unroll
                for (int bj = 0; bj < 2; ++bj) *(v4u*)(rowp + bj * 128) = pack8(acc[ai][bj][m][0] * sc, acc[ai][bj][m][1] * sc); }
    }
};
struct EpiSwiglu {
    bf16* O; int ldo; const float* stats;
    __device__ __forceinline__ void operator()(const f32x4 (&acc)[2][2][4][2], const pg8::Unit& u, int wr, int wc, int fr, int fq) const {
        const int col0 = u.pn * 128 + wc * 32 + 8 * fq, row0 = u.pm * 256 + wr * 64 + fr;
        float rs[8]; rows_rstd16(stats, row0, fq, rs);
#pragma unroll
        for (int ai = 0; ai < 2; ++ai)
#pragma unroll
            for (int m = 0; m < 4; ++m) { const int r = row0 + ai * 128 + m * 16; const float sc = rs[ai * 4 + m];
                f32x4 o[2];
#pragma unroll
                for (int n = 0; n < 2; ++n)
#pragma unroll
                    for (int i = 0; i < 4; ++i) o[n][i] = silu_f(acc[ai][0][m][n][i] * sc) * (acc[ai][1][m][n][i] * sc);
                *(v4u*)(O + (size_t)r * ldo + col0) = pack8(o[0], o[1]); }
    }
};
struct EpiResid {
    bf16* H; float* stats;
    __device__ __forceinline__ void operator()(const f32x4 (&acc)[2][2][4][2], const pg8::Unit& u, int wr, int wc, int fr, int fq) const {
        const int col0 = u.pn * 256 + wc * 32 + 8 * fq, row0 = u.pm * 256 + wr * 64 + fr;
#pragma unroll
        for (int ai = 0; ai < 2; ++ai) {
            v4u w[4][2];
#pragma unroll
            for (int m = 0; m < 4; ++m)
#pragma unroll
                for (int bj = 0; bj < 2; ++bj) w[m][bj] = *(const v4u*)(H + (size_t)(row0 + ai * 128 + m * 16) * DM + col0 + bj * 128);
            float ssm[4];
#pragma unroll
            for (int m = 0; m < 4; ++m) { bf16* rowp = H + (size_t)(row0 + ai * 128 + m * 16) * DM + col0; float ss = 0.f;
#pragma unroll
                for (int bj = 0; bj < 2; ++bj) { const v4u x = w[m][bj];
                    f32x4 a = acc[ai][bj][m][0], b = acc[ai][bj][m][1];
                    a[0] += bflo(x.x); a[1] += bfhi(x.x); a[2] += bflo(x.y); a[3] += bfhi(x.y); b[0] += bflo(x.z); b[1] += bfhi(x.z); b[2] += bflo(x.w); b[3] += bfhi(x.w);
                    ss += (a[0] * a[0] + a[1] * a[1]) + (a[2] * a[2] + a[3] * a[3]) + (b[0] * b[0] + b[1] * b[1]) + (b[2] * b[2] + b[3] * b[3]);
                    *(v4u*)(rowp + bj * 128) = pack8(a, b); }
                ss += __shfl_xor(ss, 16); ss += __shfl_xor(ss, 32); ssm[m] = ss; }
            if (fq == 0) {
#pragma unroll
                for (int m = 0; m < 4; ++m) stats[(size_t)(row0 + ai * 128 + m * 16) * 16 + u.pn * 4 + wc] = ssm[m]; } }
    }
};
struct EpiSwigluMoe {
    bf16* O; const f32x2* pinfo;
    __device__ __forceinline__ void operator()(const f32x4 (&acc)[2][2][4][2], const pg8::Unit& u, int wr, int wc, int fr, int fq) const {
        const int col0 = u.pn * 128 + wc * 32 + 8 * fq, rl0 = wr * 64 + fr;
        float rs[8];
#pragma unroll
        for (int j = 0; j < 8; ++j) rs[j] = pinfo[u.gp * 256 + rl0 + (j >> 2) * 128 + (j & 3) * 16][0];
#pragma unroll
        for (int ai = 0; ai < 2; ++ai)
#pragma unroll
            for (int m = 0; m < 4; ++m) { const int rl = rl0 + ai * 128 + m * 16; const float sc = rs[ai * 4 + m];
                f32x4 o[2];
#pragma unroll
                for (int n = 0; n < 2; ++n)
#pragma unroll
                    for (int i = 0; i < 4; ++i) o[n][i] = silu_f(acc[ai][0][m][n][i] * sc) * (acc[ai][1][m][n][i] * sc);
                *(v4u*)(O + (size_t)(u.pm * 256 + rl) * DFE + col0) = pack8(o[0], o[1]); }
    }
};
struct EpiMoeDown {
    unsigned char* Y; const int* pdst; const f32x2* pinfo;
    __device__ __forceinline__ void operator()(const f32x4 (&acc)[2][2][4][2], const pg8::Unit& u, int wr, int wc, int fr, int fq) const {
        const int col0 = u.pn * 256 + wc * 32 + 8 * fq, rl0 = wr * 64 + fr;
        int dst[8]; float wt[8];
#pragma unroll
        for (int j = 0; j < 8; ++j) { const int gi = u.gp * 256 + rl0 + (j >> 2) * 128 + (j & 3) * 16; dst[j] = pdst[gi]; wt[j] = pinfo[gi][1]; }
#pragma unroll
        for (int ai = 0; ai < 2; ++ai)
#pragma unroll
            for (int m = 0; m < 4; ++m) { const int d = dst[ai * 4 + m]; const float w = wt[ai * 4 + m];
                if (d >= 0) { bf16* rowp = (bf16*)(Y + (size_t)(d >> 1) * 4096 + (size_t)(d & 1) * 2048) + col0;
#pragma unroll
                    for (int bj = 0; bj < 2; ++bj) *(v4u*)(rowp + bj * 128) = pack8(acc[ai][bj][m][0] * w, acc[ai][bj][m][1] * w); } }
    }
};

__device__ __forceinline__ float wave_sum(float v) {
#pragma unroll
    for (int o = 1; o < 64; o <<= 1) v += __shfl_xor(v, o);
    return v;
}
__device__ __forceinline__ void transpose_item(const float* W, int K, int N, const float* gain, bf16* WT, int kb, int nb, int dmode, LAS float* scr_, int lane) {
    LAS unsigned* scr = (LAS unsigned*)scr_;
    const int k0 = 64 * kb, n0 = 64 * nb, n = n0 + 2 * (lane & 31), kh = lane >> 5;
    f32x2 v[32];
#pragma unroll
    for (int i = 0; i < 32; ++i) v[i] = (n < N) ? *(const f32x2*)(W + (size_t)(k0 + 2 * i + kh) * N + n) : (f32x2){0.f, 0.f};
    if (gain) {
#pragma unroll
        for (int i = 0; i < 32; ++i) v[i] = v[i] * gain[k0 + 2 * i + kh]; }
#pragma unroll
    for (int i = 0; i < 32; ++i) scr[(2 * i + kh) * 33 + (lane & 31)] = pk2(v[i][0], v[i][1]);
    LDS_WAIT(); asm volatile("" ::: "memory");
    const LAS bf16* T = (const LAS bf16*)scr;
    const int c = lane & 7;
    const int d0 = dmode == 0 ? n0 : 256 * (n0 >> 7) + (n0 & 127) + (dmode == 2 ? 128 : 0);
#pragma unroll
    for (int j = 0; j < 8; ++j) { const int nl = (lane >> 3) + 8 * j; unsigned x[8];
#pragma unroll
        for (int t = 0; t < 8; ++t) x[t] = T[(8 * c + t) * 66 + nl];
        v4u o; o.x = x[0] | (x[1] << 16); o.y = x[2] | (x[3] << 16); o.z = x[4] | (x[5] << 16); o.w = x[6] | (x[7] << 16);
        if (n0 + nl < N) *(v4u*)(WT + (size_t)(d0 + nl) * K + k0 + 8 * c) = o; }
    LDS_WAIT(); asm volatile("" ::: "memory");
}

struct Args { const float* in[24]; float* out; unsigned char* ws; int ph_lo, ph_hi; };
__device__ __forceinline__ const float* ain(const Args& a, int i) { return a.in[i]; }
enum { I_X = 0, I_META, I_ANORM, I_WIN, I_GWG, I_GBG, I_GNORM, I_RNORM, I_MQN, I_WUQ, I_MKVN, I_WUKV, I_DLAM, I_DNORM, I_WOUT, I_FNORM, I_FG, I_FU, I_FD, I_ROUTER, I_EG, I_EU, I_ED, I_FINAL };

#ifndef REP_FOLD
#define REP_FOLD 1
#endif
#ifndef REP_HINIT
#define REP_HINIT 1
#endif
__device__ __forceinline__ void qeff_unit(const Args& a, int li, int hh, int k16, LAS float* L, int tid) {
    const float* Wuq = ain(a, I_WUQ) + (size_t)li * 192 * 384; const float* Wukv = ain(a, I_WUKV) + (size_t)li * 64 * 512;
    const float* gq = ain(a, I_MQN) + li * 192; const float* gkv = ain(a, I_MKVN) + li * 64;
    const float* Win = ain(a, I_WIN) + (size_t)li * DM * DIN; const float* gan = ain(a, I_ANORM) + li * DM;
    bf16* W1t = (bf16*)(a.ws + WS_W1T + li * W1T_BYTES);
    LAS float* Wqa = L; LAS float* Wuk = L + 192 * 96; LAS float* Wis = Wuk;
    __syncthreads();
    for (int idx = tid; idx < 64 * 64; idx += 512) { const int n = idx >> 6, m = idx & 63; Wuk[n * 65 + m] = Wukv[n * 512 + hh * 128 + m]; }
    __syncthreads();
    for (int pass = 0; pass < 3; ++pass) { const int i = pass * 64 + (tid >> 3), ng = tid & 7; f32x4 wq[16];
#pragma unroll
        for (int j = 0; j < 16; ++j) wq[j] = *(const f32x4*)(Wuq + i * 384 + hh * 96 + 4 * j);
        const float gi = gq[i];
#pragma unroll
        for (int t = 0; t < 8; ++t) { const int n = ng * 8 + t; float s = 0.f;
#pragma unroll
            for (int j = 0; j < 16; ++j) s += (wq[j][0] * Wuk[n * 65 + 4 * j] + wq[j][1] * Wuk[n * 65 + 4 * j + 1]) + (wq[j][2] * Wuk[n * 65 + 4 * j + 2] + wq[j][3] * Wuk[n * 65 + 4 * j + 3]);
            Wqa[i * 96 + n] = gi * gkv[n] * s; }
        if (ng < 4) {
#pragma unroll
            for (int j = 0; j < 2; ++j) { const f32x4 r = *(const f32x4*)(Wuq + i * 384 + hh * 96 + 64 + ng * 8 + 4 * j); LAS float* d = Wqa + i * 96 + 64 + ng * 8 + 4 * j; d[0] = gi * r[0]; d[1] = gi * r[1]; d[2] = gi * r[2]; d[3] = gi * r[3]; } } }
    __syncthreads();
    for (int sb = 0; sb < 2; ++sb) { const int k0 = k16 * 64 + sb * 32;
        for (int idx = tid; idx < 32 * 48; idx += 512) { const int kk = idx / 48, i4 = idx % 48; const float* src = Win + (size_t)(k0 + kk) * DIN + C_CQ + 4 * i4;
            Wis[kk * 193 + 4 * i4] = src[0]; Wis[kk * 193 + 4 * i4 + 1] = src[1]; Wis[kk * 193 + 4 * i4 + 2] = src[2]; Wis[kk * 193 + 4 * i4 + 3] = src[3]; }
        __syncthreads();
        { const int kk = tid & 31, ng = tid >> 5; float acc[6] = {0.f, 0.f, 0.f, 0.f, 0.f, 0.f};
#pragma unroll 8
            for (int i = 0; i < 192; ++i) { const float w = Wis[kk * 193 + i]; const LAS f32x2* q2 = (const LAS f32x2*)(Wqa + i * 96 + ng * 6); const f32x2 q0 = q2[0], q1 = q2[1], q3 = q2[2];
                acc[0] += w * q0[0]; acc[1] += w * q0[1]; acc[2] += w * q1[0]; acc[3] += w * q1[1]; acc[4] += w * q3[0]; acc[5] += w * q3[1]; }
            const float g = gan[k0 + kk];
#pragma unroll
            for (int t = 0; t < 6; ++t) W1t[(size_t)(C_QEFF + hh * 96 + ng * 6 + t) * DM + k0 + kk] = (bf16)f2bf(g * acc[t]); }
        __syncthreads(); }
}
__device__ __forceinline__ void wofold_unit(const Args& a, int li, int hh, int nq, LAS float* L, int tid) {
    const float* Wukv = ain(a, I_WUKV) + (size_t)li * 64 * 512; const float* gkv = ain(a, I_MKVN) + li * 64; const float* Wo = ain(a, I_WOUT) + (size_t)li * DM * DM;
    bf16* Wot = (bf16*)(a.ws + WS_WOT + li * WOT_BYTES);
    LAS float* WuvT = L; LAS float* Wos = L + 64 * 64;
    __syncthreads();
    for (int idx = tid; idx < 64 * 64; idx += 512) { const int j = idx >> 6, e = idx & 63; WuvT[e * 64 + j] = Wukv[j * 512 + hh * 128 + 64 + e] * gkv[j]; }
    for (int idx = tid; idx < 64 * 64; idx += 512) { const int e = idx >> 6, n4 = idx & 63; *(LAS f32x4*)(Wos + e * 256 + 4 * n4) = *(const f32x4*)(Wo + (size_t)(512 + 64 * hh + e) * DM + nq * 256 + 4 * n4); }
    __syncthreads();
    { const int n4 = tid & 63, j8 = tid >> 6; f32x4 acc[8];
#pragma unroll
        for (int j = 0; j < 8; ++j) acc[j] = (f32x4){0.f, 0.f, 0.f, 0.f};
#pragma unroll 4
        for (int e = 0; e < 64; ++e) { const f32x4 wv = *(const LAS f32x4*)(Wos + e * 256 + 4 * n4); const f32x4 u0 = *(const LAS f32x4*)(WuvT + e * 64 + 8 * j8), u1 = *(const LAS f32x4*)(WuvT + e * 64 + 8 * j8 + 4);
#pragma unroll
            for (int j = 0; j < 4; ++j) { acc[j] += wv * u0[j]; acc[4 + j] += wv * u1[j]; } }
#pragma unroll
        for (int t = 0; t < 4; ++t) { v4u w; w.x = pk2(acc[0][t], acc[1][t]); w.y = pk2(acc[2][t], acc[3][t]); w.z = pk2(acc[4][t], acc[5][t]); w.w = pk2(acc[6][t], acc[7][t]);
            *(v4u*)(Wot + (size_t)(nq * 256 + 4 * n4 + t) * DM + 512 + 64 * hh + 8 * j8) = w; } }
    __syncthreads();
}
__device__ __forceinline__ void p0_prologue(const Args& a, LAS unsigned char* lds, int tid, int lane, int wave) {
    const int G = gridDim.x;
    for (int rep = 0; rep < REP_FOLD; ++rep)
    for (int un = blockIdx.x; un < 160; un += G) {
        if (un < 128) qeff_unit(a, un >> 6, (un >> 4) & 3, un & 15, (LAS float*)lds, tid);
        else { const int v = un - 128; wofold_unit(a, v >> 4, (v >> 2) & 3, v & 3, (LAS float*)lds, tid); }
    }
    __syncthreads();
    LAS float* scr = (LAS float*)(lds + wave * 16384);
    const int gw = blockIdx.x * 8 + wave, NGW = G * 8;
    constexpr int I_IN = 16 * 45, I_WO = 12 * 16, I_G = 16 * 44, I_D = 44 * 16;
    constexpr int NIT = 2 * I_IN + 2 * I_WO + 2 * I_G + I_D;
    for (int it = gw; it < NIT; it += NGW) {
        int r = it;
        if (r < 2 * I_IN) { const int li = r / I_IN; r %= I_IN; transpose_item(ain(a, I_WIN) + (size_t)li * DM * DIN, DM, DIN, ain(a, I_ANORM) + li * DM, (bf16*)(a.ws + WS_W1T + li * W1T_BYTES), r / 45, r % 45, 0, scr, lane); continue; } r -= 2 * I_IN;
        if (r < 2 * I_WO) { const int li = r / I_WO; r %= I_WO; int kb = r / 16; if (kb >= 8) kb += 4; transpose_item(ain(a, I_WOUT) + (size_t)li * DM * DM, DM, DM, nullptr, (bf16*)(a.ws + WS_WOT + li * WOT_BYTES), kb, r % 16, 0, scr, lane); continue; } r -= 2 * I_WO;
        if (r < I_G) { transpose_item(ain(a, I_FG), DM, DFF, ain(a, I_FNORM), (bf16*)(a.ws + WS_WGU), r / 44, r % 44, 1, scr, lane); continue; } r -= I_G;
        if (r < I_G) { transpose_item(ain(a, I_FU), DM, DFF, ain(a, I_FNORM), (bf16*)(a.ws + WS_WGU), r / 44, r % 44, 2, scr, lane); continue; } r -= I_G;
        transpose_item(ain(a, I_FD), DFF, DM, nullptr, (bf16*)(a.ws + WS_WD), r / 16, r % 16, 0, scr, lane);
    }
    const int gt = blockIdx.x * 512 + tid, NGT = G * 512;
    for (int i = gt; i < 2 * 80 * 128; i += NGT) { const int li = i / (80 * 128), r = i % (80 * 128);
        *(v4u*)(a.ws + WS_W1T + li * W1T_BYTES + (size_t)(C_QEFF + 384) * DM * 2 + (size_t)r * 16) = (v4u){0u, 0u, 0u, 0u}; }
    for (int i = gt; i < 8 * DM; i += NGT) { const int e = i >> 10, k = i & 1023; ((float*)(a.ws + WS_RT))[i] = ain(a, I_FNORM)[DM + k] * ain(a, I_ROUTER)[k * 8 + e]; }
    for (int i = gt; i < PSEQ * 48; i += NGT) { const int p = i / 48, j = i % 48; const bool isR = j < 32; const int f = isR ? j : j - 32;
        const float inv = __builtin_amdgcn_exp2f(-(float)f * (isR ? 13.287712379549449f / 32.f : 13.287712379549449f / 16.f));
        const double rev = (double)(p - 48) * (double)inv * 0.15915494309189535; const float fr = (float)(rev - __builtin_rint(rev));
        const f32x2 cs = {__builtin_amdgcn_cosf(fr), __builtin_amdgcn_sinf(fr)};
        if (isR) ((f32x2*)(a.ws + WS_TABR))[p * 32 + f] = cs; else ((f32x2*)(a.ws + WS_TABM))[p * 16 + f] = cs; }
    for (int i = gt; i < 240 * 128; i += NGT) *(v4u*)((unsigned char*)a.out + (size_t)(MR + 16) * 2048 + (size_t)i * 16) = (v4u){0u, 0u, 0u, 0u};
    bf16* hb = (bf16*)(a.ws + WS_HB); float* stA = (float*)(a.ws + WS_STA);
    for (int rep = 0; rep < REP_HINIT; ++rep)
    for (int r = gw; r < MROWS; r += NGW) {
        f32x4 v[4]; float s = 0.f;
#pragma unroll
        for (int j = 0; j < 4; ++j) { if (r < MR) v[j] = ((const f32x4*)(ain(a, I_X) + (size_t)r * DM))[lane + 64 * j]; else if (r < MR + NMETA) v[j] = ((const f32x4*)(ain(a, I_META) + (size_t)(r - MR) * DM))[lane + 64 * j]; else v[j] = (f32x4){0.f, 0.f, 0.f, 0.f};
            s += (v[j][0] * v[j][0] + v[j][1] * v[j][1]) + (v[j][2] * v[j][2] + v[j][3] * v[j][3]); }
        s = wave_sum(s);
#pragma unroll
        for (int j = 0; j < 4; ++j) { v2u w; w.x = pk2(v[j][0], v[j][1]); w.y = pk2(v[j][2], v[j][3]); ((v2u*)(hb + (size_t)r * DM))[lane + 64 * j] = w; }
        if (lane < 16) stA[(size_t)r * 16 + lane] = lane == 0 ? s : 0.f;
    }
}

__device__ __forceinline__ int src_row(int b, int c, int i) { return c == 0 ? (i < 48 ? -1 : MR + i - 48) : b * TT + 64 * (c - 1) + i; }
__device__ __forceinline__ float lg2gamma(int h) { return h == 0 ? -0.045803689613124789f : h == 1 ? -0.022720076500083529f : h == 2 ? -0.011315313227834146f : -0.0056465631411420627f; }

__device__ __forceinline__ void route_block(const Args& a, int blk, LAS unsigned char* lds, int tid, int lane, int wave) {
    LAS float* Rs = (LAS float*)lds; LAS int* lcnt = (LAS int*)(lds + 32768); LAS int* gbase = lcnt + 8; LAS int* rec = lcnt + 16;
    gu32* ctl = (gu32*)(a.ws + WS_CTL);
    const float* Rt = (const float*)(a.ws + WS_RT); const bf16* hb = (const bf16*)(a.ws + WS_HB); const float* stB = (const float*)(a.ws + WS_STB);
    __syncthreads();
    for (int idx = tid; idx < 8 * DM; idx += 512) Rs[idx] = Rt[idx];
    if (tid < 8) lcnt[tid] = 0;
    __syncthreads();
    for (int rr = 0; rr < 16; ++rr) { const int rl = wave * 16 + rr, row = blk * 128 + rl;
        const v4u w0 = *(const v4u*)(hb + (size_t)row * DM + 8 * lane), w1 = *(const v4u*)(hb + (size_t)row * DM + 512 + 8 * lane);
        const float x[16] = {bflo(w0.x), bfhi(w0.x), bflo(w0.y), bfhi(w0.y), bflo(w0.z), bfhi(w0.z), bflo(w0.w), bfhi(w0.w), bflo(w1.x), bfhi(w1.x), bflo(w1.y), bfhi(w1.y), bflo(w1.z), bfhi(w1.z), bflo(w1.w), bfhi(w1.w)};
        float st = lane < 16 ? stB[(size_t)row * 16 + lane] : 0.f; st = wave_sum(st); const float rs = __builtin_amdgcn_rsqf(st * (1.f / 1024.f) + EPS);
        float lg[8];
#pragma unroll
        for (int e = 0; e < 8; ++e) { float s = 0.f;
#pragma unroll
            for (int t = 0; t < 8; ++t) s += x[t] * Rs[e * DM + 8 * lane + t] + x[8 + t] * Rs[e * DM + 512 + 8 * lane + t];
            lg[e] = wave_sum(s) * rs; }
        int e0 = 0; float v0 = lg[0];
#pragma unroll
        for (int e = 1; e < 8; ++e) if (lg[e] > v0) { v0 = lg[e]; e0 = e; }
        int e1 = -1; float v1 = -3.0e38f;
#pragma unroll
        for (int e = 0; e < 8; ++e) if (e != e0 && lg[e] > v1) { v1 = lg[e]; e1 = e; }
        const float g0 = 1.f / (1.f + __expf(v1 - v0)), g1 = 1.f - g0;
        if (lane == 0) { const int lp0 = atomicAdd((int*)(lcnt + e0), 1), lp1 = atomicAdd((int*)(lcnt + e1), 1);
            rec[rl * 6] = e0; rec[rl * 6 + 1] = e1; rec[rl * 6 + 2] = lp0; rec[rl * 6 + 3] = lp1; rec[rl * 6 + 4] = __float_as_int(g0); rec[rl * 6 + 5] = __float_as_int(g1); } }
    __syncthreads();
    if (tid < 8) gbase[tid] = (int)__hip_atomic_fetch_add(ctl + CW_CNT + 64 * tid, (unsigned)lcnt[tid], RLX_AGENT);
    __syncthreads();
    if (tid < 256) { const int rl = tid >> 1, s = tid & 1, tok = blk * 128 + rl, e = rec[rl * 6 + s];
        ((int*)(a.ws + MO_TOKE))[tok * 2 + s] = e; ((int*)(a.ws + MO_TOKP))[tok * 2 + s] = gbase[e] + rec[rl * 6 + 2 + s]; ((int*)(a.ws + MO_TOKW))[tok * 2 + s] = rec[rl * 6 + 4 + s]; }
    __syncthreads();
}
__device__ __forceinline__ void moe_offsets(const Args& a, LAS int* offs, int tid) {
    gu32* ctl = (gu32*)(a.ws + WS_CTL);
    __syncthreads();
    if (tid == 0) { int o = 0;
        for (int e = 0; e < 8; ++e) { const int cnt = (int)__hip_atomic_load(ctl + CW_CNT + 64 * e, RLX_AGENT); offs[e] = o * 256; o += (cnt + 255) >> 8; }
        offs[8] = o; }
    __syncthreads();
}

__device__ __forceinline__ void stage_cols(const bf16* proj, int b, int c, int col0, int ncols, LAS bf16* S, int sst, int lcol0, int tid) {
    const int cpr = ncols >> 3;
    for (int idx = tid; idx < 64 * cpr; idx += 512) { const int i = idx / cpr, ch = idx - i * cpr, sr = src_row(b, c, i);
        v4u v = {0u, 0u, 0u, 0u}; if (sr >= 0) v = *(const v4u*)(proj + (size_t)sr * N1 + col0 + ch * 8);
        *(LAS v4u*)(S + i * sst + lcol0 + ch * 8) = v; }
}
__device__ __forceinline__ v4u gather8(const LAS bf16* S, int sst, int row0, int col) {
    unsigned x[8];
#pragma unroll
    for (int t = 0; t < 8; ++t) x[t] = S[(row0 + t) * sst + col];
    v4u w; w.x = x[0] | (x[1] << 16); w.y = x[2] | (x[3] << 16); w.z = x[4] | (x[5] << 16); w.w = x[6] | (x[7] << 16); return w;
}
__device__ __forceinline__ void prep2_unit(const Args& a, int li, int b, int c, int part, LAS unsigned char* lds, int tid) {
    const bf16* proj = (const bf16*)(a.ws + B_PROJ);
    LAS bf16* S = (LAS bf16*)lds;
    const int blk0 = (b * NCH + c) * 4; const size_t prow0 = (size_t)b * PSEQ + 64 * c;
    unsigned char* dout = (unsigned char*)a.out;
    __syncthreads();
    if (part == 0) {
        constexpr int SST = 536; LAS float* seg = (LAS float*)(lds + 64 * SST * 2);
        stage_cols(proj, b, c, C_AQ, 128, S, SST, 0, tid); stage_cols(proj, b, c, C_AK, 128, S, SST, 128, tid); stage_cols(proj, b, c, C_ALR, 16, S, SST, 512, tid);
        __syncthreads();
        { const int ch = tid & 127, sg = tid >> 7; const float* Wg = ain(a, I_GWG) + (size_t)li * 16 * 128; const float bg = ain(a, I_GBG)[li * 128 + ch];
            float wg[16];
#pragma unroll
            for (int r = 0; r < 16; ++r) wg[r] = Wg[r * 128 + ch];
            float cl[16]; float run = 0.f;
#pragma unroll
            for (int t = 0; t < 16; ++t) { const int i = 16 * sg + t; const v4u l0 = *(const LAS v4u*)(S + i * SST + 512), l1 = *(const LAS v4u*)(S + i * SST + 520);
                float x = bg + bflo(l0.x) * wg[0] + bfhi(l0.x) * wg[1] + bflo(l0.y) * wg[2] + bfhi(l0.y) * wg[3] + bflo(l0.z) * wg[4] + bfhi(l0.z) * wg[5] + bflo(l0.w) * wg[6] + bfhi(l0.w) * wg[7]
                               + bflo(l1.x) * wg[8] + bfhi(l1.x) * wg[9] + bflo(l1.y) * wg[10] + bfhi(l1.y) * wg[11] + bflo(l1.z) * wg[12] + bfhi(l1.z) * wg[13] + bflo(l1.w) * wg[14] + bfhi(l1.w) * wg[15];
                const float ls = fminf(x, 0.f) - __logf(1.f + __expf(-fabsf(x)));
                run += (c > 0 || i >= 48) ? ls * (1.f / 16.f) : 0.f; cl[t] = run; }
            seg[sg * 128 + ch] = run;
            __syncthreads();
            float off = 0.f;
#pragma unroll
            for (int s2 = 0; s2 < 3; ++s2) off += s2 < sg ? seg[s2 * 128 + ch] : 0.f;
            if (sg == 3) ((float*)(a.ws + WS_GD))[(size_t)(blk0 + (ch >> 5)) * 32 + (ch & 31)] = __expf(off + run);
#pragma unroll
            for (int t = 0; t < 16; ++t) { const int i = 16 * sg + t; const float cum = cl[t] + off;
                S[i * SST + ch] = (bf16)f2bf(bf2f(S[i * SST + ch]) * 0.17677669529663687f * __expf(cum)); S[i * SST + 128 + ch] = (bf16)f2bf(bf2f(S[i * SST + 128 + ch]) * __expf(-cum)); } }
        __syncthreads();
        for (int idx = tid; idx < 1024; idx += 512) { const int d8 = idx & 3, i = (idx >> 2) & 63, h = idx >> 8;
            *(v4u*)(a.ws + B_GQ + (size_t)(blk0 + h) * GQ_T + i * 80 + 16 * d8) = *(const LAS v4u*)(S + i * SST + h * 32 + 8 * d8);
            *(v4u*)(a.ws + B_GK + (size_t)(blk0 + h) * GQ_T + i * 80 + 16 * d8) = *(const LAS v4u*)(S + i * SST + 128 + h * 32 + 8 * d8); }
    } else if (part == 1) {
        constexpr int SST = 776;
        stage_cols(proj, b, c, C_RQ, 256, S, SST, 0, tid); stage_cols(proj, b, c, C_RK, 256, S, SST, 256, tid);
        LAS f32x4* tabL = (LAS f32x4*)(lds + 64 * SST * 2);
        for (int idx = tid; idx < 64 * 16; idx += 512) tabL[idx] = ((const f32x4*)(a.ws + WS_TABR))[(size_t)(64 * c) * 16 + idx];
        __syncthreads();
        const LAS f32x2* tabR = (const LAS f32x2*)tabL;
        for (int idx = tid; idx < 64 * 4 * 32; idx += 512) { const int j = idx & 31, h = (idx >> 5) & 3, i = idx >> 7; const f32x2 cs = tabR[i * 32 + j];
            LAS bf16* qp = S + i * SST + h * 64 + j; LAS bf16* kp = qp + 256;
            const float a1 = bf2f(qp[0]), a2 = bf2f(qp[32]), b1 = bf2f(kp[0]), b2 = bf2f(kp[32]);
            const float e = (float)(i + 1) * lg2gamma(h); const float fq = __builtin_amdgcn_exp2f(e), fk = 0.125f * __builtin_amdgcn_exp2f(-e);
            qp[0] = (bf16)f2bf((a1 * cs[0] - a2 * cs[1]) * fq); qp[32] = (bf16)f2bf((a1 * cs[1] + a2 * cs[0]) * fq); kp[0] = (bf16)f2bf((b1 * cs[0] - b2 * cs[1]) * fk); kp[32] = (bf16)f2bf((b1 * cs[1] + b2 * cs[0]) * fk); }
        __syncthreads();
        for (int idx = tid; idx < 2048; idx += 512) { const int d8 = idx & 7, i = (idx >> 3) & 63, h = idx >> 9;
            *(v4u*)(a.ws + B_RQ + (size_t)(blk0 + h) * RT_T + i * 144 + 16 * d8) = *(const LAS v4u*)(S + i * SST + h * 64 + 8 * d8);
            *(v4u*)(a.ws + B_RK + (size_t)(blk0 + h) * RT_T + i * 144 + 16 * d8) = *(const LAS v4u*)(S + i * SST + 256 + h * 64 + 8 * d8); }
    } else if (part == 2) {
        constexpr int SST = 680; LAS float* rsd = (LAS float*)(lds + 64 * SST * 2); LAS f32x4* tabL = (LAS f32x4*)(lds + 64 * SST * 2 + 512);
        stage_cols(proj, b, c, C_CQ, 192, S, SST, 0, tid); stage_cols(proj, b, c, C_CKV, 64, S, SST, 192, tid); stage_cols(proj, b, c, C_KPE, 32, S, SST, 256, tid); stage_cols(proj, b, c, C_QEFF, 384, S, SST, 288, tid);
        for (int idx = tid; idx < 64 * 8; idx += 512) tabL[idx] = ((const f32x4*)(a.ws + WS_TABM))[(size_t)(64 * c) * 8 + idx];
        __syncthreads();
        { const int i = tid >> 3, g = tid & 7; float sq = 0.f, sk = 0.f;
#pragma unroll
            for (int t = 0; t < 24; ++t) { const float v = bf2f(S[i * SST + g * 24 + t]); sq += v * v; }
#pragma unroll
            for (int t = 0; t < 8; ++t) { const float v = bf2f(S[i * SST + 192 + g * 8 + t]); sk += v * v; }
            sq += __shfl_xor(sq, 1); sq += __shfl_xor(sq, 2); sq += __shfl_xor(sq, 4); sk += __shfl_xor(sk, 1); sk += __shfl_xor(sk, 2); sk += __shfl_xor(sk, 4);
            if (g == 0) { rsd[i * 2] = __builtin_amdgcn_rsqf(sq * (1.f / 192.f) + EPS); rsd[i * 2 + 1] = __builtin_amdgcn_rsqf(sk * (1.f / 64.f) + EPS); } }
        __syncthreads();
        const LAS f32x2* tabM = (const LAS f32x2*)tabL; const float QS = 0.10206207261596577f * LOG2E;
        for (int idx = tid; idx < 64 * 48; idx += 512) { const int c8 = idx % 48, i = idx / 48, hh = c8 / 12, k8 = c8 % 12; const float s = rsd[i * 2] * QS; const LAS bf16* qe = S + i * SST + 288 + hh * 96; float y[8];
            if (k8 < 8) {
#pragma unroll
                for (int t = 0; t < 8; ++t) y[t] = bf2f(qe[8 * k8 + t]) * s; }
            else { const int kk = (k8 - 8) & 1, second = (k8 - 8) >> 1;
#pragma unroll
                for (int t = 0; t < 8; ++t) { const int j = 8 * kk + t; const f32x2 cs = tabM[i * 16 + j]; const float x1 = bf2f(qe[64 + j]) * s, x2 = bf2f(qe[80 + j]) * s; y[t] = second ? x1 * cs[1] + x2 * cs[0] : x1 * cs[0] - x2 * cs[1]; } }
            v4u w; w.x = pk2(y[0], y[1]); w.y = pk2(y[2], y[3]); w.z = pk2(y[4], y[5]); w.w = pk2(y[6], y[7]);
            *(v4u*)((bf16*)(a.ws + B_MQ) + (prow0 + i) * 384 + hh * 96 + 8 * k8) = w; }
        for (int idx = tid; idx < 64 * 12; idx += 512) { const int k8 = idx % 12, i = idx / 12; float y[8];
            if (k8 < 8) { const float s = rsd[i * 2 + 1];
#pragma unroll
                for (int t = 0; t < 8; ++t) y[t] = bf2f(S[i * SST + 192 + 8 * k8 + t]) * s; }
            else { const int kk = (k8 - 8) & 1, second = (k8 - 8) >> 1;
#pragma unroll
                for (int t = 0; t < 8; ++t) { const int j = 8 * kk + t; const f32x2 cs = tabM[i * 16 + j]; const float x1 = bf2f(S[i * SST + 256 + j]), x2 = bf2f(S[i * SST + 272 + j]); y[t] = second ? x1 * cs[1] + x2 * cs[0] : x1 * cs[0] - x2 * cs[1]; } }
            v4u w; w.x = pk2(y[0], y[1]); w.y = pk2(y[2], y[3]); w.z = pk2(y[4], y[5]); w.w = pk2(y[6], y[7]);
            *(v4u*)((bf16*)(a.ws + B_MK) + (prow0 + i) * 96 + 8 * k8) = w; }
    }
}

typedef float f32x16 __attribute__((ext_vector_type(16)));
typedef short s16x8 __attribute__((ext_vector_type(8)));
typedef short s16x4 __attribute__((ext_vector_type(4)));
typedef short v4i16_t __attribute__((ext_vector_type(4)));
__device__ __forceinline__ int crow(int r, int hi) { return (r & 3) + 8 * (r >> 2) + 4 * hi; }

template <int KIND>
__device__ __forceinline__ void attn_mfma_unit(const Args& a, int li, int b, int hh, int qb  , LAS unsigned char* lds, int tid, float lam, float oscale) {
    constexpr int KW = KIND ? 64 : 96, KST = KW + 8, VST = 72, NMAP = KIND ? 2 : 1, DSTEPS = KIND ? 2 : 6;
    constexpr int KCH = KW / 8 + 1, NPIECE = KCH + (KIND ? 9 : 0), PPW = KIND ? 3 : 2, SLOT = NPIECE * 1024, NSLOT = 4, OFF_JUNK = NSLOT * SLOT, OFF_WS = OFF_JUNK + 6144, OSTW = 68, OFF_OST = KIND ? 0   : OFF_WS + 2048;
    static_assert(PPW * 8 >= NPIECE && PPW * 8 - NPIECE <= 6 && (KIND ? 8 * 32 * OSTW * 4 <= NSLOT * SLOT : OFF_OST + 8 * 32 * OSTW * 4 <= RING_BYTES) && OFF_WS + 8 * 256 <= RING_BYTES, "attention LDS map / pieces per wave");
    const int lane = tid & 63, w = __builtin_amdgcn_readfirstlane(tid >> 6), r32 = lane & 31, hi = lane >> 5;
    const int q0 = qb < 0 ? 0 : 64 + 256 * qb, NT = qb < 0 ? 1 : 5 + 4 * qb;
    const bool wact = qb >= 0 || w < 2;
    const int qpos = q0 + 32 * w + r32, wlast = (q0 + 32 * w + 31) >> 6;
    const size_t prow = (size_t)b * PSEQ + qpos;
    const bf16* proj = (const bf16*)(a.ws + B_PROJ);
    const bf16* Kg = KIND ? proj + C_DK + hh * 64 : (const bf16*)(a.ws + B_MK) + (size_t)b * PSEQ * 96;
    constexpr int KLD = KIND ? N1 : 96;
    const bf16* Vg = proj + C_DV + hh * 64;
#define ATT_SRCROW(t_, r_) (KIND ? ((t_) == 0 ? ((r_) < 48 ? MR : MR + (r_) - 48) : b * TT + 64 * ((t_) - 1) + (r_)) : 64 * (t_) + (r_))
    LAS float* wsf = (LAS float*)(lds + OFF_WS) + w * 64;
    LAS float* ost = (LAS float*)(lds + OFF_OST) + w * (32 * OSTW);
    s16x8 qf[NMAP][DSTEPS];
#pragma unroll
    for (int m = 0; m < NMAP; ++m)
#pragma unroll
        for (int ds = 0; ds < DSTEPS; ++ds) {
            const int qsr = qb >= 0 ? b * TT + qpos - 64 : (qpos >= 48 ? MR + qpos - 48 : MR);
            const bf16* qp = KIND ? proj + (size_t)qsr * N1 + C_DQ + hh * 64 + 32 * m + 16 * ds + 8 * hi : (const bf16*)(a.ws + B_MQ) + prow * 384 + hh * 96 + 16 * ds + 8 * hi;
            v4u qw = wact ? *(const v4u*)qp : (v4u){0u, 0u, 0u, 0u};
            if (KIND) { const float qs = 0.17677669529663687f * LOG2E;
                qw.x = pg8::cvt_pk_bf16(bflo(qw.x) * qs, bfhi(qw.x) * qs); qw.y = pg8::cvt_pk_bf16(bflo(qw.y) * qs, bfhi(qw.y) * qs); qw.z = pg8::cvt_pk_bf16(bflo(qw.z) * qs, bfhi(qw.z) * qs); qw.w = pg8::cvt_pk_bf16(bflo(qw.w) * qs, bfhi(qw.w) * qs); }
            qf[m][ds] = __builtin_bit_cast(s16x8, qw); }
    float mref[NMAP], lrun[NMAP]; f32x16 negm = (f32x16){}, o[NMAP][2];
#pragma unroll
    for (int m = 0; m < NMAP; ++m) { mref[m] = 0.f; lrun[m] = 0.f; o[m][0] = (f32x16){}; o[m][1] = (f32x16){}; }
    int prow_[PPW], pcol[PPW], doff[PPW], isv[PPW];
#pragma unroll
    for (int j = 0; j < PPW; ++j) { const int p = __builtin_amdgcn_readfirstlane(w * PPW + j);
        if (p < KCH) { const int g = 64 * p + lane, cc = g % KCH; prow_[j] = g / KCH; pcol[j] = (cc < KCH - 1 ? cc : KCH - 2) * 8; doff[j] = p * 1024; isv[j] = 0; }
        else if (p < NPIECE) { const int g = 64 * (p - KCH) + lane, cc = g % 9; prow_[j] = g / 9; pcol[j] = (cc < 8 ? cc : 7) * 8; doff[j] = p * 1024; isv[j] = 1; }
        else { prow_[j] = lane & 15; pcol[j] = 0; doff[j] = OFF_JUNK + (p - NPIECE) * 1024; isv[j] = 0; } }
#define ATT_DMA(t_) do { const int sl_ = ((t_) & 3) * SLOT; _Pragma("unroll") for (int j = 0; j < PPW; ++j) { const size_t sr_ = (size_t)ATT_SRCROW((t_), prow_[j]); \
        const bf16* s_ = __builtin_amdgcn_readfirstlane(isv[j]) ? Vg + sr_ * N1 + pcol[j] : Kg + sr_ * KLD + pcol[j]; \
        __builtin_amdgcn_global_load_lds((const unsigned*)s_, (LAS unsigned*)(lds + __builtin_amdgcn_readfirstlane(doff[j] >= OFF_JUNK ? doff[j] : sl_ + doff[j])), 16, 0, 0); } } while (0)
#define ATT_BAR() do { asm volatile("s_waitcnt lgkmcnt(0)" ::: "memory"); __builtin_amdgcn_s_barrier(); asm volatile("" ::: "memory"); } while (0)
    ATT_BAR();
    ATT_DMA(0); if (NT > 1) ATT_DMA(1); if (NT > 2) ATT_DMA(2);
    for (int t = 0; t < NT; ++t) {
        if (t + 2 < NT) { if (KIND) asm volatile("s_waitcnt vmcnt(6)" ::: "memory"); else asm volatile("s_waitcnt vmcnt(4)" ::: "memory"); } else if (t + 1 < NT) { if (KIND) asm volatile("s_waitcnt vmcnt(3)" ::: "memory"); else asm volatile("s_waitcnt vmcnt(2)" ::: "memory"); } else asm volatile("s_waitcnt vmcnt(0)" ::: "memory");
        ATT_BAR();
        if (t + 3 < NT) ATT_DMA(t + 3);
        if (wact && t <= wlast) {
            const LAS unsigned char* Kb = lds + (t & 3) * SLOT; const LAS unsigned char* Vb = KIND ? Kb + KCH * 1024 : Kb;
            const bool need_mask = (t == 0) || (64 * t + 63 > q0 + 32 * w);
#pragma unroll
            for (int m = 0; m < NMAP; ++m) {
                f32x16 p0, p1;
                __builtin_amdgcn_s_setprio(1);
                if (KIND) { const float nm = -mref[m];
#pragma unroll
                    for (int r = 0; r < 16; ++r) { p0[r] = nm; p1[r] = nm; } }
                else { p0 = negm; p1 = negm; }
#pragma unroll
                for (int ds = 0; ds < DSTEPS; ++ds) {
                    const s16x8 k0 = *(const LAS s16x8*)(Kb + (r32 * KST + 32 * m * KIND + 16 * ds + 8 * hi) * 2);
                    const s16x8 k1 = *(const LAS s16x8*)(Kb + ((32 + r32) * KST + 32 * m * KIND + 16 * ds + 8 * hi) * 2);
                    p0 = __builtin_amdgcn_mfma_f32_32x32x16_bf16(k0, qf[m][ds], p0, 0, 0, 0);
                    p1 = __builtin_amdgcn_mfma_f32_32x32x16_bf16(k1, qf[m][ds], p1, 0, 0, 0); }
                asm volatile("s_nop 15\n\ts_nop 7" : "+v"(p0), "+v"(p1));
                __builtin_amdgcn_s_setprio(0);
                if (need_mask) {
#pragma unroll
                    for (int r = 0; r < 16; ++r) { const int kv = 64 * t + crow(r, hi);
                        if (kv > qpos || kv < 48) p0[r] = -1e30f;
                        if (kv + 32 > qpos || kv + 32 < 48) p1[r] = -1e30f; } }
                float mx = fmaxf(fmaxf(p0[0], p1[0]), fmaxf(p0[1], p1[1]));
#pragma unroll
                for (int r = 2; r < 16; r += 2) mx = fmaxf(mx, fmaxf(fmaxf(p0[r], p1[r]), fmaxf(p0[r + 1], p1[r + 1])));
                { auto rr = __builtin_amdgcn_permlane32_swap(__float_as_uint(mx), __float_as_uint(mx), false, false); mx = fmaxf(__uint_as_float(rr[0]), __uint_as_float(rr[1])); }
                if (t == 0 || __any(mx > 6.0f)) {
                    const float delta = t == 0 ? mx : fmaxf(mx, 0.f); mref[m] += delta;
#pragma unroll
                    for (int r = 0; r < 16; ++r) { p0[r] -= delta; p1[r] -= delta; if (!KIND) negm[r] = -mref[m]; }
                    if (t != 0) { const float alpha = __builtin_amdgcn_exp2f(-delta); lrun[m] *= alpha;
                        if (hi == 0) wsf[r32] = alpha;
                        f32x4 al[4];
#pragma unroll
                        for (int g = 0; g < 4; ++g) al[g] = *(const LAS f32x4*)(wsf + 8 * g + 4 * hi);
#pragma unroll
                        for (int r = 0; r < 16; ++r) { o[m][0][r] *= al[r >> 2][r & 3]; o[m][1][r] *= al[r >> 2][r & 3]; } } }
                float ls = 0.f;
#pragma unroll
                for (int r = 0; r < 16; ++r) { p0[r] = __builtin_amdgcn_exp2f(p0[r]); p1[r] = __builtin_amdgcn_exp2f(p1[r]); ls += p0[r] + p1[r]; }
                lrun[m] += ls;
                s16x8 pw[4];
#pragma unroll
                for (int ks = 0; ks < 4; ++ks) { v4u u;
                    if (ks < 2) { u.x = pg8::cvt_pk_bf16(p0[8 * ks], p0[8 * ks + 1]); u.y = pg8::cvt_pk_bf16(p0[8 * ks + 2], p0[8 * ks + 3]); u.z = pg8::cvt_pk_bf16(p0[8 * ks + 4], p0[8 * ks + 5]); u.w = pg8::cvt_pk_bf16(p0[8 * ks + 6], p0[8 * ks + 7]); }
                    else { const int k2 = ks - 2; u.x = pg8::cvt_pk_bf16(p1[8 * k2], p1[8 * k2 + 1]); u.y = pg8::cvt_pk_bf16(p1[8 * k2 + 2], p1[8 * k2 + 3]); u.z = pg8::cvt_pk_bf16(p1[8 * k2 + 4], p1[8 * k2 + 5]); u.w = pg8::cvt_pk_bf16(p1[8 * k2 + 6], p1[8 * k2 + 7]); }
                    pw[ks] = __builtin_bit_cast(s16x8, u); }
                __builtin_amdgcn_s_setprio(1);
#pragma unroll
                for (int d0 = 0; d0 < 2; ++d0)
#pragma unroll
                    for (int ks = 0; ks < 4; ++ks) { constexpr int VRB = KIND ? 144 : KST * 2;
                        const LAS unsigned char* vp = Vb + (16 * ks + 4 * hi + ((lane & 15) >> 2)) * VRB + (32 * d0 + 16 * ((lane >> 4) & 1)) * 2 + 8 * (lane & 3);
                        const s16x4 va = __builtin_bit_cast(s16x4, __builtin_amdgcn_ds_read_tr16_b64_v4i16((LAS v4i16_t*)vp)), vb = __builtin_bit_cast(s16x4, __builtin_amdgcn_ds_read_tr16_b64_v4i16((LAS v4i16_t*)(vp + 8 * VRB)));
                        const s16x8 vf = {va[0], va[1], va[2], va[3], vb[0], vb[1], vb[2], vb[3]};
                        o[m][d0] = __builtin_amdgcn_mfma_f32_32x32x16_bf16(pw[ks], vf, o[m][d0], 0, 0, 0); }
                __builtin_amdgcn_s_setprio(0);
            }
        }
    }
#undef ATT_DMA
#undef ATT_SRCROW
    ATT_BAR();
    if (wact) {
#pragma unroll
        for (int m = 0; m < NMAP; ++m) asm volatile("s_nop 15\n\ts_nop 7" : "+v"(o[m][0]), "+v"(o[m][1]));
        float il0, il1 = 0.f;
        { float l = lrun[0]; l += __shfl_xor(l, 32); il0 = l > 0.f ? 1.f / l : 0.f; }
        if (KIND) { float l = lrun[NMAP - 1]; l += __shfl_xor(l, 32); il1 = l > 0.f ? lam / l : 0.f; }
        if (hi == 0) { wsf[r32] = il0; wsf[32 + r32] = il1; }
        f32x4 a0[4], a1[4];
#pragma unroll
        for (int g = 0; g < 4; ++g) { a0[g] = *(const LAS f32x4*)(wsf + 8 * g + 4 * hi); a1[g] = *(const LAS f32x4*)(wsf + 32 + 8 * g + 4 * hi); }
#pragma unroll
        for (int d0 = 0; d0 < 2; ++d0)
#pragma unroll
            for (int r = 0; r < 16; ++r) { float v = o[0][d0][r] * a0[r >> 2][r & 3]; if (KIND) v -= o[NMAP - 1][d0][r] * a1[r >> 2][r & 3];
                ost[crow(r, hi) * OSTW + 32 * d0 + r32] = v; }
        const int row = lane >> 1, half = lane & 1, p = q0 + 32 * w + row;
        f32x4 v[8]; float ss = 0.f;
#pragma unroll
        for (int i = 0; i < 8; ++i) { v[i] = *(const LAS f32x4*)(ost + row * OSTW + 32 * half + 4 * i); ss += (v[i][0] * v[i][0] + v[i][1] * v[i][1]) + (v[i][2] * v[i][2] + v[i][3] * v[i][3]); }
        ss += __shfl_xor(ss, 1);
        const float rs = KIND ? __builtin_amdgcn_rsqf(ss * (1.f / 64.f) + EPS) * oscale : 1.f;
        const int sr = qb >= 0 ? b * TT + p - 64 : ((p >= 48 && b == 0) ? MR + p - 48 : -1);
        if (sr >= 0) { bf16* dst = (bf16*)a.out + (size_t)sr * DM + (KIND ? 768 : 512) + hh * 64 + 32 * half; const float* gn = ain(a, I_DNORM) + li * 64 + 32 * half;
#pragma unroll
            for (int i = 0; i < 4; ++i) { f32x4 x0 = v[2 * i] * rs, x1 = v[2 * i + 1] * rs;
                if (KIND) { const f32x4 g0 = *(const f32x4*)(gn + 8 * i), g1 = *(const f32x4*)(gn + 8 * i + 4); x0 = x0 * g0; x1 = x1 * g1; }
                *(v4u*)(dst + 8 * i) = pack8(x0, x1); } }
    }
    ATT_BAR();
#undef ATT_BAR
}

__device__ __forceinline__ s16x8 ldperm(const bf16* p, int hi) { const s16x4 x = *(const s16x4*)(p + 4 * hi), y = *(const s16x4*)(p + 8 + 4 * hi); return (s16x8){x[0], x[1], x[2], x[3], y[0], y[1], y[2], y[3]}; }
__device__ __forceinline__ s16x8 packacc(const f32x16& v, int k) { v4u u; u.x = pg8::cvt_pk_bf16(v[8 * k], v[8 * k + 1]); u.y = pg8::cvt_pk_bf16(v[8 * k + 2], v[8 * k + 3]); u.z = pg8::cvt_pk_bf16(v[8 * k + 4], v[8 * k + 5]); u.w = pg8::cvt_pk_bf16(v[8 * k + 6], v[8 * k + 7]); return __builtin_bit_cast(s16x8, u); }
__device__ __forceinline__ s16x8 ldperm_lds(const LAS unsigned char* p, int hi) { const s16x4 x = *(const LAS s16x4*)(p + 8 * hi), y = *(const LAS s16x4*)(p + 16 + 8 * hi); return (s16x8){x[0], x[1], x[2], x[3], y[0], y[1], y[2], y[3]}; }
template <int KIND>
__device__ __forceinline__ void lin_mfma_unit(const Args& a, int li, int b, int hp, LAS unsigned char* lds, int tid) {
    constexpr int DK = KIND ? 64 : 32, NDS = DK / 16, NDB = DK / 32, OTW = 68;
    constexpr int QROW = KIND ? 144 : 80, QT = KIND ? RT_T : GQ_T, HB = 2 * QT + VT_T, PPH = HB / 1024, NP = 2 * PPH;
    constexpr int OFF_OT = 2 * HB, OFF_G = OFF_OT + 2 * 64 * OTW * 4;
    static_assert(HB % 1024 == 0 && OFF_G + 256 <= RING_BYTES, "lin unit LDS map");
    const int lane = tid & 63, w = __builtin_amdgcn_readfirstlane(tid >> 6), r32 = lane & 31, hi = lane >> 5, hl = w >> 2, e0 = 32 * ((w >> 1) & 1), ib = w & 1, h = 2 * hp + hl;
    const unsigned char* Qg = a.ws + (KIND ? B_RQ : B_GQ); const unsigned char* Kg = a.ws + (KIND ? B_RK : B_GK);
    const bf16* proj = (const bf16*)(a.ws + B_PROJ); bf16* ob = (bf16*)a.out;
    LAS float* Ot = (LAS float*)(lds + OFF_OT);
    LAS float* Gs = (LAS float*)(lds + OFF_G);
    const LAS unsigned char* Lh = lds + hl * HB;
    const float dret = __builtin_amdgcn_exp2f(64.f * lg2gamma(h));
    f32x16 S[NDB];
#pragma unroll
    for (int db = 0; db < NDB; ++db) S[db] = (f32x16){};
#define LIN_DMA(c_) do { _Pragma("unroll") for (int j_ = 0; j_ < (NP + 7) / 8; ++j_) { const int p_ = w + 8 * j_; if (p_ < NP) { const int hl_ = p_ / PPH, pp_ = p_ % PPH; const size_t blk_ = (size_t)(b * NCH + (c_)) * 4 + 2 * hp + hl_; \
        const unsigned char* src_; \
        if (pp_ < 2 * QT / 1024) src_ = (pp_ < QT / 1024 ? Qg + blk_ * QT + pp_ * 1024 : Kg + blk_ * QT + (pp_ - QT / 1024) * 1024) + lane * 16; \
        else { const int g_ = 64 * (pp_ - 2 * QT / 1024) + lane, s_ = g_ / 9, cc_ = g_ % 9; int sr_ = src_row(b, (c_), s_); sr_ = sr_ < 0 ? MR : sr_;     \
            src_ = (const unsigned char*)(proj + (size_t)sr_ * N1 + (KIND ? C_RV : C_AV) + (2 * hp + hl_) * 64 + (cc_ < 8 ? cc_ : 7) * 8); } \
        __builtin_amdgcn_global_load_lds((const unsigned*)src_, (LAS unsigned*)(lds + hl_ * HB + pp_ * 1024), 16, 0, 0); } } } while (0)
#define LIN_BAR() do { asm volatile("s_waitcnt lgkmcnt(0)" ::: "memory"); __builtin_amdgcn_s_barrier(); asm volatile("" ::: "memory"); } while (0)
    LIN_BAR();
    if (tid < 64) Gs[tid] = ain(a, KIND ? I_RNORM : I_GNORM)[li * 64 + tid];
    LIN_DMA(0);
    const int nh = tid >> 8, nrow = (tid >> 2) & 63, nq = tid & 3, hn = 2 * hp + nh;
    for (int c = 0; c < NCH; ++c) {
        asm volatile("s_waitcnt vmcnt(0)" ::: "memory"); LIN_BAR();
        s16x8 qf[NDS], kf0[NDS], kf1[NDS], vf[4], ktf[NDB][4];
        const int sr = src_row(b, c, nrow); const bool wr = sr >= 0 && (c > 0 || b == 0);
#pragma unroll
        for (int ds = 0; ds < NDS; ++ds) { qf[ds] = ldperm_lds(Lh + (32 * ib + r32) * QROW + 32 * ds, hi); kf0[ds] = ldperm_lds(Lh + QT + r32 * QROW + 32 * ds, hi); kf1[ds] = ldperm_lds(Lh + QT + (32 + r32) * QROW + 32 * ds, hi); }
        const int trq = (lane & 15) >> 2, trb = (lane >> 4) & 1, trp = lane & 3;
#pragma unroll
        for (int ks = 0; ks < 4; ++ks) { const LAS unsigned char* vp = Lh + 2 * QT + (16 * ks + 4 * hi + trq) * 144 + (e0 + 16 * trb) * 2 + 8 * trp;
            const s16x4 va = __builtin_bit_cast(s16x4, __builtin_amdgcn_ds_read_tr16_b64_v4i16((LAS v4i16_t*)vp)), vb = __builtin_bit_cast(s16x4, __builtin_amdgcn_ds_read_tr16_b64_v4i16((LAS v4i16_t*)(vp + 8 * 144)));
            vf[ks] = (s16x8){va[0], va[1], va[2], va[3], vb[0], vb[1], vb[2], vb[3]}; }
        f32x16 aA = (f32x16){}, aB = (f32x16){};
#pragma unroll
        for (int ds = 0; ds < NDS; ++ds) { aA = __builtin_amdgcn_mfma_f32_32x32x16_bf16(kf0[ds], qf[ds], aA, 0, 0, 0); if (ib) aB = __builtin_amdgcn_mfma_f32_32x32x16_bf16(kf1[ds], qf[ds], aB, 0, 0, 0); }
        asm volatile("s_nop 15\n\ts_nop 15" : "+v"(aA), "+v"(aB));
#pragma unroll
        for (int r = 0; r < 16; ++r) if (crow(r, hi) > r32) { if (ib) aB[r] = 0.f; else aA[r] = 0.f; }
        f32x16 O = (f32x16){};
#pragma unroll
        for (int db = 0; db < NDB; ++db)
#pragma unroll
            for (int ksub = 0; ksub < 2; ++ksub) O = __builtin_amdgcn_mfma_f32_32x32x16_bf16(qf[2 * db + ksub], packacc(S[db], ksub), O, 0, 0, 0);
#pragma unroll
        for (int ksub = 0; ksub < 2; ++ksub) { O = __builtin_amdgcn_mfma_f32_32x32x16_bf16(packacc(aA, ksub), vf[ksub], O, 0, 0, 0); if (ib) O = __builtin_amdgcn_mfma_f32_32x32x16_bf16(packacc(aB, ksub), vf[2 + ksub], O, 0, 0, 0); }
#pragma unroll
        for (int db = 0; db < NDB; ++db)
#pragma unroll
            for (int ks = 0; ks < 4; ++ks) { const LAS unsigned char* kp = Lh + QT + (16 * ks + 4 * hi + trq) * QROW + (32 * db + 16 * trb) * 2 + 8 * trp;
                const s16x4 ka = __builtin_bit_cast(s16x4, __builtin_amdgcn_ds_read_tr16_b64_v4i16((LAS v4i16_t*)kp)), kb = __builtin_bit_cast(s16x4, __builtin_amdgcn_ds_read_tr16_b64_v4i16((LAS v4i16_t*)(kp + 8 * QROW)));
                ktf[db][ks] = (s16x8){ka[0], ka[1], ka[2], ka[3], kb[0], kb[1], kb[2], kb[3]}; }
        LIN_BAR();
        v4u og[2];
#pragma unroll
        for (int i = 0; i < 2; ++i) og[i] = wr ? *(const v4u*)(proj + (size_t)sr * N1 + (KIND ? C_ROG : C_AOG) + hn * 64 + 16 * nq + 8 * i) : (v4u){0u, 0u, 0u, 0u};
        f32x4 dvv[4];
        if (!KIND) { const float* dp = (const float*)(a.ws + WS_GD) + ((size_t)(b * NCH + c) * 4 + h) * 32;
#pragma unroll
            for (int g = 0; g < 4; ++g) dvv[g] = *(const f32x4*)(dp + 8 * g + 4 * hi); }
        if (c + 1 < NCH) LIN_DMA(c + 1);
#pragma unroll
        for (int db = 0; db < NDB; ++db) {
#pragma unroll
            for (int ks = 0; ks < 4; ++ks) S[db] = __builtin_amdgcn_mfma_f32_32x32x16_bf16(ktf[db][ks], vf[ks], S[db], 0, 0, 0); }
        asm volatile("s_nop 15\n\ts_nop 15" : "+v"(O));
#pragma unroll
        for (int db = 0; db < NDB; ++db) asm volatile("s_nop 15\n\ts_nop 15" : "+v"(S[db]));
#pragma unroll
        for (int db = 0; db < NDB; ++db) {
            if (KIND) { S[db] = S[db] * dret; }
            else {
#pragma unroll
                for (int g = 0; g < 4; ++g) { S[db][4 * g] *= dvv[g][0]; S[db][4 * g + 1] *= dvv[g][1]; S[db][4 * g + 2] *= dvv[g][2]; S[db][4 * g + 3] *= dvv[g][3]; } } }
#pragma unroll
        for (int r = 0; r < 16; ++r) Ot[(hl * 64 + 32 * ib + crow(r, hi)) * OTW + e0 + r32] = O[r];
        LIN_BAR();
        { f32x4 v[4]; float s1 = 0.f;
#pragma unroll
            for (int i = 0; i < 4; ++i) { v[i] = *(const LAS f32x4*)(Ot + (nh * 64 + nrow) * OTW + 16 * nq + 4 * i); s1 += (v[i][0] + v[i][1]) + (v[i][2] + v[i][3]); }
            float mean = 0.f; if (KIND) { s1 += __shfl_xor(s1, 1); s1 += __shfl_xor(s1, 2); mean = s1 * (1.f / 64.f); }
            float s2 = 0.f;
#pragma unroll
            for (int i = 0; i < 4; ++i) { v[i] = v[i] - mean; s2 += (v[i][0] * v[i][0] + v[i][1] * v[i][1]) + (v[i][2] * v[i][2] + v[i][3] * v[i][3]); }
            s2 += __shfl_xor(s2, 1); s2 += __shfl_xor(s2, 2);
            const float rs = __builtin_amdgcn_rsqf(s2 * (1.f / 64.f) + EPS);
            if (wr) { bf16* dst = ob + (size_t)sr * DM + KIND * 256 + hn * 64 + 16 * nq; const LAS float* gp = Gs + 16 * nq;
#pragma unroll
                for (int i = 0; i < 2; ++i) { const v4u g4 = og[i]; const f32x4 g0 = *(const LAS f32x4*)(gp + 8 * i), g1 = *(const LAS f32x4*)(gp + 8 * i + 4);
                    f32x4 x0 = v[2 * i] * rs * g0, x1 = v[2 * i + 1] * rs * g1;
                    x0[0] *= silu_f(bflo(g4.x)); x0[1] *= silu_f(bfhi(g4.x)); x0[2] *= silu_f(bflo(g4.y)); x0[3] *= silu_f(bfhi(g4.y)); x1[0] *= silu_f(bflo(g4.z)); x1[1] *= silu_f(bfhi(g4.z)); x1[2] *= silu_f(bflo(g4.w)); x1[3] *= silu_f(bfhi(g4.w));
                    *(v4u*)(dst + 8 * i) = pack8(x0, x1); } } }
        LIN_BAR();
    }
    asm volatile("s_waitcnt vmcnt(0)" ::: "memory");
#undef LIN_DMA
#undef LIN_BAR
}

template <int MODE, int KSTEPS  >
__device__ __forceinline__ void thin_unit(const bf16* A, int lda, const bf16* Bt, int u, bf16* H, float* stats_out, const float* stats_in, bf16* ACT, LAS unsigned char* lds, int tid) {
    constexpr int K = KSTEPS * 256;
    const int lane = tid & 63, w = __builtin_amdgcn_readfirstlane(tid >> 6), fr = lane & 15, fq = lane >> 4;
    int brow[4];
#pragma unroll
    for (int nb = 0; nb < 4; ++nb) brow[nb] = MODE == 0 ? 64 * u + 16 * nb + fr : 256 * (u >> 2) + 32 * (u & 3) + (nb >> 1) * 128 + 16 * (nb & 1) + fr;
    f32x4 acc[4];
#pragma unroll
    for (int nb = 0; nb < 4; ++nb) acc[nb] = (f32x4){0.f, 0.f, 0.f, 0.f};
    const bf16* ap = A + (size_t)fr * lda + w * (KSTEPS * 32) + 8 * fq;
    constexpr int B1 = KSTEPS > 6 ? 6 : KSTEPS;
    { s16x8 af[B1], bf[B1][4];
#pragma unroll
        for (int s = 0; s < B1; ++s) { af[s] = *(const s16x8*)(ap + 32 * s);
#pragma unroll
            for (int nb = 0; nb < 4; ++nb) bf[s][nb] = *(const s16x8*)(Bt + (size_t)brow[nb] * K + w * (KSTEPS * 32) + 32 * s + 8 * fq); }
#pragma unroll
        for (int s = 0; s < B1; ++s)
#pragma unroll
            for (int nb = 0; nb < 4; ++nb) acc[nb] = __builtin_amdgcn_mfma_f32_16x16x32_bf16(bf[s][nb], af[s], acc[nb], 0, 0, 0); }
    if (KSTEPS > B1) { constexpr int B2 = KSTEPS > B1 ? KSTEPS - B1 : 1; s16x8 af[B2], bf[B2][4];
#pragma unroll
        for (int s = 0; s < B2; ++s) { af[s] = *(const s16x8*)(ap + 32 * (B1 + s));
#pragma unroll
            for (int nb = 0; nb < 4; ++nb) bf[s][nb] = *(const s16x8*)(Bt + (size_t)brow[nb] * K + w * (KSTEPS * 32) + 32 * (B1 + s) + 8 * fq); }
#pragma unroll
        for (int s = 0; s < B2; ++s)
#pragma unroll
            for (int nb = 0; nb < 4; ++nb) acc[nb] = __builtin_amdgcn_mfma_f32_16x16x32_bf16(bf[s][nb], af[s], acc[nb], 0, 0, 0); }
    asm volatile("s_nop 15" : "+v"(acc[0]), "+v"(acc[1]), "+v"(acc[2]), "+v"(acc[3]));
    LAS f32x4* part = (LAS f32x4*)lds;
    __syncthreads();
#pragma unroll
    for (int nb = 0; nb < 4; ++nb) part[(w * 4 + nb) * 64 + lane] = acc[nb];
    __syncthreads();
    if (w == 0) {
#pragma unroll
        for (int nb = 0; nb < 4; ++nb) {
#pragma unroll
            for (int w2 = 1; w2 < 8; ++w2) acc[nb] = acc[nb] + part[(w2 * 4 + nb) * 64 + lane]; }
        const int row = MR + fr;
        if (MODE == 0) { float ss = 0.f;
#pragma unroll
            for (int nb = 0; nb < 4; ++nb) { bf16* p = H + (size_t)row * DM + 64 * u + 16 * nb + 4 * fq; const v2u wv = *(const v2u*)p;
                const float x0 = acc[nb][0] + bflo(wv.x), x1 = acc[nb][1] + bfhi(wv.x), x2 = acc[nb][2] + bflo(wv.y), x3 = acc[nb][3] + bfhi(wv.y);
                ss += (x0 * x0 + x1 * x1) + (x2 * x2 + x3 * x3);
                v2u o; o.x = pg8::cvt_pk_bf16(x0, x1); o.y = pg8::cvt_pk_bf16(x2, x3); *(v2u*)p = o; }
            ss += __shfl_xor(ss, 16); ss += __shfl_xor(ss, 32);
            if (fq == 0) stats_out[(size_t)row * 16 + u] = ss;
        } else { const f32x4* sp = (const f32x4*)(stats_in + (size_t)row * 16); const f32x4 s0 = sp[0], s1 = sp[1], s2 = sp[2], s3 = sp[3];
            const float st = ((s0[0] + s0[1]) + (s0[2] + s0[3])) + ((s1[0] + s1[1]) + (s1[2] + s1[3])) + ((s2[0] + s2[1]) + (s2[2] + s2[3])) + ((s3[0] + s3[1]) + (s3[2] + s3[3]));
            const float rs = __builtin_amdgcn_rsqf(st * (1.f / 1024.f) + EPS);
#pragma unroll
            for (int nb = 0; nb < 2; ++nb) { float y[4];
#pragma unroll
                for (int t = 0; t < 4; ++t) y[t] = silu_f(acc[nb][t] * rs) * (acc[2 + nb][t] * rs);
                v2u o; o.x = pg8::cvt_pk_bf16(y[0], y[1]); o.y = pg8::cvt_pk_bf16(y[2], y[3]);
                *(v2u*)(ACT + (size_t)row * DFF + 128 * (u >> 2) + 32 * (u & 3) + 16 * nb + 4 * fq) = o; } }
    }
    __syncthreads();
}

#ifndef REP_PREP
#define REP_PREP 1
#endif
#ifndef REP_MIX
#define REP_MIX 1
#endif
#ifndef REP_P0
#define REP_P0 1
#endif
#ifndef REP_CONV
#define REP_CONV 1
#endif
#ifndef REP_G1
#define REP_G1 1
#endif
#ifndef REP_MGU
#define REP_MGU 1
#endif
#ifndef REP_MDN
#define REP_MDN 1
#endif
#ifndef REP_BAR
#define REP_BAR 0
#endif
#ifndef REP_PART
#define REP_PART -1
#endif
#ifndef MK_ONE_LAUNCH
#define MK_ONE_LAUNCH 1
#endif
constexpr int NPHASE = 20;
constexpr int CW_Q = 12288;
__global__ void __launch_bounds__(512, 2) mega_fwd(Args a) {
    extern __shared__ __attribute__((aligned(16))) unsigned char lds_raw[];
    LAS unsigned char* lds = (LAS unsigned char*)lds_raw;
    volatile LAS unsigned* MISC = (volatile LAS unsigned*)(lds + MISC_OFF);
    int wave = __builtin_amdgcn_readfirstlane((int)threadIdx.x >> 6); asm volatile("" : "+s"(wave));
    const int G = gridDim.x;
#define TID() ((wave << 6) + lane_id())
    for (int u = TID(); u < (LDS_BYTES - RING_BYTES) / 4; u += 512) ((LAS unsigned*)(lds + RING_BYTES))[u] = 0u;
    __syncthreads();
    gu32* ctl = (gu32*)(a.ws + WS_CTL);
    const int lo = a.ph_lo, hi = a.ph_hi;
    XcdBarrier bar; bar.bar = (unsigned*)(ctl + CW_BAR); bar.x = 0; bar.st = nullptr;
    if (hi - lo > 1) bar = xcd_barrier_post((unsigned*)(ctl + CW_BAR), MISC + 8, TID() == 0);
#define IN(k) (lo <= (k) && (k) < hi)
#define OPQ() int ptid = TID(); asm volatile("" : "+v"(ptid)); const int plane = ptid & 63; (void)plane
#define SEAM(k) do { if (IN(k) && IN((k) + 1)) xcd_barrier(bar, TID() == 0); } while (0)
#define hb ((bf16*)(a.ws + WS_HB))
#define stA ((float*)(a.ws + WS_STA))
#define stB ((float*)(a.ws + WS_STB))

    for (int rep = 0; rep < REP_BAR; ++rep) xcd_barrier(bar, TID() == 0);
    if (IN(0)) { OPQ(); for (int rep = 0; rep < REP_P0; ++rep) { p0_prologue(a, lds, ptid, plane, wave); __syncthreads(); } }
    SEAM(0);

    for (int li = 0; li < 2; ++li) {
        const int pb = 1 + 6 * li;
        if (IN(pb)) {
            pg8::Gemm g{hb, (const bf16*)(a.ws + WS_W1T + li * W1T_BYTES), DM, 0, nullptr}; pg8::StaticOrder S; S.init(NPAN, N1 / 256, G, (int)blockIdx.x);
            EpiProj E{(bf16*)(a.ws + B_PROJ), stA};
            for (int rep = 0; rep < REP_G1; ++rep) pg8::gemm_phase<EpiProj, pg8::StaticOrder, false>(lds, g, S, E, wave);
        }
        SEAM(pb);
        if (IN(pb + 1)) { OPQ(); for (int rep = 0; rep < REP_PREP; ++rep) for (int u = blockIdx.x; u < NB * NCH * 3; u += G) { const int part = u % 3;     if (rep > 0 && REP_PART >= 0 && part != REP_PART) continue; int ut = ptid; asm volatile("" : "+v"(ut)); prep2_unit(a, li, (u / 3) / NCH, (u / 3) % NCH, part, lds, ut); } __syncthreads(); }
        SEAM(pb + 1);
        if (IN(pb + 2)) {
            OPQ(); const int tid = ptid;
            LAS int* qid = (LAS int*)(lds + RING_BYTES + 64);
            float lam, lam_init; { const float* lv = ain(a, I_DLAM) + li * 128; float s01 = 0.f, s23 = 0.f;
                for (int d = 0; d < 32; ++d) { s01 += lv[d] * lv[32 + d]; s23 += lv[64 + d] * lv[96 + d]; }
                lam_init = 0.8f - 0.6f * __expf(-0.3f * (float)li); lam = __expf(s01) - __expf(s23) + lam_init;
                lam = __uint_as_float(__builtin_amdgcn_readfirstlane(__float_as_uint(lam))); lam_init = __uint_as_float(__builtin_amdgcn_readfirstlane(__float_as_uint(lam_init))); }
            for (int rep = 0; rep < REP_MIX; ++rep)
            for (;;) {
                __syncthreads();
                if (tid == 0) *qid = (int)__hip_atomic_fetch_add(ctl + CW_Q + 64 * (li + 2 * rep), 1u, RLX_AGENT);
                __syncthreads();
                const int id = *qid;
                int utid = ptid; asm volatile("" : "+v"(utid));
                if (id >= 64 + 1024 + 8) break;
                if (id < 64) { if ((id & 1) == 0) lin_mfma_unit<0>(a, li, (id >> 1) & 15, id >> 5, lds, utid); else lin_mfma_unit<1>(a, li, (id >> 1) & 15, id >> 5, lds, utid); }
                else { const int v = id - 64; int qb, kind, b, hh;
                    if (v < 1024) { qb = 7 - (v >> 7); const int rem = v & 127; kind = rem >> 6; b = (rem >> 2) & 15; hh = rem & 3; } else { qb = -1; kind = (v - 1024) >> 2; b = 0; hh = v & 3; }
                    if (kind == 0) attn_mfma_unit<0>(a, li, b, hh, qb, lds, utid, 0.f, 1.f); else attn_mfma_unit<1>(a, li, b, hh, qb, lds, utid, lam, 1.f - lam_init); }
            }
        }
        SEAM(pb + 2);
        if (IN(pb + 3)) {
            if (li == 0) { OPQ(); for (int u = blockIdx.x; u < 16; u += G) thin_unit<0, 4>((const bf16*)a.out + (size_t)MR * DM, DM, (const bf16*)(a.ws + WS_WOT), u, hb, stB, nullptr, nullptr, lds, ptid); }
            pg8::Gemm g{(const bf16*)a.out, (const bf16*)(a.ws + WS_WOT + li * WOT_BYTES), DM, 0, nullptr}; pg8::StaticOrder S; S.init(NPAN - 1, 4, G, (int)blockIdx.x);
            EpiResid E{hb, stB};
            pg8::gemm_phase<EpiResid, pg8::StaticOrder, false>(lds, g, S, E, wave);
        }
        SEAM(pb + 3);
        if (li == 0) {
            if (IN(5)) {
                { OPQ(); for (int u = blockIdx.x; u < 88; u += G) thin_unit<1, 4>(hb + (size_t)MR * DM, DM, (const bf16*)(a.ws + WS_WGU), u, nullptr, nullptr, stB, (bf16*)(a.ws + B_ACT), lds, ptid); }
                pg8::Gemm g{hb, (const bf16*)(a.ws + WS_WGU), DM, 0, nullptr}; pg8::StaticOrder S; S.init(NPAN - 1, 2 * DFF / 256, G, (int)blockIdx.x);
                EpiSwiglu E{(bf16*)(a.ws + B_ACT), DFF, stB};
                pg8::gemm_phase<EpiSwiglu, pg8::StaticOrder, false>(lds, g, S, E, wave);
            }
            SEAM(5);
            if (IN(6)) {
                { OPQ(); for (int u = blockIdx.x; u < 16; u += G) thin_unit<0, 11>((const bf16*)(a.ws + B_ACT) + (size_t)MR * DFF, DFF, (const bf16*)(a.ws + WS_WD), u, hb, stA, nullptr, nullptr, lds, ptid); }
                pg8::Gemm g{(const bf16*)(a.ws + B_ACT), (const bf16*)(a.ws + WS_WD), DFF, 0, nullptr}; pg8::StaticOrder S; S.init(NPAN - 1, 4, G, (int)blockIdx.x);
                EpiResid E{hb, stA};
                pg8::gemm_phase<EpiResid, pg8::StaticOrder, false>(lds, g, S, E, wave);
            }
            SEAM(6);
        }
    }
    if (IN(11)) { OPQ(); const int tid = ptid, lane = plane;
        LAS float* scr = (LAS float*)(lds + wave * 16384);
        const int gw = blockIdx.x * 8 + wave, NGW = G * 8;
        constexpr int IG = 16 * 56, ID = 56 * 16;
        for (int rep = 0; rep < REP_CONV; ++rep)
        for (int it = gw; it < 8 * (2 * IG + ID); it += NGW) { const int e = it / (2 * IG + ID); int r = it % (2 * IG + ID);
            if (r < IG) { transpose_item(ain(a, I_EG) + (size_t)e * DM * DFE, DM, DFE, ain(a, I_FNORM) + DM, (bf16*)(a.ws + B_EGU + e * EGU_BYTES), r / 56, r % 56, 1, scr, lane); continue; } r -= IG;
            if (r < IG) { transpose_item(ain(a, I_EU) + (size_t)e * DM * DFE, DM, DFE, ain(a, I_FNORM) + DM, (bf16*)(a.ws + B_EGU + e * EGU_BYTES), r / 56, r % 56, 2, scr, lane); continue; } r -= IG;
            transpose_item(ain(a, I_ED) + (size_t)e * DFE * DM, DFE, DM, nullptr, (bf16*)(a.ws + B_ED + e * ED_BYTES), r / 16, r % 16, 0, scr, lane); }
        for (int i = blockIdx.x * 512 + tid; i < MAXPAN * 256; i += G * 512) { ((int*)(a.ws + MO_ROWIDX))[i] = -1; ((int*)(a.ws + MO_PDST))[i] = -1; ((f32x2*)(a.ws + MO_PINFO))[i] = (f32x2){0.f, 0.f}; }
        for (int blk = blockIdx.x; blk < MR / 128; blk += G) route_block(a, blk, lds, tid, lane, wave);
    }
    SEAM(11);
    LAS int* offs = (LAS int*)(lds + RING_BYTES + 128);
    if (IN(12)) { OPQ(); const int tid = ptid;
        moe_offsets(a, offs, tid);
        for (int idx = blockIdx.x * 512 + tid; idx < 2 * MR; idx += G * 512) { const int tok = idx >> 1, e = ((const int*)(a.ws + MO_TOKE))[idx], gpos = offs[e] + ((const int*)(a.ws + MO_TOKP))[idx];
            const f32x4* sp = (const f32x4*)(stB + (size_t)tok * 16); const f32x4 s0 = sp[0], s1 = sp[1], s2 = sp[2], s3 = sp[3];
            const float ss = ((s0[0] + s0[1]) + (s0[2] + s0[3])) + ((s1[0] + s1[1]) + (s1[2] + s1[3])) + ((s2[0] + s2[1]) + (s2[2] + s2[3])) + ((s3[0] + s3[1]) + (s3[2] + s3[3]));
            ((int*)(a.ws + MO_ROWIDX))[gpos] = tok; ((int*)(a.ws + MO_PDST))[gpos] = idx;
            ((f32x2*)(a.ws + MO_PINFO))[gpos] = (f32x2){__builtin_amdgcn_rsqf(ss * (1.f / 1024.f) + EPS), __int_as_float(((const int*)(a.ws + MO_TOKW))[idx])}; }
        if (blockIdx.x == 0 && tid < MAXPAN + 8) { int e = 0;
            for (int k = 1; k < 8; ++k) if (tid * 256 >= offs[k]) e = k;
            ((int*)(a.ws + MO_PEXP))[tid] = e; }
    }
    SEAM(12);
    for (int ci = 0; ci < 3; ++ci) {
        if (IN(13 + 2 * ci) || IN(14 + 2 * ci)) moe_offsets(a, offs, TID());
        int nP = 0; if (IN(13 + 2 * ci) || IN(14 + 2 * ci)) { nP = __builtin_amdgcn_readfirstlane(offs[8]) - 128 * ci; nP = nP > 128 ? 128 : nP; }
        if (IN(13 + 2 * ci) && nP > 0) {
            pg8::Gemm g{hb, (const bf16*)(a.ws + B_EGU), DM, EGU_BYTES, (const int*)(a.ws + MO_ROWIDX)}; pg8::MoeOrder S; S.init(nP, 2 * DFE / 256, G, (int)blockIdx.x, 128 * ci, (const int*)(a.ws + MO_PEXP));
            EpiSwigluMoe E{(bf16*)(a.ws + B_EACT), (const f32x2*)(a.ws + MO_PINFO)};
            for (int rep = 0; rep < REP_MGU; ++rep) pg8::gemm_phase<EpiSwigluMoe, pg8::MoeOrder, true>(lds, g, S, E, wave);
        }
        SEAM(13 + 2 * ci);
        if (IN(14 + 2 * ci) && nP > 0) {
            pg8::Gemm g{(const bf16*)(a.ws + B_EACT), (const bf16*)(a.ws + B_ED), DFE, ED_BYTES, nullptr}; pg8::MoeOrder S; S.init(nP, 4, G, (int)blockIdx.x, 128 * ci, (const int*)(a.ws + MO_PEXP));
            EpiMoeDown E{(unsigned char*)a.out, (const int*)(a.ws + MO_PDST), (const f32x2*)(a.ws + MO_PINFO)};
            for (int rep = 0; rep < REP_MDN; ++rep) pg8::gemm_phase<EpiMoeDown, pg8::MoeOrder, false>(lds, g, S, E, wave);
        }
        SEAM(14 + 2 * ci);
    }
    if (IN(19)) { OPQ(); const int lane = plane;
        const float* fn = ain(a, I_FINAL);
        for (int r = blockIdx.x * 8 + wave; r < MR; r += G * 8) {
            unsigned char* orow = (unsigned char*)a.out + (size_t)r * 4096; float v[16]; float ss = 0.f;
#pragma unroll
            for (int hf = 0; hf < 2; ++hf) { const int k = 512 * hf + 8 * lane; const v4u h4 = *(const v4u*)(hb + (size_t)r * DM + k), y0 = *(const v4u*)(orow + 2 * k), y1 = *(const v4u*)(orow + 2048 + 2 * k);
                const unsigned hw[4] = {h4.x, h4.y, h4.z, h4.w}, aw[4] = {y0.x, y0.y, y0.z, y0.w}, bw[4] = {y1.x, y1.y, y1.z, y1.w};
#pragma unroll
                for (int t = 0; t < 4; ++t) { const float x0 = bflo(hw[t]) + bflo(aw[t]) + bflo(bw[t]), x1 = bfhi(hw[t]) + bfhi(aw[t]) + bfhi(bw[t]); v[8 * hf + 2 * t] = x0; v[8 * hf + 2 * t + 1] = x1; ss += x0 * x0 + x1 * x1; } }
            ss = wave_sum(ss); const float rs = __builtin_amdgcn_rsqf(ss * (1.f / 1024.f) + EPS);
#pragma unroll
            for (int hf = 0; hf < 2; ++hf) { const int k = 512 * hf + 8 * lane; const f32x4 g0 = *(const f32x4*)(fn + k), g1 = *(const f32x4*)(fn + k + 4);
                *(f32x4*)(orow + 4 * k) = (f32x4){v[8 * hf] * rs * g0[0], v[8 * hf + 1] * rs * g0[1], v[8 * hf + 2] * rs * g0[2], v[8 * hf + 3] * rs * g0[3]};
                *(f32x4*)(orow + 4 * k + 16) = (f32x4){v[8 * hf + 4] * rs * g1[0], v[8 * hf + 5] * rs * g1[1], v[8 * hf + 6] * rs * g1[2], v[8 * hf + 7] * rs * g1[3]}; }
        }
    }
#undef IN
#undef SEAM
#undef hb
#undef stA
#undef stB
}

extern "C" void kernel_launch(void* const* d_in, const int* in_sizes, int n_in, void* d_out, int out_size, void* d_ws, size_t ws_size, hipStream_t stream) {
    static int grid = 0;
    if (grid == 0) {
        if (n_in != 24 || in_sizes[0] != MR * DM || out_size != MR * DM || ws_size < WS_NEED) { fprintf(stderr, "kernel_launch: unexpected problem (n_in %d, in0 %d, out %d, ws %zu < %zu)\n", n_in, n_in > 0 ? in_sizes[0] : -1, out_size, ws_size, (size_t)WS_NEED); grid = -1; return; }
        int dev = 0, cus = 0, per_cu = 0;
        if (hipGetDevice(&dev) != hipSuccess || hipDeviceGetAttribute(&cus, hipDeviceAttributeMultiprocessorCount, dev) != hipSuccess) { grid = -1; return; }
        if (hipFuncSetAttribute((const void*)mega_fwd, hipFuncAttributeMaxDynamicSharedMemorySize, LDS_BYTES) != hipSuccess) { fprintf(stderr, "kernel_launch: hipFuncSetAttribute failed\n"); grid = -1; return; }
        if (hipOccupancyMaxActiveBlocksPerMultiprocessor(&per_cu, (const void*)mega_fwd, 512, LDS_BYTES) != hipSuccess || per_cu < 1) fprintf(stderr, "kernel_launch: occupancy query reports %d\n", per_cu);
        (void)hipGetLastError();
        grid = cus;
    }
    if (grid < 0) return;
    if (hipMemsetAsync((char*)d_ws + WS_CTL, 0, CTL_BYTES, stream) != hipSuccess) return;
    Args a{};
    for (int i = 0; i < 24; ++i) a.in[i] = (const float*)d_in[i];
    a.out = (float*)d_out; a.ws = (unsigned char*)d_ws;
#if MK_ONE_LAUNCH
    a.ph_lo = 0; a.ph_hi = NPHASE;
    hipLaunchKernelGGL(mega_fwd, dim3(grid), dim3(512), LDS_BYTES, stream, a);
#else
    for (int p = 0; p < NPHASE; ++p) { a.ph_lo = p; a.ph_hi = p + 1; hipLaunchKernelGGL(mega_fwd, dim3(grid), dim3(512), LDS_BYTES, stream, a); }
#endif
}
```

```cpp
#include <hip/hip_runtime.h>
#include <cstdio>
#include <cstdint>

namespace pg8 {
#define PG8_LAS __attribute__((address_space(3)))
typedef unsigned short bf16_t;
typedef short bf16x8 __attribute__((ext_vector_type(8)));
typedef float f32x4 __attribute__((ext_vector_type(4)));
typedef unsigned u32x4 __attribute__((ext_vector_type(4)));
constexpr int BM = 256, BK = 64, HALF = 128, HTB = HALF * BK * 2  , STAGE_BYTES = 8 * HTB, NXCD = 8, WGM = 8;

__host__ __device__ __forceinline__ int lds_byte(int r, int c) { const int st = (r >> 4) * 2 + (c >> 5), rr = r & 15, cc = c & 31, ob = rr * 64 + cc * 2; return st * 1024 + (ob ^ (((ob >> 9) & 1) << 5)); }
__host__ __device__ __forceinline__ void stage_rc(int b, int& R, int& C) { const int st = b / 1024, sb = b % 1024, swz = sb ^ (((sb >> 9) & 1) << 5); R = (st >> 1) * 16 + swz / 64; C = (st & 1) * 32 + (swz % 64) / 2; }
__host__ __device__ __forceinline__ int perm32(int rho) { const int n = rho >> 4, i = rho & 15; return 8 * (i >> 2) + 4 * n + (i & 3); }

struct Unit { int pm, pn, e, gp; };
struct Gemm { const bf16_t* A; const bf16_t* Bt; int K; size_t estride  ; const int* rowidx  ; };

struct StaticOrder {
    int nM, nN, nwg, G, c;
    __device__ void init(int nM_, int nN_, int G_, int c_) { nM = nM_; nN = nN_; nwg = nM * nN; G = G_; c = c_; }
    __device__ __forceinline__ bool map(int i, int& pm, int& pn) const {
        const long L = (long)i * G + c; if (L >= nwg) return false;
        int wgid = (int)L; { const int q = nwg / NXCD, r = nwg % NXCD, xcd = wgid % NXCD, off = wgid / NXCD; wgid = (xcd < r ? xcd * (q + 1) : r * (q + 1) + (xcd - r) * q) + off; }
        const int nig = WGM * nN, gid = wgid / nig, fm = gid * WGM, gsz = (nM - fm) < WGM ? (nM - fm) : WGM;
        pm = fm + ((wgid % nig) % gsz); pn = (wgid % nig) / gsz; return true;
    }
    __device__ __forceinline__ bool next(int i, Unit& u) const { int pm, pn; if (!map(i, pm, pn)) return false; u.pm = pm; u.pn = pn; u.e = 0; u.gp = pm; return true; }
};
struct MoeOrder {
    StaticOrder so; int p0; const int* pexp;
    __device__ void init(int nP, int nN, int G, int c, int p0_, const int* pexp_) { so.init(nP, nN, G, c); p0 = p0_; pexp = pexp_; }
    __device__ __forceinline__ bool next(int i, Unit& u) const { int pm, pn; if (!so.map(i, pm, pn)) return false; u.pm = pm; u.pn = pn; u.gp = p0 + pm; u.e = __builtin_amdgcn_readfirstlane(pexp[u.gp]); return true; }
};

__device__ __forceinline__ unsigned cvt_pk_bf16(float lo, float hi) { unsigned r; asm volatile("v_cvt_pk_bf16_f32 %0, %1, %2" : "=v"(r) : "v"(lo), "v"(hi)); return r; }
__device__ __forceinline__ float bf_lo(unsigned w) { return __uint_as_float(w << 16); }
__device__ __forceinline__ float bf_hi(unsigned w) { return __uint_as_float(w & 0xffff0000u); }

template <class Epi, class Sched, bool GATHER>
__device__ __forceinline__ void gemm_phase(PG8_LAS unsigned char* lds, const Gemm g, const Sched& S, const Epi& E, int wave_id  ) {
    int tid_; asm volatile("v_mbcnt_lo_u32_b32 %0, -1, 0\n\tv_mbcnt_hi_u32_b32 %0, -1, %0" : "=v"(tid_)); tid_ += wave_id << 6;
    const int tid = tid_, wid = __builtin_amdgcn_readfirstlane(tid >> 6), lane = tid & 63, wr = wid >> 2, wc = wid & 3, fr = lane & 15, fq = lane >> 4;
    const int K = g.K, nt = K / BK;
    int Ra[2], Ca[2]; unsigned voffB[2];
#pragma unroll
    for (int i = 0; i < 2; ++i) { int R, C; stage_rc(tid * 16 + i * 8192, R, C); const int Rb = (R & ~31) + perm32(R & 31);
        Ra[i] = R; Ca[i] = C; voffB[i] = (unsigned)(Rb * K + C) * 2u; }
    const size_t kstep = (size_t)(BK * 2);
    const size_t hstep = (size_t)HALF * K * 2;
    const size_t tstep = 2 * hstep;
    const unsigned ldsw = (unsigned)wid * 1024u;
    const int aoff = lds_byte(wr * 64 + fr, fq * 8), boff = lds_byte(wc * 32 + fr, fq * 8);
    const char* const A0 = (const char*)g.A;
#define PG8_SA(b, h) (((b) * 2 + (h)) * HTB)
#define PG8_SB(b, h) ((4 + (b) * 2 + (h)) * HTB)
#define PG8_STAGE(bufoff, gbase, voff) do { _Pragma("unroll") for (int _i = 0; _i < 2; ++_i) \
        __builtin_amdgcn_global_load_lds((const unsigned*)((const char*)(gbase) + (voff)[_i]), (PG8_LAS unsigned*)(lds + (bufoff) + ldsw + _i * 8192), 16, 0, 0); } while (0)
#define PG8_LDA(dst, b, h) do { _Pragma("unroll") for (int m = 0; m < 4; ++m) _Pragma("unroll") for (int k = 0; k < 2; ++k) dst[m][k] = *(const PG8_LAS bf16x8*)(lds + PG8_SA(b, h) + aoff + m * 2048 + k * 1024); } while (0)
#define PG8_LDB(dst, b, h) do { _Pragma("unroll") for (int n = 0; n < 2; ++n) _Pragma("unroll") for (int k = 0; k < 2; ++k) dst[n][k] = *(const PG8_LAS bf16x8*)(lds + PG8_SB(b, h) + boff + n * 2048 + k * 1024); } while (0)
#define PG8_MMA(ai, bj, At, Bt) do { __builtin_amdgcn_s_setprio(1); _Pragma("unroll") for (int m = 0; m < 4; ++m) _Pragma("unroll") for (int n = 0; n < 2; ++n) _Pragma("unroll") for (int k = 0; k < 2; ++k) \
        acc[ai][bj][m][n] = __builtin_amdgcn_mfma_f32_16x16x32_bf16(Bt[n][k], At[m][k], acc[ai][bj][m][n], 0, 0, 0); __builtin_amdgcn_s_setprio(0); } while (0)
#define PG8_WAIT_V(n) asm volatile("s_waitcnt vmcnt(" #n ")" ::: "memory")
#define PG8_WAIT_L(n) asm volatile("s_waitcnt lgkmcnt(" #n ")" ::: "memory")
#define PG8_BAR __builtin_amdgcn_s_barrier()
#define PG8_SCHED __builtin_amdgcn_sched_barrier(0)
#define PG8_AOFFS(dst, u) do { _Pragma("unroll") for (int _h = 0; _h < 2; ++_h) _Pragma("unroll") for (int _i = 0; _i < 2; ++_i) { \
        int _row = (u).pm * BM + _h * HALF + Ra[_i]; \
        if (GATHER) { const int _gi = g.rowidx[(u).gp * BM + _h * HALF + Ra[_i]]; _row = _gi < 0 ? 0 : _gi; } \
        dst[_h][_i] = ((unsigned)_row * (unsigned)K + (unsigned)Ca[_i]) * 2u; } } while (0)
    Unit cur, nxt; int ui = 0;
    if (!S.next(0, cur)) return;
    f32x4 acc[2][2][4][2];
#pragma unroll
    for (int a = 0; a < 2; ++a)
#pragma unroll
        for (int b = 0; b < 2; ++b)
#pragma unroll
            for (int m = 0; m < 4; ++m)
#pragma unroll
                for (int n = 0; n < 2; ++n) acc[a][b][m][n] = (f32x4){0.f, 0.f, 0.f, 0.f};
    bf16x8 At[4][2], B0[2][2], B1[2][2];
    unsigned oaC[2][2], oaN[2][2];
    PG8_AOFFS(oaC, cur);
    const char* cB = (const char*)g.Bt + (size_t)cur.e * g.estride + (size_t)cur.pn * tstep;
    PG8_STAGE(PG8_SB(0, 0), cB, voffB); PG8_STAGE(PG8_SB(0, 1), cB + hstep, voffB); PG8_STAGE(PG8_SA(0, 0), A0, oaC[0]); PG8_STAGE(PG8_SA(0, 1), A0, oaC[1]);
    if (wr == 1) PG8_BAR;
    PG8_WAIT_V(2); PG8_BAR;
    PG8_STAGE(PG8_SB(1, 0), cB + kstep, voffB); PG8_STAGE(PG8_SA(1, 0), A0 + kstep, oaC[0]); PG8_STAGE(PG8_SB(1, 1), cB + hstep + kstep, voffB);
    PG8_WAIT_V(6); PG8_BAR;
    for (;;) {
        const bool has_next = S.next(ui + 1, nxt);
        if (has_next) { PG8_AOFFS(oaN, nxt); }
        else {
#pragma unroll
            for (int _h = 0; _h < 2; ++_h)
#pragma unroll
                for (int _i = 0; _i < 2; ++_i) oaN[_h][_i] = oaC[_h][_i]; }
        const char* nB = has_next ? (const char*)g.Bt + (size_t)nxt.e * g.estride + (size_t)nxt.pn * tstep : cB;
        for (int t = 0; t < nt; t += 2) {
            const bool last = (t == nt - 2);
            const char* ka1 = A0 + (size_t)(t + 1) * kstep;
            const char* ka2 = last ? A0 : A0 + (size_t)(t + 2) * kstep; const char* b2 = last ? nB : cB + (size_t)(t + 2) * kstep;
            const char* ka3 = ka2 + kstep; const char* b3 = b2 + kstep;
            unsigned o2[2][2];
#pragma unroll
            for (int _h = 0; _h < 2; ++_h)
#pragma unroll
                for (int _i = 0; _i < 2; ++_i) o2[_h][_i] = oaC[_h][_i];
            if (last) {
#pragma unroll
                for (int _h = 0; _h < 2; ++_h)
#pragma unroll
                    for (int _i = 0; _i < 2; ++_i) o2[_h][_i] = oaN[_h][_i];
                asm volatile("" : "+v"(o2[0][0]), "+v"(o2[0][1]), "+v"(o2[1][0]), "+v"(o2[1][1])); }
            PG8_LDB(B0, 0, 0); PG8_LDB(B1, 0, 1); PG8_SCHED; PG8_LDA(At, 0, 0); PG8_STAGE(PG8_SA(1, 1), ka1, oaC[1]);
            PG8_WAIT_V(8); PG8_WAIT_L(0); PG8_BAR; PG8_MMA(0, 0, At, B0); PG8_MMA(0, 1, At, B1); PG8_BAR; PG8_SCHED;
            PG8_LDA(At, 0, 1); PG8_STAGE(PG8_SB(0, 0), b2, voffB); PG8_STAGE(PG8_SB(0, 1), b2 + hstep, voffB); PG8_STAGE(PG8_SA(0, 0), ka2, o2[0]);
            PG8_WAIT_V(8); PG8_WAIT_L(0); PG8_BAR; PG8_MMA(1, 0, At, B0); PG8_MMA(1, 1, At, B1); PG8_BAR; PG8_SCHED;
            PG8_LDB(B0, 1, 0); PG8_LDB(B1, 1, 1); PG8_SCHED; PG8_LDA(At, 1, 0); PG8_STAGE(PG8_SA(0, 1), ka2, o2[1]);
            PG8_WAIT_V(8); PG8_WAIT_L(0); PG8_BAR; PG8_MMA(0, 0, At, B0); PG8_MMA(0, 1, At, B1); PG8_BAR; PG8_SCHED;
            PG8_LDA(At, 1, 1); PG8_STAGE(PG8_SB(1, 0), b3, voffB); PG8_STAGE(PG8_SB(1, 1), b3 + hstep, voffB); PG8_STAGE(PG8_SA(1, 0), ka3, o2[0]);
            PG8_WAIT_V(8); PG8_WAIT_L(0); PG8_BAR; PG8_MMA(1, 0, At, B0); PG8_MMA(1, 1, At, B1); PG8_BAR; PG8_SCHED;
        }
        if (wr == 0) PG8_BAR;
        E(acc, cur, wr, wc, fr, fq);
        if (!has_next) break;
#pragma unroll
        for (int a = 0; a < 2; ++a)
#pragma unroll
            for (int b = 0; b < 2; ++b)
#pragma unroll
                for (int m = 0; m < 4; ++m)
#pragma unroll
                    for (int n = 0; n < 2; ++n) acc[a][b][m][n] = (f32x4){0.f, 0.f, 0.f, 0.f};
        cur = nxt; cB = nB; ++ui;
#pragma unroll
        for (int _h = 0; _h < 2; ++_h)
#pragma unroll
            for (int _i = 0; _i < 2; ++_i) oaC[_h][_i] = oaN[_h][_i];
        if (wr == 1) PG8_BAR;
    }
    PG8_WAIT_V(0);
    PG8_BAR;
#undef PG8_SA
#undef PG8_SB
#undef PG8_STAGE
#undef PG8_LDA
#undef PG8_LDB
#undef PG8_MMA
#undef PG8_WAIT_V
#undef PG8_WAIT_L
#undef PG8_BAR
#undef PG8_SCHED
#undef PG8_AOFFS
}
}
#define GAS __attribute__((address_space(1)))
#define LAS __attribute__((address_space(3)))
typedef unsigned short bf16;
typedef unsigned v4u __attribute__((ext_vector_type(4)));
typedef unsigned v2u __attribute__((ext_vector_type(2)));
typedef float f32x4 __attribute__((ext_vector_type(4)));
typedef float f32x2 __attribute__((ext_vector_type(2)));
typedef GAS unsigned gu32;
#define RLX_AGENT __ATOMIC_RELAXED, __HIP_MEMORY_SCOPE_AGENT
#define LDS_WAIT() asm volatile("s_waitcnt lgkmcnt(0)" ::: "memory")
#define VM_WAIT() asm volatile("s_waitcnt vmcnt(0)" ::: "memory")
__device__ __forceinline__ unsigned f2bf(float f) { unsigned u = __builtin_bit_cast(unsigned, f); return (u + 0x7fffu + ((u >> 16) & 1u)) >> 16; }
__device__ __forceinline__ unsigned pk2(float lo, float hi) { return f2bf(lo) | (f2bf(hi) << 16); }
__device__ __forceinline__ float bf2f(bf16 h) { return __uint_as_float(((unsigned)h) << 16); }
__device__ __forceinline__ float bflo(unsigned w) { return __uint_as_float(w << 16); }
__device__ __forceinline__ float bfhi(unsigned w) { return __uint_as_float(w & 0xffff0000u); }

#define XB_TMO      128
#define XB_XCNT(j)  (256  + 64 * (j))
#define XB_XSUB(j)  (1280 + 64 * (j))
#define XB_XGEN(j)  (2304 + 64 * (j))
#define XB_TOP      3328
#define XB_TOPGEN   3392
#define XCD_BAR_WORDS 3456
#define XB_SPIN_CAP (1u << 18)

__device__ __forceinline__ unsigned xb_ld(unsigned* p)              { return __hip_atomic_load(p, __ATOMIC_RELAXED, __HIP_MEMORY_SCOPE_AGENT); }
__device__ __forceinline__ unsigned xb_add(unsigned* p, unsigned v) { return __hip_atomic_fetch_add(p, v, __ATOMIC_RELAXED, __HIP_MEMORY_SCOPE_AGENT); }
__device__ __forceinline__ unsigned xb_xcc_id() { return (unsigned)__builtin_amdgcn_s_getreg((3 << 11) | 20) & 0xFu; }
#define XB_SPIN(cond, bar) do { unsigned _sp = 0; while (cond) { __builtin_amdgcn_s_sleep(1); \
    if ((++_sp & 255u) == 0u) { if (xb_ld(&(bar)[XB_TMO])) break; if (_sp > XB_SPIN_CAP) { atomicAdd(&(bar)[XB_TMO], 1u); break; } } } } while (0)

struct XcdBarrier {
    unsigned* bar; unsigned x;
    volatile LAS unsigned* st;
};

__device__ __forceinline__ XcdBarrier xcd_barrier_post(unsigned* bar, volatile LAS unsigned* st, bool leader  ) {
    XcdBarrier b; b.bar = bar; b.x = xb_xcc_id(); b.st = st;
    if (leader) (void)xb_add(&bar[XB_XCNT(b.x)], 1u);
    return b;
}
__device__ __forceinline__ void xcd_barrier_complete(unsigned* bar, unsigned x, unsigned& nloc, unsigned& nx) {
    const unsigned G = gridDim.x * gridDim.y * gridDim.z;
    unsigned sum, cnt, mine, sp = 0u;
    for (;;) {
        sum = 0u; cnt = 0u; mine = 0u;
#pragma unroll
        for (unsigned j = 0; j < 16; ++j) { const unsigned c = xb_ld(&bar[XB_XCNT(j)]); sum += c; cnt += (c > 0u) ? 1u : 0u; mine = (j == x) ? c : mine; }
        if (sum == G) break;
        __builtin_amdgcn_s_sleep(1);
        if ((++sp & 255u) == 0u) { if (xb_ld(&bar[XB_TMO])) break; if (sp > XB_SPIN_CAP) { atomicAdd(&bar[XB_TMO], 1u); break; } }
    }
    nloc = mine > 0u ? mine : 1u; nx = cnt > 0u ? cnt : 1u;
}

__device__ __forceinline__ void xcd_barrier(const XcdBarrier& b, bool leader) {
    asm volatile("s_waitcnt vmcnt(0)" ::: "memory");
    __syncthreads();
    if (leader) {
        unsigned* bar = b.bar;
        __builtin_amdgcn_s_waitcnt(0);
        unsigned nloc = b.st[0], nx = b.st[1];
        if (nloc == 0u) { xcd_barrier_complete(bar, b.x, nloc, nx); b.st[0] = nloc; b.st[1] = nx; }
        const unsigned old = xb_add(&bar[XB_XSUB(b.x)], 1u);
        const unsigned gen = old / nloc;
        if (old + 1u == (gen + 1u) * nloc) {
            __builtin_amdgcn_fence(__ATOMIC_RELEASE, "agent");
            asm volatile("s_waitcnt vmcnt(0)" ::: "memory");
            const unsigned og = xb_add(&bar[XB_TOP], 1u);
            const unsigned tg = og / nx;
            if (og + 1u == (tg + 1u) * nx) xb_add(&bar[XB_TOPGEN], 1u);
            else XB_SPIN(xb_ld(&bar[XB_TOPGEN]) == tg, bar);
            __builtin_amdgcn_fence(__ATOMIC_ACQUIRE, "agent");
            xb_add(&bar[XB_XGEN(b.x)], 1u);
            asm volatile("s_waitcnt vmcnt(0)" ::: "memory");
        } else {
            XB_SPIN(xb_ld(&bar[XB_XGEN(b.x)]) == gen, bar);
            __builtin_amdgcn_fence(__ATOMIC_ACQUIRE, "agent");
            asm volatile("s_waitcnt vmcnt(0)" ::: "memory");
        }
    }
    __syncthreads();
}

__device__ __forceinline__ int lane_id() { int l; asm volatile("v_mbcnt_lo_u32_b32 %0, -1, 0\n\tv_mbcnt_hi_u32_b32 %0, -1, %0" : "=v"(l)); return l; }

constexpr int NB = 16, TT = 2048, DM = 1024, MR = NB * TT, NMETA = 16, MROWS = MR + 256, NPAN = MROWS / 256;
constexpr int PSEQ = 2112, NCH = 33;
constexpr int DIN = 2864, N1 = 3072;
constexpr int DFF = 2816, DFE = 3584, NEXP = 8;
constexpr float EPS = 1e-6f;
constexpr int C_AQ = 0, C_AK = 128, C_AV = 256, C_ALR = 512, C_AOG = 528, C_RQ = 784, C_RK = 1040, C_RV = 1296, C_ROG = 1552, C_CQ = 1808, C_CKV = 2000, C_KPE = 2064, C_DQ = 2096, C_DK = 2352, C_DV = 2608;
constexpr int MAXPAN = 264;
constexpr float LOG2E = 1.4426950408889634f;

constexpr size_t MiB = 1u << 20;
constexpr size_t WS_CTL = 0, CTL_BYTES = 1 * MiB;
constexpr size_t WS_TABR = 1 * MiB, WS_TABM = 1 * MiB + 576 * 1024;
constexpr size_t WS_RT = 2 * MiB;
constexpr size_t WS_WQA = 2 * MiB + 256 * 1024, WQA_BYTES = 384 * 192 * 2;
constexpr size_t WS_STA = 3 * MiB, WS_STB = 6 * MiB;
constexpr size_t WS_MOE = 9 * MiB;
constexpr size_t MO_ROWIDX = WS_MOE, MO_PDST = WS_MOE + 512 * 1024, MO_PINFO = WS_MOE + 1 * MiB, MO_TOKE = WS_MOE + 2 * MiB, MO_TOKP = MO_TOKE + 256 * 1024, MO_TOKW = MO_TOKE + 512 * 1024, MO_PEXP = WS_MOE + 3 * MiB;
constexpr size_t WS_GD = 13 * MiB;
constexpr size_t WS_W1T = 16 * MiB, W1T_BYTES = (size_t)N1 * DM * 2;
constexpr size_t WS_WOT = 29 * MiB, WOT_BYTES = (size_t)DM * DM * 2;
constexpr size_t WS_WGU = 33 * MiB;
constexpr size_t WS_WD = 44 * MiB;
constexpr size_t WS_HB = 50 * MiB;
constexpr size_t WS_BIG = 115 * MiB;
constexpr size_t B_PROJ = WS_BIG;
constexpr int GQ_T = 5120, GKT_T = 5120, RT_T = 9216, VT_T = 9216;
constexpr size_t B_GQ = WS_BIG + 210 * MiB, B_GK = WS_BIG + 221 * MiB, B_GV = WS_BIG + 232 * MiB;
constexpr size_t B_RQ = WS_BIG + 251 * MiB, B_RK = WS_BIG + 270 * MiB, B_RV = WS_BIG + 289 * MiB;
constexpr size_t B_MQ = WS_BIG + 308 * MiB, B_MK = WS_BIG + 333 * MiB;
constexpr size_t B_DQ = WS_BIG + 340 * MiB, B_DK = B_DQ + 16896 * 1024;
constexpr size_t O_DVT = 65 * MiB, O_MVT = 82 * MiB, O_GKT = 87 * MiB, O_RKT = 98 * MiB;
constexpr size_t B_ACT = WS_BIG;
constexpr size_t B_EGU = WS_BIG, EGU_BYTES = (size_t)2 * DFE * DM * 2;
constexpr size_t B_ED = WS_BIG + 112 * MiB, ED_BYTES = (size_t)DM * DFE * 2;
constexpr size_t B_EACT = WS_BIG + 168 * MiB;
constexpr size_t WS_NEED = WS_BIG + 392 * MiB;
constexpr int CW_BAR = 4096, CW_CNT = 8192;

constexpr int RING_BYTES = 131072, MISC_OFF = RING_BYTES + 320, LDS_BYTES = 147456;

__device__ __forceinline__ float silu_f(float x) { return x * __builtin_amdgcn_rcpf(1.0f + __builtin_amdgcn_exp2f(-x * LOG2E)); }
__device__ __forceinline__ v4u pack8(const f32x4 a, const f32x4 b) { v4u w; w.x = pg8::cvt_pk_bf16(a[0], a[1]); w.y = pg8::cvt_pk_bf16(a[2], a[3]); w.z = pg8::cvt_pk_bf16(b[0], b[1]); w.w = pg8::cvt_pk_bf16(b[2], b[3]); return w; }

__device__ __forceinline__ void rows_rstd16(const float* stats, int row0, int fq, float (&rs)[8]) {
    f32x4 v[8];
#pragma unroll
    for (int j = 0; j < 8; ++j) v[j] = *(const f32x4*)(stats + (size_t)(row0 + (j >> 2) * 128 + (j & 3) * 16) * 16 + 4 * fq);
#pragma unroll
    for (int j = 0; j < 8; ++j) { float s = (v[j][0] + v[j][1]) + (v[j][2] + v[j][3]); s += __shfl_xor(s, 16); s += __shfl_xor(s, 32); rs[j] = __builtin_amdgcn_rsqf(s * (1.0f / 1024.0f) + EPS); }
}
struct EpiProj {
    bf16* O; const float* stats;
    __device__ __forceinline__ void operator()(const f32x4 (&acc)[2][2][4][2], const pg8::Unit& u, int wr, int wc, int fr, int fq) const {
        const int col0 = u.pn * 256 + wc * 32 + 8 * fq, row0 = u.pm * 256 + wr * 64 + fr;
        float rs[8]; rows_rstd16(stats, row0, fq, rs);
#pragma unroll
        for (int ai = 0; ai < 2; ++ai)
#pragma unroll
            for (int m = 0; m < 4; ++m) { const int r = row0 + ai * 128 + m * 16; const float sc = rs[ai * 4 + m]; bf16* rowp = O + (size_t)r * N1 + col0;
#pragma unroll
                for (int bj = 0; bj < 2; ++bj) *(v4u*)(rowp + bj * 128) = pack8(acc[ai][bj][m][0] * sc, acc[ai][bj][m][1] * sc); }
    }
};
struct EpiSwiglu {
    bf16* O; int ldo; const float* stats;
    __device__ __forceinline__ void operator()(const f32x4 (&acc)[2][2][4][2], const pg8::Unit& u, int wr, int wc, int fr, int fq) const {
        const int col0 = u.pn * 128 + wc * 32 + 8 * fq, row0 = u.pm * 256 + wr * 64 + fr;
        float rs[8]; rows_rstd16(stats, row0, fq, rs);
#pragma unroll
        for (int ai = 0; ai < 2; ++ai)
#pragma unroll
            for (int m = 0; m < 4; ++m) { const int r = row0 + ai * 128 + m * 16; const float sc = rs[ai * 4 + m];
                f32x4 o[2];
#pragma unroll
                for (int n = 0; n < 2; ++n)
#pragma unroll
                    for (int i = 0; i < 4; ++i) o[n][i] = silu_f(acc[ai][0][m][n][i] * sc) * (acc[ai][1][m][n][i] * sc);
                *(v4u*)(O + (size_t)r * ldo + col0) = pack8(o[0], o[1]); }
    }
};
struct EpiResid {
    bf16* H; float* stats;
    __device__ __forceinline__ void operator()(const f32x4 (&acc)[2][2][4][2], const pg8::Unit& u, int wr, int wc, int fr, int fq) const {
        const int col0 = u.pn * 256 + wc * 32 + 8 * fq, row0 = u.pm * 256 + wr * 64 + fr;
#pragma unroll
        for (int ai = 0; ai < 2; ++ai) {
            v4u w[4][2];
#pragma unroll
            for (int m = 0; m < 4; ++m)
#pragma unroll
                for (int bj = 0; bj < 2; ++bj) w[m][bj] = *(const v4u*)(H + (size_t)(row0 + ai * 128 + m * 16) * DM + col0 + bj * 128);
            float ssm[4];
#pragma unroll
            for (int m = 0; m < 4; ++m) { bf16* rowp = H + (size_t)(row0 + ai * 128 + m * 16) * DM + col0; float ss = 0.f;
#pragma unroll
                for (int bj = 0; bj < 2; ++bj) { const v4u x = w[m][bj];
                    f32x4 a = acc[ai][bj][m][0], b = acc[ai][bj][m][1];
                    a[0] += bflo(x.x); a[1] += bfhi(x.x); a[2] += bflo(x.y); a[3] += bfhi(x.y); b[0] += bflo(x.z); b[1] += bfhi(x.z); b[2] += bflo(x.w); b[3] += bfhi(x.w);
                    ss += (a[0] * a[0] + a[1] * a[1]) + (a[2] * a[2] + a[3] * a[3]) + (b[0] * b[0] + b[1] * b[1]) + (b[2] * b[2] + b[3] * b[3]);
                    *(v4u*)(rowp + bj * 128) = pack8(a, b); }
                ss += __shfl_xor(ss, 16); ss += __shfl_xor(ss, 32); ssm[m] = ss; }
            if (fq == 0) {
#pragma unroll
                for (int m = 0; m < 4; ++m) stats[(size_t)(row0 + ai * 128 + m * 16) * 16 + u.pn * 4 + wc] = ssm[m]; } }
    }
};
struct EpiSwigluMoe {
    bf16* O; const f32x2* pinfo;
    __device__ __forceinline__ void operator()(const f32x4 (&acc)[2][2][4][2], const pg8::Unit& u, int wr, int wc, int fr, int fq) const {
        const int col0 = u.pn * 128 + wc * 32 + 8 * fq, rl0 = wr * 64 + fr;
        float rs[8];
#pragma unroll
        for (int j = 0; j < 8; ++j) rs[j] = pinfo[u.gp * 256 + rl0 + (j >> 2) * 128 + (j & 3) * 16][0];
#pragma unroll
        for (int ai = 0; ai < 2; ++ai)
#pragma unroll
            for (int m = 0; m < 4; ++m) { const int rl = rl0 + ai * 128 + m * 16; const float sc = rs[ai * 4 + m];
                f32x4 o[2];
#pragma unroll
                for (int n = 0; n < 2; ++n)
#pragma unroll
                    for (int i = 0; i < 4; ++i) o[n][i] = silu_f(acc[ai][0][m][n][i] * sc) * (acc[ai][1][m][n][i] * sc);
                *(v4u*)(O + (size_t)(u.pm * 256 + rl) * DFE + col0) = pack8(o[0], o[1]); }
    }
};
struct EpiMoeDown {
    unsigned char* Y; const int* pdst; const f32x2* pinfo;
    __device__ __forceinline__ void operator()(const f32x4 (&acc)[2][2][4][2], const pg8::Unit& u, int wr, int wc, int fr, int fq) const {
        const int col0 = u.pn * 256 + wc * 32 + 8 * fq, rl0 = wr * 64 + fr;
        int dst[8]; float wt[8];
#pragma unroll
        for (int j = 0; j < 8; ++j) { const int gi = u.gp * 256 + rl0 + (j >> 2) * 128 + (j & 3) * 16; dst[j] = pdst[gi]; wt[j] = pinfo[gi][1]; }
#pragma unroll
        for (int ai = 0; ai < 2; ++ai)
#pragma unroll
            for (int m = 0; m < 4; ++m) { const int d = dst[ai * 4 + m]; const float w = wt[ai * 4 + m];
                if (d >= 0) { bf16* rowp = (bf16*)(Y + (size_t)(d >> 1) * 4096 + (size_t)(d & 1) * 2048) + col0;
#pragma unroll
                    for (int bj = 0; bj < 2; ++bj) *(v4u*)(rowp + bj * 128) = pack8(acc[ai][bj][m][0] * w, acc[ai][bj][m][1] * w); } }
    }
};

__device__ __forceinline__ float wave_sum(float v) {
#pragma unroll
    for (int o = 1; o < 64; o <<= 1) v += __shfl_xor(v, o);
    return v;
}
__device__ __forceinline__ void transpose_item(const float* W, int K, int N, const float* gain, bf16* WT, int kb, int nb, int dmode, LAS float* scr_, int lane) {
    LAS unsigned* scr = (LAS unsigned*)scr_;
    const int k0 = 64 * kb, n0 = 64 * nb, n = n0 + 2 * (lane & 31), kh = lane >> 5;
    f32x2 v[32];
#pragma unroll
    for (int i = 0; i < 32; ++i) v[i] = (n < N) ? *(const f32x2*)(W + (size_t)(k0 + 2 * i + kh) * N + n) : (f32x2){0.f, 0.f};
    if (gain) {
#pragma unroll
        for (int i = 0; i < 32; ++i) v[i] = v[i] * gain[k0 + 2 * i + kh]; }
#pragma unroll
    for (int i = 0; i < 32; ++i) scr[(2 * i + kh) * 33 + (lane & 31)] = pk2(v[i][0], v[i][1]);
    LDS_WAIT(); asm volatile("" ::: "memory");
    const LAS bf16* T = (const LAS bf16*)scr;
    const int c = lane & 7;
    const int d0 = dmode == 0 ? n0 : 256 * (n0 >> 7) + (n0 & 127) + (dmode == 2 ? 128 : 0);
#pragma unroll
    for (int j = 0; j < 8; ++j) { const int nl = (lane >> 3) + 8 * j; unsigned x[8];
#pragma unroll
        for (int t = 0; t < 8; ++t) x[t] = T[(8 * c + t) * 66 + nl];
        v4u o; o.x = x[0] | (x[1] << 16); o.y = x[2] | (x[3] << 16); o.z = x[4] | (x[5] << 16); o.w = x[6] | (x[7] << 16);
        if (n0 + nl < N) *(v4u*)(WT + (size_t)(d0 + nl) * K + k0 + 8 * c) = o; }
    LDS_WAIT(); asm volatile("" ::: "memory");
}

struct Args { const float* in[24]; float* out; unsigned char* ws; int ph_lo, ph_hi; };
__device__ __forceinline__ const float* ain(const Args& a, int i) { return a.in[i]; }
enum { I_X = 0, I_META, I_ANORM, I_WIN, I_GWG, I_GBG, I_GNORM, I_RNORM, I_MQN, I_WUQ, I_MKVN, I_WUKV, I_DLAM, I_DNORM, I_WOUT, I_FNORM, I_FG, I_FU, I_FD, I_ROUTER, I_EG, I_EU, I_ED, I_FINAL };

#ifndef REP_FOLD
#define REP_FOLD 1
#endif
#ifndef REP_HINIT
#define REP_HINIT 1
#endif
__device__ __forceinline__ void wqa_unit(const Args& a, int li, int hh, LAS float* L, int tid) {
    const float* Wuq = ain(a, I_WUQ) + (size_t)li * 192 * 384; const float* Wukv = ain(a, I_WUKV) + (size_t)li * 64 * 512;
    const float* gq = ain(a, I_MQN) + li * 192; const float* gkv = ain(a, I_MKVN) + li * 64;
    bf16* WqaT = (bf16*)(a.ws + WS_WQA + li * WQA_BYTES);
    LAS float* Wqa = L; LAS float* Wuk = L + 192 * 97;
    __syncthreads();
    for (int idx = tid; idx < 64 * 64; idx += 512) { const int n = idx >> 6, m = idx & 63; Wuk[n * 65 + m] = Wukv[n * 512 + hh * 128 + m]; }
    __syncthreads();
    for (int pass = 0; pass < 3; ++pass) { const int i = pass * 64 + (tid >> 3), ng = tid & 7; f32x4 wq[16];
#pragma unroll
        for (int j = 0; j < 16; ++j) wq[j] = *(const f32x4*)(Wuq + i * 384 + hh * 96 + 4 * j);
        const float gi = gq[i];
#pragma unroll
        for (int t = 0; t < 8; ++t) { const int n = ng * 8 + t; float s = 0.f;
#pragma unroll
            for (int j = 0; j < 16; ++j) s += (wq[j][0] * Wuk[n * 65 + 4 * j] + wq[j][1] * Wuk[n * 65 + 4 * j + 1]) + (wq[j][2] * Wuk[n * 65 + 4 * j + 2] + wq[j][3] * Wuk[n * 65 + 4 * j + 3]);
            Wqa[i * 97 + n] = gi * gkv[n] * s; }
        if (ng < 4) {
#pragma unroll
            for (int j = 0; j < 2; ++j) { const f32x4 r = *(const f32x4*)(Wuq + i * 384 + hh * 96 + 64 + ng * 8 + 4 * j); LAS float* d = Wqa + i * 97 + 64 + ng * 8 + 4 * j; d[0] = gi * r[0]; d[1] = gi * r[1]; d[2] = gi * r[2]; d[3] = gi * r[3]; } } }
    __syncthreads();
    for (int idx = tid; idx < 96 * 24; idx += 512) { const int n = idx % 96, i8 = idx / 96; float v[8];
#pragma unroll
        for (int t = 0; t < 8; ++t) v[t] = Wqa[(8 * i8 + t) * 97 + n];
        v4u w; w.x = pk2(v[0], v[1]); w.y = pk2(v[2], v[3]); w.z = pk2(v[4], v[5]); w.w = pk2(v[6], v[7]);
        *(v4u*)(WqaT + (size_t)(hh * 96 + n) * 192 + 8 * i8) = w; }
    __syncthreads();
}
__device__ __forceinline__ void wofold_unit(const Args& a, int li, int hh, int nq, LAS float* L, int tid) {
    const float* Wukv = ain(a, I_WUKV) + (size_t)li * 64 * 512; const float* gkv = ain(a, I_MKVN) + li * 64; const float* Wo = ain(a, I_WOUT) + (size_t)li * DM * DM;
    bf16* Wot = (bf16*)(a.ws + WS_WOT + li * WOT_BYTES);
    LAS float* WuvT = L; LAS float* Wos = L + 64 * 64;
    __syncthreads();
    for (int idx = tid; idx < 64 * 64; idx += 512) { const int j = idx >> 6, e = idx & 63; WuvT[e * 64 + j] = Wukv[j * 512 + hh * 128 + 64 + e] * gkv[j]; }
    for (int idx = tid; idx < 64 * 64; idx += 512) { const int e = idx >> 6, n4 = idx & 63; *(LAS f32x4*)(Wos + e * 256 + 4 * n4) = *(const f32x4*)(Wo + (size_t)(512 + 64 * hh + e) * DM + nq * 256 + 4 * n4); }
    __syncthreads();
    { const int n4 = tid & 63, j8 = tid >> 6; f32x4 acc[8];
#pragma unroll
        for (int j = 0; j < 8; ++j) acc[j] = (f32x4){0.f, 0.f, 0.f, 0.f};
#pragma unroll 4
        for (int e = 0; e < 64; ++e) { const f32x4 wv = *(const LAS f32x4*)(Wos + e * 256 + 4 * n4); const f32x4 u0 = *(const LAS f32x4*)(WuvT + e * 64 + 8 * j8), u1 = *(const LAS f32x4*)(WuvT + e * 64 + 8 * j8 + 4);
#pragma unroll
            for (int j = 0; j < 4; ++j) { acc[j] += wv * u0[j]; acc[4 + j] += wv * u1[j]; } }
#pragma unroll
        for (int t = 0; t < 4; ++t) { v4u w; w.x = pk2(acc[0][t], acc[1][t]); w.y = pk2(acc[2][t], acc[3][t]); w.z = pk2(acc[4][t], acc[5][t]); w.w = pk2(acc[6][t], acc[7][t]);
            *(v4u*)(Wot + (size_t)(nq * 256 + 4 * n4 + t) * DM + 512 + 64 * hh + 8 * j8) = w; } }
    __syncthreads();
}
__device__ __forceinline__ void p0_prologue(const Args& a, LAS unsigned char* lds, int tid, int lane, int wave) {
    const int G = gridDim.x;
    for (int rep = 0; rep < REP_FOLD; ++rep)
    for (int un = blockIdx.x; un < 40; un += G) {
        if (un < 8) wqa_unit(a, un >> 2, un & 3, (LAS float*)lds, tid);
        else { const int v = un - 8; wofold_unit(a, v >> 4, (v >> 2) & 3, v & 3, (LAS float*)lds, tid); }
    }
    __syncthreads();
    LAS float* scr = (LAS float*)(lds + wave * 16384);
    const int gw = blockIdx.x * 8 + wave, NGW = G * 8;
    constexpr int I_IN = 16 * 45, I_WO = 12 * 16, I_G = 16 * 44, I_D = 44 * 16;
    constexpr int NIT = 2 * I_IN + 2 * I_WO + 2 * I_G + I_D;
    for (int it = gw; it < NIT; it += NGW) {
        int r = it;
        if (r < 2 * I_IN) { const int li = r / I_IN; r %= I_IN; transpose_item(ain(a, I_WIN) + (size_t)li * DM * DIN, DM, DIN, ain(a, I_ANORM) + li * DM, (bf16*)(a.ws + WS_W1T + li * W1T_BYTES), r / 45, r % 45, 0, scr, lane); continue; } r -= 2 * I_IN;
        if (r < 2 * I_WO) { const int li = r / I_WO; r %= I_WO; int kb = r / 16; if (kb >= 8) kb += 4; transpose_item(ain(a, I_WOUT) + (size_t)li * DM * DM, DM, DM, nullptr, (bf16*)(a.ws + WS_WOT + li * WOT_BYTES), kb, r % 16, 0, scr, lane); continue; } r -= 2 * I_WO;
        if (r < I_G) { transpose_item(ain(a, I_FG), DM, DFF, ain(a, I_FNORM), (bf16*)(a.ws + WS_WGU), r / 44, r % 44, 1, scr, lane); continue; } r -= I_G;
        if (r < I_G) { transpose_item(ain(a, I_FU), DM, DFF, ain(a, I_FNORM), (bf16*)(a.ws + WS_WGU), r / 44, r % 44, 2, scr, lane); continue; } r -= I_G;
        transpose_item(ain(a, I_FD), DFF, DM, nullptr, (bf16*)(a.ws + WS_WD), r / 16, r % 16, 0, scr, lane);
    }
    const int gt = blockIdx.x * 512 + tid, NGT = G * 512;
    for (int i = gt; i < 2 * 208 * 128; i += NGT) { const int li = i / (208 * 128), r = i % (208 * 128);
        *(v4u*)(a.ws + WS_W1T + li * W1T_BYTES + (size_t)DIN * DM * 2 + (size_t)r * 16) = (v4u){0u, 0u, 0u, 0u}; }
    for (int i = gt; i < 8 * DM; i += NGT) { const int e = i >> 10, k = i & 1023; ((float*)(a.ws + WS_RT))[i] = ain(a, I_FNORM)[DM + k] * ain(a, I_ROUTER)[k * 8 + e]; }
    for (int i = gt; i < PSEQ * 48; i += NGT) { const int p = i / 48, j = i % 48; const bool isR = j < 32; const int f = isR ? j : j - 32;
        const float inv = __builtin_amdgcn_exp2f(-(float)f * (isR ? 13.287712379549449f / 32.f : 13.287712379549449f / 16.f));
        const double rev = (double)(p - 48) * (double)inv * 0.15915494309189535; const float fr = (float)(rev - __builtin_rint(rev));
        const f32x2 cs = {__builtin_amdgcn_cosf(fr), __builtin_amdgcn_sinf(fr)};
        if (isR) ((f32x2*)(a.ws + WS_TABR))[p * 32 + f] = cs; else ((f32x2*)(a.ws + WS_TABM))[p * 16 + f] = cs; }
    for (int i = gt; i < 240 * 128; i += NGT) *(v4u*)((unsigned char*)a.out + (size_t)(MR + 16) * 2048 + (size_t)i * 16) = (v4u){0u, 0u, 0u, 0u};
    bf16* hb = (bf16*)(a.ws + WS_HB); float* stA = (float*)(a.ws + WS_STA);
    for (int rep = 0; rep < REP_HINIT; ++rep)
    for (int r = gw; r < MROWS; r += NGW) {
        f32x4 v[4]; float s = 0.f;
#pragma unroll
        for (int j = 0; j < 4; ++j) { if (r < MR) v[j] = ((const f32x4*)(ain(a, I_X) + (size_t)r * DM))[lane + 64 * j]; else if (r < MR + NMETA) v[j] = ((const f32x4*)(ain(a, I_META) + (size_t)(r - MR) * DM))[lane + 64 * j]; else v[j] = (f32x4){0.f, 0.f, 0.f, 0.f};
            s += (v[j][0] * v[j][0] + v[j][1] * v[j][1]) + (v[j][2] * v[j][2] + v[j][3] * v[j][3]); }
        s = wave_sum(s);
#pragma unroll
        for (int j = 0; j < 4; ++j) { v2u w; w.x = pk2(v[j][0], v[j][1]); w.y = pk2(v[j][2], v[j][3]); ((v2u*)(hb + (size_t)r * DM))[lane + 64 * j] = w; }
        if (lane < 16) stA[(size_t)r * 16 + lane] = lane == 0 ? s : 0.f;
    }
}

__device__ __forceinline__ int src_row(int b, int c, int i) { return c == 0 ? (i < 48 ? -1 : MR + i - 48) : b * TT + 64 * (c - 1) + i; }
__device__ __forceinline__ float lg2gamma(int h) { return h == 0 ? -0.045803689613124789f : h == 1 ? -0.022720076500083529f : h == 2 ? -0.011315313227834146f : -0.0056465631411420627f; }

__device__ __forceinline__ void route_block(const Args& a, int blk, LAS unsigned char* lds, int tid, int lane, int wave) {
    LAS float* Rs = (LAS float*)lds; LAS int* lcnt = (LAS int*)(lds + 32768); LAS int* gbase = lcnt + 8; LAS int* rec = lcnt + 16;
    gu32* ctl = (gu32*)(a.ws + WS_CTL);
    const float* Rt = (const float*)(a.ws + WS_RT); const bf16* hb = (const bf16*)(a.ws + WS_HB); const float* stB = (const float*)(a.ws + WS_STB);
    __syncthreads();
    for (int idx = tid; idx < 8 * DM; idx += 512) Rs[idx] = Rt[idx];
    if (tid < 8) lcnt[tid] = 0;
    __syncthreads();
    for (int rr = 0; rr < 16; ++rr) { const int rl = wave * 16 + rr, row = blk * 128 + rl;
        const v4u w0 = *(const v4u*)(hb + (size_t)row * DM + 8 * lane), w1 = *(const v4u*)(hb + (size_t)row * DM + 512 + 8 * lane);
        const float x[16] = {bflo(w0.x), bfhi(w0.x), bflo(w0.y), bfhi(w0.y), bflo(w0.z), bfhi(w0.z), bflo(w0.w), bfhi(w0.w), bflo(w1.x), bfhi(w1.x), bflo(w1.y), bfhi(w1.y), bflo(w1.z), bfhi(w1.z), bflo(w1.w), bfhi(w1.w)};
        float st = lane < 16 ? stB[(size_t)row * 16 + lane] : 0.f; st = wave_sum(st); const float rs = __builtin_amdgcn_rsqf(st * (1.f / 1024.f) + EPS);
        float lg[8];
#pragma unroll
        for (int e = 0; e < 8; ++e) { float s = 0.f;
#pragma unroll
            for (int t = 0; t < 8; ++t) s += x[t] * Rs[e * DM + 8 * lane + t] + x[8 + t] * Rs[e * DM + 512 + 8 * lane + t];
            lg[e] = wave_sum(s) * rs; }
        int e0 = 0; float v0 = lg[0];
#pragma unroll
        for (int e = 1; e < 8; ++e) if (lg[e] > v0) { v0 = lg[e]; e0 = e; }
        int e1 = -1; float v1 = -3.0e38f;
#pragma unroll
        for (int e = 0; e < 8; ++e) if (e != e0 && lg[e] > v1) { v1 = lg[e]; e1 = e; }
        const float g0 = 1.f / (1.f + __expf(v1 - v0)), g1 = 1.f - g0;
        if (lane == 0) { const int lp0 = atomicAdd((int*)(lcnt + e0), 1), lp1 = atomicAdd((int*)(lcnt + e1), 1);
            rec[rl * 6] = e0; rec[rl * 6 + 1] = e1; rec[rl * 6 + 2] = lp0; rec[rl * 6 + 3] = lp1; rec[rl * 6 + 4] = __float_as_int(g0); rec[rl * 6 + 5] = __float_as_int(g1); } }
    __syncthreads();
    if (tid < 8) gbase[tid] = (int)__hip_atomic_fetch_add(ctl + CW_CNT + 64 * tid, (unsigned)lcnt[tid], RLX_AGENT);
    __syncthreads();
    if (tid < 256) { const int rl = tid >> 1, s = tid & 1, tok = blk * 128 + rl, e = rec[rl * 6 + s];
        ((int*)(a.ws + MO_TOKE))[tok * 2 + s] = e; ((int*)(a.ws + MO_TOKP))[tok * 2 + s] = gbase[e] + rec[rl * 6 + 2 + s]; ((int*)(a.ws + MO_TOKW))[tok * 2 + s] = rec[rl * 6 + 4 + s]; }
    __syncthreads();
}
__device__ __forceinline__ void moe_offsets(const Args& a, LAS int* offs, int tid) {
    gu32* ctl = (gu32*)(a.ws + WS_CTL);
    __syncthreads();
    if (tid == 0) { int o = 0;
        for (int e = 0; e < 8; ++e) { const int cnt = (int)__hip_atomic_load(ctl + CW_CNT + 64 * e, RLX_AGENT); offs[e] = o * 256; o += (cnt + 255) >> 8; }
        offs[8] = o; }
    __syncthreads();
}

typedef float f32x16 __attribute__((ext_vector_type(16)));
typedef short s16x8 __attribute__((ext_vector_type(8)));
typedef short s16x4 __attribute__((ext_vector_type(4)));
typedef short v4i16_t __attribute__((ext_vector_type(4)));
__device__ __forceinline__ int crow(int r, int hi) { return (r & 3) + 8 * (r >> 2) + 4 * hi; }


__device__ __forceinline__ void stage_cols(const bf16* proj, int b, int c, int col0, int ncols, LAS bf16* S, int sst, int lcol0, int tid) {
    const int cpr = ncols >> 3;
    for (int idx = tid; idx < 64 * cpr; idx += 512) { const int i = idx / cpr, ch = idx - i * cpr, sr = src_row(b, c, i);
        v4u v = {0u, 0u, 0u, 0u}; if (sr >= 0) v = *(const v4u*)(proj + (size_t)sr * N1 + col0 + ch * 8);
        *(LAS v4u*)(S + i * sst + lcol0 + ch * 8) = v; }
}
__device__ __forceinline__ v4u gather8(const LAS bf16* S, int sst, int row0, int col) {
    unsigned x[8];
#pragma unroll
    for (int t = 0; t < 8; ++t) x[t] = S[(row0 + t) * sst + col];
    v4u w; w.x = x[0] | (x[1] << 16); w.y = x[2] | (x[3] << 16); w.z = x[4] | (x[5] << 16); w.w = x[6] | (x[7] << 16); return w;
}
__device__ __forceinline__ void prep2_unit(const Args& a, int li, int b, int c, int part, LAS unsigned char* lds, int tid) {
    const bf16* proj = (const bf16*)(a.ws + B_PROJ);
    LAS bf16* S = (LAS bf16*)lds;
    const int blk0 = (b * NCH + c) * 4; const size_t prow0 = (size_t)b * PSEQ + 64 * c;
    unsigned char* dout = (unsigned char*)a.out;
    __syncthreads();
    if (part == 0) {
        constexpr int SST = 536; LAS float* seg = (LAS float*)(lds + 64 * SST * 2);
        stage_cols(proj, b, c, C_AQ, 128, S, SST, 0, tid); stage_cols(proj, b, c, C_AK, 128, S, SST, 128, tid); stage_cols(proj, b, c, C_ALR, 16, S, SST, 512, tid);
        __syncthreads();
        { const int ch = tid & 127, sg = tid >> 7; const float* Wg = ain(a, I_GWG) + (size_t)li * 16 * 128; const float bg = ain(a, I_GBG)[li * 128 + ch];
            float wg[16];
#pragma unroll
            for (int r = 0; r < 16; ++r) wg[r] = Wg[r * 128 + ch];
            float cl[16]; float run = 0.f;
#pragma unroll
            for (int t = 0; t < 16; ++t) { const int i = 16 * sg + t; const v4u l0 = *(const LAS v4u*)(S + i * SST + 512), l1 = *(const LAS v4u*)(S + i * SST + 520);
                float x = bg + bflo(l0.x) * wg[0] + bfhi(l0.x) * wg[1] + bflo(l0.y) * wg[2] + bfhi(l0.y) * wg[3] + bflo(l0.z) * wg[4] + bfhi(l0.z) * wg[5] + bflo(l0.w) * wg[6] + bfhi(l0.w) * wg[7]
                               + bflo(l1.x) * wg[8] + bfhi(l1.x) * wg[9] + bflo(l1.y) * wg[10] + bfhi(l1.y) * wg[11] + bflo(l1.z) * wg[12] + bfhi(l1.z) * wg[13] + bflo(l1.w) * wg[14] + bfhi(l1.w) * wg[15];
                const float ls = fminf(x, 0.f) - __logf(1.f + __expf(-fabsf(x)));
                run += (c > 0 || i >= 48) ? ls * (1.f / 16.f) : 0.f; cl[t] = run; }
            seg[sg * 128 + ch] = run;
            __syncthreads();
            float off = 0.f;
#pragma unroll
            for (int s2 = 0; s2 < 3; ++s2) off += s2 < sg ? seg[s2 * 128 + ch] : 0.f;
            if (sg == 3) ((float*)(a.ws + WS_GD))[(size_t)(blk0 + (ch >> 5)) * 32 + (ch & 31)] = __expf(off + run);
#pragma unroll
            for (int t = 0; t < 16; ++t) { const int i = 16 * sg + t; const float cum = cl[t] + off;
                S[i * SST + ch] = (bf16)f2bf(bf2f(S[i * SST + ch]) * 0.17677669529663687f * __expf(cum)); S[i * SST + 128 + ch] = (bf16)f2bf(bf2f(S[i * SST + 128 + ch]) * __expf(-cum)); } }
        __syncthreads();
        for (int idx = tid; idx < 1024; idx += 512) { const int d8 = idx & 3, i = (idx >> 2) & 63, h = idx >> 8;
            *(v4u*)(a.ws + B_GQ + (size_t)(blk0 + h) * GQ_T + i * 80 + 16 * d8) = *(const LAS v4u*)(S + i * SST + h * 32 + 8 * d8);
            *(v4u*)(a.ws + B_GK + (size_t)(blk0 + h) * GQ_T + i * 80 + 16 * d8) = *(const LAS v4u*)(S + i * SST + 128 + h * 32 + 8 * d8); }
    } else if (part == 1) {
        constexpr int SST = 776;
        stage_cols(proj, b, c, C_RQ, 256, S, SST, 0, tid); stage_cols(proj, b, c, C_RK, 256, S, SST, 256, tid);
        LAS f32x4* tabL = (LAS f32x4*)(lds + 64 * SST * 2);
        for (int idx = tid; idx < 64 * 16; idx += 512) tabL[idx] = ((const f32x4*)(a.ws + WS_TABR))[(size_t)(64 * c) * 16 + idx];
        __syncthreads();
        const LAS f32x2* tabR = (const LAS f32x2*)tabL;
        for (int idx = tid; idx < 64 * 4 * 32; idx += 512) { const int j = idx & 31, h = (idx >> 5) & 3, i = idx >> 7; const f32x2 cs = tabR[i * 32 + j];
            LAS bf16* qp = S + i * SST + h * 64 + j; LAS bf16* kp = qp + 256;
            const float a1 = bf2f(qp[0]), a2 = bf2f(qp[32]), b1 = bf2f(kp[0]), b2 = bf2f(kp[32]);
            const float e = (float)(i + 1) * lg2gamma(h); const float fq = __builtin_amdgcn_exp2f(e), fk = 0.125f * __builtin_amdgcn_exp2f(-e);
            qp[0] = (bf16)f2bf((a1 * cs[0] - a2 * cs[1]) * fq); qp[32] = (bf16)f2bf((a1 * cs[1] + a2 * cs[0]) * fq); kp[0] = (bf16)f2bf((b1 * cs[0] - b2 * cs[1]) * fk); kp[32] = (bf16)f2bf((b1 * cs[1] + b2 * cs[0]) * fk); }
        __syncthreads();
        for (int idx = tid; idx < 2048; idx += 512) { const int d8 = idx & 7, i = (idx >> 3) & 63, h = idx >> 9;
            *(v4u*)(a.ws + B_RQ + (size_t)(blk0 + h) * RT_T + i * 144 + 16 * d8) = *(const LAS v4u*)(S + i * SST + h * 64 + 8 * d8);
            *(v4u*)(a.ws + B_RK + (size_t)(blk0 + h) * RT_T + i * 144 + 16 * d8) = *(const LAS v4u*)(S + i * SST + 256 + h * 64 + 8 * d8); }
    } else if (part == 2) {
        constexpr int SST = 296, OFF_RSD = 64 * SST * 2, OFF_TAB = OFF_RSD + 512, OFF_QS = OFF_TAB + 8192, QSS = 392;
        LAS float* rsd = (LAS float*)(lds + OFF_RSD); LAS f32x4* tabL = (LAS f32x4*)(lds + OFF_TAB); LAS bf16* Qs = (LAS bf16*)(lds + OFF_QS);
        stage_cols(proj, b, c, C_CQ, 192, S, SST, 0, tid); stage_cols(proj, b, c, C_CKV, 64, S, SST, 192, tid); stage_cols(proj, b, c, C_KPE, 32, S, SST, 256, tid);
        for (int idx = tid; idx < 64 * 8; idx += 512) tabL[idx] = ((const f32x4*)(a.ws + WS_TABM))[(size_t)(64 * c) * 8 + idx];
        __syncthreads();
        { const int i = tid >> 3, g = tid & 7; float sq = 0.f, sk = 0.f;
#pragma unroll
            for (int t = 0; t < 24; ++t) { const float v = bf2f(S[i * SST + g * 24 + t]); sq += v * v; }
#pragma unroll
            for (int t = 0; t < 8; ++t) { const float v = bf2f(S[i * SST + 192 + g * 8 + t]); sk += v * v; }
            sq += __shfl_xor(sq, 1); sq += __shfl_xor(sq, 2); sq += __shfl_xor(sq, 4); sk += __shfl_xor(sk, 1); sk += __shfl_xor(sk, 2); sk += __shfl_xor(sk, 4);
            if (g == 0) { rsd[i * 2] = __builtin_amdgcn_rsqf(sq * (1.f / 192.f) + EPS); rsd[i * 2 + 1] = __builtin_amdgcn_rsqf(sk * (1.f / 64.f) + EPS); } }
        __syncthreads();
        const LAS f32x2* tabM = (const LAS f32x2*)tabL; const float QS = 0.10206207261596577f * LOG2E;
        {
            const int lane = tid & 63, w = __builtin_amdgcn_readfirstlane(tid >> 6), r32 = lane & 31, hi = lane >> 5, ib = w & 1, nb0 = (w >> 1) * 3;
            const bf16* WqaT = (const bf16*)(a.ws + WS_WQA + li * WQA_BYTES);
            s16x8 af[12];
#pragma unroll
            for (int ks = 0; ks < 12; ++ks) af[ks] = *(const LAS s16x8*)(S + (32 * ib + r32) * SST + 16 * ks + 8 * hi);
            f32x16 acc[3];
#pragma unroll
            for (int j = 0; j < 3; ++j) { acc[j] = (f32x16){};
                s16x8 bfr[12];
#pragma unroll
                for (int ks = 0; ks < 12; ++ks) bfr[ks] = *(const s16x8*)(WqaT + (size_t)(32 * (nb0 + j) + r32) * 192 + 16 * ks + 8 * hi);
#pragma unroll
                for (int ks = 0; ks < 12; ++ks) acc[j] = __builtin_amdgcn_mfma_f32_32x32x16_bf16(af[ks], bfr[ks], acc[j], 0, 0, 0); }
            asm volatile("s_nop 15\n\ts_nop 7" : "+v"(acc[0]), "+v"(acc[1]), "+v"(acc[2]));
#pragma unroll
            for (int j = 0; j < 3; ++j)
#pragma unroll
                for (int r = 0; r < 16; ++r) { const int i = 32 * ib + crow(r, hi); float v = acc[j][r] * (rsd[i * 2] * QS);
                    if (j == 2) { const float o = __shfl_xor(v, 16); const f32x2 cs = tabM[i * 16 + (r32 & 15)]; v = r32 < 16 ? v * cs[0] - o * cs[1] : o * cs[1] + v * cs[0]; }
                    Qs[i * QSS + 32 * (nb0 + j) + r32] = (bf16)f2bf(v); } }
        for (int idx = tid; idx < 64 * 12; idx += 512) { const int k8 = idx % 12, i = idx / 12; float y[8];
            if (k8 < 8) { const float s = rsd[i * 2 + 1];
#pragma unroll
                for (int t = 0; t < 8; ++t) y[t] = bf2f(S[i * SST + 192 + 8 * k8 + t]) * s; }
            else { const int kk = (k8 - 8) & 1, second = (k8 - 8) >> 1;
#pragma unroll
                for (int t = 0; t < 8; ++t) { const int j = 8 * kk + t; const f32x2 cs = tabM[i * 16 + j]; const float x1 = bf2f(S[i * SST + 256 + j]), x2 = bf2f(S[i * SST + 272 + j]); y[t] = second ? x1 * cs[1] + x2 * cs[0] : x1 * cs[0] - x2 * cs[1]; } }
            v4u w; w.x = pk2(y[0], y[1]); w.y = pk2(y[2], y[3]); w.z = pk2(y[4], y[5]); w.w = pk2(y[6], y[7]);
            *(v4u*)((bf16*)(a.ws + B_MK) + (prow0 + i) * 96 + 8 * k8) = w; }
        __syncthreads();
        for (int idx = tid; idx < 64 * 48; idx += 512) { const int c8 = idx % 48, i = idx / 48;
            *(v4u*)((bf16*)(a.ws + B_MQ) + (prow0 + i) * 384 + 8 * c8) = *(const LAS v4u*)(Qs + i * QSS + 8 * c8); }
    }
}

template <int KIND>
__device__ __forceinline__ void attn_mfma_unit(const Args& a, int li, int b, int hh, int qb  , LAS unsigned char* lds, int tid, float lam, float oscale) {
    constexpr int KW = KIND ? 64 : 96, KST = KW + 8, VST = 72, NMAP = KIND ? 2 : 1, DSTEPS = KIND ? 2 : 6;
    constexpr int KCH = KW / 8 + 1, NPIECE = KCH + (KIND ? 9 : 0), PPW = KIND ? 3 : 2, SLOT = NPIECE * 1024, NSLOT = 4, OFF_JUNK = NSLOT * SLOT, OFF_WS = OFF_JUNK + 6144, OSTW = 68, OFF_OST = KIND ? 0   : OFF_WS + 2048;
    static_assert(PPW * 8 >= NPIECE && PPW * 8 - NPIECE <= 6 && (KIND ? 8 * 32 * OSTW * 4 <= NSLOT * SLOT : OFF_OST + 8 * 32 * OSTW * 4 <= RING_BYTES) && OFF_WS + 8 * 256 <= RING_BYTES, "attention LDS map / pieces per wave");
    const int lane = tid & 63, w = __builtin_amdgcn_readfirstlane(tid >> 6), r32 = lane & 31, hi = lane >> 5;
    const int q0 = qb < 0 ? 0 : 64 + 256 * qb, NT = qb < 0 ? 1 : 5 + 4 * qb;
    const bool wact = qb >= 0 || w < 2;
    const int qpos = q0 + 32 * w + r32, wlast = (q0 + 32 * w + 31) >> 6;
    const size_t prow = (size_t)b * PSEQ + qpos;
    const bf16* proj = (const bf16*)(a.ws + B_PROJ);
    const bf16* Kg = KIND ? proj + C_DK + hh * 64 : (const bf16*)(a.ws + B_MK) + (size_t)b * PSEQ * 96;
    constexpr int KLD = KIND ? N1 : 96;
    const bf16* Vg = proj + C_DV + hh * 64;
#define ATT_SRCROW(t_, r_) (KIND ? ((t_) == 0 ? ((r_) < 48 ? MR : MR + (r_) - 48) : b * TT + 64 * ((t_) - 1) + (r_)) : 64 * (t_) + (r_))
    LAS float* wsf = (LAS float*)(lds + OFF_WS) + w * 64;
    LAS float* ost = (LAS float*)(lds + OFF_OST) + w * (32 * OSTW);
    s16x8 qf[NMAP][DSTEPS];
#pragma unroll
    for (int m = 0; m < NMAP; ++m)
#pragma unroll
        for (int ds = 0; ds < DSTEPS; ++ds) {
            const int qsr = qb >= 0 ? b * TT + qpos - 64 : (qpos >= 48 ? MR + qpos - 48 : MR);
            const bf16* qp = KIND ? proj + (size_t)qsr * N1 + C_DQ + hh * 64 + 32 * m + 16 * ds + 8 * hi : (const bf16*)(a.ws + B_MQ) + prow * 384 + hh * 96 + 16 * ds + 8 * hi;
            v4u qw = wact ? *(const v4u*)qp : (v4u){0u, 0u, 0u, 0u};
            if (KIND) { const float qs = 0.17677669529663687f * LOG2E;
                qw.x = pg8::cvt_pk_bf16(bflo(qw.x) * qs, bfhi(qw.x) * qs); qw.y = pg8::cvt_pk_bf16(bflo(qw.y) * qs, bfhi(qw.y) * qs); qw.z = pg8::cvt_pk_bf16(bflo(qw.z) * qs, bfhi(qw.z) * qs); qw.w = pg8::cvt_pk_bf16(bflo(qw.w) * qs, bfhi(qw.w) * qs); }
            qf[m][ds] = __builtin_bit_cast(s16x8, qw); }
    float mref[NMAP], lrun[NMAP]; f32x16 negm = (f32x16){}, o[NMAP][2];
#pragma unroll
    for (int m = 0; m < NMAP; ++m) { mref[m] = 0.f; lrun[m] = 0.f; o[m][0] = (f32x16){}; o[m][1] = (f32x16){}; }
#define ATT_DMA(t_) do { const int sl_ = ((t_) & 3) * SLOT; _Pragma("unroll") for (int j = 0; j < PPW; ++j) { const int p_ = __builtin_amdgcn_readfirstlane(w * PPW + j); \
        int row_, col_, dst_; const bf16* base_; int ld_; \
        if (p_ < KCH) { const int g = 64 * p_ + lane, cc = g % KCH; row_ = g / KCH; col_ = (cc < KCH - 1 ? cc : KCH - 2) * 8; dst_ = sl_ + p_ * 1024; base_ = Kg; ld_ = KLD; } \
        else if (p_ < NPIECE) { const int g = 64 * (p_ - KCH) + lane, cc = g % 9; row_ = g / 9; col_ = (cc < 8 ? cc : 7) * 8; dst_ = sl_ + p_ * 1024; base_ = Vg; ld_ = N1; } \
        else { row_ = lane & 15; col_ = 0; dst_ = OFF_JUNK + (p_ - NPIECE) * 1024; base_ = Kg; ld_ = KLD; } \
        const bf16* s_ = base_ + (size_t)ATT_SRCROW((t_), row_) * ld_ + col_; \
        __builtin_amdgcn_global_load_lds((const unsigned*)s_, (LAS unsigned*)(lds + __builtin_amdgcn_readfirstlane(dst_)), 16, 0, 0); } } while (0)
#define ATT_BAR() do { asm volatile("s_waitcnt lgkmcnt(0)" ::: "memory"); __builtin_amdgcn_s_barrier(); asm volatile("" ::: "memory"); } while (0)
    ATT_BAR();
    ATT_DMA(0); if (NT > 1) ATT_DMA(1); if (NT > 2) ATT_DMA(2);
    for (int t = 0; t < NT; ++t) {
        if (t + 2 < NT) { if (KIND) asm volatile("s_waitcnt vmcnt(6)" ::: "memory"); else asm volatile("s_waitcnt vmcnt(4)" ::: "memory"); } else if (t + 1 < NT) { if (KIND) asm volatile("s_waitcnt vmcnt(3)" ::: "memory"); else asm volatile("s_waitcnt vmcnt(2)" ::: "memory"); } else asm volatile("s_waitcnt vmcnt(0)" ::: "memory");
        ATT_BAR();
        if (t + 3 < NT) ATT_DMA(t + 3);
        if (wact && t <= wlast) {
            const LAS unsigned char* Kb = lds + (t & 3) * SLOT; const LAS unsigned char* Vb = KIND ? Kb + KCH * 1024 : Kb;
            const bool need_mask = (t == 0) || (64 * t + 63 > q0 + 32 * w);
            constexpr int VRB = KIND ? 144 : KST * 2;
            const LAS unsigned char* vp0 = Vb + (4 * hi + ((lane & 15) >> 2)) * VRB + (16 * ((lane >> 4) & 1)) * 2 + 8 * (lane & 3);
#define ATT_VFRAG(d0_, ks_) ({ const LAS unsigned char* vp_ = vp0 + 16 * (ks_) * VRB + 64 * (d0_); \
        const s16x4 va_ = __builtin_bit_cast(s16x4, __builtin_amdgcn_ds_read_tr16_b64_v4i16((LAS v4i16_t*)vp_)), vb_ = __builtin_bit_cast(s16x4, __builtin_amdgcn_ds_read_tr16_b64_v4i16((LAS v4i16_t*)(vp_ + 8 * VRB))); \
        (s16x8){va_[0], va_[1], va_[2], va_[3], vb_[0], vb_[1], vb_[2], vb_[3]}; })
            s16x8 vfr0[4];
#pragma unroll
            for (int ks = 0; ks < 4; ++ks) vfr0[ks] = ATT_VFRAG(0, ks);
            __builtin_amdgcn_sched_barrier(0);
#pragma unroll
            for (int m = 0; m < NMAP; ++m) {
                f32x16 p0, p1;
                if (KIND) { const float nm = -mref[m];
#pragma unroll
                    for (int r = 0; r < 16; ++r) { p0[r] = nm; p1[r] = nm; } }
                else { p0 = negm; p1 = negm; }
                constexpr int KBATCH = KIND ? DSTEPS : 3;
#pragma unroll
                for (int d1 = 0; d1 < DSTEPS; d1 += KBATCH) {
                    s16x8 kfr[KBATCH][2];
#pragma unroll
                    for (int ds = 0; ds < KBATCH; ++ds) { kfr[ds][0] = *(const LAS s16x8*)(Kb + (r32 * KST + 32 * m * KIND + 16 * (d1 + ds) + 8 * hi) * 2); kfr[ds][1] = *(const LAS s16x8*)(Kb + ((32 + r32) * KST + 32 * m * KIND + 16 * (d1 + ds) + 8 * hi) * 2); }
                    __builtin_amdgcn_sched_barrier(0);
                    __builtin_amdgcn_s_setprio(1);
#pragma unroll
                    for (int ds = 0; ds < KBATCH; ++ds) { p0 = __builtin_amdgcn_mfma_f32_32x32x16_bf16(kfr[ds][0], qf[m][d1 + ds], p0, 0, 0, 0); p1 = __builtin_amdgcn_mfma_f32_32x32x16_bf16(kfr[ds][1], qf[m][d1 + ds], p1, 0, 0, 0); }
                    __builtin_amdgcn_s_setprio(0);
                    __builtin_amdgcn_sched_barrier(0); }
                asm volatile("s_nop 15\n\ts_nop 7" : "+v"(p0), "+v"(p1));
                __builtin_amdgcn_s_setprio(0);
                if (need_mask) {
#pragma unroll
                    for (int r = 0; r < 16; ++r) { const int kv = 64 * t + crow(r, hi);
                        if (kv > qpos || kv < 48) p0[r] = -1e30f;
                        if (kv + 32 > qpos || kv + 32 < 48) p1[r] = -1e30f; } }
                float mx = fmaxf(fmaxf(p0[0], p1[0]), fmaxf(p0[1], p1[1]));
#pragma unroll
                for (int r = 2; r < 16; r += 2) mx = fmaxf(mx, fmaxf(fmaxf(p0[r], p1[r]), fmaxf(p0[r + 1], p1[r + 1])));
                { auto rr = __builtin_amdgcn_permlane32_swap(__float_as_uint(mx), __float_as_uint(mx), false, false); mx = fmaxf(__uint_as_float(rr[0]), __uint_as_float(rr[1])); }
                if (t == 0 || __any(mx > 6.0f)) {
                    const float delta = t == 0 ? mx : fmaxf(mx, 0.f); mref[m] += delta;
#pragma unroll
                    for (int r = 0; r < 16; ++r) { p0[r] -= delta; p1[r] -= delta; if (!KIND) negm[r] = -mref[m]; }
                    if (t != 0) { const float alpha = __builtin_amdgcn_exp2f(-delta); lrun[m] *= alpha;
                        if (hi == 0) wsf[r32] = alpha;
                        f32x4 al[4];
#pragma unroll
                        for (int g = 0; g < 4; ++g) al[g] = *(const LAS f32x4*)(wsf + 8 * g + 4 * hi);
#pragma unroll
                        for (int r = 0; r < 16; ++r) { o[m][0][r] *= al[r >> 2][r & 3]; o[m][1][r] *= al[r >> 2][r & 3]; } } }
                float ls = 0.f;
#pragma unroll
                for (int r = 0; r < 16; ++r) { p0[r] = __builtin_amdgcn_exp2f(p0[r]); p1[r] = __builtin_amdgcn_exp2f(p1[r]); ls += p0[r] + p1[r]; }
                lrun[m] += ls;
                s16x8 pw[4];
#pragma unroll
                for (int ks = 0; ks < 4; ++ks) { v4u u;
                    if (ks < 2) { u.x = pg8::cvt_pk_bf16(p0[8 * ks], p0[8 * ks + 1]); u.y = pg8::cvt_pk_bf16(p0[8 * ks + 2], p0[8 * ks + 3]); u.z = pg8::cvt_pk_bf16(p0[8 * ks + 4], p0[8 * ks + 5]); u.w = pg8::cvt_pk_bf16(p0[8 * ks + 6], p0[8 * ks + 7]); }
                    else { const int k2 = ks - 2; u.x = pg8::cvt_pk_bf16(p1[8 * k2], p1[8 * k2 + 1]); u.y = pg8::cvt_pk_bf16(p1[8 * k2 + 2], p1[8 * k2 + 3]); u.z = pg8::cvt_pk_bf16(p1[8 * k2 + 4], p1[8 * k2 + 5]); u.w = pg8::cvt_pk_bf16(p1[8 * k2 + 6], p1[8 * k2 + 7]); }
                    pw[ks] = __builtin_bit_cast(s16x8, u); }
                __builtin_amdgcn_s_setprio(1);
#pragma unroll
                for (int ks = 0; ks < 4; ++ks) o[m][0] = __builtin_amdgcn_mfma_f32_32x32x16_bf16(pw[ks], vfr0[ks], o[m][0], 0, 0, 0);
                __builtin_amdgcn_s_setprio(0);
                { s16x8 vfr1[4];
#pragma unroll
                    for (int ks = 0; ks < 4; ++ks) vfr1[ks] = ATT_VFRAG(1, ks);
                    __builtin_amdgcn_sched_barrier(0);
                    __builtin_amdgcn_s_setprio(1);
#pragma unroll
                    for (int ks = 0; ks < 4; ++ks) o[m][1] = __builtin_amdgcn_mfma_f32_32x32x16_bf16(pw[ks], vfr1[ks], o[m][1], 0, 0, 0); }
                __builtin_amdgcn_s_setprio(0);
            }
        }
    }
#undef ATT_DMA
#undef ATT_VFRAG
#undef ATT_SRCROW
    ATT_BAR();
    if (KIND) { const LAS float* lp = (const LAS float*)(lds + RING_BYTES + 256); lam = lp[0]; oscale = lp[1]; }
    if (wact) {
#pragma unroll
        for (int m = 0; m < NMAP; ++m) asm volatile("s_nop 15\n\ts_nop 7" : "+v"(o[m][0]), "+v"(o[m][1]));
        float il0, il1 = 0.f;
        { float l = lrun[0]; l += __shfl_xor(l, 32); il0 = l > 0.f ? 1.f / l : 0.f; }
        if (KIND) { float l = lrun[NMAP - 1]; l += __shfl_xor(l, 32); il1 = l > 0.f ? lam / l : 0.f; }
        if (hi == 0) { wsf[r32] = il0; wsf[32 + r32] = il1; }
        f32x4 a0[4], a1[4];
#pragma unroll
        for (int g = 0; g < 4; ++g) { a0[g] = *(const LAS f32x4*)(wsf + 8 * g + 4 * hi); a1[g] = *(const LAS f32x4*)(wsf + 32 + 8 * g + 4 * hi); }
#pragma unroll
        for (int d0 = 0; d0 < 2; ++d0)
#pragma unroll
            for (int r = 0; r < 16; ++r) { float v = o[0][d0][r] * a0[r >> 2][r & 3]; if (KIND) v -= o[NMAP - 1][d0][r] * a1[r >> 2][r & 3];
                ost[crow(r, hi) * OSTW + 32 * d0 + r32] = v; }
        const int row = lane >> 1, half = lane & 1, p = q0 + 32 * w + row;
        f32x4 v[8]; float ss = 0.f;
#pragma unroll
        for (int i = 0; i < 8; ++i) { v[i] = *(const LAS f32x4*)(ost + row * OSTW + 32 * half + 4 * i); ss += (v[i][0] * v[i][0] + v[i][1] * v[i][1]) + (v[i][2] * v[i][2] + v[i][3] * v[i][3]); }
        ss += __shfl_xor(ss, 1);
        const float rs = KIND ? __builtin_amdgcn_rsqf(ss * (1.f / 64.f) + EPS) * oscale : 1.f;
        const int sr = qb >= 0 ? b * TT + p - 64 : ((p >= 48 && b == 0) ? MR + p - 48 : -1);
        if (sr >= 0) { bf16* dst = (bf16*)a.out + (size_t)sr * DM + (KIND ? 768 : 512) + hh * 64 + 32 * half; const float* gn = ain(a, I_DNORM) + li * 64 + 32 * half;
#pragma unroll
            for (int i = 0; i < 4; ++i) { f32x4 x0 = v[2 * i] * rs, x1 = v[2 * i + 1] * rs;
                if (KIND) { const f32x4 g0 = *(const f32x4*)(gn + 8 * i), g1 = *(const f32x4*)(gn + 8 * i + 4); x0 = x0 * g0; x1 = x1 * g1; }
                *(v4u*)(dst + 8 * i) = pack8(x0, x1); } }
    }
    ATT_BAR();
#undef ATT_BAR
}

__device__ __forceinline__ s16x8 ldperm(const bf16* p, int hi) { const s16x4 x = *(const s16x4*)(p + 4 * hi), y = *(const s16x4*)(p + 8 + 4 * hi); return (s16x8){x[0], x[1], x[2], x[3], y[0], y[1], y[2], y[3]}; }
__device__ __forceinline__ s16x8 packacc(const f32x16& v, int k) { v4u u; u.x = pg8::cvt_pk_bf16(v[8 * k], v[8 * k + 1]); u.y = pg8::cvt_pk_bf16(v[8 * k + 2], v[8 * k + 3]); u.z = pg8::cvt_pk_bf16(v[8 * k + 4], v[8 * k + 5]); u.w = pg8::cvt_pk_bf16(v[8 * k + 6], v[8 * k + 7]); return __builtin_bit_cast(s16x8, u); }
__device__ __forceinline__ s16x8 ldperm_lds(const LAS unsigned char* p, int hi) { const s16x4 x = *(const LAS s16x4*)(p + 8 * hi), y = *(const LAS s16x4*)(p + 16 + 8 * hi); return (s16x8){x[0], x[1], x[2], x[3], y[0], y[1], y[2], y[3]}; }
template <int KIND>
__device__ __forceinline__ void lin_mfma_unit(const Args& a, int li, int b, int hp, LAS unsigned char* lds, int tid) {
    constexpr int DK = KIND ? 64 : 32, NDS = DK / 16, NDB = DK / 32, OTW = 68;
    constexpr int QROW = KIND ? 144 : 80, QT = KIND ? RT_T : GQ_T, HB = 2 * QT + VT_T, PPH = HB / 1024, NP = 2 * PPH;
    constexpr int OFF_OT = 2 * HB, OFF_G = OFF_OT + 2 * 64 * OTW * 4;
    static_assert(HB % 1024 == 0 && OFF_G + 256 <= RING_BYTES, "lin unit LDS map");
    const int lane = tid & 63, w = __builtin_amdgcn_readfirstlane(tid >> 6), r32 = lane & 31, hi = lane >> 5, hl = w >> 2, e0 = 32 * ((w >> 1) & 1), ib = w & 1, h = 2 * hp + hl;
    const unsigned char* Qg = a.ws + (KIND ? B_RQ : B_GQ); const unsigned char* Kg = a.ws + (KIND ? B_RK : B_GK);
    const bf16* proj = (const bf16*)(a.ws + B_PROJ); bf16* ob = (bf16*)a.out;
    LAS float* Ot = (LAS float*)(lds + OFF_OT);
    LAS float* Gs = (LAS float*)(lds + OFF_G);
    const LAS unsigned char* Lh = lds + hl * HB;
    const float dret = __builtin_amdgcn_exp2f(64.f * lg2gamma(h));
    f32x16 S[NDB];
#pragma unroll
    for (int db = 0; db < NDB; ++db) S[db] = (f32x16){};
#define LIN_DMA(c_) do { _Pragma("unroll") for (int j_ = 0; j_ < (NP + 7) / 8; ++j_) { const int p_ = w + 8 * j_; if (p_ < NP) { const int hl_ = p_ / PPH, pp_ = p_ % PPH; const size_t blk_ = (size_t)(b * NCH + (c_)) * 4 + 2 * hp + hl_; \
        const unsigned char* src_; \
        if (pp_ < 2 * QT / 1024) src_ = (pp_ < QT / 1024 ? Qg + blk_ * QT + pp_ * 1024 : Kg + blk_ * QT + (pp_ - QT / 1024) * 1024) + lane * 16; \
        else { const int g_ = 64 * (pp_ - 2 * QT / 1024) + lane, s_ = g_ / 9, cc_ = g_ % 9; int sr_ = src_row(b, (c_), s_); sr_ = sr_ < 0 ? MR : sr_;     \
            src_ = (const unsigned char*)(proj + (size_t)sr_ * N1 + (KIND ? C_RV : C_AV) + (2 * hp + hl_) * 64 + (cc_ < 8 ? cc_ : 7) * 8); } \
        __builtin_amdgcn_global_load_lds((const unsigned*)src_, (LAS unsigned*)(lds + hl_ * HB + pp_ * 1024), 16, 0, 0); } } } while (0)
#define LIN_BAR() do { asm volatile("s_waitcnt lgkmcnt(0)" ::: "memory"); __builtin_amdgcn_s_barrier(); asm volatile("" ::: "memory"); } while (0)
    LIN_BAR();
    if (tid < 64) Gs[tid] = ain(a, KIND ? I_RNORM : I_GNORM)[li * 64 + tid];
    LIN_DMA(0);
    const int nh = tid >> 8, nrow = (tid >> 2) & 63, nq = tid & 3, hn = 2 * hp + nh;
    for (int c = 0; c < NCH; ++c) {
        asm volatile("s_waitcnt vmcnt(0)" ::: "memory"); LIN_BAR();
        s16x8 qf[NDS], kf0[NDS], kf1[NDS], vf[4], ktf[NDB][4];
        const int sr = src_row(b, c, nrow); const bool wr = sr >= 0 && (c > 0 || b == 0);
#pragma unroll
        for (int ds = 0; ds < NDS; ++ds) { qf[ds] = ldperm_lds(Lh + (32 * ib + r32) * QROW + 32 * ds, hi); kf0[ds] = ldperm_lds(Lh + QT + r32 * QROW + 32 * ds, hi); kf1[ds] = ldperm_lds(Lh + QT + (32 + r32) * QROW + 32 * ds, hi); }
        const int trq = (lane & 15) >> 2, trb = (lane >> 4) & 1, trp = lane & 3;
#pragma unroll
        for (int ks = 0; ks < 4; ++ks) { const LAS unsigned char* vp = Lh + 2 * QT + (16 * ks + 4 * hi + trq) * 144 + (e0 + 16 * trb) * 2 + 8 * trp;
            const s16x4 va = __builtin_bit_cast(s16x4, __builtin_amdgcn_ds_read_tr16_b64_v4i16((LAS v4i16_t*)vp)), vb = __builtin_bit_cast(s16x4, __builtin_amdgcn_ds_read_tr16_b64_v4i16((LAS v4i16_t*)(vp + 8 * 144)));
            vf[ks] = (s16x8){va[0], va[1], va[2], va[3], vb[0], vb[1], vb[2], vb[3]}; }
        f32x16 aA = (f32x16){}, aB = (f32x16){};
#pragma unroll
        for (int ds = 0; ds < NDS; ++ds) { aA = __builtin_amdgcn_mfma_f32_32x32x16_bf16(kf0[ds], qf[ds], aA, 0, 0, 0); if (ib) aB = __builtin_amdgcn_mfma_f32_32x32x16_bf16(kf1[ds], qf[ds], aB, 0, 0, 0); }
        asm volatile("s_nop 15\n\ts_nop 15" : "+v"(aA), "+v"(aB));
#pragma unroll
        for (int r = 0; r < 16; ++r) if (crow(r, hi) > r32) { if (ib) aB[r] = 0.f; else aA[r] = 0.f; }
        f32x16 O = (f32x16){};
#pragma unroll
        for (int db = 0; db < NDB; ++db)
#pragma unroll
            for (int ksub = 0; ksub < 2; ++ksub) O = __builtin_amdgcn_mfma_f32_32x32x16_bf16(qf[2 * db + ksub], packacc(S[db], ksub), O, 0, 0, 0);
#pragma unroll
        for (int ksub = 0; ksub < 2; ++ksub) { O = __builtin_amdgcn_mfma_f32_32x32x16_bf16(packacc(aA, ksub), vf[ksub], O, 0, 0, 0); if (ib) O = __builtin_amdgcn_mfma_f32_32x32x16_bf16(packacc(aB, ksub), vf[2 + ksub], O, 0, 0, 0); }
#pragma unroll
        for (int db = 0; db < NDB; ++db)
#pragma unroll
            for (int ks = 0; ks < 4; ++ks) { const LAS unsigned char* kp = Lh + QT + (16 * ks + 4 * hi + trq) * QROW + (32 * db + 16 * trb) * 2 + 8 * trp;
                const s16x4 ka = __builtin_bit_cast(s16x4, __builtin_amdgcn_ds_read_tr16_b64_v4i16((LAS v4i16_t*)kp)), kb = __builtin_bit_cast(s16x4, __builtin_amdgcn_ds_read_tr16_b64_v4i16((LAS v4i16_t*)(kp + 8 * QROW)));
                ktf[db][ks] = (s16x8){ka[0], ka[1], ka[2], ka[3], kb[0], kb[1], kb[2], kb[3]}; }
        LIN_BAR();
        v4u og[2];
#pragma unroll
        for (int i = 0; i < 2; ++i) og[i] = wr ? *(const v4u*)(proj + (size_t)sr * N1 + (KIND ? C_ROG : C_AOG) + hn * 64 + 16 * nq + 8 * i) : (v4u){0u, 0u, 0u, 0u};
        f32x4 dvv[4];
        if (!KIND) { const float* dp = (const float*)(a.ws + WS_GD) + ((size_t)(b * NCH + c) * 4 + h) * 32;
#pragma unroll
            for (int g = 0; g < 4; ++g) dvv[g] = *(const f32x4*)(dp + 8 * g + 4 * hi); }
        if (c + 1 < NCH) LIN_DMA(c + 1);
#pragma unroll
        for (int db = 0; db < NDB; ++db) {
#pragma unroll
            for (int ks = 0; ks < 4; ++ks) S[db] = __builtin_amdgcn_mfma_f32_32x32x16_bf16(ktf[db][ks], vf[ks], S[db], 0, 0, 0); }
        asm volatile("s_nop 15\n\ts_nop 15" : "+v"(O));
#pragma unroll
        for (int db = 0; db < NDB; ++db) asm volatile("s_nop 15\n\ts_nop 15" : "+v"(S[db]));
#pragma unroll
        for (int db = 0; db < NDB; ++db) {
            if (KIND) { S[db] = S[db] * dret; }
            else {
#pragma unroll
                for (int g = 0; g < 4; ++g) { S[db][4 * g] *= dvv[g][0]; S[db][4 * g + 1] *= dvv[g][1]; S[db][4 * g + 2] *= dvv[g][2]; S[db][4 * g + 3] *= dvv[g][3]; } } }
#pragma unroll
        for (int r = 0; r < 16; ++r) Ot[(hl * 64 + 32 * ib + crow(r, hi)) * OTW + e0 + r32] = O[r];
        LIN_BAR();
        { f32x4 v[4]; float s1 = 0.f;
#pragma unroll
            for (int i = 0; i < 4; ++i) { v[i] = *(const LAS f32x4*)(Ot + (nh * 64 + nrow) * OTW + 16 * nq + 4 * i); s1 += (v[i][0] + v[i][1]) + (v[i][2] + v[i][3]); }
            float mean = 0.f; if (KIND) { s1 += __shfl_xor(s1, 1); s1 += __shfl_xor(s1, 2); mean = s1 * (1.f / 64.f); }
            float s2 = 0.f;
#pragma unroll
            for (int i = 0; i < 4; ++i) { v[i] = v[i] - mean; s2 += (v[i][0] * v[i][0] + v[i][1] * v[i][1]) + (v[i][2] * v[i][2] + v[i][3] * v[i][3]); }
            s2 += __shfl_xor(s2, 1); s2 += __shfl_xor(s2, 2);
            const float rs = __builtin_amdgcn_rsqf(s2 * (1.f / 64.f) + EPS);
            if (wr) { bf16* dst = ob + (size_t)sr * DM + KIND * 256 + hn * 64 + 16 * nq; const LAS float* gp = Gs + 16 * nq;
#pragma unroll
                for (int i = 0; i < 2; ++i) { const v4u g4 = og[i]; const f32x4 g0 = *(const LAS f32x4*)(gp + 8 * i), g1 = *(const LAS f32x4*)(gp + 8 * i + 4);
                    f32x4 x0 = v[2 * i] * rs * g0, x1 = v[2 * i + 1] * rs * g1;
                    x0[0] *= silu_f(bflo(g4.x)); x0[1] *= silu_f(bfhi(g4.x)); x0[2] *= silu_f(bflo(g4.y)); x0[3] *= silu_f(bfhi(g4.y)); x1[0] *= silu_f(bflo(g4.z)); x1[1] *= silu_f(bfhi(g4.z)); x1[2] *= silu_f(bflo(g4.w)); x1[3] *= silu_f(bfhi(g4.w));
                    *(v4u*)(dst + 8 * i) = pack8(x0, x1); } } }
        LIN_BAR();
    }
    asm volatile("s_waitcnt vmcnt(0)" ::: "memory");
#undef LIN_DMA
#undef LIN_BAR
}

template <int MODE, int KSTEPS  >
__device__ __forceinline__ void thin_unit(const bf16* A, int lda, const bf16* Bt, int u, bf16* H, float* stats_out, const float* stats_in, bf16* ACT, LAS unsigned char* lds, int tid) {
    constexpr int K = KSTEPS * 256;
    const int lane = tid & 63, w = __builtin_amdgcn_readfirstlane(tid >> 6), fr = lane & 15, fq = lane >> 4;
    int brow[4];
#pragma unroll
    for (int nb = 0; nb < 4; ++nb) brow[nb] = MODE != 1 ? 64 * u + 16 * nb + fr : 256 * (u >> 2) + 32 * (u & 3) + (nb >> 1) * 128 + 16 * (nb & 1) + fr;
    f32x4 acc[4];
#pragma unroll
    for (int nb = 0; nb < 4; ++nb) acc[nb] = (f32x4){0.f, 0.f, 0.f, 0.f};
    const bf16* ap = A + (size_t)fr * lda + w * (KSTEPS * 32) + 8 * fq;
    constexpr int B1 = KSTEPS > 6 ? 6 : KSTEPS;
    { s16x8 af[B1], bf[B1][4];
#pragma unroll
        for (int s = 0; s < B1; ++s) { af[s] = *(const s16x8*)(ap + 32 * s);
#pragma unroll
            for (int nb = 0; nb < 4; ++nb) bf[s][nb] = *(const s16x8*)(Bt + (size_t)brow[nb] * K + w * (KSTEPS * 32) + 32 * s + 8 * fq); }
#pragma unroll
        for (int s = 0; s < B1; ++s)
#pragma unroll
            for (int nb = 0; nb < 4; ++nb) acc[nb] = __builtin_amdgcn_mfma_f32_16x16x32_bf16(bf[s][nb], af[s], acc[nb], 0, 0, 0); }
    if (KSTEPS > B1) { constexpr int B2 = KSTEPS > B1 ? KSTEPS - B1 : 1; s16x8 af[B2], bf[B2][4];
#pragma unroll
        for (int s = 0; s < B2; ++s) { af[s] = *(const s16x8*)(ap + 32 * (B1 + s));
#pragma unroll
            for (int nb = 0; nb < 4; ++nb) bf[s][nb] = *(const s16x8*)(Bt + (size_t)brow[nb] * K + w * (KSTEPS * 32) + 32 * (B1 + s) + 8 * fq); }
#pragma unroll
        for (int s = 0; s < B2; ++s)
#pragma unroll
            for (int nb = 0; nb < 4; ++nb) acc[nb] = __builtin_amdgcn_mfma_f32_16x16x32_bf16(bf[s][nb], af[s], acc[nb], 0, 0, 0); }
    asm volatile("s_nop 15" : "+v"(acc[0]), "+v"(acc[1]), "+v"(acc[2]), "+v"(acc[3]));
    LAS f32x4* part = (LAS f32x4*)lds;
    __syncthreads();
#pragma unroll
    for (int nb = 0; nb < 4; ++nb) part[(w * 4 + nb) * 64 + lane] = acc[nb];
    __syncthreads();
    if (w == 0) {
#pragma unroll
        for (int nb = 0; nb < 4; ++nb) {
#pragma unroll
            for (int w2 = 1; w2 < 8; ++w2) acc[nb] = acc[nb] + part[(w2 * 4 + nb) * 64 + lane]; }
        const int row = MR + fr;
        if (MODE == 0) { float ss = 0.f;
#pragma unroll
            for (int nb = 0; nb < 4; ++nb) { bf16* p = H + (size_t)row * DM + 64 * u + 16 * nb + 4 * fq; const v2u wv = *(const v2u*)p;
                const float x0 = acc[nb][0] + bflo(wv.x), x1 = acc[nb][1] + bfhi(wv.x), x2 = acc[nb][2] + bflo(wv.y), x3 = acc[nb][3] + bfhi(wv.y);
                ss += (x0 * x0 + x1 * x1) + (x2 * x2 + x3 * x3);
                v2u o; o.x = pg8::cvt_pk_bf16(x0, x1); o.y = pg8::cvt_pk_bf16(x2, x3); *(v2u*)p = o; }
            ss += __shfl_xor(ss, 16); ss += __shfl_xor(ss, 32);
            if (fq == 0) stats_out[(size_t)row * 16 + u] = ss;
        } else if (MODE == 2) { const f32x4* sp = (const f32x4*)(stats_in + (size_t)row * 16); const f32x4 s0 = sp[0], s1 = sp[1], s2 = sp[2], s3 = sp[3];
            const float st = ((s0[0] + s0[1]) + (s0[2] + s0[3])) + ((s1[0] + s1[1]) + (s1[2] + s1[3])) + ((s2[0] + s2[1]) + (s2[2] + s2[3])) + ((s3[0] + s3[1]) + (s3[2] + s3[3]));
            const float rs = __builtin_amdgcn_rsqf(st * (1.f / 1024.f) + EPS);
#pragma unroll
            for (int nb = 0; nb < 4; ++nb) { v2u o; o.x = pg8::cvt_pk_bf16(acc[nb][0] * rs, acc[nb][1] * rs); o.y = pg8::cvt_pk_bf16(acc[nb][2] * rs, acc[nb][3] * rs);
                *(v2u*)(ACT + (size_t)row * N1 + 64 * u + 16 * nb + 4 * fq) = o; }
        } else { const f32x4* sp = (const f32x4*)(stats_in + (size_t)row * 16); const f32x4 s0 = sp[0], s1 = sp[1], s2 = sp[2], s3 = sp[3];
            const float st = ((s0[0] + s0[1]) + (s0[2] + s0[3])) + ((s1[0] + s1[1]) + (s1[2] + s1[3])) + ((s2[0] + s2[1]) + (s2[2] + s2[3])) + ((s3[0] + s3[1]) + (s3[2] + s3[3]));
            const float rs = __builtin_amdgcn_rsqf(st * (1.f / 1024.f) + EPS);
#pragma unroll
            for (int nb = 0; nb < 2; ++nb) { float y[4];
#pragma unroll
                for (int t = 0; t < 4; ++t) y[t] = silu_f(acc[nb][t] * rs) * (acc[2 + nb][t] * rs);
                v2u o; o.x = pg8::cvt_pk_bf16(y[0], y[1]); o.y = pg8::cvt_pk_bf16(y[2], y[3]);
                *(v2u*)(ACT + (size_t)row * DFF + 128 * (u >> 2) + 32 * (u & 3) + 16 * nb + 4 * fq) = o; } }
    }
    __syncthreads();
}

#ifndef REP_PREP
#define REP_PREP 1
#endif
#ifndef REP_MIX
#define REP_MIX 1
#endif
#ifndef REP_P0
#define REP_P0 1
#endif
#ifndef REP_CONV
#define REP_CONV 1
#endif
#ifndef REP_G1
#define REP_G1 1
#endif
#ifndef REP_MGU
#define REP_MGU 1
#endif
#ifndef REP_MDN
#define REP_MDN 1
#endif
#ifndef REP_BAR
#define REP_BAR 0
#endif
#ifndef REP_PART
#define REP_PART -1
#endif
#ifndef MK_ONE_LAUNCH
#define MK_ONE_LAUNCH 1
#endif
constexpr int NPHASE = 20;
constexpr int CW_Q = 12288;
__global__ void __launch_bounds__(512, 2) mega_fwd(Args a) {
    extern __shared__ __attribute__((aligned(16))) unsigned char lds_raw[];
    LAS unsigned char* lds = (LAS unsigned char*)lds_raw;
    volatile LAS unsigned* MISC = (volatile LAS unsigned*)(lds + MISC_OFF);
    int wave = __builtin_amdgcn_readfirstlane((int)threadIdx.x >> 6); asm volatile("" : "+s"(wave));
    const int G = gridDim.x;
#define TID() ((wave << 6) + lane_id())
    for (int u = TID(); u < (LDS_BYTES - RING_BYTES) / 4; u += 512) ((LAS unsigned*)(lds + RING_BYTES))[u] = 0u;
    __syncthreads();
    gu32* ctl = (gu32*)(a.ws + WS_CTL);
    const int lo = a.ph_lo, hi = a.ph_hi;
    XcdBarrier bar; bar.bar = (unsigned*)(ctl + CW_BAR); bar.x = 0; bar.st = nullptr;
    if (hi - lo > 1) bar = xcd_barrier_post((unsigned*)(ctl + CW_BAR), MISC + 8, TID() == 0);
#define IN(k) (lo <= (k) && (k) < hi)
#define OPQ() int ptid = TID(); asm volatile("" : "+v"(ptid)); const int plane = ptid & 63; (void)plane
#define SEAM(k) do { if (IN(k) && IN((k) + 1)) xcd_barrier(bar, TID() == 0); } while (0)
#define hb ((bf16*)(a.ws + WS_HB))
#define stA ((float*)(a.ws + WS_STA))
#define stB ((float*)(a.ws + WS_STB))

    for (int rep = 0; rep < REP_BAR; ++rep) xcd_barrier(bar, TID() == 0);
    if (IN(0)) { OPQ(); for (int rep = 0; rep < REP_P0; ++rep) { p0_prologue(a, lds, ptid, plane, wave); __syncthreads(); } }
    SEAM(0);

    for (int li = 0; li < 2; ++li) {
        const int pb = 1 + 6 * li;
        if (IN(pb)) {
            { OPQ(); for (int u = blockIdx.x; u < N1 / 64; u += G) thin_unit<2, 4>(hb + (size_t)MR * DM, DM, (const bf16*)(a.ws + WS_W1T + li * W1T_BYTES), u, nullptr, nullptr, stA, (bf16*)(a.ws + B_PROJ), lds, ptid); }
            pg8::Gemm g{hb, (const bf16*)(a.ws + WS_W1T + li * W1T_BYTES), DM, 0, nullptr}; pg8::StaticOrder S; S.init(NPAN - 1, N1 / 256, G, (int)blockIdx.x);
            EpiProj E{(bf16*)(a.ws + B_PROJ), stA};
            for (int rep = 0; rep < REP_G1; ++rep) pg8::gemm_phase<EpiProj, pg8::StaticOrder, false>(lds, g, S, E, wave);
        }
        SEAM(pb);
        if (IN(pb + 1)) { OPQ(); for (int rep = 0; rep < REP_PREP; ++rep) for (int u = blockIdx.x; u < NB * NCH * 3; u += G) { const int part = u % 3;     if (rep > 0 && REP_PART >= 0 && part != REP_PART) continue; int ut = ptid; asm volatile("" : "+v"(ut)); prep2_unit(a, li, (u / 3) / NCH, (u / 3) % NCH, part, lds, ut); } __syncthreads(); }
        SEAM(pb + 1);
        if (IN(pb + 2)) {
            OPQ(); const int tid = ptid;
            LAS int* qid = (LAS int*)(lds + RING_BYTES + 64);
            float lam, lam_init; { const float* lv = ain(a, I_DLAM) + li * 128; float s01 = 0.f, s23 = 0.f;
                for (int d = 0; d < 32; ++d) { s01 += lv[d] * lv[32 + d]; s23 += lv[64 + d] * lv[96 + d]; }
                lam_init = 0.8f - 0.6f * __expf(-0.3f * (float)li); lam = __expf(s01) - __expf(s23) + lam_init;
                if (tid == 0) { LAS float* lp = (LAS float*)(lds + RING_BYTES + 256); lp[0] = lam; lp[1] = 1.f - lam_init; } }
            for (int rep = 0; rep < REP_MIX; ++rep)
            for (;;) {
                __syncthreads();
                if (tid == 0) *qid = (int)__hip_atomic_fetch_add(ctl + CW_Q + 64 * (li + 2 * rep), 1u, RLX_AGENT);
                __syncthreads();
                const int id = *qid;
                int utid = ptid; asm volatile("" : "+v"(utid));
                if (id >= 64 + 1024 + 8) break;
                if (id < 64) { if ((id & 1) == 0) lin_mfma_unit<0>(a, li, (id >> 1) & 15, id >> 5, lds, utid); else lin_mfma_unit<1>(a, li, (id >> 1) & 15, id >> 5, lds, utid); }
                else { const int v = id - 64; int qb, kind, b, hh;
                    if (v < 1024) { qb = 7 - (v >> 7); const int rem = v & 127; kind = rem >> 6; b = (rem >> 2) & 15; hh = rem & 3; } else { qb = -1; kind = (v - 1024) >> 2; b = 0; hh = v & 3; }
                    if (kind == 0) attn_mfma_unit<0>(a, li, b, hh, qb, lds, utid, 0.f, 1.f); else attn_mfma_unit<1>(a, li, b, hh, qb, lds, utid, 0.f, 0.f); }
            }
        }
        SEAM(pb + 2);
        if (IN(pb + 3)) {
            if (li == 0) { OPQ(); for (int u = blockIdx.x; u < 16; u += G) thin_unit<0, 4>((const bf16*)a.out + (size_t)MR * DM, DM, (const bf16*)(a.ws + WS_WOT), u, hb, stB, nullptr, nullptr, lds, ptid); }
            pg8::Gemm g{(const bf16*)a.out, (const bf16*)(a.ws + WS_WOT + li * WOT_BYTES), DM, 0, nullptr}; pg8::StaticOrder S; S.init(NPAN - 1, 4, G, (int)blockIdx.x);
            EpiResid E{hb, stB};
            pg8::gemm_phase<EpiResid, pg8::StaticOrder, false>(lds, g, S, E, wave);
        }
        SEAM(pb + 3);
        if (li == 0) {
            if (IN(5)) {
                { OPQ(); for (int u = blockIdx.x; u < 88; u += G) thin_unit<1, 4>(hb + (size_t)MR * DM, DM, (const bf16*)(a.ws + WS_WGU), u, nullptr, nullptr, stB, (bf16*)(a.ws + B_ACT), lds, ptid); }
                pg8::Gemm g{hb, (const bf16*)(a.ws + WS_WGU), DM, 0, nullptr}; pg8::StaticOrder S; S.init(NPAN - 1, 2 * DFF / 256, G, (int)blockIdx.x);
                EpiSwiglu E{(bf16*)(a.ws + B_ACT), DFF, stB};
                pg8::gemm_phase<EpiSwiglu, pg8::StaticOrder, false>(lds, g, S, E, wave);
            }
            SEAM(5);
            if (IN(6)) {
                { OPQ(); for (int u = blockIdx.x; u < 16; u += G) thin_unit<0, 11>((const bf16*)(a.ws + B_ACT) + (size_t)MR * DFF, DFF, (const bf16*)(a.ws + WS_WD), u, hb, stA, nullptr, nullptr, lds, ptid); }
                pg8::Gemm g{(const bf16*)(a.ws + B_ACT), (const bf16*)(a.ws + WS_WD), DFF, 0, nullptr}; pg8::StaticOrder S; S.init(NPAN - 1, 4, G, (int)blockIdx.x);
                EpiResid E{hb, stA};
                pg8::gemm_phase<EpiResid, pg8::StaticOrder, false>(lds, g, S, E, wave);
            }
            SEAM(6);
        }
    }
    if (IN(11)) { OPQ(); const int tid = ptid, lane = plane;
        LAS float* scr = (LAS float*)(lds + wave * 16384);
        const int gw = blockIdx.x * 8 + wave, NGW = G * 8;
        constexpr int IG = 16 * 56, ID = 56 * 16;
        for (int rep = 0; rep < REP_CONV; ++rep)
        for (int it = gw; it < 8 * (2 * IG + ID); it += NGW) { const int e = it / (2 * IG + ID); int r = it % (2 * IG + ID);
            if (r < IG) { transpose_item(ain(a, I_EG) + (size_t)e * DM * DFE, DM, DFE, ain(a, I_FNORM) + DM, (bf16*)(a.ws + B_EGU + e * EGU_BYTES), r / 56, r % 56, 1, scr, lane); continue; } r -= IG;
            if (r < IG) { transpose_item(ain(a, I_EU) + (size_t)e * DM * DFE, DM, DFE, ain(a, I_FNORM) + DM, (bf16*)(a.ws + B_EGU + e * EGU_BYTES), r / 56, r % 56, 2, scr, lane); continue; } r -= IG;
            transpose_item(ain(a, I_ED) + (size_t)e * DFE * DM, DFE, DM, nullptr, (bf16*)(a.ws + B_ED + e * ED_BYTES), r / 16, r % 16, 0, scr, lane); }
        for (int i = blockIdx.x * 512 + tid; i < MAXPAN * 256; i += G * 512) { ((int*)(a.ws + MO_ROWIDX))[i] = -1; ((int*)(a.ws + MO_PDST))[i] = -1; ((f32x2*)(a.ws + MO_PINFO))[i] = (f32x2){0.f, 0.f}; }
        for (int blk = blockIdx.x; blk < MR / 128; blk += G) route_block(a, blk, lds, tid, lane, wave);
    }
    SEAM(11);
    LAS int* offs = (LAS int*)(lds + RING_BYTES + 128);
    if (IN(12)) { OPQ(); const int tid = ptid;
        moe_offsets(a, offs, tid);
        for (int idx = blockIdx.x * 512 + tid; idx < 2 * MR; idx += G * 512) { const int tok = idx >> 1, e = ((const int*)(a.ws + MO_TOKE))[idx], gpos = offs[e] + ((const int*)(a.ws + MO_TOKP))[idx];
            const f32x4* sp = (const f32x4*)(stB + (size_t)tok * 16); const f32x4 s0 = sp[0], s1 = sp[1], s2 = sp[2], s3 = sp[3];
            const float ss = ((s0[0] + s0[1]) + (s0[2] + s0[3])) + ((s1[0] + s1[1]) + (s1[2] + s1[3])) + ((s2[0] + s2[1]) + (s2[2] + s2[3])) + ((s3[0] + s3[1]) + (s3[2] + s3[3]));
            ((int*)(a.ws + MO_ROWIDX))[gpos] = tok; ((int*)(a.ws + MO_PDST))[gpos] = idx;
            ((f32x2*)(a.ws + MO_PINFO))[gpos] = (f32x2){__builtin_amdgcn_rsqf(ss * (1.f / 1024.f) + EPS), __int_as_float(((const int*)(a.ws + MO_TOKW))[idx])}; }
        if (blockIdx.x == 0 && tid < MAXPAN + 8) { int e = 0;
            for (int k = 1; k < 8; ++k) if (tid * 256 >= offs[k]) e = k;
            ((int*)(a.ws + MO_PEXP))[tid] = e; }
    }
    SEAM(12);
    for (int ci = 0; ci < 3; ++ci) {
        if (IN(13 + 2 * ci) || IN(14 + 2 * ci)) moe_offsets(a, offs, TID());
        int nP = 0; if (IN(13 + 2 * ci) || IN(14 + 2 * ci)) { nP = __builtin_amdgcn_readfirstlane(offs[8]) - 128 * ci; nP = nP > 128 ? 128 : nP; }
        if (IN(13 + 2 * ci) && nP > 0) {
            pg8::Gemm g{hb, (const bf16*)(a.ws + B_EGU), DM, EGU_BYTES, (const int*)(a.ws + MO_ROWIDX)}; pg8::MoeOrder S; S.init(nP, 2 * DFE / 256, G, (int)blockIdx.x, 128 * ci, (const int*)(a.ws + MO_PEXP));
            EpiSwigluMoe E{(bf16*)(a.ws + B_EACT), (const f32x2*)(a.ws + MO_PINFO)};
            for (int rep = 0; rep < REP_MGU; ++rep) pg8::gemm_phase<EpiSwigluMoe, pg8::MoeOrder, true>(lds, g, S, E, wave);
        }
        SEAM(13 + 2 * ci);
        if (IN(14 + 2 * ci) && nP > 0) {
            pg8::Gemm g{(const bf16*)(a.ws + B_EACT), (const bf16*)(a.ws + B_ED), DFE, ED_BYTES, nullptr}; pg8::MoeOrder S; S.init(nP, 4, G, (int)blockIdx.x, 128 * ci, (const int*)(a.ws + MO_PEXP));
            EpiMoeDown E{(unsigned char*)a.out, (const int*)(a.ws + MO_PDST), (const f32x2*)(a.ws + MO_PINFO)};
            for (int rep = 0; rep < REP_MDN; ++rep) pg8::gemm_phase<EpiMoeDown, pg8::MoeOrder, false>(lds, g, S, E, wave);
        }
        SEAM(14 + 2 * ci);
    }
    if (IN(19)) { OPQ(); const int lane = plane;
        const float* fn = ain(a, I_FINAL);
        for (int r = blockIdx.x * 8 + wave; r < MR; r += G * 8) {
            unsigned char* orow = (unsigned char*)a.out + (size_t)r * 4096; float v[16]; float ss = 0.f;
#pragma unroll
            for (int hf = 0; hf < 2; ++hf) { const int k = 512 * hf + 8 * lane; const v4u h4 = *(const v4u*)(hb + (size_t)r * DM + k), y0 = *(const v4u*)(orow + 2 * k), y1 = *(const v4u*)(orow + 2048 + 2 * k);
                const unsigned hw[4] = {h4.x, h4.y, h4.z, h4.w}, aw[4] = {y0.x, y0.y, y0.z, y0.w}, bw[4] = {y1.x, y1.y, y1.z, y1.w};
#pragma unroll
                for (int t = 0; t < 4; ++t) { const float x0 = bflo(hw[t]) + bflo(aw[t]) + bflo(bw[t]), x1 = bfhi(hw[t]) + bfhi(aw[t]) + bfhi(bw[t]); v[8 * hf + 2 * t] = x0; v[8 * hf + 2 * t + 1] = x1; ss += x0 * x0 + x1 * x1; } }
            ss = wave_sum(ss); const float rs = __builtin_amdgcn_rsqf(ss * (1.f / 1024.f) + EPS);
#pragma unroll
            for (int hf = 0; hf < 2; ++hf) { const int k = 512 * hf + 8 * lane; const f32x4 g0 = *(const f32x4*)(fn + k), g1 = *(const f32x4*)(fn + k + 4);
                *(f32x4*)(orow + 4 * k) = (f32x4){v[8 * hf] * rs * g0[0], v[8 * hf + 1] * rs * g0[1], v[8 * hf + 2] * rs * g0[2], v[8 * hf + 3] * rs * g0[3]};
                *(f32x4*)(orow + 4 * k + 16) = (f32x4){v[8 * hf + 4] * rs * g1[0], v[8 * hf + 5] * rs * g1[1], v[8 * hf + 6] * rs * g1[2], v[8 * hf + 7] * rs * g1[3]}; }
        }
    }
#undef IN
#undef SEAM
#undef hb
#undef stA
#undef stB
}

extern "C" void kernel_launch(void* const* d_in, const int* in_sizes, int n_in, void* d_out, int out_size, void* d_ws, size_t ws_size, hipStream_t stream) {
    static int grid = 0;
    if (grid == 0) {
        if (n_in != 24 || in_sizes[0] != MR * DM || out_size != MR * DM || ws_size < WS_NEED) { fprintf(stderr, "kernel_launch: unexpected problem (n_in %d, in0 %d, out %d, ws %zu < %zu)\n", n_in, n_in > 0 ? in_sizes[0] : -1, out_size, ws_size, (size_t)WS_NEED); grid = -1; return; }
        int dev = 0, cus = 0, per_cu = 0;
        if (hipGetDevice(&dev) != hipSuccess || hipDeviceGetAttribute(&cus, hipDeviceAttributeMultiprocessorCount, dev) != hipSuccess) { grid = -1; return; }
        if (hipFuncSetAttribute((const void*)mega_fwd, hipFuncAttributeMaxDynamicSharedMemorySize, LDS_BYTES) != hipSuccess) { fprintf(stderr, "kernel_launch: hipFuncSetAttribute failed\n"); grid = -1; return; }
        if (hipOccupancyMaxActiveBlocksPerMultiprocessor(&per_cu, (const void*)mega_fwd, 512, LDS_BYTES) != hipSuccess || per_cu < 1) fprintf(stderr, "kernel_launch: occupancy query reports %d\n", per_cu);
        (void)hipGetLastError();
        grid = cus;
    }
    if (grid < 0) return;
    if (hipMemsetAsync((char*)d_ws + WS_CTL, 0, CTL_BYTES, stream) != hipSuccess) return;
    Args a{};
    for (int i = 0; i < 24; ++i) a.in[i] = (const float*)d_in[i];
    a.out = (float*)d_out; a.ws = (unsigned char*)d_ws;
#if MK_ONE_LAUNCH
    a.ph_lo = 0; a.ph_hi = NPHASE;
    hipLaunchKernelGGL(mega_fwd, dim3(grid), dim3(512), LDS_BYTES, stream, a);
#else
    for (int p = 0; p < NPHASE; ++p) { a.ph_lo = p; a.ph_hi = p + 1; hipLaunchKernelGGL(mega_fwd, dim3(grid), dim3(512), LDS_BYTES, stream, a); }
#endif
}
```

```cpp
#include <hip/hip_runtime.h>
#include <cstdio>
#include <cstdint>

namespace pg8 {
#define PG8_LAS __attribute__((address_space(3)))
typedef unsigned short bf16_t;
typedef short bf16x8 __attribute__((ext_vector_type(8)));
typedef float f32x4 __attribute__((ext_vector_type(4)));
typedef unsigned u32x4 __attribute__((ext_vector_type(4)));
constexpr int BM = 256, BK = 64, HALF = 128, HTB = HALF * BK * 2  , STAGE_BYTES = 8 * HTB, NXCD = 8, WGM = 8;

__host__ __device__ __forceinline__ int lds_byte(int r, int c) { const int st = (r >> 4) * 2 + (c >> 5), rr = r & 15, cc = c & 31, ob = rr * 64 + cc * 2; return st * 1024 + (ob ^ (((ob >> 9) & 1) << 5)); }
__host__ __device__ __forceinline__ void stage_rc(int b, int& R, int& C) { const int st = b / 1024, sb = b % 1024, swz = sb ^ (((sb >> 9) & 1) << 5); R = (st >> 1) * 16 + swz / 64; C = (st & 1) * 32 + (swz % 64) / 2; }
__host__ __device__ __forceinline__ int perm32(int rho) { const int n = rho >> 4, i = rho & 15; return 8 * (i >> 2) + 4 * n + (i & 3); }

struct Unit { int pm, pn, e, gp; };
struct Gemm { const bf16_t* A; const bf16_t* Bt; int K; size_t estride  ; const int* rowidx  ; };

struct StaticOrder {
    int nM, nN, nwg, G, c;
    __device__ void init(int nM_, int nN_, int G_, int c_) { nM = nM_; nN = nN_; nwg = nM * nN; G = G_; c = c_; }
    __device__ __forceinline__ bool map(int i, int& pm, int& pn) const { return mapL((long)i * G + c, pm, pn); }
    __device__ __forceinline__ bool mapL(long L, int& pm, int& pn) const {
        if (L >= nwg) return false;
        int wgid = (int)L; { const int q = nwg / NXCD, r = nwg % NXCD, xcd = wgid % NXCD, off = wgid / NXCD; wgid = (xcd < r ? xcd * (q + 1) : r * (q + 1) + (xcd - r) * q) + off; }
        const int nig = WGM * nN, gid = wgid / nig, fm = gid * WGM, gsz = (nM - fm) < WGM ? (nM - fm) : WGM;
        pm = fm + ((wgid % nig) % gsz); pn = (wgid % nig) / gsz; return true;
    }
    __device__ __forceinline__ bool next(int i, Unit& u) const { int pm, pn; if (!map(i, pm, pn)) return false; u.pm = pm; u.pn = pn; u.e = 0; u.gp = pm; return true; }
};
struct MoeOrder {
    StaticOrder so; int p0; const int* pexp;
    int psplit, p1;
    int H;
    __device__ void init(int nP, int nN, int G, int c, int p0_, const int* pexp_) { so.init(nP, nN, G, c); p0 = p0_; pexp = pexp_; psplit = 1 << 30; p1 = 0; H = 0; }
    __device__ __forceinline__ bool next(int i, Unit& u) const { int pm, pn; long L = (long)i * so.G + so.c;
        if (H > 0) { const int full = so.nwg / so.G, nh = full - 3;
            if (so.c < H) { if (i >= nh) return false; }
            else if (i >= full) { const int j = so.c - H; if (i > full || j >= 3 * H) return false; L = (long)(nh + j / H) * so.G + (j % H); } }
        if (!so.mapL(L, pm, pn)) return false;
        u.pm = pm; u.pn = pn; u.gp = pm < psplit ? p0 + pm : p1 + (pm - psplit); u.e = __builtin_amdgcn_readfirstlane(pexp[u.gp]); return true; }
};

__device__ __forceinline__ unsigned cvt_pk_bf16(float lo, float hi) { unsigned r; asm volatile("v_cvt_pk_bf16_f32 %0, %1, %2" : "=v"(r) : "v"(lo), "v"(hi)); return r; }
__device__ __forceinline__ float bf_lo(unsigned w) { return __uint_as_float(w << 16); }
__device__ __forceinline__ float bf_hi(unsigned w) { return __uint_as_float(w & 0xffff0000u); }

template <class Epi, class Sched, bool GATHER>
__device__ __forceinline__ void gemm_phase(PG8_LAS unsigned char* lds, const Gemm g, const Sched& S, const Epi& E, int wave_id  ) {
    int tid_; asm volatile("v_mbcnt_lo_u32_b32 %0, -1, 0\n\tv_mbcnt_hi_u32_b32 %0, -1, %0" : "=v"(tid_)); tid_ += wave_id << 6;
    const int tid = tid_, wid = __builtin_amdgcn_readfirstlane(tid >> 6), lane = tid & 63, wr = wid >> 2, wc = wid & 3, fr = lane & 15, fq = lane >> 4;
    const int K = g.K, nt = K / BK;
    int Ra[2], Ca[2]; unsigned voffB[2];
#pragma unroll
    for (int i = 0; i < 2; ++i) { int R, C; stage_rc(tid * 16 + i * 8192, R, C); const int Rb = (R & ~31) + perm32(R & 31);
        Ra[i] = R; Ca[i] = C; voffB[i] = (unsigned)(Rb * K + C) * 2u; }
    const size_t kstep = (size_t)(BK * 2);
    const size_t hstep = (size_t)HALF * K * 2;
    const size_t tstep = 2 * hstep;
    const unsigned ldsw = (unsigned)wid * 1024u;
    const int aoff = lds_byte(wr * 64 + fr, fq * 8), boff = lds_byte(wc * 32 + fr, fq * 8);
    const char* const A0 = (const char*)g.A;
#define PG8_SA(b, h) (((b) * 2 + (h)) * HTB)
#define PG8_SB(b, h) ((4 + (b) * 2 + (h)) * HTB)
#define PG8_STAGE(bufoff, gbase, voff) do { _Pragma("unroll") for (int _i = 0; _i < 2; ++_i) \
        __builtin_amdgcn_global_load_lds((const unsigned*)((const char*)(gbase) + (voff)[_i]), (PG8_LAS unsigned*)(lds + (bufoff) + ldsw + _i * 8192), 16, 0, 0); } while (0)
#define PG8_LDA(dst, b, h) do { _Pragma("unroll") for (int m = 0; m < 4; ++m) _Pragma("unroll") for (int k = 0; k < 2; ++k) dst[m][k] = *(const PG8_LAS bf16x8*)(lds + PG8_SA(b, h) + aoff + m * 2048 + k * 1024); } while (0)
#define PG8_LDB(dst, b, h) do { _Pragma("unroll") for (int n = 0; n < 2; ++n) _Pragma("unroll") for (int k = 0; k < 2; ++k) dst[n][k] = *(const PG8_LAS bf16x8*)(lds + PG8_SB(b, h) + boff + n * 2048 + k * 1024); } while (0)
#define PG8_MMA(ai, bj, At, Bt) do { __builtin_amdgcn_s_setprio(1); _Pragma("unroll") for (int m = 0; m < 4; ++m) _Pragma("unroll") for (int n = 0; n < 2; ++n) _Pragma("unroll") for (int k = 0; k < 2; ++k) \
        acc[ai][bj][m][n] = __builtin_amdgcn_mfma_f32_16x16x32_bf16(Bt[n][k], At[m][k], acc[ai][bj][m][n], 0, 0, 0); __builtin_amdgcn_s_setprio(0); } while (0)
#define PG8_WAIT_V(n) asm volatile("s_waitcnt vmcnt(" #n ")" ::: "memory")
#define PG8_WAIT_L(n) asm volatile("s_waitcnt lgkmcnt(" #n ")" ::: "memory")
#define PG8_BAR __builtin_amdgcn_s_barrier()
#define PG8_SCHED __builtin_amdgcn_sched_barrier(0)
#define PG8_AOFFS(dst, u) do { _Pragma("unroll") for (int _h = 0; _h < 2; ++_h) _Pragma("unroll") for (int _i = 0; _i < 2; ++_i) { \
        int _row = (u).pm * BM + _h * HALF + Ra[_i]; \
        if (GATHER) { const int _gi = g.rowidx[(u).gp * BM + _h * HALF + Ra[_i]]; _row = _gi < 0 ? 0 : _gi; } \
        dst[_h][_i] = ((unsigned)_row * (unsigned)K + (unsigned)Ca[_i]) * 2u; } } while (0)
    Unit cur, nxt; int ui = 0;
    if (!S.next(0, cur)) return;
    f32x4 acc[2][2][4][2];
#pragma unroll
    for (int a = 0; a < 2; ++a)
#pragma unroll
        for (int b = 0; b < 2; ++b)
#pragma unroll
            for (int m = 0; m < 4; ++m)
#pragma unroll
                for (int n = 0; n < 2; ++n) acc[a][b][m][n] = (f32x4){0.f, 0.f, 0.f, 0.f};
    bf16x8 At[4][2], B0[2][2], B1[2][2];
    unsigned oaC[2][2], oaN[2][2];
    PG8_AOFFS(oaC, cur);
    const char* cB = (const char*)g.Bt + (size_t)cur.e * g.estride + (size_t)cur.pn * tstep;
    PG8_STAGE(PG8_SB(0, 0), cB, voffB); PG8_STAGE(PG8_SB(0, 1), cB + hstep, voffB); PG8_STAGE(PG8_SA(0, 0), A0, oaC[0]); PG8_STAGE(PG8_SA(0, 1), A0, oaC[1]);
    if (wr == 1) PG8_BAR;
    PG8_WAIT_V(2); PG8_BAR;
    PG8_STAGE(PG8_SB(1, 0), cB + kstep, voffB); PG8_STAGE(PG8_SA(1, 0), A0 + kstep, oaC[0]); PG8_STAGE(PG8_SB(1, 1), cB + hstep + kstep, voffB);
    PG8_WAIT_V(6); PG8_BAR;
    for (;;) {
        const bool has_next = S.next(ui + 1, nxt);
        if (has_next) { PG8_AOFFS(oaN, nxt); }
        else {
#pragma unroll
            for (int _h = 0; _h < 2; ++_h)
#pragma unroll
                for (int _i = 0; _i < 2; ++_i) oaN[_h][_i] = oaC[_h][_i]; }
        const char* nB = has_next ? (const char*)g.Bt + (size_t)nxt.e * g.estride + (size_t)nxt.pn * tstep : cB;
        for (int t = 0; t < nt; t += 2) {
            const bool last = (t == nt - 2);
            const char* ka1 = A0 + (size_t)(t + 1) * kstep;
            const char* ka2 = last ? A0 : A0 + (size_t)(t + 2) * kstep; const char* b2 = last ? nB : cB + (size_t)(t + 2) * kstep;
            const char* ka3 = ka2 + kstep; const char* b3 = b2 + kstep;
            unsigned o2[2][2];
#pragma unroll
            for (int _h = 0; _h < 2; ++_h)
#pragma unroll
                for (int _i = 0; _i < 2; ++_i) o2[_h][_i] = oaC[_h][_i];
            if (last) {
#pragma unroll
                for (int _h = 0; _h < 2; ++_h)
#pragma unroll
                    for (int _i = 0; _i < 2; ++_i) o2[_h][_i] = oaN[_h][_i];
                asm volatile("" : "+v"(o2[0][0]), "+v"(o2[0][1]), "+v"(o2[1][0]), "+v"(o2[1][1])); }
            PG8_LDB(B0, 0, 0); PG8_LDB(B1, 0, 1); PG8_SCHED; PG8_LDA(At, 0, 0); PG8_STAGE(PG8_SA(1, 1), ka1, oaC[1]);
            PG8_WAIT_V(8); PG8_WAIT_L(0); PG8_BAR; PG8_MMA(0, 0, At, B0); PG8_MMA(0, 1, At, B1); PG8_BAR; PG8_SCHED;
            PG8_LDA(At, 0, 1); PG8_STAGE(PG8_SB(0, 0), b2, voffB); PG8_STAGE(PG8_SB(0, 1), b2 + hstep, voffB); PG8_STAGE(PG8_SA(0, 0), ka2, o2[0]);
            PG8_WAIT_V(8); PG8_WAIT_L(0); PG8_BAR; PG8_MMA(1, 0, At, B0); PG8_MMA(1, 1, At, B1); PG8_BAR; PG8_SCHED;
            PG8_LDB(B0, 1, 0); PG8_LDB(B1, 1, 1); PG8_SCHED; PG8_LDA(At, 1, 0); PG8_STAGE(PG8_SA(0, 1), ka2, o2[1]);
            PG8_WAIT_V(8); PG8_WAIT_L(0); PG8_BAR; PG8_MMA(0, 0, At, B0); PG8_MMA(0, 1, At, B1); PG8_BAR; PG8_SCHED;
            PG8_LDA(At, 1, 1); PG8_STAGE(PG8_SB(1, 0), b3, voffB); PG8_STAGE(PG8_SB(1, 1), b3 + hstep, voffB); PG8_STAGE(PG8_SA(1, 0), ka3, o2[0]);
            PG8_WAIT_V(8); PG8_WAIT_L(0); PG8_BAR; PG8_MMA(1, 0, At, B0); PG8_MMA(1, 1, At, B1); PG8_BAR; PG8_SCHED;
        }
        if (wr == 0) PG8_BAR;
        E(acc, cur, wr, wc, fr, fq);
        if (!has_next) break;
#pragma unroll
        for (int a = 0; a < 2; ++a)
#pragma unroll
            for (int b = 0; b < 2; ++b)
#pragma unroll
                for (int m = 0; m < 4; ++m)
#pragma unroll
                    for (int n = 0; n < 2; ++n) acc[a][b][m][n] = (f32x4){0.f, 0.f, 0.f, 0.f};
        cur = nxt; cB = nB; ++ui;
#pragma unroll
        for (int _h = 0; _h < 2; ++_h)
#pragma unroll
            for (int _i = 0; _i < 2; ++_i) oaC[_h][_i] = oaN[_h][_i];
        if (wr == 1) PG8_BAR;
    }
    PG8_WAIT_V(0);
    PG8_BAR;
#undef PG8_SA
#undef PG8_SB
#undef PG8_STAGE
#undef PG8_LDA
#undef PG8_LDB
#undef PG8_MMA
#undef PG8_WAIT_V
#undef PG8_WAIT_L
#undef PG8_BAR
#undef PG8_SCHED
#undef PG8_AOFFS
}
}
#define GAS __attribute__((address_space(1)))
#define LAS __attribute__((address_space(3)))
typedef unsigned short bf16;
typedef unsigned v4u __attribute__((ext_vector_type(4)));
typedef unsigned v2u __attribute__((ext_vector_type(2)));
typedef float f32x4 __attribute__((ext_vector_type(4)));
typedef float f32x2 __attribute__((ext_vector_type(2)));
typedef GAS unsigned gu32;
#define RLX_AGENT __ATOMIC_RELAXED, __HIP_MEMORY_SCOPE_AGENT
#define LDS_WAIT() asm volatile("s_waitcnt lgkmcnt(0)" ::: "memory")
#define VM_WAIT() asm volatile("s_waitcnt vmcnt(0)" ::: "memory")
__device__ __forceinline__ unsigned f2bf(float f) { unsigned u = __builtin_bit_cast(unsigned, f); return (u + 0x7fffu + ((u >> 16) & 1u)) >> 16; }
__device__ __forceinline__ unsigned pk2(float lo, float hi) { return f2bf(lo) | (f2bf(hi) << 16); }
__device__ __forceinline__ float bf2f(bf16 h) { return __uint_as_float(((unsigned)h) << 16); }
__device__ __forceinline__ float bflo(unsigned w) { return __uint_as_float(w << 16); }
__device__ __forceinline__ float bfhi(unsigned w) { return __uint_as_float(w & 0xffff0000u); }

#define XB_TMO      128
#define XB_XCNT(j)  (256  + 64 * (j))
#define XB_XSUB(j)  (1280 + 64 * (j))
#define XB_XGEN(j)  (2304 + 64 * (j))
#define XB_TOP      3328
#define XB_TOPGEN   3392
#define XCD_BAR_WORDS 3456
#define XB_SPIN_CAP (1u << 18)

__device__ __forceinline__ unsigned xb_ld(unsigned* p)              { return __hip_atomic_load(p, __ATOMIC_RELAXED, __HIP_MEMORY_SCOPE_AGENT); }
__device__ __forceinline__ unsigned xb_add(unsigned* p, unsigned v) { return __hip_atomic_fetch_add(p, v, __ATOMIC_RELAXED, __HIP_MEMORY_SCOPE_AGENT); }
__device__ __forceinline__ unsigned xb_xcc_id() { return (unsigned)__builtin_amdgcn_s_getreg((3 << 11) | 20) & 0xFu; }
#define XB_SPIN(cond, bar) do { unsigned _sp = 0; while (cond) { __builtin_amdgcn_s_sleep(1); \
    if ((++_sp & 255u) == 0u) { if (xb_ld(&(bar)[XB_TMO])) break; if (_sp > XB_SPIN_CAP) { atomicAdd(&(bar)[XB_TMO], 1u); break; } } } } while (0)

struct XcdBarrier {
    unsigned* bar; unsigned x;
    volatile LAS unsigned* st;
};

__device__ __forceinline__ XcdBarrier xcd_barrier_post(unsigned* bar, volatile LAS unsigned* st, bool leader  ) {
    XcdBarrier b; b.bar = bar; b.x = xb_xcc_id(); b.st = st;
    if (leader) (void)xb_add(&bar[XB_XCNT(b.x)], 1u);
    return b;
}
__device__ __forceinline__ void xcd_barrier_complete(unsigned* bar, unsigned x, unsigned& nloc, unsigned& nx) {
    const unsigned G = gridDim.x * gridDim.y * gridDim.z;
    unsigned sum, cnt, mine, sp = 0u;
    for (;;) {
        sum = 0u; cnt = 0u; mine = 0u;
#pragma unroll
        for (unsigned j = 0; j < 16; ++j) { const unsigned c = xb_ld(&bar[XB_XCNT(j)]); sum += c; cnt += (c > 0u) ? 1u : 0u; mine = (j == x) ? c : mine; }
        if (sum == G) break;
        __builtin_amdgcn_s_sleep(1);
        if ((++sp & 255u) == 0u) { if (xb_ld(&bar[XB_TMO])) break; if (sp > XB_SPIN_CAP) { atomicAdd(&bar[XB_TMO], 1u); break; } }
    }
    nloc = mine > 0u ? mine : 1u; nx = cnt > 0u ? cnt : 1u;
}

__device__ __forceinline__ void xcd_barrier(const XcdBarrier& b, bool leader) {
    asm volatile("s_waitcnt vmcnt(0)" ::: "memory");
    __syncthreads();
    if (leader) {
        unsigned* bar = b.bar;
        __builtin_amdgcn_s_waitcnt(0);
        unsigned nloc = b.st[0], nx = b.st[1];
        if (nloc == 0u) { xcd_barrier_complete(bar, b.x, nloc, nx); b.st[0] = nloc; b.st[1] = nx; }
        const unsigned old = xb_add(&bar[XB_XSUB(b.x)], 1u);
        const unsigned gen = old / nloc;
        if (old + 1u == (gen + 1u) * nloc) {
            __builtin_amdgcn_fence(__ATOMIC_RELEASE, "agent");
            asm volatile("s_waitcnt vmcnt(0)" ::: "memory");
            const unsigned og = xb_add(&bar[XB_TOP], 1u);
            const unsigned tg = og / nx;
            if (og + 1u == (tg + 1u) * nx) xb_add(&bar[XB_TOPGEN], 1u);
            else XB_SPIN(xb_ld(&bar[XB_TOPGEN]) == tg, bar);
            __builtin_amdgcn_fence(__ATOMIC_ACQUIRE, "agent");
            xb_add(&bar[XB_XGEN(b.x)], 1u);
            asm volatile("s_waitcnt vmcnt(0)" ::: "memory");
        } else {
            XB_SPIN(xb_ld(&bar[XB_XGEN(b.x)]) == gen, bar);
            __builtin_amdgcn_fence(__ATOMIC_ACQUIRE, "agent");
            asm volatile("s_waitcnt vmcnt(0)" ::: "memory");
        }
    }
    __syncthreads();
}

__device__ __forceinline__ int lane_id() { int l; asm volatile("v_mbcnt_lo_u32_b32 %0, -1, 0\n\tv_mbcnt_hi_u32_b32 %0, -1, %0" : "=v"(l)); return l; }

constexpr int NB = 16, TT = 2048, DM = 1024, MR = NB * TT, NMETA = 16, MROWS = MR + 256, NPAN = MROWS / 256;
constexpr int PSEQ = 2112, NCH = 33;
constexpr int DIN = 2864, N1 = 3072;
constexpr int DFF = 2816, DFE = 3584, NEXP = 8;
constexpr float EPS = 1e-6f;
constexpr int C_AQ = 0, C_AK = 128, C_AV = 256, C_ALR = 512, C_AOG = 528, C_RQ = 784, C_RK = 1040, C_RV = 1296, C_ROG = 1552, C_CQ = 1808, C_CKV = 2000, C_KPE = 2064, C_DQ = 2096, C_DK = 2352, C_DV = 2608;
constexpr int MAXPAN = 264;
constexpr float LOG2E = 1.4426950408889634f;

constexpr size_t MiB = 1u << 20;
constexpr size_t WS_CTL = 0, CTL_BYTES = 1 * MiB;
constexpr size_t WS_TABR = 1 * MiB, WS_TABM = 1 * MiB + 576 * 1024;
constexpr size_t WS_RT = 2 * MiB;
constexpr size_t WS_WQA = 2 * MiB + 256 * 1024, WQA_BYTES = 384 * 192 * 2;
constexpr size_t WS_STA = 3 * MiB, WS_STB = 6 * MiB;
constexpr size_t WS_MOE = 9 * MiB;
constexpr size_t MO_ROWIDX = WS_MOE, MO_PDST = WS_MOE + 512 * 1024, MO_PINFO = WS_MOE + 1 * MiB, MO_TOKE = WS_MOE + 2 * MiB, MO_TOKP = MO_TOKE + 256 * 1024, MO_TOKW = MO_TOKE + 512 * 1024, MO_PEXP = WS_MOE + 3 * MiB;
constexpr size_t WS_GD = 13 * MiB;
constexpr size_t WS_W1T = 16 * MiB, W1T_BYTES = (size_t)N1 * DM * 2;
constexpr size_t WS_WOT = 29 * MiB, WOT_BYTES = (size_t)DM * DM * 2;
constexpr size_t WS_WGU = 33 * MiB;
constexpr size_t WS_WD = 44 * MiB;
constexpr size_t WS_HB = 50 * MiB;
constexpr size_t WS_BIG = 115 * MiB;
constexpr size_t B_PROJ = WS_BIG;
constexpr int GQ_T = 5120, GKT_T = 5120, RT_T = 9216, VT_T = 9216;
constexpr size_t B_GQ = WS_BIG + 210 * MiB, B_GK = WS_BIG + 221 * MiB, B_GV = WS_BIG + 232 * MiB;
constexpr size_t B_RQ = WS_BIG + 251 * MiB, B_RK = WS_BIG + 270 * MiB, B_RV = WS_BIG + 289 * MiB;
constexpr size_t B_MQ = WS_BIG + 308 * MiB, B_MK = WS_BIG + 333 * MiB;
constexpr size_t B_DQ = WS_BIG + 340 * MiB, B_DK = B_DQ + 16896 * 1024;
constexpr size_t O_DVT = 65 * MiB, O_MVT = 82 * MiB, O_GKT = 87 * MiB, O_RKT = 98 * MiB;
constexpr size_t B_ACT = WS_BIG;
constexpr size_t B_EGU = WS_BIG, EGU_BYTES = (size_t)2 * DFE * DM * 2;
constexpr size_t B_ED = WS_BIG + 112 * MiB, ED_BYTES = (size_t)DM * DFE * 2;
constexpr size_t B_EACT = WS_BIG + 168 * MiB;
constexpr size_t WS_NEED = WS_BIG + 406 * MiB;
constexpr int CW_BAR = 4096, CW_CNT = 8192;

constexpr int RING_BYTES = 131072, MISC_OFF = RING_BYTES + 320, LDS_BYTES = 147456;

__device__ __forceinline__ float silu_f(float x) { return x * __builtin_amdgcn_rcpf(1.0f + __builtin_amdgcn_exp2f(-x * LOG2E)); }
__device__ __forceinline__ v4u pack8(const f32x4 a, const f32x4 b) { v4u w; w.x = pg8::cvt_pk_bf16(a[0], a[1]); w.y = pg8::cvt_pk_bf16(a[2], a[3]); w.z = pg8::cvt_pk_bf16(b[0], b[1]); w.w = pg8::cvt_pk_bf16(b[2], b[3]); return w; }

__device__ __forceinline__ void rows_rstd16(const float* stats, int row0, int fq, float (&rs)[8]) {
    f32x4 v[8];
#pragma unroll
    for (int j = 0; j < 8; ++j) v[j] = *(const f32x4*)(stats + (size_t)(row0 + (j >> 2) * 128 + (j & 3) * 16) * 16 + 4 * fq);
#pragma unroll
    for (int j = 0; j < 8; ++j) { float s = (v[j][0] + v[j][1]) + (v[j][2] + v[j][3]); s += __shfl_xor(s, 16); s += __shfl_xor(s, 32); rs[j] = __builtin_amdgcn_rsqf(s * (1.0f / 1024.0f) + EPS); }
}
struct EpiProj {
    bf16* O; const float* stats;
    __device__ __forceinline__ void operator()(const f32x4 (&acc)[2][2][4][2], const pg8::Unit& u, int wr, int wc, int fr, int fq) const {
        const int col0 = u.pn * 256 + wc * 32 + 8 * fq, row0 = u.pm * 256 + wr * 64 + fr;
        float rs[8]; rows_rstd16(stats, row0, fq, rs);
#pragma unroll
        for (int ai = 0; ai < 2; ++ai)
#pragma unroll
            for (int m = 0; m < 4; ++m) { const int r = row0 + ai * 128 + m * 16; const float sc = rs[ai * 4 + m]; bf16* rowp = O + (size_t)r * N1 + col0;
#pragma unroll
                for (int bj = 0; bj < 2; ++bj) *(v4u*)(rowp + bj * 128) = pack8(acc[ai][bj][m][0] * sc, acc[ai][bj][m][1] * sc); }
    }
};
struct EpiSwiglu {
    bf16* O; int ldo; const float* stats;
    __device__ __forceinline__ void operator()(const f32x4 (&acc)[2][2][4][2], const pg8::Unit& u, int wr, int wc, int fr, int fq) const {
        const int col0 = u.pn * 128 + wc * 32 + 8 * fq, row0 = u.pm * 256 + wr * 64 + fr;
        float rs[8]; rows_rstd16(stats, row0, fq, rs);
#pragma unroll
        for (int ai = 0; ai < 2; ++ai)
#pragma unroll
            for (int m = 0; m < 4; ++m) { const int r = row0 + ai * 128 + m * 16; const float sc = rs[ai * 4 + m];
                f32x4 o[2];
#pragma unroll
                for (int n = 0; n < 2; ++n)
#pragma unroll
                    for (int i = 0; i < 4; ++i) o[n][i] = silu_f(acc[ai][0][m][n][i] * sc) * (acc[ai][1][m][n][i] * sc);
                *(v4u*)(O + (size_t)r * ldo + col0) = pack8(o[0], o[1]); }
    }
};
struct EpiResid {
    bf16* H; float* stats;
    __device__ __forceinline__ void operator()(const f32x4 (&acc)[2][2][4][2], const pg8::Unit& u, int wr, int wc, int fr, int fq) const {
        const int col0 = u.pn * 256 + wc * 32 + 8 * fq, row0 = u.pm * 256 + wr * 64 + fr;
#pragma unroll
        for (int ai = 0; ai < 2; ++ai) {
            v4u w[4][2];
#pragma unroll
            for (int m = 0; m < 4; ++m)
#pragma unroll
                for (int bj = 0; bj < 2; ++bj) w[m][bj] = *(const v4u*)(H + (size_t)(row0 + ai * 128 + m * 16) * DM + col0 + bj * 128);
            float ssm[4];
#pragma unroll
            for (int m = 0; m < 4; ++m) { bf16* rowp = H + (size_t)(row0 + ai * 128 + m * 16) * DM + col0; float ss = 0.f;
#pragma unroll
                for (int bj = 0; bj < 2; ++bj) { const v4u x = w[m][bj];
                    f32x4 a = acc[ai][bj][m][0], b = acc[ai][bj][m][1];
                    a[0] += bflo(x.x); a[1] += bfhi(x.x); a[2] += bflo(x.y); a[3] += bfhi(x.y); b[0] += bflo(x.z); b[1] += bfhi(x.z); b[2] += bflo(x.w); b[3] += bfhi(x.w);
                    ss += (a[0] * a[0] + a[1] * a[1]) + (a[2] * a[2] + a[3] * a[3]) + (b[0] * b[0] + b[1] * b[1]) + (b[2] * b[2] + b[3] * b[3]);
                    *(v4u*)(rowp + bj * 128) = pack8(a, b); }
                ss += __shfl_xor(ss, 16); ss += __shfl_xor(ss, 32); ssm[m] = ss; }
            if (fq == 0) {
#pragma unroll
                for (int m = 0; m < 4; ++m) stats[(size_t)(row0 + ai * 128 + m * 16) * 16 + u.pn * 4 + wc] = ssm[m]; } }
    }
};
struct EpiSwigluMoe {
    bf16* O; const f32x2* pinfo;
    __device__ __forceinline__ void operator()(const f32x4 (&acc)[2][2][4][2], const pg8::Unit& u, int wr, int wc, int fr, int fq) const {
        const int col0 = u.pn * 128 + wc * 32 + 8 * fq, rl0 = wr * 64 + fr;
        float rs[8];
#pragma unroll
        for (int j = 0; j < 8; ++j) rs[j] = pinfo[u.gp * 256 + rl0 + (j >> 2) * 128 + (j & 3) * 16][0];
#pragma unroll
        for (int ai = 0; ai < 2; ++ai)
#pragma unroll
            for (int m = 0; m < 4; ++m) { const int rl = rl0 + ai * 128 + m * 16; const float sc = rs[ai * 4 + m];
                f32x4 o[2];
#pragma unroll
                for (int n = 0; n < 2; ++n)
#pragma unroll
                    for (int i = 0; i < 4; ++i) o[n][i] = silu_f(acc[ai][0][m][n][i] * sc) * (acc[ai][1][m][n][i] * sc);
                *(v4u*)(O + (size_t)(u.pm * 256 + rl) * DFE + col0) = pack8(o[0], o[1]); }
    }
};
struct EpiMoeDown {
    unsigned char* Y; const int* pdst; const f32x2* pinfo;
    __device__ __forceinline__ void operator()(const f32x4 (&acc)[2][2][4][2], const pg8::Unit& u, int wr, int wc, int fr, int fq) const {
        const int col0 = u.pn * 256 + wc * 32 + 8 * fq, rl0 = wr * 64 + fr;
        int dst[8]; float wt[8];
#pragma unroll
        for (int j = 0; j < 8; ++j) { const int gi = u.gp * 256 + rl0 + (j >> 2) * 128 + (j & 3) * 16; dst[j] = pdst[gi]; wt[j] = pinfo[gi][1]; }
#pragma unroll
        for (int ai = 0; ai < 2; ++ai)
#pragma unroll
            for (int m = 0; m < 4; ++m) { const int d = dst[ai * 4 + m]; const float w = wt[ai * 4 + m];
                if (d >= 0) { bf16* rowp = (bf16*)(Y + (size_t)(d >> 1) * 4096 + (size_t)(d & 1) * 2048) + col0;
#pragma unroll
                    for (int bj = 0; bj < 2; ++bj) *(v4u*)(rowp + bj * 128) = pack8(acc[ai][bj][m][0] * w, acc[ai][bj][m][1] * w); } }
    }
};

__device__ __forceinline__ float wave_sum(float v) {
#pragma unroll
    for (int o = 1; o < 64; o <<= 1) v += __shfl_xor(v, o);
    return v;
}
__device__ __forceinline__ void transpose_item(const float* W, int K, int N, const float* gain, bf16* WT, int kb, int nb, int dmode, LAS float* scr_, int lane) {
    LAS unsigned* scr = (LAS unsigned*)scr_;
    const int k0 = 64 * kb, n0 = 64 * nb, n = n0 + 2 * (lane & 31), kh = lane >> 5;
    f32x2 v[32];
#pragma unroll
    for (int i = 0; i < 32; ++i) v[i] = (n < N) ? *(const f32x2*)(W + (size_t)(k0 + 2 * i + kh) * N + n) : (f32x2){0.f, 0.f};
    if (gain) {
#pragma unroll
        for (int i = 0; i < 32; ++i) v[i] = v[i] * gain[k0 + 2 * i + kh]; }
#pragma unroll
    for (int i = 0; i < 32; ++i) scr[(2 * i + kh) * 33 + (lane & 31)] = pk2(v[i][0], v[i][1]);
    LDS_WAIT(); asm volatile("" ::: "memory");
    const LAS bf16* T = (const LAS bf16*)scr;
    const int c = lane & 7;
    const int d0 = dmode == 0 ? n0 : 256 * (n0 >> 7) + (n0 & 127) + (dmode == 2 ? 128 : 0);
#pragma unroll
    for (int j = 0; j < 8; ++j) { const int nl = (lane >> 3) + 8 * j; unsigned x[8];
#pragma unroll
        for (int t = 0; t < 8; ++t) x[t] = T[(8 * c + t) * 66 + nl];
        v4u o; o.x = x[0] | (x[1] << 16); o.y = x[2] | (x[3] << 16); o.z = x[4] | (x[5] << 16); o.w = x[6] | (x[7] << 16);
        if (n0 + nl < N) *(v4u*)(WT + (size_t)(d0 + nl) * K + k0 + 8 * c) = o; }
    LDS_WAIT(); asm volatile("" ::: "memory");
}

struct Args { const float* in[24]; float* out; unsigned char* ws; int ph_lo, ph_hi; };
__device__ __forceinline__ const float* ain(const Args& a, int i) { return a.in[i]; }
enum { I_X = 0, I_META, I_ANORM, I_WIN, I_GWG, I_GBG, I_GNORM, I_RNORM, I_MQN, I_WUQ, I_MKVN, I_WUKV, I_DLAM, I_DNORM, I_WOUT, I_FNORM, I_FG, I_FU, I_FD, I_ROUTER, I_EG, I_EU, I_ED, I_FINAL };

#ifndef REP_FOLD
#define REP_FOLD 1
#endif
#ifndef REP_HINIT
#define REP_HINIT 1
#endif
__device__ __forceinline__ void wqa_unit(const Args& a, int li, int hh, LAS float* L, int tid) {
    const float* Wuq = ain(a, I_WUQ) + (size_t)li * 192 * 384; const float* Wukv = ain(a, I_WUKV) + (size_t)li * 64 * 512;
    const float* gq = ain(a, I_MQN) + li * 192; const float* gkv = ain(a, I_MKVN) + li * 64;
    bf16* WqaT = (bf16*)(a.ws + WS_WQA + li * WQA_BYTES);
    LAS float* Wqa = L; LAS float* Wuk = L + 192 * 97;
    __syncthreads();
    for (int idx = tid; idx < 64 * 64; idx += 512) { const int n = idx >> 6, m = idx & 63; Wuk[n * 65 + m] = Wukv[n * 512 + hh * 128 + m]; }
    __syncthreads();
    for (int pass = 0; pass < 3; ++pass) { const int i = pass * 64 + (tid >> 3), ng = tid & 7; f32x4 wq[16];
#pragma unroll
        for (int j = 0; j < 16; ++j) wq[j] = *(const f32x4*)(Wuq + i * 384 + hh * 96 + 4 * j);
        const float gi = gq[i];
#pragma unroll
        for (int t = 0; t < 8; ++t) { const int n = ng * 8 + t; float s = 0.f;
#pragma unroll
            for (int j = 0; j < 16; ++j) s += (wq[j][0] * Wuk[n * 65 + 4 * j] + wq[j][1] * Wuk[n * 65 + 4 * j + 1]) + (wq[j][2] * Wuk[n * 65 + 4 * j + 2] + wq[j][3] * Wuk[n * 65 + 4 * j + 3]);
            Wqa[i * 97 + n] = gi * gkv[n] * s; }
        if (ng < 4) {
#pragma unroll
            for (int j = 0; j < 2; ++j) { const f32x4 r = *(const f32x4*)(Wuq + i * 384 + hh * 96 + 64 + ng * 8 + 4 * j); LAS float* d = Wqa + i * 97 + 64 + ng * 8 + 4 * j; d[0] = gi * r[0]; d[1] = gi * r[1]; d[2] = gi * r[2]; d[3] = gi * r[3]; } } }
    __syncthreads();
    for (int idx = tid; idx < 96 * 24; idx += 512) { const int n = idx % 96, i8 = idx / 96; float v[8];
#pragma unroll
        for (int t = 0; t < 8; ++t) v[t] = Wqa[(8 * i8 + t) * 97 + n];
        v4u w; w.x = pk2(v[0], v[1]); w.y = pk2(v[2], v[3]); w.z = pk2(v[4], v[5]); w.w = pk2(v[6], v[7]);
        *(v4u*)(WqaT + (size_t)(hh * 96 + n) * 192 + 8 * i8) = w; }
    __syncthreads();
}
__device__ __forceinline__ void wofold_unit(const Args& a, int li, int hh, int nq, LAS float* L, int tid) {
    const float* Wukv = ain(a, I_WUKV) + (size_t)li * 64 * 512; const float* gkv = ain(a, I_MKVN) + li * 64; const float* Wo = ain(a, I_WOUT) + (size_t)li * DM * DM;
    bf16* Wot = (bf16*)(a.ws + WS_WOT + li * WOT_BYTES);
    LAS float* WuvT = L; LAS float* Wos = L + 64 * 64;
    __syncthreads();
    for (int idx = tid; idx < 64 * 64; idx += 512) { const int j = idx >> 6, e = idx & 63; WuvT[e * 64 + j] = Wukv[j * 512 + hh * 128 + 64 + e] * gkv[j]; }
    for (int idx = tid; idx < 64 * 64; idx += 512) { const int e = idx >> 6, n4 = idx & 63; *(LAS f32x4*)(Wos + e * 256 + 4 * n4) = *(const f32x4*)(Wo + (size_t)(512 + 64 * hh + e) * DM + nq * 256 + 4 * n4); }
    __syncthreads();
    { const int n4 = tid & 63, j8 = tid >> 6; f32x4 acc[8];
#pragma unroll
        for (int j = 0; j < 8; ++j) acc[j] = (f32x4){0.f, 0.f, 0.f, 0.f};
#pragma unroll 4
        for (int e = 0; e < 64; ++e) { const f32x4 wv = *(const LAS f32x4*)(Wos + e * 256 + 4 * n4); const f32x4 u0 = *(const LAS f32x4*)(WuvT + e * 64 + 8 * j8), u1 = *(const LAS f32x4*)(WuvT + e * 64 + 8 * j8 + 4);
#pragma unroll
            for (int j = 0; j < 4; ++j) { acc[j] += wv * u0[j]; acc[4 + j] += wv * u1[j]; } }
#pragma unroll
        for (int t = 0; t < 4; ++t) { v4u w; w.x = pk2(acc[0][t], acc[1][t]); w.y = pk2(acc[2][t], acc[3][t]); w.z = pk2(acc[4][t], acc[5][t]); w.w = pk2(acc[6][t], acc[7][t]);
            *(v4u*)(Wot + (size_t)(nq * 256 + 4 * n4 + t) * DM + 512 + 64 * hh + 8 * j8) = w; } }
    __syncthreads();
}
__device__ __forceinline__ void p0_prologue(const Args& a, LAS unsigned char* lds, int tid, int lane, int wave) {
    const int G = gridDim.x;
    for (int rep = 0; rep < REP_FOLD; ++rep)
    for (int un = blockIdx.x; un < 40; un += G) {
        if (un < 8) wqa_unit(a, un >> 2, un & 3, (LAS float*)lds, tid);
        else { const int v = un - 8; wofold_unit(a, v >> 4, (v >> 2) & 3, v & 3, (LAS float*)lds, tid); }
    }
    __syncthreads();
    LAS float* scr = (LAS float*)(lds + wave * 16384);
    const int gw = blockIdx.x * 8 + wave, NGW = G * 8;
    constexpr int I_IN = 16 * 45, I_WO = 12 * 16, I_G = 16 * 44, I_D = 44 * 16;
    constexpr int NIT = 2 * I_IN + 2 * I_WO + 2 * I_G + I_D;
    for (int it = gw; it < NIT; it += NGW) {
        int r = it;
        if (r < 2 * I_IN) { const int li = r / I_IN; r %= I_IN; transpose_item(ain(a, I_WIN) + (size_t)li * DM * DIN, DM, DIN, ain(a, I_ANORM) + li * DM, (bf16*)(a.ws + WS_W1T + li * W1T_BYTES), r / 45, r % 45, 0, scr, lane); continue; } r -= 2 * I_IN;
        if (r < 2 * I_WO) { const int li = r / I_WO; r %= I_WO; int kb = r / 16; if (kb >= 8) kb += 4; transpose_item(ain(a, I_WOUT) + (size_t)li * DM * DM, DM, DM, nullptr, (bf16*)(a.ws + WS_WOT + li * WOT_BYTES), kb, r % 16, 0, scr, lane); continue; } r -= 2 * I_WO;
        if (r < I_G) { transpose_item(ain(a, I_FG), DM, DFF, ain(a, I_FNORM), (bf16*)(a.ws + WS_WGU), r / 44, r % 44, 1, scr, lane); continue; } r -= I_G;
        if (r < I_G) { transpose_item(ain(a, I_FU), DM, DFF, ain(a, I_FNORM), (bf16*)(a.ws + WS_WGU), r / 44, r % 44, 2, scr, lane); continue; } r -= I_G;
        transpose_item(ain(a, I_FD), DFF, DM, nullptr, (bf16*)(a.ws + WS_WD), r / 16, r % 16, 0, scr, lane);
    }
    const int gt = blockIdx.x * 512 + tid, NGT = G * 512;
    for (int i = gt; i < 2 * 208 * 128; i += NGT) { const int li = i / (208 * 128), r = i % (208 * 128);
        *(v4u*)(a.ws + WS_W1T + li * W1T_BYTES + (size_t)DIN * DM * 2 + (size_t)r * 16) = (v4u){0u, 0u, 0u, 0u}; }
    for (int i = gt; i < 8 * DM; i += NGT) { const int e = i >> 10, k = i & 1023; ((float*)(a.ws + WS_RT))[i] = ain(a, I_FNORM)[DM + k] * ain(a, I_ROUTER)[k * 8 + e]; }
    for (int i = gt; i < PSEQ * 48; i += NGT) { const int p = i / 48, j = i % 48; const bool isR = j < 32; const int f = isR ? j : j - 32;
        const float inv = __builtin_amdgcn_exp2f(-(float)f * (isR ? 13.287712379549449f / 32.f : 13.287712379549449f / 16.f));
        const double rev = (double)(p - 48) * (double)inv * 0.15915494309189535; const float fr = (float)(rev - __builtin_rint(rev));
        const f32x2 cs = {__builtin_amdgcn_cosf(fr), __builtin_amdgcn_sinf(fr)};
        if (isR) ((f32x2*)(a.ws + WS_TABR))[p * 32 + f] = cs; else ((f32x2*)(a.ws + WS_TABM))[p * 16 + f] = cs; }
    for (int i = gt; i < 240 * 128; i += NGT) *(v4u*)((unsigned char*)a.out + (size_t)(MR + 16) * 2048 + (size_t)i * 16) = (v4u){0u, 0u, 0u, 0u};
    bf16* hb = (bf16*)(a.ws + WS_HB); float* stA = (float*)(a.ws + WS_STA);
    for (int rep = 0; rep < REP_HINIT; ++rep)
    for (int r = gw; r < MROWS; r += NGW) {
        f32x4 v[4]; float s = 0.f;
#pragma unroll
        for (int j = 0; j < 4; ++j) { if (r < MR) v[j] = ((const f32x4*)(ain(a, I_X) + (size_t)r * DM))[lane + 64 * j]; else if (r < MR + NMETA) v[j] = ((const f32x4*)(ain(a, I_META) + (size_t)(r - MR) * DM))[lane + 64 * j]; else v[j] = (f32x4){0.f, 0.f, 0.f, 0.f};
            s += (v[j][0] * v[j][0] + v[j][1] * v[j][1]) + (v[j][2] * v[j][2] + v[j][3] * v[j][3]); }
        s = wave_sum(s);
#pragma unroll
        for (int j = 0; j < 4; ++j) { v2u w; w.x = pk2(v[j][0], v[j][1]); w.y = pk2(v[j][2], v[j][3]); ((v2u*)(hb + (size_t)r * DM))[lane + 64 * j] = w; }
        if (lane < 16) stA[(size_t)r * 16 + lane] = lane == 0 ? s : 0.f;
    }
}

__device__ __forceinline__ int src_row(int b, int c, int i) { return c == 0 ? (i < 48 ? -1 : MR + i - 48) : b * TT + 64 * (c - 1) + i; }
__device__ __forceinline__ float lg2gamma(int h) { return h == 0 ? -0.045803689613124789f : h == 1 ? -0.022720076500083529f : h == 2 ? -0.011315313227834146f : -0.0056465631411420627f; }

__device__ __forceinline__ void route_block(const Args& a, int blk, LAS unsigned char* lds, int tid, int lane, int wave) {
    LAS float* Rs = (LAS float*)lds; LAS int* lcnt = (LAS int*)(lds + 32768); LAS int* gbase = lcnt + 8; LAS int* rec = lcnt + 16;
    gu32* ctl = (gu32*)(a.ws + WS_CTL);
    const float* Rt = (const float*)(a.ws + WS_RT); const bf16* hb = (const bf16*)(a.ws + WS_HB); const float* stB = (const float*)(a.ws + WS_STB);
    __syncthreads();
    for (int idx = tid; idx < 8 * DM; idx += 512) Rs[idx] = Rt[idx];
    if (tid < 8) lcnt[tid] = 0;
    __syncthreads();
    for (int rr = 0; rr < 16; ++rr) { const int rl = wave * 16 + rr, row = blk * 128 + rl;
        const v4u w0 = *(const v4u*)(hb + (size_t)row * DM + 8 * lane), w1 = *(const v4u*)(hb + (size_t)row * DM + 512 + 8 * lane);
        const float x[16] = {bflo(w0.x), bfhi(w0.x), bflo(w0.y), bfhi(w0.y), bflo(w0.z), bfhi(w0.z), bflo(w0.w), bfhi(w0.w), bflo(w1.x), bfhi(w1.x), bflo(w1.y), bfhi(w1.y), bflo(w1.z), bfhi(w1.z), bflo(w1.w), bfhi(w1.w)};
        float st = lane < 16 ? stB[(size_t)row * 16 + lane] : 0.f; st = wave_sum(st); const float rs = __builtin_amdgcn_rsqf(st * (1.f / 1024.f) + EPS);
        float lg[8];
#pragma unroll
        for (int e = 0; e < 8; ++e) { float s = 0.f;
#pragma unroll
            for (int t = 0; t < 8; ++t) s += x[t] * Rs[e * DM + 8 * lane + t] + x[8 + t] * Rs[e * DM + 512 + 8 * lane + t];
            lg[e] = wave_sum(s) * rs; }
        int e0 = 0; float v0 = lg[0];
#pragma unroll
        for (int e = 1; e < 8; ++e) if (lg[e] > v0) { v0 = lg[e]; e0 = e; }
        int e1 = -1; float v1 = -3.0e38f;
#pragma unroll
        for (int e = 0; e < 8; ++e) if (e != e0 && lg[e] > v1) { v1 = lg[e]; e1 = e; }
        const float g0 = 1.f / (1.f + __expf(v1 - v0)), g1 = 1.f - g0;
        if (lane == 0) { const int lp0 = atomicAdd((int*)(lcnt + e0), 1), lp1 = atomicAdd((int*)(lcnt + e1), 1);
            rec[rl * 6] = e0; rec[rl * 6 + 1] = e1; rec[rl * 6 + 2] = lp0; rec[rl * 6 + 3] = lp1; rec[rl * 6 + 4] = __float_as_int(g0); rec[rl * 6 + 5] = __float_as_int(g1); } }
    __syncthreads();
    if (tid < 8) gbase[tid] = (int)__hip_atomic_fetch_add(ctl + CW_CNT + 64 * tid, (unsigned)lcnt[tid], RLX_AGENT);
    __syncthreads();
    if (tid < 256) { const int rl = tid >> 1, s = tid & 1, tok = blk * 128 + rl, e = rec[rl * 6 + s];
        ((int*)(a.ws + MO_TOKE))[tok * 2 + s] = e; ((int*)(a.ws + MO_TOKP))[tok * 2 + s] = gbase[e] + rec[rl * 6 + 2 + s]; ((int*)(a.ws + MO_TOKW))[tok * 2 + s] = rec[rl * 6 + 4 + s]; }
    __syncthreads();
}
__device__ __forceinline__ void moe_offsets(const Args& a, LAS int* offs, int tid) {
    gu32* ctl = (gu32*)(a.ws + WS_CTL);
    __syncthreads();
    if (tid == 0) { int o = 0;
        for (int e = 0; e < 8; ++e) { const int cnt = (int)__hip_atomic_load(ctl + CW_CNT + 64 * e, RLX_AGENT); offs[e] = o * 256; o += (cnt + 255) >> 8; }
        offs[8] = o; }
    __syncthreads();
}

typedef float f32x16 __attribute__((ext_vector_type(16)));
typedef short s16x8 __attribute__((ext_vector_type(8)));
typedef short s16x4 __attribute__((ext_vector_type(4)));
typedef short v4i16_t __attribute__((ext_vector_type(4)));
__device__ __forceinline__ int crow(int r, int hi) { return (r & 3) + 8 * (r >> 2) + 4 * hi; }


__device__ __forceinline__ void stage_cols(const bf16* proj, int b, int c, int col0, int ncols, LAS bf16* S, int sst, int lcol0, int tid) {
    const int cpr = ncols >> 3;
    for (int idx = tid; idx < 64 * cpr; idx += 512) { const int i = idx / cpr, ch = idx - i * cpr, sr = src_row(b, c, i);
        v4u v = {0u, 0u, 0u, 0u}; if (sr >= 0) v = *(const v4u*)(proj + (size_t)sr * N1 + col0 + ch * 8);
        *(LAS v4u*)(S + i * sst + lcol0 + ch * 8) = v; }
}
__device__ __forceinline__ v4u gather8(const LAS bf16* S, int sst, int row0, int col) {
    unsigned x[8];
#pragma unroll
    for (int t = 0; t < 8; ++t) x[t] = S[(row0 + t) * sst + col];
    v4u w; w.x = x[0] | (x[1] << 16); w.y = x[2] | (x[3] << 16); w.z = x[4] | (x[5] << 16); w.w = x[6] | (x[7] << 16); return w;
}
__device__ __forceinline__ void prep2_unit(const Args& a, int li, int b, int c, int part, LAS unsigned char* lds, int tid) {
    const bf16* proj = (const bf16*)(a.ws + B_PROJ);
    LAS bf16* S = (LAS bf16*)lds;
    const int blk0 = (b * NCH + c) * 4; const size_t prow0 = (size_t)b * PSEQ + 64 * c;
    unsigned char* dout = (unsigned char*)a.out;
    __syncthreads();
    if (part == 0) {
        constexpr int SST = 536; LAS float* seg = (LAS float*)(lds + 64 * SST * 2);
        stage_cols(proj, b, c, C_AQ, 128, S, SST, 0, tid); stage_cols(proj, b, c, C_AK, 128, S, SST, 128, tid); stage_cols(proj, b, c, C_ALR, 16, S, SST, 512, tid);
        __syncthreads();
        { const int ch = tid & 127, sg = tid >> 7; const float* Wg = ain(a, I_GWG) + (size_t)li * 16 * 128; const float bg = ain(a, I_GBG)[li * 128 + ch];
            float wg[16];
#pragma unroll
            for (int r = 0; r < 16; ++r) wg[r] = Wg[r * 128 + ch];
            float cl[16]; float run = 0.f;
#pragma unroll
            for (int t = 0; t < 16; ++t) { const int i = 16 * sg + t; const v4u l0 = *(const LAS v4u*)(S + i * SST + 512), l1 = *(const LAS v4u*)(S + i * SST + 520);
                float x = bg + bflo(l0.x) * wg[0] + bfhi(l0.x) * wg[1] + bflo(l0.y) * wg[2] + bfhi(l0.y) * wg[3] + bflo(l0.z) * wg[4] + bfhi(l0.z) * wg[5] + bflo(l0.w) * wg[6] + bfhi(l0.w) * wg[7]
                               + bflo(l1.x) * wg[8] + bfhi(l1.x) * wg[9] + bflo(l1.y) * wg[10] + bfhi(l1.y) * wg[11] + bflo(l1.z) * wg[12] + bfhi(l1.z) * wg[13] + bflo(l1.w) * wg[14] + bfhi(l1.w) * wg[15];
                const float ls = fminf(x, 0.f) - __logf(1.f + __expf(-fabsf(x)));
                run += (c > 0 || i >= 48) ? ls * (1.f / 16.f) : 0.f; cl[t] = run; }
            seg[sg * 128 + ch] = run;
            __syncthreads();
            float off = 0.f;
#pragma unroll
            for (int s2 = 0; s2 < 3; ++s2) off += s2 < sg ? seg[s2 * 128 + ch] : 0.f;
            if (sg == 3) ((float*)(a.ws + WS_GD))[(size_t)(blk0 + (ch >> 5)) * 32 + (ch & 31)] = __expf(off + run);
#pragma unroll
            for (int t = 0; t < 16; ++t) { const int i = 16 * sg + t; const float cum = cl[t] + off;
                S[i * SST + ch] = (bf16)f2bf(bf2f(S[i * SST + ch]) * 0.17677669529663687f * __expf(cum)); S[i * SST + 128 + ch] = (bf16)f2bf(bf2f(S[i * SST + 128 + ch]) * __expf(-cum)); } }
        __syncthreads();
        for (int idx = tid; idx < 1024; idx += 512) { const int d8 = idx & 3, i = (idx >> 2) & 63, h = idx >> 8;
            *(v4u*)(a.ws + B_GQ + (size_t)(blk0 + h) * GQ_T + i * 80 + 16 * d8) = *(const LAS v4u*)(S + i * SST + h * 32 + 8 * d8);
            *(v4u*)(a.ws + B_GK + (size_t)(blk0 + h) * GQ_T + i * 80 + 16 * d8) = *(const LAS v4u*)(S + i * SST + 128 + h * 32 + 8 * d8); }
    } else if (part == 1) {
        constexpr int SST = 776;
        stage_cols(proj, b, c, C_RQ, 256, S, SST, 0, tid); stage_cols(proj, b, c, C_RK, 256, S, SST, 256, tid);
        LAS f32x4* tabL = (LAS f32x4*)(lds + 64 * SST * 2);
        for (int idx = tid; idx < 64 * 16; idx += 512) tabL[idx] = ((const f32x4*)(a.ws + WS_TABR))[(size_t)(64 * c) * 16 + idx];
        __syncthreads();
        const LAS f32x2* tabR = (const LAS f32x2*)tabL;
        for (int idx = tid; idx < 64 * 4 * 32; idx += 512) { const int j = idx & 31, h = (idx >> 5) & 3, i = idx >> 7; const f32x2 cs = tabR[i * 32 + j];
            LAS bf16* qp = S + i * SST + h * 64 + j; LAS bf16* kp = qp + 256;
            const float a1 = bf2f(qp[0]), a2 = bf2f(qp[32]), b1 = bf2f(kp[0]), b2 = bf2f(kp[32]);
            const float e = (float)(i + 1) * lg2gamma(h); const float fq = __builtin_amdgcn_exp2f(e), fk = 0.125f * __builtin_amdgcn_exp2f(-e);
            qp[0] = (bf16)f2bf((a1 * cs[0] - a2 * cs[1]) * fq); qp[32] = (bf16)f2bf((a1 * cs[1] + a2 * cs[0]) * fq); kp[0] = (bf16)f2bf((b1 * cs[0] - b2 * cs[1]) * fk); kp[32] = (bf16)f2bf((b1 * cs[1] + b2 * cs[0]) * fk); }
        __syncthreads();
        for (int idx = tid; idx < 2048; idx += 512) { const int d8 = idx & 7, i = (idx >> 3) & 63, h = idx >> 9;
            *(v4u*)(a.ws + B_RQ + (size_t)(blk0 + h) * RT_T + i * 144 + 16 * d8) = *(const LAS v4u*)(S + i * SST + h * 64 + 8 * d8);
            *(v4u*)(a.ws + B_RK + (size_t)(blk0 + h) * RT_T + i * 144 + 16 * d8) = *(const LAS v4u*)(S + i * SST + 256 + h * 64 + 8 * d8); }
    } else if (part == 2) {
        constexpr int SST = 296, OFF_RSD = 64 * SST * 2, OFF_TAB = OFF_RSD + 512, OFF_QS = OFF_TAB + 8192, QSS = 392;
        LAS float* rsd = (LAS float*)(lds + OFF_RSD); LAS f32x4* tabL = (LAS f32x4*)(lds + OFF_TAB); LAS bf16* Qs = (LAS bf16*)(lds + OFF_QS);
        stage_cols(proj, b, c, C_CQ, 192, S, SST, 0, tid); stage_cols(proj, b, c, C_CKV, 64, S, SST, 192, tid); stage_cols(proj, b, c, C_KPE, 32, S, SST, 256, tid);
        for (int idx = tid; idx < 64 * 8; idx += 512) tabL[idx] = ((const f32x4*)(a.ws + WS_TABM))[(size_t)(64 * c) * 8 + idx];
        __syncthreads();
        { const int i = tid >> 3, g = tid & 7; float sq = 0.f, sk = 0.f;
#pragma unroll
            for (int t = 0; t < 24; ++t) { const float v = bf2f(S[i * SST + g * 24 + t]); sq += v * v; }
#pragma unroll
            for (int t = 0; t < 8; ++t) { const float v = bf2f(S[i * SST + 192 + g * 8 + t]); sk += v * v; }
            sq += __shfl_xor(sq, 1); sq += __shfl_xor(sq, 2); sq += __shfl_xor(sq, 4); sk += __shfl_xor(sk, 1); sk += __shfl_xor(sk, 2); sk += __shfl_xor(sk, 4);
            if (g == 0) { rsd[i * 2] = __builtin_amdgcn_rsqf(sq * (1.f / 192.f) + EPS); rsd[i * 2 + 1] = __builtin_amdgcn_rsqf(sk * (1.f / 64.f) + EPS); } }
        __syncthreads();
        const LAS f32x2* tabM = (const LAS f32x2*)tabL; const float QS = 0.10206207261596577f * LOG2E;
        {
            const int lane = tid & 63, w = __builtin_amdgcn_readfirstlane(tid >> 6), r32 = lane & 31, hi = lane >> 5, ib = w & 1, nb0 = (w >> 1) * 3;
            const bf16* WqaT = (const bf16*)(a.ws + WS_WQA + li * WQA_BYTES);
            s16x8 af[12];
#pragma unroll
            for (int ks = 0; ks < 12; ++ks) af[ks] = *(const LAS s16x8*)(S + (32 * ib + r32) * SST + 16 * ks + 8 * hi);
            f32x16 acc[3];
#pragma unroll
            for (int j = 0; j < 3; ++j) { acc[j] = (f32x16){};
                s16x8 bfr[12];
#pragma unroll
                for (int ks = 0; ks < 12; ++ks) bfr[ks] = *(const s16x8*)(WqaT + (size_t)(32 * (nb0 + j) + r32) * 192 + 16 * ks + 8 * hi);
#pragma unroll
                for (int ks = 0; ks < 12; ++ks) acc[j] = __builtin_amdgcn_mfma_f32_32x32x16_bf16(af[ks], bfr[ks], acc[j], 0, 0, 0); }
            asm volatile("s_nop 15\n\ts_nop 7" : "+v"(acc[0]), "+v"(acc[1]), "+v"(acc[2]));
#pragma unroll
            for (int j = 0; j < 3; ++j)
#pragma unroll
                for (int r = 0; r < 16; ++r) { const int i = 32 * ib + crow(r, hi); float v = acc[j][r] * (rsd[i * 2] * QS);
                    if (j == 2) { const float o = __shfl_xor(v, 16); const f32x2 cs = tabM[i * 16 + (r32 & 15)]; v = r32 < 16 ? v * cs[0] - o * cs[1] : o * cs[1] + v * cs[0]; }
                    Qs[i * QSS + 32 * (nb0 + j) + r32] = (bf16)f2bf(v); } }
        for (int idx = tid; idx < 64 * 12; idx += 512) { const int k8 = idx % 12, i = idx / 12; float y[8];
            if (k8 < 8) { const float s = rsd[i * 2 + 1];
#pragma unroll
                for (int t = 0; t < 8; ++t) y[t] = bf2f(S[i * SST + 192 + 8 * k8 + t]) * s; }
            else { const int kk = (k8 - 8) & 1, second = (k8 - 8) >> 1;
#pragma unroll
                for (int t = 0; t < 8; ++t) { const int j = 8 * kk + t; const f32x2 cs = tabM[i * 16 + j]; const float x1 = bf2f(S[i * SST + 256 + j]), x2 = bf2f(S[i * SST + 272 + j]); y[t] = second ? x1 * cs[1] + x2 * cs[0] : x1 * cs[0] - x2 * cs[1]; } }
            v4u w; w.x = pk2(y[0], y[1]); w.y = pk2(y[2], y[3]); w.z = pk2(y[4], y[5]); w.w = pk2(y[6], y[7]);
            *(v4u*)((bf16*)(a.ws + B_MK) + (prow0 + i) * 96 + 8 * k8) = w; }
        __syncthreads();
        for (int idx = tid; idx < 64 * 48; idx += 512) { const int c8 = idx % 48, i = idx / 48;
            *(v4u*)((bf16*)(a.ws + B_MQ) + (prow0 + i) * 384 + 8 * c8) = *(const LAS v4u*)(Qs + i * QSS + 8 * c8); }
    }
}

template <int KIND>
__device__ __forceinline__ void attn_mfma_unit(const Args& a, int li, int b, int hh, int qb  , LAS unsigned char* lds, int tid, float lam, float oscale) {
    constexpr int KW = KIND ? 64 : 96, KST = KW + 8, VST = 72, NMAP = KIND ? 2 : 1, DSTEPS = KIND ? 2 : 6;
    constexpr int KCH = KW / 8 + 1, NPIECE = KCH + (KIND ? 9 : 0), PPW = KIND ? 3 : 2, SLOT = NPIECE * 1024, NSLOT = 4, OFF_JUNK = NSLOT * SLOT, OFF_WS = OFF_JUNK + 6144, OSTW = 68, OFF_OST = KIND ? 0   : OFF_WS + 2048;
    static_assert(PPW * 8 >= NPIECE && PPW * 8 - NPIECE <= 6 && (KIND ? 8 * 32 * OSTW * 4 <= NSLOT * SLOT : OFF_OST + 8 * 32 * OSTW * 4 <= RING_BYTES) && OFF_WS + 8 * 256 <= RING_BYTES, "attention LDS map / pieces per wave");
    const int lane = tid & 63, w = __builtin_amdgcn_readfirstlane(tid >> 6), r32 = lane & 31, hi = lane >> 5;
    const int q0 = qb < 0 ? 0 : 64 + 256 * qb, NT = qb < 0 ? 1 : 5 + 4 * qb;
    const bool wact = qb >= 0 || w < 2;
    const int qpos = q0 + 32 * w + r32, wlast = (q0 + 32 * w + 31) >> 6;
    const size_t prow = (size_t)b * PSEQ + qpos;
    const bf16* proj = (const bf16*)(a.ws + B_PROJ);
    const bf16* Kg = KIND ? proj + C_DK + hh * 64 : (const bf16*)(a.ws + B_MK) + (size_t)b * PSEQ * 96;
    constexpr int KLD = KIND ? N1 : 96;
    const bf16* Vg = proj + C_DV + hh * 64;
#define ATT_SRCROW(t_, r_) (KIND ? ((t_) == 0 ? ((r_) < 48 ? MR : MR + (r_) - 48) : b * TT + 64 * ((t_) - 1) + (r_)) : 64 * (t_) + (r_))
    LAS float* wsf = (LAS float*)(lds + OFF_WS) + w * 64;
    LAS float* ost = (LAS float*)(lds + OFF_OST) + w * (32 * OSTW);
    s16x8 qf[NMAP][DSTEPS];
#pragma unroll
    for (int m = 0; m < NMAP; ++m)
#pragma unroll
        for (int ds = 0; ds < DSTEPS; ++ds) {
            const int qsr = qb >= 0 ? b * TT + qpos - 64 : (qpos >= 48 ? MR + qpos - 48 : MR);
            const bf16* qp = KIND ? proj + (size_t)qsr * N1 + C_DQ + hh * 64 + 32 * m + 16 * ds + 8 * hi : (const bf16*)(a.ws + B_MQ) + prow * 384 + hh * 96 + 16 * ds + 8 * hi;
            v4u qw = wact ? *(const v4u*)qp : (v4u){0u, 0u, 0u, 0u};
            if (KIND) { const float qs = 0.17677669529663687f * LOG2E;
                qw.x = pg8::cvt_pk_bf16(bflo(qw.x) * qs, bfhi(qw.x) * qs); qw.y = pg8::cvt_pk_bf16(bflo(qw.y) * qs, bfhi(qw.y) * qs); qw.z = pg8::cvt_pk_bf16(bflo(qw.z) * qs, bfhi(qw.z) * qs); qw.w = pg8::cvt_pk_bf16(bflo(qw.w) * qs, bfhi(qw.w) * qs); }
            qf[m][ds] = __builtin_bit_cast(s16x8, qw); }
    float mref[NMAP], lrun[NMAP]; f32x16 negm = (f32x16){}, o[NMAP][2];
#pragma unroll
    for (int m = 0; m < NMAP; ++m) { mref[m] = 0.f; lrun[m] = 0.f; o[m][0] = (f32x16){}; o[m][1] = (f32x16){}; }
#define ATT_DMA(t_) do { const int sl_ = ((t_) & 3) * SLOT; _Pragma("unroll") for (int j = 0; j < PPW; ++j) { const int p_ = __builtin_amdgcn_readfirstlane(w * PPW + j); \
        int row_, col_, dst_; const bf16* base_; int ld_; \
        if (p_ < KCH) { const int g = 64 * p_ + lane, cc = g % KCH; row_ = g / KCH; col_ = (cc < KCH - 1 ? cc : KCH - 2) * 8; dst_ = sl_ + p_ * 1024; base_ = Kg; ld_ = KLD; } \
        else if (p_ < NPIECE) { const int g = 64 * (p_ - KCH) + lane, cc = g % 9; row_ = g / 9; col_ = (cc < 8 ? cc : 7) * 8; dst_ = sl_ + p_ * 1024; base_ = Vg; ld_ = N1; } \
        else { row_ = lane & 15; col_ = 0; dst_ = OFF_JUNK + (p_ - NPIECE) * 1024; base_ = Kg; ld_ = KLD; } \
        const bf16* s_ = base_ + (size_t)ATT_SRCROW((t_), row_) * ld_ + col_; \
        __builtin_amdgcn_global_load_lds((const unsigned*)s_, (LAS unsigned*)(lds + __builtin_amdgcn_readfirstlane(dst_)), 16, 0, 0); } } while (0)
#define ATT_BAR() do { asm volatile("s_waitcnt lgkmcnt(0)" ::: "memory"); __builtin_amdgcn_s_barrier(); asm volatile("" ::: "memory"); } while (0)
    ATT_BAR();
    ATT_DMA(0); if (NT > 1) ATT_DMA(1); if (NT > 2) ATT_DMA(2);
    for (int t = 0; t < NT; ++t) {
        if (t + 2 < NT) { if (KIND) asm volatile("s_waitcnt vmcnt(6)" ::: "memory"); else asm volatile("s_waitcnt vmcnt(4)" ::: "memory"); } else if (t + 1 < NT) { if (KIND) asm volatile("s_waitcnt vmcnt(3)" ::: "memory"); else asm volatile("s_waitcnt vmcnt(2)" ::: "memory"); } else asm volatile("s_waitcnt vmcnt(0)" ::: "memory");
        ATT_BAR();
        if (t + 3 < NT) ATT_DMA(t + 3);
        if (wact && t <= wlast) {
            const LAS unsigned char* Kb = lds + (t & 3) * SLOT; const LAS unsigned char* Vb = KIND ? Kb + KCH * 1024 : Kb;
            const bool need_mask = (t == 0) || (64 * t + 63 > q0 + 32 * w);
            constexpr int VRB = KIND ? 144 : KST * 2;
            const LAS unsigned char* vp0 = Vb + (4 * hi + ((lane & 15) >> 2)) * VRB + (16 * ((lane >> 4) & 1)) * 2 + 8 * (lane & 3);
#define ATT_VFRAG(d0_, ks_) ({ const LAS unsigned char* vp_ = vp0 + 16 * (ks_) * VRB + 64 * (d0_); \
        const s16x4 va_ = __builtin_bit_cast(s16x4, __builtin_amdgcn_ds_read_tr16_b64_v4i16((LAS v4i16_t*)vp_)), vb_ = __builtin_bit_cast(s16x4, __builtin_amdgcn_ds_read_tr16_b64_v4i16((LAS v4i16_t*)(vp_ + 8 * VRB))); \
        (s16x8){va_[0], va_[1], va_[2], va_[3], vb_[0], vb_[1], vb_[2], vb_[3]}; })
            s16x8 vfr0[4];
#pragma unroll
            for (int ks = 0; ks < 4; ++ks) vfr0[ks] = ATT_VFRAG(0, ks);
            __builtin_amdgcn_sched_barrier(0);
#pragma unroll
            for (int m = 0; m < NMAP; ++m) {
                f32x16 p0, p1;
                if (KIND) { const float nm = -mref[m];
#pragma unroll
                    for (int r = 0; r < 16; ++r) { p0[r] = nm; p1[r] = nm; } }
                else { p0 = negm; p1 = negm; }
                constexpr int KBATCH = KIND ? DSTEPS : 3;
#pragma unroll
                for (int d1 = 0; d1 < DSTEPS; d1 += KBATCH) {
                    s16x8 kfr[KBATCH][2];
#pragma unroll
                    for (int ds = 0; ds < KBATCH; ++ds) { kfr[ds][0] = *(const LAS s16x8*)(Kb + (r32 * KST + 32 * m * KIND + 16 * (d1 + ds) + 8 * hi) * 2); kfr[ds][1] = *(const LAS s16x8*)(Kb + ((32 + r32) * KST + 32 * m * KIND + 16 * (d1 + ds) + 8 * hi) * 2); }
                    __builtin_amdgcn_sched_barrier(0);
                    __builtin_amdgcn_s_setprio(1);
#pragma unroll
                    for (int ds = 0; ds < KBATCH; ++ds) { p0 = __builtin_amdgcn_mfma_f32_32x32x16_bf16(kfr[ds][0], qf[m][d1 + ds], p0, 0, 0, 0); p1 = __builtin_amdgcn_mfma_f32_32x32x16_bf16(kfr[ds][1], qf[m][d1 + ds], p1, 0, 0, 0); }
                    __builtin_amdgcn_s_setprio(0);
                    __builtin_amdgcn_sched_barrier(0); }
                asm volatile("s_nop 15\n\ts_nop 7" : "+v"(p0), "+v"(p1));
                __builtin_amdgcn_s_setprio(0);
                if (need_mask) {
#pragma unroll
                    for (int r = 0; r < 16; ++r) { const int kv = 64 * t + crow(r, hi);
                        if (kv > qpos || kv < 48) p0[r] = -1e30f;
                        if (kv + 32 > qpos || kv + 32 < 48) p1[r] = -1e30f; } }
                float mx = fmaxf(fmaxf(p0[0], p1[0]), fmaxf(p0[1], p1[1]));
#pragma unroll
                for (int r = 2; r < 16; r += 2) mx = fmaxf(mx, fmaxf(fmaxf(p0[r], p1[r]), fmaxf(p0[r + 1], p1[r + 1])));
                { auto rr = __builtin_amdgcn_permlane32_swap(__float_as_uint(mx), __float_as_uint(mx), false, false); mx = fmaxf(__uint_as_float(rr[0]), __uint_as_float(rr[1])); }
                if (t == 0 || __any(mx > 6.0f)) {
                    const float delta = t == 0 ? mx : fmaxf(mx, 0.f); mref[m] += delta;
#pragma unroll
                    for (int r = 0; r < 16; ++r) { p0[r] -= delta; p1[r] -= delta; if (!KIND) negm[r] = -mref[m]; }
                    if (t != 0) { const float alpha = __builtin_amdgcn_exp2f(-delta); lrun[m] *= alpha;
                        if (hi == 0) wsf[r32] = alpha;
                        f32x4 al[4];
#pragma unroll
                        for (int g = 0; g < 4; ++g) al[g] = *(const LAS f32x4*)(wsf + 8 * g + 4 * hi);
#pragma unroll
                        for (int r = 0; r < 16; ++r) { o[m][0][r] *= al[r >> 2][r & 3]; o[m][1][r] *= al[r >> 2][r & 3]; } } }
                float ls = 0.f;
#pragma unroll
                for (int r = 0; r < 16; ++r) { p0[r] = __builtin_amdgcn_exp2f(p0[r]); p1[r] = __builtin_amdgcn_exp2f(p1[r]); ls += p0[r] + p1[r]; }
                lrun[m] += ls;
                s16x8 pw[4];
#pragma unroll
                for (int ks = 0; ks < 4; ++ks) { v4u u;
                    if (ks < 2) { u.x = pg8::cvt_pk_bf16(p0[8 * ks], p0[8 * ks + 1]); u.y = pg8::cvt_pk_bf16(p0[8 * ks + 2], p0[8 * ks + 3]); u.z = pg8::cvt_pk_bf16(p0[8 * ks + 4], p0[8 * ks + 5]); u.w = pg8::cvt_pk_bf16(p0[8 * ks + 6], p0[8 * ks + 7]); }
                    else { const int k2 = ks - 2; u.x = pg8::cvt_pk_bf16(p1[8 * k2], p1[8 * k2 + 1]); u.y = pg8::cvt_pk_bf16(p1[8 * k2 + 2], p1[8 * k2 + 3]); u.z = pg8::cvt_pk_bf16(p1[8 * k2 + 4], p1[8 * k2 + 5]); u.w = pg8::cvt_pk_bf16(p1[8 * k2 + 6], p1[8 * k2 + 7]); }
                    pw[ks] = __builtin_bit_cast(s16x8, u); }
                __builtin_amdgcn_s_setprio(1);
#pragma unroll
                for (int ks = 0; ks < 4; ++ks) o[m][0] = __builtin_amdgcn_mfma_f32_32x32x16_bf16(pw[ks], vfr0[ks], o[m][0], 0, 0, 0);
                __builtin_amdgcn_s_setprio(0);
                { s16x8 vfr1[4];
#pragma unroll
                    for (int ks = 0; ks < 4; ++ks) vfr1[ks] = ATT_VFRAG(1, ks);
                    __builtin_amdgcn_sched_barrier(0);
                    __builtin_amdgcn_s_setprio(1);
#pragma unroll
                    for (int ks = 0; ks < 4; ++ks) o[m][1] = __builtin_amdgcn_mfma_f32_32x32x16_bf16(pw[ks], vfr1[ks], o[m][1], 0, 0, 0); }
                __builtin_amdgcn_s_setprio(0);
            }
        }
    }
#undef ATT_DMA
#undef ATT_VFRAG
#undef ATT_SRCROW
    ATT_BAR();
    if (KIND) { const LAS float* lp = (const LAS float*)(lds + RING_BYTES + 256); lam = lp[0]; oscale = lp[1]; }
    if (wact) {
#pragma unroll
        for (int m = 0; m < NMAP; ++m) asm volatile("s_nop 15\n\ts_nop 7" : "+v"(o[m][0]), "+v"(o[m][1]));
        float il0, il1 = 0.f;
        { float l = lrun[0]; l += __shfl_xor(l, 32); il0 = l > 0.f ? 1.f / l : 0.f; }
        if (KIND) { float l = lrun[NMAP - 1]; l += __shfl_xor(l, 32); il1 = l > 0.f ? lam / l : 0.f; }
        if (hi == 0) { wsf[r32] = il0; wsf[32 + r32] = il1; }
        f32x4 a0[4], a1[4];
#pragma unroll
        for (int g = 0; g < 4; ++g) { a0[g] = *(const LAS f32x4*)(wsf + 8 * g + 4 * hi); a1[g] = *(const LAS f32x4*)(wsf + 32 + 8 * g + 4 * hi); }
#pragma unroll
        for (int d0 = 0; d0 < 2; ++d0)
#pragma unroll
            for (int r = 0; r < 16; ++r) { float v = o[0][d0][r] * a0[r >> 2][r & 3]; if (KIND) v -= o[NMAP - 1][d0][r] * a1[r >> 2][r & 3];
                ost[crow(r, hi) * OSTW + 32 * d0 + r32] = v; }
        const int row = lane >> 1, half = lane & 1, p = q0 + 32 * w + row;
        f32x4 v[8]; float ss = 0.f;
#pragma unroll
        for (int i = 0; i < 8; ++i) { v[i] = *(const LAS f32x4*)(ost + row * OSTW + 32 * half + 4 * i); ss += (v[i][0] * v[i][0] + v[i][1] * v[i][1]) + (v[i][2] * v[i][2] + v[i][3] * v[i][3]); }
        ss += __shfl_xor(ss, 1);
        const float rs = KIND ? __builtin_amdgcn_rsqf(ss * (1.f / 64.f) + EPS) * oscale : 1.f;
        const int sr = qb >= 0 ? b * TT + p - 64 : ((p >= 48 && b == 0) ? MR + p - 48 : -1);
        if (sr >= 0) { bf16* dst = (bf16*)a.out + (size_t)sr * DM + (KIND ? 768 : 512) + hh * 64 + 32 * half; const float* gn = ain(a, I_DNORM) + li * 64 + 32 * half;
#pragma unroll
            for (int i = 0; i < 4; ++i) { f32x4 x0 = v[2 * i] * rs, x1 = v[2 * i + 1] * rs;
                if (KIND) { const f32x4 g0 = *(const f32x4*)(gn + 8 * i), g1 = *(const f32x4*)(gn + 8 * i + 4); x0 = x0 * g0; x1 = x1 * g1; }
                *(v4u*)(dst + 8 * i) = pack8(x0, x1); } }
    }
    ATT_BAR();
#undef ATT_BAR
}

__device__ __forceinline__ s16x8 ldperm(const bf16* p, int hi) { const s16x4 x = *(const s16x4*)(p + 4 * hi), y = *(const s16x4*)(p + 8 + 4 * hi); return (s16x8){x[0], x[1], x[2], x[3], y[0], y[1], y[2], y[3]}; }
__device__ __forceinline__ s16x8 packacc(const f32x16& v, int k) { v4u u; u.x = pg8::cvt_pk_bf16(v[8 * k], v[8 * k + 1]); u.y = pg8::cvt_pk_bf16(v[8 * k + 2], v[8 * k + 3]); u.z = pg8::cvt_pk_bf16(v[8 * k + 4], v[8 * k + 5]); u.w = pg8::cvt_pk_bf16(v[8 * k + 6], v[8 * k + 7]); return __builtin_bit_cast(s16x8, u); }
__device__ __forceinline__ s16x8 ldperm_lds(const LAS unsigned char* p, int hi) { const s16x4 x = *(const LAS s16x4*)(p + 8 * hi), y = *(const LAS s16x4*)(p + 16 + 8 * hi); return (s16x8){x[0], x[1], x[2], x[3], y[0], y[1], y[2], y[3]}; }
template <int KIND>
__device__ __forceinline__ void lin_mfma_unit(const Args& a, int li, int b, int hp, LAS unsigned char* lds, int tid) {
    constexpr int DK = KIND ? 64 : 32, NDS = DK / 16, NDB = DK / 32, OTW = 68;
    constexpr int QROW = KIND ? 144 : 80, QT = KIND ? RT_T : GQ_T, HB = 2 * QT + VT_T, PPH = HB / 1024, NP = 2 * PPH;
    constexpr int OFF_OT = 2 * HB, OFF_G = OFF_OT + 2 * 64 * OTW * 4;
    static_assert(HB % 1024 == 0 && OFF_G + 256 <= RING_BYTES, "lin unit LDS map");
    const int lane = tid & 63, w = __builtin_amdgcn_readfirstlane(tid >> 6), r32 = lane & 31, hi = lane >> 5, hl = w >> 2, e0 = 32 * ((w >> 1) & 1), ib = w & 1, h = 2 * hp + hl;
    const unsigned char* Qg = a.ws + (KIND ? B_RQ : B_GQ); const unsigned char* Kg = a.ws + (KIND ? B_RK : B_GK);
    const bf16* proj = (const bf16*)(a.ws + B_PROJ); bf16* ob = (bf16*)a.out;
    LAS float* Ot = (LAS float*)(lds + OFF_OT);
    LAS float* Gs = (LAS float*)(lds + OFF_G);
    const LAS unsigned char* Lh = lds + hl * HB;
    const float dret = __builtin_amdgcn_exp2f(64.f * lg2gamma(h));
    f32x16 S[NDB];
#pragma unroll
    for (int db = 0; db < NDB; ++db) S[db] = (f32x16){};
#define LIN_DMA(c_) do { _Pragma("unroll") for (int j_ = 0; j_ < (NP + 7) / 8; ++j_) { const int p_ = w + 8 * j_; if (p_ < NP) { const int hl_ = p_ / PPH, pp_ = p_ % PPH; const size_t blk_ = (size_t)(b * NCH + (c_)) * 4 + 2 * hp + hl_; \
        const unsigned char* src_; \
        if (pp_ < 2 * QT / 1024) src_ = (pp_ < QT / 1024 ? Qg + blk_ * QT + pp_ * 1024 : Kg + blk_ * QT + (pp_ - QT / 1024) * 1024) + lane * 16; \
        else { const int g_ = 64 * (pp_ - 2 * QT / 1024) + lane, s_ = g_ / 9, cc_ = g_ % 9; int sr_ = src_row(b, (c_), s_); sr_ = sr_ < 0 ? MR : sr_;     \
            src_ = (const unsigned char*)(proj + (size_t)sr_ * N1 + (KIND ? C_RV : C_AV) + (2 * hp + hl_) * 64 + (cc_ < 8 ? cc_ : 7) * 8); } \
        __builtin_amdgcn_global_load_lds((const unsigned*)src_, (LAS unsigned*)(lds + hl_ * HB + pp_ * 1024), 16, 0, 0); } } } while (0)
#define LIN_BAR() do { asm volatile("s_waitcnt lgkmcnt(0)" ::: "memory"); __builtin_amdgcn_s_barrier(); asm volatile("" ::: "memory"); } while (0)
    LIN_BAR();
    if (tid < 64) Gs[tid] = ain(a, KIND ? I_RNORM : I_GNORM)[li * 64 + tid];
    LIN_DMA(0);
    const int nh = tid >> 8, nrow = (tid >> 2) & 63, nq = tid & 3, hn = 2 * hp + nh;
    for (int c = 0; c < NCH; ++c) {
        asm volatile("s_waitcnt vmcnt(0)" ::: "memory"); LIN_BAR();
        s16x8 qf[NDS], kf0[NDS], kf1[NDS], vf[4], ktf[NDB][4];
        const int sr = src_row(b, c, nrow); const bool wr = sr >= 0 && (c > 0 || b == 0);
#pragma unroll
        for (int ds = 0; ds < NDS; ++ds) { qf[ds] = ldperm_lds(Lh + (32 * ib + r32) * QROW + 32 * ds, hi); kf0[ds] = ldperm_lds(Lh + QT + r32 * QROW + 32 * ds, hi); kf1[ds] = ldperm_lds(Lh + QT + (32 + r32) * QROW + 32 * ds, hi); }
        const int trq = (lane & 15) >> 2, trb = (lane >> 4) & 1, trp = lane & 3;
#pragma unroll
        for (int ks = 0; ks < 4; ++ks) { const LAS unsigned char* vp = Lh + 2 * QT + (16 * ks + 4 * hi + trq) * 144 + (e0 + 16 * trb) * 2 + 8 * trp;
            const s16x4 va = __builtin_bit_cast(s16x4, __builtin_amdgcn_ds_read_tr16_b64_v4i16((LAS v4i16_t*)vp)), vb = __builtin_bit_cast(s16x4, __builtin_amdgcn_ds_read_tr16_b64_v4i16((LAS v4i16_t*)(vp + 8 * 144)));
            vf[ks] = (s16x8){va[0], va[1], va[2], va[3], vb[0], vb[1], vb[2], vb[3]}; }
        f32x16 aA = (f32x16){}, aB = (f32x16){};
#pragma unroll
        for (int ds = 0; ds < NDS; ++ds) { aA = __builtin_amdgcn_mfma_f32_32x32x16_bf16(kf0[ds], qf[ds], aA, 0, 0, 0); if (ib) aB = __builtin_amdgcn_mfma_f32_32x32x16_bf16(kf1[ds], qf[ds], aB, 0, 0, 0); }
        asm volatile("s_nop 15\n\ts_nop 15" : "+v"(aA), "+v"(aB));
#pragma unroll
        for (int r = 0; r < 16; ++r) if (crow(r, hi) > r32) { if (ib) aB[r] = 0.f; else aA[r] = 0.f; }
        f32x16 O = (f32x16){};
#pragma unroll
        for (int db = 0; db < NDB; ++db)
#pragma unroll
            for (int ksub = 0; ksub < 2; ++ksub) O = __builtin_amdgcn_mfma_f32_32x32x16_bf16(qf[2 * db + ksub], packacc(S[db], ksub), O, 0, 0, 0);
#pragma unroll
        for (int ksub = 0; ksub < 2; ++ksub) { O = __builtin_amdgcn_mfma_f32_32x32x16_bf16(packacc(aA, ksub), vf[ksub], O, 0, 0, 0); if (ib) O = __builtin_amdgcn_mfma_f32_32x32x16_bf16(packacc(aB, ksub), vf[2 + ksub], O, 0, 0, 0); }
#pragma unroll
        for (int db = 0; db < NDB; ++db)
#pragma unroll
            for (int ks = 0; ks < 4; ++ks) { const LAS unsigned char* kp = Lh + QT + (16 * ks + 4 * hi + trq) * QROW + (32 * db + 16 * trb) * 2 + 8 * trp;
                const s16x4 ka = __builtin_bit_cast(s16x4, __builtin_amdgcn_ds_read_tr16_b64_v4i16((LAS v4i16_t*)kp)), kb = __builtin_bit_cast(s16x4, __builtin_amdgcn_ds_read_tr16_b64_v4i16((LAS v4i16_t*)(kp + 8 * QROW)));
                ktf[db][ks] = (s16x8){ka[0], ka[1], ka[2], ka[3], kb[0], kb[1], kb[2], kb[3]}; }
        LIN_BAR();
        v4u og[2];
#pragma unroll
        for (int i = 0; i < 2; ++i) og[i] = wr ? *(const v4u*)(proj + (size_t)sr * N1 + (KIND ? C_ROG : C_AOG) + hn * 64 + 16 * nq + 8 * i) : (v4u){0u, 0u, 0u, 0u};
        f32x4 dvv[4];
        if (!KIND) { const float* dp = (const float*)(a.ws + WS_GD) + ((size_t)(b * NCH + c) * 4 + h) * 32;
#pragma unroll
            for (int g = 0; g < 4; ++g) dvv[g] = *(const f32x4*)(dp + 8 * g + 4 * hi); }
        if (c + 1 < NCH) LIN_DMA(c + 1);
#pragma unroll
        for (int db = 0; db < NDB; ++db) {
#pragma unroll
            for (int ks = 0; ks < 4; ++ks) S[db] = __builtin_amdgcn_mfma_f32_32x32x16_bf16(ktf[db][ks], vf[ks], S[db], 0, 0, 0); }
        asm volatile("s_nop 15\n\ts_nop 15" : "+v"(O));
#pragma unroll
        for (int db = 0; db < NDB; ++db) asm volatile("s_nop 15\n\ts_nop 15" : "+v"(S[db]));
#pragma unroll
        for (int db = 0; db < NDB; ++db) {
            if (KIND) { S[db] = S[db] * dret; }
            else {
#pragma unroll
                for (int g = 0; g < 4; ++g) { S[db][4 * g] *= dvv[g][0]; S[db][4 * g + 1] *= dvv[g][1]; S[db][4 * g + 2] *= dvv[g][2]; S[db][4 * g + 3] *= dvv[g][3]; } } }
#pragma unroll
        for (int r = 0; r < 16; ++r) Ot[(hl * 64 + 32 * ib + crow(r, hi)) * OTW + e0 + r32] = O[r];
        LIN_BAR();
        { f32x4 v[4]; float s1 = 0.f;
#pragma unroll
            for (int i = 0; i < 4; ++i) { v[i] = *(const LAS f32x4*)(Ot + (nh * 64 + nrow) * OTW + 16 * nq + 4 * i); s1 += (v[i][0] + v[i][1]) + (v[i][2] + v[i][3]); }
            float mean = 0.f; if (KIND) { s1 += __shfl_xor(s1, 1); s1 += __shfl_xor(s1, 2); mean = s1 * (1.f / 64.f); }
            float s2 = 0.f;
#pragma unroll
            for (int i = 0; i < 4; ++i) { v[i] = v[i] - mean; s2 += (v[i][0] * v[i][0] + v[i][1] * v[i][1]) + (v[i][2] * v[i][2] + v[i][3] * v[i][3]); }
            s2 += __shfl_xor(s2, 1); s2 += __shfl_xor(s2, 2);
            const float rs = __builtin_amdgcn_rsqf(s2 * (1.f / 64.f) + EPS);
            if (wr) { bf16* dst = ob + (size_t)sr * DM + KIND * 256 + hn * 64 + 16 * nq; const LAS float* gp = Gs + 16 * nq;
#pragma unroll
                for (int i = 0; i < 2; ++i) { const v4u g4 = og[i]; const f32x4 g0 = *(const LAS f32x4*)(gp + 8 * i), g1 = *(const LAS f32x4*)(gp + 8 * i + 4);
                    f32x4 x0 = v[2 * i] * rs * g0, x1 = v[2 * i + 1] * rs * g1;
                    x0[0] *= silu_f(bflo(g4.x)); x0[1] *= silu_f(bfhi(g4.x)); x0[2] *= silu_f(bflo(g4.y)); x0[3] *= silu_f(bfhi(g4.y)); x1[0] *= silu_f(bflo(g4.z)); x1[1] *= silu_f(bfhi(g4.z)); x1[2] *= silu_f(bflo(g4.w)); x1[3] *= silu_f(bfhi(g4.w));
                    *(v4u*)(dst + 8 * i) = pack8(x0, x1); } } }
        LIN_BAR();
    }
    asm volatile("s_waitcnt vmcnt(0)" ::: "memory");
#undef LIN_DMA
#undef LIN_BAR
}

template <int MODE, int KSTEPS  >
__device__ __forceinline__ void thin_unit(const bf16* A, int lda, const bf16* Bt, int u, bf16* H, float* stats_out, const float* stats_in, bf16* ACT, LAS unsigned char* lds, int tid) {
    constexpr int K = KSTEPS * 256;
    const int lane = tid & 63, w = __builtin_amdgcn_readfirstlane(tid >> 6), fr = lane & 15, fq = lane >> 4;
    int brow[4];
#pragma unroll
    for (int nb = 0; nb < 4; ++nb) brow[nb] = MODE != 1 ? 64 * u + 16 * nb + fr : 256 * (u >> 2) + 32 * (u & 3) + (nb >> 1) * 128 + 16 * (nb & 1) + fr;
    f32x4 acc[4];
#pragma unroll
    for (int nb = 0; nb < 4; ++nb) acc[nb] = (f32x4){0.f, 0.f, 0.f, 0.f};
    const bf16* ap = A + (size_t)fr * lda + w * (KSTEPS * 32) + 8 * fq;
    constexpr int B1 = KSTEPS > 6 ? 6 : KSTEPS;
    { s16x8 af[B1], bf[B1][4];
#pragma unroll
        for (int s = 0; s < B1; ++s) { af[s] = *(const s16x8*)(ap + 32 * s);
#pragma unroll
            for (int nb = 0; nb < 4; ++nb) bf[s][nb] = *(const s16x8*)(Bt + (size_t)brow[nb] * K + w * (KSTEPS * 32) + 32 * s + 8 * fq); }
#pragma unroll
        for (int s = 0; s < B1; ++s)
#pragma unroll
            for (int nb = 0; nb < 4; ++nb) acc[nb] = __builtin_amdgcn_mfma_f32_16x16x32_bf16(bf[s][nb], af[s], acc[nb], 0, 0, 0); }
    if (KSTEPS > B1) { constexpr int B2 = KSTEPS > B1 ? KSTEPS - B1 : 1; s16x8 af[B2], bf[B2][4];
#pragma unroll
        for (int s = 0; s < B2; ++s) { af[s] = *(const s16x8*)(ap + 32 * (B1 + s));
#pragma unroll
            for (int nb = 0; nb < 4; ++nb) bf[s][nb] = *(const s16x8*)(Bt + (size_t)brow[nb] * K + w * (KSTEPS * 32) + 32 * (B1 + s) + 8 * fq); }
#pragma unroll
        for (int s = 0; s < B2; ++s)
#pragma unroll
            for (int nb = 0; nb < 4; ++nb) acc[nb] = __builtin_amdgcn_mfma_f32_16x16x32_bf16(bf[s][nb], af[s], acc[nb], 0, 0, 0); }
    asm volatile("s_nop 15" : "+v"(acc[0]), "+v"(acc[1]), "+v"(acc[2]), "+v"(acc[3]));
    LAS f32x4* part = (LAS f32x4*)lds;
    __syncthreads();
#pragma unroll
    for (int nb = 0; nb < 4; ++nb) part[(w * 4 + nb) * 64 + lane] = acc[nb];
    __syncthreads();
    if (w == 0) {
#pragma unroll
        for (int nb = 0; nb < 4; ++nb) {
#pragma unroll
            for (int w2 = 1; w2 < 8; ++w2) acc[nb] = acc[nb] + part[(w2 * 4 + nb) * 64 + lane]; }
        const int row = MR + fr;
        if (MODE == 0) { float ss = 0.f;
#pragma unroll
            for (int nb = 0; nb < 4; ++nb) { bf16* p = H + (size_t)row * DM + 64 * u + 16 * nb + 4 * fq; const v2u wv = *(const v2u*)p;
                const float x0 = acc[nb][0] + bflo(wv.x), x1 = acc[nb][1] + bfhi(wv.x), x2 = acc[nb][2] + bflo(wv.y), x3 = acc[nb][3] + bfhi(wv.y);
                ss += (x0 * x0 + x1 * x1) + (x2 * x2 + x3 * x3);
                v2u o; o.x = pg8::cvt_pk_bf16(x0, x1); o.y = pg8::cvt_pk_bf16(x2, x3); *(v2u*)p = o; }
            ss += __shfl_xor(ss, 16); ss += __shfl_xor(ss, 32);
            if (fq == 0) stats_out[(size_t)row * 16 + u] = ss;
        } else if (MODE == 2) { const f32x4* sp = (const f32x4*)(stats_in + (size_t)row * 16); const f32x4 s0 = sp[0], s1 = sp[1], s2 = sp[2], s3 = sp[3];
            const float st = ((s0[0] + s0[1]) + (s0[2] + s0[3])) + ((s1[0] + s1[1]) + (s1[2] + s1[3])) + ((s2[0] + s2[1]) + (s2[2] + s2[3])) + ((s3[0] + s3[1]) + (s3[2] + s3[3]));
            const float rs = __builtin_amdgcn_rsqf(st * (1.f / 1024.f) + EPS);
#pragma unroll
            for (int nb = 0; nb < 4; ++nb) { v2u o; o.x = pg8::cvt_pk_bf16(acc[nb][0] * rs, acc[nb][1] * rs); o.y = pg8::cvt_pk_bf16(acc[nb][2] * rs, acc[nb][3] * rs);
                *(v2u*)(ACT + (size_t)row * N1 + 64 * u + 16 * nb + 4 * fq) = o; }
        } else { const f32x4* sp = (const f32x4*)(stats_in + (size_t)row * 16); const f32x4 s0 = sp[0], s1 = sp[1], s2 = sp[2], s3 = sp[3];
            const float st = ((s0[0] + s0[1]) + (s0[2] + s0[3])) + ((s1[0] + s1[1]) + (s1[2] + s1[3])) + ((s2[0] + s2[1]) + (s2[2] + s2[3])) + ((s3[0] + s3[1]) + (s3[2] + s3[3]));
            const float rs = __builtin_amdgcn_rsqf(st * (1.f / 1024.f) + EPS);
#pragma unroll
            for (int nb = 0; nb < 2; ++nb) { float y[4];
#pragma unroll
                for (int t = 0; t < 4; ++t) y[t] = silu_f(acc[nb][t] * rs) * (acc[2 + nb][t] * rs);
                v2u o; o.x = pg8::cvt_pk_bf16(y[0], y[1]); o.y = pg8::cvt_pk_bf16(y[2], y[3]);
                *(v2u*)(ACT + (size_t)row * DFF + 128 * (u >> 2) + 32 * (u & 3) + 16 * nb + 4 * fq) = o; } }
    }
    __syncthreads();
}

#ifndef REP_PREP
#define REP_PREP 1
#endif
#ifndef REP_MIX
#define REP_MIX 1
#endif
#ifndef REP_P0
#define REP_P0 1
#endif
#ifndef REP_CONV
#define REP_CONV 1
#endif
#ifndef REP_G1
#define REP_G1 1
#endif
#ifndef REP_MGU
#define REP_MGU 1
#endif
#ifndef REP_MDN
#define REP_MDN 1
#endif
#ifndef REP_BAR
#define REP_BAR 0
#endif
#ifndef REP_PART
#define REP_PART -1
#endif
#ifndef MK_ONE_LAUNCH
#define MK_ONE_LAUNCH 1
#endif
constexpr int NPHASE = 18;
constexpr int CW_Q = 12288;
__global__ void __launch_bounds__(512, 2) mega_fwd(Args a) {
    extern __shared__ __attribute__((aligned(16))) unsigned char lds_raw[];
    LAS unsigned char* lds = (LAS unsigned char*)lds_raw;
    volatile LAS unsigned* MISC = (volatile LAS unsigned*)(lds + MISC_OFF);
    int wave = __builtin_amdgcn_readfirstlane((int)threadIdx.x >> 6); asm volatile("" : "+s"(wave));
    const int G = gridDim.x;
#define TID() ((wave << 6) + lane_id())
    for (int u = TID(); u < (LDS_BYTES - RING_BYTES) / 4; u += 512) ((LAS unsigned*)(lds + RING_BYTES))[u] = 0u;
    __syncthreads();
    gu32* ctl = (gu32*)(a.ws + WS_CTL);
    const int lo = a.ph_lo, hi = a.ph_hi;
    XcdBarrier bar; bar.bar = (unsigned*)(ctl + CW_BAR); bar.x = 0; bar.st = nullptr;
    if (hi - lo > 1) bar = xcd_barrier_post((unsigned*)(ctl + CW_BAR), MISC + 8, TID() == 0);
#define IN(k) (lo <= (k) && (k) < hi)
#define OPQ() int ptid = TID(); asm volatile("" : "+v"(ptid)); const int plane = ptid & 63; (void)plane
#define SEAM(k) do { if (IN(k) && IN((k) + 1)) xcd_barrier(bar, TID() == 0); } while (0)
#define hb ((bf16*)(a.ws + WS_HB))
#define stA ((float*)(a.ws + WS_STA))
#define stB ((float*)(a.ws + WS_STB))

    for (int rep = 0; rep < REP_BAR; ++rep) xcd_barrier(bar, TID() == 0);
    if (IN(0)) { OPQ(); for (int rep = 0; rep < REP_P0; ++rep) { p0_prologue(a, lds, ptid, plane, wave); __syncthreads(); } }
    SEAM(0);

    for (int li = 0; li < 2; ++li) {
        const int pb = 1 + 6 * li;
        if (IN(pb)) {
            { OPQ(); for (int u = blockIdx.x; u < N1 / 64; u += G) thin_unit<2, 4>(hb + (size_t)MR * DM, DM, (const bf16*)(a.ws + WS_W1T + li * W1T_BYTES), u, nullptr, nullptr, stA, (bf16*)(a.ws + B_PROJ), lds, ptid); }
            pg8::Gemm g{hb, (const bf16*)(a.ws + WS_W1T + li * W1T_BYTES), DM, 0, nullptr}; pg8::StaticOrder S; S.init(NPAN - 1, N1 / 256, G, (int)blockIdx.x);
            EpiProj E{(bf16*)(a.ws + B_PROJ), stA};
            for (int rep = 0; rep < REP_G1; ++rep) pg8::gemm_phase<EpiProj, pg8::StaticOrder, false>(lds, g, S, E, wave);
        }
        SEAM(pb);
        if (IN(pb + 1)) { OPQ(); for (int rep = 0; rep < REP_PREP; ++rep) for (int u = blockIdx.x; u < NB * NCH * 3; u += G) { const int part = u % 3;     if (rep > 0 && REP_PART >= 0 && part != REP_PART) continue; int ut = ptid; asm volatile("" : "+v"(ut)); prep2_unit(a, li, (u / 3) / NCH, (u / 3) % NCH, part, lds, ut); } __syncthreads(); }
        SEAM(pb + 1);
        if (IN(pb + 2)) {
            OPQ(); const int tid = ptid;
            LAS int* qid = (LAS int*)(lds + RING_BYTES + 64);
            float lam, lam_init; { const float* lv = ain(a, I_DLAM) + li * 128; float s01 = 0.f, s23 = 0.f;
                for (int d = 0; d < 32; ++d) { s01 += lv[d] * lv[32 + d]; s23 += lv[64 + d] * lv[96 + d]; }
                lam_init = 0.8f - 0.6f * __expf(-0.3f * (float)li); lam = __expf(s01) - __expf(s23) + lam_init;
                if (tid == 0) { LAS float* lp = (LAS float*)(lds + RING_BYTES + 256); lp[0] = lam; lp[1] = 1.f - lam_init; } }
            for (int rep = 0; rep < REP_MIX; ++rep)
            for (;;) {
                __syncthreads();
                if (tid == 0) *qid = (int)__hip_atomic_fetch_add(ctl + CW_Q + 64 * (li + 2 * rep), 1u, RLX_AGENT);
                __syncthreads();
                const int id = *qid;
                int utid = ptid; asm volatile("" : "+v"(utid));
                if (id >= 64 + 1024 + 8) break;
                if (id < 64) { if ((id & 1) == 0) lin_mfma_unit<0>(a, li, (id >> 1) & 15, id >> 5, lds, utid); else lin_mfma_unit<1>(a, li, (id >> 1) & 15, id >> 5, lds, utid); }
                else { const int v = id - 64; int qb, kind, b, hh;
                    if (v < 1024) { qb = 7 - (v >> 7); const int rem = v & 127; kind = rem >> 6; b = (rem >> 2) & 15; hh = rem & 3; } else { qb = -1; kind = (v - 1024) >> 2; b = 0; hh = v & 3; }
                    if (kind == 0) attn_mfma_unit<0>(a, li, b, hh, qb, lds, utid, 0.f, 1.f); else attn_mfma_unit<1>(a, li, b, hh, qb, lds, utid, 0.f, 0.f); }
            }
        }
        SEAM(pb + 2);
        if (IN(pb + 3)) {
            if (li == 0) { OPQ(); for (int u = blockIdx.x; u < 16; u += G) thin_unit<0, 4>((const bf16*)a.out + (size_t)MR * DM, DM, (const bf16*)(a.ws + WS_WOT), u, hb, stB, nullptr, nullptr, lds, ptid); }
            pg8::Gemm g{(const bf16*)a.out, (const bf16*)(a.ws + WS_WOT + li * WOT_BYTES), DM, 0, nullptr}; pg8::StaticOrder S; S.init(NPAN - 1, 4, G, (int)blockIdx.x);
            EpiResid E{hb, stB};
            pg8::gemm_phase<EpiResid, pg8::StaticOrder, false>(lds, g, S, E, wave);
        }
        SEAM(pb + 3);
        if (li == 0) {
            if (IN(5)) {
                { OPQ(); for (int u = blockIdx.x; u < 88; u += G) thin_unit<1, 4>(hb + (size_t)MR * DM, DM, (const bf16*)(a.ws + WS_WGU), u, nullptr, nullptr, stB, (bf16*)(a.ws + B_ACT), lds, ptid); }
                pg8::Gemm g{hb, (const bf16*)(a.ws + WS_WGU), DM, 0, nullptr}; pg8::StaticOrder S; S.init(NPAN - 1, 2 * DFF / 256, G, (int)blockIdx.x);
                EpiSwiglu E{(bf16*)(a.ws + B_ACT), DFF, stB};
                pg8::gemm_phase<EpiSwiglu, pg8::StaticOrder, false>(lds, g, S, E, wave);
            }
            SEAM(5);
            if (IN(6)) {
                { OPQ(); for (int u = blockIdx.x; u < 16; u += G) thin_unit<0, 11>((const bf16*)(a.ws + B_ACT) + (size_t)MR * DFF, DFF, (const bf16*)(a.ws + WS_WD), u, hb, stA, nullptr, nullptr, lds, ptid); }
                pg8::Gemm g{(const bf16*)(a.ws + B_ACT), (const bf16*)(a.ws + WS_WD), DFF, 0, nullptr}; pg8::StaticOrder S; S.init(NPAN - 1, 4, G, (int)blockIdx.x);
                EpiResid E{hb, stA};
                pg8::gemm_phase<EpiResid, pg8::StaticOrder, false>(lds, g, S, E, wave);
            }
            SEAM(6);
        }
    }
    if (IN(11)) { OPQ(); const int tid = ptid, lane = plane;
        LAS float* scr = (LAS float*)(lds + wave * 16384);
        const int gw = blockIdx.x * 8 + wave, NGW = G * 8;
        constexpr int IG = 16 * 56, ID = 56 * 16;
        for (int rep = 0; rep < REP_CONV; ++rep)
        for (int it = gw; it < 8 * (2 * IG + ID); it += NGW) { const int e = it / (2 * IG + ID); int r = it % (2 * IG + ID);
            if (r < IG) { transpose_item(ain(a, I_EG) + (size_t)e * DM * DFE, DM, DFE, ain(a, I_FNORM) + DM, (bf16*)(a.ws + B_EGU + e * EGU_BYTES), r / 56, r % 56, 1, scr, lane); continue; } r -= IG;
            if (r < IG) { transpose_item(ain(a, I_EU) + (size_t)e * DM * DFE, DM, DFE, ain(a, I_FNORM) + DM, (bf16*)(a.ws + B_EGU + e * EGU_BYTES), r / 56, r % 56, 2, scr, lane); continue; } r -= IG;
            transpose_item(ain(a, I_ED) + (size_t)e * DFE * DM, DFE, DM, nullptr, (bf16*)(a.ws + B_ED + e * ED_BYTES), r / 16, r % 16, 0, scr, lane); }
        for (int i = blockIdx.x * 512 + tid; i < MAXPAN * 256; i += G * 512) { ((int*)(a.ws + MO_ROWIDX))[i] = -1; ((int*)(a.ws + MO_PDST))[i] = -1; ((f32x2*)(a.ws + MO_PINFO))[i] = (f32x2){0.f, 0.f}; }
        for (int blk = blockIdx.x; blk < MR / 128; blk += G) route_block(a, blk, lds, tid, lane, wave);
    }
    SEAM(11);
    LAS int* offs = (LAS int*)(lds + RING_BYTES + 128);
    if (IN(12)) { OPQ(); const int tid = ptid;
        moe_offsets(a, offs, tid);
        for (int idx = blockIdx.x * 512 + tid; idx < 2 * MR; idx += G * 512) { const int tok = idx >> 1, e = ((const int*)(a.ws + MO_TOKE))[idx], gpos = offs[e] + ((const int*)(a.ws + MO_TOKP))[idx];
            const f32x4* sp = (const f32x4*)(stB + (size_t)tok * 16); const f32x4 s0 = sp[0], s1 = sp[1], s2 = sp[2], s3 = sp[3];
            const float ss = ((s0[0] + s0[1]) + (s0[2] + s0[3])) + ((s1[0] + s1[1]) + (s1[2] + s1[3])) + ((s2[0] + s2[1]) + (s2[2] + s2[3])) + ((s3[0] + s3[1]) + (s3[2] + s3[3]));
            ((int*)(a.ws + MO_ROWIDX))[gpos] = tok; ((int*)(a.ws + MO_PDST))[gpos] = idx;
            ((f32x2*)(a.ws + MO_PINFO))[gpos] = (f32x2){__builtin_amdgcn_rsqf(ss * (1.f / 1024.f) + EPS), __int_as_float(((const int*)(a.ws + MO_TOKW))[idx])}; }
        if (blockIdx.x == 0 && tid < MAXPAN + 8) { int e = 0;
            for (int k = 1; k < 8; ++k) if (tid * 256 >= offs[k]) e = k;
            ((int*)(a.ws + MO_PEXP))[tid] = e; }
    }
    SEAM(12);
    int nT = 0; if (IN(13) || IN(14) || IN(15) || IN(16)) { moe_offsets(a, offs, TID()); nT = __builtin_amdgcn_readfirstlane(offs[8]); }
    const int nA = nT < 128 ? nT : 128, nB = nT < 128 ? 0 : (nT - 128 < 128 ? nT - 128 : 128), nC = nT <= 256 ? 0 : (nT - 256 < 8 ? nT - 256 : 8);
#pragma unroll 1
    for (int job = 0; job < 5; ++job) {
        const int ph = job == 0 ? 13 : job == 1 ? 14 : job <= 3 ? 15 : 16;
        if (IN(ph)) {
            if (job == 0 || job == 3) {
                const int nP = job == 0 ? nA + nC : nB;
                if (nP > 0) { pg8::Gemm g{hb, (const bf16*)(a.ws + B_EGU), DM, EGU_BYTES, (const int*)(a.ws + MO_ROWIDX)}; pg8::MoeOrder S; S.init(nP, 2 * DFE / 256, G, (int)blockIdx.x, job == 0 ? 0 : 128, (const int*)(a.ws + MO_PEXP));
                    if (job == 0) { S.psplit = nA; S.p1 = 256; } else if (nC > 0 && (nB * (2 * DFE / 256)) % G == 0 && 16 * nC <= G) S.H = 4 * nC;
                    EpiSwigluMoe E{(bf16*)(a.ws + B_EACT), (const f32x2*)(a.ws + MO_PINFO)};
                    for (int rep = 0; rep < REP_MGU; ++rep) pg8::gemm_phase<EpiSwigluMoe, pg8::MoeOrder, true>(lds, g, S, E, wave); }
            } else {
                const int nP = job == 1 ? nA : job == 2 ? nC : nB, p0 = job == 1 ? 0 : job == 2 ? 256 : 128;
                if (nP > 0) { pg8::Gemm g{(const bf16*)(a.ws + B_EACT) + (job == 2 ? (size_t)128 * 256 * DFE : (size_t)0), (const bf16*)(a.ws + B_ED), DFE, ED_BYTES, nullptr}; pg8::MoeOrder S; S.init(nP, 4, G, (int)blockIdx.x, p0, (const int*)(a.ws + MO_PEXP));
                    EpiMoeDown E{(unsigned char*)a.out, (const int*)(a.ws + MO_PDST), (const f32x2*)(a.ws + MO_PINFO)};
                    for (int rep = 0; rep < REP_MDN; ++rep) pg8::gemm_phase<EpiMoeDown, pg8::MoeOrder, false>(lds, g, S, E, wave); }
            }
        }
        if (job != 2) SEAM(ph);
    }
    if (IN(17)) { OPQ(); const int lane = plane;
        const float* fn = ain(a, I_FINAL);
        for (int r = blockIdx.x * 8 + wave; r < MR; r += G * 8) {
            unsigned char* orow = (unsigned char*)a.out + (size_t)r * 4096; float v[16]; float ss = 0.f;
#pragma unroll
            for (int hf = 0; hf < 2; ++hf) { const int k = 512 * hf + 8 * lane; const v4u h4 = *(const v4u*)(hb + (size_t)r * DM + k), y0 = *(const v4u*)(orow + 2 * k), y1 = *(const v4u*)(orow + 2048 + 2 * k);
                const unsigned hw[4] = {h4.x, h4.y, h4.z, h4.w}, aw[4] = {y0.x, y0.y, y0.z, y0.w}, bw[4] = {y1.x, y1.y, y1.z, y1.w};
#pragma unroll
                for (int t = 0; t < 4; ++t) { const float x0 = bflo(hw[t]) + bflo(aw[t]) + bflo(bw[t]), x1 = bfhi(hw[t]) + bfhi(aw[t]) + bfhi(bw[t]); v[8 * hf + 2 * t] = x0; v[8 * hf + 2 * t + 1] = x1; ss += x0 * x0 + x1 * x1; } }
            ss = wave_sum(ss); const float rs = __builtin_amdgcn_rsqf(ss * (1.f / 1024.f) + EPS);
#pragma unroll
            for (int hf = 0; hf < 2; ++hf) { const int k = 512 * hf + 8 * lane; const f32x4 g0 = *(const f32x4*)(fn + k), g1 = *(const f32x4*)(fn + k + 4);
                *(f32x4*)(orow + 4 * k) = (f32x4){v[8 * hf] * rs * g0[0], v[8 * hf + 1] * rs * g0[1], v[8 * hf + 2] * rs * g0[2], v[8 * hf + 3] * rs * g0[3]};
                *(f32x4*)(orow + 4 * k + 16) = (f32x4){v[8 * hf + 4] * rs * g1[0], v[8 * hf + 5] * rs * g1[1], v[8 * hf + 6] * rs * g1[2], v[8 * hf + 7] * rs * g1[3]}; }
        }
    }
#undef IN
#undef SEAM
#undef hb
#undef stA
#undef stB
}

extern "C" void kernel_launch(void* const* d_in, const int* in_sizes, int n_in, void* d_out, int out_size, void* d_ws, size_t ws_size, hipStream_t stream) {
    static int grid = 0;
    if (grid == 0) {
        if (n_in != 24 || in_sizes[0] != MR * DM || out_size != MR * DM || ws_size < WS_NEED) { fprintf(stderr, "kernel_launch: unexpected problem (n_in %d, in0 %d, out %d, ws %zu < %zu)\n", n_in, n_in > 0 ? in_sizes[0] : -1, out_size, ws_size, (size_t)WS_NEED); grid = -1; return; }
        int dev = 0, cus = 0, per_cu = 0;
        if (hipGetDevice(&dev) != hipSuccess || hipDeviceGetAttribute(&cus, hipDeviceAttributeMultiprocessorCount, dev) != hipSuccess) { grid = -1; return; }
        if (hipFuncSetAttribute((const void*)mega_fwd, hipFuncAttributeMaxDynamicSharedMemorySize, LDS_BYTES) != hipSuccess) { fprintf(stderr, "kernel_launch: hipFuncSetAttribute failed\n"); grid = -1; return; }
        if (hipOccupancyMaxActiveBlocksPerMultiprocessor(&per_cu, (const void*)mega_fwd, 512, LDS_BYTES) != hipSuccess || per_cu < 1) fprintf(stderr, "kernel_launch: occupancy query reports %d\n", per_cu);
        (void)hipGetLastError();
        grid = cus;
    }
    if (grid < 0) return;
    if (hipMemsetAsync((char*)d_ws + WS_CTL, 0, CTL_BYTES, stream) != hipSuccess) return;
    Args a{};
    for (int i = 0; i < 24; ++i) a.in[i] = (const float*)d_in[i];
    a.out = (float*)d_out; a.ws = (unsigned char*)d_ws;
#if MK_ONE_LAUNCH
    a.ph_lo = 0; a.ph_hi = NPHASE;
    hipLaunchKernelGGL(mega_fwd, dim3(grid), dim3(512), LDS_BYTES, stream, a);
#else
    for (int p = 0; p < NPHASE; ++p) { a.ph_lo = p; a.ph_hi = p + 1; hipLaunchKernelGGL(mega_fwd, dim3(grid), dim3(512), LDS_BYTES, stream, a); }
#endif
}
```

```cpp
#include <hip/hip_runtime.h>
#include <cstdio>
#include <cstdint>

namespace pg8 {
#define PG8_LAS __attribute__((address_space(3)))
typedef unsigned short bf16_t;
typedef short bf16x8 __attribute__((ext_vector_type(8)));
typedef float f32x4 __attribute__((ext_vector_type(4)));
typedef unsigned u32x4 __attribute__((ext_vector_type(4)));
constexpr int BM = 256, BK = 64, HALF = 128, HTB = HALF * BK * 2  , STAGE_BYTES = 8 * HTB, NXCD = 8, WGM = 8;

__host__ __device__ __forceinline__ int lds_byte(int r, int c) { const int st = (r >> 4) * 2 + (c >> 5), rr = r & 15, cc = c & 31, ob = rr * 64 + cc * 2; return st * 1024 + (ob ^ (((ob >> 9) & 1) << 5)); }
__host__ __device__ __forceinline__ void stage_rc(int b, int& R, int& C) { const int st = b / 1024, sb = b % 1024, swz = sb ^ (((sb >> 9) & 1) << 5); R = (st >> 1) * 16 + swz / 64; C = (st & 1) * 32 + (swz % 64) / 2; }
__host__ __device__ __forceinline__ int perm32(int rho) { const int n = rho >> 4, i = rho & 15; return 8 * (i >> 2) + 4 * n + (i & 3); }

struct Unit { int pm, pn, e, gp; };
struct Gemm { const bf16_t* A; const bf16_t* Bt; int K; size_t estride  ; const int* rowidx  ; };

struct StaticOrder {
    int nM, nN, nwg, G, c;
    __device__ void init(int nM_, int nN_, int G_, int c_) { nM = nM_; nN = nN_; nwg = nM * nN; G = G_; c = c_; }
    __device__ __forceinline__ bool map(int i, int& pm, int& pn) const { return mapL((long)i * G + c, pm, pn); }
    __device__ __forceinline__ bool mapL(long L, int& pm, int& pn) const {
        if (L >= nwg) return false;
        int wgid = (int)L; { const int q = nwg / NXCD, r = nwg % NXCD, xcd = wgid % NXCD, off = wgid / NXCD; wgid = (xcd < r ? xcd * (q + 1) : r * (q + 1) + (xcd - r) * q) + off; }
        const int nig = WGM * nN, gid = wgid / nig, fm = gid * WGM, gsz = (nM - fm) < WGM ? (nM - fm) : WGM;
        pm = fm + ((wgid % nig) % gsz); pn = (wgid % nig) / gsz; return true;
    }
    __device__ __forceinline__ bool next(int i, Unit& u) const { int pm, pn; if (!map(i, pm, pn)) return false; u.pm = pm; u.pn = pn; u.e = 0; u.gp = pm; return true; }
};
struct MoeOrder {
    StaticOrder so; int p0; const int* pexp;
    int psplit, p1;
    int H;
    __device__ void init(int nP, int nN, int G, int c, int p0_, const int* pexp_) { so.init(nP, nN, G, c); p0 = p0_; pexp = pexp_; psplit = 1 << 30; p1 = 0; H = 0; }
    __device__ __forceinline__ bool next(int i, Unit& u) const { int pm, pn; long L = (long)i * so.G + so.c;
        if (H > 0) { const int full = so.nwg / so.G, nh = full - 3;
            if (so.c < H) { if (i >= nh) return false; }
            else if (i >= full) { const int j = so.c - H; if (i > full || j >= 3 * H) return false; L = (long)(nh + j / H) * so.G + (j % H); } }
        if (!so.mapL(L, pm, pn)) return false;
        u.pm = pm; u.pn = pn; u.gp = pm < psplit ? p0 + pm : p1 + (pm - psplit); u.e = __builtin_amdgcn_readfirstlane(pexp[u.gp]); return true; }
};

__device__ __forceinline__ unsigned cvt_pk_bf16(float lo, float hi) { unsigned r; asm volatile("v_cvt_pk_bf16_f32 %0, %1, %2" : "=v"(r) : "v"(lo), "v"(hi)); return r; }
__device__ __forceinline__ float bf_lo(unsigned w) { return __uint_as_float(w << 16); }
__device__ __forceinline__ float bf_hi(unsigned w) { return __uint_as_float(w & 0xffff0000u); }

template <class Epi, class Sched, bool GATHER>
__device__ __forceinline__ void gemm_phase(PG8_LAS unsigned char* lds, const Gemm g, const Sched& S, const Epi& E, int wave_id  ) {
    int tid_; asm volatile("v_mbcnt_lo_u32_b32 %0, -1, 0\n\tv_mbcnt_hi_u32_b32 %0, -1, %0" : "=v"(tid_)); tid_ += wave_id << 6;
    const int tid = tid_, wid = __builtin_amdgcn_readfirstlane(tid >> 6), lane = tid & 63, wr = wid >> 2, wc = wid & 3, fr = lane & 15, fq = lane >> 4;
    const int K = g.K, nt = K / BK;
    int Ra[2], Ca[2]; unsigned voffB[2];
#pragma unroll
    for (int i = 0; i < 2; ++i) { int R, C; stage_rc(tid * 16 + i * 8192, R, C); const int Rb = (R & ~31) + perm32(R & 31);
        Ra[i] = R; Ca[i] = C; voffB[i] = (unsigned)(Rb * K + C) * 2u; }
    const size_t kstep = (size_t)(BK * 2);
    const size_t hstep = (size_t)HALF * K * 2;
    const size_t tstep = 2 * hstep;
    const unsigned ldsw = (unsigned)wid * 1024u;
    const int aoff = lds_byte(wr * 64 + fr, fq * 8), boff = lds_byte(wc * 32 + fr, fq * 8);
    const char* const A0 = (const char*)g.A;
#define PG8_SA(b, h) (((b) * 2 + (h)) * HTB)
#define PG8_SB(b, h) ((4 + (b) * 2 + (h)) * HTB)
#define PG8_STAGE(bufoff, gbase, voff) do { _Pragma("unroll") for (int _i = 0; _i < 2; ++_i) \
        __builtin_amdgcn_global_load_lds((const unsigned*)((const char*)(gbase) + (voff)[_i]), (PG8_LAS unsigned*)(lds + (bufoff) + ldsw + _i * 8192), 16, 0, 0); } while (0)
#define PG8_LDA(dst, b, h) do { _Pragma("unroll") for (int m = 0; m < 4; ++m) _Pragma("unroll") for (int k = 0; k < 2; ++k) dst[m][k] = *(const PG8_LAS bf16x8*)(lds + PG8_SA(b, h) + aoff + m * 2048 + k * 1024); } while (0)
#define PG8_LDB(dst, b, h) do { _Pragma("unroll") for (int n = 0; n < 2; ++n) _Pragma("unroll") for (int k = 0; k < 2; ++k) dst[n][k] = *(const PG8_LAS bf16x8*)(lds + PG8_SB(b, h) + boff + n * 2048 + k * 1024); } while (0)
#define PG8_MMA(ai, bj, At, Bt) do { __builtin_amdgcn_s_setprio(1); _Pragma("unroll") for (int m = 0; m < 4; ++m) _Pragma("unroll") for (int n = 0; n < 2; ++n) _Pragma("unroll") for (int k = 0; k < 2; ++k) \
        acc[ai][bj][m][n] = __builtin_amdgcn_mfma_f32_16x16x32_bf16(Bt[n][k], At[m][k], acc[ai][bj][m][n], 0, 0, 0); __builtin_amdgcn_s_setprio(0); } while (0)
#define PG8_WAIT_V(n) asm volatile("s_waitcnt vmcnt(" #n ")" ::: "memory")
#define PG8_WAIT_L(n) asm volatile("s_waitcnt lgkmcnt(" #n ")" ::: "memory")
#define PG8_BAR __builtin_amdgcn_s_barrier()
#define PG8_SCHED __builtin_amdgcn_sched_barrier(0)
#define PG8_AOFFS(dst, u) do { _Pragma("unroll") for (int _h = 0; _h < 2; ++_h) _Pragma("unroll") for (int _i = 0; _i < 2; ++_i) { \
        int _row = (u).pm * BM + _h * HALF + Ra[_i]; \
        if (GATHER) { const int _gi = g.rowidx[(u).gp * BM + _h * HALF + Ra[_i]]; _row = _gi < 0 ? 0 : _gi; } \
        dst[_h][_i] = ((unsigned)_row * (unsigned)K + (unsigned)Ca[_i]) * 2u; } } while (0)
    Unit cur, nxt; int ui = 0;
    if (!S.next(0, cur)) return;
    f32x4 acc[2][2][4][2];
#pragma unroll
    for (int a = 0; a < 2; ++a)
#pragma unroll
        for (int b = 0; b < 2; ++b)
#pragma unroll
            for (int m = 0; m < 4; ++m)
#pragma unroll
                for (int n = 0; n < 2; ++n) acc[a][b][m][n] = (f32x4){0.f, 0.f, 0.f, 0.f};
    bf16x8 At[4][2], B0[2][2], B1[2][2];
    unsigned oaC[2][2], oaN[2][2];
    PG8_AOFFS(oaC, cur);
    const char* cB = (const char*)g.Bt + (size_t)cur.e * g.estride + (size_t)cur.pn * tstep;
    PG8_STAGE(PG8_SB(0, 0), cB, voffB); PG8_STAGE(PG8_SB(0, 1), cB + hstep, voffB); PG8_STAGE(PG8_SA(0, 0), A0, oaC[0]); PG8_STAGE(PG8_SA(0, 1), A0, oaC[1]);
    if (wr == 1) PG8_BAR;
    PG8_WAIT_V(2); PG8_BAR;
    PG8_STAGE(PG8_SB(1, 0), cB + kstep, voffB); PG8_STAGE(PG8_SA(1, 0), A0 + kstep, oaC[0]); PG8_STAGE(PG8_SB(1, 1), cB + hstep + kstep, voffB);
    PG8_WAIT_V(6); PG8_BAR;
    for (;;) {
        const bool has_next = S.next(ui + 1, nxt);
        if (has_next) { PG8_AOFFS(oaN, nxt); }
        else {
#pragma unroll
            for (int _h = 0; _h < 2; ++_h)
#pragma unroll
                for (int _i = 0; _i < 2; ++_i) oaN[_h][_i] = oaC[_h][_i]; }
        const char* nB = has_next ? (const char*)g.Bt + (size_t)nxt.e * g.estride + (size_t)nxt.pn * tstep : cB;
        for (int t = 0; t < nt; t += 2) {
            const bool last = (t == nt - 2);
            const char* ka1 = A0 + (size_t)(t + 1) * kstep;
            const char* ka2 = last ? A0 : A0 + (size_t)(t + 2) * kstep; const char* b2 = last ? nB : cB + (size_t)(t + 2) * kstep;
            const char* ka3 = ka2 + kstep; const char* b3 = b2 + kstep;
            unsigned o2[2][2];
#pragma unroll
            for (int _h = 0; _h < 2; ++_h)
#pragma unroll
                for (int _i = 0; _i < 2; ++_i) o2[_h][_i] = oaC[_h][_i];
            if (last) {
#pragma unroll
                for (int _h = 0; _h < 2; ++_h)
#pragma unroll
                    for (int _i = 0; _i < 2; ++_i) o2[_h][_i] = oaN[_h][_i];
                asm volatile("" : "+v"(o2[0][0]), "+v"(o2[0][1]), "+v"(o2[1][0]), "+v"(o2[1][1])); }
            PG8_LDB(B0, 0, 0); PG8_LDB(B1, 0, 1); PG8_SCHED; PG8_LDA(At, 0, 0); PG8_STAGE(PG8_SA(1, 1), ka1, oaC[1]);
            PG8_WAIT_V(8); PG8_WAIT_L(0); PG8_BAR; PG8_MMA(0, 0, At, B0); PG8_MMA(0, 1, At, B1); PG8_BAR; PG8_SCHED;
            PG8_LDA(At, 0, 1); PG8_STAGE(PG8_SB(0, 0), b2, voffB); PG8_STAGE(PG8_SB(0, 1), b2 + hstep, voffB); PG8_STAGE(PG8_SA(0, 0), ka2, o2[0]);
            PG8_WAIT_V(8); PG8_WAIT_L(0); PG8_BAR; PG8_MMA(1, 0, At, B0); PG8_MMA(1, 1, At, B1); PG8_BAR; PG8_SCHED;
            PG8_LDB(B0, 1, 0); PG8_LDB(B1, 1, 1); PG8_SCHED; PG8_LDA(At, 1, 0); PG8_STAGE(PG8_SA(0, 1), ka2, o2[1]);
            PG8_WAIT_V(8); PG8_WAIT_L(0); PG8_BAR; PG8_MMA(0, 0, At, B0); PG8_MMA(0, 1, At, B1); PG8_BAR; PG8_SCHED;
            PG8_LDA(At, 1, 1); PG8_STAGE(PG8_SB(1, 0), b3, voffB); PG8_STAGE(PG8_SB(1, 1), b3 + hstep, voffB); PG8_STAGE(PG8_SA(1, 0), ka3, o2[0]);
            PG8_WAIT_V(8); PG8_WAIT_L(0); PG8_BAR; PG8_MMA(1, 0, At, B0); PG8_MMA(1, 1, At, B1); PG8_BAR; PG8_SCHED;
        }
        if (wr == 0) PG8_BAR;
        E(acc, cur, wr, wc, fr, fq);
        if (!has_next) break;
#pragma unroll
        for (int a = 0; a < 2; ++a)
#pragma unroll
            for (int b = 0; b < 2; ++b)
#pragma unroll
                for (int m = 0; m < 4; ++m)
#pragma unroll
                    for (int n = 0; n < 2; ++n) acc[a][b][m][n] = (f32x4){0.f, 0.f, 0.f, 0.f};
        cur = nxt; cB = nB; ++ui;
#pragma unroll
        for (int _h = 0; _h < 2; ++_h)
#pragma unroll
            for (int _i = 0; _i < 2; ++_i) oaC[_h][_i] = oaN[_h][_i];
        if (wr == 1) PG8_BAR;
    }
    PG8_WAIT_V(0);
    PG8_BAR;
#undef PG8_SA
#undef PG8_SB
#undef PG8_STAGE
#undef PG8_LDA
#undef PG8_LDB
#undef PG8_MMA
#undef PG8_WAIT_V
#undef PG8_WAIT_L
#undef PG8_BAR
#undef PG8_SCHED
#undef PG8_AOFFS
}
}
#define GAS __attribute__((address_space(1)))
#define LAS __attribute__((address_space(3)))
typedef unsigned short bf16;
typedef unsigned v4u __attribute__((ext_vector_type(4)));
typedef unsigned v2u __attribute__((ext_vector_type(2)));
typedef float f32x4 __attribute__((ext_vector_type(4)));
typedef float f32x2 __attribute__((ext_vector_type(2)));
typedef GAS unsigned gu32;
#define RLX_AGENT __ATOMIC_RELAXED, __HIP_MEMORY_SCOPE_AGENT
#define LDS_WAIT() asm volatile("s_waitcnt lgkmcnt(0)" ::: "memory")
#define VM_WAIT() asm volatile("s_waitcnt vmcnt(0)" ::: "memory")
__device__ __forceinline__ unsigned f2bf(float f) { unsigned u = __builtin_bit_cast(unsigned, f); return (u + 0x7fffu + ((u >> 16) & 1u)) >> 16; }
__device__ __forceinline__ unsigned pk2(float lo, float hi) { return f2bf(lo) | (f2bf(hi) << 16); }
__device__ __forceinline__ float bf2f(bf16 h) { return __uint_as_float(((unsigned)h) << 16); }
__device__ __forceinline__ float bflo(unsigned w) { return __uint_as_float(w << 16); }
__device__ __forceinline__ float bfhi(unsigned w) { return __uint_as_float(w & 0xffff0000u); }

#define XB_TMO      128
#define XB_XCNT(j)  (256  + 64 * (j))
#define XB_XSUB(j)  (1280 + 64 * (j))
#define XB_XGEN(j)  (2304 + 64 * (j))
#define XB_TOP      3328
#define XB_TOPGEN   3392
#define XCD_BAR_WORDS 3456
#define XB_SPIN_CAP (1u << 18)

__device__ __forceinline__ unsigned xb_ld(unsigned* p)              { return __hip_atomic_load(p, __ATOMIC_RELAXED, __HIP_MEMORY_SCOPE_AGENT); }
__device__ __forceinline__ unsigned xb_add(unsigned* p, unsigned v) { return __hip_atomic_fetch_add(p, v, __ATOMIC_RELAXED, __HIP_MEMORY_SCOPE_AGENT); }
__device__ __forceinline__ unsigned xb_xcc_id() { return (unsigned)__builtin_amdgcn_s_getreg((3 << 11) | 20) & 0xFu; }
#define XB_SPIN(cond, bar) do { unsigned _sp = 0; while (cond) { __builtin_amdgcn_s_sleep(1); \
    if ((++_sp & 255u) == 0u) { if (xb_ld(&(bar)[XB_TMO])) break; if (_sp > XB_SPIN_CAP) { atomicAdd(&(bar)[XB_TMO], 1u); break; } } } } while (0)

struct XcdBarrier {
    unsigned* bar; unsigned x;
    volatile LAS unsigned* st;
};

__device__ __forceinline__ XcdBarrier xcd_barrier_post(unsigned* bar, volatile LAS unsigned* st, bool leader  ) {
    XcdBarrier b; b.bar = bar; b.x = xb_xcc_id(); b.st = st;
    if (leader) (void)xb_add(&bar[XB_XCNT(b.x)], 1u);
    return b;
}
__device__ __forceinline__ void xcd_barrier_complete(unsigned* bar, unsigned x, unsigned& nloc, unsigned& nx) {
    const unsigned G = gridDim.x * gridDim.y * gridDim.z;
    unsigned sum, cnt, mine, sp = 0u;
    for (;;) {
        sum = 0u; cnt = 0u; mine = 0u;
#pragma unroll
        for (unsigned j = 0; j < 16; ++j) { const unsigned c = xb_ld(&bar[XB_XCNT(j)]); sum += c; cnt += (c > 0u) ? 1u : 0u; mine = (j == x) ? c : mine; }
        if (sum == G) break;
        __builtin_amdgcn_s_sleep(1);
        if ((++sp & 255u) == 0u) { if (xb_ld(&bar[XB_TMO])) break; if (sp > XB_SPIN_CAP) { atomicAdd(&bar[XB_TMO], 1u); break; } }
    }
    nloc = mine > 0u ? mine : 1u; nx = cnt > 0u ? cnt : 1u;
}

__device__ __forceinline__ void xcd_barrier(const XcdBarrier& b, bool leader) {
    asm volatile("s_waitcnt vmcnt(0)" ::: "memory");
    __syncthreads();
    if (leader) {
        unsigned* bar = b.bar;
        __builtin_amdgcn_s_waitcnt(0);
        unsigned nloc = b.st[0], nx = b.st[1];
        if (nloc == 0u) { xcd_barrier_complete(bar, b.x, nloc, nx); b.st[0] = nloc; b.st[1] = nx; }
        const unsigned old = xb_add(&bar[XB_XSUB(b.x)], 1u);
        const unsigned gen = old / nloc;
        if (old + 1u == (gen + 1u) * nloc) {
            __builtin_amdgcn_fence(__ATOMIC_RELEASE, "agent");
            asm volatile("s_waitcnt vmcnt(0)" ::: "memory");
            const unsigned og = xb_add(&bar[XB_TOP], 1u);
            const unsigned tg = og / nx;
            if (og + 1u == (tg + 1u) * nx) xb_add(&bar[XB_TOPGEN], 1u);
            else XB_SPIN(xb_ld(&bar[XB_TOPGEN]) == tg, bar);
            __builtin_amdgcn_fence(__ATOMIC_ACQUIRE, "agent");
            xb_add(&bar[XB_XGEN(b.x)], 1u);
            asm volatile("s_waitcnt vmcnt(0)" ::: "memory");
        } else {
            XB_SPIN(xb_ld(&bar[XB_XGEN(b.x)]) == gen, bar);
            __builtin_amdgcn_fence(__ATOMIC_ACQUIRE, "agent");
            asm volatile("s_waitcnt vmcnt(0)" ::: "memory");
        }
    }
    __syncthreads();
}

__device__ __forceinline__ int lane_id() { int l; asm volatile("v_mbcnt_lo_u32_b32 %0, -1, 0\n\tv_mbcnt_hi_u32_b32 %0, -1, %0" : "=v"(l)); return l; }

constexpr int NB = 16, TT = 2048, DM = 1024, MR = NB * TT, NMETA = 16, MROWS = MR + 256, NPAN = MROWS / 256;
constexpr int PSEQ = 2112, NCH = 33;
constexpr int DIN = 2864, N1 = 3072;
constexpr int DFF = 2816, DFE = 3584, NEXP = 8;
constexpr float EPS = 1e-6f;
constexpr int C_AQ = 0, C_AK = 128, C_AV = 256, C_ALR = 512, C_AOG = 528, C_RQ = 784, C_RK = 1040, C_RV = 1296, C_ROG = 1552, C_CQ = 1808, C_CKV = 2000, C_KPE = 2064, C_DQ = 2096, C_DK = 2352, C_DV = 2608;
constexpr int MAXPAN = 264;
constexpr float LOG2E = 1.4426950408889634f;

constexpr size_t MiB = 1u << 20;
constexpr size_t WS_CTL = 0, CTL_BYTES = 1 * MiB;
constexpr size_t WS_TABR = 1 * MiB, WS_TABM = 1 * MiB + 576 * 1024;
constexpr size_t WS_RT = 2 * MiB;
constexpr size_t WS_WQA = 2 * MiB + 256 * 1024, WQA_BYTES = 384 * 192 * 2;
constexpr size_t WS_STA = 3 * MiB, WS_STB = 6 * MiB;
constexpr size_t WS_MOE = 9 * MiB;
constexpr size_t MO_ROWIDX = WS_MOE, MO_PDST = WS_MOE + 512 * 1024, MO_PINFO = WS_MOE + 1 * MiB, MO_TOKE = WS_MOE + 2 * MiB, MO_TOKP = MO_TOKE + 256 * 1024, MO_TOKW = MO_TOKE + 512 * 1024, MO_PEXP = WS_MOE + 3 * MiB;
constexpr size_t WS_GD = 13 * MiB;
constexpr size_t WS_W1T = 16 * MiB, W1T_BYTES = (size_t)N1 * DM * 2;
constexpr size_t WS_WOT = 29 * MiB, WOT_BYTES = (size_t)DM * DM * 2;
constexpr size_t WS_WGU = 33 * MiB;
constexpr size_t WS_WD = 44 * MiB;
constexpr size_t WS_HB = 50 * MiB;
constexpr size_t WS_BIG = 115 * MiB;
constexpr size_t B_PROJ = WS_BIG;
constexpr int GQ_T = 5120, GKT_T = 5120, RT_T = 9216, VT_T = 9216;
constexpr size_t B_GQ = WS_BIG + 210 * MiB, B_GK = WS_BIG + 221 * MiB, B_GV = WS_BIG + 232 * MiB;
constexpr size_t B_RQ = WS_BIG + 251 * MiB, B_RK = WS_BIG + 270 * MiB, B_RV = WS_BIG + 289 * MiB;
constexpr size_t B_MQ = WS_BIG + 308 * MiB, B_MK = WS_BIG + 333 * MiB;
constexpr size_t B_DQ = WS_BIG + 340 * MiB, B_DK = B_DQ + 16896 * 1024;
constexpr size_t O_DVT = 65 * MiB, O_MVT = 82 * MiB, O_GKT = 87 * MiB, O_RKT = 98 * MiB;
constexpr size_t B_ACT = WS_BIG;
constexpr size_t B_EGU = WS_BIG, EGU_BYTES = (size_t)2 * DFE * DM * 2;
constexpr size_t B_ED = WS_BIG + 112 * MiB, ED_BYTES = (size_t)DM * DFE * 2;
constexpr size_t B_EACT = WS_BIG + 168 * MiB;
constexpr size_t WS_NEED = WS_BIG + 406 * MiB;
constexpr int CW_BAR = 4096, CW_CNT = 8192;

constexpr int RING_BYTES = 131072, MISC_OFF = RING_BYTES + 320, LDS_BYTES = 147456;

__device__ __forceinline__ float silu_f(float x) { return x * __builtin_amdgcn_rcpf(1.0f + __builtin_amdgcn_exp2f(-x * LOG2E)); }
__device__ __forceinline__ v4u pack8(const f32x4 a, const f32x4 b) { v4u w; w.x = pg8::cvt_pk_bf16(a[0], a[1]); w.y = pg8::cvt_pk_bf16(a[2], a[3]); w.z = pg8::cvt_pk_bf16(b[0], b[1]); w.w = pg8::cvt_pk_bf16(b[2], b[3]); return w; }

__device__ __forceinline__ void rows_rstd16(const float* stats, int row0, int fq, float (&rs)[8]) {
    f32x4 v[8];
#pragma unroll
    for (int j = 0; j < 8; ++j) v[j] = *(const f32x4*)(stats + (size_t)(row0 + (j >> 2) * 128 + (j & 3) * 16) * 16 + 4 * fq);
#pragma unroll
    for (int j = 0; j < 8; ++j) { float s = (v[j][0] + v[j][1]) + (v[j][2] + v[j][3]); s += __shfl_xor(s, 16); s += __shfl_xor(s, 32); rs[j] = __builtin_amdgcn_rsqf(s * (1.0f / 1024.0f) + EPS); }
}
struct EpiProj {
    bf16* O; const float* stats;
    __device__ __forceinline__ void operator()(const f32x4 (&acc)[2][2][4][2], const pg8::Unit& u, int wr, int wc, int fr, int fq) const {
        const int col0 = u.pn * 256 + wc * 32 + 8 * fq, row0 = u.pm * 256 + wr * 64 + fr;
        float rs[8]; rows_rstd16(stats, row0, fq, rs);
#ifdef PROBE_RSTD
        for (int q = 0; q < PROBE_RSTD; ++q) { const float* sp = stats; asm volatile("" : "+v"(sp), "+v"(rs[0]), "+v"(rs[1]), "+v"(rs[2]), "+v"(rs[3]), "+v"(rs[4]), "+v"(rs[5]), "+v"(rs[6]), "+v"(rs[7])); rows_rstd16(sp, row0, fq, rs); }
#endif
#pragma unroll
        for (int ai = 0; ai < 2; ++ai)
#pragma unroll
            for (int m = 0; m < 4; ++m) { const int r = row0 + ai * 128 + m * 16; const float sc = rs[ai * 4 + m]; bf16* rowp = O + (size_t)r * N1 + col0;
#pragma unroll
                for (int bj = 0; bj < 2; ++bj) *(v4u*)(rowp + bj * 128) = pack8(acc[ai][bj][m][0] * sc, acc[ai][bj][m][1] * sc); }
    }
};
struct EpiSwiglu {
    bf16* O; int ldo; const float* stats;
    __device__ __forceinline__ void operator()(const f32x4 (&acc)[2][2][4][2], const pg8::Unit& u, int wr, int wc, int fr, int fq) const {
        const int col0 = u.pn * 128 + wc * 32 + 8 * fq, row0 = u.pm * 256 + wr * 64 + fr;
        float rs[8]; rows_rstd16(stats, row0, fq, rs);
#pragma unroll
        for (int ai = 0; ai < 2; ++ai)
#pragma unroll
            for (int m = 0; m < 4; ++m) { const int r = row0 + ai * 128 + m * 16; const float sc = rs[ai * 4 + m];
                f32x4 o[2];
#pragma unroll
                for (int n = 0; n < 2; ++n)
#pragma unroll
                    for (int i = 0; i < 4; ++i) o[n][i] = silu_f(acc[ai][0][m][n][i] * sc) * (acc[ai][1][m][n][i] * sc);
                *(v4u*)(O + (size_t)r * ldo + col0) = pack8(o[0], o[1]); }
    }
};
struct EpiResid {
    bf16* H; float* stats;
    __device__ __forceinline__ void operator()(const f32x4 (&acc)[2][2][4][2], const pg8::Unit& u, int wr, int wc, int fr, int fq) const {
        const int col0 = u.pn * 256 + wc * 32 + 8 * fq, row0 = u.pm * 256 + wr * 64 + fr;
#pragma unroll
        for (int ai = 0; ai < 2; ++ai) {
            v4u w[4][2];
#pragma unroll
            for (int m = 0; m < 4; ++m)
#pragma unroll
                for (int bj = 0; bj < 2; ++bj) w[m][bj] = *(const v4u*)(H + (size_t)(row0 + ai * 128 + m * 16) * DM + col0 + bj * 128);
            float ssm[4];
#pragma unroll
            for (int m = 0; m < 4; ++m) { bf16* rowp = H + (size_t)(row0 + ai * 128 + m * 16) * DM + col0; float ss = 0.f;
#pragma unroll
                for (int bj = 0; bj < 2; ++bj) { const v4u x = w[m][bj];
                    f32x4 a = acc[ai][bj][m][0], b = acc[ai][bj][m][1];
                    a[0] += bflo(x.x); a[1] += bfhi(x.x); a[2] += bflo(x.y); a[3] += bfhi(x.y); b[0] += bflo(x.z); b[1] += bfhi(x.z); b[2] += bflo(x.w); b[3] += bfhi(x.w);
                    ss += (a[0] * a[0] + a[1] * a[1]) + (a[2] * a[2] + a[3] * a[3]) + (b[0] * b[0] + b[1] * b[1]) + (b[2] * b[2] + b[3] * b[3]);
                    *(v4u*)(rowp + bj * 128) = pack8(a, b); }
                ss += __shfl_xor(ss, 16); ss += __shfl_xor(ss, 32); ssm[m] = ss; }
            if (fq == 0) {
#pragma unroll
                for (int m = 0; m < 4; ++m) stats[(size_t)(row0 + ai * 128 + m * 16) * 16 + u.pn * 4 + wc] = ssm[m]; } }
    }
};
struct EpiSwigluMoe {
    bf16* O; const f32x2* pinfo;
    __device__ __forceinline__ void operator()(const f32x4 (&acc)[2][2][4][2], const pg8::Unit& u, int wr, int wc, int fr, int fq) const {
        const int col0 = u.pn * 128 + wc * 32 + 8 * fq, rl0 = wr * 64 + fr;
        float rs[8];
#pragma unroll
        for (int j = 0; j < 8; ++j) rs[j] = pinfo[u.gp * 256 + rl0 + (j >> 2) * 128 + (j & 3) * 16][0];
#pragma unroll
        for (int ai = 0; ai < 2; ++ai)
#pragma unroll
            for (int m = 0; m < 4; ++m) { const int rl = rl0 + ai * 128 + m * 16; const float sc = rs[ai * 4 + m];
                f32x4 o[2];
#pragma unroll
                for (int n = 0; n < 2; ++n)
#pragma unroll
                    for (int i = 0; i < 4; ++i) o[n][i] = silu_f(acc[ai][0][m][n][i] * sc) * (acc[ai][1][m][n][i] * sc);
                *(v4u*)(O + (size_t)(u.pm * 256 + rl) * DFE + col0) = pack8(o[0], o[1]); }
    }
};
struct EpiMoeDown {
    unsigned char* Y; const int* pdst; const f32x2* pinfo;
    __device__ __forceinline__ void operator()(const f32x4 (&acc)[2][2][4][2], const pg8::Unit& u, int wr, int wc, int fr, int fq) const {
        const int col0 = u.pn * 256 + wc * 32 + 8 * fq, rl0 = wr * 64 + fr;
        int dst[8]; float wt[8];
#pragma unroll
        for (int j = 0; j < 8; ++j) { const int gi = u.gp * 256 + rl0 + (j >> 2) * 128 + (j & 3) * 16; dst[j] = pdst[gi]; wt[j] = pinfo[gi][1]; }
#pragma unroll
        for (int ai = 0; ai < 2; ++ai)
#pragma unroll
            for (int m = 0; m < 4; ++m) { const int d = dst[ai * 4 + m]; const float w = wt[ai * 4 + m];
                if (d >= 0) { bf16* rowp = (bf16*)(Y + (size_t)(d >> 1) * 4096 + (size_t)(d & 1) * 2048) + col0;
#pragma unroll
                    for (int bj = 0; bj < 2; ++bj) *(v4u*)(rowp + bj * 128) = pack8(acc[ai][bj][m][0] * w, acc[ai][bj][m][1] * w); } }
    }
};

__device__ __forceinline__ float wave_sum(float v) {
#pragma unroll
    for (int o = 1; o < 64; o <<= 1) v += __shfl_xor(v, o);
    return v;
}
__device__ __forceinline__ void transpose_item(const float* W, int K, int N, const float* gain, bf16* WT, int kb, int nb, int dmode, LAS float* scr_, int lane) {
    LAS unsigned* scr = (LAS unsigned*)scr_;
    const int k0 = 64 * kb, n0 = 64 * nb, n = n0 + 2 * (lane & 31), kh = lane >> 5;
    f32x2 v[32];
#pragma unroll
    for (int i = 0; i < 32; ++i) v[i] = (n < N) ? *(const f32x2*)(W + (size_t)(k0 + 2 * i + kh) * N + n) : (f32x2){0.f, 0.f};
    if (gain) {
#pragma unroll
        for (int i = 0; i < 32; ++i) v[i] = v[i] * gain[k0 + 2 * i + kh]; }
#pragma unroll
    for (int i = 0; i < 32; ++i) scr[(2 * i + kh) * 33 + (lane & 31)] = pk2(v[i][0], v[i][1]);
    LDS_WAIT(); asm volatile("" ::: "memory");
    const LAS bf16* T = (const LAS bf16*)scr;
    const int c = lane & 7;
    const int d0 = dmode == 0 ? n0 : 256 * (n0 >> 7) + (n0 & 127) + (dmode == 2 ? 128 : 0);
#pragma unroll
    for (int j = 0; j < 8; ++j) { const int nl = (lane >> 3) + 8 * j; unsigned x[8];
#pragma unroll
        for (int t = 0; t < 8; ++t) x[t] = T[(8 * c + t) * 66 + nl];
        v4u o; o.x = x[0] | (x[1] << 16); o.y = x[2] | (x[3] << 16); o.z = x[4] | (x[5] << 16); o.w = x[6] | (x[7] << 16);
        if (n0 + nl < N) *(v4u*)(WT + (size_t)(d0 + nl) * K + k0 + 8 * c) = o; }
    LDS_WAIT(); asm volatile("" ::: "memory");
}

struct Args { const float* in[24]; float* out; unsigned char* ws; int ph_lo, ph_hi; };
__device__ __forceinline__ const float* ain(const Args& a, int i) { return a.in[i]; }
enum { I_X = 0, I_META, I_ANORM, I_WIN, I_GWG, I_GBG, I_GNORM, I_RNORM, I_MQN, I_WUQ, I_MKVN, I_WUKV, I_DLAM, I_DNORM, I_WOUT, I_FNORM, I_FG, I_FU, I_FD, I_ROUTER, I_EG, I_EU, I_ED, I_FINAL };

#ifndef REP_FOLD
#define REP_FOLD 1
#endif
#ifndef REP_HINIT
#define REP_HINIT 1
#endif
__device__ __forceinline__ void wqa_unit(const Args& a, int li, int hh, LAS float* L, int tid) {
    const float* Wuq = ain(a, I_WUQ) + (size_t)li * 192 * 384; const float* Wukv = ain(a, I_WUKV) + (size_t)li * 64 * 512;
    const float* gq = ain(a, I_MQN) + li * 192; const float* gkv = ain(a, I_MKVN) + li * 64;
    bf16* WqaT = (bf16*)(a.ws + WS_WQA + li * WQA_BYTES);
    LAS float* Wqa = L; LAS float* Wuk = L + 192 * 97;
    __syncthreads();
    for (int idx = tid; idx < 64 * 64; idx += 512) { const int n = idx >> 6, m = idx & 63; Wuk[n * 65 + m] = Wukv[n * 512 + hh * 128 + m]; }
    __syncthreads();
    for (int pass = 0; pass < 3; ++pass) { const int i = pass * 64 + (tid >> 3), ng = tid & 7; f32x4 wq[16];
#pragma unroll
        for (int j = 0; j < 16; ++j) wq[j] = *(const f32x4*)(Wuq + i * 384 + hh * 96 + 4 * j);
        const float gi = gq[i];
#pragma unroll
        for (int t = 0; t < 8; ++t) { const int n = ng * 8 + t; float s = 0.f;
#pragma unroll
            for (int j = 0; j < 16; ++j) s += (wq[j][0] * Wuk[n * 65 + 4 * j] + wq[j][1] * Wuk[n * 65 + 4 * j + 1]) + (wq[j][2] * Wuk[n * 65 + 4 * j + 2] + wq[j][3] * Wuk[n * 65 + 4 * j + 3]);
            Wqa[i * 97 + n] = gi * gkv[n] * s; }
        if (ng < 4) {
#pragma unroll
            for (int j = 0; j < 2; ++j) { const f32x4 r = *(const f32x4*)(Wuq + i * 384 + hh * 96 + 64 + ng * 8 + 4 * j); LAS float* d = Wqa + i * 97 + 64 + ng * 8 + 4 * j; d[0] = gi * r[0]; d[1] = gi * r[1]; d[2] = gi * r[2]; d[3] = gi * r[3]; } } }
    __syncthreads();
    for (int idx = tid; idx < 96 * 24; idx += 512) { const int n = idx % 96, i8 = idx / 96; float v[8];
#pragma unroll
        for (int t = 0; t < 8; ++t) v[t] = Wqa[(8 * i8 + t) * 97 + n];
        v4u w; w.x = pk2(v[0], v[1]); w.y = pk2(v[2], v[3]); w.z = pk2(v[4], v[5]); w.w = pk2(v[6], v[7]);
        *(v4u*)(WqaT + (size_t)(hh * 96 + n) * 192 + 8 * i8) = w; }
    __syncthreads();
}
__device__ __forceinline__ void wofold_unit(const Args& a, int li, int hh, int nq, LAS float* L, int tid) {
    const float* Wukv = ain(a, I_WUKV) + (size_t)li * 64 * 512; const float* gkv = ain(a, I_MKVN) + li * 64; const float* Wo = ain(a, I_WOUT) + (size_t)li * DM * DM;
    bf16* Wot = (bf16*)(a.ws + WS_WOT + li * WOT_BYTES);
    LAS float* WuvT = L; LAS float* Wos = L + 64 * 64;
    __syncthreads();
    for (int idx = tid; idx < 64 * 64; idx += 512) { const int j = idx >> 6, e = idx & 63; WuvT[e * 64 + j] = Wukv[j * 512 + hh * 128 + 64 + e] * gkv[j]; }
    for (int idx = tid; idx < 64 * 64; idx += 512) { const int e = idx >> 6, n4 = idx & 63; *(LAS f32x4*)(Wos + e * 256 + 4 * n4) = *(const f32x4*)(Wo + (size_t)(512 + 64 * hh + e) * DM + nq * 256 + 4 * n4); }
    __syncthreads();
    { const int n4 = tid & 63, j8 = tid >> 6; f32x4 acc[8];
#pragma unroll
        for (int j = 0; j < 8; ++j) acc[j] = (f32x4){0.f, 0.f, 0.f, 0.f};
#pragma unroll 4
        for (int e = 0; e < 64; ++e) { const f32x4 wv = *(const LAS f32x4*)(Wos + e * 256 + 4 * n4); const f32x4 u0 = *(const LAS f32x4*)(WuvT + e * 64 + 8 * j8), u1 = *(const LAS f32x4*)(WuvT + e * 64 + 8 * j8 + 4);
#pragma unroll
            for (int j = 0; j < 4; ++j) { acc[j] += wv * u0[j]; acc[4 + j] += wv * u1[j]; } }
#pragma unroll
        for (int t = 0; t < 4; ++t) { v4u w; w.x = pk2(acc[0][t], acc[1][t]); w.y = pk2(acc[2][t], acc[3][t]); w.z = pk2(acc[4][t], acc[5][t]); w.w = pk2(acc[6][t], acc[7][t]);
            *(v4u*)(Wot + (size_t)(nq * 256 + 4 * n4 + t) * DM + 512 + 64 * hh + 8 * j8) = w; } }
    __syncthreads();
}
__device__ __forceinline__ void p0_prologue(const Args& a, LAS unsigned char* lds, int tid, int lane, int wave) {
    const int G = gridDim.x;
    for (int rep = 0; rep < REP_FOLD; ++rep)
    for (int un = blockIdx.x; un < 40; un += G) {
        if (un < 8) wqa_unit(a, un >> 2, un & 3, (LAS float*)lds, tid);
        else { const int v = un - 8; wofold_unit(a, v >> 4, (v >> 2) & 3, v & 3, (LAS float*)lds, tid); }
    }
    __syncthreads();
    LAS float* scr = (LAS float*)(lds + wave * 16384);
    const int gw = blockIdx.x * 8 + wave, NGW = G * 8;
    constexpr int I_IN = 16 * 45, I_WO = 12 * 16, I_G = 16 * 44, I_D = 44 * 16;
    constexpr int NIT = 2 * I_IN + 2 * I_WO + 2 * I_G + I_D;
    for (int it = gw; it < NIT; it += NGW) {
        int r = it;
        if (r < 2 * I_IN) { const int li = r / I_IN; r %= I_IN; transpose_item(ain(a, I_WIN) + (size_t)li * DM * DIN, DM, DIN, ain(a, I_ANORM) + li * DM, (bf16*)(a.ws + WS_W1T + li * W1T_BYTES), r / 45, r % 45, 0, scr, lane); continue; } r -= 2 * I_IN;
        if (r < 2 * I_WO) { const int li = r / I_WO; r %= I_WO; int kb = r / 16; if (kb >= 8) kb += 4; transpose_item(ain(a, I_WOUT) + (size_t)li * DM * DM, DM, DM, nullptr, (bf16*)(a.ws + WS_WOT + li * WOT_BYTES), kb, r % 16, 0, scr, lane); continue; } r -= 2 * I_WO;
        if (r < I_G) { transpose_item(ain(a, I_FG), DM, DFF, ain(a, I_FNORM), (bf16*)(a.ws + WS_WGU), r / 44, r % 44, 1, scr, lane); continue; } r -= I_G;
        if (r < I_G) { transpose_item(ain(a, I_FU), DM, DFF, ain(a, I_FNORM), (bf16*)(a.ws + WS_WGU), r / 44, r % 44, 2, scr, lane); continue; } r -= I_G;
        transpose_item(ain(a, I_FD), DFF, DM, nullptr, (bf16*)(a.ws + WS_WD), r / 16, r % 16, 0, scr, lane);
    }
    const int gt = blockIdx.x * 512 + tid, NGT = G * 512;
    for (int i = gt; i < 2 * 208 * 128; i += NGT) { const int li = i / (208 * 128), r = i % (208 * 128);
        *(v4u*)(a.ws + WS_W1T + li * W1T_BYTES + (size_t)DIN * DM * 2 + (size_t)r * 16) = (v4u){0u, 0u, 0u, 0u}; }
    for (int i = gt; i < 8 * DM; i += NGT) { const int e = i >> 10, k = i & 1023; ((float*)(a.ws + WS_RT))[i] = ain(a, I_FNORM)[DM + k] * ain(a, I_ROUTER)[k * 8 + e]; }
    for (int i = gt; i < PSEQ * 48; i += NGT) { const int p = i / 48, j = i % 48; const bool isR = j < 32; const int f = isR ? j : j - 32;
        const float inv = __builtin_amdgcn_exp2f(-(float)f * (isR ? 13.287712379549449f / 32.f : 13.287712379549449f / 16.f));
        const double rev = (double)(p - 48) * (double)inv * 0.15915494309189535; const float fr = (float)(rev - __builtin_rint(rev));
        const f32x2 cs = {__builtin_amdgcn_cosf(fr), __builtin_amdgcn_sinf(fr)};
        if (isR) ((f32x2*)(a.ws + WS_TABR))[p * 32 + f] = cs; else ((f32x2*)(a.ws + WS_TABM))[p * 16 + f] = cs; }
    for (int i = gt; i < 240 * 128; i += NGT) *(v4u*)((unsigned char*)a.out + (size_t)(MR + 16) * 2048 + (size_t)i * 16) = (v4u){0u, 0u, 0u, 0u};
    bf16* hb = (bf16*)(a.ws + WS_HB); float* stA = (float*)(a.ws + WS_STA);
    for (int rep = 0; rep < REP_HINIT; ++rep)
    for (int r = gw; r < MROWS; r += NGW) {
        f32x4 v[4]; float s = 0.f;
#pragma unroll
        for (int j = 0; j < 4; ++j) { if (r < MR) v[j] = ((const f32x4*)(ain(a, I_X) + (size_t)r * DM))[lane + 64 * j]; else if (r < MR + NMETA) v[j] = ((const f32x4*)(ain(a, I_META) + (size_t)(r - MR) * DM))[lane + 64 * j]; else v[j] = (f32x4){0.f, 0.f, 0.f, 0.f};
            s += (v[j][0] * v[j][0] + v[j][1] * v[j][1]) + (v[j][2] * v[j][2] + v[j][3] * v[j][3]); }
        s = wave_sum(s);
#pragma unroll
        for (int j = 0; j < 4; ++j) { v2u w; w.x = pk2(v[j][0], v[j][1]); w.y = pk2(v[j][2], v[j][3]); ((v2u*)(hb + (size_t)r * DM))[lane + 64 * j] = w; }
        if (lane < 16) stA[(size_t)r * 16 + lane] = lane == 0 ? s : 0.f;
    }
}

__device__ __forceinline__ int src_row(int b, int c, int i) { return c == 0 ? (i < 48 ? -1 : MR + i - 48) : b * TT + 64 * (c - 1) + i; }
__device__ __forceinline__ float lg2gamma(int h) { return h == 0 ? -0.045803689613124789f : h == 1 ? -0.022720076500083529f : h == 2 ? -0.011315313227834146f : -0.0056465631411420627f; }

__device__ __forceinline__ void route_block(const Args& a, int blk, LAS unsigned char* lds, int tid, int lane, int wave) {
    LAS float* Rs = (LAS float*)lds; LAS int* lcnt = (LAS int*)(lds + 32768); LAS int* gbase = lcnt + 8; LAS int* rec = lcnt + 16;
    gu32* ctl = (gu32*)(a.ws + WS_CTL);
    const float* Rt = (const float*)(a.ws + WS_RT); const bf16* hb = (const bf16*)(a.ws + WS_HB); const float* stB = (const float*)(a.ws + WS_STB);
    __syncthreads();
    for (int idx = tid; idx < 8 * DM; idx += 512) Rs[idx] = Rt[idx];
    if (tid < 8) lcnt[tid] = 0;
    __syncthreads();
    for (int rr = 0; rr < 16; ++rr) { const int rl = wave * 16 + rr, row = blk * 128 + rl;
        const v4u w0 = *(const v4u*)(hb + (size_t)row * DM + 8 * lane), w1 = *(const v4u*)(hb + (size_t)row * DM + 512 + 8 * lane);
        const float x[16] = {bflo(w0.x), bfhi(w0.x), bflo(w0.y), bfhi(w0.y), bflo(w0.z), bfhi(w0.z), bflo(w0.w), bfhi(w0.w), bflo(w1.x), bfhi(w1.x), bflo(w1.y), bfhi(w1.y), bflo(w1.z), bfhi(w1.z), bflo(w1.w), bfhi(w1.w)};
        float st = lane < 16 ? stB[(size_t)row * 16 + lane] : 0.f; st = wave_sum(st); const float rs = __builtin_amdgcn_rsqf(st * (1.f / 1024.f) + EPS);
        float lg[8];
#pragma unroll
        for (int e = 0; e < 8; ++e) { float s = 0.f;
#pragma unroll
            for (int t = 0; t < 8; ++t) s += x[t] * Rs[e * DM + 8 * lane + t] + x[8 + t] * Rs[e * DM + 512 + 8 * lane + t];
            lg[e] = wave_sum(s) * rs; }
        int e0 = 0; float v0 = lg[0];
#pragma unroll
        for (int e = 1; e < 8; ++e) if (lg[e] > v0) { v0 = lg[e]; e0 = e; }
        int e1 = -1; float v1 = -3.0e38f;
#pragma unroll
        for (int e = 0; e < 8; ++e) if (e != e0 && lg[e] > v1) { v1 = lg[e]; e1 = e; }
        const float g0 = 1.f / (1.f + __expf(v1 - v0)), g1 = 1.f - g0;
        if (lane == 0) { const int lp0 = atomicAdd((int*)(lcnt + e0), 1), lp1 = atomicAdd((int*)(lcnt + e1), 1);
            rec[rl * 6] = e0; rec[rl * 6 + 1] = e1; rec[rl * 6 + 2] = lp0; rec[rl * 6 + 3] = lp1; rec[rl * 6 + 4] = __float_as_int(g0); rec[rl * 6 + 5] = __float_as_int(g1); } }
    __syncthreads();
    if (tid < 8) gbase[tid] = (int)__hip_atomic_fetch_add(ctl + CW_CNT + 64 * tid, (unsigned)lcnt[tid], RLX_AGENT);
    __syncthreads();
    if (tid < 256) { const int rl = tid >> 1, s = tid & 1, tok = blk * 128 + rl, e = rec[rl * 6 + s];
        ((int*)(a.ws + MO_TOKE))[tok * 2 + s] = e; ((int*)(a.ws + MO_TOKP))[tok * 2 + s] = gbase[e] + rec[rl * 6 + 2 + s]; ((int*)(a.ws + MO_TOKW))[tok * 2 + s] = rec[rl * 6 + 4 + s]; }
    __syncthreads();
}
__device__ __forceinline__ void moe_offsets(const Args& a, LAS int* offs, int tid) {
    gu32* ctl = (gu32*)(a.ws + WS_CTL);
    __syncthreads();
    if (tid == 0) { int o = 0;
        for (int e = 0; e < 8; ++e) { const int cnt = (int)__hip_atomic_load(ctl + CW_CNT + 64 * e, RLX_AGENT); offs[e] = o * 256; o += (cnt + 255) >> 8; }
        offs[8] = o; }
    __syncthreads();
}

typedef float f32x16 __attribute__((ext_vector_type(16)));
typedef short s16x8 __attribute__((ext_vector_type(8)));
typedef short s16x4 __attribute__((ext_vector_type(4)));
typedef short v4i16_t __attribute__((ext_vector_type(4)));
__device__ __forceinline__ int crow(int r, int hi) { return (r & 3) + 8 * (r >> 2) + 4 * hi; }


__device__ __forceinline__ void stage_cols(const bf16* proj, int b, int c, int col0, int ncols, LAS bf16* S, int sst, int lcol0, int tid) {
    const int cpr = ncols >> 3;
    for (int idx = tid; idx < 64 * cpr; idx += 512) { const int i = idx / cpr, ch = idx - i * cpr, sr = src_row(b, c, i);
        v4u v = {0u, 0u, 0u, 0u}; if (sr >= 0) v = *(const v4u*)(proj + (size_t)sr * N1 + col0 + ch * 8);
        *(LAS v4u*)(S + i * sst + lcol0 + ch * 8) = v; }
}
__device__ __forceinline__ v4u gather8(const LAS bf16* S, int sst, int row0, int col) {
    unsigned x[8];
#pragma unroll
    for (int t = 0; t < 8; ++t) x[t] = S[(row0 + t) * sst + col];
    v4u w; w.x = x[0] | (x[1] << 16); w.y = x[2] | (x[3] << 16); w.z = x[4] | (x[5] << 16); w.w = x[6] | (x[7] << 16); return w;
}
__device__ __forceinline__ void prep2_unit(const Args& a, int li, int b, int c, int part, LAS unsigned char* lds, int tid) {
    const bf16* proj = (const bf16*)(a.ws + B_PROJ);
    LAS bf16* S = (LAS bf16*)lds;
    const int blk0 = (b * NCH + c) * 4; const size_t prow0 = (size_t)b * PSEQ + 64 * c;
    unsigned char* dout = (unsigned char*)a.out;
    __syncthreads();
    if (part == 0) {
        constexpr int SST = 536; LAS float* seg = (LAS float*)(lds + 64 * SST * 2);
        stage_cols(proj, b, c, C_AQ, 128, S, SST, 0, tid); stage_cols(proj, b, c, C_AK, 128, S, SST, 128, tid); stage_cols(proj, b, c, C_ALR, 16, S, SST, 512, tid);
        __syncthreads();
        { const int ch = tid & 127, sg = tid >> 7; const float* Wg = ain(a, I_GWG) + (size_t)li * 16 * 128; const float bg = ain(a, I_GBG)[li * 128 + ch];
            float wg[16];
#pragma unroll
            for (int r = 0; r < 16; ++r) wg[r] = Wg[r * 128 + ch];
            float cl[16]; float run = 0.f;
#pragma unroll
            for (int t = 0; t < 16; ++t) { const int i = 16 * sg + t; const v4u l0 = *(const LAS v4u*)(S + i * SST + 512), l1 = *(const LAS v4u*)(S + i * SST + 520);
                float x = bg + bflo(l0.x) * wg[0] + bfhi(l0.x) * wg[1] + bflo(l0.y) * wg[2] + bfhi(l0.y) * wg[3] + bflo(l0.z) * wg[4] + bfhi(l0.z) * wg[5] + bflo(l0.w) * wg[6] + bfhi(l0.w) * wg[7]
                               + bflo(l1.x) * wg[8] + bfhi(l1.x) * wg[9] + bflo(l1.y) * wg[10] + bfhi(l1.y) * wg[11] + bflo(l1.z) * wg[12] + bfhi(l1.z) * wg[13] + bflo(l1.w) * wg[14] + bfhi(l1.w) * wg[15];
                const float ls = fminf(x, 0.f) - __logf(1.f + __expf(-fabsf(x)));
                run += (c > 0 || i >= 48) ? ls * (1.f / 16.f) : 0.f; cl[t] = run; }
            seg[sg * 128 + ch] = run;
            __syncthreads();
            float off = 0.f;
#pragma unroll
            for (int s2 = 0; s2 < 3; ++s2) off += s2 < sg ? seg[s2 * 128 + ch] : 0.f;
            if (sg == 3) ((float*)(a.ws + WS_GD))[(size_t)(blk0 + (ch >> 5)) * 32 + (ch & 31)] = __expf(off + run);
#pragma unroll
            for (int t = 0; t < 16; ++t) { const int i = 16 * sg + t; const float cum = cl[t] + off;
                S[i * SST + ch] = (bf16)f2bf(bf2f(S[i * SST + ch]) * 0.17677669529663687f * __expf(cum)); S[i * SST + 128 + ch] = (bf16)f2bf(bf2f(S[i * SST + 128 + ch]) * __expf(-cum)); } }
        __syncthreads();
        for (int idx = tid; idx < 1024; idx += 512) { const int d8 = idx & 3, i = (idx >> 2) & 63, h = idx >> 8;
            *(v4u*)(a.ws + B_GQ + (size_t)(blk0 + h) * GQ_T + i * 80 + 16 * d8) = *(const LAS v4u*)(S + i * SST + h * 32 + 8 * d8);
            *(v4u*)(a.ws + B_GK + (size_t)(blk0 + h) * GQ_T + i * 80 + 16 * d8) = *(const LAS v4u*)(S + i * SST + 128 + h * 32 + 8 * d8); }
    } else if (part == 1) {
        constexpr int SST = 776;
        stage_cols(proj, b, c, C_RQ, 256, S, SST, 0, tid); stage_cols(proj, b, c, C_RK, 256, S, SST, 256, tid);
        LAS f32x4* tabL = (LAS f32x4*)(lds + 64 * SST * 2);
        for (int idx = tid; idx < 64 * 16; idx += 512) tabL[idx] = ((const f32x4*)(a.ws + WS_TABR))[(size_t)(64 * c) * 16 + idx];
        __syncthreads();
        const LAS f32x2* tabR = (const LAS f32x2*)tabL;
        for (int idx = tid; idx < 64 * 4 * 32; idx += 512) { const int j = idx & 31, h = (idx >> 5) & 3, i = idx >> 7; const f32x2 cs = tabR[i * 32 + j];
            LAS bf16* qp = S + i * SST + h * 64 + j; LAS bf16* kp = qp + 256;
            const float a1 = bf2f(qp[0]), a2 = bf2f(qp[32]), b1 = bf2f(kp[0]), b2 = bf2f(kp[32]);
            const float e = (float)(i + 1) * lg2gamma(h); const float fq = __builtin_amdgcn_exp2f(e), fk = 0.125f * __builtin_amdgcn_exp2f(-e);
            qp[0] = (bf16)f2bf((a1 * cs[0] - a2 * cs[1]) * fq); qp[32] = (bf16)f2bf((a1 * cs[1] + a2 * cs[0]) * fq); kp[0] = (bf16)f2bf((b1 * cs[0] - b2 * cs[1]) * fk); kp[32] = (bf16)f2bf((b1 * cs[1] + b2 * cs[0]) * fk); }
        __syncthreads();
        for (int idx = tid; idx < 2048; idx += 512) { const int d8 = idx & 7, i = (idx >> 3) & 63, h = idx >> 9;
            *(v4u*)(a.ws + B_RQ + (size_t)(blk0 + h) * RT_T + i * 144 + 16 * d8) = *(const LAS v4u*)(S + i * SST + h * 64 + 8 * d8);
            *(v4u*)(a.ws + B_RK + (size_t)(blk0 + h) * RT_T + i * 144 + 16 * d8) = *(const LAS v4u*)(S + i * SST + 256 + h * 64 + 8 * d8); }
    } else if (part == 2) {
        constexpr int SST = 296, OFF_RSD = 64 * SST * 2, OFF_TAB = OFF_RSD + 512, OFF_QS = OFF_TAB + 8192, QSS = 392;
        LAS float* rsd = (LAS float*)(lds + OFF_RSD); LAS f32x4* tabL = (LAS f32x4*)(lds + OFF_TAB); LAS bf16* Qs = (LAS bf16*)(lds + OFF_QS);
        stage_cols(proj, b, c, C_CQ, 192, S, SST, 0, tid); stage_cols(proj, b, c, C_CKV, 64, S, SST, 192, tid); stage_cols(proj, b, c, C_KPE, 32, S, SST, 256, tid);
        for (int idx = tid; idx < 64 * 8; idx += 512) tabL[idx] = ((const f32x4*)(a.ws + WS_TABM))[(size_t)(64 * c) * 8 + idx];
        __syncthreads();
        { const int i = tid >> 3, g = tid & 7; float sq = 0.f, sk = 0.f;
#pragma unroll
            for (int t = 0; t < 24; ++t) { const float v = bf2f(S[i * SST + g * 24 + t]); sq += v * v; }
#pragma unroll
            for (int t = 0; t < 8; ++t) { const float v = bf2f(S[i * SST + 192 + g * 8 + t]); sk += v * v; }
            sq += __shfl_xor(sq, 1); sq += __shfl_xor(sq, 2); sq += __shfl_xor(sq, 4); sk += __shfl_xor(sk, 1); sk += __shfl_xor(sk, 2); sk += __shfl_xor(sk, 4);
            if (g == 0) { rsd[i * 2] = __builtin_amdgcn_rsqf(sq * (1.f / 192.f) + EPS); rsd[i * 2 + 1] = __builtin_amdgcn_rsqf(sk * (1.f / 64.f) + EPS); } }
        __syncthreads();
        const LAS f32x2* tabM = (const LAS f32x2*)tabL; const float QS = 0.10206207261596577f * LOG2E;
        {
            const int lane = tid & 63, w = __builtin_amdgcn_readfirstlane(tid >> 6), r32 = lane & 31, hi = lane >> 5, ib = w & 1, nb0 = (w >> 1) * 3;
            const bf16* WqaT = (const bf16*)(a.ws + WS_WQA + li * WQA_BYTES);
            s16x8 af[12];
#pragma unroll
            for (int ks = 0; ks < 12; ++ks) af[ks] = *(const LAS s16x8*)(S + (32 * ib + r32) * SST + 16 * ks + 8 * hi);
            f32x16 acc[3];
#pragma unroll
            for (int j = 0; j < 3; ++j) { acc[j] = (f32x16){};
                s16x8 bfr[12];
#pragma unroll
                for (int ks = 0; ks < 12; ++ks) bfr[ks] = *(const s16x8*)(WqaT + (size_t)(32 * (nb0 + j) + r32) * 192 + 16 * ks + 8 * hi);
#pragma unroll
                for (int ks = 0; ks < 12; ++ks) acc[j] = __builtin_amdgcn_mfma_f32_32x32x16_bf16(af[ks], bfr[ks], acc[j], 0, 0, 0); }
            asm volatile("s_nop 15\n\ts_nop 7" : "+v"(acc[0]), "+v"(acc[1]), "+v"(acc[2]));
#pragma unroll
            for (int j = 0; j < 3; ++j)
#pragma unroll
                for (int r = 0; r < 16; ++r) { const int i = 32 * ib + crow(r, hi); float v = acc[j][r] * (rsd[i * 2] * QS);
                    if (j == 2) { const float o = __shfl_xor(v, 16); const f32x2 cs = tabM[i * 16 + (r32 & 15)]; v = r32 < 16 ? v * cs[0] - o * cs[1] : o * cs[1] + v * cs[0]; }
                    Qs[i * QSS + 32 * (nb0 + j) + r32] = (bf16)f2bf(v); } }
        for (int idx = tid; idx < 64 * 12; idx += 512) { const int k8 = idx % 12, i = idx / 12; float y[8];
            if (k8 < 8) { const float s = rsd[i * 2 + 1];
#pragma unroll
                for (int t = 0; t < 8; ++t) y[t] = bf2f(S[i * SST + 192 + 8 * k8 + t]) * s; }
            else { const int kk = (k8 - 8) & 1, second = (k8 - 8) >> 1;
#pragma unroll
                for (int t = 0; t < 8; ++t) { const int j = 8 * kk + t; const f32x2 cs = tabM[i * 16 + j]; const float x1 = bf2f(S[i * SST + 256 + j]), x2 = bf2f(S[i * SST + 272 + j]); y[t] = second ? x1 * cs[1] + x2 * cs[0] : x1 * cs[0] - x2 * cs[1]; } }
            v4u w; w.x = pk2(y[0], y[1]); w.y = pk2(y[2], y[3]); w.z = pk2(y[4], y[5]); w.w = pk2(y[6], y[7]);
            *(v4u*)((bf16*)(a.ws + B_MK) + (prow0 + i) * 96 + 8 * k8) = w; }
        __syncthreads();
        for (int idx = tid; idx < 64 * 48; idx += 512) { const int c8 = idx % 48, i = idx / 48;
            *(v4u*)((bf16*)(a.ws + B_MQ) + (prow0 + i) * 384 + 8 * c8) = *(const LAS v4u*)(Qs + i * QSS + 8 * c8); }
    }
}

template <int KIND>
__device__ __forceinline__ void attn_mfma_unit(const Args& a, int li, int b, int hh, int qb  , LAS unsigned char* lds, int tid, float lam, float oscale) {
    constexpr int KW = KIND ? 64 : 96, KST = KW + 8, VST = 72, NMAP = KIND ? 2 : 1, DSTEPS = KIND ? 2 : 6;
    constexpr int KCH = KW / 8 + 1, NPIECE = KCH + (KIND ? 9 : 0), PPW = KIND ? 3 : 2, SLOT = NPIECE * 1024, NSLOT = 4, OFF_JUNK = NSLOT * SLOT, OFF_WS = OFF_JUNK + 6144, OSTW = 68, OFF_OST = KIND ? 0   : OFF_WS + 2048;
    static_assert(PPW * 8 >= NPIECE && PPW * 8 - NPIECE <= 6 && (KIND ? 8 * 32 * OSTW * 4 <= NSLOT * SLOT : OFF_OST + 8 * 32 * OSTW * 4 <= RING_BYTES) && OFF_WS + 8 * 256 <= RING_BYTES, "attention LDS map / pieces per wave");
    const int lane = tid & 63, w = __builtin_amdgcn_readfirstlane(tid >> 6), r32 = lane & 31, hi = lane >> 5;
    const int q0 = qb < 0 ? 0 : 64 + 256 * qb, NT = qb < 0 ? 1 : 5 + 4 * qb;
    const bool wact = qb >= 0 || w < 2;
    const int qpos = q0 + 32 * w + r32, wlast = (q0 + 32 * w + 31) >> 6;
    const size_t prow = (size_t)b * PSEQ + qpos;
    const bf16* proj = (const bf16*)(a.ws + B_PROJ);
    const bf16* Kg = KIND ? proj + C_DK + hh * 64 : (const bf16*)(a.ws + B_MK) + (size_t)b * PSEQ * 96;
    constexpr int KLD = KIND ? N1 : 96;
    const bf16* Vg = proj + C_DV + hh * 64;
#define ATT_SRCROW(t_, r_) (KIND ? ((t_) == 0 ? ((r_) < 48 ? MR : MR + (r_) - 48) : b * TT + 64 * ((t_) - 1) + (r_)) : 64 * (t_) + (r_))
    LAS float* wsf = (LAS float*)(lds + OFF_WS) + w * 64;
    LAS float* ost = (LAS float*)(lds + OFF_OST) + w * (32 * OSTW);
    s16x8 qf[NMAP][DSTEPS];
#pragma unroll
    for (int m = 0; m < NMAP; ++m)
#pragma unroll
        for (int ds = 0; ds < DSTEPS; ++ds) {
            const int qsr = qb >= 0 ? b * TT + qpos - 64 : (qpos >= 48 ? MR + qpos - 48 : MR);
            const bf16* qp = KIND ? proj + (size_t)qsr * N1 + C_DQ + hh * 64 + 32 * m + 16 * ds + 8 * hi : (const bf16*)(a.ws + B_MQ) + prow * 384 + hh * 96 + 16 * ds + 8 * hi;
            v4u qw = wact ? *(const v4u*)qp : (v4u){0u, 0u, 0u, 0u};
            if (KIND) { const float qs = 0.17677669529663687f * LOG2E;
                qw.x = pg8::cvt_pk_bf16(bflo(qw.x) * qs, bfhi(qw.x) * qs); qw.y = pg8::cvt_pk_bf16(bflo(qw.y) * qs, bfhi(qw.y) * qs); qw.z = pg8::cvt_pk_bf16(bflo(qw.z) * qs, bfhi(qw.z) * qs); qw.w = pg8::cvt_pk_bf16(bflo(qw.w) * qs, bfhi(qw.w) * qs); }
            qf[m][ds] = __builtin_bit_cast(s16x8, qw); }
    float mref[NMAP], lrun[NMAP]; f32x16 negm = (f32x16){}, o[NMAP][2];
#pragma unroll
    for (int m = 0; m < NMAP; ++m) { mref[m] = 0.f; lrun[m] = 0.f; o[m][0] = (f32x16){}; o[m][1] = (f32x16){}; }
#define ATT_DMA(t_) do { const int sl_ = ((t_) & 3) * SLOT; _Pragma("unroll") for (int j = 0; j < PPW; ++j) { const int p_ = __builtin_amdgcn_readfirstlane(w * PPW + j); \
        int row_, col_, dst_; const bf16* base_; int ld_; \
        if (p_ < KCH) { const int g = 64 * p_ + lane, cc = g % KCH; row_ = g / KCH; col_ = (cc < KCH - 1 ? cc : KCH - 2) * 8; dst_ = sl_ + p_ * 1024; base_ = Kg; ld_ = KLD; } \
        else if (p_ < NPIECE) { const int g = 64 * (p_ - KCH) + lane, cc = g % 9; row_ = g / 9; col_ = (cc < 8 ? cc : 7) * 8; dst_ = sl_ + p_ * 1024; base_ = Vg; ld_ = N1; } \
        else { row_ = lane & 15; col_ = 0; dst_ = OFF_JUNK + (p_ - NPIECE) * 1024; base_ = Kg; ld_ = KLD; } \
        const bf16* s_ = base_ + (size_t)ATT_SRCROW((t_), row_) * ld_ + col_; \
        __builtin_amdgcn_global_load_lds((const unsigned*)s_, (LAS unsigned*)(lds + __builtin_amdgcn_readfirstlane(dst_)), 16, 0, 0); } } while (0)
#define ATT_BAR() do { asm volatile("s_waitcnt lgkmcnt(0)" ::: "memory"); __builtin_amdgcn_s_barrier(); asm volatile("" ::: "memory"); } while (0)
    ATT_BAR();
    if (w >= 4) __builtin_amdgcn_s_setprio(1);
    ATT_DMA(0); if (NT > 1) ATT_DMA(1); if (NT > 2) ATT_DMA(2);
    for (int t = 0; t < NT; ++t) {
        if (t + 2 < NT) { if (KIND) asm volatile("s_waitcnt vmcnt(6)" ::: "memory"); else asm volatile("s_waitcnt vmcnt(4)" ::: "memory"); } else if (t + 1 < NT) { if (KIND) asm volatile("s_waitcnt vmcnt(3)" ::: "memory"); else asm volatile("s_waitcnt vmcnt(2)" ::: "memory"); } else asm volatile("s_waitcnt vmcnt(0)" ::: "memory");
        ATT_BAR();
        if (t + 3 < NT) ATT_DMA(t + 3);
        if (wact && t <= wlast) {
            const LAS unsigned char* Kb = lds + (t & 3) * SLOT; const LAS unsigned char* Vb = KIND ? Kb + KCH * 1024 : Kb;
            const bool need_mask = (t == 0) || (64 * t + 63 > q0 + 32 * w);
            constexpr int VRB = KIND ? 144 : KST * 2;
            const LAS unsigned char* vp0 = Vb + (4 * hi + ((lane & 15) >> 2)) * VRB + (16 * ((lane >> 4) & 1)) * 2 + 8 * (lane & 3);
#define ATT_VFRAG(d0_, ks_) ({ const LAS unsigned char* vp_ = vp0 + 16 * (ks_) * VRB + 64 * (d0_); \
        const s16x4 va_ = __builtin_bit_cast(s16x4, __builtin_amdgcn_ds_read_tr16_b64_v4i16((LAS v4i16_t*)vp_)), vb_ = __builtin_bit_cast(s16x4, __builtin_amdgcn_ds_read_tr16_b64_v4i16((LAS v4i16_t*)(vp_ + 8 * VRB))); \
        (s16x8){va_[0], va_[1], va_[2], va_[3], vb_[0], vb_[1], vb_[2], vb_[3]}; })
            s16x8 vfr0[4];
#pragma unroll
            for (int ks = 0; ks < 4; ++ks) vfr0[ks] = ATT_VFRAG(0, ks);
            __builtin_amdgcn_sched_barrier(0);
#pragma unroll
            for (int m = 0; m < NMAP; ++m) {
                f32x16 p0, p1;
                if (KIND) { const float nm = -mref[m];
#pragma unroll
                    for (int r = 0; r < 16; ++r) { p0[r] = nm; p1[r] = nm; } }
                else { p0 = negm; p1 = negm; }
                constexpr int KBATCH = KIND ? DSTEPS : 3;
#pragma unroll
                for (int d1 = 0; d1 < DSTEPS; d1 += KBATCH) {
                    s16x8 kfr[KBATCH][2];
#pragma unroll
                    for (int ds = 0; ds < KBATCH; ++ds) { kfr[ds][0] = *(const LAS s16x8*)(Kb + (r32 * KST + 32 * m * KIND + 16 * (d1 + ds) + 8 * hi) * 2); kfr[ds][1] = *(const LAS s16x8*)(Kb + ((32 + r32) * KST + 32 * m * KIND + 16 * (d1 + ds) + 8 * hi) * 2); }
                    __builtin_amdgcn_sched_barrier(0);

#pragma unroll
                    for (int ds = 0; ds < KBATCH; ++ds) { p0 = __builtin_amdgcn_mfma_f32_32x32x16_bf16(kfr[ds][0], qf[m][d1 + ds], p0, 0, 0, 0); p1 = __builtin_amdgcn_mfma_f32_32x32x16_bf16(kfr[ds][1], qf[m][d1 + ds], p1, 0, 0, 0); }

                    __builtin_amdgcn_sched_barrier(0); }
                asm volatile("s_nop 15\n\ts_nop 7" : "+v"(p0), "+v"(p1));

                if (need_mask) {
#pragma unroll
                    for (int r = 0; r < 16; ++r) { const int kv = 64 * t + crow(r, hi);
                        if (kv > qpos || kv < 48) p0[r] = -1e30f;
                        if (kv + 32 > qpos || kv + 32 < 48) p1[r] = -1e30f; } }
                float mx = fmaxf(fmaxf(p0[0], p1[0]), fmaxf(p0[1], p1[1]));
#pragma unroll
                for (int r = 2; r < 16; r += 2) mx = fmaxf(mx, fmaxf(fmaxf(p0[r], p1[r]), fmaxf(p0[r + 1], p1[r + 1])));
                { auto rr = __builtin_amdgcn_permlane32_swap(__float_as_uint(mx), __float_as_uint(mx), false, false); mx = fmaxf(__uint_as_float(rr[0]), __uint_as_float(rr[1])); }
                if (t == 0 || __any(mx > 6.0f)) {
                    const float delta = t == 0 ? mx : fmaxf(mx, 0.f); mref[m] += delta;
#pragma unroll
                    for (int r = 0; r < 16; ++r) { p0[r] -= delta; p1[r] -= delta; if (!KIND) negm[r] = -mref[m]; }
                    if (t != 0) { const float alpha = __builtin_amdgcn_exp2f(-delta); lrun[m] *= alpha;
                        if (hi == 0) wsf[r32] = alpha;
                        f32x4 al[4];
#pragma unroll
                        for (int g = 0; g < 4; ++g) al[g] = *(const LAS f32x4*)(wsf + 8 * g + 4 * hi);
#pragma unroll
                        for (int r = 0; r < 16; ++r) { o[m][0][r] *= al[r >> 2][r & 3]; o[m][1][r] *= al[r >> 2][r & 3]; } } }
                float ls = 0.f;
#pragma unroll
                for (int r = 0; r < 16; ++r) { p0[r] = __builtin_amdgcn_exp2f(p0[r]); p1[r] = __builtin_amdgcn_exp2f(p1[r]); ls += p0[r] + p1[r]; }
                lrun[m] += ls;
                s16x8 pw[4];
#pragma unroll
                for (int ks = 0; ks < 4; ++ks) { v4u u;
                    if (ks < 2) { u.x = pg8::cvt_pk_bf16(p0[8 * ks], p0[8 * ks + 1]); u.y = pg8::cvt_pk_bf16(p0[8 * ks + 2], p0[8 * ks + 3]); u.z = pg8::cvt_pk_bf16(p0[8 * ks + 4], p0[8 * ks + 5]); u.w = pg8::cvt_pk_bf16(p0[8 * ks + 6], p0[8 * ks + 7]); }
                    else { const int k2 = ks - 2; u.x = pg8::cvt_pk_bf16(p1[8 * k2], p1[8 * k2 + 1]); u.y = pg8::cvt_pk_bf16(p1[8 * k2 + 2], p1[8 * k2 + 3]); u.z = pg8::cvt_pk_bf16(p1[8 * k2 + 4], p1[8 * k2 + 5]); u.w = pg8::cvt_pk_bf16(p1[8 * k2 + 6], p1[8 * k2 + 7]); }
                    pw[ks] = __builtin_bit_cast(s16x8, u); }

#pragma unroll
                for (int ks = 0; ks < 4; ++ks) o[m][0] = __builtin_amdgcn_mfma_f32_32x32x16_bf16(pw[ks], vfr0[ks], o[m][0], 0, 0, 0);

                { s16x8 vfr1[4];
#pragma unroll
                    for (int ks = 0; ks < 4; ++ks) vfr1[ks] = ATT_VFRAG(1, ks);
                    __builtin_amdgcn_sched_barrier(0);

#pragma unroll
                    for (int ks = 0; ks < 4; ++ks) o[m][1] = __builtin_amdgcn_mfma_f32_32x32x16_bf16(pw[ks], vfr1[ks], o[m][1], 0, 0, 0); }

            }
        }
    }
#undef ATT_DMA
#undef ATT_VFRAG
#undef ATT_SRCROW
    __builtin_amdgcn_s_setprio(0);
    ATT_BAR();
    if (KIND) { const LAS float* lp = (const LAS float*)(lds + RING_BYTES + 256); lam = lp[0]; oscale = lp[1]; }
    if (wact) {
#pragma unroll
        for (int m = 0; m < NMAP; ++m) asm volatile("s_nop 15\n\ts_nop 7" : "+v"(o[m][0]), "+v"(o[m][1]));
        float il0, il1 = 0.f;
        { float l = lrun[0]; l += __shfl_xor(l, 32); il0 = l > 0.f ? 1.f / l : 0.f; }
        if (KIND) { float l = lrun[NMAP - 1]; l += __shfl_xor(l, 32); il1 = l > 0.f ? lam / l : 0.f; }
        if (hi == 0) { wsf[r32] = il0; wsf[32 + r32] = il1; }
        f32x4 a0[4], a1[4];
#pragma unroll
        for (int g = 0; g < 4; ++g) { a0[g] = *(const LAS f32x4*)(wsf + 8 * g + 4 * hi); a1[g] = *(const LAS f32x4*)(wsf + 32 + 8 * g + 4 * hi); }
#pragma unroll
        for (int d0 = 0; d0 < 2; ++d0)
#pragma unroll
            for (int r = 0; r < 16; ++r) { float v = o[0][d0][r] * a0[r >> 2][r & 3]; if (KIND) v -= o[NMAP - 1][d0][r] * a1[r >> 2][r & 3];
                ost[crow(r, hi) * OSTW + 32 * d0 + r32] = v; }
        const int row = lane >> 1, half = lane & 1, p = q0 + 32 * w + row;
        f32x4 v[8]; float ss = 0.f;
#pragma unroll
        for (int i = 0; i < 8; ++i) { v[i] = *(const LAS f32x4*)(ost + row * OSTW + 32 * half + 4 * i); ss += (v[i][0] * v[i][0] + v[i][1] * v[i][1]) + (v[i][2] * v[i][2] + v[i][3] * v[i][3]); }
        ss += __shfl_xor(ss, 1);
        const float rs = KIND ? __builtin_amdgcn_rsqf(ss * (1.f / 64.f) + EPS) * oscale : 1.f;
        const int sr = qb >= 0 ? b * TT + p - 64 : ((p >= 48 && b == 0) ? MR + p - 48 : -1);
        if (sr >= 0) { bf16* dst = (bf16*)a.out + (size_t)sr * DM + (KIND ? 768 : 512) + hh * 64 + 32 * half; const float* gn = ain(a, I_DNORM) + li * 64 + 32 * half;
#pragma unroll
            for (int i = 0; i < 4; ++i) { f32x4 x0 = v[2 * i] * rs, x1 = v[2 * i + 1] * rs;
                if (KIND) { const f32x4 g0 = *(const f32x4*)(gn + 8 * i), g1 = *(const f32x4*)(gn + 8 * i + 4); x0 = x0 * g0; x1 = x1 * g1; }
                *(v4u*)(dst + 8 * i) = pack8(x0, x1); } }
    }
    ATT_BAR();
#undef ATT_BAR
}

__device__ __forceinline__ s16x8 ldperm(const bf16* p, int hi) { const s16x4 x = *(const s16x4*)(p + 4 * hi), y = *(const s16x4*)(p + 8 + 4 * hi); return (s16x8){x[0], x[1], x[2], x[3], y[0], y[1], y[2], y[3]}; }
__device__ __forceinline__ s16x8 packacc(const f32x16& v, int k) { v4u u; u.x = pg8::cvt_pk_bf16(v[8 * k], v[8 * k + 1]); u.y = pg8::cvt_pk_bf16(v[8 * k + 2], v[8 * k + 3]); u.z = pg8::cvt_pk_bf16(v[8 * k + 4], v[8 * k + 5]); u.w = pg8::cvt_pk_bf16(v[8 * k + 6], v[8 * k + 7]); return __builtin_bit_cast(s16x8, u); }
__device__ __forceinline__ s16x8 ldperm_lds(const LAS unsigned char* p, int hi) { const s16x4 x = *(const LAS s16x4*)(p + 8 * hi), y = *(const LAS s16x4*)(p + 16 + 8 * hi); return (s16x8){x[0], x[1], x[2], x[3], y[0], y[1], y[2], y[3]}; }
template <int KIND>
__device__ __forceinline__ void lin_mfma_unit(const Args& a, int li, int b, int hp, LAS unsigned char* lds, int tid) {
    constexpr int DK = KIND ? 64 : 32, NDS = DK / 16, NDB = DK / 32, OTW = 68;
    constexpr int QROW = KIND ? 144 : 80, QT = KIND ? RT_T : GQ_T, HB = 2 * QT + VT_T, PPH = HB / 1024, NP = 2 * PPH;
    constexpr int OFF_OT = 2 * HB, OFF_G = OFF_OT + 2 * 64 * OTW * 4;
    static_assert(HB % 1024 == 0 && OFF_G + 256 <= RING_BYTES, "lin unit LDS map");
    const int lane = tid & 63, w = __builtin_amdgcn_readfirstlane(tid >> 6), r32 = lane & 31, hi = lane >> 5, hl = w >> 2, e0 = 32 * ((w >> 1) & 1), ib = w & 1, h = 2 * hp + hl;
    const unsigned char* Qg = a.ws + (KIND ? B_RQ : B_GQ); const unsigned char* Kg = a.ws + (KIND ? B_RK : B_GK);
    const bf16* proj = (const bf16*)(a.ws + B_PROJ); bf16* ob = (bf16*)a.out;
    LAS float* Ot = (LAS float*)(lds + OFF_OT);
    LAS float* Gs = (LAS float*)(lds + OFF_G);
    const LAS unsigned char* Lh = lds + hl * HB;
    const float dret = __builtin_amdgcn_exp2f(64.f * lg2gamma(h));
    f32x16 S[NDB];
#pragma unroll
    for (int db = 0; db < NDB; ++db) S[db] = (f32x16){};
#define LIN_DMA(c_) do { _Pragma("unroll") for (int j_ = 0; j_ < (NP + 7) / 8; ++j_) { const int p_ = w + 8 * j_; if (p_ < NP) { const int hl_ = p_ / PPH, pp_ = p_ % PPH; const size_t blk_ = (size_t)(b * NCH + (c_)) * 4 + 2 * hp + hl_; \
        const unsigned char* src_; \
        if (pp_ < 2 * QT / 1024) src_ = (pp_ < QT / 1024 ? Qg + blk_ * QT + pp_ * 1024 : Kg + blk_ * QT + (pp_ - QT / 1024) * 1024) + lane * 16; \
        else { const int g_ = 64 * (pp_ - 2 * QT / 1024) + lane, s_ = g_ / 9, cc_ = g_ % 9; int sr_ = src_row(b, (c_), s_); sr_ = sr_ < 0 ? MR : sr_;     \
            src_ = (const unsigned char*)(proj + (size_t)sr_ * N1 + (KIND ? C_RV : C_AV) + (2 * hp + hl_) * 64 + (cc_ < 8 ? cc_ : 7) * 8); } \
        __builtin_amdgcn_global_load_lds((const unsigned*)src_, (LAS unsigned*)(lds + hl_ * HB + pp_ * 1024), 16, 0, 0); } } } while (0)
#define LIN_BAR() do { asm volatile("s_waitcnt lgkmcnt(0)" ::: "memory"); __builtin_amdgcn_s_barrier(); asm volatile("" ::: "memory"); } while (0)
    LIN_BAR();
    if (tid < 64) Gs[tid] = ain(a, KIND ? I_RNORM : I_GNORM)[li * 64 + tid];
    LIN_DMA(0);
    const int nh = tid >> 8, nrow = (tid >> 2) & 63, nq = tid & 3, hn = 2 * hp + nh;
    for (int c = 0; c < NCH; ++c) {
        asm volatile("s_waitcnt vmcnt(0)" ::: "memory"); LIN_BAR();
        s16x8 qf[NDS], kf0[NDS], kf1[NDS], vf[4], ktf[NDB][4];
        const int sr = src_row(b, c, nrow); const bool wr = sr >= 0 && (c > 0 || b == 0);
#pragma unroll
        for (int ds = 0; ds < NDS; ++ds) { qf[ds] = ldperm_lds(Lh + (32 * ib + r32) * QROW + 32 * ds, hi); kf0[ds] = ldperm_lds(Lh + QT + r32 * QROW + 32 * ds, hi); kf1[ds] = ldperm_lds(Lh + QT + (32 + r32) * QROW + 32 * ds, hi); }
        const int trq = (lane & 15) >> 2, trb = (lane >> 4) & 1, trp = lane & 3;
#pragma unroll
        for (int ks = 0; ks < 4; ++ks) { const LAS unsigned char* vp = Lh + 2 * QT + (16 * ks + 4 * hi + trq) * 144 + (e0 + 16 * trb) * 2 + 8 * trp;
            const s16x4 va = __builtin_bit_cast(s16x4, __builtin_amdgcn_ds_read_tr16_b64_v4i16((LAS v4i16_t*)vp)), vb = __builtin_bit_cast(s16x4, __builtin_amdgcn_ds_read_tr16_b64_v4i16((LAS v4i16_t*)(vp + 8 * 144)));
            vf[ks] = (s16x8){va[0], va[1], va[2], va[3], vb[0], vb[1], vb[2], vb[3]}; }
        f32x16 aA = (f32x16){}, aB = (f32x16){};
#pragma unroll
        for (int ds = 0; ds < NDS; ++ds) { aA = __builtin_amdgcn_mfma_f32_32x32x16_bf16(kf0[ds], qf[ds], aA, 0, 0, 0); if (ib) aB = __builtin_amdgcn_mfma_f32_32x32x16_bf16(kf1[ds], qf[ds], aB, 0, 0, 0); }
        asm volatile("s_nop 15\n\ts_nop 15" : "+v"(aA), "+v"(aB));
#pragma unroll
        for (int r = 0; r < 16; ++r) if (crow(r, hi) > r32) { if (ib) aB[r] = 0.f; else aA[r] = 0.f; }
        f32x16 O = (f32x16){};
#pragma unroll
        for (int db = 0; db < NDB; ++db)
#pragma unroll
            for (int ksub = 0; ksub < 2; ++ksub) O = __builtin_amdgcn_mfma_f32_32x32x16_bf16(qf[2 * db + ksub], packacc(S[db], ksub), O, 0, 0, 0);
#pragma unroll
        for (int ksub = 0; ksub < 2; ++ksub) { O = __builtin_amdgcn_mfma_f32_32x32x16_bf16(packacc(aA, ksub), vf[ksub], O, 0, 0, 0); if (ib) O = __builtin_amdgcn_mfma_f32_32x32x16_bf16(packacc(aB, ksub), vf[2 + ksub], O, 0, 0, 0); }
#pragma unroll
        for (int db = 0; db < NDB; ++db)
#pragma unroll
            for (int ks = 0; ks < 4; ++ks) { const LAS unsigned char* kp = Lh + QT + (16 * ks + 4 * hi + trq) * QROW + (32 * db + 16 * trb) * 2 + 8 * trp;
                const s16x4 ka = __builtin_bit_cast(s16x4, __builtin_amdgcn_ds_read_tr16_b64_v4i16((LAS v4i16_t*)kp)), kb = __builtin_bit_cast(s16x4, __builtin_amdgcn_ds_read_tr16_b64_v4i16((LAS v4i16_t*)(kp + 8 * QROW)));
                ktf[db][ks] = (s16x8){ka[0], ka[1], ka[2], ka[3], kb[0], kb[1], kb[2], kb[3]}; }
        LIN_BAR();
        v4u og[2];
#pragma unroll
        for (int i = 0; i < 2; ++i) og[i] = wr ? *(const v4u*)(proj + (size_t)sr * N1 + (KIND ? C_ROG : C_AOG) + hn * 64 + 16 * nq + 8 * i) : (v4u){0u, 0u, 0u, 0u};
        f32x4 dvv[4];
        if (!KIND) { const float* dp = (const float*)(a.ws + WS_GD) + ((size_t)(b * NCH + c) * 4 + h) * 32;
#pragma unroll
            for (int g = 0; g < 4; ++g) dvv[g] = *(const f32x4*)(dp + 8 * g + 4 * hi); }
        if (c + 1 < NCH) LIN_DMA(c + 1);
#pragma unroll
        for (int db = 0; db < NDB; ++db) {
#pragma unroll
            for (int ks = 0; ks < 4; ++ks) S[db] = __builtin_amdgcn_mfma_f32_32x32x16_bf16(ktf[db][ks], vf[ks], S[db], 0, 0, 0); }
        asm volatile("s_nop 15\n\ts_nop 15" : "+v"(O));
#pragma unroll
        for (int db = 0; db < NDB; ++db) asm volatile("s_nop 15\n\ts_nop 15" : "+v"(S[db]));
#pragma unroll
        for (int db = 0; db < NDB; ++db) {
            if (KIND) { S[db] = S[db] * dret; }
            else {
#pragma unroll
                for (int g = 0; g < 4; ++g) { S[db][4 * g] *= dvv[g][0]; S[db][4 * g + 1] *= dvv[g][1]; S[db][4 * g + 2] *= dvv[g][2]; S[db][4 * g + 3] *= dvv[g][3]; } } }
#pragma unroll
        for (int r = 0; r < 16; ++r) Ot[(hl * 64 + 32 * ib + crow(r, hi)) * OTW + e0 + r32] = O[r];
        LIN_BAR();
        { f32x4 v[4]; float s1 = 0.f;
#pragma unroll
            for (int i = 0; i < 4; ++i) { v[i] = *(const LAS f32x4*)(Ot + (nh * 64 + nrow) * OTW + 16 * nq + 4 * i); s1 += (v[i][0] + v[i][1]) + (v[i][2] + v[i][3]); }
            float mean = 0.f; if (KIND) { s1 += __shfl_xor(s1, 1); s1 += __shfl_xor(s1, 2); mean = s1 * (1.f / 64.f); }
            float s2 = 0.f;
#pragma unroll
            for (int i = 0; i < 4; ++i) { v[i] = v[i] - mean; s2 += (v[i][0] * v[i][0] + v[i][1] * v[i][1]) + (v[i][2] * v[i][2] + v[i][3] * v[i][3]); }
            s2 += __shfl_xor(s2, 1); s2 += __shfl_xor(s2, 2);
            const float rs = __builtin_amdgcn_rsqf(s2 * (1.f / 64.f) + EPS);
            if (wr) { bf16* dst = ob + (size_t)sr * DM + KIND * 256 + hn * 64 + 16 * nq; const LAS float* gp = Gs + 16 * nq;
#pragma unroll
                for (int i = 0; i < 2; ++i) { const v4u g4 = og[i]; const f32x4 g0 = *(const LAS f32x4*)(gp + 8 * i), g1 = *(const LAS f32x4*)(gp + 8 * i + 4);
                    f32x4 x0 = v[2 * i] * rs * g0, x1 = v[2 * i + 1] * rs * g1;
                    x0[0] *= silu_f(bflo(g4.x)); x0[1] *= silu_f(bfhi(g4.x)); x0[2] *= silu_f(bflo(g4.y)); x0[3] *= silu_f(bfhi(g4.y)); x1[0] *= silu_f(bflo(g4.z)); x1[1] *= silu_f(bfhi(g4.z)); x1[2] *= silu_f(bflo(g4.w)); x1[3] *= silu_f(bfhi(g4.w));
                    *(v4u*)(dst + 8 * i) = pack8(x0, x1); } } }
        LIN_BAR();
    }
    asm volatile("s_waitcnt vmcnt(0)" ::: "memory");
#undef LIN_DMA
#undef LIN_BAR
}

template <int MODE, int KSTEPS  >
__device__ __forceinline__ void thin_unit(const bf16* A, int lda, const bf16* Bt, int u, bf16* H, float* stats_out, const float* stats_in, bf16* ACT, LAS unsigned char* lds, int tid) {
    constexpr int K = KSTEPS * 256;
    const int lane = tid & 63, w = __builtin_amdgcn_readfirstlane(tid >> 6), fr = lane & 15, fq = lane >> 4;
    int brow[4];
#pragma unroll
    for (int nb = 0; nb < 4; ++nb) brow[nb] = MODE != 1 ? 64 * u + 16 * nb + fr : 256 * (u >> 2) + 32 * (u & 3) + (nb >> 1) * 128 + 16 * (nb & 1) + fr;
    f32x4 acc[4];
#pragma unroll
    for (int nb = 0; nb < 4; ++nb) acc[nb] = (f32x4){0.f, 0.f, 0.f, 0.f};
    const bf16* ap = A + (size_t)fr * lda + w * (KSTEPS * 32) + 8 * fq;
    constexpr int B1 = KSTEPS > 6 ? 6 : KSTEPS;
    { s16x8 af[B1], bf[B1][4];
#pragma unroll
        for (int s = 0; s < B1; ++s) { af[s] = *(const s16x8*)(ap + 32 * s);
#pragma unroll
            for (int nb = 0; nb < 4; ++nb) bf[s][nb] = *(const s16x8*)(Bt + (size_t)brow[nb] * K + w * (KSTEPS * 32) + 32 * s + 8 * fq); }
#pragma unroll
        for (int s = 0; s < B1; ++s)
#pragma unroll
            for (int nb = 0; nb < 4; ++nb) acc[nb] = __builtin_amdgcn_mfma_f32_16x16x32_bf16(bf[s][nb], af[s], acc[nb], 0, 0, 0); }
    if (KSTEPS > B1) { constexpr int B2 = KSTEPS > B1 ? KSTEPS - B1 : 1; s16x8 af[B2], bf[B2][4];
#pragma unroll
        for (int s = 0; s < B2; ++s) { af[s] = *(const s16x8*)(ap + 32 * (B1 + s));
#pragma unroll
            for (int nb = 0; nb < 4; ++nb) bf[s][nb] = *(const s16x8*)(Bt + (size_t)brow[nb] * K + w * (KSTEPS * 32) + 32 * (B1 + s) + 8 * fq); }
#pragma unroll
        for (int s = 0; s < B2; ++s)
#pragma unroll
            for (int nb = 0; nb < 4; ++nb) acc[nb] = __builtin_amdgcn_mfma_f32_16x16x32_bf16(bf[s][nb], af[s], acc[nb], 0, 0, 0); }
    asm volatile("s_nop 15" : "+v"(acc[0]), "+v"(acc[1]), "+v"(acc[2]), "+v"(acc[3]));
    LAS f32x4* part = (LAS f32x4*)lds;
    __syncthreads();
#pragma unroll
    for (int nb = 0; nb < 4; ++nb) part[(w * 4 + nb) * 64 + lane] = acc[nb];
    __syncthreads();
    if (w == 0) {
#pragma unroll
        for (int nb = 0; nb < 4; ++nb) {
#pragma unroll
            for (int w2 = 1; w2 < 8; ++w2) acc[nb] = acc[nb] + part[(w2 * 4 + nb) * 64 + lane]; }
        const int row = MR + fr;
        if (MODE == 0) { float ss = 0.f;
#pragma unroll
            for (int nb = 0; nb < 4; ++nb) { bf16* p = H + (size_t)row * DM + 64 * u + 16 * nb + 4 * fq; const v2u wv = *(const v2u*)p;
                const float x0 = acc[nb][0] + bflo(wv.x), x1 = acc[nb][1] + bfhi(wv.x), x2 = acc[nb][2] + bflo(wv.y), x3 = acc[nb][3] + bfhi(wv.y);
                ss += (x0 * x0 + x1 * x1) + (x2 * x2 + x3 * x3);
                v2u o; o.x = pg8::cvt_pk_bf16(x0, x1); o.y = pg8::cvt_pk_bf16(x2, x3); *(v2u*)p = o; }
            ss += __shfl_xor(ss, 16); ss += __shfl_xor(ss, 32);
            if (fq == 0) stats_out[(size_t)row * 16 + u] = ss;
        } else if (MODE == 2) { const f32x4* sp = (const f32x4*)(stats_in + (size_t)row * 16); const f32x4 s0 = sp[0], s1 = sp[1], s2 = sp[2], s3 = sp[3];
            const float st = ((s0[0] + s0[1]) + (s0[2] + s0[3])) + ((s1[0] + s1[1]) + (s1[2] + s1[3])) + ((s2[0] + s2[1]) + (s2[2] + s2[3])) + ((s3[0] + s3[1]) + (s3[2] + s3[3]));
            const float rs = __builtin_amdgcn_rsqf(st * (1.f / 1024.f) + EPS);
#pragma unroll
            for (int nb = 0; nb < 4; ++nb) { v2u o; o.x = pg8::cvt_pk_bf16(acc[nb][0] * rs, acc[nb][1] * rs); o.y = pg8::cvt_pk_bf16(acc[nb][2] * rs, acc[nb][3] * rs);
                *(v2u*)(ACT + (size_t)row * N1 + 64 * u + 16 * nb + 4 * fq) = o; }
        } else { const f32x4* sp = (const f32x4*)(stats_in + (size_t)row * 16); const f32x4 s0 = sp[0], s1 = sp[1], s2 = sp[2], s3 = sp[3];
            const float st = ((s0[0] + s0[1]) + (s0[2] + s0[3])) + ((s1[0] + s1[1]) + (s1[2] + s1[3])) + ((s2[0] + s2[1]) + (s2[2] + s2[3])) + ((s3[0] + s3[1]) + (s3[2] + s3[3]));
            const float rs = __builtin_amdgcn_rsqf(st * (1.f / 1024.f) + EPS);
#pragma unroll
            for (int nb = 0; nb < 2; ++nb) { float y[4];
#pragma unroll
                for (int t = 0; t < 4; ++t) y[t] = silu_f(acc[nb][t] * rs) * (acc[2 + nb][t] * rs);
                v2u o; o.x = pg8::cvt_pk_bf16(y[0], y[1]); o.y = pg8::cvt_pk_bf16(y[2], y[3]);
                *(v2u*)(ACT + (size_t)row * DFF + 128 * (u >> 2) + 32 * (u & 3) + 16 * nb + 4 * fq) = o; } }
    }
    __syncthreads();
}

#ifndef REP_PREP
#define REP_PREP 1
#endif
#ifndef REP_MIX
#define REP_MIX 1
#endif
#ifndef REP_P0
#define REP_P0 1
#endif
#ifndef REP_CONV
#define REP_CONV 1
#endif
#ifndef REP_G1
#define REP_G1 1
#endif
#ifndef REP_MGU
#define REP_MGU 1
#endif
#ifndef REP_MDN
#define REP_MDN 1
#endif
#ifndef REP_BAR
#define REP_BAR 0
#endif
#ifndef REP_PART
#define REP_PART -1
#endif
#ifndef REP_FGU
#define REP_FGU 1
#endif
#ifndef MK_ONE_LAUNCH
#define MK_ONE_LAUNCH 1
#endif
constexpr int NPHASE = 18;
constexpr int CW_Q = 12288;
__global__ void __launch_bounds__(512, 2) mega_fwd(Args a) {
    extern __shared__ __attribute__((aligned(16))) unsigned char lds_raw[];
    LAS unsigned char* lds = (LAS unsigned char*)lds_raw;
    volatile LAS unsigned* MISC = (volatile LAS unsigned*)(lds + MISC_OFF);
    int wave = __builtin_amdgcn_readfirstlane((int)threadIdx.x >> 6); asm volatile("" : "+s"(wave));
    const int G = gridDim.x;
#define TID() ((wave << 6) + lane_id())
    for (int u = TID(); u < (LDS_BYTES - RING_BYTES) / 4; u += 512) ((LAS unsigned*)(lds + RING_BYTES))[u] = 0u;
    __syncthreads();
    gu32* ctl = (gu32*)(a.ws + WS_CTL);
    const int lo = a.ph_lo, hi = a.ph_hi;
    XcdBarrier bar; bar.bar = (unsigned*)(ctl + CW_BAR); bar.x = 0; bar.st = nullptr;
    if (hi - lo > 1) bar = xcd_barrier_post((unsigned*)(ctl + CW_BAR), MISC + 8, TID() == 0);
#define IN(k) (lo <= (k) && (k) < hi)
#define OPQ() int ptid = TID(); asm volatile("" : "+v"(ptid)); const int plane = ptid & 63; (void)plane
#define SEAM(k) do { if (IN(k) && IN((k) + 1)) xcd_barrier(bar, TID() == 0); } while (0)
#define hb ((bf16*)(a.ws + WS_HB))
#define stA ((float*)(a.ws + WS_STA))
#define stB ((float*)(a.ws + WS_STB))

    for (int rep = 0; rep < REP_BAR; ++rep) xcd_barrier(bar, TID() == 0);
    if (IN(0)) { OPQ(); for (int rep = 0; rep < REP_P0; ++rep) { p0_prologue(a, lds, ptid, plane, wave); __syncthreads(); } }
    SEAM(0);

    for (int li = 0; li < 2; ++li) {
        const int pb = 1 + 6 * li;
        if (IN(pb)) {
            { OPQ(); for (int u = blockIdx.x; u < N1 / 64; u += G) thin_unit<2, 4>(hb + (size_t)MR * DM, DM, (const bf16*)(a.ws + WS_W1T + li * W1T_BYTES), u, nullptr, nullptr, stA, (bf16*)(a.ws + B_PROJ), lds, ptid); }
            pg8::Gemm g{hb, (const bf16*)(a.ws + WS_W1T + li * W1T_BYTES), DM, 0, nullptr}; pg8::StaticOrder S; S.init(NPAN - 1, N1 / 256, G, (int)blockIdx.x);
            EpiProj E{(bf16*)(a.ws + B_PROJ), stA};
            for (int rep = 0; rep < REP_G1; ++rep) pg8::gemm_phase<EpiProj, pg8::StaticOrder, false>(lds, g, S, E, wave);
        }
        SEAM(pb);
        if (IN(pb + 1)) { OPQ(); for (int rep = 0; rep < REP_PREP; ++rep) for (int u = blockIdx.x; u < NB * NCH * 3; u += G) { const int part = u % 3;     if (rep > 0 && REP_PART >= 0 && part != REP_PART) continue; int ut = ptid; asm volatile("" : "+v"(ut)); prep2_unit(a, li, (u / 3) / NCH, (u / 3) % NCH, part, lds, ut); } __syncthreads(); }
        SEAM(pb + 1);
        if (IN(pb + 2)) {
            OPQ(); const int tid = ptid;
            LAS int* qid = (LAS int*)(lds + RING_BYTES + 64);
            float lam, lam_init; { const float* lv = ain(a, I_DLAM) + li * 128; float s01 = 0.f, s23 = 0.f;
                for (int d = 0; d < 32; ++d) { s01 += lv[d] * lv[32 + d]; s23 += lv[64 + d] * lv[96 + d]; }
                lam_init = 0.8f - 0.6f * __expf(-0.3f * (float)li); lam = __expf(s01) - __expf(s23) + lam_init;
                if (tid == 0) { LAS float* lp = (LAS float*)(lds + RING_BYTES + 256); lp[0] = lam; lp[1] = 1.f - lam_init; } }
            for (int rep = 0; rep < REP_MIX; ++rep)
            for (;;) {
                __syncthreads();
                if (tid == 0) *qid = (int)__hip_atomic_fetch_add(ctl + CW_Q + 64 * (li + 2 * rep), 1u, RLX_AGENT);
                __syncthreads();
                const int id = *qid;
                int utid = ptid; asm volatile("" : "+v"(utid));
                if (id >= 64 + 1024 + 8) break;
                if (id < 64) { if ((id & 1) == 0) lin_mfma_unit<0>(a, li, (id >> 1) & 15, id >> 5, lds, utid); else lin_mfma_unit<1>(a, li, (id >> 1) & 15, id >> 5, lds, utid); }
                else { const int v = id - 64; int qb, kind, b, hh;
                    if (v < 1024) { qb = 7 - (v >> 7); const int rem = v & 127; kind = rem >> 6; b = (rem >> 2) & 15; hh = rem & 3; } else { qb = -1; kind = (v - 1024) >> 2; b = 0; hh = v & 3; }
                    if (kind == 0) attn_mfma_unit<0>(a, li, b, hh, qb, lds, utid, 0.f, 1.f); else attn_mfma_unit<1>(a, li, b, hh, qb, lds, utid, 0.f, 0.f); }
            }
        }
        SEAM(pb + 2);
        if (IN(pb + 3)) {
            if (li == 0) { OPQ(); for (int u = blockIdx.x; u < 16; u += G) thin_unit<0, 4>((const bf16*)a.out + (size_t)MR * DM, DM, (const bf16*)(a.ws + WS_WOT), u, hb, stB, nullptr, nullptr, lds, ptid); }
            pg8::Gemm g{(const bf16*)a.out, (const bf16*)(a.ws + WS_WOT + li * WOT_BYTES), DM, 0, nullptr}; pg8::StaticOrder S; S.init(NPAN - 1, 4, G, (int)blockIdx.x);
            EpiResid E{hb, stB};
            pg8::gemm_phase<EpiResid, pg8::StaticOrder, false>(lds, g, S, E, wave);
        }
        SEAM(pb + 3);
        if (li == 0) {
            if (IN(5)) {
                { OPQ(); for (int u = blockIdx.x; u < 88; u += G) thin_unit<1, 4>(hb + (size_t)MR * DM, DM, (const bf16*)(a.ws + WS_WGU), u, nullptr, nullptr, stB, (bf16*)(a.ws + B_ACT), lds, ptid); }
                pg8::Gemm g{hb, (const bf16*)(a.ws + WS_WGU), DM, 0, nullptr}; pg8::StaticOrder S; S.init(NPAN - 1, 2 * DFF / 256, G, (int)blockIdx.x);
                EpiSwiglu E{(bf16*)(a.ws + B_ACT), DFF, stB};
                for (int rep = 0; rep < REP_FGU; ++rep) pg8::gemm_phase<EpiSwiglu, pg8::StaticOrder, false>(lds, g, S, E, wave);
            }
            SEAM(5);
            if (IN(6)) {
                { OPQ(); for (int u = blockIdx.x; u < 16; u += G) thin_unit<0, 11>((const bf16*)(a.ws + B_ACT) + (size_t)MR * DFF, DFF, (const bf16*)(a.ws + WS_WD), u, hb, stA, nullptr, nullptr, lds, ptid); }
                pg8::Gemm g{(const bf16*)(a.ws + B_ACT), (const bf16*)(a.ws + WS_WD), DFF, 0, nullptr}; pg8::StaticOrder S; S.init(NPAN - 1, 4, G, (int)blockIdx.x);
                EpiResid E{hb, stA};
                pg8::gemm_phase<EpiResid, pg8::StaticOrder, false>(lds, g, S, E, wave);
            }
            SEAM(6);
        }
    }
    if (IN(11)) { OPQ(); const int tid = ptid, lane = plane;
        LAS float* scr = (LAS float*)(lds + wave * 16384);
        const int gw = blockIdx.x * 8 + wave, NGW = G * 8;
        constexpr int IG = 16 * 56, ID = 56 * 16;
        for (int rep = 0; rep < REP_CONV; ++rep)
        for (int it = gw; it < 8 * (2 * IG + ID); it += NGW) { const int e = it / (2 * IG + ID); int r = it % (2 * IG + ID);
            if (r < IG) { transpose_item(ain(a, I_EG) + (size_t)e * DM * DFE, DM, DFE, ain(a, I_FNORM) + DM, (bf16*)(a.ws + B_EGU + e * EGU_BYTES), r / 56, r % 56, 1, scr, lane); continue; } r -= IG;
            if (r < IG) { transpose_item(ain(a, I_EU) + (size_t)e * DM * DFE, DM, DFE, ain(a, I_FNORM) + DM, (bf16*)(a.ws + B_EGU + e * EGU_BYTES), r / 56, r % 56, 2, scr, lane); continue; } r -= IG;
            transpose_item(ain(a, I_ED) + (size_t)e * DFE * DM, DFE, DM, nullptr, (bf16*)(a.ws + B_ED + e * ED_BYTES), r / 16, r % 16, 0, scr, lane); }
        for (int i = blockIdx.x * 512 + tid; i < MAXPAN * 256; i += G * 512) { ((int*)(a.ws + MO_ROWIDX))[i] = -1; ((int*)(a.ws + MO_PDST))[i] = -1; ((f32x2*)(a.ws + MO_PINFO))[i] = (f32x2){0.f, 0.f}; }
        for (int blk = blockIdx.x; blk < MR / 128; blk += G) route_block(a, blk, lds, tid, lane, wave);
    }
    SEAM(11);
    LAS int* offs = (LAS int*)(lds + RING_BYTES + 128);
    if (IN(12)) { OPQ(); const int tid = ptid;
        moe_offsets(a, offs, tid);
        for (int idx = blockIdx.x * 512 + tid; idx < 2 * MR; idx += G * 512) { const int tok = idx >> 1, e = ((const int*)(a.ws + MO_TOKE))[idx], gpos = offs[e] + ((const int*)(a.ws + MO_TOKP))[idx];
            const f32x4* sp = (const f32x4*)(stB + (size_t)tok * 16); const f32x4 s0 = sp[0], s1 = sp[1], s2 = sp[2], s3 = sp[3];
            const float ss = ((s0[0] + s0[1]) + (s0[2] + s0[3])) + ((s1[0] + s1[1]) + (s1[2] + s1[3])) + ((s2[0] + s2[1]) + (s2[2] + s2[3])) + ((s3[0] + s3[1]) + (s3[2] + s3[3]));
            ((int*)(a.ws + MO_ROWIDX))[gpos] = tok; ((int*)(a.ws + MO_PDST))[gpos] = idx;
            ((f32x2*)(a.ws + MO_PINFO))[gpos] = (f32x2){__builtin_amdgcn_rsqf(ss * (1.f / 1024.f) + EPS), __int_as_float(((const int*)(a.ws + MO_TOKW))[idx])}; }
        if (blockIdx.x == 0 && tid < MAXPAN + 8) { int e = 0;
            for (int k = 1; k < 8; ++k) if (tid * 256 >= offs[k]) e = k;
            ((int*)(a.ws + MO_PEXP))[tid] = e; }
    }
    SEAM(12);
    int nT = 0; if (IN(13) || IN(14) || IN(15) || IN(16)) { moe_offsets(a, offs, TID()); nT = __builtin_amdgcn_readfirstlane(offs[8]); }
    const int nA = nT < 128 ? nT : 128, nB = nT < 128 ? 0 : (nT - 128 < 128 ? nT - 128 : 128), nC = nT <= 256 ? 0 : (nT - 256 < 8 ? nT - 256 : 8);
#pragma unroll 1
    for (int job = 0; job < 5; ++job) {
        const int ph = job == 0 ? 13 : job == 1 ? 14 : job <= 3 ? 15 : 16;
        if (IN(ph)) {
            if (job == 0 || job == 3) {
                const int nP = job == 0 ? nA + nC : nB;
                if (nP > 0) { pg8::Gemm g{hb, (const bf16*)(a.ws + B_EGU), DM, EGU_BYTES, (const int*)(a.ws + MO_ROWIDX)}; pg8::MoeOrder S; S.init(nP, 2 * DFE / 256, G, (int)blockIdx.x, job == 0 ? 0 : 128, (const int*)(a.ws + MO_PEXP));
                    if (job == 0) { S.psplit = nA; S.p1 = 256; } else if (nC > 0 && (nB * (2 * DFE / 256)) % G == 0 && 16 * nC <= G) S.H = 4 * nC;
                    EpiSwigluMoe E{(bf16*)(a.ws + B_EACT), (const f32x2*)(a.ws + MO_PINFO)};
                    for (int rep = 0; rep < REP_MGU; ++rep) pg8::gemm_phase<EpiSwigluMoe, pg8::MoeOrder, true>(lds, g, S, E, wave); }
            } else {
                const int nP = job == 1 ? nA : job == 2 ? nC : nB, p0 = job == 1 ? 0 : job == 2 ? 256 : 128;
                if (nP > 0) { pg8::Gemm g{(const bf16*)(a.ws + B_EACT) + (job == 2 ? (size_t)128 * 256 * DFE : (size_t)0), (const bf16*)(a.ws + B_ED), DFE, ED_BYTES, nullptr}; pg8::MoeOrder S; S.init(nP, 4, G, (int)blockIdx.x, p0, (const int*)(a.ws + MO_PEXP));
                    EpiMoeDown E{(unsigned char*)a.out, (const int*)(a.ws + MO_PDST), (const f32x2*)(a.ws + MO_PINFO)};
                    for (int rep = 0; rep < REP_MDN; ++rep) pg8::gemm_phase<EpiMoeDown, pg8::MoeOrder, false>(lds, g, S, E, wave); }
            }
        }
        if (job != 2) SEAM(ph);
    }
    if (IN(17)) { OPQ(); const int lane = plane;
        const float* fn = ain(a, I_FINAL);
        for (int r = blockIdx.x * 8 + wave; r < MR; r += G * 8) {
            unsigned char* orow = (unsigned char*)a.out + (size_t)r * 4096; float v[16]; float ss = 0.f;
#pragma unroll
            for (int hf = 0; hf < 2; ++hf) { const int k = 512 * hf + 8 * lane; const v4u h4 = *(const v4u*)(hb + (size_t)r * DM + k), y0 = *(const v4u*)(orow + 2 * k), y1 = *(const v4u*)(orow + 2048 + 2 * k);
                const unsigned hw[4] = {h4.x, h4.y, h4.z, h4.w}, aw[4] = {y0.x, y0.y, y0.z, y0.w}, bw[4] = {y1.x, y1.y, y1.z, y1.w};
#pragma unroll
                for (int t = 0; t < 4; ++t) { const float x0 = bflo(hw[t]) + bflo(aw[t]) + bflo(bw[t]), x1 = bfhi(hw[t]) + bfhi(aw[t]) + bfhi(bw[t]); v[8 * hf + 2 * t] = x0; v[8 * hf + 2 * t + 1] = x1; ss += x0 * x0 + x1 * x1; } }
            ss = wave_sum(ss); const float rs = __builtin_amdgcn_rsqf(ss * (1.f / 1024.f) + EPS);
#pragma unroll
            for (int hf = 0; hf < 2; ++hf) { const int k = 512 * hf + 8 * lane; const f32x4 g0 = *(const f32x4*)(fn + k), g1 = *(const f32x4*)(fn + k + 4);
                *(f32x4*)(orow + 4 * k) = (f32x4){v[8 * hf] * rs * g0[0], v[8 * hf + 1] * rs * g0[1], v[8 * hf + 2] * rs * g0[2], v[8 * hf + 3] * rs * g0[3]};
                *(f32x4*)(orow + 4 * k + 16) = (f32x4){v[8 * hf + 4] * rs * g1[0], v[8 * hf + 5] * rs * g1[1], v[8 * hf + 6] * rs * g1[2], v[8 * hf + 7] * rs * g1[3]}; }
        }
    }
#undef IN
#undef SEAM
#undef hb
#undef stA
#undef stB
}

extern "C" void kernel_launch(void* const* d_in, const int* in_sizes, int n_in, void* d_out, int out_size, void* d_ws, size_t ws_size, hipStream_t stream) {
    static int grid = 0;
    if (grid == 0) {
        if (n_in != 24 || in_sizes[0] != MR * DM || out_size != MR * DM || ws_size < WS_NEED) { fprintf(stderr, "kernel_launch: unexpected problem (n_in %d, in0 %d, out %d, ws %zu < %zu)\n", n_in, n_in > 0 ? in_sizes[0] : -1, out_size, ws_size, (size_t)WS_NEED); grid = -1; return; }
        int dev = 0, cus = 0, per_cu = 0;
        if (hipGetDevice(&dev) != hipSuccess || hipDeviceGetAttribute(&cus, hipDeviceAttributeMultiprocessorCount, dev) != hipSuccess) { grid = -1; return; }
        if (hipFuncSetAttribute((const void*)mega_fwd, hipFuncAttributeMaxDynamicSharedMemorySize, LDS_BYTES) != hipSuccess) { fprintf(stderr, "kernel_launch: hipFuncSetAttribute failed\n"); grid = -1; return; }
        if (hipOccupancyMaxActiveBlocksPerMultiprocessor(&per_cu, (const void*)mega_fwd, 512, LDS_BYTES) != hipSuccess || per_cu < 1) fprintf(stderr, "kernel_launch: occupancy query reports %d\n", per_cu);
        (void)hipGetLastError();
        grid = cus;
    }
    if (grid < 0) return;
    if (hipMemsetAsync((char*)d_ws + WS_CTL, 0, CTL_BYTES, stream) != hipSuccess) return;
    Args a{};
    for (int i = 0; i < 24; ++i) a.in[i] = (const float*)d_in[i];
    a.out = (float*)d_out; a.ws = (unsigned char*)d_ws;
#if MK_ONE_LAUNCH
    a.ph_lo = 0; a.ph_hi = NPHASE;
    hipLaunchKernelGGL(mega_fwd, dim3(grid), dim3(512), LDS_BYTES, stream, a);
#else
    for (int p = 0; p < NPHASE; ++p) { a.ph_lo = p; a.ph_hi = p + 1; hipLaunchKernelGGL(mega_fwd, dim3(grid), dim3(512), LDS_BYTES, stream, a); }
#endif
}
```

```cpp
#include <hip/hip_runtime.h>
#include <cstdio>
#include <cstdint>

namespace pg8 {
#define PG8_LAS __attribute__((address_space(3)))
typedef unsigned short bf16_t;
typedef short bf16x8 __attribute__((ext_vector_type(8)));
typedef float f32x4 __attribute__((ext_vector_type(4)));
typedef unsigned u32x4 __attribute__((ext_vector_type(4)));
constexpr int BM = 256, BK = 64, HALF = 128, HTB = HALF * BK * 2  , STAGE_BYTES = 8 * HTB, NXCD = 8, WGM = 8;

__host__ __device__ __forceinline__ int lds_byte(int r, int c) { const int st = (r >> 4) * 2 + (c >> 5), rr = r & 15, cc = c & 31, ob = rr * 64 + cc * 2; return st * 1024 + (ob ^ (((ob >> 9) & 1) << 5)); }
__host__ __device__ __forceinline__ void stage_rc(int b, int& R, int& C) { const int st = b / 1024, sb = b % 1024, swz = sb ^ (((sb >> 9) & 1) << 5); R = (st >> 1) * 16 + swz / 64; C = (st & 1) * 32 + (swz % 64) / 2; }
__host__ __device__ __forceinline__ int perm32(int rho) { const int n = rho >> 4, i = rho & 15; return 8 * (i >> 2) + 4 * n + (i & 3); }

struct Unit { int pm, pn, e, gp; };
struct Gemm { const bf16_t* A; const bf16_t* Bt; int K; size_t estride  ; const int* rowidx  ; };

struct StaticOrder {
    int nM, nN, nwg, G, c;
    __device__ void init(int nM_, int nN_, int G_, int c_) { nM = nM_; nN = nN_; nwg = nM * nN; G = G_; c = c_; }
    __device__ __forceinline__ bool map(int i, int& pm, int& pn) const { return mapL((long)i * G + c, pm, pn); }
    __device__ __forceinline__ bool mapL(long L, int& pm, int& pn) const {
        if (L >= nwg) return false;
        int wgid = (int)L; { const int q = nwg / NXCD, r = nwg % NXCD, xcd = wgid % NXCD, off = wgid / NXCD; wgid = (xcd < r ? xcd * (q + 1) : r * (q + 1) + (xcd - r) * q) + off; }
        const int nig = WGM * nN, gid = wgid / nig, fm = gid * WGM, gsz = (nM - fm) < WGM ? (nM - fm) : WGM;
        pm = fm + ((wgid % nig) % gsz); pn = (wgid % nig) / gsz; return true;
    }
    __device__ __forceinline__ bool next(int i, Unit& u) const { int pm, pn; if (!map(i, pm, pn)) return false; u.pm = pm; u.pn = pn; u.e = 0; u.gp = pm; return true; }
};
struct MoeOrder {
    StaticOrder so; int p0; const int* pexp;
    int psplit, p1;
    int H;
    __device__ void init(int nP, int nN, int G, int c, int p0_, const int* pexp_) { so.init(nP, nN, G, c); p0 = p0_; pexp = pexp_; psplit = 1 << 30; p1 = 0; H = 0; }
    __device__ __forceinline__ bool next(int i, Unit& u) const { int pm, pn; long L = (long)i * so.G + so.c;
        if (H > 0) { const int full = so.nwg / so.G, nh = full - 3;
            if (so.c < H) { if (i >= nh) return false; }
            else if (i >= full) { const int j = so.c - H; if (i > full || j >= 3 * H) return false; L = (long)(nh + j / H) * so.G + (j % H); } }
        if (!so.mapL(L, pm, pn)) return false;
        u.pm = pm; u.pn = pn; u.gp = pm < psplit ? p0 + pm : p1 + (pm - psplit); u.e = __builtin_amdgcn_readfirstlane(pexp[u.gp]); return true; }
};

__device__ __forceinline__ unsigned cvt_pk_bf16(float lo, float hi) { unsigned r; asm volatile("v_cvt_pk_bf16_f32 %0, %1, %2" : "=v"(r) : "v"(lo), "v"(hi)); return r; }
__device__ __forceinline__ float bf_lo(unsigned w) { return __uint_as_float(w << 16); }
__device__ __forceinline__ float bf_hi(unsigned w) { return __uint_as_float(w & 0xffff0000u); }

template <class Epi, class Sched, bool GATHER>
__device__ __forceinline__ void gemm_phase(PG8_LAS unsigned char* lds, const Gemm g, const Sched& S, const Epi& E, int wave_id  ) {
    int tid_; asm volatile("v_mbcnt_lo_u32_b32 %0, -1, 0\n\tv_mbcnt_hi_u32_b32 %0, -1, %0" : "=v"(tid_)); tid_ += wave_id << 6;
    const int tid = tid_, wid = __builtin_amdgcn_readfirstlane(tid >> 6), lane = tid & 63, wr = wid >> 2, wc = wid & 3, fr = lane & 15, fq = lane >> 4;
    const int K = g.K, nt = K / BK;
    int Ra[2], Ca[2]; unsigned voffB[2];
#pragma unroll
    for (int i = 0; i < 2; ++i) { int R, C; stage_rc(tid * 16 + i * 8192, R, C); const int Rb = (R & ~31) + perm32(R & 31);
        Ra[i] = R; Ca[i] = C; voffB[i] = (unsigned)(Rb * K + C) * 2u; }
    const size_t kstep = (size_t)(BK * 2);
    const size_t hstep = (size_t)HALF * K * 2;
    const size_t tstep = 2 * hstep;
    const unsigned ldsw = (unsigned)wid * 1024u;
    const int aoff = lds_byte(wr * 64 + fr, fq * 8), boff = lds_byte(wc * 32 + fr, fq * 8);
    const char* const A0 = (const char*)g.A;
#define PG8_SA(b, h) (((b) * 2 + (h)) * HTB)
#define PG8_SB(b, h) ((4 + (b) * 2 + (h)) * HTB)
#define PG8_STAGE(bufoff, gbase, voff) do { _Pragma("unroll") for (int _i = 0; _i < 2; ++_i) \
        __builtin_amdgcn_global_load_lds((const unsigned*)((const char*)(gbase) + (voff)[_i]), (PG8_LAS unsigned*)(lds + (bufoff) + ldsw + _i * 8192), 16, 0, 0); } while (0)
#define PG8_LDA(dst, b, h) do { _Pragma("unroll") for (int m = 0; m < 4; ++m) _Pragma("unroll") for (int k = 0; k < 2; ++k) dst[m][k] = *(const PG8_LAS bf16x8*)(lds + PG8_SA(b, h) + aoff + m * 2048 + k * 1024); } while (0)
#define PG8_LDB(dst, b, h) do { _Pragma("unroll") for (int n = 0; n < 2; ++n) _Pragma("unroll") for (int k = 0; k < 2; ++k) dst[n][k] = *(const PG8_LAS bf16x8*)(lds + PG8_SB(b, h) + boff + n * 2048 + k * 1024); } while (0)
#define PG8_MMA(ai, bj, At, Bt) do { __builtin_amdgcn_s_setprio(1); _Pragma("unroll") for (int m = 0; m < 4; ++m) _Pragma("unroll") for (int n = 0; n < 2; ++n) _Pragma("unroll") for (int k = 0; k < 2; ++k) \
        acc[ai][bj][m][n] = __builtin_amdgcn_mfma_f32_16x16x32_bf16(Bt[n][k], At[m][k], acc[ai][bj][m][n], 0, 0, 0); __builtin_amdgcn_s_setprio(0); } while (0)
#define PG8_WAIT_V(n) asm volatile("s_waitcnt vmcnt(" #n ")" ::: "memory")
#define PG8_WAIT_L(n) asm volatile("s_waitcnt lgkmcnt(" #n ")" ::: "memory")
#define PG8_BAR __builtin_amdgcn_s_barrier()
#define PG8_SCHED __builtin_amdgcn_sched_barrier(0)
#define PG8_AOFFS(dst, u) do { _Pragma("unroll") for (int _h = 0; _h < 2; ++_h) _Pragma("unroll") for (int _i = 0; _i < 2; ++_i) { \
        int _row = (u).pm * BM + _h * HALF + Ra[_i]; \
        if (GATHER) { const int _gi = g.rowidx[(u).gp * BM + _h * HALF + Ra[_i]]; _row = _gi < 0 ? 0 : _gi; } \
        dst[_h][_i] = ((unsigned)_row * (unsigned)K + (unsigned)Ca[_i]) * 2u; } } while (0)
    Unit cur, nxt; int ui = 0;
    if (!S.next(0, cur)) return;
    f32x4 acc[2][2][4][2];
#pragma unroll
    for (int a = 0; a < 2; ++a)
#pragma unroll
        for (int b = 0; b < 2; ++b)
#pragma unroll
            for (int m = 0; m < 4; ++m)
#pragma unroll
                for (int n = 0; n < 2; ++n) acc[a][b][m][n] = (f32x4){0.f, 0.f, 0.f, 0.f};
    bf16x8 At[4][2], B0[2][2], B1[2][2];
    unsigned oaC[2][2], oaN[2][2];
    PG8_AOFFS(oaC, cur);
    const char* cB = (const char*)g.Bt + (size_t)cur.e * g.estride + (size_t)cur.pn * tstep;
    PG8_STAGE(PG8_SB(0, 0), cB, voffB); PG8_STAGE(PG8_SB(0, 1), cB + hstep, voffB); PG8_STAGE(PG8_SA(0, 0), A0, oaC[0]); PG8_STAGE(PG8_SA(0, 1), A0, oaC[1]);
    if (wr == 1) PG8_BAR;
    PG8_WAIT_V(2); PG8_BAR;
    PG8_STAGE(PG8_SB(1, 0), cB + kstep, voffB); PG8_STAGE(PG8_SA(1, 0), A0 + kstep, oaC[0]); PG8_STAGE(PG8_SB(1, 1), cB + hstep + kstep, voffB);
    PG8_WAIT_V(6); PG8_BAR;
    for (;;) {
        const bool has_next = S.next(ui + 1, nxt);
        if (has_next) { PG8_AOFFS(oaN, nxt); }
        else {
#pragma unroll
            for (int _h = 0; _h < 2; ++_h)
#pragma unroll
                for (int _i = 0; _i < 2; ++_i) oaN[_h][_i] = oaC[_h][_i]; }
        const char* nB = has_next ? (const char*)g.Bt + (size_t)nxt.e * g.estride + (size_t)nxt.pn * tstep : cB;
        for (int t = 0; t < nt; t += 2) {
            const bool last = (t == nt - 2);
            const char* ka1 = A0 + (size_t)(t + 1) * kstep;
            const char* ka2 = last ? A0 : A0 + (size_t)(t + 2) * kstep; const char* b2 = last ? nB : cB + (size_t)(t + 2) * kstep;
            const char* ka3 = ka2 + kstep; const char* b3 = b2 + kstep;
            unsigned o2[2][2];
#pragma unroll
            for (int _h = 0; _h < 2; ++_h)
#pragma unroll
                for (int _i = 0; _i < 2; ++_i) o2[_h][_i] = oaC[_h][_i];
            if (last) {
                E.prefetch(lds, cur, wid, lane);
#pragma unroll
                for (int _h = 0; _h < 2; ++_h)
#pragma unroll
                    for (int _i = 0; _i < 2; ++_i) o2[_h][_i] = oaN[_h][_i];
                asm volatile("" : "+v"(o2[0][0]), "+v"(o2[0][1]), "+v"(o2[1][0]), "+v"(o2[1][1])); }
            PG8_LDB(B0, 0, 0); PG8_LDB(B1, 0, 1); PG8_SCHED; PG8_LDA(At, 0, 0); PG8_STAGE(PG8_SA(1, 1), ka1, oaC[1]);
            PG8_WAIT_V(8); PG8_WAIT_L(0); PG8_BAR; PG8_MMA(0, 0, At, B0); PG8_MMA(0, 1, At, B1); PG8_BAR; PG8_SCHED;
            PG8_LDA(At, 0, 1); PG8_STAGE(PG8_SB(0, 0), b2, voffB); PG8_STAGE(PG8_SB(0, 1), b2 + hstep, voffB); PG8_STAGE(PG8_SA(0, 0), ka2, o2[0]);
            PG8_WAIT_V(8); PG8_WAIT_L(0); PG8_BAR; PG8_MMA(1, 0, At, B0); PG8_MMA(1, 1, At, B1); PG8_BAR; PG8_SCHED;
            PG8_LDB(B0, 1, 0); PG8_LDB(B1, 1, 1); PG8_SCHED; PG8_LDA(At, 1, 0); PG8_STAGE(PG8_SA(0, 1), ka2, o2[1]);
            PG8_WAIT_V(8); PG8_WAIT_L(0); PG8_BAR; PG8_MMA(0, 0, At, B0); PG8_MMA(0, 1, At, B1); PG8_BAR; PG8_SCHED;
            PG8_LDA(At, 1, 1); PG8_STAGE(PG8_SB(1, 0), b3, voffB); PG8_STAGE(PG8_SB(1, 1), b3 + hstep, voffB); PG8_STAGE(PG8_SA(1, 0), ka3, o2[0]);
            PG8_WAIT_V(8); PG8_WAIT_L(0); PG8_BAR; PG8_MMA(1, 0, At, B0); PG8_MMA(1, 1, At, B1); PG8_BAR; PG8_SCHED;
        }
        if (wr == 0) PG8_BAR;
        { int fr_e = fr, fq_e = fq; asm volatile("" : "+v"(fr_e), "+v"(fq_e));
          E(acc, cur, wr, wc, fr_e, fq_e, lds); }
        if (!has_next) break;
#pragma unroll
        for (int a = 0; a < 2; ++a)
#pragma unroll
            for (int b = 0; b < 2; ++b)
#pragma unroll
                for (int m = 0; m < 4; ++m)
#pragma unroll
                    for (int n = 0; n < 2; ++n) acc[a][b][m][n] = (f32x4){0.f, 0.f, 0.f, 0.f};
        cur = nxt; cB = nB; ++ui;
#pragma unroll
        for (int _h = 0; _h < 2; ++_h)
#pragma unroll
            for (int _i = 0; _i < 2; ++_i) oaC[_h][_i] = oaN[_h][_i];
        if (wr == 1) PG8_BAR;
    }
    PG8_WAIT_V(0);
    PG8_BAR;
#undef PG8_SA
#undef PG8_SB
#undef PG8_STAGE
#undef PG8_LDA
#undef PG8_LDB
#undef PG8_MMA
#undef PG8_WAIT_V
#undef PG8_WAIT_L
#undef PG8_BAR
#undef PG8_SCHED
#undef PG8_AOFFS
}
}
#define GAS __attribute__((address_space(1)))
#define LAS __attribute__((address_space(3)))
typedef unsigned short bf16;
typedef unsigned v4u __attribute__((ext_vector_type(4)));
typedef unsigned v2u __attribute__((ext_vector_type(2)));
typedef float f32x4 __attribute__((ext_vector_type(4)));
typedef float f32x2 __attribute__((ext_vector_type(2)));
typedef GAS unsigned gu32;
#define RLX_AGENT __ATOMIC_RELAXED, __HIP_MEMORY_SCOPE_AGENT
#define LDS_WAIT() asm volatile("s_waitcnt lgkmcnt(0)" ::: "memory")
#define VM_WAIT() asm volatile("s_waitcnt vmcnt(0)" ::: "memory")
__device__ __forceinline__ unsigned f2bf(float f) { unsigned u = __builtin_bit_cast(unsigned, f); return (u + 0x7fffu + ((u >> 16) & 1u)) >> 16; }
__device__ __forceinline__ unsigned pk2(float lo, float hi) { return f2bf(lo) | (f2bf(hi) << 16); }
__device__ __forceinline__ float bf2f(bf16 h) { return __uint_as_float(((unsigned)h) << 16); }
__device__ __forceinline__ float bflo(unsigned w) { return __uint_as_float(w << 16); }
__device__ __forceinline__ float bfhi(unsigned w) { return __uint_as_float(w & 0xffff0000u); }

#define XB_TMO      128
#define XB_XCNT(j)  (256  + 64 * (j))
#define XB_XSUB(j)  (1280 + 64 * (j))
#define XB_XGEN(j)  (2304 + 64 * (j))
#define XB_TOP      3328
#define XB_TOPGEN   3392
#define XCD_BAR_WORDS 3456
#define XB_SPIN_CAP (1u << 18)

__device__ __forceinline__ unsigned xb_ld(unsigned* p)              { return __hip_atomic_load(p, __ATOMIC_RELAXED, __HIP_MEMORY_SCOPE_AGENT); }
__device__ __forceinline__ unsigned xb_add(unsigned* p, unsigned v) { return __hip_atomic_fetch_add(p, v, __ATOMIC_RELAXED, __HIP_MEMORY_SCOPE_AGENT); }
__device__ __forceinline__ unsigned xb_xcc_id() { return (unsigned)__builtin_amdgcn_s_getreg((3 << 11) | 20) & 0xFu; }
#define XB_SPIN(cond, bar) do { unsigned _sp = 0; while (cond) { __builtin_amdgcn_s_sleep(1); \
    if ((++_sp & 255u) == 0u) { if (xb_ld(&(bar)[XB_TMO])) break; if (_sp > XB_SPIN_CAP) { atomicAdd(&(bar)[XB_TMO], 1u); break; } } } } while (0)

struct XcdBarrier {
    unsigned* bar; unsigned x;
    volatile LAS unsigned* st;
};

__device__ __forceinline__ XcdBarrier xcd_barrier_post(unsigned* bar, volatile LAS unsigned* st, bool leader  ) {
    XcdBarrier b; b.bar = bar; b.x = xb_xcc_id(); b.st = st;
    if (leader) (void)xb_add(&bar[XB_XCNT(b.x)], 1u);
    return b;
}
__device__ __forceinline__ void xcd_barrier_complete(unsigned* bar, unsigned x, unsigned& nloc, unsigned& nx) {
    const unsigned G = gridDim.x * gridDim.y * gridDim.z;
    unsigned sum, cnt, mine, sp = 0u;
    for (;;) {
        sum = 0u; cnt = 0u; mine = 0u;
#pragma unroll
        for (unsigned j = 0; j < 16; ++j) { const unsigned c = xb_ld(&bar[XB_XCNT(j)]); sum += c; cnt += (c > 0u) ? 1u : 0u; mine = (j == x) ? c : mine; }
        if (sum == G) break;
        __builtin_amdgcn_s_sleep(1);
        if ((++sp & 255u) == 0u) { if (xb_ld(&bar[XB_TMO])) break; if (sp > XB_SPIN_CAP) { atomicAdd(&bar[XB_TMO], 1u); break; } }
    }
    nloc = mine > 0u ? mine : 1u; nx = cnt > 0u ? cnt : 1u;
}

__device__ __forceinline__ void xcd_barrier(const XcdBarrier& b, bool leader) {
    asm volatile("s_waitcnt vmcnt(0)" ::: "memory");
    __syncthreads();
    if (leader) {
        unsigned* bar = b.bar;
        __builtin_amdgcn_s_waitcnt(0);
        unsigned nloc = b.st[0], nx = b.st[1];
        if (nloc == 0u) { xcd_barrier_complete(bar, b.x, nloc, nx); b.st[0] = nloc; b.st[1] = nx; }
        const unsigned old = xb_add(&bar[XB_XSUB(b.x)], 1u);
        const unsigned gen = old / nloc;
        if (old + 1u == (gen + 1u) * nloc) {
            __builtin_amdgcn_fence(__ATOMIC_RELEASE, "agent");
            asm volatile("s_waitcnt vmcnt(0)" ::: "memory");
            const unsigned og = xb_add(&bar[XB_TOP], 1u);
            const unsigned tg = og / nx;
            if (og + 1u == (tg + 1u) * nx) xb_add(&bar[XB_TOPGEN], 1u);
            else XB_SPIN(xb_ld(&bar[XB_TOPGEN]) == tg, bar);
            __builtin_amdgcn_fence(__ATOMIC_ACQUIRE, "agent");
            xb_add(&bar[XB_XGEN(b.x)], 1u);
            asm volatile("s_waitcnt vmcnt(0)" ::: "memory");
        } else {
            XB_SPIN(xb_ld(&bar[XB_XGEN(b.x)]) == gen, bar);
            __builtin_amdgcn_fence(__ATOMIC_ACQUIRE, "agent");
            asm volatile("s_waitcnt vmcnt(0)" ::: "memory");
        }
    }
    __syncthreads();
}

__device__ __forceinline__ int lane_id() { int l; asm volatile("v_mbcnt_lo_u32_b32 %0, -1, 0\n\tv_mbcnt_hi_u32_b32 %0, -1, %0" : "=v"(l)); return l; }

constexpr int NB = 16, TT = 2048, DM = 1024, MR = NB * TT, NMETA = 16, MROWS = MR + 256, NPAN = MROWS / 256;
constexpr int PSEQ = 2112, NCH = 33;
constexpr int DIN = 2864, N1 = 3072;
constexpr int DFF = 2816, DFE = 3584, NEXP = 8;
constexpr float EPS = 1e-6f;
constexpr int C_AQ = 0, C_AK = 128, C_AV = 256, C_ALR = 512, C_AOG = 528, C_RQ = 784, C_RK = 1040, C_RV = 1296, C_ROG = 1552, C_CQ = 1808, C_CKV = 2000, C_KPE = 2064, C_DQ = 2096, C_DK = 2352, C_DV = 2608;
constexpr int MAXPAN = 264;
constexpr float LOG2E = 1.4426950408889634f;

constexpr size_t MiB = 1u << 20;
constexpr size_t WS_CTL = 0, CTL_BYTES = 1 * MiB;
constexpr size_t WS_TABR = 1 * MiB, WS_TABM = 1 * MiB + 576 * 1024;
constexpr size_t WS_RT = 2 * MiB;
constexpr size_t WS_WQA = 2 * MiB + 256 * 1024, WQA_BYTES = 384 * 192 * 2;
constexpr size_t WS_STA = 3 * MiB, WS_STB = 6 * MiB;
constexpr size_t WS_MOE = 9 * MiB;
constexpr size_t MO_ROWIDX = WS_MOE, MO_PDST = WS_MOE + 512 * 1024, MO_PINFO = WS_MOE + 1 * MiB, MO_TOKE = WS_MOE + 2 * MiB, MO_TOKP = MO_TOKE + 256 * 1024, MO_TOKW = MO_TOKE + 512 * 1024, MO_PEXP = WS_MOE + 3 * MiB;
constexpr size_t WS_GD = 13 * MiB;
constexpr size_t WS_W1T = 16 * MiB, W1T_BYTES = (size_t)N1 * DM * 2;
constexpr size_t WS_WOT = 29 * MiB, WOT_BYTES = (size_t)DM * DM * 2;
constexpr size_t WS_WGU = 33 * MiB;
constexpr size_t WS_WD = 44 * MiB;
constexpr size_t WS_HB = 50 * MiB;
constexpr size_t WS_BIG = 115 * MiB;
constexpr size_t B_PROJ = WS_BIG;
constexpr int GQ_T = 5120, GKT_T = 5120, RT_T = 9216, VT_T = 9216;
constexpr size_t B_GQ = WS_BIG + 210 * MiB, B_GK = WS_BIG + 221 * MiB, B_GV = WS_BIG + 232 * MiB;
constexpr size_t B_RQ = WS_BIG + 251 * MiB, B_RK = WS_BIG + 270 * MiB, B_RV = WS_BIG + 289 * MiB;
constexpr size_t B_MQ = WS_BIG + 308 * MiB, B_MK = WS_BIG + 333 * MiB;
constexpr size_t B_DQ = WS_BIG + 340 * MiB, B_DK = B_DQ + 16896 * 1024;
constexpr size_t O_DVT = 65 * MiB, O_MVT = 82 * MiB, O_GKT = 87 * MiB, O_RKT = 98 * MiB;
constexpr size_t B_ACT = WS_BIG;
constexpr size_t B_EGU = WS_BIG, EGU_BYTES = (size_t)2 * DFE * DM * 2;
constexpr size_t B_ED = WS_BIG + 112 * MiB, ED_BYTES = (size_t)DM * DFE * 2;
constexpr size_t B_EACT = WS_BIG + 168 * MiB;
constexpr size_t WS_NEED = WS_BIG + 406 * MiB;
constexpr int CW_BAR = 4096, CW_CNT = 8192;

constexpr int RING_BYTES = 131072, MISC_OFF = RING_BYTES + 320, EPS_OFF = 147456, LDS_BYTES = 163840;

__device__ __forceinline__ float silu_f(float x) { return x * __builtin_amdgcn_rcpf(1.0f + __builtin_amdgcn_exp2f(-x * LOG2E)); }
__device__ __forceinline__ v4u pack8(const f32x4 a, const f32x4 b) { v4u w; w.x = pg8::cvt_pk_bf16(a[0], a[1]); w.y = pg8::cvt_pk_bf16(a[2], a[3]); w.z = pg8::cvt_pk_bf16(b[0], b[1]); w.w = pg8::cvt_pk_bf16(b[2], b[3]); return w; }

__device__ __forceinline__ void rows_rstd16(const float* stats, int row0, int fq, float (&rs)[8]) {
    f32x4 v[8];
#pragma unroll
    for (int j = 0; j < 8; ++j) v[j] = *(const f32x4*)(stats + (size_t)(row0 + (j >> 2) * 128 + (j & 3) * 16) * 16 + 4 * fq);
#pragma unroll
    for (int j = 0; j < 8; ++j) { float s = (v[j][0] + v[j][1]) + (v[j][2] + v[j][3]); s += __shfl_xor(s, 16); s += __shfl_xor(s, 32); rs[j] = __builtin_amdgcn_rsqf(s * (1.0f / 1024.0f) + EPS); }
}
__device__ __forceinline__ void stage_rows(const void* src, int bytes, LAS unsigned char* lds, int wid, int lane) {
#pragma unroll
    for (int j = 0; j < 2; ++j) { const int p = __builtin_amdgcn_readfirstlane(wid + 8 * j);
        if (p * 1024 < bytes) __builtin_amdgcn_global_load_lds((const unsigned*)((const unsigned char*)src + p * 1024 + lane * 16), (LAS unsigned*)(lds + EPS_OFF + p * 1024), 16, 0, 0); }
}
__device__ __forceinline__ void rows_rstd16_lds(const LAS unsigned char* lds, int rl0, int fq, float (&rs)[8]) {
    f32x4 v[8];
#pragma unroll
    for (int j = 0; j < 8; ++j) v[j] = *(const LAS f32x4*)(lds + EPS_OFF + (rl0 + (j >> 2) * 128 + (j & 3) * 16) * 64 + 16 * fq);
#pragma unroll
    for (int j = 0; j < 8; ++j) { float s = (v[j][0] + v[j][1]) + (v[j][2] + v[j][3]); s += __shfl_xor(s, 16); s += __shfl_xor(s, 32); rs[j] = __builtin_amdgcn_rsqf(s * (1.0f / 1024.0f) + EPS); }
}
struct EpiProj {
    bf16* O; const float* stats;
    __device__ __forceinline__ void prefetch(LAS unsigned char* lds, const pg8::Unit& u, int wid, int lane) const { stage_rows(stats + (size_t)u.pm * 256 * 16, 16384, lds, wid, lane); }
    __device__ __forceinline__ void operator()(const f32x4 (&acc)[2][2][4][2], const pg8::Unit& u, int wr, int wc, int fr, int fq, const LAS unsigned char* lds) const {
        const int col0 = u.pn * 256 + wc * 32 + 8 * fq, row0 = u.pm * 256 + wr * 64 + fr;
        float rs[8]; rows_rstd16_lds(lds, wr * 64 + fr, fq, rs);
#pragma unroll
        for (int ai = 0; ai < 2; ++ai)
#pragma unroll
            for (int m = 0; m < 4; ++m) { const int r = row0 + ai * 128 + m * 16; const float sc = rs[ai * 4 + m]; bf16* rowp = O + (size_t)r * N1 + col0;
#pragma unroll
                for (int bj = 0; bj < 2; ++bj) *(v4u*)(rowp + bj * 128) = pack8(acc[ai][bj][m][0] * sc, acc[ai][bj][m][1] * sc); }
    }
};
struct EpiSwiglu {
    bf16* O; int ldo; const float* stats;
    __device__ __forceinline__ void prefetch(LAS unsigned char* lds, const pg8::Unit& u, int wid, int lane) const { stage_rows(stats + (size_t)u.pm * 256 * 16, 16384, lds, wid, lane); }
    __device__ __forceinline__ void operator()(const f32x4 (&acc)[2][2][4][2], const pg8::Unit& u, int wr, int wc, int fr, int fq, const LAS unsigned char* lds) const {
        const int col0 = u.pn * 128 + wc * 32 + 8 * fq, row0 = u.pm * 256 + wr * 64 + fr;
        float rs[8]; rows_rstd16_lds(lds, wr * 64 + fr, fq, rs);
#pragma unroll
        for (int ai = 0; ai < 2; ++ai)
#pragma unroll
            for (int m = 0; m < 4; ++m) { const int r = row0 + ai * 128 + m * 16; const float sc = rs[ai * 4 + m];
                f32x4 o[2];
#pragma unroll
                for (int n = 0; n < 2; ++n)
#pragma unroll
                    for (int i = 0; i < 4; ++i) o[n][i] = silu_f(acc[ai][0][m][n][i] * sc) * (acc[ai][1][m][n][i] * sc);
                *(v4u*)(O + (size_t)r * ldo + col0) = pack8(o[0], o[1]); }
    }
};
struct EpiResid {
    bf16* H; float* stats;
    __device__ __forceinline__ void prefetch(LAS unsigned char*, const pg8::Unit&, int, int) const {}
    __device__ __forceinline__ void operator()(const f32x4 (&acc)[2][2][4][2], const pg8::Unit& u, int wr, int wc, int fr, int fq, const LAS unsigned char*) const {
        const int col0 = u.pn * 256 + wc * 32 + 8 * fq, row0 = u.pm * 256 + wr * 64 + fr;
#pragma unroll
        for (int ai = 0; ai < 2; ++ai) {
            v4u w[4][2];
#pragma unroll
            for (int m = 0; m < 4; ++m)
#pragma unroll
                for (int bj = 0; bj < 2; ++bj) w[m][bj] = *(const v4u*)(H + (size_t)(row0 + ai * 128 + m * 16) * DM + col0 + bj * 128);
            float ssm[4];
#pragma unroll
            for (int m = 0; m < 4; ++m) { bf16* rowp = H + (size_t)(row0 + ai * 128 + m * 16) * DM + col0; float ss = 0.f;
#pragma unroll
                for (int bj = 0; bj < 2; ++bj) { const v4u x = w[m][bj];
                    f32x4 a = acc[ai][bj][m][0], b = acc[ai][bj][m][1];
                    a[0] += bflo(x.x); a[1] += bfhi(x.x); a[2] += bflo(x.y); a[3] += bfhi(x.y); b[0] += bflo(x.z); b[1] += bfhi(x.z); b[2] += bflo(x.w); b[3] += bfhi(x.w);
                    ss += (a[0] * a[0] + a[1] * a[1]) + (a[2] * a[2] + a[3] * a[3]) + (b[0] * b[0] + b[1] * b[1]) + (b[2] * b[2] + b[3] * b[3]);
                    *(v4u*)(rowp + bj * 128) = pack8(a, b); }
                ss += __shfl_xor(ss, 16); ss += __shfl_xor(ss, 32); ssm[m] = ss; }
            if (fq == 0) {
#pragma unroll
                for (int m = 0; m < 4; ++m) stats[(size_t)(row0 + ai * 128 + m * 16) * 16 + u.pn * 4 + wc] = ssm[m]; } }
    }
};
struct EpiSwigluMoe {
    bf16* O; const f32x2* pinfo;
    __device__ __forceinline__ void prefetch(LAS unsigned char* lds, const pg8::Unit& u, int wid, int lane) const { stage_rows(pinfo + (size_t)u.gp * 256, 2048, lds, wid, lane); }
    __device__ __forceinline__ void operator()(const f32x4 (&acc)[2][2][4][2], const pg8::Unit& u, int wr, int wc, int fr, int fq, const LAS unsigned char* lds) const {
        const int col0 = u.pn * 128 + wc * 32 + 8 * fq, rl0 = wr * 64 + fr;
        float rs[8];
#pragma unroll
        for (int j = 0; j < 8; ++j) rs[j] = ((const LAS f32x2*)(lds + EPS_OFF))[rl0 + (j >> 2) * 128 + (j & 3) * 16][0];
#pragma unroll
        for (int ai = 0; ai < 2; ++ai)
#pragma unroll
            for (int m = 0; m < 4; ++m) { const int rl = rl0 + ai * 128 + m * 16; const float sc = rs[ai * 4 + m];
                f32x4 o[2];
#pragma unroll
                for (int n = 0; n < 2; ++n)
#pragma unroll
                    for (int i = 0; i < 4; ++i) o[n][i] = silu_f(acc[ai][0][m][n][i] * sc) * (acc[ai][1][m][n][i] * sc);
                *(v4u*)(O + (size_t)(u.pm * 256 + rl) * DFE + col0) = pack8(o[0], o[1]); }
    }
};
struct EpiMoeDown {
    unsigned char* Y; const int* pdst; const f32x2* pinfo;
    __device__ __forceinline__ void prefetch(LAS unsigned char* lds, const pg8::Unit& u, int wid, int lane) const {
        if (wid < 2) __builtin_amdgcn_global_load_lds((const unsigned*)((const unsigned char*)(pinfo + (size_t)u.gp * 256) + wid * 1024 + lane * 16), (LAS unsigned*)(lds + EPS_OFF + wid * 1024), 16, 0, 0);
        else if (wid == 2) __builtin_amdgcn_global_load_lds((const unsigned*)((const unsigned char*)(pdst + (size_t)u.gp * 256) + lane * 16), (LAS unsigned*)(lds + EPS_OFF + 2048), 16, 0, 0); }
    __device__ __forceinline__ void operator()(const f32x4 (&acc)[2][2][4][2], const pg8::Unit& u, int wr, int wc, int fr, int fq, const LAS unsigned char* lds) const {
        const int col0 = u.pn * 256 + wc * 32 + 8 * fq, rl0 = wr * 64 + fr;
#pragma unroll
        for (int ai = 0; ai < 2; ++ai)
#pragma unroll
            for (int m = 0; m < 4; ++m) { const int rl = rl0 + ai * 128 + m * 16; const int d = ((const LAS int*)(lds + EPS_OFF + 2048))[rl]; const float w = ((const LAS f32x2*)(lds + EPS_OFF))[rl][1];
                if (d >= 0) { bf16* rowp = (bf16*)(Y + (size_t)(d >> 1) * 4096 + (size_t)(d & 1) * 2048) + col0;
#pragma unroll
                    for (int bj = 0; bj < 2; ++bj) *(v4u*)(rowp + bj * 128) = pack8(acc[ai][bj][m][0] * w, acc[ai][bj][m][1] * w); } }
    }
};

__device__ __forceinline__ float wave_sum(float v) {
#pragma unroll
    for (int o = 1; o < 64; o <<= 1) v += __shfl_xor(v, o);
    return v;
}
__device__ __forceinline__ void transpose_item(const float* W, int K, int N, const float* gain, bf16* WT, int kb, int nb, int dmode, LAS float* scr_, int lane) {
    LAS unsigned* scr = (LAS unsigned*)scr_;
    const int k0 = 64 * kb, n0 = 64 * nb, n = n0 + 2 * (lane & 31), kh = lane >> 5;
    f32x2 v[32];
#pragma unroll
    for (int i = 0; i < 32; ++i) v[i] = (n < N) ? *(const f32x2*)(W + (size_t)(k0 + 2 * i + kh) * N + n) : (f32x2){0.f, 0.f};
    if (gain) {
#pragma unroll
        for (int i = 0; i < 32; ++i) v[i] = v[i] * gain[k0 + 2 * i + kh]; }
#pragma unroll
    for (int i = 0; i < 32; ++i) scr[(2 * i + kh) * 33 + (lane & 31)] = pk2(v[i][0], v[i][1]);
    LDS_WAIT(); asm volatile("" ::: "memory");
    const LAS bf16* T = (const LAS bf16*)scr;
    const int c = lane & 7;
    const int d0 = dmode == 0 ? n0 : 256 * (n0 >> 7) + (n0 & 127) + (dmode == 2 ? 128 : 0);
#pragma unroll
    for (int j = 0; j < 8; ++j) { const int nl = (lane >> 3) + 8 * j; unsigned x[8];
#pragma unroll
        for (int t = 0; t < 8; ++t) x[t] = T[(8 * c + t) * 66 + nl];
        v4u o; o.x = x[0] | (x[1] << 16); o.y = x[2] | (x[3] << 16); o.z = x[4] | (x[5] << 16); o.w = x[6] | (x[7] << 16);
        if (n0 + nl < N) *(v4u*)(WT + (size_t)(d0 + nl) * K + k0 + 8 * c) = o; }
    LDS_WAIT(); asm volatile("" ::: "memory");
}

struct Args { const float* in[24]; float* out; unsigned char* ws; int ph_lo, ph_hi; };
__device__ __forceinline__ const float* ain(const Args& a, int i) { return a.in[i]; }
enum { I_X = 0, I_META, I_ANORM, I_WIN, I_GWG, I_GBG, I_GNORM, I_RNORM, I_MQN, I_WUQ, I_MKVN, I_WUKV, I_DLAM, I_DNORM, I_WOUT, I_FNORM, I_FG, I_FU, I_FD, I_ROUTER, I_EG, I_EU, I_ED, I_FINAL };

#ifndef REP_FOLD
#define REP_FOLD 1
#endif
#ifndef REP_HINIT
#define REP_HINIT 1
#endif
__device__ __forceinline__ void wqa_unit(const Args& a, int li, int hh, LAS float* L, int tid) {
    const float* Wuq = ain(a, I_WUQ) + (size_t)li * 192 * 384; const float* Wukv = ain(a, I_WUKV) + (size_t)li * 64 * 512;
    const float* gq = ain(a, I_MQN) + li * 192; const float* gkv = ain(a, I_MKVN) + li * 64;
    bf16* WqaT = (bf16*)(a.ws + WS_WQA + li * WQA_BYTES);
    LAS float* Wqa = L; LAS float* Wuk = L + 192 * 97;
    __syncthreads();
    for (int idx = tid; idx < 64 * 64; idx += 512) { const int n = idx >> 6, m = idx & 63; Wuk[n * 65 + m] = Wukv[n * 512 + hh * 128 + m]; }
    __syncthreads();
    for (int pass = 0; pass < 3; ++pass) { const int i = pass * 64 + (tid >> 3), ng = tid & 7; f32x4 wq[16];
#pragma unroll
        for (int j = 0; j < 16; ++j) wq[j] = *(const f32x4*)(Wuq + i * 384 + hh * 96 + 4 * j);
        const float gi = gq[i];
#pragma unroll
        for (int t = 0; t < 8; ++t) { const int n = ng * 8 + t; float s = 0.f;
#pragma unroll
            for (int j = 0; j < 16; ++j) s += (wq[j][0] * Wuk[n * 65 + 4 * j] + wq[j][1] * Wuk[n * 65 + 4 * j + 1]) + (wq[j][2] * Wuk[n * 65 + 4 * j + 2] + wq[j][3] * Wuk[n * 65 + 4 * j + 3]);
            Wqa[i * 97 + n] = gi * gkv[n] * s; }
        if (ng < 4) {
#pragma unroll
            for (int j = 0; j < 2; ++j) { const f32x4 r = *(const f32x4*)(Wuq + i * 384 + hh * 96 + 64 + ng * 8 + 4 * j); LAS float* d = Wqa + i * 97 + 64 + ng * 8 + 4 * j; d[0] = gi * r[0]; d[1] = gi * r[1]; d[2] = gi * r[2]; d[3] = gi * r[3]; } } }
    __syncthreads();
    for (int idx = tid; idx < 96 * 24; idx += 512) { const int n = idx % 96, i8 = idx / 96; float v[8];
#pragma unroll
        for (int t = 0; t < 8; ++t) v[t] = Wqa[(8 * i8 + t) * 97 + n];
        v4u w; w.x = pk2(v[0], v[1]); w.y = pk2(v[2], v[3]); w.z = pk2(v[4], v[5]); w.w = pk2(v[6], v[7]);
        *(v4u*)(WqaT + (size_t)(hh * 96 + n) * 192 + 8 * i8) = w; }
    __syncthreads();
}
__device__ __forceinline__ void wofold_unit(const Args& a, int li, int hh, int nq, LAS float* L, int tid) {
    const float* Wukv = ain(a, I_WUKV) + (size_t)li * 64 * 512; const float* gkv = ain(a, I_MKVN) + li * 64; const float* Wo = ain(a, I_WOUT) + (size_t)li * DM * DM;
    bf16* Wot = (bf16*)(a.ws + WS_WOT + li * WOT_BYTES);
    LAS float* WuvT = L; LAS float* Wos = L + 64 * 64;
    __syncthreads();
    for (int idx = tid; idx < 64 * 64; idx += 512) { const int j = idx >> 6, e = idx & 63; WuvT[e * 64 + j] = Wukv[j * 512 + hh * 128 + 64 + e] * gkv[j]; }
    for (int idx = tid; idx < 64 * 64; idx += 512) { const int e = idx >> 6, n4 = idx & 63; *(LAS f32x4*)(Wos + e * 256 + 4 * n4) = *(const f32x4*)(Wo + (size_t)(512 + 64 * hh + e) * DM + nq * 256 + 4 * n4); }
    __syncthreads();
    { const int n4 = tid & 63, j8 = tid >> 6; f32x4 acc[8];
#pragma unroll
        for (int j = 0; j < 8; ++j) acc[j] = (f32x4){0.f, 0.f, 0.f, 0.f};
#pragma unroll 4
        for (int e = 0; e < 64; ++e) { const f32x4 wv = *(const LAS f32x4*)(Wos + e * 256 + 4 * n4); const f32x4 u0 = *(const LAS f32x4*)(WuvT + e * 64 + 8 * j8), u1 = *(const LAS f32x4*)(WuvT + e * 64 + 8 * j8 + 4);
#pragma unroll
            for (int j = 0; j < 4; ++j) { acc[j] += wv * u0[j]; acc[4 + j] += wv * u1[j]; } }
#pragma unroll
        for (int t = 0; t < 4; ++t) { v4u w; w.x = pk2(acc[0][t], acc[1][t]); w.y = pk2(acc[2][t], acc[3][t]); w.z = pk2(acc[4][t], acc[5][t]); w.w = pk2(acc[6][t], acc[7][t]);
            *(v4u*)(Wot + (size_t)(nq * 256 + 4 * n4 + t) * DM + 512 + 64 * hh + 8 * j8) = w; } }
    __syncthreads();
}
__device__ __forceinline__ void p0_prologue(const Args& a, LAS unsigned char* lds, int tid, int lane, int wave) {
    const int G = gridDim.x;
    for (int rep = 0; rep < REP_FOLD; ++rep)
    for (int un = blockIdx.x; un < 40; un += G) {
        if (un < 8) wqa_unit(a, un >> 2, un & 3, (LAS float*)lds, tid);
        else { const int v = un - 8; wofold_unit(a, v >> 4, (v >> 2) & 3, v & 3, (LAS float*)lds, tid); }
    }
    __syncthreads();
    LAS float* scr = (LAS float*)(lds + wave * 16384);
    const int gw = blockIdx.x * 8 + wave, NGW = G * 8;
    constexpr int I_IN = 16 * 45, I_WO = 12 * 16, I_G = 16 * 44, I_D = 44 * 16;
    constexpr int NIT = 2 * I_IN + 2 * I_WO + 2 * I_G + I_D;
    for (int it = gw; it < NIT; it += NGW) {
        int r = it;
        if (r < 2 * I_IN) { const int li = r / I_IN; r %= I_IN; transpose_item(ain(a, I_WIN) + (size_t)li * DM * DIN, DM, DIN, ain(a, I_ANORM) + li * DM, (bf16*)(a.ws + WS_W1T + li * W1T_BYTES), r / 45, r % 45, 0, scr, lane); continue; } r -= 2 * I_IN;
        if (r < 2 * I_WO) { const int li = r / I_WO; r %= I_WO; int kb = r / 16; if (kb >= 8) kb += 4; transpose_item(ain(a, I_WOUT) + (size_t)li * DM * DM, DM, DM, nullptr, (bf16*)(a.ws + WS_WOT + li * WOT_BYTES), kb, r % 16, 0, scr, lane); continue; } r -= 2 * I_WO;
        if (r < I_G) { transpose_item(ain(a, I_FG), DM, DFF, ain(a, I_FNORM), (bf16*)(a.ws + WS_WGU), r / 44, r % 44, 1, scr, lane); continue; } r -= I_G;
        if (r < I_G) { transpose_item(ain(a, I_FU), DM, DFF, ain(a, I_FNORM), (bf16*)(a.ws + WS_WGU), r / 44, r % 44, 2, scr, lane); continue; } r -= I_G;
        transpose_item(ain(a, I_FD), DFF, DM, nullptr, (bf16*)(a.ws + WS_WD), r / 16, r % 16, 0, scr, lane);
    }
    const int gt = blockIdx.x * 512 + tid, NGT = G * 512;
    for (int i = gt; i < 2 * 208 * 128; i += NGT) { const int li = i / (208 * 128), r = i % (208 * 128);
        *(v4u*)(a.ws + WS_W1T + li * W1T_BYTES + (size_t)DIN * DM * 2 + (size_t)r * 16) = (v4u){0u, 0u, 0u, 0u}; }
    for (int i = gt; i < 8 * DM; i += NGT) { const int e = i >> 10, k = i & 1023; ((float*)(a.ws + WS_RT))[i] = ain(a, I_FNORM)[DM + k] * ain(a, I_ROUTER)[k * 8 + e]; }
    for (int i = gt; i < PSEQ * 48; i += NGT) { const int p = i / 48, j = i % 48; const bool isR = j < 32; const int f = isR ? j : j - 32;
        const float inv = __builtin_amdgcn_exp2f(-(float)f * (isR ? 13.287712379549449f / 32.f : 13.287712379549449f / 16.f));
        const double rev = (double)(p - 48) * (double)inv * 0.15915494309189535; const float fr = (float)(rev - __builtin_rint(rev));
        const f32x2 cs = {__builtin_amdgcn_cosf(fr), __builtin_amdgcn_sinf(fr)};
        if (isR) ((f32x2*)(a.ws + WS_TABR))[p * 32 + f] = cs; else ((f32x2*)(a.ws + WS_TABM))[p * 16 + f] = cs; }
    for (int i = gt; i < 240 * 128; i += NGT) *(v4u*)((unsigned char*)a.out + (size_t)(MR + 16) * 2048 + (size_t)i * 16) = (v4u){0u, 0u, 0u, 0u};
    bf16* hb = (bf16*)(a.ws + WS_HB); float* stA = (float*)(a.ws + WS_STA);
    for (int rep = 0; rep < REP_HINIT; ++rep)
    for (int r = gw; r < MROWS; r += NGW) {
        f32x4 v[4]; float s = 0.f;
#pragma unroll
        for (int j = 0; j < 4; ++j) { if (r < MR) v[j] = ((const f32x4*)(ain(a, I_X) + (size_t)r * DM))[lane + 64 * j]; else if (r < MR + NMETA) v[j] = ((const f32x4*)(ain(a, I_META) + (size_t)(r - MR) * DM))[lane + 64 * j]; else v[j] = (f32x4){0.f, 0.f, 0.f, 0.f};
            s += (v[j][0] * v[j][0] + v[j][1] * v[j][1]) + (v[j][2] * v[j][2] + v[j][3] * v[j][3]); }
        s = wave_sum(s);
#pragma unroll
        for (int j = 0; j < 4; ++j) { v2u w; w.x = pk2(v[j][0], v[j][1]); w.y = pk2(v[j][2], v[j][3]); ((v2u*)(hb + (size_t)r * DM))[lane + 64 * j] = w; }
        if (lane < 16) stA[(size_t)r * 16 + lane] = lane == 0 ? s : 0.f;
    }
}

__device__ __forceinline__ int src_row(int b, int c, int i) { return c == 0 ? (i < 48 ? -1 : MR + i - 48) : b * TT + 64 * (c - 1) + i; }
__device__ __forceinline__ float lg2gamma(int h) { return h == 0 ? -0.045803689613124789f : h == 1 ? -0.022720076500083529f : h == 2 ? -0.011315313227834146f : -0.0056465631411420627f; }

__device__ __forceinline__ void route_block(const Args& a, int blk, LAS unsigned char* lds, int tid, int lane, int wave) {
    LAS float* Rs = (LAS float*)lds; LAS int* lcnt = (LAS int*)(lds + 32768); LAS int* gbase = lcnt + 8; LAS int* rec = lcnt + 16;
    gu32* ctl = (gu32*)(a.ws + WS_CTL);
    const float* Rt = (const float*)(a.ws + WS_RT); const bf16* hb = (const bf16*)(a.ws + WS_HB); const float* stB = (const float*)(a.ws + WS_STB);
    __syncthreads();
    for (int idx = tid; idx < 8 * DM; idx += 512) Rs[idx] = Rt[idx];
    if (tid < 8) lcnt[tid] = 0;
    __syncthreads();
    for (int rr = 0; rr < 16; ++rr) { const int rl = wave * 16 + rr, row = blk * 128 + rl;
        const v4u w0 = *(const v4u*)(hb + (size_t)row * DM + 8 * lane), w1 = *(const v4u*)(hb + (size_t)row * DM + 512 + 8 * lane);
        const float x[16] = {bflo(w0.x), bfhi(w0.x), bflo(w0.y), bfhi(w0.y), bflo(w0.z), bfhi(w0.z), bflo(w0.w), bfhi(w0.w), bflo(w1.x), bfhi(w1.x), bflo(w1.y), bfhi(w1.y), bflo(w1.z), bfhi(w1.z), bflo(w1.w), bfhi(w1.w)};
        float st = lane < 16 ? stB[(size_t)row * 16 + lane] : 0.f; st = wave_sum(st); const float rs = __builtin_amdgcn_rsqf(st * (1.f / 1024.f) + EPS);
        float lg[8];
#pragma unroll
        for (int e = 0; e < 8; ++e) { float s = 0.f;
#pragma unroll
            for (int t = 0; t < 8; ++t) s += x[t] * Rs[e * DM + 8 * lane + t] + x[8 + t] * Rs[e * DM + 512 + 8 * lane + t];
            lg[e] = wave_sum(s) * rs; }
        int e0 = 0; float v0 = lg[0];
#pragma unroll
        for (int e = 1; e < 8; ++e) if (lg[e] > v0) { v0 = lg[e]; e0 = e; }
        int e1 = -1; float v1 = -3.0e38f;
#pragma unroll
        for (int e = 0; e < 8; ++e) if (e != e0 && lg[e] > v1) { v1 = lg[e]; e1 = e; }
        const float g0 = 1.f / (1.f + __expf(v1 - v0)), g1 = 1.f - g0;
        if (lane == 0) { const int lp0 = atomicAdd((int*)(lcnt + e0), 1), lp1 = atomicAdd((int*)(lcnt + e1), 1);
            rec[rl * 6] = e0; rec[rl * 6 + 1] = e1; rec[rl * 6 + 2] = lp0; rec[rl * 6 + 3] = lp1; rec[rl * 6 + 4] = __float_as_int(g0); rec[rl * 6 + 5] = __float_as_int(g1); } }
    __syncthreads();
    if (tid < 8) gbase[tid] = (int)__hip_atomic_fetch_add(ctl + CW_CNT + 64 * tid, (unsigned)lcnt[tid], RLX_AGENT);
    __syncthreads();
    if (tid < 256) { const int rl = tid >> 1, s = tid & 1, tok = blk * 128 + rl, e = rec[rl * 6 + s];
        ((int*)(a.ws + MO_TOKE))[tok * 2 + s] = e; ((int*)(a.ws + MO_TOKP))[tok * 2 + s] = gbase[e] + rec[rl * 6 + 2 + s]; ((int*)(a.ws + MO_TOKW))[tok * 2 + s] = rec[rl * 6 + 4 + s]; }
    __syncthreads();
}
__device__ __forceinline__ void moe_offsets(const Args& a, LAS int* offs, int tid) {
    gu32* ctl = (gu32*)(a.ws + WS_CTL);
    __syncthreads();
    if (tid == 0) { int o = 0;
        for (int e = 0; e < 8; ++e) { const int cnt = (int)__hip_atomic_load(ctl + CW_CNT + 64 * e, RLX_AGENT); offs[e] = o * 256; o += (cnt + 255) >> 8; }
        offs[8] = o; }
    __syncthreads();
}

typedef float f32x16 __attribute__((ext_vector_type(16)));
typedef short s16x8 __attribute__((ext_vector_type(8)));
typedef short s16x4 __attribute__((ext_vector_type(4)));
typedef short v4i16_t __attribute__((ext_vector_type(4)));
__device__ __forceinline__ int crow(int r, int hi) { return (r & 3) + 8 * (r >> 2) + 4 * hi; }


__device__ __forceinline__ void stage_cols(const bf16* proj, int b, int c, int col0, int ncols, LAS bf16* S, int sst, int lcol0, int tid) {
    const int cpr = ncols >> 3;
    for (int idx = tid; idx < 64 * cpr; idx += 512) { const int i = idx / cpr, ch = idx - i * cpr, sr = src_row(b, c, i);
        v4u v = {0u, 0u, 0u, 0u}; if (sr >= 0) v = *(const v4u*)(proj + (size_t)sr * N1 + col0 + ch * 8);
        *(LAS v4u*)(S + i * sst + lcol0 + ch * 8) = v; }
}
__device__ __forceinline__ v4u gather8(const LAS bf16* S, int sst, int row0, int col) {
    unsigned x[8];
#pragma unroll
    for (int t = 0; t < 8; ++t) x[t] = S[(row0 + t) * sst + col];
    v4u w; w.x = x[0] | (x[1] << 16); w.y = x[2] | (x[3] << 16); w.z = x[4] | (x[5] << 16); w.w = x[6] | (x[7] << 16); return w;
}
__device__ __forceinline__ void prep2_unit(const Args& a, int li, int b, int c, int part, LAS unsigned char* lds, int tid) {
    const bf16* proj = (const bf16*)(a.ws + B_PROJ);
    LAS bf16* S = (LAS bf16*)lds;
    const int blk0 = (b * NCH + c) * 4; const size_t prow0 = (size_t)b * PSEQ + 64 * c;
    unsigned char* dout = (unsigned char*)a.out;
    __syncthreads();
    if (part == 0) {
        constexpr int SST = 536; LAS float* seg = (LAS float*)(lds + 64 * SST * 2);
        stage_cols(proj, b, c, C_AQ, 128, S, SST, 0, tid); stage_cols(proj, b, c, C_AK, 128, S, SST, 128, tid); stage_cols(proj, b, c, C_ALR, 16, S, SST, 512, tid);
        __syncthreads();
        { const int ch = tid & 127, sg = tid >> 7; const float* Wg = ain(a, I_GWG) + (size_t)li * 16 * 128; const float bg = ain(a, I_GBG)[li * 128 + ch];
            float wg[16];
#pragma unroll
            for (int r = 0; r < 16; ++r) wg[r] = Wg[r * 128 + ch];
            float cl[16]; float run = 0.f;
#pragma unroll
            for (int t = 0; t < 16; ++t) { const int i = 16 * sg + t; const v4u l0 = *(const LAS v4u*)(S + i * SST + 512), l1 = *(const LAS v4u*)(S + i * SST + 520);
                float x = bg + bflo(l0.x) * wg[0] + bfhi(l0.x) * wg[1] + bflo(l0.y) * wg[2] + bfhi(l0.y) * wg[3] + bflo(l0.z) * wg[4] + bfhi(l0.z) * wg[5] + bflo(l0.w) * wg[6] + bfhi(l0.w) * wg[7]
                               + bflo(l1.x) * wg[8] + bfhi(l1.x) * wg[9] + bflo(l1.y) * wg[10] + bfhi(l1.y) * wg[11] + bflo(l1.z) * wg[12] + bfhi(l1.z) * wg[13] + bflo(l1.w) * wg[14] + bfhi(l1.w) * wg[15];
                const float ls = fminf(x, 0.f) - __logf(1.f + __expf(-fabsf(x)));
                run += (c > 0 || i >= 48) ? ls * (1.f / 16.f) : 0.f; cl[t] = run; }
            seg[sg * 128 + ch] = run;
            __syncthreads();
            float off = 0.f;
#pragma unroll
            for (int s2 = 0; s2 < 3; ++s2) off += s2 < sg ? seg[s2 * 128 + ch] : 0.f;
            if (sg == 3) ((float*)(a.ws + WS_GD))[(size_t)(blk0 + (ch >> 5)) * 32 + (ch & 31)] = __expf(off + run);
#pragma unroll
            for (int t = 0; t < 16; ++t) { const int i = 16 * sg + t; const float cum = cl[t] + off;
                S[i * SST + ch] = (bf16)f2bf(bf2f(S[i * SST + ch]) * 0.17677669529663687f * __expf(cum)); S[i * SST + 128 + ch] = (bf16)f2bf(bf2f(S[i * SST + 128 + ch]) * __expf(-cum)); } }
        __syncthreads();
        for (int idx = tid; idx < 1024; idx += 512) { const int d8 = idx & 3, i = (idx >> 2) & 63, h = idx >> 8;
            *(v4u*)(a.ws + B_GQ + (size_t)(blk0 + h) * GQ_T + i * 80 + 16 * d8) = *(const LAS v4u*)(S + i * SST + h * 32 + 8 * d8);
            *(v4u*)(a.ws + B_GK + (size_t)(blk0 + h) * GQ_T + i * 80 + 16 * d8) = *(const LAS v4u*)(S + i * SST + 128 + h * 32 + 8 * d8); }
    } else if (part == 1) {
        constexpr int SST = 776;
        stage_cols(proj, b, c, C_RQ, 256, S, SST, 0, tid); stage_cols(proj, b, c, C_RK, 256, S, SST, 256, tid);
        LAS f32x4* tabL = (LAS f32x4*)(lds + 64 * SST * 2);
        for (int idx = tid; idx < 64 * 16; idx += 512) tabL[idx] = ((const f32x4*)(a.ws + WS_TABR))[(size_t)(64 * c) * 16 + idx];
        __syncthreads();
        const LAS f32x2* tabR = (const LAS f32x2*)tabL;
        for (int idx = tid; idx < 64 * 4 * 32; idx += 512) { const int j = idx & 31, h = (idx >> 5) & 3, i = idx >> 7; const f32x2 cs = tabR[i * 32 + j];
            LAS bf16* qp = S + i * SST + h * 64 + j; LAS bf16* kp = qp + 256;
            const float a1 = bf2f(qp[0]), a2 = bf2f(qp[32]), b1 = bf2f(kp[0]), b2 = bf2f(kp[32]);
            const float e = (float)(i + 1) * lg2gamma(h); const float fq = __builtin_amdgcn_exp2f(e), fk = 0.125f * __builtin_amdgcn_exp2f(-e);
            qp[0] = (bf16)f2bf((a1 * cs[0] - a2 * cs[1]) * fq); qp[32] = (bf16)f2bf((a1 * cs[1] + a2 * cs[0]) * fq); kp[0] = (bf16)f2bf((b1 * cs[0] - b2 * cs[1]) * fk); kp[32] = (bf16)f2bf((b1 * cs[1] + b2 * cs[0]) * fk); }
        __syncthreads();
        for (int idx = tid; idx < 2048; idx += 512) { const int d8 = idx & 7, i = (idx >> 3) & 63, h = idx >> 9;
            *(v4u*)(a.ws + B_RQ + (size_t)(blk0 + h) * RT_T + i * 144 + 16 * d8) = *(const LAS v4u*)(S + i * SST + h * 64 + 8 * d8);
            *(v4u*)(a.ws + B_RK + (size_t)(blk0 + h) * RT_T + i * 144 + 16 * d8) = *(const LAS v4u*)(S + i * SST + 256 + h * 64 + 8 * d8); }
    } else if (part == 2) {
        constexpr int SST = 296, OFF_RSD = 64 * SST * 2, OFF_TAB = OFF_RSD + 512, OFF_QS = OFF_TAB + 8192, QSS = 392;
        LAS float* rsd = (LAS float*)(lds + OFF_RSD); LAS f32x4* tabL = (LAS f32x4*)(lds + OFF_TAB); LAS bf16* Qs = (LAS bf16*)(lds + OFF_QS);
        stage_cols(proj, b, c, C_CQ, 192, S, SST, 0, tid); stage_cols(proj, b, c, C_CKV, 64, S, SST, 192, tid); stage_cols(proj, b, c, C_KPE, 32, S, SST, 256, tid);
        for (int idx = tid; idx < 64 * 8; idx += 512) tabL[idx] = ((const f32x4*)(a.ws + WS_TABM))[(size_t)(64 * c) * 8 + idx];
        __syncthreads();
        { const int i = tid >> 3, g = tid & 7; float sq = 0.f, sk = 0.f;
#pragma unroll
            for (int t = 0; t < 24; ++t) { const float v = bf2f(S[i * SST + g * 24 + t]); sq += v * v; }
#pragma unroll
            for (int t = 0; t < 8; ++t) { const float v = bf2f(S[i * SST + 192 + g * 8 + t]); sk += v * v; }
            sq += __shfl_xor(sq, 1); sq += __shfl_xor(sq, 2); sq += __shfl_xor(sq, 4); sk += __shfl_xor(sk, 1); sk += __shfl_xor(sk, 2); sk += __shfl_xor(sk, 4);
            if (g == 0) { rsd[i * 2] = __builtin_amdgcn_rsqf(sq * (1.f / 192.f) + EPS); rsd[i * 2 + 1] = __builtin_amdgcn_rsqf(sk * (1.f / 64.f) + EPS); } }
        __syncthreads();
        const LAS f32x2* tabM = (const LAS f32x2*)tabL; const float QS = 0.10206207261596577f * LOG2E;
        {
            const int lane = tid & 63, w = __builtin_amdgcn_readfirstlane(tid >> 6), r32 = lane & 31, hi = lane >> 5, ib = w & 1, nb0 = (w >> 1) * 3;
            const bf16* WqaT = (const bf16*)(a.ws + WS_WQA + li * WQA_BYTES);
            s16x8 af[12];
#pragma unroll
            for (int ks = 0; ks < 12; ++ks) af[ks] = *(const LAS s16x8*)(S + (32 * ib + r32) * SST + 16 * ks + 8 * hi);
            f32x16 acc[3];
#pragma unroll
            for (int j = 0; j < 3; ++j) { acc[j] = (f32x16){};
                s16x8 bfr[12];
#pragma unroll
                for (int ks = 0; ks < 12; ++ks) bfr[ks] = *(const s16x8*)(WqaT + (size_t)(32 * (nb0 + j) + r32) * 192 + 16 * ks + 8 * hi);
#pragma unroll
                for (int ks = 0; ks < 12; ++ks) acc[j] = __builtin_amdgcn_mfma_f32_32x32x16_bf16(af[ks], bfr[ks], acc[j], 0, 0, 0); }
            asm volatile("s_nop 15\n\ts_nop 7" : "+v"(acc[0]), "+v"(acc[1]), "+v"(acc[2]));
#pragma unroll
            for (int j = 0; j < 3; ++j)
#pragma unroll
                for (int r = 0; r < 16; ++r) { const int i = 32 * ib + crow(r, hi); float v = acc[j][r] * (rsd[i * 2] * QS);
                    if (j == 2) { const float o = __shfl_xor(v, 16); const f32x2 cs = tabM[i * 16 + (r32 & 15)]; v = r32 < 16 ? v * cs[0] - o * cs[1] : o * cs[1] + v * cs[0]; }
                    Qs[i * QSS + 32 * (nb0 + j) + r32] = (bf16)f2bf(v); } }
        for (int idx = tid; idx < 64 * 12; idx += 512) { const int k8 = idx % 12, i = idx / 12; float y[8];
            if (k8 < 8) { const float s = rsd[i * 2 + 1];
#pragma unroll
                for (int t = 0; t < 8; ++t) y[t] = bf2f(S[i * SST + 192 + 8 * k8 + t]) * s; }
            else { const int kk = (k8 - 8) & 1, second = (k8 - 8) >> 1;
#pragma unroll
                for (int t = 0; t < 8; ++t) { const int j = 8 * kk + t; const f32x2 cs = tabM[i * 16 + j]; const float x1 = bf2f(S[i * SST + 256 + j]), x2 = bf2f(S[i * SST + 272 + j]); y[t] = second ? x1 * cs[1] + x2 * cs[0] : x1 * cs[0] - x2 * cs[1]; } }
            v4u w; w.x = pk2(y[0], y[1]); w.y = pk2(y[2], y[3]); w.z = pk2(y[4], y[5]); w.w = pk2(y[6], y[7]);
            *(v4u*)((bf16*)(a.ws + B_MK) + (prow0 + i) * 96 + 8 * k8) = w; }
        __syncthreads();
        for (int idx = tid; idx < 64 * 48; idx += 512) { const int c8 = idx % 48, i = idx / 48;
            *(v4u*)((bf16*)(a.ws + B_MQ) + (prow0 + i) * 384 + 8 * c8) = *(const LAS v4u*)(Qs + i * QSS + 8 * c8); }
    }
}

template <int KIND>
__device__ __forceinline__ void attn_mfma_unit(const Args& a, int li, int b, int hh, int qb  , LAS unsigned char* lds, int tid, float lam, float oscale) {
    constexpr int KW = KIND ? 64 : 96, KST = KW + 8, VST = 72, NMAP = KIND ? 2 : 1, DSTEPS = KIND ? 2 : 6;
    constexpr int KCH = KW / 8 + 1, NPIECE = KCH + (KIND ? 9 : 0), PPW = KIND ? 3 : 2, SLOT = NPIECE * 1024, NSLOT = 4, OFF_JUNK = NSLOT * SLOT, OFF_WS = OFF_JUNK + 6144, OSTW = 68, OFF_OST = KIND ? 0   : OFF_WS + 2048;
    static_assert(PPW * 8 >= NPIECE && PPW * 8 - NPIECE <= 6 && (KIND ? 8 * 32 * OSTW * 4 <= NSLOT * SLOT : OFF_OST + 8 * 32 * OSTW * 4 <= RING_BYTES) && OFF_WS + 8 * 256 <= RING_BYTES, "attention LDS map / pieces per wave");
    const int lane = tid & 63, w = __builtin_amdgcn_readfirstlane(tid >> 6), r32 = lane & 31, hi = lane >> 5;
    const int q0 = qb < 0 ? 0 : 64 + 256 * qb, NT = qb < 0 ? 1 : 5 + 4 * qb;
    const bool wact = qb >= 0 || w < 2;
    const int qpos = q0 + 32 * w + r32, wlast = (q0 + 32 * w + 31) >> 6;
    const size_t prow = (size_t)b * PSEQ + qpos;
    const bf16* proj = (const bf16*)(a.ws + B_PROJ);
    const bf16* Kg = KIND ? proj + C_DK + hh * 64 : (const bf16*)(a.ws + B_MK) + (size_t)b * PSEQ * 96;
    constexpr int KLD = KIND ? N1 : 96;
    const bf16* Vg = proj + C_DV + hh * 64;
#define ATT_SRCROW(t_, r_) (KIND ? ((t_) == 0 ? ((r_) < 48 ? MR : MR + (r_) - 48) : b * TT + 64 * ((t_) - 1) + (r_)) : 64 * (t_) + (r_))
    LAS float* wsf = (LAS float*)(lds + OFF_WS) + w * 64;
    LAS float* ost = (LAS float*)(lds + OFF_OST) + w * (32 * OSTW);
    s16x8 qf[NMAP][DSTEPS];
#pragma unroll
    for (int m = 0; m < NMAP; ++m)
#pragma unroll
        for (int ds = 0; ds < DSTEPS; ++ds) {
            const int qsr = qb >= 0 ? b * TT + qpos - 64 : (qpos >= 48 ? MR + qpos - 48 : MR);
            const bf16* qp = KIND ? proj + (size_t)qsr * N1 + C_DQ + hh * 64 + 32 * m + 16 * ds + 8 * hi : (const bf16*)(a.ws + B_MQ) + prow * 384 + hh * 96 + 16 * ds + 8 * hi;
            v4u qw = wact ? *(const v4u*)qp : (v4u){0u, 0u, 0u, 0u};
            if (KIND) { const float qs = 0.17677669529663687f * LOG2E;
                qw.x = pg8::cvt_pk_bf16(bflo(qw.x) * qs, bfhi(qw.x) * qs); qw.y = pg8::cvt_pk_bf16(bflo(qw.y) * qs, bfhi(qw.y) * qs); qw.z = pg8::cvt_pk_bf16(bflo(qw.z) * qs, bfhi(qw.z) * qs); qw.w = pg8::cvt_pk_bf16(bflo(qw.w) * qs, bfhi(qw.w) * qs); }
            qf[m][ds] = __builtin_bit_cast(s16x8, qw); }
    float mref[NMAP], lrun[NMAP]; f32x16 negm = (f32x16){}, o[NMAP][2];
#pragma unroll
    for (int m = 0; m < NMAP; ++m) { mref[m] = 0.f; lrun[m] = 0.f; o[m][0] = (f32x16){}; o[m][1] = (f32x16){}; }
#define ATT_DMA(t_) do { const int sl_ = ((t_) & 3) * SLOT; _Pragma("unroll") for (int j = 0; j < PPW; ++j) { const int p_ = __builtin_amdgcn_readfirstlane(w * PPW + j); \
        int row_, col_, dst_; const bf16* base_; int ld_; \
        if (p_ < KCH) { const int g = 64 * p_ + lane, cc = g % KCH; row_ = g / KCH; col_ = (cc < KCH - 1 ? cc : KCH - 2) * 8; dst_ = sl_ + p_ * 1024; base_ = Kg; ld_ = KLD; } \
        else if (p_ < NPIECE) { const int g = 64 * (p_ - KCH) + lane, cc = g % 9; row_ = g / 9; col_ = (cc < 8 ? cc : 7) * 8; dst_ = sl_ + p_ * 1024; base_ = Vg; ld_ = N1; } \
        else { row_ = lane & 15; col_ = 0; dst_ = OFF_JUNK + (p_ - NPIECE) * 1024; base_ = Kg; ld_ = KLD; } \
        const bf16* s_ = base_ + (size_t)ATT_SRCROW((t_), row_) * ld_ + col_; \
        __builtin_amdgcn_global_load_lds((const unsigned*)s_, (LAS unsigned*)(lds + __builtin_amdgcn_readfirstlane(dst_)), 16, 0, 0); } } while (0)
#define ATT_BAR() do { asm volatile("s_waitcnt lgkmcnt(0)" ::: "memory"); __builtin_amdgcn_s_barrier(); asm volatile("" ::: "memory"); } while (0)
    ATT_BAR();
    if (w >= 4) __builtin_amdgcn_s_setprio(1);
    ATT_DMA(0); if (NT > 1) ATT_DMA(1); if (NT > 2) ATT_DMA(2);
    for (int t = 0; t < NT; ++t) {
        if (t + 2 < NT) { if (KIND) asm volatile("s_waitcnt vmcnt(6)" ::: "memory"); else asm volatile("s_waitcnt vmcnt(4)" ::: "memory"); } else if (t + 1 < NT) { if (KIND) asm volatile("s_waitcnt vmcnt(3)" ::: "memory"); else asm volatile("s_waitcnt vmcnt(2)" ::: "memory"); } else asm volatile("s_waitcnt vmcnt(0)" ::: "memory");
        ATT_BAR();
        if (t + 3 < NT) ATT_DMA(t + 3);
        if (wact && t <= wlast) {
            const LAS unsigned char* Kb = lds + (t & 3) * SLOT; const LAS unsigned char* Vb = KIND ? Kb + KCH * 1024 : Kb;
            const bool need_mask = (t == 0) || (64 * t + 63 > q0 + 32 * w);
            constexpr int VRB = KIND ? 144 : KST * 2;
            const LAS unsigned char* vp0 = Vb + (4 * hi + ((lane & 15) >> 2)) * VRB + (16 * ((lane >> 4) & 1)) * 2 + 8 * (lane & 3);
#define ATT_VFRAG(d0_, ks_) ({ const LAS unsigned char* vp_ = vp0 + 16 * (ks_) * VRB + 64 * (d0_); \
        const s16x4 va_ = __builtin_bit_cast(s16x4, __builtin_amdgcn_ds_read_tr16_b64_v4i16((LAS v4i16_t*)vp_)), vb_ = __builtin_bit_cast(s16x4, __builtin_amdgcn_ds_read_tr16_b64_v4i16((LAS v4i16_t*)(vp_ + 8 * VRB))); \
        (s16x8){va_[0], va_[1], va_[2], va_[3], vb_[0], vb_[1], vb_[2], vb_[3]}; })
            s16x8 vfr0[4];
#pragma unroll
            for (int ks = 0; ks < 4; ++ks) vfr0[ks] = ATT_VFRAG(0, ks);
            __builtin_amdgcn_sched_barrier(0);
#pragma unroll
            for (int m = 0; m < NMAP; ++m) {
                f32x16 p0, p1;
                if (KIND) { const float nm = -mref[m];
#pragma unroll
                    for (int r = 0; r < 16; ++r) { p0[r] = nm; p1[r] = nm; } }
                else { p0 = negm; p1 = negm; }
                constexpr int KBATCH = KIND ? DSTEPS : 3;
#pragma unroll
                for (int d1 = 0; d1 < DSTEPS; d1 += KBATCH) {
                    s16x8 kfr[KBATCH][2];
#pragma unroll
                    for (int ds = 0; ds < KBATCH; ++ds) { kfr[ds][0] = *(const LAS s16x8*)(Kb + (r32 * KST + 32 * m * KIND + 16 * (d1 + ds) + 8 * hi) * 2); kfr[ds][1] = *(const LAS s16x8*)(Kb + ((32 + r32) * KST + 32 * m * KIND + 16 * (d1 + ds) + 8 * hi) * 2); }
                    __builtin_amdgcn_sched_barrier(0);

#pragma unroll
                    for (int ds = 0; ds < KBATCH; ++ds) { p0 = __builtin_amdgcn_mfma_f32_32x32x16_bf16(kfr[ds][0], qf[m][d1 + ds], p0, 0, 0, 0); p1 = __builtin_amdgcn_mfma_f32_32x32x16_bf16(kfr[ds][1], qf[m][d1 + ds], p1, 0, 0, 0); }

                    __builtin_amdgcn_sched_barrier(0); }
                asm volatile("s_nop 15\n\ts_nop 7" : "+v"(p0), "+v"(p1));

                if (need_mask) {
#pragma unroll
                    for (int r = 0; r < 16; ++r) { const int kv = 64 * t + crow(r, hi);
                        if (kv > qpos || kv < 48) p0[r] = -1e30f;
                        if (kv + 32 > qpos || kv + 32 < 48) p1[r] = -1e30f; } }
                float mx = fmaxf(fmaxf(p0[0], p1[0]), fmaxf(p0[1], p1[1]));
#pragma unroll
                for (int r = 2; r < 16; r += 2) mx = fmaxf(mx, fmaxf(fmaxf(p0[r], p1[r]), fmaxf(p0[r + 1], p1[r + 1])));
                { auto rr = __builtin_amdgcn_permlane32_swap(__float_as_uint(mx), __float_as_uint(mx), false, false); mx = fmaxf(__uint_as_float(rr[0]), __uint_as_float(rr[1])); }
                if (t == 0 || __any(mx > 6.0f)) {
                    const float delta = t == 0 ? mx : fmaxf(mx, 0.f); mref[m] += delta;
#pragma unroll
                    for (int r = 0; r < 16; ++r) { p0[r] -= delta; p1[r] -= delta; if (!KIND) negm[r] = -mref[m]; }
                    if (t != 0) { const float alpha = __builtin_amdgcn_exp2f(-delta); lrun[m] *= alpha;
                        if (hi == 0) wsf[r32] = alpha;
                        f32x4 al[4];
#pragma unroll
                        for (int g = 0; g < 4; ++g) al[g] = *(const LAS f32x4*)(wsf + 8 * g + 4 * hi);
#pragma unroll
                        for (int r = 0; r < 16; ++r) { o[m][0][r] *= al[r >> 2][r & 3]; o[m][1][r] *= al[r >> 2][r & 3]; } } }
                float ls = 0.f;
#pragma unroll
                for (int r = 0; r < 16; ++r) { p0[r] = __builtin_amdgcn_exp2f(p0[r]); p1[r] = __builtin_amdgcn_exp2f(p1[r]); ls += p0[r] + p1[r]; }
                lrun[m] += ls;
                s16x8 pw[4];
#pragma unroll
                for (int ks = 0; ks < 4; ++ks) { v4u u;
                    if (ks < 2) { u.x = pg8::cvt_pk_bf16(p0[8 * ks], p0[8 * ks + 1]); u.y = pg8::cvt_pk_bf16(p0[8 * ks + 2], p0[8 * ks + 3]); u.z = pg8::cvt_pk_bf16(p0[8 * ks + 4], p0[8 * ks + 5]); u.w = pg8::cvt_pk_bf16(p0[8 * ks + 6], p0[8 * ks + 7]); }
                    else { const int k2 = ks - 2; u.x = pg8::cvt_pk_bf16(p1[8 * k2], p1[8 * k2 + 1]); u.y = pg8::cvt_pk_bf16(p1[8 * k2 + 2], p1[8 * k2 + 3]); u.z = pg8::cvt_pk_bf16(p1[8 * k2 + 4], p1[8 * k2 + 5]); u.w = pg8::cvt_pk_bf16(p1[8 * k2 + 6], p1[8 * k2 + 7]); }
                    pw[ks] = __builtin_bit_cast(s16x8, u); }

#pragma unroll
                for (int ks = 0; ks < 4; ++ks) o[m][0] = __builtin_amdgcn_mfma_f32_32x32x16_bf16(pw[ks], vfr0[ks], o[m][0], 0, 0, 0);

                { s16x8 vfr1[4];
#pragma unroll
                    for (int ks = 0; ks < 4; ++ks) vfr1[ks] = ATT_VFRAG(1, ks);
                    __builtin_amdgcn_sched_barrier(0);

#pragma unroll
                    for (int ks = 0; ks < 4; ++ks) o[m][1] = __builtin_amdgcn_mfma_f32_32x32x16_bf16(pw[ks], vfr1[ks], o[m][1], 0, 0, 0); }

            }
        }
    }
#undef ATT_DMA
#undef ATT_VFRAG
#undef ATT_SRCROW
    __builtin_amdgcn_s_setprio(0);
    ATT_BAR();
    if (KIND) { const LAS float* lp = (const LAS float*)(lds + RING_BYTES + 256); lam = lp[0]; oscale = lp[1]; }
    if (wact) {
#pragma unroll
        for (int m = 0; m < NMAP; ++m) asm volatile("s_nop 15\n\ts_nop 7" : "+v"(o[m][0]), "+v"(o[m][1]));
        float il0, il1 = 0.f;
        { float l = lrun[0]; l += __shfl_xor(l, 32); il0 = l > 0.f ? 1.f / l : 0.f; }
        if (KIND) { float l = lrun[NMAP - 1]; l += __shfl_xor(l, 32); il1 = l > 0.f ? lam / l : 0.f; }
        if (hi == 0) { wsf[r32] = il0; wsf[32 + r32] = il1; }
        f32x4 a0[4], a1[4];
#pragma unroll
        for (int g = 0; g < 4; ++g) { a0[g] = *(const LAS f32x4*)(wsf + 8 * g + 4 * hi); a1[g] = *(const LAS f32x4*)(wsf + 32 + 8 * g + 4 * hi); }
#pragma unroll
        for (int d0 = 0; d0 < 2; ++d0)
#pragma unroll
            for (int r = 0; r < 16; ++r) { float v = o[0][d0][r] * a0[r >> 2][r & 3]; if (KIND) v -= o[NMAP - 1][d0][r] * a1[r >> 2][r & 3];
                ost[crow(r, hi) * OSTW + 32 * d0 + r32] = v; }
        const int row = lane >> 1, half = lane & 1, p = q0 + 32 * w + row;
        f32x4 v[8]; float ss = 0.f;
#pragma unroll
        for (int i = 0; i < 8; ++i) { v[i] = *(const LAS f32x4*)(ost + row * OSTW + 32 * half + 4 * i); ss += (v[i][0] * v[i][0] + v[i][1] * v[i][1]) + (v[i][2] * v[i][2] + v[i][3] * v[i][3]); }
        ss += __shfl_xor(ss, 1);
        const float rs = KIND ? __builtin_amdgcn_rsqf(ss * (1.f / 64.f) + EPS) * oscale : 1.f;
        const int sr = qb >= 0 ? b * TT + p - 64 : ((p >= 48 && b == 0) ? MR + p - 48 : -1);
        if (sr >= 0) { bf16* dst = (bf16*)a.out + (size_t)sr * DM + (KIND ? 768 : 512) + hh * 64 + 32 * half; const float* gn = ain(a, I_DNORM) + li * 64 + 32 * half;
#pragma unroll
            for (int i = 0; i < 4; ++i) { f32x4 x0 = v[2 * i] * rs, x1 = v[2 * i + 1] * rs;
                if (KIND) { const f32x4 g0 = *(const f32x4*)(gn + 8 * i), g1 = *(const f32x4*)(gn + 8 * i + 4); x0 = x0 * g0; x1 = x1 * g1; }
                *(v4u*)(dst + 8 * i) = pack8(x0, x1); } }
    }
    ATT_BAR();
#undef ATT_BAR
}

__device__ __forceinline__ s16x8 ldperm(const bf16* p, int hi) { const s16x4 x = *(const s16x4*)(p + 4 * hi), y = *(const s16x4*)(p + 8 + 4 * hi); return (s16x8){x[0], x[1], x[2], x[3], y[0], y[1], y[2], y[3]}; }
__device__ __forceinline__ s16x8 packacc(const f32x16& v, int k) { v4u u; u.x = pg8::cvt_pk_bf16(v[8 * k], v[8 * k + 1]); u.y = pg8::cvt_pk_bf16(v[8 * k + 2], v[8 * k + 3]); u.z = pg8::cvt_pk_bf16(v[8 * k + 4], v[8 * k + 5]); u.w = pg8::cvt_pk_bf16(v[8 * k + 6], v[8 * k + 7]); return __builtin_bit_cast(s16x8, u); }
__device__ __forceinline__ s16x8 ldperm_lds(const LAS unsigned char* p, int hi) { const s16x4 x = *(const LAS s16x4*)(p + 8 * hi), y = *(const LAS s16x4*)(p + 16 + 8 * hi); return (s16x8){x[0], x[1], x[2], x[3], y[0], y[1], y[2], y[3]}; }
template <int KIND>
__device__ __forceinline__ void lin_mfma_unit(const Args& a, int li, int b, int hp, LAS unsigned char* lds, int tid) {
    constexpr int DK = KIND ? 64 : 32, NDS = DK / 16, NDB = DK / 32, OTW = 68;
    constexpr int QROW = KIND ? 144 : 80, QT = KIND ? RT_T : GQ_T, HB = 2 * QT + VT_T, PPH = HB / 1024, NP = 2 * PPH;
    constexpr int OFF_OT = 2 * HB, OFF_G = OFF_OT + 2 * 64 * OTW * 4;
    static_assert(HB % 1024 == 0 && OFF_G + 256 <= RING_BYTES, "lin unit LDS map");
    const int lane = tid & 63, w = __builtin_amdgcn_readfirstlane(tid >> 6), r32 = lane & 31, hi = lane >> 5, hl = w >> 2, e0 = 32 * ((w >> 1) & 1), ib = w & 1, h = 2 * hp + hl;
    const unsigned char* Qg = a.ws + (KIND ? B_RQ : B_GQ); const unsigned char* Kg = a.ws + (KIND ? B_RK : B_GK);
    const bf16* proj = (const bf16*)(a.ws + B_PROJ); bf16* ob = (bf16*)a.out;
    LAS float* Ot = (LAS float*)(lds + OFF_OT);
    LAS float* Gs = (LAS float*)(lds + OFF_G);
    const LAS unsigned char* Lh = lds + hl * HB;
    const float dret = __builtin_amdgcn_exp2f(64.f * lg2gamma(h));
    f32x16 S[NDB];
#pragma unroll
    for (int db = 0; db < NDB; ++db) S[db] = (f32x16){};
#define LIN_DMA(c_) do { _Pragma("unroll") for (int j_ = 0; j_ < (NP + 7) / 8; ++j_) { const int p_ = w + 8 * j_; if (p_ < NP) { const int hl_ = p_ / PPH, pp_ = p_ % PPH; const size_t blk_ = (size_t)(b * NCH + (c_)) * 4 + 2 * hp + hl_; \
        const unsigned char* src_; \
        if (pp_ < 2 * QT / 1024) src_ = (pp_ < QT / 1024 ? Qg + blk_ * QT + pp_ * 1024 : Kg + blk_ * QT + (pp_ - QT / 1024) * 1024) + lane * 16; \
        else { const int g_ = 64 * (pp_ - 2 * QT / 1024) + lane, s_ = g_ / 9, cc_ = g_ % 9; int sr_ = src_row(b, (c_), s_); sr_ = sr_ < 0 ? MR : sr_;     \
            src_ = (const unsigned char*)(proj + (size_t)sr_ * N1 + (KIND ? C_RV : C_AV) + (2 * hp + hl_) * 64 + (cc_ < 8 ? cc_ : 7) * 8); } \
        __builtin_amdgcn_global_load_lds((const unsigned*)src_, (LAS unsigned*)(lds + hl_ * HB + pp_ * 1024), 16, 0, 0); } } } while (0)
#define LIN_BAR() do { asm volatile("s_waitcnt lgkmcnt(0)" ::: "memory"); __builtin_amdgcn_s_barrier(); asm volatile("" ::: "memory"); } while (0)
    LIN_BAR();
    if (tid < 64) Gs[tid] = ain(a, KIND ? I_RNORM : I_GNORM)[li * 64 + tid];
    LIN_DMA(0);
    const int nh = tid >> 8, nrow = (tid >> 2) & 63, nq = tid & 3, hn = 2 * hp + nh;
    for (int c = 0; c < NCH; ++c) {
        asm volatile("s_waitcnt vmcnt(0)" ::: "memory"); LIN_BAR();
        s16x8 qf[NDS], kf0[NDS], kf1[NDS], vf[4], ktf[NDB][4];
        const int sr = src_row(b, c, nrow); const bool wr = sr >= 0 && (c > 0 || b == 0);
#pragma unroll
        for (int ds = 0; ds < NDS; ++ds) { qf[ds] = ldperm_lds(Lh + (32 * ib + r32) * QROW + 32 * ds, hi); kf0[ds] = ldperm_lds(Lh + QT + r32 * QROW + 32 * ds, hi); kf1[ds] = ldperm_lds(Lh + QT + (32 + r32) * QROW + 32 * ds, hi); }
        const int trq = (lane & 15) >> 2, trb = (lane >> 4) & 1, trp = lane & 3;
#pragma unroll
        for (int ks = 0; ks < 4; ++ks) { const LAS unsigned char* vp = Lh + 2 * QT + (16 * ks + 4 * hi + trq) * 144 + (e0 + 16 * trb) * 2 + 8 * trp;
            const s16x4 va = __builtin_bit_cast(s16x4, __builtin_amdgcn_ds_read_tr16_b64_v4i16((LAS v4i16_t*)vp)), vb = __builtin_bit_cast(s16x4, __builtin_amdgcn_ds_read_tr16_b64_v4i16((LAS v4i16_t*)(vp + 8 * 144)));
            vf[ks] = (s16x8){va[0], va[1], va[2], va[3], vb[0], vb[1], vb[2], vb[3]}; }
        f32x16 aA = (f32x16){}, aB = (f32x16){};
#pragma unroll
        for (int ds = 0; ds < NDS; ++ds) { aA = __builtin_amdgcn_mfma_f32_32x32x16_bf16(kf0[ds], qf[ds], aA, 0, 0, 0); if (ib) aB = __builtin_amdgcn_mfma_f32_32x32x16_bf16(kf1[ds], qf[ds], aB, 0, 0, 0); }
        asm volatile("s_nop 15\n\ts_nop 15" : "+v"(aA), "+v"(aB));
#pragma unroll
        for (int r = 0; r < 16; ++r) if (crow(r, hi) > r32) { if (ib) aB[r] = 0.f; else aA[r] = 0.f; }
        f32x16 O = (f32x16){};
#pragma unroll
        for (int db = 0; db < NDB; ++db)
#pragma unroll
            for (int ksub = 0; ksub < 2; ++ksub) O = __builtin_amdgcn_mfma_f32_32x32x16_bf16(qf[2 * db + ksub], packacc(S[db], ksub), O, 0, 0, 0);
#pragma unroll
        for (int ksub = 0; ksub < 2; ++ksub) { O = __builtin_amdgcn_mfma_f32_32x32x16_bf16(packacc(aA, ksub), vf[ksub], O, 0, 0, 0); if (ib) O = __builtin_amdgcn_mfma_f32_32x32x16_bf16(packacc(aB, ksub), vf[2 + ksub], O, 0, 0, 0); }
#pragma unroll
        for (int db = 0; db < NDB; ++db)
#pragma unroll
            for (int ks = 0; ks < 4; ++ks) { const LAS unsigned char* kp = Lh + QT + (16 * ks + 4 * hi + trq) * QROW + (32 * db + 16 * trb) * 2 + 8 * trp;
                const s16x4 ka = __builtin_bit_cast(s16x4, __builtin_amdgcn_ds_read_tr16_b64_v4i16((LAS v4i16_t*)kp)), kb = __builtin_bit_cast(s16x4, __builtin_amdgcn_ds_read_tr16_b64_v4i16((LAS v4i16_t*)(kp + 8 * QROW)));
                ktf[db][ks] = (s16x8){ka[0], ka[1], ka[2], ka[3], kb[0], kb[1], kb[2], kb[3]}; }
        LIN_BAR();
        v4u og[2];
#pragma unroll
        for (int i = 0; i < 2; ++i) og[i] = wr ? *(const v4u*)(proj + (size_t)sr * N1 + (KIND ? C_ROG : C_AOG) + hn * 64 + 16 * nq + 8 * i) : (v4u){0u, 0u, 0u, 0u};
        f32x4 dvv[4];
        if (!KIND) { const float* dp = (const float*)(a.ws + WS_GD) + ((size_t)(b * NCH + c) * 4 + h) * 32;
#pragma unroll
            for (int g = 0; g < 4; ++g) dvv[g] = *(const f32x4*)(dp + 8 * g + 4 * hi); }
        if (c + 1 < NCH) LIN_DMA(c + 1);
#pragma unroll
        for (int db = 0; db < NDB; ++db) {
#pragma unroll
            for (int ks = 0; ks < 4; ++ks) S[db] = __builtin_amdgcn_mfma_f32_32x32x16_bf16(ktf[db][ks], vf[ks], S[db], 0, 0, 0); }
        asm volatile("s_nop 15\n\ts_nop 15" : "+v"(O));
#pragma unroll
        for (int db = 0; db < NDB; ++db) asm volatile("s_nop 15\n\ts_nop 15" : "+v"(S[db]));
#pragma unroll
        for (int db = 0; db < NDB; ++db) {
            if (KIND) { S[db] = S[db] * dret; }
            else {
#pragma unroll
                for (int g = 0; g < 4; ++g) { S[db][4 * g] *= dvv[g][0]; S[db][4 * g + 1] *= dvv[g][1]; S[db][4 * g + 2] *= dvv[g][2]; S[db][4 * g + 3] *= dvv[g][3]; } } }
#pragma unroll
        for (int r = 0; r < 16; ++r) Ot[(hl * 64 + 32 * ib + crow(r, hi)) * OTW + e0 + r32] = O[r];
        LIN_BAR();
        { f32x4 v[4]; float s1 = 0.f;
#pragma unroll
            for (int i = 0; i < 4; ++i) { v[i] = *(const LAS f32x4*)(Ot + (nh * 64 + nrow) * OTW + 16 * nq + 4 * i); s1 += (v[i][0] + v[i][1]) + (v[i][2] + v[i][3]); }
            float mean = 0.f; if (KIND) { s1 += __shfl_xor(s1, 1); s1 += __shfl_xor(s1, 2); mean = s1 * (1.f / 64.f); }
            float s2 = 0.f;
#pragma unroll
            for (int i = 0; i < 4; ++i) { v[i] = v[i] - mean; s2 += (v[i][0] * v[i][0] + v[i][1] * v[i][1]) + (v[i][2] * v[i][2] + v[i][3] * v[i][3]); }
            s2 += __shfl_xor(s2, 1); s2 += __shfl_xor(s2, 2);
            const float rs = __builtin_amdgcn_rsqf(s2 * (1.f / 64.f) + EPS);
            if (wr) { bf16* dst = ob + (size_t)sr * DM + KIND * 256 + hn * 64 + 16 * nq; const LAS float* gp = Gs + 16 * nq;
#pragma unroll
                for (int i = 0; i < 2; ++i) { const v4u g4 = og[i]; const f32x4 g0 = *(const LAS f32x4*)(gp + 8 * i), g1 = *(const LAS f32x4*)(gp + 8 * i + 4);
                    f32x4 x0 = v[2 * i] * rs * g0, x1 = v[2 * i + 1] * rs * g1;
                    x0[0] *= silu_f(bflo(g4.x)); x0[1] *= silu_f(bfhi(g4.x)); x0[2] *= silu_f(bflo(g4.y)); x0[3] *= silu_f(bfhi(g4.y)); x1[0] *= silu_f(bflo(g4.z)); x1[1] *= silu_f(bfhi(g4.z)); x1[2] *= silu_f(bflo(g4.w)); x1[3] *= silu_f(bfhi(g4.w));
                    *(v4u*)(dst + 8 * i) = pack8(x0, x1); } } }
        LIN_BAR();
    }
    asm volatile("s_waitcnt vmcnt(0)" ::: "memory");
#undef LIN_DMA
#undef LIN_BAR
}

template <int MODE, int KSTEPS  >
__device__ __forceinline__ void thin_unit(const bf16* A, int lda, const bf16* Bt, int u, bf16* H, float* stats_out, const float* stats_in, bf16* ACT, LAS unsigned char* lds, int tid) {
    constexpr int K = KSTEPS * 256;
    const int lane = tid & 63, w = __builtin_amdgcn_readfirstlane(tid >> 6), fr = lane & 15, fq = lane >> 4;
    int brow[4];
#pragma unroll
    for (int nb = 0; nb < 4; ++nb) brow[nb] = MODE != 1 ? 64 * u + 16 * nb + fr : 256 * (u >> 2) + 32 * (u & 3) + (nb >> 1) * 128 + 16 * (nb & 1) + fr;
    f32x4 acc[4];
#pragma unroll
    for (int nb = 0; nb < 4; ++nb) acc[nb] = (f32x4){0.f, 0.f, 0.f, 0.f};
    const bf16* ap = A + (size_t)fr * lda + w * (KSTEPS * 32) + 8 * fq;
    constexpr int B1 = KSTEPS > 6 ? 6 : KSTEPS;
    { s16x8 af[B1], bf[B1][4];
#pragma unroll
        for (int s = 0; s < B1; ++s) { af[s] = *(const s16x8*)(ap + 32 * s);
#pragma unroll
            for (int nb = 0; nb < 4; ++nb) bf[s][nb] = *(const s16x8*)(Bt + (size_t)brow[nb] * K + w * (KSTEPS * 32) + 32 * s + 8 * fq); }
#pragma unroll
        for (int s = 0; s < B1; ++s)
#pragma unroll
            for (int nb = 0; nb < 4; ++nb) acc[nb] = __builtin_amdgcn_mfma_f32_16x16x32_bf16(bf[s][nb], af[s], acc[nb], 0, 0, 0); }
    if (KSTEPS > B1) { constexpr int B2 = KSTEPS > B1 ? KSTEPS - B1 : 1; s16x8 af[B2], bf[B2][4];
#pragma unroll
        for (int s = 0; s < B2; ++s) { af[s] = *(const s16x8*)(ap + 32 * (B1 + s));
#pragma unroll
            for (int nb = 0; nb < 4; ++nb) bf[s][nb] = *(const s16x8*)(Bt + (size_t)brow[nb] * K + w * (KSTEPS * 32) + 32 * (B1 + s) + 8 * fq); }
#pragma unroll
        for (int s = 0; s < B2; ++s)
#pragma unroll
            for (int nb = 0; nb < 4; ++nb) acc[nb] = __builtin_amdgcn_mfma_f32_16x16x32_bf16(bf[s][nb], af[s], acc[nb], 0, 0, 0); }
    asm volatile("s_nop 15" : "+v"(acc[0]), "+v"(acc[1]), "+v"(acc[2]), "+v"(acc[3]));
    LAS f32x4* part = (LAS f32x4*)lds;
    __syncthreads();
#pragma unroll
    for (int nb = 0; nb < 4; ++nb) part[(w * 4 + nb) * 64 + lane] = acc[nb];
    __syncthreads();
    if (w == 0) {
#pragma unroll
        for (int nb = 0; nb < 4; ++nb) {
#pragma unroll
            for (int w2 = 1; w2 < 8; ++w2) acc[nb] = acc[nb] + part[(w2 * 4 + nb) * 64 + lane]; }
        const int row = MR + fr;
        if (MODE == 0) { float ss = 0.f;
#pragma unroll
            for (int nb = 0; nb < 4; ++nb) { bf16* p = H + (size_t)row * DM + 64 * u + 16 * nb + 4 * fq; const v2u wv = *(const v2u*)p;
                const float x0 = acc[nb][0] + bflo(wv.x), x1 = acc[nb][1] + bfhi(wv.x), x2 = acc[nb][2] + bflo(wv.y), x3 = acc[nb][3] + bfhi(wv.y);
                ss += (x0 * x0 + x1 * x1) + (x2 * x2 + x3 * x3);
                v2u o; o.x = pg8::cvt_pk_bf16(x0, x1); o.y = pg8::cvt_pk_bf16(x2, x3); *(v2u*)p = o; }
            ss += __shfl_xor(ss, 16); ss += __shfl_xor(ss, 32);
            if (fq == 0) stats_out[(size_t)row * 16 + u] = ss;
        } else if (MODE == 2) { const f32x4* sp = (const f32x4*)(stats_in + (size_t)row * 16); const f32x4 s0 = sp[0], s1 = sp[1], s2 = sp[2], s3 = sp[3];
            const float st = ((s0[0] + s0[1]) + (s0[2] + s0[3])) + ((s1[0] + s1[1]) + (s1[2] + s1[3])) + ((s2[0] + s2[1]) + (s2[2] + s2[3])) + ((s3[0] + s3[1]) + (s3[2] + s3[3]));
            const float rs = __builtin_amdgcn_rsqf(st * (1.f / 1024.f) + EPS);
#pragma unroll
            for (int nb = 0; nb < 4; ++nb) { v2u o; o.x = pg8::cvt_pk_bf16(acc[nb][0] * rs, acc[nb][1] * rs); o.y = pg8::cvt_pk_bf16(acc[nb][2] * rs, acc[nb][3] * rs);
                *(v2u*)(ACT + (size_t)row * N1 + 64 * u + 16 * nb + 4 * fq) = o; }
        } else { const f32x4* sp = (const f32x4*)(stats_in + (size_t)row * 16); const f32x4 s0 = sp[0], s1 = sp[1], s2 = sp[2], s3 = sp[3];
            const float st = ((s0[0] + s0[1]) + (s0[2] + s0[3])) + ((s1[0] + s1[1]) + (s1[2] + s1[3])) + ((s2[0] + s2[1]) + (s2[2] + s2[3])) + ((s3[0] + s3[1]) + (s3[2] + s3[3]));
            const float rs = __builtin_amdgcn_rsqf(st * (1.f / 1024.f) + EPS);
#pragma unroll
            for (int nb = 0; nb < 2; ++nb) { float y[4];
#pragma unroll
                for (int t = 0; t < 4; ++t) y[t] = silu_f(acc[nb][t] * rs) * (acc[2 + nb][t] * rs);
                v2u o; o.x = pg8::cvt_pk_bf16(y[0], y[1]); o.y = pg8::cvt_pk_bf16(y[2], y[3]);
                *(v2u*)(ACT + (size_t)row * DFF + 128 * (u >> 2) + 32 * (u & 3) + 16 * nb + 4 * fq) = o; } }
    }
    __syncthreads();
}

#ifndef REP_PREP
#define REP_PREP 1
#endif
#ifndef REP_MIX
#define REP_MIX 1
#endif
#ifndef REP_P0
#define REP_P0 1
#endif
#ifndef REP_CONV
#define REP_CONV 1
#endif
#ifndef REP_G1
#define REP_G1 1
#endif
#ifndef REP_MGU
#define REP_MGU 1
#endif
#ifndef REP_MDN
#define REP_MDN 1
#endif
#ifndef REP_BAR
#define REP_BAR 0
#endif
#ifndef REP_PART
#define REP_PART -1
#endif
#ifndef REP_FGU
#define REP_FGU 1
#endif
#ifndef MK_ONE_LAUNCH
#define MK_ONE_LAUNCH 1
#endif
constexpr int NPHASE = 18;
constexpr int CW_Q = 12288;
__global__ void __launch_bounds__(512, 2) mega_fwd(Args a) {
    extern __shared__ __attribute__((aligned(16))) unsigned char lds_raw[];
    LAS unsigned char* lds = (LAS unsigned char*)lds_raw;
    volatile LAS unsigned* MISC = (volatile LAS unsigned*)(lds + MISC_OFF);
    int wave = __builtin_amdgcn_readfirstlane((int)threadIdx.x >> 6); asm volatile("" : "+s"(wave));
    const int G = gridDim.x;
#define TID() ((wave << 6) + lane_id())
    for (int u = TID(); u < (LDS_BYTES - RING_BYTES) / 4; u += 512) ((LAS unsigned*)(lds + RING_BYTES))[u] = 0u;
    __syncthreads();
    gu32* ctl = (gu32*)(a.ws + WS_CTL);
    const int lo = a.ph_lo, hi = a.ph_hi;
    XcdBarrier bar; bar.bar = (unsigned*)(ctl + CW_BAR); bar.x = 0; bar.st = nullptr;
    if (hi - lo > 1) bar = xcd_barrier_post((unsigned*)(ctl + CW_BAR), MISC + 8, TID() == 0);
#define IN(k) (lo <= (k) && (k) < hi)
#define OPQ() int ptid = TID(); asm volatile("" : "+v"(ptid)); const int plane = ptid & 63; (void)plane
#define SEAM(k) do { if (IN(k) && IN((k) + 1)) xcd_barrier(bar, TID() == 0); } while (0)
#define hb ((bf16*)(a.ws + WS_HB))
#define stA ((float*)(a.ws + WS_STA))
#define stB ((float*)(a.ws + WS_STB))

    for (int rep = 0; rep < REP_BAR; ++rep) xcd_barrier(bar, TID() == 0);
    if (IN(0)) { OPQ(); for (int rep = 0; rep < REP_P0; ++rep) { p0_prologue(a, lds, ptid, plane, wave); __syncthreads(); } }
    SEAM(0);

    for (int li = 0; li < 2; ++li) {
        const int pb = 1 + 6 * li;
        if (IN(pb)) {
            { OPQ(); for (int u = blockIdx.x; u < N1 / 64; u += G) thin_unit<2, 4>(hb + (size_t)MR * DM, DM, (const bf16*)(a.ws + WS_W1T + li * W1T_BYTES), u, nullptr, nullptr, stA, (bf16*)(a.ws + B_PROJ), lds, ptid); }
            pg8::Gemm g{hb, (const bf16*)(a.ws + WS_W1T + li * W1T_BYTES), DM, 0, nullptr}; pg8::StaticOrder S; S.init(NPAN - 1, N1 / 256, G, (int)blockIdx.x);
            EpiProj E{(bf16*)(a.ws + B_PROJ), stA};
            for (int rep = 0; rep < REP_G1; ++rep) pg8::gemm_phase<EpiProj, pg8::StaticOrder, false>(lds, g, S, E, wave);
        }
        SEAM(pb);
        if (IN(pb + 1)) { OPQ(); for (int rep = 0; rep < REP_PREP; ++rep) for (int u = blockIdx.x; u < NB * NCH * 3; u += G) { const int part = u % 3;     if (rep > 0 && REP_PART >= 0 && part != REP_PART) continue; int ut = ptid; asm volatile("" : "+v"(ut)); prep2_unit(a, li, (u / 3) / NCH, (u / 3) % NCH, part, lds, ut); } __syncthreads(); }
        SEAM(pb + 1);
        if (IN(pb + 2)) {
            OPQ(); const int tid = ptid;
            LAS int* qid = (LAS int*)(lds + RING_BYTES + 64);
            float lam, lam_init; { const float* lv = ain(a, I_DLAM) + li * 128; float s01 = 0.f, s23 = 0.f;
                for (int d = 0; d < 32; ++d) { s01 += lv[d] * lv[32 + d]; s23 += lv[64 + d] * lv[96 + d]; }
                lam_init = 0.8f - 0.6f * __expf(-0.3f * (float)li); lam = __expf(s01) - __expf(s23) + lam_init;
                if (tid == 0) { LAS float* lp = (LAS float*)(lds + RING_BYTES + 256); lp[0] = lam; lp[1] = 1.f - lam_init; } }
            for (int rep = 0; rep < REP_MIX; ++rep)
            for (;;) {
                __syncthreads();
                if (tid == 0) *qid = (int)__hip_atomic_fetch_add(ctl + CW_Q + 64 * (li + 2 * rep), 1u, RLX_AGENT);
                __syncthreads();
                const int id = *qid;
                int utid = ptid; asm volatile("" : "+v"(utid));
                if (id >= 64 + 1024 + 8) break;
                if (id < 64) { if ((id & 1) == 0) lin_mfma_unit<0>(a, li, (id >> 1) & 15, id >> 5, lds, utid); else lin_mfma_unit<1>(a, li, (id >> 1) & 15, id >> 5, lds, utid); }
                else { const int v = id - 64; int qb, kind, b, hh;
                    if (v < 1024) { qb = 7 - (v >> 7); const int rem = v & 127; kind = rem >> 6; b = (rem >> 2) & 15; hh = rem & 3; } else { qb = -1; kind = (v - 1024) >> 2; b = 0; hh = v & 3; }
                    if (kind == 0) attn_mfma_unit<0>(a, li, b, hh, qb, lds, utid, 0.f, 1.f); else attn_mfma_unit<1>(a, li, b, hh, qb, lds, utid, 0.f, 0.f); }
            }
        }
        SEAM(pb + 2);
        if (IN(pb + 3)) {
            if (li == 0) { OPQ(); for (int u = blockIdx.x; u < 16; u += G) thin_unit<0, 4>((const bf16*)a.out + (size_t)MR * DM, DM, (const bf16*)(a.ws + WS_WOT), u, hb, stB, nullptr, nullptr, lds, ptid); }
            pg8::Gemm g{(const bf16*)a.out, (const bf16*)(a.ws + WS_WOT + li * WOT_BYTES), DM, 0, nullptr}; pg8::StaticOrder S; S.init(NPAN - 1, 4, G, (int)blockIdx.x);
            EpiResid E{hb, stB};
            pg8::gemm_phase<EpiResid, pg8::StaticOrder, false>(lds, g, S, E, wave);
        }
        SEAM(pb + 3);
        if (li == 0) {
            if (IN(5)) {
                { OPQ(); for (int u = blockIdx.x; u < 88; u += G) thin_unit<1, 4>(hb + (size_t)MR * DM, DM, (const bf16*)(a.ws + WS_WGU), u, nullptr, nullptr, stB, (bf16*)(a.ws + B_ACT), lds, ptid); }
                pg8::Gemm g{hb, (const bf16*)(a.ws + WS_WGU), DM, 0, nullptr}; pg8::StaticOrder S; S.init(NPAN - 1, 2 * DFF / 256, G, (int)blockIdx.x);
                EpiSwiglu E{(bf16*)(a.ws + B_ACT), DFF, stB};
                for (int rep = 0; rep < REP_FGU; ++rep) pg8::gemm_phase<EpiSwiglu, pg8::StaticOrder, false>(lds, g, S, E, wave);
            }
            SEAM(5);
            if (IN(6)) {
                { OPQ(); for (int u = blockIdx.x; u < 16; u += G) thin_unit<0, 11>((const bf16*)(a.ws + B_ACT) + (size_t)MR * DFF, DFF, (const bf16*)(a.ws + WS_WD), u, hb, stA, nullptr, nullptr, lds, ptid); }
                pg8::Gemm g{(const bf16*)(a.ws + B_ACT), (const bf16*)(a.ws + WS_WD), DFF, 0, nullptr}; pg8::StaticOrder S; S.init(NPAN - 1, 4, G, (int)blockIdx.x);
                EpiResid E{hb, stA};
                pg8::gemm_phase<EpiResid, pg8::StaticOrder, false>(lds, g, S, E, wave);
            }
            SEAM(6);
        }
    }
    if (IN(11)) { OPQ(); const int tid = ptid, lane = plane;
        LAS float* scr = (LAS float*)(lds + wave * 16384);
        const int gw = blockIdx.x * 8 + wave, NGW = G * 8;
        constexpr int IG = 16 * 56, ID = 56 * 16;
        for (int rep = 0; rep < REP_CONV; ++rep)
        for (int it = gw; it < 8 * (2 * IG + ID); it += NGW) { const int e = it / (2 * IG + ID); int r = it % (2 * IG + ID);
            if (r < IG) { transpose_item(ain(a, I_EG) + (size_t)e * DM * DFE, DM, DFE, ain(a, I_FNORM) + DM, (bf16*)(a.ws + B_EGU + e * EGU_BYTES), r / 56, r % 56, 1, scr, lane); continue; } r -= IG;
            if (r < IG) { transpose_item(ain(a, I_EU) + (size_t)e * DM * DFE, DM, DFE, ain(a, I_FNORM) + DM, (bf16*)(a.ws + B_EGU + e * EGU_BYTES), r / 56, r % 56, 2, scr, lane); continue; } r -= IG;
            transpose_item(ain(a, I_ED) + (size_t)e * DFE * DM, DFE, DM, nullptr, (bf16*)(a.ws + B_ED + e * ED_BYTES), r / 16, r % 16, 0, scr, lane); }
        for (int i = blockIdx.x * 512 + tid; i < MAXPAN * 256; i += G * 512) { ((int*)(a.ws + MO_ROWIDX))[i] = -1; ((int*)(a.ws + MO_PDST))[i] = -1; ((f32x2*)(a.ws + MO_PINFO))[i] = (f32x2){0.f, 0.f}; }
        for (int blk = blockIdx.x; blk < MR / 128; blk += G) route_block(a, blk, lds, tid, lane, wave);
    }
    SEAM(11);
    LAS int* offs = (LAS int*)(lds + RING_BYTES + 128);
    if (IN(12)) { OPQ(); const int tid = ptid;
        moe_offsets(a, offs, tid);
        for (int idx = blockIdx.x * 512 + tid; idx < 2 * MR; idx += G * 512) { const int tok = idx >> 1, e = ((const int*)(a.ws + MO_TOKE))[idx], gpos = offs[e] + ((const int*)(a.ws + MO_TOKP))[idx];
            const f32x4* sp = (const f32x4*)(stB + (size_t)tok * 16); const f32x4 s0 = sp[0], s1 = sp[1], s2 = sp[2], s3 = sp[3];
            const float ss = ((s0[0] + s0[1]) + (s0[2] + s0[3])) + ((s1[0] + s1[1]) + (s1[2] + s1[3])) + ((s2[0] + s2[1]) + (s2[2] + s2[3])) + ((s3[0] + s3[1]) + (s3[2] + s3[3]));
            ((int*)(a.ws + MO_ROWIDX))[gpos] = tok; ((int*)(a.ws + MO_PDST))[gpos] = idx;
            ((f32x2*)(a.ws + MO_PINFO))[gpos] = (f32x2){__builtin_amdgcn_rsqf(ss * (1.f / 1024.f) + EPS), __int_as_float(((const int*)(a.ws + MO_TOKW))[idx])}; }
        if (blockIdx.x == 0 && tid < MAXPAN + 8) { int e = 0;
            for (int k = 1; k < 8; ++k) if (tid * 256 >= offs[k]) e = k;
            ((int*)(a.ws + MO_PEXP))[tid] = e; }
    }
    SEAM(12);
    int nT = 0; if (IN(13) || IN(14) || IN(15) || IN(16)) { moe_offsets(a, offs, TID()); nT = __builtin_amdgcn_readfirstlane(offs[8]); }
    const int nA = nT < 128 ? nT : 128, nB = nT < 128 ? 0 : (nT - 128 < 128 ? nT - 128 : 128), nC = nT <= 256 ? 0 : (nT - 256 < 8 ? nT - 256 : 8);
#pragma unroll 1
    for (int job = 0; job < 5; ++job) {
        const int ph = job == 0 ? 13 : job == 1 ? 14 : job <= 3 ? 15 : 16;
        if (IN(ph)) {
            if (job == 0 || job == 3) {
                const int nP = job == 0 ? nA + nC : nB;
                if (nP > 0) { pg8::Gemm g{hb, (const bf16*)(a.ws + B_EGU), DM, EGU_BYTES, (const int*)(a.ws + MO_ROWIDX)}; pg8::MoeOrder S; S.init(nP, 2 * DFE / 256, G, (int)blockIdx.x, job == 0 ? 0 : 128, (const int*)(a.ws + MO_PEXP));
                    if (job == 0) { S.psplit = nA; S.p1 = 256; } else if (nC > 0 && (nB * (2 * DFE / 256)) % G == 0 && 16 * nC <= G) S.H = 4 * nC;
                    EpiSwigluMoe E{(bf16*)(a.ws + B_EACT), (const f32x2*)(a.ws + MO_PINFO)};
                    for (int rep = 0; rep < REP_MGU; ++rep) pg8::gemm_phase<EpiSwigluMoe, pg8::MoeOrder, true>(lds, g, S, E, wave); }
            } else {
                const int nP = job == 1 ? nA : job == 2 ? nC : nB, p0 = job == 1 ? 0 : job == 2 ? 256 : 128;
                if (nP > 0) { pg8::Gemm g{(const bf16*)(a.ws + B_EACT) + (job == 2 ? (size_t)128 * 256 * DFE : (size_t)0), (const bf16*)(a.ws + B_ED), DFE, ED_BYTES, nullptr}; pg8::MoeOrder S; S.init(nP, 4, G, (int)blockIdx.x, p0, (const int*)(a.ws + MO_PEXP));
                    EpiMoeDown E{(unsigned char*)a.out, (const int*)(a.ws + MO_PDST), (const f32x2*)(a.ws + MO_PINFO)};
                    for (int rep = 0; rep < REP_MDN; ++rep) pg8::gemm_phase<EpiMoeDown, pg8::MoeOrder, false>(lds, g, S, E, wave); }
            }
        }
        if (job != 2) SEAM(ph);
    }
    if (IN(17)) { OPQ(); const int lane = plane;
        const float* fn = ain(a, I_FINAL);
        for (int r = blockIdx.x * 8 + wave; r < MR; r += G * 8) {
            unsigned char* orow = (unsigned char*)a.out + (size_t)r * 4096; float v[16]; float ss = 0.f;
#pragma unroll
            for (int hf = 0; hf < 2; ++hf) { const int k = 512 * hf + 8 * lane; const v4u h4 = *(const v4u*)(hb + (size_t)r * DM + k), y0 = *(const v4u*)(orow + 2 * k), y1 = *(const v4u*)(orow + 2048 + 2 * k);
                const unsigned hw[4] = {h4.x, h4.y, h4.z, h4.w}, aw[4] = {y0.x, y0.y, y0.z, y0.w}, bw[4] = {y1.x, y1.y, y1.z, y1.w};
#pragma unroll
                for (int t = 0; t < 4; ++t) { const float x0 = bflo(hw[t]) + bflo(aw[t]) + bflo(bw[t]), x1 = bfhi(hw[t]) + bfhi(aw[t]) + bfhi(bw[t]); v[8 * hf + 2 * t] = x0; v[8 * hf + 2 * t + 1] = x1; ss += x0 * x0 + x1 * x1; } }
            ss = wave_sum(ss); const float rs = __builtin_amdgcn_rsqf(ss * (1.f / 1024.f) + EPS);
#pragma unroll
            for (int hf = 0; hf < 2; ++hf) { const int k = 512 * hf + 8 * lane; const f32x4 g0 = *(const f32x4*)(fn + k), g1 = *(const f32x4*)(fn + k + 4);
                *(f32x4*)(orow + 4 * k) = (f32x4){v[8 * hf] * rs * g0[0], v[8 * hf + 1] * rs * g0[1], v[8 * hf + 2] * rs * g0[2], v[8 * hf + 3] * rs * g0[3]};
                *(f32x4*)(orow + 4 * k + 16) = (f32x4){v[8 * hf + 4] * rs * g1[0], v[8 * hf + 5] * rs * g1[1], v[8 * hf + 6] * rs * g1[2], v[8 * hf + 7] * rs * g1[3]}; }
        }
    }
#undef IN
#undef SEAM
#undef hb
#undef stA
#undef stB
}

extern "C" void kernel_launch(void* const* d_in, const int* in_sizes, int n_in, void* d_out, int out_size, void* d_ws, size_t ws_size, hipStream_t stream) {
    static int grid = 0;
    if (grid == 0) {
        if (n_in != 24 || in_sizes[0] != MR * DM || out_size != MR * DM || ws_size < WS_NEED) { fprintf(stderr, "kernel_launch: unexpected problem (n_in %d, in0 %d, out %d, ws %zu < %zu)\n", n_in, n_in > 0 ? in_sizes[0] : -1, out_size, ws_size, (size_t)WS_NEED); grid = -1; return; }
        int dev = 0, cus = 0, per_cu = 0;
        if (hipGetDevice(&dev) != hipSuccess || hipDeviceGetAttribute(&cus, hipDeviceAttributeMultiprocessorCount, dev) != hipSuccess) { grid = -1; return; }
        if (hipFuncSetAttribute((const void*)mega_fwd, hipFuncAttributeMaxDynamicSharedMemorySize, LDS_BYTES) != hipSuccess) { fprintf(stderr, "kernel_launch: hipFuncSetAttribute failed\n"); grid = -1; return; }
        if (hipOccupancyMaxActiveBlocksPerMultiprocessor(&per_cu, (const void*)mega_fwd, 512, LDS_BYTES) != hipSuccess || per_cu < 1) fprintf(stderr, "kernel_launch: occupancy query reports %d\n", per_cu);
        (void)hipGetLastError();
        grid = cus;
    }
    if (grid < 0) return;
    if (hipMemsetAsync((char*)d_ws + WS_CTL, 0, CTL_BYTES, stream) != hipSuccess) return;
    Args a{};
    for (int i = 0; i < 24; ++i) a.in[i] = (const float*)d_in[i];
    a.out = (float*)d_out; a.ws = (unsigned char*)d_ws;
#if MK_ONE_LAUNCH
    a.ph_lo = 0; a.ph_hi = NPHASE;
    hipLaunchKernelGGL(mega_fwd, dim3(grid), dim3(512), LDS_BYTES, stream, a);
#else
    for (int p = 0; p < NPHASE; ++p) { a.ph_lo = p; a.ph_hi = p + 1; hipLaunchKernelGGL(mega_fwd, dim3(grid), dim3(512), LDS_BYTES, stream, a); }
#endif
}
```

```cpp
#include <hip/hip_runtime.h>
#include <cstdio>
#include <cstdint>

namespace pg8 {
#define PG8_LAS __attribute__((address_space(3)))
typedef unsigned short bf16_t;
typedef short bf16x8 __attribute__((ext_vector_type(8)));
typedef float f32x4 __attribute__((ext_vector_type(4)));
typedef unsigned u32x4 __attribute__((ext_vector_type(4)));
typedef int i32x4 __attribute__((ext_vector_type(4)));
typedef int i32x8 __attribute__((ext_vector_type(8)));
constexpr int BM = 256, BK = 64, HALF = 128, HTB = HALF * BK * 2  , STAGE_BYTES = 8 * HTB, NXCD = 8, WGM = 8;

__host__ __device__ __forceinline__ int lds_byte(int r, int c) { const int st = (r >> 4) * 2 + (c >> 5), rr = r & 15, cc = c & 31, ob = rr * 64 + cc * 2; return st * 1024 + (ob ^ (((ob >> 9) & 1) << 5)); }
__host__ __device__ __forceinline__ void stage_rc(int b, int& R, int& C) { const int st = b / 1024, sb = b % 1024, swz = sb ^ (((sb >> 9) & 1) << 5); R = (st >> 1) * 16 + swz / 64; C = (st & 1) * 32 + (swz % 64) / 2; }
__host__ __device__ __forceinline__ int perm32(int rho) { const int n = rho >> 4, i = rho & 15; return 8 * (i >> 2) + 4 * n + (i & 3); }

struct Unit { int pm, pn, e, gp; };
struct Gemm { const bf16_t* A; const bf16_t* Bt; int K; size_t estride  ; const int* rowidx  ; };

struct StaticOrder {
    int nM, nN, nwg, G, c;
    __device__ void init(int nM_, int nN_, int G_, int c_) { nM = nM_; nN = nN_; nwg = nM * nN; G = G_; c = c_; }
    __device__ __forceinline__ bool map(int i, int& pm, int& pn) const { return mapL((long)i * G + c, pm, pn); }
    __device__ __forceinline__ bool mapL(long L, int& pm, int& pn) const {
        if (L >= nwg) return false;
        int wgid = (int)L; { const int q = nwg / NXCD, r = nwg % NXCD, xcd = wgid % NXCD, off = wgid / NXCD; wgid = (xcd < r ? xcd * (q + 1) : r * (q + 1) + (xcd - r) * q) + off; }
        const int nig = WGM * nN, gid = wgid / nig, fm = gid * WGM, gsz = (nM - fm) < WGM ? (nM - fm) : WGM;
        pm = fm + ((wgid % nig) % gsz); pn = (wgid % nig) / gsz; return true;
    }
    __device__ __forceinline__ bool next(int i, Unit& u) const { int pm, pn; if (!map(i, pm, pn)) return false; u.pm = pm; u.pn = pn; u.e = 0; u.gp = pm; return true; }
};
struct MoeOrder {
    StaticOrder so; int p0; const int* pexp;
    int psplit, p1;
    int H;
    __device__ void init(int nP, int nN, int G, int c, int p0_, const int* pexp_) { so.init(nP, nN, G, c); p0 = p0_; pexp = pexp_; psplit = 1 << 30; p1 = 0; H = 0; }
    __device__ __forceinline__ bool next(int i, Unit& u) const { int pm, pn; long L = (long)i * so.G + so.c;
        if (H > 0) { const int full = so.nwg / so.G, nh = full - 3;
            if (so.c < H) { if (i >= nh) return false; }
            else if (i >= full) { const int j = so.c - H; if (i > full || j >= 3 * H) return false; L = (long)(nh + j / H) * so.G + (j % H); } }
        if (!so.mapL(L, pm, pn)) return false;
        u.pm = pm; u.pn = pn; u.gp = pm < psplit ? p0 + pm : p1 + (pm - psplit); u.e = __builtin_amdgcn_readfirstlane(pexp[u.gp]); return true; }
};

__device__ __forceinline__ unsigned cvt_pk_bf16(float lo, float hi) { unsigned r; asm volatile("v_cvt_pk_bf16_f32 %0, %1, %2" : "=v"(r) : "v"(lo), "v"(hi)); return r; }
__device__ __forceinline__ float bf_lo(unsigned w) { return __uint_as_float(w << 16); }
__device__ __forceinline__ float bf_hi(unsigned w) { return __uint_as_float(w & 0xffff0000u); }

template <class Epi, class Sched, bool GATHER, bool F8 = false>
__device__ __forceinline__ void gemm_phase(PG8_LAS unsigned char* lds, const Gemm g, const Sched& S, const Epi& E, int wave_id  ) {
    int tid_; asm volatile("v_mbcnt_lo_u32_b32 %0, -1, 0\n\tv_mbcnt_hi_u32_b32 %0, -1, %0" : "=v"(tid_)); tid_ += wave_id << 6;
    const int tid = tid_, wid = __builtin_amdgcn_readfirstlane(tid >> 6), lane = tid & 63, wr = wid >> 2, wc = wid & 3, fr = lane & 15, fq = lane >> 4;
    const int K = g.K, nt = K / BK;
    int Ra[2], Ca[2]; unsigned voffB[2];
#pragma unroll
    for (int i = 0; i < 2; ++i) { int R, C; stage_rc(tid * 16 + i * 8192, R, C); const int Rb = (R & ~31) + perm32(R & 31);
        Ra[i] = R; Ca[i] = C; voffB[i] = (unsigned)(Rb * K + C) * 2u; }
    const size_t kstep = (size_t)(BK * 2);
    const size_t hstep = (size_t)HALF * K * 2;
    const size_t tstep = 2 * hstep;
    const unsigned ldsw = (unsigned)wid * 1024u;
    const int aoff = lds_byte(wr * 64 + fr, fq * 8), boff = lds_byte(wc * 32 + fr, fq * 8);
    const char* const A0 = (const char*)g.A;
#define PG8_SA(b, h) (((b) * 2 + (h)) * HTB)
#define PG8_SB(b, h) ((4 + (b) * 2 + (h)) * HTB)
#define PG8_STAGE(bufoff, gbase, voff) do { _Pragma("unroll") for (int _i = 0; _i < 2; ++_i) \
        __builtin_amdgcn_global_load_lds((const unsigned*)((const char*)(gbase) + (voff)[_i]), (PG8_LAS unsigned*)(lds + (bufoff) + ldsw + _i * 8192), 16, 0, 0); } while (0)
#define PG8_RDA(b, h, m, k) (*(const PG8_LAS bf16x8*)(lds + PG8_SA(b, h) + aoff + (m) * 2048 + (k) * 1024))
#define PG8_RDB(b, h, n, k) (*(const PG8_LAS bf16x8*)(lds + PG8_SB(b, h) + boff + (n) * 2048 + (k) * 1024))
#define PG8_LDA(dst, b, h) do { _Pragma("unroll") for (int m = 0; m < 4; ++m) { if (F8) { const i32x4 x0_ = *(const PG8_LAS i32x4*)(lds + PG8_SA(b, h) + aoff + m * 2048), x1_ = *(const PG8_LAS i32x4*)(lds + PG8_SA(b, h) + aoff + m * 2048 + 1024); dst##8[m] = __builtin_shufflevector(x0_, x1_, 0, 1, 2, 3, 4, 5, 6, 7); } else { dst[m][0] = PG8_RDA(b, h, m, 0); dst[m][1] = PG8_RDA(b, h, m, 1); } } } while (0)
#define PG8_LDB(dst, b, h) do { _Pragma("unroll") for (int n = 0; n < 2; ++n) { if (F8) { const i32x4 x0_ = *(const PG8_LAS i32x4*)(lds + PG8_SB(b, h) + boff + n * 2048), x1_ = *(const PG8_LAS i32x4*)(lds + PG8_SB(b, h) + boff + n * 2048 + 1024); dst##8[n] = __builtin_shufflevector(x0_, x1_, 0, 1, 2, 3, 4, 5, 6, 7); } else { dst[n][0] = PG8_RDB(b, h, n, 0); dst[n][1] = PG8_RDB(b, h, n, 1); } } } while (0)
#define PG8_CAT(x0, x1) __builtin_shufflevector(__builtin_bit_cast(i32x4, x0), __builtin_bit_cast(i32x4, x1), 0, 1, 2, 3, 4, 5, 6, 7)
#define PG8_MMA(ai, bj, At, Bt) do { __builtin_amdgcn_s_setprio(1); _Pragma("unroll") for (int m = 0; m < 4; ++m) _Pragma("unroll") for (int n = 0; n < 2; ++n) { \
        if (F8) asm("v_mfma_f32_16x16x128_f8f6f4 %0, %1, %2, %0" : "+v"(acc[ai][bj][m][n]) : "v"(Bt##8[n]), "v"(At##8[m]));         \
        else { _Pragma("unroll") for (int k = 0; k < 2; ++k) acc[ai][bj][m][n] = __builtin_amdgcn_mfma_f32_16x16x32_bf16(Bt[n][k], At[m][k], acc[ai][bj][m][n], 0, 0, 0); } } __builtin_amdgcn_s_setprio(0); } while (0)
#define PG8_WAIT_V(n) asm volatile("s_waitcnt vmcnt(" #n ")" ::: "memory")
#define PG8_WAIT_L(n) asm volatile("s_waitcnt lgkmcnt(" #n ")" ::: "memory")
#define PG8_BAR __builtin_amdgcn_s_barrier()
#define PG8_SCHED __builtin_amdgcn_sched_barrier(0)
#define PG8_AOFFS(dst, u) do { _Pragma("unroll") for (int _h = 0; _h < 2; ++_h) _Pragma("unroll") for (int _i = 0; _i < 2; ++_i) { \
        int _row = (u).pm * BM + _h * HALF + Ra[_i]; \
        if (GATHER) { const int _gi = g.rowidx[(u).gp * BM + _h * HALF + Ra[_i]]; _row = _gi < 0 ? 0 : _gi; } \
        dst[_h][_i] = ((unsigned)_row * (unsigned)K + (unsigned)Ca[_i]) * 2u; } } while (0)
    Unit cur, nxt; int ui = 0;
    if (!S.next(0, cur)) return;
    f32x4 acc[2][2][4][2];
#pragma unroll
    for (int a = 0; a < 2; ++a)
#pragma unroll
        for (int b = 0; b < 2; ++b)
#pragma unroll
            for (int m = 0; m < 4; ++m)
#pragma unroll
                for (int n = 0; n < 2; ++n) acc[a][b][m][n] = (f32x4){0.f, 0.f, 0.f, 0.f};
    bf16x8 At[4][2], B0[2][2], B1[2][2];
    i32x8 At8[4], B08[2], B18[2];
    unsigned oaC[2][2], oaN[2][2];
    PG8_AOFFS(oaC, cur);
    const char* cB = (const char*)g.Bt + (size_t)cur.e * g.estride + (size_t)cur.pn * tstep;
    PG8_STAGE(PG8_SB(0, 0), cB, voffB); PG8_STAGE(PG8_SB(0, 1), cB + hstep, voffB); PG8_STAGE(PG8_SA(0, 0), A0, oaC[0]); PG8_STAGE(PG8_SA(0, 1), A0, oaC[1]);
    if (wr == 1) PG8_BAR;
    PG8_WAIT_V(2); PG8_BAR;
    PG8_STAGE(PG8_SB(1, 0), cB + kstep, voffB); PG8_STAGE(PG8_SA(1, 0), A0 + kstep, oaC[0]); PG8_STAGE(PG8_SB(1, 1), cB + hstep + kstep, voffB);
    PG8_WAIT_V(6); PG8_BAR;
    for (;;) {
        const bool has_next = S.next(ui + 1, nxt);
        if (has_next) { PG8_AOFFS(oaN, nxt); }
        else {
#pragma unroll
            for (int _h = 0; _h < 2; ++_h)
#pragma unroll
                for (int _i = 0; _i < 2; ++_i) oaN[_h][_i] = oaC[_h][_i]; }
        const char* nB = has_next ? (const char*)g.Bt + (size_t)nxt.e * g.estride + (size_t)nxt.pn * tstep : cB;
#pragma unroll 1
        for (int t = 0; t < nt; t += 2) {
            const bool last = (t == nt - 2);
            const char* ka1 = A0 + (size_t)(t + 1) * kstep;
            const char* ka2 = last ? A0 : A0 + (size_t)(t + 2) * kstep; const char* b2 = last ? nB : cB + (size_t)(t + 2) * kstep;
            const char* ka3 = ka2 + kstep; const char* b3 = b2 + kstep;
            unsigned o2[2][2];
#pragma unroll
            for (int _h = 0; _h < 2; ++_h)
#pragma unroll
                for (int _i = 0; _i < 2; ++_i) o2[_h][_i] = oaC[_h][_i];
            if (last) {
                E.prefetch(lds, cur, wid, lane);
#pragma unroll
                for (int _h = 0; _h < 2; ++_h)
#pragma unroll
                    for (int _i = 0; _i < 2; ++_i) o2[_h][_i] = oaN[_h][_i];
                asm volatile("" : "+v"(o2[0][0]), "+v"(o2[0][1]), "+v"(o2[1][0]), "+v"(o2[1][1])); }
            PG8_LDB(B0, 0, 0); PG8_LDB(B1, 0, 1); PG8_SCHED; PG8_LDA(At, 0, 0); PG8_STAGE(PG8_SA(1, 1), ka1, oaC[1]);
            PG8_WAIT_V(8); PG8_WAIT_L(0); PG8_BAR; PG8_MMA(0, 0, At, B0); PG8_MMA(0, 1, At, B1); PG8_BAR; PG8_SCHED;
            PG8_LDA(At, 0, 1); PG8_STAGE(PG8_SB(0, 0), b2, voffB); PG8_STAGE(PG8_SB(0, 1), b2 + hstep, voffB); PG8_STAGE(PG8_SA(0, 0), ka2, o2[0]);
            PG8_WAIT_V(8); PG8_WAIT_L(0); PG8_BAR; PG8_MMA(1, 0, At, B0); PG8_MMA(1, 1, At, B1); PG8_BAR; PG8_SCHED;
            PG8_LDB(B0, 1, 0); PG8_LDB(B1, 1, 1); PG8_SCHED; PG8_LDA(At, 1, 0); PG8_STAGE(PG8_SA(0, 1), ka2, o2[1]);
            PG8_WAIT_V(8); PG8_WAIT_L(0); PG8_BAR; PG8_MMA(0, 0, At, B0); PG8_MMA(0, 1, At, B1); PG8_BAR; PG8_SCHED;
            PG8_LDA(At, 1, 1); PG8_STAGE(PG8_SB(1, 0), b3, voffB); PG8_STAGE(PG8_SB(1, 1), b3 + hstep, voffB); PG8_STAGE(PG8_SA(1, 0), ka3, o2[0]);
            PG8_WAIT_V(8); PG8_WAIT_L(0); PG8_BAR; PG8_MMA(1, 0, At, B0); PG8_MMA(1, 1, At, B1); PG8_BAR; PG8_SCHED;
        }
        if (wr == 0) PG8_BAR;
        { int fr_e = fr, fq_e = fq; asm volatile("" : "+v"(fr_e), "+v"(fq_e));
          E(acc, cur, wr, wc, fr_e, fq_e, lds); }
        if (!has_next) break;
#pragma unroll
        for (int a = 0; a < 2; ++a)
#pragma unroll
            for (int b = 0; b < 2; ++b)
#pragma unroll
                for (int m = 0; m < 4; ++m)
#pragma unroll
                    for (int n = 0; n < 2; ++n) acc[a][b][m][n] = (f32x4){0.f, 0.f, 0.f, 0.f};
        cur = nxt; cB = nB; ++ui;
#pragma unroll
        for (int _h = 0; _h < 2; ++_h)
#pragma unroll
            for (int _i = 0; _i < 2; ++_i) oaC[_h][_i] = oaN[_h][_i];
        if (wr == 1) PG8_BAR;
    }
    PG8_WAIT_V(0);
    PG8_BAR;
#undef PG8_SA
#undef PG8_SB
#undef PG8_STAGE
#undef PG8_LDA
#undef PG8_RDA
#undef PG8_RDB
#undef PG8_LDB
#undef PG8_MMA
#undef PG8_CAT
#undef PG8_WAIT_V
#undef PG8_WAIT_L
#undef PG8_BAR
#undef PG8_SCHED
#undef PG8_AOFFS
}
}
#define GAS __attribute__((address_space(1)))
#define LAS __attribute__((address_space(3)))
typedef unsigned short bf16;
typedef unsigned v4u __attribute__((ext_vector_type(4)));
typedef unsigned v2u __attribute__((ext_vector_type(2)));
typedef float f32x4 __attribute__((ext_vector_type(4)));
typedef float f32x2 __attribute__((ext_vector_type(2)));
typedef GAS unsigned gu32;
#define RLX_AGENT __ATOMIC_RELAXED, __HIP_MEMORY_SCOPE_AGENT
#define LDS_WAIT() asm volatile("s_waitcnt lgkmcnt(0)" ::: "memory")
#define VM_WAIT() asm volatile("s_waitcnt vmcnt(0)" ::: "memory")
__device__ __forceinline__ unsigned f2bf(float f) { unsigned u = __builtin_bit_cast(unsigned, f); return (u + 0x7fffu + ((u >> 16) & 1u)) >> 16; }
__device__ __forceinline__ unsigned pk2(float lo, float hi) { return f2bf(lo) | (f2bf(hi) << 16); }
__device__ __forceinline__ float bf2f(bf16 h) { return __uint_as_float(((unsigned)h) << 16); }
__device__ __forceinline__ float bflo(unsigned w) { return __uint_as_float(w << 16); }
__device__ __forceinline__ float bfhi(unsigned w) { return __uint_as_float(w & 0xffff0000u); }

#define XB_TMO      128
#define XB_XCNT(j)  (256  + 64 * (j))
#define XB_XSUB(j)  (1280 + 64 * (j))
#define XB_XGEN(j)  (2304 + 64 * (j))
#define XB_TOP      3328
#define XB_TOPGEN   3392
#define XCD_BAR_WORDS 3456
#define XB_SPIN_CAP (1u << 18)

__device__ __forceinline__ unsigned xb_ld(unsigned* p)              { return __hip_atomic_load(p, __ATOMIC_RELAXED, __HIP_MEMORY_SCOPE_AGENT); }
__device__ __forceinline__ unsigned xb_add(unsigned* p, unsigned v) { return __hip_atomic_fetch_add(p, v, __ATOMIC_RELAXED, __HIP_MEMORY_SCOPE_AGENT); }
__device__ __forceinline__ unsigned xb_xcc_id() { return (unsigned)__builtin_amdgcn_s_getreg((3 << 11) | 20) & 0xFu; }
#define XB_SPIN(cond, bar) do { unsigned _sp = 0; while (cond) { __builtin_amdgcn_s_sleep(1); \
    if ((++_sp & 255u) == 0u) { if (xb_ld(&(bar)[XB_TMO])) break; if (_sp > XB_SPIN_CAP) { atomicAdd(&(bar)[XB_TMO], 1u); break; } } } } while (0)

struct XcdBarrier {
    unsigned* bar; unsigned x;
    volatile LAS unsigned* st;
};

__device__ __forceinline__ XcdBarrier xcd_barrier_post(unsigned* bar, volatile LAS unsigned* st, bool leader  ) {
    XcdBarrier b; b.bar = bar; b.x = xb_xcc_id(); b.st = st;
    if (leader) (void)xb_add(&bar[XB_XCNT(b.x)], 1u);
    return b;
}
__device__ __forceinline__ void xcd_barrier_complete(unsigned* bar, unsigned x, unsigned& nloc, unsigned& nx) {
    const unsigned G = gridDim.x * gridDim.y * gridDim.z;
    unsigned sum, cnt, mine, sp = 0u;
    for (;;) {
        sum = 0u; cnt = 0u; mine = 0u;
#pragma unroll
        for (unsigned j = 0; j < 16; ++j) { const unsigned c = xb_ld(&bar[XB_XCNT(j)]); sum += c; cnt += (c > 0u) ? 1u : 0u; mine = (j == x) ? c : mine; }
        if (sum == G) break;
        __builtin_amdgcn_s_sleep(1);
        if ((++sp & 255u) == 0u) { if (xb_ld(&bar[XB_TMO])) break; if (sp > XB_SPIN_CAP) { atomicAdd(&bar[XB_TMO], 1u); break; } }
    }
    nloc = mine > 0u ? mine : 1u; nx = cnt > 0u ? cnt : 1u;
}

__device__ __forceinline__ void xcd_barrier(const XcdBarrier& b, bool leader) {
    asm volatile("s_waitcnt vmcnt(0)" ::: "memory");
    __syncthreads();
    if (leader) {
        unsigned* bar = b.bar;
        __builtin_amdgcn_s_waitcnt(0);
        unsigned nloc = b.st[0], nx = b.st[1];
        if (nloc == 0u) { xcd_barrier_complete(bar, b.x, nloc, nx); b.st[0] = nloc; b.st[1] = nx; }
        const unsigned old = xb_add(&bar[XB_XSUB(b.x)], 1u);
        const unsigned gen = old / nloc;
        if (old + 1u == (gen + 1u) * nloc) {
            __builtin_amdgcn_fence(__ATOMIC_RELEASE, "agent");
            asm volatile("s_waitcnt vmcnt(0)" ::: "memory");
            const unsigned og = xb_add(&bar[XB_TOP], 1u);
            const unsigned tg = og / nx;
            if (og + 1u == (tg + 1u) * nx) xb_add(&bar[XB_TOPGEN], 1u);
            else XB_SPIN(xb_ld(&bar[XB_TOPGEN]) == tg, bar);
            __builtin_amdgcn_fence(__ATOMIC_ACQUIRE, "agent");
            xb_add(&bar[XB_XGEN(b.x)], 1u);
            asm volatile("s_waitcnt vmcnt(0)" ::: "memory");
        } else {
            XB_SPIN(xb_ld(&bar[XB_XGEN(b.x)]) == gen, bar);
            __builtin_amdgcn_fence(__ATOMIC_ACQUIRE, "agent");
            asm volatile("s_waitcnt vmcnt(0)" ::: "memory");
        }
    }
    __syncthreads();
}

__device__ __forceinline__ int lane_id() { int l; asm volatile("v_mbcnt_lo_u32_b32 %0, -1, 0\n\tv_mbcnt_hi_u32_b32 %0, -1, %0" : "=v"(l)); return l; }

constexpr int NB = 16, TT = 2048, DM = 1024, MR = NB * TT, NMETA = 16, MROWS = MR + 256, NPAN = MROWS / 256;
constexpr int PSEQ = 2112, NCH = 33;
constexpr int DIN = 2864, N1 = 3072;
constexpr int DFF = 2816, DFE = 3584, NEXP = 8;
constexpr float EPS = 1e-6f;
constexpr int C_AQ = 0, C_AK = 128, C_AV = 256, C_ALR = 512, C_AOG = 528, C_RQ = 784, C_RK = 1040, C_RV = 1296, C_ROG = 1552, C_CQ = 1808, C_CKV = 2000, C_KPE = 2064, C_DQ = 2096, C_DK = 2352, C_DV = 2608;
constexpr int MAXPAN = 264;
constexpr float LOG2E = 1.4426950408889634f;

constexpr size_t MiB = 1u << 20;
constexpr size_t WS_CTL = 0, CTL_BYTES = 1 * MiB;
constexpr size_t WS_TABR = 1 * MiB, WS_TABM = 1 * MiB + 576 * 1024;
constexpr size_t WS_RT = 2 * MiB;
constexpr size_t WS_WQA = 2 * MiB + 256 * 1024, WQA_BYTES = 384 * 192 * 2;
constexpr size_t WS_STA = 3 * MiB, WS_STB = 6 * MiB;
constexpr size_t WS_MOE = 9 * MiB;
constexpr size_t MO_ROWIDX = WS_MOE, MO_PDST = WS_MOE + 512 * 1024, MO_PINFO = WS_MOE + 1 * MiB, MO_TOKE = WS_MOE + 2 * MiB, MO_TOKP = MO_TOKE + 256 * 1024, MO_TOKW = MO_TOKE + 512 * 1024, MO_PEXP = WS_MOE + 3 * MiB;
constexpr size_t WS_GD = 13 * MiB;
constexpr size_t WS_W1T = 16 * MiB, W1T_BYTES = (size_t)N1 * DM * 2;
constexpr size_t WS_WOT = 29 * MiB, WOT_BYTES = (size_t)DM * DM * 2;
constexpr size_t WS_WGU = 33 * MiB;
constexpr size_t WS_WD = 44 * MiB;
constexpr size_t WS_HB = 50 * MiB;
constexpr size_t WS_BIG = 115 * MiB;
constexpr size_t B_PROJ = WS_BIG;
constexpr int GQ_T = 5120, GKT_T = 5120, RT_T = 9216, VT_T = 9216;
constexpr size_t B_GQ = WS_BIG + 210 * MiB, B_GK = WS_BIG + 221 * MiB, B_GV = WS_BIG + 232 * MiB;
constexpr size_t B_RQ = WS_BIG + 251 * MiB, B_RK = WS_BIG + 270 * MiB, B_RV = WS_BIG + 289 * MiB;
constexpr size_t B_MQ = WS_BIG + 308 * MiB, B_MK = WS_BIG + 333 * MiB;
constexpr size_t B_DQ = WS_BIG + 340 * MiB, B_DK = B_DQ + 16896 * 1024;
constexpr size_t O_DVT = 65 * MiB, O_MVT = 82 * MiB, O_GKT = 87 * MiB, O_RKT = 98 * MiB;
constexpr size_t B_ACT = WS_BIG;
constexpr size_t B_EGU = WS_BIG, EGU_BYTES = (size_t)2 * DFE * DM;
constexpr size_t B_HB8 = WS_BIG + 56 * MiB;
constexpr float W8_SCALE = 64.f;
constexpr size_t B_ED = WS_BIG + 112 * MiB, ED_BYTES = (size_t)DM * DFE * 2;
constexpr size_t B_EACT = WS_BIG + 168 * MiB;
constexpr size_t WS_NEED = WS_BIG + 406 * MiB;
constexpr int CW_BAR = 4096, CW_CNT = 8192;

constexpr int RING_BYTES = 131072, MISC_OFF = RING_BYTES + 320, EPS_OFF = 147456, LDS_BYTES = 163840;

__device__ __forceinline__ float silu_f(float x) { return x * __builtin_amdgcn_rcpf(1.0f + __builtin_amdgcn_exp2f(-x * LOG2E)); }
__device__ __forceinline__ v4u pack8(const f32x4 a, const f32x4 b) { v4u w; w.x = pg8::cvt_pk_bf16(a[0], a[1]); w.y = pg8::cvt_pk_bf16(a[2], a[3]); w.z = pg8::cvt_pk_bf16(b[0], b[1]); w.w = pg8::cvt_pk_bf16(b[2], b[3]); return w; }

__device__ __forceinline__ void rows_rstd16(const float* stats, int row0, int fq, float (&rs)[8]) {
    f32x4 v[8];
#pragma unroll
    for (int j = 0; j < 8; ++j) v[j] = *(const f32x4*)(stats + (size_t)(row0 + (j >> 2) * 128 + (j & 3) * 16) * 16 + 4 * fq);
#pragma unroll
    for (int j = 0; j < 8; ++j) { float s = (v[j][0] + v[j][1]) + (v[j][2] + v[j][3]); s += __shfl_xor(s, 16); s += __shfl_xor(s, 32); rs[j] = __builtin_amdgcn_rsqf(s * (1.0f / 1024.0f) + EPS); }
}
__device__ __forceinline__ void stage_rows(const void* src, int bytes, LAS unsigned char* lds, int wid, int lane) {
#pragma unroll
    for (int j = 0; j < 2; ++j) { const int p = __builtin_amdgcn_readfirstlane(wid + 8 * j);
        if (p * 1024 < bytes) __builtin_amdgcn_global_load_lds((const unsigned*)((const unsigned char*)src + p * 1024 + lane * 16), (LAS unsigned*)(lds + EPS_OFF + p * 1024), 16, 0, 0); }
}
__device__ __forceinline__ void rows_rstd16_lds(const LAS unsigned char* lds, int rl0, int fq, float (&rs)[8]) {
    f32x4 v[8];
#pragma unroll
    for (int j = 0; j < 8; ++j) v[j] = *(const LAS f32x4*)(lds + EPS_OFF + (rl0 + (j >> 2) * 128 + (j & 3) * 16) * 64 + 16 * fq);
#pragma unroll
    for (int j = 0; j < 8; ++j) { float s = (v[j][0] + v[j][1]) + (v[j][2] + v[j][3]); s += __shfl_xor(s, 16); s += __shfl_xor(s, 32); rs[j] = __builtin_amdgcn_rsqf(s * (1.0f / 1024.0f) + EPS); }
}
struct EpiProj {
    bf16* O; const float* stats;
    __device__ __forceinline__ void prefetch(LAS unsigned char* lds, const pg8::Unit& u, int wid, int lane) const { stage_rows(stats + (size_t)u.pm * 256 * 16, 16384, lds, wid, lane); }
    __device__ __forceinline__ void operator()(const f32x4 (&acc)[2][2][4][2], const pg8::Unit& u, int wr, int wc, int fr, int fq, const LAS unsigned char* lds) const {
        const int col0 = u.pn * 256 + wc * 32 + 8 * fq, row0 = u.pm * 256 + wr * 64 + fr;
        float rs[8]; rows_rstd16_lds(lds, wr * 64 + fr, fq, rs);
#pragma unroll
        for (int ai = 0; ai < 2; ++ai)
#pragma unroll
            for (int m = 0; m < 4; ++m) { const int r = row0 + ai * 128 + m * 16; const float sc = rs[ai * 4 + m]; bf16* rowp = O + (size_t)r * N1 + col0;
#pragma unroll
                for (int bj = 0; bj < 2; ++bj) *(v4u*)(rowp + bj * 128) = pack8(acc[ai][bj][m][0] * sc, acc[ai][bj][m][1] * sc); }
    }
};
struct EpiSwiglu {
    bf16* O; int ldo; const float* stats;
    __device__ __forceinline__ void prefetch(LAS unsigned char* lds, const pg8::Unit& u, int wid, int lane) const { stage_rows(stats + (size_t)u.pm * 256 * 16, 16384, lds, wid, lane); }
    __device__ __forceinline__ void operator()(const f32x4 (&acc)[2][2][4][2], const pg8::Unit& u, int wr, int wc, int fr, int fq, const LAS unsigned char* lds) const {
        const int col0 = u.pn * 128 + wc * 32 + 8 * fq, row0 = u.pm * 256 + wr * 64 + fr;
        float rs[8]; rows_rstd16_lds(lds, wr * 64 + fr, fq, rs);
#pragma unroll
        for (int ai = 0; ai < 2; ++ai)
#pragma unroll
            for (int m = 0; m < 4; ++m) { const int r = row0 + ai * 128 + m * 16; const float sc = rs[ai * 4 + m];
                f32x4 o[2];
#pragma unroll
                for (int n = 0; n < 2; ++n)
#pragma unroll
                    for (int i = 0; i < 4; ++i) o[n][i] = silu_f(acc[ai][0][m][n][i] * sc) * (acc[ai][1][m][n][i] * sc);
                *(v4u*)(O + (size_t)r * ldo + col0) = pack8(o[0], o[1]); }
    }
};
struct EpiResid {
    bf16* H; float* stats;
    __device__ __forceinline__ void prefetch(LAS unsigned char*, const pg8::Unit&, int, int) const {}
    __device__ __forceinline__ void operator()(const f32x4 (&acc)[2][2][4][2], const pg8::Unit& u, int wr, int wc, int fr, int fq, const LAS unsigned char*) const {
        const int col0 = u.pn * 256 + wc * 32 + 8 * fq, row0 = u.pm * 256 + wr * 64 + fr;
#pragma unroll
        for (int ai = 0; ai < 2; ++ai) {
            v4u w[4][2];
#pragma unroll
            for (int m = 0; m < 4; ++m)
#pragma unroll
                for (int bj = 0; bj < 2; ++bj) w[m][bj] = *(const v4u*)(H + (size_t)(row0 + ai * 128 + m * 16) * DM + col0 + bj * 128);
            float ssm[4];
#pragma unroll
            for (int m = 0; m < 4; ++m) { bf16* rowp = H + (size_t)(row0 + ai * 128 + m * 16) * DM + col0; float ss = 0.f;
#pragma unroll
                for (int bj = 0; bj < 2; ++bj) { const v4u x = w[m][bj];
                    f32x4 a = acc[ai][bj][m][0], b = acc[ai][bj][m][1];
                    a[0] += bflo(x.x); a[1] += bfhi(x.x); a[2] += bflo(x.y); a[3] += bfhi(x.y); b[0] += bflo(x.z); b[1] += bfhi(x.z); b[2] += bflo(x.w); b[3] += bfhi(x.w);
                    ss += (a[0] * a[0] + a[1] * a[1]) + (a[2] * a[2] + a[3] * a[3]) + (b[0] * b[0] + b[1] * b[1]) + (b[2] * b[2] + b[3] * b[3]);
                    *(v4u*)(rowp + bj * 128) = pack8(a, b); }
                ss += __shfl_xor(ss, 16); ss += __shfl_xor(ss, 32); ssm[m] = ss; }
            if (fq == 0) {
#pragma unroll
                for (int m = 0; m < 4; ++m) stats[(size_t)(row0 + ai * 128 + m * 16) * 16 + u.pn * 4 + wc] = ssm[m]; } }
    }
};
struct EpiSwigluMoe {
    bf16* O; const f32x2* pinfo; float wscale;
    __device__ __forceinline__ void prefetch(LAS unsigned char* lds, const pg8::Unit& u, int wid, int lane) const { stage_rows(pinfo + (size_t)u.gp * 256, 2048, lds, wid, lane); }
    __device__ __forceinline__ void operator()(const f32x4 (&acc)[2][2][4][2], const pg8::Unit& u, int wr, int wc, int fr, int fq, const LAS unsigned char* lds) const {
        const int col0 = u.pn * 128 + wc * 32 + 8 * fq, rl0 = wr * 64 + fr;
        float rs[8];
#pragma unroll
        for (int j = 0; j < 8; ++j) rs[j] = ((const LAS f32x2*)(lds + EPS_OFF))[rl0 + (j >> 2) * 128 + (j & 3) * 16][0] * wscale;
#pragma unroll
        for (int ai = 0; ai < 2; ++ai)
#pragma unroll
            for (int m = 0; m < 4; ++m) { const int rl = rl0 + ai * 128 + m * 16; const float sc = rs[ai * 4 + m];
                f32x4 o[2];
#pragma unroll
                for (int n = 0; n < 2; ++n)
#pragma unroll
                    for (int i = 0; i < 4; ++i) o[n][i] = silu_f(acc[ai][0][m][n][i] * sc) * (acc[ai][1][m][n][i] * sc);
                *(v4u*)(O + (size_t)(u.pm * 256 + rl) * DFE + col0) = pack8(o[0], o[1]); }
    }
};
struct EpiMoeDown {
    unsigned char* Y; const int* pdst; const f32x2* pinfo;
    __device__ __forceinline__ void prefetch(LAS unsigned char* lds, const pg8::Unit& u, int wid, int lane) const {
        if (wid < 2) __builtin_amdgcn_global_load_lds((const unsigned*)((const unsigned char*)(pinfo + (size_t)u.gp * 256) + wid * 1024 + lane * 16), (LAS unsigned*)(lds + EPS_OFF + wid * 1024), 16, 0, 0);
        else if (wid == 2) __builtin_amdgcn_global_load_lds((const unsigned*)((const unsigned char*)(pdst + (size_t)u.gp * 256) + lane * 16), (LAS unsigned*)(lds + EPS_OFF + 2048), 16, 0, 0); }
    __device__ __forceinline__ void operator()(const f32x4 (&acc)[2][2][4][2], const pg8::Unit& u, int wr, int wc, int fr, int fq, const LAS unsigned char* lds) const {
        const int col0 = u.pn * 256 + wc * 32 + 8 * fq, rl0 = wr * 64 + fr;
#pragma unroll
        for (int ai = 0; ai < 2; ++ai)
#pragma unroll
            for (int m = 0; m < 4; ++m) { const int rl = rl0 + ai * 128 + m * 16; const int d = ((const LAS int*)(lds + EPS_OFF + 2048))[rl]; const float w = ((const LAS f32x2*)(lds + EPS_OFF))[rl][1];
                if (d >= 0) { bf16* rowp = (bf16*)(Y + (size_t)(d >> 1) * 4096 + (size_t)(d & 1) * 2048) + col0;
#pragma unroll
                    for (int bj = 0; bj < 2; ++bj) *(v4u*)(rowp + bj * 128) = pack8(acc[ai][bj][m][0] * w, acc[ai][bj][m][1] * w); } }
    }
};

__device__ __forceinline__ float wave_sum(float v) {
#pragma unroll
    for (int o = 1; o < 64; o <<= 1) v += __shfl_xor(v, o);
    return v;
}
__device__ __forceinline__ void transpose_item(const float* W, int K, int N, const float* gain, bf16* WT, int kb, int nb, int dmode, LAS float* scr_, int lane) {
    LAS unsigned* scr = (LAS unsigned*)scr_;
    const int k0 = 64 * kb, n0 = 64 * nb, n = n0 + 2 * (lane & 31), kh = lane >> 5;
    f32x2 v[32];
#pragma unroll
    for (int i = 0; i < 32; ++i) v[i] = (n < N) ? *(const f32x2*)(W + (size_t)(k0 + 2 * i + kh) * N + n) : (f32x2){0.f, 0.f};
    if (gain) {
#pragma unroll
        for (int i = 0; i < 32; ++i) v[i] = v[i] * gain[k0 + 2 * i + kh]; }
#pragma unroll
    for (int i = 0; i < 32; ++i) scr[(2 * i + kh) * 33 + (lane & 31)] = pk2(v[i][0], v[i][1]);
    LDS_WAIT(); asm volatile("" ::: "memory");
    const LAS bf16* T = (const LAS bf16*)scr;
    const int c = lane & 7;
    const int d0 = dmode == 0 ? n0 : 256 * (n0 >> 7) + (n0 & 127) + (dmode == 2 ? 128 : 0);
#pragma unroll
    for (int j = 0; j < 8; ++j) { const int nl = (lane >> 3) + 8 * j; unsigned x[8];
#pragma unroll
        for (int t = 0; t < 8; ++t) x[t] = T[(8 * c + t) * 66 + nl];
        v4u o; o.x = x[0] | (x[1] << 16); o.y = x[2] | (x[3] << 16); o.z = x[4] | (x[5] << 16); o.w = x[6] | (x[7] << 16);
        if (n0 + nl < N) *(v4u*)(WT + (size_t)(d0 + nl) * K + k0 + 8 * c) = o; }
    LDS_WAIT(); asm volatile("" ::: "memory");
}

__device__ __forceinline__ void transpose_item_f8(const float* W, int K, int N, const float* gain, unsigned char* WT, int kb, int nb, int dmode, LAS float* scr_, int lane) {
    LAS unsigned char* scr = (LAS unsigned char*)scr_;
    const int k0 = 128 * kb, n0 = 64 * nb, nl2 = 2 * (lane & 31), n = n0 + nl2, kh = lane >> 5;
#pragma unroll
    for (int half = 0; half < 2; ++half) {
        f32x2 v[32];
#pragma unroll
        for (int i = 0; i < 32; ++i) v[i] = (n < N) ? *(const f32x2*)(W + (size_t)(k0 + 64 * half + 2 * i + kh) * N + n) : (f32x2){0.f, 0.f};
#pragma unroll
        for (int i = 0; i < 32; ++i) { const float gs = gain[k0 + 64 * half + 2 * i + kh] * W8_SCALE; const int k = 64 * half + 2 * i + kh;
            const unsigned pk = (unsigned)__builtin_amdgcn_cvt_pk_fp8_f32(v[i][0] * gs, v[i][1] * gs, 0, false);
            scr[nl2 * 132 + k] = (unsigned char)(pk & 0xffu); scr[(nl2 + 1) * 132 + k] = (unsigned char)((pk >> 8) & 0xffu); } }
    LDS_WAIT(); asm volatile("" ::: "memory");
    const int c = lane & 7;
    const int d0 = dmode == 0 ? n0 : 256 * (n0 >> 7) + (n0 & 127) + (dmode == 2 ? 128 : 0);
#pragma unroll
    for (int j = 0; j < 8; ++j) { const int nl = (lane >> 3) + 8 * j; const LAS unsigned* p = (const LAS unsigned*)(scr + nl * 132 + 16 * c);
        v4u o; o.x = p[0]; o.y = p[1]; o.z = p[2]; o.w = p[3];
        if (n0 + nl < N) *(v4u*)(WT + (size_t)(d0 + nl) * K + k0 + 16 * c) = o; }
    LDS_WAIT(); asm volatile("" ::: "memory");
}

struct Args { const float* in[24]; float* out; unsigned char* ws; int ph_lo, ph_hi; };
__device__ __forceinline__ const float* ain(const Args& a, int i) { return a.in[i]; }
enum { I_X = 0, I_META, I_ANORM, I_WIN, I_GWG, I_GBG, I_GNORM, I_RNORM, I_MQN, I_WUQ, I_MKVN, I_WUKV, I_DLAM, I_DNORM, I_WOUT, I_FNORM, I_FG, I_FU, I_FD, I_ROUTER, I_EG, I_EU, I_ED, I_FINAL };

#ifndef REP_FOLD
#define REP_FOLD 1
#endif
#ifndef REP_HINIT
#define REP_HINIT 1
#endif
__device__ __forceinline__ void wqa_unit(const Args& a, int li, int hh, LAS float* L, int tid) {
    const float* Wuq = ain(a, I_WUQ) + (size_t)li * 192 * 384; const float* Wukv = ain(a, I_WUKV) + (size_t)li * 64 * 512;
    const float* gq = ain(a, I_MQN) + li * 192; const float* gkv = ain(a, I_MKVN) + li * 64;
    bf16* WqaT = (bf16*)(a.ws + WS_WQA + li * WQA_BYTES);
    LAS float* Wqa = L; LAS float* Wuk = L + 192 * 97;
    __syncthreads();
    for (int idx = tid; idx < 64 * 64; idx += 512) { const int n = idx >> 6, m = idx & 63; Wuk[n * 65 + m] = Wukv[n * 512 + hh * 128 + m]; }
    __syncthreads();
    for (int pass = 0; pass < 3; ++pass) { const int i = pass * 64 + (tid >> 3), ng = tid & 7; f32x4 wq[16];
#pragma unroll
        for (int j = 0; j < 16; ++j) wq[j] = *(const f32x4*)(Wuq + i * 384 + hh * 96 + 4 * j);
        const float gi = gq[i];
#pragma unroll
        for (int t = 0; t < 8; ++t) { const int n = ng * 8 + t; float s = 0.f;
#pragma unroll
            for (int j = 0; j < 16; ++j) s += (wq[j][0] * Wuk[n * 65 + 4 * j] + wq[j][1] * Wuk[n * 65 + 4 * j + 1]) + (wq[j][2] * Wuk[n * 65 + 4 * j + 2] + wq[j][3] * Wuk[n * 65 + 4 * j + 3]);
            Wqa[i * 97 + n] = gi * gkv[n] * s; }
        if (ng < 4) {
#pragma unroll
            for (int j = 0; j < 2; ++j) { const f32x4 r = *(const f32x4*)(Wuq + i * 384 + hh * 96 + 64 + ng * 8 + 4 * j); LAS float* d = Wqa + i * 97 + 64 + ng * 8 + 4 * j; d[0] = gi * r[0]; d[1] = gi * r[1]; d[2] = gi * r[2]; d[3] = gi * r[3]; } } }
    __syncthreads();
    for (int idx = tid; idx < 96 * 24; idx += 512) { const int n = idx % 96, i8 = idx / 96; float v[8];
#pragma unroll
        for (int t = 0; t < 8; ++t) v[t] = Wqa[(8 * i8 + t) * 97 + n];
        v4u w; w.x = pk2(v[0], v[1]); w.y = pk2(v[2], v[3]); w.z = pk2(v[4], v[5]); w.w = pk2(v[6], v[7]);
        *(v4u*)(WqaT + (size_t)(hh * 96 + n) * 192 + 8 * i8) = w; }
    __syncthreads();
}
__device__ __forceinline__ void wofold_unit(const Args& a, int li, int hh, int nq, LAS float* L, int tid) {
    const float* Wukv = ain(a, I_WUKV) + (size_t)li * 64 * 512; const float* gkv = ain(a, I_MKVN) + li * 64; const float* Wo = ain(a, I_WOUT) + (size_t)li * DM * DM;
    bf16* Wot = (bf16*)(a.ws + WS_WOT + li * WOT_BYTES);
    LAS float* WuvT = L; LAS float* Wos = L + 64 * 64;
    __syncthreads();
    for (int idx = tid; idx < 64 * 64; idx += 512) { const int j = idx >> 6, e = idx & 63; WuvT[e * 64 + j] = Wukv[j * 512 + hh * 128 + 64 + e] * gkv[j]; }
    for (int idx = tid; idx < 64 * 64; idx += 512) { const int e = idx >> 6, n4 = idx & 63; *(LAS f32x4*)(Wos + e * 256 + 4 * n4) = *(const f32x4*)(Wo + (size_t)(512 + 64 * hh + e) * DM + nq * 256 + 4 * n4); }
    __syncthreads();
    { const int n4 = tid & 63, j8 = tid >> 6; f32x4 acc[8];
#pragma unroll
        for (int j = 0; j < 8; ++j) acc[j] = (f32x4){0.f, 0.f, 0.f, 0.f};
#pragma unroll 4
        for (int e = 0; e < 64; ++e) { const f32x4 wv = *(const LAS f32x4*)(Wos + e * 256 + 4 * n4); const f32x4 u0 = *(const LAS f32x4*)(WuvT + e * 64 + 8 * j8), u1 = *(const LAS f32x4*)(WuvT + e * 64 + 8 * j8 + 4);
#pragma unroll
            for (int j = 0; j < 4; ++j) { acc[j] += wv * u0[j]; acc[4 + j] += wv * u1[j]; } }
#pragma unroll
        for (int t = 0; t < 4; ++t) { v4u w; w.x = pk2(acc[0][t], acc[1][t]); w.y = pk2(acc[2][t], acc[3][t]); w.z = pk2(acc[4][t], acc[5][t]); w.w = pk2(acc[6][t], acc[7][t]);
            *(v4u*)(Wot + (size_t)(nq * 256 + 4 * n4 + t) * DM + 512 + 64 * hh + 8 * j8) = w; } }
    __syncthreads();
}
__device__ __forceinline__ void p0_prologue(const Args& a, LAS unsigned char* lds, int tid, int lane, int wave) {
    const int G = gridDim.x;
    for (int rep = 0; rep < REP_FOLD; ++rep)
    for (int un = blockIdx.x; un < 40; un += G) {
        if (un < 8) wqa_unit(a, un >> 2, un & 3, (LAS float*)lds, tid);
        else { const int v = un - 8; wofold_unit(a, v >> 4, (v >> 2) & 3, v & 3, (LAS float*)lds, tid); }
    }
    __syncthreads();
    LAS float* scr = (LAS float*)(lds + wave * 16384);
    const int gw = blockIdx.x * 8 + wave, NGW = G * 8;
    constexpr int I_IN = 16 * 45, I_WO = 12 * 16, I_G = 16 * 44, I_D = 44 * 16;
    constexpr int NIT = 2 * I_IN + 2 * I_WO + 2 * I_G + I_D;
    for (int it = gw; it < NIT; it += NGW) {
        int r = it;
        if (r < 2 * I_IN) { const int li = r / I_IN; r %= I_IN; transpose_item(ain(a, I_WIN) + (size_t)li * DM * DIN, DM, DIN, ain(a, I_ANORM) + li * DM, (bf16*)(a.ws + WS_W1T + li * W1T_BYTES), r / 45, r % 45, 0, scr, lane); continue; } r -= 2 * I_IN;
        if (r < 2 * I_WO) { const int li = r / I_WO; r %= I_WO; int kb = r / 16; if (kb >= 8) kb += 4; transpose_item(ain(a, I_WOUT) + (size_t)li * DM * DM, DM, DM, nullptr, (bf16*)(a.ws + WS_WOT + li * WOT_BYTES), kb, r % 16, 0, scr, lane); continue; } r -= 2 * I_WO;
        if (r < I_G) { transpose_item(ain(a, I_FG), DM, DFF, ain(a, I_FNORM), (bf16*)(a.ws + WS_WGU), r / 44, r % 44, 1, scr, lane); continue; } r -= I_G;
        if (r < I_G) { transpose_item(ain(a, I_FU), DM, DFF, ain(a, I_FNORM), (bf16*)(a.ws + WS_WGU), r / 44, r % 44, 2, scr, lane); continue; } r -= I_G;
        transpose_item(ain(a, I_FD), DFF, DM, nullptr, (bf16*)(a.ws + WS_WD), r / 16, r % 16, 0, scr, lane);
    }
    const int gt = blockIdx.x * 512 + tid, NGT = G * 512;
    for (int i = gt; i < 2 * 208 * 128; i += NGT) { const int li = i / (208 * 128), r = i % (208 * 128);
        *(v4u*)(a.ws + WS_W1T + li * W1T_BYTES + (size_t)DIN * DM * 2 + (size_t)r * 16) = (v4u){0u, 0u, 0u, 0u}; }
    for (int i = gt; i < 8 * DM; i += NGT) { const int e = i >> 10, k = i & 1023; ((float*)(a.ws + WS_RT))[i] = ain(a, I_FNORM)[DM + k] * ain(a, I_ROUTER)[k * 8 + e]; }
    for (int i = gt; i < PSEQ * 48; i += NGT) { const int p = i / 48, j = i % 48; const bool isR = j < 32; const int f = isR ? j : j - 32;
        const float inv = __builtin_amdgcn_exp2f(-(float)f * (isR ? 13.287712379549449f / 32.f : 13.287712379549449f / 16.f));
        const double rev = (double)(p - 48) * (double)inv * 0.15915494309189535; const float fr = (float)(rev - __builtin_rint(rev));
        const f32x2 cs = {__builtin_amdgcn_cosf(fr), __builtin_amdgcn_sinf(fr)};
        if (isR) ((f32x2*)(a.ws + WS_TABR))[p * 32 + f] = cs; else ((f32x2*)(a.ws + WS_TABM))[p * 16 + f] = cs; }
    for (int i = gt; i < 240 * 128; i += NGT) *(v4u*)((unsigned char*)a.out + (size_t)(MR + 16) * 2048 + (size_t)i * 16) = (v4u){0u, 0u, 0u, 0u};
    bf16* hb = (bf16*)(a.ws + WS_HB); float* stA = (float*)(a.ws + WS_STA);
    for (int rep = 0; rep < REP_HINIT; ++rep)
    for (int r = gw; r < MROWS; r += NGW) {
        f32x4 v[4]; float s = 0.f;
#pragma unroll
        for (int j = 0; j < 4; ++j) { if (r < MR) v[j] = ((const f32x4*)(ain(a, I_X) + (size_t)r * DM))[lane + 64 * j]; else if (r < MR + NMETA) v[j] = ((const f32x4*)(ain(a, I_META) + (size_t)(r - MR) * DM))[lane + 64 * j]; else v[j] = (f32x4){0.f, 0.f, 0.f, 0.f};
            s += (v[j][0] * v[j][0] + v[j][1] * v[j][1]) + (v[j][2] * v[j][2] + v[j][3] * v[j][3]); }
        s = wave_sum(s);
#pragma unroll
        for (int j = 0; j < 4; ++j) { v2u w; w.x = pk2(v[j][0], v[j][1]); w.y = pk2(v[j][2], v[j][3]); ((v2u*)(hb + (size_t)r * DM))[lane + 64 * j] = w; }
        if (lane < 16) stA[(size_t)r * 16 + lane] = lane == 0 ? s : 0.f;
    }
}

__device__ __forceinline__ int src_row(int b, int c, int i) { return c == 0 ? (i < 48 ? -1 : MR + i - 48) : b * TT + 64 * (c - 1) + i; }
__device__ __forceinline__ float lg2gamma(int h) { return h == 0 ? -0.045803689613124789f : h == 1 ? -0.022720076500083529f : h == 2 ? -0.011315313227834146f : -0.0056465631411420627f; }

__device__ __forceinline__ void route_block(const Args& a, int blk, LAS unsigned char* lds, int tid, int lane, int wave) {
    LAS float* Rs = (LAS float*)lds; LAS int* lcnt = (LAS int*)(lds + 32768); LAS int* gbase = lcnt + 8; LAS int* rec = lcnt + 16;
    gu32* ctl = (gu32*)(a.ws + WS_CTL);
    const float* Rt = (const float*)(a.ws + WS_RT); const bf16* hb = (const bf16*)(a.ws + WS_HB); const float* stB = (const float*)(a.ws + WS_STB);
    __syncthreads();
    for (int idx = tid; idx < 8 * DM; idx += 512) Rs[idx] = Rt[idx];
    if (tid < 8) lcnt[tid] = 0;
    __syncthreads();
    for (int rr = 0; rr < 16; ++rr) { const int rl = wave * 16 + rr, row = blk * 128 + rl;
        const v4u w0 = *(const v4u*)(hb + (size_t)row * DM + 8 * lane), w1 = *(const v4u*)(hb + (size_t)row * DM + 512 + 8 * lane);
        const float x[16] = {bflo(w0.x), bfhi(w0.x), bflo(w0.y), bfhi(w0.y), bflo(w0.z), bfhi(w0.z), bflo(w0.w), bfhi(w0.w), bflo(w1.x), bfhi(w1.x), bflo(w1.y), bfhi(w1.y), bflo(w1.z), bfhi(w1.z), bflo(w1.w), bfhi(w1.w)};
        { unsigned q0 = (unsigned)__builtin_amdgcn_cvt_pk_fp8_f32(x[0], x[1], 0, false); q0 = (unsigned)__builtin_amdgcn_cvt_pk_fp8_f32(x[2], x[3], (int)q0, true);
          unsigned q1 = (unsigned)__builtin_amdgcn_cvt_pk_fp8_f32(x[4], x[5], 0, false); q1 = (unsigned)__builtin_amdgcn_cvt_pk_fp8_f32(x[6], x[7], (int)q1, true);
          unsigned q2 = (unsigned)__builtin_amdgcn_cvt_pk_fp8_f32(x[8], x[9], 0, false); q2 = (unsigned)__builtin_amdgcn_cvt_pk_fp8_f32(x[10], x[11], (int)q2, true);
          unsigned q3 = (unsigned)__builtin_amdgcn_cvt_pk_fp8_f32(x[12], x[13], 0, false); q3 = (unsigned)__builtin_amdgcn_cvt_pk_fp8_f32(x[14], x[15], (int)q3, true);
          unsigned char* h8 = a.ws + B_HB8 + (size_t)row * DM;
          *(uint2*)(h8 + 8 * lane) = make_uint2(q0, q1); *(uint2*)(h8 + 512 + 8 * lane) = make_uint2(q2, q3); }
        float st = lane < 16 ? stB[(size_t)row * 16 + lane] : 0.f; st = wave_sum(st); const float rs = __builtin_amdgcn_rsqf(st * (1.f / 1024.f) + EPS);
        float lg[8];
#pragma unroll
        for (int e = 0; e < 8; ++e) { float s = 0.f;
#pragma unroll
            for (int t = 0; t < 8; ++t) s += x[t] * Rs[e * DM + 8 * lane + t] + x[8 + t] * Rs[e * DM + 512 + 8 * lane + t];
            lg[e] = wave_sum(s) * rs; }
        int e0 = 0; float v0 = lg[0];
#pragma unroll
        for (int e = 1; e < 8; ++e) if (lg[e] > v0) { v0 = lg[e]; e0 = e; }
        int e1 = -1; float v1 = -3.0e38f;
#pragma unroll
        for (int e = 0; e < 8; ++e) if (e != e0 && lg[e] > v1) { v1 = lg[e]; e1 = e; }
        const float g0 = 1.f / (1.f + __expf(v1 - v0)), g1 = 1.f - g0;
        if (lane == 0) { const int lp0 = atomicAdd((int*)(lcnt + e0), 1), lp1 = atomicAdd((int*)(lcnt + e1), 1);
            rec[rl * 6] = e0; rec[rl * 6 + 1] = e1; rec[rl * 6 + 2] = lp0; rec[rl * 6 + 3] = lp1; rec[rl * 6 + 4] = __float_as_int(g0); rec[rl * 6 + 5] = __float_as_int(g1); } }
    __syncthreads();
    if (tid < 8) gbase[tid] = (int)__hip_atomic_fetch_add(ctl + CW_CNT + 64 * tid, (unsigned)lcnt[tid], RLX_AGENT);
    __syncthreads();
    if (tid < 256) { const int rl = tid >> 1, s = tid & 1, tok = blk * 128 + rl, e = rec[rl * 6 + s];
        ((int*)(a.ws + MO_TOKE))[tok * 2 + s] = e; ((int*)(a.ws + MO_TOKP))[tok * 2 + s] = gbase[e] + rec[rl * 6 + 2 + s]; ((int*)(a.ws + MO_TOKW))[tok * 2 + s] = rec[rl * 6 + 4 + s]; }
    __syncthreads();
}
__device__ __forceinline__ void moe_offsets(const Args& a, LAS int* offs, int tid) {
    gu32* ctl = (gu32*)(a.ws + WS_CTL);
    __syncthreads();
    if (tid == 0) { int o = 0;
        for (int e = 0; e < 8; ++e) { const int cnt = (int)__hip_atomic_load(ctl + CW_CNT + 64 * e, RLX_AGENT); offs[e] = o * 256; o += (cnt + 255) >> 8; }
        offs[8] = o; }
    __syncthreads();
}

typedef float f32x16 __attribute__((ext_vector_type(16)));
typedef short s16x8 __attribute__((ext_vector_type(8)));
typedef short s16x4 __attribute__((ext_vector_type(4)));
typedef short v4i16_t __attribute__((ext_vector_type(4)));
__device__ __forceinline__ int crow(int r, int hi) { return (r & 3) + 8 * (r >> 2) + 4 * hi; }


__device__ __forceinline__ void stage_cols(const bf16* proj, int b, int c, int col0, int ncols, LAS bf16* S, int sst, int lcol0, int tid) {
    const int cpr = ncols >> 3;
    for (int idx = tid; idx < 64 * cpr; idx += 512) { const int i = idx / cpr, ch = idx - i * cpr, sr = src_row(b, c, i);
        v4u v = {0u, 0u, 0u, 0u}; if (sr >= 0) v = *(const v4u*)(proj + (size_t)sr * N1 + col0 + ch * 8);
        *(LAS v4u*)(S + i * sst + lcol0 + ch * 8) = v; }
}
__device__ __forceinline__ v4u gather8(const LAS bf16* S, int sst, int row0, int col) {
    unsigned x[8];
#pragma unroll
    for (int t = 0; t < 8; ++t) x[t] = S[(row0 + t) * sst + col];
    v4u w; w.x = x[0] | (x[1] << 16); w.y = x[2] | (x[3] << 16); w.z = x[4] | (x[5] << 16); w.w = x[6] | (x[7] << 16); return w;
}
__device__ __forceinline__ void prep2_unit(const Args& a, int li, int b, int c, int part, LAS unsigned char* lds, int tid) {
    const bf16* proj = (const bf16*)(a.ws + B_PROJ);
    LAS bf16* S = (LAS bf16*)lds;
    const int blk0 = (b * NCH + c) * 4; const size_t prow0 = (size_t)b * PSEQ + 64 * c;
    unsigned char* dout = (unsigned char*)a.out;
    __syncthreads();
    if (part == 0) {
        constexpr int SST = 536; LAS float* seg = (LAS float*)(lds + 64 * SST * 2);
        stage_cols(proj, b, c, C_AQ, 128, S, SST, 0, tid); stage_cols(proj, b, c, C_AK, 128, S, SST, 128, tid); stage_cols(proj, b, c, C_ALR, 16, S, SST, 512, tid);
        __syncthreads();
        { const int ch = tid & 127, sg = tid >> 7; const float* Wg = ain(a, I_GWG) + (size_t)li * 16 * 128; const float bg = ain(a, I_GBG)[li * 128 + ch];
            float wg[16];
#pragma unroll
            for (int r = 0; r < 16; ++r) wg[r] = Wg[r * 128 + ch];
            float cl[16]; float run = 0.f;
#pragma unroll
            for (int t = 0; t < 16; ++t) { const int i = 16 * sg + t; const v4u l0 = *(const LAS v4u*)(S + i * SST + 512), l1 = *(const LAS v4u*)(S + i * SST + 520);
                float x = bg + bflo(l0.x) * wg[0] + bfhi(l0.x) * wg[1] + bflo(l0.y) * wg[2] + bfhi(l0.y) * wg[3] + bflo(l0.z) * wg[4] + bfhi(l0.z) * wg[5] + bflo(l0.w) * wg[6] + bfhi(l0.w) * wg[7]
                               + bflo(l1.x) * wg[8] + bfhi(l1.x) * wg[9] + bflo(l1.y) * wg[10] + bfhi(l1.y) * wg[11] + bflo(l1.z) * wg[12] + bfhi(l1.z) * wg[13] + bflo(l1.w) * wg[14] + bfhi(l1.w) * wg[15];
                const float ls = fminf(x, 0.f) - __logf(1.f + __expf(-fabsf(x)));
                run += (c > 0 || i >= 48) ? ls * (1.f / 16.f) : 0.f; cl[t] = run; }
            seg[sg * 128 + ch] = run;
            __syncthreads();
            float off = 0.f;
#pragma unroll
            for (int s2 = 0; s2 < 3; ++s2) off += s2 < sg ? seg[s2 * 128 + ch] : 0.f;
            if (sg == 3) ((float*)(a.ws + WS_GD))[(size_t)(blk0 + (ch >> 5)) * 32 + (ch & 31)] = __expf(off + run);
#pragma unroll
            for (int t = 0; t < 16; ++t) { const int i = 16 * sg + t; const float cum = cl[t] + off;
                S[i * SST + ch] = (bf16)f2bf(bf2f(S[i * SST + ch]) * 0.17677669529663687f * __expf(cum)); S[i * SST + 128 + ch] = (bf16)f2bf(bf2f(S[i * SST + 128 + ch]) * __expf(-cum)); } }
        __syncthreads();
        for (int idx = tid; idx < 1024; idx += 512) { const int d8 = idx & 3, i = (idx >> 2) & 63, h = idx >> 8;
            *(v4u*)(a.ws + B_GQ + (size_t)(blk0 + h) * GQ_T + i * 80 + 16 * d8) = *(const LAS v4u*)(S + i * SST + h * 32 + 8 * d8);
            *(v4u*)(a.ws + B_GK + (size_t)(blk0 + h) * GQ_T + i * 80 + 16 * d8) = *(const LAS v4u*)(S + i * SST + 128 + h * 32 + 8 * d8); }
    } else if (part == 1) {
        constexpr int SST = 776;
        stage_cols(proj, b, c, C_RQ, 256, S, SST, 0, tid); stage_cols(proj, b, c, C_RK, 256, S, SST, 256, tid);
        LAS f32x4* tabL = (LAS f32x4*)(lds + 64 * SST * 2);
        for (int idx = tid; idx < 64 * 16; idx += 512) tabL[idx] = ((const f32x4*)(a.ws + WS_TABR))[(size_t)(64 * c) * 16 + idx];
        __syncthreads();
        const LAS f32x2* tabR = (const LAS f32x2*)tabL;
        for (int idx = tid; idx < 64 * 4 * 32; idx += 512) { const int j = idx & 31, h = (idx >> 5) & 3, i = idx >> 7; const f32x2 cs = tabR[i * 32 + j];
            LAS bf16* qp = S + i * SST + h * 64 + j; LAS bf16* kp = qp + 256;
            const float a1 = bf2f(qp[0]), a2 = bf2f(qp[32]), b1 = bf2f(kp[0]), b2 = bf2f(kp[32]);
            const float e = (float)(i + 1) * lg2gamma(h); const float fq = __builtin_amdgcn_exp2f(e), fk = 0.125f * __builtin_amdgcn_exp2f(-e);
            qp[0] = (bf16)f2bf((a1 * cs[0] - a2 * cs[1]) * fq); qp[32] = (bf16)f2bf((a1 * cs[1] + a2 * cs[0]) * fq); kp[0] = (bf16)f2bf((b1 * cs[0] - b2 * cs[1]) * fk); kp[32] = (bf16)f2bf((b1 * cs[1] + b2 * cs[0]) * fk); }
        __syncthreads();
        for (int idx = tid; idx < 2048; idx += 512) { const int d8 = idx & 7, i = (idx >> 3) & 63, h = idx >> 9;
            *(v4u*)(a.ws + B_RQ + (size_t)(blk0 + h) * RT_T + i * 144 + 16 * d8) = *(const LAS v4u*)(S + i * SST + h * 64 + 8 * d8);
            *(v4u*)(a.ws + B_RK + (size_t)(blk0 + h) * RT_T + i * 144 + 16 * d8) = *(const LAS v4u*)(S + i * SST + 256 + h * 64 + 8 * d8); }
    } else if (part == 2) {
        constexpr int SST = 296, OFF_RSD = 64 * SST * 2, OFF_TAB = OFF_RSD + 512, OFF_QS = OFF_TAB + 8192, QSS = 392;
        LAS float* rsd = (LAS float*)(lds + OFF_RSD); LAS f32x4* tabL = (LAS f32x4*)(lds + OFF_TAB); LAS bf16* Qs = (LAS bf16*)(lds + OFF_QS);
        stage_cols(proj, b, c, C_CQ, 192, S, SST, 0, tid); stage_cols(proj, b, c, C_CKV, 64, S, SST, 192, tid); stage_cols(proj, b, c, C_KPE, 32, S, SST, 256, tid);
        for (int idx = tid; idx < 64 * 8; idx += 512) tabL[idx] = ((const f32x4*)(a.ws + WS_TABM))[(size_t)(64 * c) * 8 + idx];
        __syncthreads();
        { const int i = tid >> 3, g = tid & 7; float sq = 0.f, sk = 0.f;
#pragma unroll
            for (int t = 0; t < 24; ++t) { const float v = bf2f(S[i * SST + g * 24 + t]); sq += v * v; }
#pragma unroll
            for (int t = 0; t < 8; ++t) { const float v = bf2f(S[i * SST + 192 + g * 8 + t]); sk += v * v; }
            sq += __shfl_xor(sq, 1); sq += __shfl_xor(sq, 2); sq += __shfl_xor(sq, 4); sk += __shfl_xor(sk, 1); sk += __shfl_xor(sk, 2); sk += __shfl_xor(sk, 4);
            if (g == 0) { rsd[i * 2] = __builtin_amdgcn_rsqf(sq * (1.f / 192.f) + EPS); rsd[i * 2 + 1] = __builtin_amdgcn_rsqf(sk * (1.f / 64.f) + EPS); } }
        __syncthreads();
        const LAS f32x2* tabM = (const LAS f32x2*)tabL; const float QS = 0.10206207261596577f * LOG2E;
        {
            const int lane = tid & 63, w = __builtin_amdgcn_readfirstlane(tid >> 6), r32 = lane & 31, hi = lane >> 5, ib = w & 1, nb0 = (w >> 1) * 3;
            const bf16* WqaT = (const bf16*)(a.ws + WS_WQA + li * WQA_BYTES);
            s16x8 af[12];
#pragma unroll
            for (int ks = 0; ks < 12; ++ks) af[ks] = *(const LAS s16x8*)(S + (32 * ib + r32) * SST + 16 * ks + 8 * hi);
            f32x16 acc[3];
#pragma unroll
            for (int j = 0; j < 3; ++j) { acc[j] = (f32x16){};
                s16x8 bfr[12];
#pragma unroll
                for (int ks = 0; ks < 12; ++ks) bfr[ks] = *(const s16x8*)(WqaT + (size_t)(32 * (nb0 + j) + r32) * 192 + 16 * ks + 8 * hi);
#pragma unroll
                for (int ks = 0; ks < 12; ++ks) acc[j] = __builtin_amdgcn_mfma_f32_32x32x16_bf16(af[ks], bfr[ks], acc[j], 0, 0, 0); }
            asm volatile("s_nop 15\n\ts_nop 7" : "+v"(acc[0]), "+v"(acc[1]), "+v"(acc[2]));
#pragma unroll
            for (int j = 0; j < 3; ++j)
#pragma unroll
                for (int r = 0; r < 16; ++r) { const int i = 32 * ib + crow(r, hi); float v = acc[j][r] * (rsd[i * 2] * QS);
                    if (j == 2) { const float o = __shfl_xor(v, 16); const f32x2 cs = tabM[i * 16 + (r32 & 15)]; v = r32 < 16 ? v * cs[0] - o * cs[1] : o * cs[1] + v * cs[0]; }
                    Qs[i * QSS + 32 * (nb0 + j) + r32] = (bf16)f2bf(v); } }
        for (int idx = tid; idx < 64 * 12; idx += 512) { const int k8 = idx % 12, i = idx / 12; float y[8];
            if (k8 < 8) { const float s = rsd[i * 2 + 1];
#pragma unroll
                for (int t = 0; t < 8; ++t) y[t] = bf2f(S[i * SST + 192 + 8 * k8 + t]) * s; }
            else { const int kk = (k8 - 8) & 1, second = (k8 - 8) >> 1;
#pragma unroll
                for (int t = 0; t < 8; ++t) { const int j = 8 * kk + t; const f32x2 cs = tabM[i * 16 + j]; const float x1 = bf2f(S[i * SST + 256 + j]), x2 = bf2f(S[i * SST + 272 + j]); y[t] = second ? x1 * cs[1] + x2 * cs[0] : x1 * cs[0] - x2 * cs[1]; } }
            v4u w; w.x = pk2(y[0], y[1]); w.y = pk2(y[2], y[3]); w.z = pk2(y[4], y[5]); w.w = pk2(y[6], y[7]);
            *(v4u*)((bf16*)(a.ws + B_MK) + (prow0 + i) * 96 + 8 * k8) = w; }
        __syncthreads();
        for (int idx = tid; idx < 64 * 48; idx += 512) { const int c8 = idx % 48, i = idx / 48;
            *(v4u*)((bf16*)(a.ws + B_MQ) + (prow0 + i) * 384 + 8 * c8) = *(const LAS v4u*)(Qs + i * QSS + 8 * c8); }
    }
}

template <int KIND>
__device__ __forceinline__ void attn_mfma_unit(const Args& a, int li, int b, int hh, int qb  , LAS unsigned char* lds, int tid, float lam, float oscale) {
    constexpr int KW = KIND ? 64 : 96, KST = KW + 8, VST = 72, NMAP = KIND ? 2 : 1, DSTEPS = KIND ? 2 : 6;
    constexpr int KCH = KW / 8 + 1, NPIECE = KCH + (KIND ? 9 : 0), PPW = KIND ? 3 : 2, SLOT = NPIECE * 1024, NSLOT = 4, OFF_JUNK = NSLOT * SLOT, OFF_WS = OFF_JUNK + 6144, OSTW = 68, OFF_OST = KIND ? 0   : OFF_WS + 2048;
    static_assert(PPW * 8 >= NPIECE && PPW * 8 - NPIECE <= 6 && (KIND ? 8 * 32 * OSTW * 4 <= NSLOT * SLOT : OFF_OST + 8 * 32 * OSTW * 4 <= RING_BYTES) && OFF_WS + 8 * 256 <= RING_BYTES, "attention LDS map / pieces per wave");
    const int lane = tid & 63, w = __builtin_amdgcn_readfirstlane(tid >> 6), r32 = lane & 31, hi = lane >> 5;
    const int q0 = qb < 0 ? 0 : 64 + 256 * qb, NT = qb < 0 ? 1 : 5 + 4 * qb;
    const bool wact = qb >= 0 || w < 2;
    const int qpos = q0 + 32 * w + r32, wlast = (q0 + 32 * w + 31) >> 6;
    const size_t prow = (size_t)b * PSEQ + qpos;
    const bf16* proj = (const bf16*)(a.ws + B_PROJ);
    const bf16* Kg = KIND ? proj + C_DK + hh * 64 : (const bf16*)(a.ws + B_MK) + (size_t)b * PSEQ * 96;
    constexpr int KLD = KIND ? N1 : 96;
    const bf16* Vg = proj + C_DV + hh * 64;
#define ATT_SRCROW(t_, r_) (KIND ? ((t_) == 0 ? ((r_) < 48 ? MR : MR + (r_) - 48) : b * TT + 64 * ((t_) - 1) + (r_)) : 64 * (t_) + (r_))
    LAS float* wsf = (LAS float*)(lds + OFF_WS) + w * 64;
    LAS float* ost = (LAS float*)(lds + OFF_OST) + w * (32 * OSTW);
    s16x8 qf[NMAP][DSTEPS];
#pragma unroll
    for (int m = 0; m < NMAP; ++m)
#pragma unroll
        for (int ds = 0; ds < DSTEPS; ++ds) {
            const int qsr = qb >= 0 ? b * TT + qpos - 64 : (qpos >= 48 ? MR + qpos - 48 : MR);
            const bf16* qp = KIND ? proj + (size_t)qsr * N1 + C_DQ + hh * 64 + 32 * m + 16 * ds + 8 * hi : (const bf16*)(a.ws + B_MQ) + prow * 384 + hh * 96 + 16 * ds + 8 * hi;
            v4u qw = wact ? *(const v4u*)qp : (v4u){0u, 0u, 0u, 0u};
            if (KIND) { const float qs = 0.17677669529663687f * LOG2E;
                qw.x = pg8::cvt_pk_bf16(bflo(qw.x) * qs, bfhi(qw.x) * qs); qw.y = pg8::cvt_pk_bf16(bflo(qw.y) * qs, bfhi(qw.y) * qs); qw.z = pg8::cvt_pk_bf16(bflo(qw.z) * qs, bfhi(qw.z) * qs); qw.w = pg8::cvt_pk_bf16(bflo(qw.w) * qs, bfhi(qw.w) * qs); }
            qf[m][ds] = __builtin_bit_cast(s16x8, qw); }
    float mref[NMAP], lrun[NMAP]; f32x16 negm = (f32x16){}, o[NMAP][2];
#pragma unroll
    for (int m = 0; m < NMAP; ++m) { mref[m] = 0.f; lrun[m] = 0.f; o[m][0] = (f32x16){}; o[m][1] = (f32x16){}; }
#define ATT_DMA(t_) do { const int sl_ = ((t_) & 3) * SLOT; _Pragma("unroll") for (int j = 0; j < PPW; ++j) { const int p_ = __builtin_amdgcn_readfirstlane(w * PPW + j); \
        int row_, col_, dst_; const bf16* base_; int ld_; \
        if (p_ < KCH) { const int g = 64 * p_ + lane, cc = g % KCH; row_ = g / KCH; col_ = (cc < KCH - 1 ? cc : KCH - 2) * 8; dst_ = sl_ + p_ * 1024; base_ = Kg; ld_ = KLD; } \
        else if (p_ < NPIECE) { const int g = 64 * (p_ - KCH) + lane, cc = g % 9; row_ = g / 9; col_ = (cc < 8 ? cc : 7) * 8; dst_ = sl_ + p_ * 1024; base_ = Vg; ld_ = N1; } \
        else { row_ = lane & 15; col_ = 0; dst_ = OFF_JUNK + (p_ - NPIECE) * 1024; base_ = Kg; ld_ = KLD; } \
        const bf16* s_ = base_ + (size_t)ATT_SRCROW((t_), row_) * ld_ + col_; \
        __builtin_amdgcn_global_load_lds((const unsigned*)s_, (LAS unsigned*)(lds + __builtin_amdgcn_readfirstlane(dst_)), 16, 0, 0); } } while (0)
#define ATT_BAR() do { asm volatile("s_waitcnt lgkmcnt(0)" ::: "memory"); __builtin_amdgcn_s_barrier(); asm volatile("" ::: "memory"); } while (0)
    ATT_BAR();
    if (w >= 4) __builtin_amdgcn_s_setprio(1);
    ATT_DMA(0); if (NT > 1) ATT_DMA(1); if (NT > 2) ATT_DMA(2);
    for (int t = 0; t < NT; ++t) {
        if (t + 2 < NT) { if (KIND) asm volatile("s_waitcnt vmcnt(6)" ::: "memory"); else asm volatile("s_waitcnt vmcnt(4)" ::: "memory"); } else if (t + 1 < NT) { if (KIND) asm volatile("s_waitcnt vmcnt(3)" ::: "memory"); else asm volatile("s_waitcnt vmcnt(2)" ::: "memory"); } else asm volatile("s_waitcnt vmcnt(0)" ::: "memory");
        ATT_BAR();
        if (t + 3 < NT) ATT_DMA(t + 3);
        if (wact && t <= wlast) {
            const LAS unsigned char* Kb = lds + (t & 3) * SLOT; const LAS unsigned char* Vb = KIND ? Kb + KCH * 1024 : Kb;
            const bool need_mask = (t == 0) || (64 * t + 63 > q0 + 32 * w);
            constexpr int VRB = KIND ? 144 : KST * 2;
            const LAS unsigned char* vp0 = Vb + (4 * hi + ((lane & 15) >> 2)) * VRB + (16 * ((lane >> 4) & 1)) * 2 + 8 * (lane & 3);
#define ATT_VFRAG(d0_, ks_) ({ const LAS unsigned char* vp_ = vp0 + 16 * (ks_) * VRB + 64 * (d0_); \
        const s16x4 va_ = __builtin_bit_cast(s16x4, __builtin_amdgcn_ds_read_tr16_b64_v4i16((LAS v4i16_t*)vp_)), vb_ = __builtin_bit_cast(s16x4, __builtin_amdgcn_ds_read_tr16_b64_v4i16((LAS v4i16_t*)(vp_ + 8 * VRB))); \
        (s16x8){va_[0], va_[1], va_[2], va_[3], vb_[0], vb_[1], vb_[2], vb_[3]}; })
            s16x8 vfr0[4];
#pragma unroll
            for (int ks = 0; ks < 4; ++ks) vfr0[ks] = ATT_VFRAG(0, ks);
            __builtin_amdgcn_sched_barrier(0);
#pragma unroll
            for (int m = 0; m < NMAP; ++m) {
                f32x16 p0, p1;
                if (KIND) { const float nm = -mref[m];
#pragma unroll
                    for (int r = 0; r < 16; ++r) { p0[r] = nm; p1[r] = nm; } }
                else { p0 = negm; p1 = negm; }
                constexpr int KBATCH = KIND ? DSTEPS : 3;
#pragma unroll
                for (int d1 = 0; d1 < DSTEPS; d1 += KBATCH) {
                    s16x8 kfr[KBATCH][2];
#pragma unroll
                    for (int ds = 0; ds < KBATCH; ++ds) { kfr[ds][0] = *(const LAS s16x8*)(Kb + (r32 * KST + 32 * m * KIND + 16 * (d1 + ds) + 8 * hi) * 2); kfr[ds][1] = *(const LAS s16x8*)(Kb + ((32 + r32) * KST + 32 * m * KIND + 16 * (d1 + ds) + 8 * hi) * 2); }
                    __builtin_amdgcn_sched_barrier(0);

#pragma unroll
                    for (int ds = 0; ds < KBATCH; ++ds) { p0 = __builtin_amdgcn_mfma_f32_32x32x16_bf16(kfr[ds][0], qf[m][d1 + ds], p0, 0, 0, 0); p1 = __builtin_amdgcn_mfma_f32_32x32x16_bf16(kfr[ds][1], qf[m][d1 + ds], p1, 0, 0, 0); }

                    __builtin_amdgcn_sched_barrier(0); }
                asm volatile("s_nop 15\n\ts_nop 7" : "+v"(p0), "+v"(p1));

                if (need_mask) {
#pragma unroll
                    for (int r = 0; r < 16; ++r) { const int kv = 64 * t + crow(r, hi);
                        if (kv > qpos || kv < 48) p0[r] = -1e30f;
                        if (kv + 32 > qpos || kv + 32 < 48) p1[r] = -1e30f; } }
                float mx = fmaxf(fmaxf(p0[0], p1[0]), fmaxf(p0[1], p1[1]));
#pragma unroll
                for (int r = 2; r < 16; r += 2) mx = fmaxf(mx, fmaxf(fmaxf(p0[r], p1[r]), fmaxf(p0[r + 1], p1[r + 1])));
                { auto rr = __builtin_amdgcn_permlane32_swap(__float_as_uint(mx), __float_as_uint(mx), false, false); mx = fmaxf(__uint_as_float(rr[0]), __uint_as_float(rr[1])); }
                if (t == 0 || __any(mx > 6.0f)) {
                    const float delta = t == 0 ? mx : fmaxf(mx, 0.f); mref[m] += delta;
#pragma unroll
                    for (int r = 0; r < 16; ++r) { p0[r] -= delta; p1[r] -= delta; if (!KIND) negm[r] = -mref[m]; }
                    if (t != 0) { const float alpha = __builtin_amdgcn_exp2f(-delta); lrun[m] *= alpha;
                        if (hi == 0) wsf[r32] = alpha;
                        f32x4 al[4];
#pragma unroll
                        for (int g = 0; g < 4; ++g) al[g] = *(const LAS f32x4*)(wsf + 8 * g + 4 * hi);
#pragma unroll
                        for (int r = 0; r < 16; ++r) { o[m][0][r] *= al[r >> 2][r & 3]; o[m][1][r] *= al[r >> 2][r & 3]; } } }
                float ls = 0.f;
#pragma unroll
                for (int r = 0; r < 16; ++r) { p0[r] = __builtin_amdgcn_exp2f(p0[r]); p1[r] = __builtin_amdgcn_exp2f(p1[r]); ls += p0[r] + p1[r]; }
                lrun[m] += ls;
                s16x8 pw[4];
#pragma unroll
                for (int ks = 0; ks < 4; ++ks) { v4u u;
                    if (ks < 2) { u.x = pg8::cvt_pk_bf16(p0[8 * ks], p0[8 * ks + 1]); u.y = pg8::cvt_pk_bf16(p0[8 * ks + 2], p0[8 * ks + 3]); u.z = pg8::cvt_pk_bf16(p0[8 * ks + 4], p0[8 * ks + 5]); u.w = pg8::cvt_pk_bf16(p0[8 * ks + 6], p0[8 * ks + 7]); }
                    else { const int k2 = ks - 2; u.x = pg8::cvt_pk_bf16(p1[8 * k2], p1[8 * k2 + 1]); u.y = pg8::cvt_pk_bf16(p1[8 * k2 + 2], p1[8 * k2 + 3]); u.z = pg8::cvt_pk_bf16(p1[8 * k2 + 4], p1[8 * k2 + 5]); u.w = pg8::cvt_pk_bf16(p1[8 * k2 + 6], p1[8 * k2 + 7]); }
                    pw[ks] = __builtin_bit_cast(s16x8, u); }

#pragma unroll
                for (int ks = 0; ks < 4; ++ks) o[m][0] = __builtin_amdgcn_mfma_f32_32x32x16_bf16(pw[ks], vfr0[ks], o[m][0], 0, 0, 0);

                { s16x8 vfr1[4];
#pragma unroll
                    for (int ks = 0; ks < 4; ++ks) vfr1[ks] = ATT_VFRAG(1, ks);
                    __builtin_amdgcn_sched_barrier(0);

#pragma unroll
                    for (int ks = 0; ks < 4; ++ks) o[m][1] = __builtin_amdgcn_mfma_f32_32x32x16_bf16(pw[ks], vfr1[ks], o[m][1], 0, 0, 0); }

            }
        }
    }
#undef ATT_DMA
#undef ATT_VFRAG
#undef ATT_SRCROW
    __builtin_amdgcn_s_setprio(0);
    ATT_BAR();
    if (KIND) { const LAS float* lp = (const LAS float*)(lds + RING_BYTES + 256); lam = lp[0]; oscale = lp[1]; }
    if (wact) {
#pragma unroll
        for (int m = 0; m < NMAP; ++m) asm volatile("s_nop 15\n\ts_nop 7" : "+v"(o[m][0]), "+v"(o[m][1]));
        float il0, il1 = 0.f;
        { float l = lrun[0]; l += __shfl_xor(l, 32); il0 = l > 0.f ? 1.f / l : 0.f; }
        if (KIND) { float l = lrun[NMAP - 1]; l += __shfl_xor(l, 32); il1 = l > 0.f ? lam / l : 0.f; }
        if (hi == 0) { wsf[r32] = il0; wsf[32 + r32] = il1; }
        f32x4 a0[4], a1[4];
#pragma unroll
        for (int g = 0; g < 4; ++g) { a0[g] = *(const LAS f32x4*)(wsf + 8 * g + 4 * hi); a1[g] = *(const LAS f32x4*)(wsf + 32 + 8 * g + 4 * hi); }
#pragma unroll
        for (int d0 = 0; d0 < 2; ++d0)
#pragma unroll
            for (int r = 0; r < 16; ++r) { float v = o[0][d0][r] * a0[r >> 2][r & 3]; if (KIND) v -= o[NMAP - 1][d0][r] * a1[r >> 2][r & 3];
                ost[crow(r, hi) * OSTW + 32 * d0 + r32] = v; }
        const int row = lane >> 1, half = lane & 1, p = q0 + 32 * w + row;
        f32x4 v[8]; float ss = 0.f;
#pragma unroll
        for (int i = 0; i < 8; ++i) { v[i] = *(const LAS f32x4*)(ost + row * OSTW + 32 * half + 4 * i); ss += (v[i][0] * v[i][0] + v[i][1] * v[i][1]) + (v[i][2] * v[i][2] + v[i][3] * v[i][3]); }
        ss += __shfl_xor(ss, 1);
        const float rs = KIND ? __builtin_amdgcn_rsqf(ss * (1.f / 64.f) + EPS) * oscale : 1.f;
        const int sr = qb >= 0 ? b * TT + p - 64 : ((p >= 48 && b == 0) ? MR + p - 48 : -1);
        if (sr >= 0) { bf16* dst = (bf16*)a.out + (size_t)sr * DM + (KIND ? 768 : 512) + hh * 64 + 32 * half; const float* gn = ain(a, I_DNORM) + li * 64 + 32 * half;
#pragma unroll
            for (int i = 0; i < 4; ++i) { f32x4 x0 = v[2 * i] * rs, x1 = v[2 * i + 1] * rs;
                if (KIND) { const f32x4 g0 = *(const f32x4*)(gn + 8 * i), g1 = *(const f32x4*)(gn + 8 * i + 4); x0 = x0 * g0; x1 = x1 * g1; }
                *(v4u*)(dst + 8 * i) = pack8(x0, x1); } }
    }
    ATT_BAR();
#undef ATT_BAR
}

__device__ __forceinline__ s16x8 ldperm(const bf16* p, int hi) { const s16x4 x = *(const s16x4*)(p + 4 * hi), y = *(const s16x4*)(p + 8 + 4 * hi); return (s16x8){x[0], x[1], x[2], x[3], y[0], y[1], y[2], y[3]}; }
__device__ __forceinline__ s16x8 packacc(const f32x16& v, int k) { v4u u; u.x = pg8::cvt_pk_bf16(v[8 * k], v[8 * k + 1]); u.y = pg8::cvt_pk_bf16(v[8 * k + 2], v[8 * k + 3]); u.z = pg8::cvt_pk_bf16(v[8 * k + 4], v[8 * k + 5]); u.w = pg8::cvt_pk_bf16(v[8 * k + 6], v[8 * k + 7]); return __builtin_bit_cast(s16x8, u); }
__device__ __forceinline__ s16x8 ldperm_lds(const LAS unsigned char* p, int hi) { const s16x4 x = *(const LAS s16x4*)(p + 8 * hi), y = *(const LAS s16x4*)(p + 16 + 8 * hi); return (s16x8){x[0], x[1], x[2], x[3], y[0], y[1], y[2], y[3]}; }
template <int KIND>
__device__ __forceinline__ void lin_mfma_unit(const Args& a, int li, int b, int hp, LAS unsigned char* lds, int tid) {
    constexpr int DK = KIND ? 64 : 32, NDS = DK / 16, NDB = DK / 32, OTW = 68;
    constexpr int QROW = KIND ? 144 : 80, QT = KIND ? RT_T : GQ_T, HB = 2 * QT + VT_T, PPH = HB / 1024, NP = 2 * PPH;
    constexpr int OFF_OT = 2 * HB, OFF_G = OFF_OT + 2 * 64 * OTW * 4;
    static_assert(HB % 1024 == 0 && OFF_G + 256 <= RING_BYTES, "lin unit LDS map");
    const int lane = tid & 63, w = __builtin_amdgcn_readfirstlane(tid >> 6), r32 = lane & 31, hi = lane >> 5, hl = w >> 2, e0 = 32 * ((w >> 1) & 1), ib = w & 1, h = 2 * hp + hl;
    const unsigned char* Qg = a.ws + (KIND ? B_RQ : B_GQ); const unsigned char* Kg = a.ws + (KIND ? B_RK : B_GK);
    const bf16* proj = (const bf16*)(a.ws + B_PROJ); bf16* ob = (bf16*)a.out;
    LAS float* Ot = (LAS float*)(lds + OFF_OT);
    LAS float* Gs = (LAS float*)(lds + OFF_G);
    const LAS unsigned char* Lh = lds + hl * HB;
    const float dret = __builtin_amdgcn_exp2f(64.f * lg2gamma(h));
    f32x16 S[NDB];
#pragma unroll
    for (int db = 0; db < NDB; ++db) S[db] = (f32x16){};
#define LIN_DMA(c_) do { _Pragma("unroll") for (int j_ = 0; j_ < (NP + 7) / 8; ++j_) { const int p_ = w + 8 * j_; if (p_ < NP) { const int hl_ = p_ / PPH, pp_ = p_ % PPH; const size_t blk_ = (size_t)(b * NCH + (c_)) * 4 + 2 * hp + hl_; \
        const unsigned char* src_; \
        if (pp_ < 2 * QT / 1024) src_ = (pp_ < QT / 1024 ? Qg + blk_ * QT + pp_ * 1024 : Kg + blk_ * QT + (pp_ - QT / 1024) * 1024) + lane * 16; \
        else { const int g_ = 64 * (pp_ - 2 * QT / 1024) + lane, s_ = g_ / 9, cc_ = g_ % 9; int sr_ = src_row(b, (c_), s_); sr_ = sr_ < 0 ? MR : sr_;     \
            src_ = (const unsigned char*)(proj + (size_t)sr_ * N1 + (KIND ? C_RV : C_AV) + (2 * hp + hl_) * 64 + (cc_ < 8 ? cc_ : 7) * 8); } \
        __builtin_amdgcn_global_load_lds((const unsigned*)src_, (LAS unsigned*)(lds + hl_ * HB + pp_ * 1024), 16, 0, 0); } } } while (0)
#define LIN_BAR() do { asm volatile("s_waitcnt lgkmcnt(0)" ::: "memory"); __builtin_amdgcn_s_barrier(); asm volatile("" ::: "memory"); } while (0)
    LIN_BAR();
    if (tid < 64) Gs[tid] = ain(a, KIND ? I_RNORM : I_GNORM)[li * 64 + tid];
    LIN_DMA(0);
    const int nh = tid >> 8, nrow = (tid >> 2) & 63, nq = tid & 3, hn = 2 * hp + nh;
    for (int c = 0; c < NCH; ++c) {
        asm volatile("s_waitcnt vmcnt(0)" ::: "memory"); LIN_BAR();
        s16x8 qf[NDS], kf0[NDS], kf1[NDS], vf[4], ktf[NDB][4];
        const int sr = src_row(b, c, nrow); const bool wr = sr >= 0 && (c > 0 || b == 0);
#pragma unroll
        for (int ds = 0; ds < NDS; ++ds) { qf[ds] = ldperm_lds(Lh + (32 * ib + r32) * QROW + 32 * ds, hi); kf0[ds] = ldperm_lds(Lh + QT + r32 * QROW + 32 * ds, hi); kf1[ds] = ldperm_lds(Lh + QT + (32 + r32) * QROW + 32 * ds, hi); }
        const int trq = (lane & 15) >> 2, trb = (lane >> 4) & 1, trp = lane & 3;
#pragma unroll
        for (int ks = 0; ks < 4; ++ks) { const LAS unsigned char* vp = Lh + 2 * QT + (16 * ks + 4 * hi + trq) * 144 + (e0 + 16 * trb) * 2 + 8 * trp;
            const s16x4 va = __builtin_bit_cast(s16x4, __builtin_amdgcn_ds_read_tr16_b64_v4i16((LAS v4i16_t*)vp)), vb = __builtin_bit_cast(s16x4, __builtin_amdgcn_ds_read_tr16_b64_v4i16((LAS v4i16_t*)(vp + 8 * 144)));
            vf[ks] = (s16x8){va[0], va[1], va[2], va[3], vb[0], vb[1], vb[2], vb[3]}; }
        f32x16 aA = (f32x16){}, aB = (f32x16){};
#pragma unroll
        for (int ds = 0; ds < NDS; ++ds) { aA = __builtin_amdgcn_mfma_f32_32x32x16_bf16(kf0[ds], qf[ds], aA, 0, 0, 0); if (ib) aB = __builtin_amdgcn_mfma_f32_32x32x16_bf16(kf1[ds], qf[ds], aB, 0, 0, 0); }
        asm volatile("s_nop 15\n\ts_nop 15" : "+v"(aA), "+v"(aB));
#pragma unroll
        for (int r = 0; r < 16; ++r) if (crow(r, hi) > r32) { if (ib) aB[r] = 0.f; else aA[r] = 0.f; }
        f32x16 O = (f32x16){};
#pragma unroll
        for (int db = 0; db < NDB; ++db)
#pragma unroll
            for (int ksub = 0; ksub < 2; ++ksub) O = __builtin_amdgcn_mfma_f32_32x32x16_bf16(qf[2 * db + ksub], packacc(S[db], ksub), O, 0, 0, 0);
#pragma unroll
        for (int ksub = 0; ksub < 2; ++ksub) { O = __builtin_amdgcn_mfma_f32_32x32x16_bf16(packacc(aA, ksub), vf[ksub], O, 0, 0, 0); if (ib) O = __builtin_amdgcn_mfma_f32_32x32x16_bf16(packacc(aB, ksub), vf[2 + ksub], O, 0, 0, 0); }
#pragma unroll
        for (int db = 0; db < NDB; ++db)
#pragma unroll
            for (int ks = 0; ks < 4; ++ks) { const LAS unsigned char* kp = Lh + QT + (16 * ks + 4 * hi + trq) * QROW + (32 * db + 16 * trb) * 2 + 8 * trp;
                const s16x4 ka = __builtin_bit_cast(s16x4, __builtin_amdgcn_ds_read_tr16_b64_v4i16((LAS v4i16_t*)kp)), kb = __builtin_bit_cast(s16x4, __builtin_amdgcn_ds_read_tr16_b64_v4i16((LAS v4i16_t*)(kp + 8 * QROW)));
                ktf[db][ks] = (s16x8){ka[0], ka[1], ka[2], ka[3], kb[0], kb[1], kb[2], kb[3]}; }
        LIN_BAR();
        v4u og[2];
#pragma unroll
        for (int i = 0; i < 2; ++i) og[i] = wr ? *(const v4u*)(proj + (size_t)sr * N1 + (KIND ? C_ROG : C_AOG) + hn * 64 + 16 * nq + 8 * i) : (v4u){0u, 0u, 0u, 0u};
        f32x4 dvv[4];
        if (!KIND) { const float* dp = (const float*)(a.ws + WS_GD) + ((size_t)(b * NCH + c) * 4 + h) * 32;
#pragma unroll
            for (int g = 0; g < 4; ++g) dvv[g] = *(const f32x4*)(dp + 8 * g + 4 * hi); }
        if (c + 1 < NCH) LIN_DMA(c + 1);
#pragma unroll
        for (int db = 0; db < NDB; ++db) {
#pragma unroll
            for (int ks = 0; ks < 4; ++ks) S[db] = __builtin_amdgcn_mfma_f32_32x32x16_bf16(ktf[db][ks], vf[ks], S[db], 0, 0, 0); }
        asm volatile("s_nop 15\n\ts_nop 15" : "+v"(O));
#pragma unroll
        for (int db = 0; db < NDB; ++db) asm volatile("s_nop 15\n\ts_nop 15" : "+v"(S[db]));
#pragma unroll
        for (int db = 0; db < NDB; ++db) {
            if (KIND) { S[db] = S[db] * dret; }
            else {
#pragma unroll
                for (int g = 0; g < 4; ++g) { S[db][4 * g] *= dvv[g][0]; S[db][4 * g + 1] *= dvv[g][1]; S[db][4 * g + 2] *= dvv[g][2]; S[db][4 * g + 3] *= dvv[g][3]; } } }
#pragma unroll
        for (int r = 0; r < 16; ++r) Ot[(hl * 64 + 32 * ib + crow(r, hi)) * OTW + e0 + r32] = O[r];
        LIN_BAR();
        { f32x4 v[4]; float s1 = 0.f;
#pragma unroll
            for (int i = 0; i < 4; ++i) { v[i] = *(const LAS f32x4*)(Ot + (nh * 64 + nrow) * OTW + 16 * nq + 4 * i); s1 += (v[i][0] + v[i][1]) + (v[i][2] + v[i][3]); }
            float mean = 0.f; if (KIND) { s1 += __shfl_xor(s1, 1); s1 += __shfl_xor(s1, 2); mean = s1 * (1.f / 64.f); }
            float s2 = 0.f;
#pragma unroll
            for (int i = 0; i < 4; ++i) { v[i] = v[i] - mean; s2 += (v[i][0] * v[i][0] + v[i][1] * v[i][1]) + (v[i][2] * v[i][2] + v[i][3] * v[i][3]); }
            s2 += __shfl_xor(s2, 1); s2 += __shfl_xor(s2, 2);
            const float rs = __builtin_amdgcn_rsqf(s2 * (1.f / 64.f) + EPS);
            if (wr) { bf16* dst = ob + (size_t)sr * DM + KIND * 256 + hn * 64 + 16 * nq; const LAS float* gp = Gs + 16 * nq;
#pragma unroll
                for (int i = 0; i < 2; ++i) { const v4u g4 = og[i]; const f32x4 g0 = *(const LAS f32x4*)(gp + 8 * i), g1 = *(const LAS f32x4*)(gp + 8 * i + 4);
                    f32x4 x0 = v[2 * i] * rs * g0, x1 = v[2 * i + 1] * rs * g1;
                    x0[0] *= silu_f(bflo(g4.x)); x0[1] *= silu_f(bfhi(g4.x)); x0[2] *= silu_f(bflo(g4.y)); x0[3] *= silu_f(bfhi(g4.y)); x1[0] *= silu_f(bflo(g4.z)); x1[1] *= silu_f(bfhi(g4.z)); x1[2] *= silu_f(bflo(g4.w)); x1[3] *= silu_f(bfhi(g4.w));
                    *(v4u*)(dst + 8 * i) = pack8(x0, x1); } } }
        LIN_BAR();
    }
    asm volatile("s_waitcnt vmcnt(0)" ::: "memory");
#undef LIN_DMA
#undef LIN_BAR
}

template <int MODE, int KSTEPS  >
__device__ __forceinline__ void thin_unit(const bf16* A, int lda, const bf16* Bt, int u, bf16* H, float* stats_out, const float* stats_in, bf16* ACT, LAS unsigned char* lds, int tid) {
    constexpr int K = KSTEPS * 256;
    const int lane = tid & 63, w = __builtin_amdgcn_readfirstlane(tid >> 6), fr = lane & 15, fq = lane >> 4;
    int brow[4];
#pragma unroll
    for (int nb = 0; nb < 4; ++nb) brow[nb] = MODE != 1 ? 64 * u + 16 * nb + fr : 256 * (u >> 2) + 32 * (u & 3) + (nb >> 1) * 128 + 16 * (nb & 1) + fr;
    f32x4 acc[4];
#pragma unroll
    for (int nb = 0; nb < 4; ++nb) acc[nb] = (f32x4){0.f, 0.f, 0.f, 0.f};
    const bf16* ap = A + (size_t)fr * lda + w * (KSTEPS * 32) + 8 * fq;
    constexpr int B1 = KSTEPS > 6 ? 6 : KSTEPS;
    { s16x8 af[B1], bf[B1][4];
#pragma unroll
        for (int s = 0; s < B1; ++s) { af[s] = *(const s16x8*)(ap + 32 * s);
#pragma unroll
            for (int nb = 0; nb < 4; ++nb) bf[s][nb] = *(const s16x8*)(Bt + (size_t)brow[nb] * K + w * (KSTEPS * 32) + 32 * s + 8 * fq); }
#pragma unroll
        for (int s = 0; s < B1; ++s)
#pragma unroll
            for (int nb = 0; nb < 4; ++nb) acc[nb] = __builtin_amdgcn_mfma_f32_16x16x32_bf16(bf[s][nb], af[s], acc[nb], 0, 0, 0); }
    if (KSTEPS > B1) { constexpr int B2 = KSTEPS > B1 ? KSTEPS - B1 : 1; s16x8 af[B2], bf[B2][4];
#pragma unroll
        for (int s = 0; s < B2; ++s) { af[s] = *(const s16x8*)(ap + 32 * (B1 + s));
#pragma unroll
            for (int nb = 0; nb < 4; ++nb) bf[s][nb] = *(const s16x8*)(Bt + (size_t)brow[nb] * K + w * (KSTEPS * 32) + 32 * (B1 + s) + 8 * fq); }
#pragma unroll
        for (int s = 0; s < B2; ++s)
#pragma unroll
            for (int nb = 0; nb < 4; ++nb) acc[nb] = __builtin_amdgcn_mfma_f32_16x16x32_bf16(bf[s][nb], af[s], acc[nb], 0, 0, 0); }
    asm volatile("s_nop 15" : "+v"(acc[0]), "+v"(acc[1]), "+v"(acc[2]), "+v"(acc[3]));
    LAS f32x4* part = (LAS f32x4*)lds;
    __syncthreads();
#pragma unroll
    for (int nb = 0; nb < 4; ++nb) part[(w * 4 + nb) * 64 + lane] = acc[nb];
    __syncthreads();
    if (w == 0) {
#pragma unroll
        for (int nb = 0; nb < 4; ++nb) {
#pragma unroll
            for (int w2 = 1; w2 < 8; ++w2) acc[nb] = acc[nb] + part[(w2 * 4 + nb) * 64 + lane]; }
        const int row = MR + fr;
        if (MODE == 0) { float ss = 0.f;
#pragma unroll
            for (int nb = 0; nb < 4; ++nb) { bf16* p = H + (size_t)row * DM + 64 * u + 16 * nb + 4 * fq; const v2u wv = *(const v2u*)p;
                const float x0 = acc[nb][0] + bflo(wv.x), x1 = acc[nb][1] + bfhi(wv.x), x2 = acc[nb][2] + bflo(wv.y), x3 = acc[nb][3] + bfhi(wv.y);
                ss += (x0 * x0 + x1 * x1) + (x2 * x2 + x3 * x3);
                v2u o; o.x = pg8::cvt_pk_bf16(x0, x1); o.y = pg8::cvt_pk_bf16(x2, x3); *(v2u*)p = o; }
            ss += __shfl_xor(ss, 16); ss += __shfl_xor(ss, 32);
            if (fq == 0) stats_out[(size_t)row * 16 + u] = ss;
        } else if (MODE == 2) { const f32x4* sp = (const f32x4*)(stats_in + (size_t)row * 16); const f32x4 s0 = sp[0], s1 = sp[1], s2 = sp[2], s3 = sp[3];
            const float st = ((s0[0] + s0[1]) + (s0[2] + s0[3])) + ((s1[0] + s1[1]) + (s1[2] + s1[3])) + ((s2[0] + s2[1]) + (s2[2] + s2[3])) + ((s3[0] + s3[1]) + (s3[2] + s3[3]));
            const float rs = __builtin_amdgcn_rsqf(st * (1.f / 1024.f) + EPS);
#pragma unroll
            for (int nb = 0; nb < 4; ++nb) { v2u o; o.x = pg8::cvt_pk_bf16(acc[nb][0] * rs, acc[nb][1] * rs); o.y = pg8::cvt_pk_bf16(acc[nb][2] * rs, acc[nb][3] * rs);
                *(v2u*)(ACT + (size_t)row * N1 + 64 * u + 16 * nb + 4 * fq) = o; }
        } else { const f32x4* sp = (const f32x4*)(stats_in + (size_t)row * 16); const f32x4 s0 = sp[0], s1 = sp[1], s2 = sp[2], s3 = sp[3];
            const float st = ((s0[0] + s0[1]) + (s0[2] + s0[3])) + ((s1[0] + s1[1]) + (s1[2] + s1[3])) + ((s2[0] + s2[1]) + (s2[2] + s2[3])) + ((s3[0] + s3[1]) + (s3[2] + s3[3]));
            const float rs = __builtin_amdgcn_rsqf(st * (1.f / 1024.f) + EPS);
#pragma unroll
            for (int nb = 0; nb < 2; ++nb) { float y[4];
#pragma unroll
                for (int t = 0; t < 4; ++t) y[t] = silu_f(acc[nb][t] * rs) * (acc[2 + nb][t] * rs);
                v2u o; o.x = pg8::cvt_pk_bf16(y[0], y[1]); o.y = pg8::cvt_pk_bf16(y[2], y[3]);
                *(v2u*)(ACT + (size_t)row * DFF + 128 * (u >> 2) + 32 * (u & 3) + 16 * nb + 4 * fq) = o; } }
    }
    __syncthreads();
}

#ifndef REP_PREP
#define REP_PREP 1
#endif
#ifndef REP_MIX
#define REP_MIX 1
#endif
#ifndef REP_P0
#define REP_P0 1
#endif
#ifndef REP_CONV
#define REP_CONV 1
#endif
#ifndef REP_G1
#define REP_G1 1
#endif
#ifndef REP_MGU
#define REP_MGU 1
#endif
#ifndef REP_MDN
#define REP_MDN 1
#endif
#ifndef REP_BAR
#define REP_BAR 0
#endif
#ifndef REP_PART
#define REP_PART -1
#endif
#ifndef REP_FGU
#define REP_FGU 1
#endif
#ifndef MK_ONE_LAUNCH
#define MK_ONE_LAUNCH 1
#endif
constexpr int NPHASE = 18;
constexpr int CW_Q = 12288;
__global__ void __launch_bounds__(512, 2) mega_fwd(Args a) {
    extern __shared__ __attribute__((aligned(16))) unsigned char lds_raw[];
    LAS unsigned char* lds = (LAS unsigned char*)lds_raw;
    volatile LAS unsigned* MISC = (volatile LAS unsigned*)(lds + MISC_OFF);
    int wave = __builtin_amdgcn_readfirstlane((int)threadIdx.x >> 6); asm volatile("" : "+s"(wave));
    const int G = gridDim.x;
#define TID() ((wave << 6) + lane_id())
    for (int u = TID(); u < (LDS_BYTES - RING_BYTES) / 4; u += 512) ((LAS unsigned*)(lds + RING_BYTES))[u] = 0u;
    __syncthreads();
    gu32* ctl = (gu32*)(a.ws + WS_CTL);
    const int lo = a.ph_lo, hi = a.ph_hi;
    XcdBarrier bar; bar.bar = (unsigned*)(ctl + CW_BAR); bar.x = 0; bar.st = nullptr;
    if (hi - lo > 1) bar = xcd_barrier_post((unsigned*)(ctl + CW_BAR), MISC + 8, TID() == 0);
#define IN(k) (lo <= (k) && (k) < hi)
#define OPQ() int ptid = TID(); asm volatile("" : "+v"(ptid)); const int plane = ptid & 63; (void)plane
#define SEAM(k) do { if (IN(k) && IN((k) + 1)) xcd_barrier(bar, TID() == 0); } while (0)
#define hb ((bf16*)(a.ws + WS_HB))
#define stA ((float*)(a.ws + WS_STA))
#define stB ((float*)(a.ws + WS_STB))

    for (int rep = 0; rep < REP_BAR; ++rep) xcd_barrier(bar, TID() == 0);
    if (IN(0)) { OPQ(); for (int rep = 0; rep < REP_P0; ++rep) { p0_prologue(a, lds, ptid, plane, wave); __syncthreads(); } }
    SEAM(0);

    for (int li = 0; li < 2; ++li) {
        const int pb = 1 + 6 * li;
        if (IN(pb)) {
            { OPQ(); for (int u = blockIdx.x; u < N1 / 64; u += G) thin_unit<2, 4>(hb + (size_t)MR * DM, DM, (const bf16*)(a.ws + WS_W1T + li * W1T_BYTES), u, nullptr, nullptr, stA, (bf16*)(a.ws + B_PROJ), lds, ptid); }
            pg8::Gemm g{hb, (const bf16*)(a.ws + WS_W1T + li * W1T_BYTES), DM, 0, nullptr}; pg8::StaticOrder S; S.init(NPAN - 1, N1 / 256, G, (int)blockIdx.x);
            EpiProj E{(bf16*)(a.ws + B_PROJ), stA};
            for (int rep = 0; rep < REP_G1; ++rep) pg8::gemm_phase<EpiProj, pg8::StaticOrder, false>(lds, g, S, E, wave);
        }
        SEAM(pb);
        if (IN(pb + 1)) { OPQ(); for (int rep = 0; rep < REP_PREP; ++rep) for (int u = blockIdx.x; u < NB * NCH * 3; u += G) { const int part = u % 3;     if (rep > 0 && REP_PART >= 0 && part != REP_PART) continue; int ut = ptid; asm volatile("" : "+v"(ut)); prep2_unit(a, li, (u / 3) / NCH, (u / 3) % NCH, part, lds, ut); } __syncthreads(); }
        SEAM(pb + 1);
        if (IN(pb + 2)) {
            OPQ(); const int tid = ptid;
            LAS int* qid = (LAS int*)(lds + RING_BYTES + 64);
            float lam, lam_init; { const float* lv = ain(a, I_DLAM) + li * 128; float s01 = 0.f, s23 = 0.f;
                for (int d = 0; d < 32; ++d) { s01 += lv[d] * lv[32 + d]; s23 += lv[64 + d] * lv[96 + d]; }
                lam_init = 0.8f - 0.6f * __expf(-0.3f * (float)li); lam = __expf(s01) - __expf(s23) + lam_init;
                if (tid == 0) { LAS float* lp = (LAS float*)(lds + RING_BYTES + 256); lp[0] = lam; lp[1] = 1.f - lam_init; } }
            for (int rep = 0; rep < REP_MIX; ++rep)
            for (;;) {
                __syncthreads();
                if (tid == 0) *qid = (int)__hip_atomic_fetch_add(ctl + CW_Q + 64 * (li + 2 * rep), 1u, RLX_AGENT);
                __syncthreads();
                const int id = *qid;
                int utid = ptid; asm volatile("" : "+v"(utid));
                if (id >= 64 + 1024 + 8) break;
                if (id < 64) { if ((id & 1) == 0) lin_mfma_unit<0>(a, li, (id >> 1) & 15, id >> 5, lds, utid); else lin_mfma_unit<1>(a, li, (id >> 1) & 15, id >> 5, lds, utid); }
                else { const int v = id - 64; int qb, kind, b, hh;
                    if (v < 1024) { qb = 7 - (v >> 7); const int rem = v & 127; kind = rem >> 6; b = (rem >> 2) & 15; hh = rem & 3; } else { qb = -1; kind = (v - 1024) >> 2; b = 0; hh = v & 3; }
                    if (kind == 0) attn_mfma_unit<0>(a, li, b, hh, qb, lds, utid, 0.f, 1.f); else attn_mfma_unit<1>(a, li, b, hh, qb, lds, utid, 0.f, 0.f); }
            }
        }
        SEAM(pb + 2);
        if (IN(pb + 3)) {
            if (li == 0) { OPQ(); for (int u = blockIdx.x; u < 16; u += G) thin_unit<0, 4>((const bf16*)a.out + (size_t)MR * DM, DM, (const bf16*)(a.ws + WS_WOT), u, hb, stB, nullptr, nullptr, lds, ptid); }
            pg8::Gemm g{(const bf16*)a.out, (const bf16*)(a.ws + WS_WOT + li * WOT_BYTES), DM, 0, nullptr}; pg8::StaticOrder S; S.init(NPAN - 1, 4, G, (int)blockIdx.x);
            EpiResid E{hb, stB};
            pg8::gemm_phase<EpiResid, pg8::StaticOrder, false>(lds, g, S, E, wave);
        }
        SEAM(pb + 3);
        if (li == 0) {
            if (IN(5)) {
                { OPQ(); for (int u = blockIdx.x; u < 88; u += G) thin_unit<1, 4>(hb + (size_t)MR * DM, DM, (const bf16*)(a.ws + WS_WGU), u, nullptr, nullptr, stB, (bf16*)(a.ws + B_ACT), lds, ptid); }
                pg8::Gemm g{hb, (const bf16*)(a.ws + WS_WGU), DM, 0, nullptr}; pg8::StaticOrder S; S.init(NPAN - 1, 2 * DFF / 256, G, (int)blockIdx.x);
                EpiSwiglu E{(bf16*)(a.ws + B_ACT), DFF, stB};
                for (int rep = 0; rep < REP_FGU; ++rep) pg8::gemm_phase<EpiSwiglu, pg8::StaticOrder, false>(lds, g, S, E, wave);
            }
            SEAM(5);
            if (IN(6)) {
                { OPQ(); for (int u = blockIdx.x; u < 16; u += G) thin_unit<0, 11>((const bf16*)(a.ws + B_ACT) + (size_t)MR * DFF, DFF, (const bf16*)(a.ws + WS_WD), u, hb, stA, nullptr, nullptr, lds, ptid); }
                pg8::Gemm g{(const bf16*)(a.ws + B_ACT), (const bf16*)(a.ws + WS_WD), DFF, 0, nullptr}; pg8::StaticOrder S; S.init(NPAN - 1, 4, G, (int)blockIdx.x);
                EpiResid E{hb, stA};
                pg8::gemm_phase<EpiResid, pg8::StaticOrder, false>(lds, g, S, E, wave);
            }
            SEAM(6);
        }
    }
    if (IN(11)) { OPQ(); const int tid = ptid, lane = plane;
        LAS float* scr = (LAS float*)(lds + wave * 16384);
        const int gw = blockIdx.x * 8 + wave, NGW = G * 8;
        constexpr int IG = 8 * 56, ID = 56 * 16;
        for (int rep = 0; rep < REP_CONV; ++rep)
        for (int it = gw; it < 8 * (2 * IG + ID); it += NGW) { const int e = it / (2 * IG + ID); int r = it % (2 * IG + ID);
            if (r < IG) { transpose_item_f8(ain(a, I_EG) + (size_t)e * DM * DFE, DM, DFE, ain(a, I_FNORM) + DM, a.ws + B_EGU + e * EGU_BYTES, r / 56, r % 56, 1, scr, lane); continue; } r -= IG;
            if (r < IG) { transpose_item_f8(ain(a, I_EU) + (size_t)e * DM * DFE, DM, DFE, ain(a, I_FNORM) + DM, a.ws + B_EGU + e * EGU_BYTES, r / 56, r % 56, 2, scr, lane); continue; } r -= IG;
            transpose_item(ain(a, I_ED) + (size_t)e * DFE * DM, DFE, DM, nullptr, (bf16*)(a.ws + B_ED + e * ED_BYTES), r / 16, r % 16, 0, scr, lane); }
        for (int i = blockIdx.x * 512 + tid; i < MAXPAN * 256; i += G * 512) { ((int*)(a.ws + MO_ROWIDX))[i] = -1; ((int*)(a.ws + MO_PDST))[i] = -1; ((f32x2*)(a.ws + MO_PINFO))[i] = (f32x2){0.f, 0.f}; }
        for (int blk = blockIdx.x; blk < MR / 128; blk += G) route_block(a, blk, lds, tid, lane, wave);
    }
    SEAM(11);
    LAS int* offs = (LAS int*)(lds + RING_BYTES + 128);
    if (IN(12)) { OPQ(); const int tid = ptid;
        moe_offsets(a, offs, tid);
        for (int idx = blockIdx.x * 512 + tid; idx < 2 * MR; idx += G * 512) { const int tok = idx >> 1, e = ((const int*)(a.ws + MO_TOKE))[idx], gpos = offs[e] + ((const int*)(a.ws + MO_TOKP))[idx];
            const f32x4* sp = (const f32x4*)(stB + (size_t)tok * 16); const f32x4 s0 = sp[0], s1 = sp[1], s2 = sp[2], s3 = sp[3];
            const float ss = ((s0[0] + s0[1]) + (s0[2] + s0[3])) + ((s1[0] + s1[1]) + (s1[2] + s1[3])) + ((s2[0] + s2[1]) + (s2[2] + s2[3])) + ((s3[0] + s3[1]) + (s3[2] + s3[3]));
            ((int*)(a.ws + MO_ROWIDX))[gpos] = tok; ((int*)(a.ws + MO_PDST))[gpos] = idx;
            ((f32x2*)(a.ws + MO_PINFO))[gpos] = (f32x2){__builtin_amdgcn_rsqf(ss * (1.f / 1024.f) + EPS), __int_as_float(((const int*)(a.ws + MO_TOKW))[idx])}; }
        if (blockIdx.x == 0 && tid < MAXPAN + 8) { int e = 0;
            for (int k = 1; k < 8; ++k) if (tid * 256 >= offs[k]) e = k;
            ((int*)(a.ws + MO_PEXP))[tid] = e; }
    }
    SEAM(12);
    int nT = 0; if (IN(13) || IN(14) || IN(15) || IN(16)) { moe_offsets(a, offs, TID()); nT = __builtin_amdgcn_readfirstlane(offs[8]); }
    const int nA = nT < 128 ? nT : 128, nB = nT < 128 ? 0 : (nT - 128 < 128 ? nT - 128 : 128), nC = nT <= 256 ? 0 : (nT - 256 < 8 ? nT - 256 : 8);
#pragma unroll 1
    for (int job = 0; job < 5; ++job) {
        const int ph = job == 0 ? 13 : job == 1 ? 14 : job <= 3 ? 15 : 16;
        if (IN(ph)) {
            if (job == 0 || job == 3) {
                const int nP = job == 0 ? nA + nC : nB;
                if (nP > 0) { pg8::Gemm g{(const bf16*)(a.ws + B_HB8), (const bf16*)(a.ws + B_EGU), DM / 2, EGU_BYTES, (const int*)(a.ws + MO_ROWIDX)};     pg8::MoeOrder S; S.init(nP, 2 * DFE / 256, G, (int)blockIdx.x, job == 0 ? 0 : 128, (const int*)(a.ws + MO_PEXP));
                    if (job == 0) { S.psplit = nA; S.p1 = 256; } else if (nC > 0 && (nB * (2 * DFE / 256)) % G == 0 && 16 * nC <= G) S.H = 4 * nC;
                    EpiSwigluMoe E{(bf16*)(a.ws + B_EACT), (const f32x2*)(a.ws + MO_PINFO), 1.f / W8_SCALE};
                    for (int rep = 0; rep < REP_MGU; ++rep) pg8::gemm_phase<EpiSwigluMoe, pg8::MoeOrder, true, true>(lds, g, S, E, wave); }
            } else {
                const int nP = job == 1 ? nA : job == 2 ? nC : nB, p0 = job == 1 ? 0 : job == 2 ? 256 : 128;
                if (nP > 0) { pg8::Gemm g{(const bf16*)(a.ws + B_EACT) + (job == 2 ? (size_t)128 * 256 * DFE : (size_t)0), (const bf16*)(a.ws + B_ED), DFE, ED_BYTES, nullptr}; pg8::MoeOrder S; S.init(nP, 4, G, (int)blockIdx.x, p0, (const int*)(a.ws + MO_PEXP));
                    EpiMoeDown E{(unsigned char*)a.out, (const int*)(a.ws + MO_PDST), (const f32x2*)(a.ws + MO_PINFO)};
                    for (int rep = 0; rep < REP_MDN; ++rep) pg8::gemm_phase<EpiMoeDown, pg8::MoeOrder, false>(lds, g, S, E, wave); }
            }
        }
        if (job != 2) SEAM(ph);
    }
    if (IN(17)) { OPQ(); const int lane = plane;
        const float* fn = ain(a, I_FINAL);
        for (int r = blockIdx.x * 8 + wave; r < MR; r += G * 8) {
            unsigned char* orow = (unsigned char*)a.out + (size_t)r * 4096; float v[16]; float ss = 0.f;
#pragma unroll
            for (int hf = 0; hf < 2; ++hf) { const int k = 512 * hf + 8 * lane; const v4u h4 = *(const v4u*)(hb + (size_t)r * DM + k), y0 = *(const v4u*)(orow + 2 * k), y1 = *(const v4u*)(orow + 2048 + 2 * k);
                const unsigned hw[4] = {h4.x, h4.y, h4.z, h4.w}, aw[4] = {y0.x, y0.y, y0.z, y0.w}, bw[4] = {y1.x, y1.y, y1.z, y1.w};
#pragma unroll
                for (int t = 0; t < 4; ++t) { const float x0 = bflo(hw[t]) + bflo(aw[t]) + bflo(bw[t]), x1 = bfhi(hw[t]) + bfhi(aw[t]) + bfhi(bw[t]); v[8 * hf + 2 * t] = x0; v[8 * hf + 2 * t + 1] = x1; ss += x0 * x0 + x1 * x1; } }
            ss = wave_sum(ss); const float rs = __builtin_amdgcn_rsqf(ss * (1.f / 1024.f) + EPS);
#pragma unroll
            for (int hf = 0; hf < 2; ++hf) { const int k = 512 * hf + 8 * lane; const f32x4 g0 = *(const f32x4*)(fn + k), g1 = *(const f32x4*)(fn + k + 4);
                *(f32x4*)(orow + 4 * k) = (f32x4){v[8 * hf] * rs * g0[0], v[8 * hf + 1] * rs * g0[1], v[8 * hf + 2] * rs * g0[2], v[8 * hf + 3] * rs * g0[3]};
                *(f32x4*)(orow + 4 * k + 16) = (f32x4){v[8 * hf + 4] * rs * g1[0], v[8 * hf + 5] * rs * g1[1], v[8 * hf + 6] * rs * g1[2], v[8 * hf + 7] * rs * g1[3]}; }
        }
    }
#undef IN
#undef SEAM
#undef hb
#undef stA
#undef stB
}

extern "C" void kernel_launch(void* const* d_in, const int* in_sizes, int n_in, void* d_out, int out_size, void* d_ws, size_t ws_size, hipStream_t stream) {
    static int grid = 0;
    if (grid == 0) {
        if (n_in != 24 || in_sizes[0] != MR * DM || out_size != MR * DM || ws_size < WS_NEED) { fprintf(stderr, "kernel_launch: unexpected problem (n_in %d, in0 %d, out %d, ws %zu < %zu)\n", n_in, n_in > 0 ? in_sizes[0] : -1, out_size, ws_size, (size_t)WS_NEED); grid = -1; return; }
        int dev = 0, cus = 0, per_cu = 0;
        if (hipGetDevice(&dev) != hipSuccess || hipDeviceGetAttribute(&cus, hipDeviceAttributeMultiprocessorCount, dev) != hipSuccess) { grid = -1; return; }
        if (hipFuncSetAttribute((const void*)mega_fwd, hipFuncAttributeMaxDynamicSharedMemorySize, LDS_BYTES) != hipSuccess) { fprintf(stderr, "kernel_launch: hipFuncSetAttribute failed\n"); grid = -1; return; }
        if (hipOccupancyMaxActiveBlocksPerMultiprocessor(&per_cu, (const void*)mega_fwd, 512, LDS_BYTES) != hipSuccess || per_cu < 1) fprintf(stderr, "kernel_launch: occupancy query reports %d\n", per_cu);
        (void)hipGetLastError();
        grid = cus;
    }
    if (grid < 0) return;
    if (hipMemsetAsync((char*)d_ws + WS_CTL, 0, CTL_BYTES, stream) != hipSuccess) return;
    Args a{};
    for (int i = 0; i < 24; ++i) a.in[i] = (const float*)d_in[i];
    a.out = (float*)d_out; a.ws = (unsigned char*)d_ws;
#if MK_ONE_LAUNCH
    a.ph_lo = 0; a.ph_hi = NPHASE;
    hipLaunchKernelGGL(mega_fwd, dim3(grid), dim3(512), LDS_BYTES, stream, a);
#else
    for (int p = 0; p < NPHASE; ++p) { a.ph_lo = p; a.ph_hi = p + 1; hipLaunchKernelGGL(mega_fwd, dim3(grid), dim3(512), LDS_BYTES, stream, a); }
#endif
}
```

```cpp
#include <hip/hip_runtime.h>
#include <cstdio>
#include <cstdint>

namespace pg8 {
#define PG8_LAS __attribute__((address_space(3)))
typedef unsigned short bf16_t;
typedef short bf16x8 __attribute__((ext_vector_type(8)));
typedef float f32x4 __attribute__((ext_vector_type(4)));
typedef unsigned u32x4 __attribute__((ext_vector_type(4)));
typedef int i32x4 __attribute__((ext_vector_type(4)));
typedef int i32x8 __attribute__((ext_vector_type(8)));
constexpr int BM = 256, BK = 64, HALF = 128, HTB = HALF * BK * 2  , STAGE_BYTES = 8 * HTB, NXCD = 8, WGM = 8;

__host__ __device__ __forceinline__ int lds_byte(int r, int c) { const int st = (r >> 4) * 2 + (c >> 5), rr = r & 15, cc = c & 31, ob = rr * 64 + cc * 2; return st * 1024 + (ob ^ (((ob >> 9) & 1) << 5)); }
__host__ __device__ __forceinline__ void stage_rc(int b, int& R, int& C) { const int st = b / 1024, sb = b % 1024, swz = sb ^ (((sb >> 9) & 1) << 5); R = (st >> 1) * 16 + swz / 64; C = (st & 1) * 32 + (swz % 64) / 2; }
__host__ __device__ __forceinline__ int perm32(int rho) { const int n = rho >> 4, i = rho & 15; return 8 * (i >> 2) + 4 * n + (i & 3); }

struct Unit { int pm, pn, e, gp; };
struct Gemm { const bf16_t* A; const bf16_t* Bt; int K; size_t estride  ; const int* rowidx  ; };

struct StaticOrder {
    int nM, nN, nwg, G, c;
    __device__ void init(int nM_, int nN_, int G_, int c_) { nM = nM_; nN = nN_; nwg = nM * nN; G = G_; c = c_; }
    __device__ __forceinline__ bool map(int i, int& pm, int& pn) const { return mapL((long)i * G + c, pm, pn); }
    __device__ __forceinline__ bool mapL(long L, int& pm, int& pn) const {
        if (L >= nwg) return false;
        int wgid = (int)L; { const int q = nwg / NXCD, r = nwg % NXCD, xcd = wgid % NXCD, off = wgid / NXCD; wgid = (xcd < r ? xcd * (q + 1) : r * (q + 1) + (xcd - r) * q) + off; }
        const int nig = WGM * nN, gid = wgid / nig, fm = gid * WGM, gsz = (nM - fm) < WGM ? (nM - fm) : WGM;
        pm = fm + ((wgid % nig) % gsz); pn = (wgid % nig) / gsz; return true;
    }
    __device__ __forceinline__ bool next(int i, Unit& u) const { int pm, pn; if (!map(i, pm, pn)) return false; u.pm = pm; u.pn = pn; u.e = 0; u.gp = pm; return true; }
};
struct MoeOrder {
    StaticOrder so; int p0; const int* pexp;
    int psplit, p1;
    int H;
    __device__ void init(int nP, int nN, int G, int c, int p0_, const int* pexp_) { so.init(nP, nN, G, c); p0 = p0_; pexp = pexp_; psplit = 1 << 30; p1 = 0; H = 0; }
    __device__ __forceinline__ bool next(int i, Unit& u) const { int pm, pn; long L = (long)i * so.G + so.c;
        if (H > 0) { const int full = so.nwg / so.G, nh = full - 3;
            if (so.c < H) { if (i >= nh) return false; }
            else if (i >= full) { const int j = so.c - H; if (i > full || j >= 3 * H) return false; L = (long)(nh + j / H) * so.G + (j % H); } }
        if (!so.mapL(L, pm, pn)) return false;
        u.pm = pm; u.pn = pn; u.gp = pm < psplit ? p0 + pm : p1 + (pm - psplit); u.e = __builtin_amdgcn_readfirstlane(pexp[u.gp]); return true; }
};

__device__ __forceinline__ unsigned cvt_pk_bf16(float lo, float hi) { unsigned r; asm volatile("v_cvt_pk_bf16_f32 %0, %1, %2" : "=v"(r) : "v"(lo), "v"(hi)); return r; }
__device__ __forceinline__ float bf_lo(unsigned w) { return __uint_as_float(w << 16); }
__device__ __forceinline__ float bf_hi(unsigned w) { return __uint_as_float(w & 0xffff0000u); }

template <class Epi, class Sched, bool GATHER, bool F8 = false>
__device__ __forceinline__ void gemm_phase(PG8_LAS unsigned char* lds, const Gemm g, const Sched& S, const Epi& E, int wave_id  ) {
    int tid_; asm volatile("v_mbcnt_lo_u32_b32 %0, -1, 0\n\tv_mbcnt_hi_u32_b32 %0, -1, %0" : "=v"(tid_)); tid_ += wave_id << 6;
    const int tid = tid_, wid = __builtin_amdgcn_readfirstlane(tid >> 6), lane = tid & 63, wr = wid >> 2, wc = wid & 3, fr = lane & 15, fq = lane >> 4;
    const int K = g.K, nt = K / BK;
    int Ra[2], Ca[2]; unsigned voffB[2];
#pragma unroll
    for (int i = 0; i < 2; ++i) { int R, C; stage_rc(tid * 16 + i * 8192, R, C); const int Rb = (R & ~31) + perm32(R & 31);
        Ra[i] = R; Ca[i] = C; voffB[i] = (unsigned)(Rb * K + C) * 2u; }
    const size_t kstep = (size_t)(BK * 2);
    const size_t hstep = (size_t)HALF * K * 2;
    const size_t tstep = 2 * hstep;
    const unsigned ldsw = (unsigned)wid * 1024u;
    const int aoff = lds_byte(wr * 64 + fr, fq * 8), boff = lds_byte(wc * 32 + fr, fq * 8);
    const char* const A0 = (const char*)g.A;
#define PG8_SA(b, h) (((b) * 2 + (h)) * HTB)
#define PG8_SB(b, h) ((4 + (b) * 2 + (h)) * HTB)
#define PG8_STAGE(bufoff, gbase, voff) do { _Pragma("unroll") for (int _i = 0; _i < 2; ++_i) \
        __builtin_amdgcn_global_load_lds((const unsigned*)((const char*)(gbase) + (voff)[_i]), (PG8_LAS unsigned*)(lds + (bufoff) + ldsw + _i * 8192), 16, 0, 0); } while (0)
#define PG8_RDA(b, h, m, k) (*(const PG8_LAS bf16x8*)(lds + PG8_SA(b, h) + aoff + (m) * 2048 + (k) * 1024))
#define PG8_RDB(b, h, n, k) (*(const PG8_LAS bf16x8*)(lds + PG8_SB(b, h) + boff + (n) * 2048 + (k) * 1024))
#define PG8_LDA(dst, b, h) do { _Pragma("unroll") for (int m = 0; m < 4; ++m) { if (F8) { const i32x4 x0_ = *(const PG8_LAS i32x4*)(lds + PG8_SA(b, h) + aoff + m * 2048), x1_ = *(const PG8_LAS i32x4*)(lds + PG8_SA(b, h) + aoff + m * 2048 + 1024); dst##8[m] = __builtin_shufflevector(x0_, x1_, 0, 1, 2, 3, 4, 5, 6, 7); } else { dst[m][0] = PG8_RDA(b, h, m, 0); dst[m][1] = PG8_RDA(b, h, m, 1); } } } while (0)
#define PG8_LDB(dst, b, h) do { _Pragma("unroll") for (int n = 0; n < 2; ++n) { if (F8) { const i32x4 x0_ = *(const PG8_LAS i32x4*)(lds + PG8_SB(b, h) + boff + n * 2048), x1_ = *(const PG8_LAS i32x4*)(lds + PG8_SB(b, h) + boff + n * 2048 + 1024); dst##8[n] = __builtin_shufflevector(x0_, x1_, 0, 1, 2, 3, 4, 5, 6, 7); } else { dst[n][0] = PG8_RDB(b, h, n, 0); dst[n][1] = PG8_RDB(b, h, n, 1); } } } while (0)
#define PG8_CAT(x0, x1) __builtin_shufflevector(__builtin_bit_cast(i32x4, x0), __builtin_bit_cast(i32x4, x1), 0, 1, 2, 3, 4, 5, 6, 7)
#define PG8_MMA(ai, bj, At, Bt) do { __builtin_amdgcn_s_setprio(1); _Pragma("unroll") for (int m = 0; m < 4; ++m) _Pragma("unroll") for (int n = 0; n < 2; ++n) { \
        if (F8) asm("v_mfma_f32_16x16x128_f8f6f4 %0, %1, %2, %0" : "+v"(acc[ai][bj][m][n]) : "v"(Bt##8[n]), "v"(At##8[m]));         \
        else { _Pragma("unroll") for (int k = 0; k < 2; ++k) acc[ai][bj][m][n] = __builtin_amdgcn_mfma_f32_16x16x32_bf16(Bt[n][k], At[m][k], acc[ai][bj][m][n], 0, 0, 0); } } __builtin_amdgcn_s_setprio(0); } while (0)
#define PG8_WAIT_V(n) asm volatile("s_waitcnt vmcnt(" #n ")" ::: "memory")
#define PG8_WAIT_L(n) asm volatile("s_waitcnt lgkmcnt(" #n ")" ::: "memory")
#define PG8_BAR __builtin_amdgcn_s_barrier()
#define PG8_SCHED __builtin_amdgcn_sched_barrier(0)
#define PG8_AOFFS(dst, u) do { _Pragma("unroll") for (int _h = 0; _h < 2; ++_h) _Pragma("unroll") for (int _i = 0; _i < 2; ++_i) { \
        int _row = (u).pm * BM + _h * HALF + Ra[_i]; \
        if (GATHER) { const int _gi = g.rowidx[(u).gp * BM + _h * HALF + Ra[_i]]; _row = _gi < 0 ? 0 : _gi; } \
        dst[_h][_i] = ((unsigned)_row * (unsigned)K + (unsigned)Ca[_i]) * 2u; } } while (0)
    Unit cur, nxt; int ui = 0;
    if (!S.next(0, cur)) return;
    f32x4 acc[2][2][4][2];
#pragma unroll
    for (int a = 0; a < 2; ++a)
#pragma unroll
        for (int b = 0; b < 2; ++b)
#pragma unroll
            for (int m = 0; m < 4; ++m)
#pragma unroll
                for (int n = 0; n < 2; ++n) acc[a][b][m][n] = (f32x4){0.f, 0.f, 0.f, 0.f};
    bf16x8 At[4][2], B0[2][2], B1[2][2];
    i32x8 At8[4], B08[2], B18[2];
    unsigned oaC[2][2], oaN[2][2];
    PG8_AOFFS(oaC, cur);
    const char* cB = (const char*)g.Bt + (size_t)cur.e * g.estride + (size_t)cur.pn * tstep;
    PG8_STAGE(PG8_SB(0, 0), cB, voffB); PG8_STAGE(PG8_SB(0, 1), cB + hstep, voffB); PG8_STAGE(PG8_SA(0, 0), A0, oaC[0]); PG8_STAGE(PG8_SA(0, 1), A0, oaC[1]);
    if (wr == 1) PG8_BAR;
    PG8_WAIT_V(2); PG8_BAR;
    PG8_STAGE(PG8_SB(1, 0), cB + kstep, voffB); PG8_STAGE(PG8_SA(1, 0), A0 + kstep, oaC[0]); PG8_STAGE(PG8_SB(1, 1), cB + hstep + kstep, voffB);
    PG8_WAIT_V(6); PG8_BAR;
    for (;;) {
        const bool has_next = S.next(ui + 1, nxt);
        if (has_next) { PG8_AOFFS(oaN, nxt); }
        else {
#pragma unroll
            for (int _h = 0; _h < 2; ++_h)
#pragma unroll
                for (int _i = 0; _i < 2; ++_i) oaN[_h][_i] = oaC[_h][_i]; }
        const char* nB = has_next ? (const char*)g.Bt + (size_t)nxt.e * g.estride + (size_t)nxt.pn * tstep : cB;
#pragma unroll 1
        for (int t = 0; t < nt; t += 2) {
            const bool last = (t == nt - 2);
            const char* ka1 = A0 + (size_t)(t + 1) * kstep;
            const char* ka2 = last ? A0 : A0 + (size_t)(t + 2) * kstep; const char* b2 = last ? nB : cB + (size_t)(t + 2) * kstep;
            const char* ka3 = ka2 + kstep; const char* b3 = b2 + kstep;
            unsigned o2[2][2];
#pragma unroll
            for (int _h = 0; _h < 2; ++_h)
#pragma unroll
                for (int _i = 0; _i < 2; ++_i) o2[_h][_i] = oaC[_h][_i];
            if (last) {
                E.prefetch(lds, cur, wid, lane);
#pragma unroll
                for (int _h = 0; _h < 2; ++_h)
#pragma unroll
                    for (int _i = 0; _i < 2; ++_i) o2[_h][_i] = oaN[_h][_i];
                asm volatile("" : "+v"(o2[0][0]), "+v"(o2[0][1]), "+v"(o2[1][0]), "+v"(o2[1][1])); }
            PG8_LDB(B0, 0, 0); PG8_LDB(B1, 0, 1); PG8_SCHED; PG8_LDA(At, 0, 0); PG8_STAGE(PG8_SA(1, 1), ka1, oaC[1]);
            PG8_WAIT_V(8); PG8_WAIT_L(0); PG8_BAR; PG8_MMA(0, 0, At, B0); PG8_MMA(0, 1, At, B1); PG8_BAR; PG8_SCHED;
            PG8_LDA(At, 0, 1); PG8_STAGE(PG8_SB(0, 0), b2, voffB); PG8_STAGE(PG8_SB(0, 1), b2 + hstep, voffB); PG8_STAGE(PG8_SA(0, 0), ka2, o2[0]);
            PG8_WAIT_V(8); PG8_WAIT_L(0); PG8_BAR; PG8_MMA(1, 0, At, B0); PG8_MMA(1, 1, At, B1); PG8_BAR; PG8_SCHED;
            PG8_LDB(B0, 1, 0); PG8_LDB(B1, 1, 1); PG8_SCHED; PG8_LDA(At, 1, 0); PG8_STAGE(PG8_SA(0, 1), ka2, o2[1]);
            PG8_WAIT_V(8); PG8_WAIT_L(0); PG8_BAR; PG8_MMA(0, 0, At, B0); PG8_MMA(0, 1, At, B1); PG8_BAR; PG8_SCHED;
            PG8_LDA(At, 1, 1); PG8_STAGE(PG8_SB(1, 0), b3, voffB); PG8_STAGE(PG8_SB(1, 1), b3 + hstep, voffB); PG8_STAGE(PG8_SA(1, 0), ka3, o2[0]);
            PG8_WAIT_V(8); PG8_WAIT_L(0); PG8_BAR; PG8_MMA(1, 0, At, B0); PG8_MMA(1, 1, At, B1); PG8_BAR; PG8_SCHED;
        }
        if (wr == 0) PG8_BAR;
        { int fr_e = fr, fq_e = fq; asm volatile("" : "+v"(fr_e), "+v"(fq_e));
          E(acc, cur, wr, wc, fr_e, fq_e, lds); }
        if (!has_next) break;
#pragma unroll
        for (int a = 0; a < 2; ++a)
#pragma unroll
            for (int b = 0; b < 2; ++b)
#pragma unroll
                for (int m = 0; m < 4; ++m)
#pragma unroll
                    for (int n = 0; n < 2; ++n) acc[a][b][m][n] = (f32x4){0.f, 0.f, 0.f, 0.f};
        cur = nxt; cB = nB; ++ui;
#pragma unroll
        for (int _h = 0; _h < 2; ++_h)
#pragma unroll
            for (int _i = 0; _i < 2; ++_i) oaC[_h][_i] = oaN[_h][_i];
        if (wr == 1) PG8_BAR;
    }
    PG8_WAIT_V(0);
    PG8_BAR;
#undef PG8_SA
#undef PG8_SB
#undef PG8_STAGE
#undef PG8_LDA
#undef PG8_RDA
#undef PG8_RDB
#undef PG8_LDB
#undef PG8_MMA
#undef PG8_CAT
#undef PG8_WAIT_V
#undef PG8_WAIT_L
#undef PG8_BAR
#undef PG8_SCHED
#undef PG8_AOFFS
}
}
#define GAS __attribute__((address_space(1)))
#define LAS __attribute__((address_space(3)))
typedef unsigned short bf16;
typedef unsigned v4u __attribute__((ext_vector_type(4)));
typedef unsigned v2u __attribute__((ext_vector_type(2)));
typedef float f32x4 __attribute__((ext_vector_type(4)));
typedef float f32x2 __attribute__((ext_vector_type(2)));
typedef GAS unsigned gu32;
#define RLX_AGENT __ATOMIC_RELAXED, __HIP_MEMORY_SCOPE_AGENT
#define LDS_WAIT() asm volatile("s_waitcnt lgkmcnt(0)" ::: "memory")
#define VM_WAIT() asm volatile("s_waitcnt vmcnt(0)" ::: "memory")
__device__ __forceinline__ unsigned f2bf(float f) { unsigned u = __builtin_bit_cast(unsigned, f); return (u + 0x7fffu + ((u >> 16) & 1u)) >> 16; }
__device__ __forceinline__ unsigned pk2(float lo, float hi) { return f2bf(lo) | (f2bf(hi) << 16); }
__device__ __forceinline__ float bf2f(bf16 h) { return __uint_as_float(((unsigned)h) << 16); }
__device__ __forceinline__ float bflo(unsigned w) { return __uint_as_float(w << 16); }
__device__ __forceinline__ float bfhi(unsigned w) { return __uint_as_float(w & 0xffff0000u); }

#define XB_TMO      128
#define XB_XCNT(j)  (256  + 64 * (j))
#define XB_XSUB(j)  (1280 + 64 * (j))
#define XB_XGEN(j)  (2304 + 64 * (j))
#define XB_TOP      3328
#define XB_TOPGEN   3392
#define XCD_BAR_WORDS 3456
#define XB_SPIN_CAP (1u << 18)

__device__ __forceinline__ unsigned xb_ld(unsigned* p)              { return __hip_atomic_load(p, __ATOMIC_RELAXED, __HIP_MEMORY_SCOPE_AGENT); }
__device__ __forceinline__ unsigned xb_add(unsigned* p, unsigned v) { return __hip_atomic_fetch_add(p, v, __ATOMIC_RELAXED, __HIP_MEMORY_SCOPE_AGENT); }
__device__ __forceinline__ unsigned xb_xcc_id() { return (unsigned)__builtin_amdgcn_s_getreg((3 << 11) | 20) & 0xFu; }
#define XB_SPIN(cond, bar) do { unsigned _sp = 0; while (cond) { __builtin_amdgcn_s_sleep(1); \
    if ((++_sp & 255u) == 0u) { if (xb_ld(&(bar)[XB_TMO])) break; if (_sp > XB_SPIN_CAP) { atomicAdd(&(bar)[XB_TMO], 1u); break; } } } } while (0)

struct XcdBarrier {
    unsigned* bar; unsigned x;
    volatile LAS unsigned* st;
};

__device__ __forceinline__ XcdBarrier xcd_barrier_post(unsigned* bar, volatile LAS unsigned* st, bool leader  ) {
    XcdBarrier b; b.bar = bar; b.x = xb_xcc_id(); b.st = st;
    if (leader) (void)xb_add(&bar[XB_XCNT(b.x)], 1u);
    return b;
}
__device__ __forceinline__ void xcd_barrier_complete(unsigned* bar, unsigned x, unsigned& nloc, unsigned& nx) {
    const unsigned G = gridDim.x * gridDim.y * gridDim.z;
    unsigned sum, cnt, mine, sp = 0u;
    for (;;) {
        sum = 0u; cnt = 0u; mine = 0u;
#pragma unroll
        for (unsigned j = 0; j < 16; ++j) { const unsigned c = xb_ld(&bar[XB_XCNT(j)]); sum += c; cnt += (c > 0u) ? 1u : 0u; mine = (j == x) ? c : mine; }
        if (sum == G) break;
        __builtin_amdgcn_s_sleep(1);
        if ((++sp & 255u) == 0u) { if (xb_ld(&bar[XB_TMO])) break; if (sp > XB_SPIN_CAP) { atomicAdd(&bar[XB_TMO], 1u); break; } }
    }
    nloc = mine > 0u ? mine : 1u; nx = cnt > 0u ? cnt : 1u;
}

__device__ __forceinline__ void xcd_barrier(const XcdBarrier& b, bool leader) {
    asm volatile("s_waitcnt vmcnt(0)" ::: "memory");
    __syncthreads();
    if (leader) {
        unsigned* bar = b.bar;
        __builtin_amdgcn_s_waitcnt(0);
        unsigned nloc = b.st[0], nx = b.st[1];
        if (nloc == 0u) { xcd_barrier_complete(bar, b.x, nloc, nx); b.st[0] = nloc; b.st[1] = nx; }
        const unsigned old = xb_add(&bar[XB_XSUB(b.x)], 1u);
        const unsigned gen = old / nloc;
        if (old + 1u == (gen + 1u) * nloc) {
            __builtin_amdgcn_fence(__ATOMIC_RELEASE, "agent");
            asm volatile("s_waitcnt vmcnt(0)" ::: "memory");
            const unsigned og = xb_add(&bar[XB_TOP], 1u);
            const unsigned tg = og / nx;
            if (og + 1u == (tg + 1u) * nx) xb_add(&bar[XB_TOPGEN], 1u);
            else XB_SPIN(xb_ld(&bar[XB_TOPGEN]) == tg, bar);
            __builtin_amdgcn_fence(__ATOMIC_ACQUIRE, "agent");
            xb_add(&bar[XB_XGEN(b.x)], 1u);
            asm volatile("s_waitcnt vmcnt(0)" ::: "memory");
        } else {
            XB_SPIN(xb_ld(&bar[XB_XGEN(b.x)]) == gen, bar);
            __builtin_amdgcn_fence(__ATOMIC_ACQUIRE, "agent");
            asm volatile("s_waitcnt vmcnt(0)" ::: "memory");
        }
    }
    __syncthreads();
}

__device__ __forceinline__ int lane_id() { int l; asm volatile("v_mbcnt_lo_u32_b32 %0, -1, 0\n\tv_mbcnt_hi_u32_b32 %0, -1, %0" : "=v"(l)); return l; }

constexpr int NB = 16, TT = 2048, DM = 1024, MR = NB * TT, NMETA = 16, MROWS = MR + 256, NPAN = MROWS / 256;
constexpr int PSEQ = 2112, NCH = 33;
constexpr int DIN = 2864, N1 = 3072;
constexpr int DFF = 2816, DFE = 3584, NEXP = 8;
constexpr float EPS = 1e-6f;
constexpr int C_AQ = 0, C_AK = 128, C_AV = 256, C_ALR = 512, C_AOG = 528, C_RQ = 784, C_RK = 1040, C_RV = 1296, C_ROG = 1552, C_CQ = 1808, C_CKV = 2000, C_KPE = 2064, C_DQ = 2096, C_DK = 2352, C_DV = 2608;
constexpr int MAXPAN = 264;
constexpr float LOG2E = 1.4426950408889634f;

constexpr size_t MiB = 1u << 20;
constexpr size_t WS_CTL = 0, CTL_BYTES = 1 * MiB;
constexpr size_t WS_TABR = 1 * MiB, WS_TABM = 1 * MiB + 576 * 1024;
constexpr size_t WS_RT = 2 * MiB;
constexpr size_t WS_WQA = 2 * MiB + 256 * 1024, WQA_BYTES = 384 * 192 * 2;
constexpr size_t WS_STA = 3 * MiB, WS_STB = 6 * MiB;
constexpr size_t WS_MOE = 9 * MiB;
constexpr size_t MO_ROWIDX = WS_MOE, MO_PDST = WS_MOE + 512 * 1024, MO_PINFO = WS_MOE + 1 * MiB, MO_TOKE = WS_MOE + 2 * MiB, MO_TOKP = MO_TOKE + 256 * 1024, MO_TOKW = MO_TOKE + 512 * 1024, MO_PEXP = WS_MOE + 3 * MiB;
constexpr size_t WS_GD = 13 * MiB;
constexpr size_t WS_W1T = 16 * MiB, W1T_BYTES = (size_t)N1 * DM * 2;
constexpr size_t WS_WOT = 29 * MiB, WOT_BYTES = (size_t)DM * DM * 2;
constexpr size_t WS_WGU = 33 * MiB;
constexpr size_t WS_WD = 44 * MiB;
constexpr size_t WS_HB = 50 * MiB;
constexpr size_t WS_BIG = 115 * MiB;
constexpr size_t B_PROJ = WS_BIG;
constexpr int GQ_T = 5120, GKT_T = 5120, RT_T = 9216, VT_T = 9216;
constexpr size_t B_GQ = WS_BIG + 210 * MiB, B_GK = WS_BIG + 221 * MiB, B_GV = WS_BIG + 232 * MiB;
constexpr size_t B_RQ = WS_BIG + 251 * MiB, B_RK = WS_BIG + 270 * MiB, B_RV = WS_BIG + 289 * MiB;
constexpr size_t B_MQ = WS_BIG + 308 * MiB, B_MK = WS_BIG + 333 * MiB;
constexpr size_t B_DQ = WS_BIG + 340 * MiB, B_DK = B_DQ + 16896 * 1024;
constexpr size_t O_DVT = 65 * MiB, O_MVT = 82 * MiB, O_GKT = 87 * MiB, O_RKT = 98 * MiB;
constexpr size_t B_ACT = WS_BIG;
constexpr size_t B_EGU = WS_BIG, EGU_BYTES = (size_t)2 * DFE * DM;
constexpr size_t B_HB8 = WS_BIG + 56 * MiB;
constexpr float W8_SCALE = 64.f;
constexpr size_t B_ED = WS_BIG + 112 * MiB, ED_BYTES = (size_t)DM * DFE;
constexpr float ACT8_SCALE = 16.f;
constexpr size_t B_EACT = WS_BIG + 168 * MiB;
constexpr size_t WS_NEED = WS_BIG + 406 * MiB;
constexpr int CW_BAR = 4096, CW_CNT = 8192;

constexpr int RING_BYTES = 131072, MISC_OFF = RING_BYTES + 320, EPS_OFF = 147456, LDS_BYTES = 163840;

__device__ __forceinline__ float clamp8(float v) { return __builtin_amdgcn_fmed3f(v, -448.f, 448.f); }
__device__ __forceinline__ unsigned pk4_fp8(float a, float b, float c, float d) { unsigned q = (unsigned)__builtin_amdgcn_cvt_pk_fp8_f32(clamp8(a), clamp8(b), 0, false); return (unsigned)__builtin_amdgcn_cvt_pk_fp8_f32(clamp8(c), clamp8(d), (int)q, true); }
__device__ __forceinline__ float silu_f(float x) { return x * __builtin_amdgcn_rcpf(1.0f + __builtin_amdgcn_exp2f(-x * LOG2E)); }
__device__ __forceinline__ v4u pack8(const f32x4 a, const f32x4 b) { v4u w; w.x = pg8::cvt_pk_bf16(a[0], a[1]); w.y = pg8::cvt_pk_bf16(a[2], a[3]); w.z = pg8::cvt_pk_bf16(b[0], b[1]); w.w = pg8::cvt_pk_bf16(b[2], b[3]); return w; }

__device__ __forceinline__ void rows_rstd16(const float* stats, int row0, int fq, float (&rs)[8]) {
    f32x4 v[8];
#pragma unroll
    for (int j = 0; j < 8; ++j) v[j] = *(const f32x4*)(stats + (size_t)(row0 + (j >> 2) * 128 + (j & 3) * 16) * 16 + 4 * fq);
#pragma unroll
    for (int j = 0; j < 8; ++j) { float s = (v[j][0] + v[j][1]) + (v[j][2] + v[j][3]); s += __shfl_xor(s, 16); s += __shfl_xor(s, 32); rs[j] = __builtin_amdgcn_rsqf(s * (1.0f / 1024.0f) + EPS); }
}
__device__ __forceinline__ void stage_rows(const void* src, int bytes, LAS unsigned char* lds, int wid, int lane) {
#pragma unroll
    for (int j = 0; j < 2; ++j) { const int p = __builtin_amdgcn_readfirstlane(wid + 8 * j);
        if (p * 1024 < bytes) __builtin_amdgcn_global_load_lds((const unsigned*)((const unsigned char*)src + p * 1024 + lane * 16), (LAS unsigned*)(lds + EPS_OFF + p * 1024), 16, 0, 0); }
}
__device__ __forceinline__ void rows_rstd16_lds(const LAS unsigned char* lds, int rl0, int fq, float (&rs)[8]) {
    f32x4 v[8];
#pragma unroll
    for (int j = 0; j < 8; ++j) v[j] = *(const LAS f32x4*)(lds + EPS_OFF + (rl0 + (j >> 2) * 128 + (j & 3) * 16) * 64 + 16 * fq);
#pragma unroll
    for (int j = 0; j < 8; ++j) { float s = (v[j][0] + v[j][1]) + (v[j][2] + v[j][3]); s += __shfl_xor(s, 16); s += __shfl_xor(s, 32); rs[j] = __builtin_amdgcn_rsqf(s * (1.0f / 1024.0f) + EPS); }
}
struct EpiProj {
    bf16* O; const float* stats;
    __device__ __forceinline__ void prefetch(LAS unsigned char* lds, const pg8::Unit& u, int wid, int lane) const { stage_rows(stats + (size_t)u.pm * 256 * 16, 16384, lds, wid, lane); }
    __device__ __forceinline__ void operator()(const f32x4 (&acc)[2][2][4][2], const pg8::Unit& u, int wr, int wc, int fr, int fq, const LAS unsigned char* lds) const {
        const int col0 = u.pn * 256 + wc * 32 + 8 * fq, row0 = u.pm * 256 + wr * 64 + fr;
        float rs[8]; rows_rstd16_lds(lds, wr * 64 + fr, fq, rs);
#pragma unroll
        for (int ai = 0; ai < 2; ++ai)
#pragma unroll
            for (int m = 0; m < 4; ++m) { const int r = row0 + ai * 128 + m * 16; const float sc = rs[ai * 4 + m]; bf16* rowp = O + (size_t)r * N1 + col0;
#pragma unroll
                for (int bj = 0; bj < 2; ++bj) *(v4u*)(rowp + bj * 128) = pack8(acc[ai][bj][m][0] * sc, acc[ai][bj][m][1] * sc); }
    }
};
struct EpiSwiglu {
    bf16* O; int ldo; const float* stats;
    __device__ __forceinline__ void prefetch(LAS unsigned char* lds, const pg8::Unit& u, int wid, int lane) const { stage_rows(stats + (size_t)u.pm * 256 * 16, 16384, lds, wid, lane); }
    __device__ __forceinline__ void operator()(const f32x4 (&acc)[2][2][4][2], const pg8::Unit& u, int wr, int wc, int fr, int fq, const LAS unsigned char* lds) const {
        const int col0 = u.pn * 128 + wc * 32 + 8 * fq, row0 = u.pm * 256 + wr * 64 + fr;
        float rs[8]; rows_rstd16_lds(lds, wr * 64 + fr, fq, rs);
#pragma unroll
        for (int ai = 0; ai < 2; ++ai)
#pragma unroll
            for (int m = 0; m < 4; ++m) { const int r = row0 + ai * 128 + m * 16; const float sc = rs[ai * 4 + m];
                f32x4 o[2];
#pragma unroll
                for (int n = 0; n < 2; ++n)
#pragma unroll
                    for (int i = 0; i < 4; ++i) o[n][i] = silu_f(acc[ai][0][m][n][i] * sc) * (acc[ai][1][m][n][i] * sc);
                *(v4u*)(O + (size_t)r * ldo + col0) = pack8(o[0], o[1]); }
    }
};
struct EpiResid {
    bf16* H; float* stats;
    __device__ __forceinline__ void prefetch(LAS unsigned char*, const pg8::Unit&, int, int) const {}
    __device__ __forceinline__ void operator()(const f32x4 (&acc)[2][2][4][2], const pg8::Unit& u, int wr, int wc, int fr, int fq, const LAS unsigned char*) const {
        const int col0 = u.pn * 256 + wc * 32 + 8 * fq, row0 = u.pm * 256 + wr * 64 + fr;
#pragma unroll
        for (int ai = 0; ai < 2; ++ai) {
            v4u w[4][2];
#pragma unroll
            for (int m = 0; m < 4; ++m)
#pragma unroll
                for (int bj = 0; bj < 2; ++bj) w[m][bj] = *(const v4u*)(H + (size_t)(row0 + ai * 128 + m * 16) * DM + col0 + bj * 128);
            float ssm[4];
#pragma unroll
            for (int m = 0; m < 4; ++m) { bf16* rowp = H + (size_t)(row0 + ai * 128 + m * 16) * DM + col0; float ss = 0.f;
#pragma unroll
                for (int bj = 0; bj < 2; ++bj) { const v4u x = w[m][bj];
                    f32x4 a = acc[ai][bj][m][0], b = acc[ai][bj][m][1];
                    a[0] += bflo(x.x); a[1] += bfhi(x.x); a[2] += bflo(x.y); a[3] += bfhi(x.y); b[0] += bflo(x.z); b[1] += bfhi(x.z); b[2] += bflo(x.w); b[3] += bfhi(x.w);
                    ss += (a[0] * a[0] + a[1] * a[1]) + (a[2] * a[2] + a[3] * a[3]) + (b[0] * b[0] + b[1] * b[1]) + (b[2] * b[2] + b[3] * b[3]);
                    *(v4u*)(rowp + bj * 128) = pack8(a, b); }
                ss += __shfl_xor(ss, 16); ss += __shfl_xor(ss, 32); ssm[m] = ss; }
            if (fq == 0) {
#pragma unroll
                for (int m = 0; m < 4; ++m) stats[(size_t)(row0 + ai * 128 + m * 16) * 16 + u.pn * 4 + wc] = ssm[m]; } }
    }
};
struct EpiSwigluMoe {
    unsigned char* O; const f32x2* pinfo; float wscale;
    __device__ __forceinline__ void prefetch(LAS unsigned char* lds, const pg8::Unit& u, int wid, int lane) const { stage_rows(pinfo + (size_t)u.gp * 256, 2048, lds, wid, lane); }
    __device__ __forceinline__ void operator()(const f32x4 (&acc)[2][2][4][2], const pg8::Unit& u, int wr, int wc, int fr, int fq, const LAS unsigned char* lds) const {
        const int col0 = u.pn * 128 + wc * 32 + 8 * fq, rl0 = wr * 64 + fr;
        float rs[8];
#pragma unroll
        for (int j = 0; j < 8; ++j) rs[j] = ((const LAS f32x2*)(lds + EPS_OFF))[rl0 + (j >> 2) * 128 + (j & 3) * 16][0] * wscale;
#pragma unroll
        for (int ai = 0; ai < 2; ++ai)
#pragma unroll
            for (int m = 0; m < 4; ++m) { const int rl = rl0 + ai * 128 + m * 16; const float sc = rs[ai * 4 + m];
                f32x4 o[2];
#pragma unroll
                for (int n = 0; n < 2; ++n)
#pragma unroll
                    for (int i = 0; i < 4; ++i) o[n][i] = silu_f(acc[ai][0][m][n][i] * sc) * (acc[ai][1][m][n][i] * sc) * ACT8_SCALE;
                *(uint2*)(O + (size_t)(u.pm * 256 + rl) * DFE + col0) = make_uint2(pk4_fp8(o[0][0], o[0][1], o[0][2], o[0][3]), pk4_fp8(o[1][0], o[1][1], o[1][2], o[1][3])); }
    }
};
struct EpiMoeDown {
    unsigned char* Y; const int* pdst; const f32x2* pinfo; float oscale;
    __device__ __forceinline__ void prefetch(LAS unsigned char* lds, const pg8::Unit& u, int wid, int lane) const {
        if (wid < 2) __builtin_amdgcn_global_load_lds((const unsigned*)((const unsigned char*)(pinfo + (size_t)u.gp * 256) + wid * 1024 + lane * 16), (LAS unsigned*)(lds + EPS_OFF + wid * 1024), 16, 0, 0);
        else if (wid == 2) __builtin_amdgcn_global_load_lds((const unsigned*)((const unsigned char*)(pdst + (size_t)u.gp * 256) + lane * 16), (LAS unsigned*)(lds + EPS_OFF + 2048), 16, 0, 0); }
    __device__ __forceinline__ void operator()(const f32x4 (&acc)[2][2][4][2], const pg8::Unit& u, int wr, int wc, int fr, int fq, const LAS unsigned char* lds) const {
        const int col0 = u.pn * 256 + wc * 32 + 8 * fq, rl0 = wr * 64 + fr;
#pragma unroll
        for (int ai = 0; ai < 2; ++ai)
#pragma unroll
            for (int m = 0; m < 4; ++m) { const int rl = rl0 + ai * 128 + m * 16; const int d = ((const LAS int*)(lds + EPS_OFF + 2048))[rl]; const float w = ((const LAS f32x2*)(lds + EPS_OFF))[rl][1] * oscale;
                if (d >= 0) { bf16* rowp = (bf16*)(Y + (size_t)(d >> 1) * 4096 + (size_t)(d & 1) * 2048) + col0;
#pragma unroll
                    for (int bj = 0; bj < 2; ++bj) *(v4u*)(rowp + bj * 128) = pack8(acc[ai][bj][m][0] * w, acc[ai][bj][m][1] * w); } }
    }
};

__device__ __forceinline__ float wave_sum(float v) {
#pragma unroll
    for (int o = 1; o < 64; o <<= 1) v += __shfl_xor(v, o);
    return v;
}
__device__ __forceinline__ void transpose_item(const float* W, int K, int N, const float* gain, bf16* WT, int kb, int nb, int dmode, LAS float* scr_, int lane) {
    LAS unsigned* scr = (LAS unsigned*)scr_;
    const int k0 = 64 * kb, n0 = 64 * nb, n = n0 + 2 * (lane & 31), kh = lane >> 5;
    f32x2 v[32];
#pragma unroll
    for (int i = 0; i < 32; ++i) v[i] = (n < N) ? *(const f32x2*)(W + (size_t)(k0 + 2 * i + kh) * N + n) : (f32x2){0.f, 0.f};
    if (gain) {
#pragma unroll
        for (int i = 0; i < 32; ++i) v[i] = v[i] * gain[k0 + 2 * i + kh]; }
#pragma unroll
    for (int i = 0; i < 32; ++i) scr[(2 * i + kh) * 33 + (lane & 31)] = pk2(v[i][0], v[i][1]);
    LDS_WAIT(); asm volatile("" ::: "memory");
    const LAS bf16* T = (const LAS bf16*)scr;
    const int c = lane & 7;
    const int d0 = dmode == 0 ? n0 : 256 * (n0 >> 7) + (n0 & 127) + (dmode == 2 ? 128 : 0);
#pragma unroll
    for (int j = 0; j < 8; ++j) { const int nl = (lane >> 3) + 8 * j; unsigned x[8];
#pragma unroll
        for (int t = 0; t < 8; ++t) x[t] = T[(8 * c + t) * 66 + nl];
        v4u o; o.x = x[0] | (x[1] << 16); o.y = x[2] | (x[3] << 16); o.z = x[4] | (x[5] << 16); o.w = x[6] | (x[7] << 16);
        if (n0 + nl < N) *(v4u*)(WT + (size_t)(d0 + nl) * K + k0 + 8 * c) = o; }
    LDS_WAIT(); asm volatile("" ::: "memory");
}

__device__ __forceinline__ void transpose_item_f8(const float* W, int K, int N, const float* gain, unsigned char* WT, int kb, int nb, int dmode, LAS float* scr_, int lane) {
    LAS unsigned char* scr = (LAS unsigned char*)scr_;
    const int k0 = 128 * kb, n0 = 64 * nb, nl2 = 2 * (lane & 31), n = n0 + nl2, kh = lane >> 5;
#pragma unroll
    for (int half = 0; half < 2; ++half) {
        f32x2 v[32];
#pragma unroll
        for (int i = 0; i < 32; ++i) v[i] = (n < N) ? *(const f32x2*)(W + (size_t)(k0 + 64 * half + 2 * i + kh) * N + n) : (f32x2){0.f, 0.f};
#pragma unroll
        for (int i = 0; i < 32; ++i) { const float gs = (gain ? gain[k0 + 64 * half + 2 * i + kh] : 1.f) * W8_SCALE; const int k = 64 * half + 2 * i + kh;
            const unsigned pk = (unsigned)__builtin_amdgcn_cvt_pk_fp8_f32(v[i][0] * gs, v[i][1] * gs, 0, false);
            scr[nl2 * 132 + k] = (unsigned char)(pk & 0xffu); scr[(nl2 + 1) * 132 + k] = (unsigned char)((pk >> 8) & 0xffu); } }
    LDS_WAIT(); asm volatile("" ::: "memory");
    const int c = lane & 7;
    const int d0 = dmode == 0 ? n0 : 256 * (n0 >> 7) + (n0 & 127) + (dmode == 2 ? 128 : 0);
#pragma unroll
    for (int j = 0; j < 8; ++j) { const int nl = (lane >> 3) + 8 * j; const LAS unsigned* p = (const LAS unsigned*)(scr + nl * 132 + 16 * c);
        v4u o; o.x = p[0]; o.y = p[1]; o.z = p[2]; o.w = p[3];
        if (n0 + nl < N) *(v4u*)(WT + (size_t)(d0 + nl) * K + k0 + 16 * c) = o; }
    LDS_WAIT(); asm volatile("" ::: "memory");
}

struct Args { const float* in[24]; float* out; unsigned char* ws; int ph_lo, ph_hi; };
__device__ __forceinline__ const float* ain(const Args& a, int i) { return a.in[i]; }
enum { I_X = 0, I_META, I_ANORM, I_WIN, I_GWG, I_GBG, I_GNORM, I_RNORM, I_MQN, I_WUQ, I_MKVN, I_WUKV, I_DLAM, I_DNORM, I_WOUT, I_FNORM, I_FG, I_FU, I_FD, I_ROUTER, I_EG, I_EU, I_ED, I_FINAL };

#ifndef REP_FOLD
#define REP_FOLD 1
#endif
#ifndef REP_HINIT
#define REP_HINIT 1
#endif
__device__ __forceinline__ void wqa_unit(const Args& a, int li, int hh, LAS float* L, int tid) {
    const float* Wuq = ain(a, I_WUQ) + (size_t)li * 192 * 384; const float* Wukv = ain(a, I_WUKV) + (size_t)li * 64 * 512;
    const float* gq = ain(a, I_MQN) + li * 192; const float* gkv = ain(a, I_MKVN) + li * 64;
    bf16* WqaT = (bf16*)(a.ws + WS_WQA + li * WQA_BYTES);
    LAS float* Wqa = L; LAS float* Wuk = L + 192 * 97;
    __syncthreads();
    for (int idx = tid; idx < 64 * 64; idx += 512) { const int n = idx >> 6, m = idx & 63; Wuk[n * 65 + m] = Wukv[n * 512 + hh * 128 + m]; }
    __syncthreads();
    for (int pass = 0; pass < 3; ++pass) { const int i = pass * 64 + (tid >> 3), ng = tid & 7; f32x4 wq[16];
#pragma unroll
        for (int j = 0; j < 16; ++j) wq[j] = *(const f32x4*)(Wuq + i * 384 + hh * 96 + 4 * j);
        const float gi = gq[i];
#pragma unroll
        for (int t = 0; t < 8; ++t) { const int n = ng * 8 + t; float s = 0.f;
#pragma unroll
            for (int j = 0; j < 16; ++j) s += (wq[j][0] * Wuk[n * 65 + 4 * j] + wq[j][1] * Wuk[n * 65 + 4 * j + 1]) + (wq[j][2] * Wuk[n * 65 + 4 * j + 2] + wq[j][3] * Wuk[n * 65 + 4 * j + 3]);
            Wqa[i * 97 + n] = gi * gkv[n] * s; }
        if (ng < 4) {
#pragma unroll
            for (int j = 0; j < 2; ++j) { const f32x4 r = *(const f32x4*)(Wuq + i * 384 + hh * 96 + 64 + ng * 8 + 4 * j); LAS float* d = Wqa + i * 97 + 64 + ng * 8 + 4 * j; d[0] = gi * r[0]; d[1] = gi * r[1]; d[2] = gi * r[2]; d[3] = gi * r[3]; } } }
    __syncthreads();
    for (int idx = tid; idx < 96 * 24; idx += 512) { const int n = idx % 96, i8 = idx / 96; float v[8];
#pragma unroll
        for (int t = 0; t < 8; ++t) v[t] = Wqa[(8 * i8 + t) * 97 + n];
        v4u w; w.x = pk2(v[0], v[1]); w.y = pk2(v[2], v[3]); w.z = pk2(v[4], v[5]); w.w = pk2(v[6], v[7]);
        *(v4u*)(WqaT + (size_t)(hh * 96 + n) * 192 + 8 * i8) = w; }
    __syncthreads();
}
__device__ __forceinline__ void wofold_unit(const Args& a, int li, int hh, int nq, LAS float* L, int tid) {
    const float* Wukv = ain(a, I_WUKV) + (size_t)li * 64 * 512; const float* gkv = ain(a, I_MKVN) + li * 64; const float* Wo = ain(a, I_WOUT) + (size_t)li * DM * DM;
    bf16* Wot = (bf16*)(a.ws + WS_WOT + li * WOT_BYTES);
    LAS float* WuvT = L; LAS float* Wos = L + 64 * 64;
    __syncthreads();
    for (int idx = tid; idx < 64 * 64; idx += 512) { const int j = idx >> 6, e = idx & 63; WuvT[e * 64 + j] = Wukv[j * 512 + hh * 128 + 64 + e] * gkv[j]; }
    for (int idx = tid; idx < 64 * 64; idx += 512) { const int e = idx >> 6, n4 = idx & 63; *(LAS f32x4*)(Wos + e * 256 + 4 * n4) = *(const f32x4*)(Wo + (size_t)(512 + 64 * hh + e) * DM + nq * 256 + 4 * n4); }
    __syncthreads();
    { const int n4 = tid & 63, j8 = tid >> 6; f32x4 acc[8];
#pragma unroll
        for (int j = 0; j < 8; ++j) acc[j] = (f32x4){0.f, 0.f, 0.f, 0.f};
#pragma unroll 4
        for (int e = 0; e < 64; ++e) { const f32x4 wv = *(const LAS f32x4*)(Wos + e * 256 + 4 * n4); const f32x4 u0 = *(const LAS f32x4*)(WuvT + e * 64 + 8 * j8), u1 = *(const LAS f32x4*)(WuvT + e * 64 + 8 * j8 + 4);
#pragma unroll
            for (int j = 0; j < 4; ++j) { acc[j] += wv * u0[j]; acc[4 + j] += wv * u1[j]; } }
#pragma unroll
        for (int t = 0; t < 4; ++t) { v4u w; w.x = pk2(acc[0][t], acc[1][t]); w.y = pk2(acc[2][t], acc[3][t]); w.z = pk2(acc[4][t], acc[5][t]); w.w = pk2(acc[6][t], acc[7][t]);
            *(v4u*)(Wot + (size_t)(nq * 256 + 4 * n4 + t) * DM + 512 + 64 * hh + 8 * j8) = w; } }
    __syncthreads();
}
__device__ __forceinline__ void p0_prologue(const Args& a, LAS unsigned char* lds, int tid, int lane, int wave) {
    const int G = gridDim.x;
    for (int rep = 0; rep < REP_FOLD; ++rep)
    for (int un = blockIdx.x; un < 40; un += G) {
        if (un < 8) wqa_unit(a, un >> 2, un & 3, (LAS float*)lds, tid);
        else { const int v = un - 8; wofold_unit(a, v >> 4, (v >> 2) & 3, v & 3, (LAS float*)lds, tid); }
    }
    __syncthreads();
    LAS float* scr = (LAS float*)(lds + wave * 16384);
    const int gw = blockIdx.x * 8 + wave, NGW = G * 8;
    constexpr int I_IN = 16 * 45, I_WO = 12 * 16, I_G = 16 * 44, I_D = 44 * 16;
    constexpr int NIT = 2 * I_IN + 2 * I_WO + 2 * I_G + I_D;
    for (int it = gw; it < NIT; it += NGW) {
        int r = it;
        if (r < 2 * I_IN) { const int li = r / I_IN; r %= I_IN; transpose_item(ain(a, I_WIN) + (size_t)li * DM * DIN, DM, DIN, ain(a, I_ANORM) + li * DM, (bf16*)(a.ws + WS_W1T + li * W1T_BYTES), r / 45, r % 45, 0, scr, lane); continue; } r -= 2 * I_IN;
        if (r < 2 * I_WO) { const int li = r / I_WO; r %= I_WO; int kb = r / 16; if (kb >= 8) kb += 4; transpose_item(ain(a, I_WOUT) + (size_t)li * DM * DM, DM, DM, nullptr, (bf16*)(a.ws + WS_WOT + li * WOT_BYTES), kb, r % 16, 0, scr, lane); continue; } r -= 2 * I_WO;
        if (r < I_G) { transpose_item(ain(a, I_FG), DM, DFF, ain(a, I_FNORM), (bf16*)(a.ws + WS_WGU), r / 44, r % 44, 1, scr, lane); continue; } r -= I_G;
        if (r < I_G) { transpose_item(ain(a, I_FU), DM, DFF, ain(a, I_FNORM), (bf16*)(a.ws + WS_WGU), r / 44, r % 44, 2, scr, lane); continue; } r -= I_G;
        transpose_item(ain(a, I_FD), DFF, DM, nullptr, (bf16*)(a.ws + WS_WD), r / 16, r % 16, 0, scr, lane);
    }
    const int gt = blockIdx.x * 512 + tid, NGT = G * 512;
    for (int i = gt; i < 2 * 208 * 128; i += NGT) { const int li = i / (208 * 128), r = i % (208 * 128);
        *(v4u*)(a.ws + WS_W1T + li * W1T_BYTES + (size_t)DIN * DM * 2 + (size_t)r * 16) = (v4u){0u, 0u, 0u, 0u}; }
    for (int i = gt; i < 8 * DM; i += NGT) { const int e = i >> 10, k = i & 1023; ((float*)(a.ws + WS_RT))[i] = ain(a, I_FNORM)[DM + k] * ain(a, I_ROUTER)[k * 8 + e]; }
    for (int i = gt; i < PSEQ * 48; i += NGT) { const int p = i / 48, j = i % 48; const bool isR = j < 32; const int f = isR ? j : j - 32;
        const float inv = __builtin_amdgcn_exp2f(-(float)f * (isR ? 13.287712379549449f / 32.f : 13.287712379549449f / 16.f));
        const double rev = (double)(p - 48) * (double)inv * 0.15915494309189535; const float fr = (float)(rev - __builtin_rint(rev));
        const f32x2 cs = {__builtin_amdgcn_cosf(fr), __builtin_amdgcn_sinf(fr)};
        if (isR) ((f32x2*)(a.ws + WS_TABR))[p * 32 + f] = cs; else ((f32x2*)(a.ws + WS_TABM))[p * 16 + f] = cs; }
    for (int i = gt; i < 240 * 128; i += NGT) *(v4u*)((unsigned char*)a.out + (size_t)(MR + 16) * 2048 + (size_t)i * 16) = (v4u){0u, 0u, 0u, 0u};
    bf16* hb = (bf16*)(a.ws + WS_HB); float* stA = (float*)(a.ws + WS_STA);
    for (int rep = 0; rep < REP_HINIT; ++rep)
    for (int r = gw; r < MROWS; r += NGW) {
        f32x4 v[4]; float s = 0.f;
#pragma unroll
        for (int j = 0; j < 4; ++j) { if (r < MR) v[j] = ((const f32x4*)(ain(a, I_X) + (size_t)r * DM))[lane + 64 * j]; else if (r < MR + NMETA) v[j] = ((const f32x4*)(ain(a, I_META) + (size_t)(r - MR) * DM))[lane + 64 * j]; else v[j] = (f32x4){0.f, 0.f, 0.f, 0.f};
            s += (v[j][0] * v[j][0] + v[j][1] * v[j][1]) + (v[j][2] * v[j][2] + v[j][3] * v[j][3]); }
        s = wave_sum(s);
#pragma unroll
        for (int j = 0; j < 4; ++j) { v2u w; w.x = pk2(v[j][0], v[j][1]); w.y = pk2(v[j][2], v[j][3]); ((v2u*)(hb + (size_t)r * DM))[lane + 64 * j] = w; }
        if (lane < 16) stA[(size_t)r * 16 + lane] = lane == 0 ? s : 0.f;
    }
}

__device__ __forceinline__ int src_row(int b, int c, int i) { return c == 0 ? (i < 48 ? -1 : MR + i - 48) : b * TT + 64 * (c - 1) + i; }
__device__ __forceinline__ float lg2gamma(int h) { return h == 0 ? -0.045803689613124789f : h == 1 ? -0.022720076500083529f : h == 2 ? -0.011315313227834146f : -0.0056465631411420627f; }

__device__ __forceinline__ void route_block(const Args& a, int blk, LAS unsigned char* lds, int tid, int lane, int wave) {
    LAS float* Rs = (LAS float*)lds; LAS int* lcnt = (LAS int*)(lds + 32768); LAS int* gbase = lcnt + 8; LAS int* rec = lcnt + 16;
    gu32* ctl = (gu32*)(a.ws + WS_CTL);
    const float* Rt = (const float*)(a.ws + WS_RT); const bf16* hb = (const bf16*)(a.ws + WS_HB); const float* stB = (const float*)(a.ws + WS_STB);
    __syncthreads();
    for (int idx = tid; idx < 8 * DM; idx += 512) Rs[idx] = Rt[idx];
    if (tid < 8) lcnt[tid] = 0;
    __syncthreads();
    for (int rr = 0; rr < 16; ++rr) { const int rl = wave * 16 + rr, row = blk * 128 + rl;
        const v4u w0 = *(const v4u*)(hb + (size_t)row * DM + 8 * lane), w1 = *(const v4u*)(hb + (size_t)row * DM + 512 + 8 * lane);
        const float x[16] = {bflo(w0.x), bfhi(w0.x), bflo(w0.y), bfhi(w0.y), bflo(w0.z), bfhi(w0.z), bflo(w0.w), bfhi(w0.w), bflo(w1.x), bfhi(w1.x), bflo(w1.y), bfhi(w1.y), bflo(w1.z), bfhi(w1.z), bflo(w1.w), bfhi(w1.w)};
        { const unsigned q0 = pk4_fp8(x[0], x[1], x[2], x[3]), q1 = pk4_fp8(x[4], x[5], x[6], x[7]), q2 = pk4_fp8(x[8], x[9], x[10], x[11]), q3 = pk4_fp8(x[12], x[13], x[14], x[15]);
          unsigned char* h8 = a.ws + B_HB8 + (size_t)row * DM;
          *(uint2*)(h8 + 8 * lane) = make_uint2(q0, q1); *(uint2*)(h8 + 512 + 8 * lane) = make_uint2(q2, q3); }
        float st = lane < 16 ? stB[(size_t)row * 16 + lane] : 0.f; st = wave_sum(st); const float rs = __builtin_amdgcn_rsqf(st * (1.f / 1024.f) + EPS);
        float lg[8];
#pragma unroll
        for (int e = 0; e < 8; ++e) { float s = 0.f;
#pragma unroll
            for (int t = 0; t < 8; ++t) s += x[t] * Rs[e * DM + 8 * lane + t] + x[8 + t] * Rs[e * DM + 512 + 8 * lane + t];
            lg[e] = wave_sum(s) * rs; }
        int e0 = 0; float v0 = lg[0];
#pragma unroll
        for (int e = 1; e < 8; ++e) if (lg[e] > v0) { v0 = lg[e]; e0 = e; }
        int e1 = -1; float v1 = -3.0e38f;
#pragma unroll
        for (int e = 0; e < 8; ++e) if (e != e0 && lg[e] > v1) { v1 = lg[e]; e1 = e; }
        const float g0 = 1.f / (1.f + __expf(v1 - v0)), g1 = 1.f - g0;
        if (lane == 0) { const int lp0 = atomicAdd((int*)(lcnt + e0), 1), lp1 = atomicAdd((int*)(lcnt + e1), 1);
            rec[rl * 6] = e0; rec[rl * 6 + 1] = e1; rec[rl * 6 + 2] = lp0; rec[rl * 6 + 3] = lp1; rec[rl * 6 + 4] = __float_as_int(g0); rec[rl * 6 + 5] = __float_as_int(g1); } }
    __syncthreads();
    if (tid < 8) gbase[tid] = (int)__hip_atomic_fetch_add(ctl + CW_CNT + 64 * tid, (unsigned)lcnt[tid], RLX_AGENT);
    __syncthreads();
    if (tid < 256) { const int rl = tid >> 1, s = tid & 1, tok = blk * 128 + rl, e = rec[rl * 6 + s];
        ((int*)(a.ws + MO_TOKE))[tok * 2 + s] = e; ((int*)(a.ws + MO_TOKP))[tok * 2 + s] = gbase[e] + rec[rl * 6 + 2 + s]; ((int*)(a.ws + MO_TOKW))[tok * 2 + s] = rec[rl * 6 + 4 + s]; }
    __syncthreads();
}
__device__ __forceinline__ void moe_offsets(const Args& a, LAS int* offs, int tid) {
    gu32* ctl = (gu32*)(a.ws + WS_CTL);
    __syncthreads();
    if (tid == 0) { int o = 0;
        for (int e = 0; e < 8; ++e) { const int cnt = (int)__hip_atomic_load(ctl + CW_CNT + 64 * e, RLX_AGENT); offs[e] = o * 256; o += (cnt + 255) >> 8; }
        offs[8] = o; }
    __syncthreads();
}

typedef float f32x16 __attribute__((ext_vector_type(16)));
typedef short s16x8 __attribute__((ext_vector_type(8)));
typedef short s16x4 __attribute__((ext_vector_type(4)));
typedef short v4i16_t __attribute__((ext_vector_type(4)));
__device__ __forceinline__ int crow(int r, int hi) { return (r & 3) + 8 * (r >> 2) + 4 * hi; }


__device__ __forceinline__ void stage_cols(const bf16* proj, int b, int c, int col0, int ncols, LAS bf16* S, int sst, int lcol0, int tid) {
    const int cpr = ncols >> 3;
    for (int idx = tid; idx < 64 * cpr; idx += 512) { const int i = idx / cpr, ch = idx - i * cpr, sr = src_row(b, c, i);
        v4u v = {0u, 0u, 0u, 0u}; if (sr >= 0) v = *(const v4u*)(proj + (size_t)sr * N1 + col0 + ch * 8);
        *(LAS v4u*)(S + i * sst + lcol0 + ch * 8) = v; }
}
__device__ __forceinline__ v4u gather8(const LAS bf16* S, int sst, int row0, int col) {
    unsigned x[8];
#pragma unroll
    for (int t = 0; t < 8; ++t) x[t] = S[(row0 + t) * sst + col];
    v4u w; w.x = x[0] | (x[1] << 16); w.y = x[2] | (x[3] << 16); w.z = x[4] | (x[5] << 16); w.w = x[6] | (x[7] << 16); return w;
}
__device__ __forceinline__ void prep2_unit(const Args& a, int li, int b, int c, int part, LAS unsigned char* lds, int tid) {
    const bf16* proj = (const bf16*)(a.ws + B_PROJ);
    LAS bf16* S = (LAS bf16*)lds;
    const int blk0 = (b * NCH + c) * 4; const size_t prow0 = (size_t)b * PSEQ + 64 * c;
    unsigned char* dout = (unsigned char*)a.out;
    __syncthreads();
    if (part == 0) {
        constexpr int SST = 536; LAS float* seg = (LAS float*)(lds + 64 * SST * 2);
        stage_cols(proj, b, c, C_AQ, 128, S, SST, 0, tid); stage_cols(proj, b, c, C_AK, 128, S, SST, 128, tid); stage_cols(proj, b, c, C_ALR, 16, S, SST, 512, tid);
        __syncthreads();
        { const int ch = tid & 127, sg = tid >> 7; const float* Wg = ain(a, I_GWG) + (size_t)li * 16 * 128; const float bg = ain(a, I_GBG)[li * 128 + ch];
            float wg[16];
#pragma unroll
            for (int r = 0; r < 16; ++r) wg[r] = Wg[r * 128 + ch];
            float cl[16]; float run = 0.f;
#pragma unroll
            for (int t = 0; t < 16; ++t) { const int i = 16 * sg + t; const v4u l0 = *(const LAS v4u*)(S + i * SST + 512), l1 = *(const LAS v4u*)(S + i * SST + 520);
                float x = bg + bflo(l0.x) * wg[0] + bfhi(l0.x) * wg[1] + bflo(l0.y) * wg[2] + bfhi(l0.y) * wg[3] + bflo(l0.z) * wg[4] + bfhi(l0.z) * wg[5] + bflo(l0.w) * wg[6] + bfhi(l0.w) * wg[7]
                               + bflo(l1.x) * wg[8] + bfhi(l1.x) * wg[9] + bflo(l1.y) * wg[10] + bfhi(l1.y) * wg[11] + bflo(l1.z) * wg[12] + bfhi(l1.z) * wg[13] + bflo(l1.w) * wg[14] + bfhi(l1.w) * wg[15];
                const float ls = fminf(x, 0.f) - __logf(1.f + __expf(-fabsf(x)));
                run += (c > 0 || i >= 48) ? ls * (1.f / 16.f) : 0.f; cl[t] = run; }
            seg[sg * 128 + ch] = run;
            __syncthreads();
            float off = 0.f;
#pragma unroll
            for (int s2 = 0; s2 < 3; ++s2) off += s2 < sg ? seg[s2 * 128 + ch] : 0.f;
            if (sg == 3) ((float*)(a.ws + WS_GD))[(size_t)(blk0 + (ch >> 5)) * 32 + (ch & 31)] = __expf(off + run);
#pragma unroll
            for (int t = 0; t < 16; ++t) { const int i = 16 * sg + t; const float cum = cl[t] + off;
                S[i * SST + ch] = (bf16)f2bf(bf2f(S[i * SST + ch]) * 0.17677669529663687f * __expf(cum)); S[i * SST + 128 + ch] = (bf16)f2bf(bf2f(S[i * SST + 128 + ch]) * __expf(-cum)); } }
        __syncthreads();
        for (int idx = tid; idx < 1024; idx += 512) { const int d8 = idx & 3, i = (idx >> 2) & 63, h = idx >> 8;
            *(v4u*)(a.ws + B_GQ + (size_t)(blk0 + h) * GQ_T + i * 80 + 16 * d8) = *(const LAS v4u*)(S + i * SST + h * 32 + 8 * d8);
            *(v4u*)(a.ws + B_GK + (size_t)(blk0 + h) * GQ_T + i * 80 + 16 * d8) = *(const LAS v4u*)(S + i * SST + 128 + h * 32 + 8 * d8); }
    } else if (part == 1) {
        constexpr int SST = 776;
        stage_cols(proj, b, c, C_RQ, 256, S, SST, 0, tid); stage_cols(proj, b, c, C_RK, 256, S, SST, 256, tid);
        LAS f32x4* tabL = (LAS f32x4*)(lds + 64 * SST * 2);
        for (int idx = tid; idx < 64 * 16; idx += 512) tabL[idx] = ((const f32x4*)(a.ws + WS_TABR))[(size_t)(64 * c) * 16 + idx];
        __syncthreads();
        const LAS f32x2* tabR = (const LAS f32x2*)tabL;
        for (int idx = tid; idx < 64 * 4 * 32; idx += 512) { const int j = idx & 31, h = (idx >> 5) & 3, i = idx >> 7; const f32x2 cs = tabR[i * 32 + j];
            LAS bf16* qp = S + i * SST + h * 64 + j; LAS bf16* kp = qp + 256;
            const float a1 = bf2f(qp[0]), a2 = bf2f(qp[32]), b1 = bf2f(kp[0]), b2 = bf2f(kp[32]);
            const float e = (float)(i + 1) * lg2gamma(h); const float fq = __builtin_amdgcn_exp2f(e), fk = 0.125f * __builtin_amdgcn_exp2f(-e);
            qp[0] = (bf16)f2bf((a1 * cs[0] - a2 * cs[1]) * fq); qp[32] = (bf16)f2bf((a1 * cs[1] + a2 * cs[0]) * fq); kp[0] = (bf16)f2bf((b1 * cs[0] - b2 * cs[1]) * fk); kp[32] = (bf16)f2bf((b1 * cs[1] + b2 * cs[0]) * fk); }
        __syncthreads();
        for (int idx = tid; idx < 2048; idx += 512) { const int d8 = idx & 7, i = (idx >> 3) & 63, h = idx >> 9;
            *(v4u*)(a.ws + B_RQ + (size_t)(blk0 + h) * RT_T + i * 144 + 16 * d8) = *(const LAS v4u*)(S + i * SST + h * 64 + 8 * d8);
            *(v4u*)(a.ws + B_RK + (size_t)(blk0 + h) * RT_T + i * 144 + 16 * d8) = *(const LAS v4u*)(S + i * SST + 256 + h * 64 + 8 * d8); }
    } else if (part == 2) {
        constexpr int SST = 296, OFF_RSD = 64 * SST * 2, OFF_TAB = OFF_RSD + 512, OFF_QS = OFF_TAB + 8192, QSS = 392;
        LAS float* rsd = (LAS float*)(lds + OFF_RSD); LAS f32x4* tabL = (LAS f32x4*)(lds + OFF_TAB); LAS bf16* Qs = (LAS bf16*)(lds + OFF_QS);
        stage_cols(proj, b, c, C_CQ, 192, S, SST, 0, tid); stage_cols(proj, b, c, C_CKV, 64, S, SST, 192, tid); stage_cols(proj, b, c, C_KPE, 32, S, SST, 256, tid);
        for (int idx = tid; idx < 64 * 8; idx += 512) tabL[idx] = ((const f32x4*)(a.ws + WS_TABM))[(size_t)(64 * c) * 8 + idx];
        __syncthreads();
        { const int i = tid >> 3, g = tid & 7; float sq = 0.f, sk = 0.f;
#pragma unroll
            for (int t = 0; t < 24; ++t) { const float v = bf2f(S[i * SST + g * 24 + t]); sq += v * v; }
#pragma unroll
            for (int t = 0; t < 8; ++t) { const float v = bf2f(S[i * SST + 192 + g * 8 + t]); sk += v * v; }
            sq += __shfl_xor(sq, 1); sq += __shfl_xor(sq, 2); sq += __shfl_xor(sq, 4); sk += __shfl_xor(sk, 1); sk += __shfl_xor(sk, 2); sk += __shfl_xor(sk, 4);
            if (g == 0) { rsd[i * 2] = __builtin_amdgcn_rsqf(sq * (1.f / 192.f) + EPS); rsd[i * 2 + 1] = __builtin_amdgcn_rsqf(sk * (1.f / 64.f) + EPS); } }
        __syncthreads();
        const LAS f32x2* tabM = (const LAS f32x2*)tabL; const float QS = 0.10206207261596577f * LOG2E;
        {
            const int lane = tid & 63, w = __builtin_amdgcn_readfirstlane(tid >> 6), r32 = lane & 31, hi = lane >> 5, ib = w & 1, nb0 = (w >> 1) * 3;
            const bf16* WqaT = (const bf16*)(a.ws + WS_WQA + li * WQA_BYTES);
            s16x8 af[12];
#pragma unroll
            for (int ks = 0; ks < 12; ++ks) af[ks] = *(const LAS s16x8*)(S + (32 * ib + r32) * SST + 16 * ks + 8 * hi);
            f32x16 acc[3];
#pragma unroll
            for (int j = 0; j < 3; ++j) { acc[j] = (f32x16){};
                s16x8 bfr[12];
#pragma unroll
                for (int ks = 0; ks < 12; ++ks) bfr[ks] = *(const s16x8*)(WqaT + (size_t)(32 * (nb0 + j) + r32) * 192 + 16 * ks + 8 * hi);
#pragma unroll
                for (int ks = 0; ks < 12; ++ks) acc[j] = __builtin_amdgcn_mfma_f32_32x32x16_bf16(af[ks], bfr[ks], acc[j], 0, 0, 0); }
            asm volatile("s_nop 15\n\ts_nop 7" : "+v"(acc[0]), "+v"(acc[1]), "+v"(acc[2]));
#pragma unroll
            for (int j = 0; j < 3; ++j)
#pragma unroll
                for (int r = 0; r < 16; ++r) { const int i = 32 * ib + crow(r, hi); float v = acc[j][r] * (rsd[i * 2] * QS);
                    if (j == 2) { const float o = __shfl_xor(v, 16); const f32x2 cs = tabM[i * 16 + (r32 & 15)]; v = r32 < 16 ? v * cs[0] - o * cs[1] : o * cs[1] + v * cs[0]; }
                    Qs[i * QSS + 32 * (nb0 + j) + r32] = (bf16)f2bf(v); } }
        for (int idx = tid; idx < 64 * 12; idx += 512) { const int k8 = idx % 12, i = idx / 12; float y[8];
            if (k8 < 8) { const float s = rsd[i * 2 + 1];
#pragma unroll
                for (int t = 0; t < 8; ++t) y[t] = bf2f(S[i * SST + 192 + 8 * k8 + t]) * s; }
            else { const int kk = (k8 - 8) & 1, second = (k8 - 8) >> 1;
#pragma unroll
                for (int t = 0; t < 8; ++t) { const int j = 8 * kk + t; const f32x2 cs = tabM[i * 16 + j]; const float x1 = bf2f(S[i * SST + 256 + j]), x2 = bf2f(S[i * SST + 272 + j]); y[t] = second ? x1 * cs[1] + x2 * cs[0] : x1 * cs[0] - x2 * cs[1]; } }
            v4u w; w.x = pk2(y[0], y[1]); w.y = pk2(y[2], y[3]); w.z = pk2(y[4], y[5]); w.w = pk2(y[6], y[7]);
            *(v4u*)((bf16*)(a.ws + B_MK) + (prow0 + i) * 96 + 8 * k8) = w; }
        __syncthreads();
        for (int idx = tid; idx < 64 * 48; idx += 512) { const int c8 = idx % 48, i = idx / 48;
            *(v4u*)((bf16*)(a.ws + B_MQ) + (prow0 + i) * 384 + 8 * c8) = *(const LAS v4u*)(Qs + i * QSS + 8 * c8); }
    }
}

template <int KIND>
__device__ __forceinline__ void attn_mfma_unit(const Args& a, int li, int b, int hh, int qb  , LAS unsigned char* lds, int tid, float lam, float oscale) {
    constexpr int KW = KIND ? 64 : 96, KST = KW + 8, VST = 72, NMAP = KIND ? 2 : 1, DSTEPS = KIND ? 2 : 6;
    constexpr int KCH = KW / 8 + 1, NPIECE = KCH + (KIND ? 9 : 0), PPW = KIND ? 3 : 2, SLOT = NPIECE * 1024, NSLOT = 4, OFF_JUNK = NSLOT * SLOT, OFF_WS = OFF_JUNK + 6144, OSTW = 68, OFF_OST = KIND ? 0   : OFF_WS + 2048;
    static_assert(PPW * 8 >= NPIECE && PPW * 8 - NPIECE <= 6 && (KIND ? 8 * 32 * OSTW * 4 <= NSLOT * SLOT : OFF_OST + 8 * 32 * OSTW * 4 <= RING_BYTES) && OFF_WS + 8 * 256 <= RING_BYTES, "attention LDS map / pieces per wave");
    const int lane = tid & 63, w = __builtin_amdgcn_readfirstlane(tid >> 6), r32 = lane & 31, hi = lane >> 5;
    const int q0 = qb < 0 ? 0 : 64 + 256 * qb, NT = qb < 0 ? 1 : 5 + 4 * qb;
    const bool wact = qb >= 0 || w < 2;
    const int qpos = q0 + 32 * w + r32, wlast = (q0 + 32 * w + 31) >> 6;
    const size_t prow = (size_t)b * PSEQ + qpos;
    const bf16* proj = (const bf16*)(a.ws + B_PROJ);
    const bf16* Kg = KIND ? proj + C_DK + hh * 64 : (const bf16*)(a.ws + B_MK) + (size_t)b * PSEQ * 96;
    constexpr int KLD = KIND ? N1 : 96;
    const bf16* Vg = proj + C_DV + hh * 64;
#define ATT_SRCROW(t_, r_) (KIND ? ((t_) == 0 ? ((r_) < 48 ? MR : MR + (r_) - 48) : b * TT + 64 * ((t_) - 1) + (r_)) : 64 * (t_) + (r_))
    LAS float* wsf = (LAS float*)(lds + OFF_WS) + w * 64;
    LAS float* ost = (LAS float*)(lds + OFF_OST) + w * (32 * OSTW);
    s16x8 qf[NMAP][DSTEPS];
#pragma unroll
    for (int m = 0; m < NMAP; ++m)
#pragma unroll
        for (int ds = 0; ds < DSTEPS; ++ds) {
            const int qsr = qb >= 0 ? b * TT + qpos - 64 : (qpos >= 48 ? MR + qpos - 48 : MR);
            const bf16* qp = KIND ? proj + (size_t)qsr * N1 + C_DQ + hh * 64 + 32 * m + 16 * ds + 8 * hi : (const bf16*)(a.ws + B_MQ) + prow * 384 + hh * 96 + 16 * ds + 8 * hi;
            v4u qw = wact ? *(const v4u*)qp : (v4u){0u, 0u, 0u, 0u};
            if (KIND) { const float qs = 0.17677669529663687f * LOG2E;
                qw.x = pg8::cvt_pk_bf16(bflo(qw.x) * qs, bfhi(qw.x) * qs); qw.y = pg8::cvt_pk_bf16(bflo(qw.y) * qs, bfhi(qw.y) * qs); qw.z = pg8::cvt_pk_bf16(bflo(qw.z) * qs, bfhi(qw.z) * qs); qw.w = pg8::cvt_pk_bf16(bflo(qw.w) * qs, bfhi(qw.w) * qs); }
            qf[m][ds] = __builtin_bit_cast(s16x8, qw); }
    float mref[NMAP], lrun[NMAP]; f32x16 negm = (f32x16){}, o[NMAP][2];
#pragma unroll
    for (int m = 0; m < NMAP; ++m) { mref[m] = 0.f; lrun[m] = 0.f; o[m][0] = (f32x16){}; o[m][1] = (f32x16){}; }
#define ATT_DMA(t_) do { const int sl_ = ((t_) & 3) * SLOT; _Pragma("unroll") for (int j = 0; j < PPW; ++j) { const int p_ = __builtin_amdgcn_readfirstlane(w * PPW + j); \
        int row_, col_, dst_; const bf16* base_; int ld_; \
        if (p_ < KCH) { const int g = 64 * p_ + lane, cc = g % KCH; row_ = g / KCH; col_ = (cc < KCH - 1 ? cc : KCH - 2) * 8; dst_ = sl_ + p_ * 1024; base_ = Kg; ld_ = KLD; } \
        else if (p_ < NPIECE) { const int g = 64 * (p_ - KCH) + lane, cc = g % 9; row_ = g / 9; col_ = (cc < 8 ? cc : 7) * 8; dst_ = sl_ + p_ * 1024; base_ = Vg; ld_ = N1; } \
        else { row_ = lane & 15; col_ = 0; dst_ = OFF_JUNK + (p_ - NPIECE) * 1024; base_ = Kg; ld_ = KLD; } \
        const bf16* s_ = base_ + (size_t)ATT_SRCROW((t_), row_) * ld_ + col_; \
        __builtin_amdgcn_global_load_lds((const unsigned*)s_, (LAS unsigned*)(lds + __builtin_amdgcn_readfirstlane(dst_)), 16, 0, 0); } } while (0)
#define ATT_BAR() do { asm volatile("s_waitcnt lgkmcnt(0)" ::: "memory"); __builtin_amdgcn_s_barrier(); asm volatile("" ::: "memory"); } while (0)
    ATT_BAR();
    if (w >= 4) __builtin_amdgcn_s_setprio(1);
    ATT_DMA(0); if (NT > 1) ATT_DMA(1); if (NT > 2) ATT_DMA(2);
    for (int t = 0; t < NT; ++t) {
        if (t + 2 < NT) { if (KIND) asm volatile("s_waitcnt vmcnt(6)" ::: "memory"); else asm volatile("s_waitcnt vmcnt(4)" ::: "memory"); } else if (t + 1 < NT) { if (KIND) asm volatile("s_waitcnt vmcnt(3)" ::: "memory"); else asm volatile("s_waitcnt vmcnt(2)" ::: "memory"); } else asm volatile("s_waitcnt vmcnt(0)" ::: "memory");
        ATT_BAR();
        if (t + 3 < NT) ATT_DMA(t + 3);
        if (wact && t <= wlast) {
            const LAS unsigned char* Kb = lds + (t & 3) * SLOT; const LAS unsigned char* Vb = KIND ? Kb + KCH * 1024 : Kb;
            const bool need_mask = (t == 0) || (64 * t + 63 > q0 + 32 * w);
            constexpr int VRB = KIND ? 144 : KST * 2;
            const LAS unsigned char* vp0 = Vb + (4 * hi + ((lane & 15) >> 2)) * VRB + (16 * ((lane >> 4) & 1)) * 2 + 8 * (lane & 3);
#define ATT_VFRAG(d0_, ks_) ({ const LAS unsigned char* vp_ = vp0 + 16 * (ks_) * VRB + 64 * (d0_); \
        const s16x4 va_ = __builtin_bit_cast(s16x4, __builtin_amdgcn_ds_read_tr16_b64_v4i16((LAS v4i16_t*)vp_)), vb_ = __builtin_bit_cast(s16x4, __builtin_amdgcn_ds_read_tr16_b64_v4i16((LAS v4i16_t*)(vp_ + 8 * VRB))); \
        (s16x8){va_[0], va_[1], va_[2], va_[3], vb_[0], vb_[1], vb_[2], vb_[3]}; })
            s16x8 vfr0[4];
#pragma unroll
            for (int ks = 0; ks < 4; ++ks) vfr0[ks] = ATT_VFRAG(0, ks);
            __builtin_amdgcn_sched_barrier(0);
#pragma unroll
            for (int m = 0; m < NMAP; ++m) {
                f32x16 p0, p1;
                if (KIND) { const float nm = -mref[m];
#pragma unroll
                    for (int r = 0; r < 16; ++r) { p0[r] = nm; p1[r] = nm; } }
                else { p0 = negm; p1 = negm; }
                constexpr int KBATCH = KIND ? DSTEPS : 3;
#pragma unroll
                for (int d1 = 0; d1 < DSTEPS; d1 += KBATCH) {
                    s16x8 kfr[KBATCH][2];
#pragma unroll
                    for (int ds = 0; ds < KBATCH; ++ds) { kfr[ds][0] = *(const LAS s16x8*)(Kb + (r32 * KST + 32 * m * KIND + 16 * (d1 + ds) + 8 * hi) * 2); kfr[ds][1] = *(const LAS s16x8*)(Kb + ((32 + r32) * KST + 32 * m * KIND + 16 * (d1 + ds) + 8 * hi) * 2); }
                    __builtin_amdgcn_sched_barrier(0);

#pragma unroll
                    for (int ds = 0; ds < KBATCH; ++ds) { p0 = __builtin_amdgcn_mfma_f32_32x32x16_bf16(kfr[ds][0], qf[m][d1 + ds], p0, 0, 0, 0); p1 = __builtin_amdgcn_mfma_f32_32x32x16_bf16(kfr[ds][1], qf[m][d1 + ds], p1, 0, 0, 0); }

                    __builtin_amdgcn_sched_barrier(0); }
                asm volatile("s_nop 15\n\ts_nop 7" : "+v"(p0), "+v"(p1));

                if (need_mask) {
#pragma unroll
                    for (int r = 0; r < 16; ++r) { const int kv = 64 * t + crow(r, hi);
                        if (kv > qpos || kv < 48) p0[r] = -1e30f;
                        if (kv + 32 > qpos || kv + 32 < 48) p1[r] = -1e30f; } }
                float mx = fmaxf(fmaxf(p0[0], p1[0]), fmaxf(p0[1], p1[1]));
#pragma unroll
                for (int r = 2; r < 16; r += 2) mx = fmaxf(mx, fmaxf(fmaxf(p0[r], p1[r]), fmaxf(p0[r + 1], p1[r + 1])));
                { auto rr = __builtin_amdgcn_permlane32_swap(__float_as_uint(mx), __float_as_uint(mx), false, false); mx = fmaxf(__uint_as_float(rr[0]), __uint_as_float(rr[1])); }
                if (t == 0 || __any(mx > 6.0f)) {
                    const float delta = t == 0 ? mx : fmaxf(mx, 0.f); mref[m] += delta;
#pragma unroll
                    for (int r = 0; r < 16; ++r) { p0[r] -= delta; p1[r] -= delta; if (!KIND) negm[r] = -mref[m]; }
                    if (t != 0) { const float alpha = __builtin_amdgcn_exp2f(-delta); lrun[m] *= alpha;
                        if (hi == 0) wsf[r32] = alpha;
                        f32x4 al[4];
#pragma unroll
                        for (int g = 0; g < 4; ++g) al[g] = *(const LAS f32x4*)(wsf + 8 * g + 4 * hi);
#pragma unroll
                        for (int r = 0; r < 16; ++r) { o[m][0][r] *= al[r >> 2][r & 3]; o[m][1][r] *= al[r >> 2][r & 3]; } } }
                float ls = 0.f;
#pragma unroll
                for (int r = 0; r < 16; ++r) { p0[r] = __builtin_amdgcn_exp2f(p0[r]); p1[r] = __builtin_amdgcn_exp2f(p1[r]); ls += p0[r] + p1[r]; }
                lrun[m] += ls;
                s16x8 pw[4];
#pragma unroll
                for (int ks = 0; ks < 4; ++ks) { v4u u;
                    if (ks < 2) { u.x = pg8::cvt_pk_bf16(p0[8 * ks], p0[8 * ks + 1]); u.y = pg8::cvt_pk_bf16(p0[8 * ks + 2], p0[8 * ks + 3]); u.z = pg8::cvt_pk_bf16(p0[8 * ks + 4], p0[8 * ks + 5]); u.w = pg8::cvt_pk_bf16(p0[8 * ks + 6], p0[8 * ks + 7]); }
                    else { const int k2 = ks - 2; u.x = pg8::cvt_pk_bf16(p1[8 * k2], p1[8 * k2 + 1]); u.y = pg8::cvt_pk_bf16(p1[8 * k2 + 2], p1[8 * k2 + 3]); u.z = pg8::cvt_pk_bf16(p1[8 * k2 + 4], p1[8 * k2 + 5]); u.w = pg8::cvt_pk_bf16(p1[8 * k2 + 6], p1[8 * k2 + 7]); }
                    pw[ks] = __builtin_bit_cast(s16x8, u); }

#pragma unroll
                for (int ks = 0; ks < 4; ++ks) o[m][0] = __builtin_amdgcn_mfma_f32_32x32x16_bf16(pw[ks], vfr0[ks], o[m][0], 0, 0, 0);

                { s16x8 vfr1[4];
#pragma unroll
                    for (int ks = 0; ks < 4; ++ks) vfr1[ks] = ATT_VFRAG(1, ks);
                    __builtin_amdgcn_sched_barrier(0);

#pragma unroll
                    for (int ks = 0; ks < 4; ++ks) o[m][1] = __builtin_amdgcn_mfma_f32_32x32x16_bf16(pw[ks], vfr1[ks], o[m][1], 0, 0, 0); }

            }
        }
    }
#undef ATT_DMA
#undef ATT_VFRAG
#undef ATT_SRCROW
    __builtin_amdgcn_s_setprio(0);
    ATT_BAR();
    if (KIND) { const LAS float* lp = (const LAS float*)(lds + RING_BYTES + 256); lam = lp[0]; oscale = lp[1]; }
    if (wact) {
#pragma unroll
        for (int m = 0; m < NMAP; ++m) asm volatile("s_nop 15\n\ts_nop 7" : "+v"(o[m][0]), "+v"(o[m][1]));
        float il0, il1 = 0.f;
        { float l = lrun[0]; l += __shfl_xor(l, 32); il0 = l > 0.f ? 1.f / l : 0.f; }
        if (KIND) { float l = lrun[NMAP - 1]; l += __shfl_xor(l, 32); il1 = l > 0.f ? lam / l : 0.f; }
        if (hi == 0) { wsf[r32] = il0; wsf[32 + r32] = il1; }
        f32x4 a0[4], a1[4];
#pragma unroll
        for (int g = 0; g < 4; ++g) { a0[g] = *(const LAS f32x4*)(wsf + 8 * g + 4 * hi); a1[g] = *(const LAS f32x4*)(wsf + 32 + 8 * g + 4 * hi); }
#pragma unroll
        for (int d0 = 0; d0 < 2; ++d0)
#pragma unroll
            for (int r = 0; r < 16; ++r) { float v = o[0][d0][r] * a0[r >> 2][r & 3]; if (KIND) v -= o[NMAP - 1][d0][r] * a1[r >> 2][r & 3];
                ost[crow(r, hi) * OSTW + 32 * d0 + r32] = v; }
        const int row = lane >> 1, half = lane & 1, p = q0 + 32 * w + row;
        f32x4 v[8]; float ss = 0.f;
#pragma unroll
        for (int i = 0; i < 8; ++i) { v[i] = *(const LAS f32x4*)(ost + row * OSTW + 32 * half + 4 * i); ss += (v[i][0] * v[i][0] + v[i][1] * v[i][1]) + (v[i][2] * v[i][2] + v[i][3] * v[i][3]); }
        ss += __shfl_xor(ss, 1);
        const float rs = KIND ? __builtin_amdgcn_rsqf(ss * (1.f / 64.f) + EPS) * oscale : 1.f;
        const int sr = qb >= 0 ? b * TT + p - 64 : ((p >= 48 && b == 0) ? MR + p - 48 : -1);
        if (sr >= 0) { bf16* dst = (bf16*)a.out + (size_t)sr * DM + (KIND ? 768 : 512) + hh * 64 + 32 * half; const float* gn = ain(a, I_DNORM) + li * 64 + 32 * half;
#pragma unroll
            for (int i = 0; i < 4; ++i) { f32x4 x0 = v[2 * i] * rs, x1 = v[2 * i + 1] * rs;
                if (KIND) { const f32x4 g0 = *(const f32x4*)(gn + 8 * i), g1 = *(const f32x4*)(gn + 8 * i + 4); x0 = x0 * g0; x1 = x1 * g1; }
                *(v4u*)(dst + 8 * i) = pack8(x0, x1); } }
    }
    ATT_BAR();
#undef ATT_BAR
}

__device__ __forceinline__ s16x8 ldperm(const bf16* p, int hi) { const s16x4 x = *(const s16x4*)(p + 4 * hi), y = *(const s16x4*)(p + 8 + 4 * hi); return (s16x8){x[0], x[1], x[2], x[3], y[0], y[1], y[2], y[3]}; }
__device__ __forceinline__ s16x8 packacc(const f32x16& v, int k) { v4u u; u.x = pg8::cvt_pk_bf16(v[8 * k], v[8 * k + 1]); u.y = pg8::cvt_pk_bf16(v[8 * k + 2], v[8 * k + 3]); u.z = pg8::cvt_pk_bf16(v[8 * k + 4], v[8 * k + 5]); u.w = pg8::cvt_pk_bf16(v[8 * k + 6], v[8 * k + 7]); return __builtin_bit_cast(s16x8, u); }
__device__ __forceinline__ s16x8 ldperm_lds(const LAS unsigned char* p, int hi) { const s16x4 x = *(const LAS s16x4*)(p + 8 * hi), y = *(const LAS s16x4*)(p + 16 + 8 * hi); return (s16x8){x[0], x[1], x[2], x[3], y[0], y[1], y[2], y[3]}; }
template <int KIND>
__device__ __forceinline__ void lin_mfma_unit(const Args& a, int li, int b, int hp, LAS unsigned char* lds, int tid) {
    constexpr int DK = KIND ? 64 : 32, NDS = DK / 16, NDB = DK / 32, OTW = 68;
    constexpr int QROW = KIND ? 144 : 80, QT = KIND ? RT_T : GQ_T, HB = 2 * QT + VT_T, PPH = HB / 1024, NP = 2 * PPH;
    constexpr int OFF_OT = 2 * HB, OFF_G = OFF_OT + 2 * 64 * OTW * 4;
    static_assert(HB % 1024 == 0 && OFF_G + 256 <= RING_BYTES, "lin unit LDS map");
    const int lane = tid & 63, w = __builtin_amdgcn_readfirstlane(tid >> 6), r32 = lane & 31, hi = lane >> 5, hl = w >> 2, e0 = 32 * ((w >> 1) & 1), ib = w & 1, h = 2 * hp + hl;
    const unsigned char* Qg = a.ws + (KIND ? B_RQ : B_GQ); const unsigned char* Kg = a.ws + (KIND ? B_RK : B_GK);
    const bf16* proj = (const bf16*)(a.ws + B_PROJ); bf16* ob = (bf16*)a.out;
    LAS float* Ot = (LAS float*)(lds + OFF_OT);
    LAS float* Gs = (LAS float*)(lds + OFF_G);
    const LAS unsigned char* Lh = lds + hl * HB;
    const float dret = __builtin_amdgcn_exp2f(64.f * lg2gamma(h));
    f32x16 S[NDB];
#pragma unroll
    for (int db = 0; db < NDB; ++db) S[db] = (f32x16){};
#define LIN_DMA(c_) do { _Pragma("unroll") for (int j_ = 0; j_ < (NP + 7) / 8; ++j_) { const int p_ = w + 8 * j_; if (p_ < NP) { const int hl_ = p_ / PPH, pp_ = p_ % PPH; const size_t blk_ = (size_t)(b * NCH + (c_)) * 4 + 2 * hp + hl_; \
        const unsigned char* src_; \
        if (pp_ < 2 * QT / 1024) src_ = (pp_ < QT / 1024 ? Qg + blk_ * QT + pp_ * 1024 : Kg + blk_ * QT + (pp_ - QT / 1024) * 1024) + lane * 16; \
        else { const int g_ = 64 * (pp_ - 2 * QT / 1024) + lane, s_ = g_ / 9, cc_ = g_ % 9; int sr_ = src_row(b, (c_), s_); sr_ = sr_ < 0 ? MR : sr_;     \
            src_ = (const unsigned char*)(proj + (size_t)sr_ * N1 + (KIND ? C_RV : C_AV) + (2 * hp + hl_) * 64 + (cc_ < 8 ? cc_ : 7) * 8); } \
        __builtin_amdgcn_global_load_lds((const unsigned*)src_, (LAS unsigned*)(lds + hl_ * HB + pp_ * 1024), 16, 0, 0); } } } while (0)
#define LIN_BAR() do { asm volatile("s_waitcnt lgkmcnt(0)" ::: "memory"); __builtin_amdgcn_s_barrier(); asm volatile("" ::: "memory"); } while (0)
    LIN_BAR();
    if (tid < 64) Gs[tid] = ain(a, KIND ? I_RNORM : I_GNORM)[li * 64 + tid];
    LIN_DMA(0);
    const int nh = tid >> 8, nrow = (tid >> 2) & 63, nq = tid & 3, hn = 2 * hp + nh;
    for (int c = 0; c < NCH; ++c) {
        asm volatile("s_waitcnt vmcnt(0)" ::: "memory"); LIN_BAR();
        s16x8 qf[NDS], kf0[NDS], kf1[NDS], vf[4], ktf[NDB][4];
        const int sr = src_row(b, c, nrow); const bool wr = sr >= 0 && (c > 0 || b == 0);
#pragma unroll
        for (int ds = 0; ds < NDS; ++ds) { qf[ds] = ldperm_lds(Lh + (32 * ib + r32) * QROW + 32 * ds, hi); kf0[ds] = ldperm_lds(Lh + QT + r32 * QROW + 32 * ds, hi); kf1[ds] = ldperm_lds(Lh + QT + (32 + r32) * QROW + 32 * ds, hi); }
        const int trq = (lane & 15) >> 2, trb = (lane >> 4) & 1, trp = lane & 3;
#pragma unroll
        for (int ks = 0; ks < 4; ++ks) { const LAS unsigned char* vp = Lh + 2 * QT + (16 * ks + 4 * hi + trq) * 144 + (e0 + 16 * trb) * 2 + 8 * trp;
            const s16x4 va = __builtin_bit_cast(s16x4, __builtin_amdgcn_ds_read_tr16_b64_v4i16((LAS v4i16_t*)vp)), vb = __builtin_bit_cast(s16x4, __builtin_amdgcn_ds_read_tr16_b64_v4i16((LAS v4i16_t*)(vp + 8 * 144)));
            vf[ks] = (s16x8){va[0], va[1], va[2], va[3], vb[0], vb[1], vb[2], vb[3]}; }
        f32x16 aA = (f32x16){}, aB = (f32x16){};
#pragma unroll
        for (int ds = 0; ds < NDS; ++ds) { aA = __builtin_amdgcn_mfma_f32_32x32x16_bf16(kf0[ds], qf[ds], aA, 0, 0, 0); if (ib) aB = __builtin_amdgcn_mfma_f32_32x32x16_bf16(kf1[ds], qf[ds], aB, 0, 0, 0); }
        asm volatile("s_nop 15\n\ts_nop 15" : "+v"(aA), "+v"(aB));
#pragma unroll
        for (int r = 0; r < 16; ++r) if (crow(r, hi) > r32) { if (ib) aB[r] = 0.f; else aA[r] = 0.f; }
        f32x16 O = (f32x16){};
#pragma unroll
        for (int db = 0; db < NDB; ++db)
#pragma unroll
            for (int ksub = 0; ksub < 2; ++ksub) O = __builtin_amdgcn_mfma_f32_32x32x16_bf16(qf[2 * db + ksub], packacc(S[db], ksub), O, 0, 0, 0);
#pragma unroll
        for (int ksub = 0; ksub < 2; ++ksub) { O = __builtin_amdgcn_mfma_f32_32x32x16_bf16(packacc(aA, ksub), vf[ksub], O, 0, 0, 0); if (ib) O = __builtin_amdgcn_mfma_f32_32x32x16_bf16(packacc(aB, ksub), vf[2 + ksub], O, 0, 0, 0); }
#pragma unroll
        for (int db = 0; db < NDB; ++db)
#pragma unroll
            for (int ks = 0; ks < 4; ++ks) { const LAS unsigned char* kp = Lh + QT + (16 * ks + 4 * hi + trq) * QROW + (32 * db + 16 * trb) * 2 + 8 * trp;
                const s16x4 ka = __builtin_bit_cast(s16x4, __builtin_amdgcn_ds_read_tr16_b64_v4i16((LAS v4i16_t*)kp)), kb = __builtin_bit_cast(s16x4, __builtin_amdgcn_ds_read_tr16_b64_v4i16((LAS v4i16_t*)(kp + 8 * QROW)));
                ktf[db][ks] = (s16x8){ka[0], ka[1], ka[2], ka[3], kb[0], kb[1], kb[2], kb[3]}; }
        LIN_BAR();
        v4u og[2];
#pragma unroll
        for (int i = 0; i < 2; ++i) og[i] = wr ? *(const v4u*)(proj + (size_t)sr * N1 + (KIND ? C_ROG : C_AOG) + hn * 64 + 16 * nq + 8 * i) : (v4u){0u, 0u, 0u, 0u};
        f32x4 dvv[4];
        if (!KIND) { const float* dp = (const float*)(a.ws + WS_GD) + ((size_t)(b * NCH + c) * 4 + h) * 32;
#pragma unroll
            for (int g = 0; g < 4; ++g) dvv[g] = *(const f32x4*)(dp + 8 * g + 4 * hi); }
        if (c + 1 < NCH) LIN_DMA(c + 1);
#pragma unroll
        for (int db = 0; db < NDB; ++db) {
#pragma unroll
            for (int ks = 0; ks < 4; ++ks) S[db] = __builtin_amdgcn_mfma_f32_32x32x16_bf16(ktf[db][ks], vf[ks], S[db], 0, 0, 0); }
        asm volatile("s_nop 15\n\ts_nop 15" : "+v"(O));
#pragma unroll
        for (int db = 0; db < NDB; ++db) asm volatile("s_nop 15\n\ts_nop 15" : "+v"(S[db]));
#pragma unroll
        for (int db = 0; db < NDB; ++db) {
            if (KIND) { S[db] = S[db] * dret; }
            else {
#pragma unroll
                for (int g = 0; g < 4; ++g) { S[db][4 * g] *= dvv[g][0]; S[db][4 * g + 1] *= dvv[g][1]; S[db][4 * g + 2] *= dvv[g][2]; S[db][4 * g + 3] *= dvv[g][3]; } } }
#pragma unroll
        for (int r = 0; r < 16; ++r) Ot[(hl * 64 + 32 * ib + crow(r, hi)) * OTW + e0 + r32] = O[r];
        LIN_BAR();
        { f32x4 v[4]; float s1 = 0.f;
#pragma unroll
            for (int i = 0; i < 4; ++i) { v[i] = *(const LAS f32x4*)(Ot + (nh * 64 + nrow) * OTW + 16 * nq + 4 * i); s1 += (v[i][0] + v[i][1]) + (v[i][2] + v[i][3]); }
            float mean = 0.f; if (KIND) { s1 += __shfl_xor(s1, 1); s1 += __shfl_xor(s1, 2); mean = s1 * (1.f / 64.f); }
            float s2 = 0.f;
#pragma unroll
            for (int i = 0; i < 4; ++i) { v[i] = v[i] - mean; s2 += (v[i][0] * v[i][0] + v[i][1] * v[i][1]) + (v[i][2] * v[i][2] + v[i][3] * v[i][3]); }
            s2 += __shfl_xor(s2, 1); s2 += __shfl_xor(s2, 2);
            const float rs = __builtin_amdgcn_rsqf(s2 * (1.f / 64.f) + EPS);
            if (wr) { bf16* dst = ob + (size_t)sr * DM + KIND * 256 + hn * 64 + 16 * nq; const LAS float* gp = Gs + 16 * nq;
#pragma unroll
                for (int i = 0; i < 2; ++i) { const v4u g4 = og[i]; const f32x4 g0 = *(const LAS f32x4*)(gp + 8 * i), g1 = *(const LAS f32x4*)(gp + 8 * i + 4);
                    f32x4 x0 = v[2 * i] * rs * g0, x1 = v[2 * i + 1] * rs * g1;
                    x0[0] *= silu_f(bflo(g4.x)); x0[1] *= silu_f(bfhi(g4.x)); x0[2] *= silu_f(bflo(g4.y)); x0[3] *= silu_f(bfhi(g4.y)); x1[0] *= silu_f(bflo(g4.z)); x1[1] *= silu_f(bfhi(g4.z)); x1[2] *= silu_f(bflo(g4.w)); x1[3] *= silu_f(bfhi(g4.w));
                    *(v4u*)(dst + 8 * i) = pack8(x0, x1); } } }
        LIN_BAR();
    }
    asm volatile("s_waitcnt vmcnt(0)" ::: "memory");
#undef LIN_DMA
#undef LIN_BAR
}

template <int MODE, int KSTEPS  >
__device__ __forceinline__ void thin_unit(const bf16* A, int lda, const bf16* Bt, int u, bf16* H, float* stats_out, const float* stats_in, bf16* ACT, LAS unsigned char* lds, int tid) {
    constexpr int K = KSTEPS * 256;
    const int lane = tid & 63, w = __builtin_amdgcn_readfirstlane(tid >> 6), fr = lane & 15, fq = lane >> 4;
    int brow[4];
#pragma unroll
    for (int nb = 0; nb < 4; ++nb) brow[nb] = MODE != 1 ? 64 * u + 16 * nb + fr : 256 * (u >> 2) + 32 * (u & 3) + (nb >> 1) * 128 + 16 * (nb & 1) + fr;
    f32x4 acc[4];
#pragma unroll
    for (int nb = 0; nb < 4; ++nb) acc[nb] = (f32x4){0.f, 0.f, 0.f, 0.f};
    const bf16* ap = A + (size_t)fr * lda + w * (KSTEPS * 32) + 8 * fq;
    constexpr int B1 = KSTEPS > 6 ? 6 : KSTEPS;
    { s16x8 af[B1], bf[B1][4];
#pragma unroll
        for (int s = 0; s < B1; ++s) { af[s] = *(const s16x8*)(ap + 32 * s);
#pragma unroll
            for (int nb = 0; nb < 4; ++nb) bf[s][nb] = *(const s16x8*)(Bt + (size_t)brow[nb] * K + w * (KSTEPS * 32) + 32 * s + 8 * fq); }
#pragma unroll
        for (int s = 0; s < B1; ++s)
#pragma unroll
            for (int nb = 0; nb < 4; ++nb) acc[nb] = __builtin_amdgcn_mfma_f32_16x16x32_bf16(bf[s][nb], af[s], acc[nb], 0, 0, 0); }
    if (KSTEPS > B1) { constexpr int B2 = KSTEPS > B1 ? KSTEPS - B1 : 1; s16x8 af[B2], bf[B2][4];
#pragma unroll
        for (int s = 0; s < B2; ++s) { af[s] = *(const s16x8*)(ap + 32 * (B1 + s));
#pragma unroll
            for (int nb = 0; nb < 4; ++nb) bf[s][nb] = *(const s16x8*)(Bt + (size_t)brow[nb] * K + w * (KSTEPS * 32) + 32 * (B1 + s) + 8 * fq); }
#pragma unroll
        for (int s = 0; s < B2; ++s)
#pragma unroll
            for (int nb = 0; nb < 4; ++nb) acc[nb] = __builtin_amdgcn_mfma_f32_16x16x32_bf16(bf[s][nb], af[s], acc[nb], 0, 0, 0); }
    asm volatile("s_nop 15" : "+v"(acc[0]), "+v"(acc[1]), "+v"(acc[2]), "+v"(acc[3]));
    LAS f32x4* part = (LAS f32x4*)lds;
    __syncthreads();
#pragma unroll
    for (int nb = 0; nb < 4; ++nb) part[(w * 4 + nb) * 64 + lane] = acc[nb];
    __syncthreads();
    if (w == 0) {
#pragma unroll
        for (int nb = 0; nb < 4; ++nb) {
#pragma unroll
            for (int w2 = 1; w2 < 8; ++w2) acc[nb] = acc[nb] + part[(w2 * 4 + nb) * 64 + lane]; }
        const int row = MR + fr;
        if (MODE == 0) { float ss = 0.f;
#pragma unroll
            for (int nb = 0; nb < 4; ++nb) { bf16* p = H + (size_t)row * DM + 64 * u + 16 * nb + 4 * fq; const v2u wv = *(const v2u*)p;
                const float x0 = acc[nb][0] + bflo(wv.x), x1 = acc[nb][1] + bfhi(wv.x), x2 = acc[nb][2] + bflo(wv.y), x3 = acc[nb][3] + bfhi(wv.y);
                ss += (x0 * x0 + x1 * x1) + (x2 * x2 + x3 * x3);
                v2u o; o.x = pg8::cvt_pk_bf16(x0, x1); o.y = pg8::cvt_pk_bf16(x2, x3); *(v2u*)p = o; }
            ss += __shfl_xor(ss, 16); ss += __shfl_xor(ss, 32);
            if (fq == 0) stats_out[(size_t)row * 16 + u] = ss;
        } else if (MODE == 2) { const f32x4* sp = (const f32x4*)(stats_in + (size_t)row * 16); const f32x4 s0 = sp[0], s1 = sp[1], s2 = sp[2], s3 = sp[3];
            const float st = ((s0[0] + s0[1]) + (s0[2] + s0[3])) + ((s1[0] + s1[1]) + (s1[2] + s1[3])) + ((s2[0] + s2[1]) + (s2[2] + s2[3])) + ((s3[0] + s3[1]) + (s3[2] + s3[3]));
            const float rs = __builtin_amdgcn_rsqf(st * (1.f / 1024.f) + EPS);
#pragma unroll
            for (int nb = 0; nb < 4; ++nb) { v2u o; o.x = pg8::cvt_pk_bf16(acc[nb][0] * rs, acc[nb][1] * rs); o.y = pg8::cvt_pk_bf16(acc[nb][2] * rs, acc[nb][3] * rs);
                *(v2u*)(ACT + (size_t)row * N1 + 64 * u + 16 * nb + 4 * fq) = o; }
        } else { const f32x4* sp = (const f32x4*)(stats_in + (size_t)row * 16); const f32x4 s0 = sp[0], s1 = sp[1], s2 = sp[2], s3 = sp[3];
            const float st = ((s0[0] + s0[1]) + (s0[2] + s0[3])) + ((s1[0] + s1[1]) + (s1[2] + s1[3])) + ((s2[0] + s2[1]) + (s2[2] + s2[3])) + ((s3[0] + s3[1]) + (s3[2] + s3[3]));
            const float rs = __builtin_amdgcn_rsqf(st * (1.f / 1024.f) + EPS);
#pragma unroll
            for (int nb = 0; nb < 2; ++nb) { float y[4];
#pragma unroll
                for (int t = 0; t < 4; ++t) y[t] = silu_f(acc[nb][t] * rs) * (acc[2 + nb][t] * rs);
                v2u o; o.x = pg8::cvt_pk_bf16(y[0], y[1]); o.y = pg8::cvt_pk_bf16(y[2], y[3]);
                *(v2u*)(ACT + (size_t)row * DFF + 128 * (u >> 2) + 32 * (u & 3) + 16 * nb + 4 * fq) = o; } }
    }
    __syncthreads();
}

#ifndef REP_PREP
#define REP_PREP 1
#endif
#ifndef REP_MIX
#define REP_MIX 1
#endif
#ifndef REP_P0
#define REP_P0 1
#endif
#ifndef REP_CONV
#define REP_CONV 1
#endif
#ifndef REP_G1
#define REP_G1 1
#endif
#ifndef REP_MGU
#define REP_MGU 1
#endif
#ifndef REP_MDN
#define REP_MDN 1
#endif
#ifndef REP_BAR
#define REP_BAR 0
#endif
#ifndef REP_PART
#define REP_PART -1
#endif
#ifndef REP_FGU
#define REP_FGU 1
#endif
#ifndef MK_ONE_LAUNCH
#define MK_ONE_LAUNCH 1
#endif
constexpr int NPHASE = 18;
constexpr int CW_Q = 12288;
__global__ void __launch_bounds__(512, 2) mega_fwd(Args a) {
    extern __shared__ __attribute__((aligned(16))) unsigned char lds_raw[];
    LAS unsigned char* lds = (LAS unsigned char*)lds_raw;
    volatile LAS unsigned* MISC = (volatile LAS unsigned*)(lds + MISC_OFF);
    int wave = __builtin_amdgcn_readfirstlane((int)threadIdx.x >> 6); asm volatile("" : "+s"(wave));
    const int G = gridDim.x;
#define TID() ((wave << 6) + lane_id())
    for (int u = TID(); u < (LDS_BYTES - RING_BYTES) / 4; u += 512) ((LAS unsigned*)(lds + RING_BYTES))[u] = 0u;
    __syncthreads();
    gu32* ctl = (gu32*)(a.ws + WS_CTL);
    const int lo = a.ph_lo, hi = a.ph_hi;
    XcdBarrier bar; bar.bar = (unsigned*)(ctl + CW_BAR); bar.x = 0; bar.st = nullptr;
    if (hi - lo > 1) bar = xcd_barrier_post((unsigned*)(ctl + CW_BAR), MISC + 8, TID() == 0);
#define IN(k) (lo <= (k) && (k) < hi)
#define OPQ() int ptid = TID(); asm volatile("" : "+v"(ptid)); const int plane = ptid & 63; (void)plane
#define SEAM(k) do { if (IN(k) && IN((k) + 1)) xcd_barrier(bar, TID() == 0); } while (0)
#define hb ((bf16*)(a.ws + WS_HB))
#define stA ((float*)(a.ws + WS_STA))
#define stB ((float*)(a.ws + WS_STB))

    for (int rep = 0; rep < REP_BAR; ++rep) xcd_barrier(bar, TID() == 0);
    if (IN(0)) { OPQ(); for (int rep = 0; rep < REP_P0; ++rep) { p0_prologue(a, lds, ptid, plane, wave); __syncthreads(); } }
    SEAM(0);

    for (int li = 0; li < 2; ++li) {
        const int pb = 1 + 6 * li;
        if (IN(pb)) {
            { OPQ(); for (int u = blockIdx.x; u < N1 / 64; u += G) thin_unit<2, 4>(hb + (size_t)MR * DM, DM, (const bf16*)(a.ws + WS_W1T + li * W1T_BYTES), u, nullptr, nullptr, stA, (bf16*)(a.ws + B_PROJ), lds, ptid); }
            pg8::Gemm g{hb, (const bf16*)(a.ws + WS_W1T + li * W1T_BYTES), DM, 0, nullptr}; pg8::StaticOrder S; S.init(NPAN - 1, N1 / 256, G, (int)blockIdx.x);
            EpiProj E{(bf16*)(a.ws + B_PROJ), stA};
            for (int rep = 0; rep < REP_G1; ++rep) pg8::gemm_phase<EpiProj, pg8::StaticOrder, false>(lds, g, S, E, wave);
        }
        SEAM(pb);
        if (IN(pb + 1)) { OPQ(); for (int rep = 0; rep < REP_PREP; ++rep) for (int u = blockIdx.x; u < NB * NCH * 3; u += G) { const int part = u % 3;     if (rep > 0 && REP_PART >= 0 && part != REP_PART) continue; int ut = ptid; asm volatile("" : "+v"(ut)); prep2_unit(a, li, (u / 3) / NCH, (u / 3) % NCH, part, lds, ut); } __syncthreads(); }
        SEAM(pb + 1);
        if (IN(pb + 2)) {
            OPQ(); const int tid = ptid;
            LAS int* qid = (LAS int*)(lds + RING_BYTES + 64);
            float lam, lam_init; { const float* lv = ain(a, I_DLAM) + li * 128; float s01 = 0.f, s23 = 0.f;
                for (int d = 0; d < 32; ++d) { s01 += lv[d] * lv[32 + d]; s23 += lv[64 + d] * lv[96 + d]; }
                lam_init = 0.8f - 0.6f * __expf(-0.3f * (float)li); lam = __expf(s01) - __expf(s23) + lam_init;
                if (tid == 0) { LAS float* lp = (LAS float*)(lds + RING_BYTES + 256); lp[0] = lam; lp[1] = 1.f - lam_init; } }
            for (int rep = 0; rep < REP_MIX; ++rep)
            for (;;) {
                __syncthreads();
                if (tid == 0) *qid = (int)__hip_atomic_fetch_add(ctl + CW_Q + 64 * (li + 2 * rep), 1u, RLX_AGENT);
                __syncthreads();
                const int id = *qid;
                int utid = ptid; asm volatile("" : "+v"(utid));
                if (id >= 64 + 1024 + 8) break;
                if (id < 64) { if ((id & 1) == 0) lin_mfma_unit<0>(a, li, (id >> 1) & 15, id >> 5, lds, utid); else lin_mfma_unit<1>(a, li, (id >> 1) & 15, id >> 5, lds, utid); }
                else { const int v = id - 64; int qb, kind, b, hh;
                    if (v < 1024) { qb = 7 - (v >> 7); const int rem = v & 127; kind = rem >> 6; b = (rem >> 2) & 15; hh = rem & 3; } else { qb = -1; kind = (v - 1024) >> 2; b = 0; hh = v & 3; }
                    if (kind == 0) attn_mfma_unit<0>(a, li, b, hh, qb, lds, utid, 0.f, 1.f); else attn_mfma_unit<1>(a, li, b, hh, qb, lds, utid, 0.f, 0.f); }
            }
        }
        SEAM(pb + 2);
        if (IN(pb + 3)) {
            if (li == 0) { OPQ(); for (int u = blockIdx.x; u < 16; u += G) thin_unit<0, 4>((const bf16*)a.out + (size_t)MR * DM, DM, (const bf16*)(a.ws + WS_WOT), u, hb, stB, nullptr, nullptr, lds, ptid); }
            pg8::Gemm g{(const bf16*)a.out, (const bf16*)(a.ws + WS_WOT + li * WOT_BYTES), DM, 0, nullptr}; pg8::StaticOrder S; S.init(NPAN - 1, 4, G, (int)blockIdx.x);
            EpiResid E{hb, stB};
            pg8::gemm_phase<EpiResid, pg8::StaticOrder, false>(lds, g, S, E, wave);
        }
        SEAM(pb + 3);
        if (li == 0) {
            if (IN(5)) {
                { OPQ(); for (int u = blockIdx.x; u < 88; u += G) thin_unit<1, 4>(hb + (size_t)MR * DM, DM, (const bf16*)(a.ws + WS_WGU), u, nullptr, nullptr, stB, (bf16*)(a.ws + B_ACT), lds, ptid); }
                pg8::Gemm g{hb, (const bf16*)(a.ws + WS_WGU), DM, 0, nullptr}; pg8::StaticOrder S; S.init(NPAN - 1, 2 * DFF / 256, G, (int)blockIdx.x);
                EpiSwiglu E{(bf16*)(a.ws + B_ACT), DFF, stB};
                for (int rep = 0; rep < REP_FGU; ++rep) pg8::gemm_phase<EpiSwiglu, pg8::StaticOrder, false>(lds, g, S, E, wave);
            }
            SEAM(5);
            if (IN(6)) {
                { OPQ(); for (int u = blockIdx.x; u < 16; u += G) thin_unit<0, 11>((const bf16*)(a.ws + B_ACT) + (size_t)MR * DFF, DFF, (const bf16*)(a.ws + WS_WD), u, hb, stA, nullptr, nullptr, lds, ptid); }
                pg8::Gemm g{(const bf16*)(a.ws + B_ACT), (const bf16*)(a.ws + WS_WD), DFF, 0, nullptr}; pg8::StaticOrder S; S.init(NPAN - 1, 4, G, (int)blockIdx.x);
                EpiResid E{hb, stA};
                pg8::gemm_phase<EpiResid, pg8::StaticOrder, false>(lds, g, S, E, wave);
            }
            SEAM(6);
        }
    }
    if (IN(11)) { OPQ(); const int tid = ptid, lane = plane;
        LAS float* scr = (LAS float*)(lds + wave * 16384);
        const int gw = blockIdx.x * 8 + wave, NGW = G * 8;
        constexpr int IG = 8 * 56, ID = 28 * 16;
        for (int rep = 0; rep < REP_CONV; ++rep)
        for (int it = gw; it < 8 * (2 * IG + ID); it += NGW) { const int e = it / (2 * IG + ID); int r = it % (2 * IG + ID);
            if (r < IG) { transpose_item_f8(ain(a, I_EG) + (size_t)e * DM * DFE, DM, DFE, ain(a, I_FNORM) + DM, a.ws + B_EGU + e * EGU_BYTES, r / 56, r % 56, 1, scr, lane); continue; } r -= IG;
            if (r < IG) { transpose_item_f8(ain(a, I_EU) + (size_t)e * DM * DFE, DM, DFE, ain(a, I_FNORM) + DM, a.ws + B_EGU + e * EGU_BYTES, r / 56, r % 56, 2, scr, lane); continue; } r -= IG;
            transpose_item_f8(ain(a, I_ED) + (size_t)e * DFE * DM, DFE, DM, nullptr, a.ws + B_ED + e * ED_BYTES, r / 16, r % 16, 0, scr, lane); }
        for (int i = blockIdx.x * 512 + tid; i < MAXPAN * 256; i += G * 512) { ((int*)(a.ws + MO_ROWIDX))[i] = -1; ((int*)(a.ws + MO_PDST))[i] = -1; ((f32x2*)(a.ws + MO_PINFO))[i] = (f32x2){0.f, 0.f}; }
        for (int blk = blockIdx.x; blk < MR / 128; blk += G) route_block(a, blk, lds, tid, lane, wave);
    }
    SEAM(11);
    LAS int* offs = (LAS int*)(lds + RING_BYTES + 128);
    if (IN(12)) { OPQ(); const int tid = ptid;
        moe_offsets(a, offs, tid);
        for (int idx = blockIdx.x * 512 + tid; idx < 2 * MR; idx += G * 512) { const int tok = idx >> 1, e = ((const int*)(a.ws + MO_TOKE))[idx], gpos = offs[e] + ((const int*)(a.ws + MO_TOKP))[idx];
            const f32x4* sp = (const f32x4*)(stB + (size_t)tok * 16); const f32x4 s0 = sp[0], s1 = sp[1], s2 = sp[2], s3 = sp[3];
            const float ss = ((s0[0] + s0[1]) + (s0[2] + s0[3])) + ((s1[0] + s1[1]) + (s1[2] + s1[3])) + ((s2[0] + s2[1]) + (s2[2] + s2[3])) + ((s3[0] + s3[1]) + (s3[2] + s3[3]));
            ((int*)(a.ws + MO_ROWIDX))[gpos] = tok; ((int*)(a.ws + MO_PDST))[gpos] = idx;
            ((f32x2*)(a.ws + MO_PINFO))[gpos] = (f32x2){__builtin_amdgcn_rsqf(ss * (1.f / 1024.f) + EPS), __int_as_float(((const int*)(a.ws + MO_TOKW))[idx])}; }
        if (blockIdx.x == 0 && tid < MAXPAN + 8) { int e = 0;
            for (int k = 1; k < 8; ++k) if (tid * 256 >= offs[k]) e = k;
            ((int*)(a.ws + MO_PEXP))[tid] = e; }
    }
    SEAM(12);
    int nT = 0; if (IN(13) || IN(14) || IN(15) || IN(16)) { moe_offsets(a, offs, TID()); nT = __builtin_amdgcn_readfirstlane(offs[8]); }
    const int nA = nT < 128 ? nT : 128, nB = nT < 128 ? 0 : (nT - 128 < 128 ? nT - 128 : 128), nC = nT <= 256 ? 0 : (nT - 256 < 8 ? nT - 256 : 8);
#pragma unroll 1
    for (int job = 0; job < 5; ++job) {
        const int ph = job == 0 ? 13 : job == 1 ? 14 : job <= 3 ? 15 : 16;
        if (IN(ph)) {
            if (job == 0 || job == 3) {
                const int nP = job == 0 ? nA + nC : nB;
                if (nP > 0) { pg8::Gemm g{(const bf16*)(a.ws + B_HB8), (const bf16*)(a.ws + B_EGU), DM / 2, EGU_BYTES, (const int*)(a.ws + MO_ROWIDX)};     pg8::MoeOrder S; S.init(nP, 2 * DFE / 256, G, (int)blockIdx.x, job == 0 ? 0 : 128, (const int*)(a.ws + MO_PEXP));
                    if (job == 0) { S.psplit = nA; S.p1 = 256; } else if (nC > 0 && (nB * (2 * DFE / 256)) % G == 0 && 16 * nC <= G) S.H = 4 * nC;
                    EpiSwigluMoe E{a.ws + B_EACT, (const f32x2*)(a.ws + MO_PINFO), 1.f / W8_SCALE};
                    for (int rep = 0; rep < REP_MGU; ++rep) pg8::gemm_phase<EpiSwigluMoe, pg8::MoeOrder, true, true>(lds, g, S, E, wave); }
            } else {
                const int nP = job == 1 ? nA : job == 2 ? nC : nB, p0 = job == 1 ? 0 : job == 2 ? 256 : 128;
                if (nP > 0) { pg8::Gemm g{(const bf16*)(a.ws + B_EACT + (job == 2 ? (size_t)128 * 256 * DFE : (size_t)0)), (const bf16*)(a.ws + B_ED), DFE / 2, ED_BYTES, nullptr};     pg8::MoeOrder S; S.init(nP, 4, G, (int)blockIdx.x, p0, (const int*)(a.ws + MO_PEXP));
                    EpiMoeDown E{(unsigned char*)a.out, (const int*)(a.ws + MO_PDST), (const f32x2*)(a.ws + MO_PINFO), 1.f / (W8_SCALE * ACT8_SCALE)};
                    for (int rep = 0; rep < REP_MDN; ++rep) pg8::gemm_phase<EpiMoeDown, pg8::MoeOrder, false, true>(lds, g, S, E, wave); }
            }
        }
        if (job != 2) SEAM(ph);
    }
    if (IN(17)) { OPQ(); const int lane = plane;
        const float* fn = ain(a, I_FINAL);
        for (int r = blockIdx.x * 8 + wave; r < MR; r += G * 8) {
            unsigned char* orow = (unsigned char*)a.out + (size_t)r * 4096; float v[16]; float ss = 0.f;
#pragma unroll
            for (int hf = 0; hf < 2; ++hf) { const int k = 512 * hf + 8 * lane; const v4u h4 = *(const v4u*)(hb + (size_t)r * DM + k), y0 = *(const v4u*)(orow + 2 * k), y1 = *(const v4u*)(orow + 2048 + 2 * k);
                const unsigned hw[4] = {h4.x, h4.y, h4.z, h4.w}, aw[4] = {y0.x, y0.y, y0.z, y0.w}, bw[4] = {y1.x, y1.y, y1.z, y1.w};
#pragma unroll
                for (int t = 0; t < 4; ++t) { const float x0 = bflo(hw[t]) + bflo(aw[t]) + bflo(bw[t]), x1 = bfhi(hw[t]) + bfhi(aw[t]) + bfhi(bw[t]); v[8 * hf + 2 * t] = x0; v[8 * hf + 2 * t + 1] = x1; ss += x0 * x0 + x1 * x1; } }
            ss = wave_sum(ss); const float rs = __builtin_amdgcn_rsqf(ss * (1.f / 1024.f) + EPS);
#pragma unroll
            for (int hf = 0; hf < 2; ++hf) { const int k = 512 * hf + 8 * lane; const f32x4 g0 = *(const f32x4*)(fn + k), g1 = *(const f32x4*)(fn + k + 4);
                *(f32x4*)(orow + 4 * k) = (f32x4){v[8 * hf] * rs * g0[0], v[8 * hf + 1] * rs * g0[1], v[8 * hf + 2] * rs * g0[2], v[8 * hf + 3] * rs * g0[3]};
                *(f32x4*)(orow + 4 * k + 16) = (f32x4){v[8 * hf + 4] * rs * g1[0], v[8 * hf + 5] * rs * g1[1], v[8 * hf + 6] * rs * g1[2], v[8 * hf + 7] * rs * g1[3]}; }
        }
    }
#undef IN
#undef SEAM
#undef hb
#undef stA
#undef stB
}

extern "C" void kernel_launch(void* const* d_in, const int* in_sizes, int n_in, void* d_out, int out_size, void* d_ws, size_t ws_size, hipStream_t stream) {
    static int grid = 0;
    if (grid == 0) {
        if (n_in != 24 || in_sizes[0] != MR * DM || out_size != MR * DM || ws_size < WS_NEED) { fprintf(stderr, "kernel_launch: unexpected problem (n_in %d, in0 %d, out %d, ws %zu < %zu)\n", n_in, n_in > 0 ? in_sizes[0] : -1, out_size, ws_size, (size_t)WS_NEED); grid = -1; return; }
        int dev = 0, cus = 0, per_cu = 0;
        if (hipGetDevice(&dev) != hipSuccess || hipDeviceGetAttribute(&cus, hipDeviceAttributeMultiprocessorCount, dev) != hipSuccess) { grid = -1; return; }
        if (hipFuncSetAttribute((const void*)mega_fwd, hipFuncAttributeMaxDynamicSharedMemorySize, LDS_BYTES) != hipSuccess) { fprintf(stderr, "kernel_launch: hipFuncSetAttribute failed\n"); grid = -1; return; }
        if (hipOccupancyMaxActiveBlocksPerMultiprocessor(&per_cu, (const void*)mega_fwd, 512, LDS_BYTES) != hipSuccess || per_cu < 1) fprintf(stderr, "kernel_launch: occupancy query reports %d\n", per_cu);
        (void)hipGetLastError();
        grid = cus;
    }
    if (grid < 0) return;
    if (hipMemsetAsync((char*)d_ws + WS_CTL, 0, CTL_BYTES, stream) != hipSuccess) return;
    Args a{};
    for (int i = 0; i < 24; ++i) a.in[i] = (const float*)d_in[i];
    a.out = (float*)d_out; a.ws = (unsigned char*)d_ws;
#if MK_ONE_LAUNCH
    a.ph_lo = 0; a.ph_hi = NPHASE;
    hipLaunchKernelGGL(mega_fwd, dim3(grid), dim3(512), LDS_BYTES, stream, a);
#else
    for (int p = 0; p < NPHASE; ++p) { a.ph_lo = p; a.ph_hi = p + 1; hipLaunchKernelGGL(mega_fwd, dim3(grid), dim3(512), LDS_BYTES, stream, a); }
#endif
}
```

```cpp
#include <hip/hip_runtime.h>
#include <cstdio>
#include <cstdint>

namespace pg8 {
#define PG8_LAS __attribute__((address_space(3)))
typedef unsigned short bf16_t;
typedef short bf16x8 __attribute__((ext_vector_type(8)));
typedef float f32x4 __attribute__((ext_vector_type(4)));
typedef unsigned u32x4 __attribute__((ext_vector_type(4)));
typedef int i32x4 __attribute__((ext_vector_type(4)));
typedef int i32x8 __attribute__((ext_vector_type(8)));
constexpr int BM = 256, BK = 64, HALF = 128, HTB = HALF * BK * 2  , STAGE_BYTES = 8 * HTB, NXCD = 8, WGM = 8;

__host__ __device__ __forceinline__ int lds_byte(int r, int c) { const int st = (r >> 4) * 2 + (c >> 5), rr = r & 15, cc = c & 31, ob = rr * 64 + cc * 2; return st * 1024 + (ob ^ (((ob >> 9) & 1) << 5)); }
__host__ __device__ __forceinline__ void stage_rc(int b, int& R, int& C) { const int st = b / 1024, sb = b % 1024, swz = sb ^ (((sb >> 9) & 1) << 5); R = (st >> 1) * 16 + swz / 64; C = (st & 1) * 32 + (swz % 64) / 2; }
__host__ __device__ __forceinline__ int perm32(int rho) { const int n = rho >> 4, i = rho & 15; return 8 * (i >> 2) + 4 * n + (i & 3); }

struct Unit { int pm, pn, e, gp; };
struct Gemm { const bf16_t* A; const bf16_t* Bt; int K; size_t estride  ; const int* rowidx  ; };

struct StaticOrder {
    int nM, nN, nwg, G, c;
    __device__ void init(int nM_, int nN_, int G_, int c_) { nM = nM_; nN = nN_; nwg = nM * nN; G = G_; c = c_; }
    __device__ __forceinline__ bool map(int i, int& pm, int& pn) const { return mapL((long)i * G + c, pm, pn); }
    __device__ __forceinline__ bool mapL(long L, int& pm, int& pn) const {
        if (L >= nwg) return false;
        int wgid = (int)L; { const int q = nwg / NXCD, r = nwg % NXCD, xcd = wgid % NXCD, off = wgid / NXCD; wgid = (xcd < r ? xcd * (q + 1) : r * (q + 1) + (xcd - r) * q) + off; }
        const int nig = WGM * nN, gid = wgid / nig, fm = gid * WGM, gsz = (nM - fm) < WGM ? (nM - fm) : WGM;
        pm = fm + ((wgid % nig) % gsz); pn = (wgid % nig) / gsz; return true;
    }
    __device__ __forceinline__ bool next(int i, Unit& u) const { int pm, pn; if (!map(i, pm, pn)) return false; u.pm = pm; u.pn = pn; u.e = 0; u.gp = pm; return true; }
};
struct MoeOrder {
    StaticOrder so; int p0; const int* pexp;
    int psplit, p1;
    int H;
    __device__ void init(int nP, int nN, int G, int c, int p0_, const int* pexp_) { so.init(nP, nN, G, c); p0 = p0_; pexp = pexp_; psplit = 1 << 30; p1 = 0; H = 0; }
    __device__ __forceinline__ bool next(int i, Unit& u) const { int pm, pn; long L = (long)i * so.G + so.c;
        if (H > 0) { const int full = so.nwg / so.G, nh = full - 3;
            if (so.c < H) { if (i >= nh) return false; }
            else if (i >= full) { const int j = so.c - H; if (i > full || j >= 3 * H) return false; L = (long)(nh + j / H) * so.G + (j % H); } }
        if (!so.mapL(L, pm, pn)) return false;
        u.pm = pm; u.pn = pn; u.gp = pm < psplit ? p0 + pm : p1 + (pm - psplit); u.e = __builtin_amdgcn_readfirstlane(pexp[u.gp]); return true; }
};

__device__ __forceinline__ unsigned cvt_pk_bf16(float lo, float hi) { unsigned r; asm volatile("v_cvt_pk_bf16_f32 %0, %1, %2" : "=v"(r) : "v"(lo), "v"(hi)); return r; }
__device__ __forceinline__ float bf_lo(unsigned w) { return __uint_as_float(w << 16); }
__device__ __forceinline__ float bf_hi(unsigned w) { return __uint_as_float(w & 0xffff0000u); }

template <class Epi, class Sched, bool GATHER, bool F8 = false>
__device__ __forceinline__ void gemm_phase(PG8_LAS unsigned char* lds, const Gemm g, const Sched& S, const Epi& E, int wave_id  ) {
    int tid_; asm volatile("v_mbcnt_lo_u32_b32 %0, -1, 0\n\tv_mbcnt_hi_u32_b32 %0, -1, %0" : "=v"(tid_)); tid_ += wave_id << 6;
    const int tid = tid_, wid = __builtin_amdgcn_readfirstlane(tid >> 6), lane = tid & 63, wr = wid >> 2, wc = wid & 3, fr = lane & 15, fq = lane >> 4;
    const int K = g.K, nt = K / BK;
    int Ra[2], Ca[2]; unsigned voffB[2];
#pragma unroll
    for (int i = 0; i < 2; ++i) { int R, C; stage_rc(tid * 16 + i * 8192, R, C); const int Rb = (R & ~31) + perm32(R & 31);
        Ra[i] = R; Ca[i] = C; voffB[i] = (unsigned)(Rb * K + C) * 2u; }
    const size_t kstep = (size_t)(BK * 2);
    const size_t hstep = (size_t)HALF * K * 2;
    const size_t tstep = 2 * hstep;
    const unsigned ldsw = (unsigned)wid * 1024u;
    const int aoff = lds_byte(wr * 64 + fr, fq * 8), boff = lds_byte(wc * 32 + fr, fq * 8);
    const char* const A0 = (const char*)g.A;
#define PG8_SA(b, h) (((b) * 2 + (h)) * HTB)
#define PG8_SB(b, h) ((4 + (b) * 2 + (h)) * HTB)
#define PG8_STAGE(bufoff, gbase, voff) do { _Pragma("unroll") for (int _i = 0; _i < 2; ++_i) \
        __builtin_amdgcn_global_load_lds((const unsigned*)((const char*)(gbase) + (voff)[_i]), (PG8_LAS unsigned*)(lds + (bufoff) + ldsw + _i * 8192), 16, 0, 0); } while (0)
#define PG8_RDA(b, h, m, k) (*(const PG8_LAS bf16x8*)(lds + PG8_SA(b, h) + aoff + (m) * 2048 + (k) * 1024))
#define PG8_RDB(b, h, n, k) (*(const PG8_LAS bf16x8*)(lds + PG8_SB(b, h) + boff + (n) * 2048 + (k) * 1024))
#define PG8_LDA(dst, b, h) do { _Pragma("unroll") for (int m = 0; m < 4; ++m) { if (F8) { const i32x4 x0_ = *(const PG8_LAS i32x4*)(lds + PG8_SA(b, h) + aoff + m * 2048), x1_ = *(const PG8_LAS i32x4*)(lds + PG8_SA(b, h) + aoff + m * 2048 + 1024); dst##8[m] = __builtin_shufflevector(x0_, x1_, 0, 1, 2, 3, 4, 5, 6, 7); } else { dst[m][0] = PG8_RDA(b, h, m, 0); dst[m][1] = PG8_RDA(b, h, m, 1); } } } while (0)
#define PG8_LDB(dst, b, h) do { _Pragma("unroll") for (int n = 0; n < 2; ++n) { if (F8) { const i32x4 x0_ = *(const PG8_LAS i32x4*)(lds + PG8_SB(b, h) + boff + n * 2048), x1_ = *(const PG8_LAS i32x4*)(lds + PG8_SB(b, h) + boff + n * 2048 + 1024); dst##8[n] = __builtin_shufflevector(x0_, x1_, 0, 1, 2, 3, 4, 5, 6, 7); } else { dst[n][0] = PG8_RDB(b, h, n, 0); dst[n][1] = PG8_RDB(b, h, n, 1); } } } while (0)
#define PG8_CAT(x0, x1) __builtin_shufflevector(__builtin_bit_cast(i32x4, x0), __builtin_bit_cast(i32x4, x1), 0, 1, 2, 3, 4, 5, 6, 7)
#define PG8_MMA(ai, bj, At, Bt) do { __builtin_amdgcn_s_setprio(1); _Pragma("unroll") for (int m = 0; m < 4; ++m) _Pragma("unroll") for (int n = 0; n < 2; ++n) { \
        if (F8) asm("v_mfma_f32_16x16x128_f8f6f4 %0, %1, %2, %0" : "+v"(acc[ai][bj][m][n]) : "v"(Bt##8[n]), "v"(At##8[m]));         \
        else { _Pragma("unroll") for (int k = 0; k < 2; ++k) acc[ai][bj][m][n] = __builtin_amdgcn_mfma_f32_16x16x32_bf16(Bt[n][k], At[m][k], acc[ai][bj][m][n], 0, 0, 0); } } __builtin_amdgcn_s_setprio(0); } while (0)
#define PG8_WAIT_V(n) asm volatile("s_waitcnt vmcnt(" #n ")" ::: "memory")
#define PG8_WAIT_L(n) asm volatile("s_waitcnt lgkmcnt(" #n ")" ::: "memory")
#define PG8_BAR __builtin_amdgcn_s_barrier()
#define PG8_SCHED __builtin_amdgcn_sched_barrier(0)
#define PG8_AOFFS(dst, u) do { _Pragma("unroll") for (int _h = 0; _h < 2; ++_h) _Pragma("unroll") for (int _i = 0; _i < 2; ++_i) { \
        int _row = (u).pm * BM + _h * HALF + Ra[_i]; \
        if (GATHER) { const int _gi = g.rowidx[(u).gp * BM + _h * HALF + Ra[_i]]; _row = _gi < 0 ? 0 : _gi; } \
        dst[_h][_i] = ((unsigned)_row * (unsigned)K + (unsigned)Ca[_i]) * 2u; } } while (0)
    Unit cur, nxt; int ui = 0;
    if (!S.next(0, cur)) return;
    f32x4 acc[2][2][4][2];
#pragma unroll
    for (int a = 0; a < 2; ++a)
#pragma unroll
        for (int b = 0; b < 2; ++b)
#pragma unroll
            for (int m = 0; m < 4; ++m)
#pragma unroll
                for (int n = 0; n < 2; ++n) acc[a][b][m][n] = (f32x4){0.f, 0.f, 0.f, 0.f};
    bf16x8 At[4][2], B0[2][2], B1[2][2];
    i32x8 At8[4], B08[2], B18[2];
    unsigned oaC[2][2], oaN[2][2];
    PG8_AOFFS(oaC, cur);
    const char* cB = (const char*)g.Bt + (size_t)cur.e * g.estride + (size_t)cur.pn * tstep;
    PG8_STAGE(PG8_SB(0, 0), cB, voffB); PG8_STAGE(PG8_SB(0, 1), cB + hstep, voffB); PG8_STAGE(PG8_SA(0, 0), A0, oaC[0]); PG8_STAGE(PG8_SA(0, 1), A0, oaC[1]);
    if (wr == 1) PG8_BAR;
    PG8_WAIT_V(2); PG8_BAR;
    PG8_STAGE(PG8_SB(1, 0), cB + kstep, voffB); PG8_STAGE(PG8_SA(1, 0), A0 + kstep, oaC[0]); PG8_STAGE(PG8_SB(1, 1), cB + hstep + kstep, voffB);
    PG8_WAIT_V(6); PG8_BAR;
    for (;;) {
        const bool has_next = S.next(ui + 1, nxt);
        if (has_next) { PG8_AOFFS(oaN, nxt); }
        else {
#pragma unroll
            for (int _h = 0; _h < 2; ++_h)
#pragma unroll
                for (int _i = 0; _i < 2; ++_i) oaN[_h][_i] = oaC[_h][_i]; }
        const char* nB = has_next ? (const char*)g.Bt + (size_t)nxt.e * g.estride + (size_t)nxt.pn * tstep : cB;
#pragma unroll 1
        for (int t = 0; t < nt; t += 2) {
            const bool last = (t == nt - 2);
            const char* ka1 = A0 + (size_t)(t + 1) * kstep;
            const char* ka2 = last ? A0 : A0 + (size_t)(t + 2) * kstep; const char* b2 = last ? nB : cB + (size_t)(t + 2) * kstep;
            const char* ka3 = ka2 + kstep; const char* b3 = b2 + kstep;
            unsigned o2[2][2];
#pragma unroll
            for (int _h = 0; _h < 2; ++_h)
#pragma unroll
                for (int _i = 0; _i < 2; ++_i) o2[_h][_i] = oaC[_h][_i];
            if (last) {
                E.prefetch(lds, cur, wid, lane);
#pragma unroll
                for (int _h = 0; _h < 2; ++_h)
#pragma unroll
                    for (int _i = 0; _i < 2; ++_i) o2[_h][_i] = oaN[_h][_i];
                asm volatile("" : "+v"(o2[0][0]), "+v"(o2[0][1]), "+v"(o2[1][0]), "+v"(o2[1][1])); }
            PG8_LDB(B0, 0, 0); PG8_LDB(B1, 0, 1); PG8_SCHED; PG8_LDA(At, 0, 0); PG8_STAGE(PG8_SA(1, 1), ka1, oaC[1]);
            PG8_WAIT_V(8); PG8_WAIT_L(0); PG8_BAR; PG8_MMA(0, 0, At, B0); PG8_MMA(0, 1, At, B1); PG8_BAR; PG8_SCHED;
            PG8_LDA(At, 0, 1); PG8_STAGE(PG8_SB(0, 0), b2, voffB); PG8_STAGE(PG8_SB(0, 1), b2 + hstep, voffB); PG8_STAGE(PG8_SA(0, 0), ka2, o2[0]);
            PG8_WAIT_V(8); PG8_WAIT_L(0); PG8_BAR; PG8_MMA(1, 0, At, B0); PG8_MMA(1, 1, At, B1); PG8_BAR; PG8_SCHED;
            PG8_LDB(B0, 1, 0); PG8_LDB(B1, 1, 1); PG8_SCHED; PG8_LDA(At, 1, 0); PG8_STAGE(PG8_SA(0, 1), ka2, o2[1]);
            PG8_WAIT_V(8); PG8_WAIT_L(0); PG8_BAR; PG8_MMA(0, 0, At, B0); PG8_MMA(0, 1, At, B1); PG8_BAR; PG8_SCHED;
            PG8_LDA(At, 1, 1); PG8_STAGE(PG8_SB(1, 0), b3, voffB); PG8_STAGE(PG8_SB(1, 1), b3 + hstep, voffB); PG8_STAGE(PG8_SA(1, 0), ka3, o2[0]);
            PG8_WAIT_V(8); PG8_WAIT_L(0); PG8_BAR; PG8_MMA(1, 0, At, B0); PG8_MMA(1, 1, At, B1); PG8_BAR; PG8_SCHED;
        }
        if (wr == 0) PG8_BAR;
        { int fr_e = fr, fq_e = fq; asm volatile("" : "+v"(fr_e), "+v"(fq_e));
          E(acc, cur, wr, wc, fr_e, fq_e, lds); }
        if (!has_next) break;
#pragma unroll
        for (int a = 0; a < 2; ++a)
#pragma unroll
            for (int b = 0; b < 2; ++b)
#pragma unroll
                for (int m = 0; m < 4; ++m)
#pragma unroll
                    for (int n = 0; n < 2; ++n) acc[a][b][m][n] = (f32x4){0.f, 0.f, 0.f, 0.f};
        cur = nxt; cB = nB; ++ui;
#pragma unroll
        for (int _h = 0; _h < 2; ++_h)
#pragma unroll
            for (int _i = 0; _i < 2; ++_i) oaC[_h][_i] = oaN[_h][_i];
        if (wr == 1) PG8_BAR;
    }
    PG8_WAIT_V(0);
    PG8_BAR;
#undef PG8_SA
#undef PG8_SB
#undef PG8_STAGE
#undef PG8_LDA
#undef PG8_RDA
#undef PG8_RDB
#undef PG8_LDB
#undef PG8_MMA
#undef PG8_CAT
#undef PG8_WAIT_V
#undef PG8_WAIT_L
#undef PG8_BAR
#undef PG8_SCHED
#undef PG8_AOFFS
}
}
#define GAS __attribute__((address_space(1)))
#define LAS __attribute__((address_space(3)))
typedef unsigned short bf16;
typedef unsigned v4u __attribute__((ext_vector_type(4)));
typedef unsigned v2u __attribute__((ext_vector_type(2)));
typedef float f32x4 __attribute__((ext_vector_type(4)));
typedef float f32x2 __attribute__((ext_vector_type(2)));
typedef GAS unsigned gu32;
#define RLX_AGENT __ATOMIC_RELAXED, __HIP_MEMORY_SCOPE_AGENT
#define LDS_WAIT() asm volatile("s_waitcnt lgkmcnt(0)" ::: "memory")
#define VM_WAIT() asm volatile("s_waitcnt vmcnt(0)" ::: "memory")
__device__ __forceinline__ unsigned f2bf(float f) { unsigned u = __builtin_bit_cast(unsigned, f); return (u + 0x7fffu + ((u >> 16) & 1u)) >> 16; }
__device__ __forceinline__ unsigned pk2(float lo, float hi) { return f2bf(lo) | (f2bf(hi) << 16); }
__device__ __forceinline__ float bf2f(bf16 h) { return __uint_as_float(((unsigned)h) << 16); }
__device__ __forceinline__ float bflo(unsigned w) { return __uint_as_float(w << 16); }
__device__ __forceinline__ float bfhi(unsigned w) { return __uint_as_float(w & 0xffff0000u); }

#define XB_TMO      128
#define XB_XCNT(j)  (256  + 64 * (j))
#define XB_XSUB(j)  (1280 + 64 * (j))
#define XB_XGEN(j)  (2304 + 64 * (j))
#define XB_TOP      3328
#define XB_TOPGEN   3392
#define XCD_BAR_WORDS 3456
#define XB_SPIN_CAP (1u << 18)

__device__ __forceinline__ unsigned xb_ld(unsigned* p)              { return __hip_atomic_load(p, __ATOMIC_RELAXED, __HIP_MEMORY_SCOPE_AGENT); }
__device__ __forceinline__ unsigned xb_add(unsigned* p, unsigned v) { return __hip_atomic_fetch_add(p, v, __ATOMIC_RELAXED, __HIP_MEMORY_SCOPE_AGENT); }
__device__ __forceinline__ unsigned xb_xcc_id() { return (unsigned)__builtin_amdgcn_s_getreg((3 << 11) | 20) & 0xFu; }
#define XB_SPIN(cond, bar) do { unsigned _sp = 0; while (cond) { __builtin_amdgcn_s_sleep(1); \
    if ((++_sp & 255u) == 0u) { if (xb_ld(&(bar)[XB_TMO])) break; if (_sp > XB_SPIN_CAP) { atomicAdd(&(bar)[XB_TMO], 1u); break; } } } } while (0)

struct XcdBarrier {
    unsigned* bar; unsigned x;
    volatile LAS unsigned* st;
};

__device__ __forceinline__ XcdBarrier xcd_barrier_post(unsigned* bar, volatile LAS unsigned* st, bool leader  ) {
    XcdBarrier b; b.bar = bar; b.x = xb_xcc_id(); b.st = st;
    if (leader) (void)xb_add(&bar[XB_XCNT(b.x)], 1u);
    return b;
}
__device__ __forceinline__ void xcd_barrier_complete(unsigned* bar, unsigned x, unsigned& nloc, unsigned& nx) {
    const unsigned G = gridDim.x * gridDim.y * gridDim.z;
    unsigned sum, cnt, mine, sp = 0u;
    for (;;) {
        sum = 0u; cnt = 0u; mine = 0u;
#pragma unroll
        for (unsigned j = 0; j < 16; ++j) { const unsigned c = xb_ld(&bar[XB_XCNT(j)]); sum += c; cnt += (c > 0u) ? 1u : 0u; mine = (j == x) ? c : mine; }
        if (sum == G) break;
        __builtin_amdgcn_s_sleep(1);
        if ((++sp & 255u) == 0u) { if (xb_ld(&bar[XB_TMO])) break; if (sp > XB_SPIN_CAP) { atomicAdd(&bar[XB_TMO], 1u); break; } }
    }
    nloc = mine > 0u ? mine : 1u; nx = cnt > 0u ? cnt : 1u;
}

__device__ __forceinline__ void xcd_barrier(const XcdBarrier& b, bool leader) {
    asm volatile("s_waitcnt vmcnt(0)" ::: "memory");
    __syncthreads();
    if (leader) {
        unsigned* bar = b.bar;
        __builtin_amdgcn_s_waitcnt(0);
        unsigned nloc = b.st[0], nx = b.st[1];
        if (nloc == 0u) { xcd_barrier_complete(bar, b.x, nloc, nx); b.st[0] = nloc; b.st[1] = nx; }
        const unsigned old = xb_add(&bar[XB_XSUB(b.x)], 1u);
        const unsigned gen = old / nloc;
        if (old + 1u == (gen + 1u) * nloc) {
            __builtin_amdgcn_fence(__ATOMIC_RELEASE, "agent");
            asm volatile("s_waitcnt vmcnt(0)" ::: "memory");
            const unsigned og = xb_add(&bar[XB_TOP], 1u);
            const unsigned tg = og / nx;
            if (og + 1u == (tg + 1u) * nx) xb_add(&bar[XB_TOPGEN], 1u);
            else XB_SPIN(xb_ld(&bar[XB_TOPGEN]) == tg, bar);
            __builtin_amdgcn_fence(__ATOMIC_ACQUIRE, "agent");
            xb_add(&bar[XB_XGEN(b.x)], 1u);
            asm volatile("s_waitcnt vmcnt(0)" ::: "memory");
        } else {
            XB_SPIN(xb_ld(&bar[XB_XGEN(b.x)]) == gen, bar);
            __builtin_amdgcn_fence(__ATOMIC_ACQUIRE, "agent");
            asm volatile("s_waitcnt vmcnt(0)" ::: "memory");
        }
    }
    __syncthreads();
}

__device__ __forceinline__ int lane_id() { int l; asm volatile("v_mbcnt_lo_u32_b32 %0, -1, 0\n\tv_mbcnt_hi_u32_b32 %0, -1, %0" : "=v"(l)); return l; }

constexpr int NB = 16, TT = 2048, DM = 1024, MR = NB * TT, NMETA = 16, MROWS = MR + 256, NPAN = MROWS / 256;
constexpr int PSEQ = 2112, NCH = 33;
constexpr int DIN = 2864, N1 = 3072;
constexpr int DFF = 2816, DFE = 3584, NEXP = 8;
constexpr float EPS = 1e-6f;
constexpr int C_AQ = 0, C_AK = 128, C_AV = 256, C_ALR = 512, C_AOG = 528, C_RQ = 784, C_RK = 1040, C_RV = 1296, C_ROG = 1552, C_CQ = 1808, C_CKV = 2000, C_KPE = 2064, C_DQ = 2096, C_DK = 2352, C_DV = 2608;
constexpr int MAXPAN = 264;
constexpr float LOG2E = 1.4426950408889634f;

constexpr size_t MiB = 1u << 20;
constexpr size_t WS_CTL = 0, CTL_BYTES = 1 * MiB;
constexpr size_t WS_TABR = 1 * MiB, WS_TABM = 1 * MiB + 576 * 1024;
constexpr size_t WS_RT = 2 * MiB;
constexpr size_t WS_WQA = 2 * MiB + 256 * 1024, WQA_BYTES = 384 * 192 * 2;
constexpr size_t WS_STA = 3 * MiB, WS_STB = 6 * MiB;
constexpr size_t WS_MOE = 9 * MiB;
constexpr size_t MO_ROWIDX = WS_MOE, MO_PDST = WS_MOE + 512 * 1024, MO_PINFO = WS_MOE + 1 * MiB, MO_TOKE = WS_MOE + 2 * MiB, MO_TOKP = MO_TOKE + 256 * 1024, MO_TOKW = MO_TOKE + 512 * 1024, MO_PEXP = WS_MOE + 3 * MiB;
constexpr size_t WS_GD = 13 * MiB;
constexpr size_t WS_W1T = 16 * MiB, W1T_BYTES = (size_t)N1 * DM * 2;
constexpr size_t WS_WOT = 29 * MiB, WOT_BYTES = (size_t)DM * DM * 2;
constexpr size_t WS_WGU = 33 * MiB;
constexpr size_t WS_WD = 44 * MiB;
constexpr size_t WS_HB = 50 * MiB;
constexpr size_t WS_BIG = 115 * MiB;
constexpr size_t B_PROJ = WS_BIG;
constexpr int GQ_T = 5120, GKT_T = 5120, RT_T = 9216, VT_T = 9216;
constexpr size_t B_GQ = WS_BIG + 210 * MiB, B_GK = WS_BIG + 221 * MiB, B_GV = WS_BIG + 232 * MiB;
constexpr size_t B_RQ = WS_BIG + 251 * MiB, B_RK = WS_BIG + 270 * MiB, B_RV = WS_BIG + 289 * MiB;
constexpr size_t B_MQ = WS_BIG + 308 * MiB, B_MK = WS_BIG + 333 * MiB;
constexpr size_t B_DQ = WS_BIG + 340 * MiB, B_DK = B_DQ + 16896 * 1024;
constexpr size_t O_DVT = 65 * MiB, O_MVT = 82 * MiB, O_GKT = 87 * MiB, O_RKT = 98 * MiB;
constexpr size_t B_ACT = WS_BIG;
constexpr size_t B_ACTT = WS_BIG + 90 * MiB;
constexpr size_t B_HB8D = WS_BIG + 300 * MiB;
constexpr size_t WS_WGU8 = WS_BIG + 380 * MiB, WS_WD8 = WS_BIG + 390 * MiB;
constexpr size_t B_EGU = WS_BIG, EGU_BYTES = (size_t)2 * DFE * DM;
constexpr size_t B_HB8 = WS_BIG + 56 * MiB;
constexpr float W8_SCALE = 64.f;
constexpr size_t B_ED = WS_BIG + 112 * MiB, ED_BYTES = (size_t)DM * DFE;
constexpr float ACT8_SCALE = 16.f;
constexpr size_t B_EACT = WS_BIG + 168 * MiB;
constexpr size_t WS_NEED = WS_BIG + 406 * MiB;
constexpr int CW_BAR = 4096, CW_CNT = 8192;

constexpr int RING_BYTES = 131072, MISC_OFF = RING_BYTES + 320, EPS_OFF = 147456, LDS_BYTES = 163840;

__device__ __forceinline__ float clamp8(float v) { return __builtin_amdgcn_fmed3f(v, -448.f, 448.f); }
__device__ __forceinline__ unsigned pk4_fp8(float a, float b, float c, float d) { unsigned q = (unsigned)__builtin_amdgcn_cvt_pk_fp8_f32(clamp8(a), clamp8(b), 0, false); return (unsigned)__builtin_amdgcn_cvt_pk_fp8_f32(clamp8(c), clamp8(d), (int)q, true); }
__device__ __forceinline__ float silu_f(float x) { return x * __builtin_amdgcn_rcpf(1.0f + __builtin_amdgcn_exp2f(-x * LOG2E)); }
__device__ __forceinline__ v4u pack8(const f32x4 a, const f32x4 b) { v4u w; w.x = pg8::cvt_pk_bf16(a[0], a[1]); w.y = pg8::cvt_pk_bf16(a[2], a[3]); w.z = pg8::cvt_pk_bf16(b[0], b[1]); w.w = pg8::cvt_pk_bf16(b[2], b[3]); return w; }

__device__ __forceinline__ void rows_rstd16(const float* stats, int row0, int fq, float (&rs)[8]) {
    f32x4 v[8];
#pragma unroll
    for (int j = 0; j < 8; ++j) v[j] = *(const f32x4*)(stats + (size_t)(row0 + (j >> 2) * 128 + (j & 3) * 16) * 16 + 4 * fq);
#pragma unroll
    for (int j = 0; j < 8; ++j) { float s = (v[j][0] + v[j][1]) + (v[j][2] + v[j][3]); s += __shfl_xor(s, 16); s += __shfl_xor(s, 32); rs[j] = __builtin_amdgcn_rsqf(s * (1.0f / 1024.0f) + EPS); }
}
__device__ __forceinline__ void stage_rows(const void* src, int bytes, LAS unsigned char* lds, int wid, int lane) {
#pragma unroll
    for (int j = 0; j < 2; ++j) { const int p = __builtin_amdgcn_readfirstlane(wid + 8 * j);
        if (p * 1024 < bytes) __builtin_amdgcn_global_load_lds((const unsigned*)((const unsigned char*)src + p * 1024 + lane * 16), (LAS unsigned*)(lds + EPS_OFF + p * 1024), 16, 0, 0); }
}
__device__ __forceinline__ void rows_rstd16_lds(const LAS unsigned char* lds, int rl0, int fq, float (&rs)[8]) {
    f32x4 v[8];
#pragma unroll
    for (int j = 0; j < 8; ++j) v[j] = *(const LAS f32x4*)(lds + EPS_OFF + (rl0 + (j >> 2) * 128 + (j & 3) * 16) * 64 + 16 * fq);
#pragma unroll
    for (int j = 0; j < 8; ++j) { float s = (v[j][0] + v[j][1]) + (v[j][2] + v[j][3]); s += __shfl_xor(s, 16); s += __shfl_xor(s, 32); rs[j] = __builtin_amdgcn_rsqf(s * (1.0f / 1024.0f) + EPS); }
}
struct EpiProj {
    bf16* O; const float* stats;
    __device__ __forceinline__ void prefetch(LAS unsigned char* lds, const pg8::Unit& u, int wid, int lane) const { stage_rows(stats + (size_t)u.pm * 256 * 16, 16384, lds, wid, lane); }
    __device__ __forceinline__ void operator()(const f32x4 (&acc)[2][2][4][2], const pg8::Unit& u, int wr, int wc, int fr, int fq, const LAS unsigned char* lds) const {
        const int col0 = u.pn * 256 + wc * 32 + 8 * fq, row0 = u.pm * 256 + wr * 64 + fr;
        float rs[8]; rows_rstd16_lds(lds, wr * 64 + fr, fq, rs);
#pragma unroll
        for (int ai = 0; ai < 2; ++ai)
#pragma unroll
            for (int m = 0; m < 4; ++m) { const int r = row0 + ai * 128 + m * 16; const float sc = rs[ai * 4 + m]; bf16* rowp = O + (size_t)r * N1 + col0;
#pragma unroll
                for (int bj = 0; bj < 2; ++bj) *(v4u*)(rowp + bj * 128) = pack8(acc[ai][bj][m][0] * sc, acc[ai][bj][m][1] * sc); }
    }
};
struct EpiSwiglu {
    unsigned char* O; int ldo; const float* stats; float wscale;
    __device__ __forceinline__ void prefetch(LAS unsigned char* lds, const pg8::Unit& u, int wid, int lane) const { stage_rows(stats + (size_t)u.pm * 256 * 16, 16384, lds, wid, lane); }
    __device__ __forceinline__ void operator()(const f32x4 (&acc)[2][2][4][2], const pg8::Unit& u, int wr, int wc, int fr, int fq, const LAS unsigned char* lds) const {
        const int col0 = u.pn * 128 + wc * 32 + 8 * fq, row0 = u.pm * 256 + wr * 64 + fr;
        float rs[8]; rows_rstd16_lds(lds, wr * 64 + fr, fq, rs);
#pragma unroll
        for (int j = 0; j < 8; ++j) rs[j] *= wscale;
#pragma unroll
        for (int ai = 0; ai < 2; ++ai)
#pragma unroll
            for (int m = 0; m < 4; ++m) { const int r = row0 + ai * 128 + m * 16; const float sc = rs[ai * 4 + m];
                f32x4 o[2];
#pragma unroll
                for (int n = 0; n < 2; ++n)
#pragma unroll
                    for (int i = 0; i < 4; ++i) o[n][i] = silu_f(acc[ai][0][m][n][i] * sc) * (acc[ai][1][m][n][i] * sc) * ACT8_SCALE;
                *(uint2*)(O + (size_t)r * ldo + col0) = make_uint2(pk4_fp8(o[0][0], o[0][1], o[0][2], o[0][3]), pk4_fp8(o[1][0], o[1][1], o[1][2], o[1][3])); }
    }
};
struct EpiResid {
    bf16* H; float* stats; unsigned char* H8; float ascale;
    __device__ __forceinline__ void prefetch(LAS unsigned char*, const pg8::Unit&, int, int) const {}
    __device__ __forceinline__ void operator()(const f32x4 (&acc)[2][2][4][2], const pg8::Unit& u, int wr, int wc, int fr, int fq, const LAS unsigned char*) const {
        const int col0 = u.pn * 256 + wc * 32 + 8 * fq, row0 = u.pm * 256 + wr * 64 + fr;
#pragma unroll
        for (int ai = 0; ai < 2; ++ai) {
            v4u w[4][2];
#pragma unroll
            for (int m = 0; m < 4; ++m)
#pragma unroll
                for (int bj = 0; bj < 2; ++bj) w[m][bj] = *(const v4u*)(H + (size_t)(row0 + ai * 128 + m * 16) * DM + col0 + bj * 128);
            float ssm[4];
#pragma unroll
            for (int m = 0; m < 4; ++m) { bf16* rowp = H + (size_t)(row0 + ai * 128 + m * 16) * DM + col0; float ss = 0.f;
#pragma unroll
                for (int bj = 0; bj < 2; ++bj) { const v4u x = w[m][bj];
                    f32x4 a = acc[ai][bj][m][0] * ascale, b = acc[ai][bj][m][1] * ascale;
                    a[0] += bflo(x.x); a[1] += bfhi(x.x); a[2] += bflo(x.y); a[3] += bfhi(x.y); b[0] += bflo(x.z); b[1] += bfhi(x.z); b[2] += bflo(x.w); b[3] += bfhi(x.w);
                    ss += (a[0] * a[0] + a[1] * a[1]) + (a[2] * a[2] + a[3] * a[3]) + (b[0] * b[0] + b[1] * b[1]) + (b[2] * b[2] + b[3] * b[3]);
                    *(v4u*)(rowp + bj * 128) = pack8(a, b);
                    if (H8) *(uint2*)(H8 + (size_t)(row0 + ai * 128 + m * 16) * DM + col0 + bj * 128) = make_uint2(pk4_fp8(a[0], a[1], a[2], a[3]), pk4_fp8(b[0], b[1], b[2], b[3])); }
                ss += __shfl_xor(ss, 16); ss += __shfl_xor(ss, 32); ssm[m] = ss; }
            if (fq == 0) {
#pragma unroll
                for (int m = 0; m < 4; ++m) stats[(size_t)(row0 + ai * 128 + m * 16) * 16 + u.pn * 4 + wc] = ssm[m]; } }
    }
};
struct EpiSwigluMoe {
    unsigned char* O; const f32x2* pinfo; float wscale;
    __device__ __forceinline__ void prefetch(LAS unsigned char* lds, const pg8::Unit& u, int wid, int lane) const { stage_rows(pinfo + (size_t)u.gp * 256, 2048, lds, wid, lane); }
    __device__ __forceinline__ void operator()(const f32x4 (&acc)[2][2][4][2], const pg8::Unit& u, int wr, int wc, int fr, int fq, const LAS unsigned char* lds) const {
        const int col0 = u.pn * 128 + wc * 32 + 8 * fq, rl0 = wr * 64 + fr;
        float rs[8];
#pragma unroll
        for (int j = 0; j < 8; ++j) rs[j] = ((const LAS f32x2*)(lds + EPS_OFF))[rl0 + (j >> 2) * 128 + (j & 3) * 16][0] * wscale;
#pragma unroll
        for (int ai = 0; ai < 2; ++ai)
#pragma unroll
            for (int m = 0; m < 4; ++m) { const int rl = rl0 + ai * 128 + m * 16; const float sc = rs[ai * 4 + m];
                f32x4 o[2];
#pragma unroll
                for (int n = 0; n < 2; ++n)
#pragma unroll
                    for (int i = 0; i < 4; ++i) o[n][i] = silu_f(acc[ai][0][m][n][i] * sc) * (acc[ai][1][m][n][i] * sc) * ACT8_SCALE;
                *(uint2*)(O + (size_t)(u.pm * 256 + rl) * DFE + col0) = make_uint2(pk4_fp8(o[0][0], o[0][1], o[0][2], o[0][3]), pk4_fp8(o[1][0], o[1][1], o[1][2], o[1][3])); }
    }
};
struct EpiMoeDown {
    unsigned char* Y; const int* pdst; const f32x2* pinfo; float oscale;
    __device__ __forceinline__ void prefetch(LAS unsigned char* lds, const pg8::Unit& u, int wid, int lane) const {
        if (wid < 2) __builtin_amdgcn_global_load_lds((const unsigned*)((const unsigned char*)(pinfo + (size_t)u.gp * 256) + wid * 1024 + lane * 16), (LAS unsigned*)(lds + EPS_OFF + wid * 1024), 16, 0, 0);
        else if (wid == 2) __builtin_amdgcn_global_load_lds((const unsigned*)((const unsigned char*)(pdst + (size_t)u.gp * 256) + lane * 16), (LAS unsigned*)(lds + EPS_OFF + 2048), 16, 0, 0); }
    __device__ __forceinline__ void operator()(const f32x4 (&acc)[2][2][4][2], const pg8::Unit& u, int wr, int wc, int fr, int fq, const LAS unsigned char* lds) const {
        const int col0 = u.pn * 256 + wc * 32 + 8 * fq, rl0 = wr * 64 + fr;
#pragma unroll
        for (int ai = 0; ai < 2; ++ai)
#pragma unroll
            for (int m = 0; m < 4; ++m) { const int rl = rl0 + ai * 128 + m * 16; const int d = ((const LAS int*)(lds + EPS_OFF + 2048))[rl]; const float w = ((const LAS f32x2*)(lds + EPS_OFF))[rl][1] * oscale;
                if (d >= 0) { bf16* rowp = (bf16*)(Y + (size_t)(d >> 1) * 4096 + (size_t)(d & 1) * 2048) + col0;
#pragma unroll
                    for (int bj = 0; bj < 2; ++bj) *(v4u*)(rowp + bj * 128) = pack8(acc[ai][bj][m][0] * w, acc[ai][bj][m][1] * w); } }
    }
};

__device__ __forceinline__ float wave_sum(float v) {
#pragma unroll
    for (int o = 1; o < 64; o <<= 1) v += __shfl_xor(v, o);
    return v;
}
__device__ __forceinline__ void transpose_item(const float* W, int K, int N, const float* gain, bf16* WT, int kb, int nb, int dmode, LAS float* scr_, int lane) {
    LAS unsigned* scr = (LAS unsigned*)scr_;
    const int k0 = 64 * kb, n0 = 64 * nb, n = n0 + 2 * (lane & 31), kh = lane >> 5;
    f32x2 v[32];
#pragma unroll
    for (int i = 0; i < 32; ++i) v[i] = (n < N) ? *(const f32x2*)(W + (size_t)(k0 + 2 * i + kh) * N + n) : (f32x2){0.f, 0.f};
    if (gain) {
#pragma unroll
        for (int i = 0; i < 32; ++i) v[i] = v[i] * gain[k0 + 2 * i + kh]; }
#pragma unroll
    for (int i = 0; i < 32; ++i) scr[(2 * i + kh) * 33 + (lane & 31)] = pk2(v[i][0], v[i][1]);
    LDS_WAIT(); asm volatile("" ::: "memory");
    const LAS bf16* T = (const LAS bf16*)scr;
    const int c = lane & 7;
    const int d0 = dmode == 0 ? n0 : 256 * (n0 >> 7) + (n0 & 127) + (dmode == 2 ? 128 : 0);
#pragma unroll
    for (int j = 0; j < 8; ++j) { const int nl = (lane >> 3) + 8 * j; unsigned x[8];
#pragma unroll
        for (int t = 0; t < 8; ++t) x[t] = T[(8 * c + t) * 66 + nl];
        v4u o; o.x = x[0] | (x[1] << 16); o.y = x[2] | (x[3] << 16); o.z = x[4] | (x[5] << 16); o.w = x[6] | (x[7] << 16);
        if (n0 + nl < N) *(v4u*)(WT + (size_t)(d0 + nl) * K + k0 + 8 * c) = o; }
    LDS_WAIT(); asm volatile("" ::: "memory");
}

__device__ __forceinline__ void transpose_item_f8(const float* W, int K, int N, const float* gain, unsigned char* WT, int kb, int nb, int dmode, LAS float* scr_, int lane) {
    LAS unsigned char* scr = (LAS unsigned char*)scr_;
    const int k0 = 128 * kb, n0 = 64 * nb, nl2 = 2 * (lane & 31), n = n0 + nl2, kh = lane >> 5;
#pragma unroll
    for (int half = 0; half < 2; ++half) {
        f32x2 v[32];
#pragma unroll
        for (int i = 0; i < 32; ++i) v[i] = (n < N) ? *(const f32x2*)(W + (size_t)(k0 + 64 * half + 2 * i + kh) * N + n) : (f32x2){0.f, 0.f};
#pragma unroll
        for (int i = 0; i < 32; ++i) { const float gs = (gain ? gain[k0 + 64 * half + 2 * i + kh] : 1.f) * W8_SCALE; const int k = 64 * half + 2 * i + kh;
            const unsigned pk = (unsigned)__builtin_amdgcn_cvt_pk_fp8_f32(v[i][0] * gs, v[i][1] * gs, 0, false);
            scr[nl2 * 132 + k] = (unsigned char)(pk & 0xffu); scr[(nl2 + 1) * 132 + k] = (unsigned char)((pk >> 8) & 0xffu); } }
    LDS_WAIT(); asm volatile("" ::: "memory");
    const int c = lane & 7;
    const int d0 = dmode == 0 ? n0 : 256 * (n0 >> 7) + (n0 & 127) + (dmode == 2 ? 128 : 0);
#pragma unroll
    for (int j = 0; j < 8; ++j) { const int nl = (lane >> 3) + 8 * j; const LAS unsigned* p = (const LAS unsigned*)(scr + nl * 132 + 16 * c);
        v4u o; o.x = p[0]; o.y = p[1]; o.z = p[2]; o.w = p[3];
        if (n0 + nl < N) *(v4u*)(WT + (size_t)(d0 + nl) * K + k0 + 16 * c) = o; }
    LDS_WAIT(); asm volatile("" ::: "memory");
}

struct Args { const float* in[24]; float* out; unsigned char* ws; int ph_lo, ph_hi; };
__device__ __forceinline__ const float* ain(const Args& a, int i) { return a.in[i]; }
enum { I_X = 0, I_META, I_ANORM, I_WIN, I_GWG, I_GBG, I_GNORM, I_RNORM, I_MQN, I_WUQ, I_MKVN, I_WUKV, I_DLAM, I_DNORM, I_WOUT, I_FNORM, I_FG, I_FU, I_FD, I_ROUTER, I_EG, I_EU, I_ED, I_FINAL };

#ifndef REP_FOLD
#define REP_FOLD 1
#endif
#ifndef REP_HINIT
#define REP_HINIT 1
#endif
__device__ __forceinline__ void wqa_unit(const Args& a, int li, int hh, LAS float* L, int tid) {
    const float* Wuq = ain(a, I_WUQ) + (size_t)li * 192 * 384; const float* Wukv = ain(a, I_WUKV) + (size_t)li * 64 * 512;
    const float* gq = ain(a, I_MQN) + li * 192; const float* gkv = ain(a, I_MKVN) + li * 64;
    bf16* WqaT = (bf16*)(a.ws + WS_WQA + li * WQA_BYTES);
    LAS float* Wqa = L; LAS float* Wuk = L + 192 * 97;
    __syncthreads();
    for (int idx = tid; idx < 64 * 64; idx += 512) { const int n = idx >> 6, m = idx & 63; Wuk[n * 65 + m] = Wukv[n * 512 + hh * 128 + m]; }
    __syncthreads();
    for (int pass = 0; pass < 3; ++pass) { const int i = pass * 64 + (tid >> 3), ng = tid & 7; f32x4 wq[16];
#pragma unroll
        for (int j = 0; j < 16; ++j) wq[j] = *(const f32x4*)(Wuq + i * 384 + hh * 96 + 4 * j);
        const float gi = gq[i];
#pragma unroll
        for (int t = 0; t < 8; ++t) { const int n = ng * 8 + t; float s = 0.f;
#pragma unroll
            for (int j = 0; j < 16; ++j) s += (wq[j][0] * Wuk[n * 65 + 4 * j] + wq[j][1] * Wuk[n * 65 + 4 * j + 1]) + (wq[j][2] * Wuk[n * 65 + 4 * j + 2] + wq[j][3] * Wuk[n * 65 + 4 * j + 3]);
            Wqa[i * 97 + n] = gi * gkv[n] * s; }
        if (ng < 4) {
#pragma unroll
            for (int j = 0; j < 2; ++j) { const f32x4 r = *(const f32x4*)(Wuq + i * 384 + hh * 96 + 64 + ng * 8 + 4 * j); LAS float* d = Wqa + i * 97 + 64 + ng * 8 + 4 * j; d[0] = gi * r[0]; d[1] = gi * r[1]; d[2] = gi * r[2]; d[3] = gi * r[3]; } } }
    __syncthreads();
    for (int idx = tid; idx < 96 * 24; idx += 512) { const int n = idx % 96, i8 = idx / 96; float v[8];
#pragma unroll
        for (int t = 0; t < 8; ++t) v[t] = Wqa[(8 * i8 + t) * 97 + n];
        v4u w; w.x = pk2(v[0], v[1]); w.y = pk2(v[2], v[3]); w.z = pk2(v[4], v[5]); w.w = pk2(v[6], v[7]);
        *(v4u*)(WqaT + (size_t)(hh * 96 + n) * 192 + 8 * i8) = w; }
    __syncthreads();
}
__device__ __forceinline__ void wofold_unit(const Args& a, int li, int hh, int nq, LAS float* L, int tid) {
    const float* Wukv = ain(a, I_WUKV) + (size_t)li * 64 * 512; const float* gkv = ain(a, I_MKVN) + li * 64; const float* Wo = ain(a, I_WOUT) + (size_t)li * DM * DM;
    bf16* Wot = (bf16*)(a.ws + WS_WOT + li * WOT_BYTES);
    LAS float* WuvT = L; LAS float* Wos = L + 64 * 64;
    __syncthreads();
    for (int idx = tid; idx < 64 * 64; idx += 512) { const int j = idx >> 6, e = idx & 63; WuvT[e * 64 + j] = Wukv[j * 512 + hh * 128 + 64 + e] * gkv[j]; }
    for (int idx = tid; idx < 64 * 64; idx += 512) { const int e = idx >> 6, n4 = idx & 63; *(LAS f32x4*)(Wos + e * 256 + 4 * n4) = *(const f32x4*)(Wo + (size_t)(512 + 64 * hh + e) * DM + nq * 256 + 4 * n4); }
    __syncthreads();
    { const int n4 = tid & 63, j8 = tid >> 6; f32x4 acc[8];
#pragma unroll
        for (int j = 0; j < 8; ++j) acc[j] = (f32x4){0.f, 0.f, 0.f, 0.f};
#pragma unroll 4
        for (int e = 0; e < 64; ++e) { const f32x4 wv = *(const LAS f32x4*)(Wos + e * 256 + 4 * n4); const f32x4 u0 = *(const LAS f32x4*)(WuvT + e * 64 + 8 * j8), u1 = *(const LAS f32x4*)(WuvT + e * 64 + 8 * j8 + 4);
#pragma unroll
            for (int j = 0; j < 4; ++j) { acc[j] += wv * u0[j]; acc[4 + j] += wv * u1[j]; } }
#pragma unroll
        for (int t = 0; t < 4; ++t) { v4u w; w.x = pk2(acc[0][t], acc[1][t]); w.y = pk2(acc[2][t], acc[3][t]); w.z = pk2(acc[4][t], acc[5][t]); w.w = pk2(acc[6][t], acc[7][t]);
            *(v4u*)(Wot + (size_t)(nq * 256 + 4 * n4 + t) * DM + 512 + 64 * hh + 8 * j8) = w; } }
    __syncthreads();
}
__device__ __forceinline__ void p0_prologue(const Args& a, LAS unsigned char* lds, int tid, int lane, int wave) {
    const int G = gridDim.x;
    for (int rep = 0; rep < REP_FOLD; ++rep)
    for (int un = blockIdx.x; un < 40; un += G) {
        if (un < 8) wqa_unit(a, un >> 2, un & 3, (LAS float*)lds, tid);
        else { const int v = un - 8; wofold_unit(a, v >> 4, (v >> 2) & 3, v & 3, (LAS float*)lds, tid); }
    }
    __syncthreads();
    LAS float* scr = (LAS float*)(lds + wave * 16384);
    const int gw = blockIdx.x * 8 + wave, NGW = G * 8;
    constexpr int I_IN = 16 * 45, I_WO = 12 * 16, I_G = 16 * 44, I_D = 44 * 16, I_G8 = 8 * 44, I_D8 = 22 * 16;
    constexpr int NIT = 2 * I_IN + 2 * I_WO + 2 * I_G + I_D + 2 * I_G8 + I_D8;
    for (int it = gw; it < NIT; it += NGW) {
        int r = it;
        if (r < 2 * I_IN) { const int li = r / I_IN; r %= I_IN; transpose_item(ain(a, I_WIN) + (size_t)li * DM * DIN, DM, DIN, ain(a, I_ANORM) + li * DM, (bf16*)(a.ws + WS_W1T + li * W1T_BYTES), r / 45, r % 45, 0, scr, lane); continue; } r -= 2 * I_IN;
        if (r < 2 * I_WO) { const int li = r / I_WO; r %= I_WO; int kb = r / 16; if (kb >= 8) kb += 4; transpose_item(ain(a, I_WOUT) + (size_t)li * DM * DM, DM, DM, nullptr, (bf16*)(a.ws + WS_WOT + li * WOT_BYTES), kb, r % 16, 0, scr, lane); continue; } r -= 2 * I_WO;
        if (r < I_G) { transpose_item(ain(a, I_FG), DM, DFF, ain(a, I_FNORM), (bf16*)(a.ws + WS_WGU), r / 44, r % 44, 1, scr, lane); continue; } r -= I_G;
        if (r < I_G) { transpose_item(ain(a, I_FU), DM, DFF, ain(a, I_FNORM), (bf16*)(a.ws + WS_WGU), r / 44, r % 44, 2, scr, lane); continue; } r -= I_G;
        if (r < I_D) { transpose_item(ain(a, I_FD), DFF, DM, nullptr, (bf16*)(a.ws + WS_WD), r / 16, r % 16, 0, scr, lane); continue; } r -= I_D;
        if (r < I_G8) { transpose_item_f8(ain(a, I_FG), DM, DFF, ain(a, I_FNORM), a.ws + WS_WGU8, r / 44, r % 44, 1, scr, lane); continue; } r -= I_G8;
        if (r < I_G8) { transpose_item_f8(ain(a, I_FU), DM, DFF, ain(a, I_FNORM), a.ws + WS_WGU8, r / 44, r % 44, 2, scr, lane); continue; } r -= I_G8;
        transpose_item_f8(ain(a, I_FD), DFF, DM, nullptr, a.ws + WS_WD8, r / 16, r % 16, 0, scr, lane);
    }
    const int gt = blockIdx.x * 512 + tid, NGT = G * 512;
    for (int i = gt; i < 2 * 208 * 128; i += NGT) { const int li = i / (208 * 128), r = i % (208 * 128);
        *(v4u*)(a.ws + WS_W1T + li * W1T_BYTES + (size_t)DIN * DM * 2 + (size_t)r * 16) = (v4u){0u, 0u, 0u, 0u}; }
    for (int i = gt; i < 8 * DM; i += NGT) { const int e = i >> 10, k = i & 1023; ((float*)(a.ws + WS_RT))[i] = ain(a, I_FNORM)[DM + k] * ain(a, I_ROUTER)[k * 8 + e]; }
    for (int i = gt; i < PSEQ * 48; i += NGT) { const int p = i / 48, j = i % 48; const bool isR = j < 32; const int f = isR ? j : j - 32;
        const float inv = __builtin_amdgcn_exp2f(-(float)f * (isR ? 13.287712379549449f / 32.f : 13.287712379549449f / 16.f));
        const double rev = (double)(p - 48) * (double)inv * 0.15915494309189535; const float fr = (float)(rev - __builtin_rint(rev));
        const f32x2 cs = {__builtin_amdgcn_cosf(fr), __builtin_amdgcn_sinf(fr)};
        if (isR) ((f32x2*)(a.ws + WS_TABR))[p * 32 + f] = cs; else ((f32x2*)(a.ws + WS_TABM))[p * 16 + f] = cs; }
    for (int i = gt; i < 240 * 128; i += NGT) *(v4u*)((unsigned char*)a.out + (size_t)(MR + 16) * 2048 + (size_t)i * 16) = (v4u){0u, 0u, 0u, 0u};
    bf16* hb = (bf16*)(a.ws + WS_HB); float* stA = (float*)(a.ws + WS_STA);
    for (int rep = 0; rep < REP_HINIT; ++rep)
    for (int r = gw; r < MROWS; r += NGW) {
        f32x4 v[4]; float s = 0.f;
#pragma unroll
        for (int j = 0; j < 4; ++j) { if (r < MR) v[j] = ((const f32x4*)(ain(a, I_X) + (size_t)r * DM))[lane + 64 * j]; else if (r < MR + NMETA) v[j] = ((const f32x4*)(ain(a, I_META) + (size_t)(r - MR) * DM))[lane + 64 * j]; else v[j] = (f32x4){0.f, 0.f, 0.f, 0.f};
            s += (v[j][0] * v[j][0] + v[j][1] * v[j][1]) + (v[j][2] * v[j][2] + v[j][3] * v[j][3]); }
        s = wave_sum(s);
#pragma unroll
        for (int j = 0; j < 4; ++j) { v2u w; w.x = pk2(v[j][0], v[j][1]); w.y = pk2(v[j][2], v[j][3]); ((v2u*)(hb + (size_t)r * DM))[lane + 64 * j] = w; }
        if (lane < 16) stA[(size_t)r * 16 + lane] = lane == 0 ? s : 0.f;
    }
}

__device__ __forceinline__ int src_row(int b, int c, int i) { return c == 0 ? (i < 48 ? -1 : MR + i - 48) : b * TT + 64 * (c - 1) + i; }
__device__ __forceinline__ float lg2gamma(int h) { return h == 0 ? -0.045803689613124789f : h == 1 ? -0.022720076500083529f : h == 2 ? -0.011315313227834146f : -0.0056465631411420627f; }

__device__ __forceinline__ void route_block(const Args& a, int blk, LAS unsigned char* lds, int tid, int lane, int wave) {
    LAS float* Rs = (LAS float*)lds; LAS int* lcnt = (LAS int*)(lds + 32768); LAS int* gbase = lcnt + 8; LAS int* rec = lcnt + 16;
    gu32* ctl = (gu32*)(a.ws + WS_CTL);
    const float* Rt = (const float*)(a.ws + WS_RT); const bf16* hb = (const bf16*)(a.ws + WS_HB); const float* stB = (const float*)(a.ws + WS_STB);
    __syncthreads();
    for (int idx = tid; idx < 8 * DM; idx += 512) Rs[idx] = Rt[idx];
    if (tid < 8) lcnt[tid] = 0;
    __syncthreads();
    for (int rr = 0; rr < 16; ++rr) { const int rl = wave * 16 + rr, row = blk * 128 + rl;
        const v4u w0 = *(const v4u*)(hb + (size_t)row * DM + 8 * lane), w1 = *(const v4u*)(hb + (size_t)row * DM + 512 + 8 * lane);
        const float x[16] = {bflo(w0.x), bfhi(w0.x), bflo(w0.y), bfhi(w0.y), bflo(w0.z), bfhi(w0.z), bflo(w0.w), bfhi(w0.w), bflo(w1.x), bfhi(w1.x), bflo(w1.y), bfhi(w1.y), bflo(w1.z), bfhi(w1.z), bflo(w1.w), bfhi(w1.w)};
        { const unsigned q0 = pk4_fp8(x[0], x[1], x[2], x[3]), q1 = pk4_fp8(x[4], x[5], x[6], x[7]), q2 = pk4_fp8(x[8], x[9], x[10], x[11]), q3 = pk4_fp8(x[12], x[13], x[14], x[15]);
          unsigned char* h8 = a.ws + B_HB8 + (size_t)row * DM;
          *(uint2*)(h8 + 8 * lane) = make_uint2(q0, q1); *(uint2*)(h8 + 512 + 8 * lane) = make_uint2(q2, q3); }
        float st = lane < 16 ? stB[(size_t)row * 16 + lane] : 0.f; st = wave_sum(st); const float rs = __builtin_amdgcn_rsqf(st * (1.f / 1024.f) + EPS);
        float lg[8];
#pragma unroll
        for (int e = 0; e < 8; ++e) { float s = 0.f;
#pragma unroll
            for (int t = 0; t < 8; ++t) s += x[t] * Rs[e * DM + 8 * lane + t] + x[8 + t] * Rs[e * DM + 512 + 8 * lane + t];
            lg[e] = wave_sum(s) * rs; }
        int e0 = 0; float v0 = lg[0];
#pragma unroll
        for (int e = 1; e < 8; ++e) if (lg[e] > v0) { v0 = lg[e]; e0 = e; }
        int e1 = -1; float v1 = -3.0e38f;
#pragma unroll
        for (int e = 0; e < 8; ++e) if (e != e0 && lg[e] > v1) { v1 = lg[e]; e1 = e; }
        const float g0 = 1.f / (1.f + __expf(v1 - v0)), g1 = 1.f - g0;
        if (lane == 0) { const int lp0 = atomicAdd((int*)(lcnt + e0), 1), lp1 = atomicAdd((int*)(lcnt + e1), 1);
            rec[rl * 6] = e0; rec[rl * 6 + 1] = e1; rec[rl * 6 + 2] = lp0; rec[rl * 6 + 3] = lp1; rec[rl * 6 + 4] = __float_as_int(g0); rec[rl * 6 + 5] = __float_as_int(g1); } }
    __syncthreads();
    if (tid < 8) gbase[tid] = (int)__hip_atomic_fetch_add(ctl + CW_CNT + 64 * tid, (unsigned)lcnt[tid], RLX_AGENT);
    __syncthreads();
    if (tid < 256) { const int rl = tid >> 1, s = tid & 1, tok = blk * 128 + rl, e = rec[rl * 6 + s];
        ((int*)(a.ws + MO_TOKE))[tok * 2 + s] = e; ((int*)(a.ws + MO_TOKP))[tok * 2 + s] = gbase[e] + rec[rl * 6 + 2 + s]; ((int*)(a.ws + MO_TOKW))[tok * 2 + s] = rec[rl * 6 + 4 + s]; }
    __syncthreads();
}
__device__ __forceinline__ void moe_offsets(const Args& a, LAS int* offs, int tid) {
    gu32* ctl = (gu32*)(a.ws + WS_CTL);
    __syncthreads();
    if (tid == 0) { int o = 0;
        for (int e = 0; e < 8; ++e) { const int cnt = (int)__hip_atomic_load(ctl + CW_CNT + 64 * e, RLX_AGENT); offs[e] = o * 256; o += (cnt + 255) >> 8; }
        offs[8] = o; }
    __syncthreads();
}

typedef float f32x16 __attribute__((ext_vector_type(16)));
typedef short s16x8 __attribute__((ext_vector_type(8)));
typedef short s16x4 __attribute__((ext_vector_type(4)));
typedef short v4i16_t __attribute__((ext_vector_type(4)));
__device__ __forceinline__ int crow(int r, int hi) { return (r & 3) + 8 * (r >> 2) + 4 * hi; }


__device__ __forceinline__ void stage_cols(const bf16* proj, int b, int c, int col0, int ncols, LAS bf16* S, int sst, int lcol0, int tid) {
    const int cpr = ncols >> 3;
    for (int idx = tid; idx < 64 * cpr; idx += 512) { const int i = idx / cpr, ch = idx - i * cpr, sr = src_row(b, c, i);
        v4u v = {0u, 0u, 0u, 0u}; if (sr >= 0) v = *(const v4u*)(proj + (size_t)sr * N1 + col0 + ch * 8);
        *(LAS v4u*)(S + i * sst + lcol0 + ch * 8) = v; }
}
__device__ __forceinline__ v4u gather8(const LAS bf16* S, int sst, int row0, int col) {
    unsigned x[8];
#pragma unroll
    for (int t = 0; t < 8; ++t) x[t] = S[(row0 + t) * sst + col];
    v4u w; w.x = x[0] | (x[1] << 16); w.y = x[2] | (x[3] << 16); w.z = x[4] | (x[5] << 16); w.w = x[6] | (x[7] << 16); return w;
}
__device__ __forceinline__ void prep2_unit(const Args& a, int li, int b, int c, int part, LAS unsigned char* lds, int tid) {
    const bf16* proj = (const bf16*)(a.ws + B_PROJ);
    LAS bf16* S = (LAS bf16*)lds;
    const int blk0 = (b * NCH + c) * 4; const size_t prow0 = (size_t)b * PSEQ + 64 * c;
    unsigned char* dout = (unsigned char*)a.out;
    __syncthreads();
    if (part == 0) {
        constexpr int SST = 536; LAS float* seg = (LAS float*)(lds + 64 * SST * 2);
        stage_cols(proj, b, c, C_AQ, 128, S, SST, 0, tid); stage_cols(proj, b, c, C_AK, 128, S, SST, 128, tid); stage_cols(proj, b, c, C_ALR, 16, S, SST, 512, tid);
        __syncthreads();
        { const int ch = tid & 127, sg = tid >> 7; const float* Wg = ain(a, I_GWG) + (size_t)li * 16 * 128; const float bg = ain(a, I_GBG)[li * 128 + ch];
            float wg[16];
#pragma unroll
            for (int r = 0; r < 16; ++r) wg[r] = Wg[r * 128 + ch];
            float cl[16]; float run = 0.f;
#pragma unroll
            for (int t = 0; t < 16; ++t) { const int i = 16 * sg + t; const v4u l0 = *(const LAS v4u*)(S + i * SST + 512), l1 = *(const LAS v4u*)(S + i * SST + 520);
                float x = bg + bflo(l0.x) * wg[0] + bfhi(l0.x) * wg[1] + bflo(l0.y) * wg[2] + bfhi(l0.y) * wg[3] + bflo(l0.z) * wg[4] + bfhi(l0.z) * wg[5] + bflo(l0.w) * wg[6] + bfhi(l0.w) * wg[7]
                               + bflo(l1.x) * wg[8] + bfhi(l1.x) * wg[9] + bflo(l1.y) * wg[10] + bfhi(l1.y) * wg[11] + bflo(l1.z) * wg[12] + bfhi(l1.z) * wg[13] + bflo(l1.w) * wg[14] + bfhi(l1.w) * wg[15];
                const float ls = fminf(x, 0.f) - __logf(1.f + __expf(-fabsf(x)));
                run += (c > 0 || i >= 48) ? ls * (1.f / 16.f) : 0.f; cl[t] = run; }
            seg[sg * 128 + ch] = run;
            __syncthreads();
            float off = 0.f;
#pragma unroll
            for (int s2 = 0; s2 < 3; ++s2) off += s2 < sg ? seg[s2 * 128 + ch] : 0.f;
            if (sg == 3) ((float*)(a.ws + WS_GD))[(size_t)(blk0 + (ch >> 5)) * 32 + (ch & 31)] = __expf(off + run);
#pragma unroll
            for (int t = 0; t < 16; ++t) { const int i = 16 * sg + t; const float cum = cl[t] + off;
                S[i * SST + ch] = (bf16)f2bf(bf2f(S[i * SST + ch]) * 0.17677669529663687f * __expf(cum)); S[i * SST + 128 + ch] = (bf16)f2bf(bf2f(S[i * SST + 128 + ch]) * __expf(-cum)); } }
        __syncthreads();
        for (int idx = tid; idx < 1024; idx += 512) { const int d8 = idx & 3, i = (idx >> 2) & 63, h = idx >> 8;
            *(v4u*)(a.ws + B_GQ + (size_t)(blk0 + h) * GQ_T + i * 80 + 16 * d8) = *(const LAS v4u*)(S + i * SST + h * 32 + 8 * d8);
            *(v4u*)(a.ws + B_GK + (size_t)(blk0 + h) * GQ_T + i * 80 + 16 * d8) = *(const LAS v4u*)(S + i * SST + 128 + h * 32 + 8 * d8); }
    } else if (part == 1) {
        constexpr int SST = 776;
        stage_cols(proj, b, c, C_RQ, 256, S, SST, 0, tid); stage_cols(proj, b, c, C_RK, 256, S, SST, 256, tid);
        LAS f32x4* tabL = (LAS f32x4*)(lds + 64 * SST * 2);
        for (int idx = tid; idx < 64 * 16; idx += 512) tabL[idx] = ((const f32x4*)(a.ws + WS_TABR))[(size_t)(64 * c) * 16 + idx];
        __syncthreads();
        const LAS f32x2* tabR = (const LAS f32x2*)tabL;
        for (int idx = tid; idx < 64 * 4 * 32; idx += 512) { const int j = idx & 31, h = (idx >> 5) & 3, i = idx >> 7; const f32x2 cs = tabR[i * 32 + j];
            LAS bf16* qp = S + i * SST + h * 64 + j; LAS bf16* kp = qp + 256;
            const float a1 = bf2f(qp[0]), a2 = bf2f(qp[32]), b1 = bf2f(kp[0]), b2 = bf2f(kp[32]);
            const float e = (float)(i + 1) * lg2gamma(h); const float fq = __builtin_amdgcn_exp2f(e), fk = 0.125f * __builtin_amdgcn_exp2f(-e);
            qp[0] = (bf16)f2bf((a1 * cs[0] - a2 * cs[1]) * fq); qp[32] = (bf16)f2bf((a1 * cs[1] + a2 * cs[0]) * fq); kp[0] = (bf16)f2bf((b1 * cs[0] - b2 * cs[1]) * fk); kp[32] = (bf16)f2bf((b1 * cs[1] + b2 * cs[0]) * fk); }
        __syncthreads();
        for (int idx = tid; idx < 2048; idx += 512) { const int d8 = idx & 7, i = (idx >> 3) & 63, h = idx >> 9;
            *(v4u*)(a.ws + B_RQ + (size_t)(blk0 + h) * RT_T + i * 144 + 16 * d8) = *(const LAS v4u*)(S + i * SST + h * 64 + 8 * d8);
            *(v4u*)(a.ws + B_RK + (size_t)(blk0 + h) * RT_T + i * 144 + 16 * d8) = *(const LAS v4u*)(S + i * SST + 256 + h * 64 + 8 * d8); }
    } else if (part == 2) {
        constexpr int SST = 296, OFF_RSD = 64 * SST * 2, OFF_TAB = OFF_RSD + 512, OFF_QS = OFF_TAB + 8192, QSS = 392;
        LAS float* rsd = (LAS float*)(lds + OFF_RSD); LAS f32x4* tabL = (LAS f32x4*)(lds + OFF_TAB); LAS bf16* Qs = (LAS bf16*)(lds + OFF_QS);
        stage_cols(proj, b, c, C_CQ, 192, S, SST, 0, tid); stage_cols(proj, b, c, C_CKV, 64, S, SST, 192, tid); stage_cols(proj, b, c, C_KPE, 32, S, SST, 256, tid);
        for (int idx = tid; idx < 64 * 8; idx += 512) tabL[idx] = ((const f32x4*)(a.ws + WS_TABM))[(size_t)(64 * c) * 8 + idx];
        __syncthreads();
        { const int i = tid >> 3, g = tid & 7; float sq = 0.f, sk = 0.f;
#pragma unroll
            for (int t = 0; t < 24; ++t) { const float v = bf2f(S[i * SST + g * 24 + t]); sq += v * v; }
#pragma unroll
            for (int t = 0; t < 8; ++t) { const float v = bf2f(S[i * SST + 192 + g * 8 + t]); sk += v * v; }
            sq += __shfl_xor(sq, 1); sq += __shfl_xor(sq, 2); sq += __shfl_xor(sq, 4); sk += __shfl_xor(sk, 1); sk += __shfl_xor(sk, 2); sk += __shfl_xor(sk, 4);
            if (g == 0) { rsd[i * 2] = __builtin_amdgcn_rsqf(sq * (1.f / 192.f) + EPS); rsd[i * 2 + 1] = __builtin_amdgcn_rsqf(sk * (1.f / 64.f) + EPS); } }
        __syncthreads();
        const LAS f32x2* tabM = (const LAS f32x2*)tabL; const float QS = 0.10206207261596577f * LOG2E;
        {
            const int lane = tid & 63, w = __builtin_amdgcn_readfirstlane(tid >> 6), r32 = lane & 31, hi = lane >> 5, ib = w & 1, nb0 = (w >> 1) * 3;
            const bf16* WqaT = (const bf16*)(a.ws + WS_WQA + li * WQA_BYTES);
            s16x8 af[12];
#pragma unroll
            for (int ks = 0; ks < 12; ++ks) af[ks] = *(const LAS s16x8*)(S + (32 * ib + r32) * SST + 16 * ks + 8 * hi);
            f32x16 acc[3];
#pragma unroll
            for (int j = 0; j < 3; ++j) { acc[j] = (f32x16){};
                s16x8 bfr[12];
#pragma unroll
                for (int ks = 0; ks < 12; ++ks) bfr[ks] = *(const s16x8*)(WqaT + (size_t)(32 * (nb0 + j) + r32) * 192 + 16 * ks + 8 * hi);
#pragma unroll
                for (int ks = 0; ks < 12; ++ks) acc[j] = __builtin_amdgcn_mfma_f32_32x32x16_bf16(af[ks], bfr[ks], acc[j], 0, 0, 0); }
            asm volatile("s_nop 15\n\ts_nop 7" : "+v"(acc[0]), "+v"(acc[1]), "+v"(acc[2]));
#pragma unroll
            for (int j = 0; j < 3; ++j)
#pragma unroll
                for (int r = 0; r < 16; ++r) { const int i = 32 * ib + crow(r, hi); float v = acc[j][r] * (rsd[i * 2] * QS);
                    if (j == 2) { const float o = __shfl_xor(v, 16); const f32x2 cs = tabM[i * 16 + (r32 & 15)]; v = r32 < 16 ? v * cs[0] - o * cs[1] : o * cs[1] + v * cs[0]; }
                    Qs[i * QSS + 32 * (nb0 + j) + r32] = (bf16)f2bf(v); } }
        for (int idx = tid; idx < 64 * 12; idx += 512) { const int k8 = idx % 12, i = idx / 12; float y[8];
            if (k8 < 8) { const float s = rsd[i * 2 + 1];
#pragma unroll
                for (int t = 0; t < 8; ++t) y[t] = bf2f(S[i * SST + 192 + 8 * k8 + t]) * s; }
            else { const int kk = (k8 - 8) & 1, second = (k8 - 8) >> 1;
#pragma unroll
                for (int t = 0; t < 8; ++t) { const int j = 8 * kk + t; const f32x2 cs = tabM[i * 16 + j]; const float x1 = bf2f(S[i * SST + 256 + j]), x2 = bf2f(S[i * SST + 272 + j]); y[t] = second ? x1 * cs[1] + x2 * cs[0] : x1 * cs[0] - x2 * cs[1]; } }
            v4u w; w.x = pk2(y[0], y[1]); w.y = pk2(y[2], y[3]); w.z = pk2(y[4], y[5]); w.w = pk2(y[6], y[7]);
            *(v4u*)((bf16*)(a.ws + B_MK) + (prow0 + i) * 96 + 8 * k8) = w; }
        __syncthreads();
        for (int idx = tid; idx < 64 * 48; idx += 512) { const int c8 = idx % 48, i = idx / 48;
            *(v4u*)((bf16*)(a.ws + B_MQ) + (prow0 + i) * 384 + 8 * c8) = *(const LAS v4u*)(Qs + i * QSS + 8 * c8); }
    }
}

template <int KIND>
__device__ __forceinline__ void attn_mfma_unit(const Args& a, int li, int b, int hh, int qb  , LAS unsigned char* lds, int tid, float lam, float oscale) {
    constexpr int KW = KIND ? 64 : 96, KST = KW + 8, VST = 72, NMAP = KIND ? 2 : 1, DSTEPS = KIND ? 2 : 6;
    constexpr int KCH = KW / 8 + 1, NPIECE = KCH + (KIND ? 9 : 0), PPW = KIND ? 3 : 2, SLOT = NPIECE * 1024, NSLOT = 4, OFF_JUNK = NSLOT * SLOT, OFF_WS = OFF_JUNK + 6144, OSTW = 68, OFF_OST = KIND ? 0   : OFF_WS + 2048;
    static_assert(PPW * 8 >= NPIECE && PPW * 8 - NPIECE <= 6 && (KIND ? 8 * 32 * OSTW * 4 <= NSLOT * SLOT : OFF_OST + 8 * 32 * OSTW * 4 <= RING_BYTES) && OFF_WS + 8 * 256 <= RING_BYTES, "attention LDS map / pieces per wave");
    const int lane = tid & 63, w = __builtin_amdgcn_readfirstlane(tid >> 6), r32 = lane & 31, hi = lane >> 5;
    const int q0 = qb < 0 ? 0 : 64 + 256 * qb, NT = qb < 0 ? 1 : 5 + 4 * qb;
    const bool wact = qb >= 0 || w < 2;
    const int qpos = q0 + 32 * w + r32, wlast = (q0 + 32 * w + 31) >> 6;
    const size_t prow = (size_t)b * PSEQ + qpos;
    const bf16* proj = (const bf16*)(a.ws + B_PROJ);
    const bf16* Kg = KIND ? proj + C_DK + hh * 64 : (const bf16*)(a.ws + B_MK) + (size_t)b * PSEQ * 96;
    constexpr int KLD = KIND ? N1 : 96;
    const bf16* Vg = proj + C_DV + hh * 64;
#define ATT_SRCROW(t_, r_) (KIND ? ((t_) == 0 ? ((r_) < 48 ? MR : MR + (r_) - 48) : b * TT + 64 * ((t_) - 1) + (r_)) : 64 * (t_) + (r_))
    LAS float* wsf = (LAS float*)(lds + OFF_WS) + w * 64;
    LAS float* ost = (LAS float*)(lds + OFF_OST) + w * (32 * OSTW);
    s16x8 qf[NMAP][DSTEPS];
#pragma unroll
    for (int m = 0; m < NMAP; ++m)
#pragma unroll
        for (int ds = 0; ds < DSTEPS; ++ds) {
            const int qsr = qb >= 0 ? b * TT + qpos - 64 : (qpos >= 48 ? MR + qpos - 48 : MR);
            const bf16* qp = KIND ? proj + (size_t)qsr * N1 + C_DQ + hh * 64 + 32 * m + 16 * ds + 8 * hi : (const bf16*)(a.ws + B_MQ) + prow * 384 + hh * 96 + 16 * ds + 8 * hi;
            v4u qw = wact ? *(const v4u*)qp : (v4u){0u, 0u, 0u, 0u};
            if (KIND) { const float qs = 0.17677669529663687f * LOG2E;
                qw.x = pg8::cvt_pk_bf16(bflo(qw.x) * qs, bfhi(qw.x) * qs); qw.y = pg8::cvt_pk_bf16(bflo(qw.y) * qs, bfhi(qw.y) * qs); qw.z = pg8::cvt_pk_bf16(bflo(qw.z) * qs, bfhi(qw.z) * qs); qw.w = pg8::cvt_pk_bf16(bflo(qw.w) * qs, bfhi(qw.w) * qs); }
            qf[m][ds] = __builtin_bit_cast(s16x8, qw); }
    float mref[NMAP], lrun[NMAP]; f32x16 negm = (f32x16){}, o[NMAP][2];
#pragma unroll
    for (int m = 0; m < NMAP; ++m) { mref[m] = 0.f; lrun[m] = 0.f; o[m][0] = (f32x16){}; o[m][1] = (f32x16){}; }
#define ATT_DMA(t_) do { const int sl_ = ((t_) & 3) * SLOT; _Pragma("unroll") for (int j = 0; j < PPW; ++j) { const int p_ = __builtin_amdgcn_readfirstlane(w * PPW + j); \
        int row_, col_, dst_; const bf16* base_; int ld_; \
        if (p_ < KCH) { const int g = 64 * p_ + lane, cc = g % KCH; row_ = g / KCH; col_ = (cc < KCH - 1 ? cc : KCH - 2) * 8; dst_ = sl_ + p_ * 1024; base_ = Kg; ld_ = KLD; } \
        else if (p_ < NPIECE) { const int g = 64 * (p_ - KCH) + lane, cc = g % 9; row_ = g / 9; col_ = (cc < 8 ? cc : 7) * 8; dst_ = sl_ + p_ * 1024; base_ = Vg; ld_ = N1; } \
        else { row_ = lane & 15; col_ = 0; dst_ = OFF_JUNK + (p_ - NPIECE) * 1024; base_ = Kg; ld_ = KLD; } \
        const bf16* s_ = base_ + (size_t)ATT_SRCROW((t_), row_) * ld_ + col_; \
        __builtin_amdgcn_global_load_lds((const unsigned*)s_, (LAS unsigned*)(lds + __builtin_amdgcn_readfirstlane(dst_)), 16, 0, 0); } } while (0)
#define ATT_BAR() do { asm volatile("s_waitcnt lgkmcnt(0)" ::: "memory"); __builtin_amdgcn_s_barrier(); asm volatile("" ::: "memory"); } while (0)
    ATT_BAR();
    if (w >= 4) __builtin_amdgcn_s_setprio(1);
    ATT_DMA(0); if (NT > 1) ATT_DMA(1); if (NT > 2) ATT_DMA(2);
    for (int t = 0; t < NT; ++t) {
        if (t + 2 < NT) { if (KIND) asm volatile("s_waitcnt vmcnt(6)" ::: "memory"); else asm volatile("s_waitcnt vmcnt(4)" ::: "memory"); } else if (t + 1 < NT) { if (KIND) asm volatile("s_waitcnt vmcnt(3)" ::: "memory"); else asm volatile("s_waitcnt vmcnt(2)" ::: "memory"); } else asm volatile("s_waitcnt vmcnt(0)" ::: "memory");
        ATT_BAR();
        if (t + 3 < NT) ATT_DMA(t + 3);
        if (wact && t <= wlast) {
            const LAS unsigned char* Kb = lds + (t & 3) * SLOT; const LAS unsigned char* Vb = KIND ? Kb + KCH * 1024 : Kb;
            const bool need_mask = (t == 0) || (64 * t + 63 > q0 + 32 * w);
            constexpr int VRB = KIND ? 144 : KST * 2;
            const LAS unsigned char* vp0 = Vb + (4 * hi + ((lane & 15) >> 2)) * VRB + (16 * ((lane >> 4) & 1)) * 2 + 8 * (lane & 3);
#define ATT_VFRAG(d0_, ks_) ({ const LAS unsigned char* vp_ = vp0 + 16 * (ks_) * VRB + 64 * (d0_); \
        const s16x4 va_ = __builtin_bit_cast(s16x4, __builtin_amdgcn_ds_read_tr16_b64_v4i16((LAS v4i16_t*)vp_)), vb_ = __builtin_bit_cast(s16x4, __builtin_amdgcn_ds_read_tr16_b64_v4i16((LAS v4i16_t*)(vp_ + 8 * VRB))); \
        (s16x8){va_[0], va_[1], va_[2], va_[3], vb_[0], vb_[1], vb_[2], vb_[3]}; })
            s16x8 vfr0[4];
#pragma unroll
            for (int ks = 0; ks < 4; ++ks) vfr0[ks] = ATT_VFRAG(0, ks);
            __builtin_amdgcn_sched_barrier(0);
#pragma unroll
            for (int m = 0; m < NMAP; ++m) {
                f32x16 p0, p1;
                if (KIND) { const float nm = -mref[m];
#pragma unroll
                    for (int r = 0; r < 16; ++r) { p0[r] = nm; p1[r] = nm; } }
                else { p0 = negm; p1 = negm; }
                constexpr int KBATCH = KIND ? DSTEPS : 3;
#pragma unroll
                for (int d1 = 0; d1 < DSTEPS; d1 += KBATCH) {
                    s16x8 kfr[KBATCH][2];
#pragma unroll
                    for (int ds = 0; ds < KBATCH; ++ds) { kfr[ds][0] = *(const LAS s16x8*)(Kb + (r32 * KST + 32 * m * KIND + 16 * (d1 + ds) + 8 * hi) * 2); kfr[ds][1] = *(const LAS s16x8*)(Kb + ((32 + r32) * KST + 32 * m * KIND + 16 * (d1 + ds) + 8 * hi) * 2); }
                    __builtin_amdgcn_sched_barrier(0);

#pragma unroll
                    for (int ds = 0; ds < KBATCH; ++ds) { p0 = __builtin_amdgcn_mfma_f32_32x32x16_bf16(kfr[ds][0], qf[m][d1 + ds], p0, 0, 0, 0); p1 = __builtin_amdgcn_mfma_f32_32x32x16_bf16(kfr[ds][1], qf[m][d1 + ds], p1, 0, 0, 0); }

                    __builtin_amdgcn_sched_barrier(0); }
                asm volatile("s_nop 15\n\ts_nop 7" : "+v"(p0), "+v"(p1));

                if (need_mask) {
#pragma unroll
                    for (int r = 0; r < 16; ++r) { const int kv = 64 * t + crow(r, hi);
                        if (kv > qpos || kv < 48) p0[r] = -1e30f;
                        if (kv + 32 > qpos || kv + 32 < 48) p1[r] = -1e30f; } }
                float mx = fmaxf(fmaxf(p0[0], p1[0]), fmaxf(p0[1], p1[1]));
#pragma unroll
                for (int r = 2; r < 16; r += 2) mx = fmaxf(mx, fmaxf(fmaxf(p0[r], p1[r]), fmaxf(p0[r + 1], p1[r + 1])));
                { auto rr = __builtin_amdgcn_permlane32_swap(__float_as_uint(mx), __float_as_uint(mx), false, false); mx = fmaxf(__uint_as_float(rr[0]), __uint_as_float(rr[1])); }
                if (t == 0 || __any(mx > 6.0f)) {
                    const float delta = t == 0 ? mx : fmaxf(mx, 0.f); mref[m] += delta;
#pragma unroll
                    for (int r = 0; r < 16; ++r) { p0[r] -= delta; p1[r] -= delta; if (!KIND) negm[r] = -mref[m]; }
                    if (t != 0) { const float alpha = __builtin_amdgcn_exp2f(-delta); lrun[m] *= alpha;
                        if (hi == 0) wsf[r32] = alpha;
                        f32x4 al[4];
#pragma unroll
                        for (int g = 0; g < 4; ++g) al[g] = *(const LAS f32x4*)(wsf + 8 * g + 4 * hi);
#pragma unroll
                        for (int r = 0; r < 16; ++r) { o[m][0][r] *= al[r >> 2][r & 3]; o[m][1][r] *= al[r >> 2][r & 3]; } } }
                float ls = 0.f;
#pragma unroll
                for (int r = 0; r < 16; ++r) { p0[r] = __builtin_amdgcn_exp2f(p0[r]); p1[r] = __builtin_amdgcn_exp2f(p1[r]); ls += p0[r] + p1[r]; }
                lrun[m] += ls;
                s16x8 pw[4];
#pragma unroll
                for (int ks = 0; ks < 4; ++ks) { v4u u;
                    if (ks < 2) { u.x = pg8::cvt_pk_bf16(p0[8 * ks], p0[8 * ks + 1]); u.y = pg8::cvt_pk_bf16(p0[8 * ks + 2], p0[8 * ks + 3]); u.z = pg8::cvt_pk_bf16(p0[8 * ks + 4], p0[8 * ks + 5]); u.w = pg8::cvt_pk_bf16(p0[8 * ks + 6], p0[8 * ks + 7]); }
                    else { const int k2 = ks - 2; u.x = pg8::cvt_pk_bf16(p1[8 * k2], p1[8 * k2 + 1]); u.y = pg8::cvt_pk_bf16(p1[8 * k2 + 2], p1[8 * k2 + 3]); u.z = pg8::cvt_pk_bf16(p1[8 * k2 + 4], p1[8 * k2 + 5]); u.w = pg8::cvt_pk_bf16(p1[8 * k2 + 6], p1[8 * k2 + 7]); }
                    pw[ks] = __builtin_bit_cast(s16x8, u); }

#pragma unroll
                for (int ks = 0; ks < 4; ++ks) o[m][0] = __builtin_amdgcn_mfma_f32_32x32x16_bf16(pw[ks], vfr0[ks], o[m][0], 0, 0, 0);

                { s16x8 vfr1[4];
#pragma unroll
                    for (int ks = 0; ks < 4; ++ks) vfr1[ks] = ATT_VFRAG(1, ks);
                    __builtin_amdgcn_sched_barrier(0);

#pragma unroll
                    for (int ks = 0; ks < 4; ++ks) o[m][1] = __builtin_amdgcn_mfma_f32_32x32x16_bf16(pw[ks], vfr1[ks], o[m][1], 0, 0, 0); }

            }
        }
    }
#undef ATT_DMA
#undef ATT_VFRAG
#undef ATT_SRCROW
    __builtin_amdgcn_s_setprio(0);
    ATT_BAR();
    if (KIND) { const LAS float* lp = (const LAS float*)(lds + RING_BYTES + 256); lam = lp[0]; oscale = lp[1]; }
    if (wact) {
#pragma unroll
        for (int m = 0; m < NMAP; ++m) asm volatile("s_nop 15\n\ts_nop 7" : "+v"(o[m][0]), "+v"(o[m][1]));
        float il0, il1 = 0.f;
        { float l = lrun[0]; l += __shfl_xor(l, 32); il0 = l > 0.f ? 1.f / l : 0.f; }
        if (KIND) { float l = lrun[NMAP - 1]; l += __shfl_xor(l, 32); il1 = l > 0.f ? lam / l : 0.f; }
        if (hi == 0) { wsf[r32] = il0; wsf[32 + r32] = il1; }
        f32x4 a0[4], a1[4];
#pragma unroll
        for (int g = 0; g < 4; ++g) { a0[g] = *(const LAS f32x4*)(wsf + 8 * g + 4 * hi); a1[g] = *(const LAS f32x4*)(wsf + 32 + 8 * g + 4 * hi); }
#pragma unroll
        for (int d0 = 0; d0 < 2; ++d0)
#pragma unroll
            for (int r = 0; r < 16; ++r) { float v = o[0][d0][r] * a0[r >> 2][r & 3]; if (KIND) v -= o[NMAP - 1][d0][r] * a1[r >> 2][r & 3];
                ost[crow(r, hi) * OSTW + 32 * d0 + r32] = v; }
        const int row = lane >> 1, half = lane & 1, p = q0 + 32 * w + row;
        f32x4 v[8]; float ss = 0.f;
#pragma unroll
        for (int i = 0; i < 8; ++i) { v[i] = *(const LAS f32x4*)(ost + row * OSTW + 32 * half + 4 * i); ss += (v[i][0] * v[i][0] + v[i][1] * v[i][1]) + (v[i][2] * v[i][2] + v[i][3] * v[i][3]); }
        ss += __shfl_xor(ss, 1);
        const float rs = KIND ? __builtin_amdgcn_rsqf(ss * (1.f / 64.f) + EPS) * oscale : 1.f;
        const int sr = qb >= 0 ? b * TT + p - 64 : ((p >= 48 && b == 0) ? MR + p - 48 : -1);
        if (sr >= 0) { bf16* dst = (bf16*)a.out + (size_t)sr * DM + (KIND ? 768 : 512) + hh * 64 + 32 * half; const float* gn = ain(a, I_DNORM) + li * 64 + 32 * half;
#pragma unroll
            for (int i = 0; i < 4; ++i) { f32x4 x0 = v[2 * i] * rs, x1 = v[2 * i + 1] * rs;
                if (KIND) { const f32x4 g0 = *(const f32x4*)(gn + 8 * i), g1 = *(const f32x4*)(gn + 8 * i + 4); x0 = x0 * g0; x1 = x1 * g1; }
                *(v4u*)(dst + 8 * i) = pack8(x0, x1); } }
    }
    ATT_BAR();
#undef ATT_BAR
}

__device__ __forceinline__ s16x8 ldperm(const bf16* p, int hi) { const s16x4 x = *(const s16x4*)(p + 4 * hi), y = *(const s16x4*)(p + 8 + 4 * hi); return (s16x8){x[0], x[1], x[2], x[3], y[0], y[1], y[2], y[3]}; }
__device__ __forceinline__ s16x8 packacc(const f32x16& v, int k) { v4u u; u.x = pg8::cvt_pk_bf16(v[8 * k], v[8 * k + 1]); u.y = pg8::cvt_pk_bf16(v[8 * k + 2], v[8 * k + 3]); u.z = pg8::cvt_pk_bf16(v[8 * k + 4], v[8 * k + 5]); u.w = pg8::cvt_pk_bf16(v[8 * k + 6], v[8 * k + 7]); return __builtin_bit_cast(s16x8, u); }
__device__ __forceinline__ s16x8 ldperm_lds(const LAS unsigned char* p, int hi) { const s16x4 x = *(const LAS s16x4*)(p + 8 * hi), y = *(const LAS s16x4*)(p + 16 + 8 * hi); return (s16x8){x[0], x[1], x[2], x[3], y[0], y[1], y[2], y[3]}; }
template <int KIND>
__device__ __forceinline__ void lin_mfma_unit(const Args& a, int li, int b, int hp, LAS unsigned char* lds, int tid) {
    constexpr int DK = KIND ? 64 : 32, NDS = DK / 16, NDB = DK / 32, OTW = 68;
    constexpr int QROW = KIND ? 144 : 80, QT = KIND ? RT_T : GQ_T, HB = 2 * QT + VT_T, PPH = HB / 1024, NP = 2 * PPH;
    constexpr int OFF_OT = 2 * HB, OFF_G = OFF_OT + 2 * 64 * OTW * 4;
    static_assert(HB % 1024 == 0 && OFF_G + 256 <= RING_BYTES, "lin unit LDS map");
    const int lane = tid & 63, w = __builtin_amdgcn_readfirstlane(tid >> 6), r32 = lane & 31, hi = lane >> 5, hl = w >> 2, e0 = 32 * ((w >> 1) & 1), ib = w & 1, h = 2 * hp + hl;
    const unsigned char* Qg = a.ws + (KIND ? B_RQ : B_GQ); const unsigned char* Kg = a.ws + (KIND ? B_RK : B_GK);
    const bf16* proj = (const bf16*)(a.ws + B_PROJ); bf16* ob = (bf16*)a.out;
    LAS float* Ot = (LAS float*)(lds + OFF_OT);
    LAS float* Gs = (LAS float*)(lds + OFF_G);
    const LAS unsigned char* Lh = lds + hl * HB;
    const float dret = __builtin_amdgcn_exp2f(64.f * lg2gamma(h));
    f32x16 S[NDB];
#pragma unroll
    for (int db = 0; db < NDB; ++db) S[db] = (f32x16){};
#define LIN_DMA(c_) do { _Pragma("unroll") for (int j_ = 0; j_ < (NP + 7) / 8; ++j_) { const int p_ = w + 8 * j_; if (p_ < NP) { const int hl_ = p_ / PPH, pp_ = p_ % PPH; const size_t blk_ = (size_t)(b * NCH + (c_)) * 4 + 2 * hp + hl_; \
        const unsigned char* src_; \
        if (pp_ < 2 * QT / 1024) src_ = (pp_ < QT / 1024 ? Qg + blk_ * QT + pp_ * 1024 : Kg + blk_ * QT + (pp_ - QT / 1024) * 1024) + lane * 16; \
        else { const int g_ = 64 * (pp_ - 2 * QT / 1024) + lane, s_ = g_ / 9, cc_ = g_ % 9; int sr_ = src_row(b, (c_), s_); sr_ = sr_ < 0 ? MR : sr_;     \
            src_ = (const unsigned char*)(proj + (size_t)sr_ * N1 + (KIND ? C_RV : C_AV) + (2 * hp + hl_) * 64 + (cc_ < 8 ? cc_ : 7) * 8); } \
        __builtin_amdgcn_global_load_lds((const unsigned*)src_, (LAS unsigned*)(lds + hl_ * HB + pp_ * 1024), 16, 0, 0); } } } while (0)
#define LIN_BAR() do { asm volatile("s_waitcnt lgkmcnt(0)" ::: "memory"); __builtin_amdgcn_s_barrier(); asm volatile("" ::: "memory"); } while (0)
    LIN_BAR();
    if (tid < 64) Gs[tid] = ain(a, KIND ? I_RNORM : I_GNORM)[li * 64 + tid];
    LIN_DMA(0);
    const int nh = tid >> 8, nrow = (tid >> 2) & 63, nq = tid & 3, hn = 2 * hp + nh;
    for (int c = 0; c < NCH; ++c) {
        asm volatile("s_waitcnt vmcnt(0)" ::: "memory"); LIN_BAR();
        s16x8 qf[NDS], kf0[NDS], kf1[NDS], vf[4], ktf[NDB][4];
        const int sr = src_row(b, c, nrow); const bool wr = sr >= 0 && (c > 0 || b == 0);
#pragma unroll
        for (int ds = 0; ds < NDS; ++ds) { qf[ds] = ldperm_lds(Lh + (32 * ib + r32) * QROW + 32 * ds, hi); kf0[ds] = ldperm_lds(Lh + QT + r32 * QROW + 32 * ds, hi); kf1[ds] = ldperm_lds(Lh + QT + (32 + r32) * QROW + 32 * ds, hi); }
        const int trq = (lane & 15) >> 2, trb = (lane >> 4) & 1, trp = lane & 3;
#pragma unroll
        for (int ks = 0; ks < 4; ++ks) { const LAS unsigned char* vp = Lh + 2 * QT + (16 * ks + 4 * hi + trq) * 144 + (e0 + 16 * trb) * 2 + 8 * trp;
            const s16x4 va = __builtin_bit_cast(s16x4, __builtin_amdgcn_ds_read_tr16_b64_v4i16((LAS v4i16_t*)vp)), vb = __builtin_bit_cast(s16x4, __builtin_amdgcn_ds_read_tr16_b64_v4i16((LAS v4i16_t*)(vp + 8 * 144)));
            vf[ks] = (s16x8){va[0], va[1], va[2], va[3], vb[0], vb[1], vb[2], vb[3]}; }
        f32x16 aA = (f32x16){}, aB = (f32x16){};
#pragma unroll
        for (int ds = 0; ds < NDS; ++ds) { aA = __builtin_amdgcn_mfma_f32_32x32x16_bf16(kf0[ds], qf[ds], aA, 0, 0, 0); if (ib) aB = __builtin_amdgcn_mfma_f32_32x32x16_bf16(kf1[ds], qf[ds], aB, 0, 0, 0); }
        asm volatile("s_nop 15\n\ts_nop 15" : "+v"(aA), "+v"(aB));
#pragma unroll
        for (int r = 0; r < 16; ++r) if (crow(r, hi) > r32) { if (ib) aB[r] = 0.f; else aA[r] = 0.f; }
        f32x16 O = (f32x16){};
#pragma unroll
        for (int db = 0; db < NDB; ++db)
#pragma unroll
            for (int ksub = 0; ksub < 2; ++ksub) O = __builtin_amdgcn_mfma_f32_32x32x16_bf16(qf[2 * db + ksub], packacc(S[db], ksub), O, 0, 0, 0);
#pragma unroll
        for (int ksub = 0; ksub < 2; ++ksub) { O = __builtin_amdgcn_mfma_f32_32x32x16_bf16(packacc(aA, ksub), vf[ksub], O, 0, 0, 0); if (ib) O = __builtin_amdgcn_mfma_f32_32x32x16_bf16(packacc(aB, ksub), vf[2 + ksub], O, 0, 0, 0); }
#pragma unroll
        for (int db = 0; db < NDB; ++db)
#pragma unroll
            for (int ks = 0; ks < 4; ++ks) { const LAS unsigned char* kp = Lh + QT + (16 * ks + 4 * hi + trq) * QROW + (32 * db + 16 * trb) * 2 + 8 * trp;
                const s16x4 ka = __builtin_bit_cast(s16x4, __builtin_amdgcn_ds_read_tr16_b64_v4i16((LAS v4i16_t*)kp)), kb = __builtin_bit_cast(s16x4, __builtin_amdgcn_ds_read_tr16_b64_v4i16((LAS v4i16_t*)(kp + 8 * QROW)));
                ktf[db][ks] = (s16x8){ka[0], ka[1], ka[2], ka[3], kb[0], kb[1], kb[2], kb[3]}; }
        LIN_BAR();
        v4u og[2];
#pragma unroll
        for (int i = 0; i < 2; ++i) og[i] = wr ? *(const v4u*)(proj + (size_t)sr * N1 + (KIND ? C_ROG : C_AOG) + hn * 64 + 16 * nq + 8 * i) : (v4u){0u, 0u, 0u, 0u};
        f32x4 dvv[4];
        if (!KIND) { const float* dp = (const float*)(a.ws + WS_GD) + ((size_t)(b * NCH + c) * 4 + h) * 32;
#pragma unroll
            for (int g = 0; g < 4; ++g) dvv[g] = *(const f32x4*)(dp + 8 * g + 4 * hi); }
        if (c + 1 < NCH) LIN_DMA(c + 1);
#pragma unroll
        for (int db = 0; db < NDB; ++db) {
#pragma unroll
            for (int ks = 0; ks < 4; ++ks) S[db] = __builtin_amdgcn_mfma_f32_32x32x16_bf16(ktf[db][ks], vf[ks], S[db], 0, 0, 0); }
        asm volatile("s_nop 15\n\ts_nop 15" : "+v"(O));
#pragma unroll
        for (int db = 0; db < NDB; ++db) asm volatile("s_nop 15\n\ts_nop 15" : "+v"(S[db]));
#pragma unroll
        for (int db = 0; db < NDB; ++db) {
            if (KIND) { S[db] = S[db] * dret; }
            else {
#pragma unroll
                for (int g = 0; g < 4; ++g) { S[db][4 * g] *= dvv[g][0]; S[db][4 * g + 1] *= dvv[g][1]; S[db][4 * g + 2] *= dvv[g][2]; S[db][4 * g + 3] *= dvv[g][3]; } } }
#pragma unroll
        for (int r = 0; r < 16; ++r) Ot[(hl * 64 + 32 * ib + crow(r, hi)) * OTW + e0 + r32] = O[r];
        LIN_BAR();
        { f32x4 v[4]; float s1 = 0.f;
#pragma unroll
            for (int i = 0; i < 4; ++i) { v[i] = *(const LAS f32x4*)(Ot + (nh * 64 + nrow) * OTW + 16 * nq + 4 * i); s1 += (v[i][0] + v[i][1]) + (v[i][2] + v[i][3]); }
            float mean = 0.f; if (KIND) { s1 += __shfl_xor(s1, 1); s1 += __shfl_xor(s1, 2); mean = s1 * (1.f / 64.f); }
            float s2 = 0.f;
#pragma unroll
            for (int i = 0; i < 4; ++i) { v[i] = v[i] - mean; s2 += (v[i][0] * v[i][0] + v[i][1] * v[i][1]) + (v[i][2] * v[i][2] + v[i][3] * v[i][3]); }
            s2 += __shfl_xor(s2, 1); s2 += __shfl_xor(s2, 2);
            const float rs = __builtin_amdgcn_rsqf(s2 * (1.f / 64.f) + EPS);
            if (wr) { bf16* dst = ob + (size_t)sr * DM + KIND * 256 + hn * 64 + 16 * nq; const LAS float* gp = Gs + 16 * nq;
#pragma unroll
                for (int i = 0; i < 2; ++i) { const v4u g4 = og[i]; const f32x4 g0 = *(const LAS f32x4*)(gp + 8 * i), g1 = *(const LAS f32x4*)(gp + 8 * i + 4);
                    f32x4 x0 = v[2 * i] * rs * g0, x1 = v[2 * i + 1] * rs * g1;
                    x0[0] *= silu_f(bflo(g4.x)); x0[1] *= silu_f(bfhi(g4.x)); x0[2] *= silu_f(bflo(g4.y)); x0[3] *= silu_f(bfhi(g4.y)); x1[0] *= silu_f(bflo(g4.z)); x1[1] *= silu_f(bfhi(g4.z)); x1[2] *= silu_f(bflo(g4.w)); x1[3] *= silu_f(bfhi(g4.w));
                    *(v4u*)(dst + 8 * i) = pack8(x0, x1); } } }
        LIN_BAR();
    }
    asm volatile("s_waitcnt vmcnt(0)" ::: "memory");
#undef LIN_DMA
#undef LIN_BAR
}

template <int MODE, int KSTEPS  >
__device__ __forceinline__ void thin_unit(const bf16* A, int lda, const bf16* Bt, int u, bf16* H, float* stats_out, const float* stats_in, bf16* ACT, LAS unsigned char* lds, int tid) {
    constexpr int K = KSTEPS * 256;
    const int lane = tid & 63, w = __builtin_amdgcn_readfirstlane(tid >> 6), fr = lane & 15, fq = lane >> 4;
    int brow[4];
#pragma unroll
    for (int nb = 0; nb < 4; ++nb) brow[nb] = MODE != 1 ? 64 * u + 16 * nb + fr : 256 * (u >> 2) + 32 * (u & 3) + (nb >> 1) * 128 + 16 * (nb & 1) + fr;
    f32x4 acc[4];
#pragma unroll
    for (int nb = 0; nb < 4; ++nb) acc[nb] = (f32x4){0.f, 0.f, 0.f, 0.f};
    const bf16* ap = A + (size_t)fr * lda + w * (KSTEPS * 32) + 8 * fq;
    constexpr int B1 = KSTEPS > 6 ? 6 : KSTEPS;
    { s16x8 af[B1], bf[B1][4];
#pragma unroll
        for (int s = 0; s < B1; ++s) { af[s] = *(const s16x8*)(ap + 32 * s);
#pragma unroll
            for (int nb = 0; nb < 4; ++nb) bf[s][nb] = *(const s16x8*)(Bt + (size_t)brow[nb] * K + w * (KSTEPS * 32) + 32 * s + 8 * fq); }
#pragma unroll
        for (int s = 0; s < B1; ++s)
#pragma unroll
            for (int nb = 0; nb < 4; ++nb) acc[nb] = __builtin_amdgcn_mfma_f32_16x16x32_bf16(bf[s][nb], af[s], acc[nb], 0, 0, 0); }
    if (KSTEPS > B1) { constexpr int B2 = KSTEPS > B1 ? KSTEPS - B1 : 1; s16x8 af[B2], bf[B2][4];
#pragma unroll
        for (int s = 0; s < B2; ++s) { af[s] = *(const s16x8*)(ap + 32 * (B1 + s));
#pragma unroll
            for (int nb = 0; nb < 4; ++nb) bf[s][nb] = *(const s16x8*)(Bt + (size_t)brow[nb] * K + w * (KSTEPS * 32) + 32 * (B1 + s) + 8 * fq); }
#pragma unroll
        for (int s = 0; s < B2; ++s)
#pragma unroll
            for (int nb = 0; nb < 4; ++nb) acc[nb] = __builtin_amdgcn_mfma_f32_16x16x32_bf16(bf[s][nb], af[s], acc[nb], 0, 0, 0); }
    asm volatile("s_nop 15" : "+v"(acc[0]), "+v"(acc[1]), "+v"(acc[2]), "+v"(acc[3]));
    LAS f32x4* part = (LAS f32x4*)lds;
    __syncthreads();
#pragma unroll
    for (int nb = 0; nb < 4; ++nb) part[(w * 4 + nb) * 64 + lane] = acc[nb];
    __syncthreads();
    if (w == 0) {
#pragma unroll
        for (int nb = 0; nb < 4; ++nb) {
#pragma unroll
            for (int w2 = 1; w2 < 8; ++w2) acc[nb] = acc[nb] + part[(w2 * 4 + nb) * 64 + lane]; }
        const int row = MR + fr;
        if (MODE == 0) { float ss = 0.f;
#pragma unroll
            for (int nb = 0; nb < 4; ++nb) { bf16* p = H + (size_t)row * DM + 64 * u + 16 * nb + 4 * fq; const v2u wv = *(const v2u*)p;
                const float x0 = acc[nb][0] + bflo(wv.x), x1 = acc[nb][1] + bfhi(wv.x), x2 = acc[nb][2] + bflo(wv.y), x3 = acc[nb][3] + bfhi(wv.y);
                ss += (x0 * x0 + x1 * x1) + (x2 * x2 + x3 * x3);
                v2u o; o.x = pg8::cvt_pk_bf16(x0, x1); o.y = pg8::cvt_pk_bf16(x2, x3); *(v2u*)p = o; }
            ss += __shfl_xor(ss, 16); ss += __shfl_xor(ss, 32);
            if (fq == 0) stats_out[(size_t)row * 16 + u] = ss;
        } else if (MODE == 2) { const f32x4* sp = (const f32x4*)(stats_in + (size_t)row * 16); const f32x4 s0 = sp[0], s1 = sp[1], s2 = sp[2], s3 = sp[3];
            const float st = ((s0[0] + s0[1]) + (s0[2] + s0[3])) + ((s1[0] + s1[1]) + (s1[2] + s1[3])) + ((s2[0] + s2[1]) + (s2[2] + s2[3])) + ((s3[0] + s3[1]) + (s3[2] + s3[3]));
            const float rs = __builtin_amdgcn_rsqf(st * (1.f / 1024.f) + EPS);
#pragma unroll
            for (int nb = 0; nb < 4; ++nb) { v2u o; o.x = pg8::cvt_pk_bf16(acc[nb][0] * rs, acc[nb][1] * rs); o.y = pg8::cvt_pk_bf16(acc[nb][2] * rs, acc[nb][3] * rs);
                *(v2u*)(ACT + (size_t)row * N1 + 64 * u + 16 * nb + 4 * fq) = o; }
        } else { const f32x4* sp = (const f32x4*)(stats_in + (size_t)row * 16); const f32x4 s0 = sp[0], s1 = sp[1], s2 = sp[2], s3 = sp[3];
            const float st = ((s0[0] + s0[1]) + (s0[2] + s0[3])) + ((s1[0] + s1[1]) + (s1[2] + s1[3])) + ((s2[0] + s2[1]) + (s2[2] + s2[3])) + ((s3[0] + s3[1]) + (s3[2] + s3[3]));
            const float rs = __builtin_amdgcn_rsqf(st * (1.f / 1024.f) + EPS);
#pragma unroll
            for (int nb = 0; nb < 2; ++nb) { float y[4];
#pragma unroll
                for (int t = 0; t < 4; ++t) y[t] = silu_f(acc[nb][t] * rs) * (acc[2 + nb][t] * rs);
                v2u o; o.x = pg8::cvt_pk_bf16(y[0], y[1]); o.y = pg8::cvt_pk_bf16(y[2], y[3]);
                *(v2u*)(ACT + (size_t)row * DFF + 128 * (u >> 2) + 32 * (u & 3) + 16 * nb + 4 * fq) = o; } }
    }
    __syncthreads();
}

#ifndef REP_PREP
#define REP_PREP 1
#endif
#ifndef REP_MIX
#define REP_MIX 1
#endif
#ifndef REP_P0
#define REP_P0 1
#endif
#ifndef REP_CONV
#define REP_CONV 1
#endif
#ifndef REP_G1
#define REP_G1 1
#endif
#ifndef REP_MGU
#define REP_MGU 1
#endif
#ifndef REP_MDN
#define REP_MDN 1
#endif
#ifndef REP_BAR
#define REP_BAR 0
#endif
#ifndef REP_PART
#define REP_PART -1
#endif
#ifndef REP_FGU
#define REP_FGU 1
#endif
#ifndef MK_ONE_LAUNCH
#define MK_ONE_LAUNCH 1
#endif
constexpr int NPHASE = 18;
constexpr int CW_Q = 12288;
__global__ void __launch_bounds__(512, 2) mega_fwd(Args a) {
    extern __shared__ __attribute__((aligned(16))) unsigned char lds_raw[];
    LAS unsigned char* lds = (LAS unsigned char*)lds_raw;
    volatile LAS unsigned* MISC = (volatile LAS unsigned*)(lds + MISC_OFF);
    int wave = __builtin_amdgcn_readfirstlane((int)threadIdx.x >> 6); asm volatile("" : "+s"(wave));
    const int G = gridDim.x;
#define TID() ((wave << 6) + lane_id())
    for (int u = TID(); u < (LDS_BYTES - RING_BYTES) / 4; u += 512) ((LAS unsigned*)(lds + RING_BYTES))[u] = 0u;
    __syncthreads();
    gu32* ctl = (gu32*)(a.ws + WS_CTL);
    const int lo = a.ph_lo, hi = a.ph_hi;
    XcdBarrier bar; bar.bar = (unsigned*)(ctl + CW_BAR); bar.x = 0; bar.st = nullptr;
    if (hi - lo > 1) bar = xcd_barrier_post((unsigned*)(ctl + CW_BAR), MISC + 8, TID() == 0);
#define IN(k) (lo <= (k) && (k) < hi)
#define OPQ() int ptid = TID(); asm volatile("" : "+v"(ptid)); const int plane = ptid & 63; (void)plane
#define SEAM(k) do { if (IN(k) && IN((k) + 1)) xcd_barrier(bar, TID() == 0); } while (0)
#define hb ((bf16*)(a.ws + WS_HB))
#define stA ((float*)(a.ws + WS_STA))
#define stB ((float*)(a.ws + WS_STB))

    for (int rep = 0; rep < REP_BAR; ++rep) xcd_barrier(bar, TID() == 0);
    if (IN(0)) { OPQ(); for (int rep = 0; rep < REP_P0; ++rep) { p0_prologue(a, lds, ptid, plane, wave); __syncthreads(); } }
    SEAM(0);

    for (int li = 0; li < 2; ++li) {
        const int pb = 1 + 6 * li;
        if (IN(pb)) {
            { OPQ(); for (int u = blockIdx.x; u < N1 / 64; u += G) thin_unit<2, 4>(hb + (size_t)MR * DM, DM, (const bf16*)(a.ws + WS_W1T + li * W1T_BYTES), u, nullptr, nullptr, stA, (bf16*)(a.ws + B_PROJ), lds, ptid); }
            pg8::Gemm g{hb, (const bf16*)(a.ws + WS_W1T + li * W1T_BYTES), DM, 0, nullptr}; pg8::StaticOrder S; S.init(NPAN - 1, N1 / 256, G, (int)blockIdx.x);
            EpiProj E{(bf16*)(a.ws + B_PROJ), stA};
            for (int rep = 0; rep < REP_G1; ++rep) pg8::gemm_phase<EpiProj, pg8::StaticOrder, false>(lds, g, S, E, wave);
        }
        SEAM(pb);
        if (IN(pb + 1)) { OPQ(); for (int rep = 0; rep < REP_PREP; ++rep) for (int u = blockIdx.x; u < NB * NCH * 3; u += G) { const int part = u % 3;     if (rep > 0 && REP_PART >= 0 && part != REP_PART) continue; int ut = ptid; asm volatile("" : "+v"(ut)); prep2_unit(a, li, (u / 3) / NCH, (u / 3) % NCH, part, lds, ut); } __syncthreads(); }
        SEAM(pb + 1);
        if (IN(pb + 2)) {
            OPQ(); const int tid = ptid;
            LAS int* qid = (LAS int*)(lds + RING_BYTES + 64);
            float lam, lam_init; { const float* lv = ain(a, I_DLAM) + li * 128; float s01 = 0.f, s23 = 0.f;
                for (int d = 0; d < 32; ++d) { s01 += lv[d] * lv[32 + d]; s23 += lv[64 + d] * lv[96 + d]; }
                lam_init = 0.8f - 0.6f * __expf(-0.3f * (float)li); lam = __expf(s01) - __expf(s23) + lam_init;
                if (tid == 0) { LAS float* lp = (LAS float*)(lds + RING_BYTES + 256); lp[0] = lam; lp[1] = 1.f - lam_init; } }
            for (int rep = 0; rep < REP_MIX; ++rep)
            for (;;) {
                __syncthreads();
                if (tid == 0) *qid = (int)__hip_atomic_fetch_add(ctl + CW_Q + 64 * (li + 2 * rep), 1u, RLX_AGENT);
                __syncthreads();
                const int id = *qid;
                int utid = ptid; asm volatile("" : "+v"(utid));
                if (id >= 64 + 1024 + 8) break;
                if (id < 64) { if ((id & 1) == 0) lin_mfma_unit<0>(a, li, (id >> 1) & 15, id >> 5, lds, utid); else lin_mfma_unit<1>(a, li, (id >> 1) & 15, id >> 5, lds, utid); }
                else { const int v = id - 64; int qb, kind, b, hh;
                    if (v < 1024) { qb = 7 - (v >> 7); const int rem = v & 127; kind = rem >> 6; b = (rem >> 2) & 15; hh = rem & 3; } else { qb = -1; kind = (v - 1024) >> 2; b = 0; hh = v & 3; }
                    if (kind == 0) attn_mfma_unit<0>(a, li, b, hh, qb, lds, utid, 0.f, 1.f); else attn_mfma_unit<1>(a, li, b, hh, qb, lds, utid, 0.f, 0.f); }
            }
        }
        SEAM(pb + 2);
        if (IN(pb + 3)) {
            if (li == 0) { OPQ(); for (int u = blockIdx.x; u < 16; u += G) thin_unit<0, 4>((const bf16*)a.out + (size_t)MR * DM, DM, (const bf16*)(a.ws + WS_WOT), u, hb, stB, nullptr, nullptr, lds, ptid); }
            pg8::Gemm g{(const bf16*)a.out, (const bf16*)(a.ws + WS_WOT + li * WOT_BYTES), DM, 0, nullptr}; pg8::StaticOrder S; S.init(NPAN - 1, 4, G, (int)blockIdx.x);
            EpiResid E{hb, stB, li == 0 ? a.ws + B_HB8D : nullptr, 1.f};
            pg8::gemm_phase<EpiResid, pg8::StaticOrder, false>(lds, g, S, E, wave);
        }
        SEAM(pb + 3);
        if (li == 0) {
            if (IN(5)) {
                { OPQ(); for (int u = blockIdx.x; u < 88; u += G) thin_unit<1, 4>(hb + (size_t)MR * DM, DM, (const bf16*)(a.ws + WS_WGU), u, nullptr, nullptr, stB, (bf16*)(a.ws + B_ACTT), lds, ptid); }
                pg8::Gemm g{(const bf16*)(a.ws + B_HB8D), (const bf16*)(a.ws + WS_WGU8), DM / 2, 0, nullptr}; pg8::StaticOrder S; S.init(NPAN - 1, 2 * DFF / 256, G, (int)blockIdx.x);
                EpiSwiglu E{a.ws + B_ACT, DFF, stB, 1.f / W8_SCALE};
                for (int rep = 0; rep < REP_FGU; ++rep) pg8::gemm_phase<EpiSwiglu, pg8::StaticOrder, false, true>(lds, g, S, E, wave);
            }
            SEAM(5);
            if (IN(6)) {
                { OPQ(); for (int u = blockIdx.x; u < 16; u += G) thin_unit<0, 11>((const bf16*)(a.ws + B_ACTT) + (size_t)MR * DFF, DFF, (const bf16*)(a.ws + WS_WD), u, hb, stA, nullptr, nullptr, lds, ptid); }
                pg8::Gemm g{(const bf16*)(a.ws + B_ACT), (const bf16*)(a.ws + WS_WD8), DFF / 2, 0, nullptr};     pg8::StaticOrder S; S.init(NPAN - 1, 4, G, (int)blockIdx.x);
                EpiResid E{hb, stA, nullptr, 1.f / (W8_SCALE * ACT8_SCALE)};
                pg8::gemm_phase<EpiResid, pg8::StaticOrder, false, true>(lds, g, S, E, wave);
            }
            SEAM(6);
        }
    }
    if (IN(11)) { OPQ(); const int tid = ptid, lane = plane;
        LAS float* scr = (LAS float*)(lds + wave * 16384);
        const int gw = blockIdx.x * 8 + wave, NGW = G * 8;
        constexpr int IG = 8 * 56, ID = 28 * 16;
        for (int rep = 0; rep < REP_CONV; ++rep)
        for (int it = gw; it < 8 * (2 * IG + ID); it += NGW) { const int e = it / (2 * IG + ID); int r = it % (2 * IG + ID);
            if (r < IG) { transpose_item_f8(ain(a, I_EG) + (size_t)e * DM * DFE, DM, DFE, ain(a, I_FNORM) + DM, a.ws + B_EGU + e * EGU_BYTES, r / 56, r % 56, 1, scr, lane); continue; } r -= IG;
            if (r < IG) { transpose_item_f8(ain(a, I_EU) + (size_t)e * DM * DFE, DM, DFE, ain(a, I_FNORM) + DM, a.ws + B_EGU + e * EGU_BYTES, r / 56, r % 56, 2, scr, lane); continue; } r -= IG;
            transpose_item_f8(ain(a, I_ED) + (size_t)e * DFE * DM, DFE, DM, nullptr, a.ws + B_ED + e * ED_BYTES, r / 16, r % 16, 0, scr, lane); }
        for (int i = blockIdx.x * 512 + tid; i < MAXPAN * 256; i += G * 512) { ((int*)(a.ws + MO_ROWIDX))[i] = -1; ((int*)(a.ws + MO_PDST))[i] = -1; ((f32x2*)(a.ws + MO_PINFO))[i] = (f32x2){0.f, 0.f}; }
        for (int blk = blockIdx.x; blk < MR / 128; blk += G) route_block(a, blk, lds, tid, lane, wave);
    }
    SEAM(11);
    LAS int* offs = (LAS int*)(lds + RING_BYTES + 128);
    if (IN(12)) { OPQ(); const int tid = ptid;
        moe_offsets(a, offs, tid);
        for (int idx = blockIdx.x * 512 + tid; idx < 2 * MR; idx += G * 512) { const int tok = idx >> 1, e = ((const int*)(a.ws + MO_TOKE))[idx], gpos = offs[e] + ((const int*)(a.ws + MO_TOKP))[idx];
            const f32x4* sp = (const f32x4*)(stB + (size_t)tok * 16); const f32x4 s0 = sp[0], s1 = sp[1], s2 = sp[2], s3 = sp[3];
            const float ss = ((s0[0] + s0[1]) + (s0[2] + s0[3])) + ((s1[0] + s1[1]) + (s1[2] + s1[3])) + ((s2[0] + s2[1]) + (s2[2] + s2[3])) + ((s3[0] + s3[1]) + (s3[2] + s3[3]));
            ((int*)(a.ws + MO_ROWIDX))[gpos] = tok; ((int*)(a.ws + MO_PDST))[gpos] = idx;
            ((f32x2*)(a.ws + MO_PINFO))[gpos] = (f32x2){__builtin_amdgcn_rsqf(ss * (1.f / 1024.f) + EPS), __int_as_float(((const int*)(a.ws + MO_TOKW))[idx])}; }
        if (blockIdx.x == 0 && tid < MAXPAN + 8) { int e = 0;
            for (int k = 1; k < 8; ++k) if (tid * 256 >= offs[k]) e = k;
            ((int*)(a.ws + MO_PEXP))[tid] = e; }
    }
    SEAM(12);
    int nT = 0; if (IN(13) || IN(14) || IN(15) || IN(16)) { moe_offsets(a, offs, TID()); nT = __builtin_amdgcn_readfirstlane(offs[8]); }
    const int nA = nT < 128 ? nT : 128, nB = nT < 128 ? 0 : (nT - 128 < 128 ? nT - 128 : 128), nC = nT <= 256 ? 0 : (nT - 256 < 8 ? nT - 256 : 8);
#pragma unroll 1
    for (int job = 0; job < 5; ++job) {
        const int ph = job == 0 ? 13 : job == 1 ? 14 : job <= 3 ? 15 : 16;
        if (IN(ph)) {
            if (job == 0 || job == 3) {
                const int nP = job == 0 ? nA + nC : nB;
                if (nP > 0) { pg8::Gemm g{(const bf16*)(a.ws + B_HB8), (const bf16*)(a.ws + B_EGU), DM / 2, EGU_BYTES, (const int*)(a.ws + MO_ROWIDX)};     pg8::MoeOrder S; S.init(nP, 2 * DFE / 256, G, (int)blockIdx.x, job == 0 ? 0 : 128, (const int*)(a.ws + MO_PEXP));
                    if (job == 0) { S.psplit = nA; S.p1 = 256; } else if (nC > 0 && (nB * (2 * DFE / 256)) % G == 0 && 16 * nC <= G) S.H = 4 * nC;
                    EpiSwigluMoe E{a.ws + B_EACT, (const f32x2*)(a.ws + MO_PINFO), 1.f / W8_SCALE};
                    for (int rep = 0; rep < REP_MGU; ++rep) pg8::gemm_phase<EpiSwigluMoe, pg8::MoeOrder, true, true>(lds, g, S, E, wave); }
            } else {
                const int nP = job == 1 ? nA : job == 2 ? nC : nB, p0 = job == 1 ? 0 : job == 2 ? 256 : 128;
                if (nP > 0) { pg8::Gemm g{(const bf16*)(a.ws + B_EACT + (job == 2 ? (size_t)128 * 256 * DFE : (size_t)0)), (const bf16*)(a.ws + B_ED), DFE / 2, ED_BYTES, nullptr};     pg8::MoeOrder S; S.init(nP, 4, G, (int)blockIdx.x, p0, (const int*)(a.ws + MO_PEXP));
                    EpiMoeDown E{(unsigned char*)a.out, (const int*)(a.ws + MO_PDST), (const f32x2*)(a.ws + MO_PINFO), 1.f / (W8_SCALE * ACT8_SCALE)};
                    for (int rep = 0; rep < REP_MDN; ++rep) pg8::gemm_phase<EpiMoeDown, pg8::MoeOrder, false, true>(lds, g, S, E, wave); }
            }
        }
        if (job != 2) SEAM(ph);
    }
    if (IN(17)) { OPQ(); const int lane = plane;
        const float* fn = ain(a, I_FINAL);
        for (int r = blockIdx.x * 8 + wave; r < MR; r += G * 8) {
            unsigned char* orow = (unsigned char*)a.out + (size_t)r * 4096; float v[16]; float ss = 0.f;
#pragma unroll
            for (int hf = 0; hf < 2; ++hf) { const int k = 512 * hf + 8 * lane; const v4u h4 = *(const v4u*)(hb + (size_t)r * DM + k), y0 = *(const v4u*)(orow + 2 * k), y1 = *(const v4u*)(orow + 2048 + 2 * k);
                const unsigned hw[4] = {h4.x, h4.y, h4.z, h4.w}, aw[4] = {y0.x, y0.y, y0.z, y0.w}, bw[4] = {y1.x, y1.y, y1.z, y1.w};
#pragma unroll
                for (int t = 0; t < 4; ++t) { const float x0 = bflo(hw[t]) + bflo(aw[t]) + bflo(bw[t]), x1 = bfhi(hw[t]) + bfhi(aw[t]) + bfhi(bw[t]); v[8 * hf + 2 * t] = x0; v[8 * hf + 2 * t + 1] = x1; ss += x0 * x0 + x1 * x1; } }
            ss = wave_sum(ss); const float rs = __builtin_amdgcn_rsqf(ss * (1.f / 1024.f) + EPS);
#pragma unroll
            for (int hf = 0; hf < 2; ++hf) { const int k = 512 * hf + 8 * lane; const f32x4 g0 = *(const f32x4*)(fn + k), g1 = *(const f32x4*)(fn + k + 4);
                *(f32x4*)(orow + 4 * k) = (f32x4){v[8 * hf] * rs * g0[0], v[8 * hf + 1] * rs * g0[1], v[8 * hf + 2] * rs * g0[2], v[8 * hf + 3] * rs * g0[3]};
                *(f32x4*)(orow + 4 * k + 16) = (f32x4){v[8 * hf + 4] * rs * g1[0], v[8 * hf + 5] * rs * g1[1], v[8 * hf + 6] * rs * g1[2], v[8 * hf + 7] * rs * g1[3]}; }
        }
    }
#undef IN
#undef SEAM
#undef hb
#undef stA
#undef stB
}

extern "C" void kernel_launch(void* const* d_in, const int* in_sizes, int n_in, void* d_out, int out_size, void* d_ws, size_t ws_size, hipStream_t stream) {
    static int grid = 0;
    if (grid == 0) {
        if (n_in != 24 || in_sizes[0] != MR * DM || out_size != MR * DM || ws_size < WS_NEED) { fprintf(stderr, "kernel_launch: unexpected problem (n_in %d, in0 %d, out %d, ws %zu < %zu)\n", n_in, n_in > 0 ? in_sizes[0] : -1, out_size, ws_size, (size_t)WS_NEED); grid = -1; return; }
        int dev = 0, cus = 0, per_cu = 0;
        if (hipGetDevice(&dev) != hipSuccess || hipDeviceGetAttribute(&cus, hipDeviceAttributeMultiprocessorCount, dev) != hipSuccess) { grid = -1; return; }
        if (hipFuncSetAttribute((const void*)mega_fwd, hipFuncAttributeMaxDynamicSharedMemorySize, LDS_BYTES) != hipSuccess) { fprintf(stderr, "kernel_launch: hipFuncSetAttribute failed\n"); grid = -1; return; }
        if (hipOccupancyMaxActiveBlocksPerMultiprocessor(&per_cu, (const void*)mega_fwd, 512, LDS_BYTES) != hipSuccess || per_cu < 1) fprintf(stderr, "kernel_launch: occupancy query reports %d\n", per_cu);
        (void)hipGetLastError();
        grid = cus;
    }
    if (grid < 0) return;
    if (hipMemsetAsync((char*)d_ws + WS_CTL, 0, CTL_BYTES, stream) != hipSuccess) return;
    Args a{};
    for (int i = 0; i < 24; ++i) a.in[i] = (const float*)d_in[i];
    a.out = (float*)d_out; a.ws = (unsigned char*)d_ws;
#if MK_ONE_LAUNCH
    a.ph_lo = 0; a.ph_hi = NPHASE;
    hipLaunchKernelGGL(mega_fwd, dim3(grid), dim3(512), LDS_BYTES, stream, a);
#else
    for (int p = 0; p < NPHASE; ++p) { a.ph_lo = p; a.ph_hi = p + 1; hipLaunchKernelGGL(mega_fwd, dim3(grid), dim3(512), LDS_BYTES, stream, a); }
#endif
}
```

```cpp
#include <hip/hip_runtime.h>
#include <cstdio>
#include <cstdint>

namespace pg8 {
#define PG8_LAS __attribute__((address_space(3)))
typedef unsigned short bf16_t;
typedef short bf16x8 __attribute__((ext_vector_type(8)));
typedef float f32x4 __attribute__((ext_vector_type(4)));
typedef unsigned u32x4 __attribute__((ext_vector_type(4)));
typedef int i32x4 __attribute__((ext_vector_type(4)));
typedef int i32x8 __attribute__((ext_vector_type(8)));
constexpr int BM = 256, BK = 64, HALF = 128, HTB = HALF * BK * 2  , STAGE_BYTES = 8 * HTB, NXCD = 8, WGM = 8;

__host__ __device__ __forceinline__ int lds_byte(int r, int c) { const int st = (r >> 4) * 2 + (c >> 5), rr = r & 15, cc = c & 31, ob = rr * 64 + cc * 2; return st * 1024 + (ob ^ (((ob >> 9) & 1) << 5)); }
__host__ __device__ __forceinline__ void stage_rc(int b, int& R, int& C) { const int st = b / 1024, sb = b % 1024, swz = sb ^ (((sb >> 9) & 1) << 5); R = (st >> 1) * 16 + swz / 64; C = (st & 1) * 32 + (swz % 64) / 2; }
__host__ __device__ __forceinline__ int perm32(int rho) { const int n = rho >> 4, i = rho & 15; return 8 * (i >> 2) + 4 * n + (i & 3); }

struct Unit { int pm, pn, e, gp; };
struct Gemm { const bf16_t* A; const bf16_t* Bt; int K; size_t estride  ; const int* rowidx  ; };

struct StaticOrder {
    int nM, nN, nwg, G, c;
    __device__ void init(int nM_, int nN_, int G_, int c_) { nM = nM_; nN = nN_; nwg = nM * nN; G = G_; c = c_; }
    __device__ __forceinline__ bool map(int i, int& pm, int& pn) const { return mapL((long)i * G + c, pm, pn); }
    __device__ __forceinline__ bool mapL(long L, int& pm, int& pn) const {
        if (L >= nwg) return false;
        int wgid = (int)L; { const int q = nwg / NXCD, r = nwg % NXCD, xcd = wgid % NXCD, off = wgid / NXCD; wgid = (xcd < r ? xcd * (q + 1) : r * (q + 1) + (xcd - r) * q) + off; }
        const int nig = WGM * nN, gid = wgid / nig, fm = gid * WGM, gsz = (nM - fm) < WGM ? (nM - fm) : WGM;
        pm = fm + ((wgid % nig) % gsz); pn = (wgid % nig) / gsz; return true;
    }
    __device__ __forceinline__ bool next(int i, Unit& u) const { int pm, pn; if (!map(i, pm, pn)) return false; u.pm = pm; u.pn = pn; u.e = 0; u.gp = pm; return true; }
};
struct MoeOrder {
    StaticOrder so; int p0; const int* pexp;
    int psplit, p1;
    int H;
    __device__ void init(int nP, int nN, int G, int c, int p0_, const int* pexp_) { so.init(nP, nN, G, c); p0 = p0_; pexp = pexp_; psplit = 1 << 30; p1 = 0; H = 0; }
    __device__ __forceinline__ bool next(int i, Unit& u) const { int pm, pn; long L = (long)i * so.G + so.c;
        if (H > 0) { const int full = so.nwg / so.G, nh = full - 3;
            if (so.c < H) { if (i >= nh) return false; }
            else if (i >= full) { const int j = so.c - H; if (i > full || j >= 3 * H) return false; L = (long)(nh + j / H) * so.G + (j % H); } }
        if (!so.mapL(L, pm, pn)) return false;
        u.pm = pm; u.pn = pn; u.gp = pm < psplit ? p0 + pm : p1 + (pm - psplit); u.e = __builtin_amdgcn_readfirstlane(pexp[u.gp]); return true; }
};

__device__ __forceinline__ unsigned cvt_pk_bf16(float lo, float hi) { unsigned r; asm volatile("v_cvt_pk_bf16_f32 %0, %1, %2" : "=v"(r) : "v"(lo), "v"(hi)); return r; }
__device__ __forceinline__ float bf_lo(unsigned w) { return __uint_as_float(w << 16); }
__device__ __forceinline__ float bf_hi(unsigned w) { return __uint_as_float(w & 0xffff0000u); }

template <class Epi, class Sched, bool GATHER, bool F8 = false>
__device__ __forceinline__ void gemm_phase(PG8_LAS unsigned char* lds, const Gemm g, const Sched& S, const Epi& E, int wave_id  ) {
    int tid_; asm volatile("v_mbcnt_lo_u32_b32 %0, -1, 0\n\tv_mbcnt_hi_u32_b32 %0, -1, %0" : "=v"(tid_)); tid_ += wave_id << 6;
    const int tid = tid_, wid = __builtin_amdgcn_readfirstlane(tid >> 6), lane = tid & 63, wr = wid >> 2, wc = wid & 3, fr = lane & 15, fq = lane >> 4;
    const int K = g.K, nt = K / BK;
    int Ra[2], Ca[2]; unsigned voffB[2];
#pragma unroll
    for (int i = 0; i < 2; ++i) { int R, C; stage_rc(tid * 16 + i * 8192, R, C); const int Rb = (R & ~31) + perm32(R & 31);
        Ra[i] = R; Ca[i] = C; voffB[i] = (unsigned)(Rb * K + C) * 2u; }
    const size_t kstep = (size_t)(BK * 2);
    const size_t hstep = (size_t)HALF * K * 2;
    const size_t tstep = 2 * hstep;
    const unsigned ldsw = (unsigned)wid * 1024u;
    const int aoff = lds_byte(wr * 64 + fr, fq * 8), boff = lds_byte(wc * 32 + fr, fq * 8);
    const char* const A0 = (const char*)g.A;
#define PG8_SA(b, h) (((b) * 2 + (h)) * HTB)
#define PG8_SB(b, h) ((4 + (b) * 2 + (h)) * HTB)
#define PG8_STAGE(bufoff, gbase, voff) do { _Pragma("unroll") for (int _i = 0; _i < 2; ++_i) \
        __builtin_amdgcn_global_load_lds((const unsigned*)((const char*)(gbase) + (voff)[_i]), (PG8_LAS unsigned*)(lds + (bufoff) + ldsw + _i * 8192), 16, 0, 0); } while (0)
#define PG8_RDA(b, h, m, k) (*(const PG8_LAS bf16x8*)(lds + PG8_SA(b, h) + aoff + (m) * 2048 + (k) * 1024))
#define PG8_RDB(b, h, n, k) (*(const PG8_LAS bf16x8*)(lds + PG8_SB(b, h) + boff + (n) * 2048 + (k) * 1024))
#define PG8_LDA(dst, b, h) do { _Pragma("unroll") for (int m = 0; m < 4; ++m) { if (F8) { const i32x4 x0_ = *(const PG8_LAS i32x4*)(lds + PG8_SA(b, h) + aoff + m * 2048), x1_ = *(const PG8_LAS i32x4*)(lds + PG8_SA(b, h) + aoff + m * 2048 + 1024); dst##8[m] = __builtin_shufflevector(x0_, x1_, 0, 1, 2, 3, 4, 5, 6, 7); } else { dst[m][0] = PG8_RDA(b, h, m, 0); dst[m][1] = PG8_RDA(b, h, m, 1); } } } while (0)
#define PG8_LDB(dst, b, h) do { _Pragma("unroll") for (int n = 0; n < 2; ++n) { if (F8) { const i32x4 x0_ = *(const PG8_LAS i32x4*)(lds + PG8_SB(b, h) + boff + n * 2048), x1_ = *(const PG8_LAS i32x4*)(lds + PG8_SB(b, h) + boff + n * 2048 + 1024); dst##8[n] = __builtin_shufflevector(x0_, x1_, 0, 1, 2, 3, 4, 5, 6, 7); } else { dst[n][0] = PG8_RDB(b, h, n, 0); dst[n][1] = PG8_RDB(b, h, n, 1); } } } while (0)
#define PG8_CAT(x0, x1) __builtin_shufflevector(__builtin_bit_cast(i32x4, x0), __builtin_bit_cast(i32x4, x1), 0, 1, 2, 3, 4, 5, 6, 7)
#define PG8_MMA(ai, bj, At, Bt) do { __builtin_amdgcn_s_setprio(1); _Pragma("unroll") for (int m = 0; m < 4; ++m) _Pragma("unroll") for (int n = 0; n < 2; ++n) { \
        if (F8) asm("v_mfma_f32_16x16x128_f8f6f4 %0, %1, %2, %0" : "+v"(acc[ai][bj][m][n]) : "v"(Bt##8[n]), "v"(At##8[m]));         \
        else { _Pragma("unroll") for (int k = 0; k < 2; ++k) acc[ai][bj][m][n] = __builtin_amdgcn_mfma_f32_16x16x32_bf16(Bt[n][k], At[m][k], acc[ai][bj][m][n], 0, 0, 0); } } __builtin_amdgcn_s_setprio(0); } while (0)
#define PG8_WAIT_V(n) asm volatile("s_waitcnt vmcnt(" #n ")" ::: "memory")
#define PG8_WAIT_L(n) asm volatile("s_waitcnt lgkmcnt(" #n ")" ::: "memory")
#define PG8_BAR __builtin_amdgcn_s_barrier()
#define PG8_SCHED __builtin_amdgcn_sched_barrier(0)
#define PG8_AOFFS(dst, u) do { _Pragma("unroll") for (int _h = 0; _h < 2; ++_h) _Pragma("unroll") for (int _i = 0; _i < 2; ++_i) { \
        int _row = (u).pm * BM + _h * HALF + Ra[_i]; \
        if (GATHER) { const int _gi = g.rowidx[(u).gp * BM + _h * HALF + Ra[_i]]; _row = _gi < 0 ? 0 : _gi; } \
        dst[_h][_i] = ((unsigned)_row * (unsigned)K + (unsigned)Ca[_i]) * 2u; } } while (0)
    Unit cur, nxt; int ui = 0;
    if (!S.next(0, cur)) return;
    f32x4 acc[2][2][4][2];
#pragma unroll
    for (int a = 0; a < 2; ++a)
#pragma unroll
        for (int b = 0; b < 2; ++b)
#pragma unroll
            for (int m = 0; m < 4; ++m)
#pragma unroll
                for (int n = 0; n < 2; ++n) acc[a][b][m][n] = (f32x4){0.f, 0.f, 0.f, 0.f};
    bf16x8 At[4][2], B0[2][2], B1[2][2];
    i32x8 At8[4], B08[2], B18[2];
    unsigned oaC[2][2], oaN[2][2];
    PG8_AOFFS(oaC, cur);
    const char* cB = (const char*)g.Bt + (size_t)cur.e * g.estride + (size_t)cur.pn * tstep;
    PG8_STAGE(PG8_SB(0, 0), cB, voffB); PG8_STAGE(PG8_SB(0, 1), cB + hstep, voffB); PG8_STAGE(PG8_SA(0, 0), A0, oaC[0]); PG8_STAGE(PG8_SA(0, 1), A0, oaC[1]);
    if (wr == 1) PG8_BAR;
    PG8_WAIT_V(2); PG8_BAR;
    PG8_STAGE(PG8_SB(1, 0), cB + kstep, voffB); PG8_STAGE(PG8_SA(1, 0), A0 + kstep, oaC[0]); PG8_STAGE(PG8_SB(1, 1), cB + hstep + kstep, voffB);
    PG8_WAIT_V(6); PG8_BAR;
    for (;;) {
        const bool has_next = S.next(ui + 1, nxt);
        int rawN[2][2];
        if (has_next) {
            if (GATHER) {
#pragma unroll
                for (int _h = 0; _h < 2; ++_h)
#pragma unroll
                    for (int _i = 0; _i < 2; ++_i) rawN[_h][_i] = g.rowidx[nxt.gp * BM + _h * HALF + Ra[_i]];
            } else { PG8_AOFFS(oaN, nxt); } }
        else {
#pragma unroll
            for (int _h = 0; _h < 2; ++_h)
#pragma unroll
                for (int _i = 0; _i < 2; ++_i) oaN[_h][_i] = oaC[_h][_i]; }
        const char* nB = has_next ? (const char*)g.Bt + (size_t)nxt.e * g.estride + (size_t)nxt.pn * tstep : cB;
#pragma unroll 1
        for (int t = 0; t < nt; t += 2) {
            const bool last = (t == nt - 2);
            const char* ka1 = A0 + (size_t)(t + 1) * kstep;
            const char* ka2 = last ? A0 : A0 + (size_t)(t + 2) * kstep; const char* b2 = last ? nB : cB + (size_t)(t + 2) * kstep;
            const char* ka3 = ka2 + kstep; const char* b3 = b2 + kstep;
            unsigned o2[2][2];
#pragma unroll
            for (int _h = 0; _h < 2; ++_h)
#pragma unroll
                for (int _i = 0; _i < 2; ++_i) o2[_h][_i] = oaC[_h][_i];
            if (last) {
                if (GATHER && has_next) {
#pragma unroll
                    for (int _h = 0; _h < 2; ++_h)
#pragma unroll
                        for (int _i = 0; _i < 2; ++_i) { const int _gi = rawN[_h][_i]; oaN[_h][_i] = ((unsigned)(_gi < 0 ? 0 : _gi) * (unsigned)K + (unsigned)Ca[_i]) * 2u; } }
                E.prefetch(lds, cur, wid, lane);
#pragma unroll
                for (int _h = 0; _h < 2; ++_h)
#pragma unroll
                    for (int _i = 0; _i < 2; ++_i) o2[_h][_i] = oaN[_h][_i];
                asm volatile("" : "+v"(o2[0][0]), "+v"(o2[0][1]), "+v"(o2[1][0]), "+v"(o2[1][1])); }
            PG8_LDB(B0, 0, 0); PG8_LDB(B1, 0, 1); PG8_SCHED; PG8_LDA(At, 0, 0); PG8_STAGE(PG8_SA(1, 1), ka1, oaC[1]);
            PG8_WAIT_V(8); PG8_WAIT_L(0); PG8_BAR; PG8_MMA(0, 0, At, B0); PG8_MMA(0, 1, At, B1); PG8_BAR; PG8_SCHED;
            PG8_LDA(At, 0, 1); PG8_STAGE(PG8_SB(0, 0), b2, voffB); PG8_STAGE(PG8_SB(0, 1), b2 + hstep, voffB); PG8_STAGE(PG8_SA(0, 0), ka2, o2[0]);
            PG8_WAIT_V(8); PG8_WAIT_L(0); PG8_BAR; PG8_MMA(1, 0, At, B0); PG8_MMA(1, 1, At, B1); PG8_BAR; PG8_SCHED;
            PG8_LDB(B0, 1, 0); PG8_LDB(B1, 1, 1); PG8_SCHED; PG8_LDA(At, 1, 0); PG8_STAGE(PG8_SA(0, 1), ka2, o2[1]);
            PG8_WAIT_V(8); PG8_WAIT_L(0); PG8_BAR; PG8_MMA(0, 0, At, B0); PG8_MMA(0, 1, At, B1); PG8_BAR; PG8_SCHED;
            PG8_LDA(At, 1, 1); PG8_STAGE(PG8_SB(1, 0), b3, voffB); PG8_STAGE(PG8_SB(1, 1), b3 + hstep, voffB); PG8_STAGE(PG8_SA(1, 0), ka3, o2[0]);
            PG8_WAIT_V(8); PG8_WAIT_L(0); PG8_BAR; PG8_MMA(1, 0, At, B0); PG8_MMA(1, 1, At, B1); PG8_BAR; PG8_SCHED;
        }
        if (wr == 0) PG8_BAR;
        { int fr_e = fr, fq_e = fq; asm volatile("" : "+v"(fr_e), "+v"(fq_e));
          E(acc, cur, wr, wc, fr_e, fq_e, lds); }
        if (!has_next) break;
#pragma unroll
        for (int a = 0; a < 2; ++a)
#pragma unroll
            for (int b = 0; b < 2; ++b)
#pragma unroll
                for (int m = 0; m < 4; ++m)
#pragma unroll
                    for (int n = 0; n < 2; ++n) acc[a][b][m][n] = (f32x4){0.f, 0.f, 0.f, 0.f};
        cur = nxt; cB = nB; ++ui;
#pragma unroll
        for (int _h = 0; _h < 2; ++_h)
#pragma unroll
            for (int _i = 0; _i < 2; ++_i) oaC[_h][_i] = oaN[_h][_i];
        if (wr == 1) PG8_BAR;
    }
    PG8_WAIT_V(0);
    PG8_BAR;
#undef PG8_SA
#undef PG8_SB
#undef PG8_STAGE
#undef PG8_LDA
#undef PG8_RDA
#undef PG8_RDB
#undef PG8_LDB
#undef PG8_MMA
#undef PG8_CAT
#undef PG8_WAIT_V
#undef PG8_WAIT_L
#undef PG8_BAR
#undef PG8_SCHED
#undef PG8_AOFFS
}
}
#define GAS __attribute__((address_space(1)))
#define LAS __attribute__((address_space(3)))
typedef unsigned short bf16;
typedef unsigned v4u __attribute__((ext_vector_type(4)));
typedef unsigned v2u __attribute__((ext_vector_type(2)));
typedef float f32x4 __attribute__((ext_vector_type(4)));
typedef float f32x2 __attribute__((ext_vector_type(2)));
typedef GAS unsigned gu32;
#define RLX_AGENT __ATOMIC_RELAXED, __HIP_MEMORY_SCOPE_AGENT
#define LDS_WAIT() asm volatile("s_waitcnt lgkmcnt(0)" ::: "memory")
#define VM_WAIT() asm volatile("s_waitcnt vmcnt(0)" ::: "memory")
__device__ __forceinline__ unsigned f2bf(float f) { unsigned u = __builtin_bit_cast(unsigned, f); return (u + 0x7fffu + ((u >> 16) & 1u)) >> 16; }
__device__ __forceinline__ unsigned pk2(float lo, float hi) { return f2bf(lo) | (f2bf(hi) << 16); }
__device__ __forceinline__ float bf2f(bf16 h) { return __uint_as_float(((unsigned)h) << 16); }
__device__ __forceinline__ float bflo(unsigned w) { return __uint_as_float(w << 16); }
__device__ __forceinline__ float bfhi(unsigned w) { return __uint_as_float(w & 0xffff0000u); }

#define XB_TMO      128
#define XB_XCNT(j)  (256  + 64 * (j))
#define XB_XSUB(j)  (1280 + 64 * (j))
#define XB_XGEN(j)  (2304 + 64 * (j))
#define XB_TOP      3328
#define XB_TOPGEN   3392
#define XCD_BAR_WORDS 3456
#define XB_SPIN_CAP (1u << 18)

__device__ __forceinline__ unsigned xb_ld(unsigned* p)              { return __hip_atomic_load(p, __ATOMIC_RELAXED, __HIP_MEMORY_SCOPE_AGENT); }
__device__ __forceinline__ unsigned xb_add(unsigned* p, unsigned v) { return __hip_atomic_fetch_add(p, v, __ATOMIC_RELAXED, __HIP_MEMORY_SCOPE_AGENT); }
__device__ __forceinline__ unsigned xb_xcc_id() { return (unsigned)__builtin_amdgcn_s_getreg((3 << 11) | 20) & 0xFu; }
#define XB_SPIN(cond, bar) do { unsigned _sp = 0; while (cond) { __builtin_amdgcn_s_sleep(1); \
    if ((++_sp & 255u) == 0u) { if (xb_ld(&(bar)[XB_TMO])) break; if (_sp > XB_SPIN_CAP) { atomicAdd(&(bar)[XB_TMO], 1u); break; } } } } while (0)

struct XcdBarrier {
    unsigned* bar; unsigned x;
    volatile LAS unsigned* st;
};

__device__ __forceinline__ XcdBarrier xcd_barrier_post(unsigned* bar, volatile LAS unsigned* st, bool leader  ) {
    XcdBarrier b; b.bar = bar; b.x = xb_xcc_id(); b.st = st;
    if (leader) (void)xb_add(&bar[XB_XCNT(b.x)], 1u);
    return b;
}
__device__ __forceinline__ void xcd_barrier_complete(unsigned* bar, unsigned x, unsigned& nloc, unsigned& nx) {
    const unsigned G = gridDim.x * gridDim.y * gridDim.z;
    unsigned sum, cnt, mine, sp = 0u;
    for (;;) {
        sum = 0u; cnt = 0u; mine = 0u;
#pragma unroll
        for (unsigned j = 0; j < 16; ++j) { const unsigned c = xb_ld(&bar[XB_XCNT(j)]); sum += c; cnt += (c > 0u) ? 1u : 0u; mine = (j == x) ? c : mine; }
        if (sum == G) break;
        __builtin_amdgcn_s_sleep(1);
        if ((++sp & 255u) == 0u) { if (xb_ld(&bar[XB_TMO])) break; if (sp > XB_SPIN_CAP) { atomicAdd(&bar[XB_TMO], 1u); break; } }
    }
    nloc = mine > 0u ? mine : 1u; nx = cnt > 0u ? cnt : 1u;
}

__device__ __forceinline__ void xcd_barrier(const XcdBarrier& b, bool leader) {
    asm volatile("s_waitcnt vmcnt(0)" ::: "memory");
    __syncthreads();
    if (leader) {
        unsigned* bar = b.bar;
        __builtin_amdgcn_s_waitcnt(0);
        unsigned nloc = b.st[0], nx = b.st[1];
        if (nloc == 0u) { xcd_barrier_complete(bar, b.x, nloc, nx); b.st[0] = nloc; b.st[1] = nx; }
        const unsigned old = xb_add(&bar[XB_XSUB(b.x)], 1u);
        const unsigned gen = old / nloc;
        if (old + 1u == (gen + 1u) * nloc) {
            __builtin_amdgcn_fence(__ATOMIC_RELEASE, "agent");
            asm volatile("s_waitcnt vmcnt(0)" ::: "memory");
            const unsigned og = xb_add(&bar[XB_TOP], 1u);
            const unsigned tg = og / nx;
            if (og + 1u == (tg + 1u) * nx) xb_add(&bar[XB_TOPGEN], 1u);
            else XB_SPIN(xb_ld(&bar[XB_TOPGEN]) == tg, bar);
            __builtin_amdgcn_fence(__ATOMIC_ACQUIRE, "agent");
            xb_add(&bar[XB_XGEN(b.x)], 1u);
            asm volatile("s_waitcnt vmcnt(0)" ::: "memory");
        } else {
            XB_SPIN(xb_ld(&bar[XB_XGEN(b.x)]) == gen, bar);
            __builtin_amdgcn_fence(__ATOMIC_ACQUIRE, "agent");
            asm volatile("s_waitcnt vmcnt(0)" ::: "memory");
        }
    }
    __syncthreads();
}

__device__ __forceinline__ int lane_id() { int l; asm volatile("v_mbcnt_lo_u32_b32 %0, -1, 0\n\tv_mbcnt_hi_u32_b32 %0, -1, %0" : "=v"(l)); return l; }

constexpr int NB = 16, TT = 2048, DM = 1024, MR = NB * TT, NMETA = 16, MROWS = MR + 256, NPAN = MROWS / 256;
constexpr int PSEQ = 2112, NCH = 33;
constexpr int DIN = 2864, N1 = 3072;
constexpr int DFF = 2816, DFE = 3584, NEXP = 8;
constexpr float EPS = 1e-6f;
constexpr int C_AQ = 0, C_AK = 128, C_AV = 256, C_ALR = 512, C_AOG = 528, C_RQ = 784, C_RK = 1040, C_RV = 1296, C_ROG = 1552, C_CQ = 1808, C_CKV = 2000, C_KPE = 2064, C_DQ = 2096, C_DK = 2352, C_DV = 2608;
constexpr int MAXPAN = 264;
constexpr float LOG2E = 1.4426950408889634f;

constexpr size_t MiB = 1u << 20;
constexpr size_t WS_CTL = 0, CTL_BYTES = 1 * MiB;
constexpr size_t WS_TABR = 1 * MiB, WS_TABM = 1 * MiB + 576 * 1024;
constexpr size_t WS_RT = 2 * MiB;
constexpr size_t WS_WQA = 2 * MiB + 256 * 1024, WQA_BYTES = 384 * 192 * 2;
constexpr size_t WS_STA = 3 * MiB, WS_STB = 6 * MiB;
constexpr size_t WS_MOE = 9 * MiB;
constexpr size_t MO_ROWIDX = WS_MOE, MO_PDST = WS_MOE + 512 * 1024, MO_PINFO = WS_MOE + 1 * MiB, MO_TOKE = WS_MOE + 2 * MiB, MO_TOKP = MO_TOKE + 256 * 1024, MO_TOKW = MO_TOKE + 512 * 1024, MO_PEXP = WS_MOE + 3 * MiB;
constexpr size_t WS_GD = 13 * MiB;
constexpr size_t WS_W1T = 16 * MiB, W1T_BYTES = (size_t)N1 * DM * 2;
constexpr size_t WS_WOT = 29 * MiB, WOT_BYTES = (size_t)DM * DM * 2;
constexpr size_t WS_WGU = 33 * MiB;
constexpr size_t WS_WD = 44 * MiB;
constexpr size_t WS_HB = 50 * MiB;
constexpr size_t WS_BIG = 115 * MiB;
constexpr size_t B_PROJ = WS_BIG;
constexpr int GQ_T = 5120, GKT_T = 5120, RT_T = 9216, VT_T = 9216;
constexpr size_t B_GQ = WS_BIG + 210 * MiB, B_GK = WS_BIG + 221 * MiB, B_GV = WS_BIG + 232 * MiB;
constexpr size_t B_RQ = WS_BIG + 251 * MiB, B_RK = WS_BIG + 270 * MiB, B_RV = WS_BIG + 289 * MiB;
constexpr size_t B_MQ = WS_BIG + 308 * MiB, B_MK = WS_BIG + 333 * MiB;
constexpr size_t B_DQ = WS_BIG + 340 * MiB, B_DK = B_DQ + 16896 * 1024;
constexpr size_t O_DVT = 65 * MiB, O_MVT = 82 * MiB, O_GKT = 87 * MiB, O_RKT = 98 * MiB;
constexpr size_t B_ACT = WS_BIG;
constexpr size_t B_ACTT = WS_BIG;
constexpr size_t B_HB8D = WS_BIG + 300 * MiB;
constexpr size_t WS_WGU8 = WS_BIG + 380 * MiB, WS_WD8 = WS_BIG + 390 * MiB;
constexpr size_t B_EGU = WS_BIG, EGU_BYTES = (size_t)2 * DFE * DM;
constexpr size_t B_HB8 = WS_BIG + 56 * MiB;
constexpr float W8_SCALE = 64.f;
constexpr size_t B_ED = WS_BIG + 112 * MiB, ED_BYTES = (size_t)DM * DFE;
constexpr float ACT8_SCALE = 16.f;
constexpr size_t B_EACT = WS_BIG + 168 * MiB;
constexpr size_t WS_NEED = WS_BIG + 406 * MiB;
constexpr int CW_BAR = 4096, CW_CNT = 8192;

constexpr int RING_BYTES = 131072, MISC_OFF = RING_BYTES + 320, EPS_OFF = 147456, LDS_BYTES = 163840;

__device__ __forceinline__ float clamp8(float v) { return __builtin_amdgcn_fmed3f(v, -448.f, 448.f); }
__device__ __forceinline__ unsigned pk4_fp8(float a, float b, float c, float d) { unsigned q = (unsigned)__builtin_amdgcn_cvt_pk_fp8_f32(clamp8(a), clamp8(b), 0, false); return (unsigned)__builtin_amdgcn_cvt_pk_fp8_f32(clamp8(c), clamp8(d), (int)q, true); }
__device__ __forceinline__ f32x2 swiglu2(f32x2 g, f32x2 u, float c1, float c2) {
    const f32x2 ea = g * c1;
    const f32x2 d = (f32x2){__builtin_amdgcn_exp2f(ea[0]), __builtin_amdgcn_exp2f(ea[1])} + 1.0f;
    const f32x2 r = (f32x2){__builtin_amdgcn_rcpf(d[0]), __builtin_amdgcn_rcpf(d[1])};
    return ((g * u) * r) * c2;
}
__device__ __forceinline__ float silu_f(float x) { return x * __builtin_amdgcn_rcpf(1.0f + __builtin_amdgcn_exp2f(-x * LOG2E)); }
__device__ __forceinline__ v4u pack8(const f32x4 a, const f32x4 b) { v4u w; w.x = pg8::cvt_pk_bf16(a[0], a[1]); w.y = pg8::cvt_pk_bf16(a[2], a[3]); w.z = pg8::cvt_pk_bf16(b[0], b[1]); w.w = pg8::cvt_pk_bf16(b[2], b[3]); return w; }

__device__ __forceinline__ void rows_rstd16(const float* stats, int row0, int fq, float (&rs)[8]) {
    f32x4 v[8];
#pragma unroll
    for (int j = 0; j < 8; ++j) v[j] = *(const f32x4*)(stats + (size_t)(row0 + (j >> 2) * 128 + (j & 3) * 16) * 16 + 4 * fq);
#pragma unroll
    for (int j = 0; j < 8; ++j) { float s = (v[j][0] + v[j][1]) + (v[j][2] + v[j][3]); s += __shfl_xor(s, 16); s += __shfl_xor(s, 32); rs[j] = __builtin_amdgcn_rsqf(s * (1.0f / 1024.0f) + EPS); }
}
__device__ __forceinline__ void stage_rows(const void* src, int bytes, LAS unsigned char* lds, int wid, int lane) {
#pragma unroll
    for (int j = 0; j < 2; ++j) { const int p = __builtin_amdgcn_readfirstlane(wid + 8 * j);
        if (p * 1024 < bytes) __builtin_amdgcn_global_load_lds((const unsigned*)((const unsigned char*)src + p * 1024 + lane * 16), (LAS unsigned*)(lds + EPS_OFF + p * 1024), 16, 0, 0); }
}
__device__ __forceinline__ void rows_rstd16_lds(const LAS unsigned char* lds, int rl0, int fq, float (&rs)[8]) {
    f32x4 v[8];
#pragma unroll
    for (int j = 0; j < 8; ++j) v[j] = *(const LAS f32x4*)(lds + EPS_OFF + (rl0 + (j >> 2) * 128 + (j & 3) * 16) * 64 + 16 * fq);
#pragma unroll
    for (int j = 0; j < 8; ++j) { float s = (v[j][0] + v[j][1]) + (v[j][2] + v[j][3]); s += __shfl_xor(s, 16); s += __shfl_xor(s, 32); rs[j] = __builtin_amdgcn_rsqf(s * (1.0f / 1024.0f) + EPS); }
}
struct EpiProj {
    bf16* O; const float* stats;
    __device__ __forceinline__ void prefetch(LAS unsigned char* lds, const pg8::Unit& u, int wid, int lane) const { stage_rows(stats + (size_t)u.pm * 256 * 16, 16384, lds, wid, lane); }
    __device__ __forceinline__ void operator()(const f32x4 (&acc)[2][2][4][2], const pg8::Unit& u, int wr, int wc, int fr, int fq, const LAS unsigned char* lds) const {
        const int col0 = u.pn * 256 + wc * 32 + 8 * fq, row0 = u.pm * 256 + wr * 64 + fr;
        float rs[8]; rows_rstd16_lds(lds, wr * 64 + fr, fq, rs);
#pragma unroll
        for (int ai = 0; ai < 2; ++ai)
#pragma unroll
            for (int m = 0; m < 4; ++m) { const int r = row0 + ai * 128 + m * 16; const float sc = rs[ai * 4 + m]; bf16* rowp = O + (size_t)r * N1 + col0;
#pragma unroll
                for (int bj = 0; bj < 2; ++bj) *(v4u*)(rowp + bj * 128) = pack8(acc[ai][bj][m][0] * sc, acc[ai][bj][m][1] * sc); }
    }
};
struct EpiSwiglu {
    unsigned char* O; int ldo; const float* stats; float wscale;
    __device__ __forceinline__ void prefetch(LAS unsigned char* lds, const pg8::Unit& u, int wid, int lane) const { stage_rows(stats + (size_t)u.pm * 256 * 16, 16384, lds, wid, lane); }
    __device__ __forceinline__ void operator()(const f32x4 (&acc)[2][2][4][2], const pg8::Unit& u, int wr, int wc, int fr, int fq, const LAS unsigned char* lds) const {
        const int col0 = u.pn * 128 + wc * 32 + 8 * fq, row0 = u.pm * 256 + wr * 64 + fr;
        float rs[8]; rows_rstd16_lds(lds, wr * 64 + fr, fq, rs);
#pragma unroll
        for (int j = 0; j < 8; ++j) rs[j] *= wscale;
#pragma unroll
        for (int ai = 0; ai < 2; ++ai)
#pragma unroll
            for (int m = 0; m < 4; ++m) { const int r = row0 + ai * 128 + m * 16; const float sc = rs[ai * 4 + m];
                const float c1 = -sc * LOG2E, c2 = sc * sc;
                f32x4 o[2];
#pragma unroll
                for (int n = 0; n < 2; ++n) { const f32x2 lo = swiglu2(acc[ai][0][m][n].lo, acc[ai][1][m][n].lo, c1, c2), hi2 = swiglu2(acc[ai][0][m][n].hi, acc[ai][1][m][n].hi, c1, c2);
                    o[n] = (f32x4){lo[0], lo[1], hi2[0], hi2[1]}; }
                *(v4u*)((bf16*)O + (size_t)r * ldo + col0) = pack8(o[0], o[1]); }
    }
};
struct EpiResid {
    bf16* H; float* stats; unsigned char* H8; float ascale;
    __device__ __forceinline__ void prefetch(LAS unsigned char*, const pg8::Unit&, int, int) const {}
    __device__ __forceinline__ void operator()(const f32x4 (&acc)[2][2][4][2], const pg8::Unit& u, int wr, int wc, int fr, int fq, const LAS unsigned char*) const {
        const int col0 = u.pn * 256 + wc * 32 + 8 * fq, row0 = u.pm * 256 + wr * 64 + fr;
#pragma unroll
        for (int ai = 0; ai < 2; ++ai) {
            v4u w[4][2];
#pragma unroll
            for (int m = 0; m < 4; ++m)
#pragma unroll
                for (int bj = 0; bj < 2; ++bj) w[m][bj] = *(const v4u*)(H + (size_t)(row0 + ai * 128 + m * 16) * DM + col0 + bj * 128);
            float ssm[4];
#pragma unroll
            for (int m = 0; m < 4; ++m) { bf16* rowp = H + (size_t)(row0 + ai * 128 + m * 16) * DM + col0; float ss = 0.f;
#pragma unroll
                for (int bj = 0; bj < 2; ++bj) { const v4u x = w[m][bj];
                    f32x4 a = acc[ai][bj][m][0] * ascale, b = acc[ai][bj][m][1] * ascale;
                    a[0] += bflo(x.x); a[1] += bfhi(x.x); a[2] += bflo(x.y); a[3] += bfhi(x.y); b[0] += bflo(x.z); b[1] += bfhi(x.z); b[2] += bflo(x.w); b[3] += bfhi(x.w);
                    ss += (a[0] * a[0] + a[1] * a[1]) + (a[2] * a[2] + a[3] * a[3]) + (b[0] * b[0] + b[1] * b[1]) + (b[2] * b[2] + b[3] * b[3]);
                    *(v4u*)(rowp + bj * 128) = pack8(a, b);
                    if (H8) *(uint2*)(H8 + (size_t)(row0 + ai * 128 + m * 16) * DM + col0 + bj * 128) = make_uint2(pk4_fp8(a[0], a[1], a[2], a[3]), pk4_fp8(b[0], b[1], b[2], b[3])); }
                ss += __shfl_xor(ss, 16); ss += __shfl_xor(ss, 32); ssm[m] = ss; }
            if (fq == 0) {
#pragma unroll
                for (int m = 0; m < 4; ++m) stats[(size_t)(row0 + ai * 128 + m * 16) * 16 + u.pn * 4 + wc] = ssm[m]; } }
    }
};
struct EpiSwigluMoe {
    unsigned char* O; const f32x2* pinfo; float wscale;
    __device__ __forceinline__ void prefetch(LAS unsigned char* lds, const pg8::Unit& u, int wid, int lane) const { stage_rows(pinfo + (size_t)u.gp * 256, 2048, lds, wid, lane); }
    __device__ __forceinline__ void operator()(const f32x4 (&acc)[2][2][4][2], const pg8::Unit& u, int wr, int wc, int fr, int fq, const LAS unsigned char* lds) const {
        const int col0 = u.pn * 128 + wc * 32 + 8 * fq, rl0 = wr * 64 + fr;
        float rs[8];
#pragma unroll
        for (int j = 0; j < 8; ++j) rs[j] = ((const LAS f32x2*)(lds + EPS_OFF))[rl0 + (j >> 2) * 128 + (j & 3) * 16][0] * wscale;
#pragma unroll
        for (int ai = 0; ai < 2; ++ai)
#pragma unroll
            for (int m = 0; m < 4; ++m) { const int rl = rl0 + ai * 128 + m * 16; const float sc = rs[ai * 4 + m];
                const float c1 = -sc * LOG2E, c2 = sc * sc * ACT8_SCALE;
                f32x4 o[2];
#pragma unroll
                for (int n = 0; n < 2; ++n) { const f32x2 lo = swiglu2(acc[ai][0][m][n].lo, acc[ai][1][m][n].lo, c1, c2), hi2 = swiglu2(acc[ai][0][m][n].hi, acc[ai][1][m][n].hi, c1, c2);
                    o[n] = (f32x4){lo[0], lo[1], hi2[0], hi2[1]}; }
                *(uint2*)(O + (size_t)(u.pm * 256 + rl) * DFE + col0) = make_uint2(pk4_fp8(o[0][0], o[0][1], o[0][2], o[0][3]), pk4_fp8(o[1][0], o[1][1], o[1][2], o[1][3])); }
    }
};
struct EpiMoeDown {
    unsigned char* Y; const int* pdst; const f32x2* pinfo; float oscale;
    __device__ __forceinline__ void prefetch(LAS unsigned char* lds, const pg8::Unit& u, int wid, int lane) const {
        if (wid < 2) __builtin_amdgcn_global_load_lds((const unsigned*)((const unsigned char*)(pinfo + (size_t)u.gp * 256) + wid * 1024 + lane * 16), (LAS unsigned*)(lds + EPS_OFF + wid * 1024), 16, 0, 0);
        else if (wid == 2) __builtin_amdgcn_global_load_lds((const unsigned*)((const unsigned char*)(pdst + (size_t)u.gp * 256) + lane * 16), (LAS unsigned*)(lds + EPS_OFF + 2048), 16, 0, 0); }
    __device__ __forceinline__ void operator()(const f32x4 (&acc)[2][2][4][2], const pg8::Unit& u, int wr, int wc, int fr, int fq, const LAS unsigned char* lds) const {
        const int col0 = u.pn * 256 + wc * 32 + 8 * fq, rl0 = wr * 64 + fr;
#pragma unroll
        for (int ai = 0; ai < 2; ++ai)
#pragma unroll
            for (int m = 0; m < 4; ++m) { const int rl = rl0 + ai * 128 + m * 16; const int d = ((const LAS int*)(lds + EPS_OFF + 2048))[rl]; const float w = ((const LAS f32x2*)(lds + EPS_OFF))[rl][1] * oscale;
                if (d >= 0) { bf16* rowp = (bf16*)(Y + (size_t)(d >> 1) * 4096 + (size_t)(d & 1) * 2048) + col0;
#pragma unroll
                    for (int bj = 0; bj < 2; ++bj) *(v4u*)(rowp + bj * 128) = pack8(acc[ai][bj][m][0] * w, acc[ai][bj][m][1] * w); } }
    }
};

__device__ __forceinline__ float wave_sum(float v) {
#pragma unroll
    for (int o = 1; o < 64; o <<= 1) v += __shfl_xor(v, o);
    return v;
}
template <bool GAIN>
__device__ __forceinline__ void transpose_item(const float* W, int K, int N, const float* gain, bf16* WT, int kb, int nb, int dmode, LAS float* scr_, int lane) {
    LAS unsigned* scr = (LAS unsigned*)scr_;
    const int k0 = 64 * kb, n0 = 64 * nb, n = n0 + 2 * (lane & 31), kh = lane >> 5;
    f32x2 v[32];
#pragma unroll
    for (int i = 0; i < 32; ++i) v[i] = (n < N) ? *(const f32x2*)(W + (size_t)(k0 + 2 * i + kh) * N + n) : (f32x2){0.f, 0.f};
    if (GAIN) { float gv[32];
#pragma unroll
        for (int i = 0; i < 32; ++i) gv[i] = gain[k0 + 2 * i + kh];
#pragma unroll
        for (int i = 0; i < 32; ++i) v[i] = v[i] * gv[i]; }
#pragma unroll
    for (int i = 0; i < 32; ++i) scr[(2 * i + kh) * 33 + (lane & 31)] = pk2(v[i][0], v[i][1]);
    LDS_WAIT(); asm volatile("" ::: "memory");
    const LAS bf16* T = (const LAS bf16*)scr;
    const int c = lane & 7;
    const int d0 = dmode == 0 ? n0 : 256 * (n0 >> 7) + (n0 & 127) + (dmode == 2 ? 128 : 0);
#pragma unroll
    for (int j = 0; j < 8; ++j) { const int nl = (lane >> 3) + 8 * j; unsigned x[8];
#pragma unroll
        for (int t = 0; t < 8; ++t) x[t] = T[(8 * c + t) * 66 + nl];
        v4u o; o.x = x[0] | (x[1] << 16); o.y = x[2] | (x[3] << 16); o.z = x[4] | (x[5] << 16); o.w = x[6] | (x[7] << 16);
        if (n0 + nl < N) *(v4u*)(WT + (size_t)(d0 + nl) * K + k0 + 8 * c) = o; }
    LDS_WAIT(); asm volatile("" ::: "memory");
}

template <bool GAIN>
__device__ __forceinline__ void transpose_item_f8(const float* W, int K, int N, const float* gain, unsigned char* WT, int kb, int nb, int dmode, LAS float* scr_, int lane) {
    LAS unsigned char* scr = (LAS unsigned char*)scr_;
    const int k0 = 128 * kb, n0 = 64 * nb, nl2 = 2 * (lane & 31), n = n0 + nl2, kh = lane >> 5;
#pragma unroll
    for (int half = 0; half < 2; ++half) {
        f32x2 v[32];
#pragma unroll
        for (int i = 0; i < 32; ++i) v[i] = (n < N) ? *(const f32x2*)(W + (size_t)(k0 + 64 * half + 2 * i + kh) * N + n) : (f32x2){0.f, 0.f};
        float gv[32];
#pragma unroll
        for (int i = 0; i < 32; ++i) gv[i] = GAIN ? gain[k0 + 64 * half + 2 * i + kh] : 1.f;
#pragma unroll
        for (int i = 0; i < 32; ++i) { const float gs = gv[i] * W8_SCALE; const int k = 64 * half + 2 * i + kh;
            const unsigned pk = (unsigned)__builtin_amdgcn_cvt_pk_fp8_f32(__builtin_amdgcn_fmed3f(v[i][0] * gs, -448.f, 448.f), __builtin_amdgcn_fmed3f(v[i][1] * gs, -448.f, 448.f), 0, false);
            scr[nl2 * 132 + k] = (unsigned char)(pk & 0xffu); scr[(nl2 + 1) * 132 + k] = (unsigned char)((pk >> 8) & 0xffu); } }
    LDS_WAIT(); asm volatile("" ::: "memory");
    const int c = lane & 7;
    const int d0 = dmode == 0 ? n0 : 256 * (n0 >> 7) + (n0 & 127) + (dmode == 2 ? 128 : 0);
#pragma unroll
    for (int j = 0; j < 8; ++j) { const int nl = (lane >> 3) + 8 * j; const LAS unsigned* p = (const LAS unsigned*)(scr + nl * 132 + 16 * c);
        v4u o; o.x = p[0]; o.y = p[1]; o.z = p[2]; o.w = p[3];
        if (n0 + nl < N) *(v4u*)(WT + (size_t)(d0 + nl) * K + k0 + 16 * c) = o; }
    LDS_WAIT(); asm volatile("" ::: "memory");
}

struct Args { const float* in[24]; float* out; unsigned char* ws; int ph_lo, ph_hi; };
__device__ __forceinline__ const float* ain(const Args& a, int i) { return a.in[i]; }
enum { I_X = 0, I_META, I_ANORM, I_WIN, I_GWG, I_GBG, I_GNORM, I_RNORM, I_MQN, I_WUQ, I_MKVN, I_WUKV, I_DLAM, I_DNORM, I_WOUT, I_FNORM, I_FG, I_FU, I_FD, I_ROUTER, I_EG, I_EU, I_ED, I_FINAL };

#ifndef REP_FOLD
#define REP_FOLD 1
#endif
#ifndef REP_HINIT
#define REP_HINIT 1
#endif
__device__ __forceinline__ void wqa_unit(const Args& a, int li, int hh, LAS float* L, int tid) {
    const float* Wuq = ain(a, I_WUQ) + (size_t)li * 192 * 384; const float* Wukv = ain(a, I_WUKV) + (size_t)li * 64 * 512;
    const float* gq = ain(a, I_MQN) + li * 192; const float* gkv = ain(a, I_MKVN) + li * 64;
    bf16* WqaT = (bf16*)(a.ws + WS_WQA + li * WQA_BYTES);
    LAS float* Wqa = L; LAS float* Wuk = L + 192 * 97;
    __syncthreads();
    for (int idx = tid; idx < 64 * 64; idx += 512) { const int n = idx >> 6, m = idx & 63; Wuk[n * 65 + m] = Wukv[n * 512 + hh * 128 + m]; }
    __syncthreads();
    for (int pass = 0; pass < 3; ++pass) { const int i = pass * 64 + (tid >> 3), ng = tid & 7; f32x4 wq[16];
#pragma unroll
        for (int j = 0; j < 16; ++j) wq[j] = *(const f32x4*)(Wuq + i * 384 + hh * 96 + 4 * j);
        const float gi = gq[i];
#pragma unroll
        for (int t = 0; t < 8; ++t) { const int n = ng * 8 + t; float s = 0.f;
#pragma unroll
            for (int j = 0; j < 16; ++j) s += (wq[j][0] * Wuk[n * 65 + 4 * j] + wq[j][1] * Wuk[n * 65 + 4 * j + 1]) + (wq[j][2] * Wuk[n * 65 + 4 * j + 2] + wq[j][3] * Wuk[n * 65 + 4 * j + 3]);
            Wqa[i * 97 + n] = gi * gkv[n] * s; }
        if (ng < 4) {
#pragma unroll
            for (int j = 0; j < 2; ++j) { const f32x4 r = *(const f32x4*)(Wuq + i * 384 + hh * 96 + 64 + ng * 8 + 4 * j); LAS float* d = Wqa + i * 97 + 64 + ng * 8 + 4 * j; d[0] = gi * r[0]; d[1] = gi * r[1]; d[2] = gi * r[2]; d[3] = gi * r[3]; } } }
    __syncthreads();
    for (int idx = tid; idx < 96 * 24; idx += 512) { const int n = idx % 96, i8 = idx / 96; float v[8];
#pragma unroll
        for (int t = 0; t < 8; ++t) v[t] = Wqa[(8 * i8 + t) * 97 + n];
        v4u w; w.x = pk2(v[0], v[1]); w.y = pk2(v[2], v[3]); w.z = pk2(v[4], v[5]); w.w = pk2(v[6], v[7]);
        *(v4u*)(WqaT + (size_t)(hh * 96 + n) * 192 + 8 * i8) = w; }
    __syncthreads();
}
__device__ __forceinline__ void wofold_unit(const Args& a, int li, int hh, int nq, LAS float* L, int tid) {
    const float* Wukv = ain(a, I_WUKV) + (size_t)li * 64 * 512; const float* gkv = ain(a, I_MKVN) + li * 64; const float* Wo = ain(a, I_WOUT) + (size_t)li * DM * DM;
    bf16* Wot = (bf16*)(a.ws + WS_WOT + li * WOT_BYTES);
    LAS float* WuvT = L; LAS float* Wos = L + 64 * 64;
    __syncthreads();
    for (int idx = tid; idx < 64 * 64; idx += 512) { const int j = idx >> 6, e = idx & 63; WuvT[e * 64 + j] = Wukv[j * 512 + hh * 128 + 64 + e] * gkv[j]; }
    for (int idx = tid; idx < 64 * 64; idx += 512) { const int e = idx >> 6, n4 = idx & 63; *(LAS f32x4*)(Wos + e * 256 + 4 * n4) = *(const f32x4*)(Wo + (size_t)(512 + 64 * hh + e) * DM + nq * 256 + 4 * n4); }
    __syncthreads();
    { const int n4 = tid & 63, j8 = tid >> 6; f32x4 acc[8];
#pragma unroll
        for (int j = 0; j < 8; ++j) acc[j] = (f32x4){0.f, 0.f, 0.f, 0.f};
#pragma unroll 4
        for (int e = 0; e < 64; ++e) { const f32x4 wv = *(const LAS f32x4*)(Wos + e * 256 + 4 * n4); const f32x4 u0 = *(const LAS f32x4*)(WuvT + e * 64 + 8 * j8), u1 = *(const LAS f32x4*)(WuvT + e * 64 + 8 * j8 + 4);
#pragma unroll
            for (int j = 0; j < 4; ++j) { acc[j] += wv * u0[j]; acc[4 + j] += wv * u1[j]; } }
#pragma unroll
        for (int t = 0; t < 4; ++t) { v4u w; w.x = pk2(acc[0][t], acc[1][t]); w.y = pk2(acc[2][t], acc[3][t]); w.z = pk2(acc[4][t], acc[5][t]); w.w = pk2(acc[6][t], acc[7][t]);
            *(v4u*)(Wot + (size_t)(nq * 256 + 4 * n4 + t) * DM + 512 + 64 * hh + 8 * j8) = w; } }
    __syncthreads();
}
__device__ __forceinline__ void p0_prologue(const Args& a, LAS unsigned char* lds, int tid, int lane, int wave) {
    const int G = gridDim.x;
    for (int rep = 0; rep < REP_FOLD; ++rep)
    for (int un = blockIdx.x; un < 40; un += G) {
        if (un < 8) wqa_unit(a, un >> 2, un & 3, (LAS float*)lds, tid);
        else { const int v = un - 8; wofold_unit(a, v >> 4, (v >> 2) & 3, v & 3, (LAS float*)lds, tid); }
    }
    __syncthreads();
    LAS float* scr = (LAS float*)(lds + wave * 16384);
    const int gw = blockIdx.x * 8 + wave, NGW = G * 8;
    constexpr int I_IN = 16 * 45, I_WO = 12 * 16, I_G = 16 * 44, I_D = 44 * 16, I_G8 = 8 * 44;
    constexpr int NIT = 2 * I_IN + 2 * I_WO + 2 * I_G + I_D + 2 * I_G8;
    for (int it = gw; it < NIT; it += NGW) {
        int r = it;
        if (r < 2 * I_IN) { const int li = r / I_IN; r %= I_IN; transpose_item<true>(ain(a, I_WIN) + (size_t)li * DM * DIN, DM, DIN, ain(a, I_ANORM) + li * DM, (bf16*)(a.ws + WS_W1T + li * W1T_BYTES), r / 45, r % 45, 0, scr, lane); continue; } r -= 2 * I_IN;
        if (r < 2 * I_WO) { const int li = r / I_WO; r %= I_WO; int kb = r / 16; if (kb >= 8) kb += 4; transpose_item<false>(ain(a, I_WOUT) + (size_t)li * DM * DM, DM, DM, nullptr, (bf16*)(a.ws + WS_WOT + li * WOT_BYTES), kb, r % 16, 0, scr, lane); continue; } r -= 2 * I_WO;
        if (r < I_G) { transpose_item<true>(ain(a, I_FG), DM, DFF, ain(a, I_FNORM), (bf16*)(a.ws + WS_WGU), r / 44, r % 44, 1, scr, lane); continue; } r -= I_G;
        if (r < I_G) { transpose_item<true>(ain(a, I_FU), DM, DFF, ain(a, I_FNORM), (bf16*)(a.ws + WS_WGU), r / 44, r % 44, 2, scr, lane); continue; } r -= I_G;
        if (r < I_D) { transpose_item<false>(ain(a, I_FD), DFF, DM, nullptr, (bf16*)(a.ws + WS_WD), r / 16, r % 16, 0, scr, lane); continue; } r -= I_D;
        if (r < I_G8) { transpose_item_f8<true>(ain(a, I_FG), DM, DFF, ain(a, I_FNORM), a.ws + WS_WGU8, r / 44, r % 44, 1, scr, lane); continue; } r -= I_G8;
        transpose_item_f8<true>(ain(a, I_FU), DM, DFF, ain(a, I_FNORM), a.ws + WS_WGU8, r / 44, r % 44, 2, scr, lane);
    }
    const int gt = blockIdx.x * 512 + tid, NGT = G * 512;
    for (int i = gt; i < 2 * 208 * 128; i += NGT) { const int li = i / (208 * 128), r = i % (208 * 128);
        *(v4u*)(a.ws + WS_W1T + li * W1T_BYTES + (size_t)DIN * DM * 2 + (size_t)r * 16) = (v4u){0u, 0u, 0u, 0u}; }
    for (int i = gt; i < 8 * DM; i += NGT) { const int e = i >> 10, k = i & 1023; ((float*)(a.ws + WS_RT))[i] = ain(a, I_FNORM)[DM + k] * ain(a, I_ROUTER)[k * 8 + e]; }
    for (int i = gt; i < PSEQ * 48; i += NGT) { const int p = i / 48, j = i % 48; const bool isR = j < 32; const int f = isR ? j : j - 32;
        const float inv = __builtin_amdgcn_exp2f(-(float)f * (isR ? 13.287712379549449f / 32.f : 13.287712379549449f / 16.f));
        const double rev = (double)(p - 48) * (double)inv * 0.15915494309189535; const float fr = (float)(rev - __builtin_rint(rev));
        const f32x2 cs = {__builtin_amdgcn_cosf(fr), __builtin_amdgcn_sinf(fr)};
        if (isR) ((f32x2*)(a.ws + WS_TABR))[p * 32 + f] = cs; else ((f32x2*)(a.ws + WS_TABM))[p * 16 + f] = cs; }
    for (int i = gt; i < 240 * 128; i += NGT) *(v4u*)((unsigned char*)a.out + (size_t)(MR + 16) * 2048 + (size_t)i * 16) = (v4u){0u, 0u, 0u, 0u};
    bf16* hb = (bf16*)(a.ws + WS_HB); float* stA = (float*)(a.ws + WS_STA);
    for (int rep = 0; rep < REP_HINIT; ++rep)
    for (int r = gw; r < MROWS; r += NGW) {
        f32x4 v[4]; float s = 0.f;
#pragma unroll
        for (int j = 0; j < 4; ++j) { if (r < MR) v[j] = ((const f32x4*)(ain(a, I_X) + (size_t)r * DM))[lane + 64 * j]; else if (r < MR + NMETA) v[j] = ((const f32x4*)(ain(a, I_META) + (size_t)(r - MR) * DM))[lane + 64 * j]; else v[j] = (f32x4){0.f, 0.f, 0.f, 0.f};
            s += (v[j][0] * v[j][0] + v[j][1] * v[j][1]) + (v[j][2] * v[j][2] + v[j][3] * v[j][3]); }
        s = wave_sum(s);
#pragma unroll
        for (int j = 0; j < 4; ++j) { v2u w; w.x = pk2(v[j][0], v[j][1]); w.y = pk2(v[j][2], v[j][3]); ((v2u*)(hb + (size_t)r * DM))[lane + 64 * j] = w; }
        if (lane < 16) stA[(size_t)r * 16 + lane] = lane == 0 ? s : 0.f;
    }
}

__device__ __forceinline__ int src_row(int b, int c, int i) { return c == 0 ? (i < 48 ? -1 : MR + i - 48) : b * TT + 64 * (c - 1) + i; }
__device__ __forceinline__ float lg2gamma(int h) { return h == 0 ? -0.045803689613124789f : h == 1 ? -0.022720076500083529f : h == 2 ? -0.011315313227834146f : -0.0056465631411420627f; }

__device__ __forceinline__ void route_block(const Args& a, int blk, LAS unsigned char* lds, int tid, int lane, int wave) {
    LAS float* Rs = (LAS float*)lds; LAS int* lcnt = (LAS int*)(lds + 32768); LAS int* gbase = lcnt + 8; LAS int* rec = lcnt + 16;
    gu32* ctl = (gu32*)(a.ws + WS_CTL);
    const float* Rt = (const float*)(a.ws + WS_RT); const bf16* hb = (const bf16*)(a.ws + WS_HB); const float* stB = (const float*)(a.ws + WS_STB);
    __syncthreads();
    { f32x4 rv[4];
#pragma unroll
      for (int i = 0; i < 4; ++i) rv[i] = ((const f32x4*)Rt)[tid + 512 * i];
#pragma unroll
      for (int i = 0; i < 4; ++i) ((LAS f32x4*)Rs)[tid + 512 * i] = rv[i]; }
    if (tid < 8) lcnt[tid] = 0;
    __syncthreads();
    v4u nw0, nw1; float nst;
    { const int row = blk * 128 + wave * 16; nw0 = *(const v4u*)(hb + (size_t)row * DM + 8 * lane); nw1 = *(const v4u*)(hb + (size_t)row * DM + 512 + 8 * lane); nst = lane < 16 ? stB[(size_t)row * 16 + lane] : 0.f; }
    for (int rr = 0; rr < 16; ++rr) { const int rl = wave * 16 + rr, row = blk * 128 + rl;
        const v4u w0 = nw0, w1 = nw1; float st = nst;
        if (rr + 1 < 16) { const int rn = row + 1; nw0 = *(const v4u*)(hb + (size_t)rn * DM + 8 * lane); nw1 = *(const v4u*)(hb + (size_t)rn * DM + 512 + 8 * lane); nst = lane < 16 ? stB[(size_t)rn * 16 + lane] : 0.f; }
        const float x[16] = {bflo(w0.x), bfhi(w0.x), bflo(w0.y), bfhi(w0.y), bflo(w0.z), bfhi(w0.z), bflo(w0.w), bfhi(w0.w), bflo(w1.x), bfhi(w1.x), bflo(w1.y), bfhi(w1.y), bflo(w1.z), bfhi(w1.z), bflo(w1.w), bfhi(w1.w)};
        { const unsigned q0 = pk4_fp8(x[0], x[1], x[2], x[3]), q1 = pk4_fp8(x[4], x[5], x[6], x[7]), q2 = pk4_fp8(x[8], x[9], x[10], x[11]), q3 = pk4_fp8(x[12], x[13], x[14], x[15]);
          unsigned char* h8 = a.ws + B_HB8 + (size_t)row * DM;
          *(uint2*)(h8 + 8 * lane) = make_uint2(q0, q1); *(uint2*)(h8 + 512 + 8 * lane) = make_uint2(q2, q3); }
        st = wave_sum(st); const float rs = __builtin_amdgcn_rsqf(st * (1.f / 1024.f) + EPS);
        float s8[8];
#pragma unroll
        for (int e = 0; e < 8; ++e) { float s = 0.f;
#pragma unroll
            for (int t = 0; t < 8; ++t) s += x[t] * Rs[e * DM + 8 * lane + t] + x[8 + t] * Rs[e * DM + 512 + 8 * lane + t];
            s8[e] = s; }
        const bool b5 = (lane & 32) != 0, b4 = (lane & 16) != 0, b3 = (lane & 8) != 0;
        float t4[4], u2[2], vv;
#pragma unroll
        for (int i = 0; i < 4; ++i) { const float send = b5 ? s8[i] : s8[i + 4], keep = b5 ? s8[i + 4] : s8[i]; t4[i] = keep + __shfl_xor(send, 32); }
#pragma unroll
        for (int i = 0; i < 2; ++i) { const float send = b4 ? t4[i] : t4[i + 2], keep = b4 ? t4[i + 2] : t4[i]; u2[i] = keep + __shfl_xor(send, 16); }
        { const float send = b3 ? u2[0] : u2[1], keep = b3 ? u2[1] : u2[0]; vv = keep + __shfl_xor(send, 8); }
        vv += __shfl_xor(vv, 4); vv += __shfl_xor(vv, 2); vv += __shfl_xor(vv, 1);
        float lg[8];
#pragma unroll
        for (int e = 0; e < 8; ++e) lg[e] = __int_as_float(__builtin_amdgcn_readlane(__float_as_int(vv), 8 * e)) * rs;
        int e0 = 0; float v0 = lg[0];
#pragma unroll
        for (int e = 1; e < 8; ++e) if (lg[e] > v0) { v0 = lg[e]; e0 = e; }
        int e1 = -1; float v1 = -3.0e38f;
#pragma unroll
        for (int e = 0; e < 8; ++e) if (e != e0 && lg[e] > v1) { v1 = lg[e]; e1 = e; }
        const float g0 = 1.f / (1.f + __expf(v1 - v0)), g1 = 1.f - g0;
        if (lane == 0) { const int lp0 = atomicAdd((int*)(lcnt + e0), 1), lp1 = atomicAdd((int*)(lcnt + e1), 1);
            rec[rl * 6] = e0; rec[rl * 6 + 1] = e1; rec[rl * 6 + 2] = lp0; rec[rl * 6 + 3] = lp1; rec[rl * 6 + 4] = __float_as_int(g0); rec[rl * 6 + 5] = __float_as_int(g1); } }
    __syncthreads();
    if (tid < 8) gbase[tid] = (int)__hip_atomic_fetch_add(ctl + CW_CNT + 64 * tid, (unsigned)lcnt[tid], RLX_AGENT);
    __syncthreads();
    if (tid < 256) { const int rl = tid >> 1, s = tid & 1, tok = blk * 128 + rl, e = rec[rl * 6 + s];
        ((int*)(a.ws + MO_TOKE))[tok * 2 + s] = e; ((int*)(a.ws + MO_TOKP))[tok * 2 + s] = gbase[e] + rec[rl * 6 + 2 + s]; ((int*)(a.ws + MO_TOKW))[tok * 2 + s] = rec[rl * 6 + 4 + s]; }
    __syncthreads();
}
__device__ __forceinline__ void moe_offsets(const Args& a, LAS int* offs, int tid) {
    gu32* ctl = (gu32*)(a.ws + WS_CTL);
    __syncthreads();
    if (tid < 8) offs[16 + tid] = (int)__hip_atomic_load(ctl + CW_CNT + 64 * tid, RLX_AGENT);
    __syncthreads();
    if (tid == 0) { int o = 0;
        for (int e = 0; e < 8; ++e) { const int cnt = offs[16 + e]; offs[e] = o * 256; o += (cnt + 255) >> 8; }
        offs[8] = o; }
    __syncthreads();
}

typedef float f32x16 __attribute__((ext_vector_type(16)));
typedef short s16x8 __attribute__((ext_vector_type(8)));
typedef short s16x4 __attribute__((ext_vector_type(4)));
typedef short v4i16_t __attribute__((ext_vector_type(4)));
__device__ __forceinline__ int crow(int r, int hi) { return (r & 3) + 8 * (r >> 2) + 4 * hi; }


__device__ __forceinline__ void stage_cols(const bf16* proj, int b, int c, int col0, int ncols, LAS bf16* S, int sst, int lcol0, int tid) {
    const int cpr = ncols >> 3;
    for (int idx = tid; idx < 64 * cpr; idx += 512) { const int i = idx / cpr, ch = idx - i * cpr, sr = src_row(b, c, i);
        v4u v = {0u, 0u, 0u, 0u}; if (sr >= 0) v = *(const v4u*)(proj + (size_t)sr * N1 + col0 + ch * 8);
        *(LAS v4u*)(S + i * sst + lcol0 + ch * 8) = v; }
}
__device__ __forceinline__ v4u gather8(const LAS bf16* S, int sst, int row0, int col) {
    unsigned x[8];
#pragma unroll
    for (int t = 0; t < 8; ++t) x[t] = S[(row0 + t) * sst + col];
    v4u w; w.x = x[0] | (x[1] << 16); w.y = x[2] | (x[3] << 16); w.z = x[4] | (x[5] << 16); w.w = x[6] | (x[7] << 16); return w;
}
__device__ __forceinline__ void prep2_unit(const Args& a, int li, int b, int c, int part, LAS unsigned char* lds, int tid) {
    const bf16* proj = (const bf16*)(a.ws + B_PROJ);
    LAS bf16* S = (LAS bf16*)lds;
    const int blk0 = (b * NCH + c) * 4; const size_t prow0 = (size_t)b * PSEQ + 64 * c;
    unsigned char* dout = (unsigned char*)a.out;
    __syncthreads();
    if (part == 0) {
        constexpr int SST = 536; LAS float* seg = (LAS float*)(lds + 64 * SST * 2);
        stage_cols(proj, b, c, C_AQ, 128, S, SST, 0, tid); stage_cols(proj, b, c, C_AK, 128, S, SST, 128, tid); stage_cols(proj, b, c, C_ALR, 16, S, SST, 512, tid);
        __syncthreads();
        { const int ch = tid & 127, sg = tid >> 7; const float* Wg = ain(a, I_GWG) + (size_t)li * 16 * 128; const float bg = ain(a, I_GBG)[li * 128 + ch];
            float wg[16];
#pragma unroll
            for (int r = 0; r < 16; ++r) wg[r] = Wg[r * 128 + ch];
            float cl[16]; float run = 0.f;
#pragma unroll
            for (int t = 0; t < 16; ++t) { const int i = 16 * sg + t; const v4u l0 = *(const LAS v4u*)(S + i * SST + 512), l1 = *(const LAS v4u*)(S + i * SST + 520);
                float x = bg + bflo(l0.x) * wg[0] + bfhi(l0.x) * wg[1] + bflo(l0.y) * wg[2] + bfhi(l0.y) * wg[3] + bflo(l0.z) * wg[4] + bfhi(l0.z) * wg[5] + bflo(l0.w) * wg[6] + bfhi(l0.w) * wg[7]
                               + bflo(l1.x) * wg[8] + bfhi(l1.x) * wg[9] + bflo(l1.y) * wg[10] + bfhi(l1.y) * wg[11] + bflo(l1.z) * wg[12] + bfhi(l1.z) * wg[13] + bflo(l1.w) * wg[14] + bfhi(l1.w) * wg[15];
                const float ls = fminf(x, 0.f) - __logf(1.f + __expf(-fabsf(x)));
                run += (c > 0 || i >= 48) ? ls * (1.f / 16.f) : 0.f; cl[t] = run; }
            seg[sg * 128 + ch] = run;
            __syncthreads();
            float off = 0.f;
#pragma unroll
            for (int s2 = 0; s2 < 3; ++s2) off += s2 < sg ? seg[s2 * 128 + ch] : 0.f;
            if (sg == 3) ((float*)(a.ws + WS_GD))[(size_t)(blk0 + (ch >> 5)) * 32 + (ch & 31)] = __expf(off + run);
#pragma unroll
            for (int t = 0; t < 16; ++t) { const int i = 16 * sg + t; const float cum = cl[t] + off;
                S[i * SST + ch] = (bf16)f2bf(bf2f(S[i * SST + ch]) * 0.17677669529663687f * __expf(cum)); S[i * SST + 128 + ch] = (bf16)f2bf(bf2f(S[i * SST + 128 + ch]) * __expf(-cum)); } }
        __syncthreads();
        for (int idx = tid; idx < 1024; idx += 512) { const int d8 = idx & 3, i = (idx >> 2) & 63, h = idx >> 8;
            *(v4u*)(a.ws + B_GQ + (size_t)(blk0 + h) * GQ_T + i * 80 + 16 * d8) = *(const LAS v4u*)(S + i * SST + h * 32 + 8 * d8);
            *(v4u*)(a.ws + B_GK + (size_t)(blk0 + h) * GQ_T + i * 80 + 16 * d8) = *(const LAS v4u*)(S + i * SST + 128 + h * 32 + 8 * d8); }
    } else if (part == 1) {
        constexpr int SST = 776;
        stage_cols(proj, b, c, C_RQ, 256, S, SST, 0, tid); stage_cols(proj, b, c, C_RK, 256, S, SST, 256, tid);
        LAS f32x4* tabL = (LAS f32x4*)(lds + 64 * SST * 2);
        for (int idx = tid; idx < 64 * 16; idx += 512) tabL[idx] = ((const f32x4*)(a.ws + WS_TABR))[(size_t)(64 * c) * 16 + idx];
        __syncthreads();
        const LAS f32x2* tabR = (const LAS f32x2*)tabL;
        for (int idx = tid; idx < 64 * 4 * 32; idx += 512) { const int j = idx & 31, h = (idx >> 5) & 3, i = idx >> 7; const f32x2 cs = tabR[i * 32 + j];
            LAS bf16* qp = S + i * SST + h * 64 + j; LAS bf16* kp = qp + 256;
            const float a1 = bf2f(qp[0]), a2 = bf2f(qp[32]), b1 = bf2f(kp[0]), b2 = bf2f(kp[32]);
            const float e = (float)(i + 1) * lg2gamma(h); const float fq = __builtin_amdgcn_exp2f(e), fk = 0.125f * __builtin_amdgcn_exp2f(-e);
            qp[0] = (bf16)f2bf((a1 * cs[0] - a2 * cs[1]) * fq); qp[32] = (bf16)f2bf((a1 * cs[1] + a2 * cs[0]) * fq); kp[0] = (bf16)f2bf((b1 * cs[0] - b2 * cs[1]) * fk); kp[32] = (bf16)f2bf((b1 * cs[1] + b2 * cs[0]) * fk); }
        __syncthreads();
        for (int idx = tid; idx < 2048; idx += 512) { const int d8 = idx & 7, i = (idx >> 3) & 63, h = idx >> 9;
            *(v4u*)(a.ws + B_RQ + (size_t)(blk0 + h) * RT_T + i * 144 + 16 * d8) = *(const LAS v4u*)(S + i * SST + h * 64 + 8 * d8);
            *(v4u*)(a.ws + B_RK + (size_t)(blk0 + h) * RT_T + i * 144 + 16 * d8) = *(const LAS v4u*)(S + i * SST + 256 + h * 64 + 8 * d8); }
    } else if (part == 2) {
        constexpr int SST = 296, OFF_RSD = 64 * SST * 2, OFF_TAB = OFF_RSD + 512, OFF_QS = OFF_TAB + 8192, QSS = 392;
        LAS float* rsd = (LAS float*)(lds + OFF_RSD); LAS f32x4* tabL = (LAS f32x4*)(lds + OFF_TAB); LAS bf16* Qs = (LAS bf16*)(lds + OFF_QS);
        stage_cols(proj, b, c, C_CQ, 192, S, SST, 0, tid); stage_cols(proj, b, c, C_CKV, 64, S, SST, 192, tid); stage_cols(proj, b, c, C_KPE, 32, S, SST, 256, tid);
        for (int idx = tid; idx < 64 * 8; idx += 512) tabL[idx] = ((const f32x4*)(a.ws + WS_TABM))[(size_t)(64 * c) * 8 + idx];
        __syncthreads();
        { const int i = tid >> 3, g = tid & 7; float sq = 0.f, sk = 0.f;
#pragma unroll
            for (int t = 0; t < 24; ++t) { const float v = bf2f(S[i * SST + g * 24 + t]); sq += v * v; }
#pragma unroll
            for (int t = 0; t < 8; ++t) { const float v = bf2f(S[i * SST + 192 + g * 8 + t]); sk += v * v; }
            sq += __shfl_xor(sq, 1); sq += __shfl_xor(sq, 2); sq += __shfl_xor(sq, 4); sk += __shfl_xor(sk, 1); sk += __shfl_xor(sk, 2); sk += __shfl_xor(sk, 4);
            if (g == 0) { rsd[i * 2] = __builtin_amdgcn_rsqf(sq * (1.f / 192.f) + EPS); rsd[i * 2 + 1] = __builtin_amdgcn_rsqf(sk * (1.f / 64.f) + EPS); } }
        __syncthreads();
        const LAS f32x2* tabM = (const LAS f32x2*)tabL; const float QS = 0.10206207261596577f * LOG2E;
        {
            const int lane = tid & 63, w = __builtin_amdgcn_readfirstlane(tid >> 6), r32 = lane & 31, hi = lane >> 5, ib = w & 1, nb0 = (w >> 1) * 3;
            const bf16* WqaT = (const bf16*)(a.ws + WS_WQA + li * WQA_BYTES);
            s16x8 af[12];
#pragma unroll
            for (int ks = 0; ks < 12; ++ks) af[ks] = *(const LAS s16x8*)(S + (32 * ib + r32) * SST + 16 * ks + 8 * hi);
            f32x16 acc[3];
#pragma unroll
            for (int j = 0; j < 3; ++j) { acc[j] = (f32x16){};
                s16x8 bfr[12];
#pragma unroll
                for (int ks = 0; ks < 12; ++ks) bfr[ks] = *(const s16x8*)(WqaT + (size_t)(32 * (nb0 + j) + r32) * 192 + 16 * ks + 8 * hi);
#pragma unroll
                for (int ks = 0; ks < 12; ++ks) acc[j] = __builtin_amdgcn_mfma_f32_32x32x16_bf16(af[ks], bfr[ks], acc[j], 0, 0, 0); }
            asm volatile("s_nop 15\n\ts_nop 7" : "+v"(acc[0]), "+v"(acc[1]), "+v"(acc[2]));
#pragma unroll
            for (int j = 0; j < 3; ++j)
#pragma unroll
                for (int r = 0; r < 16; ++r) { const int i = 32 * ib + crow(r, hi); float v = acc[j][r] * (rsd[i * 2] * QS);
                    if (j == 2) { const float o = __shfl_xor(v, 16); const f32x2 cs = tabM[i * 16 + (r32 & 15)]; v = r32 < 16 ? v * cs[0] - o * cs[1] : o * cs[1] + v * cs[0]; }
                    Qs[i * QSS + 32 * (nb0 + j) + r32] = (bf16)f2bf(v); } }
        for (int idx = tid; idx < 64 * 12; idx += 512) { const int k8 = idx % 12, i = idx / 12; float y[8];
            if (k8 < 8) { const float s = rsd[i * 2 + 1];
#pragma unroll
                for (int t = 0; t < 8; ++t) y[t] = bf2f(S[i * SST + 192 + 8 * k8 + t]) * s; }
            else { const int kk = (k8 - 8) & 1, second = (k8 - 8) >> 1;
#pragma unroll
                for (int t = 0; t < 8; ++t) { const int j = 8 * kk + t; const f32x2 cs = tabM[i * 16 + j]; const float x1 = bf2f(S[i * SST + 256 + j]), x2 = bf2f(S[i * SST + 272 + j]); y[t] = second ? x1 * cs[1] + x2 * cs[0] : x1 * cs[0] - x2 * cs[1]; } }
            v4u w; w.x = pk2(y[0], y[1]); w.y = pk2(y[2], y[3]); w.z = pk2(y[4], y[5]); w.w = pk2(y[6], y[7]);
            *(v4u*)((bf16*)(a.ws + B_MK) + (prow0 + i) * 96 + 8 * k8) = w; }
        __syncthreads();
        for (int idx = tid; idx < 64 * 48; idx += 512) { const int c8 = idx % 48, i = idx / 48;
            *(v4u*)((bf16*)(a.ws + B_MQ) + (prow0 + i) * 384 + 8 * c8) = *(const LAS v4u*)(Qs + i * QSS + 8 * c8); }
    }
}

template <int KIND>
__device__ __forceinline__ void attn_mfma_unit(const Args& a, int li, int b, int hh, int qb  , LAS unsigned char* lds, int tid, float lam, float oscale) {
    constexpr int KW = KIND ? 64 : 96, KST = KW + 8, VST = 72, NMAP = KIND ? 2 : 1, DSTEPS = KIND ? 2 : 6;
    constexpr int KCH = KW / 8 + 1, VCH = 12  , NPIECE = KCH + (KIND ? VCH : 0), PPW = KIND ? 3 : 2, SLOT = NPIECE * 1024, NSLOT = 4, OFF_JUNK = NSLOT * SLOT, OFF_WS = OFF_JUNK + 6144, OSTW = 68, OFF_OST = KIND ? 0   : OFF_WS + 2048;
    static_assert(PPW * 8 >= NPIECE && PPW * 8 - NPIECE <= 6 && (KIND ? 8 * 32 * OSTW * 4 <= NSLOT * SLOT : OFF_OST + 8 * 32 * OSTW * 4 <= RING_BYTES) && OFF_WS + 8 * 256 <= RING_BYTES, "attention LDS map / pieces per wave");
    const int lane = tid & 63, w = __builtin_amdgcn_readfirstlane(tid >> 6), r32 = lane & 31, hi = lane >> 5;
    const int q0 = qb < 0 ? 0 : 64 + 256 * qb, NT = qb < 0 ? 1 : 5 + 4 * qb;
    const bool wact = qb >= 0 || w < 2;
    const int qpos = q0 + 32 * w + r32, wlast = (q0 + 32 * w + 31) >> 6;
    const size_t prow = (size_t)b * PSEQ + qpos;
    const bf16* proj = (const bf16*)(a.ws + B_PROJ);
    const bf16* Kg = KIND ? proj + C_DK + hh * 64 : (const bf16*)(a.ws + B_MK) + (size_t)b * PSEQ * 96;
    constexpr int KLD = KIND ? N1 : 96;
    const bf16* Vg = proj + C_DV + hh * 64;
#define ATT_SRCROW(t_, r_) (KIND ? ((t_) == 0 ? ((r_) < 48 ? MR : MR + (r_) - 48) : b * TT + 64 * ((t_) - 1) + (r_)) : 64 * (t_) + (r_))
    LAS float* wsf = (LAS float*)(lds + OFF_WS) + w * 64;
    LAS float* ost = (LAS float*)(lds + OFF_OST) + w * (32 * OSTW);
    s16x8 qf[NMAP][DSTEPS];
    { v4u qraw[NMAP][DSTEPS];
#pragma unroll
      for (int m = 0; m < NMAP; ++m)
#pragma unroll
        for (int ds = 0; ds < DSTEPS; ++ds) {
            const int qsr = qb >= 0 ? b * TT + qpos - 64 : (qpos >= 48 ? MR + qpos - 48 : MR);
            const bf16* qp = KIND ? proj + (size_t)qsr * N1 + C_DQ + hh * 64 + 32 * m + 16 * ds + 8 * hi : (const bf16*)(a.ws + B_MQ) + prow * 384 + hh * 96 + 16 * ds + 8 * hi;
            qraw[m][ds] = wact ? *(const v4u*)qp : (v4u){0u, 0u, 0u, 0u}; }
      asm volatile("" ::: "memory");
#pragma unroll
      for (int m = 0; m < NMAP; ++m)
#pragma unroll
        for (int ds = 0; ds < DSTEPS; ++ds) { v4u qw = qraw[m][ds];
            if (KIND) { const float qs = 0.17677669529663687f * LOG2E;
                qw.x = pg8::cvt_pk_bf16(bflo(qw.x) * qs, bfhi(qw.x) * qs); qw.y = pg8::cvt_pk_bf16(bflo(qw.y) * qs, bfhi(qw.y) * qs); qw.z = pg8::cvt_pk_bf16(bflo(qw.z) * qs, bfhi(qw.z) * qs); qw.w = pg8::cvt_pk_bf16(bflo(qw.w) * qs, bfhi(qw.w) * qs); }
            qf[m][ds] = __builtin_bit_cast(s16x8, qw); } }
    float mref[NMAP], lrun[NMAP]; f32x16 negm = (f32x16){}, o[NMAP][2];
#pragma unroll
    for (int m = 0; m < NMAP; ++m) { mref[m] = 0.f; lrun[m] = 0.f; o[m][0] = (f32x16){}; o[m][1] = (f32x16){}; }
#define ATT_DMA(t_) do { const int sl_ = ((t_) & 3) * SLOT; _Pragma("unroll") for (int j = 0; j < PPW; ++j) { const int p_ = __builtin_amdgcn_readfirstlane(w * PPW + j); \
        int row_, col_, dst_; const bf16* base_; int ld_; \
        if (p_ < KCH) { const int g = 64 * p_ + lane, cc = g % KCH; row_ = g / KCH; col_ = (cc < KCH - 1 ? cc : KCH - 2) * 8; dst_ = sl_ + p_ * 1024; base_ = Kg; ld_ = KLD; } \
        else if (p_ < NPIECE) { const int g = 64 * (p_ - KCH) + lane, cc = g % VCH; row_ = g / VCH; col_ = (cc < 8 ? cc : 7) * 8; dst_ = sl_ + p_ * 1024; base_ = Vg; ld_ = N1; } \
        else { row_ = lane & 15; col_ = 0; dst_ = OFF_JUNK + (p_ - NPIECE) * 1024; base_ = Kg; ld_ = KLD; } \
        const bf16* s_ = base_ + (size_t)ATT_SRCROW((t_), row_) * ld_ + col_; \
        __builtin_amdgcn_global_load_lds((const unsigned*)s_, (LAS unsigned*)(lds + __builtin_amdgcn_readfirstlane(dst_)), 16, 0, 0); } } while (0)
    unsigned voff[PPW];
#pragma unroll
    for (int j = 0; j < PPW; ++j) { const int p_ = __builtin_amdgcn_readfirstlane(w * PPW + j); int row_, col_, ld_;
        if (p_ < KCH) { const int g = 64 * p_ + lane, cc = g % KCH; row_ = g / KCH; col_ = (cc < KCH - 1 ? cc : KCH - 2) * 8; ld_ = KLD; }
        else if (p_ < NPIECE) { const int g = 64 * (p_ - KCH) + lane, cc = g % VCH; row_ = g / VCH; col_ = (cc < 8 ? cc : 7) * 8; ld_ = N1; }
        else { row_ = lane & 15; col_ = 0; ld_ = KLD; }
        voff[j] = (unsigned)(row_ * ld_ + col_) * 2u; }
#define ATT_DMA_F(t_) do { const int sl_ = ((t_) & 3) * SLOT; const int rb_ = KIND ? b * TT + 64 * ((t_) - 1) : 64 * (t_); _Pragma("unroll") for (int j = 0; j < PPW; ++j) { const int p_ = __builtin_amdgcn_readfirstlane(w * PPW + j); \
        const bool isv_ = p_ >= KCH && p_ < NPIECE; \
        const unsigned char* sb_ = (const unsigned char*)(isv_ ? Vg : Kg) + (size_t)rb_ * (size_t)((isv_ ? N1 : KLD) * 2); \
        const int dst_ = p_ < NPIECE ? sl_ + p_ * 1024 : OFF_JUNK + (p_ - NPIECE) * 1024; \
        __builtin_amdgcn_global_load_lds((const unsigned*)(sb_ + voff[j]), (LAS unsigned*)(lds + __builtin_amdgcn_readfirstlane(dst_)), 16, 0, 0); } } while (0)
#define ATT_BAR() do { asm volatile("s_waitcnt lgkmcnt(0)" ::: "memory"); __builtin_amdgcn_s_barrier(); asm volatile("" ::: "memory"); } while (0)
    ATT_BAR();
    if (w >= 4) __builtin_amdgcn_s_setprio(1);
    ATT_DMA(0); if (NT > 1) ATT_DMA(1); if (NT > 2) ATT_DMA(2);
    for (int t = 0; t < NT; ++t) {
        if (t + 2 < NT) { if (KIND) asm volatile("s_waitcnt vmcnt(6)" ::: "memory"); else asm volatile("s_waitcnt vmcnt(4)" ::: "memory"); } else if (t + 1 < NT) { if (KIND) asm volatile("s_waitcnt vmcnt(3)" ::: "memory"); else asm volatile("s_waitcnt vmcnt(2)" ::: "memory"); } else asm volatile("s_waitcnt vmcnt(0)" ::: "memory");
        ATT_BAR();
        if (t + 3 < NT) ATT_DMA_F(t + 3);
        if (wact && t <= wlast) {
            const LAS unsigned char* Kb = lds + (t & 3) * SLOT; const LAS unsigned char* Vb = KIND ? Kb + KCH * 1024 : Kb;
            const bool need_mask = (t == 0) || (64 * t + 63 > q0 + 32 * w);
            constexpr int VRB = KIND ? VCH * 16 : KST * 2;
            const LAS unsigned char* vp0 = Vb + (4 * hi + ((lane & 15) >> 2)) * VRB + (16 * ((lane >> 4) & 1)) * 2 + 8 * (lane & 3);
            const unsigned vad = (unsigned)(unsigned long)vp0;
#define ATT_VTR(o_) ({ s16x4 r_; asm volatile("ds_read_b64_tr_b16 %0, %1 offset:%2" : "=v"(r_) : "v"(vad), "n"(o_)); r_; })
#define ATT_VFRAG(d0_, ks_) ({ const s16x4 va_ = ATT_VTR(16 * (ks_) * VRB + 64 * (d0_)), vb_ = ATT_VTR(16 * (ks_) * VRB + 64 * (d0_) + 8 * VRB); \
        (s16x8){va_[0], va_[1], va_[2], va_[3], vb_[0], vb_[1], vb_[2], vb_[3]}; })
#define ATT_VWAIT(v_) asm volatile("s_waitcnt lgkmcnt(0)" : "+v"(v_[0]), "+v"(v_[1]), "+v"(v_[2]), "+v"(v_[3]))
            s16x8 vfr0[4];
            vfr0[0] = ATT_VFRAG(0, 0); vfr0[1] = ATT_VFRAG(0, 1); vfr0[2] = ATT_VFRAG(0, 2); vfr0[3] = ATT_VFRAG(0, 3);
            __builtin_amdgcn_sched_barrier(0);
#pragma unroll
            for (int m = 0; m < NMAP; ++m) {
                f32x16 p0, p1;
                if (KIND) { const float nm = -mref[m];
#pragma unroll
                    for (int r = 0; r < 16; ++r) { p0[r] = nm; p1[r] = nm; } }
                else { p0 = negm; p1 = negm; }
                constexpr int KBATCH = KIND ? DSTEPS : 3;
#pragma unroll
                for (int d1 = 0; d1 < DSTEPS; d1 += KBATCH) {
                    s16x8 kfr[KBATCH][2];
#pragma unroll
                    for (int ds = 0; ds < KBATCH; ++ds) { kfr[ds][0] = *(const LAS s16x8*)(Kb + (r32 * KST + 32 * m * KIND + 16 * (d1 + ds) + 8 * hi) * 2); kfr[ds][1] = *(const LAS s16x8*)(Kb + ((32 + r32) * KST + 32 * m * KIND + 16 * (d1 + ds) + 8 * hi) * 2); }
                    __builtin_amdgcn_sched_barrier(0);

#pragma unroll
                    for (int ds = 0; ds < KBATCH; ++ds) { p0 = __builtin_amdgcn_mfma_f32_32x32x16_bf16(kfr[ds][0], qf[m][d1 + ds], p0, 0, 0, 0); p1 = __builtin_amdgcn_mfma_f32_32x32x16_bf16(kfr[ds][1], qf[m][d1 + ds], p1, 0, 0, 0); }

                    __builtin_amdgcn_sched_barrier(0); }
                asm volatile("s_nop 15\n\ts_nop 7" : "+v"(p0), "+v"(p1));

                if (need_mask) {
#pragma unroll
                    for (int r = 0; r < 16; ++r) { const int kv = 64 * t + crow(r, hi);
                        if (kv > qpos || kv < 48) p0[r] = -1e30f;
                        if (kv + 32 > qpos || kv + 32 < 48) p1[r] = -1e30f; } }
                float mx, mxb;
                asm("v_max3_f32 %0, %1, %2, %3" : "=v"(mx) : "v"(p0[0]), "v"(p1[0]), "v"(p0[1]));
                asm("v_max3_f32 %0, %1, %2, %3" : "=v"(mxb) : "v"(p1[1]), "v"(p0[2]), "v"(p1[2]));
#pragma unroll
                for (int r = 3; r < 16; r += 2) { asm("v_max3_f32 %0, %1, %2, %3" : "=v"(mx) : "v"(mx), "v"(p0[r]), "v"(p1[r]));
                    if (r + 1 < 16) asm("v_max3_f32 %0, %1, %2, %3" : "=v"(mxb) : "v"(mxb), "v"(p0[r + 1]), "v"(p1[r + 1])); }
                asm("v_max_f32 %0, %1, %2" : "=v"(mx) : "v"(mx), "v"(mxb));
                { auto rr = __builtin_amdgcn_permlane32_swap(__float_as_uint(mx), __float_as_uint(mx), false, false); asm("v_max_f32 %0, %1, %2" : "=v"(mx) : "v"(__uint_as_float(rr[0])), "v"(__uint_as_float(rr[1]))); }
                if (t == 0 || __any(mx > 6.0f)) {
                    const float delta = t == 0 ? mx : fmaxf(mx, 0.f); mref[m] += delta;
#pragma unroll
                    for (int r = 0; r < 16; ++r) { p0[r] -= delta; p1[r] -= delta; if (!KIND) negm[r] = -mref[m]; }
                    if (t != 0) { const float alpha = __builtin_amdgcn_exp2f(-delta); lrun[m] *= alpha;
                        if (hi == 0) wsf[r32] = alpha;
                        f32x4 al[4];
#pragma unroll
                        for (int g = 0; g < 4; ++g) al[g] = *(const LAS f32x4*)(wsf + 8 * g + 4 * hi);
#pragma unroll
                        for (int r = 0; r < 16; ++r) { o[m][0][r] *= al[r >> 2][r & 3]; o[m][1][r] *= al[r >> 2][r & 3]; } } }
#pragma unroll
                for (int r = 0; r < 16; ++r) { p0[r] = __builtin_amdgcn_exp2f(p0[r]); p1[r] = __builtin_amdgcn_exp2f(p1[r]); }
                { f32x2 l2 = (f32x2){0.f, 0.f};
#pragma unroll
                  for (int r = 0; r < 16; r += 2) { l2 += (f32x2){p0[r], p0[r + 1]}; l2 += (f32x2){p1[r], p1[r + 1]}; }
                  lrun[m] += l2[0] + l2[1]; }
                s16x8 pw[4];
#pragma unroll
                for (int ks = 0; ks < 4; ++ks) { v4u u;
                    if (ks < 2) { u.x = pg8::cvt_pk_bf16(p0[8 * ks], p0[8 * ks + 1]); u.y = pg8::cvt_pk_bf16(p0[8 * ks + 2], p0[8 * ks + 3]); u.z = pg8::cvt_pk_bf16(p0[8 * ks + 4], p0[8 * ks + 5]); u.w = pg8::cvt_pk_bf16(p0[8 * ks + 6], p0[8 * ks + 7]); }
                    else { const int k2 = ks - 2; u.x = pg8::cvt_pk_bf16(p1[8 * k2], p1[8 * k2 + 1]); u.y = pg8::cvt_pk_bf16(p1[8 * k2 + 2], p1[8 * k2 + 3]); u.z = pg8::cvt_pk_bf16(p1[8 * k2 + 4], p1[8 * k2 + 5]); u.w = pg8::cvt_pk_bf16(p1[8 * k2 + 6], p1[8 * k2 + 7]); }
                    pw[ks] = __builtin_bit_cast(s16x8, u); }

                { s16x8 vfr1[4];
                    vfr1[0] = ATT_VFRAG(1, 0); vfr1[1] = ATT_VFRAG(1, 1); vfr1[2] = ATT_VFRAG(1, 2); vfr1[3] = ATT_VFRAG(1, 3);
                    if (m == 0) ATT_VWAIT(vfr0);
                    __builtin_amdgcn_sched_barrier(0);
#pragma unroll
                    for (int ks = 0; ks < 4; ++ks) o[m][0] = __builtin_amdgcn_mfma_f32_32x32x16_bf16(pw[ks], vfr0[ks], o[m][0], 0, 0, 0);
                    __builtin_amdgcn_sched_barrier(0);
                    ATT_VWAIT(vfr1);
                    __builtin_amdgcn_sched_barrier(0);
#pragma unroll
                    for (int ks = 0; ks < 4; ++ks) o[m][1] = __builtin_amdgcn_mfma_f32_32x32x16_bf16(pw[ks], vfr1[ks], o[m][1], 0, 0, 0); }

            }
        }
    }
#undef ATT_DMA
#undef ATT_DMA_F
#undef ATT_VFRAG
#undef ATT_VTR
#undef ATT_VWAIT
#undef ATT_SRCROW
    __builtin_amdgcn_s_setprio(0);
    ATT_BAR();
    if (KIND) { const LAS float* lp = (const LAS float*)(lds + RING_BYTES + 256); lam = lp[0]; oscale = lp[1]; }
    if (wact) {
#pragma unroll
        for (int m = 0; m < NMAP; ++m) asm volatile("s_nop 15\n\ts_nop 7" : "+v"(o[m][0]), "+v"(o[m][1]));
        float il0, il1 = 0.f;
        { float l = lrun[0]; l += __shfl_xor(l, 32); il0 = l > 0.f ? 1.f / l : 0.f; }
        if (KIND) { float l = lrun[NMAP - 1]; l += __shfl_xor(l, 32); il1 = l > 0.f ? lam / l : 0.f; }
        if (hi == 0) { wsf[r32] = il0; wsf[32 + r32] = il1; }
        f32x4 a0[4], a1[4];
#pragma unroll
        for (int g = 0; g < 4; ++g) { a0[g] = *(const LAS f32x4*)(wsf + 8 * g + 4 * hi); a1[g] = *(const LAS f32x4*)(wsf + 32 + 8 * g + 4 * hi); }
#pragma unroll
        for (int d0 = 0; d0 < 2; ++d0)
#pragma unroll
            for (int r = 0; r < 16; ++r) { float v = o[0][d0][r] * a0[r >> 2][r & 3]; if (KIND) v -= o[NMAP - 1][d0][r] * a1[r >> 2][r & 3];
                ost[crow(r, hi) * OSTW + 32 * d0 + r32] = v; }
        const int row = lane >> 1, half = lane & 1, p = q0 + 32 * w + row;
        f32x4 v[8]; float ss = 0.f;
#pragma unroll
        for (int i = 0; i < 8; ++i) { v[i] = *(const LAS f32x4*)(ost + row * OSTW + 32 * half + 4 * i); ss += (v[i][0] * v[i][0] + v[i][1] * v[i][1]) + (v[i][2] * v[i][2] + v[i][3] * v[i][3]); }
        ss += __shfl_xor(ss, 1);
        const float rs = KIND ? __builtin_amdgcn_rsqf(ss * (1.f / 64.f) + EPS) * oscale : 1.f;
        const int sr = qb >= 0 ? b * TT + p - 64 : ((p >= 48 && b == 0) ? MR + p - 48 : -1);
        if (sr >= 0) { bf16* dst = (bf16*)a.out + (size_t)sr * DM + (KIND ? 768 : 512) + hh * 64 + 32 * half; const float* gn = ain(a, I_DNORM) + li * 64 + 32 * half;
#pragma unroll
            for (int i = 0; i < 4; ++i) { f32x4 x0 = v[2 * i] * rs, x1 = v[2 * i + 1] * rs;
                if (KIND) { const f32x4 g0 = *(const f32x4*)(gn + 8 * i), g1 = *(const f32x4*)(gn + 8 * i + 4); x0 = x0 * g0; x1 = x1 * g1; }
                *(v4u*)(dst + 8 * i) = pack8(x0, x1); } }
    }
    ATT_BAR();
#undef ATT_BAR
}

__device__ __forceinline__ s16x8 ldperm(const bf16* p, int hi) { const s16x4 x = *(const s16x4*)(p + 4 * hi), y = *(const s16x4*)(p + 8 + 4 * hi); return (s16x8){x[0], x[1], x[2], x[3], y[0], y[1], y[2], y[3]}; }
__device__ __forceinline__ s16x8 packacc(const f32x16& v, int k) { v4u u; u.x = pg8::cvt_pk_bf16(v[8 * k], v[8 * k + 1]); u.y = pg8::cvt_pk_bf16(v[8 * k + 2], v[8 * k + 3]); u.z = pg8::cvt_pk_bf16(v[8 * k + 4], v[8 * k + 5]); u.w = pg8::cvt_pk_bf16(v[8 * k + 6], v[8 * k + 7]); return __builtin_bit_cast(s16x8, u); }
__device__ __forceinline__ s16x8 ldperm_lds(const LAS unsigned char* p, int hi) { const s16x4 x = *(const LAS s16x4*)(p + 8 * hi), y = *(const LAS s16x4*)(p + 16 + 8 * hi); return (s16x8){x[0], x[1], x[2], x[3], y[0], y[1], y[2], y[3]}; }
template <int KIND>
__device__ __forceinline__ void lin_mfma_unit(const Args& a, int li, int b, int hp, LAS unsigned char* lds, int tid) {
    constexpr int DK = KIND ? 64 : 32, NDS = DK / 16, NDB = DK / 32, OTW = 68;
    constexpr int QROW = KIND ? 144 : 80, QT = KIND ? RT_T : GQ_T, HB = 2 * QT + VT_T, PPH = HB / 1024, NP = 2 * PPH;
    constexpr int OFF_OT = 2 * HB, OFF_G = OFF_OT + 2 * 64 * OTW * 4;
    static_assert(HB % 1024 == 0 && OFF_G + 256 <= RING_BYTES, "lin unit LDS map");
    const int lane = tid & 63, w = __builtin_amdgcn_readfirstlane(tid >> 6), r32 = lane & 31, hi = lane >> 5, hl = w >> 2, e0 = 32 * ((w >> 1) & 1), ib = w & 1, h = 2 * hp + hl;
    const unsigned char* Qg = a.ws + (KIND ? B_RQ : B_GQ); const unsigned char* Kg = a.ws + (KIND ? B_RK : B_GK);
    const bf16* proj = (const bf16*)(a.ws + B_PROJ); bf16* ob = (bf16*)a.out;
    LAS float* Ot = (LAS float*)(lds + OFF_OT);
    LAS float* Gs = (LAS float*)(lds + OFF_G);
    const LAS unsigned char* Lh = lds + hl * HB;
    const float dret = __builtin_amdgcn_exp2f(64.f * lg2gamma(h));
    f32x16 S[NDB];
#pragma unroll
    for (int db = 0; db < NDB; ++db) S[db] = (f32x16){};
#define LIN_DMA(c_) do { _Pragma("unroll") for (int j_ = 0; j_ < (NP + 7) / 8; ++j_) { const int p_ = w + 8 * j_; if (p_ < NP) { const int hl_ = p_ / PPH, pp_ = p_ % PPH; const size_t blk_ = (size_t)(b * NCH + (c_)) * 4 + 2 * hp + hl_; \
        const unsigned char* src_; \
        if (pp_ < 2 * QT / 1024) src_ = (pp_ < QT / 1024 ? Qg + blk_ * QT + pp_ * 1024 : Kg + blk_ * QT + (pp_ - QT / 1024) * 1024) + lane * 16; \
        else { const int g_ = 64 * (pp_ - 2 * QT / 1024) + lane, s_ = g_ / 9, cc_ = g_ % 9; int sr_ = src_row(b, (c_), s_); sr_ = sr_ < 0 ? MR : sr_;     \
            src_ = (const unsigned char*)(proj + (size_t)sr_ * N1 + (KIND ? C_RV : C_AV) + (2 * hp + hl_) * 64 + (cc_ < 8 ? cc_ : 7) * 8); } \
        __builtin_amdgcn_global_load_lds((const unsigned*)src_, (LAS unsigned*)(lds + hl_ * HB + pp_ * 1024), 16, 0, 0); } } } while (0)
#define LIN_BAR() do { asm volatile("s_waitcnt lgkmcnt(0)" ::: "memory"); __builtin_amdgcn_s_barrier(); asm volatile("" ::: "memory"); } while (0)
    LIN_BAR();
    if (tid < 64) Gs[tid] = ain(a, KIND ? I_RNORM : I_GNORM)[li * 64 + tid];
    LIN_DMA(0);
    const int nh = tid >> 8, nrow = (tid >> 2) & 63, nq = tid & 3, hn = 2 * hp + nh;
    v4u pend[2] = {(v4u){0u, 0u, 0u, 0u}, (v4u){0u, 0u, 0u, 0u}}; bf16* pdst = ob; bool pwr = false;
    for (int c = 0; c < NCH; ++c) {
        asm volatile("s_waitcnt vmcnt(0)" ::: "memory"); LIN_BAR();
        s16x8 qf[NDS], kf0[NDS], kf1[NDS], vf[4], ktf[NDB][4];
        const int sr = src_row(b, c, nrow); const bool wr = sr >= 0 && (c > 0 || b == 0);
#pragma unroll
        for (int ds = 0; ds < NDS; ++ds) { qf[ds] = ldperm_lds(Lh + (32 * ib + r32) * QROW + 32 * ds, hi); kf0[ds] = ldperm_lds(Lh + QT + r32 * QROW + 32 * ds, hi); kf1[ds] = ldperm_lds(Lh + QT + (32 + r32) * QROW + 32 * ds, hi); }
        const int trq = (lane & 15) >> 2, trb = (lane >> 4) & 1, trp = lane & 3;
#pragma unroll
        for (int ks = 0; ks < 4; ++ks) { const LAS unsigned char* vp = Lh + 2 * QT + (16 * ks + 4 * hi + trq) * 144 + (e0 + 16 * trb) * 2 + 8 * trp;
            const s16x4 va = __builtin_bit_cast(s16x4, __builtin_amdgcn_ds_read_tr16_b64_v4i16((LAS v4i16_t*)vp)), vb = __builtin_bit_cast(s16x4, __builtin_amdgcn_ds_read_tr16_b64_v4i16((LAS v4i16_t*)(vp + 8 * 144)));
            vf[ks] = (s16x8){va[0], va[1], va[2], va[3], vb[0], vb[1], vb[2], vb[3]}; }
        asm volatile("" ::: "memory");
        if (pwr) { *(v4u*)pdst = pend[0]; *(v4u*)(pdst + 8) = pend[1]; }
        f32x16 aA = (f32x16){}, aB = (f32x16){};
#pragma unroll
        for (int ds = 0; ds < NDS; ++ds) { aA = __builtin_amdgcn_mfma_f32_32x32x16_bf16(kf0[ds], qf[ds], aA, 0, 0, 0); if (ib) aB = __builtin_amdgcn_mfma_f32_32x32x16_bf16(kf1[ds], qf[ds], aB, 0, 0, 0); }
        asm volatile("s_nop 15\n\ts_nop 15" : "+v"(aA), "+v"(aB));
#pragma unroll
        for (int r = 0; r < 16; ++r) if (crow(r, hi) > r32) { if (ib) aB[r] = 0.f; else aA[r] = 0.f; }
        f32x16 O = (f32x16){};
#pragma unroll
        for (int db = 0; db < NDB; ++db)
#pragma unroll
            for (int ksub = 0; ksub < 2; ++ksub) O = __builtin_amdgcn_mfma_f32_32x32x16_bf16(qf[2 * db + ksub], packacc(S[db], ksub), O, 0, 0, 0);
#pragma unroll
        for (int ksub = 0; ksub < 2; ++ksub) { O = __builtin_amdgcn_mfma_f32_32x32x16_bf16(packacc(aA, ksub), vf[ksub], O, 0, 0, 0); if (ib) O = __builtin_amdgcn_mfma_f32_32x32x16_bf16(packacc(aB, ksub), vf[2 + ksub], O, 0, 0, 0); }
#pragma unroll
        for (int db = 0; db < NDB; ++db)
#pragma unroll
            for (int ks = 0; ks < 4; ++ks) { const LAS unsigned char* kp = Lh + QT + (16 * ks + 4 * hi + trq) * QROW + (32 * db + 16 * trb) * 2 + 8 * trp;
                const s16x4 ka = __builtin_bit_cast(s16x4, __builtin_amdgcn_ds_read_tr16_b64_v4i16((LAS v4i16_t*)kp)), kb = __builtin_bit_cast(s16x4, __builtin_amdgcn_ds_read_tr16_b64_v4i16((LAS v4i16_t*)(kp + 8 * QROW)));
                ktf[db][ks] = (s16x8){ka[0], ka[1], ka[2], ka[3], kb[0], kb[1], kb[2], kb[3]}; }
        LIN_BAR();
        v4u og[2];
#pragma unroll
        for (int i = 0; i < 2; ++i) og[i] = wr ? *(const v4u*)(proj + (size_t)sr * N1 + (KIND ? C_ROG : C_AOG) + hn * 64 + 16 * nq + 8 * i) : (v4u){0u, 0u, 0u, 0u};
        f32x4 dvv[4];
        if (!KIND) { const float* dp = (const float*)(a.ws + WS_GD) + ((size_t)(b * NCH + c) * 4 + h) * 32;
#pragma unroll
            for (int g = 0; g < 4; ++g) dvv[g] = *(const f32x4*)(dp + 8 * g + 4 * hi); }
        if (c + 1 < NCH) LIN_DMA(c + 1);
#pragma unroll
        for (int db = 0; db < NDB; ++db) {
#pragma unroll
            for (int ks = 0; ks < 4; ++ks) S[db] = __builtin_amdgcn_mfma_f32_32x32x16_bf16(ktf[db][ks], vf[ks], S[db], 0, 0, 0); }
        asm volatile("s_nop 15\n\ts_nop 15" : "+v"(O));
#pragma unroll
        for (int db = 0; db < NDB; ++db) asm volatile("s_nop 15\n\ts_nop 15" : "+v"(S[db]));
#pragma unroll
        for (int db = 0; db < NDB; ++db) {
            if (KIND) { S[db] = S[db] * dret; }
            else {
#pragma unroll
                for (int g = 0; g < 4; ++g) { S[db][4 * g] *= dvv[g][0]; S[db][4 * g + 1] *= dvv[g][1]; S[db][4 * g + 2] *= dvv[g][2]; S[db][4 * g + 3] *= dvv[g][3]; } } }
#pragma unroll
        for (int r = 0; r < 16; ++r) Ot[(hl * 64 + 32 * ib + crow(r, hi)) * OTW + e0 + r32] = O[r];
        LIN_BAR();
        { f32x4 v[4]; float s1 = 0.f;
#pragma unroll
            for (int i = 0; i < 4; ++i) { v[i] = *(const LAS f32x4*)(Ot + (nh * 64 + nrow) * OTW + 16 * nq + 4 * i); s1 += (v[i][0] + v[i][1]) + (v[i][2] + v[i][3]); }
            float mean = 0.f; if (KIND) { s1 += __shfl_xor(s1, 1); s1 += __shfl_xor(s1, 2); mean = s1 * (1.f / 64.f); }
            float s2 = 0.f;
#pragma unroll
            for (int i = 0; i < 4; ++i) { v[i] = v[i] - mean; s2 += (v[i][0] * v[i][0] + v[i][1] * v[i][1]) + (v[i][2] * v[i][2] + v[i][3] * v[i][3]); }
            s2 += __shfl_xor(s2, 1); s2 += __shfl_xor(s2, 2);
            const float rs = __builtin_amdgcn_rsqf(s2 * (1.f / 64.f) + EPS);
            pwr = wr;
            if (wr) { bf16* dst = ob + (size_t)sr * DM + KIND * 256 + hn * 64 + 16 * nq; const LAS float* gp = Gs + 16 * nq; pdst = dst;
#pragma unroll
                for (int i = 0; i < 2; ++i) { const v4u g4 = og[i]; const f32x4 g0 = *(const LAS f32x4*)(gp + 8 * i), g1 = *(const LAS f32x4*)(gp + 8 * i + 4);
                    f32x4 x0 = v[2 * i] * rs * g0, x1 = v[2 * i + 1] * rs * g1;
                    x0[0] *= silu_f(bflo(g4.x)); x0[1] *= silu_f(bfhi(g4.x)); x0[2] *= silu_f(bflo(g4.y)); x0[3] *= silu_f(bfhi(g4.y)); x1[0] *= silu_f(bflo(g4.z)); x1[1] *= silu_f(bfhi(g4.z)); x1[2] *= silu_f(bflo(g4.w)); x1[3] *= silu_f(bfhi(g4.w));
                    pend[i] = pack8(x0, x1); } } }
        LIN_BAR();
    }
    if (pwr) { *(v4u*)pdst = pend[0]; *(v4u*)(pdst + 8) = pend[1]; }
    asm volatile("s_waitcnt vmcnt(0)" ::: "memory");
#undef LIN_DMA
#undef LIN_BAR
}

template <int MODE, int KSTEPS  >
__device__ __forceinline__ void thin_unit(const bf16* A, int lda, const bf16* Bt, int u, bf16* H, float* stats_out, const float* stats_in, bf16* ACT, LAS unsigned char* lds, int tid) {
    constexpr int K = KSTEPS * 256;
    const int lane = tid & 63, w = __builtin_amdgcn_readfirstlane(tid >> 6), fr = lane & 15, fq = lane >> 4;
    int brow[4];
#pragma unroll
    for (int nb = 0; nb < 4; ++nb) brow[nb] = MODE != 1 ? 64 * u + 16 * nb + fr : 256 * (u >> 2) + 32 * (u & 3) + (nb >> 1) * 128 + 16 * (nb & 1) + fr;
    f32x4 acc[4];
#pragma unroll
    for (int nb = 0; nb < 4; ++nb) acc[nb] = (f32x4){0.f, 0.f, 0.f, 0.f};
    const bf16* ap = A + (size_t)fr * lda + w * (KSTEPS * 32) + 8 * fq;
    constexpr int B1 = KSTEPS > 6 ? 6 : KSTEPS;
    { s16x8 af[B1], bf[B1][4];
#pragma unroll
        for (int s = 0; s < B1; ++s) { af[s] = *(const s16x8*)(ap + 32 * s);
#pragma unroll
            for (int nb = 0; nb < 4; ++nb) bf[s][nb] = *(const s16x8*)(Bt + (size_t)brow[nb] * K + w * (KSTEPS * 32) + 32 * s + 8 * fq); }
#pragma unroll
        for (int s = 0; s < B1; ++s)
#pragma unroll
            for (int nb = 0; nb < 4; ++nb) acc[nb] = __builtin_amdgcn_mfma_f32_16x16x32_bf16(bf[s][nb], af[s], acc[nb], 0, 0, 0); }
    if (KSTEPS > B1) { constexpr int B2 = KSTEPS > B1 ? KSTEPS - B1 : 1; s16x8 af[B2], bf[B2][4];
#pragma unroll
        for (int s = 0; s < B2; ++s) { af[s] = *(const s16x8*)(ap + 32 * (B1 + s));
#pragma unroll
            for (int nb = 0; nb < 4; ++nb) bf[s][nb] = *(const s16x8*)(Bt + (size_t)brow[nb] * K + w * (KSTEPS * 32) + 32 * (B1 + s) + 8 * fq); }
#pragma unroll
        for (int s = 0; s < B2; ++s)
#pragma unroll
            for (int nb = 0; nb < 4; ++nb) acc[nb] = __builtin_amdgcn_mfma_f32_16x16x32_bf16(bf[s][nb], af[s], acc[nb], 0, 0, 0); }
    asm volatile("s_nop 15" : "+v"(acc[0]), "+v"(acc[1]), "+v"(acc[2]), "+v"(acc[3]));
    LAS f32x4* part = (LAS f32x4*)lds;
    __syncthreads();
#pragma unroll
    for (int nb = 0; nb < 4; ++nb) part[(w * 4 + nb) * 64 + lane] = acc[nb];
    __syncthreads();
    if (w == 0) {
#pragma unroll
        for (int nb = 0; nb < 4; ++nb) {
#pragma unroll
            for (int w2 = 1; w2 < 8; ++w2) acc[nb] = acc[nb] + part[(w2 * 4 + nb) * 64 + lane]; }
        const int row = MR + fr;
        if (MODE == 0) { float ss = 0.f;
#pragma unroll
            for (int nb = 0; nb < 4; ++nb) { bf16* p = H + (size_t)row * DM + 64 * u + 16 * nb + 4 * fq; const v2u wv = *(const v2u*)p;
                const float x0 = acc[nb][0] + bflo(wv.x), x1 = acc[nb][1] + bfhi(wv.x), x2 = acc[nb][2] + bflo(wv.y), x3 = acc[nb][3] + bfhi(wv.y);
                ss += (x0 * x0 + x1 * x1) + (x2 * x2 + x3 * x3);
                v2u o; o.x = pg8::cvt_pk_bf16(x0, x1); o.y = pg8::cvt_pk_bf16(x2, x3); *(v2u*)p = o; }
            ss += __shfl_xor(ss, 16); ss += __shfl_xor(ss, 32);
            if (fq == 0) stats_out[(size_t)row * 16 + u] = ss;
        } else if (MODE == 2) { const f32x4* sp = (const f32x4*)(stats_in + (size_t)row * 16); const f32x4 s0 = sp[0], s1 = sp[1], s2 = sp[2], s3 = sp[3];
            const float st = ((s0[0] + s0[1]) + (s0[2] + s0[3])) + ((s1[0] + s1[1]) + (s1[2] + s1[3])) + ((s2[0] + s2[1]) + (s2[2] + s2[3])) + ((s3[0] + s3[1]) + (s3[2] + s3[3]));
            const float rs = __builtin_amdgcn_rsqf(st * (1.f / 1024.f) + EPS);
#pragma unroll
            for (int nb = 0; nb < 4; ++nb) { v2u o; o.x = pg8::cvt_pk_bf16(acc[nb][0] * rs, acc[nb][1] * rs); o.y = pg8::cvt_pk_bf16(acc[nb][2] * rs, acc[nb][3] * rs);
                *(v2u*)(ACT + (size_t)row * N1 + 64 * u + 16 * nb + 4 * fq) = o; }
        } else { const f32x4* sp = (const f32x4*)(stats_in + (size_t)row * 16); const f32x4 s0 = sp[0], s1 = sp[1], s2 = sp[2], s3 = sp[3];
            const float st = ((s0[0] + s0[1]) + (s0[2] + s0[3])) + ((s1[0] + s1[1]) + (s1[2] + s1[3])) + ((s2[0] + s2[1]) + (s2[2] + s2[3])) + ((s3[0] + s3[1]) + (s3[2] + s3[3]));
            const float rs = __builtin_amdgcn_rsqf(st * (1.f / 1024.f) + EPS);
#pragma unroll
            for (int nb = 0; nb < 2; ++nb) { float y[4];
#pragma unroll
                for (int t = 0; t < 4; ++t) y[t] = silu_f(acc[nb][t] * rs) * (acc[2 + nb][t] * rs);
                v2u o; o.x = pg8::cvt_pk_bf16(y[0], y[1]); o.y = pg8::cvt_pk_bf16(y[2], y[3]);
                *(v2u*)(ACT + (size_t)row * DFF + 128 * (u >> 2) + 32 * (u & 3) + 16 * nb + 4 * fq) = o; } }
    }
    __syncthreads();
}

#ifndef REP_PREP
#define REP_PREP 1
#endif
#ifndef REP_MIX
#define REP_MIX 1
#endif
#ifndef REP_P0
#define REP_P0 1
#endif
#ifndef REP_CONV
#define REP_CONV 1
#endif
#ifndef REP_G1
#define REP_G1 1
#endif
#ifndef REP_MGU
#define REP_MGU 1
#endif
#ifndef REP_MDN
#define REP_MDN 1
#endif
#ifndef REP_BAR
#define REP_BAR 0
#endif
#ifndef REP_PART
#define REP_PART -1
#endif
#ifndef REP_FGU
#define REP_FGU 1
#endif
#ifndef MK_ONE_LAUNCH
#define MK_ONE_LAUNCH 1
#endif
constexpr int NPHASE = 18;
constexpr int CW_Q = 12288;
__global__ void __launch_bounds__(512, 2) mega_fwd(Args a) {
    extern __shared__ __attribute__((aligned(16))) unsigned char lds_raw[];
    LAS unsigned char* lds = (LAS unsigned char*)lds_raw;
    volatile LAS unsigned* MISC = (volatile LAS unsigned*)(lds + MISC_OFF);
    int wave = __builtin_amdgcn_readfirstlane((int)threadIdx.x >> 6); asm volatile("" : "+s"(wave));
    const int G = gridDim.x;
#define TID() ((wave << 6) + lane_id())
    for (int u = TID(); u < (LDS_BYTES - RING_BYTES) / 4; u += 512) ((LAS unsigned*)(lds + RING_BYTES))[u] = 0u;
    __syncthreads();
    gu32* ctl = (gu32*)(a.ws + WS_CTL);
    const int lo = a.ph_lo, hi = a.ph_hi;
    XcdBarrier bar; bar.bar = (unsigned*)(ctl + CW_BAR); bar.x = 0; bar.st = nullptr;
    if (hi - lo > 1) bar = xcd_barrier_post((unsigned*)(ctl + CW_BAR), MISC + 8, TID() == 0);
#define IN(k) (lo <= (k) && (k) < hi)
#define OPQ() int ptid = TID(); asm volatile("" : "+v"(ptid)); const int plane = ptid & 63; (void)plane
#define SEAM(k) do { if (IN(k) && IN((k) + 1)) xcd_barrier(bar, TID() == 0); } while (0)
#define hb ((bf16*)(a.ws + WS_HB))
#define stA ((float*)(a.ws + WS_STA))
#define stB ((float*)(a.ws + WS_STB))

    for (int rep = 0; rep < REP_BAR; ++rep) xcd_barrier(bar, TID() == 0);
    if (IN(0)) { OPQ(); for (int rep = 0; rep < REP_P0; ++rep) { p0_prologue(a, lds, ptid, plane, wave); __syncthreads(); } }
    SEAM(0);

    for (int li = 0; li < 2; ++li) {
        const int pb = 1 + 6 * li;
        if (IN(pb)) {
            { OPQ(); for (int u = blockIdx.x; u < N1 / 64; u += G) thin_unit<2, 4>(hb + (size_t)MR * DM, DM, (const bf16*)(a.ws + WS_W1T + li * W1T_BYTES), u, nullptr, nullptr, stA, (bf16*)(a.ws + B_PROJ), lds, ptid); }
            pg8::Gemm g{hb, (const bf16*)(a.ws + WS_W1T + li * W1T_BYTES), DM, 0, nullptr}; pg8::StaticOrder S; S.init(NPAN - 1, N1 / 256, G, (int)blockIdx.x);
            EpiProj E{(bf16*)(a.ws + B_PROJ), stA};
            for (int rep = 0; rep < REP_G1; ++rep) pg8::gemm_phase<EpiProj, pg8::StaticOrder, false>(lds, g, S, E, wave);
        }
        SEAM(pb);
        if (IN(pb + 1)) { OPQ(); for (int rep = 0; rep < REP_PREP; ++rep) for (int u = blockIdx.x; u < NB * NCH * 3; u += G) { const int part = u % 3;     if (rep > 0 && REP_PART >= 0 && part != REP_PART) continue; int ut = ptid; asm volatile("" : "+v"(ut)); prep2_unit(a, li, (u / 3) / NCH, (u / 3) % NCH, part, lds, ut); } __syncthreads(); }
        if (IN(pb + 2)) { OPQ(); const int tid = ptid;
            float lam, lam_init; { const float* lv = ain(a, I_DLAM) + li * 128; float s01 = 0.f, s23 = 0.f;
                for (int d = 0; d < 32; ++d) { s01 += lv[d] * lv[32 + d]; s23 += lv[64 + d] * lv[96 + d]; }
                lam_init = 0.8f - 0.6f * __expf(-0.3f * (float)li); lam = __expf(s01) - __expf(s23) + lam_init;
                if (tid == 0) { LAS float* lp = (LAS float*)(lds + RING_BYTES + 256); lp[0] = lam; lp[1] = 1.f - lam_init; } } }
        SEAM(pb + 1);
        if (IN(pb + 2)) {
            OPQ(); const int tid = ptid;
            LAS int* qid = (LAS int*)(lds + RING_BYTES + 64);
            for (int rep = 0; rep < REP_MIX; ++rep) { bool first = true;
            for (;;) {
                __syncthreads();
                if (tid == 0) *qid = first ? (int)blockIdx.x : G + (int)__hip_atomic_fetch_add(ctl + CW_Q + 64 * (li + 2 * rep), 1u, RLX_AGENT);
                first = false;
                __syncthreads();
                const int id = *qid;
                int utid = ptid; asm volatile("" : "+v"(utid));
                if (id >= 64 + 1024 + 8) break;
                if (id < 64) { if ((id & 1) == 0) lin_mfma_unit<0>(a, li, (id >> 1) & 15, id >> 5, lds, utid); else lin_mfma_unit<1>(a, li, (id >> 1) & 15, id >> 5, lds, utid); }
                else { const int v = id - 64; int qb, kind, b, hh;
                    if (v < 1024) { qb = 7 - (v >> 7); const int rem = v & 127; kind = 1 - (rem >> 6);     b = (rem >> 2) & 15; hh = rem & 3; } else { qb = -1; kind = (v - 1024) >> 2; b = 0; hh = v & 3; }
                    if (kind == 0) attn_mfma_unit<0>(a, li, b, hh, qb, lds, utid, 0.f, 1.f); else attn_mfma_unit<1>(a, li, b, hh, qb, lds, utid, 0.f, 0.f); }
            } }
        }
        SEAM(pb + 2);
        if (IN(pb + 3)) {
            if (li == 0) { OPQ(); for (int u = blockIdx.x; u < 16; u += G) thin_unit<0, 4>((const bf16*)a.out + (size_t)MR * DM, DM, (const bf16*)(a.ws + WS_WOT), u, hb, stB, nullptr, nullptr, lds, ptid); }
            pg8::Gemm g{(const bf16*)a.out, (const bf16*)(a.ws + WS_WOT + li * WOT_BYTES), DM, 0, nullptr}; pg8::StaticOrder S; S.init(NPAN - 1, 4, G, (int)blockIdx.x);
            EpiResid E{hb, stB, li == 0 ? a.ws + B_HB8D : nullptr, 1.f};
            pg8::gemm_phase<EpiResid, pg8::StaticOrder, false>(lds, g, S, E, wave);
        }
        SEAM(pb + 3);
        if (li == 0) {
            if (IN(5)) {
                { OPQ(); for (int u = blockIdx.x; u < 88; u += G) thin_unit<1, 4>(hb + (size_t)MR * DM, DM, (const bf16*)(a.ws + WS_WGU), u, nullptr, nullptr, stB, (bf16*)(a.ws + B_ACTT), lds, ptid); }
                pg8::Gemm g{(const bf16*)(a.ws + B_HB8D), (const bf16*)(a.ws + WS_WGU8), DM / 2, 0, nullptr}; pg8::StaticOrder S; S.init(NPAN - 1, 2 * DFF / 256, G, (int)blockIdx.x);
                EpiSwiglu E{a.ws + B_ACT, DFF, stB, 1.f / W8_SCALE};
                for (int rep = 0; rep < REP_FGU; ++rep) pg8::gemm_phase<EpiSwiglu, pg8::StaticOrder, false, true>(lds, g, S, E, wave);
            }
            SEAM(5);
            if (IN(6)) {
                { OPQ(); for (int u = blockIdx.x; u < 16; u += G) thin_unit<0, 11>((const bf16*)(a.ws + B_ACTT) + (size_t)MR * DFF, DFF, (const bf16*)(a.ws + WS_WD), u, hb, stA, nullptr, nullptr, lds, ptid); }
                pg8::Gemm g{(const bf16*)(a.ws + B_ACT), (const bf16*)(a.ws + WS_WD), DFF, 0, nullptr}; pg8::StaticOrder S; S.init(NPAN - 1, 4, G, (int)blockIdx.x);
                EpiResid E{hb, stA, nullptr, 1.f};
                pg8::gemm_phase<EpiResid, pg8::StaticOrder, false>(lds, g, S, E, wave);
            }
            SEAM(6);
        }
    }
    if (IN(11)) { OPQ(); const int tid = ptid, lane = plane;
        LAS float* scr = (LAS float*)(lds + wave * 16384);
        const int gw = blockIdx.x * 8 + wave, NGW = G * 8;
        constexpr int IG = 8 * 56, ID = 28 * 16;
        for (int rep = 0; rep < REP_CONV; ++rep)
        for (int it = gw; it < 8 * (2 * IG + ID); it += NGW) { const int e = it / (2 * IG + ID); int r = it % (2 * IG + ID);
            if (r < IG) { transpose_item_f8<true>(ain(a, I_EG) + (size_t)e * DM * DFE, DM, DFE, ain(a, I_FNORM) + DM, a.ws + B_EGU + e * EGU_BYTES, r / 56, r % 56, 1, scr, lane); continue; } r -= IG;
            if (r < IG) { transpose_item_f8<true>(ain(a, I_EU) + (size_t)e * DM * DFE, DM, DFE, ain(a, I_FNORM) + DM, a.ws + B_EGU + e * EGU_BYTES, r / 56, r % 56, 2, scr, lane); continue; } r -= IG;
            transpose_item_f8<false>(ain(a, I_ED) + (size_t)e * DFE * DM, DFE, DM, nullptr, a.ws + B_ED + e * ED_BYTES, r / 16, r % 16, 0, scr, lane); }
        for (int i = blockIdx.x * 512 + tid; i < MAXPAN * 256; i += G * 512) { ((int*)(a.ws + MO_ROWIDX))[i] = -1; ((int*)(a.ws + MO_PDST))[i] = -1; ((f32x2*)(a.ws + MO_PINFO))[i] = (f32x2){0.f, 0.f}; }
        for (int blk = blockIdx.x; blk < MR / 128; blk += G) route_block(a, blk, lds, tid, lane, wave);
    }
    SEAM(11);
    LAS int* offs = (LAS int*)(lds + RING_BYTES + 128);
    if (IN(12)) { OPQ(); const int tid = ptid;
        moe_offsets(a, offs, tid);
        for (int idx = blockIdx.x * 512 + tid; idx < 2 * MR; idx += G * 512) { const int tok = idx >> 1, e = ((const int*)(a.ws + MO_TOKE))[idx], gpos = offs[e] + ((const int*)(a.ws + MO_TOKP))[idx];
            const f32x4* sp = (const f32x4*)(stB + (size_t)tok * 16); const f32x4 s0 = sp[0], s1 = sp[1], s2 = sp[2], s3 = sp[3];
            const float ss = ((s0[0] + s0[1]) + (s0[2] + s0[3])) + ((s1[0] + s1[1]) + (s1[2] + s1[3])) + ((s2[0] + s2[1]) + (s2[2] + s2[3])) + ((s3[0] + s3[1]) + (s3[2] + s3[3]));
            ((int*)(a.ws + MO_ROWIDX))[gpos] = tok; ((int*)(a.ws + MO_PDST))[gpos] = idx;
            ((f32x2*)(a.ws + MO_PINFO))[gpos] = (f32x2){__builtin_amdgcn_rsqf(ss * (1.f / 1024.f) + EPS), __int_as_float(((const int*)(a.ws + MO_TOKW))[idx])}; }
        if (blockIdx.x == 0 && tid < MAXPAN + 8) { int e = 0;
            for (int k = 1; k < 8; ++k) if (tid * 256 >= offs[k]) e = k;
            ((int*)(a.ws + MO_PEXP))[tid] = e; }
    }
    SEAM(12);
    int nT = 0; if (IN(13) || IN(14) || IN(15) || IN(16)) { moe_offsets(a, offs, TID()); nT = __builtin_amdgcn_readfirstlane(offs[8]); }
    const int nA = nT < 128 ? nT : 128, nB = nT < 128 ? 0 : (nT - 128 < 128 ? nT - 128 : 128), nC = nT <= 256 ? 0 : (nT - 256 < 8 ? nT - 256 : 8);
#pragma unroll 1
    for (int job = 0; job < 5; ++job) {
        const int ph = job == 0 ? 13 : job == 1 ? 14 : job <= 3 ? 15 : 16;
        if (IN(ph)) {
            if (job == 0 || job == 3) {
                const int nP = job == 0 ? nA + nC : nB;
                if (nP > 0) { pg8::Gemm g{(const bf16*)(a.ws + B_HB8), (const bf16*)(a.ws + B_EGU), DM / 2, EGU_BYTES, (const int*)(a.ws + MO_ROWIDX)};     pg8::MoeOrder S; S.init(nP, 2 * DFE / 256, G, (int)blockIdx.x, job == 0 ? 0 : 128, (const int*)(a.ws + MO_PEXP));
                    if (job == 0) { S.psplit = nA; S.p1 = 256; } else if (nC > 0 && (nB * (2 * DFE / 256)) % G == 0 && 16 * nC <= G) S.H = 4 * nC;
                    EpiSwigluMoe E{a.ws + B_EACT, (const f32x2*)(a.ws + MO_PINFO), 1.f / W8_SCALE};
                    for (int rep = 0; rep < REP_MGU; ++rep) pg8::gemm_phase<EpiSwigluMoe, pg8::MoeOrder, true, true>(lds, g, S, E, wave); }
            } else {
                const int nP = job == 1 ? nA : job == 2 ? nC : nB, p0 = job == 1 ? 0 : job == 2 ? 256 : 128;
                if (nP > 0) { pg8::Gemm g{(const bf16*)(a.ws + B_EACT + (job == 2 ? (size_t)128 * 256 * DFE : (size_t)0)), (const bf16*)(a.ws + B_ED), DFE / 2, ED_BYTES, nullptr};     pg8::MoeOrder S; S.init(nP, 4, G, (int)blockIdx.x, p0, (const int*)(a.ws + MO_PEXP));
                    EpiMoeDown E{(unsigned char*)a.out, (const int*)(a.ws + MO_PDST), (const f32x2*)(a.ws + MO_PINFO), 1.f / (W8_SCALE * ACT8_SCALE)};
                    for (int rep = 0; rep < REP_MDN; ++rep) pg8::gemm_phase<EpiMoeDown, pg8::MoeOrder, false, true>(lds, g, S, E, wave); }
            }
        }
        if (job != 2) SEAM(ph);
    }
    if (IN(17)) { OPQ(); const int lane = plane;
        const float* fn = ain(a, I_FINAL);
        for (int r = blockIdx.x * 8 + wave; r < MR; r += G * 8) {
            unsigned char* orow = (unsigned char*)a.out + (size_t)r * 4096; float v[16]; float ss = 0.f;
#pragma unroll
            for (int hf = 0; hf < 2; ++hf) { const int k = 512 * hf + 8 * lane; const v4u h4 = *(const v4u*)(hb + (size_t)r * DM + k), y0 = *(const v4u*)(orow + 2 * k), y1 = *(const v4u*)(orow + 2048 + 2 * k);
                const unsigned hw[4] = {h4.x, h4.y, h4.z, h4.w}, aw[4] = {y0.x, y0.y, y0.z, y0.w}, bw[4] = {y1.x, y1.y, y1.z, y1.w};
#pragma unroll
                for (int t = 0; t < 4; ++t) { const float x0 = bflo(hw[t]) + bflo(aw[t]) + bflo(bw[t]), x1 = bfhi(hw[t]) + bfhi(aw[t]) + bfhi(bw[t]); v[8 * hf + 2 * t] = x0; v[8 * hf + 2 * t + 1] = x1; ss += x0 * x0 + x1 * x1; } }
            ss = wave_sum(ss); const float rs = __builtin_amdgcn_rsqf(ss * (1.f / 1024.f) + EPS);
#pragma unroll
            for (int hf = 0; hf < 2; ++hf) { const int k = 512 * hf + 8 * lane; const f32x4 g0 = *(const f32x4*)(fn + k), g1 = *(const f32x4*)(fn + k + 4);
                *(f32x4*)(orow + 4 * k) = (f32x4){v[8 * hf] * rs * g0[0], v[8 * hf + 1] * rs * g0[1], v[8 * hf + 2] * rs * g0[2], v[8 * hf + 3] * rs * g0[3]};
                *(f32x4*)(orow + 4 * k + 16) = (f32x4){v[8 * hf + 4] * rs * g1[0], v[8 * hf + 5] * rs * g1[1], v[8 * hf + 6] * rs * g1[2], v[8 * hf + 7] * rs * g1[3]}; }
        }
    }
#undef IN
#undef SEAM
#undef hb
#undef stA
#undef stB
}

extern "C" void kernel_launch(void* const* d_in, const int* in_sizes, int n_in, void* d_out, int out_size, void* d_ws, size_t ws_size, hipStream_t stream) {
    static int grid = 0;
    if (grid == 0) {
        if (n_in != 24 || in_sizes[0] != MR * DM || out_size != MR * DM || ws_size < WS_NEED) { fprintf(stderr, "kernel_launch: unexpected problem (n_in %d, in0 %d, out %d, ws %zu < %zu)\n", n_in, n_in > 0 ? in_sizes[0] : -1, out_size, ws_size, (size_t)WS_NEED); grid = -1; return; }
        int dev = 0, cus = 0, per_cu = 0;
        if (hipGetDevice(&dev) != hipSuccess || hipDeviceGetAttribute(&cus, hipDeviceAttributeMultiprocessorCount, dev) != hipSuccess) { grid = -1; return; }
        if (hipFuncSetAttribute((const void*)mega_fwd, hipFuncAttributeMaxDynamicSharedMemorySize, LDS_BYTES) != hipSuccess) { fprintf(stderr, "kernel_launch: hipFuncSetAttribute failed\n"); grid = -1; return; }
        if (hipOccupancyMaxActiveBlocksPerMultiprocessor(&per_cu, (const void*)mega_fwd, 512, LDS_BYTES) != hipSuccess || per_cu < 1) fprintf(stderr, "kernel_launch: occupancy query reports %d\n", per_cu);
        (void)hipGetLastError();
        grid = cus;
    }
    if (grid < 0) return;
    if (hipMemsetAsync((char*)d_ws + WS_CTL, 0, CTL_BYTES, stream) != hipSuccess) return;
    Args a{};
    for (int i = 0; i < 24; ++i) a.in[i] = (const float*)d_in[i];
    a.out = (float*)d_out; a.ws = (unsigned char*)d_ws;
#if MK_ONE_LAUNCH
    a.ph_lo = 0; a.ph_hi = NPHASE;
    hipLaunchKernelGGL(mega_fwd, dim3(grid), dim3(512), LDS_BYTES, stream, a);
#else
    for (int p = 0; p < NPHASE; ++p) { a.ph_lo = p; a.ph_hi = p + 1; hipLaunchKernelGGL(mega_fwd, dim3(grid), dim3(512), LDS_BYTES, stream, a); }
#endif
}
```
